# Optimizing an MI355X kernel written in HIP

```python
import jax
import jax.numpy as jnp
from jax import lax
import numpy as np

D_MODEL = 1024
BATCH = 2
SEQ = 8192
DEPTH = 1

MEM_LEN = 256
NORM_EPS = 1e-6

A_GROUPS = ((128, 1), (512, 4), (2048, 16))
A_N_GROUPS = len(A_GROUPS)
A_HEADS = 4
A_HEAD_DIM = 128
A_WIDTH = A_HEADS * A_HEAD_DIM
BLOCK = 128

R_HEAD = 64
R_HEADS = 8
R_WIDTH = R_HEADS * R_HEAD
R_DECAY_LORA = 64
R_AAA_LORA = 64
R_GATE_LORA = 128
R_GN_EPS = 64e-5

C_HEADS = 4
C_HEAD_DIM = 128
C_WIDTH = C_HEADS * C_HEAD_DIM

ROPE_THETA = 500000.0
ROT_DIM = A_HEAD_DIM // 4

N_BRANCH = 3
BRANCH_WIDTH = 512

N_EXPERTS = 32
TOP_K = 4
D_FF = D_MODEL
SWIGLU_ALPHA = 1.702
SWIGLU_LIMIT = 7.0
MOE_ROWS = 256

A_QKV_COLS = A_N_GROUPS * A_WIDTH
R_COLS = 3 * R_WIDTH + R_DECAY_LORA + R_AAA_LORA + R_GATE_LORA
R_SPLITS = (R_WIDTH, 2 * R_WIDTH, 3 * R_WIDTH, 3 * R_WIDTH + R_DECAY_LORA,
            3 * R_WIDTH + R_DECAY_LORA + R_AAA_LORA)
GATE_COLS = N_BRANCH * D_MODEL
OFF_AQ = 0
OFF_AK = OFF_AQ + A_QKV_COLS
OFF_AV = OFF_AK + A_QKV_COLS
OFF_R = OFF_AV + A_QKV_COLS
OFF_CQ = OFF_R + R_COLS
OFF_GATE = OFF_CQ + C_WIDTH
IN_COLS = OFF_GATE + GATE_COLS

kernel_name = 'hybrid_dilated_rwkv7_memxattn_moe_layer'


def rms_norm(t, gain, eps=NORM_EPS):
    tf = t.astype(jnp.float32)
    y = tf * lax.rsqrt(jnp.mean(tf * tf, axis=-1, keepdims=True) + eps)
    return (y * gain.astype(jnp.float32)).astype(t.dtype)


def partial_rotary(t, positions):
    half = ROT_DIM // 2
    inv_freq = ROPE_THETA ** (-jnp.arange(half, dtype=jnp.float32) / half)
    ang = positions.astype(jnp.float32)[..., None] * inv_freq
    ang = ang.reshape(ang.shape[:2] + (1,) * (t.ndim - 3) + (half,))
    cos, sin = jnp.cos(ang), jnp.sin(ang)
    tf = t.astype(jnp.float32)
    t1, t2, rest = tf[..., :half], tf[..., half:ROT_DIM], tf[..., ROT_DIM:]
    out = jnp.concatenate([t1 * cos - t2 * sin, t2 * cos + t1 * sin, rest], axis=-1)
    return out.astype(t.dtype)


def banded_causal_attention(q, k, v, span):
    n, length, heads, dh = q.shape
    n_blk = -(-length // BLOCK)
    pad = n_blk * BLOCK - length
    qp = jnp.pad(q, ((0, 0), (0, pad), (0, 0), (0, 0)))
    kp = jnp.pad(k, ((0, 0), (span, pad), (0, 0), (0, 0)))
    vp = jnp.pad(v, ((0, 0), (span, pad), (0, 0), (0, 0)))
    scale = dh ** -0.5
    qi = jnp.arange(BLOCK)[:, None]
    ki = jnp.arange(BLOCK + span)[None, :]
    rel = qi + span - ki

    def one_block(blk):
        s0 = blk * BLOCK
        qb = lax.dynamic_slice_in_dim(qp, s0, BLOCK, axis=1)
        kb = lax.dynamic_slice_in_dim(kp, s0, BLOCK + span, axis=1)
        vb = lax.dynamic_slice_in_dim(vp, s0, BLOCK + span, axis=1)
        s = jnp.einsum('nqhd,nkhd->nhqk', qb, kb, preferred_element_type=jnp.float32) * scale
        valid = (rel >= 0) & (rel <= span) & (s0 - span + ki >= 0)
        s = jnp.where(valid, s, -jnp.inf)
        m = jnp.max(s, axis=-1, keepdims=True)
        p = jnp.exp(s - m)
        denom = jnp.sum(p, axis=-1, keepdims=True)
        o = jnp.einsum('nhqk,nkhd->nqhd', p, vb.astype(jnp.float32))
        o = o / jnp.transpose(denom, (0, 2, 1, 3))
        lse = jnp.swapaxes((m + jnp.log(denom))[..., 0], 1, 2)
        return o.astype(q.dtype), lse

    o, lse = lax.map(one_block, jnp.arange(n_blk))
    o = jnp.moveaxis(o, 0, 1).reshape(n, n_blk * BLOCK, heads, dh)[:, :length]
    lse = jnp.moveaxis(lse, 0, 1).reshape(n, n_blk * BLOCK, heads)[:, :length]
    return o, lse


def dilated_attention(q, k, v, window, dilation):
    b, s, h, dh = q.shape
    sub = s // dilation

    def to_residues(t):
        return t.reshape(b, sub, dilation, h, dh).transpose(0, 2, 1, 3, 4).reshape(b * dilation, sub, h, dh)

    o, lse = banded_causal_attention(to_residues(q), to_residues(k), to_residues(v), window // dilation)
    o = o.reshape(b, dilation, sub, h, dh).transpose(0, 2, 1, 3, 4).reshape(b, s, h, dh)
    lse = lse.reshape(b, dilation, sub, h).transpose(0, 2, 1, 3).reshape(b, s, h)
    return o, lse


def dilated_mixture_attention(zq, zk, zv, q_gain, k_gain, positions):
    b, s, _ = zq.shape
    shape = (b, s, A_N_GROUPS, A_HEADS, A_HEAD_DIM)
    q = partial_rotary(rms_norm(zq.reshape(shape), q_gain), positions)
    k = partial_rotary(rms_norm(zk.reshape(shape), k_gain), positions)
    v = zv.reshape(shape)
    outs, lses = [], []
    for g, (window, dilation) in enumerate(A_GROUPS):
        o, l = dilated_attention(q[:, :, g], k[:, :, g], v[:, :, g], window, dilation)
        outs.append(o)
        lses.append(l)
    alpha = jax.nn.softmax(jnp.stack(lses, axis=0), axis=0)
    out = jnp.einsum('gbsh,gbshd->bshd', alpha, jnp.stack(outs, axis=0).astype(jnp.float32))
    return out.reshape(b, s, A_WIDTH).astype(zq.dtype)


def rwkv7_step(state, inp):
    r_t, w_t, k_t, v_t, a_t, b_t = inp
    sa = jnp.einsum('bhvk,bhk->bhv', state, a_t)
    state = state * w_t[:, :, None, :] + sa[..., None] * b_t[:, :, None, :] + v_t[..., None] * k_t[:, :, None, :]
    y = jnp.einsum('bhvk,bhk->bhv', state, r_t)
    return state, y


def rwkv7_time_mix(zr, mu, w0, w2, a0, a2, g2, k_k, k_a, r_k, ln_w, ln_b):
    b, s, _ = zr.shape
    f32 = jnp.float32
    prev = jnp.pad(zr, ((0, 0), (1, 0), (0, 0)))[:, :-1]
    zr = zr + (prev - zr) * mu
    r, k, v, w_lo, a_lo, g_lo = jnp.split(zr, R_SPLITS, axis=-1)
    w = -jax.nn.softplus(-(w0 + jnp.tanh(w_lo) @ w2)) - 0.5
    decay = jnp.exp(-jnp.exp(w.astype(f32)))
    a = jax.nn.sigmoid(a0 + a_lo @ a2)
    g = jax.nn.sigmoid(g_lo) @ g2
    heads = lambda t: t.reshape(b, s, R_HEADS, R_HEAD).astype(f32)
    kk = heads(k * k_k)
    kk = kk / jnp.maximum(jnp.sqrt(jnp.sum(kk * kk, axis=-1, keepdims=True)), 1e-12)
    k = k * (1.0 + (a - 1.0) * k_a)
    r_h, k_h, v_h, a_h, w_h = heads(r), heads(k), heads(v), heads(a), heads(decay)
    seq_first = lambda t: jnp.moveaxis(t, 1, 0)
    xs = (seq_first(r_h), seq_first(w_h), seq_first(k_h), seq_first(v_h), seq_first(-kk), seq_first(kk * a_h))
    state0 = jnp.zeros((b, R_HEADS, R_HEAD, R_HEAD), f32)
    _, y = lax.scan(rwkv7_step, state0, xs)
    y = jnp.moveaxis(y, 0, 1)
    mean = jnp.mean(y, axis=-1, keepdims=True)
    var = jnp.mean(jnp.square(y - mean), axis=-1, keepdims=True)
    y = ((y - mean) * lax.rsqrt(var + R_GN_EPS)).reshape(b, s, R_WIDTH)
    y = y * ln_w.astype(f32) + ln_b.astype(f32)
    bonus = jnp.sum(r_h * k_h * r_k.astype(f32), axis=-1, keepdims=True) * v_h
    y = (y + bonus.reshape(b, s, R_WIDTH)) * g.astype(f32)
    return y.astype(zr.dtype)


def memory_cross_attention(zq, mem_n, w_mem_kv, q_gain, k_gain):
    b, s, _ = zq.shape
    m = mem_n.shape[1]
    q = rms_norm(zq.reshape(b, s, C_HEADS, C_HEAD_DIM), q_gain)
    k, v = jnp.split(mem_n @ w_mem_kv, 2, axis=-1)
    k = rms_norm(k.reshape(b, m, C_HEADS, C_HEAD_DIM), k_gain)
    v = v.reshape(b, m, C_HEADS, C_HEAD_DIM)
    sc = jnp.einsum('bshd,bmhd->bhsm', q, k, preferred_element_type=jnp.float32) * (C_HEAD_DIM ** -0.5)
    p = jax.nn.softmax(sc, axis=-1)
    o = jnp.einsum('bhsm,bmhd->bshd', p, v.astype(jnp.float32))
    return o.reshape(b, s, C_WIDTH).astype(zq.dtype)


def moe_ffn(h, router_w, router_b, w1, b1, w2, b2):
    b, s, d = h.shape
    n_tok = b * s
    n_assign = n_tok * TOP_K
    xt = h.reshape(n_tok, d)
    logits = (xt @ router_w + router_b).astype(jnp.float32)
    top_val, top_idx = lax.top_k(logits, TOP_K)
    gate = jax.nn.softmax(top_val, axis=-1)
    flat_e = top_idx.reshape(-1)
    flat_g = gate.reshape(-1)
    flat_tok = jnp.arange(n_assign, dtype=jnp.int32) // TOP_K
    order = jnp.argsort(flat_e)
    sorted_e = flat_e[order]
    counts = jnp.bincount(flat_e, length=N_EXPERTS)
    padded = (counts + MOE_ROWS - 1) // MOE_ROWS * MOE_ROWS
    pad_end = jnp.cumsum(padded)
    pad_start = pad_end - padded
    raw_start = jnp.cumsum(counts) - counts
    dest = pad_start[sorted_e] + jnp.arange(n_assign, dtype=jnp.int32) - raw_start[sorted_e]
    n_blocks = -(-n_assign // MOE_ROWS) + N_EXPERTS
    n_rows = n_blocks * MOE_ROWS
    row_tok = jnp.full((n_rows,), n_tok, jnp.int32).at[dest].set(flat_tok[order])
    row_gate = jnp.zeros((n_rows,), jnp.float32).at[dest].set(flat_g[order])
    block_expert = jnp.minimum(
        jnp.searchsorted(pad_end, jnp.arange(n_blocks, dtype=jnp.int32) * MOE_ROWS, side='right'),
        N_EXPERTS - 1)
    x_pad = jnp.concatenate([xt, jnp.zeros((1, d), xt.dtype)], axis=0)

    def expert_block(args):
        tok, e = args
        u = x_pad[tok] @ w1[e] + b1[e]
        glu = jnp.minimum(u[:, :D_FF], SWIGLU_LIMIT)
        lin = jnp.clip(u[:, D_FF:], -SWIGLU_LIMIT, SWIGLU_LIMIT)
        act = glu * jax.nn.sigmoid(SWIGLU_ALPHA * glu) * (lin + 1.0)
        return act @ w2[e] + b2[e]

    y_rows = lax.map(expert_block, (row_tok.reshape(n_blocks, MOE_ROWS), block_expert))
    y_rows = y_rows.reshape(n_rows, d).astype(jnp.float32) * row_gate[:, None]
    y = jax.ops.segment_sum(y_rows, row_tok, num_segments=n_tok + 1)[:n_tok]
    return y.reshape(b, s, d).astype(h.dtype)


def setup_inputs(seed: int = 0) -> dict:
    key = jax.random.key(seed)
    ks = iter(jax.random.split(key, 40))
    L, D = DEPTH, D_MODEL

    def nrm(shape, scale):
        return scale * jax.random.normal(next(ks), shape, jnp.float32)

    x = nrm((BATCH, SEQ, D), 1.0)
    mem = nrm((BATCH, MEM_LEN, D), 1.0)
    positions = (jnp.arange(SEQ, dtype=jnp.int32)[None, :]
                 + jax.random.randint(next(ks), (BATCH, 1), 0, 4096, dtype=jnp.int32))
    norm_mix = 1.0 + nrm((L, D), 0.02)
    w_in = nrm((L, D, IN_COLS), D ** -0.5)
    b_gate = nrm((L, GATE_COLS), 0.02)
    a_q_gain = 1.0 + nrm((L, A_HEAD_DIM), 0.02)
    a_k_gain = 1.0 + nrm((L, A_HEAD_DIM), 0.02)
    r_mu = jax.random.uniform(next(ks), (L, R_COLS), jnp.float32, 0.0, 1.0)
    r_w0 = jnp.broadcast_to(jnp.linspace(-6.0, -1.0, R_WIDTH, dtype=jnp.float32), (L, R_WIDTH)) + nrm((L, R_WIDTH), 0.1)
    r_w2 = nrm((L, R_DECAY_LORA, R_WIDTH), 0.1 * R_DECAY_LORA ** -0.5)
    r_a0 = nrm((L, R_WIDTH), 0.1)
    r_a2 = nrm((L, R_AAA_LORA, R_WIDTH), 0.1 * R_AAA_LORA ** -0.5)
    r_g2 = nrm((L, R_GATE_LORA, R_WIDTH), R_GATE_LORA ** -0.5)
    r_k_k = 0.85 + nrm((L, R_WIDTH), 0.02)
    r_k_a = 1.0 + nrm((L, R_WIDTH), 0.02)
    r_r_k = nrm((L, R_HEADS, R_HEAD), 0.1)
    r_ln_w = 1.0 + nrm((L, R_WIDTH), 0.02)
    r_ln_b = nrm((L, R_WIDTH), 0.01)
    mem_norm = 1.0 + nrm((L, D), 0.02)
    w_mem_kv = nrm((L, D, 2 * C_WIDTH), D ** -0.5)
    c_q_gain = 1.0 + nrm((L, C_HEAD_DIM), 0.02)
    c_k_gain = 1.0 + nrm((L, C_HEAD_DIM), 0.02)
    w_branch = nrm((L, N_BRANCH, BRANCH_WIDTH, D), BRANCH_WIDTH ** -0.5)
    w_out = nrm((L, D, D), D ** -0.5)
    norm_ffn = 1.0 + nrm((L, D), 0.02)
    router_w = nrm((L, D, N_EXPERTS), D ** -0.5)
    router_b = nrm((L, N_EXPERTS), 0.01)
    exp_w1 = nrm((L, N_EXPERTS, D, 2 * D_FF), D ** -0.5)
    exp_b1 = nrm((L, N_EXPERTS, 2 * D_FF), 0.01)
    exp_w2 = nrm((L, N_EXPERTS, D_FF, D), D_FF ** -0.5)
    exp_b2 = nrm((L, N_EXPERTS, D), 0.01)
    return {'x': x, 'mem': mem, 'positions': positions, 'norm_mix': norm_mix, 'w_in': w_in,
            'b_gate': b_gate, 'a_q_gain': a_q_gain, 'a_k_gain': a_k_gain, 'r_mu': r_mu,
            'r_w0': r_w0, 'r_w2': r_w2, 'r_a0': r_a0, 'r_a2': r_a2, 'r_g2': r_g2,
            'r_k_k': r_k_k, 'r_k_a': r_k_a, 'r_r_k': r_r_k, 'r_ln_w': r_ln_w, 'r_ln_b': r_ln_b,
            'mem_norm': mem_norm, 'w_mem_kv': w_mem_kv, 'c_q_gain': c_q_gain, 'c_k_gain': c_k_gain,
            'w_branch': w_branch, 'w_out': w_out, 'norm_ffn': norm_ffn, 'router_w': router_w,
            'router_b': router_b, 'exp_w1': exp_w1, 'exp_b1': exp_b1, 'exp_w2': exp_w2, 'exp_b2': exp_b2}


def reference(x, mem, positions, norm_mix, w_in, b_gate, a_q_gain, a_k_gain, r_mu, r_w0, r_w2,
              r_a0, r_a2, r_g2, r_k_k, r_k_a, r_r_k, r_ln_w, r_ln_b, mem_norm, w_mem_kv,
              c_q_gain, c_k_gain, w_branch, w_out, norm_ffn, router_w, router_b,
              exp_w1, exp_b1, exp_w2, exp_b2):
    b, s, d = x.shape
    for l in range(DEPTH):
        h = rms_norm(x, norm_mix[l])
        z = h @ w_in[l]
        y_a = dilated_mixture_attention(z[..., OFF_AQ:OFF_AK], z[..., OFF_AK:OFF_AV],
                                        z[..., OFF_AV:OFF_R], a_q_gain[l], a_k_gain[l], positions)
        y_b = rwkv7_time_mix(z[..., OFF_R:OFF_CQ], r_mu[l], r_w0[l], r_w2[l], r_a0[l], r_a2[l],
                             r_g2[l], r_k_k[l], r_k_a[l], r_r_k[l], r_ln_w[l], r_ln_b[l])
        y_c = memory_cross_attention(z[..., OFF_CQ:OFF_GATE], rms_norm(mem, mem_norm[l]),
                                     w_mem_kv[l], c_q_gain[l], c_k_gain[l])
        gates = jax.nn.sigmoid(z[..., OFF_GATE:] + b_gate[l]).reshape(b, s, N_BRANCH, d)
        branches = jnp.stack([y_a, y_b, y_c], axis=2)
        proj = jnp.einsum('bsnc,ncd->bsnd', branches, w_branch[l])
        merged = jnp.sum(gates * proj, axis=2)
        x = x + merged @ w_out[l]
        x = x + moe_ffn(rms_norm(x, norm_ffn[l]), router_w[l], router_b[l],
                        exp_w1[l], exp_b1[l], exp_w2[l], exp_b2[l])
    return x
```

```cpp
#include <hip/hip_runtime.h>
#include <cstdio>
#include <cstdint>
#include <cmath>
namespace pg8 {
#define PG8_LAS __attribute__((address_space(3)))
typedef unsigned short bf16_t;
typedef short bf16x8 __attribute__((ext_vector_type(8)));
typedef float f32x4 __attribute__((ext_vector_type(4)));
typedef unsigned u32x4 __attribute__((ext_vector_type(4)));
constexpr int BM = 256, BK = 64, HALF = 128, HTB = HALF * BK * 2  , STAGE_BYTES = 8 * HTB, NXCD = 8, WGM = 8;

__host__ __device__ __forceinline__ int lds_byte(int r, int c) { const int st = (r >> 4) * 2 + (c >> 5), rr = r & 15, cc = c & 31, ob = rr * 64 + cc * 2; return st * 1024 + (ob ^ (((ob >> 9) & 1) << 5)); }
__host__ __device__ __forceinline__ void stage_rc(int b, int& R, int& C) { const int st = b / 1024, sb = b % 1024, swz = sb ^ (((sb >> 9) & 1) << 5); R = (st >> 1) * 16 + swz / 64; C = (st & 1) * 32 + (swz % 64) / 2; }
__host__ __device__ __forceinline__ int perm32(int rho) { const int n = rho >> 4, i = rho & 15; return 8 * (i >> 2) + 4 * n + (i & 3); }

struct Unit { int pm, pn; };
struct Gemm { const bf16_t* A; const bf16_t* Bt; int M, N, K; };

struct StaticOrder {
    int nM, nN, nwg, G, c;
    __host__ __device__ void init(int M, int N, int G_, int c_) { nM = M / BM; nN = N / BM; nwg = nM * nN; G = G_; c = c_; }
    __host__ __device__ bool next(int i, Unit& u) const {
        const long L = (long)i * G + c; if (L >= nwg) return false;
        int wgid = (int)L; { const int q = nwg / NXCD, r = nwg % NXCD, xcd = wgid % NXCD, off = wgid / NXCD; wgid = (xcd < r ? xcd * (q + 1) : r * (q + 1) + (xcd - r) * q) + off; }
        const int nig = WGM * nN, gid = wgid / nig, fm = gid * WGM, gsz = (nM - fm) < WGM ? (nM - fm) : WGM;
        u.pm = fm + ((wgid % nig) % gsz); u.pn = (wgid % nig) / gsz; return true;
    }
    __device__ __forceinline__ void a_ready(const Unit&) const {}
    __device__ __forceinline__ void done(const Unit&) const {}
};

__device__ __forceinline__ unsigned cvt_pk_bf16(float lo, float hi) { unsigned r; asm volatile("v_cvt_pk_bf16_f32 %0, %1, %2" : "=v"(r) : "v"(lo), "v"(hi)); return r; }
typedef float f32x2 __attribute__((ext_vector_type(2)));
__device__ __forceinline__ f32x2 gelu_pk(f32x2 v) {
    const f32x2 av = __builtin_elementwise_abs(v), d = av * 0.2316418882f + 1.0f;
    f32x2 t; t.x = __builtin_amdgcn_rcpf(d.x); t.y = __builtin_amdgcn_rcpf(d.y);
    f32x2 q = t * 0.5307027145f + (-0.7265760135f); q = q * t + 0.7107068705f; q = q * t + (-0.142248368f); q = q * t + 0.127414796f; q = q * t;
    const f32x2 s = (v * v) * (-0.72134752044f);
    f32x2 e; e.x = __builtin_amdgcn_exp2f(s.x); e.y = __builtin_amdgcn_exp2f(s.y);
    const f32x2 m = v * (q * e), r = v - m;
    f32x2 o; o.x = v.x < 0.f ? m.x : r.x; o.y = v.y < 0.f ? m.y : r.y; return o;
}

template <int ACT  > struct EpiBf16 {
    static constexpr bool PERM = true, AFTER_DRAIN = false; static_assert(ACT == 0 || ACT == 1, "EpiBf16: ACT is 0 (none) or 1 (gelu_pk)");
    bf16_t* O; int ldc; const float* bias; int split_cols; size_t split_stride; float scale0;
    __device__ __forceinline__ void operator()(const f32x4 (&acc)[2][2][4][2], const Unit& u, int wr, int wc, int fr, int fq) const {
        const int row0 = u.pm * BM + wr * 64 + fr; int colt = u.pn * BM; bf16_t* base = O;
        float sc = 1.f; if (split_cols) { const int t = colt / split_cols; base += (size_t)t * split_stride; colt -= t * split_cols; if (t == 0) sc = scale0; }
        const int col0 = colt + wc * 32 + 8 * fq, bcol0 = u.pn * BM + wc * 32 + 8 * fq;
        f32x4 bv[2][2];
#pragma unroll
        for (int bj = 0; bj < 2; ++bj)
#pragma unroll
            for (int n = 0; n < 2; ++n) bv[bj][n] = bias ? *(const f32x4*)(bias + bcol0 + bj * HALF + 4 * n) : (f32x4){0.f, 0.f, 0.f, 0.f};
#pragma unroll
        for (int ai = 0; ai < 2; ++ai)
#pragma unroll
            for (int m = 0; m < 4; ++m) { bf16_t* rowp = base + (size_t)(row0 + ai * HALF + m * 16) * ldc + col0;
#pragma unroll
                for (int bj = 0; bj < 2; ++bj) { f32x4 v0 = acc[ai][bj][m][0] + bv[bj][0], v1 = acc[ai][bj][m][1] + bv[bj][1];
                    if (ACT == 1) { f32x2 a = gelu_pk((f32x2){v0[0], v0[1]}), b = gelu_pk((f32x2){v0[2], v0[3]}), c = gelu_pk((f32x2){v1[0], v1[1]}), d = gelu_pk((f32x2){v1[2], v1[3]});
                        v0 = (f32x4){a.x, a.y, b.x, b.y}; v1 = (f32x4){c.x, c.y, d.x, d.y}; }
                    v0 = v0 * sc; v1 = v1 * sc; u32x4 w; w.x = cvt_pk_bf16(v0[0], v0[1]); w.y = cvt_pk_bf16(v0[2], v0[3]); w.z = cvt_pk_bf16(v1[0], v1[1]); w.w = cvt_pk_bf16(v1[2], v1[3]);
                    *(u32x4*)(rowp + bj * HALF) = w; } }
    }
};
template <class Epi, class Sched, bool ALIGN_EPI = false, bool SP2 = false>
__device__ __forceinline__ void gemm_phase(PG8_LAS unsigned char* lds, const Gemm g, const Sched& S, const Epi& E) {
    const int tid = threadIdx.x, wid = __builtin_amdgcn_readfirstlane(tid >> 6), lane = tid & 63, wr = wid >> 2, wc = wid & 3, fr = lane & 15, fq = lane >> 4;
    const int K = g.K, nt = K / BK;
    unsigned voffA[2], voffB[2];
#pragma unroll
    for (int i = 0; i < 2; ++i) { int R, C; stage_rc(tid * 16 + i * 8192, R, C); const int Rb = Epi::PERM ? ((R & ~31) + perm32(R & 31)) : R;
        voffA[i] = (unsigned)(R * K + C) * 2u; voffB[i] = (unsigned)(Rb * K + C) * 2u; }
    const size_t kstep = (size_t)(BK * 2);
    const size_t hstep = (size_t)HALF * K * 2;
    const size_t tstep = 2 * hstep;
    const unsigned ldsw = (unsigned)wid * 1024u;
    const int aoff = lds_byte(wr * 64 + fr, fq * 8), boff = lds_byte(wc * 32 + fr, fq * 8);
#define PG8_SA(b, h) (((b) * 2 + (h)) * HTB)
#define PG8_SB(b, h) ((4 + (b) * 2 + (h)) * HTB)
#define PG8_STAGE(bufoff, gbase, voff) do { _Pragma("unroll") for (int _i = 0; _i < 2; ++_i) \
        __builtin_amdgcn_global_load_lds((const unsigned*)((const char*)(gbase) + (voff)[_i]), (PG8_LAS unsigned*)(lds + (bufoff) + ldsw + _i * 8192), 16, 0, 0); } while (0)
#define PG8_LDA(dst, b, h) do { _Pragma("unroll") for (int m = 0; m < 4; ++m) _Pragma("unroll") for (int k = 0; k < 2; ++k) dst[m][k] = *(const PG8_LAS bf16x8*)(lds + PG8_SA(b, h) + aoff + m * 2048 + k * 1024); } while (0)
#define PG8_LDB(dst, b, h) do { _Pragma("unroll") for (int n = 0; n < 2; ++n) _Pragma("unroll") for (int k = 0; k < 2; ++k) dst[n][k] = *(const PG8_LAS bf16x8*)(lds + PG8_SB(b, h) + boff + n * 2048 + k * 1024); } while (0)
#define PG8_MMA(ai, bj, At, Bt) do { __builtin_amdgcn_s_setprio(1); _Pragma("unroll") for (int m = 0; m < 4; ++m) _Pragma("unroll") for (int n = 0; n < 2; ++n) _Pragma("unroll") for (int k = 0; k < 2; ++k) \
        acc[ai][bj][m][n] = __builtin_amdgcn_mfma_f32_16x16x32_bf16(Bt[n][k], At[m][k], acc[ai][bj][m][n], 0, 0, 0); __builtin_amdgcn_s_setprio(0); } while (0)
#define PG8_WAIT_V(n) asm volatile("s_waitcnt vmcnt(" #n ")" ::: "memory")
#define PG8_WAIT_L(n) asm volatile("s_waitcnt lgkmcnt(" #n ")" ::: "memory")
#define PG8_BAR __builtin_amdgcn_s_barrier()
#define PG8_SCHED __builtin_amdgcn_sched_barrier(0)
    Unit cur, nxt; int ui = 0;
    if (!S.next(0, cur)) return;
    f32x4 acc[2][2][4][2];
#pragma unroll
    for (int a = 0; a < 2; ++a)
#pragma unroll
        for (int b = 0; b < 2; ++b)
#pragma unroll
            for (int m = 0; m < 4; ++m)
#pragma unroll
                for (int n = 0; n < 2; ++n) acc[a][b][m][n] = (f32x4){0.f, 0.f, 0.f, 0.f};
    bf16x8 At[4][2], B0[2][2], B1[2][2];
    const char* cA = (const char*)g.A + (size_t)cur.pm * tstep; const char* cB = (const char*)g.Bt + (size_t)cur.pn * tstep;
    S.a_ready(cur);
    if constexpr (SP2) {
        PG8_STAGE(PG8_SB(0, 0), cB, voffB); PG8_STAGE(PG8_SB(0, 1), cB + hstep, voffB); PG8_STAGE(PG8_SA(0, 0), cA, voffA); PG8_STAGE(PG8_SA(0, 1), cA + hstep, voffA);
        if (wr == 1) PG8_BAR;
        PG8_WAIT_V(2); PG8_BAR;
        PG8_STAGE(PG8_SB(1, 0), cB + kstep, voffB); PG8_STAGE(PG8_SA(1, 0), cA + kstep, voffA); PG8_STAGE(PG8_SB(1, 1), cB + hstep + kstep, voffB);
        PG8_WAIT_V(6); PG8_BAR;
    } else {
        PG8_STAGE(PG8_SB(0, 0), cB, voffB); PG8_STAGE(PG8_SA(0, 0), cA, voffA); PG8_STAGE(PG8_SB(0, 1), cB + hstep, voffB); PG8_STAGE(PG8_SA(0, 1), cA + hstep, voffA);
        if (wr == 1) PG8_BAR;
        PG8_WAIT_V(4); PG8_BAR;
        PG8_STAGE(PG8_SB(1, 0), cB + kstep, voffB); PG8_STAGE(PG8_SA(1, 0), cA + kstep, voffA); PG8_STAGE(PG8_SB(1, 1), cB + hstep + kstep, voffB);
        PG8_WAIT_V(6); PG8_BAR;
    }
    for (;;) {
        const bool has_next = S.next(ui + 1, nxt);
        const char* nA = has_next ? (const char*)g.A + (size_t)nxt.pm * tstep : cA; const char* nB = has_next ? (const char*)g.Bt + (size_t)nxt.pn * tstep : cB;
        for (int t = 0; t < nt; t += 2) {
            const bool last = (t == nt - 2);
            const char* a1 = cA + (size_t)(t + 1) * kstep;
            const char* a2 = last ? nA : cA + (size_t)(t + 2) * kstep; const char* b2 = last ? nB : cB + (size_t)(t + 2) * kstep;
            const char* a3 = a2 + kstep; const char* b3 = b2 + kstep;
            if (last && has_next) S.a_ready(nxt);
            if constexpr (SP2) {
            PG8_LDB(B0, 0, 0); PG8_LDB(B1, 0, 1); PG8_SCHED; PG8_LDA(At, 0, 0); PG8_STAGE(PG8_SA(1, 1), a1 + hstep, voffA);
            PG8_WAIT_V(8); PG8_WAIT_L(0); PG8_BAR; PG8_MMA(0, 0, At, B0); PG8_MMA(0, 1, At, B1); PG8_BAR; PG8_SCHED;
            PG8_LDA(At, 0, 1); PG8_STAGE(PG8_SB(0, 0), b2, voffB); PG8_STAGE(PG8_SB(0, 1), b2 + hstep, voffB); PG8_STAGE(PG8_SA(0, 0), a2, voffA);
            PG8_WAIT_V(8); PG8_WAIT_L(0); PG8_BAR; PG8_MMA(1, 0, At, B0); PG8_MMA(1, 1, At, B1); PG8_BAR; PG8_SCHED;
            PG8_LDB(B0, 1, 0); PG8_LDB(B1, 1, 1); PG8_SCHED; PG8_LDA(At, 1, 0); PG8_STAGE(PG8_SA(0, 1), a2 + hstep, voffA);
            PG8_WAIT_V(8); PG8_WAIT_L(0); PG8_BAR; PG8_MMA(0, 0, At, B0); PG8_MMA(0, 1, At, B1); PG8_BAR; PG8_SCHED;
            PG8_LDA(At, 1, 1); PG8_STAGE(PG8_SB(1, 0), b3, voffB); PG8_STAGE(PG8_SB(1, 1), b3 + hstep, voffB); PG8_STAGE(PG8_SA(1, 0), a3, voffA);
            PG8_WAIT_V(8); PG8_WAIT_L(0); PG8_BAR; PG8_MMA(1, 0, At, B0); PG8_MMA(1, 1, At, B1); PG8_BAR; PG8_SCHED;
            } else {
            PG8_LDB(B0, 0, 0); PG8_SCHED; PG8_LDA(At, 0, 0); PG8_STAGE(PG8_SA(1, 1), a1 + hstep, voffA);
            PG8_WAIT_L(8); PG8_BAR; PG8_WAIT_L(0); PG8_MMA(0, 0, At, B0); PG8_BAR; PG8_SCHED;
            PG8_LDB(B1, 0, 1); PG8_STAGE(PG8_SB(0, 0), b2, voffB);
            PG8_BAR; PG8_WAIT_L(0); PG8_MMA(0, 1, At, B1); PG8_BAR;
            PG8_LDA(At, 0, 1); PG8_STAGE(PG8_SA(0, 0), a2, voffA);
            PG8_BAR; PG8_WAIT_L(0); PG8_MMA(1, 0, At, B0); PG8_BAR; PG8_SCHED;
            PG8_STAGE(PG8_SB(0, 1), b2 + hstep, voffB);
            PG8_WAIT_V(6); PG8_BAR; PG8_MMA(1, 1, At, B1); PG8_BAR;
            PG8_LDB(B0, 1, 0); PG8_SCHED; PG8_LDA(At, 1, 0); PG8_STAGE(PG8_SA(0, 1), a2 + hstep, voffA);
            PG8_WAIT_L(8); PG8_BAR; PG8_WAIT_L(0); PG8_MMA(0, 0, At, B0); PG8_BAR; PG8_SCHED;
            PG8_LDB(B1, 1, 1); PG8_STAGE(PG8_SB(1, 0), b3, voffB);
            PG8_BAR; PG8_WAIT_L(0); PG8_MMA(0, 1, At, B1); PG8_BAR;
            PG8_LDA(At, 1, 1); PG8_STAGE(PG8_SA(1, 0), a3, voffA);
            PG8_BAR; PG8_WAIT_L(0); PG8_MMA(1, 0, At, B0); PG8_BAR; PG8_SCHED;
            PG8_STAGE(PG8_SB(1, 1), b3 + hstep, voffB);
            PG8_WAIT_V(6); PG8_BAR; PG8_MMA(1, 1, At, B1); PG8_BAR;
            }
        }
        if constexpr (ALIGN_EPI) { if (wr == 0) PG8_BAR; }
        if constexpr (!Epi::AFTER_DRAIN) { E(acc, cur, wr, wc, fr, fq); S.done(cur); }
        if (!has_next) break;
#pragma unroll
        for (int a = 0; a < 2; ++a)
#pragma unroll
            for (int b = 0; b < 2; ++b)
#pragma unroll
                for (int m = 0; m < 4; ++m)
#pragma unroll
                    for (int n = 0; n < 2; ++n) acc[a][b][m][n] = (f32x4){0.f, 0.f, 0.f, 0.f};
        cur = nxt; cA = nA; cB = nB; ++ui;
        if constexpr (ALIGN_EPI) { if (wr == 1) PG8_BAR; }
    }
    PG8_WAIT_V(0);
    if constexpr (!ALIGN_EPI) { if (wr == 0) PG8_BAR; }
    PG8_BAR;
    if constexpr (Epi::AFTER_DRAIN) { E.fused(acc, cur, wr, wc, fr, fq, lds, wid, lane); S.done(cur); }
#undef PG8_SA
#undef PG8_SB
#undef PG8_STAGE
#undef PG8_LDA
#undef PG8_LDB
#undef PG8_MMA
#undef PG8_WAIT_V
#undef PG8_WAIT_L
#undef PG8_BAR
#undef PG8_SCHED
}
}

constexpr int D_MODEL = 1024, BATCH = 2, SEQ = 8192, MTOK = BATCH * SEQ, MEM_LEN = 256, MEMROWS = BATCH * MEM_LEN;
constexpr int IN_COLS = 9984, OFF_AQ = 0, OFF_AK = 1536, OFF_AV = 3072, OFF_R = 4608, OFF_CQ = 6400, OFF_GATE = 6912;
constexpr int RW = 512;
constexpr int N_EXPERTS = 32, TOP_K = 4, D_FF = 1024, MOE_ROWS = 256;
constexpr int MAX_BLOCKS = MTOK * TOP_K / MOE_ROWS + N_EXPERTS;
constexpr int MAX_SLOTS = MAX_BLOCKS * MOE_ROWS;
constexpr float NORM_EPS = 1e-6f, R_GN_EPS = 64e-5f;
constexpr float LOG2E = 1.4426950408889634f;
constexpr float QSCALE = 0.08838834764831845f * LOG2E;

namespace pg8 {
__device__ __forceinline__ float bf_lo(unsigned w) { return __builtin_bit_cast(float, w << 16); }
__device__ __forceinline__ float bf_hi(unsigned w) { return __builtin_bit_cast(float, w & 0xffff0000u); }
__device__ __forceinline__ float sigmoidf_fast(float x) { return 1.0f / (1.0f + __expf(-x)); }

struct EpiGate {
    static constexpr bool PERM = true, AFTER_DRAIN = false;
    const bf16_t* Z; const float* bgate; float* merged; bf16_t* mergedb; int br;
    __device__ __forceinline__ void operator()(const f32x4 (&acc)[2][2][4][2], const Unit& u, int wr, int wc, int fr, int fq) const {
        const int row0 = u.pm * BM + wr * 64 + fr, col0 = u.pn * BM + wc * 32 + 8 * fq;
#pragma unroll
        for (int ai = 0; ai < 2; ++ai)
#pragma unroll
            for (int m = 0; m < 4; ++m) { const int row = row0 + ai * HALF + m * 16;
#pragma unroll
                for (int bj = 0; bj < 2; ++bj) { const int col = col0 + bj * HALF;
                    const u32x4 gz = *(const u32x4*)(Z + (size_t)row * IN_COLS + OFF_GATE + br * D_MODEL + col);
                    const f32x4 b0 = *(const f32x4*)(bgate + br * D_MODEL + col), b1 = *(const f32x4*)(bgate + br * D_MODEL + col + 4);
                    f32x4 g0, g1;
                    g0[0] = sigmoidf_fast(bf_lo(gz[0]) + b0[0]); g0[1] = sigmoidf_fast(bf_hi(gz[0]) + b0[1]); g0[2] = sigmoidf_fast(bf_lo(gz[1]) + b0[2]); g0[3] = sigmoidf_fast(bf_hi(gz[1]) + b0[3]);
                    g1[0] = sigmoidf_fast(bf_lo(gz[2]) + b1[0]); g1[1] = sigmoidf_fast(bf_hi(gz[2]) + b1[1]); g1[2] = sigmoidf_fast(bf_lo(gz[3]) + b1[2]); g1[3] = sigmoidf_fast(bf_hi(gz[3]) + b1[3]);
                    f32x4 v0 = acc[ai][bj][m][0] * g0, v1 = acc[ai][bj][m][1] * g1;
                    float* mp = merged + (size_t)row * D_MODEL + col;
                    if (br > 0) { v0 += *(const f32x4*)mp; v1 += *(const f32x4*)(mp + 4); }
                    if (br < 2) { *(f32x4*)mp = v0; *(f32x4*)(mp + 4) = v1; }
                    else { u32x4 w; w.x = cvt_pk_bf16(v0[0], v0[1]); w.y = cvt_pk_bf16(v0[2], v0[3]); w.z = cvt_pk_bf16(v1[0], v1[1]); w.w = cvt_pk_bf16(v1[2], v1[3]);
                        *(u32x4*)(mergedb + (size_t)row * D_MODEL + col) = w; } } }
    }
};
struct EpiResF32 {
    static constexpr bool PERM = true, AFTER_DRAIN = false;
    const float* base; float* out; int ldc;
    __device__ __forceinline__ void operator()(const f32x4 (&acc)[2][2][4][2], const Unit& u, int wr, int wc, int fr, int fq) const {
        const int row0 = u.pm * BM + wr * 64 + fr, col0 = u.pn * BM + wc * 32 + 8 * fq;
#pragma unroll
        for (int ai = 0; ai < 2; ++ai)
#pragma unroll
            for (int m = 0; m < 4; ++m) { const size_t off = (size_t)(row0 + ai * HALF + m * 16) * ldc + col0;
#pragma unroll
                for (int bj = 0; bj < 2; ++bj) { const float* bp = base + off + bj * HALF; float* op = out + off + bj * HALF;
                    const f32x4 x0 = *(const f32x4*)bp, x1 = *(const f32x4*)(bp + 4);
                    *(f32x4*)op = x0 + acc[ai][bj][m][0]; *(f32x4*)(op + 4) = x1 + acc[ai][bj][m][1]; } }
    }
};
struct EpiSwiGLU {
    static constexpr bool PERM = true, AFTER_DRAIN = false;
    const float* b1; bf16_t* H;
    __device__ __forceinline__ void operator()(const f32x4 (&acc)[2][2][4][2], const Unit& u, int wr, int wc, int fr, int fq) const {
        const int e = u.pn >> 3, pnl = u.pn & 7;
        const int row0 = u.pm * BM + wr * 64 + fr, ac = pnl * HALF + wc * 32 + 8 * fq;
        const float* bg = b1 + (size_t)e * 2 * D_FF + ac; const float* bl = bg + D_FF;
        const f32x4 bg0 = *(const f32x4*)bg, bg1 = *(const f32x4*)(bg + 4), bl0 = *(const f32x4*)bl, bl1 = *(const f32x4*)(bl + 4);
#pragma unroll
        for (int ai = 0; ai < 2; ++ai)
#pragma unroll
            for (int m = 0; m < 4; ++m) { const int row = row0 + ai * HALF + m * 16;
                float a[8];
#pragma unroll
                for (int n = 0; n < 2; ++n) { const f32x4 ug = acc[ai][0][m][n] + (n ? bg1 : bg0), ul = acc[ai][1][m][n] + (n ? bl1 : bl0);
#pragma unroll
                    for (int j = 0; j < 4; ++j) { const float g = fminf(ug[j], 7.0f), l = fminf(fmaxf(ul[j], -7.0f), 7.0f);
                        a[4 * n + j] = g * sigmoidf_fast(1.702f * g) * (l + 1.0f); } }
                u32x4 w; w.x = cvt_pk_bf16(a[0], a[1]); w.y = cvt_pk_bf16(a[2], a[3]); w.z = cvt_pk_bf16(a[4], a[5]); w.w = cvt_pk_bf16(a[6], a[7]);
                *(u32x4*)(H + (size_t)row * D_FF + ac) = w; }
    }
};
struct EpiMoeOut {
    static constexpr bool PERM = true, AFTER_DRAIN = false;
    const float* b2; const float* rowgate; bf16_t* Y;
    __device__ __forceinline__ void operator()(const f32x4 (&acc)[2][2][4][2], const Unit& u, int wr, int wc, int fr, int fq) const {
        const int e = u.pn >> 2, pnl = u.pn & 3;
        const int row0 = u.pm * BM + wr * 64 + fr, col0 = pnl * BM + wc * 32 + 8 * fq;
#pragma unroll
        for (int ai = 0; ai < 2; ++ai)
#pragma unroll
            for (int m = 0; m < 4; ++m) { const int row = row0 + ai * HALF + m * 16; const float gt = rowgate[row];
#pragma unroll
                for (int bj = 0; bj < 2; ++bj) { const int col = col0 + bj * HALF; const float* bp = b2 + (size_t)e * D_MODEL + col;
                    const f32x4 v0 = (acc[ai][bj][m][0] + *(const f32x4*)bp) * gt, v1 = (acc[ai][bj][m][1] + *(const f32x4*)(bp + 4)) * gt;
                    u32x4 w; w.x = cvt_pk_bf16(v0[0], v0[1]); w.y = cvt_pk_bf16(v0[2], v0[3]); w.z = cvt_pk_bf16(v1[0], v1[1]); w.w = cvt_pk_bf16(v1[2], v1[3]);
                    *(u32x4*)(Y + (size_t)row * D_MODEL + col) = w; } }
    }
};
struct MoeOrder {
    const PG8_LAS int* tab;
    int NT, G, c;
    __device__ __forceinline__ bool next(int i, Unit& u) const {
        const int nblk = tab[0]; const long L = (long)i * G + c; if (L >= (long)nblk * NT) return false;
        const int blk = (int)(L / NT), pnl = (int)(L % NT); u.pm = blk; u.pn = tab[1 + blk] * NT + pnl; return true;
    }
    __device__ __forceinline__ void a_ready(const Unit&) const {}
    __device__ __forceinline__ void done(const Unit&) const {}
};
}

constexpr int NWAVES = 8;
#ifndef MK_N_LAUNCHES
#define MK_N_LAUNCHES 0
#endif
constexpr int N_PHASES = 13;

constexpr size_t MiB = 1u << 20;
constexpr size_t WS_CTL = 0, CTL_ZERO_BYTES = 1 * MiB;
constexpr size_t WS_WIN = 2 * MiB;
constexpr size_t WS_WB = 22 * MiB;
constexpr size_t WS_WO = 25 * MiB;
constexpr size_t WS_WMEM = 27 * MiB;
constexpr size_t WS_W1 = 29 * MiB;
constexpr size_t WS_W2 = 157 * MiB;
constexpr size_t WS_XN = 221 * MiB;
constexpr size_t WS_Z = 256 * MiB;
constexpr size_t WS_RW = 568 * MiB;
constexpr size_t WS_YS = 792 * MiB;
constexpr size_t WS_YABC = 824 * MiB;
constexpr size_t WS_MRG = 872 * MiB;
constexpr size_t WS_MRGB = 936 * MiB;
constexpr size_t WS_MEMN = 968 * MiB;
constexpr size_t WS_KVM = 969 * MiB;
constexpr size_t WS_XN2 = 970 * MiB;
constexpr size_t WS_ROUTE = 1002 * MiB;
constexpr size_t WS_END = 1004 * MiB;
constexpr size_t WS_XS = 256 * MiB;
constexpr size_t WS_HACT = 400 * MiB;
constexpr size_t WS_YROWS = 544 * MiB;
constexpr size_t RWSZ = (size_t)MTOK * RW * 4;
constexpr size_t RT_TOPI = 0, RT_TOPG = 256 * 1024, RT_POS = 512 * 1024, RT_ROWGATE = 768 * 1024;
static_assert(RT_ROWGATE + (size_t)MAX_SLOTS * 4 <= 1088 * 1024, "route");
constexpr int CW_TMO = 0, CW_CODE = 1;
constexpr int CW_BAR = 4096;
constexpr int CW_CNT = 16384;
constexpr int CW_CUR = 16384 + 64;

constexpr int RING_OFF = 0, RING_BYTES = 131072;
constexpr int LDSCTL_OFF = RING_BYTES, MISC_OFF = LDSCTL_OFF + 320;
constexpr int MOETAB_OFF = MISC_OFF + 128;
constexpr int LDS_BYTES = 147456;
static_assert(MOETAB_OFF + 4 * (1 + MAX_BLOCKS + 64) <= LDS_BYTES, "LDS map");
#define GAS __attribute__((address_space(1)))
#define LAS __attribute__((address_space(3)))
typedef unsigned short bf16;
typedef unsigned v4u __attribute__((ext_vector_type(4)));
typedef float f32x4 __attribute__((ext_vector_type(4)));
typedef short bf16x8 __attribute__((ext_vector_type(8)));
typedef GAS unsigned gu32;
typedef GAS unsigned long long gu64;
#define RLX_AGENT __ATOMIC_RELAXED, __HIP_MEMORY_SCOPE_AGENT
#define LDS_WAIT() asm volatile("s_waitcnt lgkmcnt(0)" ::: "memory")
#define VM_WAIT() asm volatile("s_waitcnt vmcnt(0)" ::: "memory")
__device__ __forceinline__ unsigned long long rt() { return __builtin_amdgcn_s_memrealtime(); }
__device__ __forceinline__ unsigned f2bf(float f) { unsigned u = __builtin_bit_cast(unsigned, f); return (u + 0x7fffu + ((u >> 16) & 1u)) >> 16; }
__device__ __forceinline__ unsigned pk2(float lo, float hi) { return f2bf(lo) | (f2bf(hi) << 16); }
#define XB_TMO      128
#define XB_XCNT(j)  (256  + 64 * (j))
#define XB_XSUB(j)  (1280 + 64 * (j))
#define XB_XGEN(j)  (2304 + 64 * (j))
#define XB_TOP      3328
#define XB_TOPGEN   3392
#define XCD_BAR_WORDS 3456
#define XB_SPIN_CAP (1u << 18)

__device__ __forceinline__ unsigned xb_ld(unsigned* p)              { return __hip_atomic_load(p, __ATOMIC_RELAXED, __HIP_MEMORY_SCOPE_AGENT); }
__device__ __forceinline__ unsigned xb_add(unsigned* p, unsigned v) { return __hip_atomic_fetch_add(p, v, __ATOMIC_RELAXED, __HIP_MEMORY_SCOPE_AGENT); }
__device__ __forceinline__ unsigned xb_xcc_id() { return (unsigned)__builtin_amdgcn_s_getreg((3 << 11) | 20) & 0xFu; }
#define XB_SPIN(cond, bar) do { unsigned _sp = 0; while (cond) { __builtin_amdgcn_s_sleep(1); \
    if ((++_sp & 255u) == 0u) { if (xb_ld(&(bar)[XB_TMO])) break; if (_sp > XB_SPIN_CAP) { atomicAdd(&(bar)[XB_TMO], 1u); break; } } } } while (0)

struct XcdBarrier {
    unsigned* bar; unsigned x;
    volatile LAS unsigned* st;
};

__device__ __forceinline__ XcdBarrier xcd_barrier_post(unsigned* bar, volatile LAS unsigned* st) {
    XcdBarrier b; b.bar = bar; b.x = xb_xcc_id(); b.st = st;
    if (threadIdx.x == 0) (void)xb_add(&bar[XB_XCNT(b.x)], 1u);
    return b;
}
__device__ __forceinline__ void xcd_barrier_complete(unsigned* bar, unsigned x, unsigned& nloc, unsigned& nx) {
    const unsigned G = gridDim.x * gridDim.y * gridDim.z;
    unsigned sum, cnt, mine, sp = 0u;
    for (;;) {
        sum = 0u; cnt = 0u; mine = 0u;
#pragma unroll
        for (unsigned j = 0; j < 16; ++j) { const unsigned c = xb_ld(&bar[XB_XCNT(j)]); sum += c; cnt += (c > 0u) ? 1u : 0u; mine = (j == x) ? c : mine; }
        if (sum == G) break;
        __builtin_amdgcn_s_sleep(1);
        if ((++sp & 255u) == 0u) { if (xb_ld(&bar[XB_TMO])) break; if (sp > XB_SPIN_CAP) { atomicAdd(&bar[XB_TMO], 1u); break; } }
    }
    nloc = mine > 0u ? mine : 1u; nx = cnt > 0u ? cnt : 1u;
}

__device__ __forceinline__ void xcd_barrier(const XcdBarrier& b) {
    asm volatile("s_waitcnt vmcnt(0)" ::: "memory");
    __syncthreads();
    if (threadIdx.x == 0) {
        unsigned* bar = b.bar;
        __builtin_amdgcn_s_waitcnt(0);
        unsigned nloc = b.st[0], nx = b.st[1];
        if (nloc == 0u) { xcd_barrier_complete(bar, b.x, nloc, nx); b.st[0] = nloc; b.st[1] = nx; }
        const unsigned old = xb_add(&bar[XB_XSUB(b.x)], 1u);
        const unsigned gen = old / nloc;
        if (old + 1u == (gen + 1u) * nloc) {
            __builtin_amdgcn_fence(__ATOMIC_RELEASE, "agent");
            asm volatile("s_waitcnt vmcnt(0)" ::: "memory");
            const unsigned og = xb_add(&bar[XB_TOP], 1u);
            const unsigned tg = og / nx;
            if (og + 1u == (tg + 1u) * nx) xb_add(&bar[XB_TOPGEN], 1u);
            else XB_SPIN(xb_ld(&bar[XB_TOPGEN]) == tg, bar);
            __builtin_amdgcn_fence(__ATOMIC_ACQUIRE, "agent");
            xb_add(&bar[XB_XGEN(b.x)], 1u);
            asm volatile("s_waitcnt vmcnt(0)" ::: "memory");
        } else {
            XB_SPIN(xb_ld(&bar[XB_XGEN(b.x)]) == gen, bar);
            __builtin_amdgcn_fence(__ATOMIC_ACQUIRE, "agent");
            asm volatile("s_waitcnt vmcnt(0)" ::: "memory");
        }
    }
    __syncthreads();
}

typedef float f32x2 __attribute__((ext_vector_type(2)));
struct Frame {
    LAS unsigned char* lds;
    volatile LAS unsigned* MISC;
    gu32* ctl;
    int tid, lane, wave;
    int vcu, G;
    const float* in[32];
    float* out;
    unsigned char* ws;
};
enum { I_X = 0, I_MEM, I_POS, I_NORM_MIX, I_W_IN, I_B_GATE, I_AQ_GAIN, I_AK_GAIN, I_R_MU, I_R_W0, I_R_W2, I_R_A0, I_R_A2, I_R_G2, I_R_KK, I_R_KA, I_R_RK, I_R_LNW, I_R_LNB,
       I_MEM_NORM, I_W_MEMKV, I_CQ_GAIN, I_CK_GAIN, I_W_BRANCH, I_W_OUT, I_NORM_FFN, I_ROUTER_W, I_ROUTER_B, I_EXP_W1, I_EXP_B1, I_EXP_W2, I_EXP_B2 };

__device__ __forceinline__ float bf_lo(unsigned w) { return __builtin_bit_cast(float, w << 16); }
__device__ __forceinline__ float bf_hi(unsigned w) { return __builtin_bit_cast(float, w & 0xffff0000u); }
__device__ __forceinline__ float sigm(float x) { return 1.0f / (1.0f + __expf(-x)); }
template <int CTRL, int RM> __device__ __forceinline__ float dpp0(float v) {
    return __builtin_bit_cast(float, __builtin_amdgcn_update_dpp(0, __builtin_bit_cast(int, v), CTRL, RM, 0xf, true)); }
__device__ __forceinline__ float row16_sum(float v) {
    v += dpp0<0xB1, 0xf>(v); v += dpp0<0x4E, 0xf>(v); v += dpp0<0x141, 0xf>(v); v += dpp0<0x140, 0xf>(v); return v; }
__device__ __forceinline__ float rdlane(float v, int l) { return __builtin_bit_cast(float, __builtin_amdgcn_readlane(__builtin_bit_cast(int, v), l)); }
__device__ __forceinline__ float wave_sum(float v) {
    v = row16_sum(v); v += dpp0<0x142, 0xA>(v); v += dpp0<0x143, 0xC>(v); return rdlane(v, 63); }
__device__ __forceinline__ void half_sums(float v, float& lo, float& hi) {
    v = row16_sum(v); v += dpp0<0x142, 0xA>(v); lo = rdlane(v, 31); hi = rdlane(v, 63); }
__device__ __forceinline__ float wave_max_bp(float v) {
#pragma unroll
    for (int o = 1; o < 64; o <<= 1) v = fmaxf(v, __shfl_xor(v, o));
    return v; }

__device__ __forceinline__ void tconv_tile(const float* W, int K, int N, bf16* WT, int k0, int n0, int rowbase, int lane) {
    const int c = lane & 15, q = lane >> 4;
    const GAS f32x4* src = (const GAS f32x4*)(W + (size_t)(k0 + 16 * q) * N + n0 + 4 * c);
    const size_t rs = (size_t)N / 4;
    f32x4 v[16];
#pragma unroll
    for (int i = 0; i < 16; ++i) v[i] = src[i * rs];
#pragma unroll
    for (int j = 0; j < 4; ++j) {
        GAS v4u* dst = (GAS v4u*)(WT + (size_t)(rowbase + 4 * c + j) * K + k0 + 16 * q);
        v4u o0, o1;
        o0.x = pk2(v[0][j], v[1][j]); o0.y = pk2(v[2][j], v[3][j]); o0.z = pk2(v[4][j], v[5][j]); o0.w = pk2(v[6][j], v[7][j]);
        o1.x = pk2(v[8][j], v[9][j]); o1.y = pk2(v[10][j], v[11][j]); o1.z = pk2(v[12][j], v[13][j]); o1.w = pk2(v[14][j], v[15][j]);
        dst[0] = o0; dst[1] = o1;
    }
}
__device__ __forceinline__ void rms_row_to_bf16(const float* xrow, const float* gain, bf16* orow, int lane) {
    const GAS f32x4* xr = (const GAS f32x4*)xrow + lane; const GAS f32x4* gr = (const GAS f32x4*)gain + lane;
    f32x4 v[4]; float s = 0.f;
#pragma unroll
    for (int j = 0; j < 4; ++j) { v[j] = xr[64 * j]; s += (v[j].x * v[j].x + v[j].y * v[j].y) + (v[j].z * v[j].z + v[j].w * v[j].w); }
    const float rstd = 1.0f / sqrtf(wave_sum(s) * (1.f / D_MODEL) + NORM_EPS);
    GAS unsigned long long* o8 = (GAS unsigned long long*)orow + lane;
#pragma unroll
    for (int j = 0; j < 4; ++j) { const f32x4 g = gr[64 * j];
        o8[64 * j] = (unsigned long long)pk2(v[j].x * rstd * g.x, v[j].y * rstd * g.y) | ((unsigned long long)pk2(v[j].z * rstd * g.z, v[j].w * rstd * g.w) << 32); }
}
__device__ __forceinline__ void p0_prologue(Frame& F) {
    const int gw = F.vcu * NWAVES + F.wave, NGW = F.G * NWAVES, lane = F.lane;
    unsigned char* ws = F.ws;
    constexpr int T_IN = 16 * 156, T_WB = 3 * 128, T_WO = 256, T_WM = 256, T_W1 = 32 * 512, T_W2 = 32 * 256;
    constexpr int NT = T_IN + T_WB + T_WO + T_WM + T_W1 + T_W2;
    for (int it = gw; it < NT; it += NGW) {
        int r = it;
        if (r < T_IN) { const int kb = r / 156, nb = r % 156; tconv_tile(F.in[I_W_IN], 1024, IN_COLS, (bf16*)(ws + WS_WIN), 64 * kb, 64 * nb, 64 * nb, lane); continue; } r -= T_IN;
        if (r < T_WB) { const int b = r / 128, q = r % 128, kb = q / 16, nb = q % 16;
            tconv_tile(F.in[I_W_BRANCH] + (size_t)b * 512 * 1024, 512, 1024, (bf16*)(ws + WS_WB) + (size_t)b * 1024 * 512, 64 * kb, 64 * nb, 64 * nb, lane); continue; } r -= T_WB;
        if (r < T_WO) { const int kb = r / 16, nb = r % 16; tconv_tile(F.in[I_W_OUT], 1024, 1024, (bf16*)(ws + WS_WO), 64 * kb, 64 * nb, 64 * nb, lane); continue; } r -= T_WO;
        if (r < T_WM) { const int kb = r / 16, nb = r % 16; tconv_tile(F.in[I_W_MEMKV], 1024, 1024, (bf16*)(ws + WS_WMEM), 64 * kb, 64 * nb, 64 * nb, lane); continue; } r -= T_WM;
        if (r < T_W1) { const int e = r / 512, q = r % 512, kb = q / 32, nb = q % 32, n0 = 64 * nb;
            const int rowbase = (n0 < 1024) ? ((n0 >> 7) * 256 + (n0 & 127)) : ((((n0 - 1024) >> 7) * 256) + 128 + ((n0 - 1024) & 127));
            tconv_tile(F.in[I_EXP_W1] + (size_t)e * 1024 * 2048, 1024, 2048, (bf16*)(ws + WS_W1) + (size_t)e * 2048 * 1024, 64 * kb, n0, rowbase, lane); continue; } r -= T_W1;
        { const int e = r / 256, q = r % 256, kb = q / 16, nb = q % 16;
            tconv_tile(F.in[I_EXP_W2] + (size_t)e * 1024 * 1024, 1024, 1024, (bf16*)(ws + WS_W2) + (size_t)e * 1024 * 1024, 64 * kb, 64 * nb, 64 * nb, lane); }
    }
    for (int m = gw; m < MTOK; m += NGW) rms_row_to_bf16(F.in[I_X] + (size_t)m * D_MODEL, F.in[I_NORM_MIX], (bf16*)(ws + WS_XN) + (size_t)m * D_MODEL, lane);
    for (int m = gw; m < MEMROWS; m += NGW) rms_row_to_bf16(F.in[I_MEM] + (size_t)m * D_MODEL, F.in[I_MEM_NORM], (bf16*)(ws + WS_MEMN) + (size_t)m * D_MODEL, lane);
}

__device__ __forceinline__ void head_norm(bf16* p, const float* gain, bool rot, float c0, float s0, float c1, float s1, float scale, int lane) {
    GAS unsigned* pw = (GAS unsigned*)p + lane;
    const unsigned w = *pw; float a = bf_lo(w), b = bf_hi(w);
    const float ss = wave_sum(a * a + b * b);
    const float rstd = 1.0f / sqrtf(ss * (1.f / 128.f) + NORM_EPS);
    const f32x2 g = *((const GAS f32x2*)gain + lane);
    a = a * rstd * g.x; b = b * rstd * g.y;
    const float pa = __shfl_xor(a, 8), pb = __shfl_xor(b, 8);
    if (rot && lane < 16) {
        if (lane < 8) { a = a * c0 - pa * s0; b = b * c1 - pb * s1; }
        else          { a = a * c0 + pa * s0; b = b * c1 + pb * s1; }
    }
    *pw = pk2(a * scale, b * scale);
}
__device__ __forceinline__ void p2_prep(Frame& F) {
    const int gw = F.vcu * NWAVES + F.wave, NGW = F.G * NWAVES, lane = F.lane;
    unsigned char* ws = F.ws;
    bf16* Z = (bf16*)(ws + WS_Z);
    LAS float* lo = (LAS float*)(F.lds + RING_OFF + F.wave * 8192);
    const float* mu = F.in[I_R_MU];
    float* Rr = (float*)(ws + WS_RW); float* Rw = Rr + (size_t)MTOK * RW; float* Rk = Rw + (size_t)MTOK * RW; float* Rv = Rk + (size_t)MTOK * RW;
    float* Ra = Rv + (size_t)MTOK * RW; float* Rb = Ra + (size_t)MTOK * RW; float* Rg = Rb + (size_t)MTOK * RW;
    for (int task = gw; task < MTOK / 4; task += NGW) {
        const int m0 = task * 4, tpos0 = m0 % SEQ, bb = m0 / SEQ;
        for (int tt = 0; tt < 4; ++tt) {
            const int m = m0 + tt;
            const float pos = (float)((const int*)F.in[I_POS])[m];
            const int i0 = 2 * (lane & 7);
            const float f0 = exp2f(-(float)i0 * (18.931568569324174f / 16.0f)), f1 = exp2f(-(float)(i0 + 1) * (18.931568569324174f / 16.0f));
            float s0, c0, s1, c1; sincosf(pos * f0, &s0, &c0); sincosf(pos * f1, &s1, &c1);
            bf16* zr = Z + (size_t)m * IN_COLS;
            for (int hd = 0; hd < 12; ++hd) head_norm(zr + OFF_AQ + hd * 128, F.in[I_AQ_GAIN], true, c0, s0, c1, s1, QSCALE, lane);
            for (int hd = 0; hd < 12; ++hd) head_norm(zr + OFF_AK + hd * 128, F.in[I_AK_GAIN], true, c0, s0, c1, s1, 1.0f, lane);
            for (int hd = 0; hd < 4; ++hd)  head_norm(zr + OFF_CQ + hd * 128, F.in[I_CQ_GAIN], false, c0, s0, c1, s1, QSCALE, lane);
        }
#pragma unroll
        for (int i = 0; i < 4; ++i) { const int j = lane + 64 * i; const int col = OFF_R + 1536 + j; const float muj = mu[1536 + j];
            float prv = (tpos0 == 0) ? 0.f : __builtin_bit_cast(float, (unsigned)Z[(size_t)(m0 - 1) * IN_COLS + col] << 16);
#pragma unroll
            for (int tt = 0; tt < 4; ++tt) { const float cur = __builtin_bit_cast(float, (unsigned)Z[(size_t)(m0 + tt) * IN_COLS + col] << 16);
                float x = cur + (prv - cur) * muj; prv = cur;
                x = (i == 0) ? tanhf(x) : (i == 1) ? x : sigm(x);
                lo[j * 4 + tt] = x; } }
        LDS_WAIT(); asm volatile("" ::: "memory");
        float accw[4][8], acca[4][8], accg[4][8];
#pragma unroll
        for (int tt = 0; tt < 4; ++tt)
#pragma unroll
            for (int c = 0; c < 8; ++c) { accw[tt][c] = 0.f; acca[tt][c] = 0.f; accg[tt][c] = 0.f; }
        { const float* W2 = F.in[I_R_W2];
          for (int j = 0; j < 64; ++j) { const f32x4 xin = *(const LAS f32x4*)(lo + j * 4);
#pragma unroll
              for (int i = 0; i < 4; ++i) { const f32x2 wv = *(const GAS f32x2*)(W2 + (size_t)j * RW + 2 * lane + 128 * i);
#pragma unroll
                  for (int tt = 0; tt < 4; ++tt) { accw[tt][2 * i] += xin[tt] * wv.x; accw[tt][2 * i + 1] += xin[tt] * wv.y; } } } }
        { const float* A2 = F.in[I_R_A2];
          for (int j = 0; j < 64; ++j) { const f32x4 xin = *(const LAS f32x4*)(lo + (64 + j) * 4);
#pragma unroll
              for (int i = 0; i < 4; ++i) { const f32x2 wv = *(const GAS f32x2*)(A2 + (size_t)j * RW + 2 * lane + 128 * i);
#pragma unroll
                  for (int tt = 0; tt < 4; ++tt) { acca[tt][2 * i] += xin[tt] * wv.x; acca[tt][2 * i + 1] += xin[tt] * wv.y; } } } }
        { const float* G2 = F.in[I_R_G2];
          for (int j = 0; j < 128; ++j) { const f32x4 xin = *(const LAS f32x4*)(lo + (128 + j) * 4);
#pragma unroll
              for (int i = 0; i < 4; ++i) { const f32x2 wv = *(const GAS f32x2*)(G2 + (size_t)j * RW + 2 * lane + 128 * i);
#pragma unroll
                  for (int tt = 0; tt < 4; ++tt) { accg[tt][2 * i] += xin[tt] * wv.x; accg[tt][2 * i + 1] += xin[tt] * wv.y; } } } }
        asm volatile("" ::: "memory");
#pragma unroll
        for (int i = 0; i < 4; ++i) {
            const int c = 2 * lane + 128 * i;
            const f32x2 w0 = *(const GAS f32x2*)(F.in[I_R_W0] + c), a0 = *(const GAS f32x2*)(F.in[I_R_A0] + c), kkc = *(const GAS f32x2*)(F.in[I_R_KK] + c), kac = *(const GAS f32x2*)(F.in[I_R_KA] + c);
            const f32x2 mur = *(const GAS f32x2*)(mu + c), muk = *(const GAS f32x2*)(mu + 512 + c), muv = *(const GAS f32x2*)(mu + 1024 + c);
            unsigned pr = 0u, pk = 0u, pv = 0u;
            if (tpos0 != 0) { const bf16* zp = Z + (size_t)(m0 - 1) * IN_COLS + OFF_R + c; pr = *(const GAS unsigned*)zp; pk = *(const GAS unsigned*)(zp + 512); pv = *(const GAS unsigned*)(zp + 1024); }
#pragma unroll
            for (int tt = 0; tt < 4; ++tt) {
                const size_t m = (size_t)(m0 + tt);
                const bf16* zc = Z + m * IN_COLS + OFF_R + c;
                const unsigned cr = *(const GAS unsigned*)zc, ck = *(const GAS unsigned*)(zc + 512), cv = *(const GAS unsigned*)(zc + 1024);
                f32x2 r, k, v;
                r.x = bf_lo(cr) + (bf_lo(pr) - bf_lo(cr)) * mur.x; r.y = bf_hi(cr) + (bf_hi(pr) - bf_hi(cr)) * mur.y;
                k.x = bf_lo(ck) + (bf_lo(pk) - bf_lo(ck)) * muk.x; k.y = bf_hi(ck) + (bf_hi(pk) - bf_hi(ck)) * muk.y;
                v.x = bf_lo(cv) + (bf_lo(pv) - bf_lo(cv)) * muv.x; v.y = bf_hi(cv) + (bf_hi(pv) - bf_hi(cv)) * muv.y;
                pr = cr; pk = ck; pv = cv;
                f32x2 wd, av;
                { float x0 = w0.x + accw[tt][2 * i], x1 = w0.y + accw[tt][2 * i + 1];
                  float y0 = -x0, y1 = -x1;
                  float sp0 = fmaxf(y0, 0.f) + log1pf(__expf(-fabsf(y0))), sp1 = fmaxf(y1, 0.f) + log1pf(__expf(-fabsf(y1)));
                  wd.x = __expf(-__expf(-sp0 - 0.5f)); wd.y = __expf(-__expf(-sp1 - 0.5f)); }
                av.x = sigm(a0.x + acca[tt][2 * i]); av.y = sigm(a0.y + acca[tt][2 * i + 1]);
                f32x2 kk; kk.x = k.x * kkc.x; kk.y = k.y * kkc.y;
                float slo, shi; half_sums(kk.x * kk.x + kk.y * kk.y, slo, shi);
                const float nrm = fmaxf(sqrtf(lane < 32 ? slo : shi), 1e-12f), inv = 1.0f / nrm;
                kk.x *= inv; kk.y *= inv;
                f32x2 k2; k2.x = k.x * (1.0f + (av.x - 1.0f) * kac.x); k2.y = k.y * (1.0f + (av.y - 1.0f) * kac.y);
                f32x2 as, bs; as.x = -kk.x; as.y = -kk.y; bs.x = kk.x * av.x; bs.y = kk.y * av.y;
                f32x2 gg; gg.x = accg[tt][2 * i]; gg.y = accg[tt][2 * i + 1];
                const size_t o = m * RW + c;
                *(GAS f32x2*)(Rr + o) = r; *(GAS f32x2*)(Rw + o) = wd; *(GAS f32x2*)(Rk + o) = k2; *(GAS f32x2*)(Rv + o) = v;
                *(GAS f32x2*)(Ra + o) = as; *(GAS f32x2*)(Rb + o) = bs; *(GAS f32x2*)(Rg + o) = gg;
            }
        }
        LDS_WAIT(); asm volatile("" ::: "memory");
    }
    for (int m = gw; m < MEMROWS; m += NGW)
        for (int hd = 0; hd < 4; ++hd) head_norm((bf16*)(ws + WS_KVM) + (size_t)m * 1024 + hd * 128, F.in[I_CK_GAIN], false, 1.f, 0.f, 1.f, 0.f, 1.0f, lane);
}

__device__ __forceinline__ float qk_dot(const LAS float* q, const bf16* krow) {
    const GAS v4u* kp = (const GAS v4u*)krow; float s0 = 0.f, s1 = 0.f;
#pragma unroll
    for (int i = 0; i < 16; ++i) { const v4u w = kp[i]; const f32x4 qa = *(const LAS f32x4*)(q + 8 * i), qb = *(const LAS f32x4*)(q + 8 * i + 4);
        s0 += bf_lo(w.x) * qa[0] + bf_hi(w.x) * qa[1] + bf_lo(w.y) * qa[2] + bf_hi(w.y) * qa[3];
        s1 += bf_lo(w.z) * qb[0] + bf_hi(w.z) * qb[1] + bf_lo(w.w) * qb[2] + bf_hi(w.w) * qb[3]; }
    return s0 + s1;
}
__device__ __forceinline__ void p3_attention(Frame& F) {
    const int gw = F.vcu * NWAVES + F.wave, NGW = F.G * NWAVES, lane = F.lane;
    unsigned char* ws = F.ws;
    const bf16* Z = (const bf16*)(ws + WS_Z);
    const bf16* KV = (const bf16*)(ws + WS_KVM);
    bf16* YA = (bf16*)(ws + WS_YABC); bf16* YC = YA + (size_t)2 * MTOK * 512;
    LAS float* qs = (LAS float*)(F.lds + RING_OFF + F.wave * 8192);
    for (int task = gw; task < MTOK * 4; task += NGW) {
        const int m = task >> 2, h = task & 3, t = m % SEQ;
        const bf16* zrow = Z + (size_t)m * IN_COLS;
#pragma unroll
        for (int g = 0; g < 3; ++g) { const unsigned w = *((const GAS unsigned*)(zrow + OFF_AQ + g * 512 + h * 128) + lane); qs[g * 128 + 2 * lane] = bf_lo(w); qs[g * 128 + 2 * lane + 1] = bf_hi(w); }
        LDS_WAIT(); asm volatile("" ::: "memory");
        float sc[3][3]; float mx = -INFINITY;
#pragma unroll
        for (int g = 0; g < 3; ++g) { const int dl = (g == 0) ? 1 : (g == 1) ? 4 : 16;
#pragma unroll
            for (int p = 0; p < 3; ++p) { const int j = lane + 64 * p; const int tk = t - dl * j; float s = -INFINITY;
                if (j <= 128 && tk >= 0) s = qk_dot(qs + g * 128, zrow - (size_t)dl * j * IN_COLS + OFF_AK + g * 512 + h * 128);
                sc[g][p] = s; mx = fmaxf(mx, s); } }
        mx = wave_max_bp(mx);
        float den = 0.f;
#pragma unroll
        for (int g = 0; g < 3; ++g)
#pragma unroll
            for (int p = 0; p < 3; ++p) { sc[g][p] = exp2f(sc[g][p] - mx); den += sc[g][p]; }
        den = wave_sum(den);
        float o0 = 0.f, o1 = 0.f;
#pragma unroll
        for (int g = 0; g < 3; ++g) { const int dl = (g == 0) ? 1 : (g == 1) ? 4 : 16; const bf16* vb = zrow + OFF_AV + g * 512 + h * 128 + 2 * lane;
#pragma unroll
            for (int p = 0; p < 3; ++p) { const int nj = (p < 2) ? 64 : 1;
                for (int jj = 0; jj < nj; ++jj) { const int j = jj + 64 * p; const float pj = rdlane(sc[g][p], jj);
                    if (t - dl * j >= 0) { const unsigned w = *(const GAS unsigned*)(vb - (size_t)dl * j * IN_COLS); o0 += pj * bf_lo(w); o1 += pj * bf_hi(w); } } } }
        const float inv = 1.0f / den;
        *((GAS unsigned*)(YA + (size_t)m * 512 + h * 128) + lane) = pk2(o0 * inv, o1 * inv);
        asm volatile("" ::: "memory");
    }
    for (int task = gw; task < MTOK * 4; task += NGW) {
        const int m = task >> 2, h = task & 3, b = m / SEQ;
        const bf16* zrow = Z + (size_t)m * IN_COLS;
        { const unsigned w = *((const GAS unsigned*)(zrow + OFF_CQ + h * 128) + lane); qs[2 * lane] = bf_lo(w); qs[2 * lane + 1] = bf_hi(w); }
        LDS_WAIT(); asm volatile("" ::: "memory");
        const bf16* kb = KV + (size_t)b * MEM_LEN * 1024 + h * 128;
        float sc[4]; float mx = -INFINITY;
#pragma unroll
        for (int p = 0; p < 4; ++p) { sc[p] = qk_dot(qs, kb + (size_t)(lane + 64 * p) * 1024); mx = fmaxf(mx, sc[p]); }
        mx = wave_max_bp(mx);
        float den = 0.f;
#pragma unroll
        for (int p = 0; p < 4; ++p) { sc[p] = exp2f(sc[p] - mx); den += sc[p]; }
        den = wave_sum(den);
        float o0 = 0.f, o1 = 0.f; const bf16* vb = kb + 512 + 2 * lane;
#pragma unroll
        for (int p = 0; p < 4; ++p)
            for (int jj = 0; jj < 64; ++jj) { const float pj = rdlane(sc[p], jj); const unsigned w = *(const GAS unsigned*)(vb + (size_t)(jj + 64 * p) * 1024); o0 += pj * bf_lo(w); o1 += pj * bf_hi(w); }
        const float inv = 1.0f / den;
        *((GAS unsigned*)(YC + (size_t)m * 512 + h * 128) + lane) = pk2(o0 * inv, o1 * inv);
        asm volatile("" ::: "memory");
    }
}

struct ScanBuf { float r[4], w[4], k[4], a[4], b[4], v[4]; };
__device__ __forceinline__ void scan_load(ScanBuf& B, const float* Rr, const float* Rw, const float* Rk, const float* Rv, const float* Ra, const float* Rb, size_t o, size_t ov) {
#pragma unroll
    for (int i = 0; i < 4; ++i) { const size_t oi = o + (size_t)i * RW;
        B.r[i] = *(const GAS float*)(Rr + oi); B.w[i] = *(const GAS float*)(Rw + oi); B.k[i] = *(const GAS float*)(Rk + oi); B.a[i] = *(const GAS float*)(Ra + oi); B.b[i] = *(const GAS float*)(Rb + oi);
        B.v[i] = *(const GAS float*)(Rv + ov + (size_t)i * RW); }
}
__device__ __forceinline__ void scan_step4(const ScanBuf& B, float& S, float& yk, int lane, int sub) {
#pragma unroll
    for (int i = 0; i < 4; ++i) {
        const float sa = wave_sum(S * B.a[i]);
        S = S * B.w[i] + (sa * B.b[i] + B.v[i] * B.k[i]);
        const float y = wave_sum(S * B.r[i]);
        if (lane == sub * 4 + i) yk = y;
    }
}
__device__ __forceinline__ void p4_scan(Frame& F) {
    unsigned char* ws = F.ws; const int lane = F.lane;
    const float* Rr = (const float*)(ws + WS_RW); const float* Rw = Rr + (size_t)MTOK * RW; const float* Rk = Rw + (size_t)MTOK * RW; const float* Rv = Rk + (size_t)MTOK * RW;
    const float* Ra = Rv + (size_t)MTOK * RW; const float* Rb = Ra + (size_t)MTOK * RW;
    float* YS = (float*)(ws + WS_YS);
    if (F.wave < 4) {
        for (int row = (int)blockIdx.x * 4 + F.wave; row < BATCH * 8 * 64; row += F.G * 4) {
            const int b = row >> 9, h = (row >> 6) & 7, vr = row & 63;
            const size_t base = (size_t)b * SEQ * RW + h * 64 + lane, basev = (size_t)b * SEQ * RW + h * 64 + vr;
            float S = 0.f, yk = 0.f;
            ScanBuf A, B;
            scan_load(A, Rr, Rw, Rk, Rv, Ra, Rb, base, basev);
            for (int t0 = 0; t0 < SEQ; t0 += 8) {
                scan_load(B, Rr, Rw, Rk, Rv, Ra, Rb, base + (size_t)(t0 + 4) * RW, basev + (size_t)(t0 + 4) * RW);
                scan_step4(A, S, yk, lane, 0);
                if (t0 + 8 < SEQ) scan_load(A, Rr, Rw, Rk, Rv, Ra, Rb, base + (size_t)(t0 + 8) * RW, basev + (size_t)(t0 + 8) * RW);
                scan_step4(B, S, yk, lane, 1);
                if (lane < 8) *(GAS float*)(YS + basev + (size_t)(t0 + lane) * RW) = yk;
            }
        }
    }
}

__device__ __forceinline__ void p5_post(Frame& F) {
    const int gw = F.vcu * NWAVES + F.wave, NGW = F.G * NWAVES, lane = F.lane;
    unsigned char* ws = F.ws;
    const float* Rr = (const float*)(ws + WS_RW); const float* Rk = Rr + (size_t)2 * MTOK * RW; const float* Rv = Rk + (size_t)MTOK * RW; const float* Rg = Rr + (size_t)6 * MTOK * RW;
    const float* YS = (const float*)(ws + WS_YS);
    bf16* YB = (bf16*)(ws + WS_YABC) + (size_t)MTOK * 512;
    for (int m = gw; m < MTOK; m += NGW) {
#pragma unroll
        for (int h = 0; h < 8; ++h) { const int c = h * 64 + lane; const size_t o = (size_t)m * RW + c;
            const float y = *(const GAS float*)(YS + o), r = *(const GAS float*)(Rr + o), k = *(const GAS float*)(Rk + o), v = *(const GAS float*)(Rv + o), g = *(const GAS float*)(Rg + o);
            const float mean = wave_sum(y) * (1.f / 64.f); const float d = y - mean;
            const float var = wave_sum(d * d) * (1.f / 64.f);
            float yn = d * (1.0f / sqrtf(var + R_GN_EPS)) * F.in[I_R_LNW][c] + F.in[I_R_LNB][c];
            const float bonus = wave_sum(r * k * F.in[I_R_RK][c]) * v;
            YB[(size_t)m * 512 + c] = (bf16)f2bf((yn + bonus) * g); }
    }
}

__device__ __forceinline__ void p8_router(Frame& F) {
    const int gw = F.vcu * NWAVES + F.wave, NGW = F.G * NWAVES, lane = F.lane;
    unsigned char* ws = F.ws;
    const float* X1 = F.out; bf16* XN2 = (bf16*)(ws + WS_XN2);
    int* topi = (int*)(ws + WS_ROUTE + RT_TOPI); float* topg = (float*)(ws + WS_ROUTE + RT_TOPG);
    const float* RWt = F.in[I_ROUTER_W]; const float* RB = F.in[I_ROUTER_B]; const float* gain = F.in[I_NORM_FFN];
    for (int m = gw; m < MTOK; m += NGW) {
        const GAS f32x4* xr = (const GAS f32x4*)(X1 + (size_t)m * D_MODEL) + lane; const GAS f32x4* gr = (const GAS f32x4*)gain + lane;
        f32x4 v[4]; float s = 0.f;
#pragma unroll
        for (int j = 0; j < 4; ++j) { v[j] = xr[64 * j]; s += (v[j].x * v[j].x + v[j].y * v[j].y) + (v[j].z * v[j].z + v[j].w * v[j].w); }
        const float rstd = 1.0f / sqrtf(wave_sum(s) * (1.f / D_MODEL) + NORM_EPS);
        GAS unsigned long long* o8 = (GAS unsigned long long*)(XN2 + (size_t)m * D_MODEL) + lane;
#pragma unroll
        for (int j = 0; j < 4; ++j) { const f32x4 g = gr[64 * j]; v[j] = v[j] * rstd * g;
            o8[64 * j] = (unsigned long long)pk2(v[j].x, v[j].y) | ((unsigned long long)pk2(v[j].z, v[j].w) << 32); }
        float lg[32];
#pragma unroll
        for (int e = 0; e < 32; ++e) lg[e] = 0.f;
#pragma unroll
        for (int j = 0; j < 4; ++j)
#pragma unroll
            for (int i = 0; i < 4; ++i) { const float xv = v[j][i]; const GAS f32x4* wr = (const GAS f32x4*)(RWt + (size_t)(4 * lane + i + 256 * j) * N_EXPERTS);
#pragma unroll
                for (int q = 0; q < 8; ++q) { const f32x4 w = wr[q]; lg[4 * q] += xv * w.x; lg[4 * q + 1] += xv * w.y; lg[4 * q + 2] += xv * w.z; lg[4 * q + 3] += xv * w.w; } }
#pragma unroll
        for (int e = 0; e < 32; ++e) lg[e] = wave_sum(lg[e]) + RB[e];
        int ti[4]; float tv[4];
#pragma unroll
        for (int k = 0; k < 4; ++k) { float best = -INFINITY; int bi = 0;
#pragma unroll
            for (int e = 0; e < 32; ++e) { const bool taken = (k > 0 && ti[0] == e) || (k > 1 && ti[1] == e) || (k > 2 && ti[2] == e); if (!taken && lg[e] > best) { best = lg[e]; bi = e; } }
            ti[k] = bi; tv[k] = best; }
        const float e0 = 1.f, e1 = __expf(tv[1] - tv[0]), e2 = __expf(tv[2] - tv[0]), e3 = __expf(tv[3] - tv[0]); const float inv = 1.0f / (e0 + e1 + e2 + e3);
        if (lane < 4) { const int k = lane; const int e = (k == 0) ? ti[0] : (k == 1) ? ti[1] : (k == 2) ? ti[2] : ti[3]; const float gq = ((k == 0) ? e0 : (k == 1) ? e1 : (k == 2) ? e2 : e3) * inv;
            topi[(size_t)m * 4 + k] = e; topg[(size_t)m * 4 + k] = gq;
            __hip_atomic_fetch_add((unsigned*)(F.ctl + CW_CNT) + e, 1u, __ATOMIC_RELAXED, __HIP_MEMORY_SCOPE_AGENT); }
    }
}
__device__ __forceinline__ void moe_table(Frame& F) {
    LAS int* tab = (LAS int*)(F.lds + MOETAB_OFF);
    __syncthreads();
    if (F.tid == 0) { int acc = 0;
        for (int e = 0; e < N_EXPERTS; ++e) { const int c = (int)__hip_atomic_load((unsigned*)(F.ctl + CW_CNT) + e, __ATOMIC_RELAXED, __HIP_MEMORY_SCOPE_AGENT); const int nb = (c + MOE_ROWS - 1) / MOE_ROWS;
            tab[320 + e] = acc * MOE_ROWS; for (int q = 0; q < nb; ++q) tab[1 + acc + q] = e; acc += nb; }
        tab[0] = acc; }
    __syncthreads();
}
__device__ __forceinline__ void p9_dispatch(Frame& F) {
    const int gw = F.vcu * NWAVES + F.wave, NGW = F.G * NWAVES, lane = F.lane;
    unsigned char* ws = F.ws;
    moe_table(F);
    const LAS int* tab = (const LAS int*)(F.lds + MOETAB_OFF);
    const int* topi = (const int*)(ws + WS_ROUTE + RT_TOPI); const float* topg = (const float*)(ws + WS_ROUTE + RT_TOPG);
    int* pos = (int*)(ws + WS_ROUTE + RT_POS); float* rowgate = (float*)(ws + WS_ROUTE + RT_ROWGATE);
    const bf16* XN2 = (const bf16*)(ws + WS_XN2); bf16* XS = (bf16*)(ws + WS_XS);
    for (int m = gw; m < MTOK; m += NGW) {
        int slot = 0;
        if (lane < 4) { const int e = topi[(size_t)m * 4 + lane];
            slot = tab[320 + e] + (int)__hip_atomic_fetch_add((unsigned*)(F.ctl + CW_CUR) + e, 1u, __ATOMIC_RELAXED, __HIP_MEMORY_SCOPE_AGENT);
            pos[(size_t)m * 4 + lane] = slot; rowgate[slot] = topg[(size_t)m * 4 + lane]; }
        const GAS v4u* src = (const GAS v4u*)(XN2 + (size_t)m * D_MODEL) + lane; const v4u a = src[0], b = src[64];
#pragma unroll
        for (int k = 0; k < 4; ++k) { const int sk = __builtin_amdgcn_readlane(slot, k); GAS v4u* dst = (GAS v4u*)(XS + (size_t)sk * D_MODEL) + lane; dst[0] = a; dst[64] = b; }
    }
}
__device__ __forceinline__ void p12_combine(Frame& F) {
    const int gw = F.vcu * NWAVES + F.wave, NGW = F.G * NWAVES, lane = F.lane;
    unsigned char* ws = F.ws;
    const int* pos = (const int*)(ws + WS_ROUTE + RT_POS); const bf16* YR = (const bf16*)(ws + WS_YROWS);
    for (int m = gw; m < MTOK; m += NGW) {
        GAS f32x4* xo = (GAS f32x4*)(F.out + (size_t)m * D_MODEL) + 2 * lane;
        int pk = 0; if (lane < 4) pk = pos[(size_t)m * 4 + lane];
#pragma unroll
        for (int hf = 0; hf < 2; ++hf) { f32x4 a = xo[128 * hf], b = xo[128 * hf + 1];
#pragma unroll
            for (int k = 0; k < 4; ++k) { const int sk = __builtin_amdgcn_readlane(pk, k); const v4u w = *((const GAS v4u*)(YR + (size_t)sk * D_MODEL + 512 * hf) + lane);
                a[0] += bf_lo(w.x); a[1] += bf_hi(w.x); a[2] += bf_lo(w.y); a[3] += bf_hi(w.y); b[0] += bf_lo(w.z); b[1] += bf_hi(w.z); b[2] += bf_lo(w.w); b[3] += bf_hi(w.w); }
            xo[128 * hf] = a; xo[128 * hf + 1] = b; }
    }
}

struct Args { const float* in[32]; float* out; unsigned char* ws; int ph_lo, ph_hi, use_bar, pad; };
__global__ void __launch_bounds__(NWAVES * 64, 2) skel_fwd(Args args) {
    extern __shared__ __attribute__((aligned(16))) unsigned char lds[];
    Frame F;
    F.lds = (LAS unsigned char*)lds;
    F.MISC = (volatile LAS unsigned*)(F.lds + MISC_OFF);
    F.tid = threadIdx.x; F.lane = F.tid & 63; F.wave = __builtin_amdgcn_readfirstlane(F.tid >> 6);
    F.G = gridDim.x; { const int bx = blockIdx.x; F.vcu = (F.G % 8 == 0) ? (bx % 8) * (F.G / 8) + bx / 8 : bx; }
    unsigned char* ws = args.ws; F.ws = ws; F.out = args.out;
    F.ctl = (gu32*)(ws + WS_CTL);
#pragma unroll
    for (int i = 0; i < 32; ++i) F.in[i] = args.in[i];
    for (int u = F.tid; u < (LDS_BYTES - LDSCTL_OFF) / 4; u += NWAVES * 64) ((LAS unsigned*)(F.lds + LDSCTL_OFF))[u] = 0u;
    __syncthreads();
    XcdBarrier bar; bar.bar = (unsigned*)(F.ctl + CW_BAR); bar.x = 0; bar.st = nullptr;
    if (args.use_bar) bar = xcd_barrier_post((unsigned*)(F.ctl + CW_BAR), F.MISC + 8);
    const int lo = args.ph_lo, hi = args.ph_hi;
#define IN(k) (lo <= (k) && (k) < hi)
#define SEAM(k) do { if (IN(k) && IN((k) + 1)) xcd_barrier(bar); } while (0)
    const pg8::bf16_t* wsb = (const pg8::bf16_t*)ws;
#define BF(off) ((pg8::bf16_t*)(ws + (off)))

    if (IN(0)) { p0_prologue(F); } SEAM(0);
    if (IN(1)) {
        { pg8::Gemm g{BF(WS_XN), BF(WS_WIN), MTOK, IN_COLS, 1024}; pg8::StaticOrder S; S.init(MTOK, IN_COLS, F.G, (int)blockIdx.x);
          pg8::EpiBf16<0> E{BF(WS_Z), IN_COLS, nullptr, 0, 0, 1.f};
          pg8::gemm_phase<pg8::EpiBf16<0>, pg8::StaticOrder, true, true>(F.lds + RING_OFF, g, S, E); }
        { pg8::Gemm g{BF(WS_MEMN), BF(WS_WMEM), MEMROWS, 1024, 1024}; pg8::StaticOrder S; S.init(MEMROWS, 1024, F.G, (int)blockIdx.x);
          pg8::EpiBf16<0> E{BF(WS_KVM), 1024, nullptr, 0, 0, 1.f};
          pg8::gemm_phase<pg8::EpiBf16<0>, pg8::StaticOrder, true, true>(F.lds + RING_OFF, g, S, E); }
    } SEAM(1);
    if (IN(2)) { p2_prep(F); } SEAM(2);
    if (IN(3)) { p3_attention(F); } SEAM(3);
    if (IN(4)) { p4_scan(F); } SEAM(4);
    if (IN(5)) { p5_post(F); } SEAM(5);
    if (IN(6)) {
        for (int br = 0; br < 3; ++br) {
            pg8::Gemm g{BF(WS_YABC) + (size_t)br * MTOK * 512, BF(WS_WB) + (size_t)br * 1024 * 512, MTOK, 1024, 512}; pg8::StaticOrder S; S.init(MTOK, 1024, F.G, (int)blockIdx.x);
            pg8::EpiGate E{BF(WS_Z), F.in[I_B_GATE], (float*)(ws + WS_MRG), BF(WS_MRGB), br};
            pg8::gemm_phase<pg8::EpiGate, pg8::StaticOrder, true, true>(F.lds + RING_OFF, g, S, E);
        }
    } SEAM(6);
    if (IN(7)) {
        pg8::Gemm g{BF(WS_MRGB), BF(WS_WO), MTOK, 1024, 1024}; pg8::StaticOrder S; S.init(MTOK, 1024, F.G, (int)blockIdx.x);
        pg8::EpiResF32 E{F.in[I_X], F.out, 1024};
        pg8::gemm_phase<pg8::EpiResF32, pg8::StaticOrder, true, true>(F.lds + RING_OFF, g, S, E);
    } SEAM(7);
    if (IN(8)) { p8_router(F); } SEAM(8);
    if (IN(9)) { p9_dispatch(F); } SEAM(9);
    if (IN(10)) {
        moe_table(F);
        pg8::Gemm g{BF(WS_XS), BF(WS_W1), 0, 0, 1024}; pg8::MoeOrder S{(const PG8_LAS int*)(F.lds + MOETAB_OFF), 8, F.G, (int)blockIdx.x};
        pg8::EpiSwiGLU E{F.in[I_EXP_B1], BF(WS_HACT)};
        pg8::gemm_phase<pg8::EpiSwiGLU, pg8::MoeOrder, true, true>(F.lds + RING_OFF, g, S, E);
    } SEAM(10);
    if (IN(11)) {
        moe_table(F);
        pg8::Gemm g{BF(WS_HACT), BF(WS_W2), 0, 0, 1024}; pg8::MoeOrder S{(const PG8_LAS int*)(F.lds + MOETAB_OFF), 4, F.G, (int)blockIdx.x};
        pg8::EpiMoeOut E{F.in[I_EXP_B2], (const float*)(ws + WS_ROUTE + RT_ROWGATE), BF(WS_YROWS)};
        pg8::gemm_phase<pg8::EpiMoeOut, pg8::MoeOrder, true, true>(F.lds + RING_OFF, g, S, E);
    } SEAM(11);
    if (IN(12)) { p12_combine(F); }
#undef IN
#undef SEAM
#undef BF
    (void)wsb;
}

extern "C" void kernel_launch(void* const* d_in, const int* in_sizes, int n_in, void* d_out, int out_size, void* d_ws, size_t ws_size, hipStream_t stream) {
    static int grid = 0;
    if (grid == 0) {
        if (n_in != 32 || out_size != MTOK * D_MODEL || ws_size < WS_END) { fprintf(stderr, "kernel_launch: unexpected problem (n_in %d, out %d, ws %zu); nothing launched\n", n_in, out_size, ws_size); grid = -1; return; }
        int dev = 0, cus = 0;
        if (hipGetDevice(&dev) != hipSuccess || hipDeviceGetAttribute(&cus, hipDeviceAttributeMultiprocessorCount, dev) != hipSuccess) { grid = -1; return; }
        if (hipFuncSetAttribute((const void*)skel_fwd, hipFuncAttributeMaxDynamicSharedMemorySize, LDS_BYTES) != hipSuccess) { fprintf(stderr, "kernel_launch: hipFuncSetAttribute failed\n"); grid = -1; return; }
        (void)hipGetLastError();
        grid = cus;
    }
    if (grid < 0) return;
    (void)hipMemsetAsync((char*)d_ws + WS_CTL, 0, CTL_ZERO_BYTES, stream);
    Args a{};
    for (int i = 0; i < 32; ++i) a.in[i] = (const float*)d_in[i];
    a.out = (float*)d_out; a.ws = (unsigned char*)d_ws;
#if MK_N_LAUNCHES == 1
    a.ph_lo = 0; a.ph_hi = N_PHASES; a.use_bar = 1;
    hipLaunchKernelGGL(skel_fwd, dim3(grid), dim3(NWAVES * 64), LDS_BYTES, stream, a);
#else
    for (int p = 0; p < N_PHASES; ++p) { a.ph_lo = p; a.ph_hi = p + 1; a.use_bar = 0;
        hipLaunchKernelGGL(skel_fwd, dim3(grid), dim3(NWAVES * 64), LDS_BYTES, stream, a); }
#endif
}
```

```cpp
#include <hip/hip_runtime.h>
#include <cstdio>
#include <cstdint>
#include <cmath>
namespace pg8 {
#define PG8_LAS __attribute__((address_space(3)))
typedef unsigned short bf16_t;
typedef short bf16x8 __attribute__((ext_vector_type(8)));
typedef float f32x4 __attribute__((ext_vector_type(4)));
typedef unsigned u32x4 __attribute__((ext_vector_type(4)));
constexpr int BM = 256, BK = 64, HALF = 128, HTB = HALF * BK * 2  , STAGE_BYTES = 8 * HTB, NXCD = 8, WGM = 8;

__host__ __device__ __forceinline__ int lds_byte(int r, int c) { const int st = (r >> 4) * 2 + (c >> 5), rr = r & 15, cc = c & 31, ob = rr * 64 + cc * 2; return st * 1024 + (ob ^ (((ob >> 9) & 1) << 5)); }
__host__ __device__ __forceinline__ void stage_rc(int b, int& R, int& C) { const int st = b / 1024, sb = b % 1024, swz = sb ^ (((sb >> 9) & 1) << 5); R = (st >> 1) * 16 + swz / 64; C = (st & 1) * 32 + (swz % 64) / 2; }
__host__ __device__ __forceinline__ int perm32(int rho) { const int n = rho >> 4, i = rho & 15; return 8 * (i >> 2) + 4 * n + (i & 3); }

struct Unit { int pm, pn; };
struct Gemm { const bf16_t* A; const bf16_t* Bt; int M, N, K; };

struct StaticOrder {
    int nM, nN, nwg, G, c;
    __host__ __device__ void init(int M, int N, int G_, int c_) { nM = M / BM; nN = N / BM; nwg = nM * nN; G = G_; c = c_; }
    __host__ __device__ bool next(int i, Unit& u) const {
        const long L = (long)i * G + c; if (L >= nwg) return false;
        int wgid = (int)L; { const int q = nwg / NXCD, r = nwg % NXCD, xcd = wgid % NXCD, off = wgid / NXCD; wgid = (xcd < r ? xcd * (q + 1) : r * (q + 1) + (xcd - r) * q) + off; }
        const int nig = WGM * nN, gid = wgid / nig, fm = gid * WGM, gsz = (nM - fm) < WGM ? (nM - fm) : WGM;
        u.pm = fm + ((wgid % nig) % gsz); u.pn = (wgid % nig) / gsz; return true;
    }
    __device__ __forceinline__ void a_ready(const Unit&) const {}
    __device__ __forceinline__ void done(const Unit&) const {}
};

__device__ __forceinline__ unsigned cvt_pk_bf16(float lo, float hi) { unsigned r; asm volatile("v_cvt_pk_bf16_f32 %0, %1, %2" : "=v"(r) : "v"(lo), "v"(hi)); return r; }
typedef float f32x2 __attribute__((ext_vector_type(2)));
__device__ __forceinline__ f32x2 gelu_pk(f32x2 v) {
    const f32x2 av = __builtin_elementwise_abs(v), d = av * 0.2316418882f + 1.0f;
    f32x2 t; t.x = __builtin_amdgcn_rcpf(d.x); t.y = __builtin_amdgcn_rcpf(d.y);
    f32x2 q = t * 0.5307027145f + (-0.7265760135f); q = q * t + 0.7107068705f; q = q * t + (-0.142248368f); q = q * t + 0.127414796f; q = q * t;
    const f32x2 s = (v * v) * (-0.72134752044f);
    f32x2 e; e.x = __builtin_amdgcn_exp2f(s.x); e.y = __builtin_amdgcn_exp2f(s.y);
    const f32x2 m = v * (q * e), r = v - m;
    f32x2 o; o.x = v.x < 0.f ? m.x : r.x; o.y = v.y < 0.f ? m.y : r.y; return o;
}

template <int ACT  > struct EpiBf16 {
    static constexpr bool PERM = true, AFTER_DRAIN = false; static_assert(ACT == 0 || ACT == 1, "EpiBf16: ACT is 0 (none) or 1 (gelu_pk)");
    bf16_t* O; int ldc; const float* bias; int split_cols; size_t split_stride; float scale0;
    __device__ __forceinline__ void operator()(const f32x4 (&acc)[2][2][4][2], const Unit& u, int wr, int wc, int fr, int fq) const {
        const int row0 = u.pm * BM + wr * 64 + fr; int colt = u.pn * BM; bf16_t* base = O;
        float sc = 1.f; if (split_cols) { const int t = colt / split_cols; base += (size_t)t * split_stride; colt -= t * split_cols; if (t == 0) sc = scale0; }
        const int col0 = colt + wc * 32 + 8 * fq, bcol0 = u.pn * BM + wc * 32 + 8 * fq;
        f32x4 bv[2][2];
#pragma unroll
        for (int bj = 0; bj < 2; ++bj)
#pragma unroll
            for (int n = 0; n < 2; ++n) bv[bj][n] = bias ? *(const f32x4*)(bias + bcol0 + bj * HALF + 4 * n) : (f32x4){0.f, 0.f, 0.f, 0.f};
#pragma unroll
        for (int ai = 0; ai < 2; ++ai)
#pragma unroll
            for (int m = 0; m < 4; ++m) { bf16_t* rowp = base + (size_t)(row0 + ai * HALF + m * 16) * ldc + col0;
#pragma unroll
                for (int bj = 0; bj < 2; ++bj) { f32x4 v0 = acc[ai][bj][m][0] + bv[bj][0], v1 = acc[ai][bj][m][1] + bv[bj][1];
                    if (ACT == 1) { f32x2 a = gelu_pk((f32x2){v0[0], v0[1]}), b = gelu_pk((f32x2){v0[2], v0[3]}), c = gelu_pk((f32x2){v1[0], v1[1]}), d = gelu_pk((f32x2){v1[2], v1[3]});
                        v0 = (f32x4){a.x, a.y, b.x, b.y}; v1 = (f32x4){c.x, c.y, d.x, d.y}; }
                    v0 = v0 * sc; v1 = v1 * sc; u32x4 w; w.x = cvt_pk_bf16(v0[0], v0[1]); w.y = cvt_pk_bf16(v0[2], v0[3]); w.z = cvt_pk_bf16(v1[0], v1[1]); w.w = cvt_pk_bf16(v1[2], v1[3]);
                    *(u32x4*)(rowp + bj * HALF) = w; } }
    }
};
template <class Epi, class Sched, bool ALIGN_EPI = false, bool SP2 = false>
__device__ __forceinline__ void gemm_phase(PG8_LAS unsigned char* lds, const Gemm g, const Sched& S, const Epi& E) {
    const int tid = threadIdx.x, wid = __builtin_amdgcn_readfirstlane(tid >> 6), lane = tid & 63, wr = wid >> 2, wc = wid & 3, fr = lane & 15, fq = lane >> 4;
    const int K = g.K, nt = K / BK;
    unsigned voffA[2], voffB[2];
#pragma unroll
    for (int i = 0; i < 2; ++i) { int R, C; stage_rc(tid * 16 + i * 8192, R, C); const int Rb = Epi::PERM ? ((R & ~31) + perm32(R & 31)) : R;
        voffA[i] = (unsigned)(R * K + C) * 2u; voffB[i] = (unsigned)(Rb * K + C) * 2u; }
    const size_t kstep = (size_t)(BK * 2);
    const size_t hstep = (size_t)HALF * K * 2;
    const size_t tstep = 2 * hstep;
    const unsigned ldsw = (unsigned)wid * 1024u;
    const int aoff = lds_byte(wr * 64 + fr, fq * 8), boff = lds_byte(wc * 32 + fr, fq * 8);
#define PG8_SA(b, h) (((b) * 2 + (h)) * HTB)
#define PG8_SB(b, h) ((4 + (b) * 2 + (h)) * HTB)
#define PG8_STAGE(bufoff, gbase, voff) do { _Pragma("unroll") for (int _i = 0; _i < 2; ++_i) \
        __builtin_amdgcn_global_load_lds((const unsigned*)((const char*)(gbase) + (voff)[_i]), (PG8_LAS unsigned*)(lds + (bufoff) + ldsw + _i * 8192), 16, 0, 0); } while (0)
#define PG8_LDA(dst, b, h) do { _Pragma("unroll") for (int m = 0; m < 4; ++m) _Pragma("unroll") for (int k = 0; k < 2; ++k) dst[m][k] = *(const PG8_LAS bf16x8*)(lds + PG8_SA(b, h) + aoff + m * 2048 + k * 1024); } while (0)
#define PG8_LDB(dst, b, h) do { _Pragma("unroll") for (int n = 0; n < 2; ++n) _Pragma("unroll") for (int k = 0; k < 2; ++k) dst[n][k] = *(const PG8_LAS bf16x8*)(lds + PG8_SB(b, h) + boff + n * 2048 + k * 1024); } while (0)
#define PG8_MMA(ai, bj, At, Bt) do { __builtin_amdgcn_s_setprio(1); _Pragma("unroll") for (int m = 0; m < 4; ++m) _Pragma("unroll") for (int n = 0; n < 2; ++n) _Pragma("unroll") for (int k = 0; k < 2; ++k) \
        acc[ai][bj][m][n] = __builtin_amdgcn_mfma_f32_16x16x32_bf16(Bt[n][k], At[m][k], acc[ai][bj][m][n], 0, 0, 0); __builtin_amdgcn_s_setprio(0); } while (0)
#define PG8_WAIT_V(n) asm volatile("s_waitcnt vmcnt(" #n ")" ::: "memory")
#define PG8_WAIT_L(n) asm volatile("s_waitcnt lgkmcnt(" #n ")" ::: "memory")
#define PG8_BAR __builtin_amdgcn_s_barrier()
#define PG8_SCHED __builtin_amdgcn_sched_barrier(0)
    Unit cur, nxt; int ui = 0;
    if (!S.next(0, cur)) return;
    f32x4 acc[2][2][4][2];
#pragma unroll
    for (int a = 0; a < 2; ++a)
#pragma unroll
        for (int b = 0; b < 2; ++b)
#pragma unroll
            for (int m = 0; m < 4; ++m)
#pragma unroll
                for (int n = 0; n < 2; ++n) acc[a][b][m][n] = (f32x4){0.f, 0.f, 0.f, 0.f};
    bf16x8 At[4][2], B0[2][2], B1[2][2];
    const char* cA = (const char*)g.A + (size_t)cur.pm * tstep; const char* cB = (const char*)g.Bt + (size_t)cur.pn * tstep;
    S.a_ready(cur);
    if constexpr (SP2) {
        PG8_STAGE(PG8_SB(0, 0), cB, voffB); PG8_STAGE(PG8_SB(0, 1), cB + hstep, voffB); PG8_STAGE(PG8_SA(0, 0), cA, voffA); PG8_STAGE(PG8_SA(0, 1), cA + hstep, voffA);
        if (wr == 1) PG8_BAR;
        PG8_WAIT_V(2); PG8_BAR;
        PG8_STAGE(PG8_SB(1, 0), cB + kstep, voffB); PG8_STAGE(PG8_SA(1, 0), cA + kstep, voffA); PG8_STAGE(PG8_SB(1, 1), cB + hstep + kstep, voffB);
        PG8_WAIT_V(6); PG8_BAR;
    } else {
        PG8_STAGE(PG8_SB(0, 0), cB, voffB); PG8_STAGE(PG8_SA(0, 0), cA, voffA); PG8_STAGE(PG8_SB(0, 1), cB + hstep, voffB); PG8_STAGE(PG8_SA(0, 1), cA + hstep, voffA);
        if (wr == 1) PG8_BAR;
        PG8_WAIT_V(4); PG8_BAR;
        PG8_STAGE(PG8_SB(1, 0), cB + kstep, voffB); PG8_STAGE(PG8_SA(1, 0), cA + kstep, voffA); PG8_STAGE(PG8_SB(1, 1), cB + hstep + kstep, voffB);
        PG8_WAIT_V(6); PG8_BAR;
    }
    for (;;) {
        const bool has_next = S.next(ui + 1, nxt);
        const char* nA = has_next ? (const char*)g.A + (size_t)nxt.pm * tstep : cA; const char* nB = has_next ? (const char*)g.Bt + (size_t)nxt.pn * tstep : cB;
        for (int t = 0; t < nt; t += 2) {
            const bool last = (t == nt - 2);
            const char* a1 = cA + (size_t)(t + 1) * kstep;
            const char* a2 = last ? nA : cA + (size_t)(t + 2) * kstep; const char* b2 = last ? nB : cB + (size_t)(t + 2) * kstep;
            const char* a3 = a2 + kstep; const char* b3 = b2 + kstep;
            if (last && has_next) S.a_ready(nxt);
            if constexpr (SP2) {
            PG8_LDB(B0, 0, 0); PG8_LDB(B1, 0, 1); PG8_SCHED; PG8_LDA(At, 0, 0); PG8_STAGE(PG8_SA(1, 1), a1 + hstep, voffA);
            PG8_WAIT_V(8); PG8_WAIT_L(0); PG8_BAR; PG8_MMA(0, 0, At, B0); PG8_MMA(0, 1, At, B1); PG8_BAR; PG8_SCHED;
            PG8_LDA(At, 0, 1); PG8_STAGE(PG8_SB(0, 0), b2, voffB); PG8_STAGE(PG8_SB(0, 1), b2 + hstep, voffB); PG8_STAGE(PG8_SA(0, 0), a2, voffA);
            PG8_WAIT_V(8); PG8_WAIT_L(0); PG8_BAR; PG8_MMA(1, 0, At, B0); PG8_MMA(1, 1, At, B1); PG8_BAR; PG8_SCHED;
            PG8_LDB(B0, 1, 0); PG8_LDB(B1, 1, 1); PG8_SCHED; PG8_LDA(At, 1, 0); PG8_STAGE(PG8_SA(0, 1), a2 + hstep, voffA);
            PG8_WAIT_V(8); PG8_WAIT_L(0); PG8_BAR; PG8_MMA(0, 0, At, B0); PG8_MMA(0, 1, At, B1); PG8_BAR; PG8_SCHED;
            PG8_LDA(At, 1, 1); PG8_STAGE(PG8_SB(1, 0), b3, voffB); PG8_STAGE(PG8_SB(1, 1), b3 + hstep, voffB); PG8_STAGE(PG8_SA(1, 0), a3, voffA);
            PG8_WAIT_V(8); PG8_WAIT_L(0); PG8_BAR; PG8_MMA(1, 0, At, B0); PG8_MMA(1, 1, At, B1); PG8_BAR; PG8_SCHED;
            } else {
            PG8_LDB(B0, 0, 0); PG8_SCHED; PG8_LDA(At, 0, 0); PG8_STAGE(PG8_SA(1, 1), a1 + hstep, voffA);
            PG8_WAIT_L(8); PG8_BAR; PG8_WAIT_L(0); PG8_MMA(0, 0, At, B0); PG8_BAR; PG8_SCHED;
            PG8_LDB(B1, 0, 1); PG8_STAGE(PG8_SB(0, 0), b2, voffB);
            PG8_BAR; PG8_WAIT_L(0); PG8_MMA(0, 1, At, B1); PG8_BAR;
            PG8_LDA(At, 0, 1); PG8_STAGE(PG8_SA(0, 0), a2, voffA);
            PG8_BAR; PG8_WAIT_L(0); PG8_MMA(1, 0, At, B0); PG8_BAR; PG8_SCHED;
            PG8_STAGE(PG8_SB(0, 1), b2 + hstep, voffB);
            PG8_WAIT_V(6); PG8_BAR; PG8_MMA(1, 1, At, B1); PG8_BAR;
            PG8_LDB(B0, 1, 0); PG8_SCHED; PG8_LDA(At, 1, 0); PG8_STAGE(PG8_SA(0, 1), a2 + hstep, voffA);
            PG8_WAIT_L(8); PG8_BAR; PG8_WAIT_L(0); PG8_MMA(0, 0, At, B0); PG8_BAR; PG8_SCHED;
            PG8_LDB(B1, 1, 1); PG8_STAGE(PG8_SB(1, 0), b3, voffB);
            PG8_BAR; PG8_WAIT_L(0); PG8_MMA(0, 1, At, B1); PG8_BAR;
            PG8_LDA(At, 1, 1); PG8_STAGE(PG8_SA(1, 0), a3, voffA);
            PG8_BAR; PG8_WAIT_L(0); PG8_MMA(1, 0, At, B0); PG8_BAR; PG8_SCHED;
            PG8_STAGE(PG8_SB(1, 1), b3 + hstep, voffB);
            PG8_WAIT_V(6); PG8_BAR; PG8_MMA(1, 1, At, B1); PG8_BAR;
            }
        }
        if constexpr (ALIGN_EPI) { if (wr == 0) PG8_BAR; }
        if constexpr (!Epi::AFTER_DRAIN) { E(acc, cur, wr, wc, fr, fq); S.done(cur); }
        if (!has_next) break;
#pragma unroll
        for (int a = 0; a < 2; ++a)
#pragma unroll
            for (int b = 0; b < 2; ++b)
#pragma unroll
                for (int m = 0; m < 4; ++m)
#pragma unroll
                    for (int n = 0; n < 2; ++n) acc[a][b][m][n] = (f32x4){0.f, 0.f, 0.f, 0.f};
        cur = nxt; cA = nA; cB = nB; ++ui;
        if constexpr (ALIGN_EPI) { if (wr == 1) PG8_BAR; }
    }
    PG8_WAIT_V(0);
    if constexpr (!ALIGN_EPI) { if (wr == 0) PG8_BAR; }
    PG8_BAR;
    if constexpr (Epi::AFTER_DRAIN) { E.fused(acc, cur, wr, wc, fr, fq, lds, wid, lane); S.done(cur); }
#undef PG8_SA
#undef PG8_SB
#undef PG8_STAGE
#undef PG8_LDA
#undef PG8_LDB
#undef PG8_MMA
#undef PG8_WAIT_V
#undef PG8_WAIT_L
#undef PG8_BAR
#undef PG8_SCHED
}
}

constexpr int D_MODEL = 1024, BATCH = 2, SEQ = 8192, MTOK = BATCH * SEQ, MEM_LEN = 256, MEMROWS = BATCH * MEM_LEN;
constexpr int IN_COLS = 9984, OFF_AQ = 0, OFF_AK = 1536, OFF_AV = 3072, OFF_R = 4608, OFF_CQ = 6400, OFF_GATE = 6912;
constexpr int RW = 512;
constexpr int N_EXPERTS = 32, TOP_K = 4, D_FF = 1024, MOE_ROWS = 256;
constexpr int MAX_BLOCKS = MTOK * TOP_K / MOE_ROWS + N_EXPERTS;
constexpr int MAX_SLOTS = MAX_BLOCKS * MOE_ROWS;
constexpr float NORM_EPS = 1e-6f, R_GN_EPS = 64e-5f;
constexpr float LOG2E = 1.4426950408889634f;
constexpr float QSCALE = 0.08838834764831845f * LOG2E;

namespace pg8 {
__device__ __forceinline__ float bf_lo(unsigned w) { return __builtin_bit_cast(float, w << 16); }
__device__ __forceinline__ float bf_hi(unsigned w) { return __builtin_bit_cast(float, w & 0xffff0000u); }
__device__ __forceinline__ float sigmoidf_fast(float x) { return 1.0f / (1.0f + __expf(-x)); }

struct EpiGate {
    static constexpr bool PERM = true, AFTER_DRAIN = false;
    const bf16_t* Z; const float* bgate; float* merged; bf16_t* mergedb; int br;
    __device__ __forceinline__ void operator()(const f32x4 (&acc)[2][2][4][2], const Unit& u, int wr, int wc, int fr, int fq) const {
        const int row0 = u.pm * BM + wr * 64 + fr, col0 = u.pn * BM + wc * 32 + 8 * fq;
#pragma unroll
        for (int ai = 0; ai < 2; ++ai)
#pragma unroll
            for (int m = 0; m < 4; ++m) { const int row = row0 + ai * HALF + m * 16;
#pragma unroll
                for (int bj = 0; bj < 2; ++bj) { const int col = col0 + bj * HALF;
                    const u32x4 gz = *(const u32x4*)(Z + (size_t)row * IN_COLS + OFF_GATE + br * D_MODEL + col);
                    const f32x4 b0 = *(const f32x4*)(bgate + br * D_MODEL + col), b1 = *(const f32x4*)(bgate + br * D_MODEL + col + 4);
                    f32x4 g0, g1;
                    g0[0] = sigmoidf_fast(bf_lo(gz[0]) + b0[0]); g0[1] = sigmoidf_fast(bf_hi(gz[0]) + b0[1]); g0[2] = sigmoidf_fast(bf_lo(gz[1]) + b0[2]); g0[3] = sigmoidf_fast(bf_hi(gz[1]) + b0[3]);
                    g1[0] = sigmoidf_fast(bf_lo(gz[2]) + b1[0]); g1[1] = sigmoidf_fast(bf_hi(gz[2]) + b1[1]); g1[2] = sigmoidf_fast(bf_lo(gz[3]) + b1[2]); g1[3] = sigmoidf_fast(bf_hi(gz[3]) + b1[3]);
                    f32x4 v0 = acc[ai][bj][m][0] * g0, v1 = acc[ai][bj][m][1] * g1;
                    float* mp = merged + (size_t)row * D_MODEL + col;
                    if (br > 0) { v0 += *(const f32x4*)mp; v1 += *(const f32x4*)(mp + 4); }
                    if (br < 2) { *(f32x4*)mp = v0; *(f32x4*)(mp + 4) = v1; }
                    else { u32x4 w; w.x = cvt_pk_bf16(v0[0], v0[1]); w.y = cvt_pk_bf16(v0[2], v0[3]); w.z = cvt_pk_bf16(v1[0], v1[1]); w.w = cvt_pk_bf16(v1[2], v1[3]);
                        *(u32x4*)(mergedb + (size_t)row * D_MODEL + col) = w; } } }
    }
};
struct EpiResF32 {
    static constexpr bool PERM = true, AFTER_DRAIN = false;
    const float* base; float* out; int ldc;
    __device__ __forceinline__ void operator()(const f32x4 (&acc)[2][2][4][2], const Unit& u, int wr, int wc, int fr, int fq) const {
        const int row0 = u.pm * BM + wr * 64 + fr, col0 = u.pn * BM + wc * 32 + 8 * fq;
#pragma unroll
        for (int ai = 0; ai < 2; ++ai)
#pragma unroll
            for (int m = 0; m < 4; ++m) { const size_t off = (size_t)(row0 + ai * HALF + m * 16) * ldc + col0;
#pragma unroll
                for (int bj = 0; bj < 2; ++bj) { const float* bp = base + off + bj * HALF; float* op = out + off + bj * HALF;
                    const f32x4 x0 = *(const f32x4*)bp, x1 = *(const f32x4*)(bp + 4);
                    *(f32x4*)op = x0 + acc[ai][bj][m][0]; *(f32x4*)(op + 4) = x1 + acc[ai][bj][m][1]; } }
    }
};
struct EpiSwiGLU {
    static constexpr bool PERM = true, AFTER_DRAIN = false;
    const float* b1; bf16_t* H;
    __device__ __forceinline__ void operator()(const f32x4 (&acc)[2][2][4][2], const Unit& u, int wr, int wc, int fr, int fq) const {
        const int e = u.pn >> 3, pnl = u.pn & 7;
        const int row0 = u.pm * BM + wr * 64 + fr, ac = pnl * HALF + wc * 32 + 8 * fq;
        const float* bg = b1 + (size_t)e * 2 * D_FF + ac; const float* bl = bg + D_FF;
        const f32x4 bg0 = *(const f32x4*)bg, bg1 = *(const f32x4*)(bg + 4), bl0 = *(const f32x4*)bl, bl1 = *(const f32x4*)(bl + 4);
#pragma unroll
        for (int ai = 0; ai < 2; ++ai)
#pragma unroll
            for (int m = 0; m < 4; ++m) { const int row = row0 + ai * HALF + m * 16;
                float a[8];
#pragma unroll
                for (int n = 0; n < 2; ++n) { const f32x4 ug = acc[ai][0][m][n] + (n ? bg1 : bg0), ul = acc[ai][1][m][n] + (n ? bl1 : bl0);
#pragma unroll
                    for (int j = 0; j < 4; ++j) { const float g = fminf(ug[j], 7.0f), l = fminf(fmaxf(ul[j], -7.0f), 7.0f);
                        a[4 * n + j] = g * sigmoidf_fast(1.702f * g) * (l + 1.0f); } }
                u32x4 w; w.x = cvt_pk_bf16(a[0], a[1]); w.y = cvt_pk_bf16(a[2], a[3]); w.z = cvt_pk_bf16(a[4], a[5]); w.w = cvt_pk_bf16(a[6], a[7]);
                *(u32x4*)(H + (size_t)row * D_FF + ac) = w; }
    }
};
struct EpiMoeOut {
    static constexpr bool PERM = true, AFTER_DRAIN = false;
    const float* b2; const float* rowgate; bf16_t* Y;
    __device__ __forceinline__ void operator()(const f32x4 (&acc)[2][2][4][2], const Unit& u, int wr, int wc, int fr, int fq) const {
        const int e = u.pn >> 2, pnl = u.pn & 3;
        const int row0 = u.pm * BM + wr * 64 + fr, col0 = pnl * BM + wc * 32 + 8 * fq;
#pragma unroll
        for (int ai = 0; ai < 2; ++ai)
#pragma unroll
            for (int m = 0; m < 4; ++m) { const int row = row0 + ai * HALF + m * 16; const float gt = rowgate[row];
#pragma unroll
                for (int bj = 0; bj < 2; ++bj) { const int col = col0 + bj * HALF; const float* bp = b2 + (size_t)e * D_MODEL + col;
                    const f32x4 v0 = (acc[ai][bj][m][0] + *(const f32x4*)bp) * gt, v1 = (acc[ai][bj][m][1] + *(const f32x4*)(bp + 4)) * gt;
                    u32x4 w; w.x = cvt_pk_bf16(v0[0], v0[1]); w.y = cvt_pk_bf16(v0[2], v0[3]); w.z = cvt_pk_bf16(v1[0], v1[1]); w.w = cvt_pk_bf16(v1[2], v1[3]);
                    *(u32x4*)(Y + (size_t)row * D_MODEL + col) = w; } }
    }
};
struct MoeOrder {
    const PG8_LAS int* tab;
    int NT, G, c;
    __device__ __forceinline__ bool next(int i, Unit& u) const {
        const int nblk = tab[0]; const long L = (long)i * G + c; if (L >= (long)nblk * NT) return false;
        const int blk = (int)(L / NT), pnl = (int)(L % NT); u.pm = blk; u.pn = tab[1 + blk] * NT + pnl; return true;
    }
    __device__ __forceinline__ void a_ready(const Unit&) const {}
    __device__ __forceinline__ void done(const Unit&) const {}
};
}

constexpr int NWAVES = 8;
#ifndef MK_N_LAUNCHES
#define MK_N_LAUNCHES 1
#endif
constexpr int N_PHASES = 13;

constexpr size_t MiB = 1u << 20;
constexpr size_t WS_CTL = 0, CTL_ZERO_BYTES = 1 * MiB;
constexpr size_t WS_WIN = 2 * MiB;
constexpr size_t WS_WB = 22 * MiB;
constexpr size_t WS_WO = 25 * MiB;
constexpr size_t WS_WMEM = 27 * MiB;
constexpr size_t WS_W1 = 29 * MiB;
constexpr size_t WS_W2 = 157 * MiB;
constexpr size_t WS_XN = 221 * MiB;
constexpr size_t WS_Z = 256 * MiB;
constexpr size_t WS_RW = 568 * MiB;
constexpr size_t WS_YS = 792 * MiB;
constexpr size_t WS_YABC = 824 * MiB;
constexpr size_t WS_MRG = 872 * MiB;
constexpr size_t WS_MRGB = 936 * MiB;
constexpr size_t WS_MEMN = 968 * MiB;
constexpr size_t WS_KVM = 969 * MiB;
constexpr size_t WS_XN2 = 970 * MiB;
constexpr size_t WS_ROUTE = 1002 * MiB;
constexpr size_t WS_END = 1004 * MiB;
constexpr size_t WS_XS = 256 * MiB;
constexpr size_t WS_HACT = 400 * MiB;
constexpr size_t WS_YROWS = 544 * MiB;
constexpr size_t RWSZ = (size_t)MTOK * RW * 4;
constexpr size_t RT_TOPI = 0, RT_TOPG = 256 * 1024, RT_POS = 512 * 1024, RT_ROWGATE = 768 * 1024;
static_assert(RT_ROWGATE + (size_t)MAX_SLOTS * 4 <= 1088 * 1024, "route");
constexpr int CW_TMO = 0, CW_CODE = 1;
constexpr int CW_BAR = 4096;
constexpr int CW_CNT = 16384;
constexpr int CW_CUR = 16384 + 64;

constexpr int RING_OFF = 0, RING_BYTES = 131072;
constexpr int LDSCTL_OFF = RING_BYTES, MISC_OFF = LDSCTL_OFF + 320;
constexpr int MOETAB_OFF = MISC_OFF + 128;
constexpr int LDS_BYTES = 147456;
static_assert(MOETAB_OFF + 4 * (1 + MAX_BLOCKS + 64) <= LDS_BYTES, "LDS map");
#define GAS __attribute__((address_space(1)))
#define LAS __attribute__((address_space(3)))
typedef unsigned short bf16;
typedef unsigned v4u __attribute__((ext_vector_type(4)));
typedef float f32x4 __attribute__((ext_vector_type(4)));
typedef short bf16x8 __attribute__((ext_vector_type(8)));
typedef GAS unsigned gu32;
typedef GAS unsigned long long gu64;
#define RLX_AGENT __ATOMIC_RELAXED, __HIP_MEMORY_SCOPE_AGENT
#define LDS_WAIT() asm volatile("s_waitcnt lgkmcnt(0)" ::: "memory")
#define VM_WAIT() asm volatile("s_waitcnt vmcnt(0)" ::: "memory")
__device__ __forceinline__ unsigned long long rt() { return __builtin_amdgcn_s_memrealtime(); }
__device__ __forceinline__ unsigned f2bf(float f) { unsigned u = __builtin_bit_cast(unsigned, f); return (u + 0x7fffu + ((u >> 16) & 1u)) >> 16; }
__device__ __forceinline__ unsigned pk2(float lo, float hi) { return f2bf(lo) | (f2bf(hi) << 16); }
#define XB_TMO      128
#define XB_XCNT(j)  (256  + 64 * (j))
#define XB_XSUB(j)  (1280 + 64 * (j))
#define XB_XGEN(j)  (2304 + 64 * (j))
#define XB_TOP      3328
#define XB_TOPGEN   3392
#define XCD_BAR_WORDS 3456
#define XB_SPIN_CAP (1u << 18)

__device__ __forceinline__ unsigned xb_ld(unsigned* p)              { return __hip_atomic_load(p, __ATOMIC_RELAXED, __HIP_MEMORY_SCOPE_AGENT); }
__device__ __forceinline__ unsigned xb_add(unsigned* p, unsigned v) { return __hip_atomic_fetch_add(p, v, __ATOMIC_RELAXED, __HIP_MEMORY_SCOPE_AGENT); }
__device__ __forceinline__ unsigned xb_xcc_id() { return (unsigned)__builtin_amdgcn_s_getreg((3 << 11) | 20) & 0xFu; }
#define XB_SPIN(cond, bar) do { unsigned _sp = 0; while (cond) { __builtin_amdgcn_s_sleep(1); \
    if ((++_sp & 255u) == 0u) { if (xb_ld(&(bar)[XB_TMO])) break; if (_sp > XB_SPIN_CAP) { atomicAdd(&(bar)[XB_TMO], 1u); break; } } } } while (0)

struct XcdBarrier {
    unsigned* bar; unsigned x;
    volatile LAS unsigned* st;
};

__device__ __forceinline__ XcdBarrier xcd_barrier_post(unsigned* bar, volatile LAS unsigned* st) {
    XcdBarrier b; b.bar = bar; b.x = xb_xcc_id(); b.st = st;
    if (threadIdx.x == 0) (void)xb_add(&bar[XB_XCNT(b.x)], 1u);
    return b;
}
__device__ __forceinline__ void xcd_barrier_complete(unsigned* bar, unsigned x, unsigned& nloc, unsigned& nx) {
    const unsigned G = gridDim.x * gridDim.y * gridDim.z;
    unsigned sum, cnt, mine, sp = 0u;
    for (;;) {
        sum = 0u; cnt = 0u; mine = 0u;
#pragma unroll
        for (unsigned j = 0; j < 16; ++j) { const unsigned c = xb_ld(&bar[XB_XCNT(j)]); sum += c; cnt += (c > 0u) ? 1u : 0u; mine = (j == x) ? c : mine; }
        if (sum == G) break;
        __builtin_amdgcn_s_sleep(1);
        if ((++sp & 255u) == 0u) { if (xb_ld(&bar[XB_TMO])) break; if (sp > XB_SPIN_CAP) { atomicAdd(&bar[XB_TMO], 1u); break; } }
    }
    nloc = mine > 0u ? mine : 1u; nx = cnt > 0u ? cnt : 1u;
}

__device__ __forceinline__ void xcd_barrier(const XcdBarrier& b) {
    asm volatile("s_waitcnt vmcnt(0)" ::: "memory");
    __syncthreads();
    if (threadIdx.x == 0) {
        unsigned* bar = b.bar;
        __builtin_amdgcn_s_waitcnt(0);
        unsigned nloc = b.st[0], nx = b.st[1];
        if (nloc == 0u) { xcd_barrier_complete(bar, b.x, nloc, nx); b.st[0] = nloc; b.st[1] = nx; }
        const unsigned old = xb_add(&bar[XB_XSUB(b.x)], 1u);
        const unsigned gen = old / nloc;
        if (old + 1u == (gen + 1u) * nloc) {
            __builtin_amdgcn_fence(__ATOMIC_RELEASE, "agent");
            asm volatile("s_waitcnt vmcnt(0)" ::: "memory");
            const unsigned og = xb_add(&bar[XB_TOP], 1u);
            const unsigned tg = og / nx;
            if (og + 1u == (tg + 1u) * nx) xb_add(&bar[XB_TOPGEN], 1u);
            else XB_SPIN(xb_ld(&bar[XB_TOPGEN]) == tg, bar);
            __builtin_amdgcn_fence(__ATOMIC_ACQUIRE, "agent");
            xb_add(&bar[XB_XGEN(b.x)], 1u);
            asm volatile("s_waitcnt vmcnt(0)" ::: "memory");
        } else {
            XB_SPIN(xb_ld(&bar[XB_XGEN(b.x)]) == gen, bar);
            __builtin_amdgcn_fence(__ATOMIC_ACQUIRE, "agent");
            asm volatile("s_waitcnt vmcnt(0)" ::: "memory");
        }
    }
    __syncthreads();
}

typedef float f32x2 __attribute__((ext_vector_type(2)));
struct Frame {
    LAS unsigned char* lds;
    volatile LAS unsigned* MISC;
    gu32* ctl;
    int tid, lane, wave;
    int vcu, G;
    const float* in[32];
    float* out;
    unsigned char* ws;
};
enum { I_X = 0, I_MEM, I_POS, I_NORM_MIX, I_W_IN, I_B_GATE, I_AQ_GAIN, I_AK_GAIN, I_R_MU, I_R_W0, I_R_W2, I_R_A0, I_R_A2, I_R_G2, I_R_KK, I_R_KA, I_R_RK, I_R_LNW, I_R_LNB,
       I_MEM_NORM, I_W_MEMKV, I_CQ_GAIN, I_CK_GAIN, I_W_BRANCH, I_W_OUT, I_NORM_FFN, I_ROUTER_W, I_ROUTER_B, I_EXP_W1, I_EXP_B1, I_EXP_W2, I_EXP_B2 };

__device__ __forceinline__ float bf_lo(unsigned w) { return __builtin_bit_cast(float, w << 16); }
__device__ __forceinline__ float bf_hi(unsigned w) { return __builtin_bit_cast(float, w & 0xffff0000u); }
__device__ __forceinline__ float sigm(float x) { return 1.0f / (1.0f + __expf(-x)); }
template <int CTRL, int RM> __device__ __forceinline__ float dpp0(float v) {
    return __builtin_bit_cast(float, __builtin_amdgcn_update_dpp(0, __builtin_bit_cast(int, v), CTRL, RM, 0xf, true)); }
__device__ __forceinline__ float row16_sum(float v) {
    v += dpp0<0xB1, 0xf>(v); v += dpp0<0x4E, 0xf>(v); v += dpp0<0x141, 0xf>(v); v += dpp0<0x140, 0xf>(v); return v; }
__device__ __forceinline__ float rdlane(float v, int l) { return __builtin_bit_cast(float, __builtin_amdgcn_readlane(__builtin_bit_cast(int, v), l)); }
__device__ __forceinline__ float wave_sum(float v) {
    v = row16_sum(v); v += dpp0<0x142, 0xA>(v); v += dpp0<0x143, 0xC>(v); return rdlane(v, 63); }
__device__ __forceinline__ void half_sums(float v, float& lo, float& hi) {
    v = row16_sum(v); v += dpp0<0x142, 0xA>(v); lo = rdlane(v, 31); hi = rdlane(v, 63); }
__device__ __forceinline__ float wave_max_bp(float v) {
#pragma unroll
    for (int o = 1; o < 64; o <<= 1) v = fmaxf(v, __shfl_xor(v, o));
    return v; }

__device__ __forceinline__ void tconv_tile(const float* W, int K, int N, bf16* WT, int k0, int n0, int rowbase, int lane) {
    const int c = lane & 15, q = lane >> 4;
    const GAS f32x4* src = (const GAS f32x4*)(W + (size_t)(k0 + 16 * q) * N + n0 + 4 * c);
    const size_t rs = (size_t)N / 4;
    f32x4 v[16];
#pragma unroll
    for (int i = 0; i < 16; ++i) v[i] = src[i * rs];
#pragma unroll
    for (int j = 0; j < 4; ++j) {
        GAS v4u* dst = (GAS v4u*)(WT + (size_t)(rowbase + 4 * c + j) * K + k0 + 16 * q);
        v4u o0, o1;
        o0.x = pk2(v[0][j], v[1][j]); o0.y = pk2(v[2][j], v[3][j]); o0.z = pk2(v[4][j], v[5][j]); o0.w = pk2(v[6][j], v[7][j]);
        o1.x = pk2(v[8][j], v[9][j]); o1.y = pk2(v[10][j], v[11][j]); o1.z = pk2(v[12][j], v[13][j]); o1.w = pk2(v[14][j], v[15][j]);
        dst[0] = o0; dst[1] = o1;
    }
}
__device__ __forceinline__ void rms_row_to_bf16(const float* xrow, const float* gain, bf16* orow, int lane) {
    const GAS f32x4* xr = (const GAS f32x4*)xrow + lane; const GAS f32x4* gr = (const GAS f32x4*)gain + lane;
    f32x4 v[4]; float s = 0.f;
#pragma unroll
    for (int j = 0; j < 4; ++j) { v[j] = xr[64 * j]; s += (v[j].x * v[j].x + v[j].y * v[j].y) + (v[j].z * v[j].z + v[j].w * v[j].w); }
    const float rstd = 1.0f / sqrtf(wave_sum(s) * (1.f / D_MODEL) + NORM_EPS);
    GAS unsigned long long* o8 = (GAS unsigned long long*)orow + lane;
#pragma unroll
    for (int j = 0; j < 4; ++j) { const f32x4 g = gr[64 * j];
        o8[64 * j] = (unsigned long long)pk2(v[j].x * rstd * g.x, v[j].y * rstd * g.y) | ((unsigned long long)pk2(v[j].z * rstd * g.z, v[j].w * rstd * g.w) << 32); }
}
__device__ __forceinline__ void p0_prologue(Frame& F) {
    const int gw = F.vcu * NWAVES + F.wave, NGW = F.G * NWAVES, lane = F.lane;
    unsigned char* ws = F.ws;
    constexpr int T_IN = 16 * 156, T_WB = 3 * 128, T_WO = 256, T_WM = 256, T_W1 = 32 * 512, T_W2 = 32 * 256;
    constexpr int NT = T_IN + T_WB + T_WO + T_WM + T_W1 + T_W2;
    for (int it = gw; it < NT; it += NGW) {
        int r = it;
        if (r < T_IN) { const int kb = r / 156, nb = r % 156; tconv_tile(F.in[I_W_IN], 1024, IN_COLS, (bf16*)(ws + WS_WIN), 64 * kb, 64 * nb, 64 * nb, lane); continue; } r -= T_IN;
        if (r < T_WB) { const int b = r / 128, q = r % 128, kb = q / 16, nb = q % 16;
            tconv_tile(F.in[I_W_BRANCH] + (size_t)b * 512 * 1024, 512, 1024, (bf16*)(ws + WS_WB) + (size_t)b * 1024 * 512, 64 * kb, 64 * nb, 64 * nb, lane); continue; } r -= T_WB;
        if (r < T_WO) { const int kb = r / 16, nb = r % 16; tconv_tile(F.in[I_W_OUT], 1024, 1024, (bf16*)(ws + WS_WO), 64 * kb, 64 * nb, 64 * nb, lane); continue; } r -= T_WO;
        if (r < T_WM) { const int kb = r / 16, nb = r % 16; tconv_tile(F.in[I_W_MEMKV], 1024, 1024, (bf16*)(ws + WS_WMEM), 64 * kb, 64 * nb, 64 * nb, lane); continue; } r -= T_WM;
        if (r < T_W1) { const int e = r / 512, q = r % 512, kb = q / 32, nb = q % 32, n0 = 64 * nb;
            const int rowbase = (n0 < 1024) ? ((n0 >> 7) * 256 + (n0 & 127)) : ((((n0 - 1024) >> 7) * 256) + 128 + ((n0 - 1024) & 127));
            tconv_tile(F.in[I_EXP_W1] + (size_t)e * 1024 * 2048, 1024, 2048, (bf16*)(ws + WS_W1) + (size_t)e * 2048 * 1024, 64 * kb, n0, rowbase, lane); continue; } r -= T_W1;
        { const int e = r / 256, q = r % 256, kb = q / 16, nb = q % 16;
            tconv_tile(F.in[I_EXP_W2] + (size_t)e * 1024 * 1024, 1024, 1024, (bf16*)(ws + WS_W2) + (size_t)e * 1024 * 1024, 64 * kb, 64 * nb, 64 * nb, lane); }
    }
    for (int m = gw; m < MTOK; m += NGW) rms_row_to_bf16(F.in[I_X] + (size_t)m * D_MODEL, F.in[I_NORM_MIX], (bf16*)(ws + WS_XN) + (size_t)m * D_MODEL, lane);
    for (int m = gw; m < MEMROWS; m += NGW) rms_row_to_bf16(F.in[I_MEM] + (size_t)m * D_MODEL, F.in[I_MEM_NORM], (bf16*)(ws + WS_MEMN) + (size_t)m * D_MODEL, lane);
}

__device__ __forceinline__ void head_norm(bf16* p, const float* gain, bool rot, float c0, float s0, float c1, float s1, float scale, int lane) {
    GAS unsigned* pw = (GAS unsigned*)p + lane;
    const unsigned w = *pw; float a = bf_lo(w), b = bf_hi(w);
    const float ss = wave_sum(a * a + b * b);
    const float rstd = 1.0f / sqrtf(ss * (1.f / 128.f) + NORM_EPS);
    const f32x2 g = *((const GAS f32x2*)gain + lane);
    a = a * rstd * g.x; b = b * rstd * g.y;
    const float pa = __shfl_xor(a, 8), pb = __shfl_xor(b, 8);
    if (rot && lane < 16) {
        if (lane < 8) { a = a * c0 - pa * s0; b = b * c1 - pb * s1; }
        else          { a = a * c0 + pa * s0; b = b * c1 + pb * s1; }
    }
    *pw = pk2(a * scale, b * scale);
}
__device__ __forceinline__ void p2_prep(Frame& F) {
    const int gw = F.vcu * NWAVES + F.wave, NGW = F.G * NWAVES, lane = F.lane;
    unsigned char* ws = F.ws;
    bf16* Z = (bf16*)(ws + WS_Z);
    LAS float* lo = (LAS float*)(F.lds + RING_OFF + F.wave * 8192);
    const float* mu = F.in[I_R_MU];
    float* Rr = (float*)(ws + WS_RW); float* Rw = Rr + (size_t)MTOK * RW; float* Rk = Rw + (size_t)MTOK * RW; float* Rv = Rk + (size_t)MTOK * RW;
    float* Ra = Rv + (size_t)MTOK * RW; float* Rb = Ra + (size_t)MTOK * RW; float* Rg = Rb + (size_t)MTOK * RW;
    for (int task = gw; task < MTOK / 4; task += NGW) {
        const int m0 = task * 4, tpos0 = m0 % SEQ, bb = m0 / SEQ;
        for (int tt = 0; tt < 4; ++tt) {
            const int m = m0 + tt;
            const float pos = (float)((const int*)F.in[I_POS])[m];
            const int i0 = 2 * (lane & 7);
            const float f0 = exp2f(-(float)i0 * (18.931568569324174f / 16.0f)), f1 = exp2f(-(float)(i0 + 1) * (18.931568569324174f / 16.0f));
            float s0, c0, s1, c1; sincosf(pos * f0, &s0, &c0); sincosf(pos * f1, &s1, &c1);
            bf16* zr = Z + (size_t)m * IN_COLS;
            for (int hd = 0; hd < 12; ++hd) head_norm(zr + OFF_AQ + hd * 128, F.in[I_AQ_GAIN], true, c0, s0, c1, s1, QSCALE, lane);
            for (int hd = 0; hd < 12; ++hd) head_norm(zr + OFF_AK + hd * 128, F.in[I_AK_GAIN], true, c0, s0, c1, s1, 1.0f, lane);
            for (int hd = 0; hd < 4; ++hd)  head_norm(zr + OFF_CQ + hd * 128, F.in[I_CQ_GAIN], false, c0, s0, c1, s1, QSCALE, lane);
        }
#pragma unroll
        for (int i = 0; i < 4; ++i) { const int j = lane + 64 * i; const int col = OFF_R + 1536 + j; const float muj = mu[1536 + j];
            float prv = (tpos0 == 0) ? 0.f : __builtin_bit_cast(float, (unsigned)Z[(size_t)(m0 - 1) * IN_COLS + col] << 16);
#pragma unroll
            for (int tt = 0; tt < 4; ++tt) { const float cur = __builtin_bit_cast(float, (unsigned)Z[(size_t)(m0 + tt) * IN_COLS + col] << 16);
                float x = cur + (prv - cur) * muj; prv = cur;
                x = (i == 0) ? tanhf(x) : (i == 1) ? x : sigm(x);
                lo[j * 4 + tt] = x; } }
        LDS_WAIT(); asm volatile("" ::: "memory");
        float accw[4][8], acca[4][8], accg[4][8];
#pragma unroll
        for (int tt = 0; tt < 4; ++tt)
#pragma unroll
            for (int c = 0; c < 8; ++c) { accw[tt][c] = 0.f; acca[tt][c] = 0.f; accg[tt][c] = 0.f; }
        { const float* W2 = F.in[I_R_W2];
          for (int j = 0; j < 64; ++j) { const f32x4 xin = *(const LAS f32x4*)(lo + j * 4);
#pragma unroll
              for (int i = 0; i < 4; ++i) { const f32x2 wv = *(const GAS f32x2*)(W2 + (size_t)j * RW + 2 * lane + 128 * i);
#pragma unroll
                  for (int tt = 0; tt < 4; ++tt) { accw[tt][2 * i] += xin[tt] * wv.x; accw[tt][2 * i + 1] += xin[tt] * wv.y; } } } }
        { const float* A2 = F.in[I_R_A2];
          for (int j = 0; j < 64; ++j) { const f32x4 xin = *(const LAS f32x4*)(lo + (64 + j) * 4);
#pragma unroll
              for (int i = 0; i < 4; ++i) { const f32x2 wv = *(const GAS f32x2*)(A2 + (size_t)j * RW + 2 * lane + 128 * i);
#pragma unroll
                  for (int tt = 0; tt < 4; ++tt) { acca[tt][2 * i] += xin[tt] * wv.x; acca[tt][2 * i + 1] += xin[tt] * wv.y; } } } }
        { const float* G2 = F.in[I_R_G2];
          for (int j = 0; j < 128; ++j) { const f32x4 xin = *(const LAS f32x4*)(lo + (128 + j) * 4);
#pragma unroll
              for (int i = 0; i < 4; ++i) { const f32x2 wv = *(const GAS f32x2*)(G2 + (size_t)j * RW + 2 * lane + 128 * i);
#pragma unroll
                  for (int tt = 0; tt < 4; ++tt) { accg[tt][2 * i] += xin[tt] * wv.x; accg[tt][2 * i + 1] += xin[tt] * wv.y; } } } }
        asm volatile("" ::: "memory");
#pragma unroll
        for (int i = 0; i < 4; ++i) {
            const int c = 2 * lane + 128 * i;
            const f32x2 w0 = *(const GAS f32x2*)(F.in[I_R_W0] + c), a0 = *(const GAS f32x2*)(F.in[I_R_A0] + c), kkc = *(const GAS f32x2*)(F.in[I_R_KK] + c), kac = *(const GAS f32x2*)(F.in[I_R_KA] + c);
            const f32x2 mur = *(const GAS f32x2*)(mu + c), muk = *(const GAS f32x2*)(mu + 512 + c), muv = *(const GAS f32x2*)(mu + 1024 + c);
            unsigned pr = 0u, pk = 0u, pv = 0u;
            if (tpos0 != 0) { const bf16* zp = Z + (size_t)(m0 - 1) * IN_COLS + OFF_R + c; pr = *(const GAS unsigned*)zp; pk = *(const GAS unsigned*)(zp + 512); pv = *(const GAS unsigned*)(zp + 1024); }
#pragma unroll
            for (int tt = 0; tt < 4; ++tt) {
                const size_t m = (size_t)(m0 + tt);
                const bf16* zc = Z + m * IN_COLS + OFF_R + c;
                const unsigned cr = *(const GAS unsigned*)zc, ck = *(const GAS unsigned*)(zc + 512), cv = *(const GAS unsigned*)(zc + 1024);
                f32x2 r, k, v;
                r.x = bf_lo(cr) + (bf_lo(pr) - bf_lo(cr)) * mur.x; r.y = bf_hi(cr) + (bf_hi(pr) - bf_hi(cr)) * mur.y;
                k.x = bf_lo(ck) + (bf_lo(pk) - bf_lo(ck)) * muk.x; k.y = bf_hi(ck) + (bf_hi(pk) - bf_hi(ck)) * muk.y;
                v.x = bf_lo(cv) + (bf_lo(pv) - bf_lo(cv)) * muv.x; v.y = bf_hi(cv) + (bf_hi(pv) - bf_hi(cv)) * muv.y;
                pr = cr; pk = ck; pv = cv;
                f32x2 wd, av;
                { float x0 = w0.x + accw[tt][2 * i], x1 = w0.y + accw[tt][2 * i + 1];
                  float y0 = -x0, y1 = -x1;
                  float sp0 = fmaxf(y0, 0.f) + log1pf(__expf(-fabsf(y0))), sp1 = fmaxf(y1, 0.f) + log1pf(__expf(-fabsf(y1)));
                  wd.x = __expf(-__expf(-sp0 - 0.5f)); wd.y = __expf(-__expf(-sp1 - 0.5f)); }
                av.x = sigm(a0.x + acca[tt][2 * i]); av.y = sigm(a0.y + acca[tt][2 * i + 1]);
                f32x2 kk; kk.x = k.x * kkc.x; kk.y = k.y * kkc.y;
                float slo, shi; half_sums(kk.x * kk.x + kk.y * kk.y, slo, shi);
                const float nrm = fmaxf(sqrtf(lane < 32 ? slo : shi), 1e-12f), inv = 1.0f / nrm;
                kk.x *= inv; kk.y *= inv;
                f32x2 k2; k2.x = k.x * (1.0f + (av.x - 1.0f) * kac.x); k2.y = k.y * (1.0f + (av.y - 1.0f) * kac.y);
                f32x2 as, bs; as.x = -kk.x; as.y = -kk.y; bs.x = kk.x * av.x; bs.y = kk.y * av.y;
                f32x2 gg; gg.x = accg[tt][2 * i]; gg.y = accg[tt][2 * i + 1];
                const size_t o = m * RW + c;
                *(GAS f32x2*)(Rr + o) = r; *(GAS f32x2*)(Rw + o) = wd; *(GAS f32x2*)(Rk + o) = k2; *(GAS f32x2*)(Rv + o) = v;
                *(GAS f32x2*)(Ra + o) = as; *(GAS f32x2*)(Rb + o) = bs; *(GAS f32x2*)(Rg + o) = gg;
            }
        }
        LDS_WAIT(); asm volatile("" ::: "memory");
    }
    for (int m = gw; m < MEMROWS; m += NGW)
        for (int hd = 0; hd < 4; ++hd) head_norm((bf16*)(ws + WS_KVM) + (size_t)m * 1024 + hd * 128, F.in[I_CK_GAIN], false, 1.f, 0.f, 1.f, 0.f, 1.0f, lane);
}

__device__ __forceinline__ float qk_dot(const LAS float* q, const bf16* krow) {
    const GAS v4u* kp = (const GAS v4u*)krow; float s0 = 0.f, s1 = 0.f;
#pragma unroll
    for (int i = 0; i < 16; ++i) { const v4u w = kp[i]; const f32x4 qa = *(const LAS f32x4*)(q + 8 * i), qb = *(const LAS f32x4*)(q + 8 * i + 4);
        s0 += bf_lo(w.x) * qa[0] + bf_hi(w.x) * qa[1] + bf_lo(w.y) * qa[2] + bf_hi(w.y) * qa[3];
        s1 += bf_lo(w.z) * qb[0] + bf_hi(w.z) * qb[1] + bf_lo(w.w) * qb[2] + bf_hi(w.w) * qb[3]; }
    return s0 + s1;
}
__device__ __forceinline__ void p3_attention(Frame& F) {
    const int gw = F.vcu * NWAVES + F.wave, NGW = F.G * NWAVES, lane = F.lane;
    unsigned char* ws = F.ws;
    const bf16* Z = (const bf16*)(ws + WS_Z);
    const bf16* KV = (const bf16*)(ws + WS_KVM);
    bf16* YA = (bf16*)(ws + WS_YABC); bf16* YC = YA + (size_t)2 * MTOK * 512;
    LAS float* qs = (LAS float*)(F.lds + RING_OFF + F.wave * 8192);
    for (int task = gw; task < MTOK * 4; task += NGW) {
        const int m = task >> 2, h = task & 3, t = m % SEQ;
        const bf16* zrow = Z + (size_t)m * IN_COLS;
#pragma unroll
        for (int g = 0; g < 3; ++g) { const unsigned w = *((const GAS unsigned*)(zrow + OFF_AQ + g * 512 + h * 128) + lane); qs[g * 128 + 2 * lane] = bf_lo(w); qs[g * 128 + 2 * lane + 1] = bf_hi(w); }
        LDS_WAIT(); asm volatile("" ::: "memory");
        float sc[3][3]; float mx = -INFINITY;
#pragma unroll
        for (int g = 0; g < 3; ++g) { const int dl = (g == 0) ? 1 : (g == 1) ? 4 : 16;
#pragma unroll
            for (int p = 0; p < 3; ++p) { const int j = lane + 64 * p; const int tk = t - dl * j; float s = -INFINITY;
                if (j <= 128 && tk >= 0) s = qk_dot(qs + g * 128, zrow - (size_t)dl * j * IN_COLS + OFF_AK + g * 512 + h * 128);
                sc[g][p] = s; mx = fmaxf(mx, s); } }
        mx = wave_max_bp(mx);
        float den = 0.f;
#pragma unroll
        for (int g = 0; g < 3; ++g)
#pragma unroll
            for (int p = 0; p < 3; ++p) { sc[g][p] = exp2f(sc[g][p] - mx); den += sc[g][p]; }
        den = wave_sum(den);
        float o0 = 0.f, o1 = 0.f;
#pragma unroll
        for (int g = 0; g < 3; ++g) { const int dl = (g == 0) ? 1 : (g == 1) ? 4 : 16; const bf16* vb = zrow + OFF_AV + g * 512 + h * 128 + 2 * lane;
#pragma unroll
            for (int p = 0; p < 3; ++p) { const int nj = (p < 2) ? 64 : 1;
                for (int jj = 0; jj < nj; ++jj) { const int j = jj + 64 * p; const float pj = rdlane(sc[g][p], jj);
                    if (t - dl * j >= 0) { const unsigned w = *(const GAS unsigned*)(vb - (size_t)dl * j * IN_COLS); o0 += pj * bf_lo(w); o1 += pj * bf_hi(w); } } } }
        const float inv = 1.0f / den;
        *((GAS unsigned*)(YA + (size_t)m * 512 + h * 128) + lane) = pk2(o0 * inv, o1 * inv);
        asm volatile("" ::: "memory");
    }
    for (int task = gw; task < MTOK * 4; task += NGW) {
        const int m = task >> 2, h = task & 3, b = m / SEQ;
        const bf16* zrow = Z + (size_t)m * IN_COLS;
        { const unsigned w = *((const GAS unsigned*)(zrow + OFF_CQ + h * 128) + lane); qs[2 * lane] = bf_lo(w); qs[2 * lane + 1] = bf_hi(w); }
        LDS_WAIT(); asm volatile("" ::: "memory");
        const bf16* kb = KV + (size_t)b * MEM_LEN * 1024 + h * 128;
        float sc[4]; float mx = -INFINITY;
#pragma unroll
        for (int p = 0; p < 4; ++p) { sc[p] = qk_dot(qs, kb + (size_t)(lane + 64 * p) * 1024); mx = fmaxf(mx, sc[p]); }
        mx = wave_max_bp(mx);
        float den = 0.f;
#pragma unroll
        for (int p = 0; p < 4; ++p) { sc[p] = exp2f(sc[p] - mx); den += sc[p]; }
        den = wave_sum(den);
        float o0 = 0.f, o1 = 0.f; const bf16* vb = kb + 512 + 2 * lane;
#pragma unroll
        for (int p = 0; p < 4; ++p)
            for (int jj = 0; jj < 64; ++jj) { const float pj = rdlane(sc[p], jj); const unsigned w = *(const GAS unsigned*)(vb + (size_t)(jj + 64 * p) * 1024); o0 += pj * bf_lo(w); o1 += pj * bf_hi(w); }
        const float inv = 1.0f / den;
        *((GAS unsigned*)(YC + (size_t)m * 512 + h * 128) + lane) = pk2(o0 * inv, o1 * inv);
        asm volatile("" ::: "memory");
    }
}

struct ScanBuf { float r[4], w[4], k[4], a[4], b[4], v[4]; };
__device__ __forceinline__ void scan_load(ScanBuf& B, const float* Rr, const float* Rw, const float* Rk, const float* Rv, const float* Ra, const float* Rb, size_t o, size_t ov) {
#pragma unroll
    for (int i = 0; i < 4; ++i) { const size_t oi = o + (size_t)i * RW;
        B.r[i] = *(const GAS float*)(Rr + oi); B.w[i] = *(const GAS float*)(Rw + oi); B.k[i] = *(const GAS float*)(Rk + oi); B.a[i] = *(const GAS float*)(Ra + oi); B.b[i] = *(const GAS float*)(Rb + oi);
        B.v[i] = *(const GAS float*)(Rv + ov + (size_t)i * RW); }
}
__device__ __forceinline__ void scan_step4(const ScanBuf& B, float& S, float& yk, int lane, int sub) {
#pragma unroll
    for (int i = 0; i < 4; ++i) {
        const float sa = wave_sum(S * B.a[i]);
        S = S * B.w[i] + (sa * B.b[i] + B.v[i] * B.k[i]);
        const float y = wave_sum(S * B.r[i]);
        if (lane == sub * 4 + i) yk = y;
    }
}
__device__ __forceinline__ void p4_scan(Frame& F) {
    unsigned char* ws = F.ws; const int lane = F.lane;
    const float* Rr = (const float*)(ws + WS_RW); const float* Rw = Rr + (size_t)MTOK * RW; const float* Rk = Rw + (size_t)MTOK * RW; const float* Rv = Rk + (size_t)MTOK * RW;
    const float* Ra = Rv + (size_t)MTOK * RW; const float* Rb = Ra + (size_t)MTOK * RW;
    float* YS = (float*)(ws + WS_YS);
    if (F.wave < 4) {
        for (int row = (int)blockIdx.x * 4 + F.wave; row < BATCH * 8 * 64; row += F.G * 4) {
            const int b = row >> 9, h = (row >> 6) & 7, vr = row & 63;
            const size_t base = (size_t)b * SEQ * RW + h * 64 + lane, basev = (size_t)b * SEQ * RW + h * 64 + vr;
            float S = 0.f, yk = 0.f;
            ScanBuf A, B;
            scan_load(A, Rr, Rw, Rk, Rv, Ra, Rb, base, basev);
            for (int t0 = 0; t0 < SEQ; t0 += 8) {
                scan_load(B, Rr, Rw, Rk, Rv, Ra, Rb, base + (size_t)(t0 + 4) * RW, basev + (size_t)(t0 + 4) * RW);
                scan_step4(A, S, yk, lane, 0);
                if (t0 + 8 < SEQ) scan_load(A, Rr, Rw, Rk, Rv, Ra, Rb, base + (size_t)(t0 + 8) * RW, basev + (size_t)(t0 + 8) * RW);
                scan_step4(B, S, yk, lane, 1);
                if (lane < 8) *(GAS float*)(YS + basev + (size_t)(t0 + lane) * RW) = yk;
            }
        }
    }
}

__device__ __forceinline__ void p5_post(Frame& F) {
    const int gw = F.vcu * NWAVES + F.wave, NGW = F.G * NWAVES, lane = F.lane;
    unsigned char* ws = F.ws;
    const float* Rr = (const float*)(ws + WS_RW); const float* Rk = Rr + (size_t)2 * MTOK * RW; const float* Rv = Rk + (size_t)MTOK * RW; const float* Rg = Rr + (size_t)6 * MTOK * RW;
    const float* YS = (const float*)(ws + WS_YS);
    bf16* YB = (bf16*)(ws + WS_YABC) + (size_t)MTOK * 512;
    for (int m = gw; m < MTOK; m += NGW) {
#pragma unroll
        for (int h = 0; h < 8; ++h) { const int c = h * 64 + lane; const size_t o = (size_t)m * RW + c;
            const float y = *(const GAS float*)(YS + o), r = *(const GAS float*)(Rr + o), k = *(const GAS float*)(Rk + o), v = *(const GAS float*)(Rv + o), g = *(const GAS float*)(Rg + o);
            const float mean = wave_sum(y) * (1.f / 64.f); const float d = y - mean;
            const float var = wave_sum(d * d) * (1.f / 64.f);
            float yn = d * (1.0f / sqrtf(var + R_GN_EPS)) * F.in[I_R_LNW][c] + F.in[I_R_LNB][c];
            const float bonus = wave_sum(r * k * F.in[I_R_RK][c]) * v;
            YB[(size_t)m * 512 + c] = (bf16)f2bf((yn + bonus) * g); }
    }
}

__device__ __forceinline__ void p8_router(Frame& F) {
    const int gw = F.vcu * NWAVES + F.wave, NGW = F.G * NWAVES, lane = F.lane;
    unsigned char* ws = F.ws;
    const float* X1 = F.out; bf16* XN2 = (bf16*)(ws + WS_XN2);
    int* topi = (int*)(ws + WS_ROUTE + RT_TOPI); float* topg = (float*)(ws + WS_ROUTE + RT_TOPG);
    const float* RWt = F.in[I_ROUTER_W]; const float* RB = F.in[I_ROUTER_B]; const float* gain = F.in[I_NORM_FFN];
    for (int m = gw; m < MTOK; m += NGW) {
        const GAS f32x4* xr = (const GAS f32x4*)(X1 + (size_t)m * D_MODEL) + lane; const GAS f32x4* gr = (const GAS f32x4*)gain + lane;
        f32x4 v[4]; float s = 0.f;
#pragma unroll
        for (int j = 0; j < 4; ++j) { v[j] = xr[64 * j]; s += (v[j].x * v[j].x + v[j].y * v[j].y) + (v[j].z * v[j].z + v[j].w * v[j].w); }
        const float rstd = 1.0f / sqrtf(wave_sum(s) * (1.f / D_MODEL) + NORM_EPS);
        GAS unsigned long long* o8 = (GAS unsigned long long*)(XN2 + (size_t)m * D_MODEL) + lane;
#pragma unroll
        for (int j = 0; j < 4; ++j) { const f32x4 g = gr[64 * j]; v[j] = v[j] * rstd * g;
            o8[64 * j] = (unsigned long long)pk2(v[j].x, v[j].y) | ((unsigned long long)pk2(v[j].z, v[j].w) << 32); }
        float lg[32];
#pragma unroll
        for (int e = 0; e < 32; ++e) lg[e] = 0.f;
#pragma unroll
        for (int j = 0; j < 4; ++j)
#pragma unroll
            for (int i = 0; i < 4; ++i) { const float xv = v[j][i]; const GAS f32x4* wr = (const GAS f32x4*)(RWt + (size_t)(4 * lane + i + 256 * j) * N_EXPERTS);
#pragma unroll
                for (int q = 0; q < 8; ++q) { const f32x4 w = wr[q]; lg[4 * q] += xv * w.x; lg[4 * q + 1] += xv * w.y; lg[4 * q + 2] += xv * w.z; lg[4 * q + 3] += xv * w.w; } }
#pragma unroll
        for (int e = 0; e < 32; ++e) lg[e] = wave_sum(lg[e]) + RB[e];
        int ti[4]; float tv[4];
#pragma unroll
        for (int k = 0; k < 4; ++k) { float best = -INFINITY; int bi = 0;
#pragma unroll
            for (int e = 0; e < 32; ++e) { const bool taken = (k > 0 && ti[0] == e) || (k > 1 && ti[1] == e) || (k > 2 && ti[2] == e); if (!taken && lg[e] > best) { best = lg[e]; bi = e; } }
            ti[k] = bi; tv[k] = best; }
        const float e0 = 1.f, e1 = __expf(tv[1] - tv[0]), e2 = __expf(tv[2] - tv[0]), e3 = __expf(tv[3] - tv[0]); const float inv = 1.0f / (e0 + e1 + e2 + e3);
        if (lane < 4) { const int k = lane; const int e = (k == 0) ? ti[0] : (k == 1) ? ti[1] : (k == 2) ? ti[2] : ti[3]; const float gq = ((k == 0) ? e0 : (k == 1) ? e1 : (k == 2) ? e2 : e3) * inv;
            topi[(size_t)m * 4 + k] = e; topg[(size_t)m * 4 + k] = gq;
            __hip_atomic_fetch_add((unsigned*)(F.ctl + CW_CNT) + e, 1u, __ATOMIC_RELAXED, __HIP_MEMORY_SCOPE_AGENT); }
    }
}
__device__ __forceinline__ void moe_table(Frame& F) {
    LAS int* tab = (LAS int*)(F.lds + MOETAB_OFF);
    __syncthreads();
    if (F.tid == 0) { int acc = 0;
        for (int e = 0; e < N_EXPERTS; ++e) { const int c = (int)__hip_atomic_load((unsigned*)(F.ctl + CW_CNT) + e, __ATOMIC_RELAXED, __HIP_MEMORY_SCOPE_AGENT); const int nb = (c + MOE_ROWS - 1) / MOE_ROWS;
            tab[320 + e] = acc * MOE_ROWS; for (int q = 0; q < nb; ++q) tab[1 + acc + q] = e; acc += nb; }
        tab[0] = acc; }
    __syncthreads();
}
__device__ __forceinline__ void p9_dispatch(Frame& F) {
    const int gw = F.vcu * NWAVES + F.wave, NGW = F.G * NWAVES, lane = F.lane;
    unsigned char* ws = F.ws;
    moe_table(F);
    const LAS int* tab = (const LAS int*)(F.lds + MOETAB_OFF);
    const int* topi = (const int*)(ws + WS_ROUTE + RT_TOPI); const float* topg = (const float*)(ws + WS_ROUTE + RT_TOPG);
    int* pos = (int*)(ws + WS_ROUTE + RT_POS); float* rowgate = (float*)(ws + WS_ROUTE + RT_ROWGATE);
    const bf16* XN2 = (const bf16*)(ws + WS_XN2); bf16* XS = (bf16*)(ws + WS_XS);
    for (int m = gw; m < MTOK; m += NGW) {
        int slot = 0;
        if (lane < 4) { const int e = topi[(size_t)m * 4 + lane];
            slot = tab[320 + e] + (int)__hip_atomic_fetch_add((unsigned*)(F.ctl + CW_CUR) + e, 1u, __ATOMIC_RELAXED, __HIP_MEMORY_SCOPE_AGENT);
            pos[(size_t)m * 4 + lane] = slot; rowgate[slot] = topg[(size_t)m * 4 + lane]; }
        const GAS v4u* src = (const GAS v4u*)(XN2 + (size_t)m * D_MODEL) + lane; const v4u a = src[0], b = src[64];
#pragma unroll
        for (int k = 0; k < 4; ++k) { const int sk = __builtin_amdgcn_readlane(slot, k); GAS v4u* dst = (GAS v4u*)(XS + (size_t)sk * D_MODEL) + lane; dst[0] = a; dst[64] = b; }
    }
}
__device__ __forceinline__ void p12_combine(Frame& F) {
    const int gw = F.vcu * NWAVES + F.wave, NGW = F.G * NWAVES, lane = F.lane;
    unsigned char* ws = F.ws;
    const int* pos = (const int*)(ws + WS_ROUTE + RT_POS); const bf16* YR = (const bf16*)(ws + WS_YROWS);
    for (int m = gw; m < MTOK; m += NGW) {
        GAS f32x4* xo = (GAS f32x4*)(F.out + (size_t)m * D_MODEL) + 2 * lane;
        int pk = 0; if (lane < 4) pk = pos[(size_t)m * 4 + lane];
#pragma unroll
        for (int hf = 0; hf < 2; ++hf) { f32x4 a = xo[128 * hf], b = xo[128 * hf + 1];
#pragma unroll
            for (int k = 0; k < 4; ++k) { const int sk = __builtin_amdgcn_readlane(pk, k); const v4u w = *((const GAS v4u*)(YR + (size_t)sk * D_MODEL + 512 * hf) + lane);
                a[0] += bf_lo(w.x); a[1] += bf_hi(w.x); a[2] += bf_lo(w.y); a[3] += bf_hi(w.y); b[0] += bf_lo(w.z); b[1] += bf_hi(w.z); b[2] += bf_lo(w.w); b[3] += bf_hi(w.w); }
            xo[128 * hf] = a; xo[128 * hf + 1] = b; }
    }
}

struct Args { const float* in[32]; float* out; unsigned char* ws; int ph_lo, ph_hi, use_bar, pad; };
__global__ void __launch_bounds__(NWAVES * 64, 2) skel_fwd(Args args) {
    extern __shared__ __attribute__((aligned(16))) unsigned char lds[];
    Frame F;
    F.lds = (LAS unsigned char*)lds;
    F.MISC = (volatile LAS unsigned*)(F.lds + MISC_OFF);
    F.tid = threadIdx.x; F.lane = F.tid & 63; F.wave = __builtin_amdgcn_readfirstlane(F.tid >> 6);
    F.G = gridDim.x; { const int bx = blockIdx.x; F.vcu = (F.G % 8 == 0) ? (bx % 8) * (F.G / 8) + bx / 8 : bx; }
    unsigned char* ws = args.ws; F.ws = ws; F.out = args.out;
    F.ctl = (gu32*)(ws + WS_CTL);
#pragma unroll
    for (int i = 0; i < 32; ++i) F.in[i] = args.in[i];
    for (int u = F.tid; u < (LDS_BYTES - LDSCTL_OFF) / 4; u += NWAVES * 64) ((LAS unsigned*)(F.lds + LDSCTL_OFF))[u] = 0u;
    __syncthreads();
    XcdBarrier bar; bar.bar = (unsigned*)(F.ctl + CW_BAR); bar.x = 0; bar.st = nullptr;
    if (args.use_bar) bar = xcd_barrier_post((unsigned*)(F.ctl + CW_BAR), F.MISC + 8);
    const int lo = args.ph_lo, hi = args.ph_hi;
#define IN(k) (lo <= (k) && (k) < hi)
#define SEAM(k) do { if (IN(k) && IN((k) + 1)) xcd_barrier(bar); } while (0)
    const pg8::bf16_t* wsb = (const pg8::bf16_t*)ws;
#define BF(off) ((pg8::bf16_t*)(ws + (off)))

    if (IN(0)) { p0_prologue(F); } SEAM(0);
    if (IN(1)) {
        { pg8::Gemm g{BF(WS_XN), BF(WS_WIN), MTOK, IN_COLS, 1024}; pg8::StaticOrder S; S.init(MTOK, IN_COLS, F.G, (int)blockIdx.x);
          pg8::EpiBf16<0> E{BF(WS_Z), IN_COLS, nullptr, 0, 0, 1.f};
          pg8::gemm_phase<pg8::EpiBf16<0>, pg8::StaticOrder, true, true>(F.lds + RING_OFF, g, S, E); }
        { pg8::Gemm g{BF(WS_MEMN), BF(WS_WMEM), MEMROWS, 1024, 1024}; pg8::StaticOrder S; S.init(MEMROWS, 1024, F.G, (int)blockIdx.x);
          pg8::EpiBf16<0> E{BF(WS_KVM), 1024, nullptr, 0, 0, 1.f};
          pg8::gemm_phase<pg8::EpiBf16<0>, pg8::StaticOrder, true, true>(F.lds + RING_OFF, g, S, E); }
    } SEAM(1);
    if (IN(2)) { p2_prep(F); } SEAM(2);
    if (IN(3)) { p3_attention(F); } SEAM(3);
    if (IN(4)) { p4_scan(F); } SEAM(4);
    if (IN(5)) { p5_post(F); } SEAM(5);
    if (IN(6)) {
        for (int br = 0; br < 3; ++br) {
            pg8::Gemm g{BF(WS_YABC) + (size_t)br * MTOK * 512, BF(WS_WB) + (size_t)br * 1024 * 512, MTOK, 1024, 512}; pg8::StaticOrder S; S.init(MTOK, 1024, F.G, (int)blockIdx.x);
            pg8::EpiGate E{BF(WS_Z), F.in[I_B_GATE], (float*)(ws + WS_MRG), BF(WS_MRGB), br};
            pg8::gemm_phase<pg8::EpiGate, pg8::StaticOrder, true, true>(F.lds + RING_OFF, g, S, E);
        }
    } SEAM(6);
    if (IN(7)) {
        pg8::Gemm g{BF(WS_MRGB), BF(WS_WO), MTOK, 1024, 1024}; pg8::StaticOrder S; S.init(MTOK, 1024, F.G, (int)blockIdx.x);
        pg8::EpiResF32 E{F.in[I_X], F.out, 1024};
        pg8::gemm_phase<pg8::EpiResF32, pg8::StaticOrder, true, true>(F.lds + RING_OFF, g, S, E);
    } SEAM(7);
    if (IN(8)) { p8_router(F); } SEAM(8);
    if (IN(9)) { p9_dispatch(F); } SEAM(9);
    if (IN(10)) {
        moe_table(F);
        pg8::Gemm g{BF(WS_XS), BF(WS_W1), 0, 0, 1024}; pg8::MoeOrder S{(const PG8_LAS int*)(F.lds + MOETAB_OFF), 8, F.G, (int)blockIdx.x};
        pg8::EpiSwiGLU E{F.in[I_EXP_B1], BF(WS_HACT)};
        pg8::gemm_phase<pg8::EpiSwiGLU, pg8::MoeOrder, true, true>(F.lds + RING_OFF, g, S, E);
    } SEAM(10);
    if (IN(11)) {
        moe_table(F);
        pg8::Gemm g{BF(WS_HACT), BF(WS_W2), 0, 0, 1024}; pg8::MoeOrder S{(const PG8_LAS int*)(F.lds + MOETAB_OFF), 4, F.G, (int)blockIdx.x};
        pg8::EpiMoeOut E{F.in[I_EXP_B2], (const float*)(ws + WS_ROUTE + RT_ROWGATE), BF(WS_YROWS)};
        pg8::gemm_phase<pg8::EpiMoeOut, pg8::MoeOrder, true, true>(F.lds + RING_OFF, g, S, E);
    } SEAM(11);
    if (IN(12)) { p12_combine(F); }
#undef IN
#undef SEAM
#undef BF
    (void)wsb;
}

extern "C" void kernel_launch(void* const* d_in, const int* in_sizes, int n_in, void* d_out, int out_size, void* d_ws, size_t ws_size, hipStream_t stream) {
    static int grid = 0;
    if (grid == 0) {
        if (n_in != 32 || out_size != MTOK * D_MODEL || ws_size < WS_END) { fprintf(stderr, "kernel_launch: unexpected problem (n_in %d, out %d, ws %zu); nothing launched\n", n_in, out_size, ws_size); grid = -1; return; }
        int dev = 0, cus = 0;
        if (hipGetDevice(&dev) != hipSuccess || hipDeviceGetAttribute(&cus, hipDeviceAttributeMultiprocessorCount, dev) != hipSuccess) { grid = -1; return; }
        if (hipFuncSetAttribute((const void*)skel_fwd, hipFuncAttributeMaxDynamicSharedMemorySize, LDS_BYTES) != hipSuccess) { fprintf(stderr, "kernel_launch: hipFuncSetAttribute failed\n"); grid = -1; return; }
        (void)hipGetLastError();
        grid = cus;
    }
    if (grid < 0) return;
    (void)hipMemsetAsync((char*)d_ws + WS_CTL, 0, CTL_ZERO_BYTES, stream);
    Args a{};
    for (int i = 0; i < 32; ++i) a.in[i] = (const float*)d_in[i];
    a.out = (float*)d_out; a.ws = (unsigned char*)d_ws;
#if MK_N_LAUNCHES == 1
    a.ph_lo = 0; a.ph_hi = N_PHASES; a.use_bar = 1;
    hipLaunchKernelGGL(skel_fwd, dim3(grid), dim3(NWAVES * 64), LDS_BYTES, stream, a);
#else
    for (int p = 0; p < N_PHASES; ++p) { a.ph_lo = p; a.ph_hi = p + 1; a.use_bar = 0;
        hipLaunchKernelGGL(skel_fwd, dim3(grid), dim3(NWAVES * 64), LDS_BYTES, stream, a); }
#endif
}
```

```cpp
#include <hip/hip_runtime.h>
#include <cstdio>
#include <cstdint>
#include <cmath>
namespace pg8 {
#define PG8_LAS __attribute__((address_space(3)))
typedef unsigned short bf16_t;
typedef short bf16x8 __attribute__((ext_vector_type(8)));
typedef float f32x4 __attribute__((ext_vector_type(4)));
typedef unsigned u32x4 __attribute__((ext_vector_type(4)));
constexpr int BM = 256, BK = 64, HALF = 128, HTB = HALF * BK * 2  , STAGE_BYTES = 8 * HTB, NXCD = 8, WGM = 8;

__host__ __device__ __forceinline__ int lds_byte(int r, int c) { const int st = (r >> 4) * 2 + (c >> 5), rr = r & 15, cc = c & 31, ob = rr * 64 + cc * 2; return st * 1024 + (ob ^ (((ob >> 9) & 1) << 5)); }
__host__ __device__ __forceinline__ void stage_rc(int b, int& R, int& C) { const int st = b / 1024, sb = b % 1024, swz = sb ^ (((sb >> 9) & 1) << 5); R = (st >> 1) * 16 + swz / 64; C = (st & 1) * 32 + (swz % 64) / 2; }
__host__ __device__ __forceinline__ int perm32(int rho) { const int n = rho >> 4, i = rho & 15; return 8 * (i >> 2) + 4 * n + (i & 3); }

struct Unit { int pm, pn; };
struct Gemm { const bf16_t* A; const bf16_t* Bt; int M, N, K; };

struct StaticOrder {
    int nM, nN, nwg, G, c;
    __host__ __device__ void init(int M, int N, int G_, int c_) { nM = M / BM; nN = N / BM; nwg = nM * nN; G = G_; c = c_; }
    __host__ __device__ bool next(int i, Unit& u) const {
        const long L = (long)i * G + c; if (L >= nwg) return false;
        int wgid = (int)L; { const int q = nwg / NXCD, r = nwg % NXCD, xcd = wgid % NXCD, off = wgid / NXCD; wgid = (xcd < r ? xcd * (q + 1) : r * (q + 1) + (xcd - r) * q) + off; }
        const int nig = WGM * nN, gid = wgid / nig, fm = gid * WGM, gsz = (nM - fm) < WGM ? (nM - fm) : WGM;
        u.pm = fm + ((wgid % nig) % gsz); u.pn = (wgid % nig) / gsz; return true;
    }
    __device__ __forceinline__ void a_ready(const Unit&) const {}
    __device__ __forceinline__ void done(const Unit&) const {}
};

__device__ __forceinline__ unsigned cvt_pk_bf16(float lo, float hi) { unsigned r; asm volatile("v_cvt_pk_bf16_f32 %0, %1, %2" : "=v"(r) : "v"(lo), "v"(hi)); return r; }
typedef float f32x2 __attribute__((ext_vector_type(2)));
__device__ __forceinline__ f32x2 gelu_pk(f32x2 v) {
    const f32x2 av = __builtin_elementwise_abs(v), d = av * 0.2316418882f + 1.0f;
    f32x2 t; t.x = __builtin_amdgcn_rcpf(d.x); t.y = __builtin_amdgcn_rcpf(d.y);
    f32x2 q = t * 0.5307027145f + (-0.7265760135f); q = q * t + 0.7107068705f; q = q * t + (-0.142248368f); q = q * t + 0.127414796f; q = q * t;
    const f32x2 s = (v * v) * (-0.72134752044f);
    f32x2 e; e.x = __builtin_amdgcn_exp2f(s.x); e.y = __builtin_amdgcn_exp2f(s.y);
    const f32x2 m = v * (q * e), r = v - m;
    f32x2 o; o.x = v.x < 0.f ? m.x : r.x; o.y = v.y < 0.f ? m.y : r.y; return o;
}

template <int ACT  > struct EpiBf16 {
    static constexpr bool PERM = true, AFTER_DRAIN = false; static_assert(ACT == 0 || ACT == 1, "EpiBf16: ACT is 0 (none) or 1 (gelu_pk)");
    bf16_t* O; int ldc; const float* bias; int split_cols; size_t split_stride; float scale0;
    __device__ __forceinline__ void operator()(const f32x4 (&acc)[2][2][4][2], const Unit& u, int wr, int wc, int fr, int fq) const {
        const int row0 = u.pm * BM + wr * 64 + fr; int colt = u.pn * BM; bf16_t* base = O;
        float sc = 1.f; if (split_cols) { const int t = colt / split_cols; base += (size_t)t * split_stride; colt -= t * split_cols; if (t == 0) sc = scale0; }
        const int col0 = colt + wc * 32 + 8 * fq, bcol0 = u.pn * BM + wc * 32 + 8 * fq;
        f32x4 bv[2][2];
#pragma unroll
        for (int bj = 0; bj < 2; ++bj)
#pragma unroll
            for (int n = 0; n < 2; ++n) bv[bj][n] = bias ? *(const f32x4*)(bias + bcol0 + bj * HALF + 4 * n) : (f32x4){0.f, 0.f, 0.f, 0.f};
#pragma unroll
        for (int ai = 0; ai < 2; ++ai)
#pragma unroll
            for (int m = 0; m < 4; ++m) { bf16_t* rowp = base + (size_t)(row0 + ai * HALF + m * 16) * ldc + col0;
#pragma unroll
                for (int bj = 0; bj < 2; ++bj) { f32x4 v0 = acc[ai][bj][m][0] + bv[bj][0], v1 = acc[ai][bj][m][1] + bv[bj][1];
                    if (ACT == 1) { f32x2 a = gelu_pk((f32x2){v0[0], v0[1]}), b = gelu_pk((f32x2){v0[2], v0[3]}), c = gelu_pk((f32x2){v1[0], v1[1]}), d = gelu_pk((f32x2){v1[2], v1[3]});
                        v0 = (f32x4){a.x, a.y, b.x, b.y}; v1 = (f32x4){c.x, c.y, d.x, d.y}; }
                    v0 = v0 * sc; v1 = v1 * sc; u32x4 w; w.x = cvt_pk_bf16(v0[0], v0[1]); w.y = cvt_pk_bf16(v0[2], v0[3]); w.z = cvt_pk_bf16(v1[0], v1[1]); w.w = cvt_pk_bf16(v1[2], v1[3]);
                    *(u32x4*)(rowp + bj * HALF) = w; } }
    }
};
template <class Epi, class Sched, bool ALIGN_EPI = false, bool SP2 = false>
__device__ __forceinline__ void gemm_phase(PG8_LAS unsigned char* lds, const Gemm g, const Sched& S, const Epi& E) {
    const int tid = threadIdx.x, wid = __builtin_amdgcn_readfirstlane(tid >> 6), lane = tid & 63, wr = wid >> 2, wc = wid & 3, fr = lane & 15, fq = lane >> 4;
    const int K = g.K, nt = K / BK;
    unsigned voffA[2], voffB[2];
#pragma unroll
    for (int i = 0; i < 2; ++i) { int R, C; stage_rc(tid * 16 + i * 8192, R, C); const int Rb = Epi::PERM ? ((R & ~31) + perm32(R & 31)) : R;
        voffA[i] = (unsigned)(R * K + C) * 2u; voffB[i] = (unsigned)(Rb * K + C) * 2u; }
    const size_t kstep = (size_t)(BK * 2);
    const size_t hstep = (size_t)HALF * K * 2;
    const size_t tstep = 2 * hstep;
    const unsigned ldsw = (unsigned)wid * 1024u;
    const int aoff = lds_byte(wr * 64 + fr, fq * 8), boff = lds_byte(wc * 32 + fr, fq * 8);
#define PG8_SA(b, h) (((b) * 2 + (h)) * HTB)
#define PG8_SB(b, h) ((4 + (b) * 2 + (h)) * HTB)
#define PG8_STAGE(bufoff, gbase, voff) do { _Pragma("unroll") for (int _i = 0; _i < 2; ++_i) \
        __builtin_amdgcn_global_load_lds((const unsigned*)((const char*)(gbase) + (voff)[_i]), (PG8_LAS unsigned*)(lds + (bufoff) + ldsw + _i * 8192), 16, 0, 0); } while (0)
#define PG8_LDA(dst, b, h) do { _Pragma("unroll") for (int m = 0; m < 4; ++m) _Pragma("unroll") for (int k = 0; k < 2; ++k) dst[m][k] = *(const PG8_LAS bf16x8*)(lds + PG8_SA(b, h) + aoff + m * 2048 + k * 1024); } while (0)
#define PG8_LDB(dst, b, h) do { _Pragma("unroll") for (int n = 0; n < 2; ++n) _Pragma("unroll") for (int k = 0; k < 2; ++k) dst[n][k] = *(const PG8_LAS bf16x8*)(lds + PG8_SB(b, h) + boff + n * 2048 + k * 1024); } while (0)
#define PG8_MMA(ai, bj, At, Bt) do { __builtin_amdgcn_s_setprio(1); _Pragma("unroll") for (int m = 0; m < 4; ++m) _Pragma("unroll") for (int n = 0; n < 2; ++n) _Pragma("unroll") for (int k = 0; k < 2; ++k) \
        acc[ai][bj][m][n] = __builtin_amdgcn_mfma_f32_16x16x32_bf16(Bt[n][k], At[m][k], acc[ai][bj][m][n], 0, 0, 0); __builtin_amdgcn_s_setprio(0); } while (0)
#define PG8_WAIT_V(n) asm volatile("s_waitcnt vmcnt(" #n ")" ::: "memory")
#define PG8_WAIT_L(n) asm volatile("s_waitcnt lgkmcnt(" #n ")" ::: "memory")
#define PG8_BAR __builtin_amdgcn_s_barrier()
#define PG8_SCHED __builtin_amdgcn_sched_barrier(0)
    Unit cur, nxt; int ui = 0;
    if (!S.next(0, cur)) return;
    f32x4 acc[2][2][4][2];
#pragma unroll
    for (int a = 0; a < 2; ++a)
#pragma unroll
        for (int b = 0; b < 2; ++b)
#pragma unroll
            for (int m = 0; m < 4; ++m)
#pragma unroll
                for (int n = 0; n < 2; ++n) acc[a][b][m][n] = (f32x4){0.f, 0.f, 0.f, 0.f};
    bf16x8 At[4][2], B0[2][2], B1[2][2];
    const char* cA = (const char*)g.A + (size_t)cur.pm * tstep; const char* cB = (const char*)g.Bt + (size_t)cur.pn * tstep;
    S.a_ready(cur);
    if constexpr (SP2) {
        PG8_STAGE(PG8_SB(0, 0), cB, voffB); PG8_STAGE(PG8_SB(0, 1), cB + hstep, voffB); PG8_STAGE(PG8_SA(0, 0), cA, voffA); PG8_STAGE(PG8_SA(0, 1), cA + hstep, voffA);
        if (wr == 1) PG8_BAR;
        PG8_WAIT_V(2); PG8_BAR;
        PG8_STAGE(PG8_SB(1, 0), cB + kstep, voffB); PG8_STAGE(PG8_SA(1, 0), cA + kstep, voffA); PG8_STAGE(PG8_SB(1, 1), cB + hstep + kstep, voffB);
        PG8_WAIT_V(6); PG8_BAR;
    } else {
        PG8_STAGE(PG8_SB(0, 0), cB, voffB); PG8_STAGE(PG8_SA(0, 0), cA, voffA); PG8_STAGE(PG8_SB(0, 1), cB + hstep, voffB); PG8_STAGE(PG8_SA(0, 1), cA + hstep, voffA);
        if (wr == 1) PG8_BAR;
        PG8_WAIT_V(4); PG8_BAR;
        PG8_STAGE(PG8_SB(1, 0), cB + kstep, voffB); PG8_STAGE(PG8_SA(1, 0), cA + kstep, voffA); PG8_STAGE(PG8_SB(1, 1), cB + hstep + kstep, voffB);
        PG8_WAIT_V(6); PG8_BAR;
    }
    for (;;) {
        const bool has_next = S.next(ui + 1, nxt);
        const char* nA = has_next ? (const char*)g.A + (size_t)nxt.pm * tstep : cA; const char* nB = has_next ? (const char*)g.Bt + (size_t)nxt.pn * tstep : cB;
        for (int t = 0; t < nt; t += 2) {
            const bool last = (t == nt - 2);
            const char* a1 = cA + (size_t)(t + 1) * kstep;
            const char* a2 = last ? nA : cA + (size_t)(t + 2) * kstep; const char* b2 = last ? nB : cB + (size_t)(t + 2) * kstep;
            const char* a3 = a2 + kstep; const char* b3 = b2 + kstep;
            if (last && has_next) S.a_ready(nxt);
            if constexpr (SP2) {
            PG8_LDB(B0, 0, 0); PG8_LDB(B1, 0, 1); PG8_SCHED; PG8_LDA(At, 0, 0); PG8_STAGE(PG8_SA(1, 1), a1 + hstep, voffA);
            PG8_WAIT_V(8); PG8_WAIT_L(0); PG8_BAR; PG8_MMA(0, 0, At, B0); PG8_MMA(0, 1, At, B1); PG8_BAR; PG8_SCHED;
            PG8_LDA(At, 0, 1); PG8_STAGE(PG8_SB(0, 0), b2, voffB); PG8_STAGE(PG8_SB(0, 1), b2 + hstep, voffB); PG8_STAGE(PG8_SA(0, 0), a2, voffA);
            PG8_WAIT_V(8); PG8_WAIT_L(0); PG8_BAR; PG8_MMA(1, 0, At, B0); PG8_MMA(1, 1, At, B1); PG8_BAR; PG8_SCHED;
            PG8_LDB(B0, 1, 0); PG8_LDB(B1, 1, 1); PG8_SCHED; PG8_LDA(At, 1, 0); PG8_STAGE(PG8_SA(0, 1), a2 + hstep, voffA);
            PG8_WAIT_V(8); PG8_WAIT_L(0); PG8_BAR; PG8_MMA(0, 0, At, B0); PG8_MMA(0, 1, At, B1); PG8_BAR; PG8_SCHED;
            PG8_LDA(At, 1, 1); PG8_STAGE(PG8_SB(1, 0), b3, voffB); PG8_STAGE(PG8_SB(1, 1), b3 + hstep, voffB); PG8_STAGE(PG8_SA(1, 0), a3, voffA);
            PG8_WAIT_V(8); PG8_WAIT_L(0); PG8_BAR; PG8_MMA(1, 0, At, B0); PG8_MMA(1, 1, At, B1); PG8_BAR; PG8_SCHED;
            } else {
            PG8_LDB(B0, 0, 0); PG8_SCHED; PG8_LDA(At, 0, 0); PG8_STAGE(PG8_SA(1, 1), a1 + hstep, voffA);
            PG8_WAIT_L(8); PG8_BAR; PG8_WAIT_L(0); PG8_MMA(0, 0, At, B0); PG8_BAR; PG8_SCHED;
            PG8_LDB(B1, 0, 1); PG8_STAGE(PG8_SB(0, 0), b2, voffB);
            PG8_BAR; PG8_WAIT_L(0); PG8_MMA(0, 1, At, B1); PG8_BAR;
            PG8_LDA(At, 0, 1); PG8_STAGE(PG8_SA(0, 0), a2, voffA);
            PG8_BAR; PG8_WAIT_L(0); PG8_MMA(1, 0, At, B0); PG8_BAR; PG8_SCHED;
            PG8_STAGE(PG8_SB(0, 1), b2 + hstep, voffB);
            PG8_WAIT_V(6); PG8_BAR; PG8_MMA(1, 1, At, B1); PG8_BAR;
            PG8_LDB(B0, 1, 0); PG8_SCHED; PG8_LDA(At, 1, 0); PG8_STAGE(PG8_SA(0, 1), a2 + hstep, voffA);
            PG8_WAIT_L(8); PG8_BAR; PG8_WAIT_L(0); PG8_MMA(0, 0, At, B0); PG8_BAR; PG8_SCHED;
            PG8_LDB(B1, 1, 1); PG8_STAGE(PG8_SB(1, 0), b3, voffB);
            PG8_BAR; PG8_WAIT_L(0); PG8_MMA(0, 1, At, B1); PG8_BAR;
            PG8_LDA(At, 1, 1); PG8_STAGE(PG8_SA(1, 0), a3, voffA);
            PG8_BAR; PG8_WAIT_L(0); PG8_MMA(1, 0, At, B0); PG8_BAR; PG8_SCHED;
            PG8_STAGE(PG8_SB(1, 1), b3 + hstep, voffB);
            PG8_WAIT_V(6); PG8_BAR; PG8_MMA(1, 1, At, B1); PG8_BAR;
            }
        }
        if constexpr (ALIGN_EPI) { if (wr == 0) PG8_BAR; }
        if constexpr (!Epi::AFTER_DRAIN) { E(acc, cur, wr, wc, fr, fq); S.done(cur); }
        if (!has_next) break;
#pragma unroll
        for (int a = 0; a < 2; ++a)
#pragma unroll
            for (int b = 0; b < 2; ++b)
#pragma unroll
                for (int m = 0; m < 4; ++m)
#pragma unroll
                    for (int n = 0; n < 2; ++n) acc[a][b][m][n] = (f32x4){0.f, 0.f, 0.f, 0.f};
        cur = nxt; cA = nA; cB = nB; ++ui;
        if constexpr (ALIGN_EPI) { if (wr == 1) PG8_BAR; }
    }
    PG8_WAIT_V(0);
    if constexpr (!ALIGN_EPI) { if (wr == 0) PG8_BAR; }
    PG8_BAR;
    if constexpr (Epi::AFTER_DRAIN) { E.fused(acc, cur, wr, wc, fr, fq, lds, wid, lane); S.done(cur); }
#undef PG8_SA
#undef PG8_SB
#undef PG8_STAGE
#undef PG8_LDA
#undef PG8_LDB
#undef PG8_MMA
#undef PG8_WAIT_V
#undef PG8_WAIT_L
#undef PG8_BAR
#undef PG8_SCHED
}
}

constexpr int D_MODEL = 1024, BATCH = 2, SEQ = 8192, MTOK = BATCH * SEQ, MEM_LEN = 256, MEMROWS = BATCH * MEM_LEN;
constexpr int IN_COLS = 9984, OFF_AQ = 0, OFF_AK = 1536, OFF_AV = 3072, OFF_R = 4608, OFF_CQ = 6400, OFF_GATE = 6912;
constexpr int RW = 512;
constexpr int N_EXPERTS = 32, TOP_K = 4, D_FF = 1024, MOE_ROWS = 256;
constexpr int MAX_BLOCKS = MTOK * TOP_K / MOE_ROWS + N_EXPERTS;
constexpr int MAX_SLOTS = MAX_BLOCKS * MOE_ROWS;
constexpr float NORM_EPS = 1e-6f, R_GN_EPS = 64e-5f;
constexpr float LOG2E = 1.4426950408889634f;
constexpr float QSCALE = 0.08838834764831845f * LOG2E;

namespace pg8 {
__device__ __forceinline__ float bf_lo(unsigned w) { return __builtin_bit_cast(float, w << 16); }
__device__ __forceinline__ float bf_hi(unsigned w) { return __builtin_bit_cast(float, w & 0xffff0000u); }
__device__ __forceinline__ float sigmoidf_fast(float x) { return 1.0f / (1.0f + __expf(-x)); }

struct EpiGate {
    static constexpr bool PERM = true, AFTER_DRAIN = false;
    const bf16_t* Z; const float* bgate; float* merged; bf16_t* mergedb; int br;
    __device__ __forceinline__ void operator()(const f32x4 (&acc)[2][2][4][2], const Unit& u, int wr, int wc, int fr, int fq) const {
        const int row0 = u.pm * BM + wr * 64 + fr, col0 = u.pn * BM + wc * 32 + 8 * fq;
#pragma unroll
        for (int ai = 0; ai < 2; ++ai)
#pragma unroll
            for (int m = 0; m < 4; ++m) { const int row = row0 + ai * HALF + m * 16;
#pragma unroll
                for (int bj = 0; bj < 2; ++bj) { const int col = col0 + bj * HALF;
                    const u32x4 gz = *(const u32x4*)(Z + (size_t)row * IN_COLS + OFF_GATE + br * D_MODEL + col);
                    const f32x4 b0 = *(const f32x4*)(bgate + br * D_MODEL + col), b1 = *(const f32x4*)(bgate + br * D_MODEL + col + 4);
                    f32x4 g0, g1;
                    g0[0] = sigmoidf_fast(bf_lo(gz[0]) + b0[0]); g0[1] = sigmoidf_fast(bf_hi(gz[0]) + b0[1]); g0[2] = sigmoidf_fast(bf_lo(gz[1]) + b0[2]); g0[3] = sigmoidf_fast(bf_hi(gz[1]) + b0[3]);
                    g1[0] = sigmoidf_fast(bf_lo(gz[2]) + b1[0]); g1[1] = sigmoidf_fast(bf_hi(gz[2]) + b1[1]); g1[2] = sigmoidf_fast(bf_lo(gz[3]) + b1[2]); g1[3] = sigmoidf_fast(bf_hi(gz[3]) + b1[3]);
                    f32x4 v0 = acc[ai][bj][m][0] * g0, v1 = acc[ai][bj][m][1] * g1;
                    float* mp = merged + (size_t)row * D_MODEL + col;
                    if (br > 0) { v0 += *(const f32x4*)mp; v1 += *(const f32x4*)(mp + 4); }
                    if (br < 2) { *(f32x4*)mp = v0; *(f32x4*)(mp + 4) = v1; }
                    else { u32x4 w; w.x = cvt_pk_bf16(v0[0], v0[1]); w.y = cvt_pk_bf16(v0[2], v0[3]); w.z = cvt_pk_bf16(v1[0], v1[1]); w.w = cvt_pk_bf16(v1[2], v1[3]);
                        *(u32x4*)(mergedb + (size_t)row * D_MODEL + col) = w; } } }
    }
};
struct EpiResF32 {
    static constexpr bool PERM = true, AFTER_DRAIN = false;
    const float* base; float* out; int ldc;
    __device__ __forceinline__ void operator()(const f32x4 (&acc)[2][2][4][2], const Unit& u, int wr, int wc, int fr, int fq) const {
        const int row0 = u.pm * BM + wr * 64 + fr, col0 = u.pn * BM + wc * 32 + 8 * fq;
#pragma unroll
        for (int ai = 0; ai < 2; ++ai)
#pragma unroll
            for (int m = 0; m < 4; ++m) { const size_t off = (size_t)(row0 + ai * HALF + m * 16) * ldc + col0;
#pragma unroll
                for (int bj = 0; bj < 2; ++bj) { const float* bp = base + off + bj * HALF; float* op = out + off + bj * HALF;
                    const f32x4 x0 = *(const f32x4*)bp, x1 = *(const f32x4*)(bp + 4);
                    *(f32x4*)op = x0 + acc[ai][bj][m][0]; *(f32x4*)(op + 4) = x1 + acc[ai][bj][m][1]; } }
    }
};
struct EpiSwiGLU {
    static constexpr bool PERM = true, AFTER_DRAIN = false;
    const float* b1; bf16_t* H;
    __device__ __forceinline__ void operator()(const f32x4 (&acc)[2][2][4][2], const Unit& u, int wr, int wc, int fr, int fq) const {
        const int e = u.pn >> 3, pnl = u.pn & 7;
        const int row0 = u.pm * BM + wr * 64 + fr, ac = pnl * HALF + wc * 32 + 8 * fq;
        const float* bg = b1 + (size_t)e * 2 * D_FF + ac; const float* bl = bg + D_FF;
        const f32x4 bg0 = *(const f32x4*)bg, bg1 = *(const f32x4*)(bg + 4), bl0 = *(const f32x4*)bl, bl1 = *(const f32x4*)(bl + 4);
#pragma unroll
        for (int ai = 0; ai < 2; ++ai)
#pragma unroll
            for (int m = 0; m < 4; ++m) { const int row = row0 + ai * HALF + m * 16;
                float a[8];
#pragma unroll
                for (int n = 0; n < 2; ++n) { const f32x4 ug = acc[ai][0][m][n] + (n ? bg1 : bg0), ul = acc[ai][1][m][n] + (n ? bl1 : bl0);
#pragma unroll
                    for (int j = 0; j < 4; ++j) { const float g = fminf(ug[j], 7.0f), l = fminf(fmaxf(ul[j], -7.0f), 7.0f);
                        a[4 * n + j] = g * sigmoidf_fast(1.702f * g) * (l + 1.0f); } }
                u32x4 w; w.x = cvt_pk_bf16(a[0], a[1]); w.y = cvt_pk_bf16(a[2], a[3]); w.z = cvt_pk_bf16(a[4], a[5]); w.w = cvt_pk_bf16(a[6], a[7]);
                *(u32x4*)(H + (size_t)row * D_FF + ac) = w; }
    }
};
struct EpiMoeOut {
    static constexpr bool PERM = true, AFTER_DRAIN = false;
    const float* b2; const float* rowgate; bf16_t* Y;
    __device__ __forceinline__ void operator()(const f32x4 (&acc)[2][2][4][2], const Unit& u, int wr, int wc, int fr, int fq) const {
        const int e = u.pn >> 2, pnl = u.pn & 3;
        const int row0 = u.pm * BM + wr * 64 + fr, col0 = pnl * BM + wc * 32 + 8 * fq;
#pragma unroll
        for (int ai = 0; ai < 2; ++ai)
#pragma unroll
            for (int m = 0; m < 4; ++m) { const int row = row0 + ai * HALF + m * 16; const float gt = rowgate[row];
#pragma unroll
                for (int bj = 0; bj < 2; ++bj) { const int col = col0 + bj * HALF; const float* bp = b2 + (size_t)e * D_MODEL + col;
                    const f32x4 v0 = (acc[ai][bj][m][0] + *(const f32x4*)bp) * gt, v1 = (acc[ai][bj][m][1] + *(const f32x4*)(bp + 4)) * gt;
                    u32x4 w; w.x = cvt_pk_bf16(v0[0], v0[1]); w.y = cvt_pk_bf16(v0[2], v0[3]); w.z = cvt_pk_bf16(v1[0], v1[1]); w.w = cvt_pk_bf16(v1[2], v1[3]);
                    *(u32x4*)(Y + (size_t)row * D_MODEL + col) = w; } }
    }
};
struct MoeOrder {
    const PG8_LAS int* tab;
    int NT, G, c;
    __device__ __forceinline__ bool next(int i, Unit& u) const {
        const int nblk = tab[0]; const long L = (long)i * G + c; if (L >= (long)nblk * NT) return false;
        const int blk = (int)(L / NT), pnl = (int)(L % NT); u.pm = blk; u.pn = tab[1 + blk] * NT + pnl; return true;
    }
    __device__ __forceinline__ void a_ready(const Unit&) const {}
    __device__ __forceinline__ void done(const Unit&) const {}
};
}

namespace swa {
constexpr int D = 128;
constexpr float SCALE = 0.08838834764831845f;
constexpr float THR = 8.f;
constexpr int NW = 8, QBLK = 32, KVBLK = 64, QB = NW * QBLK;
constexpr int SHM_V = KVBLK * D * 2, SHM_K = KVBLK * D * 2;
constexpr int LDS_BYTES = 2 * SHM_V + 2 * SHM_K + NW * 64 * 4;
using bf16 = unsigned short;
typedef short bf16x8 __attribute__((ext_vector_type(8)));
typedef short s16x4 __attribute__((ext_vector_type(4)));
typedef float f32x16 __attribute__((ext_vector_type(16)));
typedef float f32x4 __attribute__((ext_vector_type(4)));
typedef unsigned u32x4 __attribute__((ext_vector_type(4)));
template <class A, class Bt> struct same_t { static constexpr bool v = false; };
template <class A> struct same_t<A, A> { static constexpr bool v = true; };
#define KSWZ(row, colB) ((row) * 256 + ((colB) ^ (((row) & 7) << 4)))
#define SBAR() __builtin_amdgcn_sched_barrier(0)
__device__ __forceinline__ int v_st(int k, int c) { const int kk = (k & ~0xC) | ((k & 4) << 1) | ((k & 8) >> 1); return ((kk >> 3) * 4 + (c >> 5)) * 512 + ((kk & 7) * 32 + (c & 31)) * 2; }
__device__ __forceinline__ int v_rd_base(int lane) { return ((lane & 3) << 3) | (((lane >> 2) & 3) << 6) | (((lane >> 4) & 1) << 5) | (((lane >> 5) & 1) << 8); }
constexpr int v_rd_off(int d0, int ks, int half) { return d0 * 512 + ks * 4096 + half * 2048; }
__device__ __forceinline__ int crow(int r, int hi) { return (r & 3) + 8 * (r >> 2) + 4 * hi; }
__device__ __forceinline__ unsigned cvtpk(float lo, float hi) {
    unsigned r; asm volatile("v_cvt_pk_bf16_f32 %0, %1, %2" : "=v"(r) : "v"(lo), "v"(hi)); return r;
}
__device__ __forceinline__ bf16x8 pack8(f32x4 a, f32x4 b) {
    u32x4 w = {cvtpk(a[0], a[1]), cvtpk(a[2], a[3]), cvtpk(b[0], b[1]), cvtpk(b[2], b[3])};
    return *reinterpret_cast<bf16x8*>(&w);
}
template <class T> __device__ __forceinline__ bf16x8 load8(const T* p) {
    if constexpr (same_t<T, float>::v) { return pack8(*(const f32x4*)p, *(const f32x4*)(p + 4)); }
    else { return *reinterpret_cast<const bf16x8*>(p); }
}
__device__ __forceinline__ void mask_tile(f32x16& p0, f32x16& p1, int dq, unsigned W) {
    const float NEG = -__builtin_inff();
#pragma unroll
    for (int r = 0; r < 16; ++r) {
        const int c = (r & 3) + 8 * (r >> 2);
        if ((unsigned)(dq - c) >= W) p0[r] = NEG;
        if ((unsigned)(dq - c - 32) >= W) p1[r] = NEG;
    }
}
__device__ __forceinline__ void partialSM(f32x16& p0, f32x16& p1, float& m_reg, float& mn, float& alpha) {
    float pmax = p0[0]; for (int r = 1; r < 16; ++r) pmax = fmaxf(pmax, p0[r]); for (int r = 0; r < 16; ++r) pmax = fmaxf(pmax, p1[r]);
    { auto rr = __builtin_amdgcn_permlane32_swap(__float_as_uint(pmax), __float_as_uint(pmax), false, false);
      pmax = fmaxf(__uint_as_float(rr[0]), __uint_as_float(rr[1])); }
    constexpr float C2 = 1.4426950408889634f * SCALE;
    if (__builtin_expect(__all((pmax - m_reg) * SCALE <= THR), 1)) { mn = m_reg; alpha = 1.f; }
    else { mn = fmaxf(m_reg, pmax); alpha = __builtin_amdgcn_exp2f((m_reg - mn) * C2); m_reg = mn; }
    const float mnL = -mn * C2;
    for (int r = 0; r < 16; ++r) p0[r] = fmaf(p0[r], C2, mnL); for (int r = 0; r < 16; ++r) p1[r] = fmaf(p1[r], C2, mnL);
    for (int r = 0; r < 16; ++r) p0[r] = __builtin_amdgcn_exp2f(p0[r]);
}
__device__ __forceinline__ void finishSM(f32x16& p0, f32x16& p1, float alpha, float& l_reg, bf16x8& pa0, bf16x8& pa1, bf16x8& pa2, bf16x8& pa3) {
    for (int r = 0; r < 16; ++r) p1[r] = __builtin_amdgcn_exp2f(p1[r]);
    float ps = 0; for (int r = 0; r < 16; ++r) ps += p0[r]; for (int r = 0; r < 16; ++r) ps += p1[r];
    { auto rr = __builtin_amdgcn_permlane32_swap(__float_as_uint(ps), __float_as_uint(ps), false, false);
      ps = __uint_as_float(rr[0]) + __uint_as_float(rr[1]); }
    l_reg = l_reg * alpha + ps;
#define PK4(P, B_, OUT) do { unsigned a0 = cvtpk(P[B_+0], P[B_+1]), a1 = cvtpk(P[B_+2], P[B_+3]);                          \
        unsigned b0 = cvtpk(P[B_+4], P[B_+5]), b1 = cvtpk(P[B_+6], P[B_+7]);                                             \
        auto r0 = __builtin_amdgcn_permlane32_swap(a0, b0, false, false); auto r1 = __builtin_amdgcn_permlane32_swap(a1, b1, false, false); \
        u32x4 w = {r0[0], r1[0], r0[1], r1[1]}; OUT = *reinterpret_cast<bf16x8*>(&w); } while (0)
    PK4(p0, 0, pa0); PK4(p0, 8, pa1); PK4(p1, 0, pa2); PK4(p1, 8, pa3);
#undef PK4
}
template <int KB, bool SK>
__device__ __forceinline__ void qkt(f32x16& p0, f32x16& p1, const char* K_lds, int r32, int hi, const bf16x8* qr, bool act) {
    if (SK && !act) { const float NEG = -__builtin_inff();
#pragma unroll
        for (int r = 0; r < 16; ++r) { p0[r] = NEG; p1[r] = NEG; } return; }
    p0 = f32x16{}; p1 = f32x16{};
    const char* kb[4];
#pragma unroll
    for (int dd = 0; dd < 4; ++dd) kb[dd] = K_lds + KB * SHM_K + KSWZ(r32, (dd * 16 + hi * 8) * 2);
#pragma unroll
    for (int d0 = 0; d0 < 8; ++d0) { const char* a = kb[d0 & 3] + (d0 >> 2) * 128;
        bf16x8 b0 = *reinterpret_cast<const bf16x8*>(a);
        bf16x8 b1 = *reinterpret_cast<const bf16x8*>(a + 32 * 256);
        p0 = __builtin_amdgcn_mfma_f32_32x32x16_bf16(b0, qr[d0], p0, 0, 0, 0);
        p1 = __builtin_amdgcn_mfma_f32_32x32x16_bf16(b1, qr[d0], p1, 0, 0, 0); }
}
template <int VB, bool SK>
__device__ __forceinline__ void pv_tile(f32x16* o, int vb0, bf16x8 pa0, bf16x8 pa1, bf16x8 pa2, bf16x8 pa3, bool act) {
    if (SK && !act) return;
#define TRRD(dst, off) asm volatile("ds_read_b64_tr_b16 %0, %1 offset:%2" : "=&v"(dst) : "v"(vb0), "i"(off) : "memory")
#define PV_D0(d0) do { s16x4 l0, l1, l2, l3, h0, h1, h2, h3; constexpr int b_ = VB * SHM_V + v_rd_off(d0, 0, 0);     \
        TRRD(l0, b_); TRRD(h0, b_ + 2048); TRRD(l1, b_ + 4096); TRRD(h1, b_ + 6144); TRRD(l2, b_ + 8192); TRRD(h2, b_ + 10240); TRRD(l3, b_ + 12288); TRRD(h3, b_ + 14336); \
        asm volatile("s_waitcnt lgkmcnt(0)" ::: "memory"); SBAR();                 \
        o[d0] = __builtin_amdgcn_mfma_f32_32x32x16_bf16(pa0, (bf16x8){l0[0], l0[1], l0[2], l0[3], h0[0], h0[1], h0[2], h0[3]}, o[d0], 0, 0, 0);   \
        o[d0] = __builtin_amdgcn_mfma_f32_32x32x16_bf16(pa1, (bf16x8){l1[0], l1[1], l1[2], l1[3], h1[0], h1[1], h1[2], h1[3]}, o[d0], 0, 0, 0);   \
        o[d0] = __builtin_amdgcn_mfma_f32_32x32x16_bf16(pa2, (bf16x8){l2[0], l2[1], l2[2], l2[3], h2[0], h2[1], h2[2], h2[3]}, o[d0], 0, 0, 0);   \
        o[d0] = __builtin_amdgcn_mfma_f32_32x32x16_bf16(pa3, (bf16x8){l3[0], l3[1], l3[2], l3[3], h3[0], h3[1], h3[2], h3[3]}, o[d0], 0, 0, 0); } while (0)
    PV_D0(0); PV_D0(1); PV_D0(2); PV_D0(3);
#undef PV_D0
#undef TRRD
}

struct BlockRef { const bf16* Q; const bf16* K; const bf16* V; bf16* O; float* LSE; int QS, KS, OS, LS, P0, skv, W; };
struct Seam { bf16x8 qr[8]; bf16x8 st_v0, st_v1, st_k0, st_k1; };
__device__ __forceinline__ int swa_jlo(int P0, int W) { const int lowk = P0 - W + 1; return lowk > 0 ? lowk / KVBLK : 0; }
#define LD8(p) (*reinterpret_cast<const bf16x8*>(p))
#define ROW(p, k0, rr, RS) ((p) + (size_t)((k0) + (rr)) * (RS) + sc)
#define VMW() asm volatile("s_waitcnt vmcnt(0)" ::: "memory")
#define VMWN(n) asm volatile("s_waitcnt vmcnt(%0)" :: "i"(n) : "memory")
#define SLOAD_H(Kp, Vp, k0, RS) do { const char* kb_ = (const char*)(Kp) + (size_t)(k0) * (size_t)(RS) * 2; const char* vb_ = (const char*)(Vp) + (size_t)(k0) * (size_t)(RS) * 2;  \
                         const unsigned oa_ = (unsigned)(sr * (RS) + sc) * 2u, ob_ = oa_ + (unsigned)(RS) * 64u;                                    \
                         S.st_v0 = LD8(vb_ + oa_); S.st_v1 = LD8(vb_ + ob_); S.st_k0 = LD8(kb_ + oa_); S.st_k1 = LD8(kb_ + ob_); } while (0)
#define SWRITE_HK(bf) do { *(bf16x8*)(K_lds + (bf) * SHM_K + kws) = S.st_k0; *(bf16x8*)(K_lds + (bf) * SHM_K + kws + 32 * 256) = S.st_k1; } while (0)
#define SWRITE_HV(bf) do { *(bf16x8*)(V_lds + (bf) * SHM_V + vst0) = S.st_v0; *(bf16x8*)(V_lds + (bf) * SHM_V + vst1) = S.st_v1; } while (0)
#define SWRITE_H(bf) do { SWRITE_HV(bf); SWRITE_HK(bf); } while (0)
__device__ __forceinline__ void swa_prime(const BlockRef& cur, char* lds, Seam& S) {
    const int tid = threadIdx.x, wid = __builtin_amdgcn_readfirstlane(tid >> 6), lane = tid & 63, r32 = lane & 31, hi = lane >> 5;
    const int sr = tid >> 4, sc = (tid & 15) * 8, kws = KSWZ(sr, sc * 2); char* K_lds = lds + 2 * SHM_V;
    const int kb0 = swa_jlo(cur.P0, cur.W) * KVBLK;
    { const char* qb_ = (const char*)cur.Q + (size_t)(wid * QBLK) * (size_t)cur.QS * 2; const unsigned qo_ = (unsigned)(r32 * cur.QS + hi * 8) * 2u;
      for (int d0 = 0; d0 < 8; ++d0) S.qr[d0] = LD8(qb_ + qo_ + d0 * 32); }
    SLOAD_H(cur.K, cur.V, kb0, cur.KS); VMW(); SWRITE_HK(0);
    __syncthreads();
}
__device__ __forceinline__ void swa_block(const BlockRef& cur, const BlockRef& nxt, char* lds, Seam& S) {
    const int tid = threadIdx.x, wid = __builtin_amdgcn_readfirstlane(tid >> 6), lane = tid & 63, r32 = lane & 31, hi = lane >> 5;
    const int W = cur.W, skv = cur.skv;
    const int j_lo = swa_jlo(cur.P0, W);
    int j_hi = (cur.P0 + QB - 1) / KVBLK + 1; if (j_hi > skv / KVBLK) j_hi = skv / KVBLK;
    const int NT = j_hi - j_lo;
    const int kbn = swa_jlo(nxt.P0, nxt.W) * KVBLK;
    const int qlo = cur.P0 + wid * QBLK, qm = qlo + r32 - 4 * hi;
    char* V_lds = lds; char* K_lds = lds + 2 * SHM_V;
    float* ws = (float*)(lds + 2 * SHM_V + 2 * SHM_K) + wid * 64; float* li_l = ws, * al_l = ws + 32;
    float m_reg = -1e30f, l_reg = 0; f32x16 o[4] = {};
    const int sr = tid >> 4, sc = (tid & 15) * 8, vst0 = v_st(sr, sc), vst1 = v_st(32 + sr, sc), kws = KSWZ(sr, sc * 2);
    const int vb0 = (int)(uintptr_t)V_lds + v_rd_base(lane);
    const bf16* Kh = cur.K; const bf16* Vh = cur.V; const int KSc = cur.KS;
#define RESC(a) do { if (__any((a) < 1.f)) { if (hi == 0) al_l[r32] = (a); asm volatile("s_waitcnt lgkmcnt(0)" ::: "memory");              \
                     for (int d_ = 0; d_ < 4; ++d_) for (int r = 0; r < 16; ++r) o[d_][r] *= al_l[crow(r, hi)]; } } while (0)
#define KBASE(t) ((j_lo + (t)) * KVBLK)
#define ACT(t) (KBASE(t) <= qlo + QBLK - 1 && KBASE(t) + KVBLK - 1 >= qlo - W + 1)
#define MASKT(P0_, P1_, t) do { const int kb_ = KBASE(t); if ((!SK || ACT(t)) && (kb_ + KVBLK - 1 > qlo || kb_ <= qlo + QBLK - 1 - W)) mask_tile(P0_, P1_, qm - kb_, (unsigned)W); } while (0)
    constexpr int NQL = 8;
    constexpr bool SK = true;
#define SEAM_K0() do { VMWN(NQL); SWRITE_HK(0); SBAR(); } while (0)
    f32x16 pA0, pA1, pB0, pB1; float mnA, mnB, alA, alB; bf16x8 pa0, pa1, pa2, pa3;
    SWRITE_HV(0); SBAR();
    if (NT > 1) { SLOAD_H(Kh, Vh, KBASE(1), KSc); }
    SBAR(); qkt<0, SK>(pA0, pA1, K_lds, r32, hi, S.qr, ACT(0));
    MASKT(pA0, pA1, 0); partialSM(pA0, pA1, m_reg, mnA, alA);
    if (NT > 1) { VMW(); SWRITE_H(1); }
    __syncthreads();
#define HALF_STEP(PX0, PX1, mnX, alX, PY0, PY1, alY, t, KB, VB, SB) do {                                                      \
        SBAR(); qkt<KB, SK>(PX0, PX1, K_lds, r32, hi, S.qr, ACT(t));                                             \
        finishSM(PY0, PY1, alY, l_reg, pa0, pa1, pa2, pa3); SBAR();                                                           \
        if ((t) + 1 < NT) { SLOAD_H(Kh, Vh, KBASE((t) + 1), KSc); SBAR(); }                                               \
        pv_tile<VB, SK>(o, vb0, pa0, pa1, pa2, pa3, ACT((t) - 1)); MASKT(PX0, PX1, (t)); partialSM(PX0, PX1, m_reg, mnX, alX);                                        \
        __syncthreads();                                                                                                      \
        if ((t) + 1 < NT) { VMW(); SWRITE_H(SB); }                                                                          \
        RESC(alX); __syncthreads(); } while (0)
    for (int t = 1; t + 1 < NT; t += 2) {
        HALF_STEP(pB0, pB1, mnB, alB, pA0, pA1, alA, t, 1, 0, 0);
        HALF_STEP(pA0, pA1, mnA, alA, pB0, pB1, alB, t + 1, 0, 1, 1);
    }
    const bool even = (NT & 1) == 0;
    if (even) { SBAR(); qkt<1, SK>(pB0, pB1, K_lds, r32, hi, S.qr, ACT(NT - 1)); SBAR(); }
    { SLOAD_H(nxt.K, nxt.V, kbn, nxt.KS); SBAR();
      const char* qb_ = (const char*)nxt.Q + (size_t)(wid * QBLK) * (size_t)nxt.QS * 2; const unsigned qo_ = (unsigned)(r32 * nxt.QS + hi * 8) * 2u;
#pragma unroll
        for (int d0 = 0; d0 < 8; ++d0) S.qr[d0] = LD8(qb_ + qo_ + d0 * 32); }
    SBAR();
    finishSM(pA0, pA1, alA, l_reg, pa0, pa1, pa2, pa3); SBAR();
    pv_tile<0, SK>(o, vb0, pa0, pa1, pa2, pa3, ACT(even ? NT - 2 : NT - 1));
    if (even) { MASKT(pB0, pB1, NT - 1); partialSM(pB0, pB1, m_reg, mnB, alB); __syncthreads(); RESC(alB);
        finishSM(pB0, pB1, alB, l_reg, pa0, pa1, pa2, pa3); SBAR(); pv_tile<1, SK>(o, vb0, pa0, pa1, pa2, pa3, ACT(NT - 1)); }
    SBAR(); SEAM_K0();
    if (hi == 0) li_l[r32] = l_reg; asm volatile("s_waitcnt lgkmcnt(0)" ::: "memory");
    if (cur.LSE != nullptr && hi == 0) cur.LSE[(size_t)(wid * QBLK + r32) * cur.LS] = __log2f(l_reg) + m_reg * (1.4426950408889634f * SCALE);
    float rli[16];
#pragma unroll
    for (int r = 0; r < 16; ++r) rli[r] = __builtin_amdgcn_rcpf(li_l[crow(r, hi)]);
    bf16* Ow = cur.O + (size_t)(wid * QBLK) * cur.OS;
#pragma unroll
    for (int r = 0; r < 16; ++r) { const int orow = crow(r, hi);
#pragma unroll
        for (int d0 = 0; d0 < 4; ++d0) { const float v = o[d0][r] * rli[r];
            const float vn = __shfl_xor(v, 1);
            if ((r32 & 1) == 0) *(unsigned*)(Ow + (size_t)orow * cur.OS + d0 * 32 + r32) = cvtpk(v, vn); } }
    __syncthreads();
#undef RESC
#undef KBASE
#undef ACT
#undef MASKT
#undef SEAM_K0
#undef HALF_STEP
}
#undef LD8
#undef ROW
#undef VMW
#undef VMWN
#undef SLOAD_H
#undef SWRITE_HK
#undef SWRITE_HV
#undef SWRITE_H
#undef KSWZ
#undef SBAR
}

constexpr int NWAVES = 8;
#ifndef MK_N_LAUNCHES
#define MK_N_LAUNCHES 1
#endif
constexpr int N_PHASES = 13;
#ifndef NAIVE_ATTN
#define NAIVE_ATTN 0
#endif
constexpr float ATT_QSCALE = NAIVE_ATTN ? QSCALE : 1.0f;

constexpr size_t MiB = 1u << 20;
constexpr size_t WS_CTL = 0, CTL_ZERO_BYTES = 1 * MiB;
constexpr size_t WS_WIN = 2 * MiB;
constexpr size_t WS_WB = 22 * MiB;
constexpr size_t WS_WO = 25 * MiB;
constexpr size_t WS_WMEM = 27 * MiB;
constexpr size_t WS_W1 = 29 * MiB;
constexpr size_t WS_W2 = 157 * MiB;
constexpr size_t WS_XN = 221 * MiB;
constexpr size_t WS_Z = 256 * MiB;
constexpr size_t WS_RW = 568 * MiB;
constexpr size_t WS_YS = 792 * MiB;
constexpr size_t WS_YABC = 824 * MiB;
constexpr size_t WS_MRG = 872 * MiB;
constexpr size_t WS_MRGB = 936 * MiB;
constexpr size_t WS_MEMN = 968 * MiB;
constexpr size_t WS_KVM = 969 * MiB;
constexpr size_t WS_XN2 = 970 * MiB;
constexpr size_t WS_ROUTE = 1002 * MiB;
constexpr size_t WS_END = 1004 * MiB;
constexpr size_t WS_XS = 256 * MiB;
constexpr size_t WS_HACT = 400 * MiB;
constexpr size_t WS_YROWS = 544 * MiB;
constexpr size_t WS_OP = WS_MRG;
constexpr size_t WS_LSE = WS_MRGB;
constexpr size_t RWSZ = (size_t)MTOK * RW * 4;
constexpr size_t RT_TOPI = 0, RT_TOPG = 256 * 1024, RT_POS = 512 * 1024, RT_ROWGATE = 768 * 1024;
static_assert(RT_ROWGATE + (size_t)MAX_SLOTS * 4 <= 1088 * 1024, "route");
constexpr int CW_TMO = 0, CW_CODE = 1;
constexpr int CW_BAR = 4096;
constexpr int CW_CNT = 16384;
constexpr int CW_CUR = 16384 + 64;

constexpr int RING_OFF = 0, RING_BYTES = 131072;
constexpr int LDSCTL_OFF = RING_BYTES, MISC_OFF = LDSCTL_OFF + 320;
constexpr int MOETAB_OFF = MISC_OFF + 128;
constexpr int LDS_BYTES = 147456;
static_assert(MOETAB_OFF + 4 * (1 + MAX_BLOCKS + 64) <= LDS_BYTES, "LDS map");
#define GAS __attribute__((address_space(1)))
#define LAS __attribute__((address_space(3)))
typedef unsigned short bf16;
typedef unsigned v4u __attribute__((ext_vector_type(4)));
typedef float f32x4 __attribute__((ext_vector_type(4)));
typedef short bf16x8 __attribute__((ext_vector_type(8)));
typedef GAS unsigned gu32;
typedef GAS unsigned long long gu64;
#define RLX_AGENT __ATOMIC_RELAXED, __HIP_MEMORY_SCOPE_AGENT
#define LDS_WAIT() asm volatile("s_waitcnt lgkmcnt(0)" ::: "memory")
#define VM_WAIT() asm volatile("s_waitcnt vmcnt(0)" ::: "memory")
__device__ __forceinline__ unsigned long long rt() { return __builtin_amdgcn_s_memrealtime(); }
__device__ __forceinline__ unsigned f2bf(float f) { unsigned u = __builtin_bit_cast(unsigned, f); return (u + 0x7fffu + ((u >> 16) & 1u)) >> 16; }
__device__ __forceinline__ unsigned pk2(float lo, float hi) { return f2bf(lo) | (f2bf(hi) << 16); }
#define XB_TMO      128
#define XB_XCNT(j)  (256  + 64 * (j))
#define XB_XSUB(j)  (1280 + 64 * (j))
#define XB_XGEN(j)  (2304 + 64 * (j))
#define XB_TOP      3328
#define XB_TOPGEN   3392
#define XCD_BAR_WORDS 3456
#define XB_SPIN_CAP (1u << 18)

__device__ __forceinline__ unsigned xb_ld(unsigned* p)              { return __hip_atomic_load(p, __ATOMIC_RELAXED, __HIP_MEMORY_SCOPE_AGENT); }
__device__ __forceinline__ unsigned xb_add(unsigned* p, unsigned v) { return __hip_atomic_fetch_add(p, v, __ATOMIC_RELAXED, __HIP_MEMORY_SCOPE_AGENT); }
__device__ __forceinline__ unsigned xb_xcc_id() { return (unsigned)__builtin_amdgcn_s_getreg((3 << 11) | 20) & 0xFu; }
#define XB_SPIN(cond, bar) do { unsigned _sp = 0; while (cond) { __builtin_amdgcn_s_sleep(1); \
    if ((++_sp & 255u) == 0u) { if (xb_ld(&(bar)[XB_TMO])) break; if (_sp > XB_SPIN_CAP) { atomicAdd(&(bar)[XB_TMO], 1u); break; } } } } while (0)

struct XcdBarrier {
    unsigned* bar; unsigned x;
    volatile LAS unsigned* st;
};

__device__ __forceinline__ XcdBarrier xcd_barrier_post(unsigned* bar, volatile LAS unsigned* st) {
    XcdBarrier b; b.bar = bar; b.x = xb_xcc_id(); b.st = st;
    if (threadIdx.x == 0) (void)xb_add(&bar[XB_XCNT(b.x)], 1u);
    return b;
}
__device__ __forceinline__ void xcd_barrier_complete(unsigned* bar, unsigned x, unsigned& nloc, unsigned& nx) {
    const unsigned G = gridDim.x * gridDim.y * gridDim.z;
    unsigned sum, cnt, mine, sp = 0u;
    for (;;) {
        sum = 0u; cnt = 0u; mine = 0u;
#pragma unroll
        for (unsigned j = 0; j < 16; ++j) { const unsigned c = xb_ld(&bar[XB_XCNT(j)]); sum += c; cnt += (c > 0u) ? 1u : 0u; mine = (j == x) ? c : mine; }
        if (sum == G) break;
        __builtin_amdgcn_s_sleep(1);
        if ((++sp & 255u) == 0u) { if (xb_ld(&bar[XB_TMO])) break; if (sp > XB_SPIN_CAP) { atomicAdd(&bar[XB_TMO], 1u); break; } }
    }
    nloc = mine > 0u ? mine : 1u; nx = cnt > 0u ? cnt : 1u;
}

__device__ __forceinline__ void xcd_barrier(const XcdBarrier& b) {
    asm volatile("s_waitcnt vmcnt(0)" ::: "memory");
    __syncthreads();
    if (threadIdx.x == 0) {
        unsigned* bar = b.bar;
        __builtin_amdgcn_s_waitcnt(0);
        unsigned nloc = b.st[0], nx = b.st[1];
        if (nloc == 0u) { xcd_barrier_complete(bar, b.x, nloc, nx); b.st[0] = nloc; b.st[1] = nx; }
        const unsigned old = xb_add(&bar[XB_XSUB(b.x)], 1u);
        const unsigned gen = old / nloc;
        if (old + 1u == (gen + 1u) * nloc) {
            __builtin_amdgcn_fence(__ATOMIC_RELEASE, "agent");
            asm volatile("s_waitcnt vmcnt(0)" ::: "memory");
            const unsigned og = xb_add(&bar[XB_TOP], 1u);
            const unsigned tg = og / nx;
            if (og + 1u == (tg + 1u) * nx) xb_add(&bar[XB_TOPGEN], 1u);
            else XB_SPIN(xb_ld(&bar[XB_TOPGEN]) == tg, bar);
            __builtin_amdgcn_fence(__ATOMIC_ACQUIRE, "agent");
            xb_add(&bar[XB_XGEN(b.x)], 1u);
            asm volatile("s_waitcnt vmcnt(0)" ::: "memory");
        } else {
            XB_SPIN(xb_ld(&bar[XB_XGEN(b.x)]) == gen, bar);
            __builtin_amdgcn_fence(__ATOMIC_ACQUIRE, "agent");
            asm volatile("s_waitcnt vmcnt(0)" ::: "memory");
        }
    }
    __syncthreads();
}

typedef float f32x2 __attribute__((ext_vector_type(2)));
struct Args { const float* in[32]; float* out; unsigned char* ws; int ph_lo, ph_hi, use_bar, pad; };
struct Frame {
    LAS unsigned char* lds;
    volatile LAS unsigned* MISC;
    gu32* ctl;
    int tid, lane, wave;
    int vcu, G;
    float* out;
    unsigned char* ws;
};
enum { I_X = 0, I_MEM, I_POS, I_NORM_MIX, I_W_IN, I_B_GATE, I_AQ_GAIN, I_AK_GAIN, I_R_MU, I_R_W0, I_R_W2, I_R_A0, I_R_A2, I_R_G2, I_R_KK, I_R_KA, I_R_RK, I_R_LNW, I_R_LNB,
       I_MEM_NORM, I_W_MEMKV, I_CQ_GAIN, I_CK_GAIN, I_W_BRANCH, I_W_OUT, I_NORM_FFN, I_ROUTER_W, I_ROUTER_B, I_EXP_W1, I_EXP_B1, I_EXP_W2, I_EXP_B2 };

__device__ __forceinline__ float bf_lo(unsigned w) { return __builtin_bit_cast(float, w << 16); }
__device__ __forceinline__ float bf_hi(unsigned w) { return __builtin_bit_cast(float, w & 0xffff0000u); }
__device__ __forceinline__ float sigm(float x) { return 1.0f / (1.0f + __expf(-x)); }
template <int CTRL, int RM> __device__ __forceinline__ float dpp0(float v) {
    return __builtin_bit_cast(float, __builtin_amdgcn_update_dpp(0, __builtin_bit_cast(int, v), CTRL, RM, 0xf, true)); }
__device__ __forceinline__ float row16_sum(float v) {
    v += dpp0<0xB1, 0xf>(v); v += dpp0<0x4E, 0xf>(v); v += dpp0<0x141, 0xf>(v); v += dpp0<0x140, 0xf>(v); return v; }
__device__ __forceinline__ float rdlane(float v, int l) { return __builtin_bit_cast(float, __builtin_amdgcn_readlane(__builtin_bit_cast(int, v), l)); }
__device__ __forceinline__ float wave_sum(float v) {
    v = row16_sum(v); v += dpp0<0x142, 0xA>(v); v += dpp0<0x143, 0xC>(v); return rdlane(v, 63); }
__device__ __forceinline__ void half_sums(float v, float& lo, float& hi) {
    v = row16_sum(v); v += dpp0<0x142, 0xA>(v); lo = rdlane(v, 31); hi = rdlane(v, 63); }
__device__ __forceinline__ float wave_max_bp(float v) {
#pragma unroll
    for (int o = 1; o < 64; o <<= 1) v = fmaxf(v, __shfl_xor(v, o));
    return v; }

__device__ __forceinline__ void tconv_tile(const float* W, int K, int N, bf16* WT, int k0, int n0, int rowbase, int lane) {
    const int c = lane & 15, q = lane >> 4;
    const GAS f32x4* src = (const GAS f32x4*)(W + (size_t)(k0 + 16 * q) * N + n0 + 4 * c);
    const size_t rs = (size_t)N / 4;
    f32x4 v[16];
#pragma unroll
    for (int i = 0; i < 16; ++i) v[i] = src[i * rs];
#pragma unroll
    for (int j = 0; j < 4; ++j) {
        GAS v4u* dst = (GAS v4u*)(WT + (size_t)(rowbase + 4 * c + j) * K + k0 + 16 * q);
        v4u o0, o1;
        o0.x = pk2(v[0][j], v[1][j]); o0.y = pk2(v[2][j], v[3][j]); o0.z = pk2(v[4][j], v[5][j]); o0.w = pk2(v[6][j], v[7][j]);
        o1.x = pk2(v[8][j], v[9][j]); o1.y = pk2(v[10][j], v[11][j]); o1.z = pk2(v[12][j], v[13][j]); o1.w = pk2(v[14][j], v[15][j]);
        dst[0] = o0; dst[1] = o1;
    }
}
__device__ __forceinline__ void rms_row_to_bf16(const float* xrow, const float* gain, bf16* orow, int lane) {
    const GAS f32x4* xr = (const GAS f32x4*)xrow + lane; const GAS f32x4* gr = (const GAS f32x4*)gain + lane;
    f32x4 v[4]; float s = 0.f;
#pragma unroll
    for (int j = 0; j < 4; ++j) { v[j] = xr[64 * j]; s += (v[j].x * v[j].x + v[j].y * v[j].y) + (v[j].z * v[j].z + v[j].w * v[j].w); }
    const float rstd = 1.0f / sqrtf(wave_sum(s) * (1.f / D_MODEL) + NORM_EPS);
    GAS unsigned long long* o8 = (GAS unsigned long long*)orow + lane;
#pragma unroll
    for (int j = 0; j < 4; ++j) { const f32x4 g = gr[64 * j];
        o8[64 * j] = (unsigned long long)pk2(v[j].x * rstd * g.x, v[j].y * rstd * g.y) | ((unsigned long long)pk2(v[j].z * rstd * g.z, v[j].w * rstd * g.w) << 32); }
}
__device__ __forceinline__ void p0_prologue(Frame& F, const Args& args) {
    const int gw = F.vcu * NWAVES + F.wave, NGW = F.G * NWAVES, lane = F.lane;
    unsigned char* ws = F.ws;
    constexpr int T_IN = 16 * 156, T_WB = 3 * 128, T_WO = 256, T_WM = 256, T_W1 = 32 * 512, T_W2 = 32 * 256;
    constexpr int NT = T_IN + T_WB + T_WO + T_WM + T_W1 + T_W2;
    for (int it = gw; it < NT; it += NGW) {
        int r = it;
        if (r < T_IN) { const int kb = r / 156, nb = r % 156; tconv_tile(args.in[I_W_IN], 1024, IN_COLS, (bf16*)(ws + WS_WIN), 64 * kb, 64 * nb, 64 * nb, lane); continue; } r -= T_IN;
        if (r < T_WB) { const int b = r / 128, q = r % 128, kb = q / 16, nb = q % 16;
            tconv_tile(args.in[I_W_BRANCH] + (size_t)b * 512 * 1024, 512, 1024, (bf16*)(ws + WS_WB) + (size_t)b * 1024 * 512, 64 * kb, 64 * nb, 64 * nb, lane); continue; } r -= T_WB;
        if (r < T_WO) { const int kb = r / 16, nb = r % 16; tconv_tile(args.in[I_W_OUT], 1024, 1024, (bf16*)(ws + WS_WO), 64 * kb, 64 * nb, 64 * nb, lane); continue; } r -= T_WO;
        if (r < T_WM) { const int kb = r / 16, nb = r % 16; tconv_tile(args.in[I_W_MEMKV], 1024, 1024, (bf16*)(ws + WS_WMEM), 64 * kb, 64 * nb, 64 * nb, lane); continue; } r -= T_WM;
        if (r < T_W1) { const int e = r / 512, q = r % 512, kb = q / 32, nb = q % 32, n0 = 64 * nb;
            const int rowbase = (n0 < 1024) ? ((n0 >> 7) * 256 + (n0 & 127)) : ((((n0 - 1024) >> 7) * 256) + 128 + ((n0 - 1024) & 127));
            tconv_tile(args.in[I_EXP_W1] + (size_t)e * 1024 * 2048, 1024, 2048, (bf16*)(ws + WS_W1) + (size_t)e * 2048 * 1024, 64 * kb, n0, rowbase, lane); continue; } r -= T_W1;
        { const int e = r / 256, q = r % 256, kb = q / 16, nb = q % 16;
            tconv_tile(args.in[I_EXP_W2] + (size_t)e * 1024 * 1024, 1024, 1024, (bf16*)(ws + WS_W2) + (size_t)e * 1024 * 1024, 64 * kb, 64 * nb, 64 * nb, lane); }
    }
    for (int m = gw; m < MTOK; m += NGW) rms_row_to_bf16(args.in[I_X] + (size_t)m * D_MODEL, args.in[I_NORM_MIX], (bf16*)(ws + WS_XN) + (size_t)m * D_MODEL, lane);
    for (int m = gw; m < MEMROWS; m += NGW) rms_row_to_bf16(args.in[I_MEM] + (size_t)m * D_MODEL, args.in[I_MEM_NORM], (bf16*)(ws + WS_MEMN) + (size_t)m * D_MODEL, lane);
}

__device__ __forceinline__ void head_norm(bf16* p, const float* gain, bool rot, float c0, float s0, float c1, float s1, float scale, int lane) {
    GAS unsigned* pw = (GAS unsigned*)p + lane;
    const unsigned w = *pw; float a = bf_lo(w), b = bf_hi(w);
    const float ss = wave_sum(a * a + b * b);
    const float rstd = 1.0f / sqrtf(ss * (1.f / 128.f) + NORM_EPS);
    const f32x2 g = *((const GAS f32x2*)gain + lane);
    a = a * rstd * g.x; b = b * rstd * g.y;
    const float pa = __shfl_xor(a, 8), pb = __shfl_xor(b, 8);
    if (rot && lane < 16) {
        if (lane < 8) { a = a * c0 - pa * s0; b = b * c1 - pb * s1; }
        else          { a = a * c0 + pa * s0; b = b * c1 + pb * s1; }
    }
    *pw = pk2(a * scale, b * scale);
}
__device__ __forceinline__ void p2_prep(Frame& F, const Args& args) {
    const int gw = F.vcu * NWAVES + F.wave, NGW = F.G * NWAVES, lane = F.lane;
    unsigned char* ws = F.ws;
    bf16* Z = (bf16*)(ws + WS_Z);
    LAS float* lo = (LAS float*)(F.lds + RING_OFF + F.wave * 8192);
    const float* mu = args.in[I_R_MU];
    float* Rr = (float*)(ws + WS_RW); float* Rw = Rr + (size_t)MTOK * RW; float* Rk = Rw + (size_t)MTOK * RW; float* Rv = Rk + (size_t)MTOK * RW;
    float* Ra = Rv + (size_t)MTOK * RW; float* Rb = Ra + (size_t)MTOK * RW; float* Rg = Rb + (size_t)MTOK * RW;
    for (int task = gw; task < MTOK / 4; task += NGW) {
        const int m0 = task * 4, tpos0 = m0 % SEQ, bb = m0 / SEQ;
        for (int tt = 0; tt < 4; ++tt) {
            const int m = m0 + tt;
            const float pos = (float)((const int*)args.in[I_POS])[m];
            const int i0 = 2 * (lane & 7);
            const float f0 = exp2f(-(float)i0 * (18.931568569324174f / 16.0f)), f1 = exp2f(-(float)(i0 + 1) * (18.931568569324174f / 16.0f));
            float s0, c0, s1, c1; sincosf(pos * f0, &s0, &c0); sincosf(pos * f1, &s1, &c1);
            bf16* zr = Z + (size_t)m * IN_COLS;
            for (int hd = 0; hd < 12; ++hd) head_norm(zr + OFF_AQ + hd * 128, args.in[I_AQ_GAIN], true, c0, s0, c1, s1, ATT_QSCALE, lane);
            for (int hd = 0; hd < 12; ++hd) head_norm(zr + OFF_AK + hd * 128, args.in[I_AK_GAIN], true, c0, s0, c1, s1, 1.0f, lane);
            for (int hd = 0; hd < 4; ++hd)  head_norm(zr + OFF_CQ + hd * 128, args.in[I_CQ_GAIN], false, c0, s0, c1, s1, ATT_QSCALE, lane);
        }
#pragma unroll
        for (int i = 0; i < 4; ++i) { const int j = lane + 64 * i; const int col = OFF_R + 1536 + j; const float muj = mu[1536 + j];
            float prv = (tpos0 == 0) ? 0.f : __builtin_bit_cast(float, (unsigned)Z[(size_t)(m0 - 1) * IN_COLS + col] << 16);
#pragma unroll
            for (int tt = 0; tt < 4; ++tt) { const float cur = __builtin_bit_cast(float, (unsigned)Z[(size_t)(m0 + tt) * IN_COLS + col] << 16);
                float x = cur + (prv - cur) * muj; prv = cur;
                x = (i == 0) ? tanhf(x) : (i == 1) ? x : sigm(x);
                lo[j * 4 + tt] = x; } }
        LDS_WAIT(); asm volatile("" ::: "memory");
        float accw[4][8], acca[4][8], accg[4][8];
#pragma unroll
        for (int tt = 0; tt < 4; ++tt)
#pragma unroll
            for (int c = 0; c < 8; ++c) { accw[tt][c] = 0.f; acca[tt][c] = 0.f; accg[tt][c] = 0.f; }
        { const float* W2 = args.in[I_R_W2];
          for (int j = 0; j < 64; ++j) { const f32x4 xin = *(const LAS f32x4*)(lo + j * 4);
#pragma unroll
              for (int i = 0; i < 4; ++i) { const f32x2 wv = *(const GAS f32x2*)(W2 + (size_t)j * RW + 2 * lane + 128 * i);
#pragma unroll
                  for (int tt = 0; tt < 4; ++tt) { accw[tt][2 * i] += xin[tt] * wv.x; accw[tt][2 * i + 1] += xin[tt] * wv.y; } } } }
        { const float* A2 = args.in[I_R_A2];
          for (int j = 0; j < 64; ++j) { const f32x4 xin = *(const LAS f32x4*)(lo + (64 + j) * 4);
#pragma unroll
              for (int i = 0; i < 4; ++i) { const f32x2 wv = *(const GAS f32x2*)(A2 + (size_t)j * RW + 2 * lane + 128 * i);
#pragma unroll
                  for (int tt = 0; tt < 4; ++tt) { acca[tt][2 * i] += xin[tt] * wv.x; acca[tt][2 * i + 1] += xin[tt] * wv.y; } } } }
        { const float* G2 = args.in[I_R_G2];
          for (int j = 0; j < 128; ++j) { const f32x4 xin = *(const LAS f32x4*)(lo + (128 + j) * 4);
#pragma unroll
              for (int i = 0; i < 4; ++i) { const f32x2 wv = *(const GAS f32x2*)(G2 + (size_t)j * RW + 2 * lane + 128 * i);
#pragma unroll
                  for (int tt = 0; tt < 4; ++tt) { accg[tt][2 * i] += xin[tt] * wv.x; accg[tt][2 * i + 1] += xin[tt] * wv.y; } } } }
        asm volatile("" ::: "memory");
#pragma unroll
        for (int i = 0; i < 4; ++i) {
            const int c = 2 * lane + 128 * i;
            const f32x2 w0 = *(const GAS f32x2*)(args.in[I_R_W0] + c), a0 = *(const GAS f32x2*)(args.in[I_R_A0] + c), kkc = *(const GAS f32x2*)(args.in[I_R_KK] + c), kac = *(const GAS f32x2*)(args.in[I_R_KA] + c);
            const f32x2 mur = *(const GAS f32x2*)(mu + c), muk = *(const GAS f32x2*)(mu + 512 + c), muv = *(const GAS f32x2*)(mu + 1024 + c);
            unsigned pr = 0u, pk = 0u, pv = 0u;
            if (tpos0 != 0) { const bf16* zp = Z + (size_t)(m0 - 1) * IN_COLS + OFF_R + c; pr = *(const GAS unsigned*)zp; pk = *(const GAS unsigned*)(zp + 512); pv = *(const GAS unsigned*)(zp + 1024); }
#pragma unroll
            for (int tt = 0; tt < 4; ++tt) {
                const size_t m = (size_t)(m0 + tt);
                const bf16* zc = Z + m * IN_COLS + OFF_R + c;
                const unsigned cr = *(const GAS unsigned*)zc, ck = *(const GAS unsigned*)(zc + 512), cv = *(const GAS unsigned*)(zc + 1024);
                f32x2 r, k, v;
                r.x = bf_lo(cr) + (bf_lo(pr) - bf_lo(cr)) * mur.x; r.y = bf_hi(cr) + (bf_hi(pr) - bf_hi(cr)) * mur.y;
                k.x = bf_lo(ck) + (bf_lo(pk) - bf_lo(ck)) * muk.x; k.y = bf_hi(ck) + (bf_hi(pk) - bf_hi(ck)) * muk.y;
                v.x = bf_lo(cv) + (bf_lo(pv) - bf_lo(cv)) * muv.x; v.y = bf_hi(cv) + (bf_hi(pv) - bf_hi(cv)) * muv.y;
                pr = cr; pk = ck; pv = cv;
                f32x2 wd, av;
                { float x0 = w0.x + accw[tt][2 * i], x1 = w0.y + accw[tt][2 * i + 1];
                  float y0 = -x0, y1 = -x1;
                  float sp0 = fmaxf(y0, 0.f) + log1pf(__expf(-fabsf(y0))), sp1 = fmaxf(y1, 0.f) + log1pf(__expf(-fabsf(y1)));
                  wd.x = __expf(-__expf(-sp0 - 0.5f)); wd.y = __expf(-__expf(-sp1 - 0.5f)); }
                av.x = sigm(a0.x + acca[tt][2 * i]); av.y = sigm(a0.y + acca[tt][2 * i + 1]);
                f32x2 kk; kk.x = k.x * kkc.x; kk.y = k.y * kkc.y;
                float slo, shi; half_sums(kk.x * kk.x + kk.y * kk.y, slo, shi);
                const float nrm = fmaxf(sqrtf(lane < 32 ? slo : shi), 1e-12f), inv = 1.0f / nrm;
                kk.x *= inv; kk.y *= inv;
                f32x2 k2; k2.x = k.x * (1.0f + (av.x - 1.0f) * kac.x); k2.y = k.y * (1.0f + (av.y - 1.0f) * kac.y);
                f32x2 as, bs; as.x = -kk.x; as.y = -kk.y; bs.x = kk.x * av.x; bs.y = kk.y * av.y;
                f32x2 gg; gg.x = accg[tt][2 * i]; gg.y = accg[tt][2 * i + 1];
                const size_t o = m * RW + c;
                *(GAS f32x2*)(Rr + o) = r; *(GAS f32x2*)(Rw + o) = wd; *(GAS f32x2*)(Rk + o) = k2; *(GAS f32x2*)(Rv + o) = v;
                *(GAS f32x2*)(Ra + o) = as; *(GAS f32x2*)(Rb + o) = bs; *(GAS f32x2*)(Rg + o) = gg;
            }
        }
        LDS_WAIT(); asm volatile("" ::: "memory");
    }
    for (int m = gw; m < MEMROWS; m += NGW)
        for (int hd = 0; hd < 4; ++hd) head_norm((bf16*)(ws + WS_KVM) + (size_t)m * 1024 + hd * 128, args.in[I_CK_GAIN], false, 1.f, 0.f, 1.f, 0.f, 1.0f, lane);
}

__device__ __forceinline__ float qk_dot(const LAS float* q, const bf16* krow) {
    const GAS v4u* kp = (const GAS v4u*)krow; float s0 = 0.f, s1 = 0.f;
#pragma unroll
    for (int i = 0; i < 16; ++i) { const v4u w = kp[i]; const f32x4 qa = *(const LAS f32x4*)(q + 8 * i), qb = *(const LAS f32x4*)(q + 8 * i + 4);
        s0 += bf_lo(w.x) * qa[0] + bf_hi(w.x) * qa[1] + bf_lo(w.y) * qa[2] + bf_hi(w.y) * qa[3];
        s1 += bf_lo(w.z) * qb[0] + bf_hi(w.z) * qb[1] + bf_lo(w.w) * qb[2] + bf_hi(w.w) * qb[3]; }
    return s0 + s1;
}
__device__ __forceinline__ void p3_attention(Frame& F) {
    const int gw = F.vcu * NWAVES + F.wave, NGW = F.G * NWAVES, lane = F.lane;
    unsigned char* ws = F.ws;
    const bf16* Z = (const bf16*)(ws + WS_Z);
    const bf16* KV = (const bf16*)(ws + WS_KVM);
    bf16* YA = (bf16*)(ws + WS_YABC); bf16* YC = YA + (size_t)2 * MTOK * 512;
    LAS float* qs = (LAS float*)(F.lds + RING_OFF + F.wave * 8192);
    for (int task = gw; task < MTOK * 4; task += NGW) {
        const int m = task >> 2, h = task & 3, t = m % SEQ;
        const bf16* zrow = Z + (size_t)m * IN_COLS;
#pragma unroll
        for (int g = 0; g < 3; ++g) { const unsigned w = *((const GAS unsigned*)(zrow + OFF_AQ + g * 512 + h * 128) + lane); qs[g * 128 + 2 * lane] = bf_lo(w); qs[g * 128 + 2 * lane + 1] = bf_hi(w); }
        LDS_WAIT(); asm volatile("" ::: "memory");
        float sc[3][3]; float mx = -INFINITY;
#pragma unroll
        for (int g = 0; g < 3; ++g) { const int dl = (g == 0) ? 1 : (g == 1) ? 4 : 16;
#pragma unroll
            for (int p = 0; p < 3; ++p) { const int j = lane + 64 * p; const int tk = t - dl * j; float s = -INFINITY;
                if (j <= 128 && tk >= 0) s = qk_dot(qs + g * 128, zrow - (size_t)dl * j * IN_COLS + OFF_AK + g * 512 + h * 128);
                sc[g][p] = s; mx = fmaxf(mx, s); } }
        mx = wave_max_bp(mx);
        float den = 0.f;
#pragma unroll
        for (int g = 0; g < 3; ++g)
#pragma unroll
            for (int p = 0; p < 3; ++p) { sc[g][p] = exp2f(sc[g][p] - mx); den += sc[g][p]; }
        den = wave_sum(den);
        float o0 = 0.f, o1 = 0.f;
#pragma unroll
        for (int g = 0; g < 3; ++g) { const int dl = (g == 0) ? 1 : (g == 1) ? 4 : 16; const bf16* vb = zrow + OFF_AV + g * 512 + h * 128 + 2 * lane;
#pragma unroll
            for (int p = 0; p < 3; ++p) { const int nj = (p < 2) ? 64 : 1;
                for (int jj = 0; jj < nj; ++jj) { const int j = jj + 64 * p; const float pj = rdlane(sc[g][p], jj);
                    if (t - dl * j >= 0) { const unsigned w = *(const GAS unsigned*)(vb - (size_t)dl * j * IN_COLS); o0 += pj * bf_lo(w); o1 += pj * bf_hi(w); } } } }
        const float inv = 1.0f / den;
        *((GAS unsigned*)(YA + (size_t)m * 512 + h * 128) + lane) = pk2(o0 * inv, o1 * inv);
        asm volatile("" ::: "memory");
    }
    for (int task = gw; task < MTOK * 4; task += NGW) {
        const int m = task >> 2, h = task & 3, b = m / SEQ;
        const bf16* zrow = Z + (size_t)m * IN_COLS;
        { const unsigned w = *((const GAS unsigned*)(zrow + OFF_CQ + h * 128) + lane); qs[2 * lane] = bf_lo(w); qs[2 * lane + 1] = bf_hi(w); }
        LDS_WAIT(); asm volatile("" ::: "memory");
        const bf16* kb = KV + (size_t)b * MEM_LEN * 1024 + h * 128;
        float sc[4]; float mx = -INFINITY;
#pragma unroll
        for (int p = 0; p < 4; ++p) { sc[p] = qk_dot(qs, kb + (size_t)(lane + 64 * p) * 1024); mx = fmaxf(mx, sc[p]); }
        mx = wave_max_bp(mx);
        float den = 0.f;
#pragma unroll
        for (int p = 0; p < 4; ++p) { sc[p] = exp2f(sc[p] - mx); den += sc[p]; }
        den = wave_sum(den);
        float o0 = 0.f, o1 = 0.f; const bf16* vb = kb + 512 + 2 * lane;
#pragma unroll
        for (int p = 0; p < 4; ++p)
            for (int jj = 0; jj < 64; ++jj) { const float pj = rdlane(sc[p], jj); const unsigned w = *(const GAS unsigned*)(vb + (size_t)(jj + 64 * p) * 1024); o0 += pj * bf_lo(w); o1 += pj * bf_hi(w); }
        const float inv = 1.0f / den;
        *((GAS unsigned*)(YC + (size_t)m * 512 + h * 128) + lane) = pk2(o0 * inv, o1 * inv);
        asm volatile("" ::: "memory");
    }
}

struct ScanBuf { float r[4], w[4], k[4], a[4], b[4], v[4]; };
__device__ __forceinline__ void scan_load(ScanBuf& B, const float* Rr, const float* Rw, const float* Rk, const float* Rv, const float* Ra, const float* Rb, size_t o, size_t ov) {
#pragma unroll
    for (int i = 0; i < 4; ++i) { const size_t oi = o + (size_t)i * RW;
        B.r[i] = *(const GAS float*)(Rr + oi); B.w[i] = *(const GAS float*)(Rw + oi); B.k[i] = *(const GAS float*)(Rk + oi); B.a[i] = *(const GAS float*)(Ra + oi); B.b[i] = *(const GAS float*)(Rb + oi);
        B.v[i] = *(const GAS float*)(Rv + ov + (size_t)i * RW); }
}
__device__ __forceinline__ void scan_step4(const ScanBuf& B, float& S, float& yk, int lane, int sub) {
#pragma unroll
    for (int i = 0; i < 4; ++i) {
        const float sa = wave_sum(S * B.a[i]);
        S = S * B.w[i] + (sa * B.b[i] + B.v[i] * B.k[i]);
        const float y = wave_sum(S * B.r[i]);
        if (lane == sub * 4 + i) yk = y;
    }
}
__device__ __forceinline__ void p4_scan(Frame& F) {
    unsigned char* ws = F.ws; const int lane = F.lane;
    const float* Rr = (const float*)(ws + WS_RW); const float* Rw = Rr + (size_t)MTOK * RW; const float* Rk = Rw + (size_t)MTOK * RW; const float* Rv = Rk + (size_t)MTOK * RW;
    const float* Ra = Rv + (size_t)MTOK * RW; const float* Rb = Ra + (size_t)MTOK * RW;
    float* YS = (float*)(ws + WS_YS);
    if (F.wave < 4) {
        for (int row = (int)blockIdx.x * 4 + F.wave; row < BATCH * 8 * 64; row += F.G * 4) {
            const int b = row >> 9, h = (row >> 6) & 7, vr = row & 63;
            const size_t base = (size_t)b * SEQ * RW + h * 64 + lane, basev = (size_t)b * SEQ * RW + h * 64 + vr;
            float S = 0.f, yk = 0.f;
            ScanBuf A, B;
            scan_load(A, Rr, Rw, Rk, Rv, Ra, Rb, base, basev);
            for (int t0 = 0; t0 < SEQ; t0 += 8) {
                scan_load(B, Rr, Rw, Rk, Rv, Ra, Rb, base + (size_t)(t0 + 4) * RW, basev + (size_t)(t0 + 4) * RW);
                scan_step4(A, S, yk, lane, 0);
                if (t0 + 8 < SEQ) scan_load(A, Rr, Rw, Rk, Rv, Ra, Rb, base + (size_t)(t0 + 8) * RW, basev + (size_t)(t0 + 8) * RW);
                scan_step4(B, S, yk, lane, 1);
                if (lane < 8) *(GAS float*)(YS + basev + (size_t)(t0 + lane) * RW) = yk;
            }
        }
    }
}

__device__ __forceinline__ void p5_post(Frame& F, const Args& args) {
    const int gw = F.vcu * NWAVES + F.wave, NGW = F.G * NWAVES, lane = F.lane;
    unsigned char* ws = F.ws;
    const float* Rr = (const float*)(ws + WS_RW); const float* Rk = Rr + (size_t)2 * MTOK * RW; const float* Rv = Rk + (size_t)MTOK * RW; const float* Rg = Rr + (size_t)6 * MTOK * RW;
    const float* YS = (const float*)(ws + WS_YS);
    bf16* YB = (bf16*)(ws + WS_YABC) + (size_t)MTOK * 512;
    const bf16* OP = (const bf16*)(ws + WS_OP); const float* LS = (const float*)(ws + WS_LSE); bf16* YA = (bf16*)(ws + WS_YABC);
    for (int m = gw; m < MTOK; m += NGW) {
#pragma unroll
        for (int h = 0; h < 4; ++h) {
            const float l0 = LS[(size_t)m * 4 + h], l1 = LS[(size_t)MTOK * 4 + (size_t)m * 4 + h], l2 = LS[(size_t)2 * MTOK * 4 + (size_t)m * 4 + h];
            const float mx = fmaxf(l0, fmaxf(l1, l2)); const float w0 = exp2f(l0 - mx), w1 = exp2f(l1 - mx), w2 = exp2f(l2 - mx); const float inv = 1.0f / (w0 + w1 + w2);
            const size_t o = (size_t)m * 512 + h * 128;
            const unsigned a = *((const GAS unsigned*)(OP + o) + lane), b = *((const GAS unsigned*)(OP + (size_t)MTOK * 512 + o) + lane), c = *((const GAS unsigned*)(OP + (size_t)2 * MTOK * 512 + o) + lane);
            *((GAS unsigned*)(YA + o) + lane) = pk2((w0 * bf_lo(a) + w1 * bf_lo(b) + w2 * bf_lo(c)) * inv, (w0 * bf_hi(a) + w1 * bf_hi(b) + w2 * bf_hi(c)) * inv); }
#pragma unroll
        for (int h = 0; h < 8; ++h) { const int c = h * 64 + lane; const size_t o = (size_t)m * RW + c;
            const float y = *(const GAS float*)(YS + o), r = *(const GAS float*)(Rr + o), k = *(const GAS float*)(Rk + o), v = *(const GAS float*)(Rv + o), g = *(const GAS float*)(Rg + o);
            const float mean = wave_sum(y) * (1.f / 64.f); const float d = y - mean;
            const float var = wave_sum(d * d) * (1.f / 64.f);
            float yn = d * (1.0f / sqrtf(var + R_GN_EPS)) * args.in[I_R_LNW][c] + args.in[I_R_LNB][c];
            const float bonus = wave_sum(r * k * args.in[I_R_RK][c]) * v;
            YB[(size_t)m * 512 + c] = (bf16)f2bf((yn + bonus) * g); }
    }
}

__device__ __forceinline__ void p8_router(Frame& F, const Args& args) {
    const int gw = F.vcu * NWAVES + F.wave, NGW = F.G * NWAVES, lane = F.lane;
    unsigned char* ws = F.ws;
    const float* X1 = F.out; bf16* XN2 = (bf16*)(ws + WS_XN2);
    int* topi = (int*)(ws + WS_ROUTE + RT_TOPI); float* topg = (float*)(ws + WS_ROUTE + RT_TOPG);
    const float* RWt = args.in[I_ROUTER_W]; const float* RB = args.in[I_ROUTER_B]; const float* gain = args.in[I_NORM_FFN];
    for (int m = gw; m < MTOK; m += NGW) {
        const GAS f32x4* xr = (const GAS f32x4*)(X1 + (size_t)m * D_MODEL) + lane; const GAS f32x4* gr = (const GAS f32x4*)gain + lane;
        f32x4 v[4]; float s = 0.f;
#pragma unroll
        for (int j = 0; j < 4; ++j) { v[j] = xr[64 * j]; s += (v[j].x * v[j].x + v[j].y * v[j].y) + (v[j].z * v[j].z + v[j].w * v[j].w); }
        const float rstd = 1.0f / sqrtf(wave_sum(s) * (1.f / D_MODEL) + NORM_EPS);
        GAS unsigned long long* o8 = (GAS unsigned long long*)(XN2 + (size_t)m * D_MODEL) + lane;
#pragma unroll
        for (int j = 0; j < 4; ++j) { const f32x4 g = gr[64 * j]; v[j] = v[j] * rstd * g;
            o8[64 * j] = (unsigned long long)pk2(v[j].x, v[j].y) | ((unsigned long long)pk2(v[j].z, v[j].w) << 32); }
        float lg[32];
#pragma unroll
        for (int e = 0; e < 32; ++e) lg[e] = 0.f;
#pragma unroll
        for (int j = 0; j < 4; ++j)
#pragma unroll
            for (int i = 0; i < 4; ++i) { const float xv = v[j][i]; const GAS f32x4* wr = (const GAS f32x4*)(RWt + (size_t)(4 * lane + i + 256 * j) * N_EXPERTS);
#pragma unroll
                for (int q = 0; q < 8; ++q) { const f32x4 w = wr[q]; lg[4 * q] += xv * w.x; lg[4 * q + 1] += xv * w.y; lg[4 * q + 2] += xv * w.z; lg[4 * q + 3] += xv * w.w; } }
#pragma unroll
        for (int e = 0; e < 32; ++e) lg[e] = wave_sum(lg[e]) + RB[e];
        int ti[4]; float tv[4];
#pragma unroll
        for (int k = 0; k < 4; ++k) { float best = -INFINITY; int bi = 0;
#pragma unroll
            for (int e = 0; e < 32; ++e) { const bool taken = (k > 0 && ti[0] == e) || (k > 1 && ti[1] == e) || (k > 2 && ti[2] == e); if (!taken && lg[e] > best) { best = lg[e]; bi = e; } }
            ti[k] = bi; tv[k] = best; }
        const float e0 = 1.f, e1 = __expf(tv[1] - tv[0]), e2 = __expf(tv[2] - tv[0]), e3 = __expf(tv[3] - tv[0]); const float inv = 1.0f / (e0 + e1 + e2 + e3);
        if (lane < 4) { const int k = lane; const int e = (k == 0) ? ti[0] : (k == 1) ? ti[1] : (k == 2) ? ti[2] : ti[3]; const float gq = ((k == 0) ? e0 : (k == 1) ? e1 : (k == 2) ? e2 : e3) * inv;
            topi[(size_t)m * 4 + k] = e; topg[(size_t)m * 4 + k] = gq;
            __hip_atomic_fetch_add((unsigned*)(F.ctl + CW_CNT) + e, 1u, __ATOMIC_RELAXED, __HIP_MEMORY_SCOPE_AGENT); }
    }
}
__device__ __forceinline__ void moe_table(Frame& F) {
    LAS int* tab = (LAS int*)(F.lds + MOETAB_OFF);
    __syncthreads();
    if (F.tid == 0) { int acc = 0;
        for (int e = 0; e < N_EXPERTS; ++e) { const int c = (int)__hip_atomic_load((unsigned*)(F.ctl + CW_CNT) + e, __ATOMIC_RELAXED, __HIP_MEMORY_SCOPE_AGENT); const int nb = (c + MOE_ROWS - 1) / MOE_ROWS;
            tab[320 + e] = acc * MOE_ROWS; for (int q = 0; q < nb; ++q) tab[1 + acc + q] = e; acc += nb; }
        tab[0] = acc; }
    __syncthreads();
}
__device__ __forceinline__ void p9_dispatch(Frame& F) {
    const int gw = F.vcu * NWAVES + F.wave, NGW = F.G * NWAVES, lane = F.lane;
    unsigned char* ws = F.ws;
    moe_table(F);
    const LAS int* tab = (const LAS int*)(F.lds + MOETAB_OFF);
    const int* topi = (const int*)(ws + WS_ROUTE + RT_TOPI); const float* topg = (const float*)(ws + WS_ROUTE + RT_TOPG);
    int* pos = (int*)(ws + WS_ROUTE + RT_POS); float* rowgate = (float*)(ws + WS_ROUTE + RT_ROWGATE);
    const bf16* XN2 = (const bf16*)(ws + WS_XN2); bf16* XS = (bf16*)(ws + WS_XS);
    for (int m = gw; m < MTOK; m += NGW) {
        int slot = 0;
        if (lane < 4) { const int e = topi[(size_t)m * 4 + lane];
            slot = tab[320 + e] + (int)__hip_atomic_fetch_add((unsigned*)(F.ctl + CW_CUR) + e, 1u, __ATOMIC_RELAXED, __HIP_MEMORY_SCOPE_AGENT);
            pos[(size_t)m * 4 + lane] = slot; rowgate[slot] = topg[(size_t)m * 4 + lane]; }
        const GAS v4u* src = (const GAS v4u*)(XN2 + (size_t)m * D_MODEL) + lane; const v4u a = src[0], b = src[64];
#pragma unroll
        for (int k = 0; k < 4; ++k) { const int sk = __builtin_amdgcn_readlane(slot, k); GAS v4u* dst = (GAS v4u*)(XS + (size_t)sk * D_MODEL) + lane; dst[0] = a; dst[64] = b; }
    }
}
__device__ __forceinline__ void p12_combine(Frame& F) {
    const int gw = F.vcu * NWAVES + F.wave, NGW = F.G * NWAVES, lane = F.lane;
    unsigned char* ws = F.ws;
    const int* pos = (const int*)(ws + WS_ROUTE + RT_POS); const bf16* YR = (const bf16*)(ws + WS_YROWS);
    for (int m = gw; m < MTOK; m += NGW) {
        GAS f32x4* xo = (GAS f32x4*)(F.out + (size_t)m * D_MODEL) + 2 * lane;
        int pk = 0; if (lane < 4) pk = pos[(size_t)m * 4 + lane];
#pragma unroll
        for (int hf = 0; hf < 2; ++hf) { f32x4 a = xo[128 * hf], b = xo[128 * hf + 1];
#pragma unroll
            for (int k = 0; k < 4; ++k) { const int sk = __builtin_amdgcn_readlane(pk, k); const v4u w = *((const GAS v4u*)(YR + (size_t)sk * D_MODEL + 512 * hf) + lane);
                a[0] += bf_lo(w.x); a[1] += bf_hi(w.x); a[2] += bf_lo(w.y); a[3] += bf_hi(w.y); b[0] += bf_lo(w.z); b[1] += bf_hi(w.z); b[2] += bf_lo(w.w); b[3] += bf_hi(w.w); }
            xo[128 * hf] = a; xo[128 * hf + 1] = b; }
    }
}

constexpr int N_ATT_A = 768, N_ATT_C = 256;
__device__ __forceinline__ swa::BlockRef attn_item(unsigned char* ws, int it) {
    swa::BlockRef r;
    const swa::bf16* Z = (const swa::bf16*)(ws + WS_Z);
    if (it < N_ATT_A) {
        const int h = it & 3, b = (it >> 2) & 1, v = it >> 3;
        int g, rr, qb;
        if (v < 32) { g = 0; rr = 0; qb = v; } else if (v < 64) { g = 1; rr = (v - 32) >> 3; qb = (v - 32) & 7; } else { g = 2; rr = (v - 64) >> 1; qb = (v - 64) & 1; }
        const int d = (g == 0) ? 1 : (g == 1) ? 4 : 16;
        const size_t row0 = (size_t)b * SEQ + rr, qrow = row0 + (size_t)d * qb * 256;
        r.Q = Z + qrow * IN_COLS + OFF_AQ + g * 512 + h * 128; r.K = Z + row0 * IN_COLS + OFF_AK + g * 512 + h * 128; r.V = Z + row0 * IN_COLS + OFF_AV + g * 512 + h * 128;
        r.O = (swa::bf16*)(ws + WS_OP) + (size_t)g * MTOK * 512 + qrow * 512 + h * 128; r.LSE = (float*)(ws + WS_LSE) + (size_t)g * MTOK * 4 + qrow * 4 + h;
        r.QS = d * IN_COLS; r.KS = d * IN_COLS; r.OS = d * 512; r.LS = d * 4; r.P0 = qb * 256; r.skv = SEQ / d; r.W = 129;
    } else {
        const int u = it - N_ATT_A, h = u & 3, b = (u >> 2) & 1, qb = u >> 3;
        const size_t qrow = (size_t)b * SEQ + (size_t)qb * 256;
        const swa::bf16* KV = (const swa::bf16*)(ws + WS_KVM) + (size_t)b * MEM_LEN * 1024 + h * 128;
        r.Q = Z + qrow * IN_COLS + OFF_CQ + h * 128; r.K = KV; r.V = KV + 512;
        r.O = (swa::bf16*)(ws + WS_YABC) + (size_t)2 * MTOK * 512 + qrow * 512 + h * 128; r.LSE = nullptr;
        r.QS = IN_COLS; r.KS = 1024; r.OS = 512; r.LS = 0; r.P0 = 256; r.skv = MEM_LEN; r.W = 1 << 20;
    }
    return r;
}
__device__ __forceinline__ void p3_attention_mfma(unsigned char* ws, char* lds, int G) {
    const int total = N_ATT_A + N_ATT_C; int L = blockIdx.x; if (L >= total) return;
    swa::BlockRef cur = attn_item(ws, L); swa::Seam S;
    swa::swa_prime(cur, lds, S);
    for (;;) {
        const int Ln = L + G; const bool last = Ln >= total;
        const swa::BlockRef nxt = last ? cur : attn_item(ws, Ln);
        swa::swa_block(cur, nxt, lds, S);
        if (last) break;
        cur = nxt; L = Ln;
    }
}

__global__ void __launch_bounds__(NWAVES * 64, 2) skel_fwd(Args args) {
    extern __shared__ __attribute__((aligned(16))) unsigned char lds[];
    Frame F;
    F.lds = (LAS unsigned char*)lds;
    F.MISC = (volatile LAS unsigned*)(F.lds + MISC_OFF);
    F.tid = threadIdx.x; F.lane = F.tid & 63; F.wave = __builtin_amdgcn_readfirstlane(F.tid >> 6);
    F.G = gridDim.x; { const int bx = blockIdx.x; F.vcu = (F.G % 8 == 0) ? (bx % 8) * (F.G / 8) + bx / 8 : bx; }
    unsigned char* ws = args.ws; F.ws = ws; F.out = args.out;
    F.ctl = (gu32*)(ws + WS_CTL);
    for (int u = F.tid; u < (LDS_BYTES - LDSCTL_OFF) / 4; u += NWAVES * 64) ((LAS unsigned*)(F.lds + LDSCTL_OFF))[u] = 0u;
    __syncthreads();
    XcdBarrier bar; bar.bar = (unsigned*)(F.ctl + CW_BAR); bar.x = 0; bar.st = nullptr;
    if (args.use_bar) bar = xcd_barrier_post((unsigned*)(F.ctl + CW_BAR), F.MISC + 8);
    const int lo = args.ph_lo, hi = args.ph_hi;
#define IN(k) (lo <= (k) && (k) < hi)
#define SEAM(k) do { if (IN(k) && IN((k) + 1)) xcd_barrier(bar); } while (0)
    const pg8::bf16_t* wsb = (const pg8::bf16_t*)ws;
#define BF(off) ((pg8::bf16_t*)(ws + (off)))

    if (IN(0)) { p0_prologue(F, args); } SEAM(0);
    if (IN(1)) {
        { pg8::Gemm g{BF(WS_XN), BF(WS_WIN), MTOK, IN_COLS, 1024}; pg8::StaticOrder S; S.init(MTOK, IN_COLS, F.G, (int)blockIdx.x);
          pg8::EpiBf16<0> E{BF(WS_Z), IN_COLS, nullptr, 0, 0, 1.f};
          pg8::gemm_phase<pg8::EpiBf16<0>, pg8::StaticOrder, true, true>(F.lds + RING_OFF, g, S, E); }
        { pg8::Gemm g{BF(WS_MEMN), BF(WS_WMEM), MEMROWS, 1024, 1024}; pg8::StaticOrder S; S.init(MEMROWS, 1024, F.G, (int)blockIdx.x);
          pg8::EpiBf16<0> E{BF(WS_KVM), 1024, nullptr, 0, 0, 1.f};
          pg8::gemm_phase<pg8::EpiBf16<0>, pg8::StaticOrder, true, true>(F.lds + RING_OFF, g, S, E); }
    } SEAM(1);
    if (IN(2)) { p2_prep(F, args); } SEAM(2);
#if NAIVE_ATTN
    if (IN(3)) { p3_attention(F); } SEAM(3);
#else
    if (IN(3)) { p3_attention_mfma(ws, (char*)lds + RING_OFF, F.G); } SEAM(3);
#endif
    if (IN(4)) { p4_scan(F); } SEAM(4);
    if (IN(5)) { p5_post(F, args); } SEAM(5);
    if (IN(6)) {
        for (int br = 0; br < 3; ++br) {
            pg8::Gemm g{BF(WS_YABC) + (size_t)br * MTOK * 512, BF(WS_WB) + (size_t)br * 1024 * 512, MTOK, 1024, 512}; pg8::StaticOrder S; S.init(MTOK, 1024, F.G, (int)blockIdx.x);
            pg8::EpiGate E{BF(WS_Z), args.in[I_B_GATE], (float*)(ws + WS_MRG), BF(WS_MRGB), br};
            pg8::gemm_phase<pg8::EpiGate, pg8::StaticOrder, true, true>(F.lds + RING_OFF, g, S, E);
        }
    } SEAM(6);
    if (IN(7)) {
        pg8::Gemm g{BF(WS_MRGB), BF(WS_WO), MTOK, 1024, 1024}; pg8::StaticOrder S; S.init(MTOK, 1024, F.G, (int)blockIdx.x);
        pg8::EpiResF32 E{args.in[I_X], F.out, 1024};
        pg8::gemm_phase<pg8::EpiResF32, pg8::StaticOrder, true, true>(F.lds + RING_OFF, g, S, E);
    } SEAM(7);
    if (IN(8)) { p8_router(F, args); } SEAM(8);
    if (IN(9)) { p9_dispatch(F); } SEAM(9);
    if (IN(10)) {
        moe_table(F);
        pg8::Gemm g{BF(WS_XS), BF(WS_W1), 0, 0, 1024}; pg8::MoeOrder S{(const PG8_LAS int*)(F.lds + MOETAB_OFF), 8, F.G, (int)blockIdx.x};
        pg8::EpiSwiGLU E{args.in[I_EXP_B1], BF(WS_HACT)};
        pg8::gemm_phase<pg8::EpiSwiGLU, pg8::MoeOrder, true, true>(F.lds + RING_OFF, g, S, E);
    } SEAM(10);
    if (IN(11)) {
        moe_table(F);
        pg8::Gemm g{BF(WS_HACT), BF(WS_W2), 0, 0, 1024}; pg8::MoeOrder S{(const PG8_LAS int*)(F.lds + MOETAB_OFF), 4, F.G, (int)blockIdx.x};
        pg8::EpiMoeOut E{args.in[I_EXP_B2], (const float*)(ws + WS_ROUTE + RT_ROWGATE), BF(WS_YROWS)};
        pg8::gemm_phase<pg8::EpiMoeOut, pg8::MoeOrder, true, true>(F.lds + RING_OFF, g, S, E);
    } SEAM(11);
    if (IN(12)) { p12_combine(F); }
#undef IN
#undef SEAM
#undef BF
    (void)wsb;
}

extern "C" void kernel_launch(void* const* d_in, const int* in_sizes, int n_in, void* d_out, int out_size, void* d_ws, size_t ws_size, hipStream_t stream) {
    static int grid = 0;
    if (grid == 0) {
        if (n_in != 32 || out_size != MTOK * D_MODEL || ws_size < WS_END) { fprintf(stderr, "kernel_launch: unexpected problem (n_in %d, out %d, ws %zu); nothing launched\n", n_in, out_size, ws_size); grid = -1; return; }
        int dev = 0, cus = 0;
        if (hipGetDevice(&dev) != hipSuccess || hipDeviceGetAttribute(&cus, hipDeviceAttributeMultiprocessorCount, dev) != hipSuccess) { grid = -1; return; }
        if (hipFuncSetAttribute((const void*)skel_fwd, hipFuncAttributeMaxDynamicSharedMemorySize, LDS_BYTES) != hipSuccess) { fprintf(stderr, "kernel_launch: hipFuncSetAttribute failed\n"); grid = -1; return; }
        (void)hipGetLastError();
        grid = cus;
    }
    if (grid < 0) return;
    (void)hipMemsetAsync((char*)d_ws + WS_CTL, 0, CTL_ZERO_BYTES, stream);
    Args a{};
    for (int i = 0; i < 32; ++i) a.in[i] = (const float*)d_in[i];
    a.out = (float*)d_out; a.ws = (unsigned char*)d_ws;
#if MK_N_LAUNCHES == 1
    a.ph_lo = 0; a.ph_hi = N_PHASES; a.use_bar = 1;
    hipLaunchKernelGGL(skel_fwd, dim3(grid), dim3(NWAVES * 64), LDS_BYTES, stream, a);
#else
    for (int p = 0; p < N_PHASES; ++p) { a.ph_lo = p; a.ph_hi = p + 1; a.use_bar = 0;
        hipLaunchKernelGGL(skel_fwd, dim3(grid), dim3(NWAVES * 64), LDS_BYTES, stream, a); }
#endif
}
```

```cpp
#include <hip/hip_runtime.h>
#include <cstdio>
#include <cstdint>
#include <cmath>
namespace pg8 {
#define PG8_LAS __attribute__((address_space(3)))
typedef unsigned short bf16_t;
typedef short bf16x8 __attribute__((ext_vector_type(8)));
typedef float f32x4 __attribute__((ext_vector_type(4)));
typedef unsigned u32x4 __attribute__((ext_vector_type(4)));
constexpr int BM = 256, BK = 64, HALF = 128, HTB = HALF * BK * 2  , STAGE_BYTES = 8 * HTB, NXCD = 8, WGM = 8;

__host__ __device__ __forceinline__ int lds_byte(int r, int c) { const int st = (r >> 4) * 2 + (c >> 5), rr = r & 15, cc = c & 31, ob = rr * 64 + cc * 2; return st * 1024 + (ob ^ (((ob >> 9) & 1) << 5)); }
__host__ __device__ __forceinline__ void stage_rc(int b, int& R, int& C) { const int st = b / 1024, sb = b % 1024, swz = sb ^ (((sb >> 9) & 1) << 5); R = (st >> 1) * 16 + swz / 64; C = (st & 1) * 32 + (swz % 64) / 2; }
__host__ __device__ __forceinline__ int perm32(int rho) { const int n = rho >> 4, i = rho & 15; return 8 * (i >> 2) + 4 * n + (i & 3); }

struct Unit { int pm, pn; };
struct Gemm { const bf16_t* A; const bf16_t* Bt; int M, N, K; };

struct StaticOrder {
    int nM, nN, nwg, G, c;
    __host__ __device__ void init(int M, int N, int G_, int c_) { nM = M / BM; nN = N / BM; nwg = nM * nN; G = G_; c = c_; }
    __host__ __device__ bool next(int i, Unit& u) const {
        const long L = (long)i * G + c; if (L >= nwg) return false;
        int wgid = (int)L; { const int q = nwg / NXCD, r = nwg % NXCD, xcd = wgid % NXCD, off = wgid / NXCD; wgid = (xcd < r ? xcd * (q + 1) : r * (q + 1) + (xcd - r) * q) + off; }
        const int nig = WGM * nN, gid = wgid / nig, fm = gid * WGM, gsz = (nM - fm) < WGM ? (nM - fm) : WGM;
        u.pm = fm + ((wgid % nig) % gsz); u.pn = (wgid % nig) / gsz; return true;
    }
    __device__ __forceinline__ void a_ready(const Unit&) const {}
    __device__ __forceinline__ void done(const Unit&) const {}
};

__device__ __forceinline__ unsigned cvt_pk_bf16(float lo, float hi) { unsigned r; asm volatile("v_cvt_pk_bf16_f32 %0, %1, %2" : "=v"(r) : "v"(lo), "v"(hi)); return r; }
typedef float f32x2 __attribute__((ext_vector_type(2)));
__device__ __forceinline__ f32x2 gelu_pk(f32x2 v) {
    const f32x2 av = __builtin_elementwise_abs(v), d = av * 0.2316418882f + 1.0f;
    f32x2 t; t.x = __builtin_amdgcn_rcpf(d.x); t.y = __builtin_amdgcn_rcpf(d.y);
    f32x2 q = t * 0.5307027145f + (-0.7265760135f); q = q * t + 0.7107068705f; q = q * t + (-0.142248368f); q = q * t + 0.127414796f; q = q * t;
    const f32x2 s = (v * v) * (-0.72134752044f);
    f32x2 e; e.x = __builtin_amdgcn_exp2f(s.x); e.y = __builtin_amdgcn_exp2f(s.y);
    const f32x2 m = v * (q * e), r = v - m;
    f32x2 o; o.x = v.x < 0.f ? m.x : r.x; o.y = v.y < 0.f ? m.y : r.y; return o;
}

template <int ACT  > struct EpiBf16 {
    static constexpr bool PERM = true, AFTER_DRAIN = false; static_assert(ACT == 0 || ACT == 1, "EpiBf16: ACT is 0 (none) or 1 (gelu_pk)");
    bf16_t* O; int ldc; const float* bias; int split_cols; size_t split_stride; float scale0;
    __device__ __forceinline__ void operator()(const f32x4 (&acc)[2][2][4][2], const Unit& u, int wr, int wc, int fr, int fq) const {
        const int row0 = u.pm * BM + wr * 64 + fr; int colt = u.pn * BM; bf16_t* base = O;
        float sc = 1.f; if (split_cols) { const int t = colt / split_cols; base += (size_t)t * split_stride; colt -= t * split_cols; if (t == 0) sc = scale0; }
        const int col0 = colt + wc * 32 + 8 * fq, bcol0 = u.pn * BM + wc * 32 + 8 * fq;
        f32x4 bv[2][2];
#pragma unroll
        for (int bj = 0; bj < 2; ++bj)
#pragma unroll
            for (int n = 0; n < 2; ++n) bv[bj][n] = bias ? *(const f32x4*)(bias + bcol0 + bj * HALF + 4 * n) : (f32x4){0.f, 0.f, 0.f, 0.f};
#pragma unroll
        for (int ai = 0; ai < 2; ++ai)
#pragma unroll
            for (int m = 0; m < 4; ++m) { bf16_t* rowp = base + (size_t)(row0 + ai * HALF + m * 16) * ldc + col0;
#pragma unroll
                for (int bj = 0; bj < 2; ++bj) { f32x4 v0 = acc[ai][bj][m][0] + bv[bj][0], v1 = acc[ai][bj][m][1] + bv[bj][1];
                    if (ACT == 1) { f32x2 a = gelu_pk((f32x2){v0[0], v0[1]}), b = gelu_pk((f32x2){v0[2], v0[3]}), c = gelu_pk((f32x2){v1[0], v1[1]}), d = gelu_pk((f32x2){v1[2], v1[3]});
                        v0 = (f32x4){a.x, a.y, b.x, b.y}; v1 = (f32x4){c.x, c.y, d.x, d.y}; }
                    v0 = v0 * sc; v1 = v1 * sc; u32x4 w; w.x = cvt_pk_bf16(v0[0], v0[1]); w.y = cvt_pk_bf16(v0[2], v0[3]); w.z = cvt_pk_bf16(v1[0], v1[1]); w.w = cvt_pk_bf16(v1[2], v1[3]);
                    *(u32x4*)(rowp + bj * HALF) = w; } }
    }
};
template <class Epi, class Sched, bool ALIGN_EPI = false, bool SP2 = false>
__device__ __forceinline__ void gemm_phase(PG8_LAS unsigned char* lds, const Gemm g, const Sched& S, const Epi& E) {
    int tid_ = threadIdx.x; asm volatile("" : "+v"(tid_));
    const int tid = tid_, wid = __builtin_amdgcn_readfirstlane(tid >> 6), lane = tid & 63, wr = wid >> 2, wc = wid & 3, fr = lane & 15, fq = lane >> 4;
    const int K = g.K, nt = K / BK;
    unsigned voffA[2], voffB[2];
#pragma unroll
    for (int i = 0; i < 2; ++i) { int R, C; stage_rc(tid * 16 + i * 8192, R, C); const int Rb = Epi::PERM ? ((R & ~31) + perm32(R & 31)) : R;
        voffA[i] = (unsigned)(R * K + C) * 2u; voffB[i] = (unsigned)(Rb * K + C) * 2u; }
    const size_t kstep = (size_t)(BK * 2);
    const size_t hstep = (size_t)HALF * K * 2;
    const size_t tstep = 2 * hstep;
    const unsigned ldsw = (unsigned)wid * 1024u;
    const int aoff = lds_byte(wr * 64 + fr, fq * 8), boff = lds_byte(wc * 32 + fr, fq * 8);
#define PG8_SA(b, h) (((b) * 2 + (h)) * HTB)
#define PG8_SB(b, h) ((4 + (b) * 2 + (h)) * HTB)
#define PG8_STAGE(bufoff, gbase, voff) do { _Pragma("unroll") for (int _i = 0; _i < 2; ++_i) \
        __builtin_amdgcn_global_load_lds((const unsigned*)((const char*)(gbase) + (voff)[_i]), (PG8_LAS unsigned*)(lds + (bufoff) + ldsw + _i * 8192), 16, 0, 0); } while (0)
#define PG8_LDA(dst, b, h) do { _Pragma("unroll") for (int m = 0; m < 4; ++m) _Pragma("unroll") for (int k = 0; k < 2; ++k) dst[m][k] = *(const PG8_LAS bf16x8*)(lds + PG8_SA(b, h) + aoff + m * 2048 + k * 1024); } while (0)
#define PG8_LDB(dst, b, h) do { _Pragma("unroll") for (int n = 0; n < 2; ++n) _Pragma("unroll") for (int k = 0; k < 2; ++k) dst[n][k] = *(const PG8_LAS bf16x8*)(lds + PG8_SB(b, h) + boff + n * 2048 + k * 1024); } while (0)
#define PG8_MMA(ai, bj, At, Bt) do { __builtin_amdgcn_s_setprio(1); _Pragma("unroll") for (int m = 0; m < 4; ++m) _Pragma("unroll") for (int n = 0; n < 2; ++n) _Pragma("unroll") for (int k = 0; k < 2; ++k) \
        acc[ai][bj][m][n] = __builtin_amdgcn_mfma_f32_16x16x32_bf16(Bt[n][k], At[m][k], acc[ai][bj][m][n], 0, 0, 0); __builtin_amdgcn_s_setprio(0); } while (0)
#define PG8_WAIT_V(n) asm volatile("s_waitcnt vmcnt(" #n ")" ::: "memory")
#define PG8_WAIT_L(n) asm volatile("s_waitcnt lgkmcnt(" #n ")" ::: "memory")
#define PG8_BAR __builtin_amdgcn_s_barrier()
#define PG8_SCHED __builtin_amdgcn_sched_barrier(0)
    Unit cur, nxt; int ui = 0;
    if (!S.next(0, cur)) return;
    f32x4 acc[2][2][4][2];
#pragma unroll
    for (int a = 0; a < 2; ++a)
#pragma unroll
        for (int b = 0; b < 2; ++b)
#pragma unroll
            for (int m = 0; m < 4; ++m)
#pragma unroll
                for (int n = 0; n < 2; ++n) acc[a][b][m][n] = (f32x4){0.f, 0.f, 0.f, 0.f};
    bf16x8 At[4][2], B0[2][2], B1[2][2];
    const char* cA = (const char*)g.A + (size_t)cur.pm * tstep; const char* cB = (const char*)g.Bt + (size_t)cur.pn * tstep;
    S.a_ready(cur);
    if constexpr (SP2) {
        PG8_STAGE(PG8_SB(0, 0), cB, voffB); PG8_STAGE(PG8_SB(0, 1), cB + hstep, voffB); PG8_STAGE(PG8_SA(0, 0), cA, voffA); PG8_STAGE(PG8_SA(0, 1), cA + hstep, voffA);
        if (wr == 1) PG8_BAR;
        PG8_WAIT_V(2); PG8_BAR;
        PG8_STAGE(PG8_SB(1, 0), cB + kstep, voffB); PG8_STAGE(PG8_SA(1, 0), cA + kstep, voffA); PG8_STAGE(PG8_SB(1, 1), cB + hstep + kstep, voffB);
        PG8_WAIT_V(6); PG8_BAR;
    } else {
        PG8_STAGE(PG8_SB(0, 0), cB, voffB); PG8_STAGE(PG8_SA(0, 0), cA, voffA); PG8_STAGE(PG8_SB(0, 1), cB + hstep, voffB); PG8_STAGE(PG8_SA(0, 1), cA + hstep, voffA);
        if (wr == 1) PG8_BAR;
        PG8_WAIT_V(4); PG8_BAR;
        PG8_STAGE(PG8_SB(1, 0), cB + kstep, voffB); PG8_STAGE(PG8_SA(1, 0), cA + kstep, voffA); PG8_STAGE(PG8_SB(1, 1), cB + hstep + kstep, voffB);
        PG8_WAIT_V(6); PG8_BAR;
    }
    for (;;) {
        const bool has_next = S.next(ui + 1, nxt);
        const char* nA = has_next ? (const char*)g.A + (size_t)nxt.pm * tstep : cA; const char* nB = has_next ? (const char*)g.Bt + (size_t)nxt.pn * tstep : cB;
        for (int t = 0; t < nt; t += 2) {
            const bool last = (t == nt - 2);
            const char* a1 = cA + (size_t)(t + 1) * kstep;
            const char* a2 = last ? nA : cA + (size_t)(t + 2) * kstep; const char* b2 = last ? nB : cB + (size_t)(t + 2) * kstep;
            const char* a3 = a2 + kstep; const char* b3 = b2 + kstep;
            if (last && has_next) S.a_ready(nxt);
            if constexpr (SP2) {
            PG8_LDB(B0, 0, 0); PG8_LDB(B1, 0, 1); PG8_SCHED; PG8_LDA(At, 0, 0); PG8_STAGE(PG8_SA(1, 1), a1 + hstep, voffA);
            PG8_WAIT_V(8); PG8_WAIT_L(0); PG8_BAR; PG8_MMA(0, 0, At, B0); PG8_MMA(0, 1, At, B1); PG8_BAR; PG8_SCHED;
            PG8_LDA(At, 0, 1); PG8_STAGE(PG8_SB(0, 0), b2, voffB); PG8_STAGE(PG8_SB(0, 1), b2 + hstep, voffB); PG8_STAGE(PG8_SA(0, 0), a2, voffA);
            PG8_WAIT_V(8); PG8_WAIT_L(0); PG8_BAR; PG8_MMA(1, 0, At, B0); PG8_MMA(1, 1, At, B1); PG8_BAR; PG8_SCHED;
            PG8_LDB(B0, 1, 0); PG8_LDB(B1, 1, 1); PG8_SCHED; PG8_LDA(At, 1, 0); PG8_STAGE(PG8_SA(0, 1), a2 + hstep, voffA);
            PG8_WAIT_V(8); PG8_WAIT_L(0); PG8_BAR; PG8_MMA(0, 0, At, B0); PG8_MMA(0, 1, At, B1); PG8_BAR; PG8_SCHED;
            PG8_LDA(At, 1, 1); PG8_STAGE(PG8_SB(1, 0), b3, voffB); PG8_STAGE(PG8_SB(1, 1), b3 + hstep, voffB); PG8_STAGE(PG8_SA(1, 0), a3, voffA);
            PG8_WAIT_V(8); PG8_WAIT_L(0); PG8_BAR; PG8_MMA(1, 0, At, B0); PG8_MMA(1, 1, At, B1); PG8_BAR; PG8_SCHED;
            } else {
            PG8_LDB(B0, 0, 0); PG8_SCHED; PG8_LDA(At, 0, 0); PG8_STAGE(PG8_SA(1, 1), a1 + hstep, voffA);
            PG8_WAIT_L(8); PG8_BAR; PG8_WAIT_L(0); PG8_MMA(0, 0, At, B0); PG8_BAR; PG8_SCHED;
            PG8_LDB(B1, 0, 1); PG8_STAGE(PG8_SB(0, 0), b2, voffB);
            PG8_BAR; PG8_WAIT_L(0); PG8_MMA(0, 1, At, B1); PG8_BAR;
            PG8_LDA(At, 0, 1); PG8_STAGE(PG8_SA(0, 0), a2, voffA);
            PG8_BAR; PG8_WAIT_L(0); PG8_MMA(1, 0, At, B0); PG8_BAR; PG8_SCHED;
            PG8_STAGE(PG8_SB(0, 1), b2 + hstep, voffB);
            PG8_WAIT_V(6); PG8_BAR; PG8_MMA(1, 1, At, B1); PG8_BAR;
            PG8_LDB(B0, 1, 0); PG8_SCHED; PG8_LDA(At, 1, 0); PG8_STAGE(PG8_SA(0, 1), a2 + hstep, voffA);
            PG8_WAIT_L(8); PG8_BAR; PG8_WAIT_L(0); PG8_MMA(0, 0, At, B0); PG8_BAR; PG8_SCHED;
            PG8_LDB(B1, 1, 1); PG8_STAGE(PG8_SB(1, 0), b3, voffB);
            PG8_BAR; PG8_WAIT_L(0); PG8_MMA(0, 1, At, B1); PG8_BAR;
            PG8_LDA(At, 1, 1); PG8_STAGE(PG8_SA(1, 0), a3, voffA);
            PG8_BAR; PG8_WAIT_L(0); PG8_MMA(1, 0, At, B0); PG8_BAR; PG8_SCHED;
            PG8_STAGE(PG8_SB(1, 1), b3 + hstep, voffB);
            PG8_WAIT_V(6); PG8_BAR; PG8_MMA(1, 1, At, B1); PG8_BAR;
            }
        }
        if constexpr (ALIGN_EPI) { if (wr == 0) PG8_BAR; }
        if constexpr (!Epi::AFTER_DRAIN) { E(acc, cur, wr, wc, fr, fq); S.done(cur); }
        if (!has_next) break;
#pragma unroll
        for (int a = 0; a < 2; ++a)
#pragma unroll
            for (int b = 0; b < 2; ++b)
#pragma unroll
                for (int m = 0; m < 4; ++m)
#pragma unroll
                    for (int n = 0; n < 2; ++n) acc[a][b][m][n] = (f32x4){0.f, 0.f, 0.f, 0.f};
        cur = nxt; cA = nA; cB = nB; ++ui;
        if constexpr (ALIGN_EPI) { if (wr == 1) PG8_BAR; }
    }
    PG8_WAIT_V(0);
    if constexpr (!ALIGN_EPI) { if (wr == 0) PG8_BAR; }
    PG8_BAR;
    if constexpr (Epi::AFTER_DRAIN) { E.fused(acc, cur, wr, wc, fr, fq, lds, wid, lane); S.done(cur); }
#undef PG8_SA
#undef PG8_SB
#undef PG8_STAGE
#undef PG8_LDA
#undef PG8_LDB
#undef PG8_MMA
#undef PG8_WAIT_V
#undef PG8_WAIT_L
#undef PG8_BAR
#undef PG8_SCHED
}
}

constexpr int D_MODEL = 1024, BATCH = 2, SEQ = 8192, MTOK = BATCH * SEQ, MEM_LEN = 256, MEMROWS = BATCH * MEM_LEN;
constexpr int IN_COLS = 9984, OFF_AQ = 0, OFF_AK = 1536, OFF_AV = 3072, OFF_R = 4608, OFF_CQ = 6400, OFF_GATE = 6912;
constexpr int RW = 512;
constexpr int N_EXPERTS = 32, TOP_K = 4, D_FF = 1024, MOE_ROWS = 256;
constexpr int MAX_BLOCKS = MTOK * TOP_K / MOE_ROWS + N_EXPERTS;
constexpr int MAX_SLOTS = MAX_BLOCKS * MOE_ROWS;
constexpr float NORM_EPS = 1e-6f, R_GN_EPS = 64e-5f;
constexpr float LOG2E = 1.4426950408889634f;
constexpr float QSCALE = 0.08838834764831845f * LOG2E;

namespace pg8 {
__device__ __forceinline__ float bf_lo(unsigned w) { return __builtin_bit_cast(float, w << 16); }
__device__ __forceinline__ float bf_hi(unsigned w) { return __builtin_bit_cast(float, w & 0xffff0000u); }
__device__ __forceinline__ float sigmoidf_fast(float x) { return 1.0f / (1.0f + __expf(-x)); }

struct EpiGate {
    static constexpr bool PERM = true, AFTER_DRAIN = false;
    const bf16_t* Z; const float* bgate; float* merged; bf16_t* mergedb; int br;
    __device__ __forceinline__ void operator()(const f32x4 (&acc)[2][2][4][2], const Unit& u, int wr, int wc, int fr, int fq) const {
        const int row0 = u.pm * BM + wr * 64 + fr, col0 = u.pn * BM + wc * 32 + 8 * fq;
#pragma unroll
        for (int ai = 0; ai < 2; ++ai)
#pragma unroll
            for (int m = 0; m < 4; ++m) { const int row = row0 + ai * HALF + m * 16;
#pragma unroll
                for (int bj = 0; bj < 2; ++bj) { const int col = col0 + bj * HALF;
                    const u32x4 gz = *(const u32x4*)(Z + (size_t)row * IN_COLS + OFF_GATE + br * D_MODEL + col);
                    const f32x4 b0 = *(const f32x4*)(bgate + br * D_MODEL + col), b1 = *(const f32x4*)(bgate + br * D_MODEL + col + 4);
                    f32x4 g0, g1;
                    g0[0] = sigmoidf_fast(bf_lo(gz[0]) + b0[0]); g0[1] = sigmoidf_fast(bf_hi(gz[0]) + b0[1]); g0[2] = sigmoidf_fast(bf_lo(gz[1]) + b0[2]); g0[3] = sigmoidf_fast(bf_hi(gz[1]) + b0[3]);
                    g1[0] = sigmoidf_fast(bf_lo(gz[2]) + b1[0]); g1[1] = sigmoidf_fast(bf_hi(gz[2]) + b1[1]); g1[2] = sigmoidf_fast(bf_lo(gz[3]) + b1[2]); g1[3] = sigmoidf_fast(bf_hi(gz[3]) + b1[3]);
                    f32x4 v0 = acc[ai][bj][m][0] * g0, v1 = acc[ai][bj][m][1] * g1;
                    float* mp = merged + (size_t)row * D_MODEL + col;
                    if (br > 0) { v0 += *(const f32x4*)mp; v1 += *(const f32x4*)(mp + 4); }
                    if (br < 2) { *(f32x4*)mp = v0; *(f32x4*)(mp + 4) = v1; }
                    else { u32x4 w; w.x = cvt_pk_bf16(v0[0], v0[1]); w.y = cvt_pk_bf16(v0[2], v0[3]); w.z = cvt_pk_bf16(v1[0], v1[1]); w.w = cvt_pk_bf16(v1[2], v1[3]);
                        *(u32x4*)(mergedb + (size_t)row * D_MODEL + col) = w; } } }
    }
};
struct EpiResF32 {
    static constexpr bool PERM = true, AFTER_DRAIN = false;
    const float* base; float* out; int ldc;
    __device__ __forceinline__ void operator()(const f32x4 (&acc)[2][2][4][2], const Unit& u, int wr, int wc, int fr, int fq) const {
        const int row0 = u.pm * BM + wr * 64 + fr, col0 = u.pn * BM + wc * 32 + 8 * fq;
#pragma unroll
        for (int ai = 0; ai < 2; ++ai)
#pragma unroll
            for (int m = 0; m < 4; ++m) { const size_t off = (size_t)(row0 + ai * HALF + m * 16) * ldc + col0;
#pragma unroll
                for (int bj = 0; bj < 2; ++bj) { const float* bp = base + off + bj * HALF; float* op = out + off + bj * HALF;
                    const f32x4 x0 = *(const f32x4*)bp, x1 = *(const f32x4*)(bp + 4);
                    *(f32x4*)op = x0 + acc[ai][bj][m][0]; *(f32x4*)(op + 4) = x1 + acc[ai][bj][m][1]; } }
    }
};
struct EpiSwiGLU {
    static constexpr bool PERM = true, AFTER_DRAIN = false;
    const float* b1; bf16_t* H;
    __device__ __forceinline__ void operator()(const f32x4 (&acc)[2][2][4][2], const Unit& u, int wr, int wc, int fr, int fq) const {
        const int e = u.pn >> 3, pnl = u.pn & 7;
        const int row0 = u.pm * BM + wr * 64 + fr, ac = pnl * HALF + wc * 32 + 8 * fq;
        const float* bg = b1 + (size_t)e * 2 * D_FF + ac; const float* bl = bg + D_FF;
        const f32x4 bg0 = *(const f32x4*)bg, bg1 = *(const f32x4*)(bg + 4), bl0 = *(const f32x4*)bl, bl1 = *(const f32x4*)(bl + 4);
#pragma unroll
        for (int ai = 0; ai < 2; ++ai)
#pragma unroll
            for (int m = 0; m < 4; ++m) { const int row = row0 + ai * HALF + m * 16;
                float a[8];
#pragma unroll
                for (int n = 0; n < 2; ++n) { const f32x4 ug = acc[ai][0][m][n] + (n ? bg1 : bg0), ul = acc[ai][1][m][n] + (n ? bl1 : bl0);
#pragma unroll
                    for (int j = 0; j < 4; ++j) { const float g = fminf(ug[j], 7.0f), l = fminf(fmaxf(ul[j], -7.0f), 7.0f);
                        a[4 * n + j] = g * sigmoidf_fast(1.702f * g) * (l + 1.0f); } }
                u32x4 w; w.x = cvt_pk_bf16(a[0], a[1]); w.y = cvt_pk_bf16(a[2], a[3]); w.z = cvt_pk_bf16(a[4], a[5]); w.w = cvt_pk_bf16(a[6], a[7]);
                *(u32x4*)(H + (size_t)row * D_FF + ac) = w; }
    }
};
struct EpiMoeOut {
    static constexpr bool PERM = true, AFTER_DRAIN = false;
    const float* b2; const float* rowgate; bf16_t* Y;
    __device__ __forceinline__ void operator()(const f32x4 (&acc)[2][2][4][2], const Unit& u, int wr, int wc, int fr, int fq) const {
        const int e = u.pn >> 2, pnl = u.pn & 3;
        const int row0 = u.pm * BM + wr * 64 + fr, col0 = pnl * BM + wc * 32 + 8 * fq;
#pragma unroll
        for (int ai = 0; ai < 2; ++ai)
#pragma unroll
            for (int m = 0; m < 4; ++m) { const int row = row0 + ai * HALF + m * 16; const float gt = rowgate[row];
#pragma unroll
                for (int bj = 0; bj < 2; ++bj) { const int col = col0 + bj * HALF; const float* bp = b2 + (size_t)e * D_MODEL + col;
                    const f32x4 v0 = (acc[ai][bj][m][0] + *(const f32x4*)bp) * gt, v1 = (acc[ai][bj][m][1] + *(const f32x4*)(bp + 4)) * gt;
                    u32x4 w; w.x = cvt_pk_bf16(v0[0], v0[1]); w.y = cvt_pk_bf16(v0[2], v0[3]); w.z = cvt_pk_bf16(v1[0], v1[1]); w.w = cvt_pk_bf16(v1[2], v1[3]);
                    *(u32x4*)(Y + (size_t)row * D_MODEL + col) = w; } }
    }
};
struct MoeOrder {
    const PG8_LAS int* tab;
    int NT, G, c;
    __device__ __forceinline__ bool next(int i, Unit& u) const {
        const int nblk = tab[0]; const long L = (long)i * G + c; if (L >= (long)nblk * NT) return false;
        const int blk = (int)(L / NT), pnl = (int)(L % NT); u.pm = blk; u.pn = tab[1 + blk] * NT + pnl; return true;
    }
    __device__ __forceinline__ void a_ready(const Unit&) const {}
    __device__ __forceinline__ void done(const Unit&) const {}
};
}

namespace swa {
constexpr int D = 128;
constexpr float SCALE = 0.08838834764831845f;
constexpr float THR = 8.f;
constexpr int NW = 8, QBLK = 32, KVBLK = 64, QB = NW * QBLK;
constexpr int SHM_V = KVBLK * D * 2, SHM_K = KVBLK * D * 2;
constexpr int LDS_BYTES = 2 * SHM_V + 2 * SHM_K + NW * 64 * 4;
using bf16 = unsigned short;
typedef short bf16x8 __attribute__((ext_vector_type(8)));
typedef short s16x4 __attribute__((ext_vector_type(4)));
typedef float f32x16 __attribute__((ext_vector_type(16)));
typedef float f32x4 __attribute__((ext_vector_type(4)));
typedef unsigned u32x4 __attribute__((ext_vector_type(4)));
template <class A, class Bt> struct same_t { static constexpr bool v = false; };
template <class A> struct same_t<A, A> { static constexpr bool v = true; };
#define KSWZ(row, colB) ((row) * 256 + ((colB) ^ (((row) & 7) << 4)))
#define SBAR() __builtin_amdgcn_sched_barrier(0)
__device__ __forceinline__ int v_st(int k, int c) { const int kk = (k & ~0xC) | ((k & 4) << 1) | ((k & 8) >> 1); return ((kk >> 3) * 4 + (c >> 5)) * 512 + ((kk & 7) * 32 + (c & 31)) * 2; }
__device__ __forceinline__ int v_rd_base(int lane) { return ((lane & 3) << 3) | (((lane >> 2) & 3) << 6) | (((lane >> 4) & 1) << 5) | (((lane >> 5) & 1) << 8); }
constexpr int v_rd_off(int d0, int ks, int half) { return d0 * 512 + ks * 4096 + half * 2048; }
__device__ __forceinline__ int crow(int r, int hi) { return (r & 3) + 8 * (r >> 2) + 4 * hi; }
__device__ __forceinline__ unsigned cvtpk(float lo, float hi) {
    unsigned r; asm volatile("v_cvt_pk_bf16_f32 %0, %1, %2" : "=v"(r) : "v"(lo), "v"(hi)); return r;
}
__device__ __forceinline__ bf16x8 pack8(f32x4 a, f32x4 b) {
    u32x4 w = {cvtpk(a[0], a[1]), cvtpk(a[2], a[3]), cvtpk(b[0], b[1]), cvtpk(b[2], b[3])};
    return *reinterpret_cast<bf16x8*>(&w);
}
template <class T> __device__ __forceinline__ bf16x8 load8(const T* p) {
    if constexpr (same_t<T, float>::v) { return pack8(*(const f32x4*)p, *(const f32x4*)(p + 4)); }
    else { return *reinterpret_cast<const bf16x8*>(p); }
}
__device__ __forceinline__ void mask_tile(f32x16& p0, f32x16& p1, int dq, unsigned W) {
    const float NEG = -__builtin_inff();
#pragma unroll
    for (int r = 0; r < 16; ++r) {
        const int c = (r & 3) + 8 * (r >> 2);
        if ((unsigned)(dq - c) >= W) p0[r] = NEG;
        if ((unsigned)(dq - c - 32) >= W) p1[r] = NEG;
    }
}
__device__ __forceinline__ void partialSM(f32x16& p0, f32x16& p1, float& m_reg, float& mn, float& alpha) {
    float pmax = p0[0]; for (int r = 1; r < 16; ++r) pmax = fmaxf(pmax, p0[r]); for (int r = 0; r < 16; ++r) pmax = fmaxf(pmax, p1[r]);
    { auto rr = __builtin_amdgcn_permlane32_swap(__float_as_uint(pmax), __float_as_uint(pmax), false, false);
      pmax = fmaxf(__uint_as_float(rr[0]), __uint_as_float(rr[1])); }
    constexpr float C2 = 1.4426950408889634f * SCALE;
    if (__builtin_expect(__all((pmax - m_reg) * SCALE <= THR), 1)) { mn = m_reg; alpha = 1.f; }
    else { mn = fmaxf(m_reg, pmax); alpha = __builtin_amdgcn_exp2f((m_reg - mn) * C2); m_reg = mn; }
    const float mnL = -mn * C2;
    for (int r = 0; r < 16; ++r) p0[r] = fmaf(p0[r], C2, mnL); for (int r = 0; r < 16; ++r) p1[r] = fmaf(p1[r], C2, mnL);
    for (int r = 0; r < 16; ++r) p0[r] = __builtin_amdgcn_exp2f(p0[r]);
}
__device__ __forceinline__ void finishSM(f32x16& p0, f32x16& p1, float alpha, float& l_reg, bf16x8& pa0, bf16x8& pa1, bf16x8& pa2, bf16x8& pa3) {
    for (int r = 0; r < 16; ++r) p1[r] = __builtin_amdgcn_exp2f(p1[r]);
    float ps = 0; for (int r = 0; r < 16; ++r) ps += p0[r]; for (int r = 0; r < 16; ++r) ps += p1[r];
    { auto rr = __builtin_amdgcn_permlane32_swap(__float_as_uint(ps), __float_as_uint(ps), false, false);
      ps = __uint_as_float(rr[0]) + __uint_as_float(rr[1]); }
    l_reg = l_reg * alpha + ps;
#define PK4(P, B_, OUT) do { unsigned a0 = cvtpk(P[B_+0], P[B_+1]), a1 = cvtpk(P[B_+2], P[B_+3]);                          \
        unsigned b0 = cvtpk(P[B_+4], P[B_+5]), b1 = cvtpk(P[B_+6], P[B_+7]);                                             \
        auto r0 = __builtin_amdgcn_permlane32_swap(a0, b0, false, false); auto r1 = __builtin_amdgcn_permlane32_swap(a1, b1, false, false); \
        u32x4 w = {r0[0], r1[0], r0[1], r1[1]}; OUT = *reinterpret_cast<bf16x8*>(&w); } while (0)
    PK4(p0, 0, pa0); PK4(p0, 8, pa1); PK4(p1, 0, pa2); PK4(p1, 8, pa3);
#undef PK4
}
template <int KB, bool SK>
__device__ __forceinline__ void qkt(f32x16& p0, f32x16& p1, const char* K_lds, int r32, int hi, const bf16x8* qr, bool act) {
    if (SK && !act) { const float NEG = -__builtin_inff();
#pragma unroll
        for (int r = 0; r < 16; ++r) { p0[r] = NEG; p1[r] = NEG; } return; }
    p0 = f32x16{}; p1 = f32x16{};
    const char* kb[4];
#pragma unroll
    for (int dd = 0; dd < 4; ++dd) kb[dd] = K_lds + KB * SHM_K + KSWZ(r32, (dd * 16 + hi * 8) * 2);
#pragma unroll
    for (int d0 = 0; d0 < 8; ++d0) { const char* a = kb[d0 & 3] + (d0 >> 2) * 128;
        bf16x8 b0 = *reinterpret_cast<const bf16x8*>(a);
        bf16x8 b1 = *reinterpret_cast<const bf16x8*>(a + 32 * 256);
        p0 = __builtin_amdgcn_mfma_f32_32x32x16_bf16(b0, qr[d0], p0, 0, 0, 0);
        p1 = __builtin_amdgcn_mfma_f32_32x32x16_bf16(b1, qr[d0], p1, 0, 0, 0); }
}
template <int VB, bool SK>
__device__ __forceinline__ void pv_tile(f32x16* o, int vb0, bf16x8 pa0, bf16x8 pa1, bf16x8 pa2, bf16x8 pa3, bool act) {
    if (SK && !act) return;
#define TRRD(dst, off) asm volatile("ds_read_b64_tr_b16 %0, %1 offset:%2" : "=&v"(dst) : "v"(vb0), "i"(off) : "memory")
#define PV_D0(d0) do { s16x4 l0, l1, l2, l3, h0, h1, h2, h3; constexpr int b_ = VB * SHM_V + v_rd_off(d0, 0, 0);     \
        TRRD(l0, b_); TRRD(h0, b_ + 2048); TRRD(l1, b_ + 4096); TRRD(h1, b_ + 6144); TRRD(l2, b_ + 8192); TRRD(h2, b_ + 10240); TRRD(l3, b_ + 12288); TRRD(h3, b_ + 14336); \
        asm volatile("s_waitcnt lgkmcnt(0)" ::: "memory"); SBAR();                 \
        o[d0] = __builtin_amdgcn_mfma_f32_32x32x16_bf16(pa0, (bf16x8){l0[0], l0[1], l0[2], l0[3], h0[0], h0[1], h0[2], h0[3]}, o[d0], 0, 0, 0);   \
        o[d0] = __builtin_amdgcn_mfma_f32_32x32x16_bf16(pa1, (bf16x8){l1[0], l1[1], l1[2], l1[3], h1[0], h1[1], h1[2], h1[3]}, o[d0], 0, 0, 0);   \
        o[d0] = __builtin_amdgcn_mfma_f32_32x32x16_bf16(pa2, (bf16x8){l2[0], l2[1], l2[2], l2[3], h2[0], h2[1], h2[2], h2[3]}, o[d0], 0, 0, 0);   \
        o[d0] = __builtin_amdgcn_mfma_f32_32x32x16_bf16(pa3, (bf16x8){l3[0], l3[1], l3[2], l3[3], h3[0], h3[1], h3[2], h3[3]}, o[d0], 0, 0, 0); } while (0)
    PV_D0(0); PV_D0(1); PV_D0(2); PV_D0(3);
#undef PV_D0
#undef TRRD
}

struct BlockRef { const bf16* Q; const bf16* K; const bf16* V; bf16* O; float* LSE; int QS, KS, OS, LS, P0, skv, W; };
struct Seam { bf16x8 qr[8]; bf16x8 st_v0, st_v1, st_k0, st_k1; };
__device__ __forceinline__ int swa_jlo(int P0, int W) { const int lowk = P0 - W + 1; return lowk > 0 ? lowk / KVBLK : 0; }
#define LD8(p) (*reinterpret_cast<const bf16x8*>(p))
#define ROW(p, k0, rr, RS) ((p) + (size_t)((k0) + (rr)) * (RS) + sc)
#define VMW() asm volatile("s_waitcnt vmcnt(0)" ::: "memory")
#define VMWN(n) asm volatile("s_waitcnt vmcnt(%0)" :: "i"(n) : "memory")
#define SLOAD_H(Kp, Vp, k0, RS) do { const char* kb_ = (const char*)(Kp) + (size_t)(k0) * (size_t)(RS) * 2; const char* vb_ = (const char*)(Vp) + (size_t)(k0) * (size_t)(RS) * 2;  \
                         const unsigned oa_ = (unsigned)(sr * (RS) + sc) * 2u, ob_ = oa_ + (unsigned)(RS) * 64u;                                    \
                         S.st_v0 = LD8(vb_ + oa_); S.st_v1 = LD8(vb_ + ob_); S.st_k0 = LD8(kb_ + oa_); S.st_k1 = LD8(kb_ + ob_); } while (0)
#define SWRITE_HK(bf) do { *(bf16x8*)(K_lds + (bf) * SHM_K + kws) = S.st_k0; *(bf16x8*)(K_lds + (bf) * SHM_K + kws + 32 * 256) = S.st_k1; } while (0)
#define SWRITE_HV(bf) do { *(bf16x8*)(V_lds + (bf) * SHM_V + vst0) = S.st_v0; *(bf16x8*)(V_lds + (bf) * SHM_V + vst1) = S.st_v1; } while (0)
#define SWRITE_H(bf) do { SWRITE_HV(bf); SWRITE_HK(bf); } while (0)
__device__ __forceinline__ void swa_prime(const BlockRef& cur, char* lds, Seam& S) {
    int tid_ = threadIdx.x; asm volatile("" : "+v"(tid_));
    const int tid = tid_, wid = __builtin_amdgcn_readfirstlane(tid >> 6), lane = tid & 63, r32 = lane & 31, hi = lane >> 5;
    const int sr = tid >> 4, sc = (tid & 15) * 8, kws = KSWZ(sr, sc * 2); char* K_lds = lds + 2 * SHM_V;
    const int kb0 = swa_jlo(cur.P0, cur.W) * KVBLK;
    { const char* qb_ = (const char*)cur.Q + (size_t)(wid * QBLK) * (size_t)cur.QS * 2; const unsigned qo_ = (unsigned)(r32 * cur.QS + hi * 8) * 2u;
      for (int d0 = 0; d0 < 8; ++d0) S.qr[d0] = LD8(qb_ + qo_ + d0 * 32); }
    SLOAD_H(cur.K, cur.V, kb0, cur.KS); VMW(); SWRITE_HK(0);
    __syncthreads();
}
__device__ __forceinline__ void swa_block(const BlockRef& cur, const BlockRef& nxt, char* lds, Seam& S) {
    int tid_ = threadIdx.x; asm volatile("" : "+v"(tid_));
    const int tid = tid_, wid = __builtin_amdgcn_readfirstlane(tid >> 6), lane = tid & 63, r32 = lane & 31, hi = lane >> 5;
    const int W = cur.W, skv = cur.skv;
    const int j_lo = swa_jlo(cur.P0, W);
    int j_hi = (cur.P0 + QB - 1) / KVBLK + 1; if (j_hi > skv / KVBLK) j_hi = skv / KVBLK;
    const int NT = j_hi - j_lo;
    const int kbn = swa_jlo(nxt.P0, nxt.W) * KVBLK;
    const int qlo = cur.P0 + wid * QBLK, qm = qlo + r32 - 4 * hi;
    char* V_lds = lds; char* K_lds = lds + 2 * SHM_V;
    float* ws = (float*)(lds + 2 * SHM_V + 2 * SHM_K) + wid * 64; float* li_l = ws, * al_l = ws + 32;
    float m_reg = -1e30f, l_reg = 0; f32x16 o[4] = {};
    const int sr = tid >> 4, sc = (tid & 15) * 8, vst0 = v_st(sr, sc), vst1 = v_st(32 + sr, sc), kws = KSWZ(sr, sc * 2);
    const int vb0 = (int)(uintptr_t)V_lds + v_rd_base(lane);
    const bf16* Kh = cur.K; const bf16* Vh = cur.V; const int KSc = cur.KS;
#define RESC(a) do { if (__any((a) < 1.f)) { if (hi == 0) al_l[r32] = (a); asm volatile("s_waitcnt lgkmcnt(0)" ::: "memory");              \
                     for (int d_ = 0; d_ < 4; ++d_) for (int r = 0; r < 16; ++r) o[d_][r] *= al_l[crow(r, hi)]; } } while (0)
#define KBASE(t) ((j_lo + (t)) * KVBLK)
#define ACT(t) (KBASE(t) <= qlo + QBLK - 1 && KBASE(t) + KVBLK - 1 >= qlo - W + 1)
#define MASKT(P0_, P1_, t) do { const int kb_ = KBASE(t); if ((!SK || ACT(t)) && (kb_ + KVBLK - 1 > qlo || kb_ <= qlo + QBLK - 1 - W)) mask_tile(P0_, P1_, qm - kb_, (unsigned)W); } while (0)
    constexpr int NQL = 8;
    constexpr bool SK = true;
#define SEAM_K0() do { VMWN(NQL); SWRITE_HK(0); SBAR(); } while (0)
    f32x16 pA0, pA1, pB0, pB1; float mnA, mnB, alA, alB; bf16x8 pa0, pa1, pa2, pa3;
    SWRITE_HV(0); SBAR();
    if (NT > 1) { SLOAD_H(Kh, Vh, KBASE(1), KSc); }
    SBAR(); qkt<0, SK>(pA0, pA1, K_lds, r32, hi, S.qr, ACT(0));
    MASKT(pA0, pA1, 0); partialSM(pA0, pA1, m_reg, mnA, alA);
    if (NT > 1) { VMW(); SWRITE_H(1); }
    __syncthreads();
#define HALF_STEP(PX0, PX1, mnX, alX, PY0, PY1, alY, t, KB, VB, SB) do {                                                      \
        SBAR(); qkt<KB, SK>(PX0, PX1, K_lds, r32, hi, S.qr, ACT(t));                                             \
        finishSM(PY0, PY1, alY, l_reg, pa0, pa1, pa2, pa3); SBAR();                                                           \
        if ((t) + 1 < NT) { SLOAD_H(Kh, Vh, KBASE((t) + 1), KSc); SBAR(); }                                               \
        pv_tile<VB, SK>(o, vb0, pa0, pa1, pa2, pa3, ACT((t) - 1)); MASKT(PX0, PX1, (t)); partialSM(PX0, PX1, m_reg, mnX, alX);                                        \
        __syncthreads();                                                                                                      \
        if ((t) + 1 < NT) { VMW(); SWRITE_H(SB); }                                                                          \
        RESC(alX); __syncthreads(); } while (0)
    for (int t = 1; t + 1 < NT; t += 2) {
        HALF_STEP(pB0, pB1, mnB, alB, pA0, pA1, alA, t, 1, 0, 0);
        HALF_STEP(pA0, pA1, mnA, alA, pB0, pB1, alB, t + 1, 0, 1, 1);
    }
    const bool even = (NT & 1) == 0;
    if (even) { SBAR(); qkt<1, SK>(pB0, pB1, K_lds, r32, hi, S.qr, ACT(NT - 1)); SBAR(); }
    { SLOAD_H(nxt.K, nxt.V, kbn, nxt.KS); SBAR();
      const char* qb_ = (const char*)nxt.Q + (size_t)(wid * QBLK) * (size_t)nxt.QS * 2; const unsigned qo_ = (unsigned)(r32 * nxt.QS + hi * 8) * 2u;
#pragma unroll
        for (int d0 = 0; d0 < 8; ++d0) S.qr[d0] = LD8(qb_ + qo_ + d0 * 32); }
    SBAR();
    finishSM(pA0, pA1, alA, l_reg, pa0, pa1, pa2, pa3); SBAR();
    pv_tile<0, SK>(o, vb0, pa0, pa1, pa2, pa3, ACT(even ? NT - 2 : NT - 1));
    if (even) { MASKT(pB0, pB1, NT - 1); partialSM(pB0, pB1, m_reg, mnB, alB); __syncthreads(); RESC(alB);
        finishSM(pB0, pB1, alB, l_reg, pa0, pa1, pa2, pa3); SBAR(); pv_tile<1, SK>(o, vb0, pa0, pa1, pa2, pa3, ACT(NT - 1)); }
    SBAR(); SEAM_K0();
    if (hi == 0) li_l[r32] = l_reg; asm volatile("s_waitcnt lgkmcnt(0)" ::: "memory");
    if (cur.LSE != nullptr && hi == 0) cur.LSE[(size_t)(wid * QBLK + r32) * cur.LS] = __log2f(l_reg) + m_reg * (1.4426950408889634f * SCALE);
    float rli[16];
#pragma unroll
    for (int r = 0; r < 16; ++r) rli[r] = __builtin_amdgcn_rcpf(li_l[crow(r, hi)]);
    bf16* Ow = cur.O + (size_t)(wid * QBLK) * cur.OS;
#pragma unroll
    for (int r = 0; r < 16; ++r) { const int orow = crow(r, hi);
#pragma unroll
        for (int d0 = 0; d0 < 4; ++d0) { const float v = o[d0][r] * rli[r];
            const float vn = __shfl_xor(v, 1);
            if ((r32 & 1) == 0) *(unsigned*)(Ow + (size_t)orow * cur.OS + d0 * 32 + r32) = cvtpk(v, vn); } }
    __syncthreads();
#undef RESC
#undef KBASE
#undef ACT
#undef MASKT
#undef SEAM_K0
#undef HALF_STEP
}
#undef LD8
#undef ROW
#undef VMW
#undef VMWN
#undef SLOAD_H
#undef SWRITE_HK
#undef SWRITE_HV
#undef SWRITE_H
#undef KSWZ
#undef SBAR
}

constexpr int NWAVES = 8;
#ifndef MK_N_LAUNCHES
#define MK_N_LAUNCHES 1
#endif
constexpr int N_PHASES = 13;
#ifndef NAIVE_ATTN
#define NAIVE_ATTN 0
#endif
constexpr float ATT_QSCALE = NAIVE_ATTN ? QSCALE : 1.0f;

constexpr size_t MiB = 1u << 20;
constexpr size_t WS_CTL = 0, CTL_ZERO_BYTES = 1 * MiB;
constexpr size_t WS_WIN = 2 * MiB;
constexpr size_t WS_WB = 22 * MiB;
constexpr size_t WS_WO = 25 * MiB;
constexpr size_t WS_WMEM = 27 * MiB;
constexpr size_t WS_W1 = 29 * MiB;
constexpr size_t WS_W2 = 157 * MiB;
constexpr size_t WS_XN = 221 * MiB;
constexpr size_t WS_Z = 256 * MiB;
constexpr size_t WS_RW = 568 * MiB;
constexpr size_t WS_YS = 792 * MiB;
constexpr size_t WS_YABC = 824 * MiB;
constexpr size_t WS_MRG = 872 * MiB;
constexpr size_t WS_MRGB = 936 * MiB;
constexpr size_t WS_MEMN = 968 * MiB;
constexpr size_t WS_KVM = 969 * MiB;
constexpr size_t WS_XN2 = 970 * MiB;
constexpr size_t WS_ROUTE = 1002 * MiB;
constexpr size_t WS_END = 1004 * MiB;
constexpr size_t WS_XS = 256 * MiB;
constexpr size_t WS_HACT = 400 * MiB;
constexpr size_t WS_YROWS = 544 * MiB;
constexpr size_t WS_OP = WS_MRG;
constexpr size_t WS_LSE = WS_MRGB;
constexpr size_t RWSZ = (size_t)MTOK * RW * 4;
constexpr size_t RT_TOPI = 0, RT_TOPG = 256 * 1024, RT_POS = 512 * 1024, RT_ROWGATE = 768 * 1024;
static_assert(RT_ROWGATE + (size_t)MAX_SLOTS * 4 <= 1088 * 1024, "route");
constexpr int CW_TMO = 0, CW_CODE = 1;
constexpr int CW_BAR = 4096;
constexpr int CW_CNT = 16384;
constexpr int CW_CUR = 16384 + 2048;

constexpr int RING_OFF = 0, RING_BYTES = 131072;
constexpr int LDSCTL_OFF = 143360, MISC_OFF = LDSCTL_OFF + 320;
constexpr int MOETAB_OFF = MISC_OFF + 128;
constexpr int HIST_OFF = MOETAB_OFF + 1536;
constexpr int LDS_BYTES = 147456;
static_assert(HIST_OFF + 4 * 320 <= LDS_BYTES, "LDS map");
#define GAS __attribute__((address_space(1)))
#define LAS __attribute__((address_space(3)))
typedef unsigned short bf16;
typedef unsigned v4u __attribute__((ext_vector_type(4)));
typedef float f32x4 __attribute__((ext_vector_type(4)));
typedef short bf16x8 __attribute__((ext_vector_type(8)));
typedef GAS unsigned gu32;
typedef GAS unsigned long long gu64;
#define RLX_AGENT __ATOMIC_RELAXED, __HIP_MEMORY_SCOPE_AGENT
#define LDS_WAIT() asm volatile("s_waitcnt lgkmcnt(0)" ::: "memory")
#define VM_WAIT() asm volatile("s_waitcnt vmcnt(0)" ::: "memory")
__device__ __forceinline__ unsigned long long rt() { return __builtin_amdgcn_s_memrealtime(); }
__device__ __forceinline__ unsigned f2bf(float f) { unsigned u = __builtin_bit_cast(unsigned, f); return (u + 0x7fffu + ((u >> 16) & 1u)) >> 16; }
__device__ __forceinline__ unsigned pk2(float lo, float hi) { return f2bf(lo) | (f2bf(hi) << 16); }
#define XB_TMO      128
#define XB_XCNT(j)  (256  + 64 * (j))
#define XB_XSUB(j)  (1280 + 64 * (j))
#define XB_XGEN(j)  (2304 + 64 * (j))
#define XB_TOP      3328
#define XB_TOPGEN   3392
#define XCD_BAR_WORDS 3456
#define XB_SPIN_CAP (1u << 18)

__device__ __forceinline__ unsigned xb_ld(unsigned* p)              { return __hip_atomic_load(p, __ATOMIC_RELAXED, __HIP_MEMORY_SCOPE_AGENT); }
__device__ __forceinline__ unsigned xb_add(unsigned* p, unsigned v) { return __hip_atomic_fetch_add(p, v, __ATOMIC_RELAXED, __HIP_MEMORY_SCOPE_AGENT); }
__device__ __forceinline__ unsigned xb_xcc_id() { return (unsigned)__builtin_amdgcn_s_getreg((3 << 11) | 20) & 0xFu; }
#define XB_SPIN(cond, bar) do { unsigned _sp = 0; while (cond) { __builtin_amdgcn_s_sleep(1); \
    if ((++_sp & 255u) == 0u) { if (xb_ld(&(bar)[XB_TMO])) break; if (_sp > XB_SPIN_CAP) { atomicAdd(&(bar)[XB_TMO], 1u); break; } } } } while (0)

struct XcdBarrier {
    unsigned* bar; unsigned x;
    volatile LAS unsigned* st;
};

__device__ __forceinline__ XcdBarrier xcd_barrier_post(unsigned* bar, volatile LAS unsigned* st) {
    XcdBarrier b; b.bar = bar; b.x = xb_xcc_id(); b.st = st;
    if (threadIdx.x == 0) (void)xb_add(&bar[XB_XCNT(b.x)], 1u);
    return b;
}
__device__ __forceinline__ void xcd_barrier_complete(unsigned* bar, unsigned x, unsigned& nloc, unsigned& nx) {
    const unsigned G = gridDim.x * gridDim.y * gridDim.z;
    unsigned sum, cnt, mine, sp = 0u;
    for (;;) {
        sum = 0u; cnt = 0u; mine = 0u;
#pragma unroll
        for (unsigned j = 0; j < 16; ++j) { const unsigned c = xb_ld(&bar[XB_XCNT(j)]); sum += c; cnt += (c > 0u) ? 1u : 0u; mine = (j == x) ? c : mine; }
        if (sum == G) break;
        __builtin_amdgcn_s_sleep(1);
        if ((++sp & 255u) == 0u) { if (xb_ld(&bar[XB_TMO])) break; if (sp > XB_SPIN_CAP) { atomicAdd(&bar[XB_TMO], 1u); break; } }
    }
    nloc = mine > 0u ? mine : 1u; nx = cnt > 0u ? cnt : 1u;
}

__device__ __forceinline__ void xcd_barrier(const XcdBarrier& b) {
    asm volatile("s_waitcnt vmcnt(0)" ::: "memory");
    __syncthreads();
    if (threadIdx.x == 0) {
        unsigned* bar = b.bar;
        __builtin_amdgcn_s_waitcnt(0);
        unsigned nloc = b.st[0], nx = b.st[1];
        if (nloc == 0u) { xcd_barrier_complete(bar, b.x, nloc, nx); b.st[0] = nloc; b.st[1] = nx; }
        const unsigned old = xb_add(&bar[XB_XSUB(b.x)], 1u);
        const unsigned gen = old / nloc;
        if (old + 1u == (gen + 1u) * nloc) {
            __builtin_amdgcn_fence(__ATOMIC_RELEASE, "agent");
            asm volatile("s_waitcnt vmcnt(0)" ::: "memory");
            const unsigned og = xb_add(&bar[XB_TOP], 1u);
            const unsigned tg = og / nx;
            if (og + 1u == (tg + 1u) * nx) xb_add(&bar[XB_TOPGEN], 1u);
            else XB_SPIN(xb_ld(&bar[XB_TOPGEN]) == tg, bar);
            __builtin_amdgcn_fence(__ATOMIC_ACQUIRE, "agent");
            xb_add(&bar[XB_XGEN(b.x)], 1u);
            asm volatile("s_waitcnt vmcnt(0)" ::: "memory");
        } else {
            XB_SPIN(xb_ld(&bar[XB_XGEN(b.x)]) == gen, bar);
            __builtin_amdgcn_fence(__ATOMIC_ACQUIRE, "agent");
            asm volatile("s_waitcnt vmcnt(0)" ::: "memory");
        }
    }
    __syncthreads();
}

typedef float f32x2 __attribute__((ext_vector_type(2)));
struct Args { const float* in[32]; float* out; unsigned char* ws; int ph_lo, ph_hi, use_bar, pad; };
struct Frame {
    LAS unsigned char* lds;
    volatile LAS unsigned* MISC;
    gu32* ctl;
    int tid, lane, wave;
    int vcu, G;
    float* out;
    unsigned char* ws;
};
enum { I_X = 0, I_MEM, I_POS, I_NORM_MIX, I_W_IN, I_B_GATE, I_AQ_GAIN, I_AK_GAIN, I_R_MU, I_R_W0, I_R_W2, I_R_A0, I_R_A2, I_R_G2, I_R_KK, I_R_KA, I_R_RK, I_R_LNW, I_R_LNB,
       I_MEM_NORM, I_W_MEMKV, I_CQ_GAIN, I_CK_GAIN, I_W_BRANCH, I_W_OUT, I_NORM_FFN, I_ROUTER_W, I_ROUTER_B, I_EXP_W1, I_EXP_B1, I_EXP_W2, I_EXP_B2 };

__device__ __forceinline__ bool phase_enter(Frame& F, bool on) { int t = (int)threadIdx.x; asm volatile("" : "+v"(t)); F.tid = t; F.lane = t & 63; F.wave = __builtin_amdgcn_readfirstlane(t >> 6); return on; }
__device__ __forceinline__ const float* ldarg(int i) {
    const __attribute__((address_space(4))) char* ka = (const __attribute__((address_space(4))) char*)__builtin_amdgcn_kernarg_segment_ptr();
    asm volatile("" : "+s"(ka));
    return *(const float* const __attribute__((address_space(4)))*)(ka + 8 * i);
}
__device__ __forceinline__ int opq(int x) { asm volatile("" : "+v"(x)); return x; }
__device__ __forceinline__ float bf_lo(unsigned w) { return __builtin_bit_cast(float, w << 16); }
__device__ __forceinline__ float bf_hi(unsigned w) { return __builtin_bit_cast(float, w & 0xffff0000u); }
__device__ __forceinline__ float sigm(float x) { return 1.0f / (1.0f + __expf(-x)); }
template <int CTRL, int RM> __device__ __forceinline__ float dpp0(float v) {
    return __builtin_bit_cast(float, __builtin_amdgcn_update_dpp(0, __builtin_bit_cast(int, v), CTRL, RM, 0xf, true)); }
__device__ __forceinline__ float row16_sum(float v) {
    v += dpp0<0xB1, 0xf>(v); v += dpp0<0x4E, 0xf>(v); v += dpp0<0x141, 0xf>(v); v += dpp0<0x140, 0xf>(v); return v; }
__device__ __forceinline__ float rdlane(float v, int l) { return __builtin_bit_cast(float, __builtin_amdgcn_readlane(__builtin_bit_cast(int, v), l)); }
__device__ __forceinline__ float wave_sum(float v) {
    v = row16_sum(v); v += dpp0<0x142, 0xA>(v); v += dpp0<0x143, 0xC>(v); return rdlane(v, 63); }
__device__ __forceinline__ void half_sums(float v, float& lo, float& hi) {
    v = row16_sum(v); v += dpp0<0x142, 0xA>(v); lo = rdlane(v, 31); hi = rdlane(v, 63); }
__device__ __forceinline__ float wave_max_bp(float v) {
#pragma unroll
    for (int o = 1; o < 64; o <<= 1) v = fmaxf(v, __shfl_xor(v, o));
    return v; }

__device__ __forceinline__ void tconv_tile(const float* W, int K, int N, bf16* WT, int k0, int n0, int rowbase, int lane) {
    const int c = lane & 15, q = lane >> 4;
    const GAS f32x4* src = (const GAS f32x4*)(W + (size_t)(k0 + 16 * q) * N + n0 + 4 * c);
    const size_t rs = (size_t)N / 4;
    f32x4 v[16];
#pragma unroll
    for (int i = 0; i < 16; ++i) v[i] = src[i * rs];
#pragma unroll
    for (int j = 0; j < 4; ++j) {
        GAS v4u* dst = (GAS v4u*)(WT + (size_t)(rowbase + 4 * c + j) * K + k0 + 16 * q);
        v4u o0, o1;
        o0.x = pk2(v[0][j], v[1][j]); o0.y = pk2(v[2][j], v[3][j]); o0.z = pk2(v[4][j], v[5][j]); o0.w = pk2(v[6][j], v[7][j]);
        o1.x = pk2(v[8][j], v[9][j]); o1.y = pk2(v[10][j], v[11][j]); o1.z = pk2(v[12][j], v[13][j]); o1.w = pk2(v[14][j], v[15][j]);
        dst[0] = o0; dst[1] = o1;
    }
}
__device__ __forceinline__ void rms_row_to_bf16(const float* xrow, const float* gain, bf16* orow, int lane) {
    const GAS f32x4* xr = (const GAS f32x4*)xrow + lane; const GAS f32x4* gr = (const GAS f32x4*)gain + lane;
    f32x4 v[4]; float s = 0.f;
#pragma unroll
    for (int j = 0; j < 4; ++j) { v[j] = xr[64 * j]; s += (v[j].x * v[j].x + v[j].y * v[j].y) + (v[j].z * v[j].z + v[j].w * v[j].w); }
    const float rstd = 1.0f / sqrtf(wave_sum(s) * (1.f / D_MODEL) + NORM_EPS);
    GAS unsigned long long* o8 = (GAS unsigned long long*)orow + lane;
#pragma unroll
    for (int j = 0; j < 4; ++j) { const f32x4 g = gr[64 * j];
        o8[64 * j] = (unsigned long long)pk2(v[j].x * rstd * g.x, v[j].y * rstd * g.y) | ((unsigned long long)pk2(v[j].z * rstd * g.z, v[j].w * rstd * g.w) << 32); }
}
__device__ __forceinline__ void p0_prologue(Frame& F, const Args& args) {
    const int gw = F.vcu * NWAVES + F.wave, NGW = F.G * NWAVES, lane = F.lane;
    unsigned char* ws = F.ws;
    constexpr int T_IN = 16 * 156, T_WB = 3 * 128, T_WO = 256, T_WM = 256, T_W1 = 32 * 512, T_W2 = 32 * 256;
    constexpr int NT = T_IN + T_WB + T_WO + T_WM + T_W1 + T_W2;
    for (int it = gw; it < NT; it += NGW) {
        int r = it;
        if (r < T_IN) { const int kb = r / 156, nb = r % 156; tconv_tile(ldarg(I_W_IN), 1024, IN_COLS, (bf16*)(ws + WS_WIN), 64 * kb, 64 * nb, 64 * nb, lane); continue; } r -= T_IN;
        if (r < T_WB) { const int b = r / 128, q = r % 128, kb = q / 16, nb = q % 16;
            tconv_tile(ldarg(I_W_BRANCH) + (size_t)b * 512 * 1024, 512, 1024, (bf16*)(ws + WS_WB) + (size_t)b * 1024 * 512, 64 * kb, 64 * nb, 64 * nb, lane); continue; } r -= T_WB;
        if (r < T_WO) { const int kb = r / 16, nb = r % 16; tconv_tile(ldarg(I_W_OUT), 1024, 1024, (bf16*)(ws + WS_WO), 64 * kb, 64 * nb, 64 * nb, lane); continue; } r -= T_WO;
        if (r < T_WM) { const int kb = r / 16, nb = r % 16; tconv_tile(ldarg(I_W_MEMKV), 1024, 1024, (bf16*)(ws + WS_WMEM), 64 * kb, 64 * nb, 64 * nb, lane); continue; } r -= T_WM;
        if (r < T_W1) { const int e = r / 512, q = r % 512, kb = q / 32, nb = q % 32, n0 = 64 * nb;
            const int rowbase = (n0 < 1024) ? ((n0 >> 7) * 256 + (n0 & 127)) : ((((n0 - 1024) >> 7) * 256) + 128 + ((n0 - 1024) & 127));
            tconv_tile(ldarg(I_EXP_W1) + (size_t)e * 1024 * 2048, 1024, 2048, (bf16*)(ws + WS_W1) + (size_t)e * 2048 * 1024, 64 * kb, n0, rowbase, lane); continue; } r -= T_W1;
        { const int e = r / 256, q = r % 256, kb = q / 16, nb = q % 16;
            tconv_tile(ldarg(I_EXP_W2) + (size_t)e * 1024 * 1024, 1024, 1024, (bf16*)(ws + WS_W2) + (size_t)e * 1024 * 1024, 64 * kb, 64 * nb, 64 * nb, lane); }
    }
    for (int m = gw; m < MTOK; m += NGW) rms_row_to_bf16(ldarg(I_X) + (size_t)m * D_MODEL, ldarg(I_NORM_MIX), (bf16*)(ws + WS_XN) + (size_t)m * D_MODEL, lane);
    for (int m = gw; m < MEMROWS; m += NGW) rms_row_to_bf16(ldarg(I_MEM) + (size_t)m * D_MODEL, ldarg(I_MEM_NORM), (bf16*)(ws + WS_MEMN) + (size_t)m * D_MODEL, lane);
}

__device__ __forceinline__ void head_norm(bf16* p, const float* gain, bool rot, float c0, float s0, float c1, float s1, float scale, int lane) {
    GAS unsigned* pw = (GAS unsigned*)p + lane;
    const unsigned w = *pw; float a = bf_lo(w), b = bf_hi(w);
    const float ss = wave_sum(a * a + b * b);
    const float rstd = 1.0f / sqrtf(ss * (1.f / 128.f) + NORM_EPS);
    const f32x2 g = *((const GAS f32x2*)gain + lane);
    a = a * rstd * g.x; b = b * rstd * g.y;
    const float pa = __shfl_xor(a, 8), pb = __shfl_xor(b, 8);
    if (rot && lane < 16) {
        if (lane < 8) { a = a * c0 - pa * s0; b = b * c1 - pb * s1; }
        else          { a = a * c0 + pa * s0; b = b * c1 + pb * s1; }
    }
    *pw = pk2(a * scale, b * scale);
}
__device__ __forceinline__ void p2_prep(Frame& F, const Args& args) {
    const int gw = F.vcu * NWAVES + F.wave, NGW = F.G * NWAVES, lane = F.lane;
    unsigned char* ws = F.ws;
    bf16* Z = (bf16*)(ws + WS_Z);
    LAS float* lo = (LAS float*)(F.lds + RING_OFF + F.wave * 8192);
    const float* mu = ldarg(I_R_MU); const float* aqg = ldarg(I_AQ_GAIN); const float* akg = ldarg(I_AK_GAIN); const float* cqg = ldarg(I_CQ_GAIN); const int* posp = (const int*)ldarg(I_POS);
    float* Rr = (float*)(ws + WS_RW); float* Rw = Rr + (size_t)MTOK * RW; float* Rk = Rw + (size_t)MTOK * RW; float* Rv = Rk + (size_t)MTOK * RW;
    float* Ra = Rv + (size_t)MTOK * RW; float* Rb = Ra + (size_t)MTOK * RW; float* Rg = Rb + (size_t)MTOK * RW;
    for (int task = gw; task < MTOK / 4; task += NGW) {
        const int m0 = task * 4, tpos0 = m0 % SEQ, bb = m0 / SEQ;
        for (int tt = 0; tt < 4; ++tt) {
            const int m = m0 + tt;
            const float pos = (float)posp[m];
            const int i0 = 2 * (lane & 7);
            const float f0 = exp2f(-(float)i0 * (18.931568569324174f / 16.0f)), f1 = exp2f(-(float)(i0 + 1) * (18.931568569324174f / 16.0f));
            float s0, c0, s1, c1; sincosf(pos * f0, &s0, &c0); sincosf(pos * f1, &s1, &c1);
            bf16* zr = Z + (size_t)m * IN_COLS;
            for (int hd = 0; hd < 12; ++hd) head_norm(zr + OFF_AQ + hd * 128, aqg, true, c0, s0, c1, s1, ATT_QSCALE, lane);
            for (int hd = 0; hd < 12; ++hd) head_norm(zr + OFF_AK + hd * 128, akg, true, c0, s0, c1, s1, 1.0f, lane);
            for (int hd = 0; hd < 4; ++hd)  head_norm(zr + OFF_CQ + hd * 128, cqg, false, c0, s0, c1, s1, ATT_QSCALE, lane);
        }
#pragma unroll
        for (int i = 0; i < 4; ++i) { const int j = lane + 64 * i; const int col = OFF_R + 1536 + j; const float muj = mu[1536 + j];
            float prv = (tpos0 == 0) ? 0.f : __builtin_bit_cast(float, (unsigned)Z[(size_t)(m0 - 1) * IN_COLS + col] << 16);
#pragma unroll
            for (int tt = 0; tt < 4; ++tt) { const float cur = __builtin_bit_cast(float, (unsigned)Z[(size_t)(m0 + tt) * IN_COLS + col] << 16);
                float x = cur + (prv - cur) * muj; prv = cur;
                x = (i == 0) ? tanhf(x) : (i == 1) ? x : sigm(x);
                lo[j * 4 + tt] = x; } }
        LDS_WAIT(); asm volatile("" ::: "memory");
        float accw[4][8], acca[4][8], accg[4][8];
#pragma unroll
        for (int tt = 0; tt < 4; ++tt)
#pragma unroll
            for (int c = 0; c < 8; ++c) { accw[tt][c] = 0.f; acca[tt][c] = 0.f; accg[tt][c] = 0.f; }
        { const float* W2 = ldarg(I_R_W2);
          for (int j = 0; j < 64; ++j) { const f32x4 xin = *(const LAS f32x4*)(lo + j * 4);
#pragma unroll
              for (int i = 0; i < 4; ++i) { const f32x2 wv = *(const GAS f32x2*)(W2 + (size_t)j * RW + 2 * lane + 128 * i);
#pragma unroll
                  for (int tt = 0; tt < 4; ++tt) { accw[tt][2 * i] += xin[tt] * wv.x; accw[tt][2 * i + 1] += xin[tt] * wv.y; } } } }
        { const float* A2 = ldarg(I_R_A2);
          for (int j = 0; j < 64; ++j) { const f32x4 xin = *(const LAS f32x4*)(lo + (64 + j) * 4);
#pragma unroll
              for (int i = 0; i < 4; ++i) { const f32x2 wv = *(const GAS f32x2*)(A2 + (size_t)j * RW + 2 * lane + 128 * i);
#pragma unroll
                  for (int tt = 0; tt < 4; ++tt) { acca[tt][2 * i] += xin[tt] * wv.x; acca[tt][2 * i + 1] += xin[tt] * wv.y; } } } }
        { const float* G2 = ldarg(I_R_G2);
          for (int j = 0; j < 128; ++j) { const f32x4 xin = *(const LAS f32x4*)(lo + (128 + j) * 4);
#pragma unroll
              for (int i = 0; i < 4; ++i) { const f32x2 wv = *(const GAS f32x2*)(G2 + (size_t)j * RW + 2 * lane + 128 * i);
#pragma unroll
                  for (int tt = 0; tt < 4; ++tt) { accg[tt][2 * i] += xin[tt] * wv.x; accg[tt][2 * i + 1] += xin[tt] * wv.y; } } } }
        asm volatile("" ::: "memory");
#pragma unroll
        for (int i = 0; i < 4; ++i) {
            const int c = 2 * lane + 128 * i;
            const f32x2 w0 = *(const GAS f32x2*)(ldarg(I_R_W0) + c), a0 = *(const GAS f32x2*)(ldarg(I_R_A0) + c), kkc = *(const GAS f32x2*)(ldarg(I_R_KK) + c), kac = *(const GAS f32x2*)(ldarg(I_R_KA) + c);
            const f32x2 mur = *(const GAS f32x2*)(mu + c), muk = *(const GAS f32x2*)(mu + 512 + c), muv = *(const GAS f32x2*)(mu + 1024 + c);
            unsigned pr = 0u, pk = 0u, pv = 0u;
            if (tpos0 != 0) { const bf16* zp = Z + (size_t)(m0 - 1) * IN_COLS + OFF_R + c; pr = *(const GAS unsigned*)zp; pk = *(const GAS unsigned*)(zp + 512); pv = *(const GAS unsigned*)(zp + 1024); }
#pragma unroll
            for (int tt = 0; tt < 4; ++tt) {
                const size_t m = (size_t)(m0 + tt);
                const bf16* zc = Z + m * IN_COLS + OFF_R + c;
                const unsigned cr = *(const GAS unsigned*)zc, ck = *(const GAS unsigned*)(zc + 512), cv = *(const GAS unsigned*)(zc + 1024);
                f32x2 r, k, v;
                r.x = bf_lo(cr) + (bf_lo(pr) - bf_lo(cr)) * mur.x; r.y = bf_hi(cr) + (bf_hi(pr) - bf_hi(cr)) * mur.y;
                k.x = bf_lo(ck) + (bf_lo(pk) - bf_lo(ck)) * muk.x; k.y = bf_hi(ck) + (bf_hi(pk) - bf_hi(ck)) * muk.y;
                v.x = bf_lo(cv) + (bf_lo(pv) - bf_lo(cv)) * muv.x; v.y = bf_hi(cv) + (bf_hi(pv) - bf_hi(cv)) * muv.y;
                pr = cr; pk = ck; pv = cv;
                f32x2 wd, av;
                { float x0 = w0.x + accw[tt][2 * i], x1 = w0.y + accw[tt][2 * i + 1];
                  float y0 = -x0, y1 = -x1;
                  float sp0 = fmaxf(y0, 0.f) + log1pf(__expf(-fabsf(y0))), sp1 = fmaxf(y1, 0.f) + log1pf(__expf(-fabsf(y1)));
                  wd.x = -__expf(-sp0 - 0.5f); wd.y = -__expf(-sp1 - 0.5f); }
                av.x = sigm(a0.x + acca[tt][2 * i]); av.y = sigm(a0.y + acca[tt][2 * i + 1]);
                f32x2 kk; kk.x = k.x * kkc.x; kk.y = k.y * kkc.y;
                float slo, shi; half_sums(kk.x * kk.x + kk.y * kk.y, slo, shi);
                const float nrm = fmaxf(sqrtf(lane < 32 ? slo : shi), 1e-12f), inv = 1.0f / nrm;
                kk.x *= inv; kk.y *= inv;
                f32x2 k2; k2.x = k.x * (1.0f + (av.x - 1.0f) * kac.x); k2.y = k.y * (1.0f + (av.y - 1.0f) * kac.y);
                f32x2 as, bs; as.x = -kk.x; as.y = -kk.y; bs.x = kk.x * av.x; bs.y = kk.y * av.y;
                f32x2 gg; gg.x = accg[tt][2 * i]; gg.y = accg[tt][2 * i + 1];
                const size_t o = m * RW + c;
                *(GAS f32x2*)(Rr + o) = r; *(GAS f32x2*)(Rw + o) = wd; *(GAS f32x2*)(Rk + o) = k2; *(GAS f32x2*)(Rv + o) = v;
                *(GAS f32x2*)(Ra + o) = as; *(GAS f32x2*)(Rb + o) = bs; *(GAS f32x2*)(Rg + o) = gg;
            }
        }
        LDS_WAIT(); asm volatile("" ::: "memory");
    }
    for (int m = gw; m < MEMROWS; m += NGW)
        for (int hd = 0; hd < 4; ++hd) head_norm((bf16*)(ws + WS_KVM) + (size_t)m * 1024 + hd * 128, ldarg(I_CK_GAIN), false, 1.f, 0.f, 1.f, 0.f, 1.0f, lane);
}

__device__ __forceinline__ float qk_dot(const LAS float* q, const bf16* krow) {
    const GAS v4u* kp = (const GAS v4u*)krow; float s0 = 0.f, s1 = 0.f;
#pragma unroll
    for (int i = 0; i < 16; ++i) { const v4u w = kp[i]; const f32x4 qa = *(const LAS f32x4*)(q + 8 * i), qb = *(const LAS f32x4*)(q + 8 * i + 4);
        s0 += bf_lo(w.x) * qa[0] + bf_hi(w.x) * qa[1] + bf_lo(w.y) * qa[2] + bf_hi(w.y) * qa[3];
        s1 += bf_lo(w.z) * qb[0] + bf_hi(w.z) * qb[1] + bf_lo(w.w) * qb[2] + bf_hi(w.w) * qb[3]; }
    return s0 + s1;
}
__device__ __forceinline__ void p3_attention(Frame& F) {
    const int gw = F.vcu * NWAVES + F.wave, NGW = F.G * NWAVES, lane = F.lane;
    unsigned char* ws = F.ws;
    const bf16* Z = (const bf16*)(ws + WS_Z);
    const bf16* KV = (const bf16*)(ws + WS_KVM);
    bf16* YA = (bf16*)(ws + WS_YABC); bf16* YC = YA + (size_t)2 * MTOK * 512;
    LAS float* qs = (LAS float*)(F.lds + RING_OFF + F.wave * 8192);
    for (int task = gw; task < MTOK * 4; task += NGW) {
        const int m = task >> 2, h = task & 3, t = m % SEQ;
        const bf16* zrow = Z + (size_t)m * IN_COLS;
#pragma unroll
        for (int g = 0; g < 3; ++g) { const unsigned w = *((const GAS unsigned*)(zrow + OFF_AQ + g * 512 + h * 128) + lane); qs[g * 128 + 2 * lane] = bf_lo(w); qs[g * 128 + 2 * lane + 1] = bf_hi(w); }
        LDS_WAIT(); asm volatile("" ::: "memory");
        float sc[3][3]; float mx = -INFINITY;
#pragma unroll
        for (int g = 0; g < 3; ++g) { const int dl = (g == 0) ? 1 : (g == 1) ? 4 : 16;
#pragma unroll
            for (int p = 0; p < 3; ++p) { const int j = lane + 64 * p; const int tk = t - dl * j; float s = -INFINITY;
                if (j <= 128 && tk >= 0) s = qk_dot(qs + g * 128, zrow - (size_t)dl * j * IN_COLS + OFF_AK + g * 512 + h * 128);
                sc[g][p] = s; mx = fmaxf(mx, s); } }
        mx = wave_max_bp(mx);
        float den = 0.f;
#pragma unroll
        for (int g = 0; g < 3; ++g)
#pragma unroll
            for (int p = 0; p < 3; ++p) { sc[g][p] = exp2f(sc[g][p] - mx); den += sc[g][p]; }
        den = wave_sum(den);
        float o0 = 0.f, o1 = 0.f;
#pragma unroll
        for (int g = 0; g < 3; ++g) { const int dl = (g == 0) ? 1 : (g == 1) ? 4 : 16; const bf16* vb = zrow + OFF_AV + g * 512 + h * 128 + 2 * lane;
#pragma unroll
            for (int p = 0; p < 3; ++p) { const int nj = (p < 2) ? 64 : 1;
                for (int jj = 0; jj < nj; ++jj) { const int j = jj + 64 * p; const float pj = rdlane(sc[g][p], jj);
                    if (t - dl * j >= 0) { const unsigned w = *(const GAS unsigned*)(vb - (size_t)dl * j * IN_COLS); o0 += pj * bf_lo(w); o1 += pj * bf_hi(w); } } } }
        const float inv = 1.0f / den;
        *((GAS unsigned*)(YA + (size_t)m * 512 + h * 128) + lane) = pk2(o0 * inv, o1 * inv);
        asm volatile("" ::: "memory");
    }
    for (int task = gw; task < MTOK * 4; task += NGW) {
        const int m = task >> 2, h = task & 3, b = m / SEQ;
        const bf16* zrow = Z + (size_t)m * IN_COLS;
        { const unsigned w = *((const GAS unsigned*)(zrow + OFF_CQ + h * 128) + lane); qs[2 * lane] = bf_lo(w); qs[2 * lane + 1] = bf_hi(w); }
        LDS_WAIT(); asm volatile("" ::: "memory");
        const bf16* kb = KV + (size_t)b * MEM_LEN * 1024 + h * 128;
        float sc[4]; float mx = -INFINITY;
#pragma unroll
        for (int p = 0; p < 4; ++p) { sc[p] = qk_dot(qs, kb + (size_t)(lane + 64 * p) * 1024); mx = fmaxf(mx, sc[p]); }
        mx = wave_max_bp(mx);
        float den = 0.f;
#pragma unroll
        for (int p = 0; p < 4; ++p) { sc[p] = exp2f(sc[p] - mx); den += sc[p]; }
        den = wave_sum(den);
        float o0 = 0.f, o1 = 0.f; const bf16* vb = kb + 512 + 2 * lane;
#pragma unroll
        for (int p = 0; p < 4; ++p)
            for (int jj = 0; jj < 64; ++jj) { const float pj = rdlane(sc[p], jj); const unsigned w = *(const GAS unsigned*)(vb + (size_t)(jj + 64 * p) * 1024); o0 += pj * bf_lo(w); o1 += pj * bf_hi(w); }
        const float inv = 1.0f / den;
        *((GAS unsigned*)(YC + (size_t)m * 512 + h * 128) + lane) = pk2(o0 * inv, o1 * inv);
        asm volatile("" ::: "memory");
    }
}

__device__ __forceinline__ void p5_post(Frame& F, const Args& args) {
    const int gw = F.vcu * NWAVES + F.wave, NGW = F.G * NWAVES, lane = F.lane;
    unsigned char* ws = F.ws;
    const float* Rr = (const float*)(ws + WS_RW); const float* Rk = Rr + (size_t)2 * MTOK * RW; const float* Rv = Rk + (size_t)MTOK * RW; const float* Rg = Rr + (size_t)6 * MTOK * RW;
    const float* YS = (const float*)(ws + WS_YS);
    bf16* YB = (bf16*)(ws + WS_YABC) + (size_t)MTOK * 512;
    const bf16* OP = (const bf16*)(ws + WS_OP); const float* LS = (const float*)(ws + WS_LSE); bf16* YA = (bf16*)(ws + WS_YABC);
    for (int m = gw; m < MTOK; m += NGW) {
#pragma unroll
        for (int h = 0; h < 4; ++h) {
            const float l0 = LS[(size_t)m * 4 + h], l1 = LS[(size_t)MTOK * 4 + (size_t)m * 4 + h], l2 = LS[(size_t)2 * MTOK * 4 + (size_t)m * 4 + h];
            const float mx = fmaxf(l0, fmaxf(l1, l2)); const float w0 = exp2f(l0 - mx), w1 = exp2f(l1 - mx), w2 = exp2f(l2 - mx); const float inv = 1.0f / (w0 + w1 + w2);
            const size_t o = (size_t)m * 512 + h * 128;
            const unsigned a = *((const GAS unsigned*)(OP + o) + lane), b = *((const GAS unsigned*)(OP + (size_t)MTOK * 512 + o) + lane), c = *((const GAS unsigned*)(OP + (size_t)2 * MTOK * 512 + o) + lane);
            *((GAS unsigned*)(YA + o) + lane) = pk2((w0 * bf_lo(a) + w1 * bf_lo(b) + w2 * bf_lo(c)) * inv, (w0 * bf_hi(a) + w1 * bf_hi(b) + w2 * bf_hi(c)) * inv); }
    }
}

__device__ __forceinline__ void p8_router(Frame& F, const Args& args) {
    const int gw = F.vcu * NWAVES + F.wave, NGW = F.G * NWAVES, lane = F.lane;
    unsigned char* ws = F.ws;
    const float* X1 = F.out;
    LAS int* hist = (LAS int*)(F.lds + HIST_OFF);
    { const int t_ = opq(F.tid); if (t_ < 32) hist[t_] = 0; }
    __syncthreads();
    int* topi = (int*)(ws + WS_ROUTE + RT_TOPI); float* topg = (float*)(ws + WS_ROUTE + RT_TOPG);
    const float* RWt = ldarg(I_ROUTER_W); const float* RB = ldarg(I_ROUTER_B); const float* gain = ldarg(I_NORM_FFN);
    for (int m = gw; m < MTOK; m += NGW) {
        const GAS f32x4* xr = (const GAS f32x4*)(X1 + (size_t)m * D_MODEL) + lane; const GAS f32x4* gr = (const GAS f32x4*)gain + lane;
        f32x4 v[4]; float s = 0.f;
#pragma unroll
        for (int j = 0; j < 4; ++j) { v[j] = xr[64 * j]; s += (v[j].x * v[j].x + v[j].y * v[j].y) + (v[j].z * v[j].z + v[j].w * v[j].w); }
        const float rstd = 1.0f / sqrtf(wave_sum(s) * (1.f / D_MODEL) + NORM_EPS);
#pragma unroll
        for (int j = 0; j < 4; ++j) { const f32x4 g = gr[64 * j]; v[j] = v[j] * rstd * g; }
        float lg[32];
#pragma unroll
        for (int e = 0; e < 32; ++e) lg[e] = 0.f;
#pragma unroll
        for (int j = 0; j < 4; ++j)
#pragma unroll
            for (int i = 0; i < 4; ++i) { const float xv = v[j][i]; const GAS f32x4* wr = (const GAS f32x4*)(RWt + (size_t)(4 * lane + i + 256 * j) * N_EXPERTS);
#pragma unroll
                for (int q = 0; q < 8; ++q) { const f32x4 w = wr[q]; lg[4 * q] += xv * w.x; lg[4 * q + 1] += xv * w.y; lg[4 * q + 2] += xv * w.z; lg[4 * q + 3] += xv * w.w; } }
#pragma unroll
        for (int e = 0; e < 32; ++e) lg[e] = wave_sum(lg[e]) + RB[e];
        int ti[4]; float tv[4];
#pragma unroll
        for (int k = 0; k < 4; ++k) { float best = -INFINITY; int bi = 0;
#pragma unroll
            for (int e = 0; e < 32; ++e) { const bool taken = (k > 0 && ti[0] == e) || (k > 1 && ti[1] == e) || (k > 2 && ti[2] == e); if (!taken && lg[e] > best) { best = lg[e]; bi = e; } }
            ti[k] = bi; tv[k] = best; }
        const float e0 = 1.f, e1 = __expf(tv[1] - tv[0]), e2 = __expf(tv[2] - tv[0]), e3 = __expf(tv[3] - tv[0]); const float inv = 1.0f / (e0 + e1 + e2 + e3);
        if (lane < 4) { const int k = lane; const int e = (k == 0) ? ti[0] : (k == 1) ? ti[1] : (k == 2) ? ti[2] : ti[3]; const float gq = ((k == 0) ? e0 : (k == 1) ? e1 : (k == 2) ? e2 : e3) * inv;
            topi[(size_t)m * 4 + k] = e; topg[(size_t)m * 4 + k] = gq;
            __hip_atomic_fetch_add(hist + e, 1, __ATOMIC_RELAXED, __HIP_MEMORY_SCOPE_WORKGROUP); }
    }
    __syncthreads();
    { const int t_ = opq(F.tid); if (t_ < 32 && hist[t_] != 0) __hip_atomic_fetch_add((unsigned*)(F.ctl + CW_CNT) + 64 * t_, (unsigned)hist[t_], __ATOMIC_RELAXED, __HIP_MEMORY_SCOPE_AGENT); }
}
__device__ __forceinline__ void moe_table(Frame& F) {
    LAS int* tab = (LAS int*)(F.lds + MOETAB_OFF);
    __syncthreads();
    if (F.tid == 0) { int acc = 0;
        for (int e = 0; e < N_EXPERTS; ++e) { const int c = (int)__hip_atomic_load((unsigned*)(F.ctl + CW_CNT) + 64 * e, __ATOMIC_RELAXED, __HIP_MEMORY_SCOPE_AGENT); const int nb = (c + MOE_ROWS - 1) / MOE_ROWS;
            tab[320 + e] = acc * MOE_ROWS; for (int q = 0; q < nb; ++q) tab[1 + acc + q] = e; acc += nb; }
        tab[0] = acc; }
    __syncthreads();
}
__device__ __forceinline__ void p9_dispatch(Frame& F, const Args& args) {
    const int lane = F.lane;
    unsigned char* ws = F.ws;
    moe_table(F);
    const LAS int* tab = (const LAS int*)(F.lds + MOETAB_OFF);
    LAS int* hist = (LAS int*)(F.lds + HIST_OFF); LAS int* base = hist + 32; LAS int* slots = hist + 64;
    const int* topi = (const int*)(ws + WS_ROUTE + RT_TOPI); const float* topg = (const float*)(ws + WS_ROUTE + RT_TOPG);
    int* pos = (int*)(ws + WS_ROUTE + RT_POS); float* rowgate = (float*)(ws + WS_ROUTE + RT_ROWGATE);
    bf16* XS = (bf16*)(ws + WS_XS); const float* gain = ldarg(I_NORM_FFN);
    for (int grp = F.vcu; grp < MTOK / 64; grp += F.G) {
        const int t_ = opq(F.tid);
        if (t_ < 32) hist[t_] = 0;
        __syncthreads();
        int e = 0, rank = 0;
        if (F.tid < 256) { e = topi[(size_t)grp * 256 + F.tid]; rank = __hip_atomic_fetch_add(hist + e, 1, __ATOMIC_RELAXED, __HIP_MEMORY_SCOPE_WORKGROUP); }
        __syncthreads();
        if (F.tid < 32) { const int h = hist[F.tid]; int b0 = 0; if (h != 0) b0 = (int)__hip_atomic_fetch_add((unsigned*)(F.ctl + CW_CUR) + 64 * F.tid, (unsigned)h, __ATOMIC_RELAXED, __HIP_MEMORY_SCOPE_AGENT); base[F.tid] = tab[320 + F.tid] + b0; }
        __syncthreads();
        if (F.tid < 256) { const int slot = base[e] + rank; pos[(size_t)grp * 256 + F.tid] = slot; rowgate[slot] = topg[(size_t)grp * 256 + F.tid]; slots[F.tid] = slot; }
        __syncthreads();
        for (int i = 0; i < 8; ++i) { const int tl = F.wave * 8 + i; const size_t m = (size_t)grp * 64 + tl;
            const GAS f32x4* xr = (const GAS f32x4*)(F.out + m * D_MODEL) + 2 * lane; const GAS f32x4* gr = (const GAS f32x4*)gain + 2 * lane;
            f32x4 v[4]; float s = 0.f;
#pragma unroll
            for (int j = 0; j < 4; ++j) { v[j] = xr[128 * (j >> 1) + (j & 1)]; s += (v[j].x * v[j].x + v[j].y * v[j].y) + (v[j].z * v[j].z + v[j].w * v[j].w); }
            const float rstd = 1.0f / sqrtf(wave_sum(s) * (1.f / D_MODEL) + NORM_EPS);
            v4u o[2];
#pragma unroll
            for (int hf = 0; hf < 2; ++hf) { const f32x4 g0 = gr[128 * hf], g1 = gr[128 * hf + 1]; const f32x4 a = v[2 * hf] * rstd * g0, b = v[2 * hf + 1] * rstd * g1;
                o[hf].x = pk2(a.x, a.y); o[hf].y = pk2(a.z, a.w); o[hf].z = pk2(b.x, b.y); o[hf].w = pk2(b.z, b.w); }
#pragma unroll
            for (int k = 0; k < 4; ++k) { const int sk = slots[tl * 4 + k]; GAS v4u* dst = (GAS v4u*)(XS + (size_t)sk * D_MODEL) + lane; dst[0] = o[0]; dst[64] = o[1]; }
        }
        __syncthreads();
    }
}
__device__ __forceinline__ void p12_combine(Frame& F) {
    const int gw = F.vcu * NWAVES + F.wave, NGW = F.G * NWAVES, lane = F.lane;
    unsigned char* ws = F.ws;
    const int* pos = (const int*)(ws + WS_ROUTE + RT_POS); const bf16* YR = (const bf16*)(ws + WS_YROWS);
    for (int m = gw; m < MTOK; m += NGW) {
        GAS f32x4* xo = (GAS f32x4*)(F.out + (size_t)m * D_MODEL) + 2 * lane;
        int pk = 0; if (lane < 4) pk = pos[(size_t)m * 4 + lane];
#pragma unroll
        for (int hf = 0; hf < 2; ++hf) { f32x4 a = xo[128 * hf], b = xo[128 * hf + 1];
#pragma unroll
            for (int k = 0; k < 4; ++k) { const int sk = __builtin_amdgcn_readlane(pk, k); const v4u w = *((const GAS v4u*)(YR + (size_t)sk * D_MODEL + 512 * hf) + lane);
                a[0] += bf_lo(w.x); a[1] += bf_hi(w.x); a[2] += bf_lo(w.y); a[3] += bf_hi(w.y); b[0] += bf_lo(w.z); b[1] += bf_hi(w.z); b[2] += bf_lo(w.w); b[3] += bf_hi(w.w); }
            xo[128 * hf] = a; xo[128 * hf + 1] = b; }
    }
}

constexpr int N_ATT_A = 768, N_ATT_C = 256;
__device__ __forceinline__ swa::BlockRef attn_item(unsigned char* ws, int it) {
    swa::BlockRef r;
    const swa::bf16* Z = (const swa::bf16*)(ws + WS_Z);
    if (it < N_ATT_A) {
        const int h = it & 3, b = (it >> 2) & 1, v = it >> 3;
        int g, rr, qb;
        if (v < 32) { g = 0; rr = 0; qb = v; } else if (v < 64) { g = 1; rr = (v - 32) >> 3; qb = (v - 32) & 7; } else { g = 2; rr = (v - 64) >> 1; qb = (v - 64) & 1; }
        const int d = (g == 0) ? 1 : (g == 1) ? 4 : 16;
        const size_t row0 = (size_t)b * SEQ + rr, qrow = row0 + (size_t)d * qb * 256;
        r.Q = Z + qrow * IN_COLS + OFF_AQ + g * 512 + h * 128; r.K = Z + row0 * IN_COLS + OFF_AK + g * 512 + h * 128; r.V = Z + row0 * IN_COLS + OFF_AV + g * 512 + h * 128;
        r.O = (swa::bf16*)(ws + WS_OP) + (size_t)g * MTOK * 512 + qrow * 512 + h * 128; r.LSE = (float*)(ws + WS_LSE) + (size_t)g * MTOK * 4 + qrow * 4 + h;
        r.QS = d * IN_COLS; r.KS = d * IN_COLS; r.OS = d * 512; r.LS = d * 4; r.P0 = qb * 256; r.skv = SEQ / d; r.W = 129;
    } else {
        const int u = it - N_ATT_A, h = u & 3, b = (u >> 2) & 1, qb = u >> 3;
        const size_t qrow = (size_t)b * SEQ + (size_t)qb * 256;
        const swa::bf16* KV = (const swa::bf16*)(ws + WS_KVM) + (size_t)b * MEM_LEN * 1024 + h * 128;
        r.Q = Z + qrow * IN_COLS + OFF_CQ + h * 128; r.K = KV; r.V = KV + 512;
        r.O = (swa::bf16*)(ws + WS_YABC) + (size_t)2 * MTOK * 512 + qrow * 512 + h * 128; r.LSE = nullptr;
        r.QS = IN_COLS; r.KS = 1024; r.OS = 512; r.LS = 0; r.P0 = 256; r.skv = MEM_LEN; r.W = 1 << 20;
    }
    return r;
}
__device__ __forceinline__ void p3_attention_mfma(unsigned char* ws, char* lds, int G) {
    const int total = N_ATT_A + N_ATT_C; int L = blockIdx.x; if (L >= total) return;
    swa::BlockRef cur = attn_item(ws, L); swa::Seam S;
    swa::swa_prime(cur, lds, S);
    for (;;) {
        const int Ln = L + G; const bool last = Ln >= total;
        const swa::BlockRef nxt = last ? cur : attn_item(ws, Ln);
        swa::swa_block(cur, nxt, lds, S);
        if (last) break;
        cur = nxt; L = Ln;
    }
}

constexpr int N_RITEMS = BATCH * 8 * (SEQ / 64);
constexpr size_t WS_PHI = WS_XN;
constexpr size_t WS_PSI = WS_XN + 16 * MiB;
constexpr size_t WS_GAM = WS_YS;
constexpr size_t WS_OM = WS_XN2;
constexpr size_t WS_XFR = WS_MRG + 48 * MiB;
constexpr size_t WS_BONUS = WS_MRGB + 1 * MiB;
constexpr int RB = 9216, RLD = 72;
constexpr int R1_SEG = 15 * RB, R1_WC = R1_SEG + 2048;
static_assert(R1_WC + 256 <= LDSCTL_OFF, "R1 LDS map");
typedef LAS unsigned short* lbf_t;
__device__ __forceinline__ f32x4 r1_tile(const LAS unsigned short* X, const LAS unsigned short* Yt, int mi, int ni, f32x4 acc, int fr, int fq) {
    const LAS unsigned short* xp = X + (16 * mi + fr) * RLD + 8 * fq; const LAS unsigned short* yp = Yt + (16 * ni + fr) * RLD + 8 * fq;
    const bf16x8 a0 = *(const LAS bf16x8*)xp, a1 = *(const LAS bf16x8*)(xp + 32), b0 = *(const LAS bf16x8*)yp, b1 = *(const LAS bf16x8*)(yp + 32);
    acc = __builtin_amdgcn_mfma_f32_16x16x32_bf16(b0, a0, acc, 0, 0, 0);
    acc = __builtin_amdgcn_mfma_f32_16x16x32_bf16(b1, a1, acc, 0, 0, 0);
    return acc;
}
__device__ __forceinline__ void r1_store(LAS unsigned short* dst, int mi, int ni, f32x4 acc, int mode, bool addI, const LAS unsigned short* addT, int fr, int fq) {
    const int m = 16 * mi + fr, n0 = 16 * ni + 4 * fq;
#pragma unroll
    for (int r = 0; r < 4; ++r) { const int n = n0 + r; bool keep = true;
        if (mode == 1) keep = n < m; else if (mode == 2) keep = n <= m; else if (mode == 3) keep = m < n;
        float v = keep ? acc[r] : 0.f; if (addI && m == n) v += 1.0f; acc[r] = v; }
    if (addT != nullptr) { const unsigned long long w = *(const LAS unsigned long long*)(addT + m * RLD + n0);
        acc[0] += bf_lo((unsigned)w); acc[1] += bf_hi((unsigned)w); acc[2] += bf_lo((unsigned)(w >> 32)); acc[3] += bf_hi((unsigned)(w >> 32)); }
    *(LAS unsigned long long*)(dst + m * RLD + n0) = (unsigned long long)pk2(acc[0], acc[1]) | ((unsigned long long)pk2(acc[2], acc[3]) << 32);
}
#define R1BUF(i) ((LAS unsigned short*)(F.lds + (i) * RB))
__device__ __forceinline__ void p_r1(Frame& F, const Args& args) {
    unsigned char* ws = F.ws; const int lane = F.lane, wave = F.wave, fr = lane & 15, fq = lane >> 4;
    const float* Rr = (const float*)(ws + WS_RW); const float* Rw = Rr + (size_t)MTOK * RW; const float* Rk = Rw + (size_t)MTOK * RW; const float* Rv = Rk + (size_t)MTOK * RW;
    const float* Ra = Rv + (size_t)MTOK * RW; const float* Rb = Ra + (size_t)MTOK * RW;
    const float* rkp = ldarg(I_R_RK);
    LAS float* segsum = (LAS float*)(F.lds + R1_SEG); LAS float* wcs = (LAS float*)(F.lds + R1_WC);
    for (int item = F.vcu; item < N_RITEMS; item += F.G) {
        const int bh = item >> 7, c = item & 127, b = bh >> 3, h = bh & 7;
        const size_t row0 = (size_t)b * SEQ + (size_t)c * 64;
        { const int k = lane, tq = wave; const size_t g0 = (row0 + 8 * tq) * RW + h * 64 + k;
          float r[8], lw[8], kx[8], vx[8], ax[8], bx[8];
#pragma unroll
          for (int i = 0; i < 8; ++i) { const size_t g = g0 + (size_t)i * RW; r[i] = *(const GAS float*)(Rr + g); lw[i] = *(const GAS float*)(Rw + g); kx[i] = *(const GAS float*)(Rk + g);
              vx[i] = *(const GAS float*)(Rv + g); ax[i] = *(const GAS float*)(Ra + g); bx[i] = *(const GAS float*)(Rb + g); }
          float cs[8]; cs[0] = lw[0];
#pragma unroll
          for (int i = 1; i < 8; ++i) cs[i] = cs[i - 1] + lw[i];
          segsum[tq * 64 + k] = cs[7];
          const float rk = rkp[h * 64 + k];
#pragma unroll
          for (int i = 0; i < 8; ++i) { const float bs = wave_sum(r[i] * kx[i] * rk); if (lane == 0) *(GAS float*)((float*)(ws + WS_BONUS) + (row0 + 8 * tq + i) * 8 + h) = bs; }
          __syncthreads();
          float pre = 0.f;
#pragma unroll
          for (int q = 0; q < 7; ++q) { const float sv = segsum[q * 64 + k]; pre += (q < tq) ? sv : 0.f; }
          unsigned short at[8], rt[8], bt[8], kt[8], vt[8];
#pragma unroll
          for (int i = 0; i < 8; ++i) { const float L = pre + cs[i], Lp = L - lw[i]; const float e = __expf(L), ep = __expf(Lp), ei = __expf(-L);
              at[i] = (unsigned short)f2bf(ax[i] * ep); rt[i] = (unsigned short)f2bf(r[i] * e); bt[i] = (unsigned short)f2bf(bx[i] * ei); kt[i] = (unsigned short)f2bf(kx[i] * ei); vt[i] = (unsigned short)f2bf(vx[i]);
              if (i == 7 && tq == 7) wcs[k] = e; }
#pragma unroll
          for (int i = 0; i < 8; ++i) { const int o = (8 * tq + i) * RLD + k; R1BUF(8)[o] = at[i]; R1BUF(4)[o] = rt[i]; R1BUF(9)[o] = bt[i]; R1BUF(10)[o] = kt[i]; }
          const int ot = k * RLD + 8 * tq;
#define PK8(x) ((v4u){(unsigned)x[0] | ((unsigned)x[1] << 16), (unsigned)x[2] | ((unsigned)x[3] << 16), (unsigned)x[4] | ((unsigned)x[5] << 16), (unsigned)x[6] | ((unsigned)x[7] << 16)})
          *(LAS v4u*)(R1BUF(0) + ot) = PK8(at); *(LAS v4u*)(R1BUF(1) + ot) = PK8(bt); *(LAS v4u*)(R1BUF(2) + ot) = PK8(kt); *(LAS v4u*)(R1BUF(3) + ot) = PK8(vt);
#undef PK8
        }
        __syncthreads();
        const f32x4 zero4 = (f32x4){0.f, 0.f, 0.f, 0.f};
#pragma unroll 1
        for (int q = 0; q < 10; ++q) { const int id = wave + 8 * q, prod = id >> 4, tl = id & 15, mi = tl >> 2, ni = tl & 3;
            const LAS unsigned short* X = (prod == 1) ? R1BUF(9) : (prod >= 3) ? R1BUF(4) : R1BUF(8);
            const LAS unsigned short* Y = (prod == 0 || prod == 3) ? R1BUF(9) : (prod == 1) ? R1BUF(8) : R1BUF(10);
            const f32x4 acc = r1_tile(X, Y, mi, ni, zero4, fr, fq);
            if (prod == 0) { r1_store(R1BUF(11), mi, ni, acc, 1, false, nullptr, fr, fq); r1_store(R1BUF(13), mi, ni, acc, 1, true, nullptr, fr, fq); }
            else if (prod == 1) r1_store(R1BUF(12), mi, ni, acc, 3, false, nullptr, fr, fq);
            else if (prod == 2) r1_store(R1BUF(5), mi, ni, acc, 1, false, nullptr, fr, fq);
            else if (prod == 3) r1_store(R1BUF(6), mi, ni, acc, 2, false, nullptr, fr, fq);
            else r1_store(R1BUF(7), mi, ni, acc, 2, false, nullptr, fr, fq); }
        __syncthreads();
#pragma unroll 1
        for (int q = 0; q < 6; ++q) { const int id = wave + 8 * q, prod = id >> 4, tl = id & 15, mi = tl >> 2, ni = tl & 3;
            const LAS unsigned short* X = (prod == 0) ? R1BUF(11) : (prod == 1) ? R1BUF(12) : R1BUF(3);
            const LAS unsigned short* Y = (prod == 0) ? R1BUF(12) : (prod == 1) ? R1BUF(11) : R1BUF(5);
            const f32x4 acc = r1_tile(X, Y, mi, ni, zero4, fr, fq);
            r1_store(prod == 0 ? R1BUF(8) : prod == 1 ? R1BUF(9) : R1BUF(10), mi, ni, acc, 0, false, nullptr, fr, fq); }
        __syncthreads();
#pragma unroll 1
        for (int lv = 0; lv < 5; ++lv) {
            const bool srcB = (lv & 1) == 0;
            LAS unsigned short* sN = srcB ? R1BUF(8) : R1BUF(11); LAS unsigned short* sNT = srcB ? R1BUF(9) : R1BUF(12);
            LAS unsigned short* dN = srcB ? R1BUF(11) : R1BUF(8); LAS unsigned short* dNT = srcB ? R1BUF(12) : R1BUF(9);
            LAS unsigned short* Tc = (lv & 1) ? R1BUF(14) : R1BUF(13); LAS unsigned short* Tn = (lv & 1) ? R1BUF(13) : R1BUF(14);
            const int nprod = (lv < 3) ? 3 : (lv == 3) ? 2 : 1;
#pragma unroll 1
            for (int q = 0; q < 2 * nprod; ++q) { const int id = wave + 8 * q, p = id >> 4, tl = id & 15, mi = tl >> 2, ni = tl & 3;
                if (p == 0) { const f32x4 acc = r1_tile(Tc, sNT, mi, ni, zero4, fr, fq); r1_store(Tn, mi, ni, acc, 0, false, Tc, fr, fq); }
                else if (p == 1) { const f32x4 acc = r1_tile(sNT, sN, mi, ni, zero4, fr, fq); r1_store(dNT, mi, ni, acc, 0, false, nullptr, fr, fq); }
                else { const f32x4 acc = r1_tile(sN, sNT, mi, ni, zero4, fr, fq); r1_store(dN, mi, ni, acc, 0, false, nullptr, fr, fq); } }
            __syncthreads();
        }
#pragma unroll 1
        for (int q = 0; q < 4; ++q) { const int id = wave + 8 * q, prod = id >> 4, tl = id & 15, mi = tl >> 2, ni = tl & 3;
            const f32x4 acc = r1_tile(prod == 0 ? R1BUF(0) : R1BUF(10), R1BUF(14), mi, ni, zero4, fr, fq);
            r1_store(prod == 0 ? R1BUF(11) : R1BUF(12), mi, ni, acc, 0, false, nullptr, fr, fq); }
        __syncthreads();
        { const int mi = wave >> 1, ks = wave & 1;
          const f32x4 p0 = r1_tile(R1BUF(1), R1BUF(11), mi, 2 * ks, zero4, fr, fq), p1 = r1_tile(R1BUF(1), R1BUF(11), mi, 2 * ks + 1, zero4, fr, fq);
          const f32x4 s0 = r1_tile(R1BUF(6), R1BUF(11), mi, 2 * ks, zero4, fr, fq), s1 = r1_tile(R1BUF(6), R1BUF(11), mi, 2 * ks + 1, zero4, fr, fq);
          const int m = 16 * mi + fr; const float wc = wcs[m];
          float ph[8], ps[8];
#pragma unroll
          for (int r = 0; r < 4; ++r) { const int n0 = 32 * ks + 4 * fq + r, n1 = n0 + 16;
              ph[r] = (p0[r] + (m == n0 ? 1.f : 0.f)) * wc; ph[4 + r] = (p1[r] + (m == n1 ? 1.f : 0.f)) * wc; }
          { const unsigned long long w0 = *(const LAS unsigned long long*)(R1BUF(4) + m * RLD + 32 * ks + 4 * fq), w1 = *(const LAS unsigned long long*)(R1BUF(4) + m * RLD + 32 * ks + 16 + 4 * fq);
            ps[0] = s0[0] + bf_lo((unsigned)w0); ps[1] = s0[1] + bf_hi((unsigned)w0); ps[2] = s0[2] + bf_lo((unsigned)(w0 >> 32)); ps[3] = s0[3] + bf_hi((unsigned)(w0 >> 32));
            ps[4] = s1[0] + bf_lo((unsigned)w1); ps[5] = s1[1] + bf_hi((unsigned)w1); ps[6] = s1[2] + bf_lo((unsigned)(w1 >> 32)); ps[7] = s1[3] + bf_hi((unsigned)(w1 >> 32)); }
          const size_t fo = (((size_t)item * 4 + mi) * 2 + ks) * 64 + lane;
          *((GAS v4u*)(ws + WS_PHI) + fo) = (v4u){pk2(ph[0], ph[1]), pk2(ph[2], ph[3]), pk2(ph[4], ph[5]), pk2(ph[6], ph[7])};
          *((GAS v4u*)(ws + WS_PSI) + fo) = (v4u){pk2(ps[0], ps[1]), pk2(ps[2], ps[3]), pk2(ps[4], ps[5]), pk2(ps[6], ps[7])};
          const int vb = wave >> 1;
#pragma unroll
          for (int hh = 0; hh < 2; ++hh) { const int mt = 2 * (wave & 1) + hh;
              f32x4 ga = r1_tile(R1BUF(12), R1BUF(1), vb, mt, zero4, fr, fq); ga = r1_tile(R1BUF(3), R1BUF(2), vb, mt, ga, fr, fq);
              f32x4 om = r1_tile(R1BUF(12), R1BUF(6), vb, mt, zero4, fr, fq); om = r1_tile(R1BUF(3), R1BUF(7), vb, mt, om, fr, fq);
#pragma unroll
              for (int r = 0; r < 4; ++r) ga[r] *= wcs[16 * mt + 4 * fq + r];
              const size_t ao = (((size_t)item * 4 + vb) * 4 + mt) * 64 + lane;
              *((GAS f32x4*)(ws + WS_GAM) + ao) = ga; *((GAS f32x4*)(ws + WS_OM) + ao) = om; }
        }
        __syncthreads();
    }
}
#undef R1BUF
struct R2Buf { bf16x8 ph[4][2]; f32x4 ga[4]; };
__device__ __forceinline__ void r2_load(R2Buf& B, const unsigned char* ws, int item, int vb, int lane) {
#pragma unroll
    for (int mt = 0; mt < 4; ++mt) {
#pragma unroll
        for (int ks = 0; ks < 2; ++ks) B.ph[mt][ks] = *((const GAS bf16x8*)(ws + WS_PHI) + (((size_t)item * 4 + mt) * 2 + ks) * 64 + lane);
        B.ga[mt] = *((const GAS f32x4*)(ws + WS_GAM) + (((size_t)item * 4 + vb) * 4 + mt) * 64 + lane); }
}
__device__ __forceinline__ void r2_step(const R2Buf& B, f32x4 (&acc)[4], unsigned char* ws, int item, int vb, int lane) {
    v4u x0, x1;
    x0.x = pk2(acc[0][0], acc[0][1]); x0.y = pk2(acc[0][2], acc[0][3]); x0.z = pk2(acc[1][0], acc[1][1]); x0.w = pk2(acc[1][2], acc[1][3]);
    x1.x = pk2(acc[2][0], acc[2][1]); x1.y = pk2(acc[2][2], acc[2][3]); x1.z = pk2(acc[3][0], acc[3][1]); x1.w = pk2(acc[3][2], acc[3][3]);
    GAS v4u* xo = (GAS v4u*)(ws + WS_XFR) + (((size_t)item * 4 + vb) * 2) * 64 + lane; xo[0] = x0; xo[64] = x1;
    const bf16x8 f0 = __builtin_bit_cast(bf16x8, x0), f1 = __builtin_bit_cast(bf16x8, x1);
#pragma unroll
    for (int mt = 0; mt < 4; ++mt) { f32x4 a = B.ga[mt];
        a = __builtin_amdgcn_mfma_f32_16x16x32_bf16(B.ph[mt][0], f0, a, 0, 0, 0);
        a = __builtin_amdgcn_mfma_f32_16x16x32_bf16(B.ph[mt][1], f1, a, 0, 0, 0);
        acc[mt] = a; }
}
__device__ __forceinline__ void p_r2(Frame& F) {
    if (blockIdx.x < BATCH * 8 && F.wave < 4) {
        unsigned char* ws = F.ws; const int bh = blockIdx.x, vb = F.wave, lane = F.lane;
        f32x4 acc[4];
#pragma unroll
        for (int i = 0; i < 4; ++i) acc[i] = (f32x4){0.f, 0.f, 0.f, 0.f};
        R2Buf A, B;
        r2_load(A, ws, bh * 128, vb, lane);
        for (int c = 0; c < 128; c += 2) {
            r2_load(B, ws, bh * 128 + c + 1, vb, lane);
            r2_step(A, acc, ws, bh * 128 + c, vb, lane);
            if (c + 2 < 128) r2_load(A, ws, bh * 128 + c + 2, vb, lane);
            r2_step(B, acc, ws, bh * 128 + c + 1, vb, lane);
        }
    }
}
__device__ __forceinline__ void p_r3(Frame& F, const Args& args) {
    const int gw = F.vcu * NWAVES + F.wave, NGW = F.G * NWAVES, lane = F.lane, cc = lane & 15, q = lane >> 4;
    unsigned char* ws = F.ws;
    const float* Rv = (const float*)(ws + WS_RW) + (size_t)3 * MTOK * RW; const float* Rg = (const float*)(ws + WS_RW) + (size_t)6 * MTOK * RW;
    const float* bonus = (const float*)(ws + WS_BONUS);
    bf16* YB = (bf16*)(ws + WS_YABC) + (size_t)MTOK * 512;
    const float* lnw = ldarg(I_R_LNW); const float* lnb = ldarg(I_R_LNB);
    for (int wi = gw; wi < N_RITEMS * 4; wi += NGW) {
        const int item = wi >> 2, tt = wi & 3, bh = item >> 7, c = item & 127, b = bh >> 3, h = bh & 7;
        const bf16x8 ps0 = *((const GAS bf16x8*)(ws + WS_PSI) + (((size_t)item * 4 + tt) * 2 + 0) * 64 + lane), ps1 = *((const GAS bf16x8*)(ws + WS_PSI) + (((size_t)item * 4 + tt) * 2 + 1) * 64 + lane);
        f32x4 acc[4];
#pragma unroll
        for (int vb = 0; vb < 4; ++vb) {
            const bf16x8 x0 = *((const GAS bf16x8*)(ws + WS_XFR) + (((size_t)item * 4 + vb) * 2 + 0) * 64 + lane), x1 = *((const GAS bf16x8*)(ws + WS_XFR) + (((size_t)item * 4 + vb) * 2 + 1) * 64 + lane);
            f32x4 a = *((const GAS f32x4*)(ws + WS_OM) + (((size_t)item * 4 + vb) * 4 + tt) * 64 + lane);
            a = __builtin_amdgcn_mfma_f32_16x16x32_bf16(ps0, x0, a, 0, 0, 0);
            a = __builtin_amdgcn_mfma_f32_16x16x32_bf16(ps1, x1, a, 0, 0, 0);
            acc[vb] = a; }
        const size_t rowb = (size_t)b * SEQ + (size_t)c * 64 + 16 * tt + 4 * q;
#pragma unroll
        for (int r = 0; r < 4; ++r) { const size_t t = rowb + r;
            const float s = (acc[0][r] + acc[1][r]) + (acc[2][r] + acc[3][r]);
            const float mean = row16_sum(s) * (1.f / 64.f);
            const float d0 = acc[0][r] - mean, d1 = acc[1][r] - mean, d2 = acc[2][r] - mean, d3 = acc[3][r] - mean;
            const float var = row16_sum((d0 * d0 + d1 * d1) + (d2 * d2 + d3 * d3)) * (1.f / 64.f);
            const float rstd = 1.0f / sqrtf(var + R_GN_EPS);
            const float bn = bonus[t * 8 + h];
#pragma unroll
            for (int vb = 0; vb < 4; ++vb) { const int ch = h * 64 + 16 * vb + cc; const float d = (vb == 0) ? d0 : (vb == 1) ? d1 : (vb == 2) ? d2 : d3;
                const float yn = d * rstd * lnw[ch] + lnb[ch];
                const float vv = *(const GAS float*)(Rv + t * RW + ch), gg = *(const GAS float*)(Rg + t * RW + ch);
                YB[t * 512 + ch] = (bf16)f2bf((yn + bn * vv) * gg); } }
    }
}

__global__ void __launch_bounds__(NWAVES * 64, 2) skel_fwd(Args args) {
    extern __shared__ __attribute__((aligned(16))) unsigned char lds[];
    Frame F;
    F.lds = (LAS unsigned char*)lds;
    F.MISC = (volatile LAS unsigned*)(F.lds + MISC_OFF);
    phase_enter(F, true);
    F.G = gridDim.x; { const int bx = blockIdx.x; F.vcu = (F.G % 8 == 0) ? (bx % 8) * (F.G / 8) + bx / 8 : bx; }
    unsigned char* ws = args.ws; F.ws = ws; F.out = args.out;
    F.ctl = (gu32*)(ws + WS_CTL);
    for (int u = F.tid; u < (LDS_BYTES - LDSCTL_OFF) / 4; u += NWAVES * 64) ((LAS unsigned*)(F.lds + LDSCTL_OFF))[u] = 0u;
    __syncthreads();
    XcdBarrier bar; bar.bar = (unsigned*)(F.ctl + CW_BAR); bar.x = 0; bar.st = nullptr;
    if (args.use_bar) bar = xcd_barrier_post((unsigned*)(F.ctl + CW_BAR), F.MISC + 8);
    const int lo = args.ph_lo, hi = args.ph_hi;
#define IN(k) (phase_enter(F, lo <= (k) && (k) < hi))
#define SEAM(k) do { if (lo <= (k) && (k) + 1 < hi) xcd_barrier(bar); } while (0)
    const pg8::bf16_t* wsb = (const pg8::bf16_t*)ws;
#define BF(off) ((pg8::bf16_t*)(ws + (off)))

    if (IN(0)) { p0_prologue(F, args); } SEAM(0);
    if (IN(1)) {
        { pg8::Gemm g{BF(WS_XN), BF(WS_WIN), MTOK, IN_COLS, 1024}; pg8::StaticOrder S; S.init(MTOK, IN_COLS, F.G, (int)blockIdx.x);
          pg8::EpiBf16<0> E{BF(WS_Z), IN_COLS, nullptr, 0, 0, 1.f};
          pg8::gemm_phase<pg8::EpiBf16<0>, pg8::StaticOrder, true, true>(F.lds + RING_OFF, g, S, E); }
        { pg8::Gemm g{BF(WS_MEMN), BF(WS_WMEM), MEMROWS, 1024, 1024}; pg8::StaticOrder S; S.init(MEMROWS, 1024, F.G, (int)blockIdx.x);
          pg8::EpiBf16<0> E{BF(WS_KVM), 1024, nullptr, 0, 0, 1.f};
          pg8::gemm_phase<pg8::EpiBf16<0>, pg8::StaticOrder, true, true>(F.lds + RING_OFF, g, S, E); }
    } SEAM(1);
    if (IN(2)) { p2_prep(F, args); } SEAM(2);
#if NAIVE_ATTN
    if (IN(3)) { p3_attention(F); } SEAM(3);
#else
    if (IN(3)) { p3_attention_mfma(ws, (char*)lds + RING_OFF, F.G); __syncthreads(); phase_enter(F, true); p_r1(F, args); } SEAM(3);
#endif
    if (IN(4)) { p_r2(F); } SEAM(4);
    if (IN(5)) { p_r3(F, args); p5_post(F, args); } SEAM(5);
    if (IN(6)) {
        for (int br = 0; br < 3; ++br) {
            pg8::Gemm g{BF(WS_YABC) + (size_t)br * MTOK * 512, BF(WS_WB) + (size_t)br * 1024 * 512, MTOK, 1024, 512}; pg8::StaticOrder S; S.init(MTOK, 1024, F.G, (int)blockIdx.x);
            pg8::EpiGate E{BF(WS_Z), ldarg(I_B_GATE), (float*)(ws + WS_MRG), BF(WS_MRGB), br};
            pg8::gemm_phase<pg8::EpiGate, pg8::StaticOrder, true, true>(F.lds + RING_OFF, g, S, E);
        }
    } SEAM(6);
    if (IN(7)) {
        pg8::Gemm g{BF(WS_MRGB), BF(WS_WO), MTOK, 1024, 1024}; pg8::StaticOrder S; S.init(MTOK, 1024, F.G, (int)blockIdx.x);
        pg8::EpiResF32 E{ldarg(I_X), F.out, 1024};
        pg8::gemm_phase<pg8::EpiResF32, pg8::StaticOrder, true, true>(F.lds + RING_OFF, g, S, E);
    } SEAM(7);
    if (IN(8)) { p8_router(F, args); } SEAM(8);
    if (IN(9)) { p9_dispatch(F, args); } SEAM(9);
    if (IN(10)) {
        moe_table(F);
        pg8::Gemm g{BF(WS_XS), BF(WS_W1), 0, 0, 1024}; pg8::MoeOrder S{(const PG8_LAS int*)(F.lds + MOETAB_OFF), 8, F.G, (int)blockIdx.x};
        pg8::EpiSwiGLU E{ldarg(I_EXP_B1), BF(WS_HACT)};
        pg8::gemm_phase<pg8::EpiSwiGLU, pg8::MoeOrder, true, true>(F.lds + RING_OFF, g, S, E);
    } SEAM(10);
    if (IN(11)) {
        moe_table(F);
        pg8::Gemm g{BF(WS_HACT), BF(WS_W2), 0, 0, 1024}; pg8::MoeOrder S{(const PG8_LAS int*)(F.lds + MOETAB_OFF), 4, F.G, (int)blockIdx.x};
        pg8::EpiMoeOut E{ldarg(I_EXP_B2), (const float*)(ws + WS_ROUTE + RT_ROWGATE), BF(WS_YROWS)};
        pg8::gemm_phase<pg8::EpiMoeOut, pg8::MoeOrder, true, true>(F.lds + RING_OFF, g, S, E);
    } SEAM(11);
    if (IN(12)) { p12_combine(F); }
#undef IN
#undef SEAM
#undef BF
    (void)wsb;
}

extern "C" void kernel_launch(void* const* d_in, const int* in_sizes, int n_in, void* d_out, int out_size, void* d_ws, size_t ws_size, hipStream_t stream) {
    static int grid = 0;
    if (grid == 0) {
        if (n_in != 32 || out_size != MTOK * D_MODEL || ws_size < WS_END) { fprintf(stderr, "kernel_launch: unexpected problem (n_in %d, out %d, ws %zu); nothing launched\n", n_in, out_size, ws_size); grid = -1; return; }
        int dev = 0, cus = 0;
        if (hipGetDevice(&dev) != hipSuccess || hipDeviceGetAttribute(&cus, hipDeviceAttributeMultiprocessorCount, dev) != hipSuccess) { grid = -1; return; }
        if (hipFuncSetAttribute((const void*)skel_fwd, hipFuncAttributeMaxDynamicSharedMemorySize, LDS_BYTES) != hipSuccess) { fprintf(stderr, "kernel_launch: hipFuncSetAttribute failed\n"); grid = -1; return; }
        (void)hipGetLastError();
        grid = cus;
    }
    if (grid < 0) return;
    (void)hipMemsetAsync((char*)d_ws + WS_CTL, 0, CTL_ZERO_BYTES, stream);
    Args a{};
    for (int i = 0; i < 32; ++i) a.in[i] = (const float*)d_in[i];
    a.out = (float*)d_out; a.ws = (unsigned char*)d_ws;
#if MK_N_LAUNCHES == 1
    a.ph_lo = 0; a.ph_hi = N_PHASES; a.use_bar = 1;
    hipLaunchKernelGGL(skel_fwd, dim3(grid), dim3(NWAVES * 64), LDS_BYTES, stream, a);
#else
    for (int p = 0; p < N_PHASES; ++p) { a.ph_lo = p; a.ph_hi = p + 1; a.use_bar = 0;
        hipLaunchKernelGGL(skel_fwd, dim3(grid), dim3(NWAVES * 64), LDS_BYTES, stream, a); }
#endif
}
```

```cpp
#include <hip/hip_runtime.h>
#include <cstdio>
#include <cstdint>
#include <cmath>
namespace pg8 {
#define PG8_LAS __attribute__((address_space(3)))
typedef unsigned short bf16_t;
typedef short bf16x8 __attribute__((ext_vector_type(8)));
typedef float f32x4 __attribute__((ext_vector_type(4)));
typedef unsigned u32x4 __attribute__((ext_vector_type(4)));
constexpr int BM = 256, BK = 64, HALF = 128, HTB = HALF * BK * 2  , STAGE_BYTES = 8 * HTB, NXCD = 8, WGM = 8;

__host__ __device__ __forceinline__ int lds_byte(int r, int c) { const int st = (r >> 4) * 2 + (c >> 5), rr = r & 15, cc = c & 31, ob = rr * 64 + cc * 2; return st * 1024 + (ob ^ (((ob >> 9) & 1) << 5)); }
__host__ __device__ __forceinline__ void stage_rc(int b, int& R, int& C) { const int st = b / 1024, sb = b % 1024, swz = sb ^ (((sb >> 9) & 1) << 5); R = (st >> 1) * 16 + swz / 64; C = (st & 1) * 32 + (swz % 64) / 2; }
__host__ __device__ __forceinline__ int perm32(int rho) { const int n = rho >> 4, i = rho & 15; return 8 * (i >> 2) + 4 * n + (i & 3); }

struct Unit { int pm, pn; };
struct Gemm { const bf16_t* A; const bf16_t* Bt; int M, N, K; };

struct StaticOrder {
    int nM, nN, nwg, G, c;
    __host__ __device__ void init(int M, int N, int G_, int c_) { nM = M / BM; nN = N / BM; nwg = nM * nN; G = G_; c = c_; }
    __host__ __device__ bool next(int i, Unit& u) const {
        const long L = (long)i * G + c; if (L >= nwg) return false;
        int wgid = (int)L; { const int q = nwg / NXCD, r = nwg % NXCD, xcd = wgid % NXCD, off = wgid / NXCD; wgid = (xcd < r ? xcd * (q + 1) : r * (q + 1) + (xcd - r) * q) + off; }
        const int nig = WGM * nN, gid = wgid / nig, fm = gid * WGM, gsz = (nM - fm) < WGM ? (nM - fm) : WGM;
        u.pm = fm + ((wgid % nig) % gsz); u.pn = (wgid % nig) / gsz; return true;
    }
    __device__ __forceinline__ void a_ready(const Unit&) const {}
    __device__ __forceinline__ void done(const Unit&) const {}
};

__device__ __forceinline__ unsigned cvt_pk_bf16(float lo, float hi) { unsigned r; asm volatile("v_cvt_pk_bf16_f32 %0, %1, %2" : "=v"(r) : "v"(lo), "v"(hi)); return r; }
typedef float f32x2 __attribute__((ext_vector_type(2)));
__device__ __forceinline__ f32x2 gelu_pk(f32x2 v) {
    const f32x2 av = __builtin_elementwise_abs(v), d = av * 0.2316418882f + 1.0f;
    f32x2 t; t.x = __builtin_amdgcn_rcpf(d.x); t.y = __builtin_amdgcn_rcpf(d.y);
    f32x2 q = t * 0.5307027145f + (-0.7265760135f); q = q * t + 0.7107068705f; q = q * t + (-0.142248368f); q = q * t + 0.127414796f; q = q * t;
    const f32x2 s = (v * v) * (-0.72134752044f);
    f32x2 e; e.x = __builtin_amdgcn_exp2f(s.x); e.y = __builtin_amdgcn_exp2f(s.y);
    const f32x2 m = v * (q * e), r = v - m;
    f32x2 o; o.x = v.x < 0.f ? m.x : r.x; o.y = v.y < 0.f ? m.y : r.y; return o;
}

template <int ACT  > struct EpiBf16 {
    static constexpr bool PERM = true, AFTER_DRAIN = false; static_assert(ACT == 0 || ACT == 1, "EpiBf16: ACT is 0 (none) or 1 (gelu_pk)");
    bf16_t* O; int ldc; const float* bias; int split_cols; size_t split_stride; float scale0;
    __device__ __forceinline__ void operator()(const f32x4 (&acc)[2][2][4][2], const Unit& u, int wr, int wc, int fr, int fq) const {
        const int row0 = u.pm * BM + wr * 64 + fr; int colt = u.pn * BM; bf16_t* base = O;
        float sc = 1.f; if (split_cols) { const int t = colt / split_cols; base += (size_t)t * split_stride; colt -= t * split_cols; if (t == 0) sc = scale0; }
        const int col0 = colt + wc * 32 + 8 * fq, bcol0 = u.pn * BM + wc * 32 + 8 * fq;
        f32x4 bv[2][2];
#pragma unroll
        for (int bj = 0; bj < 2; ++bj)
#pragma unroll
            for (int n = 0; n < 2; ++n) bv[bj][n] = bias ? *(const f32x4*)(bias + bcol0 + bj * HALF + 4 * n) : (f32x4){0.f, 0.f, 0.f, 0.f};
#pragma unroll
        for (int ai = 0; ai < 2; ++ai)
#pragma unroll
            for (int m = 0; m < 4; ++m) { bf16_t* rowp = base + (size_t)(row0 + ai * HALF + m * 16) * ldc + col0;
#pragma unroll
                for (int bj = 0; bj < 2; ++bj) { f32x4 v0 = acc[ai][bj][m][0] + bv[bj][0], v1 = acc[ai][bj][m][1] + bv[bj][1];
                    if (ACT == 1) { f32x2 a = gelu_pk((f32x2){v0[0], v0[1]}), b = gelu_pk((f32x2){v0[2], v0[3]}), c = gelu_pk((f32x2){v1[0], v1[1]}), d = gelu_pk((f32x2){v1[2], v1[3]});
                        v0 = (f32x4){a.x, a.y, b.x, b.y}; v1 = (f32x4){c.x, c.y, d.x, d.y}; }
                    v0 = v0 * sc; v1 = v1 * sc; u32x4 w; w.x = cvt_pk_bf16(v0[0], v0[1]); w.y = cvt_pk_bf16(v0[2], v0[3]); w.z = cvt_pk_bf16(v1[0], v1[1]); w.w = cvt_pk_bf16(v1[2], v1[3]);
                    *(u32x4*)(rowp + bj * HALF) = w; } }
    }
};
template <class Epi, class Sched, bool ALIGN_EPI = false, bool SP2 = false>
__device__ __forceinline__ void gemm_phase(PG8_LAS unsigned char* lds, const Gemm g, const Sched& S, const Epi& E) {
    int tid_ = threadIdx.x; asm volatile("" : "+v"(tid_));
    const int tid = tid_, wid = __builtin_amdgcn_readfirstlane(tid >> 6), lane = tid & 63, wr = wid >> 2, wc = wid & 3, fr = lane & 15, fq = lane >> 4;
    const int K = g.K, nt = K / BK;
    unsigned voffA[2], voffB[2];
#pragma unroll
    for (int i = 0; i < 2; ++i) { int R, C; stage_rc(tid * 16 + i * 8192, R, C); const int Rb = Epi::PERM ? ((R & ~31) + perm32(R & 31)) : R;
        voffA[i] = (unsigned)(R * K + C) * 2u; voffB[i] = (unsigned)(Rb * K + C) * 2u; }
    const size_t kstep = (size_t)(BK * 2);
    const size_t hstep = (size_t)HALF * K * 2;
    const size_t tstep = 2 * hstep;
    const unsigned ldsw = (unsigned)wid * 1024u;
    const int aoff = lds_byte(wr * 64 + fr, fq * 8), boff = lds_byte(wc * 32 + fr, fq * 8);
#define PG8_SA(b, h) (((b) * 2 + (h)) * HTB)
#define PG8_SB(b, h) ((4 + (b) * 2 + (h)) * HTB)
#define PG8_STAGE(bufoff, gbase, voff) do { _Pragma("unroll") for (int _i = 0; _i < 2; ++_i) \
        __builtin_amdgcn_global_load_lds((const unsigned*)((const char*)(gbase) + (voff)[_i]), (PG8_LAS unsigned*)(lds + (bufoff) + ldsw + _i * 8192), 16, 0, 0); } while (0)
#define PG8_LDA(dst, b, h) do { _Pragma("unroll") for (int m = 0; m < 4; ++m) _Pragma("unroll") for (int k = 0; k < 2; ++k) dst[m][k] = *(const PG8_LAS bf16x8*)(lds + PG8_SA(b, h) + aoff + m * 2048 + k * 1024); } while (0)
#define PG8_LDB(dst, b, h) do { _Pragma("unroll") for (int n = 0; n < 2; ++n) _Pragma("unroll") for (int k = 0; k < 2; ++k) dst[n][k] = *(const PG8_LAS bf16x8*)(lds + PG8_SB(b, h) + boff + n * 2048 + k * 1024); } while (0)
#define PG8_MMA(ai, bj, At, Bt) do { __builtin_amdgcn_s_setprio(1); _Pragma("unroll") for (int m = 0; m < 4; ++m) _Pragma("unroll") for (int n = 0; n < 2; ++n) _Pragma("unroll") for (int k = 0; k < 2; ++k) \
        acc[ai][bj][m][n] = __builtin_amdgcn_mfma_f32_16x16x32_bf16(Bt[n][k], At[m][k], acc[ai][bj][m][n], 0, 0, 0); __builtin_amdgcn_s_setprio(0); } while (0)
#define PG8_WAIT_V(n) asm volatile("s_waitcnt vmcnt(" #n ")" ::: "memory")
#define PG8_WAIT_L(n) asm volatile("s_waitcnt lgkmcnt(" #n ")" ::: "memory")
#define PG8_BAR __builtin_amdgcn_s_barrier()
#define PG8_SCHED __builtin_amdgcn_sched_barrier(0)
    Unit cur, nxt; int ui = 0;
    if (!S.next(0, cur)) return;
    f32x4 acc[2][2][4][2];
#pragma unroll
    for (int a = 0; a < 2; ++a)
#pragma unroll
        for (int b = 0; b < 2; ++b)
#pragma unroll
            for (int m = 0; m < 4; ++m)
#pragma unroll
                for (int n = 0; n < 2; ++n) acc[a][b][m][n] = (f32x4){0.f, 0.f, 0.f, 0.f};
    bf16x8 At[4][2], B0[2][2], B1[2][2];
    const char* cA = (const char*)g.A + (size_t)cur.pm * tstep; const char* cB = (const char*)g.Bt + (size_t)cur.pn * tstep;
    S.a_ready(cur);
    if constexpr (SP2) {
        PG8_STAGE(PG8_SB(0, 0), cB, voffB); PG8_STAGE(PG8_SB(0, 1), cB + hstep, voffB); PG8_STAGE(PG8_SA(0, 0), cA, voffA); PG8_STAGE(PG8_SA(0, 1), cA + hstep, voffA);
        if (wr == 1) PG8_BAR;
        PG8_WAIT_V(2); PG8_BAR;
        PG8_STAGE(PG8_SB(1, 0), cB + kstep, voffB); PG8_STAGE(PG8_SA(1, 0), cA + kstep, voffA); PG8_STAGE(PG8_SB(1, 1), cB + hstep + kstep, voffB);
        PG8_WAIT_V(6); PG8_BAR;
    } else {
        PG8_STAGE(PG8_SB(0, 0), cB, voffB); PG8_STAGE(PG8_SA(0, 0), cA, voffA); PG8_STAGE(PG8_SB(0, 1), cB + hstep, voffB); PG8_STAGE(PG8_SA(0, 1), cA + hstep, voffA);
        if (wr == 1) PG8_BAR;
        PG8_WAIT_V(4); PG8_BAR;
        PG8_STAGE(PG8_SB(1, 0), cB + kstep, voffB); PG8_STAGE(PG8_SA(1, 0), cA + kstep, voffA); PG8_STAGE(PG8_SB(1, 1), cB + hstep + kstep, voffB);
        PG8_WAIT_V(6); PG8_BAR;
    }
    for (;;) {
        const bool has_next = S.next(ui + 1, nxt);
        const char* nA = has_next ? (const char*)g.A + (size_t)nxt.pm * tstep : cA; const char* nB = has_next ? (const char*)g.Bt + (size_t)nxt.pn * tstep : cB;
        for (int t = 0; t < nt; t += 2) {
            const bool last = (t == nt - 2);
            const char* a1 = cA + (size_t)(t + 1) * kstep;
            const char* a2 = last ? nA : cA + (size_t)(t + 2) * kstep; const char* b2 = last ? nB : cB + (size_t)(t + 2) * kstep;
            const char* a3 = a2 + kstep; const char* b3 = b2 + kstep;
            if (last && has_next) S.a_ready(nxt);
            if constexpr (SP2) {
            PG8_LDB(B0, 0, 0); PG8_LDB(B1, 0, 1); PG8_SCHED; PG8_LDA(At, 0, 0); PG8_STAGE(PG8_SA(1, 1), a1 + hstep, voffA);
            PG8_WAIT_V(8); PG8_WAIT_L(0); PG8_BAR; PG8_MMA(0, 0, At, B0); PG8_MMA(0, 1, At, B1); PG8_BAR; PG8_SCHED;
            PG8_LDA(At, 0, 1); PG8_STAGE(PG8_SB(0, 0), b2, voffB); PG8_STAGE(PG8_SB(0, 1), b2 + hstep, voffB); PG8_STAGE(PG8_SA(0, 0), a2, voffA);
            PG8_WAIT_V(8); PG8_WAIT_L(0); PG8_BAR; PG8_MMA(1, 0, At, B0); PG8_MMA(1, 1, At, B1); PG8_BAR; PG8_SCHED;
            PG8_LDB(B0, 1, 0); PG8_LDB(B1, 1, 1); PG8_SCHED; PG8_LDA(At, 1, 0); PG8_STAGE(PG8_SA(0, 1), a2 + hstep, voffA);
            PG8_WAIT_V(8); PG8_WAIT_L(0); PG8_BAR; PG8_MMA(0, 0, At, B0); PG8_MMA(0, 1, At, B1); PG8_BAR; PG8_SCHED;
            PG8_LDA(At, 1, 1); PG8_STAGE(PG8_SB(1, 0), b3, voffB); PG8_STAGE(PG8_SB(1, 1), b3 + hstep, voffB); PG8_STAGE(PG8_SA(1, 0), a3, voffA);
            PG8_WAIT_V(8); PG8_WAIT_L(0); PG8_BAR; PG8_MMA(1, 0, At, B0); PG8_MMA(1, 1, At, B1); PG8_BAR; PG8_SCHED;
            } else {
            PG8_LDB(B0, 0, 0); PG8_SCHED; PG8_LDA(At, 0, 0); PG8_STAGE(PG8_SA(1, 1), a1 + hstep, voffA);
            PG8_WAIT_L(8); PG8_BAR; PG8_WAIT_L(0); PG8_MMA(0, 0, At, B0); PG8_BAR; PG8_SCHED;
            PG8_LDB(B1, 0, 1); PG8_STAGE(PG8_SB(0, 0), b2, voffB);
            PG8_BAR; PG8_WAIT_L(0); PG8_MMA(0, 1, At, B1); PG8_BAR;
            PG8_LDA(At, 0, 1); PG8_STAGE(PG8_SA(0, 0), a2, voffA);
            PG8_BAR; PG8_WAIT_L(0); PG8_MMA(1, 0, At, B0); PG8_BAR; PG8_SCHED;
            PG8_STAGE(PG8_SB(0, 1), b2 + hstep, voffB);
            PG8_WAIT_V(6); PG8_BAR; PG8_MMA(1, 1, At, B1); PG8_BAR;
            PG8_LDB(B0, 1, 0); PG8_SCHED; PG8_LDA(At, 1, 0); PG8_STAGE(PG8_SA(0, 1), a2 + hstep, voffA);
            PG8_WAIT_L(8); PG8_BAR; PG8_WAIT_L(0); PG8_MMA(0, 0, At, B0); PG8_BAR; PG8_SCHED;
            PG8_LDB(B1, 1, 1); PG8_STAGE(PG8_SB(1, 0), b3, voffB);
            PG8_BAR; PG8_WAIT_L(0); PG8_MMA(0, 1, At, B1); PG8_BAR;
            PG8_LDA(At, 1, 1); PG8_STAGE(PG8_SA(1, 0), a3, voffA);
            PG8_BAR; PG8_WAIT_L(0); PG8_MMA(1, 0, At, B0); PG8_BAR; PG8_SCHED;
            PG8_STAGE(PG8_SB(1, 1), b3 + hstep, voffB);
            PG8_WAIT_V(6); PG8_BAR; PG8_MMA(1, 1, At, B1); PG8_BAR;
            }
        }
        if constexpr (ALIGN_EPI) { if (wr == 0) PG8_BAR; }
        if constexpr (!Epi::AFTER_DRAIN) { E(acc, cur, wr, wc, fr, fq); S.done(cur); }
        if (!has_next) break;
#pragma unroll
        for (int a = 0; a < 2; ++a)
#pragma unroll
            for (int b = 0; b < 2; ++b)
#pragma unroll
                for (int m = 0; m < 4; ++m)
#pragma unroll
                    for (int n = 0; n < 2; ++n) acc[a][b][m][n] = (f32x4){0.f, 0.f, 0.f, 0.f};
        cur = nxt; cA = nA; cB = nB; ++ui;
        if constexpr (ALIGN_EPI) { if (wr == 1) PG8_BAR; }
    }
    PG8_WAIT_V(0);
    if constexpr (!ALIGN_EPI) { if (wr == 0) PG8_BAR; }
    PG8_BAR;
    if constexpr (Epi::AFTER_DRAIN) { E.fused(acc, cur, wr, wc, fr, fq, lds, wid, lane); S.done(cur); }
#undef PG8_SA
#undef PG8_SB
#undef PG8_STAGE
#undef PG8_LDA
#undef PG8_LDB
#undef PG8_MMA
#undef PG8_WAIT_V
#undef PG8_WAIT_L
#undef PG8_BAR
#undef PG8_SCHED
}
}

constexpr int D_MODEL = 1024, BATCH = 2, SEQ = 8192, MTOK = BATCH * SEQ, MEM_LEN = 256, MEMROWS = BATCH * MEM_LEN;
constexpr int IN_COLS = 9984, OFF_AQ = 0, OFF_AK = 1536, OFF_AV = 3072, OFF_R = 4608, OFF_CQ = 6400, OFF_GATE = 6912;
constexpr int RW = 512;
constexpr int N_EXPERTS = 32, TOP_K = 4, D_FF = 1024, MOE_ROWS = 256;
constexpr int MAX_BLOCKS = MTOK * TOP_K / MOE_ROWS + N_EXPERTS;
constexpr int MAX_SLOTS = MAX_BLOCKS * MOE_ROWS;
constexpr float NORM_EPS = 1e-6f, R_GN_EPS = 64e-5f;
constexpr float LOG2E = 1.4426950408889634f;
constexpr float QSCALE = 0.08838834764831845f * LOG2E;

namespace pg8 {
__device__ __forceinline__ float bf_lo(unsigned w) { return __builtin_bit_cast(float, w << 16); }
__device__ __forceinline__ float bf_hi(unsigned w) { return __builtin_bit_cast(float, w & 0xffff0000u); }
__device__ __forceinline__ float sigmoidf_fast(float x) { return 1.0f / (1.0f + __expf(-x)); }

struct EpiGate {
    static constexpr bool PERM = true, AFTER_DRAIN = false;
    const bf16_t* Z; const float* bgate; float* merged; bf16_t* mergedb; int br;
    __device__ __forceinline__ void operator()(const f32x4 (&acc)[2][2][4][2], const Unit& u, int wr, int wc, int fr, int fq) const {
        const int row0 = u.pm * BM + wr * 64 + fr, col0 = u.pn * BM + wc * 32 + 8 * fq;
#pragma unroll
        for (int ai = 0; ai < 2; ++ai)
#pragma unroll
            for (int m = 0; m < 4; ++m) { const int row = row0 + ai * HALF + m * 16;
#pragma unroll
                for (int bj = 0; bj < 2; ++bj) { const int col = col0 + bj * HALF;
                    const u32x4 gz = *(const u32x4*)(Z + (size_t)row * IN_COLS + OFF_GATE + br * D_MODEL + col);
                    const f32x4 b0 = *(const f32x4*)(bgate + br * D_MODEL + col), b1 = *(const f32x4*)(bgate + br * D_MODEL + col + 4);
                    f32x4 g0, g1;
                    g0[0] = sigmoidf_fast(bf_lo(gz[0]) + b0[0]); g0[1] = sigmoidf_fast(bf_hi(gz[0]) + b0[1]); g0[2] = sigmoidf_fast(bf_lo(gz[1]) + b0[2]); g0[3] = sigmoidf_fast(bf_hi(gz[1]) + b0[3]);
                    g1[0] = sigmoidf_fast(bf_lo(gz[2]) + b1[0]); g1[1] = sigmoidf_fast(bf_hi(gz[2]) + b1[1]); g1[2] = sigmoidf_fast(bf_lo(gz[3]) + b1[2]); g1[3] = sigmoidf_fast(bf_hi(gz[3]) + b1[3]);
                    f32x4 v0 = acc[ai][bj][m][0] * g0, v1 = acc[ai][bj][m][1] * g1;
                    float* mp = merged + (size_t)row * D_MODEL + col;
                    if (br > 0) { v0 += *(const f32x4*)mp; v1 += *(const f32x4*)(mp + 4); }
                    if (br < 2) { *(f32x4*)mp = v0; *(f32x4*)(mp + 4) = v1; }
                    else { u32x4 w; w.x = cvt_pk_bf16(v0[0], v0[1]); w.y = cvt_pk_bf16(v0[2], v0[3]); w.z = cvt_pk_bf16(v1[0], v1[1]); w.w = cvt_pk_bf16(v1[2], v1[3]);
                        *(u32x4*)(mergedb + (size_t)row * D_MODEL + col) = w; } } }
    }
};
struct EpiResF32 {
    static constexpr bool PERM = true, AFTER_DRAIN = false;
    const float* base; float* out; int ldc;
    __device__ __forceinline__ void operator()(const f32x4 (&acc)[2][2][4][2], const Unit& u, int wr, int wc, int fr, int fq) const {
        const int row0 = u.pm * BM + wr * 64 + fr, col0 = u.pn * BM + wc * 32 + 8 * fq;
#pragma unroll
        for (int ai = 0; ai < 2; ++ai)
#pragma unroll
            for (int m = 0; m < 4; ++m) { const size_t off = (size_t)(row0 + ai * HALF + m * 16) * ldc + col0;
#pragma unroll
                for (int bj = 0; bj < 2; ++bj) { const float* bp = base + off + bj * HALF; float* op = out + off + bj * HALF;
                    const f32x4 x0 = *(const f32x4*)bp, x1 = *(const f32x4*)(bp + 4);
                    *(f32x4*)op = x0 + acc[ai][bj][m][0]; *(f32x4*)(op + 4) = x1 + acc[ai][bj][m][1]; } }
    }
};
struct EpiSwiGLU {
    static constexpr bool PERM = true, AFTER_DRAIN = false;
    const float* b1; bf16_t* H;
    __device__ __forceinline__ void operator()(const f32x4 (&acc)[2][2][4][2], const Unit& u, int wr, int wc, int fr, int fq) const {
        const int e = u.pn >> 3, pnl = u.pn & 7;
        const int row0 = u.pm * BM + wr * 64 + fr, ac = pnl * HALF + wc * 32 + 8 * fq;
        const float* bg = b1 + (size_t)e * 2 * D_FF + ac; const float* bl = bg + D_FF;
        const f32x4 bg0 = *(const f32x4*)bg, bg1 = *(const f32x4*)(bg + 4), bl0 = *(const f32x4*)bl, bl1 = *(const f32x4*)(bl + 4);
#pragma unroll
        for (int ai = 0; ai < 2; ++ai)
#pragma unroll
            for (int m = 0; m < 4; ++m) { const int row = row0 + ai * HALF + m * 16;
                float a[8];
#pragma unroll
                for (int n = 0; n < 2; ++n) { const f32x4 ug = acc[ai][0][m][n] + (n ? bg1 : bg0), ul = acc[ai][1][m][n] + (n ? bl1 : bl0);
#pragma unroll
                    for (int j = 0; j < 4; ++j) { const float g = fminf(ug[j], 7.0f), l = fminf(fmaxf(ul[j], -7.0f), 7.0f);
                        a[4 * n + j] = g * sigmoidf_fast(1.702f * g) * (l + 1.0f); } }
                u32x4 w; w.x = cvt_pk_bf16(a[0], a[1]); w.y = cvt_pk_bf16(a[2], a[3]); w.z = cvt_pk_bf16(a[4], a[5]); w.w = cvt_pk_bf16(a[6], a[7]);
                *(u32x4*)(H + (size_t)row * D_FF + ac) = w; }
    }
};
struct EpiMoeOut {
    static constexpr bool PERM = true, AFTER_DRAIN = false;
    const float* b2; const float* rowgate; bf16_t* Y;
    __device__ __forceinline__ void operator()(const f32x4 (&acc)[2][2][4][2], const Unit& u, int wr, int wc, int fr, int fq) const {
        const int e = u.pn >> 2, pnl = u.pn & 3;
        const int row0 = u.pm * BM + wr * 64 + fr, col0 = pnl * BM + wc * 32 + 8 * fq;
#pragma unroll
        for (int ai = 0; ai < 2; ++ai)
#pragma unroll
            for (int m = 0; m < 4; ++m) { const int row = row0 + ai * HALF + m * 16; const float gt = rowgate[row];
#pragma unroll
                for (int bj = 0; bj < 2; ++bj) { const int col = col0 + bj * HALF; const float* bp = b2 + (size_t)e * D_MODEL + col;
                    const f32x4 v0 = (acc[ai][bj][m][0] + *(const f32x4*)bp) * gt, v1 = (acc[ai][bj][m][1] + *(const f32x4*)(bp + 4)) * gt;
                    u32x4 w; w.x = cvt_pk_bf16(v0[0], v0[1]); w.y = cvt_pk_bf16(v0[2], v0[3]); w.z = cvt_pk_bf16(v1[0], v1[1]); w.w = cvt_pk_bf16(v1[2], v1[3]);
                    *(u32x4*)(Y + (size_t)row * D_MODEL + col) = w; } }
    }
};
struct MoeOrder {
    const PG8_LAS int* tab;
    int NT, G, c;
    __device__ __forceinline__ bool next(int i, Unit& u) const {
        const int nblk = tab[0]; const long L = (long)i * G + c; if (L >= (long)nblk * NT) return false;
        const int blk = (int)(L / NT), pnl = (int)(L % NT); u.pm = blk; u.pn = tab[1 + blk] * NT + pnl; return true;
    }
    __device__ __forceinline__ void a_ready(const Unit&) const {}
    __device__ __forceinline__ void done(const Unit&) const {}
};
}

namespace swa {
constexpr int D = 128;
constexpr float SCALE = 0.08838834764831845f;
constexpr float THR = 8.f;
constexpr int NW = 8, QBLK = 32, KVBLK = 64, QB = NW * QBLK;
constexpr int SHM_V = KVBLK * D * 2, SHM_K = KVBLK * D * 2;
constexpr int LDS_BYTES = 2 * SHM_V + 2 * SHM_K + NW * 64 * 4;
using bf16 = unsigned short;
typedef short bf16x8 __attribute__((ext_vector_type(8)));
typedef short s16x4 __attribute__((ext_vector_type(4)));
typedef float f32x16 __attribute__((ext_vector_type(16)));
typedef float f32x4 __attribute__((ext_vector_type(4)));
typedef unsigned u32x4 __attribute__((ext_vector_type(4)));
template <class A, class Bt> struct same_t { static constexpr bool v = false; };
template <class A> struct same_t<A, A> { static constexpr bool v = true; };
#define KSWZ(row, colB) ((row) * 256 + ((colB) ^ (((row) & 7) << 4)))
#define SBAR() __builtin_amdgcn_sched_barrier(0)
__device__ __forceinline__ int v_st(int k, int c) { const int kk = (k & ~0xC) | ((k & 4) << 1) | ((k & 8) >> 1); return ((kk >> 3) * 4 + (c >> 5)) * 512 + ((kk & 7) * 32 + (c & 31)) * 2; }
__device__ __forceinline__ int v_rd_base(int lane) { return ((lane & 3) << 3) | (((lane >> 2) & 3) << 6) | (((lane >> 4) & 1) << 5) | (((lane >> 5) & 1) << 8); }
constexpr int v_rd_off(int d0, int ks, int half) { return d0 * 512 + ks * 4096 + half * 2048; }
__device__ __forceinline__ int crow(int r, int hi) { return (r & 3) + 8 * (r >> 2) + 4 * hi; }
__device__ __forceinline__ unsigned cvtpk(float lo, float hi) {
    unsigned r; asm volatile("v_cvt_pk_bf16_f32 %0, %1, %2" : "=v"(r) : "v"(lo), "v"(hi)); return r;
}
__device__ __forceinline__ bf16x8 pack8(f32x4 a, f32x4 b) {
    u32x4 w = {cvtpk(a[0], a[1]), cvtpk(a[2], a[3]), cvtpk(b[0], b[1]), cvtpk(b[2], b[3])};
    return *reinterpret_cast<bf16x8*>(&w);
}
template <class T> __device__ __forceinline__ bf16x8 load8(const T* p) {
    if constexpr (same_t<T, float>::v) { return pack8(*(const f32x4*)p, *(const f32x4*)(p + 4)); }
    else { return *reinterpret_cast<const bf16x8*>(p); }
}
__device__ __forceinline__ void mask_tile(f32x16& p0, f32x16& p1, int dq, unsigned W) {
    const float NEG = -__builtin_inff();
#pragma unroll
    for (int r = 0; r < 16; ++r) {
        const int c = (r & 3) + 8 * (r >> 2);
        if ((unsigned)(dq - c) >= W) p0[r] = NEG;
        if ((unsigned)(dq - c - 32) >= W) p1[r] = NEG;
    }
}
__device__ __forceinline__ void partialSM(f32x16& p0, f32x16& p1, float& m_reg, float& mn, float& alpha) {
    float pmax = p0[0]; for (int r = 1; r < 16; ++r) pmax = fmaxf(pmax, p0[r]); for (int r = 0; r < 16; ++r) pmax = fmaxf(pmax, p1[r]);
    { auto rr = __builtin_amdgcn_permlane32_swap(__float_as_uint(pmax), __float_as_uint(pmax), false, false);
      pmax = fmaxf(__uint_as_float(rr[0]), __uint_as_float(rr[1])); }
    constexpr float C2 = 1.4426950408889634f * SCALE;
    if (__builtin_expect(__all((pmax - m_reg) * SCALE <= THR), 1)) { mn = m_reg; alpha = 1.f; }
    else { mn = fmaxf(m_reg, pmax); alpha = __builtin_amdgcn_exp2f((m_reg - mn) * C2); m_reg = mn; }
    const float mnL = -mn * C2;
    for (int r = 0; r < 16; ++r) p0[r] = fmaf(p0[r], C2, mnL); for (int r = 0; r < 16; ++r) p1[r] = fmaf(p1[r], C2, mnL);
    for (int r = 0; r < 16; ++r) p0[r] = __builtin_amdgcn_exp2f(p0[r]);
}
__device__ __forceinline__ void finishSM(f32x16& p0, f32x16& p1, float alpha, float& l_reg, bf16x8& pa0, bf16x8& pa1, bf16x8& pa2, bf16x8& pa3) {
    for (int r = 0; r < 16; ++r) p1[r] = __builtin_amdgcn_exp2f(p1[r]);
    float ps = 0; for (int r = 0; r < 16; ++r) ps += p0[r]; for (int r = 0; r < 16; ++r) ps += p1[r];
    { auto rr = __builtin_amdgcn_permlane32_swap(__float_as_uint(ps), __float_as_uint(ps), false, false);
      ps = __uint_as_float(rr[0]) + __uint_as_float(rr[1]); }
    l_reg = l_reg * alpha + ps;
#define PK4(P, B_, OUT) do { unsigned a0 = cvtpk(P[B_+0], P[B_+1]), a1 = cvtpk(P[B_+2], P[B_+3]);                          \
        unsigned b0 = cvtpk(P[B_+4], P[B_+5]), b1 = cvtpk(P[B_+6], P[B_+7]);                                             \
        auto r0 = __builtin_amdgcn_permlane32_swap(a0, b0, false, false); auto r1 = __builtin_amdgcn_permlane32_swap(a1, b1, false, false); \
        u32x4 w = {r0[0], r1[0], r0[1], r1[1]}; OUT = *reinterpret_cast<bf16x8*>(&w); } while (0)
    PK4(p0, 0, pa0); PK4(p0, 8, pa1); PK4(p1, 0, pa2); PK4(p1, 8, pa3);
#undef PK4
}
template <int KB, bool SK>
__device__ __forceinline__ void qkt(f32x16& p0, f32x16& p1, const char* K_lds, int r32, int hi, const bf16x8* qr, bool act) {
    if (SK && !act) { const float NEG = -__builtin_inff();
#pragma unroll
        for (int r = 0; r < 16; ++r) { p0[r] = NEG; p1[r] = NEG; } return; }
    p0 = f32x16{}; p1 = f32x16{};
    const char* kb[4];
#pragma unroll
    for (int dd = 0; dd < 4; ++dd) kb[dd] = K_lds + KB * SHM_K + KSWZ(r32, (dd * 16 + hi * 8) * 2);
#pragma unroll
    for (int d0 = 0; d0 < 8; ++d0) { const char* a = kb[d0 & 3] + (d0 >> 2) * 128;
        bf16x8 b0 = *reinterpret_cast<const bf16x8*>(a);
        bf16x8 b1 = *reinterpret_cast<const bf16x8*>(a + 32 * 256);
        p0 = __builtin_amdgcn_mfma_f32_32x32x16_bf16(b0, qr[d0], p0, 0, 0, 0);
        p1 = __builtin_amdgcn_mfma_f32_32x32x16_bf16(b1, qr[d0], p1, 0, 0, 0); }
}
template <int VB, bool SK>
__device__ __forceinline__ void pv_tile(f32x16* o, int vb0, bf16x8 pa0, bf16x8 pa1, bf16x8 pa2, bf16x8 pa3, bool act) {
    if (SK && !act) return;
#define TRRD(dst, off) asm volatile("ds_read_b64_tr_b16 %0, %1 offset:%2" : "=&v"(dst) : "v"(vb0), "i"(off) : "memory")
#define PV_D0(d0) do { s16x4 l0, l1, l2, l3, h0, h1, h2, h3; constexpr int b_ = VB * SHM_V + v_rd_off(d0, 0, 0);     \
        TRRD(l0, b_); TRRD(h0, b_ + 2048); TRRD(l1, b_ + 4096); TRRD(h1, b_ + 6144); TRRD(l2, b_ + 8192); TRRD(h2, b_ + 10240); TRRD(l3, b_ + 12288); TRRD(h3, b_ + 14336); \
        asm volatile("s_waitcnt lgkmcnt(0)" ::: "memory"); SBAR();                 \
        o[d0] = __builtin_amdgcn_mfma_f32_32x32x16_bf16(pa0, (bf16x8){l0[0], l0[1], l0[2], l0[3], h0[0], h0[1], h0[2], h0[3]}, o[d0], 0, 0, 0);   \
        o[d0] = __builtin_amdgcn_mfma_f32_32x32x16_bf16(pa1, (bf16x8){l1[0], l1[1], l1[2], l1[3], h1[0], h1[1], h1[2], h1[3]}, o[d0], 0, 0, 0);   \
        o[d0] = __builtin_amdgcn_mfma_f32_32x32x16_bf16(pa2, (bf16x8){l2[0], l2[1], l2[2], l2[3], h2[0], h2[1], h2[2], h2[3]}, o[d0], 0, 0, 0);   \
        o[d0] = __builtin_amdgcn_mfma_f32_32x32x16_bf16(pa3, (bf16x8){l3[0], l3[1], l3[2], l3[3], h3[0], h3[1], h3[2], h3[3]}, o[d0], 0, 0, 0); } while (0)
    PV_D0(0); PV_D0(1); PV_D0(2); PV_D0(3);
#undef PV_D0
#undef TRRD
}

struct BlockRef { const bf16* Q; const bf16* K; const bf16* V; bf16* O; float* LSE; int QS, KS, OS, LS, P0, skv, W; };
struct Seam { bf16x8 qr[8]; bf16x8 st_v0, st_v1, st_k0, st_k1; };
__device__ __forceinline__ int swa_jlo(int P0, int W) { const int lowk = P0 - W + 1; return lowk > 0 ? lowk / KVBLK : 0; }
#define LD8(p) (*reinterpret_cast<const bf16x8*>(p))
#define ROW(p, k0, rr, RS) ((p) + (size_t)((k0) + (rr)) * (RS) + sc)
#define VMW() asm volatile("s_waitcnt vmcnt(0)" ::: "memory")
#define VMWN(n) asm volatile("s_waitcnt vmcnt(%0)" :: "i"(n) : "memory")
#define SLOAD_H(Kp, Vp, k0, RS) do { const char* kb_ = (const char*)(Kp) + (size_t)(k0) * (size_t)(RS) * 2; const char* vb_ = (const char*)(Vp) + (size_t)(k0) * (size_t)(RS) * 2;  \
                         const unsigned oa_ = (unsigned)(sr * (RS) + sc) * 2u, ob_ = oa_ + (unsigned)(RS) * 64u;                                    \
                         S.st_v0 = LD8(vb_ + oa_); S.st_v1 = LD8(vb_ + ob_); S.st_k0 = LD8(kb_ + oa_); S.st_k1 = LD8(kb_ + ob_); } while (0)
#define SWRITE_HK(bf) do { *(bf16x8*)(K_lds + (bf) * SHM_K + kws) = S.st_k0; *(bf16x8*)(K_lds + (bf) * SHM_K + kws + 32 * 256) = S.st_k1; } while (0)
#define SWRITE_HV(bf) do { *(bf16x8*)(V_lds + (bf) * SHM_V + vst0) = S.st_v0; *(bf16x8*)(V_lds + (bf) * SHM_V + vst1) = S.st_v1; } while (0)
#define SWRITE_H(bf) do { SWRITE_HV(bf); SWRITE_HK(bf); } while (0)
__device__ __forceinline__ void swa_prime(const BlockRef& cur, char* lds, Seam& S) {
    int tid_ = threadIdx.x; asm volatile("" : "+v"(tid_));
    const int tid = tid_, wid = __builtin_amdgcn_readfirstlane(tid >> 6), lane = tid & 63, r32 = lane & 31, hi = lane >> 5;
    const int sr = tid >> 4, sc = (tid & 15) * 8, kws = KSWZ(sr, sc * 2); char* K_lds = lds + 2 * SHM_V;
    const int kb0 = swa_jlo(cur.P0, cur.W) * KVBLK;
    { const char* qb_ = (const char*)cur.Q + (size_t)(wid * QBLK) * (size_t)cur.QS * 2; const unsigned qo_ = (unsigned)(r32 * cur.QS + hi * 8) * 2u;
      for (int d0 = 0; d0 < 8; ++d0) S.qr[d0] = LD8(qb_ + qo_ + d0 * 32); }
    SLOAD_H(cur.K, cur.V, kb0, cur.KS); VMW(); SWRITE_HK(0);
    __syncthreads();
}
__device__ __forceinline__ void swa_block(const BlockRef& cur, const BlockRef& nxt, char* lds, Seam& S) {
    int tid_ = threadIdx.x; asm volatile("" : "+v"(tid_));
    const int tid = tid_, wid = __builtin_amdgcn_readfirstlane(tid >> 6), lane = tid & 63, r32 = lane & 31, hi = lane >> 5;
    const int W = cur.W, skv = cur.skv;
    const int j_lo = swa_jlo(cur.P0, W);
    int j_hi = (cur.P0 + QB - 1) / KVBLK + 1; if (j_hi > skv / KVBLK) j_hi = skv / KVBLK;
    const int NT = j_hi - j_lo;
    const int kbn = swa_jlo(nxt.P0, nxt.W) * KVBLK;
    const int qlo = cur.P0 + wid * QBLK, qm = qlo + r32 - 4 * hi;
    char* V_lds = lds; char* K_lds = lds + 2 * SHM_V;
    float* ws = (float*)(lds + 2 * SHM_V + 2 * SHM_K) + wid * 64; float* li_l = ws, * al_l = ws + 32;
    float m_reg = -1e30f, l_reg = 0; f32x16 o[4] = {};
    const int sr = tid >> 4, sc = (tid & 15) * 8, vst0 = v_st(sr, sc), vst1 = v_st(32 + sr, sc), kws = KSWZ(sr, sc * 2);
    const int vb0 = (int)(uintptr_t)V_lds + v_rd_base(lane);
    const bf16* Kh = cur.K; const bf16* Vh = cur.V; const int KSc = cur.KS;
#define RESC(a) do { if (__any((a) < 1.f)) { if (hi == 0) al_l[r32] = (a); asm volatile("s_waitcnt lgkmcnt(0)" ::: "memory");              \
                     for (int d_ = 0; d_ < 4; ++d_) for (int r = 0; r < 16; ++r) o[d_][r] *= al_l[crow(r, hi)]; } } while (0)
#define KBASE(t) ((j_lo + (t)) * KVBLK)
#define ACT(t) (KBASE(t) <= qlo + QBLK - 1 && KBASE(t) + KVBLK - 1 >= qlo - W + 1)
#define MASKT(P0_, P1_, t) do { const int kb_ = KBASE(t); if ((!SK || ACT(t)) && (kb_ + KVBLK - 1 > qlo || kb_ <= qlo + QBLK - 1 - W)) mask_tile(P0_, P1_, qm - kb_, (unsigned)W); } while (0)
    constexpr int NQL = 8;
    constexpr bool SK = true;
#define SEAM_K0() do { VMWN(NQL); SWRITE_HK(0); SBAR(); } while (0)
    f32x16 pA0, pA1, pB0, pB1; float mnA, mnB, alA, alB; bf16x8 pa0, pa1, pa2, pa3;
    SWRITE_HV(0); SBAR();
    if (NT > 1) { SLOAD_H(Kh, Vh, KBASE(1), KSc); }
    SBAR(); qkt<0, SK>(pA0, pA1, K_lds, r32, hi, S.qr, ACT(0));
    MASKT(pA0, pA1, 0); partialSM(pA0, pA1, m_reg, mnA, alA);
    if (NT > 1) { VMW(); SWRITE_H(1); }
    __syncthreads();
#define HALF_STEP(PX0, PX1, mnX, alX, PY0, PY1, alY, t, KB, VB, SB) do {                                                      \
        SBAR(); qkt<KB, SK>(PX0, PX1, K_lds, r32, hi, S.qr, ACT(t));                                             \
        finishSM(PY0, PY1, alY, l_reg, pa0, pa1, pa2, pa3); SBAR();                                                           \
        if ((t) + 1 < NT) { SLOAD_H(Kh, Vh, KBASE((t) + 1), KSc); SBAR(); }                                               \
        pv_tile<VB, SK>(o, vb0, pa0, pa1, pa2, pa3, ACT((t) - 1)); MASKT(PX0, PX1, (t)); partialSM(PX0, PX1, m_reg, mnX, alX);                                        \
        __syncthreads();                                                                                                      \
        if ((t) + 1 < NT) { VMW(); SWRITE_H(SB); }                                                                          \
        RESC(alX); __syncthreads(); } while (0)
    for (int t = 1; t + 1 < NT; t += 2) {
        HALF_STEP(pB0, pB1, mnB, alB, pA0, pA1, alA, t, 1, 0, 0);
        HALF_STEP(pA0, pA1, mnA, alA, pB0, pB1, alB, t + 1, 0, 1, 1);
    }
    const bool even = (NT & 1) == 0;
    if (even) { SBAR(); qkt<1, SK>(pB0, pB1, K_lds, r32, hi, S.qr, ACT(NT - 1)); SBAR(); }
    { SLOAD_H(nxt.K, nxt.V, kbn, nxt.KS); SBAR();
      const char* qb_ = (const char*)nxt.Q + (size_t)(wid * QBLK) * (size_t)nxt.QS * 2; const unsigned qo_ = (unsigned)(r32 * nxt.QS + hi * 8) * 2u;
#pragma unroll
        for (int d0 = 0; d0 < 8; ++d0) S.qr[d0] = LD8(qb_ + qo_ + d0 * 32); }
    SBAR();
    finishSM(pA0, pA1, alA, l_reg, pa0, pa1, pa2, pa3); SBAR();
    pv_tile<0, SK>(o, vb0, pa0, pa1, pa2, pa3, ACT(even ? NT - 2 : NT - 1));
    if (even) { MASKT(pB0, pB1, NT - 1); partialSM(pB0, pB1, m_reg, mnB, alB); __syncthreads(); RESC(alB);
        finishSM(pB0, pB1, alB, l_reg, pa0, pa1, pa2, pa3); SBAR(); pv_tile<1, SK>(o, vb0, pa0, pa1, pa2, pa3, ACT(NT - 1)); }
    SBAR(); SEAM_K0();
    if (hi == 0) li_l[r32] = l_reg; asm volatile("s_waitcnt lgkmcnt(0)" ::: "memory");
    if (cur.LSE != nullptr && hi == 0) cur.LSE[(size_t)(wid * QBLK + r32) * cur.LS] = __log2f(l_reg) + m_reg * (1.4426950408889634f * SCALE);
    float rli[16];
#pragma unroll
    for (int r = 0; r < 16; ++r) rli[r] = __builtin_amdgcn_rcpf(li_l[crow(r, hi)]);
    bf16* Ow = cur.O + (size_t)(wid * QBLK) * cur.OS;
#pragma unroll
    for (int r = 0; r < 16; ++r) { const int orow = crow(r, hi);
#pragma unroll
        for (int d0 = 0; d0 < 4; ++d0) { const float v = o[d0][r] * rli[r];
            const float vn = __shfl_xor(v, 1);
            if ((r32 & 1) == 0) *(unsigned*)(Ow + (size_t)orow * cur.OS + d0 * 32 + r32) = cvtpk(v, vn); } }
    __syncthreads();
#undef RESC
#undef KBASE
#undef ACT
#undef MASKT
#undef SEAM_K0
#undef HALF_STEP
}
#undef LD8
#undef ROW
#undef VMW
#undef VMWN
#undef SLOAD_H
#undef SWRITE_HK
#undef SWRITE_HV
#undef SWRITE_H
#undef KSWZ
#undef SBAR
}

constexpr int NWAVES = 8;
#ifndef MK_N_LAUNCHES
#define MK_N_LAUNCHES 1
#endif
constexpr int N_PHASES = 13;
#ifndef NAIVE_ATTN
#define NAIVE_ATTN 0
#endif
constexpr float ATT_QSCALE = NAIVE_ATTN ? QSCALE : 1.0f;

constexpr size_t MiB = 1u << 20;
constexpr size_t WS_CTL = 0, CTL_ZERO_BYTES = 1 * MiB;
constexpr size_t WS_WIN = 2 * MiB;
constexpr size_t WS_WB = 22 * MiB;
constexpr size_t WS_WO = 25 * MiB;
constexpr size_t WS_WMEM = 27 * MiB;
constexpr size_t WS_W1 = 29 * MiB;
constexpr size_t WS_W2 = 157 * MiB;
constexpr size_t WS_XN = 221 * MiB;
constexpr size_t WS_Z = 256 * MiB;
constexpr size_t WS_RW = 568 * MiB;
constexpr size_t WS_YS = 792 * MiB;
constexpr size_t WS_YABC = 824 * MiB;
constexpr size_t WS_MRG = 872 * MiB;
constexpr size_t WS_MRGB = 936 * MiB;
constexpr size_t WS_MEMN = 968 * MiB;
constexpr size_t WS_KVM = 969 * MiB;
constexpr size_t WS_XN2 = 970 * MiB;
constexpr size_t WS_ROUTE = 1002 * MiB;
constexpr size_t WS_END = 1004 * MiB;
constexpr size_t WS_XS = 256 * MiB;
constexpr size_t WS_HACT = 400 * MiB;
constexpr size_t WS_YROWS = 544 * MiB;
constexpr size_t WS_OP = WS_MRG;
constexpr size_t WS_LSE = WS_MRGB;
constexpr size_t RWSZ = (size_t)MTOK * RW * 4;
constexpr size_t RT_TOPI = 0, RT_TOPG = 256 * 1024, RT_POS = 512 * 1024, RT_ROWGATE = 768 * 1024;
static_assert(RT_ROWGATE + (size_t)MAX_SLOTS * 4 <= 1088 * 1024, "route");
constexpr int CW_TMO = 0, CW_CODE = 1;
constexpr int CW_BAR = 4096;
constexpr int CW_CNT = 16384;
constexpr int CW_CUR = 16384 + 2048;

constexpr int RING_OFF = 0, RING_BYTES = 131072;
constexpr int LDSCTL_OFF = 143360, MISC_OFF = LDSCTL_OFF + 320;
constexpr int MOETAB_OFF = MISC_OFF + 128;
constexpr int HIST_OFF = MOETAB_OFF + 1536;
constexpr int LDS_BYTES = 147456;
static_assert(HIST_OFF + 4 * 320 <= LDS_BYTES, "LDS map");
#define GAS __attribute__((address_space(1)))
#define LAS __attribute__((address_space(3)))
typedef unsigned short bf16;
typedef unsigned v4u __attribute__((ext_vector_type(4)));
typedef float f32x4 __attribute__((ext_vector_type(4)));
typedef short bf16x8 __attribute__((ext_vector_type(8)));
typedef GAS unsigned gu32;
typedef GAS unsigned long long gu64;
#define RLX_AGENT __ATOMIC_RELAXED, __HIP_MEMORY_SCOPE_AGENT
#define LDS_WAIT() asm volatile("s_waitcnt lgkmcnt(0)" ::: "memory")
#define VM_WAIT() asm volatile("s_waitcnt vmcnt(0)" ::: "memory")
__device__ __forceinline__ unsigned long long rt() { return __builtin_amdgcn_s_memrealtime(); }
__device__ __forceinline__ unsigned f2bf(float f) { unsigned u = __builtin_bit_cast(unsigned, f); return (u + 0x7fffu + ((u >> 16) & 1u)) >> 16; }
__device__ __forceinline__ unsigned pk2(float lo, float hi) { return f2bf(lo) | (f2bf(hi) << 16); }
#define XB_TMO      128
#define XB_XCNT(j)  (256  + 64 * (j))
#define XB_XSUB(j)  (1280 + 64 * (j))
#define XB_XGEN(j)  (2304 + 64 * (j))
#define XB_TOP      3328
#define XB_TOPGEN   3392
#define XCD_BAR_WORDS 3456
#define XB_SPIN_CAP (1u << 18)

__device__ __forceinline__ unsigned xb_ld(unsigned* p)              { return __hip_atomic_load(p, __ATOMIC_RELAXED, __HIP_MEMORY_SCOPE_AGENT); }
__device__ __forceinline__ unsigned xb_add(unsigned* p, unsigned v) { return __hip_atomic_fetch_add(p, v, __ATOMIC_RELAXED, __HIP_MEMORY_SCOPE_AGENT); }
__device__ __forceinline__ unsigned xb_xcc_id() { return (unsigned)__builtin_amdgcn_s_getreg((3 << 11) | 20) & 0xFu; }
#define XB_SPIN(cond, bar) do { unsigned _sp = 0; while (cond) { __builtin_amdgcn_s_sleep(1); \
    if ((++_sp & 255u) == 0u) { if (xb_ld(&(bar)[XB_TMO])) break; if (_sp > XB_SPIN_CAP) { atomicAdd(&(bar)[XB_TMO], 1u); break; } } } } while (0)

struct XcdBarrier {
    unsigned* bar; unsigned x;
    volatile LAS unsigned* st;
};

__device__ __forceinline__ XcdBarrier xcd_barrier_post(unsigned* bar, volatile LAS unsigned* st) {
    XcdBarrier b; b.bar = bar; b.x = xb_xcc_id(); b.st = st;
    if (threadIdx.x == 0) (void)xb_add(&bar[XB_XCNT(b.x)], 1u);
    return b;
}
__device__ __forceinline__ void xcd_barrier_complete(unsigned* bar, unsigned x, unsigned& nloc, unsigned& nx) {
    const unsigned G = gridDim.x * gridDim.y * gridDim.z;
    unsigned sum, cnt, mine, sp = 0u;
    for (;;) {
        sum = 0u; cnt = 0u; mine = 0u;
#pragma unroll
        for (unsigned j = 0; j < 16; ++j) { const unsigned c = xb_ld(&bar[XB_XCNT(j)]); sum += c; cnt += (c > 0u) ? 1u : 0u; mine = (j == x) ? c : mine; }
        if (sum == G) break;
        __builtin_amdgcn_s_sleep(1);
        if ((++sp & 255u) == 0u) { if (xb_ld(&bar[XB_TMO])) break; if (sp > XB_SPIN_CAP) { atomicAdd(&bar[XB_TMO], 1u); break; } }
    }
    nloc = mine > 0u ? mine : 1u; nx = cnt > 0u ? cnt : 1u;
}

__device__ __forceinline__ void xcd_barrier(const XcdBarrier& b) {
    asm volatile("s_waitcnt vmcnt(0)" ::: "memory");
    __syncthreads();
    if (threadIdx.x == 0) {
        unsigned* bar = b.bar;
        __builtin_amdgcn_s_waitcnt(0);
        unsigned nloc = b.st[0], nx = b.st[1];
        if (nloc == 0u) { xcd_barrier_complete(bar, b.x, nloc, nx); b.st[0] = nloc; b.st[1] = nx; }
        const unsigned old = xb_add(&bar[XB_XSUB(b.x)], 1u);
        const unsigned gen = old / nloc;
        if (old + 1u == (gen + 1u) * nloc) {
            __builtin_amdgcn_fence(__ATOMIC_RELEASE, "agent");
            asm volatile("s_waitcnt vmcnt(0)" ::: "memory");
            const unsigned og = xb_add(&bar[XB_TOP], 1u);
            const unsigned tg = og / nx;
            if (og + 1u == (tg + 1u) * nx) xb_add(&bar[XB_TOPGEN], 1u);
            else XB_SPIN(xb_ld(&bar[XB_TOPGEN]) == tg, bar);
            __builtin_amdgcn_fence(__ATOMIC_ACQUIRE, "agent");
            xb_add(&bar[XB_XGEN(b.x)], 1u);
            asm volatile("s_waitcnt vmcnt(0)" ::: "memory");
        } else {
            XB_SPIN(xb_ld(&bar[XB_XGEN(b.x)]) == gen, bar);
            __builtin_amdgcn_fence(__ATOMIC_ACQUIRE, "agent");
            asm volatile("s_waitcnt vmcnt(0)" ::: "memory");
        }
    }
    __syncthreads();
}

typedef float f32x2 __attribute__((ext_vector_type(2)));
struct Args { const float* in[32]; float* out; unsigned char* ws; int ph_lo, ph_hi, use_bar, pad; };
struct Frame {
    LAS unsigned char* lds;
    volatile LAS unsigned* MISC;
    gu32* ctl;
    int tid, lane, wave;
    int vcu, G;
    float* out;
    unsigned char* ws;
};
enum { I_X = 0, I_MEM, I_POS, I_NORM_MIX, I_W_IN, I_B_GATE, I_AQ_GAIN, I_AK_GAIN, I_R_MU, I_R_W0, I_R_W2, I_R_A0, I_R_A2, I_R_G2, I_R_KK, I_R_KA, I_R_RK, I_R_LNW, I_R_LNB,
       I_MEM_NORM, I_W_MEMKV, I_CQ_GAIN, I_CK_GAIN, I_W_BRANCH, I_W_OUT, I_NORM_FFN, I_ROUTER_W, I_ROUTER_B, I_EXP_W1, I_EXP_B1, I_EXP_W2, I_EXP_B2 };

__device__ __forceinline__ bool phase_enter(Frame& F, bool on) { int t = (int)threadIdx.x; asm volatile("" : "+v"(t)); F.tid = t; F.lane = t & 63; F.wave = __builtin_amdgcn_readfirstlane(t >> 6); return on; }
__device__ __forceinline__ const float* ldarg(int i) {
    const __attribute__((address_space(4))) char* ka = (const __attribute__((address_space(4))) char*)__builtin_amdgcn_kernarg_segment_ptr();
    asm volatile("" : "+s"(ka));
    return *(const float* const __attribute__((address_space(4)))*)(ka + 8 * i);
}
__device__ __forceinline__ int opq(int x) { asm volatile("" : "+v"(x)); return x; }
__device__ __forceinline__ float bf_lo(unsigned w) { return __builtin_bit_cast(float, w << 16); }
__device__ __forceinline__ float bf_hi(unsigned w) { return __builtin_bit_cast(float, w & 0xffff0000u); }
__device__ __forceinline__ float sigm(float x) { return 1.0f / (1.0f + __expf(-x)); }
template <int CTRL, int RM> __device__ __forceinline__ float dpp0(float v) {
    return __builtin_bit_cast(float, __builtin_amdgcn_update_dpp(0, __builtin_bit_cast(int, v), CTRL, RM, 0xf, true)); }
__device__ __forceinline__ float row16_sum(float v) {
    v += dpp0<0xB1, 0xf>(v); v += dpp0<0x4E, 0xf>(v); v += dpp0<0x141, 0xf>(v); v += dpp0<0x140, 0xf>(v); return v; }
__device__ __forceinline__ float rdlane(float v, int l) { return __builtin_bit_cast(float, __builtin_amdgcn_readlane(__builtin_bit_cast(int, v), l)); }
__device__ __forceinline__ float wave_sum(float v) {
    v = row16_sum(v); v += dpp0<0x142, 0xA>(v); v += dpp0<0x143, 0xC>(v); return rdlane(v, 63); }
__device__ __forceinline__ void half_sums(float v, float& lo, float& hi) {
    v = row16_sum(v); v += dpp0<0x142, 0xA>(v); lo = rdlane(v, 31); hi = rdlane(v, 63); }
__device__ __forceinline__ float wave_max_bp(float v) {
#pragma unroll
    for (int o = 1; o < 64; o <<= 1) v = fmaxf(v, __shfl_xor(v, o));
    return v; }

__device__ __forceinline__ void tconv_tile(const float* W, int K, int N, bf16* WT, int k0, int n0, int rowbase, int lane) {
    const int c = lane & 15, q = lane >> 4;
    const GAS f32x4* src = (const GAS f32x4*)(W + (size_t)(k0 + 16 * q) * N + n0 + 4 * c);
    const size_t rs = (size_t)N / 4;
    f32x4 v[16];
#pragma unroll
    for (int i = 0; i < 16; ++i) v[i] = src[i * rs];
#pragma unroll
    for (int j = 0; j < 4; ++j) {
        GAS v4u* dst = (GAS v4u*)(WT + (size_t)(rowbase + 4 * c + j) * K + k0 + 16 * q);
        v4u o0, o1;
        o0.x = pk2(v[0][j], v[1][j]); o0.y = pk2(v[2][j], v[3][j]); o0.z = pk2(v[4][j], v[5][j]); o0.w = pk2(v[6][j], v[7][j]);
        o1.x = pk2(v[8][j], v[9][j]); o1.y = pk2(v[10][j], v[11][j]); o1.z = pk2(v[12][j], v[13][j]); o1.w = pk2(v[14][j], v[15][j]);
        dst[0] = o0; dst[1] = o1;
    }
}
__device__ __forceinline__ void rms_row_to_bf16(const float* xrow, const float* gain, bf16* orow, int lane) {
    const GAS f32x4* xr = (const GAS f32x4*)xrow + lane; const GAS f32x4* gr = (const GAS f32x4*)gain + lane;
    f32x4 v[4]; float s = 0.f;
#pragma unroll
    for (int j = 0; j < 4; ++j) { v[j] = xr[64 * j]; s += (v[j].x * v[j].x + v[j].y * v[j].y) + (v[j].z * v[j].z + v[j].w * v[j].w); }
    const float rstd = 1.0f / sqrtf(wave_sum(s) * (1.f / D_MODEL) + NORM_EPS);
    GAS unsigned long long* o8 = (GAS unsigned long long*)orow + lane;
#pragma unroll
    for (int j = 0; j < 4; ++j) { const f32x4 g = gr[64 * j];
        o8[64 * j] = (unsigned long long)pk2(v[j].x * rstd * g.x, v[j].y * rstd * g.y) | ((unsigned long long)pk2(v[j].z * rstd * g.z, v[j].w * rstd * g.w) << 32); }
}
template <int PART> __device__ __forceinline__ void p0_prologue(Frame& F, const Args& args, int gw, int NGW) {
    const int lane = F.lane;
    unsigned char* ws = F.ws;
    constexpr int T_IN = 16 * 156, T_WB = 3 * 128, T_WO = 256, T_WM = 256, T_W1 = 32 * 512, T_W2 = 32 * 256;
    constexpr int NT = T_IN + T_WB + T_WO + T_WM + T_W1 + T_W2;
    constexpr int IT0 = (PART == 0) ? 0 : T_IN + T_WB + T_WO + T_WM, IT1 = (PART == 0) ? T_IN + T_WB + T_WO + T_WM : NT;
    for (int it = IT0 + gw; it < IT1; it += NGW) {
        int r = it;
        if (r < T_IN) { const int kb = r / 156, nb = r % 156; tconv_tile(ldarg(I_W_IN), 1024, IN_COLS, (bf16*)(ws + WS_WIN), 64 * kb, 64 * nb, 64 * nb, lane); continue; } r -= T_IN;
        if (r < T_WB) { const int b = r / 128, q = r % 128, kb = q / 16, nb = q % 16;
            tconv_tile(ldarg(I_W_BRANCH) + (size_t)b * 512 * 1024, 512, 1024, (bf16*)(ws + WS_WB) + (size_t)b * 1024 * 512, 64 * kb, 64 * nb, 64 * nb, lane); continue; } r -= T_WB;
        if (r < T_WO) { const int kb = r / 16, nb = r % 16; tconv_tile(ldarg(I_W_OUT), 1024, 1024, (bf16*)(ws + WS_WO), 64 * kb, 64 * nb, 64 * nb, lane); continue; } r -= T_WO;
        if (r < T_WM) { const int kb = r / 16, nb = r % 16; tconv_tile(ldarg(I_W_MEMKV), 1024, 1024, (bf16*)(ws + WS_WMEM), 64 * kb, 64 * nb, 64 * nb, lane); continue; } r -= T_WM;
        if (r < T_W1) { const int e = r / 512, q = r % 512, kb = q / 32, nb = q % 32, n0 = 64 * nb;
            const int rowbase = (n0 < 1024) ? ((n0 >> 7) * 256 + (n0 & 127)) : ((((n0 - 1024) >> 7) * 256) + 128 + ((n0 - 1024) & 127));
            tconv_tile(ldarg(I_EXP_W1) + (size_t)e * 1024 * 2048, 1024, 2048, (bf16*)(ws + WS_W1) + (size_t)e * 2048 * 1024, 64 * kb, n0, rowbase, lane); continue; } r -= T_W1;
        { const int e = r / 256, q = r % 256, kb = q / 16, nb = q % 16;
            tconv_tile(ldarg(I_EXP_W2) + (size_t)e * 1024 * 1024, 1024, 1024, (bf16*)(ws + WS_W2) + (size_t)e * 1024 * 1024, 64 * kb, 64 * nb, 64 * nb, lane); }
    }
    if (PART == 0) {
    for (int m = gw; m < MTOK; m += NGW) rms_row_to_bf16(ldarg(I_X) + (size_t)m * D_MODEL, ldarg(I_NORM_MIX), (bf16*)(ws + WS_XN) + (size_t)m * D_MODEL, lane);
    for (int m = gw; m < MEMROWS; m += NGW) rms_row_to_bf16(ldarg(I_MEM) + (size_t)m * D_MODEL, ldarg(I_MEM_NORM), (bf16*)(ws + WS_MEMN) + (size_t)m * D_MODEL, lane);
    }
}

__device__ __forceinline__ void head_norm(bf16* p, const float* gain, bool rot, float c0, float s0, float c1, float s1, float scale, int lane) {
    GAS unsigned* pw = (GAS unsigned*)p + lane;
    const unsigned w = *pw; float a = bf_lo(w), b = bf_hi(w);
    const float ss = wave_sum(a * a + b * b);
    const float rstd = 1.0f / sqrtf(ss * (1.f / 128.f) + NORM_EPS);
    const f32x2 g = *((const GAS f32x2*)gain + lane);
    a = a * rstd * g.x; b = b * rstd * g.y;
    const float pa = __shfl_xor(a, 8), pb = __shfl_xor(b, 8);
    if (rot && lane < 16) {
        if (lane < 8) { a = a * c0 - pa * s0; b = b * c1 - pb * s1; }
        else          { a = a * c0 + pa * s0; b = b * c1 + pb * s1; }
    }
    *pw = pk2(a * scale, b * scale);
}
__device__ __forceinline__ void p2_prep(Frame& F, const Args& args) {
    const int gw = F.vcu * NWAVES + F.wave, NGW = F.G * NWAVES, lane = F.lane;
    unsigned char* ws = F.ws;
    bf16* Z = (bf16*)(ws + WS_Z);
    LAS float* lo = (LAS float*)(F.lds + RING_OFF + F.wave * 8192);
    const float* mu = ldarg(I_R_MU); const float* aqg = ldarg(I_AQ_GAIN); const float* akg = ldarg(I_AK_GAIN); const float* cqg = ldarg(I_CQ_GAIN); const int* posp = (const int*)ldarg(I_POS);
    float* Rr = (float*)(ws + WS_RW); float* Rw = Rr + (size_t)MTOK * RW; float* Rk = Rw + (size_t)MTOK * RW; float* Rv = Rk + (size_t)MTOK * RW;
    float* Ra = Rv + (size_t)MTOK * RW; float* Rb = Ra + (size_t)MTOK * RW; float* Rg = Rb + (size_t)MTOK * RW;
    for (int task = gw; task < MTOK / 4; task += NGW) {
        const int m0 = task * 4, tpos0 = m0 % SEQ, bb = m0 / SEQ;
        for (int tt = 0; tt < 4; ++tt) {
            const int m = m0 + tt;
            const float pos = (float)posp[m];
            const int i0 = 2 * (lane & 7);
            const float f0 = exp2f(-(float)i0 * (18.931568569324174f / 16.0f)), f1 = exp2f(-(float)(i0 + 1) * (18.931568569324174f / 16.0f));
            float s0, c0, s1, c1; sincosf(pos * f0, &s0, &c0); sincosf(pos * f1, &s1, &c1);
            bf16* zr = Z + (size_t)m * IN_COLS;
            for (int hd = 0; hd < 12; ++hd) head_norm(zr + OFF_AQ + hd * 128, aqg, true, c0, s0, c1, s1, ATT_QSCALE, lane);
            for (int hd = 0; hd < 12; ++hd) head_norm(zr + OFF_AK + hd * 128, akg, true, c0, s0, c1, s1, 1.0f, lane);
            for (int hd = 0; hd < 4; ++hd)  head_norm(zr + OFF_CQ + hd * 128, cqg, false, c0, s0, c1, s1, ATT_QSCALE, lane);
        }
    }
    for (int m = gw; m < MEMROWS; m += NGW)
        for (int hd = 0; hd < 4; ++hd) head_norm((bf16*)(ws + WS_KVM) + (size_t)m * 1024 + hd * 128, ldarg(I_CK_GAIN), false, 1.f, 0.f, 1.f, 0.f, 1.0f, lane);
}

__device__ __forceinline__ void lora_stage(const float* W, LAS unsigned* wl, int tid) {
#pragma unroll
    for (int i = 0; i < 16; ++i) { const int idx = tid + 512 * i; const f32x4 v = *((const GAS f32x4*)W + idx);
        *(LAS unsigned long long*)(wl + 2 * idx) = (unsigned long long)pk2(v.x, v.y) | ((unsigned long long)pk2(v.z, v.w) << 32); }
}
__device__ __forceinline__ void lora_mac(const LAS unsigned* wl, const LAS float* lo, float (&acc)[4][8], int lane) {
#pragma unroll 4
    for (int j = 0; j < 64; ++j) { const f32x4 xin = *(const LAS f32x4*)(lo + j * 4);
#pragma unroll
        for (int i = 0; i < 4; ++i) { const unsigned w = wl[j * 256 + lane + 64 * i]; const float w0 = bf_lo(w), w1 = bf_hi(w);
#pragma unroll
            for (int tt = 0; tt < 4; ++tt) { acc[tt][2 * i] += xin[tt] * w0; acc[tt][2 * i + 1] += xin[tt] * w1; } } }
}
template <int NL> __device__ __forceinline__ void lora_in(const bf16* Z, const float* mu, int ch, int m0, LAS float* lo, int lane) {
    const int col = OFF_R + 1536 + ch; const float muj = mu[1536 + ch];
    float prv = ((m0 % SEQ) == 0) ? 0.f : __builtin_bit_cast(float, (unsigned)Z[(size_t)(m0 - 1) * IN_COLS + col] << 16);
#pragma unroll
    for (int tt = 0; tt < 4; ++tt) { const float cur = __builtin_bit_cast(float, (unsigned)Z[(size_t)(m0 + tt) * IN_COLS + col] << 16);
        float x = cur + (prv - cur) * muj; prv = cur;
        x = (NL == 0) ? tanhf(x) : (NL == 1) ? x : sigm(x);
        lo[lane * 4 + tt] = x; }
    LDS_WAIT(); asm volatile("" ::: "memory");
}
__device__ __forceinline__ void p2_rwkv(Frame& F, const Args& args) {
    const int lane = F.lane, wave = F.wave;
    unsigned char* ws = F.ws;
    const bf16* Z = (const bf16*)(ws + WS_Z);
    LAS unsigned* wl = (LAS unsigned*)(F.lds + RING_OFF);
    LAS float* lo = (LAS float*)(F.lds + RING_OFF + 65536 + wave * 1024);
    const float* mu = ldarg(I_R_MU);
    float* Rr = (float*)(ws + WS_RW); float* Rw = Rr + (size_t)MTOK * RW; float* Rk = Rw + (size_t)MTOK * RW; float* Rv = Rk + (size_t)MTOK * RW;
    float* Ra = Rv + (size_t)MTOK * RW; float* Rb = Ra + (size_t)MTOK * RW; float* Rg = Rb + (size_t)MTOK * RW;
    for (int grp = F.vcu; grp < MTOK / 64; grp += F.G) {
        const int mw = grp * 64 + wave * 8;
        lora_stage(ldarg(I_R_W2), wl, F.tid);
        __syncthreads();
        for (int tk = 0; tk < 2; ++tk) { const int m0 = mw + 4 * tk;
            lora_in<0>(Z, mu, lane, m0, lo, lane);
            float acc[4][8];
#pragma unroll
            for (int tt = 0; tt < 4; ++tt)
#pragma unroll
                for (int c = 0; c < 8; ++c) acc[tt][c] = 0.f;
            lora_mac(wl, lo, acc, lane);
            const float* w0p = ldarg(I_R_W0);
#pragma unroll
            for (int i = 0; i < 4; ++i) { const int c = 2 * lane + 128 * i; const f32x2 w0 = *(const GAS f32x2*)(w0p + c);
#pragma unroll
                for (int tt = 0; tt < 4; ++tt) { const float y0 = -(w0.x + acc[tt][2 * i]), y1 = -(w0.y + acc[tt][2 * i + 1]);
                    const float sp0 = fmaxf(y0, 0.f) + log1pf(__expf(-fabsf(y0))), sp1 = fmaxf(y1, 0.f) + log1pf(__expf(-fabsf(y1)));
                    f32x2 wd; wd.x = -__expf(-sp0 - 0.5f); wd.y = -__expf(-sp1 - 0.5f);
                    *(GAS f32x2*)(Rw + (size_t)(m0 + tt) * RW + c) = wd; } }
            LDS_WAIT(); asm volatile("" ::: "memory"); }
        __syncthreads();
        lora_stage(ldarg(I_R_A2), wl, F.tid);
        __syncthreads();
        for (int tk = 0; tk < 2; ++tk) { const int m0 = mw + 4 * tk; const int tpos0 = m0 % SEQ;
            lora_in<1>(Z, mu, 64 + lane, m0, lo, lane);
            float acca[4][8];
#pragma unroll
            for (int tt = 0; tt < 4; ++tt)
#pragma unroll
                for (int c = 0; c < 8; ++c) acca[tt][c] = 0.f;
            lora_mac(wl, lo, acca, lane);
            const float* a0p = ldarg(I_R_A0); const float* kkp = ldarg(I_R_KK); const float* kap = ldarg(I_R_KA);
#pragma unroll
            for (int i = 0; i < 4; ++i) {
                const int c = 2 * lane + 128 * i;
                const f32x2 a0 = *(const GAS f32x2*)(a0p + c), kkc = *(const GAS f32x2*)(kkp + c), kac = *(const GAS f32x2*)(kap + c);
                const f32x2 mur = *(const GAS f32x2*)(mu + c), muk = *(const GAS f32x2*)(mu + 512 + c), muv = *(const GAS f32x2*)(mu + 1024 + c);
                unsigned pr = 0u, pk = 0u, pv = 0u;
                if (tpos0 != 0) { const bf16* zp = Z + (size_t)(m0 - 1) * IN_COLS + OFF_R + c; pr = *(const GAS unsigned*)zp; pk = *(const GAS unsigned*)(zp + 512); pv = *(const GAS unsigned*)(zp + 1024); }
#pragma unroll
                for (int tt = 0; tt < 4; ++tt) {
                    const size_t m = (size_t)(m0 + tt);
                    const bf16* zc = Z + m * IN_COLS + OFF_R + c;
                    const unsigned cr = *(const GAS unsigned*)zc, ck = *(const GAS unsigned*)(zc + 512), cv = *(const GAS unsigned*)(zc + 1024);
                    f32x2 r, k, v;
                    r.x = bf_lo(cr) + (bf_lo(pr) - bf_lo(cr)) * mur.x; r.y = bf_hi(cr) + (bf_hi(pr) - bf_hi(cr)) * mur.y;
                    k.x = bf_lo(ck) + (bf_lo(pk) - bf_lo(ck)) * muk.x; k.y = bf_hi(ck) + (bf_hi(pk) - bf_hi(ck)) * muk.y;
                    v.x = bf_lo(cv) + (bf_lo(pv) - bf_lo(cv)) * muv.x; v.y = bf_hi(cv) + (bf_hi(pv) - bf_hi(cv)) * muv.y;
                    pr = cr; pk = ck; pv = cv;
                    f32x2 av; av.x = sigm(a0.x + acca[tt][2 * i]); av.y = sigm(a0.y + acca[tt][2 * i + 1]);
                    f32x2 kk; kk.x = k.x * kkc.x; kk.y = k.y * kkc.y;
                    float slo, shi; half_sums(kk.x * kk.x + kk.y * kk.y, slo, shi);
                    const float nrm = fmaxf(sqrtf(lane < 32 ? slo : shi), 1e-12f), inv = 1.0f / nrm;
                    kk.x *= inv; kk.y *= inv;
                    f32x2 k2; k2.x = k.x * (1.0f + (av.x - 1.0f) * kac.x); k2.y = k.y * (1.0f + (av.y - 1.0f) * kac.y);
                    f32x2 as, bs; as.x = -kk.x; as.y = -kk.y; bs.x = kk.x * av.x; bs.y = kk.y * av.y;
                    const size_t o = m * RW + c;
                    *(GAS f32x2*)(Rr + o) = r; *(GAS f32x2*)(Rk + o) = k2; *(GAS f32x2*)(Rv + o) = v; *(GAS f32x2*)(Ra + o) = as; *(GAS f32x2*)(Rb + o) = bs;
                }
            }
            LDS_WAIT(); asm volatile("" ::: "memory"); }
        __syncthreads();
        float accg[2][4][8];
#pragma unroll
        for (int tk = 0; tk < 2; ++tk)
#pragma unroll
            for (int tt = 0; tt < 4; ++tt)
#pragma unroll
                for (int c = 0; c < 8; ++c) accg[tk][tt][c] = 0.f;
#pragma unroll
        for (int hh = 0; hh < 2; ++hh) {
            lora_stage(ldarg(I_R_G2) + (size_t)hh * 64 * RW, wl, F.tid);
            __syncthreads();
#pragma unroll
            for (int tk = 0; tk < 2; ++tk) { lora_in<2>(Z, mu, 128 + 64 * hh + lane, mw + 4 * tk, lo, lane); lora_mac(wl, lo, accg[tk], lane); LDS_WAIT(); asm volatile("" ::: "memory"); }
            __syncthreads();
        }
#pragma unroll
        for (int tk = 0; tk < 2; ++tk)
#pragma unroll
            for (int i = 0; i < 4; ++i)
#pragma unroll
                for (int tt = 0; tt < 4; ++tt) { f32x2 gg; gg.x = accg[tk][tt][2 * i]; gg.y = accg[tk][tt][2 * i + 1]; *(GAS f32x2*)(Rg + (size_t)(mw + 4 * tk + tt) * RW + 2 * lane + 128 * i) = gg; }
    }
}

__device__ __forceinline__ float qk_dot(const LAS float* q, const bf16* krow) {
    const GAS v4u* kp = (const GAS v4u*)krow; float s0 = 0.f, s1 = 0.f;
#pragma unroll
    for (int i = 0; i < 16; ++i) { const v4u w = kp[i]; const f32x4 qa = *(const LAS f32x4*)(q + 8 * i), qb = *(const LAS f32x4*)(q + 8 * i + 4);
        s0 += bf_lo(w.x) * qa[0] + bf_hi(w.x) * qa[1] + bf_lo(w.y) * qa[2] + bf_hi(w.y) * qa[3];
        s1 += bf_lo(w.z) * qb[0] + bf_hi(w.z) * qb[1] + bf_lo(w.w) * qb[2] + bf_hi(w.w) * qb[3]; }
    return s0 + s1;
}
__device__ __forceinline__ void p3_attention(Frame& F) {
    const int gw = F.vcu * NWAVES + F.wave, NGW = F.G * NWAVES, lane = F.lane;
    unsigned char* ws = F.ws;
    const bf16* Z = (const bf16*)(ws + WS_Z);
    const bf16* KV = (const bf16*)(ws + WS_KVM);
    bf16* YA = (bf16*)(ws + WS_YABC); bf16* YC = YA + (size_t)2 * MTOK * 512;
    LAS float* qs = (LAS float*)(F.lds + RING_OFF + F.wave * 8192);
    for (int task = gw; task < MTOK * 4; task += NGW) {
        const int m = task >> 2, h = task & 3, t = m % SEQ;
        const bf16* zrow = Z + (size_t)m * IN_COLS;
#pragma unroll
        for (int g = 0; g < 3; ++g) { const unsigned w = *((const GAS unsigned*)(zrow + OFF_AQ + g * 512 + h * 128) + lane); qs[g * 128 + 2 * lane] = bf_lo(w); qs[g * 128 + 2 * lane + 1] = bf_hi(w); }
        LDS_WAIT(); asm volatile("" ::: "memory");
        float sc[3][3]; float mx = -INFINITY;
#pragma unroll
        for (int g = 0; g < 3; ++g) { const int dl = (g == 0) ? 1 : (g == 1) ? 4 : 16;
#pragma unroll
            for (int p = 0; p < 3; ++p) { const int j = lane + 64 * p; const int tk = t - dl * j; float s = -INFINITY;
                if (j <= 128 && tk >= 0) s = qk_dot(qs + g * 128, zrow - (size_t)dl * j * IN_COLS + OFF_AK + g * 512 + h * 128);
                sc[g][p] = s; mx = fmaxf(mx, s); } }
        mx = wave_max_bp(mx);
        float den = 0.f;
#pragma unroll
        for (int g = 0; g < 3; ++g)
#pragma unroll
            for (int p = 0; p < 3; ++p) { sc[g][p] = exp2f(sc[g][p] - mx); den += sc[g][p]; }
        den = wave_sum(den);
        float o0 = 0.f, o1 = 0.f;
#pragma unroll
        for (int g = 0; g < 3; ++g) { const int dl = (g == 0) ? 1 : (g == 1) ? 4 : 16; const bf16* vb = zrow + OFF_AV + g * 512 + h * 128 + 2 * lane;
#pragma unroll
            for (int p = 0; p < 3; ++p) { const int nj = (p < 2) ? 64 : 1;
                for (int jj = 0; jj < nj; ++jj) { const int j = jj + 64 * p; const float pj = rdlane(sc[g][p], jj);
                    if (t - dl * j >= 0) { const unsigned w = *(const GAS unsigned*)(vb - (size_t)dl * j * IN_COLS); o0 += pj * bf_lo(w); o1 += pj * bf_hi(w); } } } }
        const float inv = 1.0f / den;
        *((GAS unsigned*)(YA + (size_t)m * 512 + h * 128) + lane) = pk2(o0 * inv, o1 * inv);
        asm volatile("" ::: "memory");
    }
    for (int task = gw; task < MTOK * 4; task += NGW) {
        const int m = task >> 2, h = task & 3, b = m / SEQ;
        const bf16* zrow = Z + (size_t)m * IN_COLS;
        { const unsigned w = *((const GAS unsigned*)(zrow + OFF_CQ + h * 128) + lane); qs[2 * lane] = bf_lo(w); qs[2 * lane + 1] = bf_hi(w); }
        LDS_WAIT(); asm volatile("" ::: "memory");
        const bf16* kb = KV + (size_t)b * MEM_LEN * 1024 + h * 128;
        float sc[4]; float mx = -INFINITY;
#pragma unroll
        for (int p = 0; p < 4; ++p) { sc[p] = qk_dot(qs, kb + (size_t)(lane + 64 * p) * 1024); mx = fmaxf(mx, sc[p]); }
        mx = wave_max_bp(mx);
        float den = 0.f;
#pragma unroll
        for (int p = 0; p < 4; ++p) { sc[p] = exp2f(sc[p] - mx); den += sc[p]; }
        den = wave_sum(den);
        float o0 = 0.f, o1 = 0.f; const bf16* vb = kb + 512 + 2 * lane;
#pragma unroll
        for (int p = 0; p < 4; ++p)
            for (int jj = 0; jj < 64; ++jj) { const float pj = rdlane(sc[p], jj); const unsigned w = *(const GAS unsigned*)(vb + (size_t)(jj + 64 * p) * 1024); o0 += pj * bf_lo(w); o1 += pj * bf_hi(w); }
        const float inv = 1.0f / den;
        *((GAS unsigned*)(YC + (size_t)m * 512 + h * 128) + lane) = pk2(o0 * inv, o1 * inv);
        asm volatile("" ::: "memory");
    }
}

__device__ __forceinline__ void p5_post(Frame& F, const Args& args) {
    const int gw = F.vcu * NWAVES + F.wave, NGW = F.G * NWAVES, lane = F.lane;
    unsigned char* ws = F.ws;
    const float* Rr = (const float*)(ws + WS_RW); const float* Rk = Rr + (size_t)2 * MTOK * RW; const float* Rv = Rk + (size_t)MTOK * RW; const float* Rg = Rr + (size_t)6 * MTOK * RW;
    const float* YS = (const float*)(ws + WS_YS);
    bf16* YB = (bf16*)(ws + WS_YABC) + (size_t)MTOK * 512;
    const bf16* OP = (const bf16*)(ws + WS_OP); const float* LS = (const float*)(ws + WS_LSE); bf16* YA = (bf16*)(ws + WS_YABC);
    for (int m = gw; m < MTOK; m += NGW) {
#pragma unroll
        for (int h = 0; h < 4; ++h) {
            const float l0 = LS[(size_t)m * 4 + h], l1 = LS[(size_t)MTOK * 4 + (size_t)m * 4 + h], l2 = LS[(size_t)2 * MTOK * 4 + (size_t)m * 4 + h];
            const float mx = fmaxf(l0, fmaxf(l1, l2)); const float w0 = exp2f(l0 - mx), w1 = exp2f(l1 - mx), w2 = exp2f(l2 - mx); const float inv = 1.0f / (w0 + w1 + w2);
            const size_t o = (size_t)m * 512 + h * 128;
            const unsigned a = *((const GAS unsigned*)(OP + o) + lane), b = *((const GAS unsigned*)(OP + (size_t)MTOK * 512 + o) + lane), c = *((const GAS unsigned*)(OP + (size_t)2 * MTOK * 512 + o) + lane);
            *((GAS unsigned*)(YA + o) + lane) = pk2((w0 * bf_lo(a) + w1 * bf_lo(b) + w2 * bf_lo(c)) * inv, (w0 * bf_hi(a) + w1 * bf_hi(b) + w2 * bf_hi(c)) * inv); }
    }
}

__device__ __forceinline__ void p8_router(Frame& F, const Args& args) {
    const int gw = F.vcu * NWAVES + F.wave, NGW = F.G * NWAVES, lane = F.lane;
    unsigned char* ws = F.ws;
    const float* X1 = F.out;
    LAS int* hist = (LAS int*)(F.lds + HIST_OFF);
    { const int t_ = opq(F.tid); if (t_ < 32) hist[t_] = 0; }
    int* topi = (int*)(ws + WS_ROUTE + RT_TOPI); float* topg = (float*)(ws + WS_ROUTE + RT_TOPG);
    const float* RWt = ldarg(I_ROUTER_W); const float* RB = ldarg(I_ROUTER_B); const float* gain = ldarg(I_NORM_FFN);
    LAS f32x4* rw = (LAS f32x4*)(F.lds + RING_OFF);
#pragma unroll
    for (int i = 0; i < 16; ++i) { const int f = F.tid + 512 * i, k = f >> 3, c = f & 7; const f32x4 w = *((const GAS f32x4*)RWt + f); const float g = gain[k];
        rw[k * 8 + (c ^ ((k >> 1) & 7))] = w * g; }
    __syncthreads();
    const int sw = (lane >> 1) & 7;
    for (int m = gw; m < MTOK; m += NGW) {
        const GAS float* xr = (const GAS float*)(X1 + (size_t)m * D_MODEL) + lane;
        float xv[16]; float s = 0.f;
#pragma unroll
        for (int j = 0; j < 16; ++j) { xv[j] = xr[64 * j]; s += xv[j] * xv[j]; }
        const float rstd = 1.0f / sqrtf(wave_sum(s) * (1.f / D_MODEL) + NORM_EPS);
        float lg[32];
#pragma unroll
        for (int e = 0; e < 32; ++e) lg[e] = 0.f;
#pragma unroll
        for (int j = 0; j < 16; ++j) { const LAS f32x4* wr = rw + (lane + 64 * j) * 8;
#pragma unroll
            for (int q = 0; q < 8; ++q) { const f32x4 w = wr[q ^ sw]; lg[4 * q] += xv[j] * w.x; lg[4 * q + 1] += xv[j] * w.y; lg[4 * q + 2] += xv[j] * w.z; lg[4 * q + 3] += xv[j] * w.w; } }
#pragma unroll
        for (int e = 0; e < 32; ++e) lg[e] = wave_sum(lg[e]) * rstd + RB[e];
        int ti[4]; float tv[4];
#pragma unroll
        for (int k = 0; k < 4; ++k) { float best = -INFINITY; int bi = 0;
#pragma unroll
            for (int e = 0; e < 32; ++e) { const bool taken = (k > 0 && ti[0] == e) || (k > 1 && ti[1] == e) || (k > 2 && ti[2] == e); if (!taken && lg[e] > best) { best = lg[e]; bi = e; } }
            ti[k] = bi; tv[k] = best; }
        const float e0 = 1.f, e1 = __expf(tv[1] - tv[0]), e2 = __expf(tv[2] - tv[0]), e3 = __expf(tv[3] - tv[0]); const float inv = 1.0f / (e0 + e1 + e2 + e3);
        if (lane < 4) { const int k = lane; const int e = (k == 0) ? ti[0] : (k == 1) ? ti[1] : (k == 2) ? ti[2] : ti[3]; const float gq = ((k == 0) ? e0 : (k == 1) ? e1 : (k == 2) ? e2 : e3) * inv;
            topi[(size_t)m * 4 + k] = e; topg[(size_t)m * 4 + k] = gq;
            __hip_atomic_fetch_add(hist + e, 1, __ATOMIC_RELAXED, __HIP_MEMORY_SCOPE_WORKGROUP); }
    }
    __syncthreads();
    { const int t_ = opq(F.tid); if (t_ < 32 && hist[t_] != 0) __hip_atomic_fetch_add((unsigned*)(F.ctl + CW_CNT) + 64 * t_, (unsigned)hist[t_], __ATOMIC_RELAXED, __HIP_MEMORY_SCOPE_AGENT); }
}
__device__ __forceinline__ void moe_table(Frame& F) {
    LAS int* tab = (LAS int*)(F.lds + MOETAB_OFF);
    __syncthreads();
    if (F.tid == 0) { int acc = 0;
        for (int e = 0; e < N_EXPERTS; ++e) { const int c = (int)__hip_atomic_load((unsigned*)(F.ctl + CW_CNT) + 64 * e, __ATOMIC_RELAXED, __HIP_MEMORY_SCOPE_AGENT); const int nb = (c + MOE_ROWS - 1) / MOE_ROWS;
            tab[320 + e] = acc * MOE_ROWS; for (int q = 0; q < nb; ++q) tab[1 + acc + q] = e; acc += nb; }
        tab[0] = acc; }
    __syncthreads();
}
__device__ __forceinline__ void p9_dispatch(Frame& F, const Args& args) {
    const int lane = F.lane;
    unsigned char* ws = F.ws;
    moe_table(F);
    const LAS int* tab = (const LAS int*)(F.lds + MOETAB_OFF);
    LAS int* hist = (LAS int*)(F.lds + HIST_OFF); LAS int* base = hist + 32; LAS int* slots = hist + 64;
    const int* topi = (const int*)(ws + WS_ROUTE + RT_TOPI); const float* topg = (const float*)(ws + WS_ROUTE + RT_TOPG);
    int* pos = (int*)(ws + WS_ROUTE + RT_POS); float* rowgate = (float*)(ws + WS_ROUTE + RT_ROWGATE);
    bf16* XS = (bf16*)(ws + WS_XS); const float* gain = ldarg(I_NORM_FFN);
    for (int grp = F.vcu; grp < MTOK / 64; grp += F.G) {
        const int t_ = opq(F.tid);
        if (t_ < 32) hist[t_] = 0;
        __syncthreads();
        int e = 0, rank = 0;
        if (F.tid < 256) { e = topi[(size_t)grp * 256 + F.tid]; rank = __hip_atomic_fetch_add(hist + e, 1, __ATOMIC_RELAXED, __HIP_MEMORY_SCOPE_WORKGROUP); }
        __syncthreads();
        if (F.tid < 32) { const int h = hist[F.tid]; int b0 = 0; if (h != 0) b0 = (int)__hip_atomic_fetch_add((unsigned*)(F.ctl + CW_CUR) + 64 * F.tid, (unsigned)h, __ATOMIC_RELAXED, __HIP_MEMORY_SCOPE_AGENT); base[F.tid] = tab[320 + F.tid] + b0; }
        __syncthreads();
        if (F.tid < 256) { const int slot = base[e] + rank; pos[(size_t)grp * 256 + F.tid] = slot; rowgate[slot] = topg[(size_t)grp * 256 + F.tid]; slots[F.tid] = slot; }
        __syncthreads();
        for (int i = 0; i < 8; ++i) { const int tl = F.wave * 8 + i; const size_t m = (size_t)grp * 64 + tl;
            const GAS f32x4* xr = (const GAS f32x4*)(F.out + m * D_MODEL) + 2 * lane; const GAS f32x4* gr = (const GAS f32x4*)gain + 2 * lane;
            f32x4 v[4]; float s = 0.f;
#pragma unroll
            for (int j = 0; j < 4; ++j) { v[j] = xr[128 * (j >> 1) + (j & 1)]; s += (v[j].x * v[j].x + v[j].y * v[j].y) + (v[j].z * v[j].z + v[j].w * v[j].w); }
            const float rstd = 1.0f / sqrtf(wave_sum(s) * (1.f / D_MODEL) + NORM_EPS);
            v4u o[2];
#pragma unroll
            for (int hf = 0; hf < 2; ++hf) { const f32x4 g0 = gr[128 * hf], g1 = gr[128 * hf + 1]; const f32x4 a = v[2 * hf] * rstd * g0, b = v[2 * hf + 1] * rstd * g1;
                o[hf].x = pk2(a.x, a.y); o[hf].y = pk2(a.z, a.w); o[hf].z = pk2(b.x, b.y); o[hf].w = pk2(b.z, b.w); }
#pragma unroll
            for (int k = 0; k < 4; ++k) { const int sk = slots[tl * 4 + k]; GAS v4u* dst = (GAS v4u*)(XS + (size_t)sk * D_MODEL) + lane; dst[0] = o[0]; dst[64] = o[1]; }
        }
        __syncthreads();
    }
}
__device__ __forceinline__ void p12_combine(Frame& F) {
    const int gw = F.vcu * NWAVES + F.wave, NGW = F.G * NWAVES, lane = F.lane;
    unsigned char* ws = F.ws;
    const int* pos = (const int*)(ws + WS_ROUTE + RT_POS); const bf16* YR = (const bf16*)(ws + WS_YROWS);
    for (int m = gw; m < MTOK; m += NGW) {
        GAS f32x4* xo = (GAS f32x4*)(F.out + (size_t)m * D_MODEL) + 2 * lane;
        int pk = 0; if (lane < 4) pk = pos[(size_t)m * 4 + lane];
#pragma unroll
        for (int hf = 0; hf < 2; ++hf) { f32x4 a = xo[128 * hf], b = xo[128 * hf + 1];
#pragma unroll
            for (int k = 0; k < 4; ++k) { const int sk = __builtin_amdgcn_readlane(pk, k); const v4u w = *((const GAS v4u*)(YR + (size_t)sk * D_MODEL + 512 * hf) + lane);
                a[0] += bf_lo(w.x); a[1] += bf_hi(w.x); a[2] += bf_lo(w.y); a[3] += bf_hi(w.y); b[0] += bf_lo(w.z); b[1] += bf_hi(w.z); b[2] += bf_lo(w.w); b[3] += bf_hi(w.w); }
            xo[128 * hf] = a; xo[128 * hf + 1] = b; }
    }
}

constexpr int N_ATT_A = 768, N_ATT_C = 256;
__device__ __forceinline__ swa::BlockRef attn_item(unsigned char* ws, int it) {
    swa::BlockRef r;
    const swa::bf16* Z = (const swa::bf16*)(ws + WS_Z);
    if (it < N_ATT_A) {
        const int h = it & 3, b = (it >> 2) & 1, v = it >> 3;
        int g, rr, qb;
        if (v < 32) { g = 0; rr = 0; qb = v; } else if (v < 64) { g = 1; rr = (v - 32) >> 3; qb = (v - 32) & 7; } else { g = 2; rr = (v - 64) >> 1; qb = (v - 64) & 1; }
        const int d = (g == 0) ? 1 : (g == 1) ? 4 : 16;
        const size_t row0 = (size_t)b * SEQ + rr, qrow = row0 + (size_t)d * qb * 256;
        r.Q = Z + qrow * IN_COLS + OFF_AQ + g * 512 + h * 128; r.K = Z + row0 * IN_COLS + OFF_AK + g * 512 + h * 128; r.V = Z + row0 * IN_COLS + OFF_AV + g * 512 + h * 128;
        r.O = (swa::bf16*)(ws + WS_OP) + (size_t)g * MTOK * 512 + qrow * 512 + h * 128; r.LSE = (float*)(ws + WS_LSE) + (size_t)g * MTOK * 4 + qrow * 4 + h;
        r.QS = d * IN_COLS; r.KS = d * IN_COLS; r.OS = d * 512; r.LS = d * 4; r.P0 = qb * 256; r.skv = SEQ / d; r.W = 129;
    } else {
        const int u = it - N_ATT_A, h = u & 3, b = (u >> 2) & 1, qb = u >> 3;
        const size_t qrow = (size_t)b * SEQ + (size_t)qb * 256;
        const swa::bf16* KV = (const swa::bf16*)(ws + WS_KVM) + (size_t)b * MEM_LEN * 1024 + h * 128;
        r.Q = Z + qrow * IN_COLS + OFF_CQ + h * 128; r.K = KV; r.V = KV + 512;
        r.O = (swa::bf16*)(ws + WS_YABC) + (size_t)2 * MTOK * 512 + qrow * 512 + h * 128; r.LSE = nullptr;
        r.QS = IN_COLS; r.KS = 1024; r.OS = 512; r.LS = 0; r.P0 = 256; r.skv = MEM_LEN; r.W = 1 << 20;
    }
    return r;
}
__device__ __forceinline__ void p3_attention_mfma(unsigned char* ws, char* lds, int G) {
    const int total = N_ATT_A + N_ATT_C; int L = blockIdx.x; if (L >= total) return;
    swa::BlockRef cur = attn_item(ws, L); swa::Seam S;
    swa::swa_prime(cur, lds, S);
    for (;;) {
        const int Ln = L + G; const bool last = Ln >= total;
        const swa::BlockRef nxt = last ? cur : attn_item(ws, Ln);
        swa::swa_block(cur, nxt, lds, S);
        if (last) break;
        cur = nxt; L = Ln;
    }
}

constexpr int N_RITEMS = BATCH * 8 * (SEQ / 64);
constexpr size_t WS_PHI = WS_XN;
constexpr size_t WS_PSI = WS_XN + 16 * MiB;
constexpr size_t WS_GAM = WS_YS;
constexpr size_t WS_OM = WS_XN2;
constexpr size_t WS_XFR = WS_MRG + 48 * MiB;
constexpr size_t WS_BONUS = WS_MRGB + 1 * MiB;
constexpr int RB = 9216, RLD = 72;
constexpr int R1_SEG = 15 * RB, R1_WC = R1_SEG + 2048;
static_assert(R1_WC + 256 <= LDSCTL_OFF, "R1 LDS map");
typedef LAS unsigned short* lbf_t;
__device__ __forceinline__ f32x4 r1_tile(const LAS unsigned short* X, const LAS unsigned short* Yt, int mi, int ni, f32x4 acc, int fr, int fq) {
    const LAS unsigned short* xp = X + (16 * mi + fr) * RLD + 8 * fq; const LAS unsigned short* yp = Yt + (16 * ni + fr) * RLD + 8 * fq;
    const bf16x8 a0 = *(const LAS bf16x8*)xp, a1 = *(const LAS bf16x8*)(xp + 32), b0 = *(const LAS bf16x8*)yp, b1 = *(const LAS bf16x8*)(yp + 32);
    acc = __builtin_amdgcn_mfma_f32_16x16x32_bf16(b0, a0, acc, 0, 0, 0);
    acc = __builtin_amdgcn_mfma_f32_16x16x32_bf16(b1, a1, acc, 0, 0, 0);
    return acc;
}
__device__ __forceinline__ void r1_store(LAS unsigned short* dst, int mi, int ni, f32x4 acc, int mode, bool addI, const LAS unsigned short* addT, int fr, int fq) {
    const int m = 16 * mi + fr, n0 = 16 * ni + 4 * fq;
#pragma unroll
    for (int r = 0; r < 4; ++r) { const int n = n0 + r; bool keep = true;
        if (mode == 1) keep = n < m; else if (mode == 2) keep = n <= m; else if (mode == 3) keep = m < n;
        float v = keep ? acc[r] : 0.f; if (addI && m == n) v += 1.0f; acc[r] = v; }
    if (addT != nullptr) { const unsigned long long w = *(const LAS unsigned long long*)(addT + m * RLD + n0);
        acc[0] += bf_lo((unsigned)w); acc[1] += bf_hi((unsigned)w); acc[2] += bf_lo((unsigned)(w >> 32)); acc[3] += bf_hi((unsigned)(w >> 32)); }
    *(LAS unsigned long long*)(dst + m * RLD + n0) = (unsigned long long)pk2(acc[0], acc[1]) | ((unsigned long long)pk2(acc[2], acc[3]) << 32);
}
#define R1BUF(i) ((LAS unsigned short*)(F.lds + (i) * RB))
__device__ __forceinline__ void p_r1(Frame& F, const Args& args) {
    unsigned char* ws = F.ws; const int lane = F.lane, wave = F.wave, fr = lane & 15, fq = lane >> 4;
    const float* Rr = (const float*)(ws + WS_RW); const float* Rw = Rr + (size_t)MTOK * RW; const float* Rk = Rw + (size_t)MTOK * RW; const float* Rv = Rk + (size_t)MTOK * RW;
    const float* Ra = Rv + (size_t)MTOK * RW; const float* Rb = Ra + (size_t)MTOK * RW;
    const float* rkp = ldarg(I_R_RK);
    LAS float* segsum = (LAS float*)(F.lds + R1_SEG); LAS float* wcs = (LAS float*)(F.lds + R1_WC);
    for (int item = F.vcu; item < N_RITEMS; item += F.G) {
        const int bh = item >> 7, c = item & 127, b = bh >> 3, h = bh & 7;
        const size_t row0 = (size_t)b * SEQ + (size_t)c * 64;
        { const int k = lane, tq = wave; const size_t g0 = (row0 + 8 * tq) * RW + h * 64 + k;
          float r[8], lw[8], kx[8], vx[8], ax[8], bx[8];
#pragma unroll
          for (int i = 0; i < 8; ++i) { const size_t g = g0 + (size_t)i * RW; r[i] = *(const GAS float*)(Rr + g); lw[i] = *(const GAS float*)(Rw + g); kx[i] = *(const GAS float*)(Rk + g);
              vx[i] = *(const GAS float*)(Rv + g); ax[i] = *(const GAS float*)(Ra + g); bx[i] = *(const GAS float*)(Rb + g); }
          float cs[8]; cs[0] = lw[0];
#pragma unroll
          for (int i = 1; i < 8; ++i) cs[i] = cs[i - 1] + lw[i];
          segsum[tq * 64 + k] = cs[7];
          const float rk = rkp[h * 64 + k];
#pragma unroll
          for (int i = 0; i < 8; ++i) { const float bs = wave_sum(r[i] * kx[i] * rk); if (lane == 0) *(GAS float*)((float*)(ws + WS_BONUS) + (row0 + 8 * tq + i) * 8 + h) = bs; }
          __syncthreads();
          float pre = 0.f;
#pragma unroll
          for (int q = 0; q < 7; ++q) { const float sv = segsum[q * 64 + k]; pre += (q < tq) ? sv : 0.f; }
          unsigned short at[8], rt[8], bt[8], kt[8], vt[8];
#pragma unroll
          for (int i = 0; i < 8; ++i) { const float L = pre + cs[i], Lp = L - lw[i]; const float e = __expf(L), ep = __expf(Lp), ei = __expf(-L);
              at[i] = (unsigned short)f2bf(ax[i] * ep); rt[i] = (unsigned short)f2bf(r[i] * e); bt[i] = (unsigned short)f2bf(bx[i] * ei); kt[i] = (unsigned short)f2bf(kx[i] * ei); vt[i] = (unsigned short)f2bf(vx[i]);
              if (i == 7 && tq == 7) wcs[k] = e; }
#pragma unroll
          for (int i = 0; i < 8; ++i) { const int o = (8 * tq + i) * RLD + k; R1BUF(8)[o] = at[i]; R1BUF(4)[o] = rt[i]; R1BUF(9)[o] = bt[i]; R1BUF(10)[o] = kt[i]; }
          const int ot = k * RLD + 8 * tq;
#define PK8(x) ((v4u){(unsigned)x[0] | ((unsigned)x[1] << 16), (unsigned)x[2] | ((unsigned)x[3] << 16), (unsigned)x[4] | ((unsigned)x[5] << 16), (unsigned)x[6] | ((unsigned)x[7] << 16)})
          *(LAS v4u*)(R1BUF(0) + ot) = PK8(at); *(LAS v4u*)(R1BUF(1) + ot) = PK8(bt); *(LAS v4u*)(R1BUF(2) + ot) = PK8(kt); *(LAS v4u*)(R1BUF(3) + ot) = PK8(vt);
#undef PK8
        }
        __syncthreads();
        const f32x4 zero4 = (f32x4){0.f, 0.f, 0.f, 0.f};
#pragma unroll 1
        for (int q = 0; q < 10; ++q) { const int id = wave + 8 * q, prod = id >> 4, tl = id & 15, mi = tl >> 2, ni = tl & 3;
            const LAS unsigned short* X = (prod == 1) ? R1BUF(9) : (prod >= 3) ? R1BUF(4) : R1BUF(8);
            const LAS unsigned short* Y = (prod == 0 || prod == 3) ? R1BUF(9) : (prod == 1) ? R1BUF(8) : R1BUF(10);
            const f32x4 acc = r1_tile(X, Y, mi, ni, zero4, fr, fq);
            if (prod == 0) { r1_store(R1BUF(11), mi, ni, acc, 1, false, nullptr, fr, fq); r1_store(R1BUF(13), mi, ni, acc, 1, true, nullptr, fr, fq); }
            else if (prod == 1) r1_store(R1BUF(12), mi, ni, acc, 3, false, nullptr, fr, fq);
            else if (prod == 2) r1_store(R1BUF(5), mi, ni, acc, 1, false, nullptr, fr, fq);
            else if (prod == 3) r1_store(R1BUF(6), mi, ni, acc, 2, false, nullptr, fr, fq);
            else r1_store(R1BUF(7), mi, ni, acc, 2, false, nullptr, fr, fq); }
        __syncthreads();
#pragma unroll 1
        for (int q = 0; q < 6; ++q) { const int id = wave + 8 * q, prod = id >> 4, tl = id & 15, mi = tl >> 2, ni = tl & 3;
            const LAS unsigned short* X = (prod == 0) ? R1BUF(11) : (prod == 1) ? R1BUF(12) : R1BUF(3);
            const LAS unsigned short* Y = (prod == 0) ? R1BUF(12) : (prod == 1) ? R1BUF(11) : R1BUF(5);
            const f32x4 acc = r1_tile(X, Y, mi, ni, zero4, fr, fq);
            r1_store(prod == 0 ? R1BUF(8) : prod == 1 ? R1BUF(9) : R1BUF(10), mi, ni, acc, 0, false, nullptr, fr, fq); }
        __syncthreads();
#pragma unroll 1
        for (int lv = 0; lv < 5; ++lv) {
            const bool srcB = (lv & 1) == 0;
            LAS unsigned short* sN = srcB ? R1BUF(8) : R1BUF(11); LAS unsigned short* sNT = srcB ? R1BUF(9) : R1BUF(12);
            LAS unsigned short* dN = srcB ? R1BUF(11) : R1BUF(8); LAS unsigned short* dNT = srcB ? R1BUF(12) : R1BUF(9);
            LAS unsigned short* Tc = (lv & 1) ? R1BUF(14) : R1BUF(13); LAS unsigned short* Tn = (lv & 1) ? R1BUF(13) : R1BUF(14);
            const int nprod = (lv < 3) ? 3 : (lv == 3) ? 2 : 1;
#pragma unroll 1
            for (int q = 0; q < 2 * nprod; ++q) { const int id = wave + 8 * q, p = id >> 4, tl = id & 15, mi = tl >> 2, ni = tl & 3;
                if (p == 0) { const f32x4 acc = r1_tile(Tc, sNT, mi, ni, zero4, fr, fq); r1_store(Tn, mi, ni, acc, 0, false, Tc, fr, fq); }
                else if (p == 1) { const f32x4 acc = r1_tile(sNT, sN, mi, ni, zero4, fr, fq); r1_store(dNT, mi, ni, acc, 0, false, nullptr, fr, fq); }
                else { const f32x4 acc = r1_tile(sN, sNT, mi, ni, zero4, fr, fq); r1_store(dN, mi, ni, acc, 0, false, nullptr, fr, fq); } }
            __syncthreads();
        }
#pragma unroll 1
        for (int q = 0; q < 4; ++q) { const int id = wave + 8 * q, prod = id >> 4, tl = id & 15, mi = tl >> 2, ni = tl & 3;
            const f32x4 acc = r1_tile(prod == 0 ? R1BUF(0) : R1BUF(10), R1BUF(14), mi, ni, zero4, fr, fq);
            r1_store(prod == 0 ? R1BUF(11) : R1BUF(12), mi, ni, acc, 0, false, nullptr, fr, fq); }
        __syncthreads();
        { const int mi = wave >> 1, ks = wave & 1;
          const f32x4 p0 = r1_tile(R1BUF(1), R1BUF(11), mi, 2 * ks, zero4, fr, fq), p1 = r1_tile(R1BUF(1), R1BUF(11), mi, 2 * ks + 1, zero4, fr, fq);
          const f32x4 s0 = r1_tile(R1BUF(6), R1BUF(11), mi, 2 * ks, zero4, fr, fq), s1 = r1_tile(R1BUF(6), R1BUF(11), mi, 2 * ks + 1, zero4, fr, fq);
          const int m = 16 * mi + fr; const float wc = wcs[m];
          float ph[8], ps[8];
#pragma unroll
          for (int r = 0; r < 4; ++r) { const int n0 = 32 * ks + 4 * fq + r, n1 = n0 + 16;
              ph[r] = (p0[r] + (m == n0 ? 1.f : 0.f)) * wc; ph[4 + r] = (p1[r] + (m == n1 ? 1.f : 0.f)) * wc; }
          { const unsigned long long w0 = *(const LAS unsigned long long*)(R1BUF(4) + m * RLD + 32 * ks + 4 * fq), w1 = *(const LAS unsigned long long*)(R1BUF(4) + m * RLD + 32 * ks + 16 + 4 * fq);
            ps[0] = s0[0] + bf_lo((unsigned)w0); ps[1] = s0[1] + bf_hi((unsigned)w0); ps[2] = s0[2] + bf_lo((unsigned)(w0 >> 32)); ps[3] = s0[3] + bf_hi((unsigned)(w0 >> 32));
            ps[4] = s1[0] + bf_lo((unsigned)w1); ps[5] = s1[1] + bf_hi((unsigned)w1); ps[6] = s1[2] + bf_lo((unsigned)(w1 >> 32)); ps[7] = s1[3] + bf_hi((unsigned)(w1 >> 32)); }
          const size_t fo = (((size_t)item * 4 + mi) * 2 + ks) * 64 + lane;
          *((GAS v4u*)(ws + WS_PHI) + fo) = (v4u){pk2(ph[0], ph[1]), pk2(ph[2], ph[3]), pk2(ph[4], ph[5]), pk2(ph[6], ph[7])};
          *((GAS v4u*)(ws + WS_PSI) + fo) = (v4u){pk2(ps[0], ps[1]), pk2(ps[2], ps[3]), pk2(ps[4], ps[5]), pk2(ps[6], ps[7])};
          const int vb = wave >> 1;
#pragma unroll
          for (int hh = 0; hh < 2; ++hh) { const int mt = 2 * (wave & 1) + hh;
              f32x4 ga = r1_tile(R1BUF(12), R1BUF(1), vb, mt, zero4, fr, fq); ga = r1_tile(R1BUF(3), R1BUF(2), vb, mt, ga, fr, fq);
              f32x4 om = r1_tile(R1BUF(12), R1BUF(6), vb, mt, zero4, fr, fq); om = r1_tile(R1BUF(3), R1BUF(7), vb, mt, om, fr, fq);
#pragma unroll
              for (int r = 0; r < 4; ++r) ga[r] *= wcs[16 * mt + 4 * fq + r];
              const size_t ao = (((size_t)item * 4 + vb) * 4 + mt) * 64 + lane;
              *((GAS f32x4*)(ws + WS_GAM) + ao) = ga; *((GAS f32x4*)(ws + WS_OM) + ao) = om; }
        }
        __syncthreads();
    }
}
#undef R1BUF
struct R2Buf { bf16x8 ph[4][2]; f32x4 ga[4]; };
__device__ __forceinline__ void r2_load(R2Buf& B, const unsigned char* ws, int item, int vb, int lane) {
#pragma unroll
    for (int mt = 0; mt < 4; ++mt) {
#pragma unroll
        for (int ks = 0; ks < 2; ++ks) B.ph[mt][ks] = *((const GAS bf16x8*)(ws + WS_PHI) + (((size_t)item * 4 + mt) * 2 + ks) * 64 + lane);
        B.ga[mt] = *((const GAS f32x4*)(ws + WS_GAM) + (((size_t)item * 4 + vb) * 4 + mt) * 64 + lane); }
}
__device__ __forceinline__ void r2_step(const R2Buf& B, f32x4 (&acc)[4], unsigned char* ws, int item, int vb, int lane) {
    v4u x0, x1;
    x0.x = pk2(acc[0][0], acc[0][1]); x0.y = pk2(acc[0][2], acc[0][3]); x0.z = pk2(acc[1][0], acc[1][1]); x0.w = pk2(acc[1][2], acc[1][3]);
    x1.x = pk2(acc[2][0], acc[2][1]); x1.y = pk2(acc[2][2], acc[2][3]); x1.z = pk2(acc[3][0], acc[3][1]); x1.w = pk2(acc[3][2], acc[3][3]);
    GAS v4u* xo = (GAS v4u*)(ws + WS_XFR) + (((size_t)item * 4 + vb) * 2) * 64 + lane; xo[0] = x0; xo[64] = x1;
    const bf16x8 f0 = __builtin_bit_cast(bf16x8, x0), f1 = __builtin_bit_cast(bf16x8, x1);
#pragma unroll
    for (int mt = 0; mt < 4; ++mt) { f32x4 a = B.ga[mt];
        a = __builtin_amdgcn_mfma_f32_16x16x32_bf16(B.ph[mt][0], f0, a, 0, 0, 0);
        a = __builtin_amdgcn_mfma_f32_16x16x32_bf16(B.ph[mt][1], f1, a, 0, 0, 0);
        acc[mt] = a; }
}
__device__ __forceinline__ void p_r2(Frame& F) {
    if (blockIdx.x < BATCH * 8 * 4 && F.wave == 0) {
        unsigned char* ws = F.ws; const int bh = blockIdx.x >> 2, vb = blockIdx.x & 3, lane = F.lane;
        f32x4 acc[4];
#pragma unroll
        for (int i = 0; i < 4; ++i) acc[i] = (f32x4){0.f, 0.f, 0.f, 0.f};
        R2Buf A, B, C, D;
        const int it0 = bh * 128;
        r2_load(A, ws, it0, vb, lane); r2_load(B, ws, it0 + 1, vb, lane); r2_load(C, ws, it0 + 2, vb, lane);
#define R2SB() __builtin_amdgcn_sched_barrier(0)
#pragma unroll
        for (int c = 0; c < 128; c += 4) {
            r2_load(D, ws, it0 + c + 3, vb, lane); R2SB(); r2_step(A, acc, ws, it0 + c, vb, lane); R2SB();
            r2_load(A, ws, it0 + (c + 4 < 128 ? c + 4 : 127), vb, lane); R2SB(); r2_step(B, acc, ws, it0 + c + 1, vb, lane); R2SB();
            r2_load(B, ws, it0 + (c + 5 < 128 ? c + 5 : 127), vb, lane); R2SB(); r2_step(C, acc, ws, it0 + c + 2, vb, lane); R2SB();
            r2_load(C, ws, it0 + (c + 6 < 128 ? c + 6 : 127), vb, lane); R2SB(); r2_step(D, acc, ws, it0 + c + 3, vb, lane); R2SB();
        }
#undef R2SB
    }
}
__device__ __forceinline__ void p_r3(Frame& F, const Args& args) {
    const int gw = F.vcu * NWAVES + F.wave, NGW = F.G * NWAVES, lane = F.lane, cc = lane & 15, q = lane >> 4;
    unsigned char* ws = F.ws;
    const float* Rv = (const float*)(ws + WS_RW) + (size_t)3 * MTOK * RW; const float* Rg = (const float*)(ws + WS_RW) + (size_t)6 * MTOK * RW;
    const float* bonus = (const float*)(ws + WS_BONUS);
    bf16* YB = (bf16*)(ws + WS_YABC) + (size_t)MTOK * 512;
    const float* lnw = ldarg(I_R_LNW); const float* lnb = ldarg(I_R_LNB);
    for (int wi = gw; wi < N_RITEMS * 4; wi += NGW) {
        const int item = wi >> 2, tt = wi & 3, bh = item >> 7, c = item & 127, b = bh >> 3, h = bh & 7;
        const bf16x8 ps0 = *((const GAS bf16x8*)(ws + WS_PSI) + (((size_t)item * 4 + tt) * 2 + 0) * 64 + lane), ps1 = *((const GAS bf16x8*)(ws + WS_PSI) + (((size_t)item * 4 + tt) * 2 + 1) * 64 + lane);
        f32x4 acc[4];
#pragma unroll
        for (int vb = 0; vb < 4; ++vb) {
            const bf16x8 x0 = *((const GAS bf16x8*)(ws + WS_XFR) + (((size_t)item * 4 + vb) * 2 + 0) * 64 + lane), x1 = *((const GAS bf16x8*)(ws + WS_XFR) + (((size_t)item * 4 + vb) * 2 + 1) * 64 + lane);
            f32x4 a = *((const GAS f32x4*)(ws + WS_OM) + (((size_t)item * 4 + vb) * 4 + tt) * 64 + lane);
            a = __builtin_amdgcn_mfma_f32_16x16x32_bf16(ps0, x0, a, 0, 0, 0);
            a = __builtin_amdgcn_mfma_f32_16x16x32_bf16(ps1, x1, a, 0, 0, 0);
            acc[vb] = a; }
        const size_t rowb = (size_t)b * SEQ + (size_t)c * 64 + 16 * tt + 4 * q;
#pragma unroll
        for (int r = 0; r < 4; ++r) { const size_t t = rowb + r;
            const float s = (acc[0][r] + acc[1][r]) + (acc[2][r] + acc[3][r]);
            const float mean = row16_sum(s) * (1.f / 64.f);
            const float d0 = acc[0][r] - mean, d1 = acc[1][r] - mean, d2 = acc[2][r] - mean, d3 = acc[3][r] - mean;
            const float var = row16_sum((d0 * d0 + d1 * d1) + (d2 * d2 + d3 * d3)) * (1.f / 64.f);
            const float rstd = 1.0f / sqrtf(var + R_GN_EPS);
            const float bn = bonus[t * 8 + h];
#pragma unroll
            for (int vb = 0; vb < 4; ++vb) { const int ch = h * 64 + 16 * vb + cc; const float d = (vb == 0) ? d0 : (vb == 1) ? d1 : (vb == 2) ? d2 : d3;
                const float yn = d * rstd * lnw[ch] + lnb[ch];
                const float vv = *(const GAS float*)(Rv + t * RW + ch), gg = *(const GAS float*)(Rg + t * RW + ch);
                YB[t * 512 + ch] = (bf16)f2bf((yn + bn * vv) * gg); } }
    }
}

__global__ void __launch_bounds__(NWAVES * 64, 2) skel_fwd(Args args) {
    extern __shared__ __attribute__((aligned(16))) unsigned char lds[];
    Frame F;
    F.lds = (LAS unsigned char*)lds;
    F.MISC = (volatile LAS unsigned*)(F.lds + MISC_OFF);
    phase_enter(F, true);
    F.G = gridDim.x; { const int bx = blockIdx.x; F.vcu = (F.G % 8 == 0) ? (bx % 8) * (F.G / 8) + bx / 8 : bx; }
    unsigned char* ws = args.ws; F.ws = ws; F.out = args.out;
    F.ctl = (gu32*)(ws + WS_CTL);
    for (int u = F.tid; u < (LDS_BYTES - LDSCTL_OFF) / 4; u += NWAVES * 64) ((LAS unsigned*)(F.lds + LDSCTL_OFF))[u] = 0u;
    __syncthreads();
    XcdBarrier bar; bar.bar = (unsigned*)(F.ctl + CW_BAR); bar.x = 0; bar.st = nullptr;
    if (args.use_bar) bar = xcd_barrier_post((unsigned*)(F.ctl + CW_BAR), F.MISC + 8);
    const int lo = args.ph_lo, hi = args.ph_hi;
#define IN(k) (phase_enter(F, lo <= (k) && (k) < hi))
#define SEAM(k) do { if (lo <= (k) && (k) + 1 < hi) xcd_barrier(bar); } while (0)
    const pg8::bf16_t* wsb = (const pg8::bf16_t*)ws;
#define BF(off) ((pg8::bf16_t*)(ws + (off)))

    if (IN(0)) { p0_prologue<0>(F, args, F.vcu * NWAVES + F.wave, F.G * NWAVES); if (F.G <= 64) p0_prologue<1>(F, args, F.vcu * NWAVES + F.wave, F.G * NWAVES); } SEAM(0);
    if (IN(1)) {
        { pg8::Gemm g{BF(WS_XN), BF(WS_WIN), MTOK, IN_COLS, 1024}; pg8::StaticOrder S; S.init(MTOK, IN_COLS, F.G, (int)blockIdx.x);
          pg8::EpiBf16<0> E{BF(WS_Z), IN_COLS, nullptr, 0, 0, 1.f};
          pg8::gemm_phase<pg8::EpiBf16<0>, pg8::StaticOrder, true, true>(F.lds + RING_OFF, g, S, E); }
        { pg8::Gemm g{BF(WS_MEMN), BF(WS_WMEM), MEMROWS, 1024, 1024}; pg8::StaticOrder S; S.init(MEMROWS, 1024, F.G, (int)blockIdx.x);
          pg8::EpiBf16<0> E{BF(WS_KVM), 1024, nullptr, 0, 0, 1.f};
          pg8::gemm_phase<pg8::EpiBf16<0>, pg8::StaticOrder, true, true>(F.lds + RING_OFF, g, S, E); }
    } SEAM(1);
    if (IN(2)) { p2_prep(F, args); __syncthreads(); p2_rwkv(F, args); } SEAM(2);
#if NAIVE_ATTN
    if (IN(3)) { p3_attention(F); } SEAM(3);
#else
    if (IN(3)) { p3_attention_mfma(ws, (char*)lds + RING_OFF, F.G); __syncthreads(); phase_enter(F, true); p_r1(F, args); } SEAM(3);
#endif
    if (IN(4)) { p_r2(F); if (F.G > 64 && blockIdx.x >= 64) p0_prologue<1>(F, args, ((int)blockIdx.x - 64) * NWAVES + F.wave, (F.G - 64) * NWAVES); } SEAM(4);
    if (IN(5)) { p_r3(F, args); p5_post(F, args); } SEAM(5);
    if (IN(6)) {
        for (int br = 0; br < 3; ++br) {
            pg8::Gemm g{BF(WS_YABC) + (size_t)br * MTOK * 512, BF(WS_WB) + (size_t)br * 1024 * 512, MTOK, 1024, 512}; pg8::StaticOrder S; S.init(MTOK, 1024, F.G, (int)blockIdx.x);
            pg8::EpiGate E{BF(WS_Z), ldarg(I_B_GATE), (float*)(ws + WS_MRG), BF(WS_MRGB), br};
            pg8::gemm_phase<pg8::EpiGate, pg8::StaticOrder, true, true>(F.lds + RING_OFF, g, S, E);
        }
    } SEAM(6);
    if (IN(7)) {
        pg8::Gemm g{BF(WS_MRGB), BF(WS_WO), MTOK, 1024, 1024}; pg8::StaticOrder S; S.init(MTOK, 1024, F.G, (int)blockIdx.x);
        pg8::EpiResF32 E{ldarg(I_X), F.out, 1024};
        pg8::gemm_phase<pg8::EpiResF32, pg8::StaticOrder, true, true>(F.lds + RING_OFF, g, S, E);
    } SEAM(7);
    if (IN(8)) { p8_router(F, args); } SEAM(8);
    if (IN(9)) { p9_dispatch(F, args); } SEAM(9);
    if (IN(10)) {
        moe_table(F);
        pg8::Gemm g{BF(WS_XS), BF(WS_W1), 0, 0, 1024}; pg8::MoeOrder S{(const PG8_LAS int*)(F.lds + MOETAB_OFF), 8, F.G, (int)blockIdx.x};
        pg8::EpiSwiGLU E{ldarg(I_EXP_B1), BF(WS_HACT)};
        pg8::gemm_phase<pg8::EpiSwiGLU, pg8::MoeOrder, true, true>(F.lds + RING_OFF, g, S, E);
    } SEAM(10);
    if (IN(11)) {
        moe_table(F);
        pg8::Gemm g{BF(WS_HACT), BF(WS_W2), 0, 0, 1024}; pg8::MoeOrder S{(const PG8_LAS int*)(F.lds + MOETAB_OFF), 4, F.G, (int)blockIdx.x};
        pg8::EpiMoeOut E{ldarg(I_EXP_B2), (const float*)(ws + WS_ROUTE + RT_ROWGATE), BF(WS_YROWS)};
        pg8::gemm_phase<pg8::EpiMoeOut, pg8::MoeOrder, true, true>(F.lds + RING_OFF, g, S, E);
    } SEAM(11);
    if (IN(12)) { p12_combine(F); }
#undef IN
#undef SEAM
#undef BF
    (void)wsb;
}

extern "C" void kernel_launch(void* const* d_in, const int* in_sizes, int n_in, void* d_out, int out_size, void* d_ws, size_t ws_size, hipStream_t stream) {
    static int grid = 0;
    if (grid == 0) {
        if (n_in != 32 || out_size != MTOK * D_MODEL || ws_size < WS_END) { fprintf(stderr, "kernel_launch: unexpected problem (n_in %d, out %d, ws %zu); nothing launched\n", n_in, out_size, ws_size); grid = -1; return; }
        int dev = 0, cus = 0;
        if (hipGetDevice(&dev) != hipSuccess || hipDeviceGetAttribute(&cus, hipDeviceAttributeMultiprocessorCount, dev) != hipSuccess) { grid = -1; return; }
        if (hipFuncSetAttribute((const void*)skel_fwd, hipFuncAttributeMaxDynamicSharedMemorySize, LDS_BYTES) != hipSuccess) { fprintf(stderr, "kernel_launch: hipFuncSetAttribute failed\n"); grid = -1; return; }
        (void)hipGetLastError();
        grid = cus;
    }
    if (grid < 0) return;
    (void)hipMemsetAsync((char*)d_ws + WS_CTL, 0, CTL_ZERO_BYTES, stream);
    Args a{};
    for (int i = 0; i < 32; ++i) a.in[i] = (const float*)d_in[i];
    a.out = (float*)d_out; a.ws = (unsigned char*)d_ws;
#if MK_N_LAUNCHES == 1
    a.ph_lo = 0; a.ph_hi = N_PHASES; a.use_bar = 1;
    hipLaunchKernelGGL(skel_fwd, dim3(grid), dim3(NWAVES * 64), LDS_BYTES, stream, a);
#else
    for (int p = 0; p < N_PHASES; ++p) { a.ph_lo = p; a.ph_hi = p + 1; a.use_bar = 0;
        hipLaunchKernelGGL(skel_fwd, dim3(grid), dim3(NWAVES * 64), LDS_BYTES, stream, a); }
#endif
}
```

```cpp
#include <hip/hip_runtime.h>
#include <cstdio>
#include <cstdint>
#include <cmath>
namespace pg8 {
#define PG8_LAS __attribute__((address_space(3)))
typedef unsigned short bf16_t;
typedef short bf16x8 __attribute__((ext_vector_type(8)));
typedef float f32x4 __attribute__((ext_vector_type(4)));
typedef unsigned u32x4 __attribute__((ext_vector_type(4)));
constexpr int BM = 256, BK = 64, HALF = 128, HTB = HALF * BK * 2  , STAGE_BYTES = 8 * HTB, NXCD = 8, WGM = 8;

__host__ __device__ __forceinline__ int lds_byte(int r, int c) { const int st = (r >> 4) * 2 + (c >> 5), rr = r & 15, cc = c & 31, ob = rr * 64 + cc * 2; return st * 1024 + (ob ^ (((ob >> 9) & 1) << 5)); }
__host__ __device__ __forceinline__ void stage_rc(int b, int& R, int& C) { const int st = b / 1024, sb = b % 1024, swz = sb ^ (((sb >> 9) & 1) << 5); R = (st >> 1) * 16 + swz / 64; C = (st & 1) * 32 + (swz % 64) / 2; }
__host__ __device__ __forceinline__ int perm32(int rho) { const int n = rho >> 4, i = rho & 15; return 8 * (i >> 2) + 4 * n + (i & 3); }

struct Unit { int pm, pn; };
struct Gemm { const bf16_t* A; const bf16_t* Bt; int M, N, K; };

struct StaticOrder {
    int nM, nN, nwg, G, c;
    __host__ __device__ void init(int M, int N, int G_, int c_) { nM = M / BM; nN = N / BM; nwg = nM * nN; G = G_; c = c_; }
    __host__ __device__ bool next(int i, Unit& u) const {
        const long L = (long)i * G + c; if (L >= nwg) return false;
        int wgid = (int)L; { const int q = nwg / NXCD, r = nwg % NXCD, xcd = wgid % NXCD, off = wgid / NXCD; wgid = (xcd < r ? xcd * (q + 1) : r * (q + 1) + (xcd - r) * q) + off; }
        const int nig = WGM * nN, gid = wgid / nig, fm = gid * WGM, gsz = (nM - fm) < WGM ? (nM - fm) : WGM;
        u.pm = fm + ((wgid % nig) % gsz); u.pn = (wgid % nig) / gsz; return true;
    }
    __device__ __forceinline__ void a_ready(const Unit&) const {}
    __device__ __forceinline__ void done(const Unit&) const {}
};

__device__ __forceinline__ unsigned cvt_pk_bf16(float lo, float hi) { unsigned r; asm volatile("v_cvt_pk_bf16_f32 %0, %1, %2" : "=v"(r) : "v"(lo), "v"(hi)); return r; }
typedef float f32x2 __attribute__((ext_vector_type(2)));
__device__ __forceinline__ f32x2 gelu_pk(f32x2 v) {
    const f32x2 av = __builtin_elementwise_abs(v), d = av * 0.2316418882f + 1.0f;
    f32x2 t; t.x = __builtin_amdgcn_rcpf(d.x); t.y = __builtin_amdgcn_rcpf(d.y);
    f32x2 q = t * 0.5307027145f + (-0.7265760135f); q = q * t + 0.7107068705f; q = q * t + (-0.142248368f); q = q * t + 0.127414796f; q = q * t;
    const f32x2 s = (v * v) * (-0.72134752044f);
    f32x2 e; e.x = __builtin_amdgcn_exp2f(s.x); e.y = __builtin_amdgcn_exp2f(s.y);
    const f32x2 m = v * (q * e), r = v - m;
    f32x2 o; o.x = v.x < 0.f ? m.x : r.x; o.y = v.y < 0.f ? m.y : r.y; return o;
}

template <int ACT  > struct EpiBf16 {
    static constexpr bool PERM = true, AFTER_DRAIN = false; static_assert(ACT == 0 || ACT == 1, "EpiBf16: ACT is 0 (none) or 1 (gelu_pk)");
    bf16_t* O; int ldc; const float* bias; int split_cols; size_t split_stride; float scale0;
    __device__ __forceinline__ void operator()(const f32x4 (&acc)[2][2][4][2], const Unit& u, int wr, int wc, int fr, int fq) const {
        const int row0 = u.pm * BM + wr * 64 + fr; int colt = u.pn * BM; bf16_t* base = O;
        float sc = 1.f; if (split_cols) { const int t = colt / split_cols; base += (size_t)t * split_stride; colt -= t * split_cols; if (t == 0) sc = scale0; }
        const int col0 = colt + wc * 32 + 8 * fq, bcol0 = u.pn * BM + wc * 32 + 8 * fq;
        f32x4 bv[2][2];
#pragma unroll
        for (int bj = 0; bj < 2; ++bj)
#pragma unroll
            for (int n = 0; n < 2; ++n) bv[bj][n] = bias ? *(const f32x4*)(bias + bcol0 + bj * HALF + 4 * n) : (f32x4){0.f, 0.f, 0.f, 0.f};
#pragma unroll
        for (int ai = 0; ai < 2; ++ai)
#pragma unroll
            for (int m = 0; m < 4; ++m) { bf16_t* rowp = base + (size_t)(row0 + ai * HALF + m * 16) * ldc + col0;
#pragma unroll
                for (int bj = 0; bj < 2; ++bj) { f32x4 v0 = acc[ai][bj][m][0] + bv[bj][0], v1 = acc[ai][bj][m][1] + bv[bj][1];
                    if (ACT == 1) { f32x2 a = gelu_pk((f32x2){v0[0], v0[1]}), b = gelu_pk((f32x2){v0[2], v0[3]}), c = gelu_pk((f32x2){v1[0], v1[1]}), d = gelu_pk((f32x2){v1[2], v1[3]});
                        v0 = (f32x4){a.x, a.y, b.x, b.y}; v1 = (f32x4){c.x, c.y, d.x, d.y}; }
                    v0 = v0 * sc; v1 = v1 * sc; u32x4 w; w.x = cvt_pk_bf16(v0[0], v0[1]); w.y = cvt_pk_bf16(v0[2], v0[3]); w.z = cvt_pk_bf16(v1[0], v1[1]); w.w = cvt_pk_bf16(v1[2], v1[3]);
                    *(u32x4*)(rowp + bj * HALF) = w; } }
    }
};
template <class E_> struct EpiHasMid { static constexpr bool v = false; };
template <class Epi, class Sched, bool ALIGN_EPI = false, bool SP2 = false>
__device__ __forceinline__ void gemm_phase(PG8_LAS unsigned char* lds, const Gemm g, const Sched& S, const Epi& E) {
    int tid_ = threadIdx.x; asm volatile("" : "+v"(tid_));
    const int tid = tid_, wid = __builtin_amdgcn_readfirstlane(tid >> 6), lane = tid & 63, wr = wid >> 2, wc = wid & 3, fr = lane & 15, fq = lane >> 4;
    const int K = g.K, nt = K / BK;
    unsigned voffA[2], voffB[2];
#pragma unroll
    for (int i = 0; i < 2; ++i) { int R, C; stage_rc(tid * 16 + i * 8192, R, C); const int Rb = Epi::PERM ? ((R & ~31) + perm32(R & 31)) : R;
        voffA[i] = (unsigned)(R * K + C) * 2u; voffB[i] = (unsigned)(Rb * K + C) * 2u; }
    const size_t kstep = (size_t)(BK * 2);
    const size_t hstep = (size_t)HALF * K * 2;
    const size_t tstep = 2 * hstep;
    const unsigned ldsw = (unsigned)wid * 1024u;
    const int aoff = lds_byte(wr * 64 + fr, fq * 8), boff = lds_byte(wc * 32 + fr, fq * 8);
#define PG8_SA(b, h) (((b) * 2 + (h)) * HTB)
#define PG8_SB(b, h) ((4 + (b) * 2 + (h)) * HTB)
#define PG8_STAGE(bufoff, gbase, voff) do { _Pragma("unroll") for (int _i = 0; _i < 2; ++_i) \
        __builtin_amdgcn_global_load_lds((const unsigned*)((const char*)(gbase) + (voff)[_i]), (PG8_LAS unsigned*)(lds + (bufoff) + ldsw + _i * 8192), 16, 0, 0); } while (0)
#define PG8_LDA(dst, b, h) do { _Pragma("unroll") for (int m = 0; m < 4; ++m) _Pragma("unroll") for (int k = 0; k < 2; ++k) dst[m][k] = *(const PG8_LAS bf16x8*)(lds + PG8_SA(b, h) + aoff + m * 2048 + k * 1024); } while (0)
#define PG8_LDB(dst, b, h) do { _Pragma("unroll") for (int n = 0; n < 2; ++n) _Pragma("unroll") for (int k = 0; k < 2; ++k) dst[n][k] = *(const PG8_LAS bf16x8*)(lds + PG8_SB(b, h) + boff + n * 2048 + k * 1024); } while (0)
#define PG8_MMA(ai, bj, At, Bt) do { __builtin_amdgcn_s_setprio(1); _Pragma("unroll") for (int m = 0; m < 4; ++m) _Pragma("unroll") for (int n = 0; n < 2; ++n) _Pragma("unroll") for (int k = 0; k < 2; ++k) \
        acc[ai][bj][m][n] = __builtin_amdgcn_mfma_f32_16x16x32_bf16(Bt[n][k], At[m][k], acc[ai][bj][m][n], 0, 0, 0); __builtin_amdgcn_s_setprio(0); } while (0)
#define PG8_WAIT_V(n) asm volatile("s_waitcnt vmcnt(" #n ")" ::: "memory")
#define PG8_WAIT_L(n) asm volatile("s_waitcnt lgkmcnt(" #n ")" ::: "memory")
#define PG8_BAR __builtin_amdgcn_s_barrier()
#define PG8_SCHED __builtin_amdgcn_sched_barrier(0)
    Unit cur, nxt; int ui = 0;
    if (!S.next(0, cur)) return;
    f32x4 acc[2][2][4][2];
#pragma unroll
    for (int a = 0; a < 2; ++a)
#pragma unroll
        for (int b = 0; b < 2; ++b)
#pragma unroll
            for (int m = 0; m < 4; ++m)
#pragma unroll
                for (int n = 0; n < 2; ++n) acc[a][b][m][n] = (f32x4){0.f, 0.f, 0.f, 0.f};
    bf16x8 At[4][2], B0[2][2], B1[2][2];
    const char* cA = (const char*)g.A + (size_t)cur.pm * tstep; const char* cB = (const char*)g.Bt + (size_t)cur.pn * tstep;
    S.a_ready(cur);
    if constexpr (SP2) {
        PG8_STAGE(PG8_SB(0, 0), cB, voffB); PG8_STAGE(PG8_SB(0, 1), cB + hstep, voffB); PG8_STAGE(PG8_SA(0, 0), cA, voffA); PG8_STAGE(PG8_SA(0, 1), cA + hstep, voffA);
        if (wr == 1) PG8_BAR;
        PG8_WAIT_V(2); PG8_BAR;
        PG8_STAGE(PG8_SB(1, 0), cB + kstep, voffB); PG8_STAGE(PG8_SA(1, 0), cA + kstep, voffA); PG8_STAGE(PG8_SB(1, 1), cB + hstep + kstep, voffB);
        PG8_WAIT_V(6); PG8_BAR;
    } else {
        PG8_STAGE(PG8_SB(0, 0), cB, voffB); PG8_STAGE(PG8_SA(0, 0), cA, voffA); PG8_STAGE(PG8_SB(0, 1), cB + hstep, voffB); PG8_STAGE(PG8_SA(0, 1), cA + hstep, voffA);
        if (wr == 1) PG8_BAR;
        PG8_WAIT_V(4); PG8_BAR;
        PG8_STAGE(PG8_SB(1, 0), cB + kstep, voffB); PG8_STAGE(PG8_SA(1, 0), cA + kstep, voffA); PG8_STAGE(PG8_SB(1, 1), cB + hstep + kstep, voffB);
        PG8_WAIT_V(6); PG8_BAR;
    }
    for (;;) {
        const bool has_next = S.next(ui + 1, nxt);
        const char* nA = has_next ? (const char*)g.A + (size_t)nxt.pm * tstep : cA; const char* nB = has_next ? (const char*)g.Bt + (size_t)nxt.pn * tstep : cB;
        for (int t = 0; t < nt; t += 2) {
            if constexpr (EpiHasMid<Epi>::v) { if (t == 8 || t == 16) { PG8_SCHED; E.mid(acc, cur, t, wr, wc, fr, fq); PG8_SCHED; } }
            const bool last = (t == nt - 2);
            const char* a1 = cA + (size_t)(t + 1) * kstep;
            const char* a2 = last ? nA : cA + (size_t)(t + 2) * kstep; const char* b2 = last ? nB : cB + (size_t)(t + 2) * kstep;
            const char* a3 = a2 + kstep; const char* b3 = b2 + kstep;
            if (last && has_next) S.a_ready(nxt);
            if constexpr (SP2) {
            PG8_LDB(B0, 0, 0); PG8_LDB(B1, 0, 1); PG8_SCHED; PG8_LDA(At, 0, 0); PG8_STAGE(PG8_SA(1, 1), a1 + hstep, voffA);
            PG8_WAIT_V(8); PG8_WAIT_L(0); PG8_BAR; PG8_MMA(0, 0, At, B0); PG8_MMA(0, 1, At, B1); PG8_BAR; PG8_SCHED;
            PG8_LDA(At, 0, 1); PG8_STAGE(PG8_SB(0, 0), b2, voffB); PG8_STAGE(PG8_SB(0, 1), b2 + hstep, voffB); PG8_STAGE(PG8_SA(0, 0), a2, voffA);
            PG8_WAIT_V(8); PG8_WAIT_L(0); PG8_BAR; PG8_MMA(1, 0, At, B0); PG8_MMA(1, 1, At, B1); PG8_BAR; PG8_SCHED;
            PG8_LDB(B0, 1, 0); PG8_LDB(B1, 1, 1); PG8_SCHED; PG8_LDA(At, 1, 0); PG8_STAGE(PG8_SA(0, 1), a2 + hstep, voffA);
            PG8_WAIT_V(8); PG8_WAIT_L(0); PG8_BAR; PG8_MMA(0, 0, At, B0); PG8_MMA(0, 1, At, B1); PG8_BAR; PG8_SCHED;
            PG8_LDA(At, 1, 1); PG8_STAGE(PG8_SB(1, 0), b3, voffB); PG8_STAGE(PG8_SB(1, 1), b3 + hstep, voffB); PG8_STAGE(PG8_SA(1, 0), a3, voffA);
            PG8_WAIT_V(8); PG8_WAIT_L(0); PG8_BAR; PG8_MMA(1, 0, At, B0); PG8_MMA(1, 1, At, B1); PG8_BAR; PG8_SCHED;
            } else {
            PG8_LDB(B0, 0, 0); PG8_SCHED; PG8_LDA(At, 0, 0); PG8_STAGE(PG8_SA(1, 1), a1 + hstep, voffA);
            PG8_WAIT_L(8); PG8_BAR; PG8_WAIT_L(0); PG8_MMA(0, 0, At, B0); PG8_BAR; PG8_SCHED;
            PG8_LDB(B1, 0, 1); PG8_STAGE(PG8_SB(0, 0), b2, voffB);
            PG8_BAR; PG8_WAIT_L(0); PG8_MMA(0, 1, At, B1); PG8_BAR;
            PG8_LDA(At, 0, 1); PG8_STAGE(PG8_SA(0, 0), a2, voffA);
            PG8_BAR; PG8_WAIT_L(0); PG8_MMA(1, 0, At, B0); PG8_BAR; PG8_SCHED;
            PG8_STAGE(PG8_SB(0, 1), b2 + hstep, voffB);
            PG8_WAIT_V(6); PG8_BAR; PG8_MMA(1, 1, At, B1); PG8_BAR;
            PG8_LDB(B0, 1, 0); PG8_SCHED; PG8_LDA(At, 1, 0); PG8_STAGE(PG8_SA(0, 1), a2 + hstep, voffA);
            PG8_WAIT_L(8); PG8_BAR; PG8_WAIT_L(0); PG8_MMA(0, 0, At, B0); PG8_BAR; PG8_SCHED;
            PG8_LDB(B1, 1, 1); PG8_STAGE(PG8_SB(1, 0), b3, voffB);
            PG8_BAR; PG8_WAIT_L(0); PG8_MMA(0, 1, At, B1); PG8_BAR;
            PG8_LDA(At, 1, 1); PG8_STAGE(PG8_SA(1, 0), a3, voffA);
            PG8_BAR; PG8_WAIT_L(0); PG8_MMA(1, 0, At, B0); PG8_BAR; PG8_SCHED;
            PG8_STAGE(PG8_SB(1, 1), b3 + hstep, voffB);
            PG8_WAIT_V(6); PG8_BAR; PG8_MMA(1, 1, At, B1); PG8_BAR;
            }
        }
        if constexpr (ALIGN_EPI) { if (wr == 0) PG8_BAR; }
        if constexpr (!Epi::AFTER_DRAIN) { E(acc, cur, wr, wc, fr, fq); S.done(cur); }
        if (!has_next) break;
#pragma unroll
        for (int a = 0; a < 2; ++a)
#pragma unroll
            for (int b = 0; b < 2; ++b)
#pragma unroll
                for (int m = 0; m < 4; ++m)
#pragma unroll
                    for (int n = 0; n < 2; ++n) acc[a][b][m][n] = (f32x4){0.f, 0.f, 0.f, 0.f};
        cur = nxt; cA = nA; cB = nB; ++ui;
        if constexpr (ALIGN_EPI) { if (wr == 1) PG8_BAR; }
    }
    PG8_WAIT_V(0);
    if constexpr (!ALIGN_EPI) { if (wr == 0) PG8_BAR; }
    PG8_BAR;
    if constexpr (Epi::AFTER_DRAIN) { E.fused(acc, cur, wr, wc, fr, fq, lds, wid, lane); S.done(cur); }
#undef PG8_SA
#undef PG8_SB
#undef PG8_STAGE
#undef PG8_LDA
#undef PG8_LDB
#undef PG8_MMA
#undef PG8_WAIT_V
#undef PG8_WAIT_L
#undef PG8_BAR
#undef PG8_SCHED
}
}

constexpr int D_MODEL = 1024, BATCH = 2, SEQ = 8192, MTOK = BATCH * SEQ, MEM_LEN = 256, MEMROWS = BATCH * MEM_LEN;
constexpr int IN_COLS = 9984, OFF_AQ = 0, OFF_AK = 1536, OFF_AV = 3072, OFF_R = 4608, OFF_CQ = 6400, OFF_GATE = 6912;
constexpr int RW = 512;
constexpr int N_EXPERTS = 32, TOP_K = 4, D_FF = 1024, MOE_ROWS = 256;
constexpr int MAX_BLOCKS = MTOK * TOP_K / MOE_ROWS + N_EXPERTS;
constexpr int MAX_SLOTS = MAX_BLOCKS * MOE_ROWS;
constexpr float NORM_EPS = 1e-6f, R_GN_EPS = 64e-5f;
constexpr float LOG2E = 1.4426950408889634f;
constexpr float QSCALE = 0.08838834764831845f * LOG2E;

namespace pg8 {
__device__ __forceinline__ float bf_lo(unsigned w) { return __builtin_bit_cast(float, w << 16); }
__device__ __forceinline__ float bf_hi(unsigned w) { return __builtin_bit_cast(float, w & 0xffff0000u); }
__device__ __forceinline__ float sigmoidf_fast(float x) { return 1.0f / (1.0f + __expf(-x)); }

struct EpiZ {
    static constexpr bool PERM = true, AFTER_DRAIN = false;
    bf16_t* O; const float* bgate; const float* aqg; const float* akg; const float* cqg; const float* cs;
    PG8_LAS float* P;
    int ldc, mode;
    __device__ __forceinline__ void operator()(const f32x4 (&acc)[2][2][4][2], const Unit& u, int wr, int wc, int fr, int fq) const {
        const int row0 = u.pm * BM + wr * 64 + fr, col0 = u.pn * BM + wc * 32 + 8 * fq;
        const int cls = mode ? ((u.pn < 2) ? 3 : 0) : (u.pn < 6) ? 1 : (u.pn < 12) ? 2 : (u.pn == 25 || u.pn == 26) ? 3 : (u.pn >= 27) ? 4 : 0;
        if (cls >= 1 && cls <= 3) {
            const int go = wc * 32 + 8 * fq;
            const f32x4 q0 = *(const f32x4*)(aqg + go), q1 = *(const f32x4*)(aqg + go + 4), k0 = *(const f32x4*)(akg + go), k1 = *(const f32x4*)(akg + go + 4), x0 = *(const f32x4*)(cqg + go), x1 = *(const f32x4*)(cqg + go + 4);
            const f32x4 g0 = (cls == 1) ? q0 : (cls == 2) ? k0 : x0, g1 = (cls == 1) ? q1 : (cls == 2) ? k1 : x1;
#pragma unroll
            for (int ai = 0; ai < 2; ++ai)
#pragma unroll
                for (int m = 0; m < 4; ++m)
#pragma unroll
                    for (int bj = 0; bj < 2; ++bj) { const f32x4 a = acc[ai][bj][m][0], b = acc[ai][bj][m][1];
                        float s = ((a[0] * a[0] + a[1] * a[1]) + (a[2] * a[2] + a[3] * a[3])) + ((b[0] * b[0] + b[1] * b[1]) + (b[2] * b[2] + b[3] * b[3]));
                        s += __shfl_xor(s, 16); s += __shfl_xor(s, 32);
                        if (fq == 0) P[((ai * HALF + wr * 64 + m * 16 + fr) * 2 + bj) * 4 + wc] = s; }
            asm volatile("s_waitcnt lgkmcnt(0)" ::: "memory"); __builtin_amdgcn_s_barrier(); asm volatile("" ::: "memory");
#pragma unroll
            for (int ai = 0; ai < 2; ++ai)
#pragma unroll
                for (int m = 0; m < 4; ++m) { const int rl = ai * HALF + wr * 64 + m * 16 + fr, row = u.pm * BM + rl;
                    f32x4 c0 = {0.f, 0.f, 0.f, 0.f}, c1 = c0, c2 = c0, c3 = c0;
                    if (cls != 3 && wc == 0) { const f32x4* cp = (const f32x4*)(cs + (size_t)row * 32 + 16 * (fq & 1)); c0 = cp[0]; c1 = cp[1]; c2 = cp[2]; c3 = cp[3]; }
#pragma unroll
                    for (int bj = 0; bj < 2; ++bj) { const f32x4 pv = *(const PG8_LAS f32x4*)(P + (rl * 2 + bj) * 4);
                        const float rstd = 1.0f / sqrtf(((pv[0] + pv[1]) + (pv[2] + pv[3])) * (1.0f / 128.0f) + NORM_EPS);
                        f32x4 v0 = acc[ai][bj][m][0] * rstd * g0, v1 = acc[ai][bj][m][1] * rstd * g1;
                        if (cls != 3 && wc == 0) {
                            f32x4 p0, p1;
#pragma unroll
                            for (int j = 0; j < 4; ++j) { p0[j] = __shfl_xor(v0[j], 32); p1[j] = __shfl_xor(v1[j], 32); }
                            const float sg = (fq < 2) ? -1.0f : 1.0f;
                            v0[0] = v0[0] * c0[0] + sg * p0[0] * c0[1]; v0[1] = v0[1] * c0[2] + sg * p0[1] * c0[3]; v0[2] = v0[2] * c1[0] + sg * p0[2] * c1[1]; v0[3] = v0[3] * c1[2] + sg * p0[3] * c1[3];
                            v1[0] = v1[0] * c2[0] + sg * p1[0] * c2[1]; v1[1] = v1[1] * c2[2] + sg * p1[1] * c2[3]; v1[2] = v1[2] * c3[0] + sg * p1[2] * c3[1]; v1[3] = v1[3] * c3[2] + sg * p1[3] * c3[3]; }
                        u32x4 w; w.x = cvt_pk_bf16(v0[0], v0[1]); w.y = cvt_pk_bf16(v0[2], v0[3]); w.z = cvt_pk_bf16(v1[0], v1[1]); w.w = cvt_pk_bf16(v1[2], v1[3]);
                        *(u32x4*)(O + (size_t)row * ldc + col0 + bj * HALF) = w; } }
            return;
        }
        const bool gate = cls == 4;
        f32x4 bv[2][2];
#pragma unroll
        for (int bj = 0; bj < 2; ++bj)
#pragma unroll
            for (int n = 0; n < 2; ++n) bv[bj][n] = gate ? *(const f32x4*)(bgate + (col0 - OFF_GATE) + bj * HALF + 4 * n) : (f32x4){0.f, 0.f, 0.f, 0.f};
#pragma unroll
        for (int ai = 0; ai < 2; ++ai)
#pragma unroll
            for (int m = 0; m < 4; ++m) { bf16_t* rowp = O + (size_t)(row0 + ai * HALF + m * 16) * ldc + col0;
#pragma unroll
                for (int bj = 0; bj < 2; ++bj) { f32x4 v0 = acc[ai][bj][m][0] + bv[bj][0], v1 = acc[ai][bj][m][1] + bv[bj][1];
                    if (gate) {
#pragma unroll
                        for (int j = 0; j < 4; ++j) { v0[j] = sigmoidf_fast(v0[j]); v1[j] = sigmoidf_fast(v1[j]); } }
                    u32x4 w; w.x = cvt_pk_bf16(v0[0], v0[1]); w.y = cvt_pk_bf16(v0[2], v0[3]); w.z = cvt_pk_bf16(v1[0], v1[1]); w.w = cvt_pk_bf16(v1[2], v1[3]);
                    *(u32x4*)(rowp + bj * HALF) = w; } }
    }
};
struct EpiGate3 {
    static constexpr bool PERM = true, AFTER_DRAIN = false;
    const bf16_t* Z; bf16_t* mergedb;
    __device__ __forceinline__ void mid(f32x4 (&acc)[2][2][4][2], const Unit& u, int t, int wr, int wc, int fr, int fq) const {
        int fr_ = fr; asm volatile("" : "+v"(fr_));
        const int row0 = u.pm * BM + wr * 64 + fr_, col0 = u.pn * BM + wc * 32 + 8 * fq, ba = (t >> 3) - 1;
        const bf16_t* gp = Z + OFF_GATE + ba * D_MODEL + col0;
#pragma unroll
        for (int ai = 0; ai < 2; ++ai)
#pragma unroll
            for (int m = 0; m < 4; ++m) { const bf16_t* rp = gp + (size_t)(row0 + ai * HALF + m * 16) * IN_COLS;
#pragma unroll
                for (int bj = 0; bj < 2; ++bj) { const u32x4 ga = *(const u32x4*)(rp + bj * HALF), gb = *(const u32x4*)(rp + D_MODEL + bj * HALF);
                    f32x4 r0, r1;
                    r0[0] = bf_lo(ga[0]) * __builtin_amdgcn_rcpf(bf_lo(gb[0])); r0[1] = bf_hi(ga[0]) * __builtin_amdgcn_rcpf(bf_hi(gb[0])); r0[2] = bf_lo(ga[1]) * __builtin_amdgcn_rcpf(bf_lo(gb[1])); r0[3] = bf_hi(ga[1]) * __builtin_amdgcn_rcpf(bf_hi(gb[1]));
                    r1[0] = bf_lo(ga[2]) * __builtin_amdgcn_rcpf(bf_lo(gb[2])); r1[1] = bf_hi(ga[2]) * __builtin_amdgcn_rcpf(bf_hi(gb[2])); r1[2] = bf_lo(ga[3]) * __builtin_amdgcn_rcpf(bf_lo(gb[3])); r1[3] = bf_hi(ga[3]) * __builtin_amdgcn_rcpf(bf_hi(gb[3]));
                    acc[ai][bj][m][0] *= r0; acc[ai][bj][m][1] *= r1; }
                asm volatile("" ::: "memory"); }
    }
    __device__ __forceinline__ void operator()(const f32x4 (&acc)[2][2][4][2], const Unit& u, int wr, int wc, int fr, int fq) const {
        const int row0 = u.pm * BM + wr * 64 + fr, col0 = u.pn * BM + wc * 32 + 8 * fq;
#pragma unroll
        for (int ai = 0; ai < 2; ++ai)
#pragma unroll
            for (int m = 0; m < 4; ++m) { const int row = row0 + ai * HALF + m * 16;
#pragma unroll
                for (int bj = 0; bj < 2; ++bj) { const int col = col0 + bj * HALF;
                    const u32x4 gz = *(const u32x4*)(Z + (size_t)row * IN_COLS + OFF_GATE + 2 * D_MODEL + col);
                    f32x4 g0, g1;
                    g0[0] = bf_lo(gz[0]); g0[1] = bf_hi(gz[0]); g0[2] = bf_lo(gz[1]); g0[3] = bf_hi(gz[1]); g1[0] = bf_lo(gz[2]); g1[1] = bf_hi(gz[2]); g1[2] = bf_lo(gz[3]); g1[3] = bf_hi(gz[3]);
                    const f32x4 v0 = acc[ai][bj][m][0] * g0, v1 = acc[ai][bj][m][1] * g1;
                    u32x4 w; w.x = cvt_pk_bf16(v0[0], v0[1]); w.y = cvt_pk_bf16(v0[2], v0[3]); w.z = cvt_pk_bf16(v1[0], v1[1]); w.w = cvt_pk_bf16(v1[2], v1[3]);
                    *(u32x4*)(mergedb + (size_t)row * D_MODEL + col) = w; } }
    }
};
template <> struct EpiHasMid<EpiGate3> { static constexpr bool v = true; };
struct EpiResF32 {
    static constexpr bool PERM = true, AFTER_DRAIN = false;
    const float* base; float* out; int ldc;
    __device__ __forceinline__ void operator()(const f32x4 (&acc)[2][2][4][2], const Unit& u, int wr, int wc, int fr, int fq) const {
        const int row0 = u.pm * BM + wr * 64 + fr, col0 = u.pn * BM + wc * 32 + 8 * fq;
#pragma unroll
        for (int ai = 0; ai < 2; ++ai)
#pragma unroll
            for (int m = 0; m < 4; ++m) { const size_t off = (size_t)(row0 + ai * HALF + m * 16) * ldc + col0;
#pragma unroll
                for (int bj = 0; bj < 2; ++bj) { const float* bp = base + off + bj * HALF; float* op = out + off + bj * HALF;
                    const f32x4 x0 = *(const f32x4*)bp, x1 = *(const f32x4*)(bp + 4);
                    *(f32x4*)op = x0 + acc[ai][bj][m][0]; *(f32x4*)(op + 4) = x1 + acc[ai][bj][m][1]; } }
    }
};
struct EpiSwiGLU {
    static constexpr bool PERM = true, AFTER_DRAIN = false;
    const float* b1; bf16_t* H;
    __device__ __forceinline__ void operator()(const f32x4 (&acc)[2][2][4][2], const Unit& u, int wr, int wc, int fr, int fq) const {
        const int e = u.pn >> 3, pnl = u.pn & 7;
        const int row0 = u.pm * BM + wr * 64 + fr, ac = pnl * HALF + wc * 32 + 8 * fq;
        const float* bg = b1 + (size_t)e * 2 * D_FF + ac; const float* bl = bg + D_FF;
        const f32x4 bg0 = *(const f32x4*)bg, bg1 = *(const f32x4*)(bg + 4), bl0 = *(const f32x4*)bl, bl1 = *(const f32x4*)(bl + 4);
#pragma unroll
        for (int ai = 0; ai < 2; ++ai)
#pragma unroll
            for (int m = 0; m < 4; ++m) { const int row = row0 + ai * HALF + m * 16;
                float a[8];
#pragma unroll
                for (int n = 0; n < 2; ++n) { const f32x4 ug = acc[ai][0][m][n] + (n ? bg1 : bg0), ul = acc[ai][1][m][n] + (n ? bl1 : bl0);
#pragma unroll
                    for (int j = 0; j < 4; ++j) { const float g = fminf(ug[j], 7.0f), l = fminf(fmaxf(ul[j], -7.0f), 7.0f);
                        a[4 * n + j] = g * sigmoidf_fast(1.702f * g) * (l + 1.0f); } }
                u32x4 w; w.x = cvt_pk_bf16(a[0], a[1]); w.y = cvt_pk_bf16(a[2], a[3]); w.z = cvt_pk_bf16(a[4], a[5]); w.w = cvt_pk_bf16(a[6], a[7]);
                *(u32x4*)(H + (size_t)row * D_FF + ac) = w; }
    }
};
struct EpiMoeOut {
    static constexpr bool PERM = true, AFTER_DRAIN = false;
    const float* b2; const float* rowgate; bf16_t* Y;
    __device__ __forceinline__ void operator()(const f32x4 (&acc)[2][2][4][2], const Unit& u, int wr, int wc, int fr, int fq) const {
        const int e = u.pn >> 2, pnl = u.pn & 3;
        const int row0 = u.pm * BM + wr * 64 + fr, col0 = pnl * BM + wc * 32 + 8 * fq;
#pragma unroll
        for (int ai = 0; ai < 2; ++ai)
#pragma unroll
            for (int m = 0; m < 4; ++m) { const int row = row0 + ai * HALF + m * 16; const float gt = rowgate[row];
#pragma unroll
                for (int bj = 0; bj < 2; ++bj) { const int col = col0 + bj * HALF; const float* bp = b2 + (size_t)e * D_MODEL + col;
                    const f32x4 v0 = (acc[ai][bj][m][0] + *(const f32x4*)bp) * gt, v1 = (acc[ai][bj][m][1] + *(const f32x4*)(bp + 4)) * gt;
                    u32x4 w; w.x = cvt_pk_bf16(v0[0], v0[1]); w.y = cvt_pk_bf16(v0[2], v0[3]); w.z = cvt_pk_bf16(v1[0], v1[1]); w.w = cvt_pk_bf16(v1[2], v1[3]);
                    *(u32x4*)(Y + (size_t)row * D_MODEL + col) = w; } }
    }
};
struct MoeOrder {
    const PG8_LAS int* tab;
    int NT, G, c;
    __device__ __forceinline__ bool next(int i, Unit& u) const {
        const int nblk = tab[0]; const long L = (long)i * G + c; if (L >= (long)nblk * NT) return false;
        const int blk = (int)(L / NT), pnl = (int)(L % NT); u.pm = blk; u.pn = tab[1 + blk] * NT + pnl; return true;
    }
    __device__ __forceinline__ void a_ready(const Unit&) const {}
    __device__ __forceinline__ void done(const Unit&) const {}
};
}

namespace swa {
constexpr int D = 128;
constexpr float SCALE = 0.08838834764831845f;
constexpr float THR = 8.f;
constexpr int NW = 8, QBLK = 32, KVBLK = 64, QB = NW * QBLK;
constexpr int SHM_V = KVBLK * D * 2, SHM_K = KVBLK * D * 2;
constexpr int LDS_BYTES = 2 * SHM_V + 2 * SHM_K + NW * 64 * 4;
using bf16 = unsigned short;
typedef short bf16x8 __attribute__((ext_vector_type(8)));
typedef short s16x4 __attribute__((ext_vector_type(4)));
typedef float f32x16 __attribute__((ext_vector_type(16)));
typedef float f32x4 __attribute__((ext_vector_type(4)));
typedef unsigned u32x4 __attribute__((ext_vector_type(4)));
template <class A, class Bt> struct same_t { static constexpr bool v = false; };
template <class A> struct same_t<A, A> { static constexpr bool v = true; };
#define KSWZ(row, colB) ((row) * 256 + ((colB) ^ (((row) & 7) << 4)))
#define SBAR() __builtin_amdgcn_sched_barrier(0)
__device__ __forceinline__ int v_st(int k, int c) { const int kk = (k & ~0xC) | ((k & 4) << 1) | ((k & 8) >> 1); return ((kk >> 3) * 4 + (c >> 5)) * 512 + ((kk & 7) * 32 + (c & 31)) * 2; }
__device__ __forceinline__ int v_rd_base(int lane) { return ((lane & 3) << 3) | (((lane >> 2) & 3) << 6) | (((lane >> 4) & 1) << 5) | (((lane >> 5) & 1) << 8); }
constexpr int v_rd_off(int d0, int ks, int half) { return d0 * 512 + ks * 4096 + half * 2048; }
__device__ __forceinline__ int crow(int r, int hi) { return (r & 3) + 8 * (r >> 2) + 4 * hi; }
__device__ __forceinline__ unsigned cvtpk(float lo, float hi) {
    unsigned r; asm volatile("v_cvt_pk_bf16_f32 %0, %1, %2" : "=v"(r) : "v"(lo), "v"(hi)); return r;
}
__device__ __forceinline__ bf16x8 pack8(f32x4 a, f32x4 b) {
    u32x4 w = {cvtpk(a[0], a[1]), cvtpk(a[2], a[3]), cvtpk(b[0], b[1]), cvtpk(b[2], b[3])};
    return *reinterpret_cast<bf16x8*>(&w);
}
template <class T> __device__ __forceinline__ bf16x8 load8(const T* p) {
    if constexpr (same_t<T, float>::v) { return pack8(*(const f32x4*)p, *(const f32x4*)(p + 4)); }
    else { return *reinterpret_cast<const bf16x8*>(p); }
}
__device__ __forceinline__ void mask_tile(f32x16& p0, f32x16& p1, int dq, unsigned W) {
    const float NEG = -__builtin_inff();
#pragma unroll
    for (int r = 0; r < 16; ++r) {
        const int c = (r & 3) + 8 * (r >> 2);
        if ((unsigned)(dq - c) >= W) p0[r] = NEG;
        if ((unsigned)(dq - c - 32) >= W) p1[r] = NEG;
    }
}
__device__ __forceinline__ void partialSM(f32x16& p0, f32x16& p1, float& m_reg, float& mn, float& alpha) {
    float pmax = p0[0]; for (int r = 1; r < 16; ++r) pmax = fmaxf(pmax, p0[r]); for (int r = 0; r < 16; ++r) pmax = fmaxf(pmax, p1[r]);
    { auto rr = __builtin_amdgcn_permlane32_swap(__float_as_uint(pmax), __float_as_uint(pmax), false, false);
      pmax = fmaxf(__uint_as_float(rr[0]), __uint_as_float(rr[1])); }
    constexpr float C2 = 1.4426950408889634f * SCALE;
    if (__builtin_expect(__all((pmax - m_reg) * SCALE <= THR), 1)) { mn = m_reg; alpha = 1.f; }
    else { mn = fmaxf(m_reg, pmax); alpha = __builtin_amdgcn_exp2f((m_reg - mn) * C2); m_reg = mn; }
    const float mnL = -mn * C2;
    for (int r = 0; r < 16; ++r) p0[r] = fmaf(p0[r], C2, mnL); for (int r = 0; r < 16; ++r) p1[r] = fmaf(p1[r], C2, mnL);
    for (int r = 0; r < 16; ++r) p0[r] = __builtin_amdgcn_exp2f(p0[r]);
}
__device__ __forceinline__ void finishSM(f32x16& p0, f32x16& p1, float alpha, float& l_reg, bf16x8& pa0, bf16x8& pa1, bf16x8& pa2, bf16x8& pa3) {
    for (int r = 0; r < 16; ++r) p1[r] = __builtin_amdgcn_exp2f(p1[r]);
    float ps = 0; for (int r = 0; r < 16; ++r) ps += p0[r]; for (int r = 0; r < 16; ++r) ps += p1[r];
    { auto rr = __builtin_amdgcn_permlane32_swap(__float_as_uint(ps), __float_as_uint(ps), false, false);
      ps = __uint_as_float(rr[0]) + __uint_as_float(rr[1]); }
    l_reg = l_reg * alpha + ps;
#define PK4(P, B_, OUT) do { unsigned a0 = cvtpk(P[B_+0], P[B_+1]), a1 = cvtpk(P[B_+2], P[B_+3]);                          \
        unsigned b0 = cvtpk(P[B_+4], P[B_+5]), b1 = cvtpk(P[B_+6], P[B_+7]);                                             \
        auto r0 = __builtin_amdgcn_permlane32_swap(a0, b0, false, false); auto r1 = __builtin_amdgcn_permlane32_swap(a1, b1, false, false); \
        u32x4 w = {r0[0], r1[0], r0[1], r1[1]}; OUT = *reinterpret_cast<bf16x8*>(&w); } while (0)
    PK4(p0, 0, pa0); PK4(p0, 8, pa1); PK4(p1, 0, pa2); PK4(p1, 8, pa3);
#undef PK4
}
template <int KB, bool SK>
__device__ __forceinline__ void qkt(f32x16& p0, f32x16& p1, const char* K_lds, int r32, int hi, const bf16x8* qr, bool act) {
    if (SK && !act) { const float NEG = -__builtin_inff();
#pragma unroll
        for (int r = 0; r < 16; ++r) { p0[r] = NEG; p1[r] = NEG; } return; }
    p0 = f32x16{}; p1 = f32x16{};
    const char* kb[4];
#pragma unroll
    for (int dd = 0; dd < 4; ++dd) kb[dd] = K_lds + KB * SHM_K + KSWZ(r32, (dd * 16 + hi * 8) * 2);
#pragma unroll
    for (int d0 = 0; d0 < 8; ++d0) { const char* a = kb[d0 & 3] + (d0 >> 2) * 128;
        bf16x8 b0 = *reinterpret_cast<const bf16x8*>(a);
        bf16x8 b1 = *reinterpret_cast<const bf16x8*>(a + 32 * 256);
        p0 = __builtin_amdgcn_mfma_f32_32x32x16_bf16(b0, qr[d0], p0, 0, 0, 0);
        p1 = __builtin_amdgcn_mfma_f32_32x32x16_bf16(b1, qr[d0], p1, 0, 0, 0); }
}
template <int VB, bool SK>
__device__ __forceinline__ void pv_tile(f32x16* o, int vb0, bf16x8 pa0, bf16x8 pa1, bf16x8 pa2, bf16x8 pa3, bool act) {
    if (SK && !act) return;
#define TRRD(dst, off) asm volatile("ds_read_b64_tr_b16 %0, %1 offset:%2" : "=&v"(dst) : "v"(vb0), "i"(off) : "memory")
#define PV_D0(d0) do { s16x4 l0, l1, l2, l3, h0, h1, h2, h3; constexpr int b_ = VB * SHM_V + v_rd_off(d0, 0, 0);     \
        TRRD(l0, b_); TRRD(h0, b_ + 2048); TRRD(l1, b_ + 4096); TRRD(h1, b_ + 6144); TRRD(l2, b_ + 8192); TRRD(h2, b_ + 10240); TRRD(l3, b_ + 12288); TRRD(h3, b_ + 14336); \
        asm volatile("s_waitcnt lgkmcnt(0)" ::: "memory"); SBAR();                 \
        o[d0] = __builtin_amdgcn_mfma_f32_32x32x16_bf16(pa0, (bf16x8){l0[0], l0[1], l0[2], l0[3], h0[0], h0[1], h0[2], h0[3]}, o[d0], 0, 0, 0);   \
        o[d0] = __builtin_amdgcn_mfma_f32_32x32x16_bf16(pa1, (bf16x8){l1[0], l1[1], l1[2], l1[3], h1[0], h1[1], h1[2], h1[3]}, o[d0], 0, 0, 0);   \
        o[d0] = __builtin_amdgcn_mfma_f32_32x32x16_bf16(pa2, (bf16x8){l2[0], l2[1], l2[2], l2[3], h2[0], h2[1], h2[2], h2[3]}, o[d0], 0, 0, 0);   \
        o[d0] = __builtin_amdgcn_mfma_f32_32x32x16_bf16(pa3, (bf16x8){l3[0], l3[1], l3[2], l3[3], h3[0], h3[1], h3[2], h3[3]}, o[d0], 0, 0, 0); } while (0)
    PV_D0(0); PV_D0(1); PV_D0(2); PV_D0(3);
#undef PV_D0
#undef TRRD
}

struct BlockRef { const bf16* Q; const bf16* K; const bf16* V; bf16* O; float* LSE; int QS, KS, OS, LS, P0, skv, W; };
struct Seam { bf16x8 qr[8]; bf16x8 st_v0, st_v1, st_k0, st_k1; };
__device__ __forceinline__ int swa_jlo(int P0, int W) { const int lowk = P0 - W + 1; return lowk > 0 ? lowk / KVBLK : 0; }
#define LD8(p) (*reinterpret_cast<const bf16x8*>(p))
#define ROW(p, k0, rr, RS) ((p) + (size_t)((k0) + (rr)) * (RS) + sc)
#define VMW() asm volatile("s_waitcnt vmcnt(0)" ::: "memory")
#define VMWN(n) asm volatile("s_waitcnt vmcnt(%0)" :: "i"(n) : "memory")
#define SLOAD_H(Kp, Vp, k0, RS) do { const char* kb_ = (const char*)(Kp) + (size_t)(k0) * (size_t)(RS) * 2; const char* vb_ = (const char*)(Vp) + (size_t)(k0) * (size_t)(RS) * 2;  \
                         const unsigned oa_ = (unsigned)(sr * (RS) + sc) * 2u, ob_ = oa_ + (unsigned)(RS) * 64u;                                    \
                         S.st_v0 = LD8(vb_ + oa_); S.st_v1 = LD8(vb_ + ob_); S.st_k0 = LD8(kb_ + oa_); S.st_k1 = LD8(kb_ + ob_); } while (0)
#define SWRITE_HK(bf) do { *(bf16x8*)(K_lds + (bf) * SHM_K + kws) = S.st_k0; *(bf16x8*)(K_lds + (bf) * SHM_K + kws + 32 * 256) = S.st_k1; } while (0)
#define SWRITE_HV(bf) do { *(bf16x8*)(V_lds + (bf) * SHM_V + vst0) = S.st_v0; *(bf16x8*)(V_lds + (bf) * SHM_V + vst1) = S.st_v1; } while (0)
#define SWRITE_H(bf) do { SWRITE_HV(bf); SWRITE_HK(bf); } while (0)
__device__ __forceinline__ void swa_prime(const BlockRef& cur, char* lds, Seam& S) {
    int tid_ = threadIdx.x; asm volatile("" : "+v"(tid_));
    const int tid = tid_, wid = __builtin_amdgcn_readfirstlane(tid >> 6), lane = tid & 63, r32 = lane & 31, hi = lane >> 5;
    const int sr = tid >> 4, sc = (tid & 15) * 8, kws = KSWZ(sr, sc * 2); char* K_lds = lds + 2 * SHM_V;
    const int kb0 = swa_jlo(cur.P0, cur.W) * KVBLK;
    { const char* qb_ = (const char*)cur.Q + (size_t)(wid * QBLK) * (size_t)cur.QS * 2; const unsigned qo_ = (unsigned)(r32 * cur.QS + hi * 8) * 2u;
      for (int d0 = 0; d0 < 8; ++d0) S.qr[d0] = LD8(qb_ + qo_ + d0 * 32); }
    SLOAD_H(cur.K, cur.V, kb0, cur.KS); VMW(); SWRITE_HK(0);
    __syncthreads();
}
__device__ __forceinline__ void swa_block(const BlockRef& cur, const BlockRef& nxt, char* lds, Seam& S) {
    int tid_ = threadIdx.x; asm volatile("" : "+v"(tid_));
    const int tid = tid_, wid = __builtin_amdgcn_readfirstlane(tid >> 6), lane = tid & 63, r32 = lane & 31, hi = lane >> 5;
    const int W = cur.W, skv = cur.skv;
    const int j_lo = swa_jlo(cur.P0, W);
    int j_hi = (cur.P0 + QB - 1) / KVBLK + 1; if (j_hi > skv / KVBLK) j_hi = skv / KVBLK;
    const int NT = j_hi - j_lo;
    const int kbn = swa_jlo(nxt.P0, nxt.W) * KVBLK;
    const int qlo = cur.P0 + wid * QBLK, qm = qlo + r32 - 4 * hi;
    char* V_lds = lds; char* K_lds = lds + 2 * SHM_V;
    float* ws = (float*)(lds + 2 * SHM_V + 2 * SHM_K) + wid * 64; float* li_l = ws, * al_l = ws + 32;
    float m_reg = -1e30f, l_reg = 0; f32x16 o[4] = {};
    const int sr = tid >> 4, sc = (tid & 15) * 8, vst0 = v_st(sr, sc), vst1 = v_st(32 + sr, sc), kws = KSWZ(sr, sc * 2);
    const int vb0 = (int)(uintptr_t)V_lds + v_rd_base(lane);
    const bf16* Kh = cur.K; const bf16* Vh = cur.V; const int KSc = cur.KS;
#define RESC(a) do { if (__any((a) < 1.f)) { if (hi == 0) al_l[r32] = (a); asm volatile("s_waitcnt lgkmcnt(0)" ::: "memory");              \
                     for (int d_ = 0; d_ < 4; ++d_) for (int r = 0; r < 16; ++r) o[d_][r] *= al_l[crow(r, hi)]; } } while (0)
#define KBASE(t) ((j_lo + (t)) * KVBLK)
#define ACT(t) (KBASE(t) <= qlo + QBLK - 1 && KBASE(t) + KVBLK - 1 >= qlo - W + 1)
#define MASKT(P0_, P1_, t) do { const int kb_ = KBASE(t); if ((!SK || ACT(t)) && (kb_ + KVBLK - 1 > qlo || kb_ <= qlo + QBLK - 1 - W)) mask_tile(P0_, P1_, qm - kb_, (unsigned)W); } while (0)
    constexpr int NQL = 8;
    constexpr bool SK = true;
#define SEAM_K0() do { VMWN(NQL); SWRITE_HK(0); SBAR(); } while (0)
    f32x16 pA0, pA1, pB0, pB1; float mnA, mnB, alA, alB; bf16x8 pa0, pa1, pa2, pa3;
    SWRITE_HV(0); SBAR();
    if (NT > 1) { SLOAD_H(Kh, Vh, KBASE(1), KSc); }
    SBAR(); qkt<0, SK>(pA0, pA1, K_lds, r32, hi, S.qr, ACT(0));
    MASKT(pA0, pA1, 0); partialSM(pA0, pA1, m_reg, mnA, alA);
    if (NT > 1) { VMW(); SWRITE_H(1); }
    __syncthreads();
#define HALF_STEP(PX0, PX1, mnX, alX, PY0, PY1, alY, t, KB, VB, SB) do {                                                      \
        SBAR(); qkt<KB, SK>(PX0, PX1, K_lds, r32, hi, S.qr, ACT(t));                                             \
        finishSM(PY0, PY1, alY, l_reg, pa0, pa1, pa2, pa3); SBAR();                                                           \
        if ((t) + 1 < NT) { SLOAD_H(Kh, Vh, KBASE((t) + 1), KSc); SBAR(); }                                               \
        pv_tile<VB, SK>(o, vb0, pa0, pa1, pa2, pa3, ACT((t) - 1)); MASKT(PX0, PX1, (t)); partialSM(PX0, PX1, m_reg, mnX, alX);                                        \
        __syncthreads();                                                                                                      \
        if ((t) + 1 < NT) { VMW(); SWRITE_H(SB); }                                                                          \
        RESC(alX); __syncthreads(); } while (0)
    for (int t = 1; t + 1 < NT; t += 2) {
        HALF_STEP(pB0, pB1, mnB, alB, pA0, pA1, alA, t, 1, 0, 0);
        HALF_STEP(pA0, pA1, mnA, alA, pB0, pB1, alB, t + 1, 0, 1, 1);
    }
    const bool even = (NT & 1) == 0;
    if (even) { SBAR(); qkt<1, SK>(pB0, pB1, K_lds, r32, hi, S.qr, ACT(NT - 1)); SBAR(); }
    { SLOAD_H(nxt.K, nxt.V, kbn, nxt.KS); SBAR();
      const char* qb_ = (const char*)nxt.Q + (size_t)(wid * QBLK) * (size_t)nxt.QS * 2; const unsigned qo_ = (unsigned)(r32 * nxt.QS + hi * 8) * 2u;
#pragma unroll
        for (int d0 = 0; d0 < 8; ++d0) S.qr[d0] = LD8(qb_ + qo_ + d0 * 32); }
    SBAR();
    finishSM(pA0, pA1, alA, l_reg, pa0, pa1, pa2, pa3); SBAR();
    pv_tile<0, SK>(o, vb0, pa0, pa1, pa2, pa3, ACT(even ? NT - 2 : NT - 1));
    if (even) { MASKT(pB0, pB1, NT - 1); partialSM(pB0, pB1, m_reg, mnB, alB); __syncthreads(); RESC(alB);
        finishSM(pB0, pB1, alB, l_reg, pa0, pa1, pa2, pa3); SBAR(); pv_tile<1, SK>(o, vb0, pa0, pa1, pa2, pa3, ACT(NT - 1)); }
    SBAR(); SEAM_K0();
    if (hi == 0) li_l[r32] = l_reg; asm volatile("s_waitcnt lgkmcnt(0)" ::: "memory");
    if (cur.LSE != nullptr && hi == 0) cur.LSE[(size_t)(wid * QBLK + r32) * cur.LS] = __log2f(l_reg) + m_reg * (1.4426950408889634f * SCALE);
    float rli[16];
#pragma unroll
    for (int r = 0; r < 16; ++r) rli[r] = __builtin_amdgcn_rcpf(li_l[crow(r, hi)]);
    bf16* Ow = cur.O + (size_t)(wid * QBLK) * cur.OS;
#pragma unroll
    for (int r = 0; r < 16; ++r) { const int orow = crow(r, hi);
#pragma unroll
        for (int d0 = 0; d0 < 4; ++d0) { const float v = o[d0][r] * rli[r];
            const float vn = __shfl_xor(v, 1);
            if ((r32 & 1) == 0) *(unsigned*)(Ow + (size_t)orow * cur.OS + d0 * 32 + r32) = cvtpk(v, vn); } }
    __syncthreads();
#undef RESC
#undef KBASE
#undef ACT
#undef MASKT
#undef SEAM_K0
#undef HALF_STEP
}
#undef LD8
#undef ROW
#undef VMW
#undef VMWN
#undef SLOAD_H
#undef SWRITE_HK
#undef SWRITE_HV
#undef SWRITE_H
#undef KSWZ
#undef SBAR
}

constexpr int NWAVES = 8;
#ifndef MK_N_LAUNCHES
#define MK_N_LAUNCHES 1
#endif
constexpr int N_PHASES = 13;
#ifndef NAIVE_ATTN
#define NAIVE_ATTN 0
#endif
constexpr float ATT_QSCALE = NAIVE_ATTN ? QSCALE : 1.0f;

constexpr size_t MiB = 1u << 20;
constexpr size_t WS_CTL = 0, CTL_ZERO_BYTES = 1 * MiB;
constexpr size_t WS_WIN = 2 * MiB;
constexpr size_t WS_WB = 22 * MiB;
constexpr size_t WS_WO = 25 * MiB;
constexpr size_t WS_WMEM = 27 * MiB;
constexpr size_t WS_W1 = 29 * MiB;
constexpr size_t WS_W2 = 157 * MiB;
constexpr size_t WS_XN = 221 * MiB;
constexpr size_t WS_Z = 256 * MiB;
constexpr size_t WS_RW = 568 * MiB;
constexpr size_t WS_YS = 792 * MiB;
constexpr size_t WS_YABC = 824 * MiB;
constexpr size_t WS_MRG = 872 * MiB;
constexpr size_t WS_MRGB = 936 * MiB;
constexpr size_t WS_MEMN = 968 * MiB;
constexpr size_t WS_KVM = 969 * MiB;
constexpr size_t WS_XN2 = 970 * MiB;
constexpr size_t WS_ROUTE = 1002 * MiB;
constexpr size_t WS_LORA = 1004 * MiB;
constexpr size_t WS_END = 1005 * MiB;
constexpr size_t WS_XS = 256 * MiB;
constexpr size_t WS_HACT = 400 * MiB;
constexpr size_t WS_YROWS = 544 * MiB;
constexpr size_t WS_OP = WS_MRG;
constexpr size_t WS_LSE = WS_MRGB;
constexpr size_t WS_CS = WS_RW;
constexpr size_t WS_VMIX = WS_RW + 32 * MiB, WS_GMIX = WS_RW + 64 * MiB;
constexpr size_t RWSZ = (size_t)MTOK * RW * 4;
constexpr size_t RT_TOPI = 0, RT_TOPG = 256 * 1024, RT_POS = 512 * 1024, RT_ROWGATE = 768 * 1024;
static_assert(RT_ROWGATE + (size_t)MAX_SLOTS * 4 <= 1088 * 1024, "route");
constexpr int CW_TMO = 0, CW_CODE = 1;
constexpr int CW_BAR = 4096;
constexpr int CW_CNT = 16384;
constexpr int CW_CUR = 16384 + 2048;

constexpr int RING_OFF = 0, RING_BYTES = 131072;
constexpr int LDSCTL_OFF = 143360, MISC_OFF = LDSCTL_OFF + 320;
constexpr int MOETAB_OFF = MISC_OFF + 128;
constexpr int HIST_OFF = MOETAB_OFF + 1536;
constexpr int LDS_BYTES = 147456;
static_assert(HIST_OFF + 4 * 320 <= LDS_BYTES, "LDS map");
#define GAS __attribute__((address_space(1)))
#define LAS __attribute__((address_space(3)))
typedef unsigned short bf16;
typedef unsigned v4u __attribute__((ext_vector_type(4)));
typedef float f32x4 __attribute__((ext_vector_type(4)));
typedef short bf16x8 __attribute__((ext_vector_type(8)));
typedef GAS unsigned gu32;
typedef GAS unsigned long long gu64;
#define RLX_AGENT __ATOMIC_RELAXED, __HIP_MEMORY_SCOPE_AGENT
#define LDS_WAIT() asm volatile("s_waitcnt lgkmcnt(0)" ::: "memory")
#define VM_WAIT() asm volatile("s_waitcnt vmcnt(0)" ::: "memory")
__device__ __forceinline__ unsigned long long rt() { return __builtin_amdgcn_s_memrealtime(); }
typedef float f32x2_cv __attribute__((ext_vector_type(2))); typedef __bf16 bf16x2_cv __attribute__((ext_vector_type(2)));
__device__ __forceinline__ unsigned pk2(float lo, float hi) { f32x2_cv v = {lo, hi}; bf16x2_cv b = __builtin_convertvector(v, bf16x2_cv); return __builtin_bit_cast(unsigned, b); }
__device__ __forceinline__ unsigned f2bf(float f) { return pk2(f, f) & 0xffffu; }
#define XB_TMO      128
#define XB_XCNT(j)  (256  + 64 * (j))
#define XB_XSUB(j)  (1280 + 64 * (j))
#define XB_XGEN(j)  (2304 + 64 * (j))
#define XB_TOP      3328
#define XB_TOPGEN   3392
#define XCD_BAR_WORDS 3456
#define XB_SPIN_CAP (1u << 18)

__device__ __forceinline__ unsigned xb_ld(unsigned* p)              { return __hip_atomic_load(p, __ATOMIC_RELAXED, __HIP_MEMORY_SCOPE_AGENT); }
__device__ __forceinline__ unsigned xb_add(unsigned* p, unsigned v) { return __hip_atomic_fetch_add(p, v, __ATOMIC_RELAXED, __HIP_MEMORY_SCOPE_AGENT); }
__device__ __forceinline__ unsigned xb_xcc_id() { return (unsigned)__builtin_amdgcn_s_getreg((3 << 11) | 20) & 0xFu; }
#define XB_SPIN(cond, bar) do { unsigned _sp = 0; while (cond) { __builtin_amdgcn_s_sleep(1); \
    if ((++_sp & 255u) == 0u) { if (xb_ld(&(bar)[XB_TMO])) break; if (_sp > XB_SPIN_CAP) { atomicAdd(&(bar)[XB_TMO], 1u); break; } } } } while (0)

struct XcdBarrier {
    unsigned* bar; unsigned x;
    volatile LAS unsigned* st;
};

__device__ __forceinline__ XcdBarrier xcd_barrier_post(unsigned* bar, volatile LAS unsigned* st) {
    XcdBarrier b; b.bar = bar; b.x = xb_xcc_id(); b.st = st;
    if (threadIdx.x == 0) (void)xb_add(&bar[XB_XCNT(b.x)], 1u);
    return b;
}
__device__ __forceinline__ void xcd_barrier_complete(unsigned* bar, unsigned x, unsigned& nloc, unsigned& nx) {
    const unsigned G = gridDim.x * gridDim.y * gridDim.z;
    unsigned sum, cnt, mine, sp = 0u;
    for (;;) {
        sum = 0u; cnt = 0u; mine = 0u;
#pragma unroll
        for (unsigned j = 0; j < 16; ++j) { const unsigned c = xb_ld(&bar[XB_XCNT(j)]); sum += c; cnt += (c > 0u) ? 1u : 0u; mine = (j == x) ? c : mine; }
        if (sum == G) break;
        __builtin_amdgcn_s_sleep(1);
        if ((++sp & 255u) == 0u) { if (xb_ld(&bar[XB_TMO])) break; if (sp > XB_SPIN_CAP) { atomicAdd(&bar[XB_TMO], 1u); break; } }
    }
    nloc = mine > 0u ? mine : 1u; nx = cnt > 0u ? cnt : 1u;
}

__device__ __forceinline__ void xcd_barrier(const XcdBarrier& b) {
    asm volatile("s_waitcnt vmcnt(0)" ::: "memory");
    __syncthreads();
    if (threadIdx.x == 0) {
        unsigned* bar = b.bar;
        __builtin_amdgcn_s_waitcnt(0);
        unsigned nloc = b.st[0], nx = b.st[1];
        if (nloc == 0u) { xcd_barrier_complete(bar, b.x, nloc, nx); b.st[0] = nloc; b.st[1] = nx; }
        const unsigned old = xb_add(&bar[XB_XSUB(b.x)], 1u);
        const unsigned gen = old / nloc;
        if (old + 1u == (gen + 1u) * nloc) {
            __builtin_amdgcn_fence(__ATOMIC_RELEASE, "agent");
            asm volatile("s_waitcnt vmcnt(0)" ::: "memory");
            const unsigned og = xb_add(&bar[XB_TOP], 1u);
            const unsigned tg = og / nx;
            if (og + 1u == (tg + 1u) * nx) xb_add(&bar[XB_TOPGEN], 1u);
            else XB_SPIN(xb_ld(&bar[XB_TOPGEN]) == tg, bar);
            __builtin_amdgcn_fence(__ATOMIC_ACQUIRE, "agent");
            xb_add(&bar[XB_XGEN(b.x)], 1u);
            asm volatile("s_waitcnt vmcnt(0)" ::: "memory");
        } else {
            XB_SPIN(xb_ld(&bar[XB_XGEN(b.x)]) == gen, bar);
            __builtin_amdgcn_fence(__ATOMIC_ACQUIRE, "agent");
            asm volatile("s_waitcnt vmcnt(0)" ::: "memory");
        }
    }
    __syncthreads();
}

typedef float f32x2 __attribute__((ext_vector_type(2)));
struct Args { const float* in[32]; float* out; unsigned char* ws; int ph_lo, ph_hi, use_bar, pad; };
struct Frame {
    LAS unsigned char* lds;
    volatile LAS unsigned* MISC;
    gu32* ctl;
    int tid, lane, wave;
    int vcu, G;
    float* out;
    unsigned char* ws;
};
enum { I_X = 0, I_MEM, I_POS, I_NORM_MIX, I_W_IN, I_B_GATE, I_AQ_GAIN, I_AK_GAIN, I_R_MU, I_R_W0, I_R_W2, I_R_A0, I_R_A2, I_R_G2, I_R_KK, I_R_KA, I_R_RK, I_R_LNW, I_R_LNB,
       I_MEM_NORM, I_W_MEMKV, I_CQ_GAIN, I_CK_GAIN, I_W_BRANCH, I_W_OUT, I_NORM_FFN, I_ROUTER_W, I_ROUTER_B, I_EXP_W1, I_EXP_B1, I_EXP_W2, I_EXP_B2 };

__device__ __forceinline__ bool phase_enter(Frame& F, bool on) { int t = (int)threadIdx.x; asm volatile("" : "+v"(t)); F.tid = t; F.lane = t & 63; F.wave = __builtin_amdgcn_readfirstlane(t >> 6); return on; }
__device__ __forceinline__ const float* ldarg(int i) {
    const __attribute__((address_space(4))) char* ka = (const __attribute__((address_space(4))) char*)__builtin_amdgcn_kernarg_segment_ptr();
    asm volatile("" : "+s"(ka));
    return *(const float* const __attribute__((address_space(4)))*)(ka + 8 * i);
}
__device__ __forceinline__ int opq(int x) { asm volatile("" : "+v"(x)); return x; }
__device__ __forceinline__ float bf_lo(unsigned w) { return __builtin_bit_cast(float, w << 16); }
__device__ __forceinline__ float bf_hi(unsigned w) { return __builtin_bit_cast(float, w & 0xffff0000u); }
__device__ __forceinline__ float sigm(float x) { return 1.0f / (1.0f + __expf(-x)); }
template <int CTRL, int RM> __device__ __forceinline__ float dpp0(float v) {
    return __builtin_bit_cast(float, __builtin_amdgcn_update_dpp(0, __builtin_bit_cast(int, v), CTRL, RM, 0xf, true)); }
__device__ __forceinline__ float row16_sum(float v) {
    v += dpp0<0xB1, 0xf>(v); v += dpp0<0x4E, 0xf>(v); v += dpp0<0x141, 0xf>(v); v += dpp0<0x140, 0xf>(v); return v; }
__device__ __forceinline__ float rdlane(float v, int l) { return __builtin_bit_cast(float, __builtin_amdgcn_readlane(__builtin_bit_cast(int, v), l)); }
__device__ __forceinline__ float wave_sum(float v) {
    v = row16_sum(v); v += dpp0<0x142, 0xA>(v); v += dpp0<0x143, 0xC>(v); return rdlane(v, 63); }
__device__ __forceinline__ void half_sums(float v, float& lo, float& hi) {
    v = row16_sum(v); v += dpp0<0x142, 0xA>(v); lo = rdlane(v, 31); hi = rdlane(v, 63); }
__device__ __forceinline__ float wave_max_bp(float v) {
#pragma unroll
    for (int o = 1; o < 64; o <<= 1) v = fmaxf(v, __shfl_xor(v, o));
    return v; }

__device__ __forceinline__ void tconv_tile(const float* W, int K, int N, bf16* WT, int k0, int n0, int rowbase, int lane, int kd = 0) {
    const int c = lane & 15, q = lane >> 4;
    const GAS f32x4* src = (const GAS f32x4*)(W + (size_t)(k0 + 16 * q) * N + n0 + 4 * c);
    const size_t rs = (size_t)N / 4;
    f32x4 v[16];
#pragma unroll
    for (int i = 0; i < 16; ++i) v[i] = src[i * rs];
#pragma unroll
    for (int j = 0; j < 4; ++j) {
        GAS v4u* dst = (GAS v4u*)(WT + (size_t)(rowbase + 4 * c + j) * K + kd + k0 + 16 * q);
        v4u o0, o1;
        o0.x = pk2(v[0][j], v[1][j]); o0.y = pk2(v[2][j], v[3][j]); o0.z = pk2(v[4][j], v[5][j]); o0.w = pk2(v[6][j], v[7][j]);
        o1.x = pk2(v[8][j], v[9][j]); o1.y = pk2(v[10][j], v[11][j]); o1.z = pk2(v[12][j], v[13][j]); o1.w = pk2(v[14][j], v[15][j]);
        dst[0] = o0; dst[1] = o1;
    }
}
__device__ __forceinline__ void rms_row_to_bf16(const float* xrow, const float* gain, bf16* orow, int lane) {
    const GAS f32x4* xr = (const GAS f32x4*)xrow + lane; const GAS f32x4* gr = (const GAS f32x4*)gain + lane;
    f32x4 v[4]; float s = 0.f;
#pragma unroll
    for (int j = 0; j < 4; ++j) { v[j] = xr[64 * j]; s += (v[j].x * v[j].x + v[j].y * v[j].y) + (v[j].z * v[j].z + v[j].w * v[j].w); }
    const float rstd = 1.0f / sqrtf(wave_sum(s) * (1.f / D_MODEL) + NORM_EPS);
    GAS unsigned long long* o8 = (GAS unsigned long long*)orow + lane;
#pragma unroll
    for (int j = 0; j < 4; ++j) { const f32x4 g = gr[64 * j];
        o8[64 * j] = (unsigned long long)pk2(v[j].x * rstd * g.x, v[j].y * rstd * g.y) | ((unsigned long long)pk2(v[j].z * rstd * g.z, v[j].w * rstd * g.w) << 32); }
}
template <int PART> __device__ __forceinline__ void p0_prologue(Frame& F, const Args& args, int gw, int NGW) {
    const int lane = F.lane;
    unsigned char* ws = F.ws;
    constexpr int T_IN = 16 * 156, T_WB = 3 * 128, T_WO = 256, T_WM = 256, T_W1 = 32 * 512, T_W2 = 32 * 256, T_LO = 32;
    constexpr int NT = T_IN + T_WB + T_WO + T_WM + T_W1 + T_W2;
    constexpr int IT0 = (PART == 0) ? 0 : T_IN + T_WB + T_WO + T_WM, IT1 = (PART == 0) ? T_IN + T_WB + T_WO + T_WM : NT;
    for (int it = IT0 + gw; it < IT1; it += NGW) {
        int r = it;
        if (r < T_IN) { const int kb = r / 156, nb = r % 156; tconv_tile(ldarg(I_W_IN), 1024, IN_COLS, (bf16*)(ws + WS_WIN), 64 * kb, 64 * nb, 64 * nb, lane); continue; } r -= T_IN;
        if (r < T_WB) { const int b = r / 128, q = r % 128, kb = q / 16, nb = q % 16;
            tconv_tile(ldarg(I_W_BRANCH) + (size_t)b * 512 * 1024, 1536, 1024, (bf16*)(ws + WS_WB), 64 * kb, 64 * nb, 64 * nb, lane, 512 * b); continue; } r -= T_WB;
        if (r < T_WO) { const int kb = r / 16, nb = r % 16; tconv_tile(ldarg(I_W_OUT), 1024, 1024, (bf16*)(ws + WS_WO), 64 * kb, 64 * nb, 64 * nb, lane); continue; } r -= T_WO;
        if (r < T_WM) { const int kb = r / 16, nb = r % 16; tconv_tile(ldarg(I_W_MEMKV), 1024, 1024, (bf16*)(ws + WS_WMEM), 64 * kb, 64 * nb, 64 * nb, lane); continue; } r -= T_WM;
        if (r < T_W1) { const int e = r / 512, q = r % 512, kb = q / 32, nb = q % 32, n0 = 64 * nb;
            const int rowbase = (n0 < 1024) ? ((n0 >> 7) * 256 + (n0 & 127)) : ((((n0 - 1024) >> 7) * 256) + 128 + ((n0 - 1024) & 127));
            tconv_tile(ldarg(I_EXP_W1) + (size_t)e * 1024 * 2048, 1024, 2048, (bf16*)(ws + WS_W1) + (size_t)e * 2048 * 1024, 64 * kb, n0, rowbase, lane); continue; } r -= T_W1;
        { const int e = r / 256, q = r % 256, kb = q / 16, nb = q % 16;
            tconv_tile(ldarg(I_EXP_W2) + (size_t)e * 1024 * 1024, 1024, 1024, (bf16*)(ws + WS_W2) + (size_t)e * 1024 * 1024, 64 * kb, 64 * nb, 64 * nb, lane); }
    }
    if (PART == 0) {
    for (int it = gw; it < T_LO; it += NGW) {
        bf16* L = (bf16*)(ws + WS_LORA);
        if (it < 8) tconv_tile(ldarg(I_R_W2), 64, 512, L, 0, 64 * it, 64 * it, lane);
        else if (it < 16) tconv_tile(ldarg(I_R_A2), 64, 512, L + 512 * 64, 0, 64 * (it - 8), 64 * (it - 8), lane);
        else { const int q = it - 16; tconv_tile(ldarg(I_R_G2), 128, 512, L + 2 * 512 * 64, 64 * (q >> 3), 64 * (q & 7), 64 * (q & 7), lane); } }
    { const int* posp = (const int*)ldarg(I_POS); float* cs = (float*)(ws + WS_CS);
      for (int idx = gw * 64 + lane; idx < MTOK * 16; idx += NGW * 64) { const int m = idx >> 4, i = idx & 15; const float ang = (float)posp[m] * exp2f(-(float)i * (18.931568569324174f / 16.0f)); const float sn = sinf(ang), cn = cosf(ang);
          f32x2 o; o.x = cn; o.y = sn; *(GAS f32x2*)(cs + (size_t)idx * 2) = o; } }
    for (int m = gw; m < MTOK; m += NGW) rms_row_to_bf16(ldarg(I_X) + (size_t)m * D_MODEL, ldarg(I_NORM_MIX), (bf16*)(ws + WS_XN) + (size_t)m * D_MODEL, lane);
    for (int m = gw; m < MEMROWS; m += NGW) rms_row_to_bf16(ldarg(I_MEM) + (size_t)m * D_MODEL, ldarg(I_MEM_NORM), (bf16*)(ws + WS_MEMN) + (size_t)m * D_MODEL, lane);
    }
}

__device__ __forceinline__ void head_norm(bf16* p, const float* gain, bool rot, float c0, float s0, float c1, float s1, float scale, int lane) {
    GAS unsigned* pw = (GAS unsigned*)p + lane;
    const unsigned w = *pw; float a = bf_lo(w), b = bf_hi(w);
    const float ss = wave_sum(a * a + b * b);
    const float rstd = 1.0f / sqrtf(ss * (1.f / 128.f) + NORM_EPS);
    const f32x2 g = *((const GAS f32x2*)gain + lane);
    a = a * rstd * g.x; b = b * rstd * g.y;
    const float pa = __shfl_xor(a, 8), pb = __shfl_xor(b, 8);
    if (rot && lane < 16) {
        if (lane < 8) { a = a * c0 - pa * s0; b = b * c1 - pb * s1; }
        else          { a = a * c0 + pa * s0; b = b * c1 + pb * s1; }
    }
    *pw = pk2(a * scale, b * scale);
}
__device__ __forceinline__ void p2_prep(Frame& F, const Args& args) {
    const int gw = F.vcu * NWAVES + F.wave, NGW = F.G * NWAVES, lane = F.lane;
    unsigned char* ws = F.ws;
    bf16* Z = (bf16*)(ws + WS_Z);
    LAS float* lo = (LAS float*)(F.lds + RING_OFF + F.wave * 8192);
    const float* mu = ldarg(I_R_MU); const float* aqg = ldarg(I_AQ_GAIN); const float* akg = ldarg(I_AK_GAIN); const float* cqg = ldarg(I_CQ_GAIN); const int* posp = (const int*)ldarg(I_POS);
    float* Rr = (float*)(ws + WS_RW); float* Rw = Rr + (size_t)MTOK * RW; float* Rk = Rw + (size_t)MTOK * RW; float* Rv = Rk + (size_t)MTOK * RW;
    float* Ra = Rv + (size_t)MTOK * RW; float* Rb = Ra + (size_t)MTOK * RW; float* Rg = Rb + (size_t)MTOK * RW;
    for (int m = gw; m < MEMROWS; m += NGW)
        for (int hd = 0; hd < 4; ++hd) head_norm((bf16*)(ws + WS_KVM) + (size_t)m * 1024 + hd * 128, ldarg(I_CK_GAIN), false, 1.f, 0.f, 1.f, 0.f, 1.0f, lane);
}

__device__ __forceinline__ void lora_stage(const float* W, LAS unsigned* wl, int tid) {
#pragma unroll
    for (int i = 0; i < 16; ++i) { const int idx = tid + 512 * i; const f32x4 v = *((const GAS f32x4*)W + idx);
        *(LAS unsigned long long*)(wl + 2 * idx) = (unsigned long long)pk2(v.x, v.y) | ((unsigned long long)pk2(v.z, v.w) << 32); }
}
__device__ __forceinline__ void lora_mac(const LAS unsigned* wl, const LAS float* lo, float (&acc)[4][8], int lane) {
#pragma unroll 4
    for (int j = 0; j < 64; ++j) { const f32x4 xin = *(const LAS f32x4*)(lo + j * 4);
#pragma unroll
        for (int i = 0; i < 4; ++i) { const unsigned w = wl[j * 256 + lane + 64 * i]; const float w0 = bf_lo(w), w1 = bf_hi(w);
#pragma unroll
            for (int tt = 0; tt < 4; ++tt) { acc[tt][2 * i] += xin[tt] * w0; acc[tt][2 * i + 1] += xin[tt] * w1; } } }
}
template <int NL> __device__ __forceinline__ void lora_in(const bf16* Z, const float* mu, int ch, int m0, LAS float* lo, int lane) {
    const int col = OFF_R + 1536 + ch; const float muj = mu[1536 + ch];
    float prv = ((m0 % SEQ) == 0) ? 0.f : __builtin_bit_cast(float, (unsigned)Z[(size_t)(m0 - 1) * IN_COLS + col] << 16);
#pragma unroll
    for (int tt = 0; tt < 4; ++tt) { const float cur = __builtin_bit_cast(float, (unsigned)Z[(size_t)(m0 + tt) * IN_COLS + col] << 16);
        float x = cur + (prv - cur) * muj; prv = cur;
        x = (NL == 0) ? tanhf(x) : (NL == 1) ? x : sigm(x);
        lo[lane * 4 + tt] = x; }
    LDS_WAIT(); asm volatile("" ::: "memory");
}
__device__ __forceinline__ void p2_rwkv(Frame& F, const Args& args) {
    const int lane = F.lane, wave = F.wave;
    unsigned char* ws = F.ws;
    const bf16* Z = (const bf16*)(ws + WS_Z);
    LAS unsigned* wl = (LAS unsigned*)(F.lds + RING_OFF);
    LAS float* lo = (LAS float*)(F.lds + RING_OFF + 65536 + wave * 1024);
    const float* mu = ldarg(I_R_MU);
    float* Rr = (float*)(ws + WS_RW); float* Rw = Rr + (size_t)MTOK * RW; float* Rk = Rw + (size_t)MTOK * RW; float* Rv = Rk + (size_t)MTOK * RW;
    float* Ra = Rv + (size_t)MTOK * RW; float* Rb = Ra + (size_t)MTOK * RW; float* Rg = Rb + (size_t)MTOK * RW;
    for (int grp = F.vcu; grp < MTOK / 64; grp += F.G) {
        const int mw = grp * 64 + wave * 8;
        lora_stage(ldarg(I_R_W2), wl, F.tid);
        __syncthreads();
        for (int tk = 0; tk < 2; ++tk) { const int m0 = mw + 4 * tk;
            lora_in<0>(Z, mu, lane, m0, lo, lane);
            float acc[4][8];
#pragma unroll
            for (int tt = 0; tt < 4; ++tt)
#pragma unroll
                for (int c = 0; c < 8; ++c) acc[tt][c] = 0.f;
            lora_mac(wl, lo, acc, lane);
            const float* w0p = ldarg(I_R_W0);
#pragma unroll
            for (int i = 0; i < 4; ++i) { const int c = 2 * lane + 128 * i; const f32x2 w0 = *(const GAS f32x2*)(w0p + c);
#pragma unroll
                for (int tt = 0; tt < 4; ++tt) { const float y0 = -(w0.x + acc[tt][2 * i]), y1 = -(w0.y + acc[tt][2 * i + 1]);
                    const float sp0 = fmaxf(y0, 0.f) + log1pf(__expf(-fabsf(y0))), sp1 = fmaxf(y1, 0.f) + log1pf(__expf(-fabsf(y1)));
                    f32x2 wd; wd.x = -__expf(-sp0 - 0.5f); wd.y = -__expf(-sp1 - 0.5f);
                    *(GAS f32x2*)(Rw + (size_t)(m0 + tt) * RW + c) = wd; } }
            LDS_WAIT(); asm volatile("" ::: "memory"); }
        __syncthreads();
        lora_stage(ldarg(I_R_A2), wl, F.tid);
        __syncthreads();
        for (int tk = 0; tk < 2; ++tk) { const int m0 = mw + 4 * tk; const int tpos0 = m0 % SEQ;
            lora_in<1>(Z, mu, 64 + lane, m0, lo, lane);
            float acca[4][8];
#pragma unroll
            for (int tt = 0; tt < 4; ++tt)
#pragma unroll
                for (int c = 0; c < 8; ++c) acca[tt][c] = 0.f;
            lora_mac(wl, lo, acca, lane);
            const float* a0p = ldarg(I_R_A0); const float* kkp = ldarg(I_R_KK); const float* kap = ldarg(I_R_KA);
#pragma unroll
            for (int i = 0; i < 4; ++i) {
                const int c = 2 * lane + 128 * i;
                const f32x2 a0 = *(const GAS f32x2*)(a0p + c), kkc = *(const GAS f32x2*)(kkp + c), kac = *(const GAS f32x2*)(kap + c);
                const f32x2 mur = *(const GAS f32x2*)(mu + c), muk = *(const GAS f32x2*)(mu + 512 + c), muv = *(const GAS f32x2*)(mu + 1024 + c);
                unsigned pr = 0u, pk = 0u, pv = 0u;
                if (tpos0 != 0) { const bf16* zp = Z + (size_t)(m0 - 1) * IN_COLS + OFF_R + c; pr = *(const GAS unsigned*)zp; pk = *(const GAS unsigned*)(zp + 512); pv = *(const GAS unsigned*)(zp + 1024); }
#pragma unroll
                for (int tt = 0; tt < 4; ++tt) {
                    const size_t m = (size_t)(m0 + tt);
                    const bf16* zc = Z + m * IN_COLS + OFF_R + c;
                    const unsigned cr = *(const GAS unsigned*)zc, ck = *(const GAS unsigned*)(zc + 512), cv = *(const GAS unsigned*)(zc + 1024);
                    f32x2 r, k, v;
                    r.x = bf_lo(cr) + (bf_lo(pr) - bf_lo(cr)) * mur.x; r.y = bf_hi(cr) + (bf_hi(pr) - bf_hi(cr)) * mur.y;
                    k.x = bf_lo(ck) + (bf_lo(pk) - bf_lo(ck)) * muk.x; k.y = bf_hi(ck) + (bf_hi(pk) - bf_hi(ck)) * muk.y;
                    v.x = bf_lo(cv) + (bf_lo(pv) - bf_lo(cv)) * muv.x; v.y = bf_hi(cv) + (bf_hi(pv) - bf_hi(cv)) * muv.y;
                    pr = cr; pk = ck; pv = cv;
                    f32x2 av; av.x = sigm(a0.x + acca[tt][2 * i]); av.y = sigm(a0.y + acca[tt][2 * i + 1]);
                    f32x2 kk; kk.x = k.x * kkc.x; kk.y = k.y * kkc.y;
                    float slo, shi; half_sums(kk.x * kk.x + kk.y * kk.y, slo, shi);
                    const float nrm = fmaxf(sqrtf(lane < 32 ? slo : shi), 1e-12f), inv = 1.0f / nrm;
                    kk.x *= inv; kk.y *= inv;
                    f32x2 k2; k2.x = k.x * (1.0f + (av.x - 1.0f) * kac.x); k2.y = k.y * (1.0f + (av.y - 1.0f) * kac.y);
                    f32x2 as, bs; as.x = -kk.x; as.y = -kk.y; bs.x = kk.x * av.x; bs.y = kk.y * av.y;
                    const size_t o = m * RW + c;
                    *(GAS f32x2*)(Rr + o) = r; *(GAS f32x2*)(Rk + o) = k2; *(GAS f32x2*)(Rv + o) = v; *(GAS f32x2*)(Ra + o) = as; *(GAS f32x2*)(Rb + o) = bs;
                }
            }
            LDS_WAIT(); asm volatile("" ::: "memory"); }
        __syncthreads();
        float accg[2][4][8];
#pragma unroll
        for (int tk = 0; tk < 2; ++tk)
#pragma unroll
            for (int tt = 0; tt < 4; ++tt)
#pragma unroll
                for (int c = 0; c < 8; ++c) accg[tk][tt][c] = 0.f;
#pragma unroll
        for (int hh = 0; hh < 2; ++hh) {
            lora_stage(ldarg(I_R_G2) + (size_t)hh * 64 * RW, wl, F.tid);
            __syncthreads();
#pragma unroll
            for (int tk = 0; tk < 2; ++tk) { lora_in<2>(Z, mu, 128 + 64 * hh + lane, mw + 4 * tk, lo, lane); lora_mac(wl, lo, accg[tk], lane); LDS_WAIT(); asm volatile("" ::: "memory"); }
            __syncthreads();
        }
#pragma unroll
        for (int tk = 0; tk < 2; ++tk)
#pragma unroll
            for (int i = 0; i < 4; ++i)
#pragma unroll
                for (int tt = 0; tt < 4; ++tt) { f32x2 gg; gg.x = accg[tk][tt][2 * i]; gg.y = accg[tk][tt][2 * i + 1]; *(GAS f32x2*)(Rg + (size_t)(mw + 4 * tk + tt) * RW + 2 * lane + 128 * i) = gg; }
    }
}

__device__ __forceinline__ float qk_dot(const LAS float* q, const bf16* krow) {
    const GAS v4u* kp = (const GAS v4u*)krow; float s0 = 0.f, s1 = 0.f;
#pragma unroll
    for (int i = 0; i < 16; ++i) { const v4u w = kp[i]; const f32x4 qa = *(const LAS f32x4*)(q + 8 * i), qb = *(const LAS f32x4*)(q + 8 * i + 4);
        s0 += bf_lo(w.x) * qa[0] + bf_hi(w.x) * qa[1] + bf_lo(w.y) * qa[2] + bf_hi(w.y) * qa[3];
        s1 += bf_lo(w.z) * qb[0] + bf_hi(w.z) * qb[1] + bf_lo(w.w) * qb[2] + bf_hi(w.w) * qb[3]; }
    return s0 + s1;
}
__device__ __forceinline__ void p3_attention(Frame& F) {
    const int gw = F.vcu * NWAVES + F.wave, NGW = F.G * NWAVES, lane = F.lane;
    unsigned char* ws = F.ws;
    const bf16* Z = (const bf16*)(ws + WS_Z);
    const bf16* KV = (const bf16*)(ws + WS_KVM);
    bf16* YA = (bf16*)(ws + WS_YABC); bf16* YC = YA + (size_t)2 * MTOK * 512;
    LAS float* qs = (LAS float*)(F.lds + RING_OFF + F.wave * 8192);
    for (int task = gw; task < MTOK * 4; task += NGW) {
        const int m = task >> 2, h = task & 3, t = m % SEQ;
        const bf16* zrow = Z + (size_t)m * IN_COLS;
#pragma unroll
        for (int g = 0; g < 3; ++g) { const unsigned w = *((const GAS unsigned*)(zrow + OFF_AQ + g * 512 + h * 128) + lane); qs[g * 128 + 2 * lane] = bf_lo(w); qs[g * 128 + 2 * lane + 1] = bf_hi(w); }
        LDS_WAIT(); asm volatile("" ::: "memory");
        float sc[3][3]; float mx = -INFINITY;
#pragma unroll
        for (int g = 0; g < 3; ++g) { const int dl = (g == 0) ? 1 : (g == 1) ? 4 : 16;
#pragma unroll
            for (int p = 0; p < 3; ++p) { const int j = lane + 64 * p; const int tk = t - dl * j; float s = -INFINITY;
                if (j <= 128 && tk >= 0) s = qk_dot(qs + g * 128, zrow - (size_t)dl * j * IN_COLS + OFF_AK + g * 512 + h * 128);
                sc[g][p] = s; mx = fmaxf(mx, s); } }
        mx = wave_max_bp(mx);
        float den = 0.f;
#pragma unroll
        for (int g = 0; g < 3; ++g)
#pragma unroll
            for (int p = 0; p < 3; ++p) { sc[g][p] = exp2f(sc[g][p] - mx); den += sc[g][p]; }
        den = wave_sum(den);
        float o0 = 0.f, o1 = 0.f;
#pragma unroll
        for (int g = 0; g < 3; ++g) { const int dl = (g == 0) ? 1 : (g == 1) ? 4 : 16; const bf16* vb = zrow + OFF_AV + g * 512 + h * 128 + 2 * lane;
#pragma unroll
            for (int p = 0; p < 3; ++p) { const int nj = (p < 2) ? 64 : 1;
                for (int jj = 0; jj < nj; ++jj) { const int j = jj + 64 * p; const float pj = rdlane(sc[g][p], jj);
                    if (t - dl * j >= 0) { const unsigned w = *(const GAS unsigned*)(vb - (size_t)dl * j * IN_COLS); o0 += pj * bf_lo(w); o1 += pj * bf_hi(w); } } } }
        const float inv = 1.0f / den;
        *((GAS unsigned*)(YA + (size_t)m * 512 + h * 128) + lane) = pk2(o0 * inv, o1 * inv);
        asm volatile("" ::: "memory");
    }
    for (int task = gw; task < MTOK * 4; task += NGW) {
        const int m = task >> 2, h = task & 3, b = m / SEQ;
        const bf16* zrow = Z + (size_t)m * IN_COLS;
        { const unsigned w = *((const GAS unsigned*)(zrow + OFF_CQ + h * 128) + lane); qs[2 * lane] = bf_lo(w); qs[2 * lane + 1] = bf_hi(w); }
        LDS_WAIT(); asm volatile("" ::: "memory");
        const bf16* kb = KV + (size_t)b * MEM_LEN * 1024 + h * 128;
        float sc[4]; float mx = -INFINITY;
#pragma unroll
        for (int p = 0; p < 4; ++p) { sc[p] = qk_dot(qs, kb + (size_t)(lane + 64 * p) * 1024); mx = fmaxf(mx, sc[p]); }
        mx = wave_max_bp(mx);
        float den = 0.f;
#pragma unroll
        for (int p = 0; p < 4; ++p) { sc[p] = exp2f(sc[p] - mx); den += sc[p]; }
        den = wave_sum(den);
        float o0 = 0.f, o1 = 0.f; const bf16* vb = kb + 512 + 2 * lane;
#pragma unroll
        for (int p = 0; p < 4; ++p)
            for (int jj = 0; jj < 64; ++jj) { const float pj = rdlane(sc[p], jj); const unsigned w = *(const GAS unsigned*)(vb + (size_t)(jj + 64 * p) * 1024); o0 += pj * bf_lo(w); o1 += pj * bf_hi(w); }
        const float inv = 1.0f / den;
        *((GAS unsigned*)(YC + (size_t)m * 512 + h * 128) + lane) = pk2(o0 * inv, o1 * inv);
        asm volatile("" ::: "memory");
    }
}

__device__ __forceinline__ void p5_post(Frame& F, const Args& args) {
    const int gw = F.vcu * NWAVES + F.wave, NGW = F.G * NWAVES, lane = F.lane;
    unsigned char* ws = F.ws;
    const float* Rr = (const float*)(ws + WS_RW); const float* Rk = Rr + (size_t)2 * MTOK * RW; const float* Rv = Rk + (size_t)MTOK * RW; const float* Rg = Rr + (size_t)6 * MTOK * RW;
    const float* YS = (const float*)(ws + WS_YS);
    bf16* YB = (bf16*)(ws + WS_YABC) + (size_t)MTOK * 512;
    const bf16* OP = (const bf16*)(ws + WS_OP); const float* LS = (const float*)(ws + WS_LSE); bf16* YA = (bf16*)(ws + WS_YABC);
    for (int m = gw; m < MTOK; m += NGW) {
#pragma unroll
        for (int h = 0; h < 4; ++h) {
            const float l0 = LS[(size_t)m * 4 + h], l1 = LS[(size_t)MTOK * 4 + (size_t)m * 4 + h], l2 = LS[(size_t)2 * MTOK * 4 + (size_t)m * 4 + h];
            const float mx = fmaxf(l0, fmaxf(l1, l2)); const float w0 = exp2f(l0 - mx), w1 = exp2f(l1 - mx), w2 = exp2f(l2 - mx); const float inv = 1.0f / (w0 + w1 + w2);
            const size_t o = (size_t)m * 512 + h * 128;
            const unsigned a = *((const GAS unsigned*)(OP + o) + lane), b = *((const GAS unsigned*)(OP + (size_t)MTOK * 512 + o) + lane), c = *((const GAS unsigned*)(OP + (size_t)2 * MTOK * 512 + o) + lane);
            *((GAS unsigned*)(YA + (size_t)m * 1536 + h * 128) + lane) = pk2((w0 * bf_lo(a) + w1 * bf_lo(b) + w2 * bf_lo(c)) * inv, (w0 * bf_hi(a) + w1 * bf_hi(b) + w2 * bf_hi(c)) * inv); }
    }
}

__device__ __forceinline__ void p8_router(Frame& F, const Args& args) {
    const int lane = F.lane, wave = F.wave;
    unsigned char* ws = F.ws;
    const float* X1 = F.out;
    LAS int* hist = (LAS int*)(F.lds + HIST_OFF);
    { const int t_ = opq(F.tid); if (t_ < 32) hist[t_] = 0; }
    int* topi = (int*)(ws + WS_ROUTE + RT_TOPI); float* topg = (float*)(ws + WS_ROUTE + RT_TOPG);
    const float* RWt = ldarg(I_ROUTER_W); const float* RB = ldarg(I_ROUTER_B); const float* gain = ldarg(I_NORM_FFN);
    LAS float* rw = (LAS float*)(F.lds + RING_OFF);
    typedef float f32x16r __attribute__((ext_vector_type(16)));
    for (int grp = F.vcu; grp < MTOK / 64; grp += F.G) {
#pragma unroll
        for (int i = 0; i < 16; ++i) { const int f = F.tid + 512 * i, k = f >> 3; const f32x4 w = *((const GAS f32x4*)RWt + f); const float g = gain[k]; ((LAS f32x4*)rw)[f] = w * g; }
        __syncthreads();
        const int tile = wave >> 2, wq = wave & 3, i32 = lane & 31, h = lane >> 5;
        const GAS f32x4* xp = (const GAS f32x4*)(X1 + ((size_t)grp * 64 + tile * 32 + i32) * D_MODEL + wq * 256 + 4 * h);
        const LAS float* bp = rw + (wq * 256 + 4 * h) * 32 + i32;
        f32x16r acc;
#pragma unroll
        for (int r = 0; r < 16; ++r) acc[r] = 0.f;
        float ss = 0.f;
#pragma unroll 4
        for (int q = 0; q < 32; ++q) { const f32x4 xv = xp[2 * q]; ss += (xv.x * xv.x + xv.y * xv.y) + (xv.z * xv.z + xv.w * xv.w);
#pragma unroll
            for (int j = 0; j < 4; ++j) acc = __builtin_amdgcn_mfma_f32_32x32x2f32(xv[j], bp[(8 * q + j) * 32], acc, 0, 0, 0); }
        __syncthreads();
        { LAS float* part = rw + (tile * 4 + wq) * 1024;
#pragma unroll
          for (int r = 0; r < 16; ++r) part[((r & 3) + 8 * (r >> 2) + 4 * h) * 32 + i32] = acc[r];
          rw[8192 + (tile * 4 + wq) * 64 + lane] = ss; }
        __syncthreads();
        if (F.tid < 64) { const int t = F.tid, tl = t >> 5, row = t & 31; const size_t m = (size_t)grp * 64 + t;
            float s = 0.f;
#pragma unroll
            for (int q = 0; q < 4; ++q) s += rw[8192 + (tl * 4 + q) * 64 + row] + rw[8192 + (tl * 4 + q) * 64 + 32 + row];
            const float rstd = 1.0f / sqrtf(s * (1.f / D_MODEL) + NORM_EPS);
            float lg[32];
#pragma unroll
            for (int e = 0; e < 32; ++e) { const LAS float* pp = rw + (tl * 4) * 1024 + row * 32 + e; lg[e] = ((pp[0] + pp[1024]) + (pp[2048] + pp[3072])) * rstd + RB[e]; }
            int ti[4]; float tv[4];
#pragma unroll
            for (int k = 0; k < 4; ++k) { float best = -INFINITY; int bi = 0;
#pragma unroll
                for (int e = 0; e < 32; ++e) { const bool taken = (k > 0 && ti[0] == e) || (k > 1 && ti[1] == e) || (k > 2 && ti[2] == e); if (!taken && lg[e] > best) { best = lg[e]; bi = e; } }
                ti[k] = bi; tv[k] = best; }
            const float e1 = __expf(tv[1] - tv[0]), e2 = __expf(tv[2] - tv[0]), e3 = __expf(tv[3] - tv[0]); const float inv = 1.0f / (1.0f + e1 + e2 + e3);
            { typedef int i32x4 __attribute__((ext_vector_type(4))); *(GAS i32x4*)(topi + m * 4) = (i32x4){ti[0], ti[1], ti[2], ti[3]}; } *(GAS f32x4*)(topg + m * 4) = (f32x4){inv, e1 * inv, e2 * inv, e3 * inv};
#pragma unroll
            for (int k = 0; k < 4; ++k) __hip_atomic_fetch_add(hist + ti[k], 1, __ATOMIC_RELAXED, __HIP_MEMORY_SCOPE_WORKGROUP); }
        __syncthreads();
    }
    { const int t_ = opq(F.tid); if (t_ < 32 && hist[t_] != 0) __hip_atomic_fetch_add((unsigned*)(F.ctl + CW_CNT) + 64 * t_, (unsigned)hist[t_], __ATOMIC_RELAXED, __HIP_MEMORY_SCOPE_AGENT); }
}
__device__ __forceinline__ void moe_table(Frame& F) {
    LAS int* tab = (LAS int*)(F.lds + MOETAB_OFF);
    __syncthreads();
    if (F.tid == 0) { int acc = 0;
        for (int e = 0; e < N_EXPERTS; ++e) { const int c = (int)__hip_atomic_load((unsigned*)(F.ctl + CW_CNT) + 64 * e, __ATOMIC_RELAXED, __HIP_MEMORY_SCOPE_AGENT); const int nb = (c + MOE_ROWS - 1) / MOE_ROWS;
            tab[320 + e] = acc * MOE_ROWS; for (int q = 0; q < nb; ++q) tab[1 + acc + q] = e; acc += nb; }
        tab[0] = acc; }
    __syncthreads();
}
__device__ __forceinline__ void p9_dispatch(Frame& F, const Args& args) {
    const int lane = F.lane;
    unsigned char* ws = F.ws;
    moe_table(F);
    const LAS int* tab = (const LAS int*)(F.lds + MOETAB_OFF);
    LAS int* hist = (LAS int*)(F.lds + HIST_OFF); LAS int* base = hist + 32; LAS int* slots = hist + 64;
    const int* topi = (const int*)(ws + WS_ROUTE + RT_TOPI); const float* topg = (const float*)(ws + WS_ROUTE + RT_TOPG);
    int* pos = (int*)(ws + WS_ROUTE + RT_POS); float* rowgate = (float*)(ws + WS_ROUTE + RT_ROWGATE);
    bf16* XS = (bf16*)(ws + WS_XS); const float* gain = ldarg(I_NORM_FFN);
    for (int grp = F.vcu; grp < MTOK / 64; grp += F.G) {
        const int t_ = opq(F.tid);
        if (t_ < 32) hist[t_] = 0;
        __syncthreads();
        int e = 0, rank = 0;
        if (F.tid < 256) { e = topi[(size_t)grp * 256 + F.tid]; rank = __hip_atomic_fetch_add(hist + e, 1, __ATOMIC_RELAXED, __HIP_MEMORY_SCOPE_WORKGROUP); }
        __syncthreads();
        if (F.tid < 32) { const int h = hist[F.tid]; int b0 = 0; if (h != 0) b0 = (int)__hip_atomic_fetch_add((unsigned*)(F.ctl + CW_CUR) + 64 * F.tid, (unsigned)h, __ATOMIC_RELAXED, __HIP_MEMORY_SCOPE_AGENT); base[F.tid] = tab[320 + F.tid] + b0; }
        __syncthreads();
        if (F.tid < 256) { const int slot = base[e] + rank; pos[(size_t)grp * 256 + F.tid] = slot; rowgate[slot] = topg[(size_t)grp * 256 + F.tid]; slots[F.tid] = slot; }
        __syncthreads();
        for (int i = 0; i < 8; ++i) { const int tl = F.wave * 8 + i; const size_t m = (size_t)grp * 64 + tl;
            const GAS f32x4* xr = (const GAS f32x4*)(F.out + m * D_MODEL) + 2 * lane; const GAS f32x4* gr = (const GAS f32x4*)gain + 2 * lane;
            f32x4 v[4]; float s = 0.f;
#pragma unroll
            for (int j = 0; j < 4; ++j) { v[j] = xr[128 * (j >> 1) + (j & 1)]; s += (v[j].x * v[j].x + v[j].y * v[j].y) + (v[j].z * v[j].z + v[j].w * v[j].w); }
            const float rstd = 1.0f / sqrtf(wave_sum(s) * (1.f / D_MODEL) + NORM_EPS);
            v4u o[2];
#pragma unroll
            for (int hf = 0; hf < 2; ++hf) { const f32x4 g0 = gr[128 * hf], g1 = gr[128 * hf + 1]; const f32x4 a = v[2 * hf] * rstd * g0, b = v[2 * hf + 1] * rstd * g1;
                o[hf].x = pk2(a.x, a.y); o[hf].y = pk2(a.z, a.w); o[hf].z = pk2(b.x, b.y); o[hf].w = pk2(b.z, b.w); }
#pragma unroll
            for (int k = 0; k < 4; ++k) { const int sk = slots[tl * 4 + k]; GAS v4u* dst = (GAS v4u*)(XS + (size_t)sk * D_MODEL) + lane; dst[0] = o[0]; dst[64] = o[1]; }
        }
        __syncthreads();
    }
}
__device__ __forceinline__ void p12_combine(Frame& F) {
    const int gw = F.vcu * NWAVES + F.wave, NGW = F.G * NWAVES, lane = F.lane;
    unsigned char* ws = F.ws;
    const int* pos = (const int*)(ws + WS_ROUTE + RT_POS); const bf16* YR = (const bf16*)(ws + WS_YROWS);
    for (int m = gw; m < MTOK; m += NGW) {
        GAS f32x4* xo = (GAS f32x4*)(F.out + (size_t)m * D_MODEL) + 2 * lane;
        int pk = 0; if (lane < 4) pk = pos[(size_t)m * 4 + lane];
#pragma unroll
        for (int hf = 0; hf < 2; ++hf) { f32x4 a = xo[128 * hf], b = xo[128 * hf + 1];
#pragma unroll
            for (int k = 0; k < 4; ++k) { const int sk = __builtin_amdgcn_readlane(pk, k); const v4u w = *((const GAS v4u*)(YR + (size_t)sk * D_MODEL + 512 * hf) + lane);
                a[0] += bf_lo(w.x); a[1] += bf_hi(w.x); a[2] += bf_lo(w.y); a[3] += bf_hi(w.y); b[0] += bf_lo(w.z); b[1] += bf_hi(w.z); b[2] += bf_lo(w.w); b[3] += bf_hi(w.w); }
            xo[128 * hf] = a; xo[128 * hf + 1] = b; }
    }
}

constexpr int N_ATT_A = 768, N_ATT_C = 256;
__device__ __forceinline__ swa::BlockRef attn_item(unsigned char* ws, int it) {
    swa::BlockRef r;
    const swa::bf16* Z = (const swa::bf16*)(ws + WS_Z);
    if (it < N_ATT_A) {
        const int h = it & 3, b = (it >> 2) & 1, v = it >> 3;
        int g, rr, qb;
        if (v < 32) { g = 0; rr = 0; qb = v; } else if (v < 64) { g = 1; rr = (v - 32) >> 3; qb = (v - 32) & 7; } else { g = 2; rr = (v - 64) >> 1; qb = (v - 64) & 1; }
        const int d = (g == 0) ? 1 : (g == 1) ? 4 : 16;
        const size_t row0 = (size_t)b * SEQ + rr, qrow = row0 + (size_t)d * qb * 256;
        r.Q = Z + qrow * IN_COLS + OFF_AQ + g * 512 + h * 128; r.K = Z + row0 * IN_COLS + OFF_AK + g * 512 + h * 128; r.V = Z + row0 * IN_COLS + OFF_AV + g * 512 + h * 128;
        r.O = (swa::bf16*)(ws + WS_OP) + (size_t)g * MTOK * 512 + qrow * 512 + h * 128; r.LSE = (float*)(ws + WS_LSE) + (size_t)g * MTOK * 4 + qrow * 4 + h;
        r.QS = d * IN_COLS; r.KS = d * IN_COLS; r.OS = d * 512; r.LS = d * 4; r.P0 = qb * 256; r.skv = SEQ / d; r.W = 129;
    } else {
        const int u = it - N_ATT_A, h = u & 3, b = (u >> 2) & 1, qb = u >> 3;
        const size_t qrow = (size_t)b * SEQ + (size_t)qb * 256;
        const swa::bf16* KV = (const swa::bf16*)(ws + WS_KVM) + (size_t)b * MEM_LEN * 1024 + h * 128;
        r.Q = Z + qrow * IN_COLS + OFF_CQ + h * 128; r.K = KV; r.V = KV + 512;
        r.O = (swa::bf16*)(ws + WS_YABC) + qrow * 1536 + 1024 + h * 128; r.LSE = nullptr;
        r.QS = IN_COLS; r.KS = 1024; r.OS = 1536; r.LS = 0; r.P0 = 256; r.skv = MEM_LEN; r.W = 1 << 20;
    }
    return r;
}
__device__ __forceinline__ void p3_attention_mfma(unsigned char* ws, char* lds, int G) {
    const int total = N_ATT_A + N_ATT_C; int L = blockIdx.x; if (L >= total) return;
    swa::BlockRef cur = attn_item(ws, L); swa::Seam S;
    swa::swa_prime(cur, lds, S);
    for (;;) {
        const int Ln = L + G; const bool last = Ln >= total;
        const swa::BlockRef nxt = last ? cur : attn_item(ws, Ln);
        swa::swa_block(cur, nxt, lds, S);
        if (last) break;
        cur = nxt; L = Ln;
    }
}

constexpr int N_RITEMS = BATCH * 8 * (SEQ / 64);
constexpr size_t WS_PHI = WS_XN;
constexpr size_t WS_PSI = WS_XN + 16 * MiB;
constexpr size_t WS_GAM = WS_YS;
constexpr size_t WS_OM = WS_XN2;
constexpr size_t WS_XFR = WS_MRG + 48 * MiB;
constexpr size_t WS_BONUS = WS_MRGB + 1 * MiB;
constexpr int RB = 9216, RLD = 72;
constexpr int R1_SEG = 15 * RB, R1_WC = R1_SEG + 2048;
static_assert(R1_WC + 256 <= LDSCTL_OFF, "R1 LDS map");
typedef LAS unsigned short* lbf_t;
__device__ __forceinline__ f32x4 r1_tile(const LAS unsigned short* X, const LAS unsigned short* Yt, int mi, int ni, f32x4 acc, int fr, int fq) {
    const LAS unsigned short* xp = X + (16 * mi + fr) * RLD + 8 * fq; const LAS unsigned short* yp = Yt + (16 * ni + fr) * RLD + 8 * fq;
    const bf16x8 a0 = *(const LAS bf16x8*)xp, a1 = *(const LAS bf16x8*)(xp + 32), b0 = *(const LAS bf16x8*)yp, b1 = *(const LAS bf16x8*)(yp + 32);
    acc = __builtin_amdgcn_mfma_f32_16x16x32_bf16(b0, a0, acc, 0, 0, 0);
    acc = __builtin_amdgcn_mfma_f32_16x16x32_bf16(b1, a1, acc, 0, 0, 0);
    return acc;
}
__device__ __forceinline__ void r1_store(LAS unsigned short* dst, int mi, int ni, f32x4 acc, int mode, bool addI, const LAS unsigned short* addT, int fr, int fq) {
    const int m = 16 * mi + fr, n0 = 16 * ni + 4 * fq;
#pragma unroll
    for (int r = 0; r < 4; ++r) { const int n = n0 + r; bool keep = true;
        if (mode == 1) keep = n < m; else if (mode == 2) keep = n <= m; else if (mode == 3) keep = m < n;
        float v = keep ? acc[r] : 0.f; if (addI && m == n) v += 1.0f; acc[r] = v; }
    if (addT != nullptr) { const unsigned long long w = *(const LAS unsigned long long*)(addT + m * RLD + n0);
        acc[0] += bf_lo((unsigned)w); acc[1] += bf_hi((unsigned)w); acc[2] += bf_lo((unsigned)(w >> 32)); acc[3] += bf_hi((unsigned)(w >> 32)); }
    *(LAS unsigned long long*)(dst + m * RLD + n0) = (unsigned long long)pk2(acc[0], acc[1]) | ((unsigned long long)pk2(acc[2], acc[3]) << 32);
}
#define R1BUF(i) ((LAS unsigned short*)(F.lds + (i) * RB))
template <int MODE> __device__ __forceinline__ void p_r1(Frame& F, const Args& args) {
    unsigned char* ws = F.ws; const int lane0 = F.lane, wave = F.wave;
    const bf16* Z = (const bf16*)(ws + WS_Z);
    const float* rkp = ldarg(I_R_RK); const float* mu = ldarg(I_R_MU); const float* w0p = ldarg(I_R_W0); const float* a0p = ldarg(I_R_A0); const float* kkp = ldarg(I_R_KK); const float* kap = ldarg(I_R_KA);
    const bf16* W2T = (const bf16*)(ws + WS_LORA); const bf16* A2T = W2T + 512 * 64; const bf16* G2T = A2T + 512 * 64;
    bf16* VM = (bf16*)(ws + WS_VMIX); bf16* GM = (bf16*)(ws + WS_GMIX);
    LAS float* segsum = (LAS float*)(F.lds + R1_SEG); LAS float* wcs = (LAS float*)(F.lds + R1_WC);
    unsigned short zv[7][9];
#define R1LOAD(it_) do { const int bh_ = (it_) >> 7, c_ = (it_) & 127, h_ = bh_ & 7, t0_ = c_ * 64 + 8 * wave; \
        const bf16* zp_ = Z + ((size_t)(bh_ >> 3) * SEQ + t0_) * IN_COLS + OFF_R + lane; \
        _Pragma("unroll") for (int i = 0; i < 9; ++i) { const bool ok_ = (i > 0) || (t0_ > 0); const bf16* rp_ = zp_ + ((long)i - 1) * IN_COLS; const bf16* rq_ = rp_ + 64 * h_;     \
            zv[0][i] = ok_ ? rp_[1536] : (unsigned short)0; zv[1][i] = ok_ ? rp_[1600] : (unsigned short)0; zv[2][i] = ok_ ? rp_[1664] : (unsigned short)0; zv[3][i] = ok_ ? rp_[1728] : (unsigned short)0; \
            zv[4][i] = ok_ ? rq_[0] : (unsigned short)0; zv[5][i] = ok_ ? rq_[512] : (unsigned short)0; zv[6][i] = ok_ ? rq_[1024] : (unsigned short)0; } } while (0)
#define ZF(x) __builtin_bit_cast(float, (unsigned)(x) << 16)
    { const int lane = lane0; if (F.vcu < N_RITEMS) R1LOAD(F.vcu); }
    for (int item = F.vcu; item < N_RITEMS; item += F.G) {
        const int lane = opq(lane0), fr = lane & 15, fq = lane >> 4;
        const int bh = item >> 7, c = item & 127, b = bh >> 3, h = bh & 7;
        const size_t row0 = (size_t)b * SEQ + (size_t)c * 64;
        const f32x4 zero4 = (f32x4){0.f, 0.f, 0.f, 0.f};
        const int mw = wave >> 2, nw = wave & 3;
        float r[8], lw[8], kx[8], vx[8], ax[8], bx[8];
        { const int k = lane, tq = wave, ch = h * 64 + k;
#pragma unroll
          for (int g = 0; g < 4; ++g) { const float mug = mu[1536 + 64 * g + k];
#pragma unroll
              for (int i = 0; i < 8; ++i) { const float cur = ZF(zv[g][i + 1]), prv = ZF(zv[g][i]); float x = cur + (prv - cur) * mug;
                  x = (g == 0) ? tanhf(x) : (g == 1) ? x : sigm(x); const unsigned short xb = (unsigned short)f2bf(x); const int t = 8 * tq + i;
                  if (g == 0) R1BUF(11)[t * RLD + k] = xb; else if (g == 1) R1BUF(12)[t * RLD + k] = xb; else R1BUF(13)[t * 136 + 64 * (g - 2) + k] = xb; } }
          { const int tid_ = wave * 64 + lane, row = tid_ >> 3, chk = tid_ & 7;
            *(LAS v4u*)(R1BUF(5) + row * RLD + chk * 8) = *(const GAS v4u*)(W2T + (size_t)(64 * h + row) * 64 + chk * 8);
            *(LAS v4u*)(R1BUF(6) + row * RLD + chk * 8) = *(const GAS v4u*)(A2T + (size_t)(64 * h + row) * 64 + chk * 8);
#pragma unroll
            for (int hh = 0; hh < 2; ++hh) { const int rg = (tid_ >> 4) + 32 * hh, cg = tid_ & 15;
                *(LAS v4u*)(R1BUF(7) + rg * 136 + cg * 8) = *(const GAS v4u*)(G2T + (size_t)(64 * h + rg) * 128 + cg * 8); } }
          __syncthreads();
          { f32x4 dw0, dw1, da0, da1, dg0 = zero4, dg1 = zero4;
            { const LAS unsigned short* yp_ = R1BUF(5) + (16 * nw + fr) * RLD + 8 * fq; const LAS unsigned short* xp_ = R1BUF(11) + (16 * mw + fr) * RLD + 8 * fq;
              const bf16x8 y0_ = *(const LAS bf16x8*)yp_, y1_ = *(const LAS bf16x8*)(yp_ + 32), xa0_ = *(const LAS bf16x8*)xp_, xa1_ = *(const LAS bf16x8*)(xp_ + 32), xb0_ = *(const LAS bf16x8*)(xp_ + 32 * RLD), xb1_ = *(const LAS bf16x8*)(xp_ + 32 * RLD + 32);
              dw0 = __builtin_amdgcn_mfma_f32_16x16x32_bf16(y0_, xa0_, zero4, 0, 0, 0); dw1 = __builtin_amdgcn_mfma_f32_16x16x32_bf16(y0_, xb0_, zero4, 0, 0, 0);
              dw0 = __builtin_amdgcn_mfma_f32_16x16x32_bf16(y1_, xa1_, dw0, 0, 0, 0); dw1 = __builtin_amdgcn_mfma_f32_16x16x32_bf16(y1_, xb1_, dw1, 0, 0, 0); }
            { const LAS unsigned short* yp_ = R1BUF(6) + (16 * nw + fr) * RLD + 8 * fq; const LAS unsigned short* xp_ = R1BUF(12) + (16 * mw + fr) * RLD + 8 * fq;
              const bf16x8 y0_ = *(const LAS bf16x8*)yp_, y1_ = *(const LAS bf16x8*)(yp_ + 32), xa0_ = *(const LAS bf16x8*)xp_, xa1_ = *(const LAS bf16x8*)(xp_ + 32), xb0_ = *(const LAS bf16x8*)(xp_ + 32 * RLD), xb1_ = *(const LAS bf16x8*)(xp_ + 32 * RLD + 32);
              da0 = __builtin_amdgcn_mfma_f32_16x16x32_bf16(y0_, xa0_, zero4, 0, 0, 0); da1 = __builtin_amdgcn_mfma_f32_16x16x32_bf16(y0_, xb0_, zero4, 0, 0, 0);
              da0 = __builtin_amdgcn_mfma_f32_16x16x32_bf16(y1_, xa1_, da0, 0, 0, 0); da1 = __builtin_amdgcn_mfma_f32_16x16x32_bf16(y1_, xb1_, da1, 0, 0, 0); }
            { const LAS unsigned short* yp_ = R1BUF(7) + (16 * nw + fr) * 136 + 8 * fq; const LAS unsigned short* xp_ = R1BUF(13) + (16 * mw + fr) * 136 + 8 * fq;
#pragma unroll
              for (int kk = 0; kk < 4; ++kk) { const bf16x8 y_ = *(const LAS bf16x8*)(yp_ + 32 * kk), xa_ = *(const LAS bf16x8*)(xp_ + 32 * kk), xb_ = *(const LAS bf16x8*)(xp_ + 32 * 136 + 32 * kk);
                  dg0 = __builtin_amdgcn_mfma_f32_16x16x32_bf16(y_, xa_, dg0, 0, 0, 0); dg1 = __builtin_amdgcn_mfma_f32_16x16x32_bf16(y_, xb_, dg1, 0, 0, 0); } }
            const int o0 = (16 * mw + fr) * 68 + 16 * nw + 4 * fq, o1 = o0 + 32 * 68;
            *(LAS f32x4*)((LAS float*)R1BUF(0) + o0) = dw0; *(LAS f32x4*)((LAS float*)R1BUF(0) + o1) = dw1;
            *(LAS f32x4*)((LAS float*)R1BUF(2) + o0) = da0; *(LAS f32x4*)((LAS float*)R1BUF(2) + o1) = da1;
            *(LAS f32x4*)((LAS float*)R1BUF(9) + o0) = dg0; *(LAS f32x4*)((LAS float*)R1BUF(9) + o1) = dg1; }
          __syncthreads();
          { const float w0c = w0p[ch], a0c = a0p[ch], kkc = kkp[ch], kac = kap[ch], mur = mu[ch], muk = mu[512 + ch], muv = mu[1024 + ch];
#pragma unroll
            for (int i = 0; i < 8; ++i) { const int t = 8 * tq + i;
                const float dwv = ((const LAS float*)R1BUF(0))[t * 68 + k], dav = ((const LAS float*)R1BUF(2))[t * 68 + k], dgv = ((const LAS float*)R1BUF(9))[t * 68 + k];
                const float cr = ZF(zv[4][i + 1]), pr = ZF(zv[4][i]), ck = ZF(zv[5][i + 1]), pk = ZF(zv[5][i]), cv = ZF(zv[6][i + 1]), pv = ZF(zv[6][i]);
                const float rr = cr + (pr - cr) * mur, kr = ck + (pk - ck) * muk, vr = cv + (pv - cv) * muv;
                const float y = -(w0c + dwv); const float sp = fmaxf(y, 0.f) + log1pf(__expf(-fabsf(y)));
                lw[i] = -__expf(-sp - 0.5f);
                const float av = sigm(a0c + dav);
                const float kkv = kr * kkc; const float ssq = wave_sum(kkv * kkv); const float kkn = kkv * (1.0f / fmaxf(sqrtf(ssq), 1e-12f));
                r[i] = rr; vx[i] = vr; kx[i] = kr * (1.0f + (av - 1.0f) * kac); ax[i] = -kkn; bx[i] = kkn * av;
                if (MODE == 0) { VM[(row0 + t) * RW + ch] = (bf16)f2bf(vr); GM[(row0 + t) * RW + ch] = (bf16)f2bf(dgv); } } }
        }
        if (item + F.G < N_RITEMS) R1LOAD(item + F.G);
        { const int k = lane, tq = wave;
          float cs[8]; cs[0] = lw[0];
#pragma unroll
          for (int i = 1; i < 8; ++i) cs[i] = cs[i - 1] + lw[i];
          segsum[tq * 64 + k] = cs[7];
          const float rk = rkp[h * 64 + k];
#pragma unroll
          for (int i = 0; i < 8; ++i) { const float bs = wave_sum(r[i] * kx[i] * rk); if (MODE == 0 && lane == 0) *(GAS float*)((float*)(ws + WS_BONUS) + (row0 + 8 * tq + i) * 8 + h) = bs; }
          __syncthreads();
          float pre = 0.f;
#pragma unroll
          for (int q = 0; q < 7; ++q) { const float sv = segsum[q * 64 + k]; pre += (q < tq) ? sv : 0.f; }
          unsigned short at[8], rt[8], bt[8], kt[8], vt[8];
#pragma unroll
          for (int i = 0; i < 8; ++i) { const float L = pre + cs[i], Lp = L - lw[i]; const float e = __expf(L), ep = __expf(Lp), ei = __expf(-L);
              at[i] = (unsigned short)f2bf(ax[i] * ep); rt[i] = (unsigned short)f2bf(r[i] * e); bt[i] = (unsigned short)f2bf(bx[i] * ei); kt[i] = (unsigned short)f2bf(kx[i] * ei); vt[i] = (unsigned short)f2bf(vx[i]);
              if (i == 7 && tq == 7) wcs[k] = e; }
#pragma unroll
          for (int i = 0; i < 8; ++i) { const int o = (8 * tq + i) * RLD + k; R1BUF(8)[o] = at[i]; R1BUF(4)[o] = rt[i]; R1BUF(9)[o] = bt[i]; R1BUF(10)[o] = kt[i]; }
          const int ot = k * RLD + 8 * tq;
#define PK8(x) ((v4u){(unsigned)x[0] | ((unsigned)x[1] << 16), (unsigned)x[2] | ((unsigned)x[3] << 16), (unsigned)x[4] | ((unsigned)x[5] << 16), (unsigned)x[6] | ((unsigned)x[7] << 16)})
          *(LAS v4u*)(R1BUF(0) + ot) = PK8(at); *(LAS v4u*)(R1BUF(1) + ot) = PK8(bt); *(LAS v4u*)(R1BUF(2) + ot) = PK8(kt); *(LAS v4u*)(R1BUF(3) + ot) = PK8(vt);
#undef PK8
        }
        __syncthreads();
#define R1PAIR(X, Y, a0, a1) do { const LAS unsigned short* yp_ = (Y) + (16 * nw + fr) * RLD + 8 * fq; const LAS unsigned short* xp_ = (X) + (16 * mw + fr) * RLD + 8 * fq; \
            const bf16x8 y0_ = *(const LAS bf16x8*)yp_, y1_ = *(const LAS bf16x8*)(yp_ + 32), xa0_ = *(const LAS bf16x8*)xp_, xa1_ = *(const LAS bf16x8*)(xp_ + 32), xb0_ = *(const LAS bf16x8*)(xp_ + 32 * RLD), xb1_ = *(const LAS bf16x8*)(xp_ + 32 * RLD + 32); \
            a0 = __builtin_amdgcn_mfma_f32_16x16x32_bf16(y0_, xa0_, zero4, 0, 0, 0); a1 = __builtin_amdgcn_mfma_f32_16x16x32_bf16(y0_, xb0_, zero4, 0, 0, 0); \
            a0 = __builtin_amdgcn_mfma_f32_16x16x32_bf16(y1_, xa1_, a0, 0, 0, 0); a1 = __builtin_amdgcn_mfma_f32_16x16x32_bf16(y1_, xb1_, a1, 0, 0, 0); } while (0)
#define R1ST2(dst, a0, a1, mode, addI, addT) do { r1_store(dst, mw, nw, a0, mode, addI, addT, fr, fq); r1_store(dst, mw + 2, nw, a1, mode, addI, addT, fr, fq); } while (0)
        { f32x4 n0, n1, t0, t1, l0, l1, b0, b1, k0, k1;
          R1PAIR(R1BUF(8), R1BUF(9), n0, n1); R1PAIR(R1BUF(9), R1BUF(8), t0, t1); R1PAIR(R1BUF(8), R1BUF(10), l0, l1); R1PAIR(R1BUF(4), R1BUF(9), b0, b1); R1PAIR(R1BUF(4), R1BUF(10), k0, k1);
          R1ST2(R1BUF(11), n0, n1, 1, false, nullptr); R1ST2(R1BUF(13), n0, n1, 1, true, nullptr); R1ST2(R1BUF(12), t0, t1, 3, false, nullptr);
          R1ST2(R1BUF(5), l0, l1, 1, false, nullptr); R1ST2(R1BUF(6), b0, b1, 2, false, nullptr); R1ST2(R1BUF(7), k0, k1, 2, false, nullptr); }
        __syncthreads();
        { f32x4 n0, n1, t0, t1, e0, e1;
          R1PAIR(R1BUF(11), R1BUF(12), n0, n1); R1PAIR(R1BUF(12), R1BUF(11), t0, t1); R1PAIR(R1BUF(3), R1BUF(5), e0, e1);
          R1ST2(R1BUF(8), n0, n1, 0, false, nullptr); R1ST2(R1BUF(9), t0, t1, 0, false, nullptr); R1ST2(R1BUF(10), e0, e1, 0, false, nullptr); }
        __syncthreads();
#pragma unroll 1
        for (int lv = 0; lv < 5; ++lv) {
            const bool srcB = (lv & 1) == 0;
            LAS unsigned short* sN = srcB ? R1BUF(8) : R1BUF(11); LAS unsigned short* sNT = srcB ? R1BUF(9) : R1BUF(12);
            LAS unsigned short* dN = srcB ? R1BUF(11) : R1BUF(8); LAS unsigned short* dNT = srcB ? R1BUF(12) : R1BUF(9);
            LAS unsigned short* Tc = (lv & 1) ? R1BUF(14) : R1BUF(13); LAS unsigned short* Tn = (lv & 1) ? R1BUF(13) : R1BUF(14);
            f32x4 u0, u1, t0 = zero4, t1 = zero4, n0 = zero4, n1 = zero4;
            R1PAIR(Tc, sNT, u0, u1);
            if (lv < 4) R1PAIR(sNT, sN, t0, t1);
            if (lv < 3) R1PAIR(sN, sNT, n0, n1);
            R1ST2(Tn, u0, u1, 0, false, Tc);
            if (lv < 4) R1ST2(dNT, t0, t1, 0, false, nullptr);
            if (lv < 3) R1ST2(dN, n0, n1, 0, false, nullptr);
            __syncthreads();
        }
        { f32x4 g0, g1, q0, q1;
          R1PAIR(R1BUF(0), R1BUF(14), g0, g1); R1PAIR(R1BUF(10), R1BUF(14), q0, q1);
          R1ST2(R1BUF(11), g0, g1, 0, false, nullptr); R1ST2(R1BUF(12), q0, q1, 0, false, nullptr); }
        __syncthreads();
#undef R1PAIR
#undef R1ST2
        { const int mi = wave >> 1, ks = wave & 1;
          const f32x4 p0 = r1_tile(R1BUF(1), R1BUF(11), mi, 2 * ks, zero4, fr, fq), p1 = r1_tile(R1BUF(1), R1BUF(11), mi, 2 * ks + 1, zero4, fr, fq);
          const f32x4 s0 = r1_tile(R1BUF(6), R1BUF(11), mi, 2 * ks, zero4, fr, fq), s1 = r1_tile(R1BUF(6), R1BUF(11), mi, 2 * ks + 1, zero4, fr, fq);
          const int m = 16 * mi + fr; const float wc = wcs[m];
          float ph[8], ps[8];
#pragma unroll
          for (int r = 0; r < 4; ++r) { const int n0 = 32 * ks + 4 * fq + r, n1 = n0 + 16;
              ph[r] = (p0[r] + (m == n0 ? 1.f : 0.f)) * wc; ph[4 + r] = (p1[r] + (m == n1 ? 1.f : 0.f)) * wc; }
          { const unsigned long long w0 = *(const LAS unsigned long long*)(R1BUF(4) + m * RLD + 32 * ks + 4 * fq), w1 = *(const LAS unsigned long long*)(R1BUF(4) + m * RLD + 32 * ks + 16 + 4 * fq);
            ps[0] = s0[0] + bf_lo((unsigned)w0); ps[1] = s0[1] + bf_hi((unsigned)w0); ps[2] = s0[2] + bf_lo((unsigned)(w0 >> 32)); ps[3] = s0[3] + bf_hi((unsigned)(w0 >> 32));
            ps[4] = s1[0] + bf_lo((unsigned)w1); ps[5] = s1[1] + bf_hi((unsigned)w1); ps[6] = s1[2] + bf_lo((unsigned)(w1 >> 32)); ps[7] = s1[3] + bf_hi((unsigned)(w1 >> 32)); }
          const size_t fo = (((size_t)item * 4 + mi) * 2 + ks) * 64 + lane;
          if (MODE == 0) *((GAS v4u*)(ws + WS_PHI) + fo) = (v4u){pk2(ph[0], ph[1]), pk2(ph[2], ph[3]), pk2(ph[4], ph[5]), pk2(ph[6], ph[7])};
          if (MODE == 0) *((GAS v4u*)(ws + WS_PSI) + fo) = (v4u){pk2(ps[0], ps[1]), pk2(ps[2], ps[3]), pk2(ps[4], ps[5]), pk2(ps[6], ps[7])};
          const int vb = wave >> 1;
#pragma unroll
          for (int hh = 0; hh < 2; ++hh) { const int mt = 2 * (wave & 1) + hh;
              f32x4 ga = r1_tile(R1BUF(12), R1BUF(1), vb, mt, zero4, fr, fq); ga = r1_tile(R1BUF(3), R1BUF(2), vb, mt, ga, fr, fq);
              f32x4 om = r1_tile(R1BUF(12), R1BUF(6), vb, mt, zero4, fr, fq); om = r1_tile(R1BUF(3), R1BUF(7), vb, mt, om, fr, fq);
#pragma unroll
              for (int r = 0; r < 4; ++r) ga[r] *= wcs[16 * mt + 4 * fq + r];
              const size_t ao = (((size_t)item * 4 + vb) * 4 + mt) * 64 + lane;
              if (MODE == 0) { *((GAS f32x4*)(ws + WS_GAM) + ao) = ga; *((GAS f32x4*)(ws + WS_OM) + ao) = om; } else { asm volatile("" :: "v"(ga), "v"(om)); } }
        }
        __syncthreads();
    }
}
#undef R1BUF
#undef R1LOAD
#undef ZF
struct R2Buf { bf16x8 ph[4][2]; f32x4 ga[4]; };
__device__ __forceinline__ void r2_load(R2Buf& B, const unsigned char* ws, int item, int vb, int lane) {
#pragma unroll
    for (int mt = 0; mt < 4; ++mt) {
#pragma unroll
        for (int ks = 0; ks < 2; ++ks) B.ph[mt][ks] = *((const GAS bf16x8*)(ws + WS_PHI) + (((size_t)item * 4 + mt) * 2 + ks) * 64 + lane);
        B.ga[mt] = *((const GAS f32x4*)(ws + WS_GAM) + (((size_t)item * 4 + vb) * 4 + mt) * 64 + lane); }
}
__device__ __forceinline__ void r2_step(const R2Buf& B, f32x4 (&acc)[4], unsigned char* ws, int item, int vb, int lane) {
    v4u x0, x1;
    x0.x = pk2(acc[0][0], acc[0][1]); x0.y = pk2(acc[0][2], acc[0][3]); x0.z = pk2(acc[1][0], acc[1][1]); x0.w = pk2(acc[1][2], acc[1][3]);
    x1.x = pk2(acc[2][0], acc[2][1]); x1.y = pk2(acc[2][2], acc[2][3]); x1.z = pk2(acc[3][0], acc[3][1]); x1.w = pk2(acc[3][2], acc[3][3]);
    GAS v4u* xo = (GAS v4u*)(ws + WS_XFR) + (((size_t)item * 4 + vb) * 2) * 64 + lane; xo[0] = x0; xo[64] = x1;
    const bf16x8 f0 = __builtin_bit_cast(bf16x8, x0), f1 = __builtin_bit_cast(bf16x8, x1);
#pragma unroll
    for (int mt = 0; mt < 4; ++mt) { f32x4 a = B.ga[mt];
        a = __builtin_amdgcn_mfma_f32_16x16x32_bf16(B.ph[mt][0], f0, a, 0, 0, 0);
        a = __builtin_amdgcn_mfma_f32_16x16x32_bf16(B.ph[mt][1], f1, a, 0, 0, 0);
        acc[mt] = a; }
}
__device__ __forceinline__ void p_r2(Frame& F) {
    if (blockIdx.x < BATCH * 8 * 4 && F.wave == 0) {
        unsigned char* ws = F.ws; const int bh = blockIdx.x >> 2, vb = blockIdx.x & 3, lane = F.lane;
        f32x4 acc[4];
#pragma unroll
        for (int i = 0; i < 4; ++i) acc[i] = (f32x4){0.f, 0.f, 0.f, 0.f};
        R2Buf A, B, C, D;
        const int it0 = bh * 128;
        r2_load(A, ws, it0, vb, lane); r2_load(B, ws, it0 + 1, vb, lane); r2_load(C, ws, it0 + 2, vb, lane);
#define R2SB() __builtin_amdgcn_sched_barrier(0)
#pragma unroll
        for (int c = 0; c < 128; c += 4) {
            r2_load(D, ws, it0 + c + 3, vb, lane); R2SB(); r2_step(A, acc, ws, it0 + c, vb, lane); R2SB();
            r2_load(A, ws, it0 + (c + 4 < 128 ? c + 4 : 127), vb, lane); R2SB(); r2_step(B, acc, ws, it0 + c + 1, vb, lane); R2SB();
            r2_load(B, ws, it0 + (c + 5 < 128 ? c + 5 : 127), vb, lane); R2SB(); r2_step(C, acc, ws, it0 + c + 2, vb, lane); R2SB();
            r2_load(C, ws, it0 + (c + 6 < 128 ? c + 6 : 127), vb, lane); R2SB(); r2_step(D, acc, ws, it0 + c + 3, vb, lane); R2SB();
        }
#undef R2SB
    }
}
__device__ __forceinline__ void p_r3(Frame& F, const Args& args) {
    const int gw = F.vcu * NWAVES + F.wave, NGW = F.G * NWAVES, lane = F.lane, cc = lane & 15, q = lane >> 4;
    unsigned char* ws = F.ws;
    const bf16* VM = (const bf16*)(ws + WS_VMIX); const bf16* GM = (const bf16*)(ws + WS_GMIX);
    const float* bonus = (const float*)(ws + WS_BONUS);
    bf16* YB = (bf16*)(ws + WS_YABC) + 512;
    const float* lnw = ldarg(I_R_LNW); const float* lnb = ldarg(I_R_LNB);
    for (int wi = gw; wi < N_RITEMS * 4; wi += NGW) {
        const int item = wi >> 2, tt = wi & 3, bh = item >> 7, c = item & 127, b = bh >> 3, h = bh & 7;
        const bf16x8 ps0 = *((const GAS bf16x8*)(ws + WS_PSI) + (((size_t)item * 4 + tt) * 2 + 0) * 64 + lane), ps1 = *((const GAS bf16x8*)(ws + WS_PSI) + (((size_t)item * 4 + tt) * 2 + 1) * 64 + lane);
        f32x4 acc[4];
#pragma unroll
        for (int vb = 0; vb < 4; ++vb) {
            const bf16x8 x0 = *((const GAS bf16x8*)(ws + WS_XFR) + (((size_t)item * 4 + vb) * 2 + 0) * 64 + lane), x1 = *((const GAS bf16x8*)(ws + WS_XFR) + (((size_t)item * 4 + vb) * 2 + 1) * 64 + lane);
            f32x4 a = *((const GAS f32x4*)(ws + WS_OM) + (((size_t)item * 4 + vb) * 4 + tt) * 64 + lane);
            a = __builtin_amdgcn_mfma_f32_16x16x32_bf16(ps0, x0, a, 0, 0, 0);
            a = __builtin_amdgcn_mfma_f32_16x16x32_bf16(ps1, x1, a, 0, 0, 0);
            acc[vb] = a; }
        const size_t rowb = (size_t)b * SEQ + (size_t)c * 64 + 16 * tt + 4 * q;
#pragma unroll
        for (int r = 0; r < 4; ++r) { const size_t t = rowb + r;
            const float s = (acc[0][r] + acc[1][r]) + (acc[2][r] + acc[3][r]);
            const float mean = row16_sum(s) * (1.f / 64.f);
            const float d0 = acc[0][r] - mean, d1 = acc[1][r] - mean, d2 = acc[2][r] - mean, d3 = acc[3][r] - mean;
            const float var = row16_sum((d0 * d0 + d1 * d1) + (d2 * d2 + d3 * d3)) * (1.f / 64.f);
            const float rstd = 1.0f / sqrtf(var + R_GN_EPS);
            const float bn = bonus[t * 8 + h];
#pragma unroll
            for (int vb = 0; vb < 4; ++vb) { const int ch = h * 64 + 16 * vb + cc; const float d = (vb == 0) ? d0 : (vb == 1) ? d1 : (vb == 2) ? d2 : d3;
                const float yn = d * rstd * lnw[ch] + lnb[ch];
                const float vv = __builtin_bit_cast(float, (unsigned)VM[t * RW + ch] << 16), gg = __builtin_bit_cast(float, (unsigned)GM[t * RW + ch] << 16);
                YB[t * 1536 + ch] = (bf16)f2bf((yn + bn * vv) * gg); } }
    }
}

__global__ void __launch_bounds__(NWAVES * 64, 2) skel_fwd(Args args) {
    extern __shared__ __attribute__((aligned(16))) unsigned char lds[];
    Frame F;
    F.lds = (LAS unsigned char*)lds;
    F.MISC = (volatile LAS unsigned*)(F.lds + MISC_OFF);
    phase_enter(F, true);
    F.G = gridDim.x; { const int bx = blockIdx.x; F.vcu = (F.G % 8 == 0) ? (bx % 8) * (F.G / 8) + bx / 8 : bx; }
    unsigned char* ws = args.ws; F.ws = ws; F.out = args.out;
    F.ctl = (gu32*)(ws + WS_CTL);
    for (int u = F.tid; u < (LDS_BYTES - LDSCTL_OFF) / 4; u += NWAVES * 64) ((LAS unsigned*)(F.lds + LDSCTL_OFF))[u] = 0u;
    __syncthreads();
    XcdBarrier bar; bar.bar = (unsigned*)(F.ctl + CW_BAR); bar.x = 0; bar.st = nullptr;
    if (args.use_bar) bar = xcd_barrier_post((unsigned*)(F.ctl + CW_BAR), F.MISC + 8);
    const int lo = args.ph_lo, hi = args.ph_hi;
#define IN(k) (phase_enter(F, lo <= (k) && (k) < hi))
#define SEAM(k) do { if (lo <= (k) && (k) + 1 < hi) xcd_barrier(bar); } while (0)
    const pg8::bf16_t* wsb = (const pg8::bf16_t*)ws;
#define BF(off) ((pg8::bf16_t*)(ws + (off)))

    if (IN(0)) { p0_prologue<0>(F, args, F.vcu * NWAVES + F.wave, F.G * NWAVES); if (F.G <= 64) p0_prologue<1>(F, args, F.vcu * NWAVES + F.wave, F.G * NWAVES); } SEAM(0);
    if (IN(1)) {
        { pg8::Gemm g{BF(WS_XN), BF(WS_WIN), MTOK, IN_COLS, 1024}; pg8::StaticOrder S; S.init(MTOK, IN_COLS, F.G, (int)blockIdx.x);
          pg8::EpiZ E{BF(WS_Z), ldarg(I_B_GATE), ldarg(I_AQ_GAIN), ldarg(I_AK_GAIN), ldarg(I_CQ_GAIN), (const float*)(ws + WS_CS), (PG8_LAS float*)(F.lds + 131072), IN_COLS, 0};
          pg8::gemm_phase<pg8::EpiZ, pg8::StaticOrder, true, true>(F.lds + RING_OFF, g, S, E); }
        { pg8::Gemm g{BF(WS_MEMN), BF(WS_WMEM), MEMROWS, 1024, 1024}; pg8::StaticOrder S; S.init(MEMROWS, 1024, F.G, (int)blockIdx.x);
          const float* ckg_ = ldarg(I_CK_GAIN);
          pg8::EpiZ E{BF(WS_KVM), ckg_, ckg_, ckg_, ckg_, ckg_, (PG8_LAS float*)(F.lds + 131072), 1024, 1};
          pg8::gemm_phase<pg8::EpiZ, pg8::StaticOrder, true, true>(F.lds + RING_OFF, g, S, E); }
    } SEAM(1);
#if NAIVE_ATTN
    if (IN(3)) { p3_attention(F); } SEAM(3);
#else
    if (IN(3)) { p3_attention_mfma(ws, (char*)lds + RING_OFF, F.G); __syncthreads(); phase_enter(F, true); p_r1<0>(F, args); } SEAM(3);
#endif
    if (IN(4)) { p_r2(F); if (F.G > 64 && blockIdx.x >= 64) p0_prologue<1>(F, args, ((int)blockIdx.x - 64) * NWAVES + F.wave, (F.G - 64) * NWAVES); } SEAM(4);
    if (IN(5)) { p_r3(F, args); p5_post(F, args); } SEAM(5);
    if (IN(6)) {
        pg8::Gemm g{BF(WS_YABC), BF(WS_WB), MTOK, 1024, 1536}; pg8::StaticOrder S; S.init(MTOK, 1024, F.G, (int)blockIdx.x);
        pg8::EpiGate3 E{BF(WS_Z), BF(WS_MRGB)};
        pg8::gemm_phase<pg8::EpiGate3, pg8::StaticOrder, true, true>(F.lds + RING_OFF, g, S, E);
    } SEAM(6);
    if (IN(7)) {
        pg8::Gemm g{BF(WS_MRGB), BF(WS_WO), MTOK, 1024, 1024}; pg8::StaticOrder S; S.init(MTOK, 1024, F.G, (int)blockIdx.x);
        pg8::EpiResF32 E{ldarg(I_X), F.out, 1024};
        pg8::gemm_phase<pg8::EpiResF32, pg8::StaticOrder, true, true>(F.lds + RING_OFF, g, S, E);
    } SEAM(7);
    if (IN(8)) { p8_router(F, args); } SEAM(8);
    if (IN(9)) { p9_dispatch(F, args); } SEAM(9);
    if (IN(10)) {
        moe_table(F);
        pg8::Gemm g{BF(WS_XS), BF(WS_W1), 0, 0, 1024}; pg8::MoeOrder S{(const PG8_LAS int*)(F.lds + MOETAB_OFF), 8, F.G, (int)blockIdx.x};
        pg8::EpiSwiGLU E{ldarg(I_EXP_B1), BF(WS_HACT)};
        pg8::gemm_phase<pg8::EpiSwiGLU, pg8::MoeOrder, true, true>(F.lds + RING_OFF, g, S, E);
    } SEAM(10);
    if (IN(11)) {
        moe_table(F);
        pg8::Gemm g{BF(WS_HACT), BF(WS_W2), 0, 0, 1024}; pg8::MoeOrder S{(const PG8_LAS int*)(F.lds + MOETAB_OFF), 4, F.G, (int)blockIdx.x};
        pg8::EpiMoeOut E{ldarg(I_EXP_B2), (const float*)(ws + WS_ROUTE + RT_ROWGATE), BF(WS_YROWS)};
        pg8::gemm_phase<pg8::EpiMoeOut, pg8::MoeOrder, true, true>(F.lds + RING_OFF, g, S, E);
    } SEAM(11);
    if (IN(12)) { p12_combine(F); }
#undef IN
#undef SEAM
#undef BF
    (void)wsb;
}

extern "C" void kernel_launch(void* const* d_in, const int* in_sizes, int n_in, void* d_out, int out_size, void* d_ws, size_t ws_size, hipStream_t stream) {
    static int grid = 0;
    if (grid == 0) {
        if (n_in != 32 || out_size != MTOK * D_MODEL || ws_size < WS_END) { fprintf(stderr, "kernel_launch: unexpected problem (n_in %d, out %d, ws %zu); nothing launched\n", n_in, out_size, ws_size); grid = -1; return; }
        int dev = 0, cus = 0;
        if (hipGetDevice(&dev) != hipSuccess || hipDeviceGetAttribute(&cus, hipDeviceAttributeMultiprocessorCount, dev) != hipSuccess) { grid = -1; return; }
        if (hipFuncSetAttribute((const void*)skel_fwd, hipFuncAttributeMaxDynamicSharedMemorySize, LDS_BYTES) != hipSuccess) { fprintf(stderr, "kernel_launch: hipFuncSetAttribute failed\n"); grid = -1; return; }
        (void)hipGetLastError();
        grid = cus;
    }
    if (grid < 0) return;
    (void)hipMemsetAsync((char*)d_ws + WS_CTL, 0, CTL_ZERO_BYTES, stream);
    Args a{};
    for (int i = 0; i < 32; ++i) a.in[i] = (const float*)d_in[i];
    a.out = (float*)d_out; a.ws = (unsigned char*)d_ws;
#if MK_N_LAUNCHES == 1
    a.ph_lo = 0; a.ph_hi = N_PHASES; a.use_bar = 1;
    hipLaunchKernelGGL(skel_fwd, dim3(grid), dim3(NWAVES * 64), LDS_BYTES, stream, a);
#else
    for (int p = 0; p < N_PHASES; ++p) { a.ph_lo = p; a.ph_hi = p + 1; a.use_bar = 0;
        hipLaunchKernelGGL(skel_fwd, dim3(grid), dim3(NWAVES * 64), LDS_BYTES, stream, a); }
#endif
}
```

```cpp
#include <hip/hip_runtime.h>
#include <cstdio>
#include <cstdint>
#include <cmath>
namespace pg8 {
#define PG8_LAS __attribute__((address_space(3)))
typedef unsigned short bf16_t;
typedef short bf16x8 __attribute__((ext_vector_type(8)));
typedef float f32x4 __attribute__((ext_vector_type(4)));
typedef unsigned u32x4 __attribute__((ext_vector_type(4)));
constexpr int BM = 256, BK = 64, HALF = 128, HTB = HALF * BK * 2  , STAGE_BYTES = 8 * HTB, NXCD = 8, WGM = 8;

__host__ __device__ __forceinline__ int lds_byte(int r, int c) { const int st = (r >> 4) * 2 + (c >> 5), rr = r & 15, cc = c & 31, ob = rr * 64 + cc * 2; return st * 1024 + (ob ^ (((ob >> 9) & 1) << 5)); }
__host__ __device__ __forceinline__ void stage_rc(int b, int& R, int& C) { const int st = b / 1024, sb = b % 1024, swz = sb ^ (((sb >> 9) & 1) << 5); R = (st >> 1) * 16 + swz / 64; C = (st & 1) * 32 + (swz % 64) / 2; }
__host__ __device__ __forceinline__ int perm32(int rho) { const int n = rho >> 4, i = rho & 15; return 8 * (i >> 2) + 4 * n + (i & 3); }

struct Unit { int pm, pn; };
typedef int v4i_t __attribute__((ext_vector_type(4))); typedef int v8i_t __attribute__((ext_vector_type(8)));
struct Gemm { const bf16_t* A; const bf16_t* Bt; int M, N, K; int sca = 0x7f7f7f7f, scb = 0x7f7f7f7f; };

struct StaticOrder {
    int nM, nN, nwg, G, c;
    __host__ __device__ void init(int M, int N, int G_, int c_) { nM = M / BM; nN = N / BM; nwg = nM * nN; G = G_; c = c_; }
    __host__ __device__ bool next(int i, Unit& u) const {
        const long L = (long)i * G + c; if (L >= nwg) return false;
        int wgid = (int)L; { const int q = nwg / NXCD, r = nwg % NXCD, xcd = wgid % NXCD, off = wgid / NXCD; wgid = (xcd < r ? xcd * (q + 1) : r * (q + 1) + (xcd - r) * q) + off; }
        const int nig = WGM * nN, gid = wgid / nig, fm = gid * WGM, gsz = (nM - fm) < WGM ? (nM - fm) : WGM;
        u.pm = fm + ((wgid % nig) % gsz); u.pn = (wgid % nig) / gsz; return true;
    }
    __device__ __forceinline__ void a_ready(const Unit&) const {}
    __device__ __forceinline__ void done(const Unit&) const {}
};

__device__ __forceinline__ unsigned cvt_pk_bf16(float lo, float hi) { unsigned r; asm volatile("v_cvt_pk_bf16_f32 %0, %1, %2" : "=v"(r) : "v"(lo), "v"(hi)); return r; }
typedef float f32x2 __attribute__((ext_vector_type(2)));
__device__ __forceinline__ f32x2 gelu_pk(f32x2 v) {
    const f32x2 av = __builtin_elementwise_abs(v), d = av * 0.2316418882f + 1.0f;
    f32x2 t; t.x = __builtin_amdgcn_rcpf(d.x); t.y = __builtin_amdgcn_rcpf(d.y);
    f32x2 q = t * 0.5307027145f + (-0.7265760135f); q = q * t + 0.7107068705f; q = q * t + (-0.142248368f); q = q * t + 0.127414796f; q = q * t;
    const f32x2 s = (v * v) * (-0.72134752044f);
    f32x2 e; e.x = __builtin_amdgcn_exp2f(s.x); e.y = __builtin_amdgcn_exp2f(s.y);
    const f32x2 m = v * (q * e), r = v - m;
    f32x2 o; o.x = v.x < 0.f ? m.x : r.x; o.y = v.y < 0.f ? m.y : r.y; return o;
}

template <int ACT  > struct EpiBf16 {
    static constexpr bool PERM = true, AFTER_DRAIN = false; static_assert(ACT == 0 || ACT == 1, "EpiBf16: ACT is 0 (none) or 1 (gelu_pk)");
    bf16_t* O; int ldc; const float* bias; int split_cols; size_t split_stride; float scale0;
    __device__ __forceinline__ void operator()(const f32x4 (&acc)[2][2][4][2], const Unit& u, int wr, int wc, int fr, int fq) const {
        const int row0 = u.pm * BM + wr * 64 + fr; int colt = u.pn * BM; bf16_t* base = O;
        float sc = 1.f; if (split_cols) { const int t = colt / split_cols; base += (size_t)t * split_stride; colt -= t * split_cols; if (t == 0) sc = scale0; }
        const int col0 = colt + wc * 32 + 8 * fq, bcol0 = u.pn * BM + wc * 32 + 8 * fq;
        f32x4 bv[2][2];
#pragma unroll
        for (int bj = 0; bj < 2; ++bj)
#pragma unroll
            for (int n = 0; n < 2; ++n) bv[bj][n] = bias ? *(const f32x4*)(bias + bcol0 + bj * HALF + 4 * n) : (f32x4){0.f, 0.f, 0.f, 0.f};
#pragma unroll
        for (int ai = 0; ai < 2; ++ai)
#pragma unroll
            for (int m = 0; m < 4; ++m) { bf16_t* rowp = base + (size_t)(row0 + ai * HALF + m * 16) * ldc + col0;
#pragma unroll
                for (int bj = 0; bj < 2; ++bj) { f32x4 v0 = acc[ai][bj][m][0] + bv[bj][0], v1 = acc[ai][bj][m][1] + bv[bj][1];
                    if (ACT == 1) { f32x2 a = gelu_pk((f32x2){v0[0], v0[1]}), b = gelu_pk((f32x2){v0[2], v0[3]}), c = gelu_pk((f32x2){v1[0], v1[1]}), d = gelu_pk((f32x2){v1[2], v1[3]});
                        v0 = (f32x4){a.x, a.y, b.x, b.y}; v1 = (f32x4){c.x, c.y, d.x, d.y}; }
                    v0 = v0 * sc; v1 = v1 * sc; u32x4 w; w.x = cvt_pk_bf16(v0[0], v0[1]); w.y = cvt_pk_bf16(v0[2], v0[3]); w.z = cvt_pk_bf16(v1[0], v1[1]); w.w = cvt_pk_bf16(v1[2], v1[3]);
                    *(u32x4*)(rowp + bj * HALF) = w; } }
    }
};
template <class E_> struct EpiHasMid { static constexpr bool v = false; };
template <class Epi, class Sched, bool ALIGN_EPI = false, bool SP2 = false, bool FP8 = false>
__device__ __forceinline__ void gemm_phase(PG8_LAS unsigned char* lds, const Gemm g, const Sched& S, const Epi& E) {
    int tid_ = threadIdx.x; asm volatile("" : "+v"(tid_));
    const int tid = tid_, wid = __builtin_amdgcn_readfirstlane(tid >> 6), lane = tid & 63, wr = wid >> 2, wc = wid & 3, fr = lane & 15, fq = lane >> 4;
    const int K = FP8 ? g.K / 2 : g.K, nt = K / BK;
    unsigned voffA[2], voffB[2];
#pragma unroll
    for (int i = 0; i < 2; ++i) { int R, C; stage_rc(tid * 16 + i * 8192, R, C); const int Rb = Epi::PERM ? ((R & ~31) + perm32(R & 31)) : R;
        voffA[i] = (unsigned)(R * K + C) * 2u; voffB[i] = (unsigned)(Rb * K + C) * 2u; }
    const size_t kstep = (size_t)(BK * 2);
    const size_t hstep = (size_t)HALF * K * 2;
    const size_t tstep = 2 * hstep;
    const unsigned ldsw = (unsigned)wid * 1024u;
    const int aoff = FP8 ? lds_byte(wr * 64 + fr, fq * 16) : lds_byte(wr * 64 + fr, fq * 8), boff = FP8 ? lds_byte(wc * 32 + fr, fq * 16) : lds_byte(wc * 32 + fr, fq * 8);
    constexpr int PIECE1 = FP8 ? 16 : 1024; (void)PIECE1;
#define PG8_SA(b, h) (((b) * 2 + (h)) * HTB)
#define PG8_SB(b, h) ((4 + (b) * 2 + (h)) * HTB)
#define PG8_STAGE(bufoff, gbase, voff) do { _Pragma("unroll") for (int _i = 0; _i < 2; ++_i) \
        __builtin_amdgcn_global_load_lds((const unsigned*)((const char*)(gbase) + (voff)[_i]), (PG8_LAS unsigned*)(lds + (bufoff) + ldsw + _i * 8192), 16, 0, 0); } while (0)
#define PG8_LD8(p_) __builtin_shufflevector(*(const PG8_LAS v4i_t*)(p_), *(const PG8_LAS v4i_t*)((p_) + 16), 0, 1, 2, 3, 4, 5, 6, 7)
#define PG8_LDA(dst, b, h) do { if constexpr (FP8) { _Pragma("unroll") for (int m = 0; m < 4; ++m) dst##8[m] = PG8_LD8(lds + PG8_SA(b, h) + aoff + m * 2048); } \
        else { _Pragma("unroll") for (int m = 0; m < 4; ++m) _Pragma("unroll") for (int k = 0; k < 2; ++k) dst[m][k] = *(const PG8_LAS bf16x8*)(lds + PG8_SA(b, h) + aoff + k * 1024 + m * 2048); } } while (0)
#define PG8_LDB(dst, b, h) do { if constexpr (FP8) { _Pragma("unroll") for (int n = 0; n < 2; ++n) dst##8[n] = PG8_LD8(lds + PG8_SB(b, h) + boff + n * 2048); } \
        else { _Pragma("unroll") for (int n = 0; n < 2; ++n) _Pragma("unroll") for (int k = 0; k < 2; ++k) dst[n][k] = *(const PG8_LAS bf16x8*)(lds + PG8_SB(b, h) + boff + k * 1024 + n * 2048); } } while (0)
#define PG8_MMA(ai, bj, At, Bt) do { __builtin_amdgcn_s_setprio(1); \
        if constexpr (FP8) { _Pragma("unroll") for (int m = 0; m < 4; ++m) _Pragma("unroll") for (int n = 0; n < 2; ++n) \
            asm volatile("v_mfma_scale_f32_16x16x128_f8f6f4 %0, %1, %2, %0, %3, %4 op_sel_hi:[0,0,0]" : "+v"(acc[ai][bj][m][n]) : "v"(Bt##8[n]), "v"(At##8[m]), "v"(scb_v), "v"(sca_v)); } \
        else { _Pragma("unroll") for (int m = 0; m < 4; ++m) _Pragma("unroll") for (int n = 0; n < 2; ++n) _Pragma("unroll") for (int k = 0; k < 2; ++k) \
            acc[ai][bj][m][n] = __builtin_amdgcn_mfma_f32_16x16x32_bf16(Bt[n][k], At[m][k], acc[ai][bj][m][n], 0, 0, 0); } __builtin_amdgcn_s_setprio(0); } while (0)
#define PG8_WAIT_V(n) asm volatile("s_waitcnt vmcnt(" #n ")" ::: "memory")
#define PG8_WAIT_L(n) asm volatile("s_waitcnt lgkmcnt(" #n ")" ::: "memory")
#define PG8_BAR __builtin_amdgcn_s_barrier()
#define PG8_SCHED __builtin_amdgcn_sched_barrier(0)
    Unit cur, nxt; int ui = 0;
    if (!S.next(0, cur)) return;
    f32x4 acc[2][2][4][2];
#pragma unroll
    for (int a = 0; a < 2; ++a)
#pragma unroll
        for (int b = 0; b < 2; ++b)
#pragma unroll
            for (int m = 0; m < 4; ++m)
#pragma unroll
                for (int n = 0; n < 2; ++n) acc[a][b][m][n] = (f32x4){0.f, 0.f, 0.f, 0.f};
    const int sca_v = g.sca, scb_v = g.scb;
    bf16x8 At[4][2], B0[2][2], B1[2][2];
    v8i_t At8[4], B08[2], B18[2];
    const char* cA = (const char*)g.A + (size_t)cur.pm * tstep; const char* cB = (const char*)g.Bt + (size_t)cur.pn * tstep;
    S.a_ready(cur);
    if constexpr (SP2) {
        PG8_STAGE(PG8_SB(0, 0), cB, voffB); PG8_STAGE(PG8_SB(0, 1), cB + hstep, voffB); PG8_STAGE(PG8_SA(0, 0), cA, voffA); PG8_STAGE(PG8_SA(0, 1), cA + hstep, voffA);
        if (wr == 1) PG8_BAR;
        PG8_WAIT_V(2); PG8_BAR;
        PG8_STAGE(PG8_SB(1, 0), cB + kstep, voffB); PG8_STAGE(PG8_SA(1, 0), cA + kstep, voffA); PG8_STAGE(PG8_SB(1, 1), cB + hstep + kstep, voffB);
        PG8_WAIT_V(6); PG8_BAR;
    } else {
        PG8_STAGE(PG8_SB(0, 0), cB, voffB); PG8_STAGE(PG8_SA(0, 0), cA, voffA); PG8_STAGE(PG8_SB(0, 1), cB + hstep, voffB); PG8_STAGE(PG8_SA(0, 1), cA + hstep, voffA);
        if (wr == 1) PG8_BAR;
        PG8_WAIT_V(4); PG8_BAR;
        PG8_STAGE(PG8_SB(1, 0), cB + kstep, voffB); PG8_STAGE(PG8_SA(1, 0), cA + kstep, voffA); PG8_STAGE(PG8_SB(1, 1), cB + hstep + kstep, voffB);
        PG8_WAIT_V(6); PG8_BAR;
    }
    for (;;) {
        const bool has_next = S.next(ui + 1, nxt);
        const char* nA = has_next ? (const char*)g.A + (size_t)nxt.pm * tstep : cA; const char* nB = has_next ? (const char*)g.Bt + (size_t)nxt.pn * tstep : cB;
#pragma unroll 1
        for (int t = 0; t < nt; t += 2) {
            if constexpr (EpiHasMid<Epi>::v) { if (t == 8 || t == 16) { PG8_SCHED; E.mid(acc, cur, t, wr, wc, fr, fq); PG8_SCHED; } }
            const bool last = (t == nt - 2);
            const char* a1 = cA + (size_t)(t + 1) * kstep;
            const char* a2 = last ? nA : cA + (size_t)(t + 2) * kstep; const char* b2 = last ? nB : cB + (size_t)(t + 2) * kstep;
            const char* a3 = a2 + kstep; const char* b3 = b2 + kstep;
            if (last && has_next) S.a_ready(nxt);
            if constexpr (SP2) {
            PG8_LDB(B0, 0, 0); PG8_LDB(B1, 0, 1); PG8_SCHED; PG8_LDA(At, 0, 0); PG8_STAGE(PG8_SA(1, 1), a1 + hstep, voffA);
            PG8_WAIT_V(8); PG8_WAIT_L(0); PG8_BAR; PG8_MMA(0, 0, At, B0); PG8_MMA(0, 1, At, B1); PG8_BAR; PG8_SCHED;
            PG8_LDA(At, 0, 1); PG8_STAGE(PG8_SB(0, 0), b2, voffB); PG8_STAGE(PG8_SB(0, 1), b2 + hstep, voffB); PG8_STAGE(PG8_SA(0, 0), a2, voffA);
            PG8_WAIT_V(8); PG8_WAIT_L(0); PG8_BAR; PG8_MMA(1, 0, At, B0); PG8_MMA(1, 1, At, B1); PG8_BAR; PG8_SCHED;
            PG8_LDB(B0, 1, 0); PG8_LDB(B1, 1, 1); PG8_SCHED; PG8_LDA(At, 1, 0); PG8_STAGE(PG8_SA(0, 1), a2 + hstep, voffA);
            PG8_WAIT_V(8); PG8_WAIT_L(0); PG8_BAR; PG8_MMA(0, 0, At, B0); PG8_MMA(0, 1, At, B1); PG8_BAR; PG8_SCHED;
            PG8_LDA(At, 1, 1); PG8_STAGE(PG8_SB(1, 0), b3, voffB); PG8_STAGE(PG8_SB(1, 1), b3 + hstep, voffB); PG8_STAGE(PG8_SA(1, 0), a3, voffA);
            PG8_WAIT_V(8); PG8_WAIT_L(0); PG8_BAR; PG8_MMA(1, 0, At, B0); PG8_MMA(1, 1, At, B1); PG8_BAR; PG8_SCHED;
            } else {
            PG8_LDB(B0, 0, 0); PG8_SCHED; PG8_LDA(At, 0, 0); PG8_STAGE(PG8_SA(1, 1), a1 + hstep, voffA);
            PG8_WAIT_L(8); PG8_BAR; PG8_WAIT_L(0); PG8_MMA(0, 0, At, B0); PG8_BAR; PG8_SCHED;
            PG8_LDB(B1, 0, 1); PG8_STAGE(PG8_SB(0, 0), b2, voffB);
            PG8_BAR; PG8_WAIT_L(0); PG8_MMA(0, 1, At, B1); PG8_BAR;
            PG8_LDA(At, 0, 1); PG8_STAGE(PG8_SA(0, 0), a2, voffA);
            PG8_BAR; PG8_WAIT_L(0); PG8_MMA(1, 0, At, B0); PG8_BAR; PG8_SCHED;
            PG8_STAGE(PG8_SB(0, 1), b2 + hstep, voffB);
            PG8_WAIT_V(6); PG8_BAR; PG8_MMA(1, 1, At, B1); PG8_BAR;
            PG8_LDB(B0, 1, 0); PG8_SCHED; PG8_LDA(At, 1, 0); PG8_STAGE(PG8_SA(0, 1), a2 + hstep, voffA);
            PG8_WAIT_L(8); PG8_BAR; PG8_WAIT_L(0); PG8_MMA(0, 0, At, B0); PG8_BAR; PG8_SCHED;
            PG8_LDB(B1, 1, 1); PG8_STAGE(PG8_SB(1, 0), b3, voffB);
            PG8_BAR; PG8_WAIT_L(0); PG8_MMA(0, 1, At, B1); PG8_BAR;
            PG8_LDA(At, 1, 1); PG8_STAGE(PG8_SA(1, 0), a3, voffA);
            PG8_BAR; PG8_WAIT_L(0); PG8_MMA(1, 0, At, B0); PG8_BAR; PG8_SCHED;
            PG8_STAGE(PG8_SB(1, 1), b3 + hstep, voffB);
            PG8_WAIT_V(6); PG8_BAR; PG8_MMA(1, 1, At, B1); PG8_BAR;
            }
        }
        if constexpr (FP8) { asm volatile("s_nop 15\n\ts_nop 15" ::: "memory"); }
        if constexpr (ALIGN_EPI) { if (wr == 0) PG8_BAR; }
        if constexpr (!Epi::AFTER_DRAIN) { E(acc, cur, wr, wc, fr, fq); S.done(cur); }
        if (!has_next) break;
#pragma unroll
        for (int a = 0; a < 2; ++a)
#pragma unroll
            for (int b = 0; b < 2; ++b)
#pragma unroll
                for (int m = 0; m < 4; ++m)
#pragma unroll
                    for (int n = 0; n < 2; ++n) acc[a][b][m][n] = (f32x4){0.f, 0.f, 0.f, 0.f};
        cur = nxt; cA = nA; cB = nB; ++ui;
        if constexpr (ALIGN_EPI) { if (wr == 1) PG8_BAR; }
    }
    PG8_WAIT_V(0);
    if constexpr (!ALIGN_EPI) { if (wr == 0) PG8_BAR; }
    PG8_BAR;
    if constexpr (Epi::AFTER_DRAIN) { E.fused(acc, cur, wr, wc, fr, fq, lds, wid, lane); S.done(cur); }
#undef PG8_SA
#undef PG8_SB
#undef PG8_STAGE
#undef PG8_LD8
#undef PG8_LDA
#undef PG8_LDB
#undef PG8_MMA
#undef PG8_WAIT_V
#undef PG8_WAIT_L
#undef PG8_BAR
#undef PG8_SCHED
}
}

constexpr int D_MODEL = 1024, BATCH = 2, SEQ = 8192, MTOK = BATCH * SEQ, MEM_LEN = 256, MEMROWS = BATCH * MEM_LEN;
constexpr int IN_COLS = 9984, OFF_AQ = 0, OFF_AK = 1536, OFF_AV = 3072, OFF_R = 4608, OFF_CQ = 6400, OFF_GATE = 6912;
constexpr int RW = 512;
constexpr int N_EXPERTS = 32, TOP_K = 4, D_FF = 1024, MOE_ROWS = 256;
constexpr int MAX_BLOCKS = MTOK * TOP_K / MOE_ROWS + N_EXPERTS;
constexpr int MAX_SLOTS = MAX_BLOCKS * MOE_ROWS;
constexpr float NORM_EPS = 1e-6f, R_GN_EPS = 64e-5f;
constexpr float LOG2E = 1.4426950408889634f;
constexpr float QSCALE = 0.08838834764831845f * LOG2E;

namespace pg8 {
__device__ __forceinline__ float bf_lo(unsigned w) { return __builtin_bit_cast(float, w << 16); }
__device__ __forceinline__ float bf_hi(unsigned w) { return __builtin_bit_cast(float, w & 0xffff0000u); }
__device__ __forceinline__ float sigmoidf_fast(float x) { return 1.0f / (1.0f + __expf(-x)); }

struct EpiZ {
    static constexpr bool PERM = true, AFTER_DRAIN = false;
    bf16_t* O; const float* bgate; const float* aqg; const float* akg; const float* cqg; const float* cs;
    PG8_LAS float* P;
    int ldc, mode;
    __device__ __forceinline__ void operator()(const f32x4 (&acc)[2][2][4][2], const Unit& u, int wr, int wc, int fr, int fq) const {
        const int row0 = u.pm * BM + wr * 64 + fr, col0 = u.pn * BM + wc * 32 + 8 * fq;
        const int cls = mode ? ((u.pn < 2) ? 3 : 0) : (u.pn < 6) ? 1 : (u.pn < 12) ? 2 : (u.pn == 25 || u.pn == 26) ? 3 : (u.pn >= 27) ? 4 : 0;
        if (cls >= 1 && cls <= 3) {
            const int go = wc * 32 + 8 * fq;
            const f32x4 q0 = *(const f32x4*)(aqg + go), q1 = *(const f32x4*)(aqg + go + 4), k0 = *(const f32x4*)(akg + go), k1 = *(const f32x4*)(akg + go + 4), x0 = *(const f32x4*)(cqg + go), x1 = *(const f32x4*)(cqg + go + 4);
            const f32x4 g0 = (cls == 1) ? q0 : (cls == 2) ? k0 : x0, g1 = (cls == 1) ? q1 : (cls == 2) ? k1 : x1;
#pragma unroll
            for (int ai = 0; ai < 2; ++ai)
#pragma unroll
                for (int m = 0; m < 4; ++m)
#pragma unroll
                    for (int bj = 0; bj < 2; ++bj) { const f32x4 a = acc[ai][bj][m][0], b = acc[ai][bj][m][1];
                        float s = ((a[0] * a[0] + a[1] * a[1]) + (a[2] * a[2] + a[3] * a[3])) + ((b[0] * b[0] + b[1] * b[1]) + (b[2] * b[2] + b[3] * b[3]));
                        s += __shfl_xor(s, 16); s += __shfl_xor(s, 32);
                        if (fq == 0) P[((ai * HALF + wr * 64 + m * 16 + fr) * 2 + bj) * 4 + wc] = s; }
            asm volatile("s_waitcnt lgkmcnt(0)" ::: "memory"); __builtin_amdgcn_s_barrier(); asm volatile("" ::: "memory");
#pragma unroll
            for (int ai = 0; ai < 2; ++ai)
#pragma unroll
                for (int m = 0; m < 4; ++m) { const int rl = ai * HALF + wr * 64 + m * 16 + fr, row = u.pm * BM + rl;
                    f32x4 c0 = {0.f, 0.f, 0.f, 0.f}, c1 = c0, c2 = c0, c3 = c0;
                    if (cls != 3 && wc == 0) { const f32x4* cp = (const f32x4*)(cs + (size_t)row * 32 + 16 * (fq & 1)); c0 = cp[0]; c1 = cp[1]; c2 = cp[2]; c3 = cp[3]; }
#pragma unroll
                    for (int bj = 0; bj < 2; ++bj) { const f32x4 pv = *(const PG8_LAS f32x4*)(P + (rl * 2 + bj) * 4);
                        const float rstd = 1.0f / sqrtf(((pv[0] + pv[1]) + (pv[2] + pv[3])) * (1.0f / 128.0f) + NORM_EPS);
                        f32x4 v0 = acc[ai][bj][m][0] * rstd * g0, v1 = acc[ai][bj][m][1] * rstd * g1;
                        if (cls != 3 && wc == 0) {
                            f32x4 p0, p1;
#pragma unroll
                            for (int j = 0; j < 4; ++j) { p0[j] = __shfl_xor(v0[j], 32); p1[j] = __shfl_xor(v1[j], 32); }
                            const float sg = (fq < 2) ? -1.0f : 1.0f;
                            v0[0] = v0[0] * c0[0] + sg * p0[0] * c0[1]; v0[1] = v0[1] * c0[2] + sg * p0[1] * c0[3]; v0[2] = v0[2] * c1[0] + sg * p0[2] * c1[1]; v0[3] = v0[3] * c1[2] + sg * p0[3] * c1[3];
                            v1[0] = v1[0] * c2[0] + sg * p1[0] * c2[1]; v1[1] = v1[1] * c2[2] + sg * p1[1] * c2[3]; v1[2] = v1[2] * c3[0] + sg * p1[2] * c3[1]; v1[3] = v1[3] * c3[2] + sg * p1[3] * c3[3]; }
                        u32x4 w; w.x = cvt_pk_bf16(v0[0], v0[1]); w.y = cvt_pk_bf16(v0[2], v0[3]); w.z = cvt_pk_bf16(v1[0], v1[1]); w.w = cvt_pk_bf16(v1[2], v1[3]);
                        *(u32x4*)(O + (size_t)row * ldc + col0 + bj * HALF) = w; } }
            return;
        }
        const bool gate = cls == 4;
        f32x4 bv[2][2];
#pragma unroll
        for (int bj = 0; bj < 2; ++bj)
#pragma unroll
            for (int n = 0; n < 2; ++n) bv[bj][n] = gate ? *(const f32x4*)(bgate + (col0 - OFF_GATE) + bj * HALF + 4 * n) : (f32x4){0.f, 0.f, 0.f, 0.f};
#pragma unroll
        for (int ai = 0; ai < 2; ++ai)
#pragma unroll
            for (int m = 0; m < 4; ++m) { bf16_t* rowp = O + (size_t)(row0 + ai * HALF + m * 16) * ldc + col0;
#pragma unroll
                for (int bj = 0; bj < 2; ++bj) { f32x4 v0 = acc[ai][bj][m][0] + bv[bj][0], v1 = acc[ai][bj][m][1] + bv[bj][1];
                    if (gate) {
#pragma unroll
                        for (int j = 0; j < 4; ++j) { v0[j] = sigmoidf_fast(v0[j]); v1[j] = sigmoidf_fast(v1[j]); } }
                    u32x4 w; w.x = cvt_pk_bf16(v0[0], v0[1]); w.y = cvt_pk_bf16(v0[2], v0[3]); w.z = cvt_pk_bf16(v1[0], v1[1]); w.w = cvt_pk_bf16(v1[2], v1[3]);
                    *(u32x4*)(rowp + bj * HALF) = w; } }
    }
};
struct EpiGate3 {
    static constexpr bool PERM = true, AFTER_DRAIN = false;
    const bf16_t* Z; bf16_t* mergedb;
    __device__ __forceinline__ void mid(f32x4 (&acc)[2][2][4][2], const Unit& u, int t, int wr, int wc, int fr, int fq) const {
        int fr_ = fr; asm volatile("" : "+v"(fr_));
        const int row0 = u.pm * BM + wr * 64 + fr_, col0 = u.pn * BM + wc * 32 + 8 * fq, ba = (t >> 3) - 1;
        const bf16_t* gp = Z + OFF_GATE + ba * D_MODEL + col0;
#pragma unroll
        for (int ai = 0; ai < 2; ++ai)
#pragma unroll
            for (int m = 0; m < 4; ++m) { const bf16_t* rp = gp + (size_t)(row0 + ai * HALF + m * 16) * IN_COLS;
#pragma unroll
                for (int bj = 0; bj < 2; ++bj) { const u32x4 ga = *(const u32x4*)(rp + bj * HALF), gb = *(const u32x4*)(rp + D_MODEL + bj * HALF);
                    f32x4 r0, r1;
                    r0[0] = bf_lo(ga[0]) * __builtin_amdgcn_rcpf(bf_lo(gb[0])); r0[1] = bf_hi(ga[0]) * __builtin_amdgcn_rcpf(bf_hi(gb[0])); r0[2] = bf_lo(ga[1]) * __builtin_amdgcn_rcpf(bf_lo(gb[1])); r0[3] = bf_hi(ga[1]) * __builtin_amdgcn_rcpf(bf_hi(gb[1]));
                    r1[0] = bf_lo(ga[2]) * __builtin_amdgcn_rcpf(bf_lo(gb[2])); r1[1] = bf_hi(ga[2]) * __builtin_amdgcn_rcpf(bf_hi(gb[2])); r1[2] = bf_lo(ga[3]) * __builtin_amdgcn_rcpf(bf_lo(gb[3])); r1[3] = bf_hi(ga[3]) * __builtin_amdgcn_rcpf(bf_hi(gb[3]));
                    acc[ai][bj][m][0] *= r0; acc[ai][bj][m][1] *= r1; }
                if (m == 3) asm volatile("" ::: "memory"); }
    }
    __device__ __forceinline__ void operator()(const f32x4 (&acc)[2][2][4][2], const Unit& u, int wr, int wc, int fr, int fq) const {
        const int row0 = u.pm * BM + wr * 64 + fr, col0 = u.pn * BM + wc * 32 + 8 * fq;
#pragma unroll
        for (int ai = 0; ai < 2; ++ai)
#pragma unroll
            for (int m = 0; m < 4; ++m) { const int row = row0 + ai * HALF + m * 16;
#pragma unroll
                for (int bj = 0; bj < 2; ++bj) { const int col = col0 + bj * HALF;
                    const u32x4 gz = *(const u32x4*)(Z + (size_t)row * IN_COLS + OFF_GATE + 2 * D_MODEL + col);
                    f32x4 g0, g1;
                    g0[0] = bf_lo(gz[0]); g0[1] = bf_hi(gz[0]); g0[2] = bf_lo(gz[1]); g0[3] = bf_hi(gz[1]); g1[0] = bf_lo(gz[2]); g1[1] = bf_hi(gz[2]); g1[2] = bf_lo(gz[3]); g1[3] = bf_hi(gz[3]);
                    const f32x4 v0 = acc[ai][bj][m][0] * g0, v1 = acc[ai][bj][m][1] * g1;
                    u32x4 w; w.x = cvt_pk_bf16(v0[0], v0[1]); w.y = cvt_pk_bf16(v0[2], v0[3]); w.z = cvt_pk_bf16(v1[0], v1[1]); w.w = cvt_pk_bf16(v1[2], v1[3]);
                    *(u32x4*)(mergedb + (size_t)row * D_MODEL + col) = w; } }
    }
};
template <> struct EpiHasMid<EpiGate3> { static constexpr bool v = true; };
struct EpiResF32 {
    static constexpr bool PERM = true, AFTER_DRAIN = false;
    const float* base; float* out; int ldc;
    __device__ __forceinline__ void operator()(const f32x4 (&acc)[2][2][4][2], const Unit& u, int wr, int wc, int fr, int fq) const {
        const int row0 = u.pm * BM + wr * 64 + fr, col0 = u.pn * BM + wc * 32 + 8 * fq;
#pragma unroll
        for (int ai = 0; ai < 2; ++ai)
#pragma unroll
            for (int m = 0; m < 4; ++m) { const size_t off = (size_t)(row0 + ai * HALF + m * 16) * ldc + col0;
#pragma unroll
                for (int bj = 0; bj < 2; ++bj) { const float* bp = base + off + bj * HALF; float* op = out + off + bj * HALF;
                    const f32x4 x0 = *(const f32x4*)bp, x1 = *(const f32x4*)(bp + 4);
                    *(f32x4*)op = x0 + acc[ai][bj][m][0]; *(f32x4*)(op + 4) = x1 + acc[ai][bj][m][1]; } }
    }
};
struct EpiSwiGLU {
    static constexpr bool PERM = true, AFTER_DRAIN = false;
    const float* b1; bf16_t* H;
    __device__ __forceinline__ void operator()(const f32x4 (&acc)[2][2][4][2], const Unit& u, int wr, int wc, int fr, int fq) const {
        const int e = u.pn >> 3, pnl = u.pn & 7;
        const int row0 = u.pm * BM + wr * 64 + fr, ac = pnl * HALF + wc * 32 + 8 * fq;
        const float* bg = b1 + (size_t)e * 2 * D_FF + ac; const float* bl = bg + D_FF;
        const f32x4 bg0 = *(const f32x4*)bg, bg1 = *(const f32x4*)(bg + 4), bl0 = *(const f32x4*)bl, bl1 = *(const f32x4*)(bl + 4);
#pragma unroll
        for (int ai = 0; ai < 2; ++ai)
#pragma unroll
            for (int m = 0; m < 4; ++m) { const int row = row0 + ai * HALF + m * 16;
                float a[8];
#pragma unroll
                for (int n = 0; n < 2; ++n) { const f32x4 ug = acc[ai][0][m][n] + (n ? bg1 : bg0), ul = acc[ai][1][m][n] + (n ? bl1 : bl0);
#pragma unroll
                    for (int j = 0; j < 4; ++j) { const float g = fminf(ug[j], 7.0f), l = fminf(fmaxf(ul[j], -7.0f), 7.0f);
                        a[4 * n + j] = g * sigmoidf_fast(1.702f * g) * (l + 1.0f); } }
                unsigned w0 = 0, w1 = 0;
                w0 = __builtin_amdgcn_cvt_pk_fp8_f32(a[0] * 8.0f, a[1] * 8.0f, w0, false); w0 = __builtin_amdgcn_cvt_pk_fp8_f32(a[2] * 8.0f, a[3] * 8.0f, w0, true);
                w1 = __builtin_amdgcn_cvt_pk_fp8_f32(a[4] * 8.0f, a[5] * 8.0f, w1, false); w1 = __builtin_amdgcn_cvt_pk_fp8_f32(a[6] * 8.0f, a[7] * 8.0f, w1, true);
                *(unsigned long long*)((unsigned char*)H + (size_t)row * D_FF + ac) = (unsigned long long)w0 | ((unsigned long long)w1 << 32); }
    }
};
struct EpiMoeOut {
    static constexpr bool PERM = true, AFTER_DRAIN = false;
    const float* b2; const float* rowgate; bf16_t* Y;
    __device__ __forceinline__ void operator()(const f32x4 (&acc)[2][2][4][2], const Unit& u, int wr, int wc, int fr, int fq) const {
        const int e = u.pn >> 2, pnl = u.pn & 3;
        const int row0 = u.pm * BM + wr * 64 + fr, col0 = pnl * BM + wc * 32 + 8 * fq;
#pragma unroll
        for (int ai = 0; ai < 2; ++ai)
#pragma unroll
            for (int m = 0; m < 4; ++m) { const int row = row0 + ai * HALF + m * 16; const float gt = rowgate[row];
#pragma unroll
                for (int bj = 0; bj < 2; ++bj) { const int col = col0 + bj * HALF; const float* bp = b2 + (size_t)e * D_MODEL + col;
                    const f32x4 v0 = (acc[ai][bj][m][0] + *(const f32x4*)bp) * gt, v1 = (acc[ai][bj][m][1] + *(const f32x4*)(bp + 4)) * gt;
                    u32x4 w; w.x = cvt_pk_bf16(v0[0], v0[1]); w.y = cvt_pk_bf16(v0[2], v0[3]); w.z = cvt_pk_bf16(v1[0], v1[1]); w.w = cvt_pk_bf16(v1[2], v1[3]);
                    *(u32x4*)(Y + (size_t)row * D_MODEL + col) = w; } }
    }
};
struct MoeOrder {
    const PG8_LAS int* tab;
    int NT, G, c;
    __device__ __forceinline__ bool next(int i, Unit& u) const {
        const int nblk = tab[0]; const long L = (long)i * G + c; if (L >= (long)nblk * NT) return false;
        const int blk = (int)(L / NT), pnl = (int)(L % NT); u.pm = blk; u.pn = tab[1 + blk] * NT + pnl; return true;
    }
    __device__ __forceinline__ void a_ready(const Unit&) const {}
    __device__ __forceinline__ void done(const Unit&) const {}
};
}

namespace swa {
constexpr int D = 128;
constexpr float SCALE = 0.08838834764831845f;
constexpr float THR = 8.f;
constexpr int NW = 8, QBLK = 32, KVBLK = 64, QB = NW * QBLK;
constexpr int SHM_V = KVBLK * D * 2, SHM_K = KVBLK * D * 2;
constexpr int LDS_BYTES = 2 * SHM_V + 2 * SHM_K + NW * 64 * 4;
using bf16 = unsigned short;
typedef short bf16x8 __attribute__((ext_vector_type(8)));
typedef short s16x4 __attribute__((ext_vector_type(4)));
typedef float f32x16 __attribute__((ext_vector_type(16)));
typedef float f32x4 __attribute__((ext_vector_type(4)));
typedef unsigned u32x4 __attribute__((ext_vector_type(4)));
template <class A, class Bt> struct same_t { static constexpr bool v = false; };
template <class A> struct same_t<A, A> { static constexpr bool v = true; };
#define KSWZ(row, colB) ((row) * 256 + ((colB) ^ (((row) & 7) << 4)))
#define SBAR() __builtin_amdgcn_sched_barrier(0)
__device__ __forceinline__ int v_st(int k, int c) { const int kk = (k & ~0xC) | ((k & 4) << 1) | ((k & 8) >> 1); return ((kk >> 3) * 4 + (c >> 5)) * 512 + ((kk & 7) * 32 + (c & 31)) * 2; }
__device__ __forceinline__ int v_rd_base(int lane) { return ((lane & 3) << 3) | (((lane >> 2) & 3) << 6) | (((lane >> 4) & 1) << 5) | (((lane >> 5) & 1) << 8); }
constexpr int v_rd_off(int d0, int ks, int half) { return d0 * 512 + ks * 4096 + half * 2048; }
__device__ __forceinline__ int crow(int r, int hi) { return (r & 3) + 8 * (r >> 2) + 4 * hi; }
__device__ __forceinline__ unsigned cvtpk(float lo, float hi) {
    unsigned r; asm volatile("v_cvt_pk_bf16_f32 %0, %1, %2" : "=v"(r) : "v"(lo), "v"(hi)); return r;
}
__device__ __forceinline__ bf16x8 pack8(f32x4 a, f32x4 b) {
    u32x4 w = {cvtpk(a[0], a[1]), cvtpk(a[2], a[3]), cvtpk(b[0], b[1]), cvtpk(b[2], b[3])};
    return *reinterpret_cast<bf16x8*>(&w);
}
template <class T> __device__ __forceinline__ bf16x8 load8(const T* p) {
    if constexpr (same_t<T, float>::v) { return pack8(*(const f32x4*)p, *(const f32x4*)(p + 4)); }
    else { return *reinterpret_cast<const bf16x8*>(p); }
}
__device__ __forceinline__ void mask_tile(f32x16& p0, f32x16& p1, int dq, unsigned W) {
    const float NEG = -__builtin_inff();
#pragma unroll
    for (int r = 0; r < 16; ++r) {
        const int c = (r & 3) + 8 * (r >> 2);
        if ((unsigned)(dq - c) >= W) p0[r] = NEG;
        if ((unsigned)(dq - c - 32) >= W) p1[r] = NEG;
    }
}
__device__ __forceinline__ void partialSM(f32x16& p0, f32x16& p1, float& m_reg, float& mn, float& alpha) {
    float pmax = p0[0]; for (int r = 1; r < 16; ++r) pmax = fmaxf(pmax, p0[r]); for (int r = 0; r < 16; ++r) pmax = fmaxf(pmax, p1[r]);
    { auto rr = __builtin_amdgcn_permlane32_swap(__float_as_uint(pmax), __float_as_uint(pmax), false, false);
      pmax = fmaxf(__uint_as_float(rr[0]), __uint_as_float(rr[1])); }
    constexpr float C2 = 1.4426950408889634f * SCALE;
    if (__builtin_expect(__all((pmax - m_reg) * SCALE <= THR), 1)) { mn = m_reg; alpha = 1.f; }
    else { mn = fmaxf(m_reg, pmax); alpha = __builtin_amdgcn_exp2f((m_reg - mn) * C2); m_reg = mn; }
    const float mnL = -mn * C2;
    for (int r = 0; r < 16; ++r) p0[r] = fmaf(p0[r], C2, mnL); for (int r = 0; r < 16; ++r) p1[r] = fmaf(p1[r], C2, mnL);
    for (int r = 0; r < 16; ++r) p0[r] = __builtin_amdgcn_exp2f(p0[r]);
}
__device__ __forceinline__ void finishSM(f32x16& p0, f32x16& p1, float alpha, float& l_reg, bf16x8& pa0, bf16x8& pa1, bf16x8& pa2, bf16x8& pa3) {
    for (int r = 0; r < 16; ++r) p1[r] = __builtin_amdgcn_exp2f(p1[r]);
    float ps = 0; for (int r = 0; r < 16; ++r) ps += p0[r]; for (int r = 0; r < 16; ++r) ps += p1[r];
    { auto rr = __builtin_amdgcn_permlane32_swap(__float_as_uint(ps), __float_as_uint(ps), false, false);
      ps = __uint_as_float(rr[0]) + __uint_as_float(rr[1]); }
    l_reg = l_reg * alpha + ps;
#define PK4(P, B_, OUT) do { unsigned a0 = cvtpk(P[B_+0], P[B_+1]), a1 = cvtpk(P[B_+2], P[B_+3]);                          \
        unsigned b0 = cvtpk(P[B_+4], P[B_+5]), b1 = cvtpk(P[B_+6], P[B_+7]);                                             \
        auto r0 = __builtin_amdgcn_permlane32_swap(a0, b0, false, false); auto r1 = __builtin_amdgcn_permlane32_swap(a1, b1, false, false); \
        u32x4 w = {r0[0], r1[0], r0[1], r1[1]}; OUT = *reinterpret_cast<bf16x8*>(&w); } while (0)
    PK4(p0, 0, pa0); PK4(p0, 8, pa1); PK4(p1, 0, pa2); PK4(p1, 8, pa3);
#undef PK4
}
template <int KB, bool SK>
__device__ __forceinline__ void qkt(f32x16& p0, f32x16& p1, const char* K_lds, int r32, int hi, const bf16x8* qr, bool act) {
    if (SK && !act) { const float NEG = -__builtin_inff();
#pragma unroll
        for (int r = 0; r < 16; ++r) { p0[r] = NEG; p1[r] = NEG; } return; }
    p0 = f32x16{}; p1 = f32x16{};
    const char* kb[4];
#pragma unroll
    for (int dd = 0; dd < 4; ++dd) kb[dd] = K_lds + KB * SHM_K + KSWZ(r32, (dd * 16 + hi * 8) * 2);
#pragma unroll
    for (int d0 = 0; d0 < 8; ++d0) { const char* a = kb[d0 & 3] + (d0 >> 2) * 128;
        bf16x8 b0 = *reinterpret_cast<const bf16x8*>(a);
        bf16x8 b1 = *reinterpret_cast<const bf16x8*>(a + 32 * 256);
        p0 = __builtin_amdgcn_mfma_f32_32x32x16_bf16(b0, qr[d0], p0, 0, 0, 0);
        p1 = __builtin_amdgcn_mfma_f32_32x32x16_bf16(b1, qr[d0], p1, 0, 0, 0); }
}
template <int VB, bool SK>
__device__ __forceinline__ void pv_tile(f32x16* o, int vb0, bf16x8 pa0, bf16x8 pa1, bf16x8 pa2, bf16x8 pa3, bool act) {
    if (SK && !act) return;
#define TRRD(dst, off) asm volatile("ds_read_b64_tr_b16 %0, %1 offset:%2" : "=&v"(dst) : "v"(vb0), "i"(off) : "memory")
#define PV_D0(d0) do { s16x4 l0, l1, l2, l3, h0, h1, h2, h3; constexpr int b_ = VB * SHM_V + v_rd_off(d0, 0, 0);     \
        TRRD(l0, b_); TRRD(h0, b_ + 2048); TRRD(l1, b_ + 4096); TRRD(h1, b_ + 6144); TRRD(l2, b_ + 8192); TRRD(h2, b_ + 10240); TRRD(l3, b_ + 12288); TRRD(h3, b_ + 14336); \
        asm volatile("s_waitcnt lgkmcnt(0)" ::: "memory"); SBAR();                 \
        o[d0] = __builtin_amdgcn_mfma_f32_32x32x16_bf16(pa0, (bf16x8){l0[0], l0[1], l0[2], l0[3], h0[0], h0[1], h0[2], h0[3]}, o[d0], 0, 0, 0);   \
        o[d0] = __builtin_amdgcn_mfma_f32_32x32x16_bf16(pa1, (bf16x8){l1[0], l1[1], l1[2], l1[3], h1[0], h1[1], h1[2], h1[3]}, o[d0], 0, 0, 0);   \
        o[d0] = __builtin_amdgcn_mfma_f32_32x32x16_bf16(pa2, (bf16x8){l2[0], l2[1], l2[2], l2[3], h2[0], h2[1], h2[2], h2[3]}, o[d0], 0, 0, 0);   \
        o[d0] = __builtin_amdgcn_mfma_f32_32x32x16_bf16(pa3, (bf16x8){l3[0], l3[1], l3[2], l3[3], h3[0], h3[1], h3[2], h3[3]}, o[d0], 0, 0, 0); } while (0)
    PV_D0(0); PV_D0(1); PV_D0(2); PV_D0(3);
#undef PV_D0
#undef TRRD
}

struct BlockRef { const bf16* Q; const bf16* K; const bf16* V; bf16* O; float* LSE; int QS, KS, OS, LS, P0, skv, W; };
struct Seam { bf16x8 qr[8]; bf16x8 st_v0, st_v1, st_k0, st_k1; };
__device__ __forceinline__ int swa_jlo(int P0, int W) { const int lowk = P0 - W + 1; return lowk > 0 ? lowk / KVBLK : 0; }
#define LD8(p) (*reinterpret_cast<const bf16x8*>(p))
#define ROW(p, k0, rr, RS) ((p) + (size_t)((k0) + (rr)) * (RS) + sc)
#define VMW() asm volatile("s_waitcnt vmcnt(0)" ::: "memory")
#define VMWN(n) asm volatile("s_waitcnt vmcnt(%0)" :: "i"(n) : "memory")
#define SLOAD_H(Kp, Vp, k0, RS) do { const char* kb_ = (const char*)(Kp) + (size_t)(k0) * (size_t)(RS) * 2; const char* vb_ = (const char*)(Vp) + (size_t)(k0) * (size_t)(RS) * 2;  \
                         const unsigned oa_ = (unsigned)(sr * (RS) + sc) * 2u, ob_ = oa_ + (unsigned)(RS) * 64u;                                    \
                         S.st_v0 = LD8(vb_ + oa_); S.st_v1 = LD8(vb_ + ob_); S.st_k0 = LD8(kb_ + oa_); S.st_k1 = LD8(kb_ + ob_); } while (0)
#define SWRITE_HK(bf) do { *(bf16x8*)(K_lds + (bf) * SHM_K + kws) = S.st_k0; *(bf16x8*)(K_lds + (bf) * SHM_K + kws + 32 * 256) = S.st_k1; } while (0)
#define SWRITE_HV(bf) do { *(bf16x8*)(V_lds + (bf) * SHM_V + vst0) = S.st_v0; *(bf16x8*)(V_lds + (bf) * SHM_V + vst1) = S.st_v1; } while (0)
#define SWRITE_H(bf) do { SWRITE_HV(bf); SWRITE_HK(bf); } while (0)
__device__ __forceinline__ void swa_prime(const BlockRef& cur, char* lds, Seam& S) {
    int tid_ = threadIdx.x; asm volatile("" : "+v"(tid_));
    const int tid = tid_, wid = __builtin_amdgcn_readfirstlane(tid >> 6), lane = tid & 63, r32 = lane & 31, hi = lane >> 5;
    const int sr = tid >> 4, sc = (tid & 15) * 8, kws = KSWZ(sr, sc * 2); char* K_lds = lds + 2 * SHM_V;
    const int kb0 = swa_jlo(cur.P0, cur.W) * KVBLK;
    { const char* qb_ = (const char*)cur.Q + (size_t)(wid * QBLK) * (size_t)cur.QS * 2; const unsigned qo_ = (unsigned)(r32 * cur.QS + hi * 8) * 2u;
      for (int d0 = 0; d0 < 8; ++d0) S.qr[d0] = LD8(qb_ + qo_ + d0 * 32); }
    SLOAD_H(cur.K, cur.V, kb0, cur.KS); VMW(); SWRITE_HK(0);
    __syncthreads();
}
__device__ __forceinline__ void swa_block(const BlockRef& cur, const BlockRef& nxt, char* lds, Seam& S) {
    int tid_ = threadIdx.x; asm volatile("" : "+v"(tid_));
    const int tid = tid_, wid = __builtin_amdgcn_readfirstlane(tid >> 6), lane = tid & 63, r32 = lane & 31, hi = lane >> 5;
    const int W = cur.W, skv = cur.skv;
    const int j_lo = swa_jlo(cur.P0, W);
    int j_hi = (cur.P0 + QB - 1) / KVBLK + 1; if (j_hi > skv / KVBLK) j_hi = skv / KVBLK;
    const int NT = j_hi - j_lo;
    const int kbn = swa_jlo(nxt.P0, nxt.W) * KVBLK;
    const int qlo = cur.P0 + wid * QBLK, qm = qlo + r32 - 4 * hi;
    char* V_lds = lds; char* K_lds = lds + 2 * SHM_V;
    float* ws = (float*)(lds + 2 * SHM_V + 2 * SHM_K) + wid * 64; float* li_l = ws, * al_l = ws + 32;
    float m_reg = -1e30f, l_reg = 0; f32x16 o[4] = {};
    const int sr = tid >> 4, sc = (tid & 15) * 8, vst0 = v_st(sr, sc), vst1 = v_st(32 + sr, sc), kws = KSWZ(sr, sc * 2);
    const int vb0 = (int)(uintptr_t)V_lds + v_rd_base(lane);
    const bf16* Kh = cur.K; const bf16* Vh = cur.V; const int KSc = cur.KS;
#define RESC(a) do { if (__any((a) < 1.f)) { if (hi == 0) al_l[r32] = (a); asm volatile("s_waitcnt lgkmcnt(0)" ::: "memory");              \
                     for (int d_ = 0; d_ < 4; ++d_) for (int r = 0; r < 16; ++r) o[d_][r] *= al_l[crow(r, hi)]; } } while (0)
#define KBASE(t) ((j_lo + (t)) * KVBLK)
#define ACT(t) (KBASE(t) <= qlo + QBLK - 1 && KBASE(t) + KVBLK - 1 >= qlo - W + 1)
#define MASKT(P0_, P1_, t) do { const int kb_ = KBASE(t); if ((!SK || ACT(t)) && (kb_ + KVBLK - 1 > qlo || kb_ <= qlo + QBLK - 1 - W)) mask_tile(P0_, P1_, qm - kb_, (unsigned)W); } while (0)
    constexpr int NQL = 8;
    constexpr bool SK = true;
#define SEAM_K0() do { VMWN(NQL); SWRITE_HK(0); SBAR(); } while (0)
    f32x16 pA0, pA1, pB0, pB1; float mnA, mnB, alA, alB; bf16x8 pa0, pa1, pa2, pa3;
    SWRITE_HV(0); SBAR();
    if (NT > 1) { SLOAD_H(Kh, Vh, KBASE(1), KSc); }
    SBAR(); qkt<0, SK>(pA0, pA1, K_lds, r32, hi, S.qr, ACT(0));
    MASKT(pA0, pA1, 0); partialSM(pA0, pA1, m_reg, mnA, alA);
    if (NT > 1) { VMW(); SWRITE_H(1); }
    __syncthreads();
#define HALF_STEP(PX0, PX1, mnX, alX, PY0, PY1, alY, t, KB, VB, SB) do {                                                      \
        SBAR(); qkt<KB, SK>(PX0, PX1, K_lds, r32, hi, S.qr, ACT(t));                                             \
        finishSM(PY0, PY1, alY, l_reg, pa0, pa1, pa2, pa3); SBAR();                                                           \
        if ((t) + 1 < NT) { SLOAD_H(Kh, Vh, KBASE((t) + 1), KSc); SBAR(); }                                               \
        pv_tile<VB, SK>(o, vb0, pa0, pa1, pa2, pa3, ACT((t) - 1)); MASKT(PX0, PX1, (t)); partialSM(PX0, PX1, m_reg, mnX, alX);                                        \
        __syncthreads();                                                                                                      \
        if ((t) + 1 < NT) { VMW(); SWRITE_H(SB); }                                                                          \
        RESC(alX); __syncthreads(); } while (0)
    for (int t = 1; t + 1 < NT; t += 2) {
        HALF_STEP(pB0, pB1, mnB, alB, pA0, pA1, alA, t, 1, 0, 0);
        HALF_STEP(pA0, pA1, mnA, alA, pB0, pB1, alB, t + 1, 0, 1, 1);
    }
    const bool even = (NT & 1) == 0;
    if (even) { SBAR(); qkt<1, SK>(pB0, pB1, K_lds, r32, hi, S.qr, ACT(NT - 1)); SBAR(); }
    { SLOAD_H(nxt.K, nxt.V, kbn, nxt.KS); SBAR();
      const char* qb_ = (const char*)nxt.Q + (size_t)(wid * QBLK) * (size_t)nxt.QS * 2; const unsigned qo_ = (unsigned)(r32 * nxt.QS + hi * 8) * 2u;
#pragma unroll
        for (int d0 = 0; d0 < 8; ++d0) S.qr[d0] = LD8(qb_ + qo_ + d0 * 32); }
    SBAR();
    finishSM(pA0, pA1, alA, l_reg, pa0, pa1, pa2, pa3); SBAR();
    pv_tile<0, SK>(o, vb0, pa0, pa1, pa2, pa3, ACT(even ? NT - 2 : NT - 1));
    if (even) { MASKT(pB0, pB1, NT - 1); partialSM(pB0, pB1, m_reg, mnB, alB); __syncthreads(); RESC(alB);
        finishSM(pB0, pB1, alB, l_reg, pa0, pa1, pa2, pa3); SBAR(); pv_tile<1, SK>(o, vb0, pa0, pa1, pa2, pa3, ACT(NT - 1)); }
    SBAR(); SEAM_K0();
    if (hi == 0) li_l[r32] = l_reg; asm volatile("s_waitcnt lgkmcnt(0)" ::: "memory");
    if (cur.LSE != nullptr && hi == 0) cur.LSE[(size_t)(wid * QBLK + r32) * cur.LS] = __log2f(l_reg) + m_reg * (1.4426950408889634f * SCALE);
    float rli[16];
#pragma unroll
    for (int r = 0; r < 16; ++r) rli[r] = __builtin_amdgcn_rcpf(li_l[crow(r, hi)]);
    bf16* Ow = cur.O + (size_t)(wid * QBLK) * cur.OS;
#pragma unroll
    for (int r = 0; r < 16; ++r) { const int orow = crow(r, hi);
#pragma unroll
        for (int d0 = 0; d0 < 4; ++d0) { const float v = o[d0][r] * rli[r];
            const float vn = __shfl_xor(v, 1);
            if ((r32 & 1) == 0) *(unsigned*)(Ow + (size_t)orow * cur.OS + d0 * 32 + r32) = cvtpk(v, vn); } }
    __syncthreads();
#undef RESC
#undef KBASE
#undef ACT
#undef MASKT
#undef SEAM_K0
#undef HALF_STEP
}
#undef LD8
#undef ROW
#undef VMW
#undef VMWN
#undef SLOAD_H
#undef SWRITE_HK
#undef SWRITE_HV
#undef SWRITE_H
#undef KSWZ
#undef SBAR
}

constexpr int NWAVES = 8;
#ifndef MK_N_LAUNCHES
#define MK_N_LAUNCHES 1
#endif
constexpr int N_PHASES = 13;
constexpr float W8_SCALE = 32.0f, H8_SCALE = 8.0f;
constexpr int SC_ONE = 0x7f7f7f7f, SC_W8 = 0x7a7a7a7a  , SC_H8 = 0x7c7c7c7c  ;
#ifndef NAIVE_ATTN
#define NAIVE_ATTN 0
#endif
constexpr float ATT_QSCALE = NAIVE_ATTN ? QSCALE : 1.0f;

constexpr size_t MiB = 1u << 20;
constexpr size_t WS_CTL = 0, CTL_ZERO_BYTES = 1 * MiB;
constexpr size_t WS_WIN = 2 * MiB;
constexpr size_t WS_WB = 22 * MiB;
constexpr size_t WS_WO = 25 * MiB;
constexpr size_t WS_WMEM = 27 * MiB;
constexpr size_t WS_W1 = 29 * MiB;
constexpr size_t WS_W2 = 157 * MiB;
constexpr size_t WS_XN = 221 * MiB;
constexpr size_t WS_Z = 256 * MiB;
constexpr size_t WS_RW = 568 * MiB;
constexpr size_t WS_YS = 792 * MiB;
constexpr size_t WS_YABC = 824 * MiB;
constexpr size_t WS_MRG = 872 * MiB;
constexpr size_t WS_MRGB = 936 * MiB;
constexpr size_t WS_MEMN = 968 * MiB;
constexpr size_t WS_KVM = 969 * MiB;
constexpr size_t WS_XN2 = 970 * MiB;
constexpr size_t WS_ROUTE = 1002 * MiB;
constexpr size_t WS_LORA = 1004 * MiB;
constexpr size_t WS_END = 1005 * MiB;
constexpr size_t WS_XS = 256 * MiB;
constexpr size_t WS_HACT = 400 * MiB;
constexpr size_t WS_YROWS = 544 * MiB;
constexpr size_t WS_OP = WS_MRG;
constexpr size_t WS_LSE = WS_MRGB;
constexpr size_t WS_CS = WS_RW;
constexpr size_t WS_VMIX = WS_RW + 32 * MiB, WS_GMIX = WS_RW + 64 * MiB;
constexpr size_t RWSZ = (size_t)MTOK * RW * 4;
constexpr size_t RT_TOPI = 0, RT_TOPG = 256 * 1024, RT_POS = 512 * 1024, RT_ROWGATE = 768 * 1024;
static_assert(RT_ROWGATE + (size_t)MAX_SLOTS * 4 <= 1088 * 1024, "route");
constexpr int CW_TMO = 0, CW_CODE = 1;
constexpr int CW_BAR = 4096;
constexpr int CW_CNT = 16384;
constexpr int CW_CUR = 16384 + 2048;

constexpr int RING_OFF = 0, RING_BYTES = 131072;
constexpr int LDSCTL_OFF = 143360, MISC_OFF = LDSCTL_OFF + 320;
constexpr int MOETAB_OFF = MISC_OFF + 128;
constexpr int HIST_OFF = MOETAB_OFF + 1536;
constexpr int LDS_BYTES = 147456;
static_assert(HIST_OFF + 4 * 320 <= LDS_BYTES, "LDS map");
#define GAS __attribute__((address_space(1)))
#define LAS __attribute__((address_space(3)))
typedef unsigned short bf16;
typedef unsigned v4u __attribute__((ext_vector_type(4)));
typedef float f32x4 __attribute__((ext_vector_type(4)));
typedef short bf16x8 __attribute__((ext_vector_type(8)));
typedef GAS unsigned gu32;
typedef GAS unsigned long long gu64;
#define RLX_AGENT __ATOMIC_RELAXED, __HIP_MEMORY_SCOPE_AGENT
#define LDS_WAIT() asm volatile("s_waitcnt lgkmcnt(0)" ::: "memory")
#define VM_WAIT() asm volatile("s_waitcnt vmcnt(0)" ::: "memory")
__device__ __forceinline__ unsigned long long rt() { return __builtin_amdgcn_s_memrealtime(); }
typedef float f32x2_cv __attribute__((ext_vector_type(2))); typedef __bf16 bf16x2_cv __attribute__((ext_vector_type(2)));
__device__ __forceinline__ unsigned pk2(float lo, float hi) { f32x2_cv v = {lo, hi}; bf16x2_cv b = __builtin_convertvector(v, bf16x2_cv); return __builtin_bit_cast(unsigned, b); }
__device__ __forceinline__ unsigned f2bf(float f) { return pk2(f, f) & 0xffffu; }
#define XB_TMO      128
#define XB_XCNT(j)  (256  + 64 * (j))
#define XB_XSUB(j)  (1280 + 64 * (j))
#define XB_XGEN(j)  (2304 + 64 * (j))
#define XB_TOP      3328
#define XB_TOPGEN   3392
#define XCD_BAR_WORDS 3456
#define XB_SPIN_CAP (1u << 18)

__device__ __forceinline__ unsigned xb_ld(unsigned* p)              { return __hip_atomic_load(p, __ATOMIC_RELAXED, __HIP_MEMORY_SCOPE_AGENT); }
__device__ __forceinline__ unsigned xb_add(unsigned* p, unsigned v) { return __hip_atomic_fetch_add(p, v, __ATOMIC_RELAXED, __HIP_MEMORY_SCOPE_AGENT); }
__device__ __forceinline__ unsigned xb_xcc_id() { return (unsigned)__builtin_amdgcn_s_getreg((3 << 11) | 20) & 0xFu; }
#define XB_SPIN(cond, bar) do { unsigned _sp = 0; while (cond) { __builtin_amdgcn_s_sleep(1); \
    if ((++_sp & 255u) == 0u) { if (xb_ld(&(bar)[XB_TMO])) break; if (_sp > XB_SPIN_CAP) { atomicAdd(&(bar)[XB_TMO], 1u); break; } } } } while (0)

struct XcdBarrier {
    unsigned* bar; unsigned x;
    volatile LAS unsigned* st;
};

__device__ __forceinline__ XcdBarrier xcd_barrier_post(unsigned* bar, volatile LAS unsigned* st) {
    XcdBarrier b; b.bar = bar; b.x = xb_xcc_id(); b.st = st;
    if (threadIdx.x == 0) (void)xb_add(&bar[XB_XCNT(b.x)], 1u);
    return b;
}
__device__ __forceinline__ void xcd_barrier_complete(unsigned* bar, unsigned x, unsigned& nloc, unsigned& nx) {
    const unsigned G = gridDim.x * gridDim.y * gridDim.z;
    unsigned sum, cnt, mine, sp = 0u;
    for (;;) {
        sum = 0u; cnt = 0u; mine = 0u;
#pragma unroll
        for (unsigned j = 0; j < 16; ++j) { const unsigned c = xb_ld(&bar[XB_XCNT(j)]); sum += c; cnt += (c > 0u) ? 1u : 0u; mine = (j == x) ? c : mine; }
        if (sum == G) break;
        __builtin_amdgcn_s_sleep(1);
        if ((++sp & 255u) == 0u) { if (xb_ld(&bar[XB_TMO])) break; if (sp > XB_SPIN_CAP) { atomicAdd(&bar[XB_TMO], 1u); break; } }
    }
    nloc = mine > 0u ? mine : 1u; nx = cnt > 0u ? cnt : 1u;
}

__device__ __forceinline__ void xcd_barrier(const XcdBarrier& b) {
    asm volatile("s_waitcnt vmcnt(0)" ::: "memory");
    __syncthreads();
    if (threadIdx.x == 0) {
        unsigned* bar = b.bar;
        __builtin_amdgcn_s_waitcnt(0);
        unsigned nloc = b.st[0], nx = b.st[1];
        if (nloc == 0u) { xcd_barrier_complete(bar, b.x, nloc, nx); b.st[0] = nloc; b.st[1] = nx; }
        const unsigned old = xb_add(&bar[XB_XSUB(b.x)], 1u);
        const unsigned gen = old / nloc;
        if (old + 1u == (gen + 1u) * nloc) {
            __builtin_amdgcn_fence(__ATOMIC_RELEASE, "agent");
            asm volatile("s_waitcnt vmcnt(0)" ::: "memory");
            const unsigned og = xb_add(&bar[XB_TOP], 1u);
            const unsigned tg = og / nx;
            if (og + 1u == (tg + 1u) * nx) xb_add(&bar[XB_TOPGEN], 1u);
            else XB_SPIN(xb_ld(&bar[XB_TOPGEN]) == tg, bar);
            __builtin_amdgcn_fence(__ATOMIC_ACQUIRE, "agent");
            xb_add(&bar[XB_XGEN(b.x)], 1u);
            asm volatile("s_waitcnt vmcnt(0)" ::: "memory");
        } else {
            XB_SPIN(xb_ld(&bar[XB_XGEN(b.x)]) == gen, bar);
            __builtin_amdgcn_fence(__ATOMIC_ACQUIRE, "agent");
            asm volatile("s_waitcnt vmcnt(0)" ::: "memory");
        }
    }
    __syncthreads();
}

typedef float f32x2 __attribute__((ext_vector_type(2)));
struct Args { const float* in[32]; float* out; unsigned char* ws; int ph_lo, ph_hi, use_bar, pad; };
struct Frame {
    LAS unsigned char* lds;
    volatile LAS unsigned* MISC;
    gu32* ctl;
    int tid, lane, wave;
    int vcu, G;
    float* out;
    unsigned char* ws;
};
enum { I_X = 0, I_MEM, I_POS, I_NORM_MIX, I_W_IN, I_B_GATE, I_AQ_GAIN, I_AK_GAIN, I_R_MU, I_R_W0, I_R_W2, I_R_A0, I_R_A2, I_R_G2, I_R_KK, I_R_KA, I_R_RK, I_R_LNW, I_R_LNB,
       I_MEM_NORM, I_W_MEMKV, I_CQ_GAIN, I_CK_GAIN, I_W_BRANCH, I_W_OUT, I_NORM_FFN, I_ROUTER_W, I_ROUTER_B, I_EXP_W1, I_EXP_B1, I_EXP_W2, I_EXP_B2 };

__device__ __forceinline__ bool phase_enter(Frame& F, bool on) { int t = (int)threadIdx.x; asm volatile("" : "+v"(t)); F.tid = t; F.lane = t & 63; F.wave = __builtin_amdgcn_readfirstlane(t >> 6); return on; }
__device__ __forceinline__ const float* ldarg(int i) {
    const __attribute__((address_space(4))) char* ka = (const __attribute__((address_space(4))) char*)__builtin_amdgcn_kernarg_segment_ptr();
    asm volatile("" : "+s"(ka));
    return *(const float* const __attribute__((address_space(4)))*)(ka + 8 * i);
}
__device__ __forceinline__ unsigned pk4_fp8(float a, float b, float c, float d) { unsigned w = 0; w = __builtin_amdgcn_cvt_pk_fp8_f32(a, b, w, false); w = __builtin_amdgcn_cvt_pk_fp8_f32(c, d, w, true); return w; }
__device__ __forceinline__ float fast_sigm(float x) { return __builtin_amdgcn_rcpf(1.0f + __builtin_amdgcn_exp2f(-1.4426950408889634f * x)); }
__device__ __forceinline__ float fast_tanh(float x) { return 1.0f - 2.0f * __builtin_amdgcn_rcpf(1.0f + __builtin_amdgcn_exp2f(2.8853900817779268f * x)); }
__device__ __forceinline__ float fast_softplus(float y) { return fmaxf(y, 0.f) + 0.6931471805599453f * __builtin_amdgcn_logf(1.0f + __builtin_amdgcn_exp2f(-1.4426950408889634f * fabsf(y))); }
__device__ __forceinline__ int opq(int x) { asm volatile("" : "+v"(x)); return x; }
__device__ __forceinline__ float bf_lo(unsigned w) { return __builtin_bit_cast(float, w << 16); }
__device__ __forceinline__ float bf_hi(unsigned w) { return __builtin_bit_cast(float, w & 0xffff0000u); }
__device__ __forceinline__ float sigm(float x) { return 1.0f / (1.0f + __expf(-x)); }
template <int CTRL, int RM> __device__ __forceinline__ float dpp0(float v) {
    return __builtin_bit_cast(float, __builtin_amdgcn_update_dpp(0, __builtin_bit_cast(int, v), CTRL, RM, 0xf, true)); }
__device__ __forceinline__ float row16_sum(float v) {
    v += dpp0<0xB1, 0xf>(v); v += dpp0<0x4E, 0xf>(v); v += dpp0<0x141, 0xf>(v); v += dpp0<0x140, 0xf>(v); return v; }
__device__ __forceinline__ float rdlane(float v, int l) { return __builtin_bit_cast(float, __builtin_amdgcn_readlane(__builtin_bit_cast(int, v), l)); }
__device__ __forceinline__ float wave_sum(float v) {
    v = row16_sum(v); v += dpp0<0x142, 0xA>(v); v += dpp0<0x143, 0xC>(v); return rdlane(v, 63); }
__device__ __forceinline__ void half_sums(float v, float& lo, float& hi) {
    v = row16_sum(v); v += dpp0<0x142, 0xA>(v); lo = rdlane(v, 31); hi = rdlane(v, 63); }
__device__ __forceinline__ float wave_max_bp(float v) {
#pragma unroll
    for (int o = 1; o < 64; o <<= 1) v = fmaxf(v, __shfl_xor(v, o));
    return v; }

__device__ __forceinline__ void tconv_tile(const float* W, int K, int N, bf16* WT, int k0, int n0, int rowbase, int lane, int kd = 0) {
    const int c = lane & 15, q = lane >> 4;
    const GAS f32x4* src = (const GAS f32x4*)(W + (size_t)(k0 + 16 * q) * N + n0 + 4 * c);
    const size_t rs = (size_t)N / 4;
    f32x4 v[16];
#pragma unroll
    for (int i = 0; i < 16; ++i) v[i] = src[i * rs];
#pragma unroll
    for (int j = 0; j < 4; ++j) {
        GAS v4u* dst = (GAS v4u*)(WT + (size_t)(rowbase + 4 * c + j) * K + kd + k0 + 16 * q);
        v4u o0, o1;
        o0.x = pk2(v[0][j], v[1][j]); o0.y = pk2(v[2][j], v[3][j]); o0.z = pk2(v[4][j], v[5][j]); o0.w = pk2(v[6][j], v[7][j]);
        o1.x = pk2(v[8][j], v[9][j]); o1.y = pk2(v[10][j], v[11][j]); o1.z = pk2(v[12][j], v[13][j]); o1.w = pk2(v[14][j], v[15][j]);
        dst[0] = o0; dst[1] = o1;
    }
}
__device__ __forceinline__ void tconv_tile128(const float* W, int K, int N, bf16* WT, int k0, int n0, int rowbase, int lane) {
    const int c = lane & 31, q = lane >> 5;
    const GAS f32x4* src = (const GAS f32x4*)(W + (size_t)(k0 + 32 * q) * N + n0 + 4 * c);
    const size_t rs = (size_t)N / 4;
    f32x4 v[32];
#pragma unroll
    for (int i = 0; i < 32; ++i) v[i] = src[i * rs];
#pragma unroll
    for (int j = 0; j < 4; ++j) {
        GAS v4u* dst = (GAS v4u*)(WT + (size_t)(rowbase + 4 * c + j) * K + k0 + 32 * q);
#pragma unroll
        for (int g = 0; g < 4; ++g) { v4u o; o.x = pk2(v[8 * g][j], v[8 * g + 1][j]); o.y = pk2(v[8 * g + 2][j], v[8 * g + 3][j]); o.z = pk2(v[8 * g + 4][j], v[8 * g + 5][j]); o.w = pk2(v[8 * g + 6][j], v[8 * g + 7][j]); dst[g] = o; }
    }
}
__device__ __forceinline__ void tconv_tile_f8(const float* W, int K, int N, unsigned char* WT, int k0, int n0, int rowbase, int lane, float sc) {
    const int c = lane & 15, q = lane >> 4;
    const GAS f32x4* src = (const GAS f32x4*)(W + (size_t)(k0 + 16 * q) * N + n0 + 4 * c);
    const size_t rs = (size_t)N / 4;
    f32x4 v[16];
#pragma unroll
    for (int i = 0; i < 16; ++i) v[i] = src[i * rs] * sc;
#pragma unroll
    for (int j = 0; j < 4; ++j) {
        v4u o; o.x = pk4_fp8(v[0][j], v[1][j], v[2][j], v[3][j]); o.y = pk4_fp8(v[4][j], v[5][j], v[6][j], v[7][j]); o.z = pk4_fp8(v[8][j], v[9][j], v[10][j], v[11][j]); o.w = pk4_fp8(v[12][j], v[13][j], v[14][j], v[15][j]);
        *(GAS v4u*)(WT + (size_t)(rowbase + 4 * c + j) * K + k0 + 16 * q) = o;
    }
}
__device__ __forceinline__ void rms_row_to_bf16(const float* xrow, const float* gain, bf16* orow, int lane) {
    const GAS f32x4* xr = (const GAS f32x4*)xrow + lane; const GAS f32x4* gr = (const GAS f32x4*)gain + lane;
    f32x4 v[4]; float s = 0.f;
#pragma unroll
    for (int j = 0; j < 4; ++j) { v[j] = xr[64 * j]; s += (v[j].x * v[j].x + v[j].y * v[j].y) + (v[j].z * v[j].z + v[j].w * v[j].w); }
    const float rstd = 1.0f / sqrtf(wave_sum(s) * (1.f / D_MODEL) + NORM_EPS);
    GAS unsigned long long* o8 = (GAS unsigned long long*)orow + lane;
#pragma unroll
    for (int j = 0; j < 4; ++j) { const f32x4 g = gr[64 * j];
        o8[64 * j] = (unsigned long long)pk2(v[j].x * rstd * g.x, v[j].y * rstd * g.y) | ((unsigned long long)pk2(v[j].z * rstd * g.z, v[j].w * rstd * g.w) << 32); }
}
template <int PART> __device__ __forceinline__ void p0_prologue(Frame& F, const Args& args, int gw, int NGW) {
    const int lane = F.lane;
    unsigned char* ws = F.ws;
    constexpr int T_IN = 16 * 156, T_WB = 3 * 128, T_WO = 256, T_WM = 256, T_W1 = 32 * 512, T_W2 = 32 * 256, T_LO = 32;
    constexpr int NT = T_IN + T_WB + T_WO + T_WM + T_W1 + T_W2;
    constexpr int IT0 = (PART == 0) ? 0 : T_IN + T_WB + T_WO + T_WM, IT1 = (PART == 0) ? T_IN + T_WB + T_WO + T_WM : NT;
    for (int it = IT0 + gw; it < IT1; it += NGW) {
        int r = it;
        if (r < T_IN) { const int kb = r / 156, nb = r % 156; tconv_tile(ldarg(I_W_IN), 1024, IN_COLS, (bf16*)(ws + WS_WIN), 64 * kb, 64 * nb, 64 * nb, lane); continue; } r -= T_IN;
        if (r < T_WB) { const int b = r / 128, q = r % 128, kb = q / 16, nb = q % 16;
            tconv_tile(ldarg(I_W_BRANCH) + (size_t)b * 512 * 1024, 1536, 1024, (bf16*)(ws + WS_WB), 64 * kb, 64 * nb, 64 * nb, lane, 512 * b); continue; } r -= T_WB;
        if (r < T_WO) { const int kb = r / 16, nb = r % 16; tconv_tile(ldarg(I_W_OUT), 1024, 1024, (bf16*)(ws + WS_WO), 64 * kb, 64 * nb, 64 * nb, lane); continue; } r -= T_WO;
        if (r < T_WM) { const int kb = r / 16, nb = r % 16; tconv_tile(ldarg(I_W_MEMKV), 1024, 1024, (bf16*)(ws + WS_WMEM), 64 * kb, 64 * nb, 64 * nb, lane); continue; } r -= T_WM;
        if (r < T_W1) { const int e = r / 512, q = r % 512, kb = q % 16, nb = q / 16, n0 = 64 * nb;
            const int rowbase = (n0 < 1024) ? ((n0 >> 7) * 256 + (n0 & 127)) : ((((n0 - 1024) >> 7) * 256) + 128 + ((n0 - 1024) & 127));
            tconv_tile_f8(ldarg(I_EXP_W1) + (size_t)e * 1024 * 2048, 1024, 2048, ws + WS_W1 + (size_t)e * 2048 * 1024, 64 * kb, n0, rowbase, lane, W8_SCALE); continue; } r -= T_W1;
        { const int e = r / 256, q = r % 256, kb = q % 16, nb = q / 16;
            tconv_tile_f8(ldarg(I_EXP_W2) + (size_t)e * 1024 * 1024, 1024, 1024, ws + WS_W2 + (size_t)e * 1024 * 1024, 64 * kb, 64 * nb, 64 * nb, lane, W8_SCALE); }
    }
    if (PART == 0) {
    for (int it = gw; it < T_LO; it += NGW) {
        bf16* L = (bf16*)(ws + WS_LORA);
        if (it < 8) tconv_tile(ldarg(I_R_W2), 64, 512, L, 0, 64 * it, 64 * it, lane);
        else if (it < 16) tconv_tile(ldarg(I_R_A2), 64, 512, L + 512 * 64, 0, 64 * (it - 8), 64 * (it - 8), lane);
        else { const int q = it - 16; tconv_tile(ldarg(I_R_G2), 128, 512, L + 2 * 512 * 64, 64 * (q >> 3), 64 * (q & 7), 64 * (q & 7), lane); } }
    { const int* posp = (const int*)ldarg(I_POS); float* cs = (float*)(ws + WS_CS);
      for (int idx = gw * 64 + lane; idx < MTOK * 16; idx += NGW * 64) { const int m = idx >> 4, i = idx & 15; const float ang = (float)posp[m] * exp2f(-(float)i * (18.931568569324174f / 16.0f)); const float sn = sinf(ang), cn = cosf(ang);
          f32x2 o; o.x = cn; o.y = sn; *(GAS f32x2*)(cs + (size_t)idx * 2) = o; } }
    for (int m = gw; m < MTOK; m += NGW) rms_row_to_bf16(ldarg(I_X) + (size_t)m * D_MODEL, ldarg(I_NORM_MIX), (bf16*)(ws + WS_XN) + (size_t)m * D_MODEL, lane);
    for (int m = gw; m < MEMROWS; m += NGW) rms_row_to_bf16(ldarg(I_MEM) + (size_t)m * D_MODEL, ldarg(I_MEM_NORM), (bf16*)(ws + WS_MEMN) + (size_t)m * D_MODEL, lane);
    }
}

__device__ __forceinline__ void head_norm(bf16* p, const float* gain, bool rot, float c0, float s0, float c1, float s1, float scale, int lane) {
    GAS unsigned* pw = (GAS unsigned*)p + lane;
    const unsigned w = *pw; float a = bf_lo(w), b = bf_hi(w);
    const float ss = wave_sum(a * a + b * b);
    const float rstd = 1.0f / sqrtf(ss * (1.f / 128.f) + NORM_EPS);
    const f32x2 g = *((const GAS f32x2*)gain + lane);
    a = a * rstd * g.x; b = b * rstd * g.y;
    const float pa = __shfl_xor(a, 8), pb = __shfl_xor(b, 8);
    if (rot && lane < 16) {
        if (lane < 8) { a = a * c0 - pa * s0; b = b * c1 - pb * s1; }
        else          { a = a * c0 + pa * s0; b = b * c1 + pb * s1; }
    }
    *pw = pk2(a * scale, b * scale);
}
__device__ __forceinline__ void p2_prep(Frame& F, const Args& args) {
    const int gw = F.vcu * NWAVES + F.wave, NGW = F.G * NWAVES, lane = F.lane;
    unsigned char* ws = F.ws;
    bf16* Z = (bf16*)(ws + WS_Z);
    LAS float* lo = (LAS float*)(F.lds + RING_OFF + F.wave * 8192);
    const float* mu = ldarg(I_R_MU); const float* aqg = ldarg(I_AQ_GAIN); const float* akg = ldarg(I_AK_GAIN); const float* cqg = ldarg(I_CQ_GAIN); const int* posp = (const int*)ldarg(I_POS);
    float* Rr = (float*)(ws + WS_RW); float* Rw = Rr + (size_t)MTOK * RW; float* Rk = Rw + (size_t)MTOK * RW; float* Rv = Rk + (size_t)MTOK * RW;
    float* Ra = Rv + (size_t)MTOK * RW; float* Rb = Ra + (size_t)MTOK * RW; float* Rg = Rb + (size_t)MTOK * RW;
    for (int m = gw; m < MEMROWS; m += NGW)
        for (int hd = 0; hd < 4; ++hd) head_norm((bf16*)(ws + WS_KVM) + (size_t)m * 1024 + hd * 128, ldarg(I_CK_GAIN), false, 1.f, 0.f, 1.f, 0.f, 1.0f, lane);
}

__device__ __forceinline__ void lora_stage(const float* W, LAS unsigned* wl, int tid) {
#pragma unroll
    for (int i = 0; i < 16; ++i) { const int idx = tid + 512 * i; const f32x4 v = *((const GAS f32x4*)W + idx);
        *(LAS unsigned long long*)(wl + 2 * idx) = (unsigned long long)pk2(v.x, v.y) | ((unsigned long long)pk2(v.z, v.w) << 32); }
}
__device__ __forceinline__ void lora_mac(const LAS unsigned* wl, const LAS float* lo, float (&acc)[4][8], int lane) {
#pragma unroll 4
    for (int j = 0; j < 64; ++j) { const f32x4 xin = *(const LAS f32x4*)(lo + j * 4);
#pragma unroll
        for (int i = 0; i < 4; ++i) { const unsigned w = wl[j * 256 + lane + 64 * i]; const float w0 = bf_lo(w), w1 = bf_hi(w);
#pragma unroll
            for (int tt = 0; tt < 4; ++tt) { acc[tt][2 * i] += xin[tt] * w0; acc[tt][2 * i + 1] += xin[tt] * w1; } } }
}
template <int NL> __device__ __forceinline__ void lora_in(const bf16* Z, const float* mu, int ch, int m0, LAS float* lo, int lane) {
    const int col = OFF_R + 1536 + ch; const float muj = mu[1536 + ch];
    float prv = ((m0 % SEQ) == 0) ? 0.f : __builtin_bit_cast(float, (unsigned)Z[(size_t)(m0 - 1) * IN_COLS + col] << 16);
#pragma unroll
    for (int tt = 0; tt < 4; ++tt) { const float cur = __builtin_bit_cast(float, (unsigned)Z[(size_t)(m0 + tt) * IN_COLS + col] << 16);
        float x = cur + (prv - cur) * muj; prv = cur;
        x = (NL == 0) ? tanhf(x) : (NL == 1) ? x : sigm(x);
        lo[lane * 4 + tt] = x; }
    LDS_WAIT(); asm volatile("" ::: "memory");
}
__device__ __forceinline__ void p2_rwkv(Frame& F, const Args& args) {
    const int lane = F.lane, wave = F.wave;
    unsigned char* ws = F.ws;
    const bf16* Z = (const bf16*)(ws + WS_Z);
    LAS unsigned* wl = (LAS unsigned*)(F.lds + RING_OFF);
    LAS float* lo = (LAS float*)(F.lds + RING_OFF + 65536 + wave * 1024);
    const float* mu = ldarg(I_R_MU);
    float* Rr = (float*)(ws + WS_RW); float* Rw = Rr + (size_t)MTOK * RW; float* Rk = Rw + (size_t)MTOK * RW; float* Rv = Rk + (size_t)MTOK * RW;
    float* Ra = Rv + (size_t)MTOK * RW; float* Rb = Ra + (size_t)MTOK * RW; float* Rg = Rb + (size_t)MTOK * RW;
    for (int grp = F.vcu; grp < MTOK / 64; grp += F.G) {
        const int mw = grp * 64 + wave * 8;
        lora_stage(ldarg(I_R_W2), wl, F.tid);
        __syncthreads();
        for (int tk = 0; tk < 2; ++tk) { const int m0 = mw + 4 * tk;
            lora_in<0>(Z, mu, lane, m0, lo, lane);
            float acc[4][8];
#pragma unroll
            for (int tt = 0; tt < 4; ++tt)
#pragma unroll
                for (int c = 0; c < 8; ++c) acc[tt][c] = 0.f;
            lora_mac(wl, lo, acc, lane);
            const float* w0p = ldarg(I_R_W0);
#pragma unroll
            for (int i = 0; i < 4; ++i) { const int c = 2 * lane + 128 * i; const f32x2 w0 = *(const GAS f32x2*)(w0p + c);
#pragma unroll
                for (int tt = 0; tt < 4; ++tt) { const float y0 = -(w0.x + acc[tt][2 * i]), y1 = -(w0.y + acc[tt][2 * i + 1]);
                    const float sp0 = fmaxf(y0, 0.f) + log1pf(__expf(-fabsf(y0))), sp1 = fmaxf(y1, 0.f) + log1pf(__expf(-fabsf(y1)));
                    f32x2 wd; wd.x = -__expf(-sp0 - 0.5f); wd.y = -__expf(-sp1 - 0.5f);
                    *(GAS f32x2*)(Rw + (size_t)(m0 + tt) * RW + c) = wd; } }
            LDS_WAIT(); asm volatile("" ::: "memory"); }
        __syncthreads();
        lora_stage(ldarg(I_R_A2), wl, F.tid);
        __syncthreads();
        for (int tk = 0; tk < 2; ++tk) { const int m0 = mw + 4 * tk; const int tpos0 = m0 % SEQ;
            lora_in<1>(Z, mu, 64 + lane, m0, lo, lane);
            float acca[4][8];
#pragma unroll
            for (int tt = 0; tt < 4; ++tt)
#pragma unroll
                for (int c = 0; c < 8; ++c) acca[tt][c] = 0.f;
            lora_mac(wl, lo, acca, lane);
            const float* a0p = ldarg(I_R_A0); const float* kkp = ldarg(I_R_KK); const float* kap = ldarg(I_R_KA);
#pragma unroll
            for (int i = 0; i < 4; ++i) {
                const int c = 2 * lane + 128 * i;
                const f32x2 a0 = *(const GAS f32x2*)(a0p + c), kkc = *(const GAS f32x2*)(kkp + c), kac = *(const GAS f32x2*)(kap + c);
                const f32x2 mur = *(const GAS f32x2*)(mu + c), muk = *(const GAS f32x2*)(mu + 512 + c), muv = *(const GAS f32x2*)(mu + 1024 + c);
                unsigned pr = 0u, pk = 0u, pv = 0u;
                if (tpos0 != 0) { const bf16* zp = Z + (size_t)(m0 - 1) * IN_COLS + OFF_R + c; pr = *(const GAS unsigned*)zp; pk = *(const GAS unsigned*)(zp + 512); pv = *(const GAS unsigned*)(zp + 1024); }
#pragma unroll
                for (int tt = 0; tt < 4; ++tt) {
                    const size_t m = (size_t)(m0 + tt);
                    const bf16* zc = Z + m * IN_COLS + OFF_R + c;
                    const unsigned cr = *(const GAS unsigned*)zc, ck = *(const GAS unsigned*)(zc + 512), cv = *(const GAS unsigned*)(zc + 1024);
                    f32x2 r, k, v;
                    r.x = bf_lo(cr) + (bf_lo(pr) - bf_lo(cr)) * mur.x; r.y = bf_hi(cr) + (bf_hi(pr) - bf_hi(cr)) * mur.y;
                    k.x = bf_lo(ck) + (bf_lo(pk) - bf_lo(ck)) * muk.x; k.y = bf_hi(ck) + (bf_hi(pk) - bf_hi(ck)) * muk.y;
                    v.x = bf_lo(cv) + (bf_lo(pv) - bf_lo(cv)) * muv.x; v.y = bf_hi(cv) + (bf_hi(pv) - bf_hi(cv)) * muv.y;
                    pr = cr; pk = ck; pv = cv;
                    f32x2 av; av.x = sigm(a0.x + acca[tt][2 * i]); av.y = sigm(a0.y + acca[tt][2 * i + 1]);
                    f32x2 kk; kk.x = k.x * kkc.x; kk.y = k.y * kkc.y;
                    float slo, shi; half_sums(kk.x * kk.x + kk.y * kk.y, slo, shi);
                    const float nrm = fmaxf(sqrtf(lane < 32 ? slo : shi), 1e-12f), inv = 1.0f / nrm;
                    kk.x *= inv; kk.y *= inv;
                    f32x2 k2; k2.x = k.x * (1.0f + (av.x - 1.0f) * kac.x); k2.y = k.y * (1.0f + (av.y - 1.0f) * kac.y);
                    f32x2 as, bs; as.x = -kk.x; as.y = -kk.y; bs.x = kk.x * av.x; bs.y = kk.y * av.y;
                    const size_t o = m * RW + c;
                    *(GAS f32x2*)(Rr + o) = r; *(GAS f32x2*)(Rk + o) = k2; *(GAS f32x2*)(Rv + o) = v; *(GAS f32x2*)(Ra + o) = as; *(GAS f32x2*)(Rb + o) = bs;
                }
            }
            LDS_WAIT(); asm volatile("" ::: "memory"); }
        __syncthreads();
        float accg[2][4][8];
#pragma unroll
        for (int tk = 0; tk < 2; ++tk)
#pragma unroll
            for (int tt = 0; tt < 4; ++tt)
#pragma unroll
                for (int c = 0; c < 8; ++c) accg[tk][tt][c] = 0.f;
#pragma unroll
        for (int hh = 0; hh < 2; ++hh) {
            lora_stage(ldarg(I_R_G2) + (size_t)hh * 64 * RW, wl, F.tid);
            __syncthreads();
#pragma unroll
            for (int tk = 0; tk < 2; ++tk) { lora_in<2>(Z, mu, 128 + 64 * hh + lane, mw + 4 * tk, lo, lane); lora_mac(wl, lo, accg[tk], lane); LDS_WAIT(); asm volatile("" ::: "memory"); }
            __syncthreads();
        }
#pragma unroll
        for (int tk = 0; tk < 2; ++tk)
#pragma unroll
            for (int i = 0; i < 4; ++i)
#pragma unroll
                for (int tt = 0; tt < 4; ++tt) { f32x2 gg; gg.x = accg[tk][tt][2 * i]; gg.y = accg[tk][tt][2 * i + 1]; *(GAS f32x2*)(Rg + (size_t)(mw + 4 * tk + tt) * RW + 2 * lane + 128 * i) = gg; }
    }
}

__device__ __forceinline__ float qk_dot(const LAS float* q, const bf16* krow) {
    const GAS v4u* kp = (const GAS v4u*)krow; float s0 = 0.f, s1 = 0.f;
#pragma unroll
    for (int i = 0; i < 16; ++i) { const v4u w = kp[i]; const f32x4 qa = *(const LAS f32x4*)(q + 8 * i), qb = *(const LAS f32x4*)(q + 8 * i + 4);
        s0 += bf_lo(w.x) * qa[0] + bf_hi(w.x) * qa[1] + bf_lo(w.y) * qa[2] + bf_hi(w.y) * qa[3];
        s1 += bf_lo(w.z) * qb[0] + bf_hi(w.z) * qb[1] + bf_lo(w.w) * qb[2] + bf_hi(w.w) * qb[3]; }
    return s0 + s1;
}
__device__ __forceinline__ void p3_attention(Frame& F) {
    const int gw = F.vcu * NWAVES + F.wave, NGW = F.G * NWAVES, lane = F.lane;
    unsigned char* ws = F.ws;
    const bf16* Z = (const bf16*)(ws + WS_Z);
    const bf16* KV = (const bf16*)(ws + WS_KVM);
    bf16* YA = (bf16*)(ws + WS_YABC); bf16* YC = YA + (size_t)2 * MTOK * 512;
    LAS float* qs = (LAS float*)(F.lds + RING_OFF + F.wave * 8192);
    for (int task = gw; task < MTOK * 4; task += NGW) {
        const int m = task >> 2, h = task & 3, t = m % SEQ;
        const bf16* zrow = Z + (size_t)m * IN_COLS;
#pragma unroll
        for (int g = 0; g < 3; ++g) { const unsigned w = *((const GAS unsigned*)(zrow + OFF_AQ + g * 512 + h * 128) + lane); qs[g * 128 + 2 * lane] = bf_lo(w); qs[g * 128 + 2 * lane + 1] = bf_hi(w); }
        LDS_WAIT(); asm volatile("" ::: "memory");
        float sc[3][3]; float mx = -INFINITY;
#pragma unroll
        for (int g = 0; g < 3; ++g) { const int dl = (g == 0) ? 1 : (g == 1) ? 4 : 16;
#pragma unroll
            for (int p = 0; p < 3; ++p) { const int j = lane + 64 * p; const int tk = t - dl * j; float s = -INFINITY;
                if (j <= 128 && tk >= 0) s = qk_dot(qs + g * 128, zrow - (size_t)dl * j * IN_COLS + OFF_AK + g * 512 + h * 128);
                sc[g][p] = s; mx = fmaxf(mx, s); } }
        mx = wave_max_bp(mx);
        float den = 0.f;
#pragma unroll
        for (int g = 0; g < 3; ++g)
#pragma unroll
            for (int p = 0; p < 3; ++p) { sc[g][p] = exp2f(sc[g][p] - mx); den += sc[g][p]; }
        den = wave_sum(den);
        float o0 = 0.f, o1 = 0.f;
#pragma unroll
        for (int g = 0; g < 3; ++g) { const int dl = (g == 0) ? 1 : (g == 1) ? 4 : 16; const bf16* vb = zrow + OFF_AV + g * 512 + h * 128 + 2 * lane;
#pragma unroll
            for (int p = 0; p < 3; ++p) { const int nj = (p < 2) ? 64 : 1;
                for (int jj = 0; jj < nj; ++jj) { const int j = jj + 64 * p; const float pj = rdlane(sc[g][p], jj);
                    if (t - dl * j >= 0) { const unsigned w = *(const GAS unsigned*)(vb - (size_t)dl * j * IN_COLS); o0 += pj * bf_lo(w); o1 += pj * bf_hi(w); } } } }
        const float inv = 1.0f / den;
        *((GAS unsigned*)(YA + (size_t)m * 512 + h * 128) + lane) = pk2(o0 * inv, o1 * inv);
        asm volatile("" ::: "memory");
    }
    for (int task = gw; task < MTOK * 4; task += NGW) {
        const int m = task >> 2, h = task & 3, b = m / SEQ;
        const bf16* zrow = Z + (size_t)m * IN_COLS;
        { const unsigned w = *((const GAS unsigned*)(zrow + OFF_CQ + h * 128) + lane); qs[2 * lane] = bf_lo(w); qs[2 * lane + 1] = bf_hi(w); }
        LDS_WAIT(); asm volatile("" ::: "memory");
        const bf16* kb = KV + (size_t)b * MEM_LEN * 1024 + h * 128;
        float sc[4]; float mx = -INFINITY;
#pragma unroll
        for (int p = 0; p < 4; ++p) { sc[p] = qk_dot(qs, kb + (size_t)(lane + 64 * p) * 1024); mx = fmaxf(mx, sc[p]); }
        mx = wave_max_bp(mx);
        float den = 0.f;
#pragma unroll
        for (int p = 0; p < 4; ++p) { sc[p] = exp2f(sc[p] - mx); den += sc[p]; }
        den = wave_sum(den);
        float o0 = 0.f, o1 = 0.f; const bf16* vb = kb + 512 + 2 * lane;
#pragma unroll
        for (int p = 0; p < 4; ++p)
            for (int jj = 0; jj < 64; ++jj) { const float pj = rdlane(sc[p], jj); const unsigned w = *(const GAS unsigned*)(vb + (size_t)(jj + 64 * p) * 1024); o0 += pj * bf_lo(w); o1 += pj * bf_hi(w); }
        const float inv = 1.0f / den;
        *((GAS unsigned*)(YC + (size_t)m * 512 + h * 128) + lane) = pk2(o0 * inv, o1 * inv);
        asm volatile("" ::: "memory");
    }
}

__device__ __forceinline__ void p5_post(Frame& F, const Args& args) {
    const int gw = F.vcu * NWAVES + F.wave, NGW = F.G * NWAVES, lane = F.lane;
    unsigned char* ws = F.ws;
    const float* Rr = (const float*)(ws + WS_RW); const float* Rk = Rr + (size_t)2 * MTOK * RW; const float* Rv = Rk + (size_t)MTOK * RW; const float* Rg = Rr + (size_t)6 * MTOK * RW;
    const float* YS = (const float*)(ws + WS_YS);
    bf16* YB = (bf16*)(ws + WS_YABC) + (size_t)MTOK * 512;
    const bf16* OP = (const bf16*)(ws + WS_OP); const float* LS = (const float*)(ws + WS_LSE); bf16* YA = (bf16*)(ws + WS_YABC);
    for (int m = gw; m < MTOK; m += NGW) {
#pragma unroll
        for (int h = 0; h < 4; ++h) {
            const float l0 = LS[(size_t)m * 4 + h], l1 = LS[(size_t)MTOK * 4 + (size_t)m * 4 + h], l2 = LS[(size_t)2 * MTOK * 4 + (size_t)m * 4 + h];
            const float mx = fmaxf(l0, fmaxf(l1, l2)); const float w0 = exp2f(l0 - mx), w1 = exp2f(l1 - mx), w2 = exp2f(l2 - mx); const float inv = 1.0f / (w0 + w1 + w2);
            const size_t o = (size_t)m * 512 + h * 128;
            const unsigned a = *((const GAS unsigned*)(OP + o) + lane), b = *((const GAS unsigned*)(OP + (size_t)MTOK * 512 + o) + lane), c = *((const GAS unsigned*)(OP + (size_t)2 * MTOK * 512 + o) + lane);
            *((GAS unsigned*)(YA + (size_t)m * 1536 + h * 128) + lane) = pk2((w0 * bf_lo(a) + w1 * bf_lo(b) + w2 * bf_lo(c)) * inv, (w0 * bf_hi(a) + w1 * bf_hi(b) + w2 * bf_hi(c)) * inv); }
    }
}

__device__ __forceinline__ void p8_router(Frame& F, const Args& args) {
    const int lane = F.lane, wave = F.wave;
    unsigned char* ws = F.ws;
    const float* X1 = F.out;
    LAS int* hist = (LAS int*)(F.lds + HIST_OFF);
    { const int t_ = opq(F.tid); if (t_ < 32) hist[t_] = 0; }
    int* topi = (int*)(ws + WS_ROUTE + RT_TOPI); float* topg = (float*)(ws + WS_ROUTE + RT_TOPG);
    const float* RWt = ldarg(I_ROUTER_W); const float* RB = ldarg(I_ROUTER_B); const float* gain = ldarg(I_NORM_FFN);
    LAS float* rw = (LAS float*)(F.lds + RING_OFF);
    typedef float f32x16r __attribute__((ext_vector_type(16)));
    for (int grp = F.vcu; grp < MTOK / 64; grp += F.G) {
#pragma unroll
        for (int i = 0; i < 16; ++i) { const int f = F.tid + 512 * i, k = f >> 3; const f32x4 w = *((const GAS f32x4*)RWt + f); const float g = gain[k]; ((LAS f32x4*)rw)[f] = w * g; }
        __syncthreads();
        const int tile = wave >> 2, wq = wave & 3, i32 = lane & 31, h = lane >> 5;
        const GAS f32x4* xp = (const GAS f32x4*)(X1 + ((size_t)grp * 64 + tile * 32 + i32) * D_MODEL + wq * 256 + 4 * h);
        const LAS float* bp = rw + (wq * 256 + 4 * h) * 32 + i32;
        f32x16r acc;
#pragma unroll
        for (int r = 0; r < 16; ++r) acc[r] = 0.f;
        float ss = 0.f;
#pragma unroll 4
        for (int q = 0; q < 32; ++q) { const f32x4 xv = xp[2 * q]; ss += (xv.x * xv.x + xv.y * xv.y) + (xv.z * xv.z + xv.w * xv.w);
#pragma unroll
            for (int j = 0; j < 4; ++j) acc = __builtin_amdgcn_mfma_f32_32x32x2f32(xv[j], bp[(8 * q + j) * 32], acc, 0, 0, 0); }
        __syncthreads();
        { LAS float* part = rw + (tile * 4 + wq) * 1024;
#pragma unroll
          for (int r = 0; r < 16; ++r) part[((r & 3) + 8 * (r >> 2) + 4 * h) * 32 + i32] = acc[r];
          rw[8192 + (tile * 4 + wq) * 64 + lane] = ss; }
        __syncthreads();
        if (F.tid < 64) { const int t = F.tid, tl = t >> 5, row = t & 31; const size_t m = (size_t)grp * 64 + t;
            float s = 0.f;
#pragma unroll
            for (int q = 0; q < 4; ++q) s += rw[8192 + (tl * 4 + q) * 64 + row] + rw[8192 + (tl * 4 + q) * 64 + 32 + row];
            const float rstd = 1.0f / sqrtf(s * (1.f / D_MODEL) + NORM_EPS);
            float lg[32];
#pragma unroll
            for (int e = 0; e < 32; ++e) { const LAS float* pp = rw + (tl * 4) * 1024 + row * 32 + e; lg[e] = ((pp[0] + pp[1024]) + (pp[2048] + pp[3072])) * rstd + RB[e]; }
            int ti[4]; float tv[4];
#pragma unroll
            for (int k = 0; k < 4; ++k) { float best = -INFINITY; int bi = 0;
#pragma unroll
                for (int e = 0; e < 32; ++e) { const bool taken = (k > 0 && ti[0] == e) || (k > 1 && ti[1] == e) || (k > 2 && ti[2] == e); if (!taken && lg[e] > best) { best = lg[e]; bi = e; } }
                ti[k] = bi; tv[k] = best; }
            const float e1 = __expf(tv[1] - tv[0]), e2 = __expf(tv[2] - tv[0]), e3 = __expf(tv[3] - tv[0]); const float inv = 1.0f / (1.0f + e1 + e2 + e3);
            { typedef int i32x4 __attribute__((ext_vector_type(4))); *(GAS i32x4*)(topi + m * 4) = (i32x4){ti[0], ti[1], ti[2], ti[3]}; } *(GAS f32x4*)(topg + m * 4) = (f32x4){inv, e1 * inv, e2 * inv, e3 * inv};
#pragma unroll
            for (int k = 0; k < 4; ++k) __hip_atomic_fetch_add(hist + ti[k], 1, __ATOMIC_RELAXED, __HIP_MEMORY_SCOPE_WORKGROUP); }
        __syncthreads();
    }
    { const int t_ = opq(F.tid); if (t_ < 32 && hist[t_] != 0) __hip_atomic_fetch_add((unsigned*)(F.ctl + CW_CNT) + 64 * t_, (unsigned)hist[t_], __ATOMIC_RELAXED, __HIP_MEMORY_SCOPE_AGENT); }
}
__device__ __forceinline__ void moe_table(Frame& F) {
    LAS int* tab = (LAS int*)(F.lds + MOETAB_OFF);
    __syncthreads();
    if (F.tid == 0) { int acc = 0;
        for (int e = 0; e < N_EXPERTS; ++e) { const int c = (int)__hip_atomic_load((unsigned*)(F.ctl + CW_CNT) + 64 * e, __ATOMIC_RELAXED, __HIP_MEMORY_SCOPE_AGENT); const int nb = (c + MOE_ROWS - 1) / MOE_ROWS;
            tab[320 + e] = acc * MOE_ROWS; for (int q = 0; q < nb; ++q) tab[1 + acc + q] = e; acc += nb; }
        tab[0] = acc; }
    __syncthreads();
}
__device__ __forceinline__ void p9_dispatch(Frame& F, const Args& args) {
    const int lane = F.lane;
    unsigned char* ws = F.ws;
    moe_table(F);
    const LAS int* tab = (const LAS int*)(F.lds + MOETAB_OFF);
    LAS int* hist = (LAS int*)(F.lds + HIST_OFF); LAS int* base = hist + 32; LAS int* slots = hist + 64;
    const int* topi = (const int*)(ws + WS_ROUTE + RT_TOPI); const float* topg = (const float*)(ws + WS_ROUTE + RT_TOPG);
    int* pos = (int*)(ws + WS_ROUTE + RT_POS); float* rowgate = (float*)(ws + WS_ROUTE + RT_ROWGATE);
    bf16* XS = (bf16*)(ws + WS_XS); const float* gain = ldarg(I_NORM_FFN);
    for (int grp = F.vcu; grp < MTOK / 64; grp += F.G) {
        const int t_ = opq(F.tid);
        if (t_ < 32) hist[t_] = 0;
        __syncthreads();
        int e = 0, rank = 0;
        if (F.tid < 256) { e = topi[(size_t)grp * 256 + F.tid]; rank = __hip_atomic_fetch_add(hist + e, 1, __ATOMIC_RELAXED, __HIP_MEMORY_SCOPE_WORKGROUP); }
        __syncthreads();
        if (F.tid < 32) { const int h = hist[F.tid]; int b0 = 0; if (h != 0) b0 = (int)__hip_atomic_fetch_add((unsigned*)(F.ctl + CW_CUR) + 64 * F.tid, (unsigned)h, __ATOMIC_RELAXED, __HIP_MEMORY_SCOPE_AGENT); base[F.tid] = tab[320 + F.tid] + b0; }
        __syncthreads();
        if (F.tid < 256) { const int slot = base[e] + rank; pos[(size_t)grp * 256 + F.tid] = slot; rowgate[slot] = topg[(size_t)grp * 256 + F.tid]; slots[F.tid] = slot; }
        __syncthreads();
        { f32x4 v[8][4];
#pragma unroll
          for (int i = 0; i < 8; ++i) { const GAS f32x4* xr = (const GAS f32x4*)(F.out + ((size_t)grp * 64 + F.wave * 8 + i) * D_MODEL) + 2 * lane;
#pragma unroll
              for (int j = 0; j < 4; ++j) v[i][j] = xr[128 * (j >> 1) + (j & 1)]; }
          const GAS f32x4* gr = (const GAS f32x4*)gain + 2 * lane; const f32x4 g00 = gr[0], g01 = gr[1], g10 = gr[128], g11 = gr[129];
#pragma unroll
          for (int i = 0; i < 8; ++i) { const int tl = F.wave * 8 + i;
              float s = 0.f;
#pragma unroll
              for (int j = 0; j < 4; ++j) s += (v[i][j].x * v[i][j].x + v[i][j].y * v[i][j].y) + (v[i][j].z * v[i][j].z + v[i][j].w * v[i][j].w);
              const float rstd = 1.0f / sqrtf(wave_sum(s) * (1.f / D_MODEL) + NORM_EPS);
              unsigned long long o[2];
              { const f32x4 a = v[i][0] * rstd * g00, b = v[i][1] * rstd * g01; o[0] = (unsigned long long)pk4_fp8(a.x, a.y, a.z, a.w) | ((unsigned long long)pk4_fp8(b.x, b.y, b.z, b.w) << 32); }
              { const f32x4 a = v[i][2] * rstd * g10, b = v[i][3] * rstd * g11; o[1] = (unsigned long long)pk4_fp8(a.x, a.y, a.z, a.w) | ((unsigned long long)pk4_fp8(b.x, b.y, b.z, b.w) << 32); }
#pragma unroll
              for (int k = 0; k < 4; ++k) { const int sk = slots[tl * 4 + k]; GAS unsigned long long* dst = (GAS unsigned long long*)((unsigned char*)XS + (size_t)sk * D_MODEL) + lane; dst[0] = o[0]; dst[64] = o[1]; } } }
        __syncthreads();
    }
}
__device__ __forceinline__ void p12_combine(Frame& F) {
    const int gw = F.vcu * NWAVES + F.wave, NGW = F.G * NWAVES, lane = F.lane;
    unsigned char* ws = F.ws;
    const int* pos = (const int*)(ws + WS_ROUTE + RT_POS); const bf16* YR = (const bf16*)(ws + WS_YROWS);
    for (int blk = gw; blk < MTOK / 8; blk += NGW) {
        const int m0 = blk * 8;
        int pk = 0; if (lane < 32) pk = pos[(size_t)m0 * 4 + lane];
#pragma unroll
        for (int tp = 0; tp < 4; ++tp) {
            f32x4 a[2][2], b[2][2]; v4u w[2][2][4];
#pragma unroll
            for (int u = 0; u < 2; ++u) { const int t = 2 * tp + u; GAS f32x4* xo = (GAS f32x4*)(F.out + (size_t)(m0 + t) * D_MODEL) + 2 * lane;
#pragma unroll
                for (int hf = 0; hf < 2; ++hf) { a[u][hf] = xo[128 * hf]; b[u][hf] = xo[128 * hf + 1];
#pragma unroll
                    for (int k = 0; k < 4; ++k) { const int sk = __builtin_amdgcn_readlane(pk, 4 * t + k); w[u][hf][k] = *((const GAS v4u*)(YR + (size_t)sk * D_MODEL + 512 * hf) + lane); } } }
#pragma unroll
            for (int u = 0; u < 2; ++u) { const int t = 2 * tp + u; GAS f32x4* xo = (GAS f32x4*)(F.out + (size_t)(m0 + t) * D_MODEL) + 2 * lane;
#pragma unroll
                for (int hf = 0; hf < 2; ++hf) { f32x4 aa = a[u][hf], bb = b[u][hf];
#pragma unroll
                    for (int k = 0; k < 4; ++k) { const v4u ww = w[u][hf][k];
                        aa[0] += bf_lo(ww.x); aa[1] += bf_hi(ww.x); aa[2] += bf_lo(ww.y); aa[3] += bf_hi(ww.y); bb[0] += bf_lo(ww.z); bb[1] += bf_hi(ww.z); bb[2] += bf_lo(ww.w); bb[3] += bf_hi(ww.w); }
                    xo[128 * hf] = aa; xo[128 * hf + 1] = bb; } }
        }
    }
}

constexpr int N_ATT_A = 768, N_ATT_C = 256;
__device__ __forceinline__ swa::BlockRef attn_item(unsigned char* ws, int it) {
    swa::BlockRef r;
    const swa::bf16* Z = (const swa::bf16*)(ws + WS_Z);
    if (it < N_ATT_A) {
        const int h = it & 3, b = (it >> 2) & 1, v = it >> 3;
        int g, rr, qb;
        if (v < 32) { g = 0; rr = 0; qb = v; } else if (v < 64) { g = 1; rr = (v - 32) >> 3; qb = (v - 32) & 7; } else { g = 2; rr = (v - 64) >> 1; qb = (v - 64) & 1; }
        const int d = (g == 0) ? 1 : (g == 1) ? 4 : 16;
        const size_t row0 = (size_t)b * SEQ + rr, qrow = row0 + (size_t)d * qb * 256;
        r.Q = Z + qrow * IN_COLS + OFF_AQ + g * 512 + h * 128; r.K = Z + row0 * IN_COLS + OFF_AK + g * 512 + h * 128; r.V = Z + row0 * IN_COLS + OFF_AV + g * 512 + h * 128;
        r.O = (swa::bf16*)(ws + WS_OP) + (size_t)g * MTOK * 512 + qrow * 512 + h * 128; r.LSE = (float*)(ws + WS_LSE) + (size_t)g * MTOK * 4 + qrow * 4 + h;
        r.QS = d * IN_COLS; r.KS = d * IN_COLS; r.OS = d * 512; r.LS = d * 4; r.P0 = qb * 256; r.skv = SEQ / d; r.W = 129;
    } else {
        const int u = it - N_ATT_A, h = u & 3, b = (u >> 2) & 1, qb = u >> 3;
        const size_t qrow = (size_t)b * SEQ + (size_t)qb * 256;
        const swa::bf16* KV = (const swa::bf16*)(ws + WS_KVM) + (size_t)b * MEM_LEN * 1024 + h * 128;
        r.Q = Z + qrow * IN_COLS + OFF_CQ + h * 128; r.K = KV; r.V = KV + 512;
        r.O = (swa::bf16*)(ws + WS_YABC) + qrow * 1536 + 1024 + h * 128; r.LSE = nullptr;
        r.QS = IN_COLS; r.KS = 1024; r.OS = 1536; r.LS = 0; r.P0 = 256; r.skv = MEM_LEN; r.W = 1 << 20;
    }
    return r;
}
__device__ __forceinline__ void p3_attention_mfma(unsigned char* ws, char* lds, int G) {
    const int total = N_ATT_A + N_ATT_C; int L = blockIdx.x; if (L >= total) return;
    swa::BlockRef cur = attn_item(ws, L); swa::Seam S;
    swa::swa_prime(cur, lds, S);
    for (;;) {
        const int Ln = L + G; const bool last = Ln >= total;
        const swa::BlockRef nxt = last ? cur : attn_item(ws, Ln);
        swa::swa_block(cur, nxt, lds, S);
        if (last) break;
        cur = nxt; L = Ln;
    }
}

constexpr int N_RITEMS = BATCH * 8 * (SEQ / 64);
constexpr size_t WS_PHI = WS_XN;
constexpr size_t WS_PSI = WS_XN + 16 * MiB;
constexpr size_t WS_GAM = WS_YS;
constexpr size_t WS_OM = WS_XN2;
constexpr size_t WS_XFR = WS_MRG + 48 * MiB;
constexpr size_t WS_BONUS = WS_MRGB + 1 * MiB;
constexpr int RB = 9216, RLD = 72;
constexpr int R1_SEG = 15 * RB, R1_WC = R1_SEG + 2048;
static_assert(R1_WC + 256 <= LDSCTL_OFF, "R1 LDS map");
typedef LAS unsigned short* lbf_t;
__device__ __forceinline__ f32x4 r1_tile(const LAS unsigned short* X, const LAS unsigned short* Yt, int mi, int ni, f32x4 acc, int fr, int fq) {
    const LAS unsigned short* xp = X + (16 * mi + fr) * RLD + 8 * fq; const LAS unsigned short* yp = Yt + (16 * ni + fr) * RLD + 8 * fq;
    const bf16x8 a0 = *(const LAS bf16x8*)xp, a1 = *(const LAS bf16x8*)(xp + 32), b0 = *(const LAS bf16x8*)yp, b1 = *(const LAS bf16x8*)(yp + 32);
    acc = __builtin_amdgcn_mfma_f32_16x16x32_bf16(b0, a0, acc, 0, 0, 0);
    acc = __builtin_amdgcn_mfma_f32_16x16x32_bf16(b1, a1, acc, 0, 0, 0);
    return acc;
}
__device__ __forceinline__ void r1_store(LAS unsigned short* dst, int mi, int ni, f32x4 acc, int mode, bool addI, const LAS unsigned short* addT, int fr, int fq) {
    const int m = 16 * mi + fr, n0 = 16 * ni + 4 * fq;
#pragma unroll
    for (int r = 0; r < 4; ++r) { const int n = n0 + r; bool keep = true;
        if (mode == 1) keep = n < m; else if (mode == 2) keep = n <= m; else if (mode == 3) keep = m < n;
        float v = keep ? acc[r] : 0.f; if (addI && m == n) v += 1.0f; acc[r] = v; }
    if (addT != nullptr) { const unsigned long long w = *(const LAS unsigned long long*)(addT + m * RLD + n0);
        acc[0] += bf_lo((unsigned)w); acc[1] += bf_hi((unsigned)w); acc[2] += bf_lo((unsigned)(w >> 32)); acc[3] += bf_hi((unsigned)(w >> 32)); }
    *(LAS unsigned long long*)(dst + m * RLD + n0) = (unsigned long long)pk2(acc[0], acc[1]) | ((unsigned long long)pk2(acc[2], acc[3]) << 32);
}
#define R1BUF(i) ((LAS unsigned short*)(F.lds + (i) * RB))
template <int MODE> __device__ __forceinline__ void p_r1(Frame& F, const Args& args) {
    unsigned char* ws = F.ws; const int lane0 = F.lane, wave = F.wave;
    const bf16* Z = (const bf16*)(ws + WS_Z);
    const float* rkp = ldarg(I_R_RK); const float* mu = ldarg(I_R_MU); const float* w0p = ldarg(I_R_W0); const float* a0p = ldarg(I_R_A0); const float* kkp = ldarg(I_R_KK); const float* kap = ldarg(I_R_KA);
    const bf16* W2T = (const bf16*)(ws + WS_LORA); const bf16* A2T = W2T + 512 * 64; const bf16* G2T = A2T + 512 * 64;
    bf16* VM = (bf16*)(ws + WS_VMIX); bf16* GM = (bf16*)(ws + WS_GMIX);
    LAS float* segsum = (LAS float*)(F.lds + R1_SEG); LAS float* wcs = (LAS float*)(F.lds + R1_WC);
    unsigned short zv[7][9];
#define R1LOAD(it_) do { const int bh_ = (it_) >> 7, c_ = (it_) & 127, h_ = bh_ & 7, t0_ = c_ * 64 + 8 * wave; \
        const bf16* zp_ = Z + ((size_t)(bh_ >> 3) * SEQ + t0_) * IN_COLS + OFF_R + lane; \
        _Pragma("unroll") for (int i = 0; i < 9; ++i) { const bool ok_ = (i > 0) || (t0_ > 0); const bf16* rp_ = zp_ + ((long)i - 1) * IN_COLS; const bf16* rq_ = rp_ + 64 * h_;     \
            zv[0][i] = ok_ ? rp_[1536] : (unsigned short)0; zv[1][i] = ok_ ? rp_[1600] : (unsigned short)0; zv[2][i] = ok_ ? rp_[1664] : (unsigned short)0; zv[3][i] = ok_ ? rp_[1728] : (unsigned short)0; \
            zv[4][i] = ok_ ? rq_[0] : (unsigned short)0; zv[5][i] = ok_ ? rq_[512] : (unsigned short)0; zv[6][i] = ok_ ? rq_[1024] : (unsigned short)0; } } while (0)
#define ZF(x) __builtin_bit_cast(float, (unsigned)(x) << 16)
    { const int lane = lane0; if (F.vcu < N_RITEMS) R1LOAD(F.vcu); }
    for (int item = F.vcu; item < N_RITEMS; item += F.G) {
        const int lane = opq(lane0), fr = lane & 15, fq = lane >> 4;
        const int bh = item >> 7, c = item & 127, b = bh >> 3, h = bh & 7;
        const size_t row0 = (size_t)b * SEQ + (size_t)c * 64;
        const f32x4 zero4 = (f32x4){0.f, 0.f, 0.f, 0.f};
        const int mw = wave >> 2, nw = wave & 3;
        float r[8], lw[8], kx[8], vx[8], ax[8], bx[8];
        { const int k = lane, tq = wave, ch = h * 64 + k;
#pragma unroll
          for (int g = 0; g < 4; ++g) { const float mug = mu[1536 + 64 * g + k];
#pragma unroll
              for (int i = 0; i < 8; ++i) { const float cur = ZF(zv[g][i + 1]), prv = ZF(zv[g][i]); float x = cur + (prv - cur) * mug;
                  x = (g == 0) ? fast_tanh(x) : (g == 1) ? x : fast_sigm(x); const unsigned short xb = (unsigned short)f2bf(x); const int t = 8 * tq + i;
                  if (g == 0) R1BUF(11)[t * RLD + k] = xb; else if (g == 1) R1BUF(12)[t * RLD + k] = xb; else R1BUF(13)[t * 136 + 64 * (g - 2) + k] = xb; } }
          { const int tid_ = wave * 64 + lane, row = tid_ >> 3, chk = tid_ & 7;
            *(LAS v4u*)(R1BUF(5) + row * RLD + chk * 8) = *(const GAS v4u*)(W2T + (size_t)(64 * h + row) * 64 + chk * 8);
            *(LAS v4u*)(R1BUF(6) + row * RLD + chk * 8) = *(const GAS v4u*)(A2T + (size_t)(64 * h + row) * 64 + chk * 8);
#pragma unroll
            for (int hh = 0; hh < 2; ++hh) { const int rg = (tid_ >> 4) + 32 * hh, cg = tid_ & 15;
                *(LAS v4u*)(R1BUF(7) + rg * 136 + cg * 8) = *(const GAS v4u*)(G2T + (size_t)(64 * h + rg) * 128 + cg * 8); } }
          __syncthreads();
          { f32x4 dw0, dw1, da0, da1, dg0 = zero4, dg1 = zero4;
            { const LAS unsigned short* yp_ = R1BUF(5) + (16 * nw + fr) * RLD + 8 * fq; const LAS unsigned short* xp_ = R1BUF(11) + (16 * mw + fr) * RLD + 8 * fq;
              const bf16x8 y0_ = *(const LAS bf16x8*)yp_, y1_ = *(const LAS bf16x8*)(yp_ + 32), xa0_ = *(const LAS bf16x8*)xp_, xa1_ = *(const LAS bf16x8*)(xp_ + 32), xb0_ = *(const LAS bf16x8*)(xp_ + 32 * RLD), xb1_ = *(const LAS bf16x8*)(xp_ + 32 * RLD + 32);
              dw0 = __builtin_amdgcn_mfma_f32_16x16x32_bf16(y0_, xa0_, zero4, 0, 0, 0); dw1 = __builtin_amdgcn_mfma_f32_16x16x32_bf16(y0_, xb0_, zero4, 0, 0, 0);
              dw0 = __builtin_amdgcn_mfma_f32_16x16x32_bf16(y1_, xa1_, dw0, 0, 0, 0); dw1 = __builtin_amdgcn_mfma_f32_16x16x32_bf16(y1_, xb1_, dw1, 0, 0, 0); }
            { const LAS unsigned short* yp_ = R1BUF(6) + (16 * nw + fr) * RLD + 8 * fq; const LAS unsigned short* xp_ = R1BUF(12) + (16 * mw + fr) * RLD + 8 * fq;
              const bf16x8 y0_ = *(const LAS bf16x8*)yp_, y1_ = *(const LAS bf16x8*)(yp_ + 32), xa0_ = *(const LAS bf16x8*)xp_, xa1_ = *(const LAS bf16x8*)(xp_ + 32), xb0_ = *(const LAS bf16x8*)(xp_ + 32 * RLD), xb1_ = *(const LAS bf16x8*)(xp_ + 32 * RLD + 32);
              da0 = __builtin_amdgcn_mfma_f32_16x16x32_bf16(y0_, xa0_, zero4, 0, 0, 0); da1 = __builtin_amdgcn_mfma_f32_16x16x32_bf16(y0_, xb0_, zero4, 0, 0, 0);
              da0 = __builtin_amdgcn_mfma_f32_16x16x32_bf16(y1_, xa1_, da0, 0, 0, 0); da1 = __builtin_amdgcn_mfma_f32_16x16x32_bf16(y1_, xb1_, da1, 0, 0, 0); }
            { const LAS unsigned short* yp_ = R1BUF(7) + (16 * nw + fr) * 136 + 8 * fq; const LAS unsigned short* xp_ = R1BUF(13) + (16 * mw + fr) * 136 + 8 * fq;
#pragma unroll
              for (int kk = 0; kk < 4; ++kk) { const bf16x8 y_ = *(const LAS bf16x8*)(yp_ + 32 * kk), xa_ = *(const LAS bf16x8*)(xp_ + 32 * kk), xb_ = *(const LAS bf16x8*)(xp_ + 32 * 136 + 32 * kk);
                  dg0 = __builtin_amdgcn_mfma_f32_16x16x32_bf16(y_, xa_, dg0, 0, 0, 0); dg1 = __builtin_amdgcn_mfma_f32_16x16x32_bf16(y_, xb_, dg1, 0, 0, 0); } }
            const int o0 = (16 * mw + fr) * 68 + 16 * nw + 4 * fq, o1 = o0 + 32 * 68;
            *(LAS f32x4*)((LAS float*)R1BUF(0) + o0) = dw0; *(LAS f32x4*)((LAS float*)R1BUF(0) + o1) = dw1;
            *(LAS f32x4*)((LAS float*)R1BUF(2) + o0) = da0; *(LAS f32x4*)((LAS float*)R1BUF(2) + o1) = da1;
            *(LAS f32x4*)((LAS float*)R1BUF(9) + o0) = dg0; *(LAS f32x4*)((LAS float*)R1BUF(9) + o1) = dg1; }
          __syncthreads();
          { const float w0c = w0p[ch], a0c = a0p[ch], kkc = kkp[ch], kac = kap[ch], mur = mu[ch], muk = mu[512 + ch], muv = mu[1024 + ch];
#pragma unroll
            for (int i = 0; i < 8; ++i) { const int t = 8 * tq + i;
                const float dwv = ((const LAS float*)R1BUF(0))[t * 68 + k], dav = ((const LAS float*)R1BUF(2))[t * 68 + k], dgv = ((const LAS float*)R1BUF(9))[t * 68 + k];
                const float cr = ZF(zv[4][i + 1]), pr = ZF(zv[4][i]), ck = ZF(zv[5][i + 1]), pk = ZF(zv[5][i]), cv = ZF(zv[6][i + 1]), pv = ZF(zv[6][i]);
                const float rr = cr + (pr - cr) * mur, kr = ck + (pk - ck) * muk, vr = cv + (pv - cv) * muv;
                const float y = -(w0c + dwv); const float sp = fast_softplus(y);
                lw[i] = -__expf(-sp - 0.5f);
                const float av = fast_sigm(a0c + dav);
                const float kkv = kr * kkc; const float ssq = wave_sum(kkv * kkv); const float kkn = kkv * __builtin_amdgcn_rsqf(fmaxf(ssq, 1e-24f));
                r[i] = rr; vx[i] = vr; kx[i] = kr * (1.0f + (av - 1.0f) * kac); ax[i] = -kkn; bx[i] = kkn * av;
                if (MODE == 0) { VM[(row0 + t) * RW + ch] = (bf16)f2bf(vr); GM[(row0 + t) * RW + ch] = (bf16)f2bf(dgv); } } }
        }
        if (item + F.G < N_RITEMS) R1LOAD(item + F.G);
        { const int k = lane, tq = wave;
          float cs[8]; cs[0] = lw[0];
#pragma unroll
          for (int i = 1; i < 8; ++i) cs[i] = cs[i - 1] + lw[i];
          segsum[tq * 64 + k] = cs[7];
          const float rk = rkp[h * 64 + k];
#pragma unroll
          for (int i = 0; i < 8; ++i) { const float bs = wave_sum(r[i] * kx[i] * rk); if (MODE == 0 && lane == 0) *(GAS float*)((float*)(ws + WS_BONUS) + (row0 + 8 * tq + i) * 8 + h) = bs; }
          __syncthreads();
          float pre = 0.f;
#pragma unroll
          for (int q = 0; q < 7; ++q) { const float sv = segsum[q * 64 + k]; pre += (q < tq) ? sv : 0.f; }
          unsigned short at[8], rt[8], bt[8], kt[8], vt[8];
#pragma unroll
          for (int i = 0; i < 8; ++i) { const float L = pre + cs[i], Lp = L - lw[i]; const float e = __expf(L), ep = __expf(Lp), ei = __expf(-L);
              at[i] = (unsigned short)f2bf(ax[i] * ep); rt[i] = (unsigned short)f2bf(r[i] * e); bt[i] = (unsigned short)f2bf(bx[i] * ei); kt[i] = (unsigned short)f2bf(kx[i] * ei); vt[i] = (unsigned short)f2bf(vx[i]);
              if (i == 7 && tq == 7) wcs[k] = e; }
#pragma unroll
          for (int i = 0; i < 8; ++i) { const int o = (8 * tq + i) * RLD + k; R1BUF(8)[o] = at[i]; R1BUF(4)[o] = rt[i]; R1BUF(9)[o] = bt[i]; R1BUF(10)[o] = kt[i]; }
          const int ot = k * RLD + 8 * tq;
#define PK8(x) ((v4u){(unsigned)x[0] | ((unsigned)x[1] << 16), (unsigned)x[2] | ((unsigned)x[3] << 16), (unsigned)x[4] | ((unsigned)x[5] << 16), (unsigned)x[6] | ((unsigned)x[7] << 16)})
          *(LAS v4u*)(R1BUF(0) + ot) = PK8(at); *(LAS v4u*)(R1BUF(1) + ot) = PK8(bt); *(LAS v4u*)(R1BUF(2) + ot) = PK8(kt); *(LAS v4u*)(R1BUF(3) + ot) = PK8(vt);
#undef PK8
        }
        __syncthreads();
#define R1PAIR(X, Y, a0, a1) do { const LAS unsigned short* yp_ = (Y) + (16 * nw + fr) * RLD + 8 * fq; const LAS unsigned short* xp_ = (X) + (16 * mw + fr) * RLD + 8 * fq; \
            const bf16x8 y0_ = *(const LAS bf16x8*)yp_, y1_ = *(const LAS bf16x8*)(yp_ + 32), xa0_ = *(const LAS bf16x8*)xp_, xa1_ = *(const LAS bf16x8*)(xp_ + 32), xb0_ = *(const LAS bf16x8*)(xp_ + 32 * RLD), xb1_ = *(const LAS bf16x8*)(xp_ + 32 * RLD + 32); \
            a0 = __builtin_amdgcn_mfma_f32_16x16x32_bf16(y0_, xa0_, zero4, 0, 0, 0); a1 = __builtin_amdgcn_mfma_f32_16x16x32_bf16(y0_, xb0_, zero4, 0, 0, 0); \
            a0 = __builtin_amdgcn_mfma_f32_16x16x32_bf16(y1_, xa1_, a0, 0, 0, 0); a1 = __builtin_amdgcn_mfma_f32_16x16x32_bf16(y1_, xb1_, a1, 0, 0, 0); } while (0)
#define R1ST2(dst, a0, a1, mode, addI, addT) do { r1_store(dst, mw, nw, a0, mode, addI, addT, fr, fq); r1_store(dst, mw + 2, nw, a1, mode, addI, addT, fr, fq); } while (0)
        { f32x4 n0, n1, t0, t1, l0, l1, b0, b1, k0, k1;
          R1PAIR(R1BUF(8), R1BUF(9), n0, n1); R1PAIR(R1BUF(9), R1BUF(8), t0, t1); R1PAIR(R1BUF(8), R1BUF(10), l0, l1); R1PAIR(R1BUF(4), R1BUF(9), b0, b1); R1PAIR(R1BUF(4), R1BUF(10), k0, k1);
          R1ST2(R1BUF(11), n0, n1, 1, false, nullptr); R1ST2(R1BUF(13), n0, n1, 1, true, nullptr); R1ST2(R1BUF(12), t0, t1, 3, false, nullptr);
          R1ST2(R1BUF(5), l0, l1, 1, false, nullptr); R1ST2(R1BUF(6), b0, b1, 2, false, nullptr); R1ST2(R1BUF(7), k0, k1, 2, false, nullptr); }
        __syncthreads();
        { f32x4 n0, n1, t0, t1, e0, e1;
          R1PAIR(R1BUF(11), R1BUF(12), n0, n1); R1PAIR(R1BUF(12), R1BUF(11), t0, t1); R1PAIR(R1BUF(3), R1BUF(5), e0, e1);
          R1ST2(R1BUF(8), n0, n1, 0, false, nullptr); R1ST2(R1BUF(9), t0, t1, 0, false, nullptr); R1ST2(R1BUF(10), e0, e1, 0, false, nullptr); }
        __syncthreads();
#pragma unroll 1
        for (int lv = 0; lv < 5; ++lv) {
            const bool srcB = (lv & 1) == 0;
            LAS unsigned short* sN = srcB ? R1BUF(8) : R1BUF(11); LAS unsigned short* sNT = srcB ? R1BUF(9) : R1BUF(12);
            LAS unsigned short* dN = srcB ? R1BUF(11) : R1BUF(8); LAS unsigned short* dNT = srcB ? R1BUF(12) : R1BUF(9);
            LAS unsigned short* Tc = (lv & 1) ? R1BUF(14) : R1BUF(13); LAS unsigned short* Tn = (lv & 1) ? R1BUF(13) : R1BUF(14);
            f32x4 u0, u1, t0 = zero4, t1 = zero4, n0 = zero4, n1 = zero4;
            R1PAIR(Tc, sNT, u0, u1);
            if (lv < 4) R1PAIR(sNT, sN, t0, t1);
            if (lv < 3) R1PAIR(sN, sNT, n0, n1);
            R1ST2(Tn, u0, u1, 0, false, Tc);
            if (lv < 4) R1ST2(dNT, t0, t1, 0, false, nullptr);
            if (lv < 3) R1ST2(dN, n0, n1, 0, false, nullptr);
            __syncthreads();
        }
        { f32x4 g0, g1, q0, q1;
          R1PAIR(R1BUF(0), R1BUF(14), g0, g1); R1PAIR(R1BUF(10), R1BUF(14), q0, q1);
          R1ST2(R1BUF(11), g0, g1, 0, false, nullptr); R1ST2(R1BUF(12), q0, q1, 0, false, nullptr); }
        __syncthreads();
#undef R1PAIR
#undef R1ST2
        { const int mi = wave >> 1, ks = wave & 1;
          const f32x4 p0 = r1_tile(R1BUF(1), R1BUF(11), mi, 2 * ks, zero4, fr, fq), p1 = r1_tile(R1BUF(1), R1BUF(11), mi, 2 * ks + 1, zero4, fr, fq);
          const f32x4 s0 = r1_tile(R1BUF(6), R1BUF(11), mi, 2 * ks, zero4, fr, fq), s1 = r1_tile(R1BUF(6), R1BUF(11), mi, 2 * ks + 1, zero4, fr, fq);
          const int m = 16 * mi + fr; const float wc = wcs[m];
          float ph[8], ps[8];
#pragma unroll
          for (int r = 0; r < 4; ++r) { const int n0 = 32 * ks + 4 * fq + r, n1 = n0 + 16;
              ph[r] = (p0[r] + (m == n0 ? 1.f : 0.f)) * wc; ph[4 + r] = (p1[r] + (m == n1 ? 1.f : 0.f)) * wc; }
          { const unsigned long long w0 = *(const LAS unsigned long long*)(R1BUF(4) + m * RLD + 32 * ks + 4 * fq), w1 = *(const LAS unsigned long long*)(R1BUF(4) + m * RLD + 32 * ks + 16 + 4 * fq);
            ps[0] = s0[0] + bf_lo((unsigned)w0); ps[1] = s0[1] + bf_hi((unsigned)w0); ps[2] = s0[2] + bf_lo((unsigned)(w0 >> 32)); ps[3] = s0[3] + bf_hi((unsigned)(w0 >> 32));
            ps[4] = s1[0] + bf_lo((unsigned)w1); ps[5] = s1[1] + bf_hi((unsigned)w1); ps[6] = s1[2] + bf_lo((unsigned)(w1 >> 32)); ps[7] = s1[3] + bf_hi((unsigned)(w1 >> 32)); }
          const size_t fo = (((size_t)item * 4 + mi) * 2 + ks) * 64 + lane;
          if (MODE == 0) *((GAS v4u*)(ws + WS_PHI) + fo) = (v4u){pk2(ph[0], ph[1]), pk2(ph[2], ph[3]), pk2(ph[4], ph[5]), pk2(ph[6], ph[7])};
          if (MODE == 0) *((GAS v4u*)(ws + WS_PSI) + fo) = (v4u){pk2(ps[0], ps[1]), pk2(ps[2], ps[3]), pk2(ps[4], ps[5]), pk2(ps[6], ps[7])};
          const int vb = wave >> 1;
#pragma unroll
          for (int hh = 0; hh < 2; ++hh) { const int mt = 2 * (wave & 1) + hh;
              f32x4 ga = r1_tile(R1BUF(12), R1BUF(1), vb, mt, zero4, fr, fq); ga = r1_tile(R1BUF(3), R1BUF(2), vb, mt, ga, fr, fq);
              f32x4 om = r1_tile(R1BUF(12), R1BUF(6), vb, mt, zero4, fr, fq); om = r1_tile(R1BUF(3), R1BUF(7), vb, mt, om, fr, fq);
#pragma unroll
              for (int r = 0; r < 4; ++r) ga[r] *= wcs[16 * mt + 4 * fq + r];
              const size_t ao = (((size_t)item * 4 + vb) * 4 + mt) * 64 + lane;
              if (MODE == 0) { *((GAS f32x4*)(ws + WS_GAM) + ao) = ga; *((GAS f32x4*)(ws + WS_OM) + ao) = om; } else { asm volatile("" :: "v"(ga), "v"(om)); } }
        }
        __syncthreads();
    }
}
#undef R1BUF
#undef R1LOAD
#undef ZF
struct R2Buf { bf16x8 ph[4][2]; f32x4 ga[4]; };
__device__ __forceinline__ void r2_load(R2Buf& B, const unsigned char* ws, int item, int vb, int lane) {
#pragma unroll
    for (int mt = 0; mt < 4; ++mt) {
#pragma unroll
        for (int ks = 0; ks < 2; ++ks) B.ph[mt][ks] = *((const GAS bf16x8*)(ws + WS_PHI) + (((size_t)item * 4 + mt) * 2 + ks) * 64 + lane);
        B.ga[mt] = *((const GAS f32x4*)(ws + WS_GAM) + (((size_t)item * 4 + vb) * 4 + mt) * 64 + lane); }
}
__device__ __forceinline__ void r2_step(const R2Buf& B, f32x4 (&acc)[4], unsigned char* ws, int item, int vb, int lane) {
    v4u x0, x1;
    x0.x = pk2(acc[0][0], acc[0][1]); x0.y = pk2(acc[0][2], acc[0][3]); x0.z = pk2(acc[1][0], acc[1][1]); x0.w = pk2(acc[1][2], acc[1][3]);
    x1.x = pk2(acc[2][0], acc[2][1]); x1.y = pk2(acc[2][2], acc[2][3]); x1.z = pk2(acc[3][0], acc[3][1]); x1.w = pk2(acc[3][2], acc[3][3]);
    GAS v4u* xo = (GAS v4u*)(ws + WS_XFR) + (((size_t)item * 4 + vb) * 2) * 64 + lane; xo[0] = x0; xo[64] = x1;
    const bf16x8 f0 = __builtin_bit_cast(bf16x8, x0), f1 = __builtin_bit_cast(bf16x8, x1);
#pragma unroll
    for (int mt = 0; mt < 4; ++mt) { f32x4 a = B.ga[mt];
        a = __builtin_amdgcn_mfma_f32_16x16x32_bf16(B.ph[mt][0], f0, a, 0, 0, 0);
        a = __builtin_amdgcn_mfma_f32_16x16x32_bf16(B.ph[mt][1], f1, a, 0, 0, 0);
        acc[mt] = a; }
}
__device__ __forceinline__ void p_r2(Frame& F) {
    if (blockIdx.x < BATCH * 8 * 4 && F.wave == 0) {
        unsigned char* ws = F.ws; const int bh = blockIdx.x >> 2, vb = blockIdx.x & 3, lane = F.lane;
        f32x4 acc[4];
#pragma unroll
        for (int i = 0; i < 4; ++i) acc[i] = (f32x4){0.f, 0.f, 0.f, 0.f};
        R2Buf A, B, C, D;
        const int it0 = bh * 128;
        r2_load(A, ws, it0, vb, lane); r2_load(B, ws, it0 + 1, vb, lane); r2_load(C, ws, it0 + 2, vb, lane);
#define R2SB() __builtin_amdgcn_sched_barrier(0)
#pragma unroll
        for (int c = 0; c < 128; c += 4) {
            r2_load(D, ws, it0 + c + 3, vb, lane); R2SB(); r2_step(A, acc, ws, it0 + c, vb, lane); R2SB();
            r2_load(A, ws, it0 + (c + 4 < 128 ? c + 4 : 127), vb, lane); R2SB(); r2_step(B, acc, ws, it0 + c + 1, vb, lane); R2SB();
            r2_load(B, ws, it0 + (c + 5 < 128 ? c + 5 : 127), vb, lane); R2SB(); r2_step(C, acc, ws, it0 + c + 2, vb, lane); R2SB();
            r2_load(C, ws, it0 + (c + 6 < 128 ? c + 6 : 127), vb, lane); R2SB(); r2_step(D, acc, ws, it0 + c + 3, vb, lane); R2SB();
        }
#undef R2SB
    }
}
__device__ __forceinline__ void p_r3(Frame& F, const Args& args) {
    const int gw = F.vcu * NWAVES + F.wave, NGW = F.G * NWAVES, lane = F.lane, cc = lane & 15, q = lane >> 4;
    unsigned char* ws = F.ws;
    const bf16* VM = (const bf16*)(ws + WS_VMIX); const bf16* GM = (const bf16*)(ws + WS_GMIX);
    const float* bonus = (const float*)(ws + WS_BONUS);
    bf16* YB = (bf16*)(ws + WS_YABC) + 512;
    const float* lnw = ldarg(I_R_LNW); const float* lnb = ldarg(I_R_LNB);
#pragma unroll 2
    for (int wi = gw; wi < N_RITEMS * 4; wi += NGW) {
        const int item = wi >> 2, tt = wi & 3, bh = item >> 7, c = item & 127, b = bh >> 3, h = bh & 7;
        const bf16x8 ps0 = *((const GAS bf16x8*)(ws + WS_PSI) + (((size_t)item * 4 + tt) * 2 + 0) * 64 + lane), ps1 = *((const GAS bf16x8*)(ws + WS_PSI) + (((size_t)item * 4 + tt) * 2 + 1) * 64 + lane);
        f32x4 acc[4];
#pragma unroll
        for (int vb = 0; vb < 4; ++vb) {
            const bf16x8 x0 = *((const GAS bf16x8*)(ws + WS_XFR) + (((size_t)item * 4 + vb) * 2 + 0) * 64 + lane), x1 = *((const GAS bf16x8*)(ws + WS_XFR) + (((size_t)item * 4 + vb) * 2 + 1) * 64 + lane);
            f32x4 a = *((const GAS f32x4*)(ws + WS_OM) + (((size_t)item * 4 + vb) * 4 + tt) * 64 + lane);
            a = __builtin_amdgcn_mfma_f32_16x16x32_bf16(ps0, x0, a, 0, 0, 0);
            a = __builtin_amdgcn_mfma_f32_16x16x32_bf16(ps1, x1, a, 0, 0, 0);
            acc[vb] = a; }
        const size_t rowb = (size_t)b * SEQ + (size_t)c * 64 + 16 * tt + 4 * q;
#pragma unroll
        for (int r = 0; r < 4; ++r) { const size_t t = rowb + r;
            const float s = (acc[0][r] + acc[1][r]) + (acc[2][r] + acc[3][r]);
            const float mean = row16_sum(s) * (1.f / 64.f);
            const float d0 = acc[0][r] - mean, d1 = acc[1][r] - mean, d2 = acc[2][r] - mean, d3 = acc[3][r] - mean;
            const float var = row16_sum((d0 * d0 + d1 * d1) + (d2 * d2 + d3 * d3)) * (1.f / 64.f);
            const float rstd = 1.0f / sqrtf(var + R_GN_EPS);
            const float bn = bonus[t * 8 + h];
#pragma unroll
            for (int vb = 0; vb < 4; ++vb) { const int ch = h * 64 + 16 * vb + cc; const float d = (vb == 0) ? d0 : (vb == 1) ? d1 : (vb == 2) ? d2 : d3;
                const float yn = d * rstd * lnw[ch] + lnb[ch];
                const float vv = __builtin_bit_cast(float, (unsigned)VM[t * RW + ch] << 16), gg = __builtin_bit_cast(float, (unsigned)GM[t * RW + ch] << 16);
                YB[t * 1536 + ch] = (bf16)f2bf((yn + bn * vv) * gg); } }
    }
}

__global__ void __launch_bounds__(NWAVES * 64, 2) skel_fwd(Args args) {
    extern __shared__ __attribute__((aligned(16))) unsigned char lds[];
    Frame F;
    F.lds = (LAS unsigned char*)lds;
    F.MISC = (volatile LAS unsigned*)(F.lds + MISC_OFF);
    phase_enter(F, true);
    F.G = gridDim.x; { const int bx = blockIdx.x; F.vcu = (F.G % 8 == 0) ? (bx % 8) * (F.G / 8) + bx / 8 : bx; }
    unsigned char* ws = args.ws; F.ws = ws; F.out = args.out;
    F.ctl = (gu32*)(ws + WS_CTL);
    for (int u = F.tid; u < (LDS_BYTES - LDSCTL_OFF) / 4; u += NWAVES * 64) ((LAS unsigned*)(F.lds + LDSCTL_OFF))[u] = 0u;
    __syncthreads();
    XcdBarrier bar; bar.bar = (unsigned*)(F.ctl + CW_BAR); bar.x = 0; bar.st = nullptr;
    if (args.use_bar) bar = xcd_barrier_post((unsigned*)(F.ctl + CW_BAR), F.MISC + 8);
    const int lo = args.ph_lo, hi = args.ph_hi;
#define IN(k) (phase_enter(F, lo <= (k) && (k) < hi))
#define SEAM(k) do { if (lo <= (k) && (k) + 1 < hi) xcd_barrier(bar); } while (0)
    const pg8::bf16_t* wsb = (const pg8::bf16_t*)ws;
#define BF(off) ((pg8::bf16_t*)(ws + (off)))

    if (IN(0)) { p0_prologue<0>(F, args, F.vcu * NWAVES + F.wave, F.G * NWAVES); if (F.G <= 64) p0_prologue<1>(F, args, F.vcu * NWAVES + F.wave, F.G * NWAVES); } SEAM(0);
    if (IN(1)) {
        { pg8::Gemm g{BF(WS_XN), BF(WS_WIN), MTOK, IN_COLS, 1024}; pg8::StaticOrder S; S.init(MTOK, IN_COLS, F.G, (int)blockIdx.x);
          pg8::EpiZ E{BF(WS_Z), ldarg(I_B_GATE), ldarg(I_AQ_GAIN), ldarg(I_AK_GAIN), ldarg(I_CQ_GAIN), (const float*)(ws + WS_CS), (PG8_LAS float*)(F.lds + 131072), IN_COLS, 0};
          pg8::gemm_phase<pg8::EpiZ, pg8::StaticOrder, true, true>(F.lds + RING_OFF, g, S, E); }
        { pg8::Gemm g{BF(WS_MEMN), BF(WS_WMEM), MEMROWS, 1024, 1024}; pg8::StaticOrder S; S.init(MEMROWS, 1024, F.G, (int)blockIdx.x);
          const float* ckg_ = ldarg(I_CK_GAIN);
          pg8::EpiZ E{BF(WS_KVM), ckg_, ckg_, ckg_, ckg_, ckg_, (PG8_LAS float*)(F.lds + 131072), 1024, 1};
          pg8::gemm_phase<pg8::EpiZ, pg8::StaticOrder, true, true>(F.lds + RING_OFF, g, S, E); }
    } SEAM(1);
#if NAIVE_ATTN
    if (IN(3)) { p3_attention(F); } SEAM(3);
#else
    if (IN(3)) { p3_attention_mfma(ws, (char*)lds + RING_OFF, F.G); __syncthreads(); phase_enter(F, true); p_r1<0>(F, args); } SEAM(3);
#endif
    if (IN(4)) { p_r2(F); if (F.G > 64 && blockIdx.x >= 64) p0_prologue<1>(F, args, ((int)blockIdx.x - 64) * NWAVES + F.wave, (F.G - 64) * NWAVES); } SEAM(4);
    if (IN(5)) { p_r3(F, args); p5_post(F, args); } SEAM(5);
    if (IN(6)) {
        pg8::Gemm g{BF(WS_YABC), BF(WS_WB), MTOK, 1024, 1536}; pg8::StaticOrder S; S.init(MTOK, 1024, F.G, (int)blockIdx.x);
        pg8::EpiGate3 E{BF(WS_Z), BF(WS_MRGB)};
        pg8::gemm_phase<pg8::EpiGate3, pg8::StaticOrder, true, true>(F.lds + RING_OFF, g, S, E);
    } SEAM(6);
    if (IN(7)) {
        pg8::Gemm g{BF(WS_MRGB), BF(WS_WO), MTOK, 1024, 1024}; pg8::StaticOrder S; S.init(MTOK, 1024, F.G, (int)blockIdx.x);
        pg8::EpiResF32 E{ldarg(I_X), F.out, 1024};
        pg8::gemm_phase<pg8::EpiResF32, pg8::StaticOrder, true, true>(F.lds + RING_OFF, g, S, E);
    } SEAM(7);
    if (IN(8)) { p8_router(F, args); } SEAM(8);
    if (IN(9)) { p9_dispatch(F, args); } SEAM(9);
    if (IN(10)) {
        moe_table(F);
        pg8::Gemm g{BF(WS_XS), BF(WS_W1), 0, 0, 1024, SC_ONE, SC_W8}; pg8::MoeOrder S{(const PG8_LAS int*)(F.lds + MOETAB_OFF), 8, F.G, (int)blockIdx.x};
        pg8::EpiSwiGLU E{ldarg(I_EXP_B1), BF(WS_HACT)};
        pg8::gemm_phase<pg8::EpiSwiGLU, pg8::MoeOrder, true, true, true>(F.lds + RING_OFF, g, S, E);
    } SEAM(10);
    if (IN(11)) {
        moe_table(F);
        pg8::Gemm g{BF(WS_HACT), BF(WS_W2), 0, 0, 1024, SC_H8, SC_W8}; pg8::MoeOrder S{(const PG8_LAS int*)(F.lds + MOETAB_OFF), 4, F.G, (int)blockIdx.x};
        pg8::EpiMoeOut E{ldarg(I_EXP_B2), (const float*)(ws + WS_ROUTE + RT_ROWGATE), BF(WS_YROWS)};
        pg8::gemm_phase<pg8::EpiMoeOut, pg8::MoeOrder, true, true, true>(F.lds + RING_OFF, g, S, E);
    } SEAM(11);
    if (IN(12)) { p12_combine(F); }
#undef IN
#undef SEAM
#undef BF
    (void)wsb;
}

extern "C" void kernel_launch(void* const* d_in, const int* in_sizes, int n_in, void* d_out, int out_size, void* d_ws, size_t ws_size, hipStream_t stream) {
    static int grid = 0;
    if (grid == 0) {
        if (n_in != 32 || out_size != MTOK * D_MODEL || ws_size < WS_END) { fprintf(stderr, "kernel_launch: unexpected problem (n_in %d, out %d, ws %zu); nothing launched\n", n_in, out_size, ws_size); grid = -1; return; }
        int dev = 0, cus = 0;
        if (hipGetDevice(&dev) != hipSuccess || hipDeviceGetAttribute(&cus, hipDeviceAttributeMultiprocessorCount, dev) != hipSuccess) { grid = -1; return; }
        if (hipFuncSetAttribute((const void*)skel_fwd, hipFuncAttributeMaxDynamicSharedMemorySize, LDS_BYTES) != hipSuccess) { fprintf(stderr, "kernel_launch: hipFuncSetAttribute failed\n"); grid = -1; return; }
        (void)hipGetLastError();
        grid = cus;
    }
    if (grid < 0) return;
    (void)hipMemsetAsync((char*)d_ws + WS_CTL, 0, CTL_ZERO_BYTES, stream);
    Args a{};
    for (int i = 0; i < 32; ++i) a.in[i] = (const float*)d_in[i];
    a.out = (float*)d_out; a.ws = (unsigned char*)d_ws;
#if MK_N_LAUNCHES == 1
    a.ph_lo = 0; a.ph_hi = N_PHASES; a.use_bar = 1;
    hipLaunchKernelGGL(skel_fwd, dim3(grid), dim3(NWAVES * 64), LDS_BYTES, stream, a);
#else
    for (int p = 0; p < N_PHASES; ++p) { a.ph_lo = p; a.ph_hi = p + 1; a.use_bar = 0;
        hipLaunchKernelGGL(skel_fwd, dim3(grid), dim3(NWAVES * 64), LDS_BYTES, stream, a); }
#endif
}
```

```cpp
#include <hip/hip_runtime.h>
#include <cstdio>
#include <cstdint>
#include <cmath>
namespace pg8 {
#define PG8_LAS __attribute__((address_space(3)))
typedef unsigned short bf16_t;
typedef short bf16x8 __attribute__((ext_vector_type(8)));
typedef float f32x4 __attribute__((ext_vector_type(4)));
typedef unsigned u32x4 __attribute__((ext_vector_type(4)));
constexpr int BM = 256, BK = 64, HALF = 128, HTB = HALF * BK * 2  , STAGE_BYTES = 8 * HTB, NXCD = 8, WGM = 8;

__host__ __device__ __forceinline__ int lds_byte(int r, int c) { const int st = (r >> 4) * 2 + (c >> 5), rr = r & 15, cc = c & 31, ob = rr * 64 + cc * 2; return st * 1024 + (ob ^ (((ob >> 9) & 1) << 5)); }
__host__ __device__ __forceinline__ void stage_rc(int b, int& R, int& C) { const int st = b / 1024, sb = b % 1024, swz = sb ^ (((sb >> 9) & 1) << 5); R = (st >> 1) * 16 + swz / 64; C = (st & 1) * 32 + (swz % 64) / 2; }
__host__ __device__ __forceinline__ int perm32(int rho) { const int n = rho >> 4, i = rho & 15; return 8 * (i >> 2) + 4 * n + (i & 3); }

struct Unit { int pm, pn; };
typedef int v4i_t __attribute__((ext_vector_type(4))); typedef int v8i_t __attribute__((ext_vector_type(8)));
struct Gemm { const bf16_t* A; const bf16_t* Bt; int M, N, K; int sca = 0x7f7f7f7f, scb = 0x7f7f7f7f; };

struct StaticOrder {
    int nM, nN, nwg, G, c;
    __host__ __device__ void init(int M, int N, int G_, int c_) { nM = M / BM; nN = N / BM; nwg = nM * nN; G = G_; c = c_; }
    __host__ __device__ bool next(int i, Unit& u) const {
        const long L = (long)i * G + c; if (L >= nwg) return false;
        int wgid = (int)L; { const int q = nwg / NXCD, r = nwg % NXCD, xcd = wgid % NXCD, off = wgid / NXCD; wgid = (xcd < r ? xcd * (q + 1) : r * (q + 1) + (xcd - r) * q) + off; }
        const int nig = WGM * nN, gid = wgid / nig, fm = gid * WGM, gsz = (nM - fm) < WGM ? (nM - fm) : WGM;
        u.pm = fm + ((wgid % nig) % gsz); u.pn = (wgid % nig) / gsz; return true;
    }
    __device__ __forceinline__ void a_ready(const Unit&) const {}
    __device__ __forceinline__ void done(const Unit&) const {}
};

__device__ __forceinline__ unsigned cvt_pk_bf16(float lo, float hi) { unsigned r; asm volatile("v_cvt_pk_bf16_f32 %0, %1, %2" : "=v"(r) : "v"(lo), "v"(hi)); return r; }
typedef float f32x2 __attribute__((ext_vector_type(2)));
__device__ __forceinline__ f32x2 gelu_pk(f32x2 v) {
    const f32x2 av = __builtin_elementwise_abs(v), d = av * 0.2316418882f + 1.0f;
    f32x2 t; t.x = __builtin_amdgcn_rcpf(d.x); t.y = __builtin_amdgcn_rcpf(d.y);
    f32x2 q = t * 0.5307027145f + (-0.7265760135f); q = q * t + 0.7107068705f; q = q * t + (-0.142248368f); q = q * t + 0.127414796f; q = q * t;
    const f32x2 s = (v * v) * (-0.72134752044f);
    f32x2 e; e.x = __builtin_amdgcn_exp2f(s.x); e.y = __builtin_amdgcn_exp2f(s.y);
    const f32x2 m = v * (q * e), r = v - m;
    f32x2 o; o.x = v.x < 0.f ? m.x : r.x; o.y = v.y < 0.f ? m.y : r.y; return o;
}

template <int ACT  > struct EpiBf16 {
    static constexpr bool PERM = true, AFTER_DRAIN = false; static_assert(ACT == 0 || ACT == 1, "EpiBf16: ACT is 0 (none) or 1 (gelu_pk)");
    bf16_t* O; int ldc; const float* bias; int split_cols; size_t split_stride; float scale0;
    __device__ __forceinline__ void operator()(const f32x4 (&acc)[2][2][4][2], const Unit& u, int wr, int wc, int fr, int fq) const {
        const int row0 = u.pm * BM + wr * 64 + fr; int colt = u.pn * BM; bf16_t* base = O;
        float sc = 1.f; if (split_cols) { const int t = colt / split_cols; base += (size_t)t * split_stride; colt -= t * split_cols; if (t == 0) sc = scale0; }
        const int col0 = colt + wc * 32 + 8 * fq, bcol0 = u.pn * BM + wc * 32 + 8 * fq;
        f32x4 bv[2][2];
#pragma unroll
        for (int bj = 0; bj < 2; ++bj)
#pragma unroll
            for (int n = 0; n < 2; ++n) bv[bj][n] = bias ? *(const f32x4*)(bias + bcol0 + bj * HALF + 4 * n) : (f32x4){0.f, 0.f, 0.f, 0.f};
#pragma unroll
        for (int ai = 0; ai < 2; ++ai)
#pragma unroll
            for (int m = 0; m < 4; ++m) { bf16_t* rowp = base + (size_t)(row0 + ai * HALF + m * 16) * ldc + col0;
#pragma unroll
                for (int bj = 0; bj < 2; ++bj) { f32x4 v0 = acc[ai][bj][m][0] + bv[bj][0], v1 = acc[ai][bj][m][1] + bv[bj][1];
                    if (ACT == 1) { f32x2 a = gelu_pk((f32x2){v0[0], v0[1]}), b = gelu_pk((f32x2){v0[2], v0[3]}), c = gelu_pk((f32x2){v1[0], v1[1]}), d = gelu_pk((f32x2){v1[2], v1[3]});
                        v0 = (f32x4){a.x, a.y, b.x, b.y}; v1 = (f32x4){c.x, c.y, d.x, d.y}; }
                    v0 = v0 * sc; v1 = v1 * sc; u32x4 w; w.x = cvt_pk_bf16(v0[0], v0[1]); w.y = cvt_pk_bf16(v0[2], v0[3]); w.z = cvt_pk_bf16(v1[0], v1[1]); w.w = cvt_pk_bf16(v1[2], v1[3]);
                    *(u32x4*)(rowp + bj * HALF) = w; } }
    }
};
template <class E_> struct EpiHasMid { static constexpr bool v = false; };
template <class Epi, class Sched, bool ALIGN_EPI = false, bool SP2 = false, bool FP8 = false>
__device__ __forceinline__ void gemm_phase(PG8_LAS unsigned char* lds, const Gemm g, const Sched& S, const Epi& E) {
    int tid_ = threadIdx.x; asm volatile("" : "+v"(tid_));
    const int tid = tid_, wid = __builtin_amdgcn_readfirstlane(tid >> 6), lane = tid & 63, wr = wid >> 2, wc = wid & 3, fr = lane & 15, fq = lane >> 4;
    const int K = FP8 ? g.K / 2 : g.K, nt = K / BK;
    unsigned voffA[2], voffB[2];
#pragma unroll
    for (int i = 0; i < 2; ++i) { int R, C; stage_rc(tid * 16 + i * 8192, R, C); const int Rb = Epi::PERM ? ((R & ~31) + perm32(R & 31)) : R;
        voffA[i] = (unsigned)(R * K + C) * 2u; voffB[i] = (unsigned)(Rb * K + C) * 2u; }
    const size_t kstep = (size_t)(BK * 2);
    const size_t hstep = (size_t)HALF * K * 2;
    const size_t tstep = 2 * hstep;
    const unsigned ldsw = (unsigned)wid * 1024u;
    const int aoff = FP8 ? lds_byte(wr * 64 + fr, fq * 16) : lds_byte(wr * 64 + fr, fq * 8), boff = FP8 ? lds_byte(wc * 32 + fr, fq * 16) : lds_byte(wc * 32 + fr, fq * 8);
    constexpr int PIECE1 = FP8 ? 16 : 1024; (void)PIECE1;
#define PG8_SA(b, h) (((b) * 2 + (h)) * HTB)
#define PG8_SB(b, h) ((4 + (b) * 2 + (h)) * HTB)
#define PG8_STAGE(bufoff, gbase, voff) do { _Pragma("unroll") for (int _i = 0; _i < 2; ++_i) \
        __builtin_amdgcn_global_load_lds((const unsigned*)((const char*)(gbase) + (voff)[_i]), (PG8_LAS unsigned*)(lds + (bufoff) + ldsw + _i * 8192), 16, 0, 0); } while (0)
#define PG8_LD8(p_) __builtin_shufflevector(*(const PG8_LAS v4i_t*)(p_), *(const PG8_LAS v4i_t*)((p_) + 16), 0, 1, 2, 3, 4, 5, 6, 7)
#define PG8_LDA(dst, b, h) do { if constexpr (FP8) { _Pragma("unroll") for (int m = 0; m < 4; ++m) dst##8[m] = PG8_LD8(lds + PG8_SA(b, h) + aoff + m * 2048); } \
        else { _Pragma("unroll") for (int m = 0; m < 4; ++m) _Pragma("unroll") for (int k = 0; k < 2; ++k) dst[m][k] = *(const PG8_LAS bf16x8*)(lds + PG8_SA(b, h) + aoff + k * 1024 + m * 2048); } } while (0)
#define PG8_LDB(dst, b, h) do { if constexpr (FP8) { _Pragma("unroll") for (int n = 0; n < 2; ++n) dst##8[n] = PG8_LD8(lds + PG8_SB(b, h) + boff + n * 2048); } \
        else { _Pragma("unroll") for (int n = 0; n < 2; ++n) _Pragma("unroll") for (int k = 0; k < 2; ++k) dst[n][k] = *(const PG8_LAS bf16x8*)(lds + PG8_SB(b, h) + boff + k * 1024 + n * 2048); } } while (0)
#define PG8_MMA(ai, bj, At, Bt) do { __builtin_amdgcn_s_setprio(1); \
        if constexpr (FP8) { _Pragma("unroll") for (int m = 0; m < 4; ++m) _Pragma("unroll") for (int n = 0; n < 2; ++n) \
            asm volatile("v_mfma_scale_f32_16x16x128_f8f6f4 %0, %1, %2, %0, %3, %4 op_sel_hi:[0,0,0]" : "+v"(acc[ai][bj][m][n]) : "v"(Bt##8[n]), "v"(At##8[m]), "v"(scb_v), "v"(sca_v)); } \
        else { _Pragma("unroll") for (int m = 0; m < 4; ++m) _Pragma("unroll") for (int n = 0; n < 2; ++n) _Pragma("unroll") for (int k = 0; k < 2; ++k) \
            acc[ai][bj][m][n] = __builtin_amdgcn_mfma_f32_16x16x32_bf16(Bt[n][k], At[m][k], acc[ai][bj][m][n], 0, 0, 0); } __builtin_amdgcn_s_setprio(0); } while (0)
#define PG8_WAIT_V(n) asm volatile("s_waitcnt vmcnt(" #n ")" ::: "memory")
#define PG8_WAIT_L(n) asm volatile("s_waitcnt lgkmcnt(" #n ")" ::: "memory")
#define PG8_BAR __builtin_amdgcn_s_barrier()
#define PG8_SCHED __builtin_amdgcn_sched_barrier(0)
    Unit cur, nxt; int ui = 0;
    if (!S.next(0, cur)) return;
    f32x4 acc[2][2][4][2];
#pragma unroll
    for (int a = 0; a < 2; ++a)
#pragma unroll
        for (int b = 0; b < 2; ++b)
#pragma unroll
            for (int m = 0; m < 4; ++m)
#pragma unroll
                for (int n = 0; n < 2; ++n) acc[a][b][m][n] = (f32x4){0.f, 0.f, 0.f, 0.f};
    const int sca_v = g.sca, scb_v = g.scb;
    bf16x8 At[4][2], B0[2][2], B1[2][2];
    v8i_t At8[4], B08[2], B18[2];
    const char* cA = (const char*)g.A + (size_t)cur.pm * tstep; const char* cB = (const char*)g.Bt + (size_t)cur.pn * tstep;
    S.a_ready(cur);
    if constexpr (SP2) {
        PG8_STAGE(PG8_SB(0, 0), cB, voffB); PG8_STAGE(PG8_SB(0, 1), cB + hstep, voffB); PG8_STAGE(PG8_SA(0, 0), cA, voffA); PG8_STAGE(PG8_SA(0, 1), cA + hstep, voffA);
        if (wr == 1) PG8_BAR;
        PG8_WAIT_V(2); PG8_BAR;
        PG8_STAGE(PG8_SB(1, 0), cB + kstep, voffB); PG8_STAGE(PG8_SA(1, 0), cA + kstep, voffA); PG8_STAGE(PG8_SB(1, 1), cB + hstep + kstep, voffB);
        PG8_WAIT_V(6); PG8_BAR;
    } else {
        PG8_STAGE(PG8_SB(0, 0), cB, voffB); PG8_STAGE(PG8_SA(0, 0), cA, voffA); PG8_STAGE(PG8_SB(0, 1), cB + hstep, voffB); PG8_STAGE(PG8_SA(0, 1), cA + hstep, voffA);
        if (wr == 1) PG8_BAR;
        PG8_WAIT_V(4); PG8_BAR;
        PG8_STAGE(PG8_SB(1, 0), cB + kstep, voffB); PG8_STAGE(PG8_SA(1, 0), cA + kstep, voffA); PG8_STAGE(PG8_SB(1, 1), cB + hstep + kstep, voffB);
        PG8_WAIT_V(6); PG8_BAR;
    }
    for (;;) {
        const bool has_next = S.next(ui + 1, nxt);
        const char* nA = has_next ? (const char*)g.A + (size_t)nxt.pm * tstep : cA; const char* nB = has_next ? (const char*)g.Bt + (size_t)nxt.pn * tstep : cB;
#pragma unroll 1
        for (int t = 0; t < nt; t += 2) {
            if constexpr (EpiHasMid<Epi>::v) { if (t == 8 || t == 16) { PG8_SCHED; E.mid(acc, cur, t, wr, wc, fr, fq); PG8_SCHED; } }
            const bool last = (t == nt - 2);
            const char* a1 = cA + (size_t)(t + 1) * kstep;
            const char* a2 = last ? nA : cA + (size_t)(t + 2) * kstep; const char* b2 = last ? nB : cB + (size_t)(t + 2) * kstep;
            const char* a3 = a2 + kstep; const char* b3 = b2 + kstep;
            if (last && has_next) S.a_ready(nxt);
            if constexpr (SP2) {
            PG8_LDB(B0, 0, 0); PG8_LDB(B1, 0, 1); PG8_SCHED; PG8_LDA(At, 0, 0); PG8_STAGE(PG8_SA(1, 1), a1 + hstep, voffA);
            PG8_WAIT_V(8); PG8_WAIT_L(0); PG8_BAR; PG8_MMA(0, 0, At, B0); PG8_MMA(0, 1, At, B1); PG8_BAR; PG8_SCHED;
            PG8_LDA(At, 0, 1); PG8_STAGE(PG8_SB(0, 0), b2, voffB); PG8_STAGE(PG8_SB(0, 1), b2 + hstep, voffB); PG8_STAGE(PG8_SA(0, 0), a2, voffA);
            PG8_WAIT_V(8); PG8_WAIT_L(0); PG8_BAR; PG8_MMA(1, 0, At, B0); PG8_MMA(1, 1, At, B1); PG8_BAR; PG8_SCHED;
            PG8_LDB(B0, 1, 0); PG8_LDB(B1, 1, 1); PG8_SCHED; PG8_LDA(At, 1, 0); PG8_STAGE(PG8_SA(0, 1), a2 + hstep, voffA);
            PG8_WAIT_V(8); PG8_WAIT_L(0); PG8_BAR; PG8_MMA(0, 0, At, B0); PG8_MMA(0, 1, At, B1); PG8_BAR; PG8_SCHED;
            PG8_LDA(At, 1, 1); PG8_STAGE(PG8_SB(1, 0), b3, voffB); PG8_STAGE(PG8_SB(1, 1), b3 + hstep, voffB); PG8_STAGE(PG8_SA(1, 0), a3, voffA);
            PG8_WAIT_V(8); PG8_WAIT_L(0); PG8_BAR; PG8_MMA(1, 0, At, B0); PG8_MMA(1, 1, At, B1); PG8_BAR; PG8_SCHED;
            } else {
            PG8_LDB(B0, 0, 0); PG8_SCHED; PG8_LDA(At, 0, 0); PG8_STAGE(PG8_SA(1, 1), a1 + hstep, voffA);
            PG8_WAIT_L(8); PG8_BAR; PG8_WAIT_L(0); PG8_MMA(0, 0, At, B0); PG8_BAR; PG8_SCHED;
            PG8_LDB(B1, 0, 1); PG8_STAGE(PG8_SB(0, 0), b2, voffB);
            PG8_BAR; PG8_WAIT_L(0); PG8_MMA(0, 1, At, B1); PG8_BAR;
            PG8_LDA(At, 0, 1); PG8_STAGE(PG8_SA(0, 0), a2, voffA);
            PG8_BAR; PG8_WAIT_L(0); PG8_MMA(1, 0, At, B0); PG8_BAR; PG8_SCHED;
            PG8_STAGE(PG8_SB(0, 1), b2 + hstep, voffB);
            PG8_WAIT_V(6); PG8_BAR; PG8_MMA(1, 1, At, B1); PG8_BAR;
            PG8_LDB(B0, 1, 0); PG8_SCHED; PG8_LDA(At, 1, 0); PG8_STAGE(PG8_SA(0, 1), a2 + hstep, voffA);
            PG8_WAIT_L(8); PG8_BAR; PG8_WAIT_L(0); PG8_MMA(0, 0, At, B0); PG8_BAR; PG8_SCHED;
            PG8_LDB(B1, 1, 1); PG8_STAGE(PG8_SB(1, 0), b3, voffB);
            PG8_BAR; PG8_WAIT_L(0); PG8_MMA(0, 1, At, B1); PG8_BAR;
            PG8_LDA(At, 1, 1); PG8_STAGE(PG8_SA(1, 0), a3, voffA);
            PG8_BAR; PG8_WAIT_L(0); PG8_MMA(1, 0, At, B0); PG8_BAR; PG8_SCHED;
            PG8_STAGE(PG8_SB(1, 1), b3 + hstep, voffB);
            PG8_WAIT_V(6); PG8_BAR; PG8_MMA(1, 1, At, B1); PG8_BAR;
            }
        }
        if constexpr (FP8) { asm volatile("s_nop 15\n\ts_nop 15" ::: "memory"); }
        if constexpr (ALIGN_EPI) { if (wr == 0) PG8_BAR; }
        if constexpr (!Epi::AFTER_DRAIN) { E(acc, cur, wr, wc, fr, fq); S.done(cur); }
        if (!has_next) break;
#pragma unroll
        for (int a = 0; a < 2; ++a)
#pragma unroll
            for (int b = 0; b < 2; ++b)
#pragma unroll
                for (int m = 0; m < 4; ++m)
#pragma unroll
                    for (int n = 0; n < 2; ++n) acc[a][b][m][n] = (f32x4){0.f, 0.f, 0.f, 0.f};
        cur = nxt; cA = nA; cB = nB; ++ui;
        if constexpr (ALIGN_EPI) { if (wr == 1) PG8_BAR; }
    }
    PG8_WAIT_V(0);
    if constexpr (!ALIGN_EPI) { if (wr == 0) PG8_BAR; }
    PG8_BAR;
    if constexpr (Epi::AFTER_DRAIN) { E.fused(acc, cur, wr, wc, fr, fq, lds, wid, lane); S.done(cur); }
#undef PG8_SA
#undef PG8_SB
#undef PG8_STAGE
#undef PG8_LD8
#undef PG8_LDA
#undef PG8_LDB
#undef PG8_MMA
#undef PG8_WAIT_V
#undef PG8_WAIT_L
#undef PG8_BAR
#undef PG8_SCHED
}
}

constexpr int D_MODEL = 1024, BATCH = 2, SEQ = 8192, MTOK = BATCH * SEQ, MEM_LEN = 256, MEMROWS = BATCH * MEM_LEN;
constexpr int IN_COLS = 9984, OFF_AQ = 0, OFF_AK = 1536, OFF_AV = 3072, OFF_R = 4608, OFF_CQ = 6400, OFF_GATE = 6912;
constexpr int RW = 512;
constexpr int N_EXPERTS = 32, TOP_K = 4, D_FF = 1024, MOE_ROWS = 256;
constexpr int MAX_BLOCKS = MTOK * TOP_K / MOE_ROWS + N_EXPERTS;
constexpr int MAX_SLOTS = MAX_BLOCKS * MOE_ROWS;
constexpr float NORM_EPS = 1e-6f, R_GN_EPS = 64e-5f;
constexpr float LOG2E = 1.4426950408889634f;
constexpr float QSCALE = 0.08838834764831845f * LOG2E;

namespace pg8 {
__device__ __forceinline__ float bf_lo(unsigned w) { return __builtin_bit_cast(float, w << 16); }
__device__ __forceinline__ float bf_hi(unsigned w) { return __builtin_bit_cast(float, w & 0xffff0000u); }
__device__ __forceinline__ float sigmoidf_fast(float x) { return __builtin_amdgcn_rcpf(1.0f + __builtin_amdgcn_exp2f(-1.4426950408889634f * x)); }

struct EpiZ {
    static constexpr bool PERM = true, AFTER_DRAIN = false;
    bf16_t* O; const float* bgate; const float* aqg; const float* akg; const float* cqg; const float* cs;
    bf16_t* KV; const float* ckg;
    PG8_LAS float* P;
    __device__ __forceinline__ void operator()(const f32x4 (&acc)[2][2][4][2], const Unit& u, int wr, int wc, int fr, int fq) const {
        const bool mem = u.pm >= 64; const int pnl = mem ? u.pn - 39 : u.pn, ldc = mem ? 1024 : IN_COLS;
        bf16_t* const Ob = mem ? KV - (size_t)64 * BM * 1024 : O;
        const int row0 = u.pm * BM + wr * 64 + fr, col0 = pnl * BM + wc * 32 + 8 * fq;
        const int cls = mem ? ((pnl < 2) ? 3 : 0) : (pnl < 6) ? 1 : (pnl < 12) ? 2 : (pnl == 25 || pnl == 26) ? 3 : (pnl >= 27) ? 4 : 0;
        if (cls >= 1 && cls <= 3) {
            const int go = wc * 32 + 8 * fq;
            const f32x4 q0 = *(const f32x4*)(aqg + go), q1 = *(const f32x4*)(aqg + go + 4), k0 = *(const f32x4*)(akg + go), k1 = *(const f32x4*)(akg + go + 4), x0 = *(const f32x4*)(cqg + go), x1 = *(const f32x4*)(cqg + go + 4);
            const f32x4 m0 = *(const f32x4*)(ckg + go), m1 = *(const f32x4*)(ckg + go + 4);
            const f32x4 g0 = mem ? m0 : (cls == 1) ? q0 : (cls == 2) ? k0 : x0, g1 = mem ? m1 : (cls == 1) ? q1 : (cls == 2) ? k1 : x1;
#pragma unroll
            for (int ai = 0; ai < 2; ++ai)
#pragma unroll
                for (int m = 0; m < 4; ++m)
#pragma unroll
                    for (int bj = 0; bj < 2; ++bj) { const f32x4 a = acc[ai][bj][m][0], b = acc[ai][bj][m][1];
                        float s = ((a[0] * a[0] + a[1] * a[1]) + (a[2] * a[2] + a[3] * a[3])) + ((b[0] * b[0] + b[1] * b[1]) + (b[2] * b[2] + b[3] * b[3]));
                        s += __shfl_xor(s, 16); s += __shfl_xor(s, 32);
                        if (fq == 0) P[((ai * HALF + wr * 64 + m * 16 + fr) * 2 + bj) * 4 + wc] = s; }
            asm volatile("s_waitcnt lgkmcnt(0)" ::: "memory"); __builtin_amdgcn_s_barrier(); asm volatile("" ::: "memory");
#pragma unroll
            for (int ai = 0; ai < 2; ++ai)
#pragma unroll
                for (int m = 0; m < 4; ++m) { const int rl = ai * HALF + wr * 64 + m * 16 + fr, row = u.pm * BM + rl;
                    f32x4 c0 = {0.f, 0.f, 0.f, 0.f}, c1 = c0, c2 = c0, c3 = c0;
                    if (cls != 3 && wc == 0) { const f32x4* cp = (const f32x4*)(cs + (size_t)row * 32 + 16 * (fq & 1)); c0 = cp[0]; c1 = cp[1]; c2 = cp[2]; c3 = cp[3]; }
#pragma unroll
                    for (int bj = 0; bj < 2; ++bj) { const f32x4 pv = *(const PG8_LAS f32x4*)(P + (rl * 2 + bj) * 4);
                        const float rstd = __builtin_amdgcn_rsqf(((pv[0] + pv[1]) + (pv[2] + pv[3])) * (1.0f / 128.0f) + NORM_EPS);
                        f32x4 v0 = acc[ai][bj][m][0] * rstd * g0, v1 = acc[ai][bj][m][1] * rstd * g1;
                        if (cls != 3 && wc == 0) {
                            f32x4 p0, p1;
#pragma unroll
                            for (int j = 0; j < 4; ++j) { p0[j] = __shfl_xor(v0[j], 32); p1[j] = __shfl_xor(v1[j], 32); }
                            const float sg = (fq < 2) ? -1.0f : 1.0f;
                            v0[0] = v0[0] * c0[0] + sg * p0[0] * c0[1]; v0[1] = v0[1] * c0[2] + sg * p0[1] * c0[3]; v0[2] = v0[2] * c1[0] + sg * p0[2] * c1[1]; v0[3] = v0[3] * c1[2] + sg * p0[3] * c1[3];
                            v1[0] = v1[0] * c2[0] + sg * p1[0] * c2[1]; v1[1] = v1[1] * c2[2] + sg * p1[1] * c2[3]; v1[2] = v1[2] * c3[0] + sg * p1[2] * c3[1]; v1[3] = v1[3] * c3[2] + sg * p1[3] * c3[3]; }
                        u32x4 w; w.x = cvt_pk_bf16(v0[0], v0[1]); w.y = cvt_pk_bf16(v0[2], v0[3]); w.z = cvt_pk_bf16(v1[0], v1[1]); w.w = cvt_pk_bf16(v1[2], v1[3]);
                        *(u32x4*)(Ob + (size_t)row * ldc + col0 + bj * HALF) = w; } }
            return;
        }
        const bool gate = cls == 4;
        f32x4 bv[2][2];
#pragma unroll
        for (int bj = 0; bj < 2; ++bj)
#pragma unroll
            for (int n = 0; n < 2; ++n) bv[bj][n] = gate ? *(const f32x4*)(bgate + (col0 - OFF_GATE) + bj * HALF + 4 * n) : (f32x4){0.f, 0.f, 0.f, 0.f};
#pragma unroll
        for (int ai = 0; ai < 2; ++ai)
#pragma unroll
            for (int m = 0; m < 4; ++m) { bf16_t* rowp = Ob + (size_t)(row0 + ai * HALF + m * 16) * ldc + col0;
#pragma unroll
                for (int bj = 0; bj < 2; ++bj) { f32x4 v0 = acc[ai][bj][m][0] + bv[bj][0], v1 = acc[ai][bj][m][1] + bv[bj][1];
                    if (gate) {
#pragma unroll
                        for (int j = 0; j < 4; ++j) { v0[j] = sigmoidf_fast(v0[j]); v1[j] = sigmoidf_fast(v1[j]); } }
                    u32x4 w; w.x = cvt_pk_bf16(v0[0], v0[1]); w.y = cvt_pk_bf16(v0[2], v0[3]); w.z = cvt_pk_bf16(v1[0], v1[1]); w.w = cvt_pk_bf16(v1[2], v1[3]);
                    *(u32x4*)(rowp + bj * HALF) = w; } }
    }
};

template <int SET> struct ZOrder {
    StaticOrder so; int nz;
    __device__ void init(int G_, int c_) { so.init(MTOK, (SET == 0 ? 27 : 12) * BM, G_, c_); nz = 64 * (SET == 0 ? 27 : 12); }
    __device__ __forceinline__ bool next(int i, Unit& u) const {
        if (so.next(i, u)) { const int t = u.pn;
            if (SET == 1) u.pn = t + 27;
            return true; }
        if (SET == 0) { const long L = (long)i * so.G + so.c - nz; if (L >= 0 && L < 8) { u.pm = 64 + (int)(L & 1); u.pn = 39 + (int)(L >> 1); return true; } }
        return false;
    }
    __device__ __forceinline__ void a_ready(const Unit&) const {}
    __device__ __forceinline__ void done(const Unit&) const {}
};
struct EpiGate3 {
    static constexpr bool PERM = true, AFTER_DRAIN = false;
    const bf16_t* Z; bf16_t* mergedb;
    __device__ __forceinline__ void mid(f32x4 (&acc)[2][2][4][2], const Unit& u, int t, int wr, int wc, int fr, int fq) const {
        int fr_ = fr; asm volatile("" : "+v"(fr_));
        const int row0 = u.pm * BM + wr * 64 + fr_, col0 = u.pn * BM + wc * 32 + 8 * fq, ba = (t >> 3) - 1;
        const bf16_t* gp = Z + OFF_GATE + ba * D_MODEL + col0;
#pragma unroll
        for (int ai = 0; ai < 2; ++ai)
#pragma unroll
            for (int m = 0; m < 4; ++m) { const bf16_t* rp = gp + (size_t)(row0 + ai * HALF + m * 16) * IN_COLS;
#pragma unroll
                for (int bj = 0; bj < 2; ++bj) { const u32x4 ga = *(const u32x4*)(rp + bj * HALF), gb = *(const u32x4*)(rp + D_MODEL + bj * HALF);
                    f32x4 r0, r1;
                    r0[0] = bf_lo(ga[0]) * __builtin_amdgcn_rcpf(bf_lo(gb[0])); r0[1] = bf_hi(ga[0]) * __builtin_amdgcn_rcpf(bf_hi(gb[0])); r0[2] = bf_lo(ga[1]) * __builtin_amdgcn_rcpf(bf_lo(gb[1])); r0[3] = bf_hi(ga[1]) * __builtin_amdgcn_rcpf(bf_hi(gb[1]));
                    r1[0] = bf_lo(ga[2]) * __builtin_amdgcn_rcpf(bf_lo(gb[2])); r1[1] = bf_hi(ga[2]) * __builtin_amdgcn_rcpf(bf_hi(gb[2])); r1[2] = bf_lo(ga[3]) * __builtin_amdgcn_rcpf(bf_lo(gb[3])); r1[3] = bf_hi(ga[3]) * __builtin_amdgcn_rcpf(bf_hi(gb[3]));
                    acc[ai][bj][m][0] *= r0; acc[ai][bj][m][1] *= r1; }
                if (m == 3) asm volatile("" ::: "memory"); }
    }
    __device__ __forceinline__ void operator()(const f32x4 (&acc)[2][2][4][2], const Unit& u, int wr, int wc, int fr, int fq) const {
        const int row0 = u.pm * BM + wr * 64 + fr, col0 = u.pn * BM + wc * 32 + 8 * fq;
#pragma unroll
        for (int ai = 0; ai < 2; ++ai)
#pragma unroll
            for (int m = 0; m < 4; ++m) { const int row = row0 + ai * HALF + m * 16;
#pragma unroll
                for (int bj = 0; bj < 2; ++bj) { const int col = col0 + bj * HALF;
                    const u32x4 gz = *(const u32x4*)(Z + (size_t)row * IN_COLS + OFF_GATE + 2 * D_MODEL + col);
                    f32x4 g0, g1;
                    g0[0] = bf_lo(gz[0]); g0[1] = bf_hi(gz[0]); g0[2] = bf_lo(gz[1]); g0[3] = bf_hi(gz[1]); g1[0] = bf_lo(gz[2]); g1[1] = bf_hi(gz[2]); g1[2] = bf_lo(gz[3]); g1[3] = bf_hi(gz[3]);
                    const f32x4 v0 = acc[ai][bj][m][0] * g0, v1 = acc[ai][bj][m][1] * g1;
                    u32x4 w; w.x = cvt_pk_bf16(v0[0], v0[1]); w.y = cvt_pk_bf16(v0[2], v0[3]); w.z = cvt_pk_bf16(v1[0], v1[1]); w.w = cvt_pk_bf16(v1[2], v1[3]);
                    *(u32x4*)(mergedb + (size_t)row * D_MODEL + col) = w; } }
    }
};
template <> struct EpiHasMid<EpiGate3> { static constexpr bool v = true; };
struct EpiGate3NoMid : EpiGate3 {};
struct EpiResF32 {
    static constexpr bool PERM = true, AFTER_DRAIN = false;
    const float* base; float* out; int ldc;
    __device__ __forceinline__ void operator()(const f32x4 (&acc)[2][2][4][2], const Unit& u, int wr, int wc, int fr, int fq) const {
        const int row0 = u.pm * BM + wr * 64 + fr, col0 = u.pn * BM + wc * 32 + 8 * fq;
#pragma unroll
        for (int ai = 0; ai < 2; ++ai)
#pragma unroll
            for (int m = 0; m < 4; ++m) { const size_t off = (size_t)(row0 + ai * HALF + m * 16) * ldc + col0;
#pragma unroll
                for (int bj = 0; bj < 2; ++bj) { const float* bp = base + off + bj * HALF; float* op = out + off + bj * HALF;
                    const f32x4 x0 = *(const f32x4*)bp, x1 = *(const f32x4*)(bp + 4);
                    *(f32x4*)op = x0 + acc[ai][bj][m][0]; *(f32x4*)(op + 4) = x1 + acc[ai][bj][m][1]; } }
    }
};
struct EpiSwiGLU {
    static constexpr bool PERM = true, AFTER_DRAIN = false;
    const float* b1; bf16_t* H;
    __device__ __forceinline__ void operator()(const f32x4 (&acc)[2][2][4][2], const Unit& u, int wr, int wc, int fr, int fq) const {
        const int e = u.pn >> 3, pnl = u.pn & 7;
        const int row0 = u.pm * BM + wr * 64 + fr, ac = pnl * HALF + wc * 32 + 8 * fq;
        const float* bg = b1 + (size_t)e * 2 * D_FF + ac; const float* bl = bg + D_FF;
        const f32x4 bg0 = *(const f32x4*)bg, bg1 = *(const f32x4*)(bg + 4), bl0 = *(const f32x4*)bl, bl1 = *(const f32x4*)(bl + 4);
#pragma unroll
        for (int ai = 0; ai < 2; ++ai)
#pragma unroll
            for (int m = 0; m < 4; ++m) { const int row = row0 + ai * HALF + m * 16;
                float a[8];
#pragma unroll
                for (int n = 0; n < 2; ++n) { const f32x4 ug = acc[ai][0][m][n] + (n ? bg1 : bg0), ul = acc[ai][1][m][n] + (n ? bl1 : bl0);
#pragma unroll
                    for (int j = 0; j < 4; ++j) { const float g = fminf(ug[j], 7.0f), l = fminf(fmaxf(ul[j], -7.0f), 7.0f);
                        a[4 * n + j] = g * sigmoidf_fast(1.702f * g) * (l + 1.0f); } }
                unsigned w0 = 0, w1 = 0;
                w0 = __builtin_amdgcn_cvt_pk_fp8_f32(a[0] * 8.0f, a[1] * 8.0f, w0, false); w0 = __builtin_amdgcn_cvt_pk_fp8_f32(a[2] * 8.0f, a[3] * 8.0f, w0, true);
                w1 = __builtin_amdgcn_cvt_pk_fp8_f32(a[4] * 8.0f, a[5] * 8.0f, w1, false); w1 = __builtin_amdgcn_cvt_pk_fp8_f32(a[6] * 8.0f, a[7] * 8.0f, w1, true);
                *(unsigned long long*)((unsigned char*)H + (size_t)row * D_FF + ac) = (unsigned long long)w0 | ((unsigned long long)w1 << 32); }
    }
};
struct EpiMoeOut {
    static constexpr bool PERM = true, AFTER_DRAIN = false;
    const float* b2; const float* rowgate; bf16_t* Y;
    __device__ __forceinline__ void operator()(const f32x4 (&acc)[2][2][4][2], const Unit& u, int wr, int wc, int fr, int fq) const {
        const int e = u.pn >> 2, pnl = u.pn & 3;
        const int row0 = u.pm * BM + wr * 64 + fr, col0 = pnl * BM + wc * 32 + 8 * fq;
#pragma unroll
        for (int ai = 0; ai < 2; ++ai)
#pragma unroll
            for (int m = 0; m < 4; ++m) { const int row = row0 + ai * HALF + m * 16; const float gt = rowgate[row];
#pragma unroll
                for (int bj = 0; bj < 2; ++bj) { const int col = col0 + bj * HALF; const float* bp = b2 + (size_t)e * D_MODEL + col;
                    const f32x4 v0 = (acc[ai][bj][m][0] + *(const f32x4*)bp) * gt, v1 = (acc[ai][bj][m][1] + *(const f32x4*)(bp + 4)) * gt;
                    u32x4 w; w.x = cvt_pk_bf16(v0[0], v0[1]); w.y = cvt_pk_bf16(v0[2], v0[3]); w.z = cvt_pk_bf16(v1[0], v1[1]); w.w = cvt_pk_bf16(v1[2], v1[3]);
                    *(u32x4*)(Y + (size_t)row * D_MODEL + col) = w; } }
    }
};
struct MoeOrder {
    const PG8_LAS int* tab;
    int NT, G, c;
    __device__ __forceinline__ bool next(int i, Unit& u) const {
        const int nblk = tab[0]; const long L = (long)i * G + c; if (L >= (long)nblk * NT) return false;
        const int blk = (int)(L / NT), pnl = (int)(L % NT); u.pm = blk; u.pn = tab[1 + blk] * NT + pnl; return true;
    }
    __device__ __forceinline__ void a_ready(const Unit&) const {}
    __device__ __forceinline__ void done(const Unit&) const {}
};
}

namespace swa {
constexpr int D = 128;
constexpr float SCALE = 0.08838834764831845f;
constexpr float THR = 8.f;
constexpr int NW = 8, QBLK = 32, KVBLK = 64, QB = NW * QBLK;
constexpr int SHM_V = KVBLK * D * 2, SHM_K = KVBLK * D * 2;
constexpr int LDS_BYTES = 2 * SHM_V + 2 * SHM_K + NW * 64 * 4;
using bf16 = unsigned short;
typedef short bf16x8 __attribute__((ext_vector_type(8)));
typedef short s16x4 __attribute__((ext_vector_type(4)));
typedef float f32x16 __attribute__((ext_vector_type(16)));
typedef float f32x4 __attribute__((ext_vector_type(4)));
typedef unsigned u32x4 __attribute__((ext_vector_type(4)));
template <class A, class Bt> struct same_t { static constexpr bool v = false; };
template <class A> struct same_t<A, A> { static constexpr bool v = true; };
#define KSWZ(row, colB) ((row) * 256 + ((colB) ^ (((row) & 7) << 4)))
#define SBAR() __builtin_amdgcn_sched_barrier(0)
__device__ __forceinline__ int v_st(int k, int c) { const int kk = (k & ~0xC) | ((k & 4) << 1) | ((k & 8) >> 1); return ((kk >> 3) * 4 + (c >> 5)) * 512 + ((kk & 7) * 32 + (c & 31)) * 2; }
__device__ __forceinline__ int v_rd_base(int lane) { return ((lane & 3) << 3) | (((lane >> 2) & 3) << 6) | (((lane >> 4) & 1) << 5) | (((lane >> 5) & 1) << 8); }
constexpr int v_rd_off(int d0, int ks, int half) { return d0 * 512 + ks * 4096 + half * 2048; }
__device__ __forceinline__ int crow(int r, int hi) { return (r & 3) + 8 * (r >> 2) + 4 * hi; }
__device__ __forceinline__ unsigned cvtpk(float lo, float hi) {
    unsigned r; asm volatile("v_cvt_pk_bf16_f32 %0, %1, %2" : "=v"(r) : "v"(lo), "v"(hi)); return r;
}
__device__ __forceinline__ bf16x8 pack8(f32x4 a, f32x4 b) {
    u32x4 w = {cvtpk(a[0], a[1]), cvtpk(a[2], a[3]), cvtpk(b[0], b[1]), cvtpk(b[2], b[3])};
    return *reinterpret_cast<bf16x8*>(&w);
}
template <class T> __device__ __forceinline__ bf16x8 load8(const T* p) {
    if constexpr (same_t<T, float>::v) { return pack8(*(const f32x4*)p, *(const f32x4*)(p + 4)); }
    else { return *reinterpret_cast<const bf16x8*>(p); }
}
__device__ __forceinline__ void mask_tile(f32x16& p0, f32x16& p1, int dq, unsigned W) {
    const float NEG = -__builtin_inff();
#pragma unroll
    for (int r = 0; r < 16; ++r) {
        const int c = (r & 3) + 8 * (r >> 2);
        if ((unsigned)(dq - c) >= W) p0[r] = NEG;
        if ((unsigned)(dq - c - 32) >= W) p1[r] = NEG;
    }
}
__device__ __forceinline__ void partialSM(f32x16& p0, f32x16& p1, float& m_reg, float& mn, float& alpha) {
    float pmax = p0[0]; for (int r = 1; r < 16; ++r) pmax = fmaxf(pmax, p0[r]); for (int r = 0; r < 16; ++r) pmax = fmaxf(pmax, p1[r]);
    { auto rr = __builtin_amdgcn_permlane32_swap(__float_as_uint(pmax), __float_as_uint(pmax), false, false);
      pmax = fmaxf(__uint_as_float(rr[0]), __uint_as_float(rr[1])); }
    constexpr float C2 = 1.4426950408889634f * SCALE;
    if (__builtin_expect(__all((pmax - m_reg) * SCALE <= THR), 1)) { mn = m_reg; alpha = 1.f; }
    else { mn = fmaxf(m_reg, pmax); alpha = __builtin_amdgcn_exp2f((m_reg - mn) * C2); m_reg = mn; }
    const float mnL = -mn * C2;
    for (int r = 0; r < 16; ++r) p0[r] = fmaf(p0[r], C2, mnL); for (int r = 0; r < 16; ++r) p1[r] = fmaf(p1[r], C2, mnL);
    for (int r = 0; r < 16; ++r) p0[r] = __builtin_amdgcn_exp2f(p0[r]);
}
__device__ __forceinline__ void finishSM(f32x16& p0, f32x16& p1, float alpha, float& l_reg, bf16x8& pa0, bf16x8& pa1, bf16x8& pa2, bf16x8& pa3) {
    for (int r = 0; r < 16; ++r) p1[r] = __builtin_amdgcn_exp2f(p1[r]);
    float ps = 0; for (int r = 0; r < 16; ++r) ps += p0[r]; for (int r = 0; r < 16; ++r) ps += p1[r];
    { auto rr = __builtin_amdgcn_permlane32_swap(__float_as_uint(ps), __float_as_uint(ps), false, false);
      ps = __uint_as_float(rr[0]) + __uint_as_float(rr[1]); }
    l_reg = l_reg * alpha + ps;
#define PK4(P, B_, OUT) do { unsigned a0 = cvtpk(P[B_+0], P[B_+1]), a1 = cvtpk(P[B_+2], P[B_+3]);                          \
        unsigned b0 = cvtpk(P[B_+4], P[B_+5]), b1 = cvtpk(P[B_+6], P[B_+7]);                                             \
        auto r0 = __builtin_amdgcn_permlane32_swap(a0, b0, false, false); auto r1 = __builtin_amdgcn_permlane32_swap(a1, b1, false, false); \
        u32x4 w = {r0[0], r1[0], r0[1], r1[1]}; OUT = *reinterpret_cast<bf16x8*>(&w); } while (0)
    PK4(p0, 0, pa0); PK4(p0, 8, pa1); PK4(p1, 0, pa2); PK4(p1, 8, pa3);
#undef PK4
}
template <int KB, bool SK>
__device__ __forceinline__ void qkt(f32x16& p0, f32x16& p1, const char* K_lds, int r32, int hi, const bf16x8* qr, bool act) {
    if (SK && !act) { const float NEG = -__builtin_inff();
#pragma unroll
        for (int r = 0; r < 16; ++r) { p0[r] = NEG; p1[r] = NEG; } return; }
    p0 = f32x16{}; p1 = f32x16{};
    const char* kb[4];
#pragma unroll
    for (int dd = 0; dd < 4; ++dd) kb[dd] = K_lds + KB * SHM_K + KSWZ(r32, (dd * 16 + hi * 8) * 2);
#pragma unroll
    for (int d0 = 0; d0 < 8; ++d0) { const char* a = kb[d0 & 3] + (d0 >> 2) * 128;
        bf16x8 b0 = *reinterpret_cast<const bf16x8*>(a);
        bf16x8 b1 = *reinterpret_cast<const bf16x8*>(a + 32 * 256);
        p0 = __builtin_amdgcn_mfma_f32_32x32x16_bf16(b0, qr[d0], p0, 0, 0, 0);
        p1 = __builtin_amdgcn_mfma_f32_32x32x16_bf16(b1, qr[d0], p1, 0, 0, 0); }
}
template <int VB, bool SK>
__device__ __forceinline__ void pv_tile(f32x16* o, int vb0, bf16x8 pa0, bf16x8 pa1, bf16x8 pa2, bf16x8 pa3, bool act) {
    if (SK && !act) return;
#define TRRD(dst, off) asm volatile("ds_read_b64_tr_b16 %0, %1 offset:%2" : "=&v"(dst) : "v"(vb0), "i"(off) : "memory")
#define PV_D0(d0) do { s16x4 l0, l1, l2, l3, h0, h1, h2, h3; constexpr int b_ = VB * SHM_V + v_rd_off(d0, 0, 0);     \
        TRRD(l0, b_); TRRD(h0, b_ + 2048); TRRD(l1, b_ + 4096); TRRD(h1, b_ + 6144); TRRD(l2, b_ + 8192); TRRD(h2, b_ + 10240); TRRD(l3, b_ + 12288); TRRD(h3, b_ + 14336); \
        asm volatile("s_waitcnt lgkmcnt(0)" ::: "memory"); SBAR();                 \
        o[d0] = __builtin_amdgcn_mfma_f32_32x32x16_bf16(pa0, (bf16x8){l0[0], l0[1], l0[2], l0[3], h0[0], h0[1], h0[2], h0[3]}, o[d0], 0, 0, 0);   \
        o[d0] = __builtin_amdgcn_mfma_f32_32x32x16_bf16(pa1, (bf16x8){l1[0], l1[1], l1[2], l1[3], h1[0], h1[1], h1[2], h1[3]}, o[d0], 0, 0, 0);   \
        o[d0] = __builtin_amdgcn_mfma_f32_32x32x16_bf16(pa2, (bf16x8){l2[0], l2[1], l2[2], l2[3], h2[0], h2[1], h2[2], h2[3]}, o[d0], 0, 0, 0);   \
        o[d0] = __builtin_amdgcn_mfma_f32_32x32x16_bf16(pa3, (bf16x8){l3[0], l3[1], l3[2], l3[3], h3[0], h3[1], h3[2], h3[3]}, o[d0], 0, 0, 0); } while (0)
    PV_D0(0); PV_D0(1); PV_D0(2); PV_D0(3);
#undef PV_D0
#undef TRRD
}

struct BlockRef { const bf16* Q; const bf16* K; const bf16* V; bf16* O; float* LSE; int QS, KS, OS, LS, P0, skv, W; };
struct Seam { bf16x8 qr[8]; bf16x8 st_v0, st_v1, st_k0, st_k1; };
__device__ __forceinline__ int swa_jlo(int P0, int W) { const int lowk = P0 - W + 1; return lowk > 0 ? lowk / KVBLK : 0; }
#define LD8(p) (*reinterpret_cast<const bf16x8*>(p))
#define ROW(p, k0, rr, RS) ((p) + (size_t)((k0) + (rr)) * (RS) + sc)
#define VMW() asm volatile("s_waitcnt vmcnt(0)" ::: "memory")
#define VMWN(n) asm volatile("s_waitcnt vmcnt(%0)" :: "i"(n) : "memory")
#define SLOAD_H(Kp, Vp, k0, RS) do { const char* kb_ = (const char*)(Kp) + (size_t)(k0) * (size_t)(RS) * 2; const char* vb_ = (const char*)(Vp) + (size_t)(k0) * (size_t)(RS) * 2;  \
                         const unsigned oa_ = (unsigned)(sr * (RS) + sc) * 2u, ob_ = oa_ + (unsigned)(RS) * 64u;                                    \
                         S.st_v0 = LD8(vb_ + oa_); S.st_v1 = LD8(vb_ + ob_); S.st_k0 = LD8(kb_ + oa_); S.st_k1 = LD8(kb_ + ob_); } while (0)
#define SWRITE_HK(bf) do { *(bf16x8*)(K_lds + (bf) * SHM_K + kws) = S.st_k0; *(bf16x8*)(K_lds + (bf) * SHM_K + kws + 32 * 256) = S.st_k1; } while (0)
#define SWRITE_HV(bf) do { *(bf16x8*)(V_lds + (bf) * SHM_V + vst0) = S.st_v0; *(bf16x8*)(V_lds + (bf) * SHM_V + vst1) = S.st_v1; } while (0)
#define SWRITE_H(bf) do { SWRITE_HV(bf); SWRITE_HK(bf); } while (0)
__device__ __forceinline__ void swa_prime(const BlockRef& cur, char* lds, Seam& S) {
    int tid_ = threadIdx.x; asm volatile("" : "+v"(tid_));
    const int tid = tid_, wid = __builtin_amdgcn_readfirstlane(tid >> 6), lane = tid & 63, r32 = lane & 31, hi = lane >> 5;
    const int sr = tid >> 4, sc = (tid & 15) * 8, kws = KSWZ(sr, sc * 2); char* K_lds = lds + 2 * SHM_V;
    const int kb0 = swa_jlo(cur.P0, cur.W) * KVBLK;
    { const char* qb_ = (const char*)cur.Q + (size_t)(wid * QBLK) * (size_t)cur.QS * 2; const unsigned qo_ = (unsigned)(r32 * cur.QS + hi * 8) * 2u;
      for (int d0 = 0; d0 < 8; ++d0) S.qr[d0] = LD8(qb_ + qo_ + d0 * 32); }
    SLOAD_H(cur.K, cur.V, kb0, cur.KS); VMW(); SWRITE_HK(0);
    __syncthreads();
}
__device__ __forceinline__ void swa_block(const BlockRef& cur, const BlockRef& nxt, char* lds, Seam& S) {
    int tid_ = threadIdx.x; asm volatile("" : "+v"(tid_));
    const int tid = tid_, wid = __builtin_amdgcn_readfirstlane(tid >> 6), lane = tid & 63, r32 = lane & 31, hi = lane >> 5;
    const int W = cur.W, skv = cur.skv;
    const int j_lo = swa_jlo(cur.P0, W);
    int j_hi = (cur.P0 + QB - 1) / KVBLK + 1; if (j_hi > skv / KVBLK) j_hi = skv / KVBLK;
    const int NT = j_hi - j_lo;
    const int kbn = swa_jlo(nxt.P0, nxt.W) * KVBLK;
    const int qlo = cur.P0 + wid * QBLK, qm = qlo + r32 - 4 * hi;
    char* V_lds = lds; char* K_lds = lds + 2 * SHM_V;
    float* ws = (float*)(lds + 2 * SHM_V + 2 * SHM_K) + wid * 64; float* li_l = ws, * al_l = ws + 32;
    float m_reg = -1e30f, l_reg = 0; f32x16 o[4] = {};
    const int sr = tid >> 4, sc = (tid & 15) * 8, vst0 = v_st(sr, sc), vst1 = v_st(32 + sr, sc), kws = KSWZ(sr, sc * 2);
    const int vb0 = (int)(uintptr_t)V_lds + v_rd_base(lane);
    const bf16* Kh = cur.K; const bf16* Vh = cur.V; const int KSc = cur.KS;
#define RESC(a) do { if (__any((a) < 1.f)) { if (hi == 0) al_l[r32] = (a); asm volatile("s_waitcnt lgkmcnt(0)" ::: "memory");              \
                     for (int d_ = 0; d_ < 4; ++d_) for (int r = 0; r < 16; ++r) o[d_][r] *= al_l[crow(r, hi)]; } } while (0)
#define KBASE(t) ((j_lo + (t)) * KVBLK)
#define ACT(t) (KBASE(t) <= qlo + QBLK - 1 && KBASE(t) + KVBLK - 1 >= qlo - W + 1)
#define MASKT(P0_, P1_, t) do { const int kb_ = KBASE(t); if ((!SK || ACT(t)) && (kb_ + KVBLK - 1 > qlo || kb_ <= qlo + QBLK - 1 - W)) mask_tile(P0_, P1_, qm - kb_, (unsigned)W); } while (0)
    constexpr int NQL = 8;
    constexpr bool SK = true;
#define SEAM_K0() do { VMWN(NQL); SWRITE_HK(0); SBAR(); } while (0)
    f32x16 pA0, pA1, pB0, pB1; float mnA, mnB, alA, alB; bf16x8 pa0, pa1, pa2, pa3;
    SWRITE_HV(0); SBAR();
    if (NT > 1) { SLOAD_H(Kh, Vh, KBASE(1), KSc); }
    SBAR(); qkt<0, SK>(pA0, pA1, K_lds, r32, hi, S.qr, ACT(0));
    MASKT(pA0, pA1, 0); partialSM(pA0, pA1, m_reg, mnA, alA);
    if (NT > 1) { VMW(); SWRITE_H(1); }
    __syncthreads();
#define HALF_STEP(PX0, PX1, mnX, alX, PY0, PY1, alY, t, KB, VB, SB) do {                                                      \
        SBAR(); qkt<KB, SK>(PX0, PX1, K_lds, r32, hi, S.qr, ACT(t));                                             \
        finishSM(PY0, PY1, alY, l_reg, pa0, pa1, pa2, pa3); SBAR();                                                           \
        if ((t) + 1 < NT) { SLOAD_H(Kh, Vh, KBASE((t) + 1), KSc); SBAR(); }                                               \
        pv_tile<VB, SK>(o, vb0, pa0, pa1, pa2, pa3, ACT((t) - 1)); MASKT(PX0, PX1, (t)); partialSM(PX0, PX1, m_reg, mnX, alX);                                        \
        __syncthreads();                                                                                                      \
        if ((t) + 1 < NT) { VMW(); SWRITE_H(SB); }                                                                          \
        RESC(alX); __syncthreads(); } while (0)
    for (int t = 1; t + 1 < NT; t += 2) {
        HALF_STEP(pB0, pB1, mnB, alB, pA0, pA1, alA, t, 1, 0, 0);
        HALF_STEP(pA0, pA1, mnA, alA, pB0, pB1, alB, t + 1, 0, 1, 1);
    }
    const bool even = (NT & 1) == 0;
    if (even) { SBAR(); qkt<1, SK>(pB0, pB1, K_lds, r32, hi, S.qr, ACT(NT - 1)); SBAR(); }
    { SLOAD_H(nxt.K, nxt.V, kbn, nxt.KS); SBAR();
      const char* qb_ = (const char*)nxt.Q + (size_t)(wid * QBLK) * (size_t)nxt.QS * 2; const unsigned qo_ = (unsigned)(r32 * nxt.QS + hi * 8) * 2u;
#pragma unroll
        for (int d0 = 0; d0 < 8; ++d0) S.qr[d0] = LD8(qb_ + qo_ + d0 * 32); }
    SBAR();
    finishSM(pA0, pA1, alA, l_reg, pa0, pa1, pa2, pa3); SBAR();
    pv_tile<0, SK>(o, vb0, pa0, pa1, pa2, pa3, ACT(even ? NT - 2 : NT - 1));
    if (even) { MASKT(pB0, pB1, NT - 1); partialSM(pB0, pB1, m_reg, mnB, alB); __syncthreads(); RESC(alB);
        finishSM(pB0, pB1, alB, l_reg, pa0, pa1, pa2, pa3); SBAR(); pv_tile<1, SK>(o, vb0, pa0, pa1, pa2, pa3, ACT(NT - 1)); }
    SBAR(); SEAM_K0();
    if (hi == 0) li_l[r32] = l_reg; asm volatile("s_waitcnt lgkmcnt(0)" ::: "memory");
    if (cur.LSE != nullptr && hi == 0) cur.LSE[(size_t)(wid * QBLK + r32) * cur.LS] = __log2f(l_reg) + m_reg * (1.4426950408889634f * SCALE);
    float rli[16];
#pragma unroll
    for (int r = 0; r < 16; ++r) rli[r] = __builtin_amdgcn_rcpf(li_l[crow(r, hi)]);
    bf16* Ow = cur.O + (size_t)(wid * QBLK) * cur.OS;
#pragma unroll
    for (int r = 0; r < 16; ++r) { const int orow = crow(r, hi);
#pragma unroll
        for (int d0 = 0; d0 < 4; ++d0) { const float v = o[d0][r] * rli[r];
            const float vn = __shfl_xor(v, 1);
            if ((r32 & 1) == 0) *(unsigned*)(Ow + (size_t)orow * cur.OS + d0 * 32 + r32) = cvtpk(v, vn); } }
    __syncthreads();
#undef RESC
#undef KBASE
#undef ACT
#undef MASKT
#undef SEAM_K0
#undef HALF_STEP
}
#undef LD8
#undef ROW
#undef VMW
#undef VMWN
#undef SLOAD_H
#undef SWRITE_HK
#undef SWRITE_HV
#undef SWRITE_H
#undef KSWZ
#undef SBAR
}

constexpr int NWAVES = 8;
#ifndef MK_N_LAUNCHES
#define MK_N_LAUNCHES 1
#endif
constexpr int N_PHASES = 13;
constexpr float W8_SCALE = 32.0f, H8_SCALE = 8.0f;
constexpr int SC_ONE = 0x7f7f7f7f, SC_W8 = 0x7a7a7a7a  , SC_H8 = 0x7c7c7c7c  ;
#ifndef NAIVE_ATTN
#define NAIVE_ATTN 0
#endif
constexpr float ATT_QSCALE = NAIVE_ATTN ? QSCALE : 1.0f;

constexpr size_t MiB = 1u << 20;
constexpr size_t WS_CTL = 0, CTL_ZERO_BYTES = 1 * MiB;
constexpr size_t WS_WIN = 2 * MiB;
constexpr size_t WS_WB = 24 * MiB;
constexpr size_t WS_WO = 27 * MiB;
constexpr size_t WS_WMEM = WS_WIN + (size_t)9984 * 1024 * 2;
constexpr size_t WS_W1 = 29 * MiB;
constexpr size_t WS_W2 = 157 * MiB;
constexpr size_t WS_XN = 221 * MiB;
constexpr size_t WS_Z = 256 * MiB;
constexpr size_t WS_RW = 568 * MiB;
constexpr size_t WS_YS = 792 * MiB;
constexpr size_t WS_YABC = 824 * MiB;
constexpr size_t WS_MRG = 872 * MiB;
constexpr size_t WS_MRGB = 936 * MiB;
constexpr size_t WS_MEMN = WS_XN + (size_t)16384 * 1024 * 2;
constexpr size_t WS_KVM = 969 * MiB;
constexpr size_t WS_XN2 = 970 * MiB;
constexpr size_t WS_ROUTE = 1002 * MiB;
constexpr size_t WS_LORA = 1004 * MiB;
constexpr size_t WS_END = 1005 * MiB;
constexpr size_t WS_XS = 256 * MiB;
constexpr size_t WS_HACT = 400 * MiB;
constexpr size_t WS_YROWS = 544 * MiB;
constexpr size_t WS_OP = WS_MRG;
constexpr size_t WS_LSE = WS_MRGB;
constexpr size_t WS_CS = WS_RW;
constexpr size_t WS_VMIX = WS_RW + 32 * MiB, WS_GMIX = WS_RW + 64 * MiB;
constexpr size_t WS_XN8 = WS_YS, WS_WIN8 = WS_YS + 16 * MiB;
constexpr size_t RWSZ = (size_t)MTOK * RW * 4;
constexpr size_t RT_TOPI = 0, RT_TOPG = 256 * 1024, RT_POS = 512 * 1024, RT_ROWGATE = 768 * 1024;
static_assert(RT_ROWGATE + (size_t)MAX_SLOTS * 4 <= 1088 * 1024, "route");
constexpr int CW_TMO = 0, CW_CODE = 1;
constexpr int CW_BAR = 4096;
constexpr int CW_CNT = 16384;
constexpr int CW_CUR = 16384 + 2048;

constexpr int RING_OFF = 0, RING_BYTES = 131072;
constexpr int LDSCTL_OFF = 143360, MISC_OFF = LDSCTL_OFF + 320;
constexpr int MOETAB_OFF = MISC_OFF + 128;
constexpr int HIST_OFF = MOETAB_OFF + 1536;
constexpr int LDS_BYTES = 147456;
static_assert(HIST_OFF + 4 * 320 <= LDS_BYTES, "LDS map");
#define GAS __attribute__((address_space(1)))
#define LAS __attribute__((address_space(3)))
typedef unsigned short bf16;
typedef unsigned v4u __attribute__((ext_vector_type(4)));
typedef float f32x4 __attribute__((ext_vector_type(4)));
typedef short bf16x8 __attribute__((ext_vector_type(8)));
typedef GAS unsigned gu32;
typedef GAS unsigned long long gu64;
#define RLX_AGENT __ATOMIC_RELAXED, __HIP_MEMORY_SCOPE_AGENT
#define LDS_WAIT() asm volatile("s_waitcnt lgkmcnt(0)" ::: "memory")
#define VM_WAIT() asm volatile("s_waitcnt vmcnt(0)" ::: "memory")
__device__ __forceinline__ unsigned long long rt() { return __builtin_amdgcn_s_memrealtime(); }
typedef float f32x2_cv __attribute__((ext_vector_type(2))); typedef __bf16 bf16x2_cv __attribute__((ext_vector_type(2)));
__device__ __forceinline__ unsigned pk2(float lo, float hi) { f32x2_cv v = {lo, hi}; bf16x2_cv b = __builtin_convertvector(v, bf16x2_cv); return __builtin_bit_cast(unsigned, b); }
__device__ __forceinline__ unsigned f2bf(float f) { return pk2(f, f) & 0xffffu; }
#define XB_TMO      128
#define XB_XCNT(j)  (256  + 64 * (j))
#define XB_XSUB(j)  (1280 + 64 * (j))
#define XB_XGEN(j)  (2304 + 64 * (j))
#define XB_TOP      3328
#define XB_TOPGEN   3392
#define XCD_BAR_WORDS 3456
#define XB_SPIN_CAP (1u << 18)

__device__ __forceinline__ unsigned xb_ld(unsigned* p)              { return __hip_atomic_load(p, __ATOMIC_RELAXED, __HIP_MEMORY_SCOPE_AGENT); }
__device__ __forceinline__ unsigned xb_add(unsigned* p, unsigned v) { return __hip_atomic_fetch_add(p, v, __ATOMIC_RELAXED, __HIP_MEMORY_SCOPE_AGENT); }
__device__ __forceinline__ unsigned xb_xcc_id() { return (unsigned)__builtin_amdgcn_s_getreg((3 << 11) | 20) & 0xFu; }
#define XB_SPIN(cond, bar) do { unsigned _sp = 0; while (cond) { __builtin_amdgcn_s_sleep(1); \
    if ((++_sp & 255u) == 0u) { if (xb_ld(&(bar)[XB_TMO])) break; if (_sp > XB_SPIN_CAP) { atomicAdd(&(bar)[XB_TMO], 1u); break; } } } } while (0)

struct XcdBarrier {
    unsigned* bar; unsigned x;
    volatile LAS unsigned* st;
};

__device__ __forceinline__ XcdBarrier xcd_barrier_post(unsigned* bar, volatile LAS unsigned* st) {
    XcdBarrier b; b.bar = bar; b.x = xb_xcc_id(); b.st = st;
    if (threadIdx.x == 0) (void)xb_add(&bar[XB_XCNT(b.x)], 1u);
    return b;
}
__device__ __forceinline__ void xcd_barrier_complete(unsigned* bar, unsigned x, unsigned& nloc, unsigned& nx) {
    const unsigned G = gridDim.x * gridDim.y * gridDim.z;
    unsigned sum, cnt, mine, sp = 0u;
    for (;;) {
        sum = 0u; cnt = 0u; mine = 0u;
#pragma unroll
        for (unsigned j = 0; j < 16; ++j) { const unsigned c = xb_ld(&bar[XB_XCNT(j)]); sum += c; cnt += (c > 0u) ? 1u : 0u; mine = (j == x) ? c : mine; }
        if (sum == G) break;
        __builtin_amdgcn_s_sleep(1);
        if ((++sp & 255u) == 0u) { if (xb_ld(&bar[XB_TMO])) break; if (sp > XB_SPIN_CAP) { atomicAdd(&bar[XB_TMO], 1u); break; } }
    }
    nloc = mine > 0u ? mine : 1u; nx = cnt > 0u ? cnt : 1u;
}

__device__ __forceinline__ void xcd_barrier(const XcdBarrier& b) {
    asm volatile("s_waitcnt vmcnt(0)" ::: "memory");
    __syncthreads();
    if (threadIdx.x == 0) {
        unsigned* bar = b.bar;
        __builtin_amdgcn_s_waitcnt(0);
        unsigned nloc = b.st[0], nx = b.st[1];
        if (nloc == 0u) { xcd_barrier_complete(bar, b.x, nloc, nx); b.st[0] = nloc; b.st[1] = nx; }
        const unsigned old = xb_add(&bar[XB_XSUB(b.x)], 1u);
        const unsigned gen = old / nloc;
        if (old + 1u == (gen + 1u) * nloc) {
            __builtin_amdgcn_fence(__ATOMIC_RELEASE, "agent");
            asm volatile("s_waitcnt vmcnt(0)" ::: "memory");
            const unsigned og = xb_add(&bar[XB_TOP], 1u);
            const unsigned tg = og / nx;
            if (og + 1u == (tg + 1u) * nx) xb_add(&bar[XB_TOPGEN], 1u);
            else XB_SPIN(xb_ld(&bar[XB_TOPGEN]) == tg, bar);
            __builtin_amdgcn_fence(__ATOMIC_ACQUIRE, "agent");
            xb_add(&bar[XB_XGEN(b.x)], 1u);
            asm volatile("s_waitcnt vmcnt(0)" ::: "memory");
        } else {
            XB_SPIN(xb_ld(&bar[XB_XGEN(b.x)]) == gen, bar);
            __builtin_amdgcn_fence(__ATOMIC_ACQUIRE, "agent");
            asm volatile("s_waitcnt vmcnt(0)" ::: "memory");
        }
    }
    __syncthreads();
}

typedef float f32x2 __attribute__((ext_vector_type(2)));
struct Args { const float* in[32]; float* out; unsigned char* ws; int ph_lo, ph_hi, use_bar, pad; };
struct Frame {
    LAS unsigned char* lds;
    volatile LAS unsigned* MISC;
    gu32* ctl;
    int tid, lane, wave;
    int vcu, G;
    float* out;
    unsigned char* ws;
};
enum { I_X = 0, I_MEM, I_POS, I_NORM_MIX, I_W_IN, I_B_GATE, I_AQ_GAIN, I_AK_GAIN, I_R_MU, I_R_W0, I_R_W2, I_R_A0, I_R_A2, I_R_G2, I_R_KK, I_R_KA, I_R_RK, I_R_LNW, I_R_LNB,
       I_MEM_NORM, I_W_MEMKV, I_CQ_GAIN, I_CK_GAIN, I_W_BRANCH, I_W_OUT, I_NORM_FFN, I_ROUTER_W, I_ROUTER_B, I_EXP_W1, I_EXP_B1, I_EXP_W2, I_EXP_B2 };

__device__ __forceinline__ bool phase_enter(Frame& F, bool on) { int t = (int)threadIdx.x; asm volatile("" : "+v"(t)); F.tid = t; F.lane = t & 63; F.wave = __builtin_amdgcn_readfirstlane(t >> 6); return on; }
__device__ __forceinline__ const float* ldarg(int i) {
    const __attribute__((address_space(4))) char* ka = (const __attribute__((address_space(4))) char*)__builtin_amdgcn_kernarg_segment_ptr();
    asm volatile("" : "+s"(ka));
    return *(const float* const __attribute__((address_space(4)))*)(ka + 8 * i);
}
__device__ __forceinline__ unsigned pk4_fp8(float a, float b, float c, float d) { unsigned w = 0; w = __builtin_amdgcn_cvt_pk_fp8_f32(a, b, w, false); w = __builtin_amdgcn_cvt_pk_fp8_f32(c, d, w, true); return w; }
__device__ __forceinline__ float fast_sigm(float x) { return __builtin_amdgcn_rcpf(1.0f + __builtin_amdgcn_exp2f(-1.4426950408889634f * x)); }
__device__ __forceinline__ float fast_tanh(float x) { return 1.0f - 2.0f * __builtin_amdgcn_rcpf(1.0f + __builtin_amdgcn_exp2f(2.8853900817779268f * x)); }
__device__ __forceinline__ float fast_softplus(float y) { return fmaxf(y, 0.f) + 0.6931471805599453f * __builtin_amdgcn_logf(1.0f + __builtin_amdgcn_exp2f(-1.4426950408889634f * fabsf(y))); }
__device__ __forceinline__ int opq(int x) { asm volatile("" : "+v"(x)); return x; }
__device__ __forceinline__ float bf_lo(unsigned w) { return __builtin_bit_cast(float, w << 16); }
__device__ __forceinline__ float bf_hi(unsigned w) { return __builtin_bit_cast(float, w & 0xffff0000u); }
__device__ __forceinline__ float sigm(float x) { return 1.0f / (1.0f + __expf(-x)); }
template <int CTRL, int RM> __device__ __forceinline__ float dpp0(float v) {
    return __builtin_bit_cast(float, __builtin_amdgcn_update_dpp(0, __builtin_bit_cast(int, v), CTRL, RM, 0xf, true)); }
__device__ __forceinline__ float row16_sum(float v) {
    v += dpp0<0xB1, 0xf>(v); v += dpp0<0x4E, 0xf>(v); v += dpp0<0x141, 0xf>(v); v += dpp0<0x140, 0xf>(v); return v; }
__device__ __forceinline__ float rdlane(float v, int l) { return __builtin_bit_cast(float, __builtin_amdgcn_readlane(__builtin_bit_cast(int, v), l)); }
__device__ __forceinline__ float wave_sum(float v) {
    v = row16_sum(v); v += dpp0<0x142, 0xA>(v); v += dpp0<0x143, 0xC>(v); return rdlane(v, 63); }
__device__ __forceinline__ void half_sums(float v, float& lo, float& hi) {
    v = row16_sum(v); v += dpp0<0x142, 0xA>(v); lo = rdlane(v, 31); hi = rdlane(v, 63); }
__device__ __forceinline__ float wave_max_bp(float v) {
#pragma unroll
    for (int o = 1; o < 64; o <<= 1) v = fmaxf(v, __shfl_xor(v, o));
    return v; }

__device__ __forceinline__ void tconv_tile(const float* W, int K, int N, bf16* WT, int k0, int n0, int rowbase, int lane, int kd = 0) {
    const int c = lane & 15, q = lane >> 4;
    const GAS f32x4* src = (const GAS f32x4*)(W + (size_t)(k0 + 16 * q) * N + n0 + 4 * c);
    const size_t rs = (size_t)N / 4;
    f32x4 v[16];
#pragma unroll
    for (int i = 0; i < 16; ++i) v[i] = src[i * rs];
#pragma unroll
    for (int j = 0; j < 4; ++j) {
        GAS v4u* dst = (GAS v4u*)(WT + (size_t)(rowbase + 4 * c + j) * K + kd + k0 + 16 * q);
        v4u o0, o1;
        o0.x = pk2(v[0][j], v[1][j]); o0.y = pk2(v[2][j], v[3][j]); o0.z = pk2(v[4][j], v[5][j]); o0.w = pk2(v[6][j], v[7][j]);
        o1.x = pk2(v[8][j], v[9][j]); o1.y = pk2(v[10][j], v[11][j]); o1.z = pk2(v[12][j], v[13][j]); o1.w = pk2(v[14][j], v[15][j]);
        dst[0] = o0; dst[1] = o1;
    }
}
__device__ __forceinline__ void tconv_tile128(const float* W, int K, int N, bf16* WT, int k0, int n0, int rowbase, int lane) {
    const int c = lane & 31, q = lane >> 5;
    const GAS f32x4* src = (const GAS f32x4*)(W + (size_t)(k0 + 32 * q) * N + n0 + 4 * c);
    const size_t rs = (size_t)N / 4;
    f32x4 v[32];
#pragma unroll
    for (int i = 0; i < 32; ++i) v[i] = src[i * rs];
#pragma unroll
    for (int j = 0; j < 4; ++j) {
        GAS v4u* dst = (GAS v4u*)(WT + (size_t)(rowbase + 4 * c + j) * K + k0 + 32 * q);
#pragma unroll
        for (int g = 0; g < 4; ++g) { v4u o; o.x = pk2(v[8 * g][j], v[8 * g + 1][j]); o.y = pk2(v[8 * g + 2][j], v[8 * g + 3][j]); o.z = pk2(v[8 * g + 4][j], v[8 * g + 5][j]); o.w = pk2(v[8 * g + 6][j], v[8 * g + 7][j]); dst[g] = o; }
    }
}
__device__ __forceinline__ void tconv_tile_f8(const float* W, int K, int N, unsigned char* WT, int k0, int n0, int rowbase, int lane, float sc) {
    const int c = lane & 15, q = lane >> 4;
    const GAS f32x4* src = (const GAS f32x4*)(W + (size_t)(k0 + 16 * q) * N + n0 + 4 * c);
    const size_t rs = (size_t)N / 4;
    f32x4 v[16];
#pragma unroll
    for (int i = 0; i < 16; ++i) v[i] = src[i * rs] * sc;
#pragma unroll
    for (int j = 0; j < 4; ++j) {
        v4u o; o.x = pk4_fp8(v[0][j], v[1][j], v[2][j], v[3][j]); o.y = pk4_fp8(v[4][j], v[5][j], v[6][j], v[7][j]); o.z = pk4_fp8(v[8][j], v[9][j], v[10][j], v[11][j]); o.w = pk4_fp8(v[12][j], v[13][j], v[14][j], v[15][j]);
        *(GAS v4u*)(WT + (size_t)(rowbase + 4 * c + j) * K + k0 + 16 * q) = o;
    }
}
__device__ __forceinline__ void tc8_load(const float* W, int N, int k0, int n0, int lane, f32x4 (&v)[16]) {
    const int c = lane & 15, q = lane >> 4; const GAS f32x4* src = (const GAS f32x4*)(W + (size_t)(k0 + 16 * q) * N + n0 + 4 * c); const size_t rs = (size_t)N / 4;
#pragma unroll
    for (int i = 0; i < 16; ++i) v[i] = src[i * rs];
}
__device__ __forceinline__ void tc8_store(unsigned char* WT, int K, int k0, int rowbase, int lane, const f32x4 (&v)[16], float sc) {
    const int c = lane & 15, q = lane >> 4;
#pragma unroll
    for (int j = 0; j < 4; ++j) {
        v4u o; o.x = pk4_fp8(v[0][j] * sc, v[1][j] * sc, v[2][j] * sc, v[3][j] * sc); o.y = pk4_fp8(v[4][j] * sc, v[5][j] * sc, v[6][j] * sc, v[7][j] * sc);
        o.z = pk4_fp8(v[8][j] * sc, v[9][j] * sc, v[10][j] * sc, v[11][j] * sc); o.w = pk4_fp8(v[12][j] * sc, v[13][j] * sc, v[14][j] * sc, v[15][j] * sc);
        *(GAS v4u*)(WT + (size_t)(rowbase + 4 * c + j) * K + k0 + 16 * q) = o; }
}
__device__ __forceinline__ void w1_tile(int r, const float* W1, unsigned char* W1T, const float*& W, unsigned char*& WT, int& k0, int& n0, int& rowbase) {
    const int e = r / 512, q = r % 512, kb = q % 16, nb = q / 16; n0 = 64 * nb; k0 = 64 * kb;
    rowbase = (n0 < 1024) ? ((n0 >> 7) * 256 + (n0 & 127)) : ((((n0 - 1024) >> 7) * 256) + 128 + ((n0 - 1024) & 127));
    W = W1 + (size_t)e * 1024 * 2048; WT = W1T + (size_t)e * 2048 * 1024;
}
__device__ __forceinline__ void rms_row_to_bf16(const float* xrow, const float* gain, bf16* orow, int lane, unsigned char* orow8 = nullptr) {
    const GAS f32x4* xr = (const GAS f32x4*)xrow + lane; const GAS f32x4* gr = (const GAS f32x4*)gain + lane;
    f32x4 v[4]; float s = 0.f;
#pragma unroll
    for (int j = 0; j < 4; ++j) { v[j] = xr[64 * j]; s += (v[j].x * v[j].x + v[j].y * v[j].y) + (v[j].z * v[j].z + v[j].w * v[j].w); }
    const float rstd = 1.0f / sqrtf(wave_sum(s) * (1.f / D_MODEL) + NORM_EPS);
    GAS unsigned long long* o8 = (GAS unsigned long long*)orow + lane;
#pragma unroll
    for (int j = 0; j < 4; ++j) { const f32x4 g = gr[64 * j];
        o8[64 * j] = (unsigned long long)pk2(v[j].x * rstd * g.x, v[j].y * rstd * g.y) | ((unsigned long long)pk2(v[j].z * rstd * g.z, v[j].w * rstd * g.w) << 32);
        if (orow8) ((GAS unsigned*)orow8 + lane)[64 * j] = pk4_fp8(v[j].x * rstd * g.x, v[j].y * rstd * g.y, v[j].z * rstd * g.z, v[j].w * rstd * g.w); }
}
template <int PART> __device__ __forceinline__ void p0_prologue(Frame& F, const Args& args, int gw, int NGW) {
    const int lane = F.lane;
    unsigned char* ws = F.ws;
    constexpr int T_IN = 16 * 156, T_WB = 3 * 128, T_WO = 256, T_WM = 256, T_W1 = 32 * 512, T_W2 = 32 * 256, T_LO = 32;
    constexpr int NT = T_IN + T_WB + T_WO + T_WM + T_W1 + T_W2;
    constexpr int IT0 = (PART == 0) ? 0 : (PART == 1) ? T_IN + T_WB + T_WO + T_WM + T_W1 : T_IN + T_WB + T_WO + T_WM, IT1 = (PART == 0) ? T_IN + T_WB + T_WO + T_WM : (PART == 1) ? NT : T_IN + T_WB + T_WO + T_WM + T_W1;
    for (int it = IT0 + gw; it < IT1; it += NGW) {
        int r = it;
        if (r < T_IN) { const int kb = r / 156, nb = r % 156, nt = nb >> 2;
            if (nt >= 27) tconv_tile_f8(ldarg(I_W_IN), 1024, IN_COLS, ws + WS_WIN8, 64 * kb, 64 * nb, 64 * nb, lane, W8_SCALE);
            else tconv_tile(ldarg(I_W_IN), 1024, IN_COLS, (bf16*)(ws + WS_WIN), 64 * kb, 64 * nb, 64 * nb, lane);
            continue; } r -= T_IN;
        if (r < T_WB) { const int b = r / 128, q = r % 128, kb = q / 16, nb = q % 16;
            tconv_tile(ldarg(I_W_BRANCH) + (size_t)b * 512 * 1024, 1536, 1024, (bf16*)(ws + WS_WB), 64 * kb, 64 * nb, 64 * nb, lane, 512 * b); continue; } r -= T_WB;
        if (r < T_WO) { const int kb = r / 16, nb = r % 16; tconv_tile(ldarg(I_W_OUT), 1024, 1024, (bf16*)(ws + WS_WO), 64 * kb, 64 * nb, 64 * nb, lane); continue; } r -= T_WO;
        if (r < T_WM) { const int kb = r / 16, nb = r % 16; tconv_tile(ldarg(I_W_MEMKV), 1024, 1024, (bf16*)(ws + WS_WMEM), 64 * kb, 64 * nb, 64 * nb, lane); continue; } r -= T_WM;
        if (r < T_W1) { const int e = r / 512, q = r % 512, kb = q % 16, nb = q / 16, n0 = 64 * nb;
            const int rowbase = (n0 < 1024) ? ((n0 >> 7) * 256 + (n0 & 127)) : ((((n0 - 1024) >> 7) * 256) + 128 + ((n0 - 1024) & 127));
            tconv_tile_f8(ldarg(I_EXP_W1) + (size_t)e * 1024 * 2048, 1024, 2048, ws + WS_W1 + (size_t)e * 2048 * 1024, 64 * kb, n0, rowbase, lane, W8_SCALE); continue; } r -= T_W1;
        { const int e = r / 256, q = r % 256, kb = q % 16, nb = q / 16;
            tconv_tile_f8(ldarg(I_EXP_W2) + (size_t)e * 1024 * 1024, 1024, 1024, ws + WS_W2 + (size_t)e * 1024 * 1024, 64 * kb, 64 * nb, 64 * nb, lane, W8_SCALE); }
    }
    if (PART == 0) {
    for (int it = gw; it < T_LO; it += NGW) {
        bf16* L = (bf16*)(ws + WS_LORA);
        if (it < 8) tconv_tile(ldarg(I_R_W2), 64, 512, L, 0, 64 * it, 64 * it, lane);
        else if (it < 16) tconv_tile(ldarg(I_R_A2), 64, 512, L + 512 * 64, 0, 64 * (it - 8), 64 * (it - 8), lane);
        else { const int q = it - 16; tconv_tile(ldarg(I_R_G2), 128, 512, L + 2 * 512 * 64, 64 * (q >> 3), 64 * (q & 7), 64 * (q & 7), lane); } }
    { const int* posp = (const int*)ldarg(I_POS); float* cs = (float*)(ws + WS_CS);
      for (int idx = gw * 64 + lane; idx < MTOK * 16; idx += NGW * 64) { const int m = idx >> 4, i = idx & 15; const float ang = (float)posp[m] * exp2f(-(float)i * (18.931568569324174f / 16.0f)); const float sn = sinf(ang), cn = cosf(ang);
          f32x2 o; o.x = cn; o.y = sn; *(GAS f32x2*)(cs + (size_t)idx * 2) = o; } }
    for (int m = gw; m < MTOK; m += NGW) rms_row_to_bf16(ldarg(I_X) + (size_t)m * D_MODEL, ldarg(I_NORM_MIX), (bf16*)(ws + WS_XN) + (size_t)m * D_MODEL, lane, ws + WS_XN8 + (size_t)m * D_MODEL);
    for (int m = gw; m < MEMROWS; m += NGW) rms_row_to_bf16(ldarg(I_MEM) + (size_t)m * D_MODEL, ldarg(I_MEM_NORM), (bf16*)(ws + WS_MEMN) + (size_t)m * D_MODEL, lane);
    }
}

__device__ __forceinline__ void head_norm(bf16* p, const float* gain, bool rot, float c0, float s0, float c1, float s1, float scale, int lane) {
    GAS unsigned* pw = (GAS unsigned*)p + lane;
    const unsigned w = *pw; float a = bf_lo(w), b = bf_hi(w);
    const float ss = wave_sum(a * a + b * b);
    const float rstd = 1.0f / sqrtf(ss * (1.f / 128.f) + NORM_EPS);
    const f32x2 g = *((const GAS f32x2*)gain + lane);
    a = a * rstd * g.x; b = b * rstd * g.y;
    const float pa = __shfl_xor(a, 8), pb = __shfl_xor(b, 8);
    if (rot && lane < 16) {
        if (lane < 8) { a = a * c0 - pa * s0; b = b * c1 - pb * s1; }
        else          { a = a * c0 + pa * s0; b = b * c1 + pb * s1; }
    }
    *pw = pk2(a * scale, b * scale);
}
__device__ __forceinline__ void p2_prep(Frame& F, const Args& args) {
    const int gw = F.vcu * NWAVES + F.wave, NGW = F.G * NWAVES, lane = F.lane;
    unsigned char* ws = F.ws;
    bf16* Z = (bf16*)(ws + WS_Z);
    LAS float* lo = (LAS float*)(F.lds + RING_OFF + F.wave * 8192);
    const float* mu = ldarg(I_R_MU); const float* aqg = ldarg(I_AQ_GAIN); const float* akg = ldarg(I_AK_GAIN); const float* cqg = ldarg(I_CQ_GAIN); const int* posp = (const int*)ldarg(I_POS);
    float* Rr = (float*)(ws + WS_RW); float* Rw = Rr + (size_t)MTOK * RW; float* Rk = Rw + (size_t)MTOK * RW; float* Rv = Rk + (size_t)MTOK * RW;
    float* Ra = Rv + (size_t)MTOK * RW; float* Rb = Ra + (size_t)MTOK * RW; float* Rg = Rb + (size_t)MTOK * RW;
    for (int m = gw; m < MEMROWS; m += NGW)
        for (int hd = 0; hd < 4; ++hd) head_norm((bf16*)(ws + WS_KVM) + (size_t)m * 1024 + hd * 128, ldarg(I_CK_GAIN), false, 1.f, 0.f, 1.f, 0.f, 1.0f, lane);
}

__device__ __forceinline__ void lora_stage(const float* W, LAS unsigned* wl, int tid) {
#pragma unroll
    for (int i = 0; i < 16; ++i) { const int idx = tid + 512 * i; const f32x4 v = *((const GAS f32x4*)W + idx);
        *(LAS unsigned long long*)(wl + 2 * idx) = (unsigned long long)pk2(v.x, v.y) | ((unsigned long long)pk2(v.z, v.w) << 32); }
}
__device__ __forceinline__ void lora_mac(const LAS unsigned* wl, const LAS float* lo, float (&acc)[4][8], int lane) {
#pragma unroll 4
    for (int j = 0; j < 64; ++j) { const f32x4 xin = *(const LAS f32x4*)(lo + j * 4);
#pragma unroll
        for (int i = 0; i < 4; ++i) { const unsigned w = wl[j * 256 + lane + 64 * i]; const float w0 = bf_lo(w), w1 = bf_hi(w);
#pragma unroll
            for (int tt = 0; tt < 4; ++tt) { acc[tt][2 * i] += xin[tt] * w0; acc[tt][2 * i + 1] += xin[tt] * w1; } } }
}
template <int NL> __device__ __forceinline__ void lora_in(const bf16* Z, const float* mu, int ch, int m0, LAS float* lo, int lane) {
    const int col = OFF_R + 1536 + ch; const float muj = mu[1536 + ch];
    float prv = ((m0 % SEQ) == 0) ? 0.f : __builtin_bit_cast(float, (unsigned)Z[(size_t)(m0 - 1) * IN_COLS + col] << 16);
#pragma unroll
    for (int tt = 0; tt < 4; ++tt) { const float cur = __builtin_bit_cast(float, (unsigned)Z[(size_t)(m0 + tt) * IN_COLS + col] << 16);
        float x = cur + (prv - cur) * muj; prv = cur;
        x = (NL == 0) ? tanhf(x) : (NL == 1) ? x : sigm(x);
        lo[lane * 4 + tt] = x; }
    LDS_WAIT(); asm volatile("" ::: "memory");
}
__device__ __forceinline__ void p2_rwkv(Frame& F, const Args& args) {
    const int lane = F.lane, wave = F.wave;
    unsigned char* ws = F.ws;
    const bf16* Z = (const bf16*)(ws + WS_Z);
    LAS unsigned* wl = (LAS unsigned*)(F.lds + RING_OFF);
    LAS float* lo = (LAS float*)(F.lds + RING_OFF + 65536 + wave * 1024);
    const float* mu = ldarg(I_R_MU);
    float* Rr = (float*)(ws + WS_RW); float* Rw = Rr + (size_t)MTOK * RW; float* Rk = Rw + (size_t)MTOK * RW; float* Rv = Rk + (size_t)MTOK * RW;
    float* Ra = Rv + (size_t)MTOK * RW; float* Rb = Ra + (size_t)MTOK * RW; float* Rg = Rb + (size_t)MTOK * RW;
    for (int grp = F.vcu; grp < MTOK / 64; grp += F.G) {
        const int mw = grp * 64 + wave * 8;
        lora_stage(ldarg(I_R_W2), wl, F.tid);
        __syncthreads();
        for (int tk = 0; tk < 2; ++tk) { const int m0 = mw + 4 * tk;
            lora_in<0>(Z, mu, lane, m0, lo, lane);
            float acc[4][8];
#pragma unroll
            for (int tt = 0; tt < 4; ++tt)
#pragma unroll
                for (int c = 0; c < 8; ++c) acc[tt][c] = 0.f;
            lora_mac(wl, lo, acc, lane);
            const float* w0p = ldarg(I_R_W0);
#pragma unroll
            for (int i = 0; i < 4; ++i) { const int c = 2 * lane + 128 * i; const f32x2 w0 = *(const GAS f32x2*)(w0p + c);
#pragma unroll
                for (int tt = 0; tt < 4; ++tt) { const float y0 = -(w0.x + acc[tt][2 * i]), y1 = -(w0.y + acc[tt][2 * i + 1]);
                    const float sp0 = fmaxf(y0, 0.f) + log1pf(__expf(-fabsf(y0))), sp1 = fmaxf(y1, 0.f) + log1pf(__expf(-fabsf(y1)));
                    f32x2 wd; wd.x = -__expf(-sp0 - 0.5f); wd.y = -__expf(-sp1 - 0.5f);
                    *(GAS f32x2*)(Rw + (size_t)(m0 + tt) * RW + c) = wd; } }
            LDS_WAIT(); asm volatile("" ::: "memory"); }
        __syncthreads();
        lora_stage(ldarg(I_R_A2), wl, F.tid);
        __syncthreads();
        for (int tk = 0; tk < 2; ++tk) { const int m0 = mw + 4 * tk; const int tpos0 = m0 % SEQ;
            lora_in<1>(Z, mu, 64 + lane, m0, lo, lane);
            float acca[4][8];
#pragma unroll
            for (int tt = 0; tt < 4; ++tt)
#pragma unroll
                for (int c = 0; c < 8; ++c) acca[tt][c] = 0.f;
            lora_mac(wl, lo, acca, lane);
            const float* a0p = ldarg(I_R_A0); const float* kkp = ldarg(I_R_KK); const float* kap = ldarg(I_R_KA);
#pragma unroll
            for (int i = 0; i < 4; ++i) {
                const int c = 2 * lane + 128 * i;
                const f32x2 a0 = *(const GAS f32x2*)(a0p + c), kkc = *(const GAS f32x2*)(kkp + c), kac = *(const GAS f32x2*)(kap + c);
                const f32x2 mur = *(const GAS f32x2*)(mu + c), muk = *(const GAS f32x2*)(mu + 512 + c), muv = *(const GAS f32x2*)(mu + 1024 + c);
                unsigned pr = 0u, pk = 0u, pv = 0u;
                if (tpos0 != 0) { const bf16* zp = Z + (size_t)(m0 - 1) * IN_COLS + OFF_R + c; pr = *(const GAS unsigned*)zp; pk = *(const GAS unsigned*)(zp + 512); pv = *(const GAS unsigned*)(zp + 1024); }
#pragma unroll
                for (int tt = 0; tt < 4; ++tt) {
                    const size_t m = (size_t)(m0 + tt);
                    const bf16* zc = Z + m * IN_COLS + OFF_R + c;
                    const unsigned cr = *(const GAS unsigned*)zc, ck = *(const GAS unsigned*)(zc + 512), cv = *(const GAS unsigned*)(zc + 1024);
                    f32x2 r, k, v;
                    r.x = bf_lo(cr) + (bf_lo(pr) - bf_lo(cr)) * mur.x; r.y = bf_hi(cr) + (bf_hi(pr) - bf_hi(cr)) * mur.y;
                    k.x = bf_lo(ck) + (bf_lo(pk) - bf_lo(ck)) * muk.x; k.y = bf_hi(ck) + (bf_hi(pk) - bf_hi(ck)) * muk.y;
                    v.x = bf_lo(cv) + (bf_lo(pv) - bf_lo(cv)) * muv.x; v.y = bf_hi(cv) + (bf_hi(pv) - bf_hi(cv)) * muv.y;
                    pr = cr; pk = ck; pv = cv;
                    f32x2 av; av.x = sigm(a0.x + acca[tt][2 * i]); av.y = sigm(a0.y + acca[tt][2 * i + 1]);
                    f32x2 kk; kk.x = k.x * kkc.x; kk.y = k.y * kkc.y;
                    float slo, shi; half_sums(kk.x * kk.x + kk.y * kk.y, slo, shi);
                    const float nrm = fmaxf(sqrtf(lane < 32 ? slo : shi), 1e-12f), inv = 1.0f / nrm;
                    kk.x *= inv; kk.y *= inv;
                    f32x2 k2; k2.x = k.x * (1.0f + (av.x - 1.0f) * kac.x); k2.y = k.y * (1.0f + (av.y - 1.0f) * kac.y);
                    f32x2 as, bs; as.x = -kk.x; as.y = -kk.y; bs.x = kk.x * av.x; bs.y = kk.y * av.y;
                    const size_t o = m * RW + c;
                    *(GAS f32x2*)(Rr + o) = r; *(GAS f32x2*)(Rk + o) = k2; *(GAS f32x2*)(Rv + o) = v; *(GAS f32x2*)(Ra + o) = as; *(GAS f32x2*)(Rb + o) = bs;
                }
            }
            LDS_WAIT(); asm volatile("" ::: "memory"); }
        __syncthreads();
        float accg[2][4][8];
#pragma unroll
        for (int tk = 0; tk < 2; ++tk)
#pragma unroll
            for (int tt = 0; tt < 4; ++tt)
#pragma unroll
                for (int c = 0; c < 8; ++c) accg[tk][tt][c] = 0.f;
#pragma unroll
        for (int hh = 0; hh < 2; ++hh) {
            lora_stage(ldarg(I_R_G2) + (size_t)hh * 64 * RW, wl, F.tid);
            __syncthreads();
#pragma unroll
            for (int tk = 0; tk < 2; ++tk) { lora_in<2>(Z, mu, 128 + 64 * hh + lane, mw + 4 * tk, lo, lane); lora_mac(wl, lo, accg[tk], lane); LDS_WAIT(); asm volatile("" ::: "memory"); }
            __syncthreads();
        }
#pragma unroll
        for (int tk = 0; tk < 2; ++tk)
#pragma unroll
            for (int i = 0; i < 4; ++i)
#pragma unroll
                for (int tt = 0; tt < 4; ++tt) { f32x2 gg; gg.x = accg[tk][tt][2 * i]; gg.y = accg[tk][tt][2 * i + 1]; *(GAS f32x2*)(Rg + (size_t)(mw + 4 * tk + tt) * RW + 2 * lane + 128 * i) = gg; }
    }
}

__device__ __forceinline__ float qk_dot(const LAS float* q, const bf16* krow) {
    const GAS v4u* kp = (const GAS v4u*)krow; float s0 = 0.f, s1 = 0.f;
#pragma unroll
    for (int i = 0; i < 16; ++i) { const v4u w = kp[i]; const f32x4 qa = *(const LAS f32x4*)(q + 8 * i), qb = *(const LAS f32x4*)(q + 8 * i + 4);
        s0 += bf_lo(w.x) * qa[0] + bf_hi(w.x) * qa[1] + bf_lo(w.y) * qa[2] + bf_hi(w.y) * qa[3];
        s1 += bf_lo(w.z) * qb[0] + bf_hi(w.z) * qb[1] + bf_lo(w.w) * qb[2] + bf_hi(w.w) * qb[3]; }
    return s0 + s1;
}
__device__ __forceinline__ void p3_attention(Frame& F) {
    const int gw = F.vcu * NWAVES + F.wave, NGW = F.G * NWAVES, lane = F.lane;
    unsigned char* ws = F.ws;
    const bf16* Z = (const bf16*)(ws + WS_Z);
    const bf16* KV = (const bf16*)(ws + WS_KVM);
    bf16* YA = (bf16*)(ws + WS_YABC); bf16* YC = YA + (size_t)2 * MTOK * 512;
    LAS float* qs = (LAS float*)(F.lds + RING_OFF + F.wave * 8192);
    for (int task = gw; task < MTOK * 4; task += NGW) {
        const int m = task >> 2, h = task & 3, t = m % SEQ;
        const bf16* zrow = Z + (size_t)m * IN_COLS;
#pragma unroll
        for (int g = 0; g < 3; ++g) { const unsigned w = *((const GAS unsigned*)(zrow + OFF_AQ + g * 512 + h * 128) + lane); qs[g * 128 + 2 * lane] = bf_lo(w); qs[g * 128 + 2 * lane + 1] = bf_hi(w); }
        LDS_WAIT(); asm volatile("" ::: "memory");
        float sc[3][3]; float mx = -INFINITY;
#pragma unroll
        for (int g = 0; g < 3; ++g) { const int dl = (g == 0) ? 1 : (g == 1) ? 4 : 16;
#pragma unroll
            for (int p = 0; p < 3; ++p) { const int j = lane + 64 * p; const int tk = t - dl * j; float s = -INFINITY;
                if (j <= 128 && tk >= 0) s = qk_dot(qs + g * 128, zrow - (size_t)dl * j * IN_COLS + OFF_AK + g * 512 + h * 128);
                sc[g][p] = s; mx = fmaxf(mx, s); } }
        mx = wave_max_bp(mx);
        float den = 0.f;
#pragma unroll
        for (int g = 0; g < 3; ++g)
#pragma unroll
            for (int p = 0; p < 3; ++p) { sc[g][p] = exp2f(sc[g][p] - mx); den += sc[g][p]; }
        den = wave_sum(den);
        float o0 = 0.f, o1 = 0.f;
#pragma unroll
        for (int g = 0; g < 3; ++g) { const int dl = (g == 0) ? 1 : (g == 1) ? 4 : 16; const bf16* vb = zrow + OFF_AV + g * 512 + h * 128 + 2 * lane;
#pragma unroll
            for (int p = 0; p < 3; ++p) { const int nj = (p < 2) ? 64 : 1;
                for (int jj = 0; jj < nj; ++jj) { const int j = jj + 64 * p; const float pj = rdlane(sc[g][p], jj);
                    if (t - dl * j >= 0) { const unsigned w = *(const GAS unsigned*)(vb - (size_t)dl * j * IN_COLS); o0 += pj * bf_lo(w); o1 += pj * bf_hi(w); } } } }
        const float inv = 1.0f / den;
        *((GAS unsigned*)(YA + (size_t)m * 512 + h * 128) + lane) = pk2(o0 * inv, o1 * inv);
        asm volatile("" ::: "memory");
    }
    for (int task = gw; task < MTOK * 4; task += NGW) {
        const int m = task >> 2, h = task & 3, b = m / SEQ;
        const bf16* zrow = Z + (size_t)m * IN_COLS;
        { const unsigned w = *((const GAS unsigned*)(zrow + OFF_CQ + h * 128) + lane); qs[2 * lane] = bf_lo(w); qs[2 * lane + 1] = bf_hi(w); }
        LDS_WAIT(); asm volatile("" ::: "memory");
        const bf16* kb = KV + (size_t)b * MEM_LEN * 1024 + h * 128;
        float sc[4]; float mx = -INFINITY;
#pragma unroll
        for (int p = 0; p < 4; ++p) { sc[p] = qk_dot(qs, kb + (size_t)(lane + 64 * p) * 1024); mx = fmaxf(mx, sc[p]); }
        mx = wave_max_bp(mx);
        float den = 0.f;
#pragma unroll
        for (int p = 0; p < 4; ++p) { sc[p] = exp2f(sc[p] - mx); den += sc[p]; }
        den = wave_sum(den);
        float o0 = 0.f, o1 = 0.f; const bf16* vb = kb + 512 + 2 * lane;
#pragma unroll
        for (int p = 0; p < 4; ++p)
            for (int jj = 0; jj < 64; ++jj) { const float pj = rdlane(sc[p], jj); const unsigned w = *(const GAS unsigned*)(vb + (size_t)(jj + 64 * p) * 1024); o0 += pj * bf_lo(w); o1 += pj * bf_hi(w); }
        const float inv = 1.0f / den;
        *((GAS unsigned*)(YC + (size_t)m * 512 + h * 128) + lane) = pk2(o0 * inv, o1 * inv);
        asm volatile("" ::: "memory");
    }
}

__device__ __forceinline__ void p5_post(Frame& F, const Args& args) {
    const int gw = F.vcu * NWAVES + F.wave, NGW = F.G * NWAVES, lane = F.lane;
    unsigned char* ws = F.ws;
    const float* Rr = (const float*)(ws + WS_RW); const float* Rk = Rr + (size_t)2 * MTOK * RW; const float* Rv = Rk + (size_t)MTOK * RW; const float* Rg = Rr + (size_t)6 * MTOK * RW;
    const float* YS = (const float*)(ws + WS_YS);
    bf16* YB = (bf16*)(ws + WS_YABC) + (size_t)MTOK * 512;
    const bf16* OP = (const bf16*)(ws + WS_OP); const float* LS = (const float*)(ws + WS_LSE); bf16* YA = (bf16*)(ws + WS_YABC);
    for (int m = gw; m < MTOK; m += NGW) {
#pragma unroll
        for (int h = 0; h < 4; ++h) {
            const float l0 = LS[(size_t)m * 4 + h], l1 = LS[(size_t)MTOK * 4 + (size_t)m * 4 + h], l2 = LS[(size_t)2 * MTOK * 4 + (size_t)m * 4 + h];
            const float mx = fmaxf(l0, fmaxf(l1, l2)); const float w0 = exp2f(l0 - mx), w1 = exp2f(l1 - mx), w2 = exp2f(l2 - mx); const float inv = 1.0f / (w0 + w1 + w2);
            const size_t o = (size_t)m * 512 + h * 128;
            const unsigned a = *((const GAS unsigned*)(OP + o) + lane), b = *((const GAS unsigned*)(OP + (size_t)MTOK * 512 + o) + lane), c = *((const GAS unsigned*)(OP + (size_t)2 * MTOK * 512 + o) + lane);
            *((GAS unsigned*)(YA + (size_t)m * 1536 + h * 128) + lane) = pk2((w0 * bf_lo(a) + w1 * bf_lo(b) + w2 * bf_lo(c)) * inv, (w0 * bf_hi(a) + w1 * bf_hi(b) + w2 * bf_hi(c)) * inv); }
    }
}

__device__ __forceinline__ void p8_router(Frame& F, const Args& args) {
    const int lane = F.lane, wave = F.wave;
    unsigned char* ws = F.ws;
    const float* X1 = F.out;
    LAS int* hist = (LAS int*)(F.lds + HIST_OFF);
    { const int t_ = opq(F.tid); if (t_ < 32) hist[t_] = 0; }
    int* topi = (int*)(ws + WS_ROUTE + RT_TOPI); float* topg = (float*)(ws + WS_ROUTE + RT_TOPG);
    const float* RWt = ldarg(I_ROUTER_W); const float* RB = ldarg(I_ROUTER_B); const float* gain = ldarg(I_NORM_FFN);
    LAS float* rw = (LAS float*)(F.lds + RING_OFF);
    typedef float f32x16r __attribute__((ext_vector_type(16)));
    for (int grp = F.vcu; grp < MTOK / 64; grp += F.G) {
#pragma unroll
        for (int i = 0; i < 16; ++i) { const int f = F.tid + 512 * i, k = f >> 3; const f32x4 w = *((const GAS f32x4*)RWt + f); const float g = gain[k]; ((LAS f32x4*)rw)[f] = w * g; }
        __syncthreads();
        const int tile = wave >> 2, wq = wave & 3, i32 = lane & 31, h = lane >> 5;
        const GAS f32x4* xp = (const GAS f32x4*)(X1 + ((size_t)grp * 64 + tile * 32 + i32) * D_MODEL + wq * 256 + 4 * h);
        const LAS float* bp = rw + (wq * 256 + 4 * h) * 32 + i32;
        f32x16r acc;
#pragma unroll
        for (int r = 0; r < 16; ++r) acc[r] = 0.f;
        float ss = 0.f;
#pragma unroll 4
        for (int q = 0; q < 32; ++q) { const f32x4 xv = xp[2 * q]; ss += (xv.x * xv.x + xv.y * xv.y) + (xv.z * xv.z + xv.w * xv.w);
#pragma unroll
            for (int j = 0; j < 4; ++j) acc = __builtin_amdgcn_mfma_f32_32x32x2f32(xv[j], bp[(8 * q + j) * 32], acc, 0, 0, 0); }
        __syncthreads();
        { LAS float* part = rw + (tile * 4 + wq) * 1024;
#pragma unroll
          for (int r = 0; r < 16; ++r) part[((r & 3) + 8 * (r >> 2) + 4 * h) * 32 + i32] = acc[r];
          rw[8192 + (tile * 4 + wq) * 64 + lane] = ss; }
        __syncthreads();
        if (F.tid < 64) { const int t = F.tid, tl = t >> 5, row = t & 31; const size_t m = (size_t)grp * 64 + t;
            float s = 0.f;
#pragma unroll
            for (int q = 0; q < 4; ++q) s += rw[8192 + (tl * 4 + q) * 64 + row] + rw[8192 + (tl * 4 + q) * 64 + 32 + row];
            const float rstd = 1.0f / sqrtf(s * (1.f / D_MODEL) + NORM_EPS);
            float lg[32];
#pragma unroll
            for (int e = 0; e < 32; ++e) { const LAS float* pp = rw + (tl * 4) * 1024 + row * 32 + e; lg[e] = ((pp[0] + pp[1024]) + (pp[2048] + pp[3072])) * rstd + RB[e]; }
            int ti[4]; float tv[4];
#pragma unroll
            for (int k = 0; k < 4; ++k) { float best = -INFINITY; int bi = 0;
#pragma unroll
                for (int e = 0; e < 32; ++e) { const bool taken = (k > 0 && ti[0] == e) || (k > 1 && ti[1] == e) || (k > 2 && ti[2] == e); if (!taken && lg[e] > best) { best = lg[e]; bi = e; } }
                ti[k] = bi; tv[k] = best; }
            const float e1 = __expf(tv[1] - tv[0]), e2 = __expf(tv[2] - tv[0]), e3 = __expf(tv[3] - tv[0]); const float inv = 1.0f / (1.0f + e1 + e2 + e3);
            { typedef int i32x4 __attribute__((ext_vector_type(4))); *(GAS i32x4*)(topi + m * 4) = (i32x4){ti[0], ti[1], ti[2], ti[3]}; } *(GAS f32x4*)(topg + m * 4) = (f32x4){inv, e1 * inv, e2 * inv, e3 * inv};
#pragma unroll
            for (int k = 0; k < 4; ++k) __hip_atomic_fetch_add(hist + ti[k], 1, __ATOMIC_RELAXED, __HIP_MEMORY_SCOPE_WORKGROUP); }
        __syncthreads();
    }
    { const int t_ = opq(F.tid); if (t_ < 32 && hist[t_] != 0) __hip_atomic_fetch_add((unsigned*)(F.ctl + CW_CNT) + 64 * t_, (unsigned)hist[t_], __ATOMIC_RELAXED, __HIP_MEMORY_SCOPE_AGENT); }
}
__device__ __forceinline__ void moe_table(Frame& F) {
    LAS int* tab = (LAS int*)(F.lds + MOETAB_OFF);
    __syncthreads();
    if (F.tid == 0) { int acc = 0;
        for (int e = 0; e < N_EXPERTS; ++e) { const int c = (int)__hip_atomic_load((unsigned*)(F.ctl + CW_CNT) + 64 * e, __ATOMIC_RELAXED, __HIP_MEMORY_SCOPE_AGENT); const int nb = (c + MOE_ROWS - 1) / MOE_ROWS;
            tab[320 + e] = acc * MOE_ROWS; for (int q = 0; q < nb; ++q) tab[1 + acc + q] = e; acc += nb; }
        tab[0] = acc; }
    __syncthreads();
}
__device__ __forceinline__ void p9_dispatch(Frame& F, const Args& args) {
    const int lane = F.lane;
    unsigned char* ws = F.ws;
    moe_table(F);
    const LAS int* tab = (const LAS int*)(F.lds + MOETAB_OFF);
    LAS int* hist = (LAS int*)(F.lds + HIST_OFF); LAS int* base = hist + 32; LAS int* slots = hist + 64;
    const int* topi = (const int*)(ws + WS_ROUTE + RT_TOPI); const float* topg = (const float*)(ws + WS_ROUTE + RT_TOPG);
    int* pos = (int*)(ws + WS_ROUTE + RT_POS); float* rowgate = (float*)(ws + WS_ROUTE + RT_ROWGATE);
    bf16* XS = (bf16*)(ws + WS_XS); const float* gain = ldarg(I_NORM_FFN);
    for (int grp = F.vcu; grp < MTOK / 64; grp += F.G) {
        const int t_ = opq(F.tid);
        if (t_ < 32) hist[t_] = 0;
        __syncthreads();
        int e = 0, rank = 0;
        if (F.tid < 256) { e = topi[(size_t)grp * 256 + F.tid]; rank = __hip_atomic_fetch_add(hist + e, 1, __ATOMIC_RELAXED, __HIP_MEMORY_SCOPE_WORKGROUP); }
        __syncthreads();
        if (F.tid < 32) { const int h = hist[F.tid]; int b0 = 0; if (h != 0) b0 = (int)__hip_atomic_fetch_add((unsigned*)(F.ctl + CW_CUR) + 64 * F.tid, (unsigned)h, __ATOMIC_RELAXED, __HIP_MEMORY_SCOPE_AGENT); base[F.tid] = tab[320 + F.tid] + b0; }
        __syncthreads();
        if (F.tid < 256) { const int slot = base[e] + rank; pos[(size_t)grp * 256 + F.tid] = slot; rowgate[slot] = topg[(size_t)grp * 256 + F.tid]; slots[F.tid] = slot; }
        __syncthreads();
        { f32x4 v[8][4];
#pragma unroll
          for (int i = 0; i < 8; ++i) { const GAS f32x4* xr = (const GAS f32x4*)(F.out + ((size_t)grp * 64 + F.wave * 8 + i) * D_MODEL) + 2 * lane;
#pragma unroll
              for (int j = 0; j < 4; ++j) v[i][j] = xr[128 * (j >> 1) + (j & 1)]; }
          const GAS f32x4* gr = (const GAS f32x4*)gain + 2 * lane; const f32x4 g00 = gr[0], g01 = gr[1], g10 = gr[128], g11 = gr[129];
#pragma unroll
          for (int i = 0; i < 8; ++i) { const int tl = F.wave * 8 + i;
              float s = 0.f;
#pragma unroll
              for (int j = 0; j < 4; ++j) s += (v[i][j].x * v[i][j].x + v[i][j].y * v[i][j].y) + (v[i][j].z * v[i][j].z + v[i][j].w * v[i][j].w);
              const float rstd = 1.0f / sqrtf(wave_sum(s) * (1.f / D_MODEL) + NORM_EPS);
              unsigned long long o[2];
              { const f32x4 a = v[i][0] * rstd * g00, b = v[i][1] * rstd * g01; o[0] = (unsigned long long)pk4_fp8(a.x, a.y, a.z, a.w) | ((unsigned long long)pk4_fp8(b.x, b.y, b.z, b.w) << 32); }
              { const f32x4 a = v[i][2] * rstd * g10, b = v[i][3] * rstd * g11; o[1] = (unsigned long long)pk4_fp8(a.x, a.y, a.z, a.w) | ((unsigned long long)pk4_fp8(b.x, b.y, b.z, b.w) << 32); }
#pragma unroll
              for (int k = 0; k < 4; ++k) { const int sk = slots[tl * 4 + k]; GAS unsigned long long* dst = (GAS unsigned long long*)((unsigned char*)XS + (size_t)sk * D_MODEL) + lane; dst[0] = o[0]; dst[64] = o[1]; } } }
        __syncthreads();
    }
}
__device__ __forceinline__ void p12_combine(Frame& F) {
    const int gw = F.vcu * NWAVES + F.wave, NGW = F.G * NWAVES, lane = F.lane;
    unsigned char* ws = F.ws;
    const int* pos = (const int*)(ws + WS_ROUTE + RT_POS); const bf16* YR = (const bf16*)(ws + WS_YROWS);
    for (int blk = gw; blk < MTOK / 8; blk += NGW) {
        const int m0 = blk * 8;
        int pk = 0; if (lane < 32) pk = pos[(size_t)m0 * 4 + lane];
#pragma unroll
        for (int tp = 0; tp < 4; ++tp) {
            f32x4 a[2][2], b[2][2]; v4u w[2][2][4];
#pragma unroll
            for (int u = 0; u < 2; ++u) { const int t = 2 * tp + u; GAS f32x4* xo = (GAS f32x4*)(F.out + (size_t)(m0 + t) * D_MODEL) + 2 * lane;
#pragma unroll
                for (int hf = 0; hf < 2; ++hf) { a[u][hf] = xo[128 * hf]; b[u][hf] = xo[128 * hf + 1];
#pragma unroll
                    for (int k = 0; k < 4; ++k) { const int sk = __builtin_amdgcn_readlane(pk, 4 * t + k); w[u][hf][k] = *((const GAS v4u*)(YR + (size_t)sk * D_MODEL + 512 * hf) + lane); } } }
#pragma unroll
            for (int u = 0; u < 2; ++u) { const int t = 2 * tp + u; GAS f32x4* xo = (GAS f32x4*)(F.out + (size_t)(m0 + t) * D_MODEL) + 2 * lane;
#pragma unroll
                for (int hf = 0; hf < 2; ++hf) { f32x4 aa = a[u][hf], bb = b[u][hf];
#pragma unroll
                    for (int k = 0; k < 4; ++k) { const v4u ww = w[u][hf][k];
                        aa[0] += bf_lo(ww.x); aa[1] += bf_hi(ww.x); aa[2] += bf_lo(ww.y); aa[3] += bf_hi(ww.y); bb[0] += bf_lo(ww.z); bb[1] += bf_hi(ww.z); bb[2] += bf_lo(ww.w); bb[3] += bf_hi(ww.w); }
                    xo[128 * hf] = aa; xo[128 * hf + 1] = bb; } }
        }
    }
}

constexpr int N_ATT_A = 768, N_ATT_C = 256;
__device__ __forceinline__ swa::BlockRef attn_item(unsigned char* ws, int it) {
    swa::BlockRef r;
    const swa::bf16* Z = (const swa::bf16*)(ws + WS_Z);
    if (it < N_ATT_A) {
        const int h = it & 3, b = (it >> 2) & 1, v = it >> 3;
        int g, rr, qb;
        if (v < 32) { g = 0; rr = 0; qb = v; } else if (v < 64) { g = 1; rr = (v - 32) >> 3; qb = (v - 32) & 7; } else { g = 2; rr = (v - 64) >> 1; qb = (v - 64) & 1; }
        const int d = (g == 0) ? 1 : (g == 1) ? 4 : 16;
        const size_t row0 = (size_t)b * SEQ + rr, qrow = row0 + (size_t)d * qb * 256;
        r.Q = Z + qrow * IN_COLS + OFF_AQ + g * 512 + h * 128; r.K = Z + row0 * IN_COLS + OFF_AK + g * 512 + h * 128; r.V = Z + row0 * IN_COLS + OFF_AV + g * 512 + h * 128;
        r.O = (swa::bf16*)(ws + WS_OP) + (size_t)g * MTOK * 512 + qrow * 512 + h * 128; r.LSE = (float*)(ws + WS_LSE) + (size_t)g * MTOK * 4 + qrow * 4 + h;
        r.QS = d * IN_COLS; r.KS = d * IN_COLS; r.OS = d * 512; r.LS = d * 4; r.P0 = qb * 256; r.skv = SEQ / d; r.W = 129;
    } else {
        const int u = it - N_ATT_A, h = u & 3, b = (u >> 2) & 1, qb = u >> 3;
        const size_t qrow = (size_t)b * SEQ + (size_t)qb * 256;
        const swa::bf16* KV = (const swa::bf16*)(ws + WS_KVM) + (size_t)b * MEM_LEN * 1024 + h * 128;
        r.Q = Z + qrow * IN_COLS + OFF_CQ + h * 128; r.K = KV; r.V = KV + 512;
        r.O = (swa::bf16*)(ws + WS_YABC) + qrow * 1536 + 1024 + h * 128; r.LSE = nullptr;
        r.QS = IN_COLS; r.KS = 1024; r.OS = 1536; r.LS = 0; r.P0 = 256; r.skv = MEM_LEN; r.W = 1 << 20;
    }
    return r;
}
__device__ __forceinline__ void p3_attention_mfma(unsigned char* ws, char* lds, int G) {
    const int total = N_ATT_A + N_ATT_C; int L = blockIdx.x; if (L >= total) return;
    swa::BlockRef cur = attn_item(ws, L); swa::Seam S;
    swa::swa_prime(cur, lds, S);
    for (;;) {
        const int Ln = L + G; const bool last = Ln >= total;
        const swa::BlockRef nxt = last ? cur : attn_item(ws, Ln);
        swa::swa_block(cur, nxt, lds, S);
        if (last) break;
        cur = nxt; L = Ln;
    }
}

constexpr int N_RITEMS = BATCH * 8 * (SEQ / 64);
constexpr size_t WS_PHI = WS_XN;
constexpr size_t WS_PSI = WS_XN + 16 * MiB;
constexpr size_t WS_GAM = WS_YS;
constexpr size_t WS_OM = WS_XN2;
constexpr size_t WS_XFR = WS_MRG + 48 * MiB;
constexpr size_t WS_BONUS = WS_MRGB + 1 * MiB;
constexpr int RB = 9216, RLD = 72;
constexpr int R1_SEG = 15 * RB, R1_WC = R1_SEG + 2048;
static_assert(R1_WC + 256 <= LDSCTL_OFF, "R1 LDS map");
typedef LAS unsigned short* lbf_t;
__device__ __forceinline__ f32x4 r1_tile(const LAS unsigned short* X, const LAS unsigned short* Yt, int mi, int ni, f32x4 acc, int fr, int fq) {
    const LAS unsigned short* xp = X + (16 * mi + fr) * RLD + 8 * fq; const LAS unsigned short* yp = Yt + (16 * ni + fr) * RLD + 8 * fq;
    const bf16x8 a0 = *(const LAS bf16x8*)xp, a1 = *(const LAS bf16x8*)(xp + 32), b0 = *(const LAS bf16x8*)yp, b1 = *(const LAS bf16x8*)(yp + 32);
    acc = __builtin_amdgcn_mfma_f32_16x16x32_bf16(b0, a0, acc, 0, 0, 0);
    acc = __builtin_amdgcn_mfma_f32_16x16x32_bf16(b1, a1, acc, 0, 0, 0);
    return acc;
}
__device__ __forceinline__ void r1_store(LAS unsigned short* dst, int mi, int ni, f32x4 acc, int mode, bool addI, const LAS unsigned short* addT, int fr, int fq) {
    const int m = 16 * mi + fr, n0 = 16 * ni + 4 * fq;
#pragma unroll
    for (int r = 0; r < 4; ++r) { const int n = n0 + r; bool keep = true;
        if (mode == 1) keep = n < m; else if (mode == 2) keep = n <= m; else if (mode == 3) keep = m < n;
        float v = keep ? acc[r] : 0.f; if (addI && m == n) v += 1.0f; acc[r] = v; }
    if (addT != nullptr) { const unsigned long long w = *(const LAS unsigned long long*)(addT + m * RLD + n0);
        acc[0] += bf_lo((unsigned)w); acc[1] += bf_hi((unsigned)w); acc[2] += bf_lo((unsigned)(w >> 32)); acc[3] += bf_hi((unsigned)(w >> 32)); }
    *(LAS unsigned long long*)(dst + m * RLD + n0) = (unsigned long long)pk2(acc[0], acc[1]) | ((unsigned long long)pk2(acc[2], acc[3]) << 32);
}
#define R1BUF(i) ((LAS unsigned short*)(F.lds + (i) * RB))
template <int MODE> __device__ __forceinline__ void p_r1(Frame& F, const Args& args) {
    unsigned char* ws = F.ws; const int lane0 = F.lane, wave = F.wave;
    const bf16* Z = (const bf16*)(ws + WS_Z);
    const float* rkp = ldarg(I_R_RK); const float* mu = ldarg(I_R_MU); const float* w0p = ldarg(I_R_W0); const float* a0p = ldarg(I_R_A0); const float* kkp = ldarg(I_R_KK); const float* kap = ldarg(I_R_KA);
    const float* w1src = ldarg(I_EXP_W1);
    const bf16* W2T = (const bf16*)(ws + WS_LORA); const bf16* A2T = W2T + 512 * 64; const bf16* G2T = A2T + 512 * 64;
    bf16* VM = (bf16*)(ws + WS_VMIX); bf16* GM = (bf16*)(ws + WS_GMIX);
    LAS float* segsum = (LAS float*)(F.lds + R1_SEG); LAS float* wcs = (LAS float*)(F.lds + R1_WC);
    unsigned short zv[7][9];
#define R1LOAD(it_) do { const int bh_ = (it_) >> 7, c_ = (it_) & 127, h_ = bh_ & 7, t0_ = c_ * 64 + 8 * wave; \
        const bf16* zp_ = Z + ((size_t)(bh_ >> 3) * SEQ + t0_) * IN_COLS + OFF_R + lane; \
        _Pragma("unroll") for (int i = 0; i < 9; ++i) { const bool ok_ = (i > 0) || (t0_ > 0); const bf16* rp_ = zp_ + ((long)i - 1) * IN_COLS; const bf16* rq_ = rp_ + 64 * h_;     \
            zv[0][i] = ok_ ? rp_[1536] : (unsigned short)0; zv[1][i] = ok_ ? rp_[1600] : (unsigned short)0; zv[2][i] = ok_ ? rp_[1664] : (unsigned short)0; zv[3][i] = ok_ ? rp_[1728] : (unsigned short)0; \
            zv[4][i] = ok_ ? rq_[0] : (unsigned short)0; zv[5][i] = ok_ ? rq_[512] : (unsigned short)0; zv[6][i] = ok_ ? rq_[1024] : (unsigned short)0; } } while (0)
#define ZF(x) __builtin_bit_cast(float, (unsigned)(x) << 16)
    { const int lane = lane0; if (F.vcu < N_RITEMS) R1LOAD(F.vcu); }
    for (int item = F.vcu; item < N_RITEMS; item += F.G) {
        const int lane = opq(lane0), fr = lane & 15, fq = lane >> 4;
        const int bh = item >> 7, c = item & 127, b = bh >> 3, h = bh & 7;
        const size_t row0 = (size_t)b * SEQ + (size_t)c * 64;
        f32x4 tcv[16]; const float* tcW; unsigned char* tcWT; int tck0, tcn0, tcrb;
        w1_tile(item * 8 + wave, w1src, ws + WS_W1, tcW, tcWT, tck0, tcn0, tcrb); tc8_load(tcW, 2048, tck0, tcn0, lane, tcv);
        const f32x4 zero4 = (f32x4){0.f, 0.f, 0.f, 0.f};
        const int mw = wave >> 2, nw = wave & 3;
        float r[8], lw[8], kx[8], vx[8], ax[8], bx[8];
        { const int k = lane, tq = wave, ch = h * 64 + k;
#pragma unroll
          for (int g = 0; g < 4; ++g) { const float mug = mu[1536 + 64 * g + k];
#pragma unroll
              for (int i = 0; i < 8; ++i) { const float cur = ZF(zv[g][i + 1]), prv = ZF(zv[g][i]); float x = cur + (prv - cur) * mug;
                  x = (g == 0) ? fast_tanh(x) : (g == 1) ? x : fast_sigm(x); const unsigned short xb = (unsigned short)f2bf(x); const int t = 8 * tq + i;
                  if (g == 0) R1BUF(11)[t * RLD + k] = xb; else if (g == 1) R1BUF(12)[t * RLD + k] = xb; else R1BUF(13)[t * 136 + 64 * (g - 2) + k] = xb; } }
          { const int tid_ = wave * 64 + lane, row = tid_ >> 3, chk = tid_ & 7;
            *(LAS v4u*)(R1BUF(5) + row * RLD + chk * 8) = *(const GAS v4u*)(W2T + (size_t)(64 * h + row) * 64 + chk * 8);
            *(LAS v4u*)(R1BUF(6) + row * RLD + chk * 8) = *(const GAS v4u*)(A2T + (size_t)(64 * h + row) * 64 + chk * 8);
#pragma unroll
            for (int hh = 0; hh < 2; ++hh) { const int rg = (tid_ >> 4) + 32 * hh, cg = tid_ & 15;
                *(LAS v4u*)(R1BUF(7) + rg * 136 + cg * 8) = *(const GAS v4u*)(G2T + (size_t)(64 * h + rg) * 128 + cg * 8); } }
          __syncthreads();
          { f32x4 dw0, dw1, da0, da1, dg0 = zero4, dg1 = zero4;
            { const LAS unsigned short* yp_ = R1BUF(5) + (16 * nw + fr) * RLD + 8 * fq; const LAS unsigned short* xp_ = R1BUF(11) + (16 * mw + fr) * RLD + 8 * fq;
              const bf16x8 y0_ = *(const LAS bf16x8*)yp_, y1_ = *(const LAS bf16x8*)(yp_ + 32), xa0_ = *(const LAS bf16x8*)xp_, xa1_ = *(const LAS bf16x8*)(xp_ + 32), xb0_ = *(const LAS bf16x8*)(xp_ + 32 * RLD), xb1_ = *(const LAS bf16x8*)(xp_ + 32 * RLD + 32);
              dw0 = __builtin_amdgcn_mfma_f32_16x16x32_bf16(y0_, xa0_, zero4, 0, 0, 0); dw1 = __builtin_amdgcn_mfma_f32_16x16x32_bf16(y0_, xb0_, zero4, 0, 0, 0);
              dw0 = __builtin_amdgcn_mfma_f32_16x16x32_bf16(y1_, xa1_, dw0, 0, 0, 0); dw1 = __builtin_amdgcn_mfma_f32_16x16x32_bf16(y1_, xb1_, dw1, 0, 0, 0); }
            { const LAS unsigned short* yp_ = R1BUF(6) + (16 * nw + fr) * RLD + 8 * fq; const LAS unsigned short* xp_ = R1BUF(12) + (16 * mw + fr) * RLD + 8 * fq;
              const bf16x8 y0_ = *(const LAS bf16x8*)yp_, y1_ = *(const LAS bf16x8*)(yp_ + 32), xa0_ = *(const LAS bf16x8*)xp_, xa1_ = *(const LAS bf16x8*)(xp_ + 32), xb0_ = *(const LAS bf16x8*)(xp_ + 32 * RLD), xb1_ = *(const LAS bf16x8*)(xp_ + 32 * RLD + 32);
              da0 = __builtin_amdgcn_mfma_f32_16x16x32_bf16(y0_, xa0_, zero4, 0, 0, 0); da1 = __builtin_amdgcn_mfma_f32_16x16x32_bf16(y0_, xb0_, zero4, 0, 0, 0);
              da0 = __builtin_amdgcn_mfma_f32_16x16x32_bf16(y1_, xa1_, da0, 0, 0, 0); da1 = __builtin_amdgcn_mfma_f32_16x16x32_bf16(y1_, xb1_, da1, 0, 0, 0); }
            { const LAS unsigned short* yp_ = R1BUF(7) + (16 * nw + fr) * 136 + 8 * fq; const LAS unsigned short* xp_ = R1BUF(13) + (16 * mw + fr) * 136 + 8 * fq;
#pragma unroll
              for (int kk = 0; kk < 4; ++kk) { const bf16x8 y_ = *(const LAS bf16x8*)(yp_ + 32 * kk), xa_ = *(const LAS bf16x8*)(xp_ + 32 * kk), xb_ = *(const LAS bf16x8*)(xp_ + 32 * 136 + 32 * kk);
                  dg0 = __builtin_amdgcn_mfma_f32_16x16x32_bf16(y_, xa_, dg0, 0, 0, 0); dg1 = __builtin_amdgcn_mfma_f32_16x16x32_bf16(y_, xb_, dg1, 0, 0, 0); } }
            const int o0 = (16 * mw + fr) * 68 + 16 * nw + 4 * fq, o1 = o0 + 32 * 68;
            *(LAS f32x4*)((LAS float*)R1BUF(0) + o0) = dw0; *(LAS f32x4*)((LAS float*)R1BUF(0) + o1) = dw1;
            *(LAS f32x4*)((LAS float*)R1BUF(2) + o0) = da0; *(LAS f32x4*)((LAS float*)R1BUF(2) + o1) = da1;
            *(LAS f32x4*)((LAS float*)R1BUF(9) + o0) = dg0; *(LAS f32x4*)((LAS float*)R1BUF(9) + o1) = dg1; }
          __syncthreads();
          { const float w0c = w0p[ch], a0c = a0p[ch], kkc = kkp[ch], kac = kap[ch], mur = mu[ch], muk = mu[512 + ch], muv = mu[1024 + ch];
#pragma unroll
            for (int i = 0; i < 8; ++i) { const int t = 8 * tq + i;
                const float dwv = ((const LAS float*)R1BUF(0))[t * 68 + k], dav = ((const LAS float*)R1BUF(2))[t * 68 + k], dgv = ((const LAS float*)R1BUF(9))[t * 68 + k];
                const float cr = ZF(zv[4][i + 1]), pr = ZF(zv[4][i]), ck = ZF(zv[5][i + 1]), pk = ZF(zv[5][i]), cv = ZF(zv[6][i + 1]), pv = ZF(zv[6][i]);
                const float rr = cr + (pr - cr) * mur, kr = ck + (pk - ck) * muk, vr = cv + (pv - cv) * muv;
                const float y = -(w0c + dwv); const float sp = fast_softplus(y);
                lw[i] = -__expf(-sp - 0.5f);
                const float av = fast_sigm(a0c + dav);
                const float kkv = kr * kkc; const float ssq = wave_sum(kkv * kkv); const float kkn = kkv * __builtin_amdgcn_rsqf(fmaxf(ssq, 1e-24f));
                r[i] = rr; vx[i] = vr; kx[i] = kr * (1.0f + (av - 1.0f) * kac); ax[i] = -kkn; bx[i] = kkn * av;
                if (MODE == 0) { VM[(row0 + t) * RW + ch] = (bf16)f2bf(vr); GM[(row0 + t) * RW + ch] = (bf16)f2bf(dgv); } } }
        }
        if (item + F.G < N_RITEMS) R1LOAD(item + F.G);
        { const int k = lane, tq = wave;
          float cs[8]; cs[0] = lw[0];
#pragma unroll
          for (int i = 1; i < 8; ++i) cs[i] = cs[i - 1] + lw[i];
          segsum[tq * 64 + k] = cs[7];
          const float rk = rkp[h * 64 + k];
#pragma unroll
          for (int i = 0; i < 8; ++i) { const float bs = wave_sum(r[i] * kx[i] * rk); if (MODE == 0 && lane == 0) *(GAS float*)((float*)(ws + WS_BONUS) + (row0 + 8 * tq + i) * 8 + h) = bs; }
          __syncthreads();
          float pre = 0.f;
#pragma unroll
          for (int q = 0; q < 7; ++q) { const float sv = segsum[q * 64 + k]; pre += (q < tq) ? sv : 0.f; }
          unsigned short at[8], rt[8], bt[8], kt[8], vt[8];
#pragma unroll
          for (int i = 0; i < 8; ++i) { const float L = pre + cs[i], Lp = L - lw[i]; const float e = __expf(L), ep = __expf(Lp), ei = __expf(-L);
              at[i] = (unsigned short)f2bf(ax[i] * ep); rt[i] = (unsigned short)f2bf(r[i] * e); bt[i] = (unsigned short)f2bf(bx[i] * ei); kt[i] = (unsigned short)f2bf(kx[i] * ei); vt[i] = (unsigned short)f2bf(vx[i]);
              if (i == 7 && tq == 7) wcs[k] = e; }
#pragma unroll
          for (int i = 0; i < 8; ++i) { const int o = (8 * tq + i) * RLD + k; R1BUF(8)[o] = at[i]; R1BUF(4)[o] = rt[i]; R1BUF(9)[o] = bt[i]; R1BUF(10)[o] = kt[i]; }
          const int ot = k * RLD + 8 * tq;
#define PK8(x) ((v4u){(unsigned)x[0] | ((unsigned)x[1] << 16), (unsigned)x[2] | ((unsigned)x[3] << 16), (unsigned)x[4] | ((unsigned)x[5] << 16), (unsigned)x[6] | ((unsigned)x[7] << 16)})
          *(LAS v4u*)(R1BUF(0) + ot) = PK8(at); *(LAS v4u*)(R1BUF(1) + ot) = PK8(bt); *(LAS v4u*)(R1BUF(2) + ot) = PK8(kt); *(LAS v4u*)(R1BUF(3) + ot) = PK8(vt);
#undef PK8
        }
        __syncthreads();
#define R1PAIR(X, Y, a0, a1) do { const LAS unsigned short* yp_ = (Y) + (16 * nw + fr) * RLD + 8 * fq; const LAS unsigned short* xp_ = (X) + (16 * mw + fr) * RLD + 8 * fq; \
            const bf16x8 y0_ = *(const LAS bf16x8*)yp_, y1_ = *(const LAS bf16x8*)(yp_ + 32), xa0_ = *(const LAS bf16x8*)xp_, xa1_ = *(const LAS bf16x8*)(xp_ + 32), xb0_ = *(const LAS bf16x8*)(xp_ + 32 * RLD), xb1_ = *(const LAS bf16x8*)(xp_ + 32 * RLD + 32); \
            a0 = __builtin_amdgcn_mfma_f32_16x16x32_bf16(y0_, xa0_, zero4, 0, 0, 0); a1 = __builtin_amdgcn_mfma_f32_16x16x32_bf16(y0_, xb0_, zero4, 0, 0, 0); \
            a0 = __builtin_amdgcn_mfma_f32_16x16x32_bf16(y1_, xa1_, a0, 0, 0, 0); a1 = __builtin_amdgcn_mfma_f32_16x16x32_bf16(y1_, xb1_, a1, 0, 0, 0); } while (0)
#define R1ST2(dst, a0, a1, mode, addI, addT) do { r1_store(dst, mw, nw, a0, mode, addI, addT, fr, fq); r1_store(dst, mw + 2, nw, a1, mode, addI, addT, fr, fq); } while (0)
        { f32x4 n0, n1, t0, t1, l0, l1, b0, b1, k0, k1;
          R1PAIR(R1BUF(8), R1BUF(9), n0, n1); R1PAIR(R1BUF(9), R1BUF(8), t0, t1); R1PAIR(R1BUF(8), R1BUF(10), l0, l1); R1PAIR(R1BUF(4), R1BUF(9), b0, b1); R1PAIR(R1BUF(4), R1BUF(10), k0, k1);
          R1ST2(R1BUF(11), n0, n1, 1, false, nullptr); R1ST2(R1BUF(13), n0, n1, 1, true, nullptr); R1ST2(R1BUF(12), t0, t1, 3, false, nullptr);
          R1ST2(R1BUF(5), l0, l1, 1, false, nullptr); R1ST2(R1BUF(6), b0, b1, 2, false, nullptr); R1ST2(R1BUF(7), k0, k1, 2, false, nullptr); }
        __syncthreads();
        { f32x4 n0, n1, t0, t1, e0, e1;
          R1PAIR(R1BUF(11), R1BUF(12), n0, n1); R1PAIR(R1BUF(12), R1BUF(11), t0, t1); R1PAIR(R1BUF(3), R1BUF(5), e0, e1);
          R1ST2(R1BUF(8), n0, n1, 0, false, nullptr); R1ST2(R1BUF(9), t0, t1, 0, false, nullptr); R1ST2(R1BUF(10), e0, e1, 0, false, nullptr); }
        __syncthreads();
#pragma unroll 1
        for (int lv = 0; lv < 5; ++lv) {
            const bool srcB = (lv & 1) == 0;
            LAS unsigned short* sN = srcB ? R1BUF(8) : R1BUF(11); LAS unsigned short* sNT = srcB ? R1BUF(9) : R1BUF(12);
            LAS unsigned short* dN = srcB ? R1BUF(11) : R1BUF(8); LAS unsigned short* dNT = srcB ? R1BUF(12) : R1BUF(9);
            LAS unsigned short* Tc = (lv & 1) ? R1BUF(14) : R1BUF(13); LAS unsigned short* Tn = (lv & 1) ? R1BUF(13) : R1BUF(14);
            f32x4 u0, u1, t0 = zero4, t1 = zero4, n0 = zero4, n1 = zero4;
            R1PAIR(Tc, sNT, u0, u1);
            if (lv < 4) R1PAIR(sNT, sN, t0, t1);
            if (lv < 3) R1PAIR(sN, sNT, n0, n1);
            R1ST2(Tn, u0, u1, 0, false, Tc);
            if (lv < 4) R1ST2(dNT, t0, t1, 0, false, nullptr);
            if (lv < 3) R1ST2(dN, n0, n1, 0, false, nullptr);
            __syncthreads();
        }
        { f32x4 g0, g1, q0, q1;
          R1PAIR(R1BUF(0), R1BUF(14), g0, g1); R1PAIR(R1BUF(10), R1BUF(14), q0, q1);
          R1ST2(R1BUF(11), g0, g1, 0, false, nullptr); R1ST2(R1BUF(12), q0, q1, 0, false, nullptr); }
        __syncthreads();
#undef R1PAIR
#undef R1ST2
        { const int mi = wave >> 1, ks = wave & 1;
          const f32x4 p0 = r1_tile(R1BUF(1), R1BUF(11), mi, 2 * ks, zero4, fr, fq), p1 = r1_tile(R1BUF(1), R1BUF(11), mi, 2 * ks + 1, zero4, fr, fq);
          const f32x4 s0 = r1_tile(R1BUF(6), R1BUF(11), mi, 2 * ks, zero4, fr, fq), s1 = r1_tile(R1BUF(6), R1BUF(11), mi, 2 * ks + 1, zero4, fr, fq);
          const int m = 16 * mi + fr; const float wc = wcs[m];
          float ph[8], ps[8];
#pragma unroll
          for (int r = 0; r < 4; ++r) { const int n0 = 32 * ks + 4 * fq + r, n1 = n0 + 16;
              ph[r] = (p0[r] + (m == n0 ? 1.f : 0.f)) * wc; ph[4 + r] = (p1[r] + (m == n1 ? 1.f : 0.f)) * wc; }
          { const unsigned long long w0 = *(const LAS unsigned long long*)(R1BUF(4) + m * RLD + 32 * ks + 4 * fq), w1 = *(const LAS unsigned long long*)(R1BUF(4) + m * RLD + 32 * ks + 16 + 4 * fq);
            ps[0] = s0[0] + bf_lo((unsigned)w0); ps[1] = s0[1] + bf_hi((unsigned)w0); ps[2] = s0[2] + bf_lo((unsigned)(w0 >> 32)); ps[3] = s0[3] + bf_hi((unsigned)(w0 >> 32));
            ps[4] = s1[0] + bf_lo((unsigned)w1); ps[5] = s1[1] + bf_hi((unsigned)w1); ps[6] = s1[2] + bf_lo((unsigned)(w1 >> 32)); ps[7] = s1[3] + bf_hi((unsigned)(w1 >> 32)); }
          const size_t fo = (((size_t)item * 4 + mi) * 2 + ks) * 64 + lane;
          if (MODE == 0) *((GAS v4u*)(ws + WS_PHI) + fo) = (v4u){pk2(ph[0], ph[1]), pk2(ph[2], ph[3]), pk2(ph[4], ph[5]), pk2(ph[6], ph[7])};
          if (MODE == 0) *((GAS v4u*)(ws + WS_PSI) + fo) = (v4u){pk2(ps[0], ps[1]), pk2(ps[2], ps[3]), pk2(ps[4], ps[5]), pk2(ps[6], ps[7])};
          const int vb = wave >> 1;
#pragma unroll
          for (int hh = 0; hh < 2; ++hh) { const int mt = 2 * (wave & 1) + hh;
              f32x4 ga = r1_tile(R1BUF(12), R1BUF(1), vb, mt, zero4, fr, fq); ga = r1_tile(R1BUF(3), R1BUF(2), vb, mt, ga, fr, fq);
              f32x4 om = r1_tile(R1BUF(12), R1BUF(6), vb, mt, zero4, fr, fq); om = r1_tile(R1BUF(3), R1BUF(7), vb, mt, om, fr, fq);
#pragma unroll
              for (int r = 0; r < 4; ++r) ga[r] *= wcs[16 * mt + 4 * fq + r];
              const size_t ao = (((size_t)item * 4 + vb) * 4 + mt) * 64 + lane;
              if (MODE == 0) { *((GAS f32x4*)(ws + WS_GAM) + ao) = ga; *((GAS f32x4*)(ws + WS_OM) + ao) = om; } else { asm volatile("" :: "v"(ga), "v"(om)); } }
        }
        tc8_store(tcWT, 1024, tck0, tcrb, lane, tcv, W8_SCALE);
        __syncthreads();
    }
}
#undef R1BUF
#undef R1LOAD
#undef ZF
struct R2Buf { bf16x8 ph[4][2]; f32x4 ga[4]; };
__device__ __forceinline__ void r2_load(R2Buf& B, const unsigned char* ws, int item, int vb, int lane) {
#pragma unroll
    for (int mt = 0; mt < 4; ++mt) {
#pragma unroll
        for (int ks = 0; ks < 2; ++ks) B.ph[mt][ks] = *((const GAS bf16x8*)(ws + WS_PHI) + (((size_t)item * 4 + mt) * 2 + ks) * 64 + lane);
        B.ga[mt] = *((const GAS f32x4*)(ws + WS_GAM) + (((size_t)item * 4 + vb) * 4 + mt) * 64 + lane); }
}
__device__ __forceinline__ void r2_step(const R2Buf& B, f32x4 (&acc)[4], unsigned char* ws, int item, int vb, int lane) {
    v4u x0, x1;
    x0.x = pk2(acc[0][0], acc[0][1]); x0.y = pk2(acc[0][2], acc[0][3]); x0.z = pk2(acc[1][0], acc[1][1]); x0.w = pk2(acc[1][2], acc[1][3]);
    x1.x = pk2(acc[2][0], acc[2][1]); x1.y = pk2(acc[2][2], acc[2][3]); x1.z = pk2(acc[3][0], acc[3][1]); x1.w = pk2(acc[3][2], acc[3][3]);
    GAS v4u* xo = (GAS v4u*)(ws + WS_XFR) + (((size_t)item * 4 + vb) * 2) * 64 + lane; xo[0] = x0; xo[64] = x1;
    const bf16x8 f0 = __builtin_bit_cast(bf16x8, x0), f1 = __builtin_bit_cast(bf16x8, x1);
#pragma unroll
    for (int mt = 0; mt < 4; ++mt) { f32x4 a = B.ga[mt];
        a = __builtin_amdgcn_mfma_f32_16x16x32_bf16(B.ph[mt][0], f0, a, 0, 0, 0);
        a = __builtin_amdgcn_mfma_f32_16x16x32_bf16(B.ph[mt][1], f1, a, 0, 0, 0);
        acc[mt] = a; }
}
__device__ __forceinline__ void p_r2(Frame& F) {
    if (blockIdx.x < BATCH * 8 * 4 && F.wave == 0) {
        unsigned char* ws = F.ws; const int bh = blockIdx.x >> 2, vb = blockIdx.x & 3, lane = F.lane;
        f32x4 acc[4];
#pragma unroll
        for (int i = 0; i < 4; ++i) acc[i] = (f32x4){0.f, 0.f, 0.f, 0.f};
        R2Buf A, B, C, D;
        const int it0 = bh * 128;
        r2_load(A, ws, it0, vb, lane); r2_load(B, ws, it0 + 1, vb, lane); r2_load(C, ws, it0 + 2, vb, lane);
#define R2SB() __builtin_amdgcn_sched_barrier(0)
#pragma unroll
        for (int c = 0; c < 128; c += 4) {
            r2_load(D, ws, it0 + c + 3, vb, lane); R2SB(); r2_step(A, acc, ws, it0 + c, vb, lane); R2SB();
            r2_load(A, ws, it0 + (c + 4 < 128 ? c + 4 : 127), vb, lane); R2SB(); r2_step(B, acc, ws, it0 + c + 1, vb, lane); R2SB();
            r2_load(B, ws, it0 + (c + 5 < 128 ? c + 5 : 127), vb, lane); R2SB(); r2_step(C, acc, ws, it0 + c + 2, vb, lane); R2SB();
            r2_load(C, ws, it0 + (c + 6 < 128 ? c + 6 : 127), vb, lane); R2SB(); r2_step(D, acc, ws, it0 + c + 3, vb, lane); R2SB();
        }
#undef R2SB
    }
}
__device__ __forceinline__ void p_r3(Frame& F, const Args& args) {
    const int gw = F.vcu * NWAVES + F.wave, NGW = F.G * NWAVES, lane = F.lane, cc = lane & 15, q = lane >> 4;
    unsigned char* ws = F.ws;
    const bf16* VM = (const bf16*)(ws + WS_VMIX); const bf16* GM = (const bf16*)(ws + WS_GMIX);
    const float* bonus = (const float*)(ws + WS_BONUS);
    bf16* YB = (bf16*)(ws + WS_YABC) + 512;
    const float* lnw = ldarg(I_R_LNW); const float* lnb = ldarg(I_R_LNB);
#pragma unroll 2
    for (int wi = gw; wi < N_RITEMS * 4; wi += NGW) {
        const int item = wi >> 2, tt = wi & 3, bh = item >> 7, c = item & 127, b = bh >> 3, h = bh & 7;
        const bf16x8 ps0 = *((const GAS bf16x8*)(ws + WS_PSI) + (((size_t)item * 4 + tt) * 2 + 0) * 64 + lane), ps1 = *((const GAS bf16x8*)(ws + WS_PSI) + (((size_t)item * 4 + tt) * 2 + 1) * 64 + lane);
        f32x4 acc[4];
#pragma unroll
        for (int vb = 0; vb < 4; ++vb) {
            const bf16x8 x0 = *((const GAS bf16x8*)(ws + WS_XFR) + (((size_t)item * 4 + vb) * 2 + 0) * 64 + lane), x1 = *((const GAS bf16x8*)(ws + WS_XFR) + (((size_t)item * 4 + vb) * 2 + 1) * 64 + lane);
            f32x4 a = *((const GAS f32x4*)(ws + WS_OM) + (((size_t)item * 4 + vb) * 4 + tt) * 64 + lane);
            a = __builtin_amdgcn_mfma_f32_16x16x32_bf16(ps0, x0, a, 0, 0, 0);
            a = __builtin_amdgcn_mfma_f32_16x16x32_bf16(ps1, x1, a, 0, 0, 0);
            acc[vb] = a; }
        const size_t rowb = (size_t)b * SEQ + (size_t)c * 64 + 16 * tt + 4 * q;
#pragma unroll
        for (int r = 0; r < 4; ++r) { const size_t t = rowb + r;
            const float s = (acc[0][r] + acc[1][r]) + (acc[2][r] + acc[3][r]);
            const float mean = row16_sum(s) * (1.f / 64.f);
            const float d0 = acc[0][r] - mean, d1 = acc[1][r] - mean, d2 = acc[2][r] - mean, d3 = acc[3][r] - mean;
            const float var = row16_sum((d0 * d0 + d1 * d1) + (d2 * d2 + d3 * d3)) * (1.f / 64.f);
            const float rstd = 1.0f / sqrtf(var + R_GN_EPS);
            const float bn = bonus[t * 8 + h];
#pragma unroll
            for (int vb = 0; vb < 4; ++vb) { const int ch = h * 64 + 16 * vb + cc; const float d = (vb == 0) ? d0 : (vb == 1) ? d1 : (vb == 2) ? d2 : d3;
                const float yn = d * rstd * lnw[ch] + lnb[ch];
                const float vv = __builtin_bit_cast(float, (unsigned)VM[t * RW + ch] << 16), gg = __builtin_bit_cast(float, (unsigned)GM[t * RW + ch] << 16);
                YB[t * 1536 + ch] = (bf16)f2bf((yn + bn * vv) * gg); } }
    }
}

__global__ void __launch_bounds__(NWAVES * 64, 2) skel_fwd(Args args) {
    extern __shared__ __attribute__((aligned(16))) unsigned char lds[];
    Frame F;
    F.lds = (LAS unsigned char*)lds;
    F.MISC = (volatile LAS unsigned*)(F.lds + MISC_OFF);
    phase_enter(F, true);
    F.G = gridDim.x; { const int bx = blockIdx.x; F.vcu = (F.G % 8 == 0) ? (bx % 8) * (F.G / 8) + bx / 8 : bx; }
    unsigned char* ws = args.ws; F.ws = ws; F.out = args.out;
    F.ctl = (gu32*)(ws + WS_CTL);
    for (int u = F.tid; u < (LDS_BYTES - LDSCTL_OFF) / 4; u += NWAVES * 64) ((LAS unsigned*)(F.lds + LDSCTL_OFF))[u] = 0u;
    __syncthreads();
    XcdBarrier bar; bar.bar = (unsigned*)(F.ctl + CW_BAR); bar.x = 0; bar.st = nullptr;
    if (args.use_bar) bar = xcd_barrier_post((unsigned*)(F.ctl + CW_BAR), F.MISC + 8);
    const int lo = args.ph_lo, hi = args.ph_hi;
#define IN(k) (phase_enter(F, lo <= (k) && (k) < hi))
#define SEAM(k) do { if (lo <= (k) && (k) + 1 < hi) xcd_barrier(bar); } while (0)
    const pg8::bf16_t* wsb = (const pg8::bf16_t*)ws;
#define BF(off) ((pg8::bf16_t*)(ws + (off)))

    if (IN(0)) { p0_prologue<0>(F, args, F.vcu * NWAVES + F.wave, F.G * NWAVES); if (F.G <= 64) p0_prologue<1>(F, args, F.vcu * NWAVES + F.wave, F.G * NWAVES); } SEAM(0);
    if (IN(1)) {
        const float* ckg_ = ldarg(I_CK_GAIN);
        pg8::EpiZ E{BF(WS_Z), ldarg(I_B_GATE), ldarg(I_AQ_GAIN), ldarg(I_AK_GAIN), ldarg(I_CQ_GAIN), (const float*)(ws + WS_CS), BF(WS_KVM), ckg_, (PG8_LAS float*)(F.lds + 131072)};
        { pg8::Gemm g{BF(WS_XN), BF(WS_WIN), MTOK + MEMROWS, IN_COLS + 1024, 1024}; pg8::ZOrder<0> S; S.init(F.G, (int)blockIdx.x);
          pg8::gemm_phase<pg8::EpiZ, pg8::ZOrder<0>, true, true>(F.lds + RING_OFF, g, S, E); }
        { pg8::Gemm g{BF(WS_XN8), BF(WS_WIN8), MTOK, IN_COLS, 1024, SC_ONE, SC_W8}; pg8::ZOrder<1> S; S.init(F.G, (int)blockIdx.x);
          pg8::gemm_phase<pg8::EpiZ, pg8::ZOrder<1>, true, true, true>(F.lds + RING_OFF, g, S, E); }
    } SEAM(1);
#if NAIVE_ATTN
    if (IN(3)) { p3_attention(F); } SEAM(3);
#else
    if (IN(3)) { p3_attention_mfma(ws, (char*)lds + RING_OFF, F.G); __syncthreads(); phase_enter(F, true); p_r1<0>(F, args); } SEAM(3);
#endif
    if (IN(4)) { p_r2(F); if (F.G > 64 && blockIdx.x >= 64) p0_prologue<1>(F, args, ((int)blockIdx.x - 64) * NWAVES + F.wave, (F.G - 64) * NWAVES); } SEAM(4);
    if (IN(5)) { p_r3(F, args); p5_post(F, args); } SEAM(5);
    if (IN(6)) {
        pg8::Gemm g{BF(WS_YABC), BF(WS_WB), MTOK, 1024, 1536}; pg8::StaticOrder S; S.init(MTOK, 1024, F.G, (int)blockIdx.x);
        pg8::EpiGate3 E{BF(WS_Z), BF(WS_MRGB)};
        pg8::gemm_phase<pg8::EpiGate3, pg8::StaticOrder, true, true>(F.lds + RING_OFF, g, S, E);
    } SEAM(6);
    if (IN(7)) {
        pg8::Gemm g{BF(WS_MRGB), BF(WS_WO), MTOK, 1024, 1024}; pg8::StaticOrder S; S.init(MTOK, 1024, F.G, (int)blockIdx.x);
        pg8::EpiResF32 E{ldarg(I_X), F.out, 1024};
        pg8::gemm_phase<pg8::EpiResF32, pg8::StaticOrder, true, true>(F.lds + RING_OFF, g, S, E);
    } SEAM(7);
    if (IN(8)) { p8_router(F, args); } SEAM(8);
    if (IN(9)) { p9_dispatch(F, args); } SEAM(9);
    if (IN(10)) {
        moe_table(F);
        pg8::Gemm g{BF(WS_XS), BF(WS_W1), 0, 0, 1024, SC_ONE, SC_W8}; pg8::MoeOrder S{(const PG8_LAS int*)(F.lds + MOETAB_OFF), 8, F.G, (int)blockIdx.x};
        pg8::EpiSwiGLU E{ldarg(I_EXP_B1), BF(WS_HACT)};
        pg8::gemm_phase<pg8::EpiSwiGLU, pg8::MoeOrder, true, true, true>(F.lds + RING_OFF, g, S, E);
    } SEAM(10);
    if (IN(11)) {
        moe_table(F);
        pg8::Gemm g{BF(WS_HACT), BF(WS_W2), 0, 0, 1024, SC_H8, SC_W8}; pg8::MoeOrder S{(const PG8_LAS int*)(F.lds + MOETAB_OFF), 4, F.G, (int)blockIdx.x};
        pg8::EpiMoeOut E{ldarg(I_EXP_B2), (const float*)(ws + WS_ROUTE + RT_ROWGATE), BF(WS_YROWS)};
        pg8::gemm_phase<pg8::EpiMoeOut, pg8::MoeOrder, true, true, true>(F.lds + RING_OFF, g, S, E);
    } SEAM(11);
    if (IN(12)) { p12_combine(F); }
#undef IN
#undef SEAM
#undef BF
    (void)wsb;
}

extern "C" void kernel_launch(void* const* d_in, const int* in_sizes, int n_in, void* d_out, int out_size, void* d_ws, size_t ws_size, hipStream_t stream) {
    static int grid = 0;
    if (grid == 0) {
        if (n_in != 32 || out_size != MTOK * D_MODEL || ws_size < WS_END) { fprintf(stderr, "kernel_launch: unexpected problem (n_in %d, out %d, ws %zu); nothing launched\n", n_in, out_size, ws_size); grid = -1; return; }
        int dev = 0, cus = 0;
        if (hipGetDevice(&dev) != hipSuccess || hipDeviceGetAttribute(&cus, hipDeviceAttributeMultiprocessorCount, dev) != hipSuccess) { grid = -1; return; }
        if (hipFuncSetAttribute((const void*)skel_fwd, hipFuncAttributeMaxDynamicSharedMemorySize, LDS_BYTES) != hipSuccess) { fprintf(stderr, "kernel_launch: hipFuncSetAttribute failed\n"); grid = -1; return; }
        (void)hipGetLastError();
        grid = cus;
    }
    if (grid < 0) return;
    (void)hipMemsetAsync((char*)d_ws + WS_CTL, 0, CTL_ZERO_BYTES, stream);
    Args a{};
    for (int i = 0; i < 32; ++i) a.in[i] = (const float*)d_in[i];
    a.out = (float*)d_out; a.ws = (unsigned char*)d_ws;
#if MK_N_LAUNCHES == 1
    a.ph_lo = 0; a.ph_hi = N_PHASES; a.use_bar = 1;
    hipLaunchKernelGGL(skel_fwd, dim3(grid), dim3(NWAVES * 64), LDS_BYTES, stream, a);
#else
    for (int p = 0; p < N_PHASES; ++p) { a.ph_lo = p; a.ph_hi = p + 1; a.use_bar = 0;
        hipLaunchKernelGGL(skel_fwd, dim3(grid), dim3(NWAVES * 64), LDS_BYTES, stream, a); }
#endif
}
```

```cpp
#include <hip/hip_runtime.h>
#include <cstdio>
#include <cstdint>
#include <cmath>
namespace pg8 {
#define PG8_LAS __attribute__((address_space(3)))
typedef unsigned short bf16_t;
typedef short bf16x8 __attribute__((ext_vector_type(8)));
typedef float f32x4 __attribute__((ext_vector_type(4)));
typedef unsigned u32x4 __attribute__((ext_vector_type(4)));
constexpr int BM = 256, BK = 64, HALF = 128, HTB = HALF * BK * 2  , STAGE_BYTES = 8 * HTB, NXCD = 8, WGM = 8;

__host__ __device__ __forceinline__ int lds_byte(int r, int c) { const int st = (r >> 4) * 2 + (c >> 5), rr = r & 15, cc = c & 31, ob = rr * 64 + cc * 2; return st * 1024 + (ob ^ (((ob >> 9) & 1) << 5)); }
__host__ __device__ __forceinline__ void stage_rc(int b, int& R, int& C) { const int st = b / 1024, sb = b % 1024, swz = sb ^ (((sb >> 9) & 1) << 5); R = (st >> 1) * 16 + swz / 64; C = (st & 1) * 32 + (swz % 64) / 2; }
__host__ __device__ __forceinline__ int perm32(int rho) { const int n = rho >> 4, i = rho & 15; return 8 * (i >> 2) + 4 * n + (i & 3); }

struct Unit { int pm, pn; };
typedef int v4i_t __attribute__((ext_vector_type(4))); typedef int v8i_t __attribute__((ext_vector_type(8)));
struct Gemm { const bf16_t* A; const bf16_t* Bt; int M, N, K; int sca = 0x7f7f7f7f, scb = 0x7f7f7f7f; };

struct StaticOrder {
    int nM, nN, nwg, G, c;
    __host__ __device__ void init(int M, int N, int G_, int c_) { nM = M / BM; nN = N / BM; nwg = nM * nN; G = G_; c = c_; }
    __host__ __device__ bool next(int i, Unit& u) const {
        const long L = (long)i * G + c; if (L >= nwg) return false;
        int wgid = (int)L; { const int q = nwg / NXCD, r = nwg % NXCD, xcd = wgid % NXCD, off = wgid / NXCD; wgid = (xcd < r ? xcd * (q + 1) : r * (q + 1) + (xcd - r) * q) + off; }
        const int nig = WGM * nN, gid = wgid / nig, fm = gid * WGM, gsz = (nM - fm) < WGM ? (nM - fm) : WGM;
        u.pm = fm + ((wgid % nig) % gsz); u.pn = (wgid % nig) / gsz; return true;
    }
    __device__ __forceinline__ void a_ready(const Unit&) const {}
    __device__ __forceinline__ void done(const Unit&) const {}
};

__device__ __forceinline__ unsigned cvt_pk_bf16(float lo, float hi) { unsigned r; asm volatile("v_cvt_pk_bf16_f32 %0, %1, %2" : "=v"(r) : "v"(lo), "v"(hi)); return r; }
typedef float f32x2 __attribute__((ext_vector_type(2)));
__device__ __forceinline__ f32x2 gelu_pk(f32x2 v) {
    const f32x2 av = __builtin_elementwise_abs(v), d = av * 0.2316418882f + 1.0f;
    f32x2 t; t.x = __builtin_amdgcn_rcpf(d.x); t.y = __builtin_amdgcn_rcpf(d.y);
    f32x2 q = t * 0.5307027145f + (-0.7265760135f); q = q * t + 0.7107068705f; q = q * t + (-0.142248368f); q = q * t + 0.127414796f; q = q * t;
    const f32x2 s = (v * v) * (-0.72134752044f);
    f32x2 e; e.x = __builtin_amdgcn_exp2f(s.x); e.y = __builtin_amdgcn_exp2f(s.y);
    const f32x2 m = v * (q * e), r = v - m;
    f32x2 o; o.x = v.x < 0.f ? m.x : r.x; o.y = v.y < 0.f ? m.y : r.y; return o;
}

template <int ACT  > struct EpiBf16 {
    static constexpr bool PERM = true, AFTER_DRAIN = false; static_assert(ACT == 0 || ACT == 1, "EpiBf16: ACT is 0 (none) or 1 (gelu_pk)");
    bf16_t* O; int ldc; const float* bias; int split_cols; size_t split_stride; float scale0;
    __device__ __forceinline__ void operator()(const f32x4 (&acc)[2][2][4][2], const Unit& u, int wr, int wc, int fr, int fq) const {
        const int row0 = u.pm * BM + wr * 64 + fr; int colt = u.pn * BM; bf16_t* base = O;
        float sc = 1.f; if (split_cols) { const int t = colt / split_cols; base += (size_t)t * split_stride; colt -= t * split_cols; if (t == 0) sc = scale0; }
        const int col0 = colt + wc * 32 + 8 * fq, bcol0 = u.pn * BM + wc * 32 + 8 * fq;
        f32x4 bv[2][2];
#pragma unroll
        for (int bj = 0; bj < 2; ++bj)
#pragma unroll
            for (int n = 0; n < 2; ++n) bv[bj][n] = bias ? *(const f32x4*)(bias + bcol0 + bj * HALF + 4 * n) : (f32x4){0.f, 0.f, 0.f, 0.f};
#pragma unroll
        for (int ai = 0; ai < 2; ++ai)
#pragma unroll
            for (int m = 0; m < 4; ++m) { bf16_t* rowp = base + (size_t)(row0 + ai * HALF + m * 16) * ldc + col0;
#pragma unroll
                for (int bj = 0; bj < 2; ++bj) { f32x4 v0 = acc[ai][bj][m][0] + bv[bj][0], v1 = acc[ai][bj][m][1] + bv[bj][1];
                    if (ACT == 1) { f32x2 a = gelu_pk((f32x2){v0[0], v0[1]}), b = gelu_pk((f32x2){v0[2], v0[3]}), c = gelu_pk((f32x2){v1[0], v1[1]}), d = gelu_pk((f32x2){v1[2], v1[3]});
                        v0 = (f32x4){a.x, a.y, b.x, b.y}; v1 = (f32x4){c.x, c.y, d.x, d.y}; }
                    v0 = v0 * sc; v1 = v1 * sc; u32x4 w; w.x = cvt_pk_bf16(v0[0], v0[1]); w.y = cvt_pk_bf16(v0[2], v0[3]); w.z = cvt_pk_bf16(v1[0], v1[1]); w.w = cvt_pk_bf16(v1[2], v1[3]);
                    *(u32x4*)(rowp + bj * HALF) = w; } }
    }
};
template <class E_> struct EpiHasMid { static constexpr bool v = false; };
template <class Epi, class Sched, bool ALIGN_EPI = false, bool SP2 = false, bool FP8 = false>
__device__ __forceinline__ void gemm_phase(PG8_LAS unsigned char* lds, const Gemm g, const Sched& S, const Epi& E) {
    int tid_ = threadIdx.x; asm volatile("" : "+v"(tid_));
    const int tid = tid_, wid = __builtin_amdgcn_readfirstlane(tid >> 6), lane = tid & 63, wr = wid >> 2, wc = wid & 3, fr = lane & 15, fq = lane >> 4;
    const int K = FP8 ? g.K / 2 : g.K, nt = K / BK;
    unsigned voffA[2], voffB[2];
#pragma unroll
    for (int i = 0; i < 2; ++i) { int R, C; stage_rc(tid * 16 + i * 8192, R, C); const int Rb = Epi::PERM ? ((R & ~31) + perm32(R & 31)) : R;
        voffA[i] = (unsigned)(R * K + C) * 2u; voffB[i] = (unsigned)(Rb * K + C) * 2u; }
    const size_t kstep = (size_t)(BK * 2);
    const size_t hstep = (size_t)HALF * K * 2;
    const size_t tstep = 2 * hstep;
    const unsigned ldsw = (unsigned)wid * 1024u;
    const int aoff = FP8 ? lds_byte(wr * 64 + fr, fq * 16) : lds_byte(wr * 64 + fr, fq * 8), boff = FP8 ? lds_byte(wc * 32 + fr, fq * 16) : lds_byte(wc * 32 + fr, fq * 8);
    constexpr int PIECE1 = FP8 ? 16 : 1024; (void)PIECE1;
#define PG8_SA(b, h) (((b) * 2 + (h)) * HTB)
#define PG8_SB(b, h) ((4 + (b) * 2 + (h)) * HTB)
#define PG8_STAGE(bufoff, gbase, voff) do { _Pragma("unroll") for (int _i = 0; _i < 2; ++_i) \
        __builtin_amdgcn_global_load_lds((const unsigned*)((const char*)(gbase) + (voff)[_i]), (PG8_LAS unsigned*)(lds + (bufoff) + ldsw + _i * 8192), 16, 0, 0); } while (0)
#define PG8_LD8(p_) __builtin_shufflevector(*(const PG8_LAS v4i_t*)(p_), *(const PG8_LAS v4i_t*)((p_) + 16), 0, 1, 2, 3, 4, 5, 6, 7)
#define PG8_LDA(dst, b, h) do { if constexpr (FP8) { _Pragma("unroll") for (int m = 0; m < 4; ++m) dst##8[m] = PG8_LD8(lds + PG8_SA(b, h) + aoff + m * 2048); } \
        else { _Pragma("unroll") for (int m = 0; m < 4; ++m) _Pragma("unroll") for (int k = 0; k < 2; ++k) dst[m][k] = *(const PG8_LAS bf16x8*)(lds + PG8_SA(b, h) + aoff + k * 1024 + m * 2048); } } while (0)
#define PG8_LDB(dst, b, h) do { if constexpr (FP8) { _Pragma("unroll") for (int n = 0; n < 2; ++n) dst##8[n] = PG8_LD8(lds + PG8_SB(b, h) + boff + n * 2048); } \
        else { _Pragma("unroll") for (int n = 0; n < 2; ++n) _Pragma("unroll") for (int k = 0; k < 2; ++k) dst[n][k] = *(const PG8_LAS bf16x8*)(lds + PG8_SB(b, h) + boff + k * 1024 + n * 2048); } } while (0)
#define PG8_MMA(ai, bj, At, Bt) do { __builtin_amdgcn_s_setprio(1); \
        if constexpr (FP8) { _Pragma("unroll") for (int m = 0; m < 4; ++m) _Pragma("unroll") for (int n = 0; n < 2; ++n) \
            asm volatile("v_mfma_scale_f32_16x16x128_f8f6f4 %0, %1, %2, %0, %3, %4 op_sel_hi:[0,0,0]" : "+v"(acc[ai][bj][m][n]) : "v"(Bt##8[n]), "v"(At##8[m]), "v"(scb_v), "v"(sca_v)); } \
        else { _Pragma("unroll") for (int m = 0; m < 4; ++m) _Pragma("unroll") for (int n = 0; n < 2; ++n) _Pragma("unroll") for (int k = 0; k < 2; ++k) \
            acc[ai][bj][m][n] = __builtin_amdgcn_mfma_f32_16x16x32_bf16(Bt[n][k], At[m][k], acc[ai][bj][m][n], 0, 0, 0); } __builtin_amdgcn_s_setprio(0); } while (0)
#define PG8_WAIT_V(n) asm volatile("s_waitcnt vmcnt(" #n ")" ::: "memory")
#define PG8_WAIT_L(n) asm volatile("s_waitcnt lgkmcnt(" #n ")" ::: "memory")
#define PG8_BAR __builtin_amdgcn_s_barrier()
#define PG8_SCHED __builtin_amdgcn_sched_barrier(0)
    Unit cur, nxt; int ui = 0;
    if (!S.next(0, cur)) return;
    f32x4 acc[2][2][4][2];
#pragma unroll
    for (int a = 0; a < 2; ++a)
#pragma unroll
        for (int b = 0; b < 2; ++b)
#pragma unroll
            for (int m = 0; m < 4; ++m)
#pragma unroll
                for (int n = 0; n < 2; ++n) acc[a][b][m][n] = (f32x4){0.f, 0.f, 0.f, 0.f};
    const int sca_v = g.sca, scb_v = g.scb;
    bf16x8 At[4][2], B0[2][2], B1[2][2];
    v8i_t At8[4], B08[2], B18[2];
    const char* cA = (const char*)g.A + (size_t)cur.pm * tstep; const char* cB = (const char*)g.Bt + (size_t)cur.pn * tstep;
    S.a_ready(cur);
    if constexpr (SP2) {
        PG8_STAGE(PG8_SB(0, 0), cB, voffB); PG8_STAGE(PG8_SB(0, 1), cB + hstep, voffB); PG8_STAGE(PG8_SA(0, 0), cA, voffA); PG8_STAGE(PG8_SA(0, 1), cA + hstep, voffA);
        if (wr == 1) PG8_BAR;
        PG8_WAIT_V(2); PG8_BAR;
        PG8_STAGE(PG8_SB(1, 0), cB + kstep, voffB); PG8_STAGE(PG8_SA(1, 0), cA + kstep, voffA); PG8_STAGE(PG8_SB(1, 1), cB + hstep + kstep, voffB);
        PG8_WAIT_V(6); PG8_BAR;
    } else {
        PG8_STAGE(PG8_SB(0, 0), cB, voffB); PG8_STAGE(PG8_SA(0, 0), cA, voffA); PG8_STAGE(PG8_SB(0, 1), cB + hstep, voffB); PG8_STAGE(PG8_SA(0, 1), cA + hstep, voffA);
        if (wr == 1) PG8_BAR;
        PG8_WAIT_V(4); PG8_BAR;
        PG8_STAGE(PG8_SB(1, 0), cB + kstep, voffB); PG8_STAGE(PG8_SA(1, 0), cA + kstep, voffA); PG8_STAGE(PG8_SB(1, 1), cB + hstep + kstep, voffB);
        PG8_WAIT_V(6); PG8_BAR;
    }
    for (;;) {
        const bool has_next = S.next(ui + 1, nxt);
        const char* nA = has_next ? (const char*)g.A + (size_t)nxt.pm * tstep : cA; const char* nB = has_next ? (const char*)g.Bt + (size_t)nxt.pn * tstep : cB;
#pragma unroll 1
        for (int t = 0; t < nt; t += 2) {
            if constexpr (EpiHasMid<Epi>::v) { if (t == 8 || t == 16) { PG8_SCHED; E.mid(acc, cur, t, wr, wc, fr, fq); PG8_SCHED; } }
            const bool last = (t == nt - 2);
            const char* a1 = cA + (size_t)(t + 1) * kstep;
            const char* a2 = last ? nA : cA + (size_t)(t + 2) * kstep; const char* b2 = last ? nB : cB + (size_t)(t + 2) * kstep;
            const char* a3 = a2 + kstep; const char* b3 = b2 + kstep;
            if (last && has_next) S.a_ready(nxt);
            if constexpr (SP2) {
            PG8_LDB(B0, 0, 0); PG8_LDB(B1, 0, 1); PG8_SCHED; PG8_LDA(At, 0, 0); PG8_STAGE(PG8_SA(1, 1), a1 + hstep, voffA);
            PG8_WAIT_V(8); PG8_WAIT_L(0); PG8_BAR; PG8_MMA(0, 0, At, B0); PG8_MMA(0, 1, At, B1); PG8_BAR; PG8_SCHED;
            PG8_LDA(At, 0, 1); PG8_STAGE(PG8_SB(0, 0), b2, voffB); PG8_STAGE(PG8_SB(0, 1), b2 + hstep, voffB); PG8_STAGE(PG8_SA(0, 0), a2, voffA);
            PG8_WAIT_V(8); PG8_WAIT_L(0); PG8_BAR; PG8_MMA(1, 0, At, B0); PG8_MMA(1, 1, At, B1); PG8_BAR; PG8_SCHED;
            PG8_LDB(B0, 1, 0); PG8_LDB(B1, 1, 1); PG8_SCHED; PG8_LDA(At, 1, 0); PG8_STAGE(PG8_SA(0, 1), a2 + hstep, voffA);
            PG8_WAIT_V(8); PG8_WAIT_L(0); PG8_BAR; PG8_MMA(0, 0, At, B0); PG8_MMA(0, 1, At, B1); PG8_BAR; PG8_SCHED;
            PG8_LDA(At, 1, 1); PG8_STAGE(PG8_SB(1, 0), b3, voffB); PG8_STAGE(PG8_SB(1, 1), b3 + hstep, voffB); PG8_STAGE(PG8_SA(1, 0), a3, voffA);
            PG8_WAIT_V(8); PG8_WAIT_L(0); PG8_BAR; PG8_MMA(1, 0, At, B0); PG8_MMA(1, 1, At, B1); PG8_BAR; PG8_SCHED;
            } else {
            PG8_LDB(B0, 0, 0); PG8_SCHED; PG8_LDA(At, 0, 0); PG8_STAGE(PG8_SA(1, 1), a1 + hstep, voffA);
            PG8_WAIT_L(8); PG8_BAR; PG8_WAIT_L(0); PG8_MMA(0, 0, At, B0); PG8_BAR; PG8_SCHED;
            PG8_LDB(B1, 0, 1); PG8_STAGE(PG8_SB(0, 0), b2, voffB);
            PG8_BAR; PG8_WAIT_L(0); PG8_MMA(0, 1, At, B1); PG8_BAR;
            PG8_LDA(At, 0, 1); PG8_STAGE(PG8_SA(0, 0), a2, voffA);
            PG8_BAR; PG8_WAIT_L(0); PG8_MMA(1, 0, At, B0); PG8_BAR; PG8_SCHED;
            PG8_STAGE(PG8_SB(0, 1), b2 + hstep, voffB);
            PG8_WAIT_V(6); PG8_BAR; PG8_MMA(1, 1, At, B1); PG8_BAR;
            PG8_LDB(B0, 1, 0); PG8_SCHED; PG8_LDA(At, 1, 0); PG8_STAGE(PG8_SA(0, 1), a2 + hstep, voffA);
            PG8_WAIT_L(8); PG8_BAR; PG8_WAIT_L(0); PG8_MMA(0, 0, At, B0); PG8_BAR; PG8_SCHED;
            PG8_LDB(B1, 1, 1); PG8_STAGE(PG8_SB(1, 0), b3, voffB);
            PG8_BAR; PG8_WAIT_L(0); PG8_MMA(0, 1, At, B1); PG8_BAR;
            PG8_LDA(At, 1, 1); PG8_STAGE(PG8_SA(1, 0), a3, voffA);
            PG8_BAR; PG8_WAIT_L(0); PG8_MMA(1, 0, At, B0); PG8_BAR; PG8_SCHED;
            PG8_STAGE(PG8_SB(1, 1), b3 + hstep, voffB);
            PG8_WAIT_V(6); PG8_BAR; PG8_MMA(1, 1, At, B1); PG8_BAR;
            }
        }
        if constexpr (FP8) { asm volatile("s_nop 15\n\ts_nop 15" ::: "memory"); }
        if constexpr (ALIGN_EPI) { if (wr == 0) PG8_BAR; }
        if constexpr (!Epi::AFTER_DRAIN) { E(acc, cur, wr, wc, fr, fq); S.done(cur); }
        if (!has_next) break;
#pragma unroll
        for (int a = 0; a < 2; ++a)
#pragma unroll
            for (int b = 0; b < 2; ++b)
#pragma unroll
                for (int m = 0; m < 4; ++m)
#pragma unroll
                    for (int n = 0; n < 2; ++n) acc[a][b][m][n] = (f32x4){0.f, 0.f, 0.f, 0.f};
        cur = nxt; cA = nA; cB = nB; ++ui;
        if constexpr (ALIGN_EPI) { if (wr == 1) PG8_BAR; }
    }
    PG8_WAIT_V(0);
    if constexpr (!ALIGN_EPI) { if (wr == 0) PG8_BAR; }
    PG8_BAR;
    if constexpr (Epi::AFTER_DRAIN) { E.fused(acc, cur, wr, wc, fr, fq, lds, wid, lane); S.done(cur); }
#undef PG8_SA
#undef PG8_SB
#undef PG8_STAGE
#undef PG8_LD8
#undef PG8_LDA
#undef PG8_LDB
#undef PG8_MMA
#undef PG8_WAIT_V
#undef PG8_WAIT_L
#undef PG8_BAR
#undef PG8_SCHED
}
}

constexpr int D_MODEL = 1024, BATCH = 2, SEQ = 8192, MTOK = BATCH * SEQ, MEM_LEN = 256, MEMROWS = BATCH * MEM_LEN;
constexpr int IN_COLS = 9984, OFF_AQ = 0, OFF_AK = 1536, OFF_AV = 3072, OFF_R = 4608, OFF_CQ = 6400, OFF_GATE = 6912;
constexpr int RW = 512;
constexpr int N_EXPERTS = 32, TOP_K = 4, D_FF = 1024, MOE_ROWS = 256;
constexpr int MAX_BLOCKS = MTOK * TOP_K / MOE_ROWS + N_EXPERTS;
constexpr int MAX_SLOTS = MAX_BLOCKS * MOE_ROWS;
constexpr float NORM_EPS = 1e-6f, R_GN_EPS = 64e-5f;
constexpr float LOG2E = 1.4426950408889634f;
constexpr float QSCALE = 0.08838834764831845f * LOG2E;

namespace pg8 {
__device__ __forceinline__ float bf_lo(unsigned w) { return __builtin_bit_cast(float, w << 16); }
__device__ __forceinline__ float bf_hi(unsigned w) { return __builtin_bit_cast(float, w & 0xffff0000u); }
__device__ __forceinline__ float sigmoidf_fast(float x) { return __builtin_amdgcn_rcpf(1.0f + __builtin_amdgcn_exp2f(-1.4426950408889634f * x)); }

struct EpiZ {
    static constexpr bool PERM = true, AFTER_DRAIN = false;
    bf16_t* O; const float* bgate; const float* aqg; const float* akg; const float* cqg; const float* cs;
    bf16_t* KV; const float* ckg;
    PG8_LAS float* P;
    __device__ __forceinline__ void operator()(const f32x4 (&acc)[2][2][4][2], const Unit& u, int wr, int wc, int fr, int fq) const {
        const bool mem = u.pm >= 64; const int pnl = mem ? u.pn - 39 : u.pn, ldc = mem ? 1024 : IN_COLS;
        bf16_t* const Ob = mem ? KV - (size_t)64 * BM * 1024 : O;
        const int row0 = u.pm * BM + wr * 64 + fr, col0 = pnl * BM + wc * 32 + 8 * fq;
        const int cls = mem ? ((pnl < 2) ? 3 : 0) : (pnl < 6) ? 1 : (pnl < 12) ? 2 : (pnl == 25 || pnl == 26) ? 3 : (pnl >= 27) ? 4 : 0;
        if (cls >= 1 && cls <= 3) {
            const int go = wc * 32 + 8 * fq;
            const f32x4 q0 = *(const f32x4*)(aqg + go), q1 = *(const f32x4*)(aqg + go + 4), k0 = *(const f32x4*)(akg + go), k1 = *(const f32x4*)(akg + go + 4), x0 = *(const f32x4*)(cqg + go), x1 = *(const f32x4*)(cqg + go + 4);
            const f32x4 m0 = *(const f32x4*)(ckg + go), m1 = *(const f32x4*)(ckg + go + 4);
            const f32x4 g0 = mem ? m0 : (cls == 1) ? q0 : (cls == 2) ? k0 : x0, g1 = mem ? m1 : (cls == 1) ? q1 : (cls == 2) ? k1 : x1;
#pragma unroll
            for (int ai = 0; ai < 2; ++ai)
#pragma unroll
                for (int m = 0; m < 4; ++m)
#pragma unroll
                    for (int bj = 0; bj < 2; ++bj) { const f32x4 a = acc[ai][bj][m][0], b = acc[ai][bj][m][1];
                        float s = ((a[0] * a[0] + a[1] * a[1]) + (a[2] * a[2] + a[3] * a[3])) + ((b[0] * b[0] + b[1] * b[1]) + (b[2] * b[2] + b[3] * b[3]));
                        s += __shfl_xor(s, 16); s += __shfl_xor(s, 32);
                        if (fq == 0) P[((ai * HALF + wr * 64 + m * 16 + fr) * 2 + bj) * 4 + wc] = s; }
            asm volatile("s_waitcnt lgkmcnt(0)" ::: "memory"); __builtin_amdgcn_s_barrier(); asm volatile("" ::: "memory");
#pragma unroll
            for (int ai = 0; ai < 2; ++ai)
#pragma unroll
                for (int m = 0; m < 4; ++m) { const int rl = ai * HALF + wr * 64 + m * 16 + fr, row = u.pm * BM + rl;
                    f32x4 c0 = {0.f, 0.f, 0.f, 0.f}, c1 = c0, c2 = c0, c3 = c0;
                    if (cls != 3 && wc == 0) { const f32x4* cp = (const f32x4*)(cs + (size_t)row * 32 + 16 * (fq & 1)); c0 = cp[0]; c1 = cp[1]; c2 = cp[2]; c3 = cp[3]; }
#pragma unroll
                    for (int bj = 0; bj < 2; ++bj) { const f32x4 pv = *(const PG8_LAS f32x4*)(P + (rl * 2 + bj) * 4);
                        const float rstd = __builtin_amdgcn_rsqf(((pv[0] + pv[1]) + (pv[2] + pv[3])) * (1.0f / 128.0f) + NORM_EPS);
                        f32x4 v0 = acc[ai][bj][m][0] * rstd * g0, v1 = acc[ai][bj][m][1] * rstd * g1;
                        if (cls != 3 && wc == 0) {
                            f32x4 p0, p1;
#pragma unroll
                            for (int j = 0; j < 4; ++j) { p0[j] = __shfl_xor(v0[j], 32); p1[j] = __shfl_xor(v1[j], 32); }
                            const float sg = (fq < 2) ? -1.0f : 1.0f;
                            v0[0] = v0[0] * c0[0] + sg * p0[0] * c0[1]; v0[1] = v0[1] * c0[2] + sg * p0[1] * c0[3]; v0[2] = v0[2] * c1[0] + sg * p0[2] * c1[1]; v0[3] = v0[3] * c1[2] + sg * p0[3] * c1[3];
                            v1[0] = v1[0] * c2[0] + sg * p1[0] * c2[1]; v1[1] = v1[1] * c2[2] + sg * p1[1] * c2[3]; v1[2] = v1[2] * c3[0] + sg * p1[2] * c3[1]; v1[3] = v1[3] * c3[2] + sg * p1[3] * c3[3]; }
                        u32x4 w; w.x = cvt_pk_bf16(v0[0], v0[1]); w.y = cvt_pk_bf16(v0[2], v0[3]); w.z = cvt_pk_bf16(v1[0], v1[1]); w.w = cvt_pk_bf16(v1[2], v1[3]);
                        *(u32x4*)(Ob + (size_t)row * ldc + col0 + bj * HALF) = w; } }
            return;
        }
        const bool gate = cls == 4;
        f32x4 bv[2][2];
#pragma unroll
        for (int bj = 0; bj < 2; ++bj)
#pragma unroll
            for (int n = 0; n < 2; ++n) bv[bj][n] = gate ? *(const f32x4*)(bgate + (col0 - OFF_GATE) + bj * HALF + 4 * n) : (f32x4){0.f, 0.f, 0.f, 0.f};
#pragma unroll
        for (int ai = 0; ai < 2; ++ai)
#pragma unroll
            for (int m = 0; m < 4; ++m) { bf16_t* rowp = Ob + (size_t)(row0 + ai * HALF + m * 16) * ldc + col0;
#pragma unroll
                for (int bj = 0; bj < 2; ++bj) { f32x4 v0 = acc[ai][bj][m][0] + bv[bj][0], v1 = acc[ai][bj][m][1] + bv[bj][1];
                    if (gate) {
#pragma unroll
                        for (int j = 0; j < 4; ++j) { v0[j] = sigmoidf_fast(v0[j]); v1[j] = sigmoidf_fast(v1[j]); } }
                    u32x4 w; w.x = cvt_pk_bf16(v0[0], v0[1]); w.y = cvt_pk_bf16(v0[2], v0[3]); w.z = cvt_pk_bf16(v1[0], v1[1]); w.w = cvt_pk_bf16(v1[2], v1[3]);
                    *(u32x4*)(rowp + bj * HALF) = w; } }
    }
};

template <int SET> struct ZOrder {
    StaticOrder so; int nz;
    __device__ void init(int G_, int c_) { so.init(MTOK, (SET == 0 ? 27 : 12) * BM, G_, c_); nz = 64 * (SET == 0 ? 27 : 12); }
    __device__ __forceinline__ bool next(int i, Unit& u) const {
        if (so.next(i, u)) { const int t = u.pn;
            if (SET == 1) u.pn = t + 27;
            return true; }
        if (SET == 0) { const long L = (long)i * so.G + so.c - nz; if (L >= 0 && L < 8) { u.pm = 64 + (int)(L & 1); u.pn = 39 + (int)(L >> 1); return true; } }
        return false;
    }
    __device__ __forceinline__ void a_ready(const Unit&) const {}
    __device__ __forceinline__ void done(const Unit&) const {}
};
struct EpiGate3 {
    static constexpr bool PERM = true, AFTER_DRAIN = false;
    const bf16_t* Z; bf16_t* mergedb;
    __device__ __forceinline__ void mid(f32x4 (&acc)[2][2][4][2], const Unit& u, int t, int wr, int wc, int fr, int fq) const {
        int fr_ = fr; asm volatile("" : "+v"(fr_));
        const int row0 = u.pm * BM + wr * 64 + fr_, col0 = u.pn * BM + wc * 32 + 8 * fq, ba = (t >> 3) - 1;
        const bf16_t* gp = Z + OFF_GATE + ba * D_MODEL + col0;
#pragma unroll
        for (int ai = 0; ai < 2; ++ai)
#pragma unroll
            for (int m = 0; m < 4; ++m) { const bf16_t* rp = gp + (size_t)(row0 + ai * HALF + m * 16) * IN_COLS;
#pragma unroll
                for (int bj = 0; bj < 2; ++bj) { const u32x4 ga = *(const u32x4*)(rp + bj * HALF), gb = *(const u32x4*)(rp + D_MODEL + bj * HALF);
                    f32x4 r0, r1;
                    r0[0] = bf_lo(ga[0]) * __builtin_amdgcn_rcpf(bf_lo(gb[0])); r0[1] = bf_hi(ga[0]) * __builtin_amdgcn_rcpf(bf_hi(gb[0])); r0[2] = bf_lo(ga[1]) * __builtin_amdgcn_rcpf(bf_lo(gb[1])); r0[3] = bf_hi(ga[1]) * __builtin_amdgcn_rcpf(bf_hi(gb[1]));
                    r1[0] = bf_lo(ga[2]) * __builtin_amdgcn_rcpf(bf_lo(gb[2])); r1[1] = bf_hi(ga[2]) * __builtin_amdgcn_rcpf(bf_hi(gb[2])); r1[2] = bf_lo(ga[3]) * __builtin_amdgcn_rcpf(bf_lo(gb[3])); r1[3] = bf_hi(ga[3]) * __builtin_amdgcn_rcpf(bf_hi(gb[3]));
                    acc[ai][bj][m][0] *= r0; acc[ai][bj][m][1] *= r1; }
                if (m == 3) asm volatile("" ::: "memory"); }
    }
    __device__ __forceinline__ void operator()(const f32x4 (&acc)[2][2][4][2], const Unit& u, int wr, int wc, int fr, int fq) const {
        const int row0 = u.pm * BM + wr * 64 + fr, col0 = u.pn * BM + wc * 32 + 8 * fq;
        u32x4 gzr[2][4][2];
#pragma unroll
        for (int ai = 0; ai < 2; ++ai)
#pragma unroll
            for (int m = 0; m < 4; ++m)
#pragma unroll
                for (int bj = 0; bj < 2; ++bj) gzr[ai][m][bj] = *(const u32x4*)(Z + (size_t)(row0 + ai * HALF + m * 16) * IN_COLS + OFF_GATE + 2 * D_MODEL + col0 + bj * HALF);
#pragma unroll
        for (int ai = 0; ai < 2; ++ai)
#pragma unroll
            for (int m = 0; m < 4; ++m) { const int row = row0 + ai * HALF + m * 16;
#pragma unroll
                for (int bj = 0; bj < 2; ++bj) { const int col = col0 + bj * HALF; const u32x4 gz = gzr[ai][m][bj];
                    f32x4 g0, g1;
                    g0[0] = bf_lo(gz[0]); g0[1] = bf_hi(gz[0]); g0[2] = bf_lo(gz[1]); g0[3] = bf_hi(gz[1]); g1[0] = bf_lo(gz[2]); g1[1] = bf_hi(gz[2]); g1[2] = bf_lo(gz[3]); g1[3] = bf_hi(gz[3]);
                    const f32x4 v0 = acc[ai][bj][m][0] * g0, v1 = acc[ai][bj][m][1] * g1;
                    u32x4 w; w.x = cvt_pk_bf16(v0[0], v0[1]); w.y = cvt_pk_bf16(v0[2], v0[3]); w.z = cvt_pk_bf16(v1[0], v1[1]); w.w = cvt_pk_bf16(v1[2], v1[3]);
                    *(u32x4*)(mergedb + (size_t)row * D_MODEL + col) = w; } }
    }
};
template <> struct EpiHasMid<EpiGate3> { static constexpr bool v = true; };
struct EpiGate3NoMid : EpiGate3 {};
struct EpiResF32 {
    static constexpr bool PERM = true, AFTER_DRAIN = false;
    const float* base; float* out; int ldc;
    __device__ __forceinline__ void operator()(const f32x4 (&acc)[2][2][4][2], const Unit& u, int wr, int wc, int fr, int fq) const {
        const int row0 = u.pm * BM + wr * 64 + fr, col0 = u.pn * BM + wc * 32 + 8 * fq;
#pragma unroll
        for (int ai = 0; ai < 2; ++ai) {
            f32x4 xr[4][2][2];
#pragma unroll
            for (int m = 0; m < 4; ++m)
#pragma unroll
                for (int bj = 0; bj < 2; ++bj) { const float* bp = base + (size_t)(row0 + ai * HALF + m * 16) * ldc + col0 + bj * HALF; xr[m][bj][0] = *(const f32x4*)bp; xr[m][bj][1] = *(const f32x4*)(bp + 4); }
#pragma unroll
            for (int m = 0; m < 4; ++m)
#pragma unroll
                for (int bj = 0; bj < 2; ++bj) { float* op = out + (size_t)(row0 + ai * HALF + m * 16) * ldc + col0 + bj * HALF;
                    *(f32x4*)op = xr[m][bj][0] + acc[ai][bj][m][0]; *(f32x4*)(op + 4) = xr[m][bj][1] + acc[ai][bj][m][1]; }
            asm volatile("" ::: "memory"); }
    }
};
struct EpiSwiGLU {
    static constexpr bool PERM = true, AFTER_DRAIN = false;
    const float* b1; bf16_t* H;
    __device__ __forceinline__ void operator()(const f32x4 (&acc)[2][2][4][2], const Unit& u, int wr, int wc, int fr, int fq) const {
        const int e = u.pn >> 3, pnl = u.pn & 7;
        const int row0 = u.pm * BM + wr * 64 + fr, ac = pnl * HALF + wc * 32 + 8 * fq;
        const float* bg = b1 + (size_t)e * 2 * D_FF + ac; const float* bl = bg + D_FF;
        const f32x4 bg0 = *(const f32x4*)bg, bg1 = *(const f32x4*)(bg + 4), bl0 = *(const f32x4*)bl, bl1 = *(const f32x4*)(bl + 4);
#pragma unroll
        for (int ai = 0; ai < 2; ++ai)
#pragma unroll
            for (int m = 0; m < 4; ++m) { const int row = row0 + ai * HALF + m * 16;
                float a[8];
#pragma unroll
                for (int n = 0; n < 2; ++n) { const f32x4 ug = acc[ai][0][m][n] + (n ? bg1 : bg0), ul = acc[ai][1][m][n] + (n ? bl1 : bl0);
#pragma unroll
                    for (int j = 0; j < 4; ++j) { const float g = fminf(ug[j], 7.0f), l = fminf(fmaxf(ul[j], -7.0f), 7.0f);
                        a[4 * n + j] = g * sigmoidf_fast(1.702f * g) * (l + 1.0f); } }
                unsigned w0 = 0, w1 = 0;
                w0 = __builtin_amdgcn_cvt_pk_fp8_f32(a[0] * 8.0f, a[1] * 8.0f, w0, false); w0 = __builtin_amdgcn_cvt_pk_fp8_f32(a[2] * 8.0f, a[3] * 8.0f, w0, true);
                w1 = __builtin_amdgcn_cvt_pk_fp8_f32(a[4] * 8.0f, a[5] * 8.0f, w1, false); w1 = __builtin_amdgcn_cvt_pk_fp8_f32(a[6] * 8.0f, a[7] * 8.0f, w1, true);
                *(unsigned long long*)((unsigned char*)H + (size_t)row * D_FF + ac) = (unsigned long long)w0 | ((unsigned long long)w1 << 32); }
    }
};
struct EpiMoeOut {
    static constexpr bool PERM = true, AFTER_DRAIN = false;
    const float* b2; const float* rowgate; bf16_t* Y;
    __device__ __forceinline__ void operator()(const f32x4 (&acc)[2][2][4][2], const Unit& u, int wr, int wc, int fr, int fq) const {
        const int e = u.pn >> 2, pnl = u.pn & 3;
        const int row0 = u.pm * BM + wr * 64 + fr, col0 = pnl * BM + wc * 32 + 8 * fq;
        float gtr[2][4]; f32x4 bb[2][2];
#pragma unroll
        for (int ai = 0; ai < 2; ++ai)
#pragma unroll
            for (int m = 0; m < 4; ++m) gtr[ai][m] = rowgate[row0 + ai * HALF + m * 16];
#pragma unroll
        for (int bj = 0; bj < 2; ++bj) { const float* bp = b2 + (size_t)e * D_MODEL + col0 + bj * HALF; bb[bj][0] = *(const f32x4*)bp; bb[bj][1] = *(const f32x4*)(bp + 4); }
#pragma unroll
        for (int ai = 0; ai < 2; ++ai)
#pragma unroll
            for (int m = 0; m < 4; ++m) { const int row = row0 + ai * HALF + m * 16; const float gt = gtr[ai][m];
#pragma unroll
                for (int bj = 0; bj < 2; ++bj) { const int col = col0 + bj * HALF;
                    const f32x4 v0 = (acc[ai][bj][m][0] + bb[bj][0]) * gt, v1 = (acc[ai][bj][m][1] + bb[bj][1]) * gt;
                    unsigned w0 = 0, w1 = 0;
                    w0 = __builtin_amdgcn_cvt_pk_fp8_f32(v0[0] * 16.0f, v0[1] * 16.0f, w0, false); w0 = __builtin_amdgcn_cvt_pk_fp8_f32(v0[2] * 16.0f, v0[3] * 16.0f, w0, true);
                    w1 = __builtin_amdgcn_cvt_pk_fp8_f32(v1[0] * 16.0f, v1[1] * 16.0f, w1, false); w1 = __builtin_amdgcn_cvt_pk_fp8_f32(v1[2] * 16.0f, v1[3] * 16.0f, w1, true);
                    *(unsigned long long*)((unsigned char*)Y + (size_t)row * D_MODEL + col) = (unsigned long long)w0 | ((unsigned long long)w1 << 32); } }
    }
};
struct MoeOrder {
    const PG8_LAS int* tab;
    int NT, G, c;
    __device__ __forceinline__ bool next(int i, Unit& u) const {
        const int nblk = tab[0]; const long L = (long)i * G + c; if (L >= (long)nblk * NT) return false;
        const int blk = (int)(L / NT), pnl = (int)(L % NT); u.pm = blk; u.pn = tab[1 + blk] * NT + pnl; return true;
    }
    __device__ __forceinline__ void a_ready(const Unit&) const {}
    __device__ __forceinline__ void done(const Unit&) const {}
};
}

namespace swa {
constexpr int D = 128;
constexpr float SCALE = 0.08838834764831845f;
constexpr float THR = 8.f;
constexpr int NW = 8, QBLK = 32, KVBLK = 64, QB = NW * QBLK;
constexpr int SHM_V = KVBLK * D * 2, SHM_K = KVBLK * D * 2;
constexpr int LDS_BYTES = 2 * SHM_V + 2 * SHM_K + NW * 64 * 4;
using bf16 = unsigned short;
typedef short bf16x8 __attribute__((ext_vector_type(8)));
typedef short s16x4 __attribute__((ext_vector_type(4)));
typedef float f32x16 __attribute__((ext_vector_type(16)));
typedef float f32x4 __attribute__((ext_vector_type(4)));
typedef unsigned u32x4 __attribute__((ext_vector_type(4)));
template <class A, class Bt> struct same_t { static constexpr bool v = false; };
template <class A> struct same_t<A, A> { static constexpr bool v = true; };
#define KSWZ(row, colB) ((row) * 256 + ((colB) ^ (((row) & 7) << 4)))
#define SBAR() __builtin_amdgcn_sched_barrier(0)
__device__ __forceinline__ int v_st(int k, int c) { const int kk = (k & ~0xC) | ((k & 4) << 1) | ((k & 8) >> 1); return ((kk >> 3) * 4 + (c >> 5)) * 512 + ((kk & 7) * 32 + (c & 31)) * 2; }
__device__ __forceinline__ int v_rd_base(int lane) { return ((lane & 3) << 3) | (((lane >> 2) & 3) << 6) | (((lane >> 4) & 1) << 5) | (((lane >> 5) & 1) << 8); }
constexpr int v_rd_off(int d0, int ks, int half) { return d0 * 512 + ks * 4096 + half * 2048; }
__device__ __forceinline__ int crow(int r, int hi) { return (r & 3) + 8 * (r >> 2) + 4 * hi; }
__device__ __forceinline__ unsigned cvtpk(float lo, float hi) {
    unsigned r; asm volatile("v_cvt_pk_bf16_f32 %0, %1, %2" : "=v"(r) : "v"(lo), "v"(hi)); return r;
}
__device__ __forceinline__ bf16x8 pack8(f32x4 a, f32x4 b) {
    u32x4 w = {cvtpk(a[0], a[1]), cvtpk(a[2], a[3]), cvtpk(b[0], b[1]), cvtpk(b[2], b[3])};
    return *reinterpret_cast<bf16x8*>(&w);
}
template <class T> __device__ __forceinline__ bf16x8 load8(const T* p) {
    if constexpr (same_t<T, float>::v) { return pack8(*(const f32x4*)p, *(const f32x4*)(p + 4)); }
    else { return *reinterpret_cast<const bf16x8*>(p); }
}
__device__ __forceinline__ void mask_tile(f32x16& p0, f32x16& p1, int dq, unsigned W) {
    const float NEG = -__builtin_inff();
#pragma unroll
    for (int r = 0; r < 16; ++r) {
        const int c = (r & 3) + 8 * (r >> 2);
        if ((unsigned)(dq - c) >= W) p0[r] = NEG;
        if ((unsigned)(dq - c - 32) >= W) p1[r] = NEG;
    }
}
__device__ __forceinline__ void partialSM(f32x16& p0, f32x16& p1, float& m_reg, float& mn, float& alpha) {
    float pmax = p0[0]; for (int r = 1; r < 16; ++r) pmax = fmaxf(pmax, p0[r]); for (int r = 0; r < 16; ++r) pmax = fmaxf(pmax, p1[r]);
    { auto rr = __builtin_amdgcn_permlane32_swap(__float_as_uint(pmax), __float_as_uint(pmax), false, false);
      pmax = fmaxf(__uint_as_float(rr[0]), __uint_as_float(rr[1])); }
    constexpr float C2 = 1.4426950408889634f * SCALE;
    if (__builtin_expect(__all((pmax - m_reg) * SCALE <= THR), 1)) { mn = m_reg; alpha = 1.f; }
    else { mn = fmaxf(m_reg, pmax); alpha = __builtin_amdgcn_exp2f((m_reg - mn) * C2); m_reg = mn; }
    const float mnL = -mn * C2;
    for (int r = 0; r < 16; ++r) p0[r] = fmaf(p0[r], C2, mnL); for (int r = 0; r < 16; ++r) p1[r] = fmaf(p1[r], C2, mnL);
    for (int r = 0; r < 16; ++r) p0[r] = __builtin_amdgcn_exp2f(p0[r]);
}
__device__ __forceinline__ void finishSM(f32x16& p0, f32x16& p1, float alpha, float& l_reg, bf16x8& pa0, bf16x8& pa1, bf16x8& pa2, bf16x8& pa3) {
    for (int r = 0; r < 16; ++r) p1[r] = __builtin_amdgcn_exp2f(p1[r]);
    float ps = 0; for (int r = 0; r < 16; ++r) ps += p0[r]; for (int r = 0; r < 16; ++r) ps += p1[r];
    { auto rr = __builtin_amdgcn_permlane32_swap(__float_as_uint(ps), __float_as_uint(ps), false, false);
      ps = __uint_as_float(rr[0]) + __uint_as_float(rr[1]); }
    l_reg = l_reg * alpha + ps;
#define PK4(P, B_, OUT) do { unsigned a0 = cvtpk(P[B_+0], P[B_+1]), a1 = cvtpk(P[B_+2], P[B_+3]);                          \
        unsigned b0 = cvtpk(P[B_+4], P[B_+5]), b1 = cvtpk(P[B_+6], P[B_+7]);                                             \
        auto r0 = __builtin_amdgcn_permlane32_swap(a0, b0, false, false); auto r1 = __builtin_amdgcn_permlane32_swap(a1, b1, false, false); \
        u32x4 w = {r0[0], r1[0], r0[1], r1[1]}; OUT = *reinterpret_cast<bf16x8*>(&w); } while (0)
    PK4(p0, 0, pa0); PK4(p0, 8, pa1); PK4(p1, 0, pa2); PK4(p1, 8, pa3);
#undef PK4
}
template <int KB, bool SK>
__device__ __forceinline__ void qkt(f32x16& p0, f32x16& p1, const char* K_lds, int r32, int hi, const bf16x8* qr, bool act) {
    if (SK && !act) { const float NEG = -__builtin_inff();
#pragma unroll
        for (int r = 0; r < 16; ++r) { p0[r] = NEG; p1[r] = NEG; } return; }
    p0 = f32x16{}; p1 = f32x16{};
    const char* kb[4];
#pragma unroll
    for (int dd = 0; dd < 4; ++dd) kb[dd] = K_lds + KB * SHM_K + KSWZ(r32, (dd * 16 + hi * 8) * 2);
#pragma unroll
    for (int d0 = 0; d0 < 8; ++d0) { const char* a = kb[d0 & 3] + (d0 >> 2) * 128;
        bf16x8 b0 = *reinterpret_cast<const bf16x8*>(a);
        bf16x8 b1 = *reinterpret_cast<const bf16x8*>(a + 32 * 256);
        p0 = __builtin_amdgcn_mfma_f32_32x32x16_bf16(b0, qr[d0], p0, 0, 0, 0);
        p1 = __builtin_amdgcn_mfma_f32_32x32x16_bf16(b1, qr[d0], p1, 0, 0, 0); }
}
template <int VB, bool SK>
__device__ __forceinline__ void pv_tile(f32x16* o, int vb0, bf16x8 pa0, bf16x8 pa1, bf16x8 pa2, bf16x8 pa3, bool act) {
    if (SK && !act) return;
#define TRRD(dst, off) asm volatile("ds_read_b64_tr_b16 %0, %1 offset:%2" : "=&v"(dst) : "v"(vb0), "i"(off) : "memory")
#define PV_D0(d0) do { s16x4 l0, l1, l2, l3, h0, h1, h2, h3; constexpr int b_ = VB * SHM_V + v_rd_off(d0, 0, 0);     \
        TRRD(l0, b_); TRRD(h0, b_ + 2048); TRRD(l1, b_ + 4096); TRRD(h1, b_ + 6144); TRRD(l2, b_ + 8192); TRRD(h2, b_ + 10240); TRRD(l3, b_ + 12288); TRRD(h3, b_ + 14336); \
        asm volatile("s_waitcnt lgkmcnt(0)" ::: "memory"); SBAR();                 \
        o[d0] = __builtin_amdgcn_mfma_f32_32x32x16_bf16(pa0, (bf16x8){l0[0], l0[1], l0[2], l0[3], h0[0], h0[1], h0[2], h0[3]}, o[d0], 0, 0, 0);   \
        o[d0] = __builtin_amdgcn_mfma_f32_32x32x16_bf16(pa1, (bf16x8){l1[0], l1[1], l1[2], l1[3], h1[0], h1[1], h1[2], h1[3]}, o[d0], 0, 0, 0);   \
        o[d0] = __builtin_amdgcn_mfma_f32_32x32x16_bf16(pa2, (bf16x8){l2[0], l2[1], l2[2], l2[3], h2[0], h2[1], h2[2], h2[3]}, o[d0], 0, 0, 0);   \
        o[d0] = __builtin_amdgcn_mfma_f32_32x32x16_bf16(pa3, (bf16x8){l3[0], l3[1], l3[2], l3[3], h3[0], h3[1], h3[2], h3[3]}, o[d0], 0, 0, 0); } while (0)
    PV_D0(0); PV_D0(1); PV_D0(2); PV_D0(3);
#undef PV_D0
#undef TRRD
}

struct BlockRef { const bf16* Q; const bf16* K; const bf16* V; bf16* O; float* LSE; int QS, KS, OS, LS, P0, skv, W; };
struct Seam { bf16x8 qr[8]; bf16x8 st_v0, st_v1, st_k0, st_k1; };
__device__ __forceinline__ int swa_jlo(int P0, int W) { const int lowk = P0 - W + 1; return lowk > 0 ? lowk / KVBLK : 0; }
#define LD8(p) (*reinterpret_cast<const bf16x8*>(p))
#define ROW(p, k0, rr, RS) ((p) + (size_t)((k0) + (rr)) * (RS) + sc)
#define VMW() asm volatile("s_waitcnt vmcnt(0)" ::: "memory")
#define VMWN(n) asm volatile("s_waitcnt vmcnt(%0)" :: "i"(n) : "memory")
#define SLOAD_H(Kp, Vp, k0, RS) do { const char* kb_ = (const char*)(Kp) + (size_t)(k0) * (size_t)(RS) * 2; const char* vb_ = (const char*)(Vp) + (size_t)(k0) * (size_t)(RS) * 2;  \
                         const unsigned oa_ = (unsigned)(sr * (RS) + sc) * 2u, ob_ = oa_ + (unsigned)(RS) * 64u;                                    \
                         S.st_v0 = LD8(vb_ + oa_); S.st_v1 = LD8(vb_ + ob_); S.st_k0 = LD8(kb_ + oa_); S.st_k1 = LD8(kb_ + ob_); } while (0)
#define SWRITE_HK(bf) do { *(bf16x8*)(K_lds + (bf) * SHM_K + kws) = S.st_k0; *(bf16x8*)(K_lds + (bf) * SHM_K + kws + 32 * 256) = S.st_k1; } while (0)
#define SWRITE_HV(bf) do { *(bf16x8*)(V_lds + (bf) * SHM_V + vst0) = S.st_v0; *(bf16x8*)(V_lds + (bf) * SHM_V + vst1) = S.st_v1; } while (0)
#define SWRITE_H(bf) do { SWRITE_HV(bf); SWRITE_HK(bf); } while (0)
__device__ __forceinline__ void swa_prime(const BlockRef& cur, char* lds, Seam& S) {
    int tid_ = threadIdx.x; asm volatile("" : "+v"(tid_));
    const int tid = tid_, wid = __builtin_amdgcn_readfirstlane(tid >> 6), lane = tid & 63, r32 = lane & 31, hi = lane >> 5;
    const int sr = tid >> 4, sc = (tid & 15) * 8, kws = KSWZ(sr, sc * 2); char* K_lds = lds + 2 * SHM_V;
    const int kb0 = swa_jlo(cur.P0, cur.W) * KVBLK;
    { const char* qb_ = (const char*)cur.Q + (size_t)(wid * QBLK) * (size_t)cur.QS * 2; const unsigned qo_ = (unsigned)(r32 * cur.QS + hi * 8) * 2u;
      for (int d0 = 0; d0 < 8; ++d0) S.qr[d0] = LD8(qb_ + qo_ + d0 * 32); }
    SLOAD_H(cur.K, cur.V, kb0, cur.KS); VMW(); SWRITE_HK(0);
    __syncthreads();
}
__device__ __forceinline__ void swa_block(const BlockRef& cur, const BlockRef& nxt, char* lds, Seam& S) {
    int tid_ = threadIdx.x; asm volatile("" : "+v"(tid_));
    const int tid = tid_, wid = __builtin_amdgcn_readfirstlane(tid >> 6), lane = tid & 63, r32 = lane & 31, hi = lane >> 5;
    const int W = cur.W, skv = cur.skv;
    const int j_lo = swa_jlo(cur.P0, W);
    int j_hi = (cur.P0 + QB - 1) / KVBLK + 1; if (j_hi > skv / KVBLK) j_hi = skv / KVBLK;
    const int NT = j_hi - j_lo;
    const int kbn = swa_jlo(nxt.P0, nxt.W) * KVBLK;
    const int qlo = cur.P0 + wid * QBLK, qm = qlo + r32 - 4 * hi;
    char* V_lds = lds; char* K_lds = lds + 2 * SHM_V;
    float* ws = (float*)(lds + 2 * SHM_V + 2 * SHM_K) + wid * 64; float* li_l = ws, * al_l = ws + 32;
    float m_reg = -1e30f, l_reg = 0; f32x16 o[4] = {};
    const int sr = tid >> 4, sc = (tid & 15) * 8, vst0 = v_st(sr, sc), vst1 = v_st(32 + sr, sc), kws = KSWZ(sr, sc * 2);
    const int vb0 = (int)(uintptr_t)V_lds + v_rd_base(lane);
    const bf16* Kh = cur.K; const bf16* Vh = cur.V; const int KSc = cur.KS;
#define RESC(a) do { if (__any((a) < 1.f)) { if (hi == 0) al_l[r32] = (a); asm volatile("s_waitcnt lgkmcnt(0)" ::: "memory");              \
                     for (int d_ = 0; d_ < 4; ++d_) for (int r = 0; r < 16; ++r) o[d_][r] *= al_l[crow(r, hi)]; } } while (0)
#define KBASE(t) ((j_lo + (t)) * KVBLK)
#define ACT(t) (KBASE(t) <= qlo + QBLK - 1 && KBASE(t) + KVBLK - 1 >= qlo - W + 1)
#define MASKT(P0_, P1_, t) do { const int kb_ = KBASE(t); if ((!SK || ACT(t)) && (kb_ + KVBLK - 1 > qlo || kb_ <= qlo + QBLK - 1 - W)) mask_tile(P0_, P1_, qm - kb_, (unsigned)W); } while (0)
    constexpr int NQL = 8;
    constexpr bool SK = true;
#define SEAM_K0() do { VMWN(NQL); SWRITE_HK(0); SBAR(); } while (0)
    f32x16 pA0, pA1, pB0, pB1; float mnA, mnB, alA, alB; bf16x8 pa0, pa1, pa2, pa3;
    SWRITE_HV(0); SBAR();
    if (NT > 1) { SLOAD_H(Kh, Vh, KBASE(1), KSc); }
    SBAR(); qkt<0, SK>(pA0, pA1, K_lds, r32, hi, S.qr, ACT(0));
    MASKT(pA0, pA1, 0); partialSM(pA0, pA1, m_reg, mnA, alA);
    if (NT > 1) { VMW(); SWRITE_H(1); }
    __syncthreads();
#define HALF_STEP(PX0, PX1, mnX, alX, PY0, PY1, alY, t, KB, VB, SB) do {                                                      \
        SBAR(); qkt<KB, SK>(PX0, PX1, K_lds, r32, hi, S.qr, ACT(t));                                             \
        finishSM(PY0, PY1, alY, l_reg, pa0, pa1, pa2, pa3); SBAR();                                                           \
        if ((t) + 1 < NT) { SLOAD_H(Kh, Vh, KBASE((t) + 1), KSc); SBAR(); }                                               \
        pv_tile<VB, SK>(o, vb0, pa0, pa1, pa2, pa3, ACT((t) - 1)); MASKT(PX0, PX1, (t)); partialSM(PX0, PX1, m_reg, mnX, alX);                                        \
        __syncthreads();                                                                                                      \
        if ((t) + 1 < NT) { VMW(); SWRITE_H(SB); }                                                                          \
        RESC(alX); __syncthreads(); } while (0)
    for (int t = 1; t + 1 < NT; t += 2) {
        HALF_STEP(pB0, pB1, mnB, alB, pA0, pA1, alA, t, 1, 0, 0);
        HALF_STEP(pA0, pA1, mnA, alA, pB0, pB1, alB, t + 1, 0, 1, 1);
    }
    const bool even = (NT & 1) == 0;
    if (even) { SBAR(); qkt<1, SK>(pB0, pB1, K_lds, r32, hi, S.qr, ACT(NT - 1)); SBAR(); }
    { SLOAD_H(nxt.K, nxt.V, kbn, nxt.KS); SBAR();
      const char* qb_ = (const char*)nxt.Q + (size_t)(wid * QBLK) * (size_t)nxt.QS * 2; const unsigned qo_ = (unsigned)(r32 * nxt.QS + hi * 8) * 2u;
#pragma unroll
        for (int d0 = 0; d0 < 8; ++d0) S.qr[d0] = LD8(qb_ + qo_ + d0 * 32); }
    SBAR();
    finishSM(pA0, pA1, alA, l_reg, pa0, pa1, pa2, pa3); SBAR();
    pv_tile<0, SK>(o, vb0, pa0, pa1, pa2, pa3, ACT(even ? NT - 2 : NT - 1));
    if (even) { MASKT(pB0, pB1, NT - 1); partialSM(pB0, pB1, m_reg, mnB, alB); __syncthreads(); RESC(alB);
        finishSM(pB0, pB1, alB, l_reg, pa0, pa1, pa2, pa3); SBAR(); pv_tile<1, SK>(o, vb0, pa0, pa1, pa2, pa3, ACT(NT - 1)); }
    SBAR(); SEAM_K0();
    if (hi == 0) li_l[r32] = l_reg; asm volatile("s_waitcnt lgkmcnt(0)" ::: "memory");
    if (cur.LSE != nullptr && hi == 0) cur.LSE[(size_t)(wid * QBLK + r32) * cur.LS] = __log2f(l_reg) + m_reg * (1.4426950408889634f * SCALE);
    float rli[16];
#pragma unroll
    for (int r = 0; r < 16; ++r) rli[r] = __builtin_amdgcn_rcpf(li_l[crow(r, hi)]);
    bf16* Ow = cur.O + (size_t)(wid * QBLK) * cur.OS;
#pragma unroll
    for (int r = 0; r < 16; ++r) { const int orow = crow(r, hi);
#pragma unroll
        for (int d0 = 0; d0 < 4; ++d0) { const float v = o[d0][r] * rli[r];
            const float vn = __shfl_xor(v, 1);
            if ((r32 & 1) == 0) *(unsigned*)(Ow + (size_t)orow * cur.OS + d0 * 32 + r32) = cvtpk(v, vn); } }
    __syncthreads();
#undef RESC
#undef KBASE
#undef ACT
#undef MASKT
#undef SEAM_K0
#undef HALF_STEP
}
#undef LD8
#undef ROW
#undef VMW
#undef VMWN
#undef SLOAD_H
#undef SWRITE_HK
#undef SWRITE_HV
#undef SWRITE_H
#undef KSWZ
#undef SBAR
}

constexpr int NWAVES = 8;
#ifndef MK_N_LAUNCHES
#define MK_N_LAUNCHES 1
#endif
constexpr int N_PHASES = 13;
constexpr float W8_SCALE = 32.0f, H8_SCALE = 8.0f;
constexpr int SC_ONE = 0x7f7f7f7f, SC_W8 = 0x7a7a7a7a  , SC_H8 = 0x7c7c7c7c  ;
#ifndef NAIVE_ATTN
#define NAIVE_ATTN 0
#endif
constexpr float ATT_QSCALE = NAIVE_ATTN ? QSCALE : 1.0f;

constexpr size_t MiB = 1u << 20;
constexpr size_t WS_CTL = 0, CTL_ZERO_BYTES = 1 * MiB;
constexpr size_t WS_WIN = 2 * MiB;
constexpr size_t WS_WB = 24 * MiB;
constexpr size_t WS_WO = 27 * MiB;
constexpr size_t WS_WMEM = WS_WIN + (size_t)9984 * 1024 * 2;
constexpr size_t WS_W1 = 29 * MiB;
constexpr size_t WS_W2 = 157 * MiB;
constexpr size_t WS_XN = 221 * MiB;
constexpr size_t WS_Z = 256 * MiB;
constexpr size_t WS_RW = 568 * MiB;
constexpr size_t WS_YS = 792 * MiB;
constexpr size_t WS_YABC = 824 * MiB;
constexpr size_t WS_MRG = 872 * MiB;
constexpr size_t WS_MRGB = 936 * MiB;
constexpr size_t WS_MEMN = WS_XN + (size_t)16384 * 1024 * 2;
constexpr size_t WS_KVM = 969 * MiB;
constexpr size_t WS_XN2 = 970 * MiB;
constexpr size_t WS_ROUTE = 1002 * MiB;
constexpr size_t WS_LORA = 1004 * MiB;
constexpr size_t WS_END = 1005 * MiB;
constexpr size_t WS_XS = 256 * MiB;
constexpr size_t WS_HACT = 400 * MiB;
constexpr size_t WS_YROWS = 544 * MiB;
constexpr size_t WS_OP = WS_MRG;
constexpr size_t WS_LSE = WS_MRGB;
constexpr size_t WS_CS = WS_RW;
constexpr size_t WS_VMIX = WS_RW + 32 * MiB, WS_GMIX = WS_RW + 64 * MiB;
constexpr size_t WS_XN8 = WS_YS, WS_WIN8 = WS_YS + 16 * MiB;
constexpr size_t RWSZ = (size_t)MTOK * RW * 4;
constexpr size_t RT_TOPI = 0, RT_TOPG = 256 * 1024, RT_POS = 512 * 1024, RT_ROWGATE = 768 * 1024;
static_assert(RT_ROWGATE + (size_t)MAX_SLOTS * 4 <= 1088 * 1024, "route");
constexpr int CW_TMO = 0, CW_CODE = 1;
constexpr int CW_BAR = 4096;
constexpr int CW_CNT = 16384;
constexpr int CW_CUR = 16384 + 2048;

constexpr int RING_OFF = 0, RING_BYTES = 131072;
constexpr int LDSCTL_OFF = 143360, MISC_OFF = LDSCTL_OFF + 320;
constexpr int MOETAB_OFF = MISC_OFF + 128;
constexpr int HIST_OFF = MOETAB_OFF + 1536;
constexpr int LDS_BYTES = 147456;
static_assert(HIST_OFF + 4 * 320 <= LDS_BYTES, "LDS map");
#define GAS __attribute__((address_space(1)))
#define LAS __attribute__((address_space(3)))
typedef unsigned short bf16;
typedef unsigned v4u __attribute__((ext_vector_type(4)));
typedef float f32x4 __attribute__((ext_vector_type(4)));
typedef short bf16x8 __attribute__((ext_vector_type(8)));
typedef GAS unsigned gu32;
typedef GAS unsigned long long gu64;
#define RLX_AGENT __ATOMIC_RELAXED, __HIP_MEMORY_SCOPE_AGENT
#define LDS_WAIT() asm volatile("s_waitcnt lgkmcnt(0)" ::: "memory")
#define VM_WAIT() asm volatile("s_waitcnt vmcnt(0)" ::: "memory")
__device__ __forceinline__ unsigned long long rt() { return __builtin_amdgcn_s_memrealtime(); }
typedef float f32x2_cv __attribute__((ext_vector_type(2))); typedef __bf16 bf16x2_cv __attribute__((ext_vector_type(2)));
__device__ __forceinline__ unsigned pk2(float lo, float hi) { f32x2_cv v = {lo, hi}; bf16x2_cv b = __builtin_convertvector(v, bf16x2_cv); return __builtin_bit_cast(unsigned, b); }
__device__ __forceinline__ unsigned f2bf(float f) { return pk2(f, f) & 0xffffu; }
#define XB_TMO      128
#define XB_XCNT(j)  (256  + 64 * (j))
#define XB_XSUB(j)  (1280 + 64 * (j))
#define XB_XGEN(j)  (2304 + 64 * (j))
#define XB_TOP      3328
#define XB_TOPGEN   3392
#define XCD_BAR_WORDS 3456
#define XB_SPIN_CAP (1u << 18)

__device__ __forceinline__ unsigned xb_ld(unsigned* p)              { return __hip_atomic_load(p, __ATOMIC_RELAXED, __HIP_MEMORY_SCOPE_AGENT); }
__device__ __forceinline__ unsigned xb_add(unsigned* p, unsigned v) { return __hip_atomic_fetch_add(p, v, __ATOMIC_RELAXED, __HIP_MEMORY_SCOPE_AGENT); }
__device__ __forceinline__ unsigned xb_xcc_id() { return (unsigned)__builtin_amdgcn_s_getreg((3 << 11) | 20) & 0xFu; }
#define XB_SPIN(cond, bar) do { unsigned _sp = 0; while (cond) { __builtin_amdgcn_s_sleep(1); \
    if ((++_sp & 255u) == 0u) { if (xb_ld(&(bar)[XB_TMO])) break; if (_sp > XB_SPIN_CAP) { atomicAdd(&(bar)[XB_TMO], 1u); break; } } } } while (0)

struct XcdBarrier {
    unsigned* bar; unsigned x;
    volatile LAS unsigned* st;
};

__device__ __forceinline__ XcdBarrier xcd_barrier_post(unsigned* bar, volatile LAS unsigned* st) {
    XcdBarrier b; b.bar = bar; b.x = xb_xcc_id(); b.st = st;
    if (threadIdx.x == 0) (void)xb_add(&bar[XB_XCNT(b.x)], 1u);
    return b;
}
__device__ __forceinline__ void xcd_barrier_complete(unsigned* bar, unsigned x, unsigned& nloc, unsigned& nx) {
    const unsigned G = gridDim.x * gridDim.y * gridDim.z;
    unsigned sum, cnt, mine, sp = 0u;
    for (;;) {
        sum = 0u; cnt = 0u; mine = 0u;
#pragma unroll
        for (unsigned j = 0; j < 16; ++j) { const unsigned c = xb_ld(&bar[XB_XCNT(j)]); sum += c; cnt += (c > 0u) ? 1u : 0u; mine = (j == x) ? c : mine; }
        if (sum == G) break;
        __builtin_amdgcn_s_sleep(1);
        if ((++sp & 255u) == 0u) { if (xb_ld(&bar[XB_TMO])) break; if (sp > XB_SPIN_CAP) { atomicAdd(&bar[XB_TMO], 1u); break; } }
    }
    nloc = mine > 0u ? mine : 1u; nx = cnt > 0u ? cnt : 1u;
}

__device__ __forceinline__ void xcd_barrier(const XcdBarrier& b) {
    asm volatile("s_waitcnt vmcnt(0)" ::: "memory");
    __syncthreads();
    if (threadIdx.x == 0) {
        unsigned* bar = b.bar;
        __builtin_amdgcn_s_waitcnt(0);
        unsigned nloc = b.st[0], nx = b.st[1];
        if (nloc == 0u) { xcd_barrier_complete(bar, b.x, nloc, nx); b.st[0] = nloc; b.st[1] = nx; }
        const unsigned old = xb_add(&bar[XB_XSUB(b.x)], 1u);
        const unsigned gen = old / nloc;
        if (old + 1u == (gen + 1u) * nloc) {
            __builtin_amdgcn_fence(__ATOMIC_RELEASE, "agent");
            asm volatile("s_waitcnt vmcnt(0)" ::: "memory");
            const unsigned og = xb_add(&bar[XB_TOP], 1u);
            const unsigned tg = og / nx;
            if (og + 1u == (tg + 1u) * nx) xb_add(&bar[XB_TOPGEN], 1u);
            else XB_SPIN(xb_ld(&bar[XB_TOPGEN]) == tg, bar);
            __builtin_amdgcn_fence(__ATOMIC_ACQUIRE, "agent");
            xb_add(&bar[XB_XGEN(b.x)], 1u);
            asm volatile("s_waitcnt vmcnt(0)" ::: "memory");
        } else {
            XB_SPIN(xb_ld(&bar[XB_XGEN(b.x)]) == gen, bar);
            __builtin_amdgcn_fence(__ATOMIC_ACQUIRE, "agent");
            asm volatile("s_waitcnt vmcnt(0)" ::: "memory");
        }
    }
    __syncthreads();
}

typedef float f32x2 __attribute__((ext_vector_type(2)));
struct Args { const float* in[32]; float* out; unsigned char* ws; int ph_lo, ph_hi, use_bar, pad; };
struct Frame {
    LAS unsigned char* lds;
    volatile LAS unsigned* MISC;
    gu32* ctl;
    int tid, lane, wave;
    int vcu, G;
    float* out;
    unsigned char* ws;
};
enum { I_X = 0, I_MEM, I_POS, I_NORM_MIX, I_W_IN, I_B_GATE, I_AQ_GAIN, I_AK_GAIN, I_R_MU, I_R_W0, I_R_W2, I_R_A0, I_R_A2, I_R_G2, I_R_KK, I_R_KA, I_R_RK, I_R_LNW, I_R_LNB,
       I_MEM_NORM, I_W_MEMKV, I_CQ_GAIN, I_CK_GAIN, I_W_BRANCH, I_W_OUT, I_NORM_FFN, I_ROUTER_W, I_ROUTER_B, I_EXP_W1, I_EXP_B1, I_EXP_W2, I_EXP_B2 };

__device__ __forceinline__ bool phase_enter(Frame& F, bool on) { int t = (int)threadIdx.x; asm volatile("" : "+v"(t)); F.tid = t; F.lane = t & 63; F.wave = __builtin_amdgcn_readfirstlane(t >> 6); return on; }
__device__ __forceinline__ const float* ldarg(int i) {
    const __attribute__((address_space(4))) char* ka = (const __attribute__((address_space(4))) char*)__builtin_amdgcn_kernarg_segment_ptr();
    asm volatile("" : "+s"(ka));
    return *(const float* const __attribute__((address_space(4)))*)(ka + 8 * i);
}
__device__ __forceinline__ unsigned pk4_fp8(float a, float b, float c, float d) { unsigned w = 0; w = __builtin_amdgcn_cvt_pk_fp8_f32(a, b, w, false); w = __builtin_amdgcn_cvt_pk_fp8_f32(c, d, w, true); return w; }
__device__ __forceinline__ float fast_sigm(float x) { return __builtin_amdgcn_rcpf(1.0f + __builtin_amdgcn_exp2f(-1.4426950408889634f * x)); }
__device__ __forceinline__ float fast_tanh(float x) { return 1.0f - 2.0f * __builtin_amdgcn_rcpf(1.0f + __builtin_amdgcn_exp2f(2.8853900817779268f * x)); }
__device__ __forceinline__ float fast_softplus(float y) { return fmaxf(y, 0.f) + 0.6931471805599453f * __builtin_amdgcn_logf(1.0f + __builtin_amdgcn_exp2f(-1.4426950408889634f * fabsf(y))); }
__device__ __forceinline__ int opq(int x) { asm volatile("" : "+v"(x)); return x; }
__device__ __forceinline__ float bf_lo(unsigned w) { return __builtin_bit_cast(float, w << 16); }
__device__ __forceinline__ float bf_hi(unsigned w) { return __builtin_bit_cast(float, w & 0xffff0000u); }
__device__ __forceinline__ float sigm(float x) { return 1.0f / (1.0f + __expf(-x)); }
template <int CTRL, int RM> __device__ __forceinline__ float dpp0(float v) {
    return __builtin_bit_cast(float, __builtin_amdgcn_update_dpp(0, __builtin_bit_cast(int, v), CTRL, RM, 0xf, true)); }
__device__ __forceinline__ float row16_sum(float v) {
    v += dpp0<0xB1, 0xf>(v); v += dpp0<0x4E, 0xf>(v); v += dpp0<0x141, 0xf>(v); v += dpp0<0x140, 0xf>(v); return v; }
__device__ __forceinline__ float rdlane(float v, int l) { return __builtin_bit_cast(float, __builtin_amdgcn_readlane(__builtin_bit_cast(int, v), l)); }
__device__ __forceinline__ float wave_sum(float v) {
    v = row16_sum(v); v += dpp0<0x142, 0xA>(v); v += dpp0<0x143, 0xC>(v); return rdlane(v, 63); }
__device__ __forceinline__ void half_sums(float v, float& lo, float& hi) {
    v = row16_sum(v); v += dpp0<0x142, 0xA>(v); lo = rdlane(v, 31); hi = rdlane(v, 63); }
__device__ __forceinline__ float wave_max_bp(float v) {
#pragma unroll
    for (int o = 1; o < 64; o <<= 1) v = fmaxf(v, __shfl_xor(v, o));
    return v; }

__device__ __forceinline__ void tconv_tile(const float* W, int K, int N, bf16* WT, int k0, int n0, int rowbase, int lane, int kd = 0) {
    const int c = lane & 15, q = lane >> 4;
    const GAS f32x4* src = (const GAS f32x4*)(W + (size_t)(k0 + 16 * q) * N + n0 + 4 * c);
    const size_t rs = (size_t)N / 4;
    f32x4 v[16];
#pragma unroll
    for (int i = 0; i < 16; ++i) v[i] = src[i * rs];
#pragma unroll
    for (int j = 0; j < 4; ++j) {
        GAS v4u* dst = (GAS v4u*)(WT + (size_t)(rowbase + 4 * c + j) * K + kd + k0 + 16 * q);
        v4u o0, o1;
        o0.x = pk2(v[0][j], v[1][j]); o0.y = pk2(v[2][j], v[3][j]); o0.z = pk2(v[4][j], v[5][j]); o0.w = pk2(v[6][j], v[7][j]);
        o1.x = pk2(v[8][j], v[9][j]); o1.y = pk2(v[10][j], v[11][j]); o1.z = pk2(v[12][j], v[13][j]); o1.w = pk2(v[14][j], v[15][j]);
        dst[0] = o0; dst[1] = o1;
    }
}
__device__ __forceinline__ void tconv_tile128(const float* W, int K, int N, bf16* WT, int k0, int n0, int rowbase, int lane) {
    const int c = lane & 31, q = lane >> 5;
    const GAS f32x4* src = (const GAS f32x4*)(W + (size_t)(k0 + 32 * q) * N + n0 + 4 * c);
    const size_t rs = (size_t)N / 4;
    f32x4 v[32];
#pragma unroll
    for (int i = 0; i < 32; ++i) v[i] = src[i * rs];
#pragma unroll
    for (int j = 0; j < 4; ++j) {
        GAS v4u* dst = (GAS v4u*)(WT + (size_t)(rowbase + 4 * c + j) * K + k0 + 32 * q);
#pragma unroll
        for (int g = 0; g < 4; ++g) { v4u o; o.x = pk2(v[8 * g][j], v[8 * g + 1][j]); o.y = pk2(v[8 * g + 2][j], v[8 * g + 3][j]); o.z = pk2(v[8 * g + 4][j], v[8 * g + 5][j]); o.w = pk2(v[8 * g + 6][j], v[8 * g + 7][j]); dst[g] = o; }
    }
}
__device__ __forceinline__ void tconv_tile_f8(const float* W, int K, int N, unsigned char* WT, int k0, int n0, int rowbase, int lane, float sc) {
    const int c = lane & 15, q = lane >> 4;
    const GAS f32x4* src = (const GAS f32x4*)(W + (size_t)(k0 + 16 * q) * N + n0 + 4 * c);
    const size_t rs = (size_t)N / 4;
    f32x4 v[16];
#pragma unroll
    for (int i = 0; i < 16; ++i) v[i] = src[i * rs] * sc;
#pragma unroll
    for (int j = 0; j < 4; ++j) {
        v4u o; o.x = pk4_fp8(v[0][j], v[1][j], v[2][j], v[3][j]); o.y = pk4_fp8(v[4][j], v[5][j], v[6][j], v[7][j]); o.z = pk4_fp8(v[8][j], v[9][j], v[10][j], v[11][j]); o.w = pk4_fp8(v[12][j], v[13][j], v[14][j], v[15][j]);
        *(GAS v4u*)(WT + (size_t)(rowbase + 4 * c + j) * K + k0 + 16 * q) = o;
    }
}
__device__ __forceinline__ void tc8_load(const float* W, int N, int k0, int n0, int lane, f32x4 (&v)[16]) {
    const int c = lane & 15, q = lane >> 4; const GAS f32x4* src = (const GAS f32x4*)(W + (size_t)(k0 + 16 * q) * N + n0 + 4 * c); const size_t rs = (size_t)N / 4;
#pragma unroll
    for (int i = 0; i < 16; ++i) v[i] = src[i * rs];
}
__device__ __forceinline__ void tc8_store(unsigned char* WT, int K, int k0, int rowbase, int lane, const f32x4 (&v)[16], float sc) {
    const int c = lane & 15, q = lane >> 4;
#pragma unroll
    for (int j = 0; j < 4; ++j) {
        v4u o; o.x = pk4_fp8(v[0][j] * sc, v[1][j] * sc, v[2][j] * sc, v[3][j] * sc); o.y = pk4_fp8(v[4][j] * sc, v[5][j] * sc, v[6][j] * sc, v[7][j] * sc);
        o.z = pk4_fp8(v[8][j] * sc, v[9][j] * sc, v[10][j] * sc, v[11][j] * sc); o.w = pk4_fp8(v[12][j] * sc, v[13][j] * sc, v[14][j] * sc, v[15][j] * sc);
        *(GAS v4u*)(WT + (size_t)(rowbase + 4 * c + j) * K + k0 + 16 * q) = o; }
}
__device__ __forceinline__ void w1_tile(int r, const float* W1, unsigned char* W1T, const float*& W, unsigned char*& WT, int& k0, int& n0, int& rowbase) {
    const int e = r / 512, q = r % 512, kb = q % 16, nb = q / 16; n0 = 64 * nb; k0 = 64 * kb;
    rowbase = (n0 < 1024) ? ((n0 >> 7) * 256 + (n0 & 127)) : ((((n0 - 1024) >> 7) * 256) + 128 + ((n0 - 1024) & 127));
    W = W1 + (size_t)e * 1024 * 2048; WT = W1T + (size_t)e * 2048 * 1024;
}
__device__ __forceinline__ void rms_row_to_bf16(const float* xrow, const float* gain, bf16* orow, int lane, unsigned char* orow8 = nullptr) {
    const GAS f32x4* xr = (const GAS f32x4*)xrow + lane; const GAS f32x4* gr = (const GAS f32x4*)gain + lane;
    f32x4 v[4]; float s = 0.f;
#pragma unroll
    for (int j = 0; j < 4; ++j) { v[j] = xr[64 * j]; s += (v[j].x * v[j].x + v[j].y * v[j].y) + (v[j].z * v[j].z + v[j].w * v[j].w); }
    const float rstd = 1.0f / sqrtf(wave_sum(s) * (1.f / D_MODEL) + NORM_EPS);
    GAS unsigned long long* o8 = (GAS unsigned long long*)orow + lane;
#pragma unroll
    for (int j = 0; j < 4; ++j) { const f32x4 g = gr[64 * j];
        o8[64 * j] = (unsigned long long)pk2(v[j].x * rstd * g.x, v[j].y * rstd * g.y) | ((unsigned long long)pk2(v[j].z * rstd * g.z, v[j].w * rstd * g.w) << 32);
        if (orow8) ((GAS unsigned*)orow8 + lane)[64 * j] = pk4_fp8(v[j].x * rstd * g.x, v[j].y * rstd * g.y, v[j].z * rstd * g.z, v[j].w * rstd * g.w); }
}
template <int PART> __device__ __forceinline__ void p0_prologue(Frame& F, const Args& args, int gw, int NGW) {
    const int lane = F.lane;
    unsigned char* ws = F.ws;
    constexpr int T_IN = 16 * 156, T_WB = 3 * 128, T_WO = 256, T_WM = 256, T_W1 = 32 * 512, T_W2 = 32 * 256, T_LO = 32;
    constexpr int NT = T_IN + T_WB + T_WO + T_WM + T_W1 + T_W2;
    constexpr int IT0 = (PART == 0) ? 0 : (PART == 1) ? T_IN + T_WB + T_WO + T_WM + T_W1 : T_IN + T_WB + T_WO + T_WM, IT1 = (PART == 0) ? T_IN + T_WB + T_WO + T_WM : (PART == 1) ? NT : T_IN + T_WB + T_WO + T_WM + T_W1;
    for (int it = IT0 + gw; it < IT1; it += NGW) {
        int r = it;
        if (r < T_IN) { const int kb = r / 156, nb = r % 156, nt = nb >> 2;
            if (nt >= 27) tconv_tile_f8(ldarg(I_W_IN), 1024, IN_COLS, ws + WS_WIN8, 64 * kb, 64 * nb, 64 * nb, lane, W8_SCALE);
            else tconv_tile(ldarg(I_W_IN), 1024, IN_COLS, (bf16*)(ws + WS_WIN), 64 * kb, 64 * nb, 64 * nb, lane);
            continue; } r -= T_IN;
        if (r < T_WB) { const int b = r / 128, q = r % 128, kb = q / 16, nb = q % 16;
            tconv_tile(ldarg(I_W_BRANCH) + (size_t)b * 512 * 1024, 1536, 1024, (bf16*)(ws + WS_WB), 64 * kb, 64 * nb, 64 * nb, lane, 512 * b); continue; } r -= T_WB;
        if (r < T_WO) { const int kb = r / 16, nb = r % 16; tconv_tile(ldarg(I_W_OUT), 1024, 1024, (bf16*)(ws + WS_WO), 64 * kb, 64 * nb, 64 * nb, lane); continue; } r -= T_WO;
        if (r < T_WM) { const int kb = r / 16, nb = r % 16; tconv_tile(ldarg(I_W_MEMKV), 1024, 1024, (bf16*)(ws + WS_WMEM), 64 * kb, 64 * nb, 64 * nb, lane); continue; } r -= T_WM;
        if (r < T_W1) { const int e = r / 512, q = r % 512, kb = q % 16, nb = q / 16, n0 = 64 * nb;
            const int rowbase = (n0 < 1024) ? ((n0 >> 7) * 256 + (n0 & 127)) : ((((n0 - 1024) >> 7) * 256) + 128 + ((n0 - 1024) & 127));
            tconv_tile_f8(ldarg(I_EXP_W1) + (size_t)e * 1024 * 2048, 1024, 2048, ws + WS_W1 + (size_t)e * 2048 * 1024, 64 * kb, n0, rowbase, lane, W8_SCALE); continue; } r -= T_W1;
        { const int e = r / 256, q = r % 256, kb = q % 16, nb = q / 16;
            tconv_tile_f8(ldarg(I_EXP_W2) + (size_t)e * 1024 * 1024, 1024, 1024, ws + WS_W2 + (size_t)e * 1024 * 1024, 64 * kb, 64 * nb, 64 * nb, lane, W8_SCALE); }
    }
    if (PART == 0) {
    for (int it = gw; it < T_LO; it += NGW) {
        bf16* L = (bf16*)(ws + WS_LORA);
        if (it < 8) tconv_tile(ldarg(I_R_W2), 64, 512, L, 0, 64 * it, 64 * it, lane);
        else if (it < 16) tconv_tile(ldarg(I_R_A2), 64, 512, L + 512 * 64, 0, 64 * (it - 8), 64 * (it - 8), lane);
        else { const int q = it - 16; tconv_tile(ldarg(I_R_G2), 128, 512, L + 2 * 512 * 64, 64 * (q >> 3), 64 * (q & 7), 64 * (q & 7), lane); } }
    { const int* posp = (const int*)ldarg(I_POS); float* cs = (float*)(ws + WS_CS);
      for (int idx = gw * 64 + lane; idx < MTOK * 16; idx += NGW * 64) { const int m = idx >> 4, i = idx & 15; const float ang = (float)posp[m] * exp2f(-(float)i * (18.931568569324174f / 16.0f)); const float sn = sinf(ang), cn = cosf(ang);
          f32x2 o; o.x = cn; o.y = sn; *(GAS f32x2*)(cs + (size_t)idx * 2) = o; } }
    for (int m = gw; m < MTOK; m += NGW) rms_row_to_bf16(ldarg(I_X) + (size_t)m * D_MODEL, ldarg(I_NORM_MIX), (bf16*)(ws + WS_XN) + (size_t)m * D_MODEL, lane, ws + WS_XN8 + (size_t)m * D_MODEL);
    for (int m = gw; m < MEMROWS; m += NGW) rms_row_to_bf16(ldarg(I_MEM) + (size_t)m * D_MODEL, ldarg(I_MEM_NORM), (bf16*)(ws + WS_MEMN) + (size_t)m * D_MODEL, lane);
    }
}

__device__ __forceinline__ void head_norm(bf16* p, const float* gain, bool rot, float c0, float s0, float c1, float s1, float scale, int lane) {
    GAS unsigned* pw = (GAS unsigned*)p + lane;
    const unsigned w = *pw; float a = bf_lo(w), b = bf_hi(w);
    const float ss = wave_sum(a * a + b * b);
    const float rstd = 1.0f / sqrtf(ss * (1.f / 128.f) + NORM_EPS);
    const f32x2 g = *((const GAS f32x2*)gain + lane);
    a = a * rstd * g.x; b = b * rstd * g.y;
    const float pa = __shfl_xor(a, 8), pb = __shfl_xor(b, 8);
    if (rot && lane < 16) {
        if (lane < 8) { a = a * c0 - pa * s0; b = b * c1 - pb * s1; }
        else          { a = a * c0 + pa * s0; b = b * c1 + pb * s1; }
    }
    *pw = pk2(a * scale, b * scale);
}
__device__ __forceinline__ void p2_prep(Frame& F, const Args& args) {
    const int gw = F.vcu * NWAVES + F.wave, NGW = F.G * NWAVES, lane = F.lane;
    unsigned char* ws = F.ws;
    bf16* Z = (bf16*)(ws + WS_Z);
    LAS float* lo = (LAS float*)(F.lds + RING_OFF + F.wave * 8192);
    const float* mu = ldarg(I_R_MU); const float* aqg = ldarg(I_AQ_GAIN); const float* akg = ldarg(I_AK_GAIN); const float* cqg = ldarg(I_CQ_GAIN); const int* posp = (const int*)ldarg(I_POS);
    float* Rr = (float*)(ws + WS_RW); float* Rw = Rr + (size_t)MTOK * RW; float* Rk = Rw + (size_t)MTOK * RW; float* Rv = Rk + (size_t)MTOK * RW;
    float* Ra = Rv + (size_t)MTOK * RW; float* Rb = Ra + (size_t)MTOK * RW; float* Rg = Rb + (size_t)MTOK * RW;
    for (int m = gw; m < MEMROWS; m += NGW)
        for (int hd = 0; hd < 4; ++hd) head_norm((bf16*)(ws + WS_KVM) + (size_t)m * 1024 + hd * 128, ldarg(I_CK_GAIN), false, 1.f, 0.f, 1.f, 0.f, 1.0f, lane);
}

__device__ __forceinline__ void lora_stage(const float* W, LAS unsigned* wl, int tid) {
#pragma unroll
    for (int i = 0; i < 16; ++i) { const int idx = tid + 512 * i; const f32x4 v = *((const GAS f32x4*)W + idx);
        *(LAS unsigned long long*)(wl + 2 * idx) = (unsigned long long)pk2(v.x, v.y) | ((unsigned long long)pk2(v.z, v.w) << 32); }
}
__device__ __forceinline__ void lora_mac(const LAS unsigned* wl, const LAS float* lo, float (&acc)[4][8], int lane) {
#pragma unroll 4
    for (int j = 0; j < 64; ++j) { const f32x4 xin = *(const LAS f32x4*)(lo + j * 4);
#pragma unroll
        for (int i = 0; i < 4; ++i) { const unsigned w = wl[j * 256 + lane + 64 * i]; const float w0 = bf_lo(w), w1 = bf_hi(w);
#pragma unroll
            for (int tt = 0; tt < 4; ++tt) { acc[tt][2 * i] += xin[tt] * w0; acc[tt][2 * i + 1] += xin[tt] * w1; } } }
}
template <int NL> __device__ __forceinline__ void lora_in(const bf16* Z, const float* mu, int ch, int m0, LAS float* lo, int lane) {
    const int col = OFF_R + 1536 + ch; const float muj = mu[1536 + ch];
    float prv = ((m0 % SEQ) == 0) ? 0.f : __builtin_bit_cast(float, (unsigned)Z[(size_t)(m0 - 1) * IN_COLS + col] << 16);
#pragma unroll
    for (int tt = 0; tt < 4; ++tt) { const float cur = __builtin_bit_cast(float, (unsigned)Z[(size_t)(m0 + tt) * IN_COLS + col] << 16);
        float x = cur + (prv - cur) * muj; prv = cur;
        x = (NL == 0) ? tanhf(x) : (NL == 1) ? x : sigm(x);
        lo[lane * 4 + tt] = x; }
    LDS_WAIT(); asm volatile("" ::: "memory");
}
__device__ __forceinline__ void p2_rwkv(Frame& F, const Args& args) {
    const int lane = F.lane, wave = F.wave;
    unsigned char* ws = F.ws;
    const bf16* Z = (const bf16*)(ws + WS_Z);
    LAS unsigned* wl = (LAS unsigned*)(F.lds + RING_OFF);
    LAS float* lo = (LAS float*)(F.lds + RING_OFF + 65536 + wave * 1024);
    const float* mu = ldarg(I_R_MU);
    float* Rr = (float*)(ws + WS_RW); float* Rw = Rr + (size_t)MTOK * RW; float* Rk = Rw + (size_t)MTOK * RW; float* Rv = Rk + (size_t)MTOK * RW;
    float* Ra = Rv + (size_t)MTOK * RW; float* Rb = Ra + (size_t)MTOK * RW; float* Rg = Rb + (size_t)MTOK * RW;
    for (int grp = F.vcu; grp < MTOK / 64; grp += F.G) {
        const int mw = grp * 64 + wave * 8;
        lora_stage(ldarg(I_R_W2), wl, F.tid);
        __syncthreads();
        for (int tk = 0; tk < 2; ++tk) { const int m0 = mw + 4 * tk;
            lora_in<0>(Z, mu, lane, m0, lo, lane);
            float acc[4][8];
#pragma unroll
            for (int tt = 0; tt < 4; ++tt)
#pragma unroll
                for (int c = 0; c < 8; ++c) acc[tt][c] = 0.f;
            lora_mac(wl, lo, acc, lane);
            const float* w0p = ldarg(I_R_W0);
#pragma unroll
            for (int i = 0; i < 4; ++i) { const int c = 2 * lane + 128 * i; const f32x2 w0 = *(const GAS f32x2*)(w0p + c);
#pragma unroll
                for (int tt = 0; tt < 4; ++tt) { const float y0 = -(w0.x + acc[tt][2 * i]), y1 = -(w0.y + acc[tt][2 * i + 1]);
                    const float sp0 = fmaxf(y0, 0.f) + log1pf(__expf(-fabsf(y0))), sp1 = fmaxf(y1, 0.f) + log1pf(__expf(-fabsf(y1)));
                    f32x2 wd; wd.x = -__expf(-sp0 - 0.5f); wd.y = -__expf(-sp1 - 0.5f);
                    *(GAS f32x2*)(Rw + (size_t)(m0 + tt) * RW + c) = wd; } }
            LDS_WAIT(); asm volatile("" ::: "memory"); }
        __syncthreads();
        lora_stage(ldarg(I_R_A2), wl, F.tid);
        __syncthreads();
        for (int tk = 0; tk < 2; ++tk) { const int m0 = mw + 4 * tk; const int tpos0 = m0 % SEQ;
            lora_in<1>(Z, mu, 64 + lane, m0, lo, lane);
            float acca[4][8];
#pragma unroll
            for (int tt = 0; tt < 4; ++tt)
#pragma unroll
                for (int c = 0; c < 8; ++c) acca[tt][c] = 0.f;
            lora_mac(wl, lo, acca, lane);
            const float* a0p = ldarg(I_R_A0); const float* kkp = ldarg(I_R_KK); const float* kap = ldarg(I_R_KA);
#pragma unroll
            for (int i = 0; i < 4; ++i) {
                const int c = 2 * lane + 128 * i;
                const f32x2 a0 = *(const GAS f32x2*)(a0p + c), kkc = *(const GAS f32x2*)(kkp + c), kac = *(const GAS f32x2*)(kap + c);
                const f32x2 mur = *(const GAS f32x2*)(mu + c), muk = *(const GAS f32x2*)(mu + 512 + c), muv = *(const GAS f32x2*)(mu + 1024 + c);
                unsigned pr = 0u, pk = 0u, pv = 0u;
                if (tpos0 != 0) { const bf16* zp = Z + (size_t)(m0 - 1) * IN_COLS + OFF_R + c; pr = *(const GAS unsigned*)zp; pk = *(const GAS unsigned*)(zp + 512); pv = *(const GAS unsigned*)(zp + 1024); }
#pragma unroll
                for (int tt = 0; tt < 4; ++tt) {
                    const size_t m = (size_t)(m0 + tt);
                    const bf16* zc = Z + m * IN_COLS + OFF_R + c;
                    const unsigned cr = *(const GAS unsigned*)zc, ck = *(const GAS unsigned*)(zc + 512), cv = *(const GAS unsigned*)(zc + 1024);
                    f32x2 r, k, v;
                    r.x = bf_lo(cr) + (bf_lo(pr) - bf_lo(cr)) * mur.x; r.y = bf_hi(cr) + (bf_hi(pr) - bf_hi(cr)) * mur.y;
                    k.x = bf_lo(ck) + (bf_lo(pk) - bf_lo(ck)) * muk.x; k.y = bf_hi(ck) + (bf_hi(pk) - bf_hi(ck)) * muk.y;
                    v.x = bf_lo(cv) + (bf_lo(pv) - bf_lo(cv)) * muv.x; v.y = bf_hi(cv) + (bf_hi(pv) - bf_hi(cv)) * muv.y;
                    pr = cr; pk = ck; pv = cv;
                    f32x2 av; av.x = sigm(a0.x + acca[tt][2 * i]); av.y = sigm(a0.y + acca[tt][2 * i + 1]);
                    f32x2 kk; kk.x = k.x * kkc.x; kk.y = k.y * kkc.y;
                    float slo, shi; half_sums(kk.x * kk.x + kk.y * kk.y, slo, shi);
                    const float nrm = fmaxf(sqrtf(lane < 32 ? slo : shi), 1e-12f), inv = 1.0f / nrm;
                    kk.x *= inv; kk.y *= inv;
                    f32x2 k2; k2.x = k.x * (1.0f + (av.x - 1.0f) * kac.x); k2.y = k.y * (1.0f + (av.y - 1.0f) * kac.y);
                    f32x2 as, bs; as.x = -kk.x; as.y = -kk.y; bs.x = kk.x * av.x; bs.y = kk.y * av.y;
                    const size_t o = m * RW + c;
                    *(GAS f32x2*)(Rr + o) = r; *(GAS f32x2*)(Rk + o) = k2; *(GAS f32x2*)(Rv + o) = v; *(GAS f32x2*)(Ra + o) = as; *(GAS f32x2*)(Rb + o) = bs;
                }
            }
            LDS_WAIT(); asm volatile("" ::: "memory"); }
        __syncthreads();
        float accg[2][4][8];
#pragma unroll
        for (int tk = 0; tk < 2; ++tk)
#pragma unroll
            for (int tt = 0; tt < 4; ++tt)
#pragma unroll
                for (int c = 0; c < 8; ++c) accg[tk][tt][c] = 0.f;
#pragma unroll
        for (int hh = 0; hh < 2; ++hh) {
            lora_stage(ldarg(I_R_G2) + (size_t)hh * 64 * RW, wl, F.tid);
            __syncthreads();
#pragma unroll
            for (int tk = 0; tk < 2; ++tk) { lora_in<2>(Z, mu, 128 + 64 * hh + lane, mw + 4 * tk, lo, lane); lora_mac(wl, lo, accg[tk], lane); LDS_WAIT(); asm volatile("" ::: "memory"); }
            __syncthreads();
        }
#pragma unroll
        for (int tk = 0; tk < 2; ++tk)
#pragma unroll
            for (int i = 0; i < 4; ++i)
#pragma unroll
                for (int tt = 0; tt < 4; ++tt) { f32x2 gg; gg.x = accg[tk][tt][2 * i]; gg.y = accg[tk][tt][2 * i + 1]; *(GAS f32x2*)(Rg + (size_t)(mw + 4 * tk + tt) * RW + 2 * lane + 128 * i) = gg; }
    }
}

__device__ __forceinline__ float qk_dot(const LAS float* q, const bf16* krow) {
    const GAS v4u* kp = (const GAS v4u*)krow; float s0 = 0.f, s1 = 0.f;
#pragma unroll
    for (int i = 0; i < 16; ++i) { const v4u w = kp[i]; const f32x4 qa = *(const LAS f32x4*)(q + 8 * i), qb = *(const LAS f32x4*)(q + 8 * i + 4);
        s0 += bf_lo(w.x) * qa[0] + bf_hi(w.x) * qa[1] + bf_lo(w.y) * qa[2] + bf_hi(w.y) * qa[3];
        s1 += bf_lo(w.z) * qb[0] + bf_hi(w.z) * qb[1] + bf_lo(w.w) * qb[2] + bf_hi(w.w) * qb[3]; }
    return s0 + s1;
}
__device__ __forceinline__ void p3_attention(Frame& F) {
    const int gw = F.vcu * NWAVES + F.wave, NGW = F.G * NWAVES, lane = F.lane;
    unsigned char* ws = F.ws;
    const bf16* Z = (const bf16*)(ws + WS_Z);
    const bf16* KV = (const bf16*)(ws + WS_KVM);
    bf16* YA = (bf16*)(ws + WS_YABC); bf16* YC = YA + (size_t)2 * MTOK * 512;
    LAS float* qs = (LAS float*)(F.lds + RING_OFF + F.wave * 8192);
    for (int task = gw; task < MTOK * 4; task += NGW) {
        const int m = task >> 2, h = task & 3, t = m % SEQ;
        const bf16* zrow = Z + (size_t)m * IN_COLS;
#pragma unroll
        for (int g = 0; g < 3; ++g) { const unsigned w = *((const GAS unsigned*)(zrow + OFF_AQ + g * 512 + h * 128) + lane); qs[g * 128 + 2 * lane] = bf_lo(w); qs[g * 128 + 2 * lane + 1] = bf_hi(w); }
        LDS_WAIT(); asm volatile("" ::: "memory");
        float sc[3][3]; float mx = -INFINITY;
#pragma unroll
        for (int g = 0; g < 3; ++g) { const int dl = (g == 0) ? 1 : (g == 1) ? 4 : 16;
#pragma unroll
            for (int p = 0; p < 3; ++p) { const int j = lane + 64 * p; const int tk = t - dl * j; float s = -INFINITY;
                if (j <= 128 && tk >= 0) s = qk_dot(qs + g * 128, zrow - (size_t)dl * j * IN_COLS + OFF_AK + g * 512 + h * 128);
                sc[g][p] = s; mx = fmaxf(mx, s); } }
        mx = wave_max_bp(mx);
        float den = 0.f;
#pragma unroll
        for (int g = 0; g < 3; ++g)
#pragma unroll
            for (int p = 0; p < 3; ++p) { sc[g][p] = exp2f(sc[g][p] - mx); den += sc[g][p]; }
        den = wave_sum(den);
        float o0 = 0.f, o1 = 0.f;
#pragma unroll
        for (int g = 0; g < 3; ++g) { const int dl = (g == 0) ? 1 : (g == 1) ? 4 : 16; const bf16* vb = zrow + OFF_AV + g * 512 + h * 128 + 2 * lane;
#pragma unroll
            for (int p = 0; p < 3; ++p) { const int nj = (p < 2) ? 64 : 1;
                for (int jj = 0; jj < nj; ++jj) { const int j = jj + 64 * p; const float pj = rdlane(sc[g][p], jj);
                    if (t - dl * j >= 0) { const unsigned w = *(const GAS unsigned*)(vb - (size_t)dl * j * IN_COLS); o0 += pj * bf_lo(w); o1 += pj * bf_hi(w); } } } }
        const float inv = 1.0f / den;
        *((GAS unsigned*)(YA + (size_t)m * 512 + h * 128) + lane) = pk2(o0 * inv, o1 * inv);
        asm volatile("" ::: "memory");
    }
    for (int task = gw; task < MTOK * 4; task += NGW) {
        const int m = task >> 2, h = task & 3, b = m / SEQ;
        const bf16* zrow = Z + (size_t)m * IN_COLS;
        { const unsigned w = *((const GAS unsigned*)(zrow + OFF_CQ + h * 128) + lane); qs[2 * lane] = bf_lo(w); qs[2 * lane + 1] = bf_hi(w); }
        LDS_WAIT(); asm volatile("" ::: "memory");
        const bf16* kb = KV + (size_t)b * MEM_LEN * 1024 + h * 128;
        float sc[4]; float mx = -INFINITY;
#pragma unroll
        for (int p = 0; p < 4; ++p) { sc[p] = qk_dot(qs, kb + (size_t)(lane + 64 * p) * 1024); mx = fmaxf(mx, sc[p]); }
        mx = wave_max_bp(mx);
        float den = 0.f;
#pragma unroll
        for (int p = 0; p < 4; ++p) { sc[p] = exp2f(sc[p] - mx); den += sc[p]; }
        den = wave_sum(den);
        float o0 = 0.f, o1 = 0.f; const bf16* vb = kb + 512 + 2 * lane;
#pragma unroll
        for (int p = 0; p < 4; ++p)
            for (int jj = 0; jj < 64; ++jj) { const float pj = rdlane(sc[p], jj); const unsigned w = *(const GAS unsigned*)(vb + (size_t)(jj + 64 * p) * 1024); o0 += pj * bf_lo(w); o1 += pj * bf_hi(w); }
        const float inv = 1.0f / den;
        *((GAS unsigned*)(YC + (size_t)m * 512 + h * 128) + lane) = pk2(o0 * inv, o1 * inv);
        asm volatile("" ::: "memory");
    }
}

__device__ __forceinline__ void p5_post(Frame& F, const Args& args) {
    const int gw = F.vcu * NWAVES + F.wave, NGW = F.G * NWAVES, lane = F.lane;
    unsigned char* ws = F.ws;
    const float* Rr = (const float*)(ws + WS_RW); const float* Rk = Rr + (size_t)2 * MTOK * RW; const float* Rv = Rk + (size_t)MTOK * RW; const float* Rg = Rr + (size_t)6 * MTOK * RW;
    const float* YS = (const float*)(ws + WS_YS);
    bf16* YB = (bf16*)(ws + WS_YABC) + (size_t)MTOK * 512;
    const bf16* OP = (const bf16*)(ws + WS_OP); const float* LS = (const float*)(ws + WS_LSE); bf16* YA = (bf16*)(ws + WS_YABC);
    for (int m = gw; m < MTOK; m += NGW) {
        float l0[4], l1[4], l2[4]; unsigned pa[4], pb[4], pc[4];
#pragma unroll
        for (int h = 0; h < 4; ++h) { l0[h] = LS[(size_t)m * 4 + h]; l1[h] = LS[(size_t)MTOK * 4 + (size_t)m * 4 + h]; l2[h] = LS[(size_t)2 * MTOK * 4 + (size_t)m * 4 + h];
            const size_t o = (size_t)m * 512 + h * 128;
            pa[h] = *((const GAS unsigned*)(OP + o) + lane); pb[h] = *((const GAS unsigned*)(OP + (size_t)MTOK * 512 + o) + lane); pc[h] = *((const GAS unsigned*)(OP + (size_t)2 * MTOK * 512 + o) + lane); }
#pragma unroll
        for (int h = 0; h < 4; ++h) {
            const float mx = fmaxf(l0[h], fmaxf(l1[h], l2[h])); const float w0 = exp2f(l0[h] - mx), w1 = exp2f(l1[h] - mx), w2 = exp2f(l2[h] - mx); const float inv = __builtin_amdgcn_rcpf(w0 + w1 + w2);
            *((GAS unsigned*)(YA + (size_t)m * 1536 + h * 128) + lane) = pk2((w0 * bf_lo(pa[h]) + w1 * bf_lo(pb[h]) + w2 * bf_lo(pc[h])) * inv, (w0 * bf_hi(pa[h]) + w1 * bf_hi(pb[h]) + w2 * bf_hi(pc[h])) * inv); }
    }
}

__device__ __forceinline__ void p8_router(Frame& F, const Args& args) {
    const int lane = F.lane, wave = F.wave;
    unsigned char* ws = F.ws;
    const float* X1 = F.out;
    LAS int* hist = (LAS int*)(F.lds + HIST_OFF);
    { const int t_ = opq(F.tid); if (t_ < 32) hist[t_] = 0; }
    int* topi = (int*)(ws + WS_ROUTE + RT_TOPI); float* topg = (float*)(ws + WS_ROUTE + RT_TOPG);
    const float* RWt = ldarg(I_ROUTER_W); const float* RB = ldarg(I_ROUTER_B); const float* gain = ldarg(I_NORM_FFN);
    LAS float* rw = (LAS float*)(F.lds + RING_OFF);
    typedef float f32x16r __attribute__((ext_vector_type(16)));
    for (int grp = F.vcu; grp < MTOK / 64; grp += F.G) {
#pragma unroll
        for (int i = 0; i < 16; ++i) { const int f = F.tid + 512 * i, k = f >> 3; const f32x4 w = *((const GAS f32x4*)RWt + f); const float g = gain[k]; ((LAS f32x4*)rw)[f] = w * g; }
        __syncthreads();
        const int tile = wave >> 2, wq = wave & 3, i32 = lane & 31, h = lane >> 5;
        const GAS f32x4* xp = (const GAS f32x4*)(X1 + ((size_t)grp * 64 + tile * 32 + i32) * D_MODEL + wq * 256 + 4 * h);
        const LAS float* bp = rw + (wq * 256 + 4 * h) * 32 + i32;
        f32x16r acc;
#pragma unroll
        for (int r = 0; r < 16; ++r) acc[r] = 0.f;
        float ss = 0.f;
#pragma unroll 4
        for (int q = 0; q < 32; ++q) { const f32x4 xv = xp[2 * q]; ss += (xv.x * xv.x + xv.y * xv.y) + (xv.z * xv.z + xv.w * xv.w);
#pragma unroll
            for (int j = 0; j < 4; ++j) acc = __builtin_amdgcn_mfma_f32_32x32x2f32(xv[j], bp[(8 * q + j) * 32], acc, 0, 0, 0); }
        __syncthreads();
        { LAS float* part = rw + (tile * 4 + wq) * 1024;
#pragma unroll
          for (int r = 0; r < 16; ++r) part[((r & 3) + 8 * (r >> 2) + 4 * h) * 32 + i32] = acc[r];
          rw[8192 + (tile * 4 + wq) * 64 + lane] = ss; }
        __syncthreads();
        if (F.tid < 64) { const int t = F.tid, tl = t >> 5, row = t & 31; const size_t m = (size_t)grp * 64 + t;
            float s = 0.f;
#pragma unroll
            for (int q = 0; q < 4; ++q) s += rw[8192 + (tl * 4 + q) * 64 + row] + rw[8192 + (tl * 4 + q) * 64 + 32 + row];
            const float rstd = 1.0f / sqrtf(s * (1.f / D_MODEL) + NORM_EPS);
            float lg[32];
#pragma unroll
            for (int e = 0; e < 32; ++e) { const LAS float* pp = rw + (tl * 4) * 1024 + row * 32 + e; lg[e] = ((pp[0] + pp[1024]) + (pp[2048] + pp[3072])) * rstd + RB[e]; }
            int ti[4]; float tv[4];
#pragma unroll
            for (int k = 0; k < 4; ++k) { float best = -INFINITY; int bi = 0;
#pragma unroll
                for (int e = 0; e < 32; ++e) { const bool taken = (k > 0 && ti[0] == e) || (k > 1 && ti[1] == e) || (k > 2 && ti[2] == e); if (!taken && lg[e] > best) { best = lg[e]; bi = e; } }
                ti[k] = bi; tv[k] = best; }
            const float e1 = __expf(tv[1] - tv[0]), e2 = __expf(tv[2] - tv[0]), e3 = __expf(tv[3] - tv[0]); const float inv = 1.0f / (1.0f + e1 + e2 + e3);
            { typedef int i32x4 __attribute__((ext_vector_type(4))); *(GAS i32x4*)(topi + m * 4) = (i32x4){ti[0], ti[1], ti[2], ti[3]}; } *(GAS f32x4*)(topg + m * 4) = (f32x4){inv, e1 * inv, e2 * inv, e3 * inv};
#pragma unroll
            for (int k = 0; k < 4; ++k) __hip_atomic_fetch_add(hist + ti[k], 1, __ATOMIC_RELAXED, __HIP_MEMORY_SCOPE_WORKGROUP); }
        __syncthreads();
    }
    { const int t_ = opq(F.tid); if (t_ < 32 && hist[t_] != 0) __hip_atomic_fetch_add((unsigned*)(F.ctl + CW_CNT) + 64 * t_, (unsigned)hist[t_], __ATOMIC_RELAXED, __HIP_MEMORY_SCOPE_AGENT); }
}
__device__ __forceinline__ void moe_table(Frame& F) {
    LAS int* tab = (LAS int*)(F.lds + MOETAB_OFF);
    __syncthreads();
    if (F.tid == 0) { int acc = 0;
        for (int e = 0; e < N_EXPERTS; ++e) { const int c = (int)__hip_atomic_load((unsigned*)(F.ctl + CW_CNT) + 64 * e, __ATOMIC_RELAXED, __HIP_MEMORY_SCOPE_AGENT); const int nb = (c + MOE_ROWS - 1) / MOE_ROWS;
            tab[320 + e] = acc * MOE_ROWS; for (int q = 0; q < nb; ++q) tab[1 + acc + q] = e; acc += nb; }
        tab[0] = acc; }
    __syncthreads();
}
__device__ __forceinline__ void p9_dispatch(Frame& F, const Args& args) {
    const int lane = F.lane;
    unsigned char* ws = F.ws;
    moe_table(F);
    const LAS int* tab = (const LAS int*)(F.lds + MOETAB_OFF);
    LAS int* hist = (LAS int*)(F.lds + HIST_OFF); LAS int* base = hist + 32; LAS int* slots = hist + 64;
    const int* topi = (const int*)(ws + WS_ROUTE + RT_TOPI); const float* topg = (const float*)(ws + WS_ROUTE + RT_TOPG);
    int* pos = (int*)(ws + WS_ROUTE + RT_POS); float* rowgate = (float*)(ws + WS_ROUTE + RT_ROWGATE);
    bf16* XS = (bf16*)(ws + WS_XS); const float* gain = ldarg(I_NORM_FFN);
    for (int grp = F.vcu; grp < MTOK / 64; grp += F.G) {
        const int t_ = opq(F.tid);
        if (t_ < 32) hist[t_] = 0;
        __syncthreads();
        int e = 0, rank = 0;
        if (F.tid < 256) { e = topi[(size_t)grp * 256 + F.tid]; rank = __hip_atomic_fetch_add(hist + e, 1, __ATOMIC_RELAXED, __HIP_MEMORY_SCOPE_WORKGROUP); }
        __syncthreads();
        if (F.tid < 32) { const int h = hist[F.tid]; int b0 = 0; if (h != 0) b0 = (int)__hip_atomic_fetch_add((unsigned*)(F.ctl + CW_CUR) + 64 * F.tid, (unsigned)h, __ATOMIC_RELAXED, __HIP_MEMORY_SCOPE_AGENT); base[F.tid] = tab[320 + F.tid] + b0; }
        __syncthreads();
        if (F.tid < 256) { const int slot = base[e] + rank; pos[(size_t)grp * 256 + F.tid] = slot; rowgate[slot] = topg[(size_t)grp * 256 + F.tid]; slots[F.tid] = slot; }
        __syncthreads();
        { f32x4 v[8][4];
#pragma unroll
          for (int i = 0; i < 8; ++i) { const GAS f32x4* xr = (const GAS f32x4*)(F.out + ((size_t)grp * 64 + F.wave * 8 + i) * D_MODEL) + 2 * lane;
#pragma unroll
              for (int j = 0; j < 4; ++j) v[i][j] = xr[128 * (j >> 1) + (j & 1)]; }
          const GAS f32x4* gr = (const GAS f32x4*)gain + 2 * lane; const f32x4 g00 = gr[0], g01 = gr[1], g10 = gr[128], g11 = gr[129];
#pragma unroll
          for (int i = 0; i < 8; ++i) { const int tl = F.wave * 8 + i;
              float s = 0.f;
#pragma unroll
              for (int j = 0; j < 4; ++j) s += (v[i][j].x * v[i][j].x + v[i][j].y * v[i][j].y) + (v[i][j].z * v[i][j].z + v[i][j].w * v[i][j].w);
              const float rstd = 1.0f / sqrtf(wave_sum(s) * (1.f / D_MODEL) + NORM_EPS);
              unsigned long long o[2];
              { const f32x4 a = v[i][0] * rstd * g00, b = v[i][1] * rstd * g01; o[0] = (unsigned long long)pk4_fp8(a.x, a.y, a.z, a.w) | ((unsigned long long)pk4_fp8(b.x, b.y, b.z, b.w) << 32); }
              { const f32x4 a = v[i][2] * rstd * g10, b = v[i][3] * rstd * g11; o[1] = (unsigned long long)pk4_fp8(a.x, a.y, a.z, a.w) | ((unsigned long long)pk4_fp8(b.x, b.y, b.z, b.w) << 32); }
#pragma unroll
              for (int k = 0; k < 4; ++k) { const int sk = slots[tl * 4 + k]; GAS unsigned long long* dst = (GAS unsigned long long*)((unsigned char*)XS + (size_t)sk * D_MODEL) + lane; dst[0] = o[0]; dst[64] = o[1]; } } }
        __syncthreads();
    }
}
__device__ __forceinline__ void p12_combine(Frame& F) {
    const int gw = F.vcu * NWAVES + F.wave, NGW = F.G * NWAVES, lane = F.lane;
    unsigned char* ws = F.ws;
    const int* pos = (const int*)(ws + WS_ROUTE + RT_POS); const bf16* YR = (const bf16*)(ws + WS_YROWS);
    for (int blk = gw; blk < MTOK / 8; blk += NGW) {
        const int m0 = blk * 8;
        int pk = 0; if (lane < 32) pk = pos[(size_t)m0 * 4 + lane];
#pragma unroll
        for (int tp = 0; tp < 4; ++tp) {
            f32x4 a[2][2], b[2][2]; unsigned long long w[2][2][4];
#pragma unroll
            for (int u = 0; u < 2; ++u) { const int t = 2 * tp + u; GAS f32x4* xo = (GAS f32x4*)(F.out + (size_t)(m0 + t) * D_MODEL) + 2 * lane;
#pragma unroll
                for (int hf = 0; hf < 2; ++hf) { a[u][hf] = xo[128 * hf]; b[u][hf] = xo[128 * hf + 1];
#pragma unroll
                    for (int k = 0; k < 4; ++k) { const int sk = __builtin_amdgcn_readlane(pk, 4 * t + k); w[u][hf][k] = *((const GAS unsigned long long*)((const unsigned char*)YR + (size_t)sk * D_MODEL + 512 * hf) + lane); } } }
#pragma unroll
            for (int u = 0; u < 2; ++u) { const int t = 2 * tp + u; GAS f32x4* xo = (GAS f32x4*)(F.out + (size_t)(m0 + t) * D_MODEL) + 2 * lane;
#pragma unroll
                for (int hf = 0; hf < 2; ++hf) { f32x4 aa = a[u][hf], bb = b[u][hf];
#pragma unroll
                    for (int k = 0; k < 4; ++k) { const unsigned lo_ = (unsigned)w[u][hf][k], hi_ = (unsigned)(w[u][hf][k] >> 32);
                        const f32x2 p0 = __builtin_amdgcn_cvt_pk_f32_fp8(lo_, false), p1 = __builtin_amdgcn_cvt_pk_f32_fp8(lo_, true), p2 = __builtin_amdgcn_cvt_pk_f32_fp8(hi_, false), p3 = __builtin_amdgcn_cvt_pk_f32_fp8(hi_, true);
                        aa[0] += p0.x * 0.0625f; aa[1] += p0.y * 0.0625f; aa[2] += p1.x * 0.0625f; aa[3] += p1.y * 0.0625f; bb[0] += p2.x * 0.0625f; bb[1] += p2.y * 0.0625f; bb[2] += p3.x * 0.0625f; bb[3] += p3.y * 0.0625f; }
                    xo[128 * hf] = aa; xo[128 * hf + 1] = bb; } }
        }
    }
}

constexpr int N_ATT_A = 768, N_ATT_C = 256;
__device__ __forceinline__ swa::BlockRef attn_item(unsigned char* ws, int it) {
    swa::BlockRef r;
    const swa::bf16* Z = (const swa::bf16*)(ws + WS_Z);
    if (it < N_ATT_A) {
        const int h = it & 3, b = (it >> 2) & 1, v = it >> 3;
        int g, rr, qb;
        if (v < 32) { g = 0; rr = 0; qb = v; } else if (v < 64) { g = 1; rr = (v - 32) >> 3; qb = (v - 32) & 7; } else { g = 2; rr = (v - 64) >> 1; qb = (v - 64) & 1; }
        const int d = (g == 0) ? 1 : (g == 1) ? 4 : 16;
        const size_t row0 = (size_t)b * SEQ + rr, qrow = row0 + (size_t)d * qb * 256;
        r.Q = Z + qrow * IN_COLS + OFF_AQ + g * 512 + h * 128; r.K = Z + row0 * IN_COLS + OFF_AK + g * 512 + h * 128; r.V = Z + row0 * IN_COLS + OFF_AV + g * 512 + h * 128;
        r.O = (swa::bf16*)(ws + WS_OP) + (size_t)g * MTOK * 512 + qrow * 512 + h * 128; r.LSE = (float*)(ws + WS_LSE) + (size_t)g * MTOK * 4 + qrow * 4 + h;
        r.QS = d * IN_COLS; r.KS = d * IN_COLS; r.OS = d * 512; r.LS = d * 4; r.P0 = qb * 256; r.skv = SEQ / d; r.W = 129;
    } else {
        const int u = it - N_ATT_A, h = u & 3, b = (u >> 2) & 1, qb = u >> 3;
        const size_t qrow = (size_t)b * SEQ + (size_t)qb * 256;
        const swa::bf16* KV = (const swa::bf16*)(ws + WS_KVM) + (size_t)b * MEM_LEN * 1024 + h * 128;
        r.Q = Z + qrow * IN_COLS + OFF_CQ + h * 128; r.K = KV; r.V = KV + 512;
        r.O = (swa::bf16*)(ws + WS_YABC) + qrow * 1536 + 1024 + h * 128; r.LSE = nullptr;
        r.QS = IN_COLS; r.KS = 1024; r.OS = 1536; r.LS = 0; r.P0 = 256; r.skv = MEM_LEN; r.W = 1 << 20;
    }
    return r;
}
__device__ __forceinline__ void p3_attention_mfma(unsigned char* ws, char* lds, int G) {
    const int total = N_ATT_A + N_ATT_C; int L = blockIdx.x; if (L >= total) return;
    swa::BlockRef cur = attn_item(ws, L); swa::Seam S;
    swa::swa_prime(cur, lds, S);
    for (;;) {
        const int Ln = L + G; const bool last = Ln >= total;
        const swa::BlockRef nxt = last ? cur : attn_item(ws, Ln);
        swa::swa_block(cur, nxt, lds, S);
        if (last) break;
        cur = nxt; L = Ln;
    }
}

constexpr int N_RITEMS = BATCH * 8 * (SEQ / 64);
constexpr size_t WS_PHI = WS_XN;
constexpr size_t WS_PSI = WS_XN + 16 * MiB;
constexpr size_t WS_GAM = WS_YS;
constexpr size_t WS_OM = WS_XN2;
constexpr size_t WS_XFR = WS_MRG + 48 * MiB;
constexpr size_t WS_BONUS = WS_MRGB + 1 * MiB;
constexpr int RB = 9216, RLD = 72;
constexpr int R1_SEG = 15 * RB, R1_WC = R1_SEG + 2048;
static_assert(R1_WC + 256 <= LDSCTL_OFF, "R1 LDS map");
typedef LAS unsigned short* lbf_t;
__device__ __forceinline__ f32x4 r1_tile(const LAS unsigned short* X, const LAS unsigned short* Yt, int mi, int ni, f32x4 acc, int fr, int fq) {
    const LAS unsigned short* xp = X + (16 * mi + fr) * RLD + 8 * fq; const LAS unsigned short* yp = Yt + (16 * ni + fr) * RLD + 8 * fq;
    const bf16x8 a0 = *(const LAS bf16x8*)xp, a1 = *(const LAS bf16x8*)(xp + 32), b0 = *(const LAS bf16x8*)yp, b1 = *(const LAS bf16x8*)(yp + 32);
    acc = __builtin_amdgcn_mfma_f32_16x16x32_bf16(b0, a0, acc, 0, 0, 0);
    acc = __builtin_amdgcn_mfma_f32_16x16x32_bf16(b1, a1, acc, 0, 0, 0);
    return acc;
}
__device__ __forceinline__ void r1_store(LAS unsigned short* dst, int mi, int ni, f32x4 acc, int mode, bool addI, const LAS unsigned short* addT, int fr, int fq) {
    const int m = 16 * mi + fr, n0 = 16 * ni + 4 * fq;
#pragma unroll
    for (int r = 0; r < 4; ++r) { const int n = n0 + r; bool keep = true;
        if (mode == 1) keep = n < m; else if (mode == 2) keep = n <= m; else if (mode == 3) keep = m < n;
        float v = keep ? acc[r] : 0.f; if (addI && m == n) v += 1.0f; acc[r] = v; }
    if (addT != nullptr) { const unsigned long long w = *(const LAS unsigned long long*)(addT + m * RLD + n0);
        acc[0] += bf_lo((unsigned)w); acc[1] += bf_hi((unsigned)w); acc[2] += bf_lo((unsigned)(w >> 32)); acc[3] += bf_hi((unsigned)(w >> 32)); }
    *(LAS unsigned long long*)(dst + m * RLD + n0) = (unsigned long long)pk2(acc[0], acc[1]) | ((unsigned long long)pk2(acc[2], acc[3]) << 32);
}
#define R1BUF(i) ((LAS unsigned short*)(F.lds + (i) * RB))
template <int MODE> __device__ __forceinline__ void p_r1(Frame& F, const Args& args) {
    unsigned char* ws = F.ws; const int lane0 = F.lane, wave = F.wave;
    const bf16* Z = (const bf16*)(ws + WS_Z);
    const float* rkp = ldarg(I_R_RK); const float* mu = ldarg(I_R_MU); const float* w0p = ldarg(I_R_W0); const float* a0p = ldarg(I_R_A0); const float* kkp = ldarg(I_R_KK); const float* kap = ldarg(I_R_KA);
    const float* w1src = ldarg(I_EXP_W1);
    const bf16* W2T = (const bf16*)(ws + WS_LORA); const bf16* A2T = W2T + 512 * 64; const bf16* G2T = A2T + 512 * 64;
    bf16* VM = (bf16*)(ws + WS_VMIX); bf16* GM = (bf16*)(ws + WS_GMIX);
    LAS float* segsum = (LAS float*)(F.lds + R1_SEG); LAS float* wcs = (LAS float*)(F.lds + R1_WC);
    unsigned short zv[7][9];
#define R1LOAD(it_) do { const int bh_ = (it_) >> 7, c_ = (it_) & 127, h_ = bh_ & 7, t0_ = c_ * 64 + 8 * wave; \
        const bf16* zp_ = Z + ((size_t)(bh_ >> 3) * SEQ + t0_) * IN_COLS + OFF_R + lane; \
        _Pragma("unroll") for (int i = 0; i < 9; ++i) { const bool ok_ = (i > 0) || (t0_ > 0); const bf16* rp_ = zp_ + ((long)i - 1) * IN_COLS; const bf16* rq_ = rp_ + 64 * h_;     \
            zv[0][i] = ok_ ? rp_[1536] : (unsigned short)0; zv[1][i] = ok_ ? rp_[1600] : (unsigned short)0; zv[2][i] = ok_ ? rp_[1664] : (unsigned short)0; zv[3][i] = ok_ ? rp_[1728] : (unsigned short)0; \
            zv[4][i] = ok_ ? rq_[0] : (unsigned short)0; zv[5][i] = ok_ ? rq_[512] : (unsigned short)0; zv[6][i] = ok_ ? rq_[1024] : (unsigned short)0; } } while (0)
#define ZF(x) __builtin_bit_cast(float, (unsigned)(x) << 16)
    { const int lane = lane0; if (F.vcu < N_RITEMS) R1LOAD(F.vcu); }
    for (int item = F.vcu; item < N_RITEMS; item += F.G) {
        const int lane = opq(lane0), fr = lane & 15, fq = lane >> 4;
        const int bh = item >> 7, c = item & 127, b = bh >> 3, h = bh & 7;
        const size_t row0 = (size_t)b * SEQ + (size_t)c * 64;
        f32x4 tcv[16]; const float* tcW; unsigned char* tcWT; int tck0, tcn0, tcrb;
        w1_tile(item * 8 + wave, w1src, ws + WS_W1, tcW, tcWT, tck0, tcn0, tcrb); tc8_load(tcW, 2048, tck0, tcn0, lane, tcv);
        const f32x4 zero4 = (f32x4){0.f, 0.f, 0.f, 0.f};
        const int mw = wave >> 2, nw = wave & 3;
        float r[8], lw[8], kx[8], vx[8], ax[8], bx[8];
        { const int k = lane, tq = wave, ch = h * 64 + k;
#pragma unroll
          for (int g = 0; g < 4; ++g) { const float mug = mu[1536 + 64 * g + k];
#pragma unroll
              for (int i = 0; i < 8; ++i) { const float cur = ZF(zv[g][i + 1]), prv = ZF(zv[g][i]); float x = cur + (prv - cur) * mug;
                  x = (g == 0) ? fast_tanh(x) : (g == 1) ? x : fast_sigm(x); const unsigned short xb = (unsigned short)f2bf(x); const int t = 8 * tq + i;
                  if (g == 0) R1BUF(11)[t * RLD + k] = xb; else if (g == 1) R1BUF(12)[t * RLD + k] = xb; else R1BUF(13)[t * 136 + 64 * (g - 2) + k] = xb; } }
          { const int tid_ = wave * 64 + lane, row = tid_ >> 3, chk = tid_ & 7;
            *(LAS v4u*)(R1BUF(5) + row * RLD + chk * 8) = *(const GAS v4u*)(W2T + (size_t)(64 * h + row) * 64 + chk * 8);
            *(LAS v4u*)(R1BUF(6) + row * RLD + chk * 8) = *(const GAS v4u*)(A2T + (size_t)(64 * h + row) * 64 + chk * 8);
#pragma unroll
            for (int hh = 0; hh < 2; ++hh) { const int rg = (tid_ >> 4) + 32 * hh, cg = tid_ & 15;
                *(LAS v4u*)(R1BUF(7) + rg * 136 + cg * 8) = *(const GAS v4u*)(G2T + (size_t)(64 * h + rg) * 128 + cg * 8); } }
          __syncthreads();
          { f32x4 dw0, dw1, da0, da1, dg0 = zero4, dg1 = zero4;
            { const LAS unsigned short* yp_ = R1BUF(5) + (16 * nw + fr) * RLD + 8 * fq; const LAS unsigned short* xp_ = R1BUF(11) + (16 * mw + fr) * RLD + 8 * fq;
              const bf16x8 y0_ = *(const LAS bf16x8*)yp_, y1_ = *(const LAS bf16x8*)(yp_ + 32), xa0_ = *(const LAS bf16x8*)xp_, xa1_ = *(const LAS bf16x8*)(xp_ + 32), xb0_ = *(const LAS bf16x8*)(xp_ + 32 * RLD), xb1_ = *(const LAS bf16x8*)(xp_ + 32 * RLD + 32);
              dw0 = __builtin_amdgcn_mfma_f32_16x16x32_bf16(y0_, xa0_, zero4, 0, 0, 0); dw1 = __builtin_amdgcn_mfma_f32_16x16x32_bf16(y0_, xb0_, zero4, 0, 0, 0);
              dw0 = __builtin_amdgcn_mfma_f32_16x16x32_bf16(y1_, xa1_, dw0, 0, 0, 0); dw1 = __builtin_amdgcn_mfma_f32_16x16x32_bf16(y1_, xb1_, dw1, 0, 0, 0); }
            { const LAS unsigned short* yp_ = R1BUF(6) + (16 * nw + fr) * RLD + 8 * fq; const LAS unsigned short* xp_ = R1BUF(12) + (16 * mw + fr) * RLD + 8 * fq;
              const bf16x8 y0_ = *(const LAS bf16x8*)yp_, y1_ = *(const LAS bf16x8*)(yp_ + 32), xa0_ = *(const LAS bf16x8*)xp_, xa1_ = *(const LAS bf16x8*)(xp_ + 32), xb0_ = *(const LAS bf16x8*)(xp_ + 32 * RLD), xb1_ = *(const LAS bf16x8*)(xp_ + 32 * RLD + 32);
              da0 = __builtin_amdgcn_mfma_f32_16x16x32_bf16(y0_, xa0_, zero4, 0, 0, 0); da1 = __builtin_amdgcn_mfma_f32_16x16x32_bf16(y0_, xb0_, zero4, 0, 0, 0);
              da0 = __builtin_amdgcn_mfma_f32_16x16x32_bf16(y1_, xa1_, da0, 0, 0, 0); da1 = __builtin_amdgcn_mfma_f32_16x16x32_bf16(y1_, xb1_, da1, 0, 0, 0); }
            { const LAS unsigned short* yp_ = R1BUF(7) + (16 * nw + fr) * 136 + 8 * fq; const LAS unsigned short* xp_ = R1BUF(13) + (16 * mw + fr) * 136 + 8 * fq;
#pragma unroll
              for (int kk = 0; kk < 4; ++kk) { const bf16x8 y_ = *(const LAS bf16x8*)(yp_ + 32 * kk), xa_ = *(const LAS bf16x8*)(xp_ + 32 * kk), xb_ = *(const LAS bf16x8*)(xp_ + 32 * 136 + 32 * kk);
                  dg0 = __builtin_amdgcn_mfma_f32_16x16x32_bf16(y_, xa_, dg0, 0, 0, 0); dg1 = __builtin_amdgcn_mfma_f32_16x16x32_bf16(y_, xb_, dg1, 0, 0, 0); } }
            const int o0 = (16 * mw + fr) * 68 + 16 * nw + 4 * fq, o1 = o0 + 32 * 68;
            *(LAS f32x4*)((LAS float*)R1BUF(0) + o0) = dw0; *(LAS f32x4*)((LAS float*)R1BUF(0) + o1) = dw1;
            *(LAS f32x4*)((LAS float*)R1BUF(2) + o0) = da0; *(LAS f32x4*)((LAS float*)R1BUF(2) + o1) = da1;
            *(LAS f32x4*)((LAS float*)R1BUF(9) + o0) = dg0; *(LAS f32x4*)((LAS float*)R1BUF(9) + o1) = dg1; }
          __syncthreads();
          { const float w0c = w0p[ch], a0c = a0p[ch], kkc = kkp[ch], kac = kap[ch], mur = mu[ch], muk = mu[512 + ch], muv = mu[1024 + ch];
#pragma unroll
            for (int i = 0; i < 8; ++i) { const int t = 8 * tq + i;
                const float dwv = ((const LAS float*)R1BUF(0))[t * 68 + k], dav = ((const LAS float*)R1BUF(2))[t * 68 + k], dgv = ((const LAS float*)R1BUF(9))[t * 68 + k];
                const float cr = ZF(zv[4][i + 1]), pr = ZF(zv[4][i]), ck = ZF(zv[5][i + 1]), pk = ZF(zv[5][i]), cv = ZF(zv[6][i + 1]), pv = ZF(zv[6][i]);
                const float rr = cr + (pr - cr) * mur, kr = ck + (pk - ck) * muk, vr = cv + (pv - cv) * muv;
                const float y = -(w0c + dwv); const float sp = fast_softplus(y);
                lw[i] = -__expf(-sp - 0.5f);
                const float av = fast_sigm(a0c + dav);
                const float kkv = kr * kkc; const float ssq = wave_sum(kkv * kkv); const float kkn = kkv * __builtin_amdgcn_rsqf(fmaxf(ssq, 1e-24f));
                r[i] = rr; vx[i] = vr; kx[i] = kr * (1.0f + (av - 1.0f) * kac); ax[i] = -kkn; bx[i] = kkn * av;
                if (MODE == 0) { VM[(row0 + t) * RW + ch] = (bf16)f2bf(vr); GM[(row0 + t) * RW + ch] = (bf16)f2bf(dgv); } } }
        }
        if (item + F.G < N_RITEMS) R1LOAD(item + F.G);
        { const int k = lane, tq = wave;
          float cs[8]; cs[0] = lw[0];
#pragma unroll
          for (int i = 1; i < 8; ++i) cs[i] = cs[i - 1] + lw[i];
          segsum[tq * 64 + k] = cs[7];
          const float rk = rkp[h * 64 + k];
#pragma unroll
          for (int i = 0; i < 8; ++i) { const float bs = wave_sum(r[i] * kx[i] * rk); if (MODE == 0 && lane == 0) *(GAS float*)((float*)(ws + WS_BONUS) + (row0 + 8 * tq + i) * 8 + h) = bs; }
          __syncthreads();
          float pre = 0.f;
#pragma unroll
          for (int q = 0; q < 7; ++q) { const float sv = segsum[q * 64 + k]; pre += (q < tq) ? sv : 0.f; }
          unsigned short at[8], rt[8], bt[8], kt[8], vt[8];
#pragma unroll
          for (int i = 0; i < 8; ++i) { const float L = pre + cs[i], Lp = L - lw[i]; const float e = __expf(L), ep = __expf(Lp), ei = __expf(-L);
              at[i] = (unsigned short)f2bf(ax[i] * ep); rt[i] = (unsigned short)f2bf(r[i] * e); bt[i] = (unsigned short)f2bf(bx[i] * ei); kt[i] = (unsigned short)f2bf(kx[i] * ei); vt[i] = (unsigned short)f2bf(vx[i]);
              if (i == 7 && tq == 7) wcs[k] = e; }
#pragma unroll
          for (int i = 0; i < 8; ++i) { const int o = (8 * tq + i) * RLD + k; R1BUF(8)[o] = at[i]; R1BUF(4)[o] = rt[i]; R1BUF(9)[o] = bt[i]; R1BUF(10)[o] = kt[i]; }
          const int ot = k * RLD + 8 * tq;
#define PK8(x) ((v4u){(unsigned)x[0] | ((unsigned)x[1] << 16), (unsigned)x[2] | ((unsigned)x[3] << 16), (unsigned)x[4] | ((unsigned)x[5] << 16), (unsigned)x[6] | ((unsigned)x[7] << 16)})
          *(LAS v4u*)(R1BUF(0) + ot) = PK8(at); *(LAS v4u*)(R1BUF(1) + ot) = PK8(bt); *(LAS v4u*)(R1BUF(2) + ot) = PK8(kt); *(LAS v4u*)(R1BUF(3) + ot) = PK8(vt);
#undef PK8
        }
        __syncthreads();
#define R1PAIR(X, Y, a0, a1) do { const LAS unsigned short* yp_ = (Y) + (16 * nw + fr) * RLD + 8 * fq; const LAS unsigned short* xp_ = (X) + (16 * mw + fr) * RLD + 8 * fq; \
            const bf16x8 y0_ = *(const LAS bf16x8*)yp_, y1_ = *(const LAS bf16x8*)(yp_ + 32), xa0_ = *(const LAS bf16x8*)xp_, xa1_ = *(const LAS bf16x8*)(xp_ + 32), xb0_ = *(const LAS bf16x8*)(xp_ + 32 * RLD), xb1_ = *(const LAS bf16x8*)(xp_ + 32 * RLD + 32); \
            a0 = __builtin_amdgcn_mfma_f32_16x16x32_bf16(y0_, xa0_, zero4, 0, 0, 0); a1 = __builtin_amdgcn_mfma_f32_16x16x32_bf16(y0_, xb0_, zero4, 0, 0, 0); \
            a0 = __builtin_amdgcn_mfma_f32_16x16x32_bf16(y1_, xa1_, a0, 0, 0, 0); a1 = __builtin_amdgcn_mfma_f32_16x16x32_bf16(y1_, xb1_, a1, 0, 0, 0); } while (0)
#define R1ST2(dst, a0, a1, mode, addI, addT) do { r1_store(dst, mw, nw, a0, mode, addI, addT, fr, fq); r1_store(dst, mw + 2, nw, a1, mode, addI, addT, fr, fq); } while (0)
        { f32x4 n0, n1, t0, t1, l0, l1, b0, b1, k0, k1;
          R1PAIR(R1BUF(8), R1BUF(9), n0, n1); R1PAIR(R1BUF(9), R1BUF(8), t0, t1); R1PAIR(R1BUF(8), R1BUF(10), l0, l1); R1PAIR(R1BUF(4), R1BUF(9), b0, b1); R1PAIR(R1BUF(4), R1BUF(10), k0, k1);
          R1ST2(R1BUF(11), n0, n1, 1, false, nullptr); R1ST2(R1BUF(13), n0, n1, 1, true, nullptr); R1ST2(R1BUF(12), t0, t1, 3, false, nullptr);
          R1ST2(R1BUF(5), l0, l1, 1, false, nullptr); R1ST2(R1BUF(6), b0, b1, 2, false, nullptr); R1ST2(R1BUF(7), k0, k1, 2, false, nullptr); }
        __syncthreads();
        { f32x4 n0, n1, t0, t1, e0, e1;
          R1PAIR(R1BUF(11), R1BUF(12), n0, n1); R1PAIR(R1BUF(12), R1BUF(11), t0, t1); R1PAIR(R1BUF(3), R1BUF(5), e0, e1);
          R1ST2(R1BUF(8), n0, n1, 0, false, nullptr); R1ST2(R1BUF(9), t0, t1, 0, false, nullptr); R1ST2(R1BUF(10), e0, e1, 0, false, nullptr); }
        __syncthreads();
#pragma unroll 1
        for (int lv = 0; lv < 5; ++lv) {
            const bool srcB = (lv & 1) == 0;
            LAS unsigned short* sN = srcB ? R1BUF(8) : R1BUF(11); LAS unsigned short* sNT = srcB ? R1BUF(9) : R1BUF(12);
            LAS unsigned short* dN = srcB ? R1BUF(11) : R1BUF(8); LAS unsigned short* dNT = srcB ? R1BUF(12) : R1BUF(9);
            LAS unsigned short* Tc = (lv & 1) ? R1BUF(14) : R1BUF(13); LAS unsigned short* Tn = (lv & 1) ? R1BUF(13) : R1BUF(14);
            f32x4 u0, u1, t0 = zero4, t1 = zero4, n0 = zero4, n1 = zero4;
            R1PAIR(Tc, sNT, u0, u1);
            if (lv < 4) R1PAIR(sNT, sN, t0, t1);
            if (lv < 3) R1PAIR(sN, sNT, n0, n1);
            R1ST2(Tn, u0, u1, 0, false, Tc);
            if (lv < 4) R1ST2(dNT, t0, t1, 0, false, nullptr);
            if (lv < 3) R1ST2(dN, n0, n1, 0, false, nullptr);
            __syncthreads();
        }
        { f32x4 g0, g1, q0, q1;
          R1PAIR(R1BUF(0), R1BUF(14), g0, g1); R1PAIR(R1BUF(10), R1BUF(14), q0, q1);
          R1ST2(R1BUF(11), g0, g1, 0, false, nullptr); R1ST2(R1BUF(12), q0, q1, 0, false, nullptr); }
        __syncthreads();
#undef R1PAIR
#undef R1ST2
        { const int mi = wave >> 1, ks = wave & 1;
          const f32x4 p0 = r1_tile(R1BUF(1), R1BUF(11), mi, 2 * ks, zero4, fr, fq), p1 = r1_tile(R1BUF(1), R1BUF(11), mi, 2 * ks + 1, zero4, fr, fq);
          const f32x4 s0 = r1_tile(R1BUF(6), R1BUF(11), mi, 2 * ks, zero4, fr, fq), s1 = r1_tile(R1BUF(6), R1BUF(11), mi, 2 * ks + 1, zero4, fr, fq);
          const int m = 16 * mi + fr; const float wc = wcs[m];
          float ph[8], ps[8];
#pragma unroll
          for (int r = 0; r < 4; ++r) { const int n0 = 32 * ks + 4 * fq + r, n1 = n0 + 16;
              ph[r] = (p0[r] + (m == n0 ? 1.f : 0.f)) * wc; ph[4 + r] = (p1[r] + (m == n1 ? 1.f : 0.f)) * wc; }
          { const unsigned long long w0 = *(const LAS unsigned long long*)(R1BUF(4) + m * RLD + 32 * ks + 4 * fq), w1 = *(const LAS unsigned long long*)(R1BUF(4) + m * RLD + 32 * ks + 16 + 4 * fq);
            ps[0] = s0[0] + bf_lo((unsigned)w0); ps[1] = s0[1] + bf_hi((unsigned)w0); ps[2] = s0[2] + bf_lo((unsigned)(w0 >> 32)); ps[3] = s0[3] + bf_hi((unsigned)(w0 >> 32));
            ps[4] = s1[0] + bf_lo((unsigned)w1); ps[5] = s1[1] + bf_hi((unsigned)w1); ps[6] = s1[2] + bf_lo((unsigned)(w1 >> 32)); ps[7] = s1[3] + bf_hi((unsigned)(w1 >> 32)); }
          const size_t fo = (((size_t)item * 4 + mi) * 2 + ks) * 64 + lane;
          if (MODE == 0) *((GAS v4u*)(ws + WS_PHI) + fo) = (v4u){pk2(ph[0], ph[1]), pk2(ph[2], ph[3]), pk2(ph[4], ph[5]), pk2(ph[6], ph[7])};
          if (MODE == 0) *((GAS v4u*)(ws + WS_PSI) + fo) = (v4u){pk2(ps[0], ps[1]), pk2(ps[2], ps[3]), pk2(ps[4], ps[5]), pk2(ps[6], ps[7])};
          const int vb = wave >> 1;
#pragma unroll
          for (int hh = 0; hh < 2; ++hh) { const int mt = 2 * (wave & 1) + hh;
              f32x4 ga = r1_tile(R1BUF(12), R1BUF(1), vb, mt, zero4, fr, fq); ga = r1_tile(R1BUF(3), R1BUF(2), vb, mt, ga, fr, fq);
              f32x4 om = r1_tile(R1BUF(12), R1BUF(6), vb, mt, zero4, fr, fq); om = r1_tile(R1BUF(3), R1BUF(7), vb, mt, om, fr, fq);
#pragma unroll
              for (int r = 0; r < 4; ++r) ga[r] *= wcs[16 * mt + 4 * fq + r];
              const size_t ao = (((size_t)item * 4 + vb) * 4 + mt) * 64 + lane;
              if (MODE == 0) { *((GAS f32x4*)(ws + WS_GAM) + ao) = ga; *((GAS f32x4*)(ws + WS_OM) + ao) = om; } else { asm volatile("" :: "v"(ga), "v"(om)); } }
        }
        tc8_store(tcWT, 1024, tck0, tcrb, lane, tcv, W8_SCALE);
        __syncthreads();
    }
}
#undef R1BUF
#undef R1LOAD
#undef ZF
struct R2Buf { bf16x8 ph[4][2]; f32x4 ga[4]; };
__device__ __forceinline__ void r2_load(R2Buf& B, const unsigned char* ws, int item, int vb, int lane) {
#pragma unroll
    for (int mt = 0; mt < 4; ++mt) {
#pragma unroll
        for (int ks = 0; ks < 2; ++ks) B.ph[mt][ks] = *((const GAS bf16x8*)(ws + WS_PHI) + (((size_t)item * 4 + mt) * 2 + ks) * 64 + lane);
        B.ga[mt] = *((const GAS f32x4*)(ws + WS_GAM) + (((size_t)item * 4 + vb) * 4 + mt) * 64 + lane); }
}
__device__ __forceinline__ void r2_step(const R2Buf& B, f32x4 (&acc)[4], unsigned char* ws, int item, int vb, int lane) {
    v4u x0, x1;
    x0.x = pk2(acc[0][0], acc[0][1]); x0.y = pk2(acc[0][2], acc[0][3]); x0.z = pk2(acc[1][0], acc[1][1]); x0.w = pk2(acc[1][2], acc[1][3]);
    x1.x = pk2(acc[2][0], acc[2][1]); x1.y = pk2(acc[2][2], acc[2][3]); x1.z = pk2(acc[3][0], acc[3][1]); x1.w = pk2(acc[3][2], acc[3][3]);
    GAS v4u* xo = (GAS v4u*)(ws + WS_XFR) + (((size_t)item * 4 + vb) * 2) * 64 + lane; xo[0] = x0; xo[64] = x1;
    const bf16x8 f0 = __builtin_bit_cast(bf16x8, x0), f1 = __builtin_bit_cast(bf16x8, x1);
#pragma unroll
    for (int mt = 0; mt < 4; ++mt) { f32x4 a = B.ga[mt];
        a = __builtin_amdgcn_mfma_f32_16x16x32_bf16(B.ph[mt][0], f0, a, 0, 0, 0);
        a = __builtin_amdgcn_mfma_f32_16x16x32_bf16(B.ph[mt][1], f1, a, 0, 0, 0);
        acc[mt] = a; }
}
__device__ __forceinline__ void p_r2(Frame& F) {
    if (blockIdx.x < BATCH * 8 * 4 && F.wave == 0) {
        unsigned char* ws = F.ws; const int bh = blockIdx.x >> 2, vb = blockIdx.x & 3, lane = F.lane;
        f32x4 acc[4];
#pragma unroll
        for (int i = 0; i < 4; ++i) acc[i] = (f32x4){0.f, 0.f, 0.f, 0.f};
        R2Buf A, B, C, D;
        const int it0 = bh * 128;
        r2_load(A, ws, it0, vb, lane); r2_load(B, ws, it0 + 1, vb, lane); r2_load(C, ws, it0 + 2, vb, lane);
#define R2SB() __builtin_amdgcn_sched_barrier(0)
#pragma unroll
        for (int c = 0; c < 128; c += 4) {
            r2_load(D, ws, it0 + c + 3, vb, lane); R2SB(); r2_step(A, acc, ws, it0 + c, vb, lane); R2SB();
            r2_load(A, ws, it0 + (c + 4 < 128 ? c + 4 : 127), vb, lane); R2SB(); r2_step(B, acc, ws, it0 + c + 1, vb, lane); R2SB();
            r2_load(B, ws, it0 + (c + 5 < 128 ? c + 5 : 127), vb, lane); R2SB(); r2_step(C, acc, ws, it0 + c + 2, vb, lane); R2SB();
            r2_load(C, ws, it0 + (c + 6 < 128 ? c + 6 : 127), vb, lane); R2SB(); r2_step(D, acc, ws, it0 + c + 3, vb, lane); R2SB();
        }
#undef R2SB
    }
}
__device__ __forceinline__ void p_r3(Frame& F, const Args& args) {
    const int gw = F.vcu * NWAVES + F.wave, NGW = F.G * NWAVES, lane = F.lane, cc = lane & 15, q = lane >> 4;
    unsigned char* ws = F.ws;
    const bf16* VM = (const bf16*)(ws + WS_VMIX); const bf16* GM = (const bf16*)(ws + WS_GMIX);
    const float* bonus = (const float*)(ws + WS_BONUS);
    bf16* YB = (bf16*)(ws + WS_YABC) + 512;
    const float* lnw = ldarg(I_R_LNW); const float* lnb = ldarg(I_R_LNB);
#pragma unroll 2
    for (int wi = gw; wi < N_RITEMS * 4; wi += NGW) {
        const int item = wi >> 2, tt = wi & 3, bh = item >> 7, c = item & 127, b = bh >> 3, h = bh & 7;
        const bf16x8 ps0 = *((const GAS bf16x8*)(ws + WS_PSI) + (((size_t)item * 4 + tt) * 2 + 0) * 64 + lane), ps1 = *((const GAS bf16x8*)(ws + WS_PSI) + (((size_t)item * 4 + tt) * 2 + 1) * 64 + lane);
        f32x4 acc[4];
#pragma unroll
        for (int vb = 0; vb < 4; ++vb) {
            const bf16x8 x0 = *((const GAS bf16x8*)(ws + WS_XFR) + (((size_t)item * 4 + vb) * 2 + 0) * 64 + lane), x1 = *((const GAS bf16x8*)(ws + WS_XFR) + (((size_t)item * 4 + vb) * 2 + 1) * 64 + lane);
            f32x4 a = *((const GAS f32x4*)(ws + WS_OM) + (((size_t)item * 4 + vb) * 4 + tt) * 64 + lane);
            a = __builtin_amdgcn_mfma_f32_16x16x32_bf16(ps0, x0, a, 0, 0, 0);
            a = __builtin_amdgcn_mfma_f32_16x16x32_bf16(ps1, x1, a, 0, 0, 0);
            acc[vb] = a; }
        const size_t rowb = (size_t)b * SEQ + (size_t)c * 64 + 16 * tt + 4 * q;
        unsigned short vmr[4][4], gmr[4][4]; float bnr[4], lw4[4], lb4[4];
#pragma unroll
        for (int vb = 0; vb < 4; ++vb) { const int ch = h * 64 + 16 * vb + cc; lw4[vb] = lnw[ch]; lb4[vb] = lnb[ch]; }
#pragma unroll
        for (int r = 0; r < 4; ++r) { const size_t t = rowb + r; bnr[r] = bonus[t * 8 + h];
#pragma unroll
            for (int vb = 0; vb < 4; ++vb) { const int ch = h * 64 + 16 * vb + cc; vmr[r][vb] = VM[t * RW + ch]; gmr[r][vb] = GM[t * RW + ch]; } }
#pragma unroll
        for (int r = 0; r < 4; ++r) { const size_t t = rowb + r;
            const float s = (acc[0][r] + acc[1][r]) + (acc[2][r] + acc[3][r]);
            const float mean = row16_sum(s) * (1.f / 64.f);
            const float d0 = acc[0][r] - mean, d1 = acc[1][r] - mean, d2 = acc[2][r] - mean, d3 = acc[3][r] - mean;
            const float var = row16_sum((d0 * d0 + d1 * d1) + (d2 * d2 + d3 * d3)) * (1.f / 64.f);
            const float rstd = __builtin_amdgcn_rsqf(var + R_GN_EPS);
            const float bn = bnr[r];
#pragma unroll
            for (int vb = 0; vb < 4; ++vb) { const int ch = h * 64 + 16 * vb + cc; const float d = (vb == 0) ? d0 : (vb == 1) ? d1 : (vb == 2) ? d2 : d3;
                const float yn = d * rstd * lw4[vb] + lb4[vb];
                const float vv = __builtin_bit_cast(float, (unsigned)vmr[r][vb] << 16), gg = __builtin_bit_cast(float, (unsigned)gmr[r][vb] << 16);
                YB[t * 1536 + ch] = (bf16)f2bf((yn + bn * vv) * gg); } }
    }
}

__global__ void __launch_bounds__(NWAVES * 64, 2) skel_fwd(Args args) {
    extern __shared__ __attribute__((aligned(16))) unsigned char lds[];
    Frame F;
    F.lds = (LAS unsigned char*)lds;
    F.MISC = (volatile LAS unsigned*)(F.lds + MISC_OFF);
    phase_enter(F, true);
    F.G = gridDim.x; { const int bx = blockIdx.x; F.vcu = (F.G % 8 == 0) ? (bx % 8) * (F.G / 8) + bx / 8 : bx; }
    unsigned char* ws = args.ws; F.ws = ws; F.out = args.out;
    F.ctl = (gu32*)(ws + WS_CTL);
    for (int u = F.tid; u < (LDS_BYTES - LDSCTL_OFF) / 4; u += NWAVES * 64) ((LAS unsigned*)(F.lds + LDSCTL_OFF))[u] = 0u;
    __syncthreads();
    XcdBarrier bar; bar.bar = (unsigned*)(F.ctl + CW_BAR); bar.x = 0; bar.st = nullptr;
    if (args.use_bar) bar = xcd_barrier_post((unsigned*)(F.ctl + CW_BAR), F.MISC + 8);
    const int lo = args.ph_lo, hi = args.ph_hi;
#define IN(k) (phase_enter(F, lo <= (k) && (k) < hi))
#define SEAM(k) do { if (lo <= (k) && (k) + 1 < hi) xcd_barrier(bar); } while (0)
    const pg8::bf16_t* wsb = (const pg8::bf16_t*)ws;
#define BF(off) ((pg8::bf16_t*)(ws + (off)))

    if (IN(0)) { p0_prologue<0>(F, args, F.vcu * NWAVES + F.wave, F.G * NWAVES); if (F.G <= 64) p0_prologue<1>(F, args, F.vcu * NWAVES + F.wave, F.G * NWAVES); } SEAM(0);
    if (IN(1)) {
        const float* ckg_ = ldarg(I_CK_GAIN);
        pg8::EpiZ E{BF(WS_Z), ldarg(I_B_GATE), ldarg(I_AQ_GAIN), ldarg(I_AK_GAIN), ldarg(I_CQ_GAIN), (const float*)(ws + WS_CS), BF(WS_KVM), ckg_, (PG8_LAS float*)(F.lds + 131072)};
        { pg8::Gemm g{BF(WS_XN), BF(WS_WIN), MTOK + MEMROWS, IN_COLS + 1024, 1024}; pg8::ZOrder<0> S; S.init(F.G, (int)blockIdx.x);
          pg8::gemm_phase<pg8::EpiZ, pg8::ZOrder<0>, true, true>(F.lds + RING_OFF, g, S, E); }
        { pg8::Gemm g{BF(WS_XN8), BF(WS_WIN8), MTOK, IN_COLS, 1024, SC_ONE, SC_W8}; pg8::ZOrder<1> S; S.init(F.G, (int)blockIdx.x);
          pg8::gemm_phase<pg8::EpiZ, pg8::ZOrder<1>, true, true, true>(F.lds + RING_OFF, g, S, E); }
    } SEAM(1);
#if NAIVE_ATTN
    if (IN(3)) { p3_attention(F); } SEAM(3);
#else
    if (IN(3)) { p3_attention_mfma(ws, (char*)lds + RING_OFF, F.G); __syncthreads(); phase_enter(F, true); p_r1<0>(F, args); } SEAM(3);
#endif
    if (IN(4)) { p_r2(F); if (F.G > 64 && blockIdx.x >= 64) p0_prologue<1>(F, args, ((int)blockIdx.x - 64) * NWAVES + F.wave, (F.G - 64) * NWAVES); } SEAM(4);
    if (IN(5)) { p_r3(F, args); p5_post(F, args); } SEAM(5);
    if (IN(6)) {
        pg8::Gemm g{BF(WS_YABC), BF(WS_WB), MTOK, 1024, 1536}; pg8::StaticOrder S; S.init(MTOK, 1024, F.G, (int)blockIdx.x);
        pg8::EpiGate3 E{BF(WS_Z), BF(WS_MRGB)};
        pg8::gemm_phase<pg8::EpiGate3, pg8::StaticOrder, true, true>(F.lds + RING_OFF, g, S, E);
    } SEAM(6);
    if (IN(7)) {
        pg8::Gemm g{BF(WS_MRGB), BF(WS_WO), MTOK, 1024, 1024}; pg8::StaticOrder S; S.init(MTOK, 1024, F.G, (int)blockIdx.x);
        pg8::EpiResF32 E{ldarg(I_X), F.out, 1024};
        pg8::gemm_phase<pg8::EpiResF32, pg8::StaticOrder, true, true>(F.lds + RING_OFF, g, S, E);
    } SEAM(7);
    if (IN(8)) { p8_router(F, args); } SEAM(8);
    if (IN(9)) { p9_dispatch(F, args); } SEAM(9);
    if (IN(10)) {
        moe_table(F);
        pg8::Gemm g{BF(WS_XS), BF(WS_W1), 0, 0, 1024, SC_ONE, SC_W8}; pg8::MoeOrder S{(const PG8_LAS int*)(F.lds + MOETAB_OFF), 8, F.G, (int)blockIdx.x};
        pg8::EpiSwiGLU E{ldarg(I_EXP_B1), BF(WS_HACT)};
        pg8::gemm_phase<pg8::EpiSwiGLU, pg8::MoeOrder, true, true, true>(F.lds + RING_OFF, g, S, E);
    } SEAM(10);
    if (IN(11)) {
        moe_table(F);
        pg8::Gemm g{BF(WS_HACT), BF(WS_W2), 0, 0, 1024, SC_H8, SC_W8}; pg8::MoeOrder S{(const PG8_LAS int*)(F.lds + MOETAB_OFF), 4, F.G, (int)blockIdx.x};
        pg8::EpiMoeOut E{ldarg(I_EXP_B2), (const float*)(ws + WS_ROUTE + RT_ROWGATE), BF(WS_YROWS)};
        pg8::gemm_phase<pg8::EpiMoeOut, pg8::MoeOrder, true, true, true>(F.lds + RING_OFF, g, S, E);
    } SEAM(11);
    if (IN(12)) { p12_combine(F); }
#undef IN
#undef SEAM
#undef BF
    (void)wsb;
}

extern "C" void kernel_launch(void* const* d_in, const int* in_sizes, int n_in, void* d_out, int out_size, void* d_ws, size_t ws_size, hipStream_t stream) {
    static int grid = 0;
    if (grid == 0) {
        if (n_in != 32 || out_size != MTOK * D_MODEL || ws_size < WS_END) { fprintf(stderr, "kernel_launch: unexpected problem (n_in %d, out %d, ws %zu); nothing launched\n", n_in, out_size, ws_size); grid = -1; return; }
        int dev = 0, cus = 0;
        if (hipGetDevice(&dev) != hipSuccess || hipDeviceGetAttribute(&cus, hipDeviceAttributeMultiprocessorCount, dev) != hipSuccess) { grid = -1; return; }
        if (hipFuncSetAttribute((const void*)skel_fwd, hipFuncAttributeMaxDynamicSharedMemorySize, LDS_BYTES) != hipSuccess) { fprintf(stderr, "kernel_launch: hipFuncSetAttribute failed\n"); grid = -1; return; }
        (void)hipGetLastError();
        grid = cus;
    }
    if (grid < 0) return;
    (void)hipMemsetAsync((char*)d_ws + WS_CTL, 0, CTL_ZERO_BYTES, stream);
    Args a{};
    for (int i = 0; i < 32; ++i) a.in[i] = (const float*)d_in[i];
    a.out = (float*)d_out; a.ws = (unsigned char*)d_ws;
#if MK_N_LAUNCHES == 1
    a.ph_lo = 0; a.ph_hi = N_PHASES; a.use_bar = 1;
    hipLaunchKernelGGL(skel_fwd, dim3(grid), dim3(NWAVES * 64), LDS_BYTES, stream, a);
#else
    for (int p = 0; p < N_PHASES; ++p) { a.ph_lo = p; a.ph_hi = p + 1; a.use_bar = 0;
        hipLaunchKernelGGL(skel_fwd, dim3(grid), dim3(NWAVES * 64), LDS_BYTES, stream, a); }
#endif
}
```

```cpp
#include <hip/hip_runtime.h>
#include <cstdio>
#include <cstdint>
#include <cmath>
namespace pg8 {
#define PG8_LAS __attribute__((address_space(3)))
typedef unsigned short bf16_t;
typedef short bf16x8 __attribute__((ext_vector_type(8)));
typedef float f32x4 __attribute__((ext_vector_type(4)));
typedef unsigned u32x4 __attribute__((ext_vector_type(4)));
constexpr int BM = 256, BK = 64, HALF = 128, HTB = HALF * BK * 2  , STAGE_BYTES = 8 * HTB, NXCD = 8, WGM = 8;

__host__ __device__ __forceinline__ int lds_byte(int r, int c) { const int st = (r >> 4) * 2 + (c >> 5), rr = r & 15, cc = c & 31, ob = rr * 64 + cc * 2; return st * 1024 + (ob ^ (((ob >> 9) & 1) << 5)); }
__host__ __device__ __forceinline__ void stage_rc(int b, int& R, int& C) { const int st = b / 1024, sb = b % 1024, swz = sb ^ (((sb >> 9) & 1) << 5); R = (st >> 1) * 16 + swz / 64; C = (st & 1) * 32 + (swz % 64) / 2; }
__host__ __device__ __forceinline__ int perm32(int rho) { const int n = rho >> 4, i = rho & 15; return 8 * (i >> 2) + 4 * n + (i & 3); }

struct Unit { int pm, pn; };
typedef int v4i_t __attribute__((ext_vector_type(4))); typedef int v8i_t __attribute__((ext_vector_type(8)));
struct Gemm { const bf16_t* A; const bf16_t* Bt; int M, N, K; int sca = 0x7f7f7f7f, scb = 0x7f7f7f7f; int prof = 0; };
#ifdef PG8_PROF
__device__ unsigned long long pg8_prof[4];
#endif

struct StaticOrder {
    int nM, nN, nwg, G, c;
    __host__ __device__ void init(int M, int N, int G_, int c_) { nM = M / BM; nN = N / BM; nwg = nM * nN; G = G_; c = c_; }
    __host__ __device__ bool next(int i, Unit& u) const {
        const long L = (long)i * G + c; if (L >= nwg) return false;
        int wgid = (int)L; { const int q = nwg / NXCD, r = nwg % NXCD, xcd = wgid % NXCD, off = wgid / NXCD; wgid = (xcd < r ? xcd * (q + 1) : r * (q + 1) + (xcd - r) * q) + off; }
        const int nig = WGM * nN, gid = wgid / nig, fm = gid * WGM, gsz = (nM - fm) < WGM ? (nM - fm) : WGM;
        u.pm = fm + ((wgid % nig) % gsz); u.pn = (wgid % nig) / gsz; return true;
    }
    __device__ __forceinline__ void a_ready(const Unit&) const {}
    __device__ __forceinline__ void done(const Unit&) const {}
};

__device__ __forceinline__ unsigned cvt_pk_bf16(float lo, float hi) { unsigned r; asm volatile("v_cvt_pk_bf16_f32 %0, %1, %2" : "=v"(r) : "v"(lo), "v"(hi)); return r; }
typedef float f32x2 __attribute__((ext_vector_type(2)));
__device__ __forceinline__ f32x2 gelu_pk(f32x2 v) {
    const f32x2 av = __builtin_elementwise_abs(v), d = av * 0.2316418882f + 1.0f;
    f32x2 t; t.x = __builtin_amdgcn_rcpf(d.x); t.y = __builtin_amdgcn_rcpf(d.y);
    f32x2 q = t * 0.5307027145f + (-0.7265760135f); q = q * t + 0.7107068705f; q = q * t + (-0.142248368f); q = q * t + 0.127414796f; q = q * t;
    const f32x2 s = (v * v) * (-0.72134752044f);
    f32x2 e; e.x = __builtin_amdgcn_exp2f(s.x); e.y = __builtin_amdgcn_exp2f(s.y);
    const f32x2 m = v * (q * e), r = v - m;
    f32x2 o; o.x = v.x < 0.f ? m.x : r.x; o.y = v.y < 0.f ? m.y : r.y; return o;
}

template <int ACT  > struct EpiBf16 {
    static constexpr bool PERM = true, AFTER_DRAIN = false; static_assert(ACT == 0 || ACT == 1, "EpiBf16: ACT is 0 (none) or 1 (gelu_pk)");
    bf16_t* O; int ldc; const float* bias; int split_cols; size_t split_stride; float scale0;
    __device__ __forceinline__ void operator()(const f32x4 (&acc)[2][2][4][2], const Unit& u, int wr, int wc, int fr, int fq) const {
        const int row0 = u.pm * BM + wr * 64 + fr; int colt = u.pn * BM; bf16_t* base = O;
        float sc = 1.f; if (split_cols) { const int t = colt / split_cols; base += (size_t)t * split_stride; colt -= t * split_cols; if (t == 0) sc = scale0; }
        const int col0 = colt + wc * 32 + 8 * fq, bcol0 = u.pn * BM + wc * 32 + 8 * fq;
        f32x4 bv[2][2];
#pragma unroll
        for (int bj = 0; bj < 2; ++bj)
#pragma unroll
            for (int n = 0; n < 2; ++n) bv[bj][n] = bias ? *(const f32x4*)(bias + bcol0 + bj * HALF + 4 * n) : (f32x4){0.f, 0.f, 0.f, 0.f};
#pragma unroll
        for (int ai = 0; ai < 2; ++ai)
#pragma unroll
            for (int m = 0; m < 4; ++m) { bf16_t* rowp = base + (size_t)(row0 + ai * HALF + m * 16) * ldc + col0;
#pragma unroll
                for (int bj = 0; bj < 2; ++bj) { f32x4 v0 = acc[ai][bj][m][0] + bv[bj][0], v1 = acc[ai][bj][m][1] + bv[bj][1];
                    if (ACT == 1) { f32x2 a = gelu_pk((f32x2){v0[0], v0[1]}), b = gelu_pk((f32x2){v0[2], v0[3]}), c = gelu_pk((f32x2){v1[0], v1[1]}), d = gelu_pk((f32x2){v1[2], v1[3]});
                        v0 = (f32x4){a.x, a.y, b.x, b.y}; v1 = (f32x4){c.x, c.y, d.x, d.y}; }
                    v0 = v0 * sc; v1 = v1 * sc; u32x4 w; w.x = cvt_pk_bf16(v0[0], v0[1]); w.y = cvt_pk_bf16(v0[2], v0[3]); w.z = cvt_pk_bf16(v1[0], v1[1]); w.w = cvt_pk_bf16(v1[2], v1[3]);
                    *(u32x4*)(rowp + bj * HALF) = w; } }
    }
};
template <class E_> struct EpiHasMid { static constexpr bool v = false; };
template <class Epi, class Sched, bool ALIGN_EPI = false, bool SP2 = false, bool FP8 = false>
__device__ __forceinline__ void gemm_phase(PG8_LAS unsigned char* lds, const Gemm g, const Sched& S, const Epi& E) {
    int tid_ = threadIdx.x; asm volatile("" : "+v"(tid_));
    const int tid = tid_, wid = __builtin_amdgcn_readfirstlane(tid >> 6), lane = tid & 63, wr = wid >> 2, wc = wid & 3, fr = lane & 15, fq = lane >> 4;
    const int K = FP8 ? g.K / 2 : g.K, nt = K / BK;
    unsigned voffA[2], voffB[2];
#pragma unroll
    for (int i = 0; i < 2; ++i) { int R, C; stage_rc(tid * 16 + i * 8192, R, C); const int Rb = Epi::PERM ? ((R & ~31) + perm32(R & 31)) : R;
        voffA[i] = (unsigned)(R * K + C) * 2u; voffB[i] = (unsigned)(Rb * K + C) * 2u; }
    const size_t kstep = (size_t)(BK * 2);
    const size_t hstep = (size_t)HALF * K * 2;
    const size_t tstep = 2 * hstep;
    const unsigned ldsw = (unsigned)wid * 1024u;
    const int aoff = FP8 ? lds_byte(wr * 64 + fr, fq * 16) : lds_byte(wr * 64 + fr, fq * 8), boff = FP8 ? lds_byte(wc * 32 + fr, fq * 16) : lds_byte(wc * 32 + fr, fq * 8);
    constexpr int PIECE1 = FP8 ? 16 : 1024; (void)PIECE1;
#define PG8_SA(b, h) (((b) * 2 + (h)) * HTB)
#define PG8_SB(b, h) ((4 + (b) * 2 + (h)) * HTB)
#define PG8_STAGE(bufoff, gbase, voff) do { _Pragma("unroll") for (int _i = 0; _i < 2; ++_i) \
        __builtin_amdgcn_global_load_lds((const unsigned*)((const char*)(gbase) + (voff)[_i]), (PG8_LAS unsigned*)(lds + (bufoff) + ldsw + _i * 8192), 16, 0, 0); } while (0)
#define PG8_LD8(p_) __builtin_shufflevector(*(const PG8_LAS v4i_t*)(p_), *(const PG8_LAS v4i_t*)((p_) + 16), 0, 1, 2, 3, 4, 5, 6, 7)
#define PG8_LDA(dst, b, h) do { if constexpr (FP8) { _Pragma("unroll") for (int m = 0; m < 4; ++m) dst##8[m] = PG8_LD8(lds + PG8_SA(b, h) + aoff + m * 2048); } \
        else { _Pragma("unroll") for (int m = 0; m < 4; ++m) _Pragma("unroll") for (int k = 0; k < 2; ++k) dst[m][k] = *(const PG8_LAS bf16x8*)(lds + PG8_SA(b, h) + aoff + k * 1024 + m * 2048); } } while (0)
#define PG8_LDB(dst, b, h) do { if constexpr (FP8) { _Pragma("unroll") for (int n = 0; n < 2; ++n) dst##8[n] = PG8_LD8(lds + PG8_SB(b, h) + boff + n * 2048); } \
        else { _Pragma("unroll") for (int n = 0; n < 2; ++n) _Pragma("unroll") for (int k = 0; k < 2; ++k) dst[n][k] = *(const PG8_LAS bf16x8*)(lds + PG8_SB(b, h) + boff + k * 1024 + n * 2048); } } while (0)
#define PG8_MMA(ai, bj, At, Bt) do { __builtin_amdgcn_s_setprio(1); \
        if constexpr (FP8) { _Pragma("unroll") for (int m = 0; m < 4; ++m) _Pragma("unroll") for (int n = 0; n < 2; ++n) \
            asm volatile("v_mfma_scale_f32_16x16x128_f8f6f4 %0, %1, %2, %0, %3, %4 op_sel_hi:[0,0,0]" : "+v"(acc[ai][bj][m][n]) : "v"(Bt##8[n]), "v"(At##8[m]), "v"(scb_v), "v"(sca_v)); } \
        else { _Pragma("unroll") for (int m = 0; m < 4; ++m) _Pragma("unroll") for (int n = 0; n < 2; ++n) _Pragma("unroll") for (int k = 0; k < 2; ++k) \
            acc[ai][bj][m][n] = __builtin_amdgcn_mfma_f32_16x16x32_bf16(Bt[n][k], At[m][k], acc[ai][bj][m][n], 0, 0, 0); } __builtin_amdgcn_s_setprio(0); } while (0)
#define PG8_WAIT_V(n) asm volatile("s_waitcnt vmcnt(" #n ")" ::: "memory")
#define PG8_WAIT_L(n) asm volatile("s_waitcnt lgkmcnt(" #n ")" ::: "memory")
#define PG8_BAR __builtin_amdgcn_s_barrier()
#define PG8_SCHED __builtin_amdgcn_sched_barrier(0)
    Unit cur, nxt; int ui = 0;
#ifdef PG8_PROF
#define PG8_TS(slot) do { if (g.prof && wid == 0) { const unsigned n_ = (unsigned)__builtin_amdgcn_s_memrealtime(); volatile PG8_LAS unsigned* p_ = (volatile PG8_LAS unsigned*)(lds + 143744); p_[slot] += n_ - p_[2]; p_[2] = n_; } } while (0)
#else
#define PG8_TS(slot) do { } while (0)
#endif
    if (!S.next(0, cur)) return;
    f32x4 acc[2][2][4][2];
#pragma unroll
    for (int a = 0; a < 2; ++a)
#pragma unroll
        for (int b = 0; b < 2; ++b)
#pragma unroll
            for (int m = 0; m < 4; ++m)
#pragma unroll
                for (int n = 0; n < 2; ++n) acc[a][b][m][n] = (f32x4){0.f, 0.f, 0.f, 0.f};
    const int sca_v = g.sca, scb_v = g.scb;
    bf16x8 At[4][2], B0[2][2], B1[2][2];
    v8i_t At8[4], B08[2], B18[2];
    const char* cA = (const char*)g.A + (size_t)cur.pm * tstep; const char* cB = (const char*)g.Bt + (size_t)cur.pn * tstep;
    S.a_ready(cur);
    if constexpr (SP2) {
        PG8_STAGE(PG8_SB(0, 0), cB, voffB); PG8_STAGE(PG8_SB(0, 1), cB + hstep, voffB); PG8_STAGE(PG8_SA(0, 0), cA, voffA); PG8_STAGE(PG8_SA(0, 1), cA + hstep, voffA);
        if (wr == 1) PG8_BAR;
        PG8_WAIT_V(2); PG8_BAR;
        PG8_STAGE(PG8_SB(1, 0), cB + kstep, voffB); PG8_STAGE(PG8_SA(1, 0), cA + kstep, voffA); PG8_STAGE(PG8_SB(1, 1), cB + hstep + kstep, voffB);
        PG8_WAIT_V(6); PG8_BAR;
    } else {
        PG8_STAGE(PG8_SB(0, 0), cB, voffB); PG8_STAGE(PG8_SA(0, 0), cA, voffA); PG8_STAGE(PG8_SB(0, 1), cB + hstep, voffB); PG8_STAGE(PG8_SA(0, 1), cA + hstep, voffA);
        if (wr == 1) PG8_BAR;
        PG8_WAIT_V(4); PG8_BAR;
        PG8_STAGE(PG8_SB(1, 0), cB + kstep, voffB); PG8_STAGE(PG8_SA(1, 0), cA + kstep, voffA); PG8_STAGE(PG8_SB(1, 1), cB + hstep + kstep, voffB);
        PG8_WAIT_V(6); PG8_BAR;
    }
    for (;;) {
        const bool has_next = S.next(ui + 1, nxt);
        const char* nA = has_next ? (const char*)g.A + (size_t)nxt.pm * tstep : cA; const char* nB = has_next ? (const char*)g.Bt + (size_t)nxt.pn * tstep : cB;
        PG8_TS(3);
#pragma unroll 1
        for (int t = 0; t < nt; t += 2) {
            if constexpr (EpiHasMid<Epi>::v) { if (t == 8 || t == 16) { PG8_SCHED; E.mid(acc, cur, t, wr, wc, fr, fq); PG8_SCHED; } }
            const bool last = (t == nt - 2);
            const char* a1 = cA + (size_t)(t + 1) * kstep;
            const char* a2 = last ? nA : cA + (size_t)(t + 2) * kstep; const char* b2 = last ? nB : cB + (size_t)(t + 2) * kstep;
            const char* a3 = a2 + kstep; const char* b3 = b2 + kstep;
            if (last && has_next) S.a_ready(nxt);
            if constexpr (SP2) {
            PG8_LDB(B0, 0, 0); PG8_LDB(B1, 0, 1); PG8_SCHED; PG8_LDA(At, 0, 0); PG8_STAGE(PG8_SA(1, 1), a1 + hstep, voffA);
            PG8_WAIT_V(8); PG8_WAIT_L(0); PG8_BAR; PG8_MMA(0, 0, At, B0); PG8_MMA(0, 1, At, B1); PG8_BAR; PG8_SCHED;
            PG8_LDA(At, 0, 1); PG8_STAGE(PG8_SB(0, 0), b2, voffB); PG8_STAGE(PG8_SB(0, 1), b2 + hstep, voffB); PG8_STAGE(PG8_SA(0, 0), a2, voffA);
            PG8_WAIT_V(8); PG8_WAIT_L(0); PG8_BAR; PG8_MMA(1, 0, At, B0); PG8_MMA(1, 1, At, B1); PG8_BAR; PG8_SCHED;
            PG8_LDB(B0, 1, 0); PG8_LDB(B1, 1, 1); PG8_SCHED; PG8_LDA(At, 1, 0); PG8_STAGE(PG8_SA(0, 1), a2 + hstep, voffA);
            PG8_WAIT_V(8); PG8_WAIT_L(0); PG8_BAR; PG8_MMA(0, 0, At, B0); PG8_MMA(0, 1, At, B1); PG8_BAR; PG8_SCHED;
            PG8_LDA(At, 1, 1); PG8_STAGE(PG8_SB(1, 0), b3, voffB); PG8_STAGE(PG8_SB(1, 1), b3 + hstep, voffB); PG8_STAGE(PG8_SA(1, 0), a3, voffA);
            PG8_WAIT_V(8); PG8_WAIT_L(0); PG8_BAR; PG8_MMA(1, 0, At, B0); PG8_MMA(1, 1, At, B1); PG8_BAR; PG8_SCHED;
            } else {
            PG8_LDB(B0, 0, 0); PG8_SCHED; PG8_LDA(At, 0, 0); PG8_STAGE(PG8_SA(1, 1), a1 + hstep, voffA);
            PG8_WAIT_L(8); PG8_BAR; PG8_WAIT_L(0); PG8_MMA(0, 0, At, B0); PG8_BAR; PG8_SCHED;
            PG8_LDB(B1, 0, 1); PG8_STAGE(PG8_SB(0, 0), b2, voffB);
            PG8_BAR; PG8_WAIT_L(0); PG8_MMA(0, 1, At, B1); PG8_BAR;
            PG8_LDA(At, 0, 1); PG8_STAGE(PG8_SA(0, 0), a2, voffA);
            PG8_BAR; PG8_WAIT_L(0); PG8_MMA(1, 0, At, B0); PG8_BAR; PG8_SCHED;
            PG8_STAGE(PG8_SB(0, 1), b2 + hstep, voffB);
            PG8_WAIT_V(6); PG8_BAR; PG8_MMA(1, 1, At, B1); PG8_BAR;
            PG8_LDB(B0, 1, 0); PG8_SCHED; PG8_LDA(At, 1, 0); PG8_STAGE(PG8_SA(0, 1), a2 + hstep, voffA);
            PG8_WAIT_L(8); PG8_BAR; PG8_WAIT_L(0); PG8_MMA(0, 0, At, B0); PG8_BAR; PG8_SCHED;
            PG8_LDB(B1, 1, 1); PG8_STAGE(PG8_SB(1, 0), b3, voffB);
            PG8_BAR; PG8_WAIT_L(0); PG8_MMA(0, 1, At, B1); PG8_BAR;
            PG8_LDA(At, 1, 1); PG8_STAGE(PG8_SA(1, 0), a3, voffA);
            PG8_BAR; PG8_WAIT_L(0); PG8_MMA(1, 0, At, B0); PG8_BAR; PG8_SCHED;
            PG8_STAGE(PG8_SB(1, 1), b3 + hstep, voffB);
            PG8_WAIT_V(6); PG8_BAR; PG8_MMA(1, 1, At, B1); PG8_BAR;
            }
        }
        PG8_TS(0);
        if constexpr (FP8) { asm volatile("s_nop 15\n\ts_nop 15" ::: "memory"); }
        if constexpr (ALIGN_EPI) { if (wr == 0) PG8_BAR; }
        if constexpr (!Epi::AFTER_DRAIN) { E(acc, cur, wr, wc, fr, fq); S.done(cur); }
        PG8_TS(1);
        if (!has_next) break;
#pragma unroll
        for (int a = 0; a < 2; ++a)
#pragma unroll
            for (int b = 0; b < 2; ++b)
#pragma unroll
                for (int m = 0; m < 4; ++m)
#pragma unroll
                    for (int n = 0; n < 2; ++n) acc[a][b][m][n] = (f32x4){0.f, 0.f, 0.f, 0.f};
        cur = nxt; cA = nA; cB = nB; ++ui;
        if constexpr (ALIGN_EPI) { if (wr == 1) PG8_BAR; }
    }
#ifdef PG8_PROF
    if (g.prof && blockIdx.x == 0 && tid == 0) { volatile PG8_LAS unsigned* p_ = (volatile PG8_LAS unsigned*)(lds + 143744); pg8_prof[0] = p_[0]; pg8_prof[1] = p_[1]; pg8_prof[2] = (unsigned long long)(ui + 1); }
#endif
    PG8_WAIT_V(0);
    if constexpr (!ALIGN_EPI) { if (wr == 0) PG8_BAR; }
    PG8_BAR;
    if constexpr (Epi::AFTER_DRAIN) { E.fused(acc, cur, wr, wc, fr, fq, lds, wid, lane); S.done(cur); }
#undef PG8_SA
#undef PG8_SB
#undef PG8_STAGE
#undef PG8_LD8
#undef PG8_LDA
#undef PG8_LDB
#undef PG8_MMA
#undef PG8_WAIT_V
#undef PG8_WAIT_L
#undef PG8_BAR
#undef PG8_SCHED
}
}

constexpr int D_MODEL = 1024, BATCH = 2, SEQ = 8192, MTOK = BATCH * SEQ, MEM_LEN = 256, MEMROWS = BATCH * MEM_LEN;
constexpr int IN_COLS = 9984, OFF_AQ = 0, OFF_AK = 1536, OFF_AV = 3072, OFF_R = 4608, OFF_CQ = 6400, OFF_GATE = 6912;
constexpr int RW = 512;
constexpr int N_EXPERTS = 32, TOP_K = 4, D_FF = 1024, MOE_ROWS = 256;
constexpr int MAX_BLOCKS = MTOK * TOP_K / MOE_ROWS + N_EXPERTS;
constexpr int MAX_SLOTS = MAX_BLOCKS * MOE_ROWS;
constexpr float NORM_EPS = 1e-6f, R_GN_EPS = 64e-5f;
constexpr float LOG2E = 1.4426950408889634f;
constexpr float QSCALE = 0.08838834764831845f * LOG2E;

namespace pg8 {
__device__ __forceinline__ float bf_lo(unsigned w) { return __builtin_bit_cast(float, w << 16); }
__device__ __forceinline__ float bf_hi(unsigned w) { return __builtin_bit_cast(float, w & 0xffff0000u); }
__device__ __forceinline__ float sigmoidf_fast(float x) { return __builtin_amdgcn_rcpf(1.0f + __builtin_amdgcn_exp2f(-1.4426950408889634f * x)); }

struct EpiZ {
    static constexpr bool PERM = true, AFTER_DRAIN = false;
    bf16_t* O; const float* bgate; const float* aqg; const float* akg; const float* cqg; const float* cs;
    bf16_t* KV; const float* ckg;
    PG8_LAS float* P;
    __device__ __forceinline__ void operator()(const f32x4 (&acc)[2][2][4][2], const Unit& u, int wr, int wc, int fr, int fq) const {
        const bool mem = u.pm >= 64; const int pnl = mem ? u.pn - 39 : u.pn, ldc = mem ? 1024 : IN_COLS;
        bf16_t* const Ob = mem ? KV - (size_t)64 * BM * 1024 : O;
        const int row0 = u.pm * BM + wr * 64 + fr, col0 = pnl * BM + wc * 32 + 8 * fq;
        const int cls = mem ? ((pnl < 2) ? 3 : 0) : (pnl < 6) ? 1 : (pnl < 12) ? 2 : (pnl == 25 || pnl == 26) ? 3 : (pnl >= 27) ? 4 : 0;
        if (cls >= 1 && cls <= 3) {
            const int go = wc * 32 + 8 * fq;
            const f32x4 q0 = *(const f32x4*)(aqg + go), q1 = *(const f32x4*)(aqg + go + 4), k0 = *(const f32x4*)(akg + go), k1 = *(const f32x4*)(akg + go + 4), x0 = *(const f32x4*)(cqg + go), x1 = *(const f32x4*)(cqg + go + 4);
            const f32x4 m0 = *(const f32x4*)(ckg + go), m1 = *(const f32x4*)(ckg + go + 4);
            const f32x4 g0 = mem ? m0 : (cls == 1) ? q0 : (cls == 2) ? k0 : x0, g1 = mem ? m1 : (cls == 1) ? q1 : (cls == 2) ? k1 : x1;
#pragma unroll
            for (int ai = 0; ai < 2; ++ai)
#pragma unroll
                for (int m = 0; m < 4; ++m)
#pragma unroll
                    for (int bj = 0; bj < 2; ++bj) { const f32x4 a = acc[ai][bj][m][0], b = acc[ai][bj][m][1];
                        float s = ((a[0] * a[0] + a[1] * a[1]) + (a[2] * a[2] + a[3] * a[3])) + ((b[0] * b[0] + b[1] * b[1]) + (b[2] * b[2] + b[3] * b[3]));
                        s += __shfl_xor(s, 16); s += __shfl_xor(s, 32);
                        if (fq == 0) P[((ai * HALF + wr * 64 + m * 16 + fr) * 2 + bj) * 4 + wc] = s; }
            asm volatile("s_waitcnt lgkmcnt(0)" ::: "memory"); __builtin_amdgcn_s_barrier(); asm volatile("" ::: "memory");
#pragma unroll
            for (int ai = 0; ai < 2; ++ai)
#pragma unroll
                for (int m = 0; m < 4; ++m) { const int rl = ai * HALF + wr * 64 + m * 16 + fr, row = u.pm * BM + rl;
                    f32x4 c0 = {0.f, 0.f, 0.f, 0.f}, c1 = c0, c2 = c0, c3 = c0;
                    if (cls != 3 && wc == 0) { const f32x4* cp = (const f32x4*)(cs + (size_t)row * 32 + 16 * (fq & 1)); c0 = cp[0]; c1 = cp[1]; c2 = cp[2]; c3 = cp[3]; }
#pragma unroll
                    for (int bj = 0; bj < 2; ++bj) { const f32x4 pv = *(const PG8_LAS f32x4*)(P + (rl * 2 + bj) * 4);
                        const float rstd = __builtin_amdgcn_rsqf(((pv[0] + pv[1]) + (pv[2] + pv[3])) * (1.0f / 128.0f) + NORM_EPS);
                        f32x4 v0 = acc[ai][bj][m][0] * rstd * g0, v1 = acc[ai][bj][m][1] * rstd * g1;
                        if (cls != 3 && wc == 0) {
                            f32x4 p0, p1;
#pragma unroll
                            for (int j = 0; j < 4; ++j) { p0[j] = __shfl_xor(v0[j], 32); p1[j] = __shfl_xor(v1[j], 32); }
                            const float sg = (fq < 2) ? -1.0f : 1.0f;
                            v0[0] = v0[0] * c0[0] + sg * p0[0] * c0[1]; v0[1] = v0[1] * c0[2] + sg * p0[1] * c0[3]; v0[2] = v0[2] * c1[0] + sg * p0[2] * c1[1]; v0[3] = v0[3] * c1[2] + sg * p0[3] * c1[3];
                            v1[0] = v1[0] * c2[0] + sg * p1[0] * c2[1]; v1[1] = v1[1] * c2[2] + sg * p1[1] * c2[3]; v1[2] = v1[2] * c3[0] + sg * p1[2] * c3[1]; v1[3] = v1[3] * c3[2] + sg * p1[3] * c3[3]; }
                        u32x4 w; w.x = cvt_pk_bf16(v0[0], v0[1]); w.y = cvt_pk_bf16(v0[2], v0[3]); w.z = cvt_pk_bf16(v1[0], v1[1]); w.w = cvt_pk_bf16(v1[2], v1[3]);
                        *(u32x4*)(Ob + (size_t)row * ldc + col0 + bj * HALF) = w; } }
            return;
        }
        const bool gate = cls == 4;
        f32x4 bv[2][2];
#pragma unroll
        for (int bj = 0; bj < 2; ++bj)
#pragma unroll
            for (int n = 0; n < 2; ++n) bv[bj][n] = gate ? *(const f32x4*)(bgate + (col0 - OFF_GATE) + bj * HALF + 4 * n) : (f32x4){0.f, 0.f, 0.f, 0.f};
#pragma unroll
        for (int ai = 0; ai < 2; ++ai)
#pragma unroll
            for (int m = 0; m < 4; ++m) { bf16_t* rowp = Ob + (size_t)(row0 + ai * HALF + m * 16) * ldc + col0;
#pragma unroll
                for (int bj = 0; bj < 2; ++bj) { f32x4 v0 = acc[ai][bj][m][0] + bv[bj][0], v1 = acc[ai][bj][m][1] + bv[bj][1];
                    if (gate) {
#pragma unroll
                        for (int j = 0; j < 4; ++j) { v0[j] = sigmoidf_fast(v0[j]); v1[j] = sigmoidf_fast(v1[j]); } }
                    u32x4 w; w.x = cvt_pk_bf16(v0[0], v0[1]); w.y = cvt_pk_bf16(v0[2], v0[3]); w.z = cvt_pk_bf16(v1[0], v1[1]); w.w = cvt_pk_bf16(v1[2], v1[3]);
                    *(u32x4*)(rowp + bj * HALF) = w; } }
    }
};

template <int SET> struct ZOrder {
    StaticOrder so; int nz;
    __device__ void init(int G_, int c_) { so.init(MTOK, (SET == 0 ? 27 : 12) * BM, G_, c_); nz = 64 * (SET == 0 ? 27 : 12); }
    __device__ __forceinline__ bool next(int i, Unit& u) const {
        if (so.next(i, u)) { const int t = u.pn;
            if (SET == 1) u.pn = t + 27;
            return true; }
        if (SET == 0) { const long L = (long)i * so.G + so.c - nz; if (L >= 0 && L < 8) { u.pm = 64 + (int)(L & 1); u.pn = 39 + (int)(L >> 1); return true; } }
        return false;
    }
    __device__ __forceinline__ void a_ready(const Unit&) const {}
    __device__ __forceinline__ void done(const Unit&) const {}
};
struct EpiGate3 {
    static constexpr bool PERM = true, AFTER_DRAIN = false;
    const bf16_t* Z; bf16_t* mergedb;
    __device__ __forceinline__ void mid(f32x4 (&acc)[2][2][4][2], const Unit& u, int t, int wr, int wc, int fr, int fq) const {
        int fr_ = fr; asm volatile("" : "+v"(fr_));
        const int row0 = u.pm * BM + wr * 64 + fr_, col0 = u.pn * BM + wc * 32 + 8 * fq, ba = (t >> 3) - 1;
        const bf16_t* gp = Z + OFF_GATE + ba * D_MODEL + col0;
#pragma unroll
        for (int ai = 0; ai < 2; ++ai)
#pragma unroll
            for (int m = 0; m < 4; ++m) { const bf16_t* rp = gp + (size_t)(row0 + ai * HALF + m * 16) * IN_COLS;
#pragma unroll
                for (int bj = 0; bj < 2; ++bj) { const u32x4 ga = *(const u32x4*)(rp + bj * HALF), gb = *(const u32x4*)(rp + D_MODEL + bj * HALF);
                    f32x4 r0, r1;
                    r0[0] = bf_lo(ga[0]) * __builtin_amdgcn_rcpf(bf_lo(gb[0])); r0[1] = bf_hi(ga[0]) * __builtin_amdgcn_rcpf(bf_hi(gb[0])); r0[2] = bf_lo(ga[1]) * __builtin_amdgcn_rcpf(bf_lo(gb[1])); r0[3] = bf_hi(ga[1]) * __builtin_amdgcn_rcpf(bf_hi(gb[1]));
                    r1[0] = bf_lo(ga[2]) * __builtin_amdgcn_rcpf(bf_lo(gb[2])); r1[1] = bf_hi(ga[2]) * __builtin_amdgcn_rcpf(bf_hi(gb[2])); r1[2] = bf_lo(ga[3]) * __builtin_amdgcn_rcpf(bf_lo(gb[3])); r1[3] = bf_hi(ga[3]) * __builtin_amdgcn_rcpf(bf_hi(gb[3]));
                    acc[ai][bj][m][0] *= r0; acc[ai][bj][m][1] *= r1; }
                if (m == 3) asm volatile("" ::: "memory"); }
    }
    __device__ __forceinline__ void operator()(const f32x4 (&acc)[2][2][4][2], const Unit& u, int wr, int wc, int fr, int fq) const {
        const int row0 = u.pm * BM + wr * 64 + fr, col0 = u.pn * BM + wc * 32 + 8 * fq;
        u32x4 gzr[2][4][2];
#pragma unroll
        for (int ai = 0; ai < 2; ++ai)
#pragma unroll
            for (int m = 0; m < 4; ++m)
#pragma unroll
                for (int bj = 0; bj < 2; ++bj) gzr[ai][m][bj] = *(const u32x4*)(Z + (size_t)(row0 + ai * HALF + m * 16) * IN_COLS + OFF_GATE + 2 * D_MODEL + col0 + bj * HALF);
#pragma unroll
        for (int ai = 0; ai < 2; ++ai)
#pragma unroll
            for (int m = 0; m < 4; ++m) { const int row = row0 + ai * HALF + m * 16;
#pragma unroll
                for (int bj = 0; bj < 2; ++bj) { const int col = col0 + bj * HALF; const u32x4 gz = gzr[ai][m][bj];
                    f32x4 g0, g1;
                    g0[0] = bf_lo(gz[0]); g0[1] = bf_hi(gz[0]); g0[2] = bf_lo(gz[1]); g0[3] = bf_hi(gz[1]); g1[0] = bf_lo(gz[2]); g1[1] = bf_hi(gz[2]); g1[2] = bf_lo(gz[3]); g1[3] = bf_hi(gz[3]);
                    const f32x4 v0 = acc[ai][bj][m][0] * g0, v1 = acc[ai][bj][m][1] * g1;
                    u32x4 w; w.x = cvt_pk_bf16(v0[0], v0[1]); w.y = cvt_pk_bf16(v0[2], v0[3]); w.z = cvt_pk_bf16(v1[0], v1[1]); w.w = cvt_pk_bf16(v1[2], v1[3]);
                    *(u32x4*)(mergedb + (size_t)row * D_MODEL + col) = w; } }
    }
};
template <> struct EpiHasMid<EpiGate3> { static constexpr bool v = true; };
struct EpiGate3NoMid : EpiGate3 {};
struct EpiResF32 {
    static constexpr bool PERM = true, AFTER_DRAIN = false;
    const float* base; float* out; int ldc;
    __device__ __forceinline__ void operator()(const f32x4 (&acc)[2][2][4][2], const Unit& u, int wr, int wc, int fr, int fq) const {
        const int row0 = u.pm * BM + wr * 64 + fr, col0 = u.pn * BM + wc * 32 + 8 * fq;
#pragma unroll
        for (int ai = 0; ai < 2; ++ai) {
            f32x4 xr[4][2][2];
#pragma unroll
            for (int m = 0; m < 4; ++m)
#pragma unroll
                for (int bj = 0; bj < 2; ++bj) { const float* bp = base + (size_t)(row0 + ai * HALF + m * 16) * ldc + col0 + bj * HALF; xr[m][bj][0] = *(const f32x4*)bp; xr[m][bj][1] = *(const f32x4*)(bp + 4); }
#pragma unroll
            for (int m = 0; m < 4; ++m)
#pragma unroll
                for (int bj = 0; bj < 2; ++bj) { float* op = out + (size_t)(row0 + ai * HALF + m * 16) * ldc + col0 + bj * HALF;
                    *(f32x4*)op = xr[m][bj][0] + acc[ai][bj][m][0]; *(f32x4*)(op + 4) = xr[m][bj][1] + acc[ai][bj][m][1]; }
            asm volatile("" ::: "memory"); }
    }
};
struct EpiSwiGLU {
    static constexpr bool PERM = true, AFTER_DRAIN = false;
    const float* b1; bf16_t* H;
    __device__ __forceinline__ void operator()(const f32x4 (&acc)[2][2][4][2], const Unit& u, int wr, int wc, int fr, int fq) const {
        const int e = u.pn >> 3, pnl = u.pn & 7;
        const int row0 = u.pm * BM + wr * 64 + fr, ac = pnl * HALF + wc * 32 + 8 * fq;
        const float* bg = b1 + (size_t)e * 2 * D_FF + ac; const float* bl = bg + D_FF;
        const f32x4 bg0 = *(const f32x4*)bg, bg1 = *(const f32x4*)(bg + 4), bl0 = *(const f32x4*)bl, bl1 = *(const f32x4*)(bl + 4);
#pragma unroll
        for (int ai = 0; ai < 2; ++ai)
#pragma unroll
            for (int m = 0; m < 4; ++m) { const int row = row0 + ai * HALF + m * 16;
                float a[8];
#pragma unroll
                for (int n = 0; n < 2; ++n) { const f32x4 ug = acc[ai][0][m][n] + (n ? bg1 : bg0), ul = acc[ai][1][m][n] + (n ? bl1 : bl0);
#pragma unroll
                    for (int j = 0; j < 4; ++j) { const float g = fminf(ug[j], 7.0f), l = fminf(fmaxf(ul[j], -7.0f), 7.0f);
                        a[4 * n + j] = g * sigmoidf_fast(1.702f * g) * (l + 1.0f); } }
                unsigned w0 = 0, w1 = 0;
                w0 = __builtin_amdgcn_cvt_pk_fp8_f32(a[0] * 8.0f, a[1] * 8.0f, w0, false); w0 = __builtin_amdgcn_cvt_pk_fp8_f32(a[2] * 8.0f, a[3] * 8.0f, w0, true);
                w1 = __builtin_amdgcn_cvt_pk_fp8_f32(a[4] * 8.0f, a[5] * 8.0f, w1, false); w1 = __builtin_amdgcn_cvt_pk_fp8_f32(a[6] * 8.0f, a[7] * 8.0f, w1, true);
                *(unsigned long long*)((unsigned char*)H + (size_t)row * D_FF + ac) = (unsigned long long)w0 | ((unsigned long long)w1 << 32); }
    }
};
struct EpiMoeOut {
    static constexpr bool PERM = true, AFTER_DRAIN = false;
    const float* b2; const float* rowgate; bf16_t* Y;
    __device__ __forceinline__ void operator()(const f32x4 (&acc)[2][2][4][2], const Unit& u, int wr, int wc, int fr, int fq) const {
        const int e = u.pn >> 2, pnl = u.pn & 3;
        const int row0 = u.pm * BM + wr * 64 + fr, col0 = pnl * BM + wc * 32 + 8 * fq;
        float gtr[2][4]; f32x4 bb[2][2];
#pragma unroll
        for (int ai = 0; ai < 2; ++ai)
#pragma unroll
            for (int m = 0; m < 4; ++m) gtr[ai][m] = rowgate[row0 + ai * HALF + m * 16];
#pragma unroll
        for (int bj = 0; bj < 2; ++bj) { const float* bp = b2 + (size_t)e * D_MODEL + col0 + bj * HALF; bb[bj][0] = *(const f32x4*)bp; bb[bj][1] = *(const f32x4*)(bp + 4); }
#pragma unroll
        for (int ai = 0; ai < 2; ++ai)
#pragma unroll
            for (int m = 0; m < 4; ++m) { const int row = row0 + ai * HALF + m * 16; const float gt = gtr[ai][m];
#pragma unroll
                for (int bj = 0; bj < 2; ++bj) { const int col = col0 + bj * HALF;
                    const f32x4 v0 = (acc[ai][bj][m][0] + bb[bj][0]) * gt, v1 = (acc[ai][bj][m][1] + bb[bj][1]) * gt;
                    unsigned w0 = 0, w1 = 0;
                    w0 = __builtin_amdgcn_cvt_pk_fp8_f32(v0[0] * 16.0f, v0[1] * 16.0f, w0, false); w0 = __builtin_amdgcn_cvt_pk_fp8_f32(v0[2] * 16.0f, v0[3] * 16.0f, w0, true);
                    w1 = __builtin_amdgcn_cvt_pk_fp8_f32(v1[0] * 16.0f, v1[1] * 16.0f, w1, false); w1 = __builtin_amdgcn_cvt_pk_fp8_f32(v1[2] * 16.0f, v1[3] * 16.0f, w1, true);
                    *(unsigned long long*)((unsigned char*)Y + (size_t)row * D_MODEL + col) = (unsigned long long)w0 | ((unsigned long long)w1 << 32); } }
    }
};
struct MoeOrder {
    const PG8_LAS int* tab;
    int NT, G, c;
    __device__ __forceinline__ bool next(int i, Unit& u) const {
        const int nblk = tab[0], nu = nblk * NT; const long L0 = (long)i * G + c; if (L0 >= (long)nu) return false;
        int L = (int)L0; { const int q = nu / NXCD, r = nu % NXCD, xcd = L % NXCD, off = L / NXCD; L = (xcd < r ? xcd * (q + 1) : r * (q + 1) + (xcd - r) * q) + off; }
        const int blk = L / NT, pnl = L % NT; u.pm = blk; u.pn = tab[1 + blk] * NT + pnl; return true;
    }
    __device__ __forceinline__ void a_ready(const Unit&) const {}
    __device__ __forceinline__ void done(const Unit&) const {}
};
}

namespace swa {
constexpr int D = 128;
constexpr float SCALE = 0.08838834764831845f;
constexpr float THR = 8.f;
constexpr int NW = 8, QBLK = 32, KVBLK = 64, QB = NW * QBLK;
constexpr int SHM_V = KVBLK * D * 2, SHM_K = KVBLK * D * 2;
constexpr int LDS_BYTES = 2 * SHM_V + 2 * SHM_K + NW * 64 * 4;
using bf16 = unsigned short;
typedef short bf16x8 __attribute__((ext_vector_type(8)));
typedef short s16x4 __attribute__((ext_vector_type(4)));
typedef float f32x16 __attribute__((ext_vector_type(16)));
typedef float f32x4 __attribute__((ext_vector_type(4)));
typedef unsigned u32x4 __attribute__((ext_vector_type(4)));
template <class A, class Bt> struct same_t { static constexpr bool v = false; };
template <class A> struct same_t<A, A> { static constexpr bool v = true; };
#define KSWZ(row, colB) ((row) * 256 + ((colB) ^ (((row) & 7) << 4)))
#define SBAR() __builtin_amdgcn_sched_barrier(0)
__device__ __forceinline__ int v_st(int k, int c) { const int kk = (k & ~0xC) | ((k & 4) << 1) | ((k & 8) >> 1); return ((kk >> 3) * 4 + (c >> 5)) * 512 + ((kk & 7) * 32 + (c & 31)) * 2; }
__device__ __forceinline__ int v_rd_base(int lane) { return ((lane & 3) << 3) | (((lane >> 2) & 3) << 6) | (((lane >> 4) & 1) << 5) | (((lane >> 5) & 1) << 8); }
constexpr int v_rd_off(int d0, int ks, int half) { return d0 * 512 + ks * 4096 + half * 2048; }
__device__ __forceinline__ int crow(int r, int hi) { return (r & 3) + 8 * (r >> 2) + 4 * hi; }
__device__ __forceinline__ unsigned cvtpk(float lo, float hi) {
    unsigned r; asm volatile("v_cvt_pk_bf16_f32 %0, %1, %2" : "=v"(r) : "v"(lo), "v"(hi)); return r;
}
__device__ __forceinline__ bf16x8 pack8(f32x4 a, f32x4 b) {
    u32x4 w = {cvtpk(a[0], a[1]), cvtpk(a[2], a[3]), cvtpk(b[0], b[1]), cvtpk(b[2], b[3])};
    return *reinterpret_cast<bf16x8*>(&w);
}
template <class T> __device__ __forceinline__ bf16x8 load8(const T* p) {
    if constexpr (same_t<T, float>::v) { return pack8(*(const f32x4*)p, *(const f32x4*)(p + 4)); }
    else { return *reinterpret_cast<const bf16x8*>(p); }
}
__device__ __forceinline__ void mask_tile(f32x16& p0, f32x16& p1, int dq, unsigned W) {
    const float NEG = -__builtin_inff();
#pragma unroll
    for (int r = 0; r < 16; ++r) {
        const int c = (r & 3) + 8 * (r >> 2);
        if ((unsigned)(dq - c) >= W) p0[r] = NEG;
        if ((unsigned)(dq - c - 32) >= W) p1[r] = NEG;
    }
}
__device__ __forceinline__ void partialSM(f32x16& p0, f32x16& p1, float& m_reg, float& mn, float& alpha) {
    float pmax = p0[0]; for (int r = 1; r < 16; ++r) pmax = fmaxf(pmax, p0[r]); for (int r = 0; r < 16; ++r) pmax = fmaxf(pmax, p1[r]);
    { auto rr = __builtin_amdgcn_permlane32_swap(__float_as_uint(pmax), __float_as_uint(pmax), false, false);
      pmax = fmaxf(__uint_as_float(rr[0]), __uint_as_float(rr[1])); }
    constexpr float C2 = 1.4426950408889634f * SCALE;
    if (__builtin_expect(__all((pmax - m_reg) * SCALE <= THR), 1)) { mn = m_reg; alpha = 1.f; }
    else { mn = fmaxf(m_reg, pmax); alpha = __builtin_amdgcn_exp2f((m_reg - mn) * C2); m_reg = mn; }
    const float mnL = -mn * C2;
    for (int r = 0; r < 16; ++r) p0[r] = fmaf(p0[r], C2, mnL); for (int r = 0; r < 16; ++r) p1[r] = fmaf(p1[r], C2, mnL);
    for (int r = 0; r < 16; ++r) p0[r] = __builtin_amdgcn_exp2f(p0[r]);
}
__device__ __forceinline__ void finishSM(f32x16& p0, f32x16& p1, float alpha, float& l_reg, bf16x8& pa0, bf16x8& pa1, bf16x8& pa2, bf16x8& pa3) {
    for (int r = 0; r < 16; ++r) p1[r] = __builtin_amdgcn_exp2f(p1[r]);
    float ps = 0; for (int r = 0; r < 16; ++r) ps += p0[r]; for (int r = 0; r < 16; ++r) ps += p1[r];
    { auto rr = __builtin_amdgcn_permlane32_swap(__float_as_uint(ps), __float_as_uint(ps), false, false);
      ps = __uint_as_float(rr[0]) + __uint_as_float(rr[1]); }
    l_reg = l_reg * alpha + ps;
#define PK4(P, B_, OUT) do { unsigned a0 = cvtpk(P[B_+0], P[B_+1]), a1 = cvtpk(P[B_+2], P[B_+3]);                          \
        unsigned b0 = cvtpk(P[B_+4], P[B_+5]), b1 = cvtpk(P[B_+6], P[B_+7]);                                             \
        auto r0 = __builtin_amdgcn_permlane32_swap(a0, b0, false, false); auto r1 = __builtin_amdgcn_permlane32_swap(a1, b1, false, false); \
        u32x4 w = {r0[0], r1[0], r0[1], r1[1]}; OUT = *reinterpret_cast<bf16x8*>(&w); } while (0)
    PK4(p0, 0, pa0); PK4(p0, 8, pa1); PK4(p1, 0, pa2); PK4(p1, 8, pa3);
#undef PK4
}
template <int KB, bool SK>
__device__ __forceinline__ void qkt(f32x16& p0, f32x16& p1, const char* K_lds, int r32, int hi, const bf16x8* qr, bool act) {
    if (SK && !act) { const float NEG = -__builtin_inff();
#pragma unroll
        for (int r = 0; r < 16; ++r) { p0[r] = NEG; p1[r] = NEG; } return; }
    p0 = f32x16{}; p1 = f32x16{};
    const char* kb[4];
#pragma unroll
    for (int dd = 0; dd < 4; ++dd) kb[dd] = K_lds + KB * SHM_K + KSWZ(r32, (dd * 16 + hi * 8) * 2);
#pragma unroll
    for (int d0 = 0; d0 < 8; ++d0) { const char* a = kb[d0 & 3] + (d0 >> 2) * 128;
        bf16x8 b0 = *reinterpret_cast<const bf16x8*>(a);
        bf16x8 b1 = *reinterpret_cast<const bf16x8*>(a + 32 * 256);
        p0 = __builtin_amdgcn_mfma_f32_32x32x16_bf16(b0, qr[d0], p0, 0, 0, 0);
        p1 = __builtin_amdgcn_mfma_f32_32x32x16_bf16(b1, qr[d0], p1, 0, 0, 0); }
}
template <int VB, bool SK>
__device__ __forceinline__ void pv_tile(f32x16* o, int vb0, bf16x8 pa0, bf16x8 pa1, bf16x8 pa2, bf16x8 pa3, bool act) {
    if (SK && !act) return;
#define TRRD(dst, off) asm volatile("ds_read_b64_tr_b16 %0, %1 offset:%2" : "=&v"(dst) : "v"(vb0), "i"(off) : "memory")
#define PV_D0(d0) do { s16x4 l0, l1, l2, l3, h0, h1, h2, h3; constexpr int b_ = VB * SHM_V + v_rd_off(d0, 0, 0);     \
        TRRD(l0, b_); TRRD(h0, b_ + 2048); TRRD(l1, b_ + 4096); TRRD(h1, b_ + 6144); TRRD(l2, b_ + 8192); TRRD(h2, b_ + 10240); TRRD(l3, b_ + 12288); TRRD(h3, b_ + 14336); \
        asm volatile("s_waitcnt lgkmcnt(0)" ::: "memory"); SBAR();                 \
        o[d0] = __builtin_amdgcn_mfma_f32_32x32x16_bf16(pa0, (bf16x8){l0[0], l0[1], l0[2], l0[3], h0[0], h0[1], h0[2], h0[3]}, o[d0], 0, 0, 0);   \
        o[d0] = __builtin_amdgcn_mfma_f32_32x32x16_bf16(pa1, (bf16x8){l1[0], l1[1], l1[2], l1[3], h1[0], h1[1], h1[2], h1[3]}, o[d0], 0, 0, 0);   \
        o[d0] = __builtin_amdgcn_mfma_f32_32x32x16_bf16(pa2, (bf16x8){l2[0], l2[1], l2[2], l2[3], h2[0], h2[1], h2[2], h2[3]}, o[d0], 0, 0, 0);   \
        o[d0] = __builtin_amdgcn_mfma_f32_32x32x16_bf16(pa3, (bf16x8){l3[0], l3[1], l3[2], l3[3], h3[0], h3[1], h3[2], h3[3]}, o[d0], 0, 0, 0); } while (0)
    PV_D0(0); PV_D0(1); PV_D0(2); PV_D0(3);
#undef PV_D0
#undef TRRD
}

struct BlockRef { const bf16* Q; const bf16* K; const bf16* V; bf16* O; float* LSE; int QS, KS, OS, LS, P0, skv, W; };
struct Seam { bf16x8 qr[8]; bf16x8 st_v0, st_v1, st_k0, st_k1; };
__device__ __forceinline__ int swa_jlo(int P0, int W) { const int lowk = P0 - W + 1; return lowk > 0 ? lowk / KVBLK : 0; }
#define LD8(p) (*reinterpret_cast<const bf16x8*>(p))
#define ROW(p, k0, rr, RS) ((p) + (size_t)((k0) + (rr)) * (RS) + sc)
#define VMW() asm volatile("s_waitcnt vmcnt(0)" ::: "memory")
#define VMWN(n) asm volatile("s_waitcnt vmcnt(%0)" :: "i"(n) : "memory")
#define SLOAD_H(Kp, Vp, k0, RS) do { const char* kb_ = (const char*)(Kp) + (size_t)(k0) * (size_t)(RS) * 2; const char* vb_ = (const char*)(Vp) + (size_t)(k0) * (size_t)(RS) * 2;  \
                         const unsigned oa_ = (unsigned)(sr * (RS) + sc) * 2u, ob_ = oa_ + (unsigned)(RS) * 64u;                                    \
                         S.st_v0 = LD8(vb_ + oa_); S.st_v1 = LD8(vb_ + ob_); S.st_k0 = LD8(kb_ + oa_); S.st_k1 = LD8(kb_ + ob_); } while (0)
#define SWRITE_HK(bf) do { *(bf16x8*)(K_lds + (bf) * SHM_K + kws) = S.st_k0; *(bf16x8*)(K_lds + (bf) * SHM_K + kws + 32 * 256) = S.st_k1; } while (0)
#define SWRITE_HV(bf) do { *(bf16x8*)(V_lds + (bf) * SHM_V + vst0) = S.st_v0; *(bf16x8*)(V_lds + (bf) * SHM_V + vst1) = S.st_v1; } while (0)
#define SWRITE_H(bf) do { SWRITE_HV(bf); SWRITE_HK(bf); } while (0)
__device__ __forceinline__ void swa_prime(const BlockRef& cur, char* lds, Seam& S) {
    int tid_ = threadIdx.x; asm volatile("" : "+v"(tid_));
    const int tid = tid_, wid = __builtin_amdgcn_readfirstlane(tid >> 6), lane = tid & 63, r32 = lane & 31, hi = lane >> 5;
    const int sr = tid >> 4, sc = (tid & 15) * 8, kws = KSWZ(sr, sc * 2); char* K_lds = lds + 2 * SHM_V;
    const int kb0 = swa_jlo(cur.P0, cur.W) * KVBLK;
    { const char* qb_ = (const char*)cur.Q + (size_t)(wid * QBLK) * (size_t)cur.QS * 2; const unsigned qo_ = (unsigned)(r32 * cur.QS + hi * 8) * 2u;
      for (int d0 = 0; d0 < 8; ++d0) S.qr[d0] = LD8(qb_ + qo_ + d0 * 32); }
    SLOAD_H(cur.K, cur.V, kb0, cur.KS); VMW(); SWRITE_HK(0);
    __syncthreads();
}
__device__ __forceinline__ void swa_block(const BlockRef& cur, const BlockRef& nxt, char* lds, Seam& S) {
    int tid_ = threadIdx.x; asm volatile("" : "+v"(tid_));
    const int tid = tid_, wid = __builtin_amdgcn_readfirstlane(tid >> 6), lane = tid & 63, r32 = lane & 31, hi = lane >> 5;
    const int W = cur.W, skv = cur.skv;
    const int j_lo = swa_jlo(cur.P0, W);
    int j_hi = (cur.P0 + QB - 1) / KVBLK + 1; if (j_hi > skv / KVBLK) j_hi = skv / KVBLK;
    const int NT = j_hi - j_lo;
    const int kbn = swa_jlo(nxt.P0, nxt.W) * KVBLK;
    const int qlo = cur.P0 + wid * QBLK, qm = qlo + r32 - 4 * hi;
    char* V_lds = lds; char* K_lds = lds + 2 * SHM_V;
    float* ws = (float*)(lds + 2 * SHM_V + 2 * SHM_K) + wid * 64; float* li_l = ws, * al_l = ws + 32;
    float m_reg = -1e30f, l_reg = 0; f32x16 o[4] = {};
    const int sr = tid >> 4, sc = (tid & 15) * 8, vst0 = v_st(sr, sc), vst1 = v_st(32 + sr, sc), kws = KSWZ(sr, sc * 2);
    const int vb0 = (int)(uintptr_t)V_lds + v_rd_base(lane);
    const bf16* Kh = cur.K; const bf16* Vh = cur.V; const int KSc = cur.KS;
#define RESC(a) do { if (__any((a) < 1.f)) { if (hi == 0) al_l[r32] = (a); asm volatile("s_waitcnt lgkmcnt(0)" ::: "memory");              \
                     for (int d_ = 0; d_ < 4; ++d_) for (int r = 0; r < 16; ++r) o[d_][r] *= al_l[crow(r, hi)]; } } while (0)
#define KBASE(t) ((j_lo + (t)) * KVBLK)
#define ACT(t) (KBASE(t) <= qlo + QBLK - 1 && KBASE(t) + KVBLK - 1 >= qlo - W + 1)
#define MASKT(P0_, P1_, t) do { const int kb_ = KBASE(t); if ((!SK || ACT(t)) && (kb_ + KVBLK - 1 > qlo || kb_ <= qlo + QBLK - 1 - W)) mask_tile(P0_, P1_, qm - kb_, (unsigned)W); } while (0)
    constexpr int NQL = 8;
    constexpr bool SK = true;
#define SEAM_K0() do { VMWN(NQL); SWRITE_HK(0); SBAR(); } while (0)
    f32x16 pA0, pA1, pB0, pB1; float mnA, mnB, alA, alB; bf16x8 pa0, pa1, pa2, pa3;
    SWRITE_HV(0); SBAR();
    if (NT > 1) { SLOAD_H(Kh, Vh, KBASE(1), KSc); }
    SBAR(); qkt<0, SK>(pA0, pA1, K_lds, r32, hi, S.qr, ACT(0));
    MASKT(pA0, pA1, 0); partialSM(pA0, pA1, m_reg, mnA, alA);
    if (NT > 1) { VMW(); SWRITE_H(1); }
    __syncthreads();
#define HALF_STEP(PX0, PX1, mnX, alX, PY0, PY1, alY, t, KB, VB, SB) do {                                                      \
        SBAR(); qkt<KB, SK>(PX0, PX1, K_lds, r32, hi, S.qr, ACT(t));                                             \
        finishSM(PY0, PY1, alY, l_reg, pa0, pa1, pa2, pa3); SBAR();                                                           \
        if ((t) + 1 < NT) { SLOAD_H(Kh, Vh, KBASE((t) + 1), KSc); SBAR(); }                                               \
        pv_tile<VB, SK>(o, vb0, pa0, pa1, pa2, pa3, ACT((t) - 1)); MASKT(PX0, PX1, (t)); partialSM(PX0, PX1, m_reg, mnX, alX);                                        \
        __syncthreads();                                                                                                      \
        if ((t) + 1 < NT) { VMW(); SWRITE_H(SB); }                                                                          \
        RESC(alX); __syncthreads(); } while (0)
    for (int t = 1; t + 1 < NT; t += 2) {
        HALF_STEP(pB0, pB1, mnB, alB, pA0, pA1, alA, t, 1, 0, 0);
        HALF_STEP(pA0, pA1, mnA, alA, pB0, pB1, alB, t + 1, 0, 1, 1);
    }
    const bool even = (NT & 1) == 0;
    if (even) { SBAR(); qkt<1, SK>(pB0, pB1, K_lds, r32, hi, S.qr, ACT(NT - 1)); SBAR(); }
    { SLOAD_H(nxt.K, nxt.V, kbn, nxt.KS); SBAR();
      const char* qb_ = (const char*)nxt.Q + (size_t)(wid * QBLK) * (size_t)nxt.QS * 2; const unsigned qo_ = (unsigned)(r32 * nxt.QS + hi * 8) * 2u;
#pragma unroll
        for (int d0 = 0; d0 < 8; ++d0) S.qr[d0] = LD8(qb_ + qo_ + d0 * 32); }
    SBAR();
    finishSM(pA0, pA1, alA, l_reg, pa0, pa1, pa2, pa3); SBAR();
    pv_tile<0, SK>(o, vb0, pa0, pa1, pa2, pa3, ACT(even ? NT - 2 : NT - 1));
    if (even) { MASKT(pB0, pB1, NT - 1); partialSM(pB0, pB1, m_reg, mnB, alB); __syncthreads(); RESC(alB);
        finishSM(pB0, pB1, alB, l_reg, pa0, pa1, pa2, pa3); SBAR(); pv_tile<1, SK>(o, vb0, pa0, pa1, pa2, pa3, ACT(NT - 1)); }
    SBAR(); SEAM_K0();
    if (hi == 0) li_l[r32] = l_reg; asm volatile("s_waitcnt lgkmcnt(0)" ::: "memory");
    if (cur.LSE != nullptr && hi == 0) cur.LSE[(size_t)(wid * QBLK + r32) * cur.LS] = __log2f(l_reg) + m_reg * (1.4426950408889634f * SCALE);
    float rli[16];
#pragma unroll
    for (int r = 0; r < 16; ++r) rli[r] = __builtin_amdgcn_rcpf(li_l[crow(r, hi)]);
    bf16* Ow = cur.O + (size_t)(wid * QBLK) * cur.OS;
#pragma unroll
    for (int r = 0; r < 16; ++r) { const int orow = crow(r, hi);
#pragma unroll
        for (int d0 = 0; d0 < 4; ++d0) { const float v = o[d0][r] * rli[r];
            const float vn = __shfl_xor(v, 1);
            if ((r32 & 1) == 0) *(unsigned*)(Ow + (size_t)orow * cur.OS + d0 * 32 + r32) = cvtpk(v, vn); } }
    __syncthreads();
#undef RESC
#undef KBASE
#undef ACT
#undef MASKT
#undef SEAM_K0
#undef HALF_STEP
}
#undef LD8
#undef ROW
#undef VMW
#undef VMWN
#undef SLOAD_H
#undef SWRITE_HK
#undef SWRITE_HV
#undef SWRITE_H
#undef KSWZ
#undef SBAR
}

constexpr int NWAVES = 8;
#ifndef MK_N_LAUNCHES
#define MK_N_LAUNCHES 1
#endif
constexpr int N_PHASES = 13;
constexpr float W8_SCALE = 32.0f, H8_SCALE = 8.0f;
constexpr int SC_ONE = 0x7f7f7f7f, SC_W8 = 0x7a7a7a7a  , SC_H8 = 0x7c7c7c7c  ;
#ifndef NAIVE_ATTN
#define NAIVE_ATTN 0
#endif
constexpr float ATT_QSCALE = NAIVE_ATTN ? QSCALE : 1.0f;

constexpr size_t MiB = 1u << 20;
constexpr size_t WS_CTL = 0, CTL_ZERO_BYTES = 1 * MiB;
constexpr size_t WS_WIN = 2 * MiB;
constexpr size_t WS_WB = 24 * MiB;
constexpr size_t WS_WO = 27 * MiB;
constexpr size_t WS_WMEM = WS_WIN + (size_t)9984 * 1024 * 2;
constexpr size_t WS_W1 = 29 * MiB;
constexpr size_t WS_W2 = 157 * MiB;
constexpr size_t WS_XN = 221 * MiB;
constexpr size_t WS_Z = 256 * MiB;
constexpr size_t WS_RW = 568 * MiB;
constexpr size_t WS_YS = 792 * MiB;
constexpr size_t WS_YABC = 824 * MiB;
constexpr size_t WS_MRG = 872 * MiB;
constexpr size_t WS_MRGB = 936 * MiB;
constexpr size_t WS_MEMN = WS_XN + (size_t)16384 * 1024 * 2;
constexpr size_t WS_KVM = 969 * MiB;
constexpr size_t WS_XN2 = 970 * MiB;
constexpr size_t WS_ROUTE = 1002 * MiB;
constexpr size_t WS_LORA = 1004 * MiB;
constexpr size_t WS_END = 1005 * MiB;
constexpr size_t WS_XS = 256 * MiB;
constexpr size_t WS_HACT = 400 * MiB;
constexpr size_t WS_YROWS = 544 * MiB;
constexpr size_t WS_OP = WS_MRG;
constexpr size_t WS_LSE = WS_MRGB;
constexpr size_t WS_CS = WS_RW;
constexpr size_t WS_VMIX = WS_RW + 32 * MiB, WS_GMIX = WS_RW + 64 * MiB;
constexpr size_t WS_XN8 = WS_YS, WS_WIN8 = WS_YS + 16 * MiB;
constexpr size_t RWSZ = (size_t)MTOK * RW * 4;
constexpr size_t RT_TOPI = 0, RT_TOPG = 256 * 1024, RT_POS = 512 * 1024, RT_ROWGATE = 768 * 1024;
static_assert(RT_ROWGATE + (size_t)MAX_SLOTS * 4 <= 1088 * 1024, "route");
constexpr int CW_TMO = 0, CW_CODE = 1;
constexpr int CW_BAR = 4096;
constexpr int CW_CNT = 16384;
constexpr int CW_CUR = 16384 + 2048;

constexpr int RING_OFF = 0, RING_BYTES = 131072;
constexpr int LDSCTL_OFF = 143360, MISC_OFF = LDSCTL_OFF + 320;
constexpr int MOETAB_OFF = MISC_OFF + 128;
constexpr int HIST_OFF = MOETAB_OFF + 1536;
constexpr int LDS_BYTES = 147456;
static_assert(HIST_OFF + 4 * 320 <= LDS_BYTES, "LDS map");
#define GAS __attribute__((address_space(1)))
#define LAS __attribute__((address_space(3)))
typedef unsigned short bf16;
typedef unsigned v4u __attribute__((ext_vector_type(4)));
typedef float f32x4 __attribute__((ext_vector_type(4)));
typedef short bf16x8 __attribute__((ext_vector_type(8)));
typedef GAS unsigned gu32;
typedef GAS unsigned long long gu64;
#define RLX_AGENT __ATOMIC_RELAXED, __HIP_MEMORY_SCOPE_AGENT
#define LDS_WAIT() asm volatile("s_waitcnt lgkmcnt(0)" ::: "memory")
#define VM_WAIT() asm volatile("s_waitcnt vmcnt(0)" ::: "memory")
__device__ __forceinline__ unsigned long long rt() { return __builtin_amdgcn_s_memrealtime(); }
typedef float f32x2_cv __attribute__((ext_vector_type(2))); typedef __bf16 bf16x2_cv __attribute__((ext_vector_type(2)));
__device__ __forceinline__ unsigned pk2(float lo, float hi) { f32x2_cv v = {lo, hi}; bf16x2_cv b = __builtin_convertvector(v, bf16x2_cv); return __builtin_bit_cast(unsigned, b); }
__device__ __forceinline__ unsigned f2bf(float f) { return pk2(f, f) & 0xffffu; }
#define XB_TMO      128
#define XB_XCNT(j)  (256  + 64 * (j))
#define XB_XSUB(j)  (1280 + 64 * (j))
#define XB_XGEN(j)  (2304 + 64 * (j))
#define XB_TOP      3328
#define XB_TOPGEN   3392
#define XCD_BAR_WORDS 3456
#define XB_SPIN_CAP (1u << 18)

__device__ __forceinline__ unsigned xb_ld(unsigned* p)              { return __hip_atomic_load(p, __ATOMIC_RELAXED, __HIP_MEMORY_SCOPE_AGENT); }
__device__ __forceinline__ unsigned xb_add(unsigned* p, unsigned v) { return __hip_atomic_fetch_add(p, v, __ATOMIC_RELAXED, __HIP_MEMORY_SCOPE_AGENT); }
__device__ __forceinline__ unsigned xb_xcc_id() { return (unsigned)__builtin_amdgcn_s_getreg((3 << 11) | 20) & 0xFu; }
#define XB_SPIN(cond, bar) do { unsigned _sp = 0; while (cond) { __builtin_amdgcn_s_sleep(1); \
    if ((++_sp & 255u) == 0u) { if (xb_ld(&(bar)[XB_TMO])) break; if (_sp > XB_SPIN_CAP) { atomicAdd(&(bar)[XB_TMO], 1u); break; } } } } while (0)

struct XcdBarrier {
    unsigned* bar; unsigned x;
    volatile LAS unsigned* st;
};

__device__ __forceinline__ XcdBarrier xcd_barrier_post(unsigned* bar, volatile LAS unsigned* st) {
    XcdBarrier b; b.bar = bar; b.x = xb_xcc_id(); b.st = st;
    if (threadIdx.x == 0) (void)xb_add(&bar[XB_XCNT(b.x)], 1u);
    return b;
}
__device__ __forceinline__ void xcd_barrier_complete(unsigned* bar, unsigned x, unsigned& nloc, unsigned& nx) {
    const unsigned G = gridDim.x * gridDim.y * gridDim.z;
    unsigned sum, cnt, mine, sp = 0u;
    for (;;) {
        sum = 0u; cnt = 0u; mine = 0u;
#pragma unroll
        for (unsigned j = 0; j < 16; ++j) { const unsigned c = xb_ld(&bar[XB_XCNT(j)]); sum += c; cnt += (c > 0u) ? 1u : 0u; mine = (j == x) ? c : mine; }
        if (sum == G) break;
        __builtin_amdgcn_s_sleep(1);
        if ((++sp & 255u) == 0u) { if (xb_ld(&bar[XB_TMO])) break; if (sp > XB_SPIN_CAP) { atomicAdd(&bar[XB_TMO], 1u); break; } }
    }
    nloc = mine > 0u ? mine : 1u; nx = cnt > 0u ? cnt : 1u;
}

__device__ __forceinline__ void xcd_barrier(const XcdBarrier& b) {
    asm volatile("s_waitcnt vmcnt(0)" ::: "memory");
    __syncthreads();
    if (threadIdx.x == 0) {
        unsigned* bar = b.bar;
        __builtin_amdgcn_s_waitcnt(0);
        unsigned nloc = b.st[0], nx = b.st[1];
        if (nloc == 0u) { xcd_barrier_complete(bar, b.x, nloc, nx); b.st[0] = nloc; b.st[1] = nx; }
        const unsigned old = xb_add(&bar[XB_XSUB(b.x)], 1u);
        const unsigned gen = old / nloc;
        if (old + 1u == (gen + 1u) * nloc) {
            __builtin_amdgcn_fence(__ATOMIC_RELEASE, "agent");
            asm volatile("s_waitcnt vmcnt(0)" ::: "memory");
            const unsigned og = xb_add(&bar[XB_TOP], 1u);
            const unsigned tg = og / nx;
            if (og + 1u == (tg + 1u) * nx) xb_add(&bar[XB_TOPGEN], 1u);
            else XB_SPIN(xb_ld(&bar[XB_TOPGEN]) == tg, bar);
            __builtin_amdgcn_fence(__ATOMIC_ACQUIRE, "agent");
            xb_add(&bar[XB_XGEN(b.x)], 1u);
            asm volatile("s_waitcnt vmcnt(0)" ::: "memory");
        } else {
            XB_SPIN(xb_ld(&bar[XB_XGEN(b.x)]) == gen, bar);
            __builtin_amdgcn_fence(__ATOMIC_ACQUIRE, "agent");
            asm volatile("s_waitcnt vmcnt(0)" ::: "memory");
        }
    }
    __syncthreads();
}

typedef float f32x2 __attribute__((ext_vector_type(2)));
struct Args { const float* in[32]; float* out; unsigned char* ws; int ph_lo, ph_hi, use_bar, pad; };
struct Frame {
    LAS unsigned char* lds;
    volatile LAS unsigned* MISC;
    gu32* ctl;
    int tid, lane, wave;
    int vcu, G;
    float* out;
    unsigned char* ws;
};
enum { I_X = 0, I_MEM, I_POS, I_NORM_MIX, I_W_IN, I_B_GATE, I_AQ_GAIN, I_AK_GAIN, I_R_MU, I_R_W0, I_R_W2, I_R_A0, I_R_A2, I_R_G2, I_R_KK, I_R_KA, I_R_RK, I_R_LNW, I_R_LNB,
       I_MEM_NORM, I_W_MEMKV, I_CQ_GAIN, I_CK_GAIN, I_W_BRANCH, I_W_OUT, I_NORM_FFN, I_ROUTER_W, I_ROUTER_B, I_EXP_W1, I_EXP_B1, I_EXP_W2, I_EXP_B2 };

__device__ __forceinline__ bool phase_enter(Frame& F, bool on) { int t = (int)threadIdx.x; asm volatile("" : "+v"(t)); F.tid = t; F.lane = t & 63; F.wave = __builtin_amdgcn_readfirstlane(t >> 6); return on; }
__device__ __forceinline__ const float* ldarg(int i) {
    const __attribute__((address_space(4))) char* ka = (const __attribute__((address_space(4))) char*)__builtin_amdgcn_kernarg_segment_ptr();
    asm volatile("" : "+s"(ka));
    return *(const float* const __attribute__((address_space(4)))*)(ka + 8 * i);
}
__device__ __forceinline__ unsigned pk4_fp8(float a, float b, float c, float d) { unsigned w = 0; w = __builtin_amdgcn_cvt_pk_fp8_f32(a, b, w, false); w = __builtin_amdgcn_cvt_pk_fp8_f32(c, d, w, true); return w; }
__device__ __forceinline__ float fast_sigm(float x) { return __builtin_amdgcn_rcpf(1.0f + __builtin_amdgcn_exp2f(-1.4426950408889634f * x)); }
__device__ __forceinline__ float fast_tanh(float x) { return 1.0f - 2.0f * __builtin_amdgcn_rcpf(1.0f + __builtin_amdgcn_exp2f(2.8853900817779268f * x)); }
__device__ __forceinline__ float fast_softplus(float y) { return fmaxf(y, 0.f) + 0.6931471805599453f * __builtin_amdgcn_logf(1.0f + __builtin_amdgcn_exp2f(-1.4426950408889634f * fabsf(y))); }
__device__ __forceinline__ int opq(int x) { asm volatile("" : "+v"(x)); return x; }
__device__ __forceinline__ float bf_lo(unsigned w) { return __builtin_bit_cast(float, w << 16); }
__device__ __forceinline__ float bf_hi(unsigned w) { return __builtin_bit_cast(float, w & 0xffff0000u); }
__device__ __forceinline__ float sigm(float x) { return 1.0f / (1.0f + __expf(-x)); }
template <int CTRL, int RM> __device__ __forceinline__ float dpp0(float v) {
    return __builtin_bit_cast(float, __builtin_amdgcn_update_dpp(0, __builtin_bit_cast(int, v), CTRL, RM, 0xf, true)); }
__device__ __forceinline__ float row16_sum(float v) {
    v += dpp0<0xB1, 0xf>(v); v += dpp0<0x4E, 0xf>(v); v += dpp0<0x141, 0xf>(v); v += dpp0<0x140, 0xf>(v); return v; }
__device__ __forceinline__ float rdlane(float v, int l) { return __builtin_bit_cast(float, __builtin_amdgcn_readlane(__builtin_bit_cast(int, v), l)); }
__device__ __forceinline__ float wave_sum(float v) {
    v = row16_sum(v); v += dpp0<0x142, 0xA>(v); v += dpp0<0x143, 0xC>(v); return rdlane(v, 63); }
__device__ __forceinline__ void half_sums(float v, float& lo, float& hi) {
    v = row16_sum(v); v += dpp0<0x142, 0xA>(v); lo = rdlane(v, 31); hi = rdlane(v, 63); }
__device__ __forceinline__ float wave_max_bp(float v) {
#pragma unroll
    for (int o = 1; o < 64; o <<= 1) v = fmaxf(v, __shfl_xor(v, o));
    return v; }

__device__ __forceinline__ void tconv_tile(const float* W, int K, int N, bf16* WT, int k0, int n0, int rowbase, int lane, int kd = 0) {
    const int c = lane & 15, q = lane >> 4;
    const GAS f32x4* src = (const GAS f32x4*)(W + (size_t)(k0 + 16 * q) * N + n0 + 4 * c);
    const size_t rs = (size_t)N / 4;
    f32x4 v[16];
#pragma unroll
    for (int i = 0; i < 16; ++i) v[i] = src[i * rs];
#pragma unroll
    for (int j = 0; j < 4; ++j) {
        GAS v4u* dst = (GAS v4u*)(WT + (size_t)(rowbase + 4 * c + j) * K + kd + k0 + 16 * q);
        v4u o0, o1;
        o0.x = pk2(v[0][j], v[1][j]); o0.y = pk2(v[2][j], v[3][j]); o0.z = pk2(v[4][j], v[5][j]); o0.w = pk2(v[6][j], v[7][j]);
        o1.x = pk2(v[8][j], v[9][j]); o1.y = pk2(v[10][j], v[11][j]); o1.z = pk2(v[12][j], v[13][j]); o1.w = pk2(v[14][j], v[15][j]);
        dst[0] = o0; dst[1] = o1;
    }
}
__device__ __forceinline__ void tconv_tile128(const float* W, int K, int N, bf16* WT, int k0, int n0, int rowbase, int lane) {
    const int c = lane & 31, q = lane >> 5;
    const GAS f32x4* src = (const GAS f32x4*)(W + (size_t)(k0 + 32 * q) * N + n0 + 4 * c);
    const size_t rs = (size_t)N / 4;
    f32x4 v[32];
#pragma unroll
    for (int i = 0; i < 32; ++i) v[i] = src[i * rs];
#pragma unroll
    for (int j = 0; j < 4; ++j) {
        GAS v4u* dst = (GAS v4u*)(WT + (size_t)(rowbase + 4 * c + j) * K + k0 + 32 * q);
#pragma unroll
        for (int g = 0; g < 4; ++g) { v4u o; o.x = pk2(v[8 * g][j], v[8 * g + 1][j]); o.y = pk2(v[8 * g + 2][j], v[8 * g + 3][j]); o.z = pk2(v[8 * g + 4][j], v[8 * g + 5][j]); o.w = pk2(v[8 * g + 6][j], v[8 * g + 7][j]); dst[g] = o; }
    }
}
__device__ __forceinline__ void tconv_tile_f8(const float* W, int K, int N, unsigned char* WT, int k0, int n0, int rowbase, int lane, float sc) {
    const int c = lane & 15, q = lane >> 4;
    const GAS f32x4* src = (const GAS f32x4*)(W + (size_t)(k0 + 16 * q) * N + n0 + 4 * c);
    const size_t rs = (size_t)N / 4;
    f32x4 v[16];
#pragma unroll
    for (int i = 0; i < 16; ++i) v[i] = src[i * rs] * sc;
#pragma unroll
    for (int j = 0; j < 4; ++j) {
        v4u o; o.x = pk4_fp8(v[0][j], v[1][j], v[2][j], v[3][j]); o.y = pk4_fp8(v[4][j], v[5][j], v[6][j], v[7][j]); o.z = pk4_fp8(v[8][j], v[9][j], v[10][j], v[11][j]); o.w = pk4_fp8(v[12][j], v[13][j], v[14][j], v[15][j]);
        *(GAS v4u*)(WT + (size_t)(rowbase + 4 * c + j) * K + k0 + 16 * q) = o;
    }
}
__device__ __forceinline__ void tc8_load(const float* W, int N, int k0, int n0, int lane, f32x4 (&v)[16]) {
    const int c = lane & 15, q = lane >> 4; const GAS f32x4* src = (const GAS f32x4*)(W + (size_t)(k0 + 16 * q) * N + n0 + 4 * c); const size_t rs = (size_t)N / 4;
#pragma unroll
    for (int i = 0; i < 16; ++i) v[i] = src[i * rs];
}
__device__ __forceinline__ void tc8_store(unsigned char* WT, int K, int k0, int rowbase, int lane, const f32x4 (&v)[16], float sc) {
    const int c = lane & 15, q = lane >> 4;
#pragma unroll
    for (int j = 0; j < 4; ++j) {
        v4u o; o.x = pk4_fp8(v[0][j] * sc, v[1][j] * sc, v[2][j] * sc, v[3][j] * sc); o.y = pk4_fp8(v[4][j] * sc, v[5][j] * sc, v[6][j] * sc, v[7][j] * sc);
        o.z = pk4_fp8(v[8][j] * sc, v[9][j] * sc, v[10][j] * sc, v[11][j] * sc); o.w = pk4_fp8(v[12][j] * sc, v[13][j] * sc, v[14][j] * sc, v[15][j] * sc);
        *(GAS v4u*)(WT + (size_t)(rowbase + 4 * c + j) * K + k0 + 16 * q) = o; }
}
__device__ __forceinline__ void w1_tile(int r, const float* W1, unsigned char* W1T, const float*& W, unsigned char*& WT, int& k0, int& n0, int& rowbase) {
    const int e = r / 512, q = r % 512, kb = q % 16, nb = q / 16; n0 = 64 * nb; k0 = 64 * kb;
    rowbase = (n0 < 1024) ? ((n0 >> 7) * 256 + (n0 & 127)) : ((((n0 - 1024) >> 7) * 256) + 128 + ((n0 - 1024) & 127));
    W = W1 + (size_t)e * 1024 * 2048; WT = W1T + (size_t)e * 2048 * 1024;
}
__device__ __forceinline__ void rms_row_to_bf16(const float* xrow, const float* gain, bf16* orow, int lane, unsigned char* orow8 = nullptr) {
    const GAS f32x4* xr = (const GAS f32x4*)xrow + lane; const GAS f32x4* gr = (const GAS f32x4*)gain + lane;
    f32x4 v[4]; float s = 0.f;
#pragma unroll
    for (int j = 0; j < 4; ++j) { v[j] = xr[64 * j]; s += (v[j].x * v[j].x + v[j].y * v[j].y) + (v[j].z * v[j].z + v[j].w * v[j].w); }
    const float rstd = 1.0f / sqrtf(wave_sum(s) * (1.f / D_MODEL) + NORM_EPS);
    GAS unsigned long long* o8 = (GAS unsigned long long*)orow + lane;
#pragma unroll
    for (int j = 0; j < 4; ++j) { const f32x4 g = gr[64 * j];
        o8[64 * j] = (unsigned long long)pk2(v[j].x * rstd * g.x, v[j].y * rstd * g.y) | ((unsigned long long)pk2(v[j].z * rstd * g.z, v[j].w * rstd * g.w) << 32);
        if (orow8) ((GAS unsigned*)orow8 + lane)[64 * j] = pk4_fp8(v[j].x * rstd * g.x, v[j].y * rstd * g.y, v[j].z * rstd * g.z, v[j].w * rstd * g.w); }
}
template <int PART> __device__ __forceinline__ void p0_prologue(Frame& F, const Args& args, int gw, int NGW) {
    const int lane = F.lane;
    unsigned char* ws = F.ws;
    constexpr int T_IN = 16 * 156, T_WB = 3 * 128, T_WO = 256, T_WM = 256, T_W1 = 32 * 512, T_W2 = 32 * 256, T_LO = 32;
    constexpr int NT = T_IN + T_WB + T_WO + T_WM + T_W1 + T_W2;
    constexpr int IT0 = (PART == 0) ? 0 : (PART == 1) ? T_IN + T_WB + T_WO + T_WM + T_W1 : T_IN + T_WB + T_WO + T_WM, IT1 = (PART == 0) ? T_IN + T_WB + T_WO + T_WM : (PART == 1) ? NT : T_IN + T_WB + T_WO + T_WM + T_W1;
    for (int it = IT0 + gw; it < IT1; it += NGW) {
        int r = it;
        if (r < T_IN) { const int kb = r / 156, nb = r % 156, nt = nb >> 2;
            if (nt >= 27) tconv_tile_f8(ldarg(I_W_IN), 1024, IN_COLS, ws + WS_WIN8, 64 * kb, 64 * nb, 64 * nb, lane, W8_SCALE);
            else tconv_tile(ldarg(I_W_IN), 1024, IN_COLS, (bf16*)(ws + WS_WIN), 64 * kb, 64 * nb, 64 * nb, lane);
            continue; } r -= T_IN;
        if (r < T_WB) { const int b = r / 128, q = r % 128, kb = q / 16, nb = q % 16;
            tconv_tile(ldarg(I_W_BRANCH) + (size_t)b * 512 * 1024, 1536, 1024, (bf16*)(ws + WS_WB), 64 * kb, 64 * nb, 64 * nb, lane, 512 * b); continue; } r -= T_WB;
        if (r < T_WO) { const int kb = r / 16, nb = r % 16; tconv_tile(ldarg(I_W_OUT), 1024, 1024, (bf16*)(ws + WS_WO), 64 * kb, 64 * nb, 64 * nb, lane); continue; } r -= T_WO;
        if (r < T_WM) { const int kb = r / 16, nb = r % 16; tconv_tile(ldarg(I_W_MEMKV), 1024, 1024, (bf16*)(ws + WS_WMEM), 64 * kb, 64 * nb, 64 * nb, lane); continue; } r -= T_WM;
        if (r < T_W1) { const int e = r / 512, q = r % 512, kb = q % 16, nb = q / 16, n0 = 64 * nb;
            const int rowbase = (n0 < 1024) ? ((n0 >> 7) * 256 + (n0 & 127)) : ((((n0 - 1024) >> 7) * 256) + 128 + ((n0 - 1024) & 127));
            tconv_tile_f8(ldarg(I_EXP_W1) + (size_t)e * 1024 * 2048, 1024, 2048, ws + WS_W1 + (size_t)e * 2048 * 1024, 64 * kb, n0, rowbase, lane, W8_SCALE); continue; } r -= T_W1;
        { const int e = r / 256, q = r % 256, kb = q % 16, nb = q / 16;
            tconv_tile_f8(ldarg(I_EXP_W2) + (size_t)e * 1024 * 1024, 1024, 1024, ws + WS_W2 + (size_t)e * 1024 * 1024, 64 * kb, 64 * nb, 64 * nb, lane, W8_SCALE); }
    }
    if (PART == 0) {
    for (int it = gw; it < T_LO; it += NGW) {
        bf16* L = (bf16*)(ws + WS_LORA);
        if (it < 8) tconv_tile(ldarg(I_R_W2), 64, 512, L, 0, 64 * it, 64 * it, lane);
        else if (it < 16) tconv_tile(ldarg(I_R_A2), 64, 512, L + 512 * 64, 0, 64 * (it - 8), 64 * (it - 8), lane);
        else { const int q = it - 16; tconv_tile(ldarg(I_R_G2), 128, 512, L + 2 * 512 * 64, 64 * (q >> 3), 64 * (q & 7), 64 * (q & 7), lane); } }
    { const int* posp = (const int*)ldarg(I_POS); float* cs = (float*)(ws + WS_CS);
      for (int idx = gw * 64 + lane; idx < MTOK * 16; idx += NGW * 64) { const int m = idx >> 4, i = idx & 15; const float ang = (float)posp[m] * exp2f(-(float)i * (18.931568569324174f / 16.0f)); const float sn = sinf(ang), cn = cosf(ang);
          f32x2 o; o.x = cn; o.y = sn; *(GAS f32x2*)(cs + (size_t)idx * 2) = o; } }
    for (int m = gw; m < MTOK; m += NGW) rms_row_to_bf16(ldarg(I_X) + (size_t)m * D_MODEL, ldarg(I_NORM_MIX), (bf16*)(ws + WS_XN) + (size_t)m * D_MODEL, lane, ws + WS_XN8 + (size_t)m * D_MODEL);
    for (int m = gw; m < MEMROWS; m += NGW) rms_row_to_bf16(ldarg(I_MEM) + (size_t)m * D_MODEL, ldarg(I_MEM_NORM), (bf16*)(ws + WS_MEMN) + (size_t)m * D_MODEL, lane);
    }
}

__device__ __forceinline__ void head_norm(bf16* p, const float* gain, bool rot, float c0, float s0, float c1, float s1, float scale, int lane) {
    GAS unsigned* pw = (GAS unsigned*)p + lane;
    const unsigned w = *pw; float a = bf_lo(w), b = bf_hi(w);
    const float ss = wave_sum(a * a + b * b);
    const float rstd = 1.0f / sqrtf(ss * (1.f / 128.f) + NORM_EPS);
    const f32x2 g = *((const GAS f32x2*)gain + lane);
    a = a * rstd * g.x; b = b * rstd * g.y;
    const float pa = __shfl_xor(a, 8), pb = __shfl_xor(b, 8);
    if (rot && lane < 16) {
        if (lane < 8) { a = a * c0 - pa * s0; b = b * c1 - pb * s1; }
        else          { a = a * c0 + pa * s0; b = b * c1 + pb * s1; }
    }
    *pw = pk2(a * scale, b * scale);
}
__device__ __forceinline__ void p2_prep(Frame& F, const Args& args) {
    const int gw = F.vcu * NWAVES + F.wave, NGW = F.G * NWAVES, lane = F.lane;
    unsigned char* ws = F.ws;
    bf16* Z = (bf16*)(ws + WS_Z);
    LAS float* lo = (LAS float*)(F.lds + RING_OFF + F.wave * 8192);
    const float* mu = ldarg(I_R_MU); const float* aqg = ldarg(I_AQ_GAIN); const float* akg = ldarg(I_AK_GAIN); const float* cqg = ldarg(I_CQ_GAIN); const int* posp = (const int*)ldarg(I_POS);
    float* Rr = (float*)(ws + WS_RW); float* Rw = Rr + (size_t)MTOK * RW; float* Rk = Rw + (size_t)MTOK * RW; float* Rv = Rk + (size_t)MTOK * RW;
    float* Ra = Rv + (size_t)MTOK * RW; float* Rb = Ra + (size_t)MTOK * RW; float* Rg = Rb + (size_t)MTOK * RW;
    for (int m = gw; m < MEMROWS; m += NGW)
        for (int hd = 0; hd < 4; ++hd) head_norm((bf16*)(ws + WS_KVM) + (size_t)m * 1024 + hd * 128, ldarg(I_CK_GAIN), false, 1.f, 0.f, 1.f, 0.f, 1.0f, lane);
}

__device__ __forceinline__ void lora_stage(const float* W, LAS unsigned* wl, int tid) {
#pragma unroll
    for (int i = 0; i < 16; ++i) { const int idx = tid + 512 * i; const f32x4 v = *((const GAS f32x4*)W + idx);
        *(LAS unsigned long long*)(wl + 2 * idx) = (unsigned long long)pk2(v.x, v.y) | ((unsigned long long)pk2(v.z, v.w) << 32); }
}
__device__ __forceinline__ void lora_mac(const LAS unsigned* wl, const LAS float* lo, float (&acc)[4][8], int lane) {
#pragma unroll 4
    for (int j = 0; j < 64; ++j) { const f32x4 xin = *(const LAS f32x4*)(lo + j * 4);
#pragma unroll
        for (int i = 0; i < 4; ++i) { const unsigned w = wl[j * 256 + lane + 64 * i]; const float w0 = bf_lo(w), w1 = bf_hi(w);
#pragma unroll
            for (int tt = 0; tt < 4; ++tt) { acc[tt][2 * i] += xin[tt] * w0; acc[tt][2 * i + 1] += xin[tt] * w1; } } }
}
template <int NL> __device__ __forceinline__ void lora_in(const bf16* Z, const float* mu, int ch, int m0, LAS float* lo, int lane) {
    const int col = OFF_R + 1536 + ch; const float muj = mu[1536 + ch];
    float prv = ((m0 % SEQ) == 0) ? 0.f : __builtin_bit_cast(float, (unsigned)Z[(size_t)(m0 - 1) * IN_COLS + col] << 16);
#pragma unroll
    for (int tt = 0; tt < 4; ++tt) { const float cur = __builtin_bit_cast(float, (unsigned)Z[(size_t)(m0 + tt) * IN_COLS + col] << 16);
        float x = cur + (prv - cur) * muj; prv = cur;
        x = (NL == 0) ? tanhf(x) : (NL == 1) ? x : sigm(x);
        lo[lane * 4 + tt] = x; }
    LDS_WAIT(); asm volatile("" ::: "memory");
}
__device__ __forceinline__ void p2_rwkv(Frame& F, const Args& args) {
    const int lane = F.lane, wave = F.wave;
    unsigned char* ws = F.ws;
    const bf16* Z = (const bf16*)(ws + WS_Z);
    LAS unsigned* wl = (LAS unsigned*)(F.lds + RING_OFF);
    LAS float* lo = (LAS float*)(F.lds + RING_OFF + 65536 + wave * 1024);
    const float* mu = ldarg(I_R_MU);
    float* Rr = (float*)(ws + WS_RW); float* Rw = Rr + (size_t)MTOK * RW; float* Rk = Rw + (size_t)MTOK * RW; float* Rv = Rk + (size_t)MTOK * RW;
    float* Ra = Rv + (size_t)MTOK * RW; float* Rb = Ra + (size_t)MTOK * RW; float* Rg = Rb + (size_t)MTOK * RW;
    for (int grp = F.vcu; grp < MTOK / 64; grp += F.G) {
        const int mw = grp * 64 + wave * 8;
        lora_stage(ldarg(I_R_W2), wl, F.tid);
        __syncthreads();
        for (int tk = 0; tk < 2; ++tk) { const int m0 = mw + 4 * tk;
            lora_in<0>(Z, mu, lane, m0, lo, lane);
            float acc[4][8];
#pragma unroll
            for (int tt = 0; tt < 4; ++tt)
#pragma unroll
                for (int c = 0; c < 8; ++c) acc[tt][c] = 0.f;
            lora_mac(wl, lo, acc, lane);
            const float* w0p = ldarg(I_R_W0);
#pragma unroll
            for (int i = 0; i < 4; ++i) { const int c = 2 * lane + 128 * i; const f32x2 w0 = *(const GAS f32x2*)(w0p + c);
#pragma unroll
                for (int tt = 0; tt < 4; ++tt) { const float y0 = -(w0.x + acc[tt][2 * i]), y1 = -(w0.y + acc[tt][2 * i + 1]);
                    const float sp0 = fmaxf(y0, 0.f) + log1pf(__expf(-fabsf(y0))), sp1 = fmaxf(y1, 0.f) + log1pf(__expf(-fabsf(y1)));
                    f32x2 wd; wd.x = -__expf(-sp0 - 0.5f); wd.y = -__expf(-sp1 - 0.5f);
                    *(GAS f32x2*)(Rw + (size_t)(m0 + tt) * RW + c) = wd; } }
            LDS_WAIT(); asm volatile("" ::: "memory"); }
        __syncthreads();
        lora_stage(ldarg(I_R_A2), wl, F.tid);
        __syncthreads();
        for (int tk = 0; tk < 2; ++tk) { const int m0 = mw + 4 * tk; const int tpos0 = m0 % SEQ;
            lora_in<1>(Z, mu, 64 + lane, m0, lo, lane);
            float acca[4][8];
#pragma unroll
            for (int tt = 0; tt < 4; ++tt)
#pragma unroll
                for (int c = 0; c < 8; ++c) acca[tt][c] = 0.f;
            lora_mac(wl, lo, acca, lane);
            const float* a0p = ldarg(I_R_A0); const float* kkp = ldarg(I_R_KK); const float* kap = ldarg(I_R_KA);
#pragma unroll
            for (int i = 0; i < 4; ++i) {
                const int c = 2 * lane + 128 * i;
                const f32x2 a0 = *(const GAS f32x2*)(a0p + c), kkc = *(const GAS f32x2*)(kkp + c), kac = *(const GAS f32x2*)(kap + c);
                const f32x2 mur = *(const GAS f32x2*)(mu + c), muk = *(const GAS f32x2*)(mu + 512 + c), muv = *(const GAS f32x2*)(mu + 1024 + c);
                unsigned pr = 0u, pk = 0u, pv = 0u;
                if (tpos0 != 0) { const bf16* zp = Z + (size_t)(m0 - 1) * IN_COLS + OFF_R + c; pr = *(const GAS unsigned*)zp; pk = *(const GAS unsigned*)(zp + 512); pv = *(const GAS unsigned*)(zp + 1024); }
#pragma unroll
                for (int tt = 0; tt < 4; ++tt) {
                    const size_t m = (size_t)(m0 + tt);
                    const bf16* zc = Z + m * IN_COLS + OFF_R + c;
                    const unsigned cr = *(const GAS unsigned*)zc, ck = *(const GAS unsigned*)(zc + 512), cv = *(const GAS unsigned*)(zc + 1024);
                    f32x2 r, k, v;
                    r.x = bf_lo(cr) + (bf_lo(pr) - bf_lo(cr)) * mur.x; r.y = bf_hi(cr) + (bf_hi(pr) - bf_hi(cr)) * mur.y;
                    k.x = bf_lo(ck) + (bf_lo(pk) - bf_lo(ck)) * muk.x; k.y = bf_hi(ck) + (bf_hi(pk) - bf_hi(ck)) * muk.y;
                    v.x = bf_lo(cv) + (bf_lo(pv) - bf_lo(cv)) * muv.x; v.y = bf_hi(cv) + (bf_hi(pv) - bf_hi(cv)) * muv.y;
                    pr = cr; pk = ck; pv = cv;
                    f32x2 av; av.x = sigm(a0.x + acca[tt][2 * i]); av.y = sigm(a0.y + acca[tt][2 * i + 1]);
                    f32x2 kk; kk.x = k.x * kkc.x; kk.y = k.y * kkc.y;
                    float slo, shi; half_sums(kk.x * kk.x + kk.y * kk.y, slo, shi);
                    const float nrm = fmaxf(sqrtf(lane < 32 ? slo : shi), 1e-12f), inv = 1.0f / nrm;
                    kk.x *= inv; kk.y *= inv;
                    f32x2 k2; k2.x = k.x * (1.0f + (av.x - 1.0f) * kac.x); k2.y = k.y * (1.0f + (av.y - 1.0f) * kac.y);
                    f32x2 as, bs; as.x = -kk.x; as.y = -kk.y; bs.x = kk.x * av.x; bs.y = kk.y * av.y;
                    const size_t o = m * RW + c;
                    *(GAS f32x2*)(Rr + o) = r; *(GAS f32x2*)(Rk + o) = k2; *(GAS f32x2*)(Rv + o) = v; *(GAS f32x2*)(Ra + o) = as; *(GAS f32x2*)(Rb + o) = bs;
                }
            }
            LDS_WAIT(); asm volatile("" ::: "memory"); }
        __syncthreads();
        float accg[2][4][8];
#pragma unroll
        for (int tk = 0; tk < 2; ++tk)
#pragma unroll
            for (int tt = 0; tt < 4; ++tt)
#pragma unroll
                for (int c = 0; c < 8; ++c) accg[tk][tt][c] = 0.f;
#pragma unroll
        for (int hh = 0; hh < 2; ++hh) {
            lora_stage(ldarg(I_R_G2) + (size_t)hh * 64 * RW, wl, F.tid);
            __syncthreads();
#pragma unroll
            for (int tk = 0; tk < 2; ++tk) { lora_in<2>(Z, mu, 128 + 64 * hh + lane, mw + 4 * tk, lo, lane); lora_mac(wl, lo, accg[tk], lane); LDS_WAIT(); asm volatile("" ::: "memory"); }
            __syncthreads();
        }
#pragma unroll
        for (int tk = 0; tk < 2; ++tk)
#pragma unroll
            for (int i = 0; i < 4; ++i)
#pragma unroll
                for (int tt = 0; tt < 4; ++tt) { f32x2 gg; gg.x = accg[tk][tt][2 * i]; gg.y = accg[tk][tt][2 * i + 1]; *(GAS f32x2*)(Rg + (size_t)(mw + 4 * tk + tt) * RW + 2 * lane + 128 * i) = gg; }
    }
}

__device__ __forceinline__ float qk_dot(const LAS float* q, const bf16* krow) {
    const GAS v4u* kp = (const GAS v4u*)krow; float s0 = 0.f, s1 = 0.f;
#pragma unroll
    for (int i = 0; i < 16; ++i) { const v4u w = kp[i]; const f32x4 qa = *(const LAS f32x4*)(q + 8 * i), qb = *(const LAS f32x4*)(q + 8 * i + 4);
        s0 += bf_lo(w.x) * qa[0] + bf_hi(w.x) * qa[1] + bf_lo(w.y) * qa[2] + bf_hi(w.y) * qa[3];
        s1 += bf_lo(w.z) * qb[0] + bf_hi(w.z) * qb[1] + bf_lo(w.w) * qb[2] + bf_hi(w.w) * qb[3]; }
    return s0 + s1;
}
__device__ __forceinline__ void p3_attention(Frame& F) {
    const int gw = F.vcu * NWAVES + F.wave, NGW = F.G * NWAVES, lane = F.lane;
    unsigned char* ws = F.ws;
    const bf16* Z = (const bf16*)(ws + WS_Z);
    const bf16* KV = (const bf16*)(ws + WS_KVM);
    bf16* YA = (bf16*)(ws + WS_YABC); bf16* YC = YA + (size_t)2 * MTOK * 512;
    LAS float* qs = (LAS float*)(F.lds + RING_OFF + F.wave * 8192);
    for (int task = gw; task < MTOK * 4; task += NGW) {
        const int m = task >> 2, h = task & 3, t = m % SEQ;
        const bf16* zrow = Z + (size_t)m * IN_COLS;
#pragma unroll
        for (int g = 0; g < 3; ++g) { const unsigned w = *((const GAS unsigned*)(zrow + OFF_AQ + g * 512 + h * 128) + lane); qs[g * 128 + 2 * lane] = bf_lo(w); qs[g * 128 + 2 * lane + 1] = bf_hi(w); }
        LDS_WAIT(); asm volatile("" ::: "memory");
        float sc[3][3]; float mx = -INFINITY;
#pragma unroll
        for (int g = 0; g < 3; ++g) { const int dl = (g == 0) ? 1 : (g == 1) ? 4 : 16;
#pragma unroll
            for (int p = 0; p < 3; ++p) { const int j = lane + 64 * p; const int tk = t - dl * j; float s = -INFINITY;
                if (j <= 128 && tk >= 0) s = qk_dot(qs + g * 128, zrow - (size_t)dl * j * IN_COLS + OFF_AK + g * 512 + h * 128);
                sc[g][p] = s; mx = fmaxf(mx, s); } }
        mx = wave_max_bp(mx);
        float den = 0.f;
#pragma unroll
        for (int g = 0; g < 3; ++g)
#pragma unroll
            for (int p = 0; p < 3; ++p) { sc[g][p] = exp2f(sc[g][p] - mx); den += sc[g][p]; }
        den = wave_sum(den);
        float o0 = 0.f, o1 = 0.f;
#pragma unroll
        for (int g = 0; g < 3; ++g) { const int dl = (g == 0) ? 1 : (g == 1) ? 4 : 16; const bf16* vb = zrow + OFF_AV + g * 512 + h * 128 + 2 * lane;
#pragma unroll
            for (int p = 0; p < 3; ++p) { const int nj = (p < 2) ? 64 : 1;
                for (int jj = 0; jj < nj; ++jj) { const int j = jj + 64 * p; const float pj = rdlane(sc[g][p], jj);
                    if (t - dl * j >= 0) { const unsigned w = *(const GAS unsigned*)(vb - (size_t)dl * j * IN_COLS); o0 += pj * bf_lo(w); o1 += pj * bf_hi(w); } } } }
        const float inv = 1.0f / den;
        *((GAS unsigned*)(YA + (size_t)m * 512 + h * 128) + lane) = pk2(o0 * inv, o1 * inv);
        asm volatile("" ::: "memory");
    }
    for (int task = gw; task < MTOK * 4; task += NGW) {
        const int m = task >> 2, h = task & 3, b = m / SEQ;
        const bf16* zrow = Z + (size_t)m * IN_COLS;
        { const unsigned w = *((const GAS unsigned*)(zrow + OFF_CQ + h * 128) + lane); qs[2 * lane] = bf_lo(w); qs[2 * lane + 1] = bf_hi(w); }
        LDS_WAIT(); asm volatile("" ::: "memory");
        const bf16* kb = KV + (size_t)b * MEM_LEN * 1024 + h * 128;
        float sc[4]; float mx = -INFINITY;
#pragma unroll
        for (int p = 0; p < 4; ++p) { sc[p] = qk_dot(qs, kb + (size_t)(lane + 64 * p) * 1024); mx = fmaxf(mx, sc[p]); }
        mx = wave_max_bp(mx);
        float den = 0.f;
#pragma unroll
        for (int p = 0; p < 4; ++p) { sc[p] = exp2f(sc[p] - mx); den += sc[p]; }
        den = wave_sum(den);
        float o0 = 0.f, o1 = 0.f; const bf16* vb = kb + 512 + 2 * lane;
#pragma unroll
        for (int p = 0; p < 4; ++p)
            for (int jj = 0; jj < 64; ++jj) { const float pj = rdlane(sc[p], jj); const unsigned w = *(const GAS unsigned*)(vb + (size_t)(jj + 64 * p) * 1024); o0 += pj * bf_lo(w); o1 += pj * bf_hi(w); }
        const float inv = 1.0f / den;
        *((GAS unsigned*)(YC + (size_t)m * 512 + h * 128) + lane) = pk2(o0 * inv, o1 * inv);
        asm volatile("" ::: "memory");
    }
}

__device__ __forceinline__ void p5_post(Frame& F, const Args& args) {
    const int gw = F.vcu * NWAVES + F.wave, NGW = F.G * NWAVES, lane = F.lane;
    unsigned char* ws = F.ws;
    const float* Rr = (const float*)(ws + WS_RW); const float* Rk = Rr + (size_t)2 * MTOK * RW; const float* Rv = Rk + (size_t)MTOK * RW; const float* Rg = Rr + (size_t)6 * MTOK * RW;
    const float* YS = (const float*)(ws + WS_YS);
    bf16* YB = (bf16*)(ws + WS_YABC) + (size_t)MTOK * 512;
    const bf16* OP = (const bf16*)(ws + WS_OP); const float* LS = (const float*)(ws + WS_LSE); bf16* YA = (bf16*)(ws + WS_YABC);
    for (int m = gw; m < MTOK; m += NGW) {
        float l0[4], l1[4], l2[4]; unsigned pa[4], pb[4], pc[4];
#pragma unroll
        for (int h = 0; h < 4; ++h) { l0[h] = LS[(size_t)m * 4 + h]; l1[h] = LS[(size_t)MTOK * 4 + (size_t)m * 4 + h]; l2[h] = LS[(size_t)2 * MTOK * 4 + (size_t)m * 4 + h];
            const size_t o = (size_t)m * 512 + h * 128;
            pa[h] = *((const GAS unsigned*)(OP + o) + lane); pb[h] = *((const GAS unsigned*)(OP + (size_t)MTOK * 512 + o) + lane); pc[h] = *((const GAS unsigned*)(OP + (size_t)2 * MTOK * 512 + o) + lane); }
#pragma unroll
        for (int h = 0; h < 4; ++h) {
            const float mx = fmaxf(l0[h], fmaxf(l1[h], l2[h])); const float w0 = exp2f(l0[h] - mx), w1 = exp2f(l1[h] - mx), w2 = exp2f(l2[h] - mx); const float inv = __builtin_amdgcn_rcpf(w0 + w1 + w2);
            *((GAS unsigned*)(YA + (size_t)m * 1536 + h * 128) + lane) = pk2((w0 * bf_lo(pa[h]) + w1 * bf_lo(pb[h]) + w2 * bf_lo(pc[h])) * inv, (w0 * bf_hi(pa[h]) + w1 * bf_hi(pb[h]) + w2 * bf_hi(pc[h])) * inv); }
    }
}

__device__ __forceinline__ void p8_router(Frame& F, const Args& args) {
    const int lane = F.lane, wave = F.wave;
    unsigned char* ws = F.ws;
    const float* X1 = F.out;
    LAS int* hist = (LAS int*)(F.lds + HIST_OFF);
    { const int t_ = opq(F.tid); if (t_ < 32) hist[t_] = 0; }
    int* topi = (int*)(ws + WS_ROUTE + RT_TOPI); float* topg = (float*)(ws + WS_ROUTE + RT_TOPG);
    const float* RWt = ldarg(I_ROUTER_W); const float* RB = ldarg(I_ROUTER_B); const float* gain = ldarg(I_NORM_FFN);
    LAS float* rw = (LAS float*)(F.lds + RING_OFF);
    typedef float f32x16r __attribute__((ext_vector_type(16)));
    for (int grp = F.vcu; grp < MTOK / 64; grp += F.G) {
#pragma unroll
        for (int i = 0; i < 16; ++i) { const int f = F.tid + 512 * i, k = f >> 3; const f32x4 w = *((const GAS f32x4*)RWt + f); const float g = gain[k]; ((LAS f32x4*)rw)[f] = w * g; }
        __syncthreads();
        const int tile = wave >> 2, wq = wave & 3, i32 = lane & 31, h = lane >> 5;
        const GAS f32x4* xp = (const GAS f32x4*)(X1 + ((size_t)grp * 64 + tile * 32 + i32) * D_MODEL + wq * 256 + 4 * h);
        const LAS float* bp = rw + (wq * 256 + 4 * h) * 32 + i32;
        f32x16r acc;
#pragma unroll
        for (int r = 0; r < 16; ++r) acc[r] = 0.f;
        float ss = 0.f;
#pragma unroll 4
        for (int q = 0; q < 32; ++q) { const f32x4 xv = xp[2 * q]; ss += (xv.x * xv.x + xv.y * xv.y) + (xv.z * xv.z + xv.w * xv.w);
#pragma unroll
            for (int j = 0; j < 4; ++j) acc = __builtin_amdgcn_mfma_f32_32x32x2f32(xv[j], bp[(8 * q + j) * 32], acc, 0, 0, 0); }
        __syncthreads();
        { LAS float* part = rw + (tile * 4 + wq) * 1024;
#pragma unroll
          for (int r = 0; r < 16; ++r) part[((r & 3) + 8 * (r >> 2) + 4 * h) * 32 + i32] = acc[r];
          rw[8192 + (tile * 4 + wq) * 64 + lane] = ss; }
        __syncthreads();
        if (F.tid < 64) { const int t = F.tid, tl = t >> 5, row = t & 31; const size_t m = (size_t)grp * 64 + t;
            float s = 0.f;
#pragma unroll
            for (int q = 0; q < 4; ++q) s += rw[8192 + (tl * 4 + q) * 64 + row] + rw[8192 + (tl * 4 + q) * 64 + 32 + row];
            const float rstd = 1.0f / sqrtf(s * (1.f / D_MODEL) + NORM_EPS);
            float lg[32];
#pragma unroll
            for (int e = 0; e < 32; ++e) { const LAS float* pp = rw + (tl * 4) * 1024 + row * 32 + e; lg[e] = ((pp[0] + pp[1024]) + (pp[2048] + pp[3072])) * rstd + RB[e]; }
            int ti[4]; float tv[4];
#pragma unroll
            for (int k = 0; k < 4; ++k) { float best = -INFINITY; int bi = 0;
#pragma unroll
                for (int e = 0; e < 32; ++e) { const bool taken = (k > 0 && ti[0] == e) || (k > 1 && ti[1] == e) || (k > 2 && ti[2] == e); if (!taken && lg[e] > best) { best = lg[e]; bi = e; } }
                ti[k] = bi; tv[k] = best; }
            const float e1 = __expf(tv[1] - tv[0]), e2 = __expf(tv[2] - tv[0]), e3 = __expf(tv[3] - tv[0]); const float inv = 1.0f / (1.0f + e1 + e2 + e3);
            { typedef int i32x4 __attribute__((ext_vector_type(4))); *(GAS i32x4*)(topi + m * 4) = (i32x4){ti[0], ti[1], ti[2], ti[3]}; } *(GAS f32x4*)(topg + m * 4) = (f32x4){inv, e1 * inv, e2 * inv, e3 * inv};
#pragma unroll
            for (int k = 0; k < 4; ++k) __hip_atomic_fetch_add(hist + ti[k], 1, __ATOMIC_RELAXED, __HIP_MEMORY_SCOPE_WORKGROUP); }
        __syncthreads();
    }
    { const int t_ = opq(F.tid); if (t_ < 32 && hist[t_] != 0) __hip_atomic_fetch_add((unsigned*)(F.ctl + CW_CNT) + 64 * t_, (unsigned)hist[t_], __ATOMIC_RELAXED, __HIP_MEMORY_SCOPE_AGENT); }
}
__device__ __forceinline__ void moe_table(Frame& F) {
    LAS int* tab = (LAS int*)(F.lds + MOETAB_OFF);
    __syncthreads();
    if (F.tid < 64) {
        const int e = opq(F.tid); int nb = 0;
        if (e < 32) { const int c = (int)__hip_atomic_load((unsigned*)(F.ctl + CW_CNT) + 64 * e, __ATOMIC_RELAXED, __HIP_MEMORY_SCOPE_AGENT); nb = (c + MOE_ROWS - 1) / MOE_ROWS; }
        int acc = 0;
#pragma unroll
        for (int j = 0; j < 32; ++j) { const int v = __builtin_amdgcn_readlane(nb, j); acc += (j < e) ? v : 0; }
        if (e < 32) { tab[320 + e] = acc * MOE_ROWS; for (int q = 0; q < nb; ++q) tab[1 + acc + q] = e; }
        if (e == 32) tab[0] = acc; }
    __syncthreads();
}
__device__ __forceinline__ void p9_dispatch(Frame& F, const Args& args) {
    const int lane = F.lane;
    unsigned char* ws = F.ws;
    moe_table(F);
    const LAS int* tab = (const LAS int*)(F.lds + MOETAB_OFF);
    LAS int* hist = (LAS int*)(F.lds + HIST_OFF); LAS int* base = hist + 32; LAS int* slots = hist + 64;
    const int* topi = (const int*)(ws + WS_ROUTE + RT_TOPI); const float* topg = (const float*)(ws + WS_ROUTE + RT_TOPG);
    int* pos = (int*)(ws + WS_ROUTE + RT_POS); float* rowgate = (float*)(ws + WS_ROUTE + RT_ROWGATE);
    bf16* XS = (bf16*)(ws + WS_XS); const float* gain = ldarg(I_NORM_FFN);
    for (int grp = F.vcu; grp < MTOK / 64; grp += F.G) {
        const int t_ = opq(F.tid);
        if (t_ < 32) hist[t_] = 0;
        f32x4 v[8][4];
#pragma unroll
        for (int i = 0; i < 8; ++i) { const GAS f32x4* xr = (const GAS f32x4*)(F.out + ((size_t)grp * 64 + F.wave * 8 + i) * D_MODEL) + 2 * lane;
#pragma unroll
            for (int j = 0; j < 4; ++j) v[i][j] = xr[128 * (j >> 1) + (j & 1)]; }
        const GAS f32x4* gr = (const GAS f32x4*)gain + 2 * lane; const f32x4 g00 = gr[0], g01 = gr[1], g10 = gr[128], g11 = gr[129];
        __syncthreads();
        int e = 0, rank = 0;
        if (F.tid < 256) { e = topi[(size_t)grp * 256 + F.tid]; rank = __hip_atomic_fetch_add(hist + e, 1, __ATOMIC_RELAXED, __HIP_MEMORY_SCOPE_WORKGROUP); }
        __syncthreads();
        if (F.tid < 32) { const int h = hist[F.tid]; int b0 = 0; if (h != 0) b0 = (int)__hip_atomic_fetch_add((unsigned*)(F.ctl + CW_CUR) + 64 * F.tid, (unsigned)h, __ATOMIC_RELAXED, __HIP_MEMORY_SCOPE_AGENT); base[F.tid] = tab[320 + F.tid] + b0; }
        __syncthreads();
        if (F.tid < 256) { const int slot = base[e] + rank; pos[(size_t)grp * 256 + F.tid] = slot; rowgate[slot] = topg[(size_t)grp * 256 + F.tid]; slots[F.tid] = slot; }
        __syncthreads();
        {
#pragma unroll
          for (int i = 0; i < 8; ++i) { const int tl = F.wave * 8 + i;
              float s = 0.f;
#pragma unroll
              for (int j = 0; j < 4; ++j) s += (v[i][j].x * v[i][j].x + v[i][j].y * v[i][j].y) + (v[i][j].z * v[i][j].z + v[i][j].w * v[i][j].w);
              const float rstd = 1.0f / sqrtf(wave_sum(s) * (1.f / D_MODEL) + NORM_EPS);
              unsigned long long o[2];
              { const f32x4 a = v[i][0] * rstd * g00, b = v[i][1] * rstd * g01; o[0] = (unsigned long long)pk4_fp8(a.x, a.y, a.z, a.w) | ((unsigned long long)pk4_fp8(b.x, b.y, b.z, b.w) << 32); }
              { const f32x4 a = v[i][2] * rstd * g10, b = v[i][3] * rstd * g11; o[1] = (unsigned long long)pk4_fp8(a.x, a.y, a.z, a.w) | ((unsigned long long)pk4_fp8(b.x, b.y, b.z, b.w) << 32); }
#pragma unroll
              for (int k = 0; k < 4; ++k) { const int sk = slots[tl * 4 + k]; GAS unsigned long long* dst = (GAS unsigned long long*)((unsigned char*)XS + (size_t)sk * D_MODEL) + lane; dst[0] = o[0]; dst[64] = o[1]; } } }
        __syncthreads();
    }
}
__device__ __forceinline__ void p12_combine(Frame& F) {
    const int gw = F.vcu * NWAVES + F.wave, NGW = F.G * NWAVES, lane = F.lane;
    unsigned char* ws = F.ws;
    const int* pos = (const int*)(ws + WS_ROUTE + RT_POS); const bf16* YR = (const bf16*)(ws + WS_YROWS);
    for (int blk = gw; blk < MTOK / 8; blk += NGW) {
        const int m0 = blk * 8;
        int pk = 0; if (lane < 32) pk = pos[(size_t)m0 * 4 + lane];
#pragma unroll
        for (int tp = 0; tp < 4; ++tp) {
            f32x4 a[2][2], b[2][2]; unsigned long long w[2][2][4];
#pragma unroll
            for (int u = 0; u < 2; ++u) { const int t = 2 * tp + u; GAS f32x4* xo = (GAS f32x4*)(F.out + (size_t)(m0 + t) * D_MODEL) + 2 * lane;
#pragma unroll
                for (int hf = 0; hf < 2; ++hf) { a[u][hf] = xo[128 * hf]; b[u][hf] = xo[128 * hf + 1];
#pragma unroll
                    for (int k = 0; k < 4; ++k) { const int sk = __builtin_amdgcn_readlane(pk, 4 * t + k); w[u][hf][k] = *((const GAS unsigned long long*)((const unsigned char*)YR + (size_t)sk * D_MODEL + 512 * hf) + lane); } } }
#pragma unroll
            for (int u = 0; u < 2; ++u) { const int t = 2 * tp + u; GAS f32x4* xo = (GAS f32x4*)(F.out + (size_t)(m0 + t) * D_MODEL) + 2 * lane;
#pragma unroll
                for (int hf = 0; hf < 2; ++hf) { f32x4 aa = a[u][hf], bb = b[u][hf];
#pragma unroll
                    for (int k = 0; k < 4; ++k) { const unsigned lo_ = (unsigned)w[u][hf][k], hi_ = (unsigned)(w[u][hf][k] >> 32);
                        const f32x2 p0 = __builtin_amdgcn_cvt_pk_f32_fp8(lo_, false), p1 = __builtin_amdgcn_cvt_pk_f32_fp8(lo_, true), p2 = __builtin_amdgcn_cvt_pk_f32_fp8(hi_, false), p3 = __builtin_amdgcn_cvt_pk_f32_fp8(hi_, true);
                        aa[0] += p0.x * 0.0625f; aa[1] += p0.y * 0.0625f; aa[2] += p1.x * 0.0625f; aa[3] += p1.y * 0.0625f; bb[0] += p2.x * 0.0625f; bb[1] += p2.y * 0.0625f; bb[2] += p3.x * 0.0625f; bb[3] += p3.y * 0.0625f; }
                    xo[128 * hf] = aa; xo[128 * hf + 1] = bb; } }
        }
    }
}

constexpr int N_ATT_A = 768, N_ATT_C = 256;
__device__ __forceinline__ swa::BlockRef attn_item(unsigned char* ws, int it) {
    swa::BlockRef r;
    const swa::bf16* Z = (const swa::bf16*)(ws + WS_Z);
    if (it < N_ATT_A) {
        const int h = it & 3, b = (it >> 2) & 1, v = it >> 3;
        int g, rr, qb;
        if (v < 32) { g = 0; rr = 0; qb = v; } else if (v < 64) { g = 1; rr = (v - 32) >> 3; qb = (v - 32) & 7; } else { g = 2; rr = (v - 64) >> 1; qb = (v - 64) & 1; }
        const int d = (g == 0) ? 1 : (g == 1) ? 4 : 16;
        const size_t row0 = (size_t)b * SEQ + rr, qrow = row0 + (size_t)d * qb * 256;
        r.Q = Z + qrow * IN_COLS + OFF_AQ + g * 512 + h * 128; r.K = Z + row0 * IN_COLS + OFF_AK + g * 512 + h * 128; r.V = Z + row0 * IN_COLS + OFF_AV + g * 512 + h * 128;
        r.O = (swa::bf16*)(ws + WS_OP) + (size_t)g * MTOK * 512 + qrow * 512 + h * 128; r.LSE = (float*)(ws + WS_LSE) + (size_t)g * MTOK * 4 + qrow * 4 + h;
        r.QS = d * IN_COLS; r.KS = d * IN_COLS; r.OS = d * 512; r.LS = d * 4; r.P0 = qb * 256; r.skv = SEQ / d; r.W = 129;
    } else {
        const int u = it - N_ATT_A, h = u & 3, b = (u >> 2) & 1, qb = u >> 3;
        const size_t qrow = (size_t)b * SEQ + (size_t)qb * 256;
        const swa::bf16* KV = (const swa::bf16*)(ws + WS_KVM) + (size_t)b * MEM_LEN * 1024 + h * 128;
        r.Q = Z + qrow * IN_COLS + OFF_CQ + h * 128; r.K = KV; r.V = KV + 512;
        r.O = (swa::bf16*)(ws + WS_YABC) + qrow * 1536 + 1024 + h * 128; r.LSE = nullptr;
        r.QS = IN_COLS; r.KS = 1024; r.OS = 1536; r.LS = 0; r.P0 = 256; r.skv = MEM_LEN; r.W = 1 << 20;
    }
    return r;
}
__device__ __forceinline__ void p3_attention_mfma(unsigned char* ws, char* lds, int G) {
    const int total = N_ATT_A + N_ATT_C; int L = blockIdx.x; if (L >= total) return;
    swa::BlockRef cur = attn_item(ws, L); swa::Seam S;
    swa::swa_prime(cur, lds, S);
    for (;;) {
        const int Ln = L + G; const bool last = Ln >= total;
        const swa::BlockRef nxt = last ? cur : attn_item(ws, Ln);
        swa::swa_block(cur, nxt, lds, S);
        if (last) break;
        cur = nxt; L = Ln;
    }
}

constexpr int N_RITEMS = BATCH * 8 * (SEQ / 64);
constexpr size_t WS_PHI = WS_XN;
constexpr size_t WS_PSI = WS_XN + 16 * MiB;
constexpr size_t WS_GAM = WS_YS;
constexpr size_t WS_OM = WS_XN2;
constexpr size_t WS_XFR = WS_MRG + 48 * MiB;
constexpr size_t WS_BONUS = WS_MRGB + 1 * MiB;
constexpr int RB = 9216, RLD = 72;
constexpr int R1_SEG = 15 * RB, R1_WC = R1_SEG + 2048;
static_assert(R1_WC + 256 <= LDSCTL_OFF, "R1 LDS map");
typedef LAS unsigned short* lbf_t;
__device__ __forceinline__ f32x4 r1_tile(const LAS unsigned short* X, const LAS unsigned short* Yt, int mi, int ni, f32x4 acc, int fr, int fq) {
    const LAS unsigned short* xp = X + (16 * mi + fr) * RLD + 8 * fq; const LAS unsigned short* yp = Yt + (16 * ni + fr) * RLD + 8 * fq;
    const bf16x8 a0 = *(const LAS bf16x8*)xp, a1 = *(const LAS bf16x8*)(xp + 32), b0 = *(const LAS bf16x8*)yp, b1 = *(const LAS bf16x8*)(yp + 32);
    acc = __builtin_amdgcn_mfma_f32_16x16x32_bf16(b0, a0, acc, 0, 0, 0);
    acc = __builtin_amdgcn_mfma_f32_16x16x32_bf16(b1, a1, acc, 0, 0, 0);
    return acc;
}
__device__ __forceinline__ void r1_store(LAS unsigned short* dst, int mi, int ni, f32x4 acc, int mode, bool addI, const LAS unsigned short* addT, int fr, int fq) {
    const int m = 16 * mi + fr, n0 = 16 * ni + 4 * fq;
#pragma unroll
    for (int r = 0; r < 4; ++r) { const int n = n0 + r; bool keep = true;
        if (mode == 1) keep = n < m; else if (mode == 2) keep = n <= m; else if (mode == 3) keep = m < n;
        float v = keep ? acc[r] : 0.f; if (addI && m == n) v += 1.0f; acc[r] = v; }
    if (addT != nullptr) { const unsigned long long w = *(const LAS unsigned long long*)(addT + m * RLD + n0);
        acc[0] += bf_lo((unsigned)w); acc[1] += bf_hi((unsigned)w); acc[2] += bf_lo((unsigned)(w >> 32)); acc[3] += bf_hi((unsigned)(w >> 32)); }
    *(LAS unsigned long long*)(dst + m * RLD + n0) = (unsigned long long)pk2(acc[0], acc[1]) | ((unsigned long long)pk2(acc[2], acc[3]) << 32);
}
#define R1BUF(i) ((LAS unsigned short*)(F.lds + (i) * RB))
template <int MODE> __device__ __forceinline__ void p_r1(Frame& F, const Args& args) {
    unsigned char* ws = F.ws; const int lane0 = F.lane, wave = F.wave;
    const bf16* Z = (const bf16*)(ws + WS_Z);
    const float* rkp = ldarg(I_R_RK); const float* mu = ldarg(I_R_MU); const float* w0p = ldarg(I_R_W0); const float* a0p = ldarg(I_R_A0); const float* kkp = ldarg(I_R_KK); const float* kap = ldarg(I_R_KA);
    const float* w1src = ldarg(I_EXP_W1);
    const bf16* W2T = (const bf16*)(ws + WS_LORA); const bf16* A2T = W2T + 512 * 64; const bf16* G2T = A2T + 512 * 64;
    bf16* VM = (bf16*)(ws + WS_VMIX); bf16* GM = (bf16*)(ws + WS_GMIX);
    LAS float* segsum = (LAS float*)(F.lds + R1_SEG); LAS float* wcs = (LAS float*)(F.lds + R1_WC);
    unsigned short zv[7][9];
#define R1LOAD(it_) do { const int bh_ = (it_) >> 7, c_ = (it_) & 127, h_ = bh_ & 7, t0_ = c_ * 64 + 8 * wave; \
        const bf16* zp_ = Z + ((size_t)(bh_ >> 3) * SEQ + t0_) * IN_COLS + OFF_R + lane; \
        _Pragma("unroll") for (int i = 0; i < 9; ++i) { const bool ok_ = (i > 0) || (t0_ > 0); const bf16* rp_ = zp_ + ((long)i - 1) * IN_COLS; const bf16* rq_ = rp_ + 64 * h_;     \
            zv[0][i] = ok_ ? rp_[1536] : (unsigned short)0; zv[1][i] = ok_ ? rp_[1600] : (unsigned short)0; zv[2][i] = ok_ ? rp_[1664] : (unsigned short)0; zv[3][i] = ok_ ? rp_[1728] : (unsigned short)0; \
            zv[4][i] = ok_ ? rq_[0] : (unsigned short)0; zv[5][i] = ok_ ? rq_[512] : (unsigned short)0; zv[6][i] = ok_ ? rq_[1024] : (unsigned short)0; } } while (0)
#define ZF(x) __builtin_bit_cast(float, (unsigned)(x) << 16)
    { const int lane = lane0; if (F.vcu < N_RITEMS) R1LOAD(F.vcu); }
    for (int item = F.vcu; item < N_RITEMS; item += F.G) {
        const int lane = opq(lane0), fr = lane & 15, fq = lane >> 4;
        const int bh = item >> 7, c = item & 127, b = bh >> 3, h = bh & 7;
        const size_t row0 = (size_t)b * SEQ + (size_t)c * 64;
        f32x4 tcv[16]; const float* tcW; unsigned char* tcWT; int tck0, tcn0, tcrb;
        w1_tile(item * 8 + wave, w1src, ws + WS_W1, tcW, tcWT, tck0, tcn0, tcrb); tc8_load(tcW, 2048, tck0, tcn0, lane, tcv);
        const f32x4 zero4 = (f32x4){0.f, 0.f, 0.f, 0.f};
        const int mw = wave >> 2, nw = wave & 3;
        float r[8], lw[8], kx[8], vx[8], ax[8], bx[8];
        { const int k = lane, tq = wave, ch = h * 64 + k;
#pragma unroll
          for (int g = 0; g < 4; ++g) { const float mug = mu[1536 + 64 * g + k];
#pragma unroll
              for (int i = 0; i < 8; ++i) { const float cur = ZF(zv[g][i + 1]), prv = ZF(zv[g][i]); float x = cur + (prv - cur) * mug;
                  x = (g == 0) ? fast_tanh(x) : (g == 1) ? x : fast_sigm(x); const unsigned short xb = (unsigned short)f2bf(x); const int t = 8 * tq + i;
                  if (g == 0) R1BUF(11)[t * RLD + k] = xb; else if (g == 1) R1BUF(12)[t * RLD + k] = xb; else R1BUF(13)[t * 136 + 64 * (g - 2) + k] = xb; } }
          { const int tid_ = wave * 64 + lane, row = tid_ >> 3, chk = tid_ & 7;
            *(LAS v4u*)(R1BUF(5) + row * RLD + chk * 8) = *(const GAS v4u*)(W2T + (size_t)(64 * h + row) * 64 + chk * 8);
            *(LAS v4u*)(R1BUF(6) + row * RLD + chk * 8) = *(const GAS v4u*)(A2T + (size_t)(64 * h + row) * 64 + chk * 8);
#pragma unroll
            for (int hh = 0; hh < 2; ++hh) { const int rg = (tid_ >> 4) + 32 * hh, cg = tid_ & 15;
                *(LAS v4u*)(R1BUF(7) + rg * 136 + cg * 8) = *(const GAS v4u*)(G2T + (size_t)(64 * h + rg) * 128 + cg * 8); } }
          __syncthreads();
          { f32x4 dw0, dw1, da0, da1, dg0 = zero4, dg1 = zero4;
            { const LAS unsigned short* yp_ = R1BUF(5) + (16 * nw + fr) * RLD + 8 * fq; const LAS unsigned short* xp_ = R1BUF(11) + (16 * mw + fr) * RLD + 8 * fq;
              const bf16x8 y0_ = *(const LAS bf16x8*)yp_, y1_ = *(const LAS bf16x8*)(yp_ + 32), xa0_ = *(const LAS bf16x8*)xp_, xa1_ = *(const LAS bf16x8*)(xp_ + 32), xb0_ = *(const LAS bf16x8*)(xp_ + 32 * RLD), xb1_ = *(const LAS bf16x8*)(xp_ + 32 * RLD + 32);
              dw0 = __builtin_amdgcn_mfma_f32_16x16x32_bf16(y0_, xa0_, zero4, 0, 0, 0); dw1 = __builtin_amdgcn_mfma_f32_16x16x32_bf16(y0_, xb0_, zero4, 0, 0, 0);
              dw0 = __builtin_amdgcn_mfma_f32_16x16x32_bf16(y1_, xa1_, dw0, 0, 0, 0); dw1 = __builtin_amdgcn_mfma_f32_16x16x32_bf16(y1_, xb1_, dw1, 0, 0, 0); }
            { const LAS unsigned short* yp_ = R1BUF(6) + (16 * nw + fr) * RLD + 8 * fq; const LAS unsigned short* xp_ = R1BUF(12) + (16 * mw + fr) * RLD + 8 * fq;
              const bf16x8 y0_ = *(const LAS bf16x8*)yp_, y1_ = *(const LAS bf16x8*)(yp_ + 32), xa0_ = *(const LAS bf16x8*)xp_, xa1_ = *(const LAS bf16x8*)(xp_ + 32), xb0_ = *(const LAS bf16x8*)(xp_ + 32 * RLD), xb1_ = *(const LAS bf16x8*)(xp_ + 32 * RLD + 32);
              da0 = __builtin_amdgcn_mfma_f32_16x16x32_bf16(y0_, xa0_, zero4, 0, 0, 0); da1 = __builtin_amdgcn_mfma_f32_16x16x32_bf16(y0_, xb0_, zero4, 0, 0, 0);
              da0 = __builtin_amdgcn_mfma_f32_16x16x32_bf16(y1_, xa1_, da0, 0, 0, 0); da1 = __builtin_amdgcn_mfma_f32_16x16x32_bf16(y1_, xb1_, da1, 0, 0, 0); }
            { const LAS unsigned short* yp_ = R1BUF(7) + (16 * nw + fr) * 136 + 8 * fq; const LAS unsigned short* xp_ = R1BUF(13) + (16 * mw + fr) * 136 + 8 * fq;
#pragma unroll
              for (int kk = 0; kk < 4; ++kk) { const bf16x8 y_ = *(const LAS bf16x8*)(yp_ + 32 * kk), xa_ = *(const LAS bf16x8*)(xp_ + 32 * kk), xb_ = *(const LAS bf16x8*)(xp_ + 32 * 136 + 32 * kk);
                  dg0 = __builtin_amdgcn_mfma_f32_16x16x32_bf16(y_, xa_, dg0, 0, 0, 0); dg1 = __builtin_amdgcn_mfma_f32_16x16x32_bf16(y_, xb_, dg1, 0, 0, 0); } }
            const int o0 = (16 * mw + fr) * 68 + 16 * nw + 4 * fq, o1 = o0 + 32 * 68;
            *(LAS f32x4*)((LAS float*)R1BUF(0) + o0) = dw0; *(LAS f32x4*)((LAS float*)R1BUF(0) + o1) = dw1;
            *(LAS f32x4*)((LAS float*)R1BUF(2) + o0) = da0; *(LAS f32x4*)((LAS float*)R1BUF(2) + o1) = da1;
            *(LAS f32x4*)((LAS float*)R1BUF(9) + o0) = dg0; *(LAS f32x4*)((LAS float*)R1BUF(9) + o1) = dg1; }
          __syncthreads();
          { const float w0c = w0p[ch], a0c = a0p[ch], kkc = kkp[ch], kac = kap[ch], mur = mu[ch], muk = mu[512 + ch], muv = mu[1024 + ch];
#pragma unroll
            for (int i = 0; i < 8; ++i) { const int t = 8 * tq + i;
                const float dwv = ((const LAS float*)R1BUF(0))[t * 68 + k], dav = ((const LAS float*)R1BUF(2))[t * 68 + k], dgv = ((const LAS float*)R1BUF(9))[t * 68 + k];
                const float cr = ZF(zv[4][i + 1]), pr = ZF(zv[4][i]), ck = ZF(zv[5][i + 1]), pk = ZF(zv[5][i]), cv = ZF(zv[6][i + 1]), pv = ZF(zv[6][i]);
                const float rr = cr + (pr - cr) * mur, kr = ck + (pk - ck) * muk, vr = cv + (pv - cv) * muv;
                const float y = -(w0c + dwv); const float sp = fast_softplus(y);
                lw[i] = -__expf(-sp - 0.5f);
                const float av = fast_sigm(a0c + dav);
                const float kkv = kr * kkc; const float ssq = wave_sum(kkv * kkv); const float kkn = kkv * __builtin_amdgcn_rsqf(fmaxf(ssq, 1e-24f));
                r[i] = rr; vx[i] = vr; kx[i] = kr * (1.0f + (av - 1.0f) * kac); ax[i] = -kkn; bx[i] = kkn * av;
                if (MODE == 0) { VM[(row0 + t) * RW + ch] = (bf16)f2bf(vr); GM[(row0 + t) * RW + ch] = (bf16)f2bf(dgv); } } }
        }
        if (item + F.G < N_RITEMS) R1LOAD(item + F.G);
        { const int k = lane, tq = wave;
          float cs[8]; cs[0] = lw[0];
#pragma unroll
          for (int i = 1; i < 8; ++i) cs[i] = cs[i - 1] + lw[i];
          segsum[tq * 64 + k] = cs[7];
          const float rk = rkp[h * 64 + k];
#pragma unroll
          for (int i = 0; i < 8; ++i) { const float bs = wave_sum(r[i] * kx[i] * rk); if (MODE == 0 && lane == 0) *(GAS float*)((float*)(ws + WS_BONUS) + (row0 + 8 * tq + i) * 8 + h) = bs; }
          __syncthreads();
          float pre = 0.f;
#pragma unroll
          for (int q = 0; q < 7; ++q) { const float sv = segsum[q * 64 + k]; pre += (q < tq) ? sv : 0.f; }
          unsigned short at[8], rt[8], bt[8], kt[8], vt[8];
#pragma unroll
          for (int i = 0; i < 8; ++i) { const float L = pre + cs[i], Lp = L - lw[i]; const float e = __expf(L), ep = __expf(Lp), ei = __expf(-L);
              at[i] = (unsigned short)f2bf(ax[i] * ep); rt[i] = (unsigned short)f2bf(r[i] * e); bt[i] = (unsigned short)f2bf(bx[i] * ei); kt[i] = (unsigned short)f2bf(kx[i] * ei); vt[i] = (unsigned short)f2bf(vx[i]);
              if (i == 7 && tq == 7) wcs[k] = e; }
#pragma unroll
          for (int i = 0; i < 8; ++i) { const int o = (8 * tq + i) * RLD + k; R1BUF(8)[o] = at[i]; R1BUF(4)[o] = rt[i]; R1BUF(9)[o] = bt[i]; R1BUF(10)[o] = kt[i]; }
          const int ot = k * RLD + 8 * tq;
#define PK8(x) ((v4u){(unsigned)x[0] | ((unsigned)x[1] << 16), (unsigned)x[2] | ((unsigned)x[3] << 16), (unsigned)x[4] | ((unsigned)x[5] << 16), (unsigned)x[6] | ((unsigned)x[7] << 16)})
          *(LAS v4u*)(R1BUF(0) + ot) = PK8(at); *(LAS v4u*)(R1BUF(1) + ot) = PK8(bt); *(LAS v4u*)(R1BUF(2) + ot) = PK8(kt); *(LAS v4u*)(R1BUF(3) + ot) = PK8(vt);
#undef PK8
        }
        __syncthreads();
#define R1PAIR(X, Y, a0, a1) do { const LAS unsigned short* yp_ = (Y) + (16 * nw + fr) * RLD + 8 * fq; const LAS unsigned short* xp_ = (X) + (16 * mw + fr) * RLD + 8 * fq; \
            const bf16x8 y0_ = *(const LAS bf16x8*)yp_, y1_ = *(const LAS bf16x8*)(yp_ + 32), xa0_ = *(const LAS bf16x8*)xp_, xa1_ = *(const LAS bf16x8*)(xp_ + 32), xb0_ = *(const LAS bf16x8*)(xp_ + 32 * RLD), xb1_ = *(const LAS bf16x8*)(xp_ + 32 * RLD + 32); \
            a0 = __builtin_amdgcn_mfma_f32_16x16x32_bf16(y0_, xa0_, zero4, 0, 0, 0); a1 = __builtin_amdgcn_mfma_f32_16x16x32_bf16(y0_, xb0_, zero4, 0, 0, 0); \
            a0 = __builtin_amdgcn_mfma_f32_16x16x32_bf16(y1_, xa1_, a0, 0, 0, 0); a1 = __builtin_amdgcn_mfma_f32_16x16x32_bf16(y1_, xb1_, a1, 0, 0, 0); } while (0)
#define R1ST2(dst, a0, a1, mode, addI, addT) do { r1_store(dst, mw, nw, a0, mode, addI, addT, fr, fq); r1_store(dst, mw + 2, nw, a1, mode, addI, addT, fr, fq); } while (0)
        { f32x4 n0, n1, t0, t1, l0, l1, b0, b1, k0, k1;
          R1PAIR(R1BUF(8), R1BUF(9), n0, n1); R1PAIR(R1BUF(9), R1BUF(8), t0, t1); R1PAIR(R1BUF(8), R1BUF(10), l0, l1); R1PAIR(R1BUF(4), R1BUF(9), b0, b1); R1PAIR(R1BUF(4), R1BUF(10), k0, k1);
          R1ST2(R1BUF(11), n0, n1, 1, false, nullptr); R1ST2(R1BUF(13), n0, n1, 1, true, nullptr); R1ST2(R1BUF(12), t0, t1, 3, false, nullptr);
          R1ST2(R1BUF(5), l0, l1, 1, false, nullptr); R1ST2(R1BUF(6), b0, b1, 2, false, nullptr); R1ST2(R1BUF(7), k0, k1, 2, false, nullptr); }
        __syncthreads();
        { f32x4 n0, n1, t0, t1, e0, e1;
          R1PAIR(R1BUF(11), R1BUF(12), n0, n1); R1PAIR(R1BUF(12), R1BUF(11), t0, t1); R1PAIR(R1BUF(3), R1BUF(5), e0, e1);
          R1ST2(R1BUF(8), n0, n1, 0, false, nullptr); R1ST2(R1BUF(9), t0, t1, 0, false, nullptr); R1ST2(R1BUF(10), e0, e1, 0, false, nullptr); }
        __syncthreads();
#pragma unroll 1
        for (int lv = 0; lv < 5; ++lv) {
            const bool srcB = (lv & 1) == 0;
            LAS unsigned short* sN = srcB ? R1BUF(8) : R1BUF(11); LAS unsigned short* sNT = srcB ? R1BUF(9) : R1BUF(12);
            LAS unsigned short* dN = srcB ? R1BUF(11) : R1BUF(8); LAS unsigned short* dNT = srcB ? R1BUF(12) : R1BUF(9);
            LAS unsigned short* Tc = (lv & 1) ? R1BUF(14) : R1BUF(13); LAS unsigned short* Tn = (lv & 1) ? R1BUF(13) : R1BUF(14);
            f32x4 u0, u1, t0 = zero4, t1 = zero4, n0 = zero4, n1 = zero4;
            R1PAIR(Tc, sNT, u0, u1);
            if (lv < 4) R1PAIR(sNT, sN, t0, t1);
            if (lv < 3) R1PAIR(sN, sNT, n0, n1);
            R1ST2(Tn, u0, u1, 0, false, Tc);
            if (lv < 4) R1ST2(dNT, t0, t1, 0, false, nullptr);
            if (lv < 3) R1ST2(dN, n0, n1, 0, false, nullptr);
            __syncthreads();
        }
        { f32x4 g0, g1, q0, q1;
          R1PAIR(R1BUF(0), R1BUF(14), g0, g1); R1PAIR(R1BUF(10), R1BUF(14), q0, q1);
          R1ST2(R1BUF(11), g0, g1, 0, false, nullptr); R1ST2(R1BUF(12), q0, q1, 0, false, nullptr); }
        __syncthreads();
#undef R1PAIR
#undef R1ST2
        { const int mi = wave >> 1, ks = wave & 1;
          const f32x4 p0 = r1_tile(R1BUF(1), R1BUF(11), mi, 2 * ks, zero4, fr, fq), p1 = r1_tile(R1BUF(1), R1BUF(11), mi, 2 * ks + 1, zero4, fr, fq);
          const f32x4 s0 = r1_tile(R1BUF(6), R1BUF(11), mi, 2 * ks, zero4, fr, fq), s1 = r1_tile(R1BUF(6), R1BUF(11), mi, 2 * ks + 1, zero4, fr, fq);
          const int m = 16 * mi + fr; const float wc = wcs[m];
          float ph[8], ps[8];
#pragma unroll
          for (int r = 0; r < 4; ++r) { const int n0 = 32 * ks + 4 * fq + r, n1 = n0 + 16;
              ph[r] = (p0[r] + (m == n0 ? 1.f : 0.f)) * wc; ph[4 + r] = (p1[r] + (m == n1 ? 1.f : 0.f)) * wc; }
          { const unsigned long long w0 = *(const LAS unsigned long long*)(R1BUF(4) + m * RLD + 32 * ks + 4 * fq), w1 = *(const LAS unsigned long long*)(R1BUF(4) + m * RLD + 32 * ks + 16 + 4 * fq);
            ps[0] = s0[0] + bf_lo((unsigned)w0); ps[1] = s0[1] + bf_hi((unsigned)w0); ps[2] = s0[2] + bf_lo((unsigned)(w0 >> 32)); ps[3] = s0[3] + bf_hi((unsigned)(w0 >> 32));
            ps[4] = s1[0] + bf_lo((unsigned)w1); ps[5] = s1[1] + bf_hi((unsigned)w1); ps[6] = s1[2] + bf_lo((unsigned)(w1 >> 32)); ps[7] = s1[3] + bf_hi((unsigned)(w1 >> 32)); }
          const size_t fo = (((size_t)item * 4 + mi) * 2 + ks) * 64 + lane;
          if (MODE == 0) *((GAS v4u*)(ws + WS_PHI) + fo) = (v4u){pk2(ph[0], ph[1]), pk2(ph[2], ph[3]), pk2(ph[4], ph[5]), pk2(ph[6], ph[7])};
          if (MODE == 0) *((GAS v4u*)(ws + WS_PSI) + fo) = (v4u){pk2(ps[0], ps[1]), pk2(ps[2], ps[3]), pk2(ps[4], ps[5]), pk2(ps[6], ps[7])};
          const int vb = wave >> 1;
#pragma unroll
          for (int hh = 0; hh < 2; ++hh) { const int mt = 2 * (wave & 1) + hh;
              f32x4 ga = r1_tile(R1BUF(12), R1BUF(1), vb, mt, zero4, fr, fq); ga = r1_tile(R1BUF(3), R1BUF(2), vb, mt, ga, fr, fq);
              f32x4 om = r1_tile(R1BUF(12), R1BUF(6), vb, mt, zero4, fr, fq); om = r1_tile(R1BUF(3), R1BUF(7), vb, mt, om, fr, fq);
#pragma unroll
              for (int r = 0; r < 4; ++r) ga[r] *= wcs[16 * mt + 4 * fq + r];
              const size_t ao = (((size_t)item * 4 + vb) * 4 + mt) * 64 + lane;
              if (MODE == 0) { *((GAS f32x4*)(ws + WS_GAM) + ao) = ga; *((GAS f32x4*)(ws + WS_OM) + ao) = om; } else { asm volatile("" :: "v"(ga), "v"(om)); } }
        }
        tc8_store(tcWT, 1024, tck0, tcrb, lane, tcv, W8_SCALE);
        __syncthreads();
    }
}
#undef R1BUF
#undef R1LOAD
#undef ZF
struct R2Buf { bf16x8 ph[4][2]; f32x4 ga[4]; };
__device__ __forceinline__ void r2_load(R2Buf& B, const unsigned char* ws, int item, int vb, int lane) {
#pragma unroll
    for (int mt = 0; mt < 4; ++mt) {
#pragma unroll
        for (int ks = 0; ks < 2; ++ks) B.ph[mt][ks] = *((const GAS bf16x8*)(ws + WS_PHI) + (((size_t)item * 4 + mt) * 2 + ks) * 64 + lane);
        B.ga[mt] = *((const GAS f32x4*)(ws + WS_GAM) + (((size_t)item * 4 + vb) * 4 + mt) * 64 + lane); }
}
__device__ __forceinline__ void r2_step(const R2Buf& B, f32x4 (&acc)[4], unsigned char* ws, int item, int vb, int lane) {
    v4u x0, x1;
    x0.x = pk2(acc[0][0], acc[0][1]); x0.y = pk2(acc[0][2], acc[0][3]); x0.z = pk2(acc[1][0], acc[1][1]); x0.w = pk2(acc[1][2], acc[1][3]);
    x1.x = pk2(acc[2][0], acc[2][1]); x1.y = pk2(acc[2][2], acc[2][3]); x1.z = pk2(acc[3][0], acc[3][1]); x1.w = pk2(acc[3][2], acc[3][3]);
    GAS v4u* xo = (GAS v4u*)(ws + WS_XFR) + (((size_t)item * 4 + vb) * 2) * 64 + lane; xo[0] = x0; xo[64] = x1;
    const bf16x8 f0 = __builtin_bit_cast(bf16x8, x0), f1 = __builtin_bit_cast(bf16x8, x1);
#pragma unroll
    for (int mt = 0; mt < 4; ++mt) { f32x4 a = B.ga[mt];
        a = __builtin_amdgcn_mfma_f32_16x16x32_bf16(B.ph[mt][0], f0, a, 0, 0, 0);
        a = __builtin_amdgcn_mfma_f32_16x16x32_bf16(B.ph[mt][1], f1, a, 0, 0, 0);
        acc[mt] = a; }
}
__device__ __forceinline__ void p_r2(Frame& F) {
    if (blockIdx.x < BATCH * 8 * 4 && F.wave == 0) {
        unsigned char* ws = F.ws; const int bh = blockIdx.x >> 2, vb = blockIdx.x & 3, lane = F.lane;
        f32x4 acc[4];
#pragma unroll
        for (int i = 0; i < 4; ++i) acc[i] = (f32x4){0.f, 0.f, 0.f, 0.f};
        R2Buf A, B, C, D;
        const int it0 = bh * 128;
        r2_load(A, ws, it0, vb, lane); r2_load(B, ws, it0 + 1, vb, lane); r2_load(C, ws, it0 + 2, vb, lane);
#define R2SB() __builtin_amdgcn_sched_barrier(0)
#pragma unroll
        for (int c = 0; c < 128; c += 4) {
            r2_load(D, ws, it0 + c + 3, vb, lane); R2SB(); r2_step(A, acc, ws, it0 + c, vb, lane); R2SB();
            r2_load(A, ws, it0 + (c + 4 < 128 ? c + 4 : 127), vb, lane); R2SB(); r2_step(B, acc, ws, it0 + c + 1, vb, lane); R2SB();
            r2_load(B, ws, it0 + (c + 5 < 128 ? c + 5 : 127), vb, lane); R2SB(); r2_step(C, acc, ws, it0 + c + 2, vb, lane); R2SB();
            r2_load(C, ws, it0 + (c + 6 < 128 ? c + 6 : 127), vb, lane); R2SB(); r2_step(D, acc, ws, it0 + c + 3, vb, lane); R2SB();
        }
#undef R2SB
    }
}
__device__ __forceinline__ void p_r3(Frame& F, const Args& args) {
    const int gw = F.vcu * NWAVES + F.wave, NGW = F.G * NWAVES, lane = F.lane, cc = lane & 15, q = lane >> 4;
    unsigned char* ws = F.ws;
    const bf16* VM = (const bf16*)(ws + WS_VMIX); const bf16* GM = (const bf16*)(ws + WS_GMIX);
    const float* bonus = (const float*)(ws + WS_BONUS);
    bf16* YB = (bf16*)(ws + WS_YABC) + 512;
    const float* lnw = ldarg(I_R_LNW); const float* lnb = ldarg(I_R_LNB);
#pragma unroll 2
    for (int wi = gw; wi < N_RITEMS * 4; wi += NGW) {
        const int item = wi >> 2, tt = wi & 3, bh = item >> 7, c = item & 127, b = bh >> 3, h = bh & 7;
        const bf16x8 ps0 = *((const GAS bf16x8*)(ws + WS_PSI) + (((size_t)item * 4 + tt) * 2 + 0) * 64 + lane), ps1 = *((const GAS bf16x8*)(ws + WS_PSI) + (((size_t)item * 4 + tt) * 2 + 1) * 64 + lane);
        f32x4 acc[4];
#pragma unroll
        for (int vb = 0; vb < 4; ++vb) {
            const bf16x8 x0 = *((const GAS bf16x8*)(ws + WS_XFR) + (((size_t)item * 4 + vb) * 2 + 0) * 64 + lane), x1 = *((const GAS bf16x8*)(ws + WS_XFR) + (((size_t)item * 4 + vb) * 2 + 1) * 64 + lane);
            f32x4 a = *((const GAS f32x4*)(ws + WS_OM) + (((size_t)item * 4 + vb) * 4 + tt) * 64 + lane);
            a = __builtin_amdgcn_mfma_f32_16x16x32_bf16(ps0, x0, a, 0, 0, 0);
            a = __builtin_amdgcn_mfma_f32_16x16x32_bf16(ps1, x1, a, 0, 0, 0);
            acc[vb] = a; }
        const size_t rowb = (size_t)b * SEQ + (size_t)c * 64 + 16 * tt + 4 * q;
        unsigned short vmr[4][4], gmr[4][4]; float bnr[4], lw4[4], lb4[4];
#pragma unroll
        for (int vb = 0; vb < 4; ++vb) { const int ch = h * 64 + 16 * vb + cc; lw4[vb] = lnw[ch]; lb4[vb] = lnb[ch]; }
#pragma unroll
        for (int r = 0; r < 4; ++r) { const size_t t = rowb + r; bnr[r] = bonus[t * 8 + h];
#pragma unroll
            for (int vb = 0; vb < 4; ++vb) { const int ch = h * 64 + 16 * vb + cc; vmr[r][vb] = VM[t * RW + ch]; gmr[r][vb] = GM[t * RW + ch]; } }
#pragma unroll
        for (int r = 0; r < 4; ++r) { const size_t t = rowb + r;
            const float s = (acc[0][r] + acc[1][r]) + (acc[2][r] + acc[3][r]);
            const float mean = row16_sum(s) * (1.f / 64.f);
            const float d0 = acc[0][r] - mean, d1 = acc[1][r] - mean, d2 = acc[2][r] - mean, d3 = acc[3][r] - mean;
            const float var = row16_sum((d0 * d0 + d1 * d1) + (d2 * d2 + d3 * d3)) * (1.f / 64.f);
            const float rstd = __builtin_amdgcn_rsqf(var + R_GN_EPS);
            const float bn = bnr[r];
#pragma unroll
            for (int vb = 0; vb < 4; ++vb) { const int ch = h * 64 + 16 * vb + cc; const float d = (vb == 0) ? d0 : (vb == 1) ? d1 : (vb == 2) ? d2 : d3;
                const float yn = d * rstd * lw4[vb] + lb4[vb];
                const float vv = __builtin_bit_cast(float, (unsigned)vmr[r][vb] << 16), gg = __builtin_bit_cast(float, (unsigned)gmr[r][vb] << 16);
                YB[t * 1536 + ch] = (bf16)f2bf((yn + bn * vv) * gg); } }
    }
}

__global__ void __launch_bounds__(NWAVES * 64, 2) skel_fwd(Args args) {
    extern __shared__ __attribute__((aligned(16))) unsigned char lds[];
    Frame F;
    F.lds = (LAS unsigned char*)lds;
    F.MISC = (volatile LAS unsigned*)(F.lds + MISC_OFF);
    phase_enter(F, true);
    F.G = gridDim.x; { const int bx = blockIdx.x; F.vcu = (F.G % 8 == 0) ? (bx % 8) * (F.G / 8) + bx / 8 : bx; }
    unsigned char* ws = args.ws; F.ws = ws; F.out = args.out;
    F.ctl = (gu32*)(ws + WS_CTL);
    for (int u = F.tid; u < (LDS_BYTES - LDSCTL_OFF) / 4; u += NWAVES * 64) ((LAS unsigned*)(F.lds + LDSCTL_OFF))[u] = 0u;
    __syncthreads();
    XcdBarrier bar; bar.bar = (unsigned*)(F.ctl + CW_BAR); bar.x = 0; bar.st = nullptr;
    if (args.use_bar) bar = xcd_barrier_post((unsigned*)(F.ctl + CW_BAR), F.MISC + 8);
    const int lo = args.ph_lo, hi = args.ph_hi;
#define IN(k) (phase_enter(F, lo <= (k) && (k) < hi))
#define SEAM(k) do { if (lo <= (k) && (k) + 1 < hi) xcd_barrier(bar); } while (0)
    const pg8::bf16_t* wsb = (const pg8::bf16_t*)ws;
#define BF(off) ((pg8::bf16_t*)(ws + (off)))

    if (IN(0)) { p0_prologue<0>(F, args, F.vcu * NWAVES + F.wave, F.G * NWAVES); if (F.G <= 64) p0_prologue<1>(F, args, F.vcu * NWAVES + F.wave, F.G * NWAVES); } SEAM(0);
    if (IN(1)) {
        const float* ckg_ = ldarg(I_CK_GAIN);
        pg8::EpiZ E{BF(WS_Z), ldarg(I_B_GATE), ldarg(I_AQ_GAIN), ldarg(I_AK_GAIN), ldarg(I_CQ_GAIN), (const float*)(ws + WS_CS), BF(WS_KVM), ckg_, (PG8_LAS float*)(F.lds + 131072)};
        { pg8::Gemm g{BF(WS_XN), BF(WS_WIN), MTOK + MEMROWS, IN_COLS + 1024, 1024}; pg8::ZOrder<0> S; S.init(F.G, (int)blockIdx.x);
          pg8::gemm_phase<pg8::EpiZ, pg8::ZOrder<0>, true, true>(F.lds + RING_OFF, g, S, E); }
        { pg8::Gemm g{BF(WS_XN8), BF(WS_WIN8), MTOK, IN_COLS, 1024, SC_ONE, SC_W8}; pg8::ZOrder<1> S; S.init(F.G, (int)blockIdx.x);
          pg8::gemm_phase<pg8::EpiZ, pg8::ZOrder<1>, true, true, true>(F.lds + RING_OFF, g, S, E); }
    } SEAM(1);
#if NAIVE_ATTN
    if (IN(3)) { p3_attention(F); } SEAM(3);
#else
    if (IN(3)) { p3_attention_mfma(ws, (char*)lds + RING_OFF, F.G); __syncthreads(); phase_enter(F, true); p_r1<0>(F, args); } SEAM(3);
#endif
    if (IN(4)) { p_r2(F); if (F.G > 64 && blockIdx.x >= 64) p0_prologue<1>(F, args, ((int)blockIdx.x - 64) * NWAVES + F.wave, (F.G - 64) * NWAVES); } SEAM(4);
    if (IN(5)) { p_r3(F, args); p5_post(F, args); } SEAM(5);
    if (IN(6)) {
        pg8::Gemm g{BF(WS_YABC), BF(WS_WB), MTOK, 1024, 1536}; pg8::StaticOrder S; S.init(MTOK, 1024, F.G, (int)blockIdx.x);
        pg8::EpiGate3 E{BF(WS_Z), BF(WS_MRGB)};
        pg8::gemm_phase<pg8::EpiGate3, pg8::StaticOrder, true, true>(F.lds + RING_OFF, g, S, E);
    } SEAM(6);
    if (IN(7)) {
        pg8::Gemm g{BF(WS_MRGB), BF(WS_WO), MTOK, 1024, 1024}; pg8::StaticOrder S; S.init(MTOK, 1024, F.G, (int)blockIdx.x);
        pg8::EpiResF32 E{ldarg(I_X), F.out, 1024};
        pg8::gemm_phase<pg8::EpiResF32, pg8::StaticOrder, true, true>(F.lds + RING_OFF, g, S, E);
    } SEAM(7);
    if (IN(8)) { p8_router(F, args); } SEAM(8);
    if (IN(9)) { p9_dispatch(F, args); } SEAM(9);
    if (IN(10)) {
        moe_table(F);
        pg8::Gemm g{BF(WS_XS), BF(WS_W1), 0, 0, 1024, SC_ONE, SC_W8}; pg8::MoeOrder S{(const PG8_LAS int*)(F.lds + MOETAB_OFF), 8, F.G, (int)blockIdx.x};
        pg8::EpiSwiGLU E{ldarg(I_EXP_B1), BF(WS_HACT)};
        pg8::gemm_phase<pg8::EpiSwiGLU, pg8::MoeOrder, true, true, true>(F.lds + RING_OFF, g, S, E);
    } SEAM(10);
    if (IN(11)) {
        moe_table(F);
        pg8::Gemm g{BF(WS_HACT), BF(WS_W2), 0, 0, 1024, SC_H8, SC_W8}; pg8::MoeOrder S{(const PG8_LAS int*)(F.lds + MOETAB_OFF), 4, F.G, (int)blockIdx.x};
        pg8::EpiMoeOut E{ldarg(I_EXP_B2), (const float*)(ws + WS_ROUTE + RT_ROWGATE), BF(WS_YROWS)};
        pg8::gemm_phase<pg8::EpiMoeOut, pg8::MoeOrder, true, true, true>(F.lds + RING_OFF, g, S, E);
    } SEAM(11);
    if (IN(12)) { p12_combine(F); }
#undef IN
#undef SEAM
#undef BF
    (void)wsb;
}

extern "C" void kernel_launch(void* const* d_in, const int* in_sizes, int n_in, void* d_out, int out_size, void* d_ws, size_t ws_size, hipStream_t stream) {
    static int grid = 0;
    if (grid == 0) {
        if (n_in != 32 || out_size != MTOK * D_MODEL || ws_size < WS_END) { fprintf(stderr, "kernel_launch: unexpected problem (n_in %d, out %d, ws %zu); nothing launched\n", n_in, out_size, ws_size); grid = -1; return; }
        int dev = 0, cus = 0;
        if (hipGetDevice(&dev) != hipSuccess || hipDeviceGetAttribute(&cus, hipDeviceAttributeMultiprocessorCount, dev) != hipSuccess) { grid = -1; return; }
        if (hipFuncSetAttribute((const void*)skel_fwd, hipFuncAttributeMaxDynamicSharedMemorySize, LDS_BYTES) != hipSuccess) { fprintf(stderr, "kernel_launch: hipFuncSetAttribute failed\n"); grid = -1; return; }
        (void)hipGetLastError();
        grid = cus;
    }
    if (grid < 0) return;
    (void)hipMemsetAsync((char*)d_ws + WS_CTL, 0, CTL_ZERO_BYTES, stream);
    Args a{};
    for (int i = 0; i < 32; ++i) a.in[i] = (const float*)d_in[i];
    a.out = (float*)d_out; a.ws = (unsigned char*)d_ws;
#if MK_N_LAUNCHES == 1
    a.ph_lo = 0; a.ph_hi = N_PHASES; a.use_bar = 1;
    hipLaunchKernelGGL(skel_fwd, dim3(grid), dim3(NWAVES * 64), LDS_BYTES, stream, a);
#else
    for (int p = 0; p < N_PHASES; ++p) { a.ph_lo = p; a.ph_hi = p + 1; a.use_bar = 0;
        hipLaunchKernelGGL(skel_fwd, dim3(grid), dim3(NWAVES * 64), LDS_BYTES, stream, a); }
#endif
}
```

```cpp
#include <hip/hip_runtime.h>
#include <cstdio>
#include <cstdint>
#include <cmath>
namespace pg8 {
#define PG8_LAS __attribute__((address_space(3)))
typedef unsigned short bf16_t;
typedef short bf16x8 __attribute__((ext_vector_type(8)));
typedef float f32x4 __attribute__((ext_vector_type(4)));
typedef unsigned u32x4 __attribute__((ext_vector_type(4)));
constexpr int BM = 256, BK = 64, HALF = 128, HTB = HALF * BK * 2  , STAGE_BYTES = 8 * HTB, NXCD = 8, WGM = 8;

__host__ __device__ __forceinline__ int lds_byte(int r, int c) { const int st = (r >> 4) * 2 + (c >> 5), rr = r & 15, cc = c & 31, ob = rr * 64 + cc * 2; return st * 1024 + (ob ^ (((ob >> 9) & 1) << 5)); }
__host__ __device__ __forceinline__ void stage_rc(int b, int& R, int& C) { const int st = b / 1024, sb = b % 1024, swz = sb ^ (((sb >> 9) & 1) << 5); R = (st >> 1) * 16 + swz / 64; C = (st & 1) * 32 + (swz % 64) / 2; }
__host__ __device__ __forceinline__ int perm32(int rho) { const int n = rho >> 4, i = rho & 15; return 8 * (i >> 2) + 4 * n + (i & 3); }

struct Unit { int pm, pn; };
typedef int v4i_t __attribute__((ext_vector_type(4))); typedef int v8i_t __attribute__((ext_vector_type(8)));
struct Gemm { const bf16_t* A; const bf16_t* Bt; int M, N, K; int sca = 0x7f7f7f7f, scb = 0x7f7f7f7f; int prof = 0; };
#ifdef PG8_PROF
__device__ unsigned long long pg8_prof[4];
#endif

struct StaticOrder {
    int nM, nN, nwg, G, c;
    __host__ __device__ void init(int M, int N, int G_, int c_) { nM = M / BM; nN = N / BM; nwg = nM * nN; G = G_; c = c_; }
    __host__ __device__ bool next(int i, Unit& u) const {
        const long L = (long)i * G + c; if (L >= nwg) return false;
        int wgid = (int)L; { const int q = nwg / NXCD, r = nwg % NXCD, xcd = wgid % NXCD, off = wgid / NXCD; wgid = (xcd < r ? xcd * (q + 1) : r * (q + 1) + (xcd - r) * q) + off; }
        const int nig = WGM * nN, gid = wgid / nig, fm = gid * WGM, gsz = (nM - fm) < WGM ? (nM - fm) : WGM;
        u.pm = fm + ((wgid % nig) % gsz); u.pn = (wgid % nig) / gsz; return true;
    }
    __device__ __forceinline__ void a_ready(const Unit&) const {}
    __device__ __forceinline__ void done(const Unit&) const {}
};

__device__ __forceinline__ unsigned cvt_pk_bf16(float lo, float hi) { unsigned r; asm volatile("v_cvt_pk_bf16_f32 %0, %1, %2" : "=v"(r) : "v"(lo), "v"(hi)); return r; }
typedef float f32x2 __attribute__((ext_vector_type(2)));
__device__ __forceinline__ f32x2 gelu_pk(f32x2 v) {
    const f32x2 av = __builtin_elementwise_abs(v), d = av * 0.2316418882f + 1.0f;
    f32x2 t; t.x = __builtin_amdgcn_rcpf(d.x); t.y = __builtin_amdgcn_rcpf(d.y);
    f32x2 q = t * 0.5307027145f + (-0.7265760135f); q = q * t + 0.7107068705f; q = q * t + (-0.142248368f); q = q * t + 0.127414796f; q = q * t;
    const f32x2 s = (v * v) * (-0.72134752044f);
    f32x2 e; e.x = __builtin_amdgcn_exp2f(s.x); e.y = __builtin_amdgcn_exp2f(s.y);
    const f32x2 m = v * (q * e), r = v - m;
    f32x2 o; o.x = v.x < 0.f ? m.x : r.x; o.y = v.y < 0.f ? m.y : r.y; return o;
}

template <int ACT  > struct EpiBf16 {
    static constexpr bool PERM = true, AFTER_DRAIN = false; static_assert(ACT == 0 || ACT == 1, "EpiBf16: ACT is 0 (none) or 1 (gelu_pk)");
    bf16_t* O; int ldc; const float* bias; int split_cols; size_t split_stride; float scale0;
    __device__ __forceinline__ void operator()(const f32x4 (&acc)[2][2][4][2], const Unit& u, int wr, int wc, int fr, int fq) const {
        const int row0 = u.pm * BM + wr * 64 + fr; int colt = u.pn * BM; bf16_t* base = O;
        float sc = 1.f; if (split_cols) { const int t = colt / split_cols; base += (size_t)t * split_stride; colt -= t * split_cols; if (t == 0) sc = scale0; }
        const int col0 = colt + wc * 32 + 8 * fq, bcol0 = u.pn * BM + wc * 32 + 8 * fq;
        f32x4 bv[2][2];
#pragma unroll
        for (int bj = 0; bj < 2; ++bj)
#pragma unroll
            for (int n = 0; n < 2; ++n) bv[bj][n] = bias ? *(const f32x4*)(bias + bcol0 + bj * HALF + 4 * n) : (f32x4){0.f, 0.f, 0.f, 0.f};
#pragma unroll
        for (int ai = 0; ai < 2; ++ai)
#pragma unroll
            for (int m = 0; m < 4; ++m) { bf16_t* rowp = base + (size_t)(row0 + ai * HALF + m * 16) * ldc + col0;
#pragma unroll
                for (int bj = 0; bj < 2; ++bj) { f32x4 v0 = acc[ai][bj][m][0] + bv[bj][0], v1 = acc[ai][bj][m][1] + bv[bj][1];
                    if (ACT == 1) { f32x2 a = gelu_pk((f32x2){v0[0], v0[1]}), b = gelu_pk((f32x2){v0[2], v0[3]}), c = gelu_pk((f32x2){v1[0], v1[1]}), d = gelu_pk((f32x2){v1[2], v1[3]});
                        v0 = (f32x4){a.x, a.y, b.x, b.y}; v1 = (f32x4){c.x, c.y, d.x, d.y}; }
                    v0 = v0 * sc; v1 = v1 * sc; u32x4 w; w.x = cvt_pk_bf16(v0[0], v0[1]); w.y = cvt_pk_bf16(v0[2], v0[3]); w.z = cvt_pk_bf16(v1[0], v1[1]); w.w = cvt_pk_bf16(v1[2], v1[3]);
                    *(u32x4*)(rowp + bj * HALF) = w; } }
    }
};
template <class E_> struct EpiHasMid { static constexpr bool v = false; };
template <class Epi, class Sched, bool ALIGN_EPI = false, bool SP2 = false, bool FP8 = false>
__device__ __forceinline__ void gemm_phase(PG8_LAS unsigned char* lds, const Gemm g, const Sched& S, const Epi& E) {
    int tid_ = threadIdx.x; asm volatile("" : "+v"(tid_));
    const int tid = tid_, wid = __builtin_amdgcn_readfirstlane(tid >> 6), lane = tid & 63, wr = wid >> 2, wc = wid & 3, fr = lane & 15, fq = lane >> 4;
    const int K = FP8 ? g.K / 2 : g.K, nt = K / BK;
    unsigned voffA[2], voffB[2];
#pragma unroll
    for (int i = 0; i < 2; ++i) { int R, C; stage_rc(tid * 16 + i * 8192, R, C); const int Rb = Epi::PERM ? ((R & ~31) + perm32(R & 31)) : R;
        voffA[i] = (unsigned)(R * K + C) * 2u; voffB[i] = (unsigned)(Rb * K + C) * 2u; }
    const size_t kstep = (size_t)(BK * 2);
    const size_t hstep = (size_t)HALF * K * 2;
    const size_t tstep = 2 * hstep;
    const unsigned ldsw = (unsigned)wid * 1024u;
    const int aoff = FP8 ? lds_byte(wr * 64 + fr, fq * 16) : lds_byte(wr * 64 + fr, fq * 8), boff = FP8 ? lds_byte(wc * 32 + fr, fq * 16) : lds_byte(wc * 32 + fr, fq * 8);
    constexpr int PIECE1 = FP8 ? 16 : 1024; (void)PIECE1;
#define PG8_SA(b, h) (((b) * 2 + (h)) * HTB)
#define PG8_SB(b, h) ((4 + (b) * 2 + (h)) * HTB)
#define PG8_STAGE(bufoff, gbase, voff) do { _Pragma("unroll") for (int _i = 0; _i < 2; ++_i) \
        __builtin_amdgcn_global_load_lds((const unsigned*)((const char*)(gbase) + (voff)[_i]), (PG8_LAS unsigned*)(lds + (bufoff) + ldsw + _i * 8192), 16, 0, 0); } while (0)
#define PG8_LD8(p_) __builtin_shufflevector(*(const PG8_LAS v4i_t*)(p_), *(const PG8_LAS v4i_t*)((p_) + 16), 0, 1, 2, 3, 4, 5, 6, 7)
#define PG8_LDA(dst, b, h) do { if constexpr (FP8) { _Pragma("unroll") for (int m = 0; m < 4; ++m) dst##8[m] = PG8_LD8(lds + PG8_SA(b, h) + aoff + m * 2048); } \
        else { _Pragma("unroll") for (int m = 0; m < 4; ++m) _Pragma("unroll") for (int k = 0; k < 2; ++k) dst[m][k] = *(const PG8_LAS bf16x8*)(lds + PG8_SA(b, h) + aoff + k * 1024 + m * 2048); } } while (0)
#define PG8_LDB(dst, b, h) do { if constexpr (FP8) { _Pragma("unroll") for (int n = 0; n < 2; ++n) dst##8[n] = PG8_LD8(lds + PG8_SB(b, h) + boff + n * 2048); } \
        else { _Pragma("unroll") for (int n = 0; n < 2; ++n) _Pragma("unroll") for (int k = 0; k < 2; ++k) dst[n][k] = *(const PG8_LAS bf16x8*)(lds + PG8_SB(b, h) + boff + k * 1024 + n * 2048); } } while (0)
#define PG8_MMA(ai, bj, At, Bt) do { __builtin_amdgcn_s_setprio(1); \
        if constexpr (FP8) { _Pragma("unroll") for (int m = 0; m < 4; ++m) _Pragma("unroll") for (int n = 0; n < 2; ++n) \
            asm volatile("v_mfma_scale_f32_16x16x128_f8f6f4 %0, %1, %2, %0, %3, %4 op_sel_hi:[0,0,0]" : "+v"(acc[ai][bj][m][n]) : "v"(Bt##8[n]), "v"(At##8[m]), "v"(scb_v), "v"(sca_v)); } \
        else { _Pragma("unroll") for (int m = 0; m < 4; ++m) _Pragma("unroll") for (int n = 0; n < 2; ++n) _Pragma("unroll") for (int k = 0; k < 2; ++k) \
            acc[ai][bj][m][n] = __builtin_amdgcn_mfma_f32_16x16x32_bf16(Bt[n][k], At[m][k], acc[ai][bj][m][n], 0, 0, 0); } __builtin_amdgcn_s_setprio(0); } while (0)
#define PG8_WAIT_V(n) asm volatile("s_waitcnt vmcnt(" #n ")" ::: "memory")
#define PG8_WAIT_L(n) asm volatile("s_waitcnt lgkmcnt(" #n ")" ::: "memory")
#define PG8_BAR __builtin_amdgcn_s_barrier()
#define PG8_SCHED __builtin_amdgcn_sched_barrier(0)
    Unit cur, nxt; int ui = 0;
#ifdef PG8_PROF
#define PG8_TS(slot) do { if (g.prof && wid == 0) { const unsigned n_ = (unsigned)__builtin_amdgcn_s_memrealtime(); volatile PG8_LAS unsigned* p_ = (volatile PG8_LAS unsigned*)(lds + 143744); p_[slot] += n_ - p_[2]; p_[2] = n_; } } while (0)
#else
#define PG8_TS(slot) do { } while (0)
#endif
    if (!S.next(0, cur)) return;
    f32x4 acc[2][2][4][2];
#pragma unroll
    for (int a = 0; a < 2; ++a)
#pragma unroll
        for (int b = 0; b < 2; ++b)
#pragma unroll
            for (int m = 0; m < 4; ++m)
#pragma unroll
                for (int n = 0; n < 2; ++n) acc[a][b][m][n] = (f32x4){0.f, 0.f, 0.f, 0.f};
    const int sca_v = g.sca, scb_v = g.scb;
    bf16x8 At[4][2], B0[2][2], B1[2][2];
    v8i_t At8[4], B08[2], B18[2];
    const char* cA = (const char*)g.A + (size_t)cur.pm * tstep; const char* cB = (const char*)g.Bt + (size_t)cur.pn * tstep;
    S.a_ready(cur);
    if constexpr (SP2) {
        PG8_STAGE(PG8_SB(0, 0), cB, voffB); PG8_STAGE(PG8_SB(0, 1), cB + hstep, voffB); PG8_STAGE(PG8_SA(0, 0), cA, voffA); PG8_STAGE(PG8_SA(0, 1), cA + hstep, voffA);
        if (wr == 1) PG8_BAR;
        PG8_WAIT_V(2); PG8_BAR;
        PG8_STAGE(PG8_SB(1, 0), cB + kstep, voffB); PG8_STAGE(PG8_SA(1, 0), cA + kstep, voffA); PG8_STAGE(PG8_SB(1, 1), cB + hstep + kstep, voffB);
        PG8_WAIT_V(6); PG8_BAR;
    } else {
        PG8_STAGE(PG8_SB(0, 0), cB, voffB); PG8_STAGE(PG8_SA(0, 0), cA, voffA); PG8_STAGE(PG8_SB(0, 1), cB + hstep, voffB); PG8_STAGE(PG8_SA(0, 1), cA + hstep, voffA);
        if (wr == 1) PG8_BAR;
        PG8_WAIT_V(4); PG8_BAR;
        PG8_STAGE(PG8_SB(1, 0), cB + kstep, voffB); PG8_STAGE(PG8_SA(1, 0), cA + kstep, voffA); PG8_STAGE(PG8_SB(1, 1), cB + hstep + kstep, voffB);
        PG8_WAIT_V(6); PG8_BAR;
    }
    for (;;) {
        const bool has_next = S.next(ui + 1, nxt);
        const char* nA = has_next ? (const char*)g.A + (size_t)nxt.pm * tstep : cA; const char* nB = has_next ? (const char*)g.Bt + (size_t)nxt.pn * tstep : cB;
        PG8_TS(3);
#pragma unroll 1
        for (int t = 0; t < nt; t += 2) {
            if constexpr (EpiHasMid<Epi>::v) { if (t == 8 || t == 16) { PG8_SCHED; E.mid(acc, cur, t, wr, wc, fr, fq); PG8_SCHED; } }
            const bool last = (t == nt - 2);
            const char* a1 = cA + (size_t)(t + 1) * kstep;
            const char* a2 = last ? nA : cA + (size_t)(t + 2) * kstep; const char* b2 = last ? nB : cB + (size_t)(t + 2) * kstep;
            const char* a3 = a2 + kstep; const char* b3 = b2 + kstep;
            if (last && has_next) S.a_ready(nxt);
            if constexpr (SP2) {
            PG8_LDB(B0, 0, 0); PG8_LDB(B1, 0, 1); PG8_SCHED; PG8_LDA(At, 0, 0); PG8_STAGE(PG8_SA(1, 1), a1 + hstep, voffA);
            PG8_WAIT_V(8); PG8_WAIT_L(0); PG8_BAR; PG8_MMA(0, 0, At, B0); PG8_MMA(0, 1, At, B1); PG8_BAR; PG8_SCHED;
            PG8_LDA(At, 0, 1); PG8_STAGE(PG8_SB(0, 0), b2, voffB); PG8_STAGE(PG8_SB(0, 1), b2 + hstep, voffB); PG8_STAGE(PG8_SA(0, 0), a2, voffA);
            PG8_WAIT_V(8); PG8_WAIT_L(0); PG8_BAR; PG8_MMA(1, 0, At, B0); PG8_MMA(1, 1, At, B1); PG8_BAR; PG8_SCHED;
            PG8_LDB(B0, 1, 0); PG8_LDB(B1, 1, 1); PG8_SCHED; PG8_LDA(At, 1, 0); PG8_STAGE(PG8_SA(0, 1), a2 + hstep, voffA);
            PG8_WAIT_V(8); PG8_WAIT_L(0); PG8_BAR; PG8_MMA(0, 0, At, B0); PG8_MMA(0, 1, At, B1); PG8_BAR; PG8_SCHED;
            PG8_LDA(At, 1, 1); PG8_STAGE(PG8_SB(1, 0), b3, voffB); PG8_STAGE(PG8_SB(1, 1), b3 + hstep, voffB); PG8_STAGE(PG8_SA(1, 0), a3, voffA);
            PG8_WAIT_V(8); PG8_WAIT_L(0); PG8_BAR; PG8_MMA(1, 0, At, B0); PG8_MMA(1, 1, At, B1); PG8_BAR; PG8_SCHED;
            } else {
            PG8_LDB(B0, 0, 0); PG8_SCHED; PG8_LDA(At, 0, 0); PG8_STAGE(PG8_SA(1, 1), a1 + hstep, voffA);
            PG8_WAIT_L(8); PG8_BAR; PG8_WAIT_L(0); PG8_MMA(0, 0, At, B0); PG8_BAR; PG8_SCHED;
            PG8_LDB(B1, 0, 1); PG8_STAGE(PG8_SB(0, 0), b2, voffB);
            PG8_BAR; PG8_WAIT_L(0); PG8_MMA(0, 1, At, B1); PG8_BAR;
            PG8_LDA(At, 0, 1); PG8_STAGE(PG8_SA(0, 0), a2, voffA);
            PG8_BAR; PG8_WAIT_L(0); PG8_MMA(1, 0, At, B0); PG8_BAR; PG8_SCHED;
            PG8_STAGE(PG8_SB(0, 1), b2 + hstep, voffB);
            PG8_WAIT_V(6); PG8_BAR; PG8_MMA(1, 1, At, B1); PG8_BAR;
            PG8_LDB(B0, 1, 0); PG8_SCHED; PG8_LDA(At, 1, 0); PG8_STAGE(PG8_SA(0, 1), a2 + hstep, voffA);
            PG8_WAIT_L(8); PG8_BAR; PG8_WAIT_L(0); PG8_MMA(0, 0, At, B0); PG8_BAR; PG8_SCHED;
            PG8_LDB(B1, 1, 1); PG8_STAGE(PG8_SB(1, 0), b3, voffB);
            PG8_BAR; PG8_WAIT_L(0); PG8_MMA(0, 1, At, B1); PG8_BAR;
            PG8_LDA(At, 1, 1); PG8_STAGE(PG8_SA(1, 0), a3, voffA);
            PG8_BAR; PG8_WAIT_L(0); PG8_MMA(1, 0, At, B0); PG8_BAR; PG8_SCHED;
            PG8_STAGE(PG8_SB(1, 1), b3 + hstep, voffB);
            PG8_WAIT_V(6); PG8_BAR; PG8_MMA(1, 1, At, B1); PG8_BAR;
            }
        }
        PG8_TS(0);
        if constexpr (FP8) { asm volatile("s_nop 15\n\ts_nop 15" ::: "memory"); }
        if constexpr (ALIGN_EPI) { if (wr == 0) PG8_BAR; }
        if constexpr (!Epi::AFTER_DRAIN) { E(acc, cur, wr, wc, fr, fq); S.done(cur); }
        PG8_TS(1);
        if (!has_next) break;
#pragma unroll
        for (int a = 0; a < 2; ++a)
#pragma unroll
            for (int b = 0; b < 2; ++b)
#pragma unroll
                for (int m = 0; m < 4; ++m)
#pragma unroll
                    for (int n = 0; n < 2; ++n) acc[a][b][m][n] = (f32x4){0.f, 0.f, 0.f, 0.f};
        cur = nxt; cA = nA; cB = nB; ++ui;
        if constexpr (ALIGN_EPI) { if (wr == 1) PG8_BAR; }
    }
#ifdef PG8_PROF
    if (g.prof && blockIdx.x == 0 && tid == 0) { volatile PG8_LAS unsigned* p_ = (volatile PG8_LAS unsigned*)(lds + 143744); pg8_prof[0] = p_[0]; pg8_prof[1] = p_[1]; pg8_prof[2] = (unsigned long long)(ui + 1); }
#endif
    PG8_WAIT_V(0);
    if constexpr (!ALIGN_EPI) { if (wr == 0) PG8_BAR; }
    PG8_BAR;
    if constexpr (Epi::AFTER_DRAIN) { E.fused(acc, cur, wr, wc, fr, fq, lds, wid, lane); S.done(cur); }
#undef PG8_SA
#undef PG8_SB
#undef PG8_STAGE
#undef PG8_LD8
#undef PG8_LDA
#undef PG8_LDB
#undef PG8_MMA
#undef PG8_WAIT_V
#undef PG8_WAIT_L
#undef PG8_BAR
#undef PG8_SCHED
}
}

constexpr int D_MODEL = 1024, BATCH = 2, SEQ = 8192, MTOK = BATCH * SEQ, MEM_LEN = 256, MEMROWS = BATCH * MEM_LEN;
constexpr int IN_COLS = 9984, OFF_AQ = 0, OFF_AK = 1536, OFF_AV = 3072, OFF_R = 4608, OFF_CQ = 6400, OFF_GATE = 6912;
constexpr int RW = 512;
constexpr int N_EXPERTS = 32, TOP_K = 4, D_FF = 1024, MOE_ROWS = 256;
constexpr int MAX_BLOCKS = MTOK * TOP_K / MOE_ROWS + N_EXPERTS;
constexpr int MAX_SLOTS = MAX_BLOCKS * MOE_ROWS;
constexpr float NORM_EPS = 1e-6f, R_GN_EPS = 64e-5f;
constexpr float LOG2E = 1.4426950408889634f;
constexpr float QSCALE = 0.08838834764831845f * LOG2E;

namespace pg8 {
__device__ __forceinline__ float bf_lo(unsigned w) { return __builtin_bit_cast(float, w << 16); }
__device__ __forceinline__ float bf_hi(unsigned w) { return __builtin_bit_cast(float, w & 0xffff0000u); }
__device__ __forceinline__ float sigmoidf_fast(float x) { return __builtin_amdgcn_rcpf(1.0f + __builtin_amdgcn_exp2f(-1.4426950408889634f * x)); }

struct EpiZ {
    static constexpr bool PERM = true, AFTER_DRAIN = false;
    bf16_t* O; const float* bgate; const float* aqg; const float* akg; const float* cqg; const float* cs;
    bf16_t* KV; const float* ckg;
    PG8_LAS float* P;
    __device__ __forceinline__ void operator()(const f32x4 (&acc)[2][2][4][2], const Unit& u, int wr, int wc, int fr, int fq) const {
        const bool mem = u.pm >= 64; const int pnl = mem ? u.pn - 39 : u.pn, ldc = mem ? 1024 : IN_COLS;
        bf16_t* const Ob = mem ? KV - (size_t)64 * BM * 1024 : O;
        const int row0 = u.pm * BM + wr * 64 + fr, col0 = pnl * BM + wc * 32 + 8 * fq;
        const int cls = mem ? ((pnl < 2) ? 3 : 0) : (pnl < 6) ? 1 : (pnl < 12) ? 2 : (pnl == 25 || pnl == 26) ? 3 : (pnl >= 27) ? 4 : 0;
        if (cls >= 1 && cls <= 3) {
            const int go = wc * 32 + 8 * fq;
            const f32x4 q0 = *(const f32x4*)(aqg + go), q1 = *(const f32x4*)(aqg + go + 4), k0 = *(const f32x4*)(akg + go), k1 = *(const f32x4*)(akg + go + 4), x0 = *(const f32x4*)(cqg + go), x1 = *(const f32x4*)(cqg + go + 4);
            const f32x4 m0 = *(const f32x4*)(ckg + go), m1 = *(const f32x4*)(ckg + go + 4);
            const f32x4 g0 = mem ? m0 : (cls == 1) ? q0 : (cls == 2) ? k0 : x0, g1 = mem ? m1 : (cls == 1) ? q1 : (cls == 2) ? k1 : x1;
#pragma unroll
            for (int ai = 0; ai < 2; ++ai)
#pragma unroll
                for (int m = 0; m < 4; ++m)
#pragma unroll
                    for (int bj = 0; bj < 2; ++bj) { const f32x4 a = acc[ai][bj][m][0], b = acc[ai][bj][m][1];
                        float s = ((a[0] * a[0] + a[1] * a[1]) + (a[2] * a[2] + a[3] * a[3])) + ((b[0] * b[0] + b[1] * b[1]) + (b[2] * b[2] + b[3] * b[3]));
                        s += __shfl_xor(s, 16); s += __shfl_xor(s, 32);
                        if (fq == 0) P[((ai * HALF + wr * 64 + m * 16 + fr) * 2 + bj) * 4 + wc] = s; }
            asm volatile("s_waitcnt lgkmcnt(0)" ::: "memory"); __builtin_amdgcn_s_barrier(); asm volatile("" ::: "memory");
#pragma unroll
            for (int ai = 0; ai < 2; ++ai)
#pragma unroll
                for (int m = 0; m < 4; ++m) { const int rl = ai * HALF + wr * 64 + m * 16 + fr, row = u.pm * BM + rl;
                    f32x4 c0 = {0.f, 0.f, 0.f, 0.f}, c1 = c0, c2 = c0, c3 = c0;
                    if (cls != 3 && wc == 0) { const f32x4* cp = (const f32x4*)(cs + (size_t)row * 32 + 16 * (fq & 1)); c0 = cp[0]; c1 = cp[1]; c2 = cp[2]; c3 = cp[3]; }
#pragma unroll
                    for (int bj = 0; bj < 2; ++bj) { const f32x4 pv = *(const PG8_LAS f32x4*)(P + (rl * 2 + bj) * 4);
                        const float rstd = __builtin_amdgcn_rsqf(((pv[0] + pv[1]) + (pv[2] + pv[3])) * (1.0f / 128.0f) + NORM_EPS);
                        f32x4 v0 = acc[ai][bj][m][0] * rstd * g0, v1 = acc[ai][bj][m][1] * rstd * g1;
                        if (cls != 3 && wc == 0) {
                            f32x4 p0, p1;
#pragma unroll
                            for (int j = 0; j < 4; ++j) { p0[j] = __shfl_xor(v0[j], 32); p1[j] = __shfl_xor(v1[j], 32); }
                            const float sg = (fq < 2) ? -1.0f : 1.0f;
                            v0[0] = v0[0] * c0[0] + sg * p0[0] * c0[1]; v0[1] = v0[1] * c0[2] + sg * p0[1] * c0[3]; v0[2] = v0[2] * c1[0] + sg * p0[2] * c1[1]; v0[3] = v0[3] * c1[2] + sg * p0[3] * c1[3];
                            v1[0] = v1[0] * c2[0] + sg * p1[0] * c2[1]; v1[1] = v1[1] * c2[2] + sg * p1[1] * c2[3]; v1[2] = v1[2] * c3[0] + sg * p1[2] * c3[1]; v1[3] = v1[3] * c3[2] + sg * p1[3] * c3[3]; }
                        u32x4 w; w.x = cvt_pk_bf16(v0[0], v0[1]); w.y = cvt_pk_bf16(v0[2], v0[3]); w.z = cvt_pk_bf16(v1[0], v1[1]); w.w = cvt_pk_bf16(v1[2], v1[3]);
                        *(u32x4*)(Ob + (size_t)row * ldc + col0 + bj * HALF) = w; } }
            return;
        }
        const bool gate = cls == 4;
        f32x4 bv[2][2];
#pragma unroll
        for (int bj = 0; bj < 2; ++bj)
#pragma unroll
            for (int n = 0; n < 2; ++n) bv[bj][n] = gate ? *(const f32x4*)(bgate + (col0 - OFF_GATE) + bj * HALF + 4 * n) : (f32x4){0.f, 0.f, 0.f, 0.f};
#pragma unroll
        for (int ai = 0; ai < 2; ++ai)
#pragma unroll
            for (int m = 0; m < 4; ++m) { bf16_t* rowp = Ob + (size_t)(row0 + ai * HALF + m * 16) * ldc + col0;
#pragma unroll
                for (int bj = 0; bj < 2; ++bj) { f32x4 v0 = acc[ai][bj][m][0] + bv[bj][0], v1 = acc[ai][bj][m][1] + bv[bj][1];
                    if (gate) {
#pragma unroll
                        for (int j = 0; j < 4; ++j) { v0[j] = sigmoidf_fast(v0[j]); v1[j] = sigmoidf_fast(v1[j]); } }
                    u32x4 w; w.x = cvt_pk_bf16(v0[0], v0[1]); w.y = cvt_pk_bf16(v0[2], v0[3]); w.z = cvt_pk_bf16(v1[0], v1[1]); w.w = cvt_pk_bf16(v1[2], v1[3]);
                    *(u32x4*)(rowp + bj * HALF) = w; } }
    }
};

template <int SET> struct ZOrder {
    StaticOrder so; int nz;
    __device__ void init(int G_, int c_) { so.init(MTOK, (SET == 0 ? 15 : 24) * BM, G_, c_); nz = 64 * (SET == 0 ? 15 : 24); }
    __device__ __forceinline__ bool next(int i, Unit& u) const {
        if (so.next(i, u)) { const int t = u.pn;
            if (SET == 0) u.pn = t + 12; else u.pn = (t < 12) ? t : t + 15;
            return true; }
        if (SET == 0) { const long L = (long)i * so.G + so.c - nz; if (L >= 0 && L < 8) { u.pm = 64 + (int)(L & 1); u.pn = 39 + (int)(L >> 1); return true; } }
        return false;
    }
    __device__ __forceinline__ void a_ready(const Unit&) const {}
    __device__ __forceinline__ void done(const Unit&) const {}
};
struct EpiGate3 {
    static constexpr bool PERM = true, AFTER_DRAIN = false;
    const bf16_t* Z; bf16_t* mergedb;
    __device__ __forceinline__ void mid(f32x4 (&acc)[2][2][4][2], const Unit& u, int t, int wr, int wc, int fr, int fq) const {
        int fr_ = fr; asm volatile("" : "+v"(fr_));
        const int row0 = u.pm * BM + wr * 64 + fr_, col0 = u.pn * BM + wc * 32 + 8 * fq, ba = (t >> 3) - 1;
        const bf16_t* gp = Z + OFF_GATE + ba * D_MODEL + col0;
#pragma unroll
        for (int ai = 0; ai < 2; ++ai)
#pragma unroll
            for (int m = 0; m < 4; ++m) { const bf16_t* rp = gp + (size_t)(row0 + ai * HALF + m * 16) * IN_COLS;
#pragma unroll
                for (int bj = 0; bj < 2; ++bj) { const u32x4 ga = *(const u32x4*)(rp + bj * HALF), gb = *(const u32x4*)(rp + D_MODEL + bj * HALF);
                    f32x4 r0, r1;
                    r0[0] = bf_lo(ga[0]) * __builtin_amdgcn_rcpf(bf_lo(gb[0])); r0[1] = bf_hi(ga[0]) * __builtin_amdgcn_rcpf(bf_hi(gb[0])); r0[2] = bf_lo(ga[1]) * __builtin_amdgcn_rcpf(bf_lo(gb[1])); r0[3] = bf_hi(ga[1]) * __builtin_amdgcn_rcpf(bf_hi(gb[1]));
                    r1[0] = bf_lo(ga[2]) * __builtin_amdgcn_rcpf(bf_lo(gb[2])); r1[1] = bf_hi(ga[2]) * __builtin_amdgcn_rcpf(bf_hi(gb[2])); r1[2] = bf_lo(ga[3]) * __builtin_amdgcn_rcpf(bf_lo(gb[3])); r1[3] = bf_hi(ga[3]) * __builtin_amdgcn_rcpf(bf_hi(gb[3]));
                    acc[ai][bj][m][0] *= r0; acc[ai][bj][m][1] *= r1; }
                if (m == 3) asm volatile("" ::: "memory"); }
    }
    __device__ __forceinline__ void operator()(const f32x4 (&acc)[2][2][4][2], const Unit& u, int wr, int wc, int fr, int fq) const {
        const int row0 = u.pm * BM + wr * 64 + fr, col0 = u.pn * BM + wc * 32 + 8 * fq;
        u32x4 gzr[2][4][2];
#pragma unroll
        for (int ai = 0; ai < 2; ++ai)
#pragma unroll
            for (int m = 0; m < 4; ++m)
#pragma unroll
                for (int bj = 0; bj < 2; ++bj) gzr[ai][m][bj] = *(const u32x4*)(Z + (size_t)(row0 + ai * HALF + m * 16) * IN_COLS + OFF_GATE + 2 * D_MODEL + col0 + bj * HALF);
#pragma unroll
        for (int ai = 0; ai < 2; ++ai)
#pragma unroll
            for (int m = 0; m < 4; ++m) { const int row = row0 + ai * HALF + m * 16;
#pragma unroll
                for (int bj = 0; bj < 2; ++bj) { const int col = col0 + bj * HALF; const u32x4 gz = gzr[ai][m][bj];
                    f32x4 g0, g1;
                    g0[0] = bf_lo(gz[0]); g0[1] = bf_hi(gz[0]); g0[2] = bf_lo(gz[1]); g0[3] = bf_hi(gz[1]); g1[0] = bf_lo(gz[2]); g1[1] = bf_hi(gz[2]); g1[2] = bf_lo(gz[3]); g1[3] = bf_hi(gz[3]);
                    const f32x4 v0 = acc[ai][bj][m][0] * g0, v1 = acc[ai][bj][m][1] * g1;
                    u32x4 w; w.x = cvt_pk_bf16(v0[0], v0[1]); w.y = cvt_pk_bf16(v0[2], v0[3]); w.z = cvt_pk_bf16(v1[0], v1[1]); w.w = cvt_pk_bf16(v1[2], v1[3]);
                    *(u32x4*)(mergedb + (size_t)row * D_MODEL + col) = w; } }
    }
};
template <> struct EpiHasMid<EpiGate3> { static constexpr bool v = true; };
struct EpiGate3NoMid : EpiGate3 {};
struct EpiResF32 {
    static constexpr bool PERM = true, AFTER_DRAIN = false;
    const float* base; float* out; int ldc;
    __device__ __forceinline__ void operator()(const f32x4 (&acc)[2][2][4][2], const Unit& u, int wr, int wc, int fr, int fq) const {
        const int row0 = u.pm * BM + wr * 64 + fr, col0 = u.pn * BM + wc * 32 + 8 * fq;
#pragma unroll
        for (int ai = 0; ai < 2; ++ai) {
            f32x4 xr[4][2][2];
#pragma unroll
            for (int m = 0; m < 4; ++m)
#pragma unroll
                for (int bj = 0; bj < 2; ++bj) { const float* bp = base + (size_t)(row0 + ai * HALF + m * 16) * ldc + col0 + bj * HALF; xr[m][bj][0] = *(const f32x4*)bp; xr[m][bj][1] = *(const f32x4*)(bp + 4); }
#pragma unroll
            for (int m = 0; m < 4; ++m)
#pragma unroll
                for (int bj = 0; bj < 2; ++bj) { float* op = out + (size_t)(row0 + ai * HALF + m * 16) * ldc + col0 + bj * HALF;
                    *(f32x4*)op = xr[m][bj][0] + acc[ai][bj][m][0]; *(f32x4*)(op + 4) = xr[m][bj][1] + acc[ai][bj][m][1]; }
            asm volatile("" ::: "memory"); }
    }
};
struct EpiSwiGLU {
    static constexpr bool PERM = true, AFTER_DRAIN = false;
    const float* b1; bf16_t* H;
    __device__ __forceinline__ void operator()(const f32x4 (&acc)[2][2][4][2], const Unit& u, int wr, int wc, int fr, int fq) const {
        const int e = u.pn >> 3, pnl = u.pn & 7;
        const int row0 = u.pm * BM + wr * 64 + fr, ac = pnl * HALF + wc * 32 + 8 * fq;
        const float* bg = b1 + (size_t)e * 2 * D_FF + ac; const float* bl = bg + D_FF;
        const f32x4 bg0 = *(const f32x4*)bg, bg1 = *(const f32x4*)(bg + 4), bl0 = *(const f32x4*)bl, bl1 = *(const f32x4*)(bl + 4);
#pragma unroll
        for (int ai = 0; ai < 2; ++ai)
#pragma unroll
            for (int m = 0; m < 4; ++m) { const int row = row0 + ai * HALF + m * 16;
                float a[8];
#pragma unroll
                for (int n = 0; n < 2; ++n) { const f32x4 ug = acc[ai][0][m][n] + (n ? bg1 : bg0), ul = acc[ai][1][m][n] + (n ? bl1 : bl0);
#pragma unroll
                    for (int j = 0; j < 4; ++j) { const float g = fminf(ug[j], 7.0f), l = fminf(fmaxf(ul[j], -7.0f), 7.0f);
                        a[4 * n + j] = g * sigmoidf_fast(1.702f * g) * (l + 1.0f); } }
                unsigned w0 = 0, w1 = 0;
                w0 = __builtin_amdgcn_cvt_pk_fp8_f32(a[0] * 8.0f, a[1] * 8.0f, w0, false); w0 = __builtin_amdgcn_cvt_pk_fp8_f32(a[2] * 8.0f, a[3] * 8.0f, w0, true);
                w1 = __builtin_amdgcn_cvt_pk_fp8_f32(a[4] * 8.0f, a[5] * 8.0f, w1, false); w1 = __builtin_amdgcn_cvt_pk_fp8_f32(a[6] * 8.0f, a[7] * 8.0f, w1, true);
                *(unsigned long long*)((unsigned char*)H + (size_t)row * D_FF + ac) = (unsigned long long)w0 | ((unsigned long long)w1 << 32); }
    }
};
struct EpiMoeOut {
    static constexpr bool PERM = true, AFTER_DRAIN = false;
    const float* b2; const float* rowgate; bf16_t* Y;
    __device__ __forceinline__ void operator()(const f32x4 (&acc)[2][2][4][2], const Unit& u, int wr, int wc, int fr, int fq) const {
        const int e = u.pn >> 2, pnl = u.pn & 3;
        const int row0 = u.pm * BM + wr * 64 + fr, col0 = pnl * BM + wc * 32 + 8 * fq;
        float gtr[2][4]; f32x4 bb[2][2];
#pragma unroll
        for (int ai = 0; ai < 2; ++ai)
#pragma unroll
            for (int m = 0; m < 4; ++m) gtr[ai][m] = rowgate[row0 + ai * HALF + m * 16];
#pragma unroll
        for (int bj = 0; bj < 2; ++bj) { const float* bp = b2 + (size_t)e * D_MODEL + col0 + bj * HALF; bb[bj][0] = *(const f32x4*)bp; bb[bj][1] = *(const f32x4*)(bp + 4); }
#pragma unroll
        for (int ai = 0; ai < 2; ++ai)
#pragma unroll
            for (int m = 0; m < 4; ++m) { const int row = row0 + ai * HALF + m * 16; const float gt = gtr[ai][m];
#pragma unroll
                for (int bj = 0; bj < 2; ++bj) { const int col = col0 + bj * HALF;
                    const f32x4 v0 = (acc[ai][bj][m][0] + bb[bj][0]) * gt, v1 = (acc[ai][bj][m][1] + bb[bj][1]) * gt;
                    unsigned w0 = 0, w1 = 0;
                    w0 = __builtin_amdgcn_cvt_pk_fp8_f32(v0[0] * 16.0f, v0[1] * 16.0f, w0, false); w0 = __builtin_amdgcn_cvt_pk_fp8_f32(v0[2] * 16.0f, v0[3] * 16.0f, w0, true);
                    w1 = __builtin_amdgcn_cvt_pk_fp8_f32(v1[0] * 16.0f, v1[1] * 16.0f, w1, false); w1 = __builtin_amdgcn_cvt_pk_fp8_f32(v1[2] * 16.0f, v1[3] * 16.0f, w1, true);
                    *(unsigned long long*)((unsigned char*)Y + (size_t)row * D_MODEL + col) = (unsigned long long)w0 | ((unsigned long long)w1 << 32); } }
    }
};
struct MoeOrder {
    const PG8_LAS int* tab;
    int NT, G, c;
    __device__ __forceinline__ bool next(int i, Unit& u) const {
        const int nblk = tab[0], nu = nblk * NT; const long L0 = (long)i * G + c; if (L0 >= (long)nu) return false;
        int L = (int)L0; { const int q = nu / NXCD, r = nu % NXCD, xcd = L % NXCD, off = L / NXCD; L = (xcd < r ? xcd * (q + 1) : r * (q + 1) + (xcd - r) * q) + off; }
        const int blk = L / NT, pnl = L % NT; u.pm = blk; u.pn = tab[1 + blk] * NT + pnl; return true;
    }
    __device__ __forceinline__ void a_ready(const Unit&) const {}
    __device__ __forceinline__ void done(const Unit&) const {}
};
}

namespace swa {
constexpr int D = 128;
constexpr float SCALE = 0.08838834764831845f;
constexpr float THR = 8.f;
constexpr int NW = 8, QBLK = 32, KVBLK = 64, QB = NW * QBLK;
constexpr int SHM_V = KVBLK * D * 2, SHM_K = KVBLK * D * 2;
constexpr int LDS_BYTES = 2 * SHM_V + 2 * SHM_K + NW * 64 * 4;
using bf16 = unsigned short;
typedef short bf16x8 __attribute__((ext_vector_type(8)));
typedef short s16x4 __attribute__((ext_vector_type(4)));
typedef float f32x16 __attribute__((ext_vector_type(16)));
typedef float f32x4 __attribute__((ext_vector_type(4)));
typedef unsigned u32x4 __attribute__((ext_vector_type(4)));
template <class A, class Bt> struct same_t { static constexpr bool v = false; };
template <class A> struct same_t<A, A> { static constexpr bool v = true; };
#define KSWZ(row, colB) ((row) * 256 + ((colB) ^ (((row) & 7) << 4)))
#define SBAR() __builtin_amdgcn_sched_barrier(0)
__device__ __forceinline__ int v_st(int k, int c) { const int kk = (k & ~0xC) | ((k & 4) << 1) | ((k & 8) >> 1); return ((kk >> 3) * 4 + (c >> 5)) * 512 + ((kk & 7) * 32 + (c & 31)) * 2; }
__device__ __forceinline__ int v_rd_base(int lane) { return ((lane & 3) << 3) | (((lane >> 2) & 3) << 6) | (((lane >> 4) & 1) << 5) | (((lane >> 5) & 1) << 8); }
constexpr int v_rd_off(int d0, int ks, int half) { return d0 * 512 + ks * 4096 + half * 2048; }
__device__ __forceinline__ int crow(int r, int hi) { return (r & 3) + 8 * (r >> 2) + 4 * hi; }
__device__ __forceinline__ unsigned cvtpk(float lo, float hi) {
    unsigned r; asm volatile("v_cvt_pk_bf16_f32 %0, %1, %2" : "=v"(r) : "v"(lo), "v"(hi)); return r;
}
__device__ __forceinline__ bf16x8 pack8(f32x4 a, f32x4 b) {
    u32x4 w = {cvtpk(a[0], a[1]), cvtpk(a[2], a[3]), cvtpk(b[0], b[1]), cvtpk(b[2], b[3])};
    return *reinterpret_cast<bf16x8*>(&w);
}
template <class T> __device__ __forceinline__ bf16x8 load8(const T* p) {
    if constexpr (same_t<T, float>::v) { return pack8(*(const f32x4*)p, *(const f32x4*)(p + 4)); }
    else { return *reinterpret_cast<const bf16x8*>(p); }
}
__device__ __forceinline__ void mask_tile(f32x16& p0, f32x16& p1, int dq, unsigned W) {
    const float NEG = -__builtin_inff();
#pragma unroll
    for (int r = 0; r < 16; ++r) {
        const int c = (r & 3) + 8 * (r >> 2);
        if ((unsigned)(dq - c) >= W) p0[r] = NEG;
        if ((unsigned)(dq - c - 32) >= W) p1[r] = NEG;
    }
}
__device__ __forceinline__ void partialSM(f32x16& p0, f32x16& p1, float& m_reg, float& mn, float& alpha) {
    float pmax = p0[0]; for (int r = 1; r < 16; ++r) pmax = fmaxf(pmax, p0[r]); for (int r = 0; r < 16; ++r) pmax = fmaxf(pmax, p1[r]);
    { auto rr = __builtin_amdgcn_permlane32_swap(__float_as_uint(pmax), __float_as_uint(pmax), false, false);
      pmax = fmaxf(__uint_as_float(rr[0]), __uint_as_float(rr[1])); }
    constexpr float C2 = 1.4426950408889634f * SCALE;
    if (__builtin_expect(__all((pmax - m_reg) * SCALE <= THR), 1)) { mn = m_reg; alpha = 1.f; }
    else { mn = fmaxf(m_reg, pmax); alpha = __builtin_amdgcn_exp2f((m_reg - mn) * C2); m_reg = mn; }
    const float mnL = -mn * C2;
    for (int r = 0; r < 16; ++r) p0[r] = fmaf(p0[r], C2, mnL); for (int r = 0; r < 16; ++r) p1[r] = fmaf(p1[r], C2, mnL);
    for (int r = 0; r < 16; ++r) p0[r] = __builtin_amdgcn_exp2f(p0[r]);
}
__device__ __forceinline__ void finishSM(f32x16& p0, f32x16& p1, float alpha, float& l_reg, bf16x8& pa0, bf16x8& pa1, bf16x8& pa2, bf16x8& pa3) {
    for (int r = 0; r < 16; ++r) p1[r] = __builtin_amdgcn_exp2f(p1[r]);
    float ps = 0; for (int r = 0; r < 16; ++r) ps += p0[r]; for (int r = 0; r < 16; ++r) ps += p1[r];
    { auto rr = __builtin_amdgcn_permlane32_swap(__float_as_uint(ps), __float_as_uint(ps), false, false);
      ps = __uint_as_float(rr[0]) + __uint_as_float(rr[1]); }
    l_reg = l_reg * alpha + ps;
#define PK4(P, B_, OUT) do { unsigned a0 = cvtpk(P[B_+0], P[B_+1]), a1 = cvtpk(P[B_+2], P[B_+3]);                          \
        unsigned b0 = cvtpk(P[B_+4], P[B_+5]), b1 = cvtpk(P[B_+6], P[B_+7]);                                             \
        auto r0 = __builtin_amdgcn_permlane32_swap(a0, b0, false, false); auto r1 = __builtin_amdgcn_permlane32_swap(a1, b1, false, false); \
        u32x4 w = {r0[0], r1[0], r0[1], r1[1]}; OUT = *reinterpret_cast<bf16x8*>(&w); } while (0)
    PK4(p0, 0, pa0); PK4(p0, 8, pa1); PK4(p1, 0, pa2); PK4(p1, 8, pa3);
#undef PK4
}
template <int KB, bool SK>
__device__ __forceinline__ void qkt(f32x16& p0, f32x16& p1, const char* K_lds, int r32, int hi, const bf16x8* qr, bool act) {
    if (SK && !act) { const float NEG = -__builtin_inff();
#pragma unroll
        for (int r = 0; r < 16; ++r) { p0[r] = NEG; p1[r] = NEG; } return; }
    p0 = f32x16{}; p1 = f32x16{};
    const char* kb[4];
#pragma unroll
    for (int dd = 0; dd < 4; ++dd) kb[dd] = K_lds + KB * SHM_K + KSWZ(r32, (dd * 16 + hi * 8) * 2);
#pragma unroll
    for (int d0 = 0; d0 < 8; ++d0) { const char* a = kb[d0 & 3] + (d0 >> 2) * 128;
        bf16x8 b0 = *reinterpret_cast<const bf16x8*>(a);
        bf16x8 b1 = *reinterpret_cast<const bf16x8*>(a + 32 * 256);
        p0 = __builtin_amdgcn_mfma_f32_32x32x16_bf16(b0, qr[d0], p0, 0, 0, 0);
        p1 = __builtin_amdgcn_mfma_f32_32x32x16_bf16(b1, qr[d0], p1, 0, 0, 0); }
}
template <int VB, bool SK>
__device__ __forceinline__ void pv_tile(f32x16* o, int vb0, bf16x8 pa0, bf16x8 pa1, bf16x8 pa2, bf16x8 pa3, bool act) {
    if (SK && !act) return;
#define TRRD(dst, off) asm volatile("ds_read_b64_tr_b16 %0, %1 offset:%2" : "=&v"(dst) : "v"(vb0), "i"(off) : "memory")
#define PV_D0(d0) do { s16x4 l0, l1, l2, l3, h0, h1, h2, h3; constexpr int b_ = VB * SHM_V + v_rd_off(d0, 0, 0);     \
        TRRD(l0, b_); TRRD(h0, b_ + 2048); TRRD(l1, b_ + 4096); TRRD(h1, b_ + 6144); TRRD(l2, b_ + 8192); TRRD(h2, b_ + 10240); TRRD(l3, b_ + 12288); TRRD(h3, b_ + 14336); \
        asm volatile("s_waitcnt lgkmcnt(0)" ::: "memory"); SBAR();                 \
        o[d0] = __builtin_amdgcn_mfma_f32_32x32x16_bf16(pa0, (bf16x8){l0[0], l0[1], l0[2], l0[3], h0[0], h0[1], h0[2], h0[3]}, o[d0], 0, 0, 0);   \
        o[d0] = __builtin_amdgcn_mfma_f32_32x32x16_bf16(pa1, (bf16x8){l1[0], l1[1], l1[2], l1[3], h1[0], h1[1], h1[2], h1[3]}, o[d0], 0, 0, 0);   \
        o[d0] = __builtin_amdgcn_mfma_f32_32x32x16_bf16(pa2, (bf16x8){l2[0], l2[1], l2[2], l2[3], h2[0], h2[1], h2[2], h2[3]}, o[d0], 0, 0, 0);   \
        o[d0] = __builtin_amdgcn_mfma_f32_32x32x16_bf16(pa3, (bf16x8){l3[0], l3[1], l3[2], l3[3], h3[0], h3[1], h3[2], h3[3]}, o[d0], 0, 0, 0); } while (0)
    PV_D0(0); PV_D0(1); PV_D0(2); PV_D0(3);
#undef PV_D0
#undef TRRD
}

struct BlockRef { const bf16* Q; const bf16* K; const bf16* V; bf16* O; float* LSE; int QS, KS, OS, LS, P0, skv, W; };
struct Seam { bf16x8 qr[8]; bf16x8 st_v0, st_v1, st_k0, st_k1; };
__device__ __forceinline__ int swa_jlo(int P0, int W) { const int lowk = P0 - W + 1; return lowk > 0 ? lowk / KVBLK : 0; }
#define LD8(p) (*reinterpret_cast<const bf16x8*>(p))
#define ROW(p, k0, rr, RS) ((p) + (size_t)((k0) + (rr)) * (RS) + sc)
#define VMW() asm volatile("s_waitcnt vmcnt(0)" ::: "memory")
#define VMWN(n) asm volatile("s_waitcnt vmcnt(%0)" :: "i"(n) : "memory")
#define SLOAD_H(Kp, Vp, k0, RS) do { const char* kb_ = (const char*)(Kp) + (size_t)(k0) * (size_t)(RS) * 2; const char* vb_ = (const char*)(Vp) + (size_t)(k0) * (size_t)(RS) * 2;  \
                         const unsigned oa_ = (unsigned)(sr * (RS) + sc) * 2u, ob_ = oa_ + (unsigned)(RS) * 64u;                                    \
                         S.st_v0 = LD8(vb_ + oa_); S.st_v1 = LD8(vb_ + ob_); S.st_k0 = LD8(kb_ + oa_); S.st_k1 = LD8(kb_ + ob_); } while (0)
#define SWRITE_HK(bf) do { *(bf16x8*)(K_lds + (bf) * SHM_K + kws) = S.st_k0; *(bf16x8*)(K_lds + (bf) * SHM_K + kws + 32 * 256) = S.st_k1; } while (0)
#define SWRITE_HV(bf) do { *(bf16x8*)(V_lds + (bf) * SHM_V + vst0) = S.st_v0; *(bf16x8*)(V_lds + (bf) * SHM_V + vst1) = S.st_v1; } while (0)
#define SWRITE_H(bf) do { SWRITE_HV(bf); SWRITE_HK(bf); } while (0)
__device__ __forceinline__ void swa_prime(const BlockRef& cur, char* lds, Seam& S) {
    int tid_ = threadIdx.x; asm volatile("" : "+v"(tid_));
    const int tid = tid_, wid = __builtin_amdgcn_readfirstlane(tid >> 6), lane = tid & 63, r32 = lane & 31, hi = lane >> 5;
    const int sr = tid >> 4, sc = (tid & 15) * 8, kws = KSWZ(sr, sc * 2); char* K_lds = lds + 2 * SHM_V;
    const int kb0 = swa_jlo(cur.P0, cur.W) * KVBLK;
    { const char* qb_ = (const char*)cur.Q + (size_t)(wid * QBLK) * (size_t)cur.QS * 2; const unsigned qo_ = (unsigned)(r32 * cur.QS + hi * 8) * 2u;
      for (int d0 = 0; d0 < 8; ++d0) S.qr[d0] = LD8(qb_ + qo_ + d0 * 32); }
    SLOAD_H(cur.K, cur.V, kb0, cur.KS); VMW(); SWRITE_HK(0);
    __syncthreads();
}
__device__ __forceinline__ void swa_block(const BlockRef& cur, const BlockRef& nxt, char* lds, Seam& S) {
    int tid_ = threadIdx.x; asm volatile("" : "+v"(tid_));
    const int tid = tid_, wid = __builtin_amdgcn_readfirstlane(tid >> 6), lane = tid & 63, r32 = lane & 31, hi = lane >> 5;
    const int W = cur.W, skv = cur.skv;
    const int j_lo = swa_jlo(cur.P0, W);
    int j_hi = (cur.P0 + QB - 1) / KVBLK + 1; if (j_hi > skv / KVBLK) j_hi = skv / KVBLK;
    const int NT = j_hi - j_lo;
    const int kbn = swa_jlo(nxt.P0, nxt.W) * KVBLK;
    const int qlo = cur.P0 + wid * QBLK, qm = qlo + r32 - 4 * hi;
    char* V_lds = lds; char* K_lds = lds + 2 * SHM_V;
    float* ws = (float*)(lds + 2 * SHM_V + 2 * SHM_K) + wid * 64; float* li_l = ws, * al_l = ws + 32;
    float m_reg = -1e30f, l_reg = 0; f32x16 o[4] = {};
    const int sr = tid >> 4, sc = (tid & 15) * 8, vst0 = v_st(sr, sc), vst1 = v_st(32 + sr, sc), kws = KSWZ(sr, sc * 2);
    const int vb0 = (int)(uintptr_t)V_lds + v_rd_base(lane);
    const bf16* Kh = cur.K; const bf16* Vh = cur.V; const int KSc = cur.KS;
#define RESC(a) do { if (__any((a) < 1.f)) { if (hi == 0) al_l[r32] = (a); asm volatile("s_waitcnt lgkmcnt(0)" ::: "memory");              \
                     for (int d_ = 0; d_ < 4; ++d_) for (int r = 0; r < 16; ++r) o[d_][r] *= al_l[crow(r, hi)]; } } while (0)
#define KBASE(t) ((j_lo + (t)) * KVBLK)
#define ACT(t) (KBASE(t) <= qlo + QBLK - 1 && KBASE(t) + KVBLK - 1 >= qlo - W + 1)
#define MASKT(P0_, P1_, t) do { const int kb_ = KBASE(t); if ((!SK || ACT(t)) && (kb_ + KVBLK - 1 > qlo || kb_ <= qlo + QBLK - 1 - W)) mask_tile(P0_, P1_, qm - kb_, (unsigned)W); } while (0)
    constexpr int NQL = 8;
    constexpr bool SK = true;
#define SEAM_K0() do { VMWN(NQL); SWRITE_HK(0); SBAR(); } while (0)
    f32x16 pA0, pA1, pB0, pB1; float mnA, mnB, alA, alB; bf16x8 pa0, pa1, pa2, pa3;
    SWRITE_HV(0); SBAR();
    if (NT > 1) { SLOAD_H(Kh, Vh, KBASE(1), KSc); }
    SBAR(); qkt<0, SK>(pA0, pA1, K_lds, r32, hi, S.qr, ACT(0));
    MASKT(pA0, pA1, 0); partialSM(pA0, pA1, m_reg, mnA, alA);
    if (NT > 1) { VMW(); SWRITE_H(1); }
    __syncthreads();
#define HALF_STEP(PX0, PX1, mnX, alX, PY0, PY1, alY, t, KB, VB, SB) do {                                                      \
        SBAR(); qkt<KB, SK>(PX0, PX1, K_lds, r32, hi, S.qr, ACT(t));                                             \
        finishSM(PY0, PY1, alY, l_reg, pa0, pa1, pa2, pa3); SBAR();                                                           \
        if ((t) + 1 < NT) { SLOAD_H(Kh, Vh, KBASE((t) + 1), KSc); SBAR(); }                                               \
        pv_tile<VB, SK>(o, vb0, pa0, pa1, pa2, pa3, ACT((t) - 1)); MASKT(PX0, PX1, (t)); partialSM(PX0, PX1, m_reg, mnX, alX);                                        \
        __syncthreads();                                                                                                      \
        if ((t) + 1 < NT) { VMW(); SWRITE_H(SB); }                                                                          \
        RESC(alX); __syncthreads(); } while (0)
    for (int t = 1; t + 1 < NT; t += 2) {
        HALF_STEP(pB0, pB1, mnB, alB, pA0, pA1, alA, t, 1, 0, 0);
        HALF_STEP(pA0, pA1, mnA, alA, pB0, pB1, alB, t + 1, 0, 1, 1);
    }
    const bool even = (NT & 1) == 0;
    if (even) { SBAR(); qkt<1, SK>(pB0, pB1, K_lds, r32, hi, S.qr, ACT(NT - 1)); SBAR(); }
    { SLOAD_H(nxt.K, nxt.V, kbn, nxt.KS); SBAR();
      const char* qb_ = (const char*)nxt.Q + (size_t)(wid * QBLK) * (size_t)nxt.QS * 2; const unsigned qo_ = (unsigned)(r32 * nxt.QS + hi * 8) * 2u;
#pragma unroll
        for (int d0 = 0; d0 < 8; ++d0) S.qr[d0] = LD8(qb_ + qo_ + d0 * 32); }
    SBAR();
    finishSM(pA0, pA1, alA, l_reg, pa0, pa1, pa2, pa3); SBAR();
    pv_tile<0, SK>(o, vb0, pa0, pa1, pa2, pa3, ACT(even ? NT - 2 : NT - 1));
    if (even) { MASKT(pB0, pB1, NT - 1); partialSM(pB0, pB1, m_reg, mnB, alB); __syncthreads(); RESC(alB);
        finishSM(pB0, pB1, alB, l_reg, pa0, pa1, pa2, pa3); SBAR(); pv_tile<1, SK>(o, vb0, pa0, pa1, pa2, pa3, ACT(NT - 1)); }
    SBAR(); SEAM_K0();
    if (hi == 0) li_l[r32] = l_reg; asm volatile("s_waitcnt lgkmcnt(0)" ::: "memory");
    if (cur.LSE != nullptr && hi == 0) cur.LSE[(size_t)(wid * QBLK + r32) * cur.LS] = __log2f(l_reg) + m_reg * (1.4426950408889634f * SCALE);
    float rli[16];
#pragma unroll
    for (int r = 0; r < 16; ++r) rli[r] = __builtin_amdgcn_rcpf(li_l[crow(r, hi)]);
    bf16* Ow = cur.O + (size_t)(wid * QBLK) * cur.OS;
#pragma unroll
    for (int r = 0; r < 16; ++r) { const int orow = crow(r, hi);
#pragma unroll
        for (int d0 = 0; d0 < 4; ++d0) { const float v = o[d0][r] * rli[r];
            const float vn = __shfl_xor(v, 1);
            if ((r32 & 1) == 0) *(unsigned*)(Ow + (size_t)orow * cur.OS + d0 * 32 + r32) = cvtpk(v, vn); } }
    __syncthreads();
#undef RESC
#undef KBASE
#undef ACT
#undef MASKT
#undef SEAM_K0
#undef HALF_STEP
}
#undef LD8
#undef ROW
#undef VMW
#undef VMWN
#undef SLOAD_H
#undef SWRITE_HK
#undef SWRITE_HV
#undef SWRITE_H
#undef KSWZ
#undef SBAR
}

constexpr int NWAVES = 8;
#ifndef MK_N_LAUNCHES
#define MK_N_LAUNCHES 1
#endif
constexpr int N_PHASES = 13;
constexpr float W8_SCALE = 32.0f, H8_SCALE = 8.0f;
constexpr int SC_ONE = 0x7f7f7f7f, SC_W8 = 0x7a7a7a7a  , SC_H8 = 0x7c7c7c7c  ;
#ifndef NAIVE_ATTN
#define NAIVE_ATTN 0
#endif
constexpr float ATT_QSCALE = NAIVE_ATTN ? QSCALE : 1.0f;

constexpr size_t MiB = 1u << 20;
constexpr size_t WS_CTL = 0, CTL_ZERO_BYTES = 1 * MiB;
constexpr size_t WS_WIN = 2 * MiB;
constexpr size_t WS_WB = 24 * MiB;
constexpr size_t WS_WO = 27 * MiB;
constexpr size_t WS_WMEM = WS_WIN + (size_t)9984 * 1024 * 2;
constexpr size_t WS_W1 = 29 * MiB;
constexpr size_t WS_W2 = 157 * MiB;
constexpr size_t WS_XN = 221 * MiB;
constexpr size_t WS_Z = 256 * MiB;
constexpr size_t WS_RW = 568 * MiB;
constexpr size_t WS_YS = 792 * MiB;
constexpr size_t WS_YABC = 824 * MiB;
constexpr size_t WS_MRG = 872 * MiB;
constexpr size_t WS_MRGB = 936 * MiB;
constexpr size_t WS_MEMN = WS_XN + (size_t)16384 * 1024 * 2;
constexpr size_t WS_KVM = 969 * MiB;
constexpr size_t WS_XN2 = 970 * MiB;
constexpr size_t WS_ROUTE = 1002 * MiB;
constexpr size_t WS_LORA = 1004 * MiB;
constexpr size_t WS_END = 1005 * MiB;
constexpr size_t WS_XS = 256 * MiB;
constexpr size_t WS_HACT = 400 * MiB;
constexpr size_t WS_YROWS = 544 * MiB;
constexpr size_t WS_OP = WS_MRG;
constexpr size_t WS_LSE = WS_MRGB;
constexpr size_t WS_CS = WS_RW;
constexpr size_t WS_VMIX = WS_RW + 32 * MiB, WS_GMIX = WS_RW + 64 * MiB;
constexpr size_t WS_XN8 = WS_YS, WS_WIN8 = WS_YS + 16 * MiB;
constexpr size_t RWSZ = (size_t)MTOK * RW * 4;
constexpr size_t RT_TOPI = 0, RT_TOPG = 256 * 1024, RT_POS = 512 * 1024, RT_ROWGATE = 768 * 1024;
static_assert(RT_ROWGATE + (size_t)MAX_SLOTS * 4 <= 1088 * 1024, "route");
constexpr int CW_TMO = 0, CW_CODE = 1;
constexpr int CW_BAR = 4096;
constexpr int CW_CNT = 16384;
constexpr int CW_CUR = 16384 + 2048;

constexpr int RING_OFF = 0, RING_BYTES = 131072;
constexpr int LDSCTL_OFF = 143360, MISC_OFF = LDSCTL_OFF + 320;
constexpr int MOETAB_OFF = MISC_OFF + 128;
constexpr int HIST_OFF = MOETAB_OFF + 1536;
constexpr int LDS_BYTES = 147456;
static_assert(HIST_OFF + 4 * 320 <= LDS_BYTES, "LDS map");
#define GAS __attribute__((address_space(1)))
#define LAS __attribute__((address_space(3)))
typedef unsigned short bf16;
typedef unsigned v4u __attribute__((ext_vector_type(4)));
typedef float f32x4 __attribute__((ext_vector_type(4)));
typedef short bf16x8 __attribute__((ext_vector_type(8)));
typedef GAS unsigned gu32;
typedef GAS unsigned long long gu64;
#define RLX_AGENT __ATOMIC_RELAXED, __HIP_MEMORY_SCOPE_AGENT
#define LDS_WAIT() asm volatile("s_waitcnt lgkmcnt(0)" ::: "memory")
#define VM_WAIT() asm volatile("s_waitcnt vmcnt(0)" ::: "memory")
__device__ __forceinline__ unsigned long long rt() { return __builtin_amdgcn_s_memrealtime(); }
typedef float f32x2_cv __attribute__((ext_vector_type(2))); typedef __bf16 bf16x2_cv __attribute__((ext_vector_type(2)));
__device__ __forceinline__ unsigned pk2(float lo, float hi) { f32x2_cv v = {lo, hi}; bf16x2_cv b = __builtin_convertvector(v, bf16x2_cv); return __builtin_bit_cast(unsigned, b); }
__device__ __forceinline__ unsigned f2bf(float f) { return pk2(f, f) & 0xffffu; }
#define XB_TMO      128
#define XB_XCNT(j)  (256  + 64 * (j))
#define XB_XSUB(j)  (1280 + 64 * (j))
#define XB_XGEN(j)  (2304 + 64 * (j))
#define XB_TOP      3328
#define XB_TOPGEN   3392
#define XCD_BAR_WORDS 3456
#define XB_SPIN_CAP (1u << 18)

__device__ __forceinline__ unsigned xb_ld(unsigned* p)              { return __hip_atomic_load(p, __ATOMIC_RELAXED, __HIP_MEMORY_SCOPE_AGENT); }
__device__ __forceinline__ unsigned xb_add(unsigned* p, unsigned v) { return __hip_atomic_fetch_add(p, v, __ATOMIC_RELAXED, __HIP_MEMORY_SCOPE_AGENT); }
__device__ __forceinline__ unsigned xb_xcc_id() { return (unsigned)__builtin_amdgcn_s_getreg((3 << 11) | 20) & 0xFu; }
#define XB_SPIN(cond, bar) do { unsigned _sp = 0; while (cond) { __builtin_amdgcn_s_sleep(1); \
    if ((++_sp & 255u) == 0u) { if (xb_ld(&(bar)[XB_TMO])) break; if (_sp > XB_SPIN_CAP) { atomicAdd(&(bar)[XB_TMO], 1u); break; } } } } while (0)

struct XcdBarrier {
    unsigned* bar; unsigned x;
    volatile LAS unsigned* st;
};

__device__ __forceinline__ XcdBarrier xcd_barrier_post(unsigned* bar, volatile LAS unsigned* st) {
    XcdBarrier b; b.bar = bar; b.x = xb_xcc_id(); b.st = st;
    if (threadIdx.x == 0) (void)xb_add(&bar[XB_XCNT(b.x)], 1u);
    return b;
}
__device__ __forceinline__ void xcd_barrier_complete(unsigned* bar, unsigned x, unsigned& nloc, unsigned& nx) {
    const unsigned G = gridDim.x * gridDim.y * gridDim.z;
    unsigned sum, cnt, mine, sp = 0u;
    for (;;) {
        sum = 0u; cnt = 0u; mine = 0u;
#pragma unroll
        for (unsigned j = 0; j < 16; ++j) { const unsigned c = xb_ld(&bar[XB_XCNT(j)]); sum += c; cnt += (c > 0u) ? 1u : 0u; mine = (j == x) ? c : mine; }
        if (sum == G) break;
        __builtin_amdgcn_s_sleep(1);
        if ((++sp & 255u) == 0u) { if (xb_ld(&bar[XB_TMO])) break; if (sp > XB_SPIN_CAP) { atomicAdd(&bar[XB_TMO], 1u); break; } }
    }
    nloc = mine > 0u ? mine : 1u; nx = cnt > 0u ? cnt : 1u;
}

__device__ __forceinline__ void xcd_barrier(const XcdBarrier& b) {
    asm volatile("s_waitcnt vmcnt(0)" ::: "memory");
    __syncthreads();
    if (threadIdx.x == 0) {
        unsigned* bar = b.bar;
        __builtin_amdgcn_s_waitcnt(0);
        unsigned nloc = b.st[0], nx = b.st[1];
        if (nloc == 0u) { xcd_barrier_complete(bar, b.x, nloc, nx); b.st[0] = nloc; b.st[1] = nx; }
        const unsigned old = xb_add(&bar[XB_XSUB(b.x)], 1u);
        const unsigned gen = old / nloc;
        if (old + 1u == (gen + 1u) * nloc) {
            __builtin_amdgcn_fence(__ATOMIC_RELEASE, "agent");
            asm volatile("s_waitcnt vmcnt(0)" ::: "memory");
            const unsigned og = xb_add(&bar[XB_TOP], 1u);
            const unsigned tg = og / nx;
            if (og + 1u == (tg + 1u) * nx) xb_add(&bar[XB_TOPGEN], 1u);
            else XB_SPIN(xb_ld(&bar[XB_TOPGEN]) == tg, bar);
            __builtin_amdgcn_fence(__ATOMIC_ACQUIRE, "agent");
            xb_add(&bar[XB_XGEN(b.x)], 1u);
            asm volatile("s_waitcnt vmcnt(0)" ::: "memory");
        } else {
            XB_SPIN(xb_ld(&bar[XB_XGEN(b.x)]) == gen, bar);
            __builtin_amdgcn_fence(__ATOMIC_ACQUIRE, "agent");
            asm volatile("s_waitcnt vmcnt(0)" ::: "memory");
        }
    }
    __syncthreads();
}

typedef float f32x2 __attribute__((ext_vector_type(2)));
struct Args { const float* in[32]; float* out; unsigned char* ws; int ph_lo, ph_hi, use_bar, pad; };
struct Frame {
    LAS unsigned char* lds;
    volatile LAS unsigned* MISC;
    gu32* ctl;
    int tid, lane, wave;
    int vcu, G;
    float* out;
    unsigned char* ws;
};
enum { I_X = 0, I_MEM, I_POS, I_NORM_MIX, I_W_IN, I_B_GATE, I_AQ_GAIN, I_AK_GAIN, I_R_MU, I_R_W0, I_R_W2, I_R_A0, I_R_A2, I_R_G2, I_R_KK, I_R_KA, I_R_RK, I_R_LNW, I_R_LNB,
       I_MEM_NORM, I_W_MEMKV, I_CQ_GAIN, I_CK_GAIN, I_W_BRANCH, I_W_OUT, I_NORM_FFN, I_ROUTER_W, I_ROUTER_B, I_EXP_W1, I_EXP_B1, I_EXP_W2, I_EXP_B2 };

__device__ __forceinline__ bool phase_enter(Frame& F, bool on) { int t = (int)threadIdx.x; asm volatile("" : "+v"(t)); F.tid = t; F.lane = t & 63; F.wave = __builtin_amdgcn_readfirstlane(t >> 6); return on; }
__device__ __forceinline__ const float* ldarg(int i) {
    const __attribute__((address_space(4))) char* ka = (const __attribute__((address_space(4))) char*)__builtin_amdgcn_kernarg_segment_ptr();
    asm volatile("" : "+s"(ka));
    return *(const float* const __attribute__((address_space(4)))*)(ka + 8 * i);
}
__device__ __forceinline__ unsigned pk4_fp8(float a, float b, float c, float d) { unsigned w = 0; w = __builtin_amdgcn_cvt_pk_fp8_f32(a, b, w, false); w = __builtin_amdgcn_cvt_pk_fp8_f32(c, d, w, true); return w; }
__device__ __forceinline__ float fast_sigm(float x) { return __builtin_amdgcn_rcpf(1.0f + __builtin_amdgcn_exp2f(-1.4426950408889634f * x)); }
__device__ __forceinline__ float fast_tanh(float x) { return 1.0f - 2.0f * __builtin_amdgcn_rcpf(1.0f + __builtin_amdgcn_exp2f(2.8853900817779268f * x)); }
__device__ __forceinline__ float fast_softplus(float y) { return fmaxf(y, 0.f) + 0.6931471805599453f * __builtin_amdgcn_logf(1.0f + __builtin_amdgcn_exp2f(-1.4426950408889634f * fabsf(y))); }
__device__ __forceinline__ int opq(int x) { asm volatile("" : "+v"(x)); return x; }
__device__ __forceinline__ float bf_lo(unsigned w) { return __builtin_bit_cast(float, w << 16); }
__device__ __forceinline__ float bf_hi(unsigned w) { return __builtin_bit_cast(float, w & 0xffff0000u); }
__device__ __forceinline__ float sigm(float x) { return 1.0f / (1.0f + __expf(-x)); }
template <int CTRL, int RM> __device__ __forceinline__ float dpp0(float v) {
    return __builtin_bit_cast(float, __builtin_amdgcn_update_dpp(0, __builtin_bit_cast(int, v), CTRL, RM, 0xf, true)); }
__device__ __forceinline__ float row16_sum(float v) {
    v += dpp0<0xB1, 0xf>(v); v += dpp0<0x4E, 0xf>(v); v += dpp0<0x141, 0xf>(v); v += dpp0<0x140, 0xf>(v); return v; }
__device__ __forceinline__ float rdlane(float v, int l) { return __builtin_bit_cast(float, __builtin_amdgcn_readlane(__builtin_bit_cast(int, v), l)); }
__device__ __forceinline__ float wave_sum(float v) {
    v = row16_sum(v); v += dpp0<0x142, 0xA>(v); v += dpp0<0x143, 0xC>(v); return rdlane(v, 63); }
__device__ __forceinline__ void half_sums(float v, float& lo, float& hi) {
    v = row16_sum(v); v += dpp0<0x142, 0xA>(v); lo = rdlane(v, 31); hi = rdlane(v, 63); }
__device__ __forceinline__ float wave_max_bp(float v) {
#pragma unroll
    for (int o = 1; o < 64; o <<= 1) v = fmaxf(v, __shfl_xor(v, o));
    return v; }

__device__ __forceinline__ void tconv_tile(const float* W, int K, int N, bf16* WT, int k0, int n0, int rowbase, int lane, int kd = 0) {
    const int c = lane & 15, q = lane >> 4;
    const GAS f32x4* src = (const GAS f32x4*)(W + (size_t)(k0 + 16 * q) * N + n0 + 4 * c);
    const size_t rs = (size_t)N / 4;
    f32x4 v[16];
#pragma unroll
    for (int i = 0; i < 16; ++i) v[i] = src[i * rs];
#pragma unroll
    for (int j = 0; j < 4; ++j) {
        GAS v4u* dst = (GAS v4u*)(WT + (size_t)(rowbase + 4 * c + j) * K + kd + k0 + 16 * q);
        v4u o0, o1;
        o0.x = pk2(v[0][j], v[1][j]); o0.y = pk2(v[2][j], v[3][j]); o0.z = pk2(v[4][j], v[5][j]); o0.w = pk2(v[6][j], v[7][j]);
        o1.x = pk2(v[8][j], v[9][j]); o1.y = pk2(v[10][j], v[11][j]); o1.z = pk2(v[12][j], v[13][j]); o1.w = pk2(v[14][j], v[15][j]);
        dst[0] = o0; dst[1] = o1;
    }
}
__device__ __forceinline__ void tconv_tile128(const float* W, int K, int N, bf16* WT, int k0, int n0, int rowbase, int lane) {
    const int c = lane & 31, q = lane >> 5;
    const GAS f32x4* src = (const GAS f32x4*)(W + (size_t)(k0 + 32 * q) * N + n0 + 4 * c);
    const size_t rs = (size_t)N / 4;
    f32x4 v[32];
#pragma unroll
    for (int i = 0; i < 32; ++i) v[i] = src[i * rs];
#pragma unroll
    for (int j = 0; j < 4; ++j) {
        GAS v4u* dst = (GAS v4u*)(WT + (size_t)(rowbase + 4 * c + j) * K + k0 + 32 * q);
#pragma unroll
        for (int g = 0; g < 4; ++g) { v4u o; o.x = pk2(v[8 * g][j], v[8 * g + 1][j]); o.y = pk2(v[8 * g + 2][j], v[8 * g + 3][j]); o.z = pk2(v[8 * g + 4][j], v[8 * g + 5][j]); o.w = pk2(v[8 * g + 6][j], v[8 * g + 7][j]); dst[g] = o; }
    }
}
__device__ __forceinline__ void tconv_tile_f8(const float* W, int K, int N, unsigned char* WT, int k0, int n0, int rowbase, int lane, float sc) {
    const int c = lane & 15, q = lane >> 4;
    const GAS f32x4* src = (const GAS f32x4*)(W + (size_t)(k0 + 16 * q) * N + n0 + 4 * c);
    const size_t rs = (size_t)N / 4;
    f32x4 v[16];
#pragma unroll
    for (int i = 0; i < 16; ++i) v[i] = src[i * rs] * sc;
#pragma unroll
    for (int j = 0; j < 4; ++j) {
        v4u o; o.x = pk4_fp8(v[0][j], v[1][j], v[2][j], v[3][j]); o.y = pk4_fp8(v[4][j], v[5][j], v[6][j], v[7][j]); o.z = pk4_fp8(v[8][j], v[9][j], v[10][j], v[11][j]); o.w = pk4_fp8(v[12][j], v[13][j], v[14][j], v[15][j]);
        *(GAS v4u*)(WT + (size_t)(rowbase + 4 * c + j) * K + k0 + 16 * q) = o;
    }
}
__device__ __forceinline__ void tc8_load(const float* W, int N, int k0, int n0, int lane, f32x4 (&v)[16]) {
    const int c = lane & 15, q = lane >> 4; const GAS f32x4* src = (const GAS f32x4*)(W + (size_t)(k0 + 16 * q) * N + n0 + 4 * c); const size_t rs = (size_t)N / 4;
#pragma unroll
    for (int i = 0; i < 16; ++i) v[i] = src[i * rs];
}
__device__ __forceinline__ void tc8_store(unsigned char* WT, int K, int k0, int rowbase, int lane, const f32x4 (&v)[16], float sc) {
    const int c = lane & 15, q = lane >> 4;
#pragma unroll
    for (int j = 0; j < 4; ++j) {
        v4u o; o.x = pk4_fp8(v[0][j] * sc, v[1][j] * sc, v[2][j] * sc, v[3][j] * sc); o.y = pk4_fp8(v[4][j] * sc, v[5][j] * sc, v[6][j] * sc, v[7][j] * sc);
        o.z = pk4_fp8(v[8][j] * sc, v[9][j] * sc, v[10][j] * sc, v[11][j] * sc); o.w = pk4_fp8(v[12][j] * sc, v[13][j] * sc, v[14][j] * sc, v[15][j] * sc);
        *(GAS v4u*)(WT + (size_t)(rowbase + 4 * c + j) * K + k0 + 16 * q) = o; }
}
__device__ __forceinline__ void w1_tile(int r, const float* W1, unsigned char* W1T, const float*& W, unsigned char*& WT, int& k0, int& n0, int& rowbase) {
    const int e = r / 512, q = r % 512, kb = q % 16, nb = q / 16; n0 = 64 * nb; k0 = 64 * kb;
    rowbase = (n0 < 1024) ? ((n0 >> 7) * 256 + (n0 & 127)) : ((((n0 - 1024) >> 7) * 256) + 128 + ((n0 - 1024) & 127));
    W = W1 + (size_t)e * 1024 * 2048; WT = W1T + (size_t)e * 2048 * 1024;
}
__device__ __forceinline__ void rms_row_to_bf16(const float* xrow, const float* gain, bf16* orow, int lane, unsigned char* orow8 = nullptr) {
    const GAS f32x4* xr = (const GAS f32x4*)xrow + lane; const GAS f32x4* gr = (const GAS f32x4*)gain + lane;
    f32x4 v[4]; float s = 0.f;
#pragma unroll
    for (int j = 0; j < 4; ++j) { v[j] = xr[64 * j]; s += (v[j].x * v[j].x + v[j].y * v[j].y) + (v[j].z * v[j].z + v[j].w * v[j].w); }
    const float rstd = 1.0f / sqrtf(wave_sum(s) * (1.f / D_MODEL) + NORM_EPS);
    GAS unsigned long long* o8 = (GAS unsigned long long*)orow + lane;
#pragma unroll
    for (int j = 0; j < 4; ++j) { const f32x4 g = gr[64 * j];
        o8[64 * j] = (unsigned long long)pk2(v[j].x * rstd * g.x, v[j].y * rstd * g.y) | ((unsigned long long)pk2(v[j].z * rstd * g.z, v[j].w * rstd * g.w) << 32);
        if (orow8) ((GAS unsigned*)orow8 + lane)[64 * j] = pk4_fp8(v[j].x * rstd * g.x, v[j].y * rstd * g.y, v[j].z * rstd * g.z, v[j].w * rstd * g.w); }
}
template <int PART> __device__ __forceinline__ void p0_prologue(Frame& F, const Args& args, int gw, int NGW) {
    const int lane = F.lane;
    unsigned char* ws = F.ws;
    constexpr int T_IN = 16 * 156, T_WB = 3 * 128, T_WO = 256, T_WM = 256, T_W1 = 32 * 512, T_W2 = 32 * 256, T_LO = 32;
    constexpr int NT = T_IN + T_WB + T_WO + T_WM + T_W1 + T_W2;
    constexpr int IT0 = (PART == 0) ? 0 : (PART == 1) ? T_IN + T_WB + T_WO + T_WM + T_W1 : T_IN + T_WB + T_WO + T_WM, IT1 = (PART == 0) ? T_IN + T_WB + T_WO + T_WM : (PART == 1) ? NT : T_IN + T_WB + T_WO + T_WM + T_W1;
    for (int it = IT0 + gw; it < IT1; it += NGW) {
        int r = it;
        if (r < T_IN) { const int kb = r / 156, nb = r % 156, nt = nb >> 2;
            if (nt < 12 || nt >= 27) tconv_tile_f8(ldarg(I_W_IN), 1024, IN_COLS, ws + WS_WIN8, 64 * kb, 64 * nb, 64 * nb, lane, W8_SCALE);
            else tconv_tile(ldarg(I_W_IN), 1024, IN_COLS, (bf16*)(ws + WS_WIN), 64 * kb, 64 * nb, 64 * nb, lane);
            continue; } r -= T_IN;
        if (r < T_WB) { const int b = r / 128, q = r % 128, kb = q / 16, nb = q % 16;
            tconv_tile(ldarg(I_W_BRANCH) + (size_t)b * 512 * 1024, 1536, 1024, (bf16*)(ws + WS_WB), 64 * kb, 64 * nb, 64 * nb, lane, 512 * b); continue; } r -= T_WB;
        if (r < T_WO) { const int kb = r / 16, nb = r % 16; tconv_tile(ldarg(I_W_OUT), 1024, 1024, (bf16*)(ws + WS_WO), 64 * kb, 64 * nb, 64 * nb, lane); continue; } r -= T_WO;
        if (r < T_WM) { const int kb = r / 16, nb = r % 16; tconv_tile(ldarg(I_W_MEMKV), 1024, 1024, (bf16*)(ws + WS_WMEM), 64 * kb, 64 * nb, 64 * nb, lane); continue; } r -= T_WM;
        if (r < T_W1) { const int e = r / 512, q = r % 512, kb = q % 16, nb = q / 16, n0 = 64 * nb;
            const int rowbase = (n0 < 1024) ? ((n0 >> 7) * 256 + (n0 & 127)) : ((((n0 - 1024) >> 7) * 256) + 128 + ((n0 - 1024) & 127));
            tconv_tile_f8(ldarg(I_EXP_W1) + (size_t)e * 1024 * 2048, 1024, 2048, ws + WS_W1 + (size_t)e * 2048 * 1024, 64 * kb, n0, rowbase, lane, W8_SCALE); continue; } r -= T_W1;
        { const int e = r / 256, q = r % 256, kb = q % 16, nb = q / 16;
            tconv_tile_f8(ldarg(I_EXP_W2) + (size_t)e * 1024 * 1024, 1024, 1024, ws + WS_W2 + (size_t)e * 1024 * 1024, 64 * kb, 64 * nb, 64 * nb, lane, W8_SCALE); }
    }
    if (PART == 0) {
    for (int it = gw; it < T_LO; it += NGW) {
        bf16* L = (bf16*)(ws + WS_LORA);
        if (it < 8) tconv_tile(ldarg(I_R_W2), 64, 512, L, 0, 64 * it, 64 * it, lane);
        else if (it < 16) tconv_tile(ldarg(I_R_A2), 64, 512, L + 512 * 64, 0, 64 * (it - 8), 64 * (it - 8), lane);
        else { const int q = it - 16; tconv_tile(ldarg(I_R_G2), 128, 512, L + 2 * 512 * 64, 64 * (q >> 3), 64 * (q & 7), 64 * (q & 7), lane); } }
    { const int* posp = (const int*)ldarg(I_POS); float* cs = (float*)(ws + WS_CS);
      for (int idx = gw * 64 + lane; idx < MTOK * 16; idx += NGW * 64) { const int m = idx >> 4, i = idx & 15; const float ang = (float)posp[m] * exp2f(-(float)i * (18.931568569324174f / 16.0f)); const float sn = sinf(ang), cn = cosf(ang);
          f32x2 o; o.x = cn; o.y = sn; *(GAS f32x2*)(cs + (size_t)idx * 2) = o; } }
    for (int m = gw; m < MTOK; m += NGW) rms_row_to_bf16(ldarg(I_X) + (size_t)m * D_MODEL, ldarg(I_NORM_MIX), (bf16*)(ws + WS_XN) + (size_t)m * D_MODEL, lane, ws + WS_XN8 + (size_t)m * D_MODEL);
    for (int m = gw; m < MEMROWS; m += NGW) rms_row_to_bf16(ldarg(I_MEM) + (size_t)m * D_MODEL, ldarg(I_MEM_NORM), (bf16*)(ws + WS_MEMN) + (size_t)m * D_MODEL, lane);
    }
}

__device__ __forceinline__ void head_norm(bf16* p, const float* gain, bool rot, float c0, float s0, float c1, float s1, float scale, int lane) {
    GAS unsigned* pw = (GAS unsigned*)p + lane;
    const unsigned w = *pw; float a = bf_lo(w), b = bf_hi(w);
    const float ss = wave_sum(a * a + b * b);
    const float rstd = 1.0f / sqrtf(ss * (1.f / 128.f) + NORM_EPS);
    const f32x2 g = *((const GAS f32x2*)gain + lane);
    a = a * rstd * g.x; b = b * rstd * g.y;
    const float pa = __shfl_xor(a, 8), pb = __shfl_xor(b, 8);
    if (rot && lane < 16) {
        if (lane < 8) { a = a * c0 - pa * s0; b = b * c1 - pb * s1; }
        else          { a = a * c0 + pa * s0; b = b * c1 + pb * s1; }
    }
    *pw = pk2(a * scale, b * scale);
}
__device__ __forceinline__ void p2_prep(Frame& F, const Args& args) {
    const int gw = F.vcu * NWAVES + F.wave, NGW = F.G * NWAVES, lane = F.lane;
    unsigned char* ws = F.ws;
    bf16* Z = (bf16*)(ws + WS_Z);
    LAS float* lo = (LAS float*)(F.lds + RING_OFF + F.wave * 8192);
    const float* mu = ldarg(I_R_MU); const float* aqg = ldarg(I_AQ_GAIN); const float* akg = ldarg(I_AK_GAIN); const float* cqg = ldarg(I_CQ_GAIN); const int* posp = (const int*)ldarg(I_POS);
    float* Rr = (float*)(ws + WS_RW); float* Rw = Rr + (size_t)MTOK * RW; float* Rk = Rw + (size_t)MTOK * RW; float* Rv = Rk + (size_t)MTOK * RW;
    float* Ra = Rv + (size_t)MTOK * RW; float* Rb = Ra + (size_t)MTOK * RW; float* Rg = Rb + (size_t)MTOK * RW;
    for (int m = gw; m < MEMROWS; m += NGW)
        for (int hd = 0; hd < 4; ++hd) head_norm((bf16*)(ws + WS_KVM) + (size_t)m * 1024 + hd * 128, ldarg(I_CK_GAIN), false, 1.f, 0.f, 1.f, 0.f, 1.0f, lane);
}

__device__ __forceinline__ void lora_stage(const float* W, LAS unsigned* wl, int tid) {
#pragma unroll
    for (int i = 0; i < 16; ++i) { const int idx = tid + 512 * i; const f32x4 v = *((const GAS f32x4*)W + idx);
        *(LAS unsigned long long*)(wl + 2 * idx) = (unsigned long long)pk2(v.x, v.y) | ((unsigned long long)pk2(v.z, v.w) << 32); }
}
__device__ __forceinline__ void lora_mac(const LAS unsigned* wl, const LAS float* lo, float (&acc)[4][8], int lane) {
#pragma unroll 4
    for (int j = 0; j < 64; ++j) { const f32x4 xin = *(const LAS f32x4*)(lo + j * 4);
#pragma unroll
        for (int i = 0; i < 4; ++i) { const unsigned w = wl[j * 256 + lane + 64 * i]; const float w0 = bf_lo(w), w1 = bf_hi(w);
#pragma unroll
            for (int tt = 0; tt < 4; ++tt) { acc[tt][2 * i] += xin[tt] * w0; acc[tt][2 * i + 1] += xin[tt] * w1; } } }
}
template <int NL> __device__ __forceinline__ void lora_in(const bf16* Z, const float* mu, int ch, int m0, LAS float* lo, int lane) {
    const int col = OFF_R + 1536 + ch; const float muj = mu[1536 + ch];
    float prv = ((m0 % SEQ) == 0) ? 0.f : __builtin_bit_cast(float, (unsigned)Z[(size_t)(m0 - 1) * IN_COLS + col] << 16);
#pragma unroll
    for (int tt = 0; tt < 4; ++tt) { const float cur = __builtin_bit_cast(float, (unsigned)Z[(size_t)(m0 + tt) * IN_COLS + col] << 16);
        float x = cur + (prv - cur) * muj; prv = cur;
        x = (NL == 0) ? tanhf(x) : (NL == 1) ? x : sigm(x);
        lo[lane * 4 + tt] = x; }
    LDS_WAIT(); asm volatile("" ::: "memory");
}
__device__ __forceinline__ void p2_rwkv(Frame& F, const Args& args) {
    const int lane = F.lane, wave = F.wave;
    unsigned char* ws = F.ws;
    const bf16* Z = (const bf16*)(ws + WS_Z);
    LAS unsigned* wl = (LAS unsigned*)(F.lds + RING_OFF);
    LAS float* lo = (LAS float*)(F.lds + RING_OFF + 65536 + wave * 1024);
    const float* mu = ldarg(I_R_MU);
    float* Rr = (float*)(ws + WS_RW); float* Rw = Rr + (size_t)MTOK * RW; float* Rk = Rw + (size_t)MTOK * RW; float* Rv = Rk + (size_t)MTOK * RW;
    float* Ra = Rv + (size_t)MTOK * RW; float* Rb = Ra + (size_t)MTOK * RW; float* Rg = Rb + (size_t)MTOK * RW;
    for (int grp = F.vcu; grp < MTOK / 64; grp += F.G) {
        const int mw = grp * 64 + wave * 8;
        lora_stage(ldarg(I_R_W2), wl, F.tid);
        __syncthreads();
        for (int tk = 0; tk < 2; ++tk) { const int m0 = mw + 4 * tk;
            lora_in<0>(Z, mu, lane, m0, lo, lane);
            float acc[4][8];
#pragma unroll
            for (int tt = 0; tt < 4; ++tt)
#pragma unroll
                for (int c = 0; c < 8; ++c) acc[tt][c] = 0.f;
            lora_mac(wl, lo, acc, lane);
            const float* w0p = ldarg(I_R_W0);
#pragma unroll
            for (int i = 0; i < 4; ++i) { const int c = 2 * lane + 128 * i; const f32x2 w0 = *(const GAS f32x2*)(w0p + c);
#pragma unroll
                for (int tt = 0; tt < 4; ++tt) { const float y0 = -(w0.x + acc[tt][2 * i]), y1 = -(w0.y + acc[tt][2 * i + 1]);
                    const float sp0 = fmaxf(y0, 0.f) + log1pf(__expf(-fabsf(y0))), sp1 = fmaxf(y1, 0.f) + log1pf(__expf(-fabsf(y1)));
                    f32x2 wd; wd.x = -__expf(-sp0 - 0.5f); wd.y = -__expf(-sp1 - 0.5f);
                    *(GAS f32x2*)(Rw + (size_t)(m0 + tt) * RW + c) = wd; } }
            LDS_WAIT(); asm volatile("" ::: "memory"); }
        __syncthreads();
        lora_stage(ldarg(I_R_A2), wl, F.tid);
        __syncthreads();
        for (int tk = 0; tk < 2; ++tk) { const int m0 = mw + 4 * tk; const int tpos0 = m0 % SEQ;
            lora_in<1>(Z, mu, 64 + lane, m0, lo, lane);
            float acca[4][8];
#pragma unroll
            for (int tt = 0; tt < 4; ++tt)
#pragma unroll
                for (int c = 0; c < 8; ++c) acca[tt][c] = 0.f;
            lora_mac(wl, lo, acca, lane);
            const float* a0p = ldarg(I_R_A0); const float* kkp = ldarg(I_R_KK); const float* kap = ldarg(I_R_KA);
#pragma unroll
            for (int i = 0; i < 4; ++i) {
                const int c = 2 * lane + 128 * i;
                const f32x2 a0 = *(const GAS f32x2*)(a0p + c), kkc = *(const GAS f32x2*)(kkp + c), kac = *(const GAS f32x2*)(kap + c);
                const f32x2 mur = *(const GAS f32x2*)(mu + c), muk = *(const GAS f32x2*)(mu + 512 + c), muv = *(const GAS f32x2*)(mu + 1024 + c);
                unsigned pr = 0u, pk = 0u, pv = 0u;
                if (tpos0 != 0) { const bf16* zp = Z + (size_t)(m0 - 1) * IN_COLS + OFF_R + c; pr = *(const GAS unsigned*)zp; pk = *(const GAS unsigned*)(zp + 512); pv = *(const GAS unsigned*)(zp + 1024); }
#pragma unroll
                for (int tt = 0; tt < 4; ++tt) {
                    const size_t m = (size_t)(m0 + tt);
                    const bf16* zc = Z + m * IN_COLS + OFF_R + c;
                    const unsigned cr = *(const GAS unsigned*)zc, ck = *(const GAS unsigned*)(zc + 512), cv = *(const GAS unsigned*)(zc + 1024);
                    f32x2 r, k, v;
                    r.x = bf_lo(cr) + (bf_lo(pr) - bf_lo(cr)) * mur.x; r.y = bf_hi(cr) + (bf_hi(pr) - bf_hi(cr)) * mur.y;
                    k.x = bf_lo(ck) + (bf_lo(pk) - bf_lo(ck)) * muk.x; k.y = bf_hi(ck) + (bf_hi(pk) - bf_hi(ck)) * muk.y;
                    v.x = bf_lo(cv) + (bf_lo(pv) - bf_lo(cv)) * muv.x; v.y = bf_hi(cv) + (bf_hi(pv) - bf_hi(cv)) * muv.y;
                    pr = cr; pk = ck; pv = cv;
                    f32x2 av; av.x = sigm(a0.x + acca[tt][2 * i]); av.y = sigm(a0.y + acca[tt][2 * i + 1]);
                    f32x2 kk; kk.x = k.x * kkc.x; kk.y = k.y * kkc.y;
                    float slo, shi; half_sums(kk.x * kk.x + kk.y * kk.y, slo, shi);
                    const float nrm = fmaxf(sqrtf(lane < 32 ? slo : shi), 1e-12f), inv = 1.0f / nrm;
                    kk.x *= inv; kk.y *= inv;
                    f32x2 k2; k2.x = k.x * (1.0f + (av.x - 1.0f) * kac.x); k2.y = k.y * (1.0f + (av.y - 1.0f) * kac.y);
                    f32x2 as, bs; as.x = -kk.x; as.y = -kk.y; bs.x = kk.x * av.x; bs.y = kk.y * av.y;
                    const size_t o = m * RW + c;
                    *(GAS f32x2*)(Rr + o) = r; *(GAS f32x2*)(Rk + o) = k2; *(GAS f32x2*)(Rv + o) = v; *(GAS f32x2*)(Ra + o) = as; *(GAS f32x2*)(Rb + o) = bs;
                }
            }
            LDS_WAIT(); asm volatile("" ::: "memory"); }
        __syncthreads();
        float accg[2][4][8];
#pragma unroll
        for (int tk = 0; tk < 2; ++tk)
#pragma unroll
            for (int tt = 0; tt < 4; ++tt)
#pragma unroll
                for (int c = 0; c < 8; ++c) accg[tk][tt][c] = 0.f;
#pragma unroll
        for (int hh = 0; hh < 2; ++hh) {
            lora_stage(ldarg(I_R_G2) + (size_t)hh * 64 * RW, wl, F.tid);
            __syncthreads();
#pragma unroll
            for (int tk = 0; tk < 2; ++tk) { lora_in<2>(Z, mu, 128 + 64 * hh + lane, mw + 4 * tk, lo, lane); lora_mac(wl, lo, accg[tk], lane); LDS_WAIT(); asm volatile("" ::: "memory"); }
            __syncthreads();
        }
#pragma unroll
        for (int tk = 0; tk < 2; ++tk)
#pragma unroll
            for (int i = 0; i < 4; ++i)
#pragma unroll
                for (int tt = 0; tt < 4; ++tt) { f32x2 gg; gg.x = accg[tk][tt][2 * i]; gg.y = accg[tk][tt][2 * i + 1]; *(GAS f32x2*)(Rg + (size_t)(mw + 4 * tk + tt) * RW + 2 * lane + 128 * i) = gg; }
    }
}

__device__ __forceinline__ float qk_dot(const LAS float* q, const bf16* krow) {
    const GAS v4u* kp = (const GAS v4u*)krow; float s0 = 0.f, s1 = 0.f;
#pragma unroll
    for (int i = 0; i < 16; ++i) { const v4u w = kp[i]; const f32x4 qa = *(const LAS f32x4*)(q + 8 * i), qb = *(const LAS f32x4*)(q + 8 * i + 4);
        s0 += bf_lo(w.x) * qa[0] + bf_hi(w.x) * qa[1] + bf_lo(w.y) * qa[2] + bf_hi(w.y) * qa[3];
        s1 += bf_lo(w.z) * qb[0] + bf_hi(w.z) * qb[1] + bf_lo(w.w) * qb[2] + bf_hi(w.w) * qb[3]; }
    return s0 + s1;
}
__device__ __forceinline__ void p3_attention(Frame& F) {
    const int gw = F.vcu * NWAVES + F.wave, NGW = F.G * NWAVES, lane = F.lane;
    unsigned char* ws = F.ws;
    const bf16* Z = (const bf16*)(ws + WS_Z);
    const bf16* KV = (const bf16*)(ws + WS_KVM);
    bf16* YA = (bf16*)(ws + WS_YABC); bf16* YC = YA + (size_t)2 * MTOK * 512;
    LAS float* qs = (LAS float*)(F.lds + RING_OFF + F.wave * 8192);
    for (int task = gw; task < MTOK * 4; task += NGW) {
        const int m = task >> 2, h = task & 3, t = m % SEQ;
        const bf16* zrow = Z + (size_t)m * IN_COLS;
#pragma unroll
        for (int g = 0; g < 3; ++g) { const unsigned w = *((const GAS unsigned*)(zrow + OFF_AQ + g * 512 + h * 128) + lane); qs[g * 128 + 2 * lane] = bf_lo(w); qs[g * 128 + 2 * lane + 1] = bf_hi(w); }
        LDS_WAIT(); asm volatile("" ::: "memory");
        float sc[3][3]; float mx = -INFINITY;
#pragma unroll
        for (int g = 0; g < 3; ++g) { const int dl = (g == 0) ? 1 : (g == 1) ? 4 : 16;
#pragma unroll
            for (int p = 0; p < 3; ++p) { const int j = lane + 64 * p; const int tk = t - dl * j; float s = -INFINITY;
                if (j <= 128 && tk >= 0) s = qk_dot(qs + g * 128, zrow - (size_t)dl * j * IN_COLS + OFF_AK + g * 512 + h * 128);
                sc[g][p] = s; mx = fmaxf(mx, s); } }
        mx = wave_max_bp(mx);
        float den = 0.f;
#pragma unroll
        for (int g = 0; g < 3; ++g)
#pragma unroll
            for (int p = 0; p < 3; ++p) { sc[g][p] = exp2f(sc[g][p] - mx); den += sc[g][p]; }
        den = wave_sum(den);
        float o0 = 0.f, o1 = 0.f;
#pragma unroll
        for (int g = 0; g < 3; ++g) { const int dl = (g == 0) ? 1 : (g == 1) ? 4 : 16; const bf16* vb = zrow + OFF_AV + g * 512 + h * 128 + 2 * lane;
#pragma unroll
            for (int p = 0; p < 3; ++p) { const int nj = (p < 2) ? 64 : 1;
                for (int jj = 0; jj < nj; ++jj) { const int j = jj + 64 * p; const float pj = rdlane(sc[g][p], jj);
                    if (t - dl * j >= 0) { const unsigned w = *(const GAS unsigned*)(vb - (size_t)dl * j * IN_COLS); o0 += pj * bf_lo(w); o1 += pj * bf_hi(w); } } } }
        const float inv = 1.0f / den;
        *((GAS unsigned*)(YA + (size_t)m * 512 + h * 128) + lane) = pk2(o0 * inv, o1 * inv);
        asm volatile("" ::: "memory");
    }
    for (int task = gw; task < MTOK * 4; task += NGW) {
        const int m = task >> 2, h = task & 3, b = m / SEQ;
        const bf16* zrow = Z + (size_t)m * IN_COLS;
        { const unsigned w = *((const GAS unsigned*)(zrow + OFF_CQ + h * 128) + lane); qs[2 * lane] = bf_lo(w); qs[2 * lane + 1] = bf_hi(w); }
        LDS_WAIT(); asm volatile("" ::: "memory");
        const bf16* kb = KV + (size_t)b * MEM_LEN * 1024 + h * 128;
        float sc[4]; float mx = -INFINITY;
#pragma unroll
        for (int p = 0; p < 4; ++p) { sc[p] = qk_dot(qs, kb + (size_t)(lane + 64 * p) * 1024); mx = fmaxf(mx, sc[p]); }
        mx = wave_max_bp(mx);
        float den = 0.f;
#pragma unroll
        for (int p = 0; p < 4; ++p) { sc[p] = exp2f(sc[p] - mx); den += sc[p]; }
        den = wave_sum(den);
        float o0 = 0.f, o1 = 0.f; const bf16* vb = kb + 512 + 2 * lane;
#pragma unroll
        for (int p = 0; p < 4; ++p)
            for (int jj = 0; jj < 64; ++jj) { const float pj = rdlane(sc[p], jj); const unsigned w = *(const GAS unsigned*)(vb + (size_t)(jj + 64 * p) * 1024); o0 += pj * bf_lo(w); o1 += pj * bf_hi(w); }
        const float inv = 1.0f / den;
        *((GAS unsigned*)(YC + (size_t)m * 512 + h * 128) + lane) = pk2(o0 * inv, o1 * inv);
        asm volatile("" ::: "memory");
    }
}

__device__ __forceinline__ void p5_post(Frame& F, const Args& args) {
    const int gw = F.vcu * NWAVES + F.wave, NGW = F.G * NWAVES, lane = F.lane;
    unsigned char* ws = F.ws;
    const float* Rr = (const float*)(ws + WS_RW); const float* Rk = Rr + (size_t)2 * MTOK * RW; const float* Rv = Rk + (size_t)MTOK * RW; const float* Rg = Rr + (size_t)6 * MTOK * RW;
    const float* YS = (const float*)(ws + WS_YS);
    bf16* YB = (bf16*)(ws + WS_YABC) + (size_t)MTOK * 512;
    const bf16* OP = (const bf16*)(ws + WS_OP); const float* LS = (const float*)(ws + WS_LSE); bf16* YA = (bf16*)(ws + WS_YABC);
    for (int m = gw; m < MTOK; m += NGW) {
        float l0[4], l1[4], l2[4]; unsigned pa[4], pb[4], pc[4];
#pragma unroll
        for (int h = 0; h < 4; ++h) { l0[h] = LS[(size_t)m * 4 + h]; l1[h] = LS[(size_t)MTOK * 4 + (size_t)m * 4 + h]; l2[h] = LS[(size_t)2 * MTOK * 4 + (size_t)m * 4 + h];
            const size_t o = (size_t)m * 512 + h * 128;
            pa[h] = *((const GAS unsigned*)(OP + o) + lane); pb[h] = *((const GAS unsigned*)(OP + (size_t)MTOK * 512 + o) + lane); pc[h] = *((const GAS unsigned*)(OP + (size_t)2 * MTOK * 512 + o) + lane); }
#pragma unroll
        for (int h = 0; h < 4; ++h) {
            const float mx = fmaxf(l0[h], fmaxf(l1[h], l2[h])); const float w0 = exp2f(l0[h] - mx), w1 = exp2f(l1[h] - mx), w2 = exp2f(l2[h] - mx); const float inv = __builtin_amdgcn_rcpf(w0 + w1 + w2);
            *((GAS unsigned*)(YA + (size_t)m * 1536 + h * 128) + lane) = pk2((w0 * bf_lo(pa[h]) + w1 * bf_lo(pb[h]) + w2 * bf_lo(pc[h])) * inv, (w0 * bf_hi(pa[h]) + w1 * bf_hi(pb[h]) + w2 * bf_hi(pc[h])) * inv); }
    }
}

__device__ __forceinline__ void p8_router(Frame& F, const Args& args) {
    const int lane = F.lane, wave = F.wave;
    unsigned char* ws = F.ws;
    const float* X1 = F.out;
    LAS int* hist = (LAS int*)(F.lds + HIST_OFF);
    { const int t_ = opq(F.tid); if (t_ < 32) hist[t_] = 0; }
    int* topi = (int*)(ws + WS_ROUTE + RT_TOPI); float* topg = (float*)(ws + WS_ROUTE + RT_TOPG);
    const float* RWt = ldarg(I_ROUTER_W); const float* RB = ldarg(I_ROUTER_B); const float* gain = ldarg(I_NORM_FFN);
    LAS float* rw = (LAS float*)(F.lds + RING_OFF);
    typedef float f32x16r __attribute__((ext_vector_type(16)));
    for (int grp = F.vcu; grp < MTOK / 64; grp += F.G) {
#pragma unroll
        for (int i = 0; i < 16; ++i) { const int f = F.tid + 512 * i, k = f >> 3; const f32x4 w = *((const GAS f32x4*)RWt + f); const float g = gain[k]; ((LAS f32x4*)rw)[f] = w * g; }
        __syncthreads();
        const int tile = wave >> 2, wq = wave & 3, i32 = lane & 31, h = lane >> 5;
        const GAS f32x4* xp = (const GAS f32x4*)(X1 + ((size_t)grp * 64 + tile * 32 + i32) * D_MODEL + wq * 256 + 4 * h);
        const LAS float* bp = rw + (wq * 256 + 4 * h) * 32 + i32;
        f32x16r acc;
#pragma unroll
        for (int r = 0; r < 16; ++r) acc[r] = 0.f;
        float ss = 0.f;
#pragma unroll 4
        for (int q = 0; q < 32; ++q) { const f32x4 xv = xp[2 * q]; ss += (xv.x * xv.x + xv.y * xv.y) + (xv.z * xv.z + xv.w * xv.w);
#pragma unroll
            for (int j = 0; j < 4; ++j) acc = __builtin_amdgcn_mfma_f32_32x32x2f32(xv[j], bp[(8 * q + j) * 32], acc, 0, 0, 0); }
        __syncthreads();
        { LAS float* part = rw + (tile * 4 + wq) * 1024;
#pragma unroll
          for (int r = 0; r < 16; ++r) part[((r & 3) + 8 * (r >> 2) + 4 * h) * 32 + i32] = acc[r];
          rw[8192 + (tile * 4 + wq) * 64 + lane] = ss; }
        __syncthreads();
        if (F.tid < 64) { const int t = F.tid, tl = t >> 5, row = t & 31; const size_t m = (size_t)grp * 64 + t;
            float s = 0.f;
#pragma unroll
            for (int q = 0; q < 4; ++q) s += rw[8192 + (tl * 4 + q) * 64 + row] + rw[8192 + (tl * 4 + q) * 64 + 32 + row];
            const float rstd = 1.0f / sqrtf(s * (1.f / D_MODEL) + NORM_EPS);
            float lg[32];
#pragma unroll
            for (int e = 0; e < 32; ++e) { const LAS float* pp = rw + (tl * 4) * 1024 + row * 32 + e; lg[e] = ((pp[0] + pp[1024]) + (pp[2048] + pp[3072])) * rstd + RB[e]; }
            int ti[4]; float tv[4];
#pragma unroll
            for (int k = 0; k < 4; ++k) { float best = -INFINITY; int bi = 0;
#pragma unroll
                for (int e = 0; e < 32; ++e) { const bool taken = (k > 0 && ti[0] == e) || (k > 1 && ti[1] == e) || (k > 2 && ti[2] == e); if (!taken && lg[e] > best) { best = lg[e]; bi = e; } }
                ti[k] = bi; tv[k] = best; }
            const float e1 = __expf(tv[1] - tv[0]), e2 = __expf(tv[2] - tv[0]), e3 = __expf(tv[3] - tv[0]); const float inv = 1.0f / (1.0f + e1 + e2 + e3);
            { typedef int i32x4 __attribute__((ext_vector_type(4))); *(GAS i32x4*)(topi + m * 4) = (i32x4){ti[0], ti[1], ti[2], ti[3]}; } *(GAS f32x4*)(topg + m * 4) = (f32x4){inv, e1 * inv, e2 * inv, e3 * inv};
#pragma unroll
            for (int k = 0; k < 4; ++k) __hip_atomic_fetch_add(hist + ti[k], 1, __ATOMIC_RELAXED, __HIP_MEMORY_SCOPE_WORKGROUP); }
        __syncthreads();
    }
    { const int t_ = opq(F.tid); if (t_ < 32 && hist[t_] != 0) __hip_atomic_fetch_add((unsigned*)(F.ctl + CW_CNT) + 64 * t_, (unsigned)hist[t_], __ATOMIC_RELAXED, __HIP_MEMORY_SCOPE_AGENT); }
}
__device__ __forceinline__ void moe_table(Frame& F) {
    LAS int* tab = (LAS int*)(F.lds + MOETAB_OFF);
    __syncthreads();
    if (F.tid < 64) {
        const int e = opq(F.tid); int nb = 0;
        if (e < 32) { const int c = (int)__hip_atomic_load((unsigned*)(F.ctl + CW_CNT) + 64 * e, __ATOMIC_RELAXED, __HIP_MEMORY_SCOPE_AGENT); nb = (c + MOE_ROWS - 1) / MOE_ROWS; }
        int acc = 0;
#pragma unroll
        for (int j = 0; j < 32; ++j) { const int v = __builtin_amdgcn_readlane(nb, j); acc += (j < e) ? v : 0; }
        if (e < 32) { tab[320 + e] = acc * MOE_ROWS; for (int q = 0; q < nb; ++q) tab[1 + acc + q] = e; }
        if (e == 32) tab[0] = acc; }
    __syncthreads();
}
__device__ __forceinline__ void p9_dispatch(Frame& F, const Args& args) {
    const int lane = F.lane;
    unsigned char* ws = F.ws;
    moe_table(F);
    const LAS int* tab = (const LAS int*)(F.lds + MOETAB_OFF);
    LAS int* hist = (LAS int*)(F.lds + HIST_OFF); LAS int* base = hist + 32; LAS int* slots = hist + 64;
    const int* topi = (const int*)(ws + WS_ROUTE + RT_TOPI); const float* topg = (const float*)(ws + WS_ROUTE + RT_TOPG);
    int* pos = (int*)(ws + WS_ROUTE + RT_POS); float* rowgate = (float*)(ws + WS_ROUTE + RT_ROWGATE);
    bf16* XS = (bf16*)(ws + WS_XS); const float* gain = ldarg(I_NORM_FFN);
    for (int grp = F.vcu; grp < MTOK / 64; grp += F.G) {
        const int t_ = opq(F.tid);
        if (t_ < 32) hist[t_] = 0;
        f32x4 v[8][4];
#pragma unroll
        for (int i = 0; i < 8; ++i) { const GAS f32x4* xr = (const GAS f32x4*)(F.out + ((size_t)grp * 64 + F.wave * 8 + i) * D_MODEL) + 2 * lane;
#pragma unroll
            for (int j = 0; j < 4; ++j) v[i][j] = xr[128 * (j >> 1) + (j & 1)]; }
        const GAS f32x4* gr = (const GAS f32x4*)gain + 2 * lane; const f32x4 g00 = gr[0], g01 = gr[1], g10 = gr[128], g11 = gr[129];
        __syncthreads();
        int e = 0, rank = 0;
        if (F.tid < 256) { e = topi[(size_t)grp * 256 + F.tid]; rank = __hip_atomic_fetch_add(hist + e, 1, __ATOMIC_RELAXED, __HIP_MEMORY_SCOPE_WORKGROUP); }
        __syncthreads();
        if (F.tid < 32) { const int h = hist[F.tid]; int b0 = 0; if (h != 0) b0 = (int)__hip_atomic_fetch_add((unsigned*)(F.ctl + CW_CUR) + 64 * F.tid, (unsigned)h, __ATOMIC_RELAXED, __HIP_MEMORY_SCOPE_AGENT); base[F.tid] = tab[320 + F.tid] + b0; }
        __syncthreads();
        if (F.tid < 256) { const int slot = base[e] + rank; pos[(size_t)grp * 256 + F.tid] = slot; rowgate[slot] = topg[(size_t)grp * 256 + F.tid]; slots[F.tid] = slot; }
        __syncthreads();
        {
#pragma unroll
          for (int i = 0; i < 8; ++i) { const int tl = F.wave * 8 + i;
              float s = 0.f;
#pragma unroll
              for (int j = 0; j < 4; ++j) s += (v[i][j].x * v[i][j].x + v[i][j].y * v[i][j].y) + (v[i][j].z * v[i][j].z + v[i][j].w * v[i][j].w);
              const float rstd = 1.0f / sqrtf(wave_sum(s) * (1.f / D_MODEL) + NORM_EPS);
              unsigned long long o[2];
              { const f32x4 a = v[i][0] * rstd * g00, b = v[i][1] * rstd * g01; o[0] = (unsigned long long)pk4_fp8(a.x, a.y, a.z, a.w) | ((unsigned long long)pk4_fp8(b.x, b.y, b.z, b.w) << 32); }
              { const f32x4 a = v[i][2] * rstd * g10, b = v[i][3] * rstd * g11; o[1] = (unsigned long long)pk4_fp8(a.x, a.y, a.z, a.w) | ((unsigned long long)pk4_fp8(b.x, b.y, b.z, b.w) << 32); }
#pragma unroll
              for (int k = 0; k < 4; ++k) { const int sk = slots[tl * 4 + k]; GAS unsigned long long* dst = (GAS unsigned long long*)((unsigned char*)XS + (size_t)sk * D_MODEL) + lane; dst[0] = o[0]; dst[64] = o[1]; } } }
        __syncthreads();
    }
}
__device__ __forceinline__ void p12_combine(Frame& F) {
    const int gw = F.vcu * NWAVES + F.wave, NGW = F.G * NWAVES, lane = F.lane;
    unsigned char* ws = F.ws;
    const int* pos = (const int*)(ws + WS_ROUTE + RT_POS); const bf16* YR = (const bf16*)(ws + WS_YROWS);
    for (int blk = gw; blk < MTOK / 8; blk += NGW) {
        const int m0 = blk * 8;
        int pk = 0; if (lane < 32) pk = pos[(size_t)m0 * 4 + lane];
#pragma unroll
        for (int tp = 0; tp < 4; ++tp) {
            f32x4 a[2][2], b[2][2]; unsigned long long w[2][2][4];
#pragma unroll
            for (int u = 0; u < 2; ++u) { const int t = 2 * tp + u; GAS f32x4* xo = (GAS f32x4*)(F.out + (size_t)(m0 + t) * D_MODEL) + 2 * lane;
#pragma unroll
                for (int hf = 0; hf < 2; ++hf) { a[u][hf] = xo[128 * hf]; b[u][hf] = xo[128 * hf + 1];
#pragma unroll
                    for (int k = 0; k < 4; ++k) { const int sk = __builtin_amdgcn_readlane(pk, 4 * t + k); w[u][hf][k] = *((const GAS unsigned long long*)((const unsigned char*)YR + (size_t)sk * D_MODEL + 512 * hf) + lane); } } }
#pragma unroll
            for (int u = 0; u < 2; ++u) { const int t = 2 * tp + u; GAS f32x4* xo = (GAS f32x4*)(F.out + (size_t)(m0 + t) * D_MODEL) + 2 * lane;
#pragma unroll
                for (int hf = 0; hf < 2; ++hf) { f32x4 aa = a[u][hf], bb = b[u][hf];
#pragma unroll
                    for (int k = 0; k < 4; ++k) { const unsigned lo_ = (unsigned)w[u][hf][k], hi_ = (unsigned)(w[u][hf][k] >> 32);
                        const f32x2 p0 = __builtin_amdgcn_cvt_pk_f32_fp8(lo_, false), p1 = __builtin_amdgcn_cvt_pk_f32_fp8(lo_, true), p2 = __builtin_amdgcn_cvt_pk_f32_fp8(hi_, false), p3 = __builtin_amdgcn_cvt_pk_f32_fp8(hi_, true);
                        aa[0] += p0.x * 0.0625f; aa[1] += p0.y * 0.0625f; aa[2] += p1.x * 0.0625f; aa[3] += p1.y * 0.0625f; bb[0] += p2.x * 0.0625f; bb[1] += p2.y * 0.0625f; bb[2] += p3.x * 0.0625f; bb[3] += p3.y * 0.0625f; }
                    xo[128 * hf] = aa; xo[128 * hf + 1] = bb; } }
        }
    }
}

constexpr int N_ATT_A = 768, N_ATT_C = 256;
__device__ __forceinline__ swa::BlockRef attn_item(unsigned char* ws, int it) {
    swa::BlockRef r;
    const swa::bf16* Z = (const swa::bf16*)(ws + WS_Z);
    if (it < N_ATT_A) {
        const int h = it & 3, b = (it >> 2) & 1, v = it >> 3;
        int g, rr, qb;
        if (v < 32) { g = 0; rr = 0; qb = v; } else if (v < 64) { g = 1; rr = (v - 32) >> 3; qb = (v - 32) & 7; } else { g = 2; rr = (v - 64) >> 1; qb = (v - 64) & 1; }
        const int d = (g == 0) ? 1 : (g == 1) ? 4 : 16;
        const size_t row0 = (size_t)b * SEQ + rr, qrow = row0 + (size_t)d * qb * 256;
        r.Q = Z + qrow * IN_COLS + OFF_AQ + g * 512 + h * 128; r.K = Z + row0 * IN_COLS + OFF_AK + g * 512 + h * 128; r.V = Z + row0 * IN_COLS + OFF_AV + g * 512 + h * 128;
        r.O = (swa::bf16*)(ws + WS_OP) + (size_t)g * MTOK * 512 + qrow * 512 + h * 128; r.LSE = (float*)(ws + WS_LSE) + (size_t)g * MTOK * 4 + qrow * 4 + h;
        r.QS = d * IN_COLS; r.KS = d * IN_COLS; r.OS = d * 512; r.LS = d * 4; r.P0 = qb * 256; r.skv = SEQ / d; r.W = 129;
    } else {
        const int u = it - N_ATT_A, h = u & 3, b = (u >> 2) & 1, qb = u >> 3;
        const size_t qrow = (size_t)b * SEQ + (size_t)qb * 256;
        const swa::bf16* KV = (const swa::bf16*)(ws + WS_KVM) + (size_t)b * MEM_LEN * 1024 + h * 128;
        r.Q = Z + qrow * IN_COLS + OFF_CQ + h * 128; r.K = KV; r.V = KV + 512;
        r.O = (swa::bf16*)(ws + WS_YABC) + qrow * 1536 + 1024 + h * 128; r.LSE = nullptr;
        r.QS = IN_COLS; r.KS = 1024; r.OS = 1536; r.LS = 0; r.P0 = 256; r.skv = MEM_LEN; r.W = 1 << 20;
    }
    return r;
}
__device__ __forceinline__ void p3_attention_mfma(unsigned char* ws, char* lds, int G) {
    const int total = N_ATT_A + N_ATT_C; int L = blockIdx.x; if (L >= total) return;
    swa::BlockRef cur = attn_item(ws, L); swa::Seam S;
    swa::swa_prime(cur, lds, S);
    for (;;) {
        const int Ln = L + G; const bool last = Ln >= total;
        const swa::BlockRef nxt = last ? cur : attn_item(ws, Ln);
        swa::swa_block(cur, nxt, lds, S);
        if (last) break;
        cur = nxt; L = Ln;
    }
}

constexpr int N_RITEMS = BATCH * 8 * (SEQ / 64);
constexpr size_t WS_PHI = WS_XN;
constexpr size_t WS_PSI = WS_XN + 16 * MiB;
constexpr size_t WS_GAM = WS_YS;
constexpr size_t WS_OM = WS_XN2;
constexpr size_t WS_XFR = WS_MRG + 48 * MiB;
constexpr size_t WS_BONUS = WS_MRGB + 1 * MiB;
constexpr int RB = 9216, RLD = 72;
constexpr int R1_SEG = 15 * RB, R1_WC = R1_SEG + 2048;
static_assert(R1_WC + 256 <= LDSCTL_OFF, "R1 LDS map");
typedef LAS unsigned short* lbf_t;
__device__ __forceinline__ f32x4 r1_tile(const LAS unsigned short* X, const LAS unsigned short* Yt, int mi, int ni, f32x4 acc, int fr, int fq) {
    const LAS unsigned short* xp = X + (16 * mi + fr) * RLD + 8 * fq; const LAS unsigned short* yp = Yt + (16 * ni + fr) * RLD + 8 * fq;
    const bf16x8 a0 = *(const LAS bf16x8*)xp, a1 = *(const LAS bf16x8*)(xp + 32), b0 = *(const LAS bf16x8*)yp, b1 = *(const LAS bf16x8*)(yp + 32);
    acc = __builtin_amdgcn_mfma_f32_16x16x32_bf16(b0, a0, acc, 0, 0, 0);
    acc = __builtin_amdgcn_mfma_f32_16x16x32_bf16(b1, a1, acc, 0, 0, 0);
    return acc;
}
__device__ __forceinline__ void r1_store(LAS unsigned short* dst, int mi, int ni, f32x4 acc, int mode, bool addI, const LAS unsigned short* addT, int fr, int fq) {
    const int m = 16 * mi + fr, n0 = 16 * ni + 4 * fq;
#pragma unroll
    for (int r = 0; r < 4; ++r) { const int n = n0 + r; bool keep = true;
        if (mode == 1) keep = n < m; else if (mode == 2) keep = n <= m; else if (mode == 3) keep = m < n;
        float v = keep ? acc[r] : 0.f; if (addI && m == n) v += 1.0f; acc[r] = v; }
    if (addT != nullptr) { const unsigned long long w = *(const LAS unsigned long long*)(addT + m * RLD + n0);
        acc[0] += bf_lo((unsigned)w); acc[1] += bf_hi((unsigned)w); acc[2] += bf_lo((unsigned)(w >> 32)); acc[3] += bf_hi((unsigned)(w >> 32)); }
    *(LAS unsigned long long*)(dst + m * RLD + n0) = (unsigned long long)pk2(acc[0], acc[1]) | ((unsigned long long)pk2(acc[2], acc[3]) << 32);
}
#define R1BUF(i) ((LAS unsigned short*)(F.lds + (i) * RB))
template <int MODE> __device__ __forceinline__ void p_r1(Frame& F, const Args& args) {
    unsigned char* ws = F.ws; const int lane0 = F.lane, wave = F.wave;
    const bf16* Z = (const bf16*)(ws + WS_Z);
    const float* rkp = ldarg(I_R_RK); const float* mu = ldarg(I_R_MU); const float* w0p = ldarg(I_R_W0); const float* a0p = ldarg(I_R_A0); const float* kkp = ldarg(I_R_KK); const float* kap = ldarg(I_R_KA);
    const float* w1src = ldarg(I_EXP_W1);
    const bf16* W2T = (const bf16*)(ws + WS_LORA); const bf16* A2T = W2T + 512 * 64; const bf16* G2T = A2T + 512 * 64;
    bf16* VM = (bf16*)(ws + WS_VMIX); bf16* GM = (bf16*)(ws + WS_GMIX);
    LAS float* segsum = (LAS float*)(F.lds + R1_SEG); LAS float* wcs = (LAS float*)(F.lds + R1_WC);
    unsigned short zv[7][9];
#define R1LOAD(it_) do { const int bh_ = (it_) >> 7, c_ = (it_) & 127, h_ = bh_ & 7, t0_ = c_ * 64 + 8 * wave; \
        const bf16* zp_ = Z + ((size_t)(bh_ >> 3) * SEQ + t0_) * IN_COLS + OFF_R + lane; \
        _Pragma("unroll") for (int i = 0; i < 9; ++i) { const bool ok_ = (i > 0) || (t0_ > 0); const bf16* rp_ = zp_ + ((long)i - 1) * IN_COLS; const bf16* rq_ = rp_ + 64 * h_;     \
            zv[0][i] = ok_ ? rp_[1536] : (unsigned short)0; zv[1][i] = ok_ ? rp_[1600] : (unsigned short)0; zv[2][i] = ok_ ? rp_[1664] : (unsigned short)0; zv[3][i] = ok_ ? rp_[1728] : (unsigned short)0; \
            zv[4][i] = ok_ ? rq_[0] : (unsigned short)0; zv[5][i] = ok_ ? rq_[512] : (unsigned short)0; zv[6][i] = ok_ ? rq_[1024] : (unsigned short)0; } } while (0)
#define ZF(x) __builtin_bit_cast(float, (unsigned)(x) << 16)
    { const int lane = lane0; if (F.vcu < N_RITEMS) R1LOAD(F.vcu); }
    for (int item = F.vcu; item < N_RITEMS; item += F.G) {
        const int lane = opq(lane0), fr = lane & 15, fq = lane >> 4;
        const int bh = item >> 7, c = item & 127, b = bh >> 3, h = bh & 7;
        const size_t row0 = (size_t)b * SEQ + (size_t)c * 64;
        f32x4 tcv[16]; const float* tcW; unsigned char* tcWT; int tck0, tcn0, tcrb;
        w1_tile(item * 8 + wave, w1src, ws + WS_W1, tcW, tcWT, tck0, tcn0, tcrb); tc8_load(tcW, 2048, tck0, tcn0, lane, tcv);
        const f32x4 zero4 = (f32x4){0.f, 0.f, 0.f, 0.f};
        const int mw = wave >> 2, nw = wave & 3;
        float r[8], lw[8], kx[8], vx[8], ax[8], bx[8];
        { const int k = lane, tq = wave, ch = h * 64 + k;
#pragma unroll
          for (int g = 0; g < 4; ++g) { const float mug = mu[1536 + 64 * g + k];
#pragma unroll
              for (int i = 0; i < 8; ++i) { const float cur = ZF(zv[g][i + 1]), prv = ZF(zv[g][i]); float x = cur + (prv - cur) * mug;
                  x = (g == 0) ? fast_tanh(x) : (g == 1) ? x : fast_sigm(x); const unsigned short xb = (unsigned short)f2bf(x); const int t = 8 * tq + i;
                  if (g == 0) R1BUF(11)[t * RLD + k] = xb; else if (g == 1) R1BUF(12)[t * RLD + k] = xb; else R1BUF(13)[t * 136 + 64 * (g - 2) + k] = xb; } }
          { const int tid_ = wave * 64 + lane, row = tid_ >> 3, chk = tid_ & 7;
            *(LAS v4u*)(R1BUF(5) + row * RLD + chk * 8) = *(const GAS v4u*)(W2T + (size_t)(64 * h + row) * 64 + chk * 8);
            *(LAS v4u*)(R1BUF(6) + row * RLD + chk * 8) = *(const GAS v4u*)(A2T + (size_t)(64 * h + row) * 64 + chk * 8);
#pragma unroll
            for (int hh = 0; hh < 2; ++hh) { const int rg = (tid_ >> 4) + 32 * hh, cg = tid_ & 15;
                *(LAS v4u*)(R1BUF(7) + rg * 136 + cg * 8) = *(const GAS v4u*)(G2T + (size_t)(64 * h + rg) * 128 + cg * 8); } }
          __syncthreads();
          { f32x4 dw0, dw1, da0, da1, dg0 = zero4, dg1 = zero4;
            { const LAS unsigned short* yp_ = R1BUF(5) + (16 * nw + fr) * RLD + 8 * fq; const LAS unsigned short* xp_ = R1BUF(11) + (16 * mw + fr) * RLD + 8 * fq;
              const bf16x8 y0_ = *(const LAS bf16x8*)yp_, y1_ = *(const LAS bf16x8*)(yp_ + 32), xa0_ = *(const LAS bf16x8*)xp_, xa1_ = *(const LAS bf16x8*)(xp_ + 32), xb0_ = *(const LAS bf16x8*)(xp_ + 32 * RLD), xb1_ = *(const LAS bf16x8*)(xp_ + 32 * RLD + 32);
              dw0 = __builtin_amdgcn_mfma_f32_16x16x32_bf16(y0_, xa0_, zero4, 0, 0, 0); dw1 = __builtin_amdgcn_mfma_f32_16x16x32_bf16(y0_, xb0_, zero4, 0, 0, 0);
              dw0 = __builtin_amdgcn_mfma_f32_16x16x32_bf16(y1_, xa1_, dw0, 0, 0, 0); dw1 = __builtin_amdgcn_mfma_f32_16x16x32_bf16(y1_, xb1_, dw1, 0, 0, 0); }
            { const LAS unsigned short* yp_ = R1BUF(6) + (16 * nw + fr) * RLD + 8 * fq; const LAS unsigned short* xp_ = R1BUF(12) + (16 * mw + fr) * RLD + 8 * fq;
              const bf16x8 y0_ = *(const LAS bf16x8*)yp_, y1_ = *(const LAS bf16x8*)(yp_ + 32), xa0_ = *(const LAS bf16x8*)xp_, xa1_ = *(const LAS bf16x8*)(xp_ + 32), xb0_ = *(const LAS bf16x8*)(xp_ + 32 * RLD), xb1_ = *(const LAS bf16x8*)(xp_ + 32 * RLD + 32);
              da0 = __builtin_amdgcn_mfma_f32_16x16x32_bf16(y0_, xa0_, zero4, 0, 0, 0); da1 = __builtin_amdgcn_mfma_f32_16x16x32_bf16(y0_, xb0_, zero4, 0, 0, 0);
              da0 = __builtin_amdgcn_mfma_f32_16x16x32_bf16(y1_, xa1_, da0, 0, 0, 0); da1 = __builtin_amdgcn_mfma_f32_16x16x32_bf16(y1_, xb1_, da1, 0, 0, 0); }
            { const LAS unsigned short* yp_ = R1BUF(7) + (16 * nw + fr) * 136 + 8 * fq; const LAS unsigned short* xp_ = R1BUF(13) + (16 * mw + fr) * 136 + 8 * fq;
#pragma unroll
              for (int kk = 0; kk < 4; ++kk) { const bf16x8 y_ = *(const LAS bf16x8*)(yp_ + 32 * kk), xa_ = *(const LAS bf16x8*)(xp_ + 32 * kk), xb_ = *(const LAS bf16x8*)(xp_ + 32 * 136 + 32 * kk);
                  dg0 = __builtin_amdgcn_mfma_f32_16x16x32_bf16(y_, xa_, dg0, 0, 0, 0); dg1 = __builtin_amdgcn_mfma_f32_16x16x32_bf16(y_, xb_, dg1, 0, 0, 0); } }
            const int o0 = (16 * mw + fr) * 68 + 16 * nw + 4 * fq, o1 = o0 + 32 * 68;
            *(LAS f32x4*)((LAS float*)R1BUF(0) + o0) = dw0; *(LAS f32x4*)((LAS float*)R1BUF(0) + o1) = dw1;
            *(LAS f32x4*)((LAS float*)R1BUF(2) + o0) = da0; *(LAS f32x4*)((LAS float*)R1BUF(2) + o1) = da1;
            *(LAS f32x4*)((LAS float*)R1BUF(9) + o0) = dg0; *(LAS f32x4*)((LAS float*)R1BUF(9) + o1) = dg1; }
          __syncthreads();
          { const float w0c = w0p[ch], a0c = a0p[ch], kkc = kkp[ch], kac = kap[ch], mur = mu[ch], muk = mu[512 + ch], muv = mu[1024 + ch];
#pragma unroll
            for (int i = 0; i < 8; ++i) { const int t = 8 * tq + i;
                const float dwv = ((const LAS float*)R1BUF(0))[t * 68 + k], dav = ((const LAS float*)R1BUF(2))[t * 68 + k], dgv = ((const LAS float*)R1BUF(9))[t * 68 + k];
                const float cr = ZF(zv[4][i + 1]), pr = ZF(zv[4][i]), ck = ZF(zv[5][i + 1]), pk = ZF(zv[5][i]), cv = ZF(zv[6][i + 1]), pv = ZF(zv[6][i]);
                const float rr = cr + (pr - cr) * mur, kr = ck + (pk - ck) * muk, vr = cv + (pv - cv) * muv;
                const float y = -(w0c + dwv); const float sp = fast_softplus(y);
                lw[i] = -__expf(-sp - 0.5f);
                const float av = fast_sigm(a0c + dav);
                const float kkv = kr * kkc; const float ssq = wave_sum(kkv * kkv); const float kkn = kkv * __builtin_amdgcn_rsqf(fmaxf(ssq, 1e-24f));
                r[i] = rr; vx[i] = vr; kx[i] = kr * (1.0f + (av - 1.0f) * kac); ax[i] = -kkn; bx[i] = kkn * av;
                if (MODE == 0) { VM[(row0 + t) * RW + ch] = (bf16)f2bf(vr); GM[(row0 + t) * RW + ch] = (bf16)f2bf(dgv); } } }
        }
        if (item + F.G < N_RITEMS) R1LOAD(item + F.G);
        { const int k = lane, tq = wave;
          float cs[8]; cs[0] = lw[0];
#pragma unroll
          for (int i = 1; i < 8; ++i) cs[i] = cs[i - 1] + lw[i];
          segsum[tq * 64 + k] = cs[7];
          const float rk = rkp[h * 64 + k];
#pragma unroll
          for (int i = 0; i < 8; ++i) { const float bs = wave_sum(r[i] * kx[i] * rk); if (MODE == 0 && lane == 0) *(GAS float*)((float*)(ws + WS_BONUS) + (row0 + 8 * tq + i) * 8 + h) = bs; }
          __syncthreads();
          float pre = 0.f;
#pragma unroll
          for (int q = 0; q < 7; ++q) { const float sv = segsum[q * 64 + k]; pre += (q < tq) ? sv : 0.f; }
          unsigned short at[8], rt[8], bt[8], kt[8], vt[8];
#pragma unroll
          for (int i = 0; i < 8; ++i) { const float L = pre + cs[i], Lp = L - lw[i]; const float e = __expf(L), ep = __expf(Lp), ei = __expf(-L);
              at[i] = (unsigned short)f2bf(ax[i] * ep); rt[i] = (unsigned short)f2bf(r[i] * e); bt[i] = (unsigned short)f2bf(bx[i] * ei); kt[i] = (unsigned short)f2bf(kx[i] * ei); vt[i] = (unsigned short)f2bf(vx[i]);
              if (i == 7 && tq == 7) wcs[k] = e; }
#pragma unroll
          for (int i = 0; i < 8; ++i) { const int o = (8 * tq + i) * RLD + k; R1BUF(8)[o] = at[i]; R1BUF(4)[o] = rt[i]; R1BUF(9)[o] = bt[i]; R1BUF(10)[o] = kt[i]; }
          const int ot = k * RLD + 8 * tq;
#define PK8(x) ((v4u){(unsigned)x[0] | ((unsigned)x[1] << 16), (unsigned)x[2] | ((unsigned)x[3] << 16), (unsigned)x[4] | ((unsigned)x[5] << 16), (unsigned)x[6] | ((unsigned)x[7] << 16)})
          *(LAS v4u*)(R1BUF(0) + ot) = PK8(at); *(LAS v4u*)(R1BUF(1) + ot) = PK8(bt); *(LAS v4u*)(R1BUF(2) + ot) = PK8(kt); *(LAS v4u*)(R1BUF(3) + ot) = PK8(vt);
#undef PK8
        }
        __syncthreads();
#define R1PAIR(X, Y, a0, a1) do { const LAS unsigned short* yp_ = (Y) + (16 * nw + fr) * RLD + 8 * fq; const LAS unsigned short* xp_ = (X) + (16 * mw + fr) * RLD + 8 * fq; \
            const bf16x8 y0_ = *(const LAS bf16x8*)yp_, y1_ = *(const LAS bf16x8*)(yp_ + 32), xa0_ = *(const LAS bf16x8*)xp_, xa1_ = *(const LAS bf16x8*)(xp_ + 32), xb0_ = *(const LAS bf16x8*)(xp_ + 32 * RLD), xb1_ = *(const LAS bf16x8*)(xp_ + 32 * RLD + 32); \
            a0 = __builtin_amdgcn_mfma_f32_16x16x32_bf16(y0_, xa0_, zero4, 0, 0, 0); a1 = __builtin_amdgcn_mfma_f32_16x16x32_bf16(y0_, xb0_, zero4, 0, 0, 0); \
            a0 = __builtin_amdgcn_mfma_f32_16x16x32_bf16(y1_, xa1_, a0, 0, 0, 0); a1 = __builtin_amdgcn_mfma_f32_16x16x32_bf16(y1_, xb1_, a1, 0, 0, 0); } while (0)
#define R1ST2(dst, a0, a1, mode, addI, addT) do { r1_store(dst, mw, nw, a0, mode, addI, addT, fr, fq); r1_store(dst, mw + 2, nw, a1, mode, addI, addT, fr, fq); } while (0)
        { f32x4 n0, n1, t0, t1, l0, l1, b0, b1, k0, k1;
          R1PAIR(R1BUF(8), R1BUF(9), n0, n1); R1PAIR(R1BUF(9), R1BUF(8), t0, t1); R1PAIR(R1BUF(8), R1BUF(10), l0, l1); R1PAIR(R1BUF(4), R1BUF(9), b0, b1); R1PAIR(R1BUF(4), R1BUF(10), k0, k1);
          R1ST2(R1BUF(11), n0, n1, 1, false, nullptr); R1ST2(R1BUF(13), n0, n1, 1, true, nullptr); R1ST2(R1BUF(12), t0, t1, 3, false, nullptr);
          R1ST2(R1BUF(5), l0, l1, 1, false, nullptr); R1ST2(R1BUF(6), b0, b1, 2, false, nullptr); R1ST2(R1BUF(7), k0, k1, 2, false, nullptr); }
        __syncthreads();
        { f32x4 n0, n1, t0, t1, e0, e1;
          R1PAIR(R1BUF(11), R1BUF(12), n0, n1); R1PAIR(R1BUF(12), R1BUF(11), t0, t1); R1PAIR(R1BUF(3), R1BUF(5), e0, e1);
          R1ST2(R1BUF(8), n0, n1, 0, false, nullptr); R1ST2(R1BUF(9), t0, t1, 0, false, nullptr); R1ST2(R1BUF(10), e0, e1, 0, false, nullptr); }
        __syncthreads();
#pragma unroll 1
        for (int lv = 0; lv < 5; ++lv) {
            const bool srcB = (lv & 1) == 0;
            LAS unsigned short* sN = srcB ? R1BUF(8) : R1BUF(11); LAS unsigned short* sNT = srcB ? R1BUF(9) : R1BUF(12);
            LAS unsigned short* dN = srcB ? R1BUF(11) : R1BUF(8); LAS unsigned short* dNT = srcB ? R1BUF(12) : R1BUF(9);
            LAS unsigned short* Tc = (lv & 1) ? R1BUF(14) : R1BUF(13); LAS unsigned short* Tn = (lv & 1) ? R1BUF(13) : R1BUF(14);
            f32x4 u0, u1, t0 = zero4, t1 = zero4, n0 = zero4, n1 = zero4;
            R1PAIR(Tc, sNT, u0, u1);
            if (lv < 4) R1PAIR(sNT, sN, t0, t1);
            if (lv < 3) R1PAIR(sN, sNT, n0, n1);
            R1ST2(Tn, u0, u1, 0, false, Tc);
            if (lv < 4) R1ST2(dNT, t0, t1, 0, false, nullptr);
            if (lv < 3) R1ST2(dN, n0, n1, 0, false, nullptr);
            __syncthreads();
        }
        { f32x4 g0, g1, q0, q1;
          R1PAIR(R1BUF(0), R1BUF(14), g0, g1); R1PAIR(R1BUF(10), R1BUF(14), q0, q1);
          R1ST2(R1BUF(11), g0, g1, 0, false, nullptr); R1ST2(R1BUF(12), q0, q1, 0, false, nullptr); }
        __syncthreads();
#undef R1PAIR
#undef R1ST2
        { const int mi = wave >> 1, ks = wave & 1;
          const f32x4 p0 = r1_tile(R1BUF(1), R1BUF(11), mi, 2 * ks, zero4, fr, fq), p1 = r1_tile(R1BUF(1), R1BUF(11), mi, 2 * ks + 1, zero4, fr, fq);
          const f32x4 s0 = r1_tile(R1BUF(6), R1BUF(11), mi, 2 * ks, zero4, fr, fq), s1 = r1_tile(R1BUF(6), R1BUF(11), mi, 2 * ks + 1, zero4, fr, fq);
          const int m = 16 * mi + fr; const float wc = wcs[m];
          float ph[8], ps[8];
#pragma unroll
          for (int r = 0; r < 4; ++r) { const int n0 = 32 * ks + 4 * fq + r, n1 = n0 + 16;
              ph[r] = (p0[r] + (m == n0 ? 1.f : 0.f)) * wc; ph[4 + r] = (p1[r] + (m == n1 ? 1.f : 0.f)) * wc; }
          { const unsigned long long w0 = *(const LAS unsigned long long*)(R1BUF(4) + m * RLD + 32 * ks + 4 * fq), w1 = *(const LAS unsigned long long*)(R1BUF(4) + m * RLD + 32 * ks + 16 + 4 * fq);
            ps[0] = s0[0] + bf_lo((unsigned)w0); ps[1] = s0[1] + bf_hi((unsigned)w0); ps[2] = s0[2] + bf_lo((unsigned)(w0 >> 32)); ps[3] = s0[3] + bf_hi((unsigned)(w0 >> 32));
            ps[4] = s1[0] + bf_lo((unsigned)w1); ps[5] = s1[1] + bf_hi((unsigned)w1); ps[6] = s1[2] + bf_lo((unsigned)(w1 >> 32)); ps[7] = s1[3] + bf_hi((unsigned)(w1 >> 32)); }
          const size_t fo = (((size_t)item * 4 + mi) * 2 + ks) * 64 + lane;
          if (MODE == 0) *((GAS v4u*)(ws + WS_PHI) + fo) = (v4u){pk2(ph[0], ph[1]), pk2(ph[2], ph[3]), pk2(ph[4], ph[5]), pk2(ph[6], ph[7])};
          if (MODE == 0) *((GAS v4u*)(ws + WS_PSI) + fo) = (v4u){pk2(ps[0], ps[1]), pk2(ps[2], ps[3]), pk2(ps[4], ps[5]), pk2(ps[6], ps[7])};
          const int vb = wave >> 1;
#pragma unroll
          for (int hh = 0; hh < 2; ++hh) { const int mt = 2 * (wave & 1) + hh;
              f32x4 ga = r1_tile(R1BUF(12), R1BUF(1), vb, mt, zero4, fr, fq); ga = r1_tile(R1BUF(3), R1BUF(2), vb, mt, ga, fr, fq);
              f32x4 om = r1_tile(R1BUF(12), R1BUF(6), vb, mt, zero4, fr, fq); om = r1_tile(R1BUF(3), R1BUF(7), vb, mt, om, fr, fq);
#pragma unroll
              for (int r = 0; r < 4; ++r) ga[r] *= wcs[16 * mt + 4 * fq + r];
              const size_t ao = (((size_t)item * 4 + vb) * 4 + mt) * 64 + lane;
              if (MODE == 0) { *((GAS f32x4*)(ws + WS_GAM) + ao) = ga; *((GAS f32x4*)(ws + WS_OM) + ao) = om; } else { asm volatile("" :: "v"(ga), "v"(om)); } }
        }
        tc8_store(tcWT, 1024, tck0, tcrb, lane, tcv, W8_SCALE);
        __syncthreads();
    }
}
#undef R1BUF
#undef R1LOAD
#undef ZF
struct R2Buf { bf16x8 ph[4][2]; f32x4 ga[4]; };
__device__ __forceinline__ void r2_load(R2Buf& B, const unsigned char* ws, int item, int vb, int lane) {
#pragma unroll
    for (int mt = 0; mt < 4; ++mt) {
#pragma unroll
        for (int ks = 0; ks < 2; ++ks) B.ph[mt][ks] = *((const GAS bf16x8*)(ws + WS_PHI) + (((size_t)item * 4 + mt) * 2 + ks) * 64 + lane);
        B.ga[mt] = *((const GAS f32x4*)(ws + WS_GAM) + (((size_t)item * 4 + vb) * 4 + mt) * 64 + lane); }
}
__device__ __forceinline__ void r2_step(const R2Buf& B, f32x4 (&acc)[4], unsigned char* ws, int item, int vb, int lane) {
    v4u x0, x1;
    x0.x = pk2(acc[0][0], acc[0][1]); x0.y = pk2(acc[0][2], acc[0][3]); x0.z = pk2(acc[1][0], acc[1][1]); x0.w = pk2(acc[1][2], acc[1][3]);
    x1.x = pk2(acc[2][0], acc[2][1]); x1.y = pk2(acc[2][2], acc[2][3]); x1.z = pk2(acc[3][0], acc[3][1]); x1.w = pk2(acc[3][2], acc[3][3]);
    GAS v4u* xo = (GAS v4u*)(ws + WS_XFR) + (((size_t)item * 4 + vb) * 2) * 64 + lane; xo[0] = x0; xo[64] = x1;
    const bf16x8 f0 = __builtin_bit_cast(bf16x8, x0), f1 = __builtin_bit_cast(bf16x8, x1);
#pragma unroll
    for (int mt = 0; mt < 4; ++mt) { f32x4 a = B.ga[mt];
        a = __builtin_amdgcn_mfma_f32_16x16x32_bf16(B.ph[mt][0], f0, a, 0, 0, 0);
        a = __builtin_amdgcn_mfma_f32_16x16x32_bf16(B.ph[mt][1], f1, a, 0, 0, 0);
        acc[mt] = a; }
}
__device__ __forceinline__ void p_r2(Frame& F) {
    if (blockIdx.x < BATCH * 8 * 4 && F.wave == 0) {
        unsigned char* ws = F.ws; const int bh = blockIdx.x >> 2, vb = blockIdx.x & 3, lane = F.lane;
        f32x4 acc[4];
#pragma unroll
        for (int i = 0; i < 4; ++i) acc[i] = (f32x4){0.f, 0.f, 0.f, 0.f};
        R2Buf A, B, C, D;
        const int it0 = bh * 128;
        r2_load(A, ws, it0, vb, lane); r2_load(B, ws, it0 + 1, vb, lane); r2_load(C, ws, it0 + 2, vb, lane);
#define R2SB() __builtin_amdgcn_sched_barrier(0)
#pragma unroll
        for (int c = 0; c < 128; c += 4) {
            r2_load(D, ws, it0 + c + 3, vb, lane); R2SB(); r2_step(A, acc, ws, it0 + c, vb, lane); R2SB();
            r2_load(A, ws, it0 + (c + 4 < 128 ? c + 4 : 127), vb, lane); R2SB(); r2_step(B, acc, ws, it0 + c + 1, vb, lane); R2SB();
            r2_load(B, ws, it0 + (c + 5 < 128 ? c + 5 : 127), vb, lane); R2SB(); r2_step(C, acc, ws, it0 + c + 2, vb, lane); R2SB();
            r2_load(C, ws, it0 + (c + 6 < 128 ? c + 6 : 127), vb, lane); R2SB(); r2_step(D, acc, ws, it0 + c + 3, vb, lane); R2SB();
        }
#undef R2SB
    }
}
__device__ __forceinline__ void p_r3(Frame& F, const Args& args) {
    const int gw = F.vcu * NWAVES + F.wave, NGW = F.G * NWAVES, lane = F.lane, cc = lane & 15, q = lane >> 4;
    unsigned char* ws = F.ws;
    const bf16* VM = (const bf16*)(ws + WS_VMIX); const bf16* GM = (const bf16*)(ws + WS_GMIX);
    const float* bonus = (const float*)(ws + WS_BONUS);
    bf16* YB = (bf16*)(ws + WS_YABC) + 512;
    const float* lnw = ldarg(I_R_LNW); const float* lnb = ldarg(I_R_LNB);
#pragma unroll 2
    for (int wi = gw; wi < N_RITEMS * 4; wi += NGW) {
        const int item = wi >> 2, tt = wi & 3, bh = item >> 7, c = item & 127, b = bh >> 3, h = bh & 7;
        const bf16x8 ps0 = *((const GAS bf16x8*)(ws + WS_PSI) + (((size_t)item * 4 + tt) * 2 + 0) * 64 + lane), ps1 = *((const GAS bf16x8*)(ws + WS_PSI) + (((size_t)item * 4 + tt) * 2 + 1) * 64 + lane);
        f32x4 acc[4];
#pragma unroll
        for (int vb = 0; vb < 4; ++vb) {
            const bf16x8 x0 = *((const GAS bf16x8*)(ws + WS_XFR) + (((size_t)item * 4 + vb) * 2 + 0) * 64 + lane), x1 = *((const GAS bf16x8*)(ws + WS_XFR) + (((size_t)item * 4 + vb) * 2 + 1) * 64 + lane);
            f32x4 a = *((const GAS f32x4*)(ws + WS_OM) + (((size_t)item * 4 + vb) * 4 + tt) * 64 + lane);
            a = __builtin_amdgcn_mfma_f32_16x16x32_bf16(ps0, x0, a, 0, 0, 0);
            a = __builtin_amdgcn_mfma_f32_16x16x32_bf16(ps1, x1, a, 0, 0, 0);
            acc[vb] = a; }
        const size_t rowb = (size_t)b * SEQ + (size_t)c * 64 + 16 * tt + 4 * q;
        unsigned short vmr[4][4], gmr[4][4]; float bnr[4], lw4[4], lb4[4];
#pragma unroll
        for (int vb = 0; vb < 4; ++vb) { const int ch = h * 64 + 16 * vb + cc; lw4[vb] = lnw[ch]; lb4[vb] = lnb[ch]; }
#pragma unroll
        for (int r = 0; r < 4; ++r) { const size_t t = rowb + r; bnr[r] = bonus[t * 8 + h];
#pragma unroll
            for (int vb = 0; vb < 4; ++vb) { const int ch = h * 64 + 16 * vb + cc; vmr[r][vb] = VM[t * RW + ch]; gmr[r][vb] = GM[t * RW + ch]; } }
#pragma unroll
        for (int r = 0; r < 4; ++r) { const size_t t = rowb + r;
            const float s = (acc[0][r] + acc[1][r]) + (acc[2][r] + acc[3][r]);
            const float mean = row16_sum(s) * (1.f / 64.f);
            const float d0 = acc[0][r] - mean, d1 = acc[1][r] - mean, d2 = acc[2][r] - mean, d3 = acc[3][r] - mean;
            const float var = row16_sum((d0 * d0 + d1 * d1) + (d2 * d2 + d3 * d3)) * (1.f / 64.f);
            const float rstd = __builtin_amdgcn_rsqf(var + R_GN_EPS);
            const float bn = bnr[r];
#pragma unroll
            for (int vb = 0; vb < 4; ++vb) { const int ch = h * 64 + 16 * vb + cc; const float d = (vb == 0) ? d0 : (vb == 1) ? d1 : (vb == 2) ? d2 : d3;
                const float yn = d * rstd * lw4[vb] + lb4[vb];
                const float vv = __builtin_bit_cast(float, (unsigned)vmr[r][vb] << 16), gg = __builtin_bit_cast(float, (unsigned)gmr[r][vb] << 16);
                YB[t * 1536 + ch] = (bf16)f2bf((yn + bn * vv) * gg); } }
    }
}

__global__ void __launch_bounds__(NWAVES * 64, 2) skel_fwd(Args args) {
    extern __shared__ __attribute__((aligned(16))) unsigned char lds[];
    Frame F;
    F.lds = (LAS unsigned char*)lds;
    F.MISC = (volatile LAS unsigned*)(F.lds + MISC_OFF);
    phase_enter(F, true);
    F.G = gridDim.x; { const int bx = blockIdx.x; F.vcu = (F.G % 8 == 0) ? (bx % 8) * (F.G / 8) + bx / 8 : bx; }
    unsigned char* ws = args.ws; F.ws = ws; F.out = args.out;
    F.ctl = (gu32*)(ws + WS_CTL);
    for (int u = F.tid; u < (LDS_BYTES - LDSCTL_OFF) / 4; u += NWAVES * 64) ((LAS unsigned*)(F.lds + LDSCTL_OFF))[u] = 0u;
    __syncthreads();
    XcdBarrier bar; bar.bar = (unsigned*)(F.ctl + CW_BAR); bar.x = 0; bar.st = nullptr;
    if (args.use_bar) bar = xcd_barrier_post((unsigned*)(F.ctl + CW_BAR), F.MISC + 8);
    const int lo = args.ph_lo, hi = args.ph_hi;
#define IN(k) (phase_enter(F, lo <= (k) && (k) < hi))
#define SEAM(k) do { if (lo <= (k) && (k) + 1 < hi) xcd_barrier(bar); } while (0)
    const pg8::bf16_t* wsb = (const pg8::bf16_t*)ws;
#define BF(off) ((pg8::bf16_t*)(ws + (off)))

    if (IN(0)) { p0_prologue<0>(F, args, F.vcu * NWAVES + F.wave, F.G * NWAVES); if (F.G <= 64) p0_prologue<1>(F, args, F.vcu * NWAVES + F.wave, F.G * NWAVES); } SEAM(0);
    if (IN(1)) {
        const float* ckg_ = ldarg(I_CK_GAIN);
        pg8::EpiZ E{BF(WS_Z), ldarg(I_B_GATE), ldarg(I_AQ_GAIN), ldarg(I_AK_GAIN), ldarg(I_CQ_GAIN), (const float*)(ws + WS_CS), BF(WS_KVM), ckg_, (PG8_LAS float*)(F.lds + 131072)};
        { pg8::Gemm g{BF(WS_XN), BF(WS_WIN), MTOK + MEMROWS, IN_COLS + 1024, 1024}; pg8::ZOrder<0> S; S.init(F.G, (int)blockIdx.x);
          pg8::gemm_phase<pg8::EpiZ, pg8::ZOrder<0>, true, true>(F.lds + RING_OFF, g, S, E); }
        { pg8::Gemm g{BF(WS_XN8), BF(WS_WIN8), MTOK, IN_COLS, 1024, SC_ONE, SC_W8}; pg8::ZOrder<1> S; S.init(F.G, (int)blockIdx.x);
          pg8::gemm_phase<pg8::EpiZ, pg8::ZOrder<1>, true, true, true>(F.lds + RING_OFF, g, S, E); }
    } SEAM(1);
#if NAIVE_ATTN
    if (IN(3)) { p3_attention(F); } SEAM(3);
#else
    if (IN(3)) { p3_attention_mfma(ws, (char*)lds + RING_OFF, F.G); __syncthreads(); phase_enter(F, true); p_r1<0>(F, args); } SEAM(3);
#endif
    if (IN(4)) { p_r2(F); if (F.G > 64 && blockIdx.x >= 64) p0_prologue<1>(F, args, ((int)blockIdx.x - 64) * NWAVES + F.wave, (F.G - 64) * NWAVES); } SEAM(4);
    if (IN(5)) { p_r3(F, args); p5_post(F, args); } SEAM(5);
    if (IN(6)) {
        pg8::Gemm g{BF(WS_YABC), BF(WS_WB), MTOK, 1024, 1536}; pg8::StaticOrder S; S.init(MTOK, 1024, F.G, (int)blockIdx.x);
        pg8::EpiGate3 E{BF(WS_Z), BF(WS_MRGB)};
        pg8::gemm_phase<pg8::EpiGate3, pg8::StaticOrder, true, true>(F.lds + RING_OFF, g, S, E);
    } SEAM(6);
    if (IN(7)) {
        pg8::Gemm g{BF(WS_MRGB), BF(WS_WO), MTOK, 1024, 1024}; pg8::StaticOrder S; S.init(MTOK, 1024, F.G, (int)blockIdx.x);
        pg8::EpiResF32 E{ldarg(I_X), F.out, 1024};
        pg8::gemm_phase<pg8::EpiResF32, pg8::StaticOrder, true, true>(F.lds + RING_OFF, g, S, E);
    } SEAM(7);
    if (IN(8)) { p8_router(F, args); } SEAM(8);
    if (IN(9)) { p9_dispatch(F, args); } SEAM(9);
    if (IN(10)) {
        moe_table(F);
        pg8::Gemm g{BF(WS_XS), BF(WS_W1), 0, 0, 1024, SC_ONE, SC_W8}; pg8::MoeOrder S{(const PG8_LAS int*)(F.lds + MOETAB_OFF), 8, F.G, (int)blockIdx.x};
        pg8::EpiSwiGLU E{ldarg(I_EXP_B1), BF(WS_HACT)};
        pg8::gemm_phase<pg8::EpiSwiGLU, pg8::MoeOrder, true, true, true>(F.lds + RING_OFF, g, S, E);
    } SEAM(10);
    if (IN(11)) {
        moe_table(F);
        pg8::Gemm g{BF(WS_HACT), BF(WS_W2), 0, 0, 1024, SC_H8, SC_W8}; pg8::MoeOrder S{(const PG8_LAS int*)(F.lds + MOETAB_OFF), 4, F.G, (int)blockIdx.x};
        pg8::EpiMoeOut E{ldarg(I_EXP_B2), (const float*)(ws + WS_ROUTE + RT_ROWGATE), BF(WS_YROWS)};
        pg8::gemm_phase<pg8::EpiMoeOut, pg8::MoeOrder, true, true, true>(F.lds + RING_OFF, g, S, E);
    } SEAM(11);
    if (IN(12)) { p12_combine(F); }
#undef IN
#undef SEAM
#undef BF
    (void)wsb;
}

extern "C" void kernel_launch(void* const* d_in, const int* in_sizes, int n_in, void* d_out, int out_size, void* d_ws, size_t ws_size, hipStream_t stream) {
    static int grid = 0;
    if (grid == 0) {
        if (n_in != 32 || out_size != MTOK * D_MODEL || ws_size < WS_END) { fprintf(stderr, "kernel_launch: unexpected problem (n_in %d, out %d, ws %zu); nothing launched\n", n_in, out_size, ws_size); grid = -1; return; }
        int dev = 0, cus = 0;
        if (hipGetDevice(&dev) != hipSuccess || hipDeviceGetAttribute(&cus, hipDeviceAttributeMultiprocessorCount, dev) != hipSuccess) { grid = -1; return; }
        if (hipFuncSetAttribute((const void*)skel_fwd, hipFuncAttributeMaxDynamicSharedMemorySize, LDS_BYTES) != hipSuccess) { fprintf(stderr, "kernel_launch: hipFuncSetAttribute failed\n"); grid = -1; return; }
        (void)hipGetLastError();
        grid = cus;
    }
    if (grid < 0) return;
    (void)hipMemsetAsync((char*)d_ws + WS_CTL, 0, CTL_ZERO_BYTES, stream);
    Args a{};
    for (int i = 0; i < 32; ++i) a.in[i] = (const float*)d_in[i];
    a.out = (float*)d_out; a.ws = (unsigned char*)d_ws;
#if MK_N_LAUNCHES == 1
    a.ph_lo = 0; a.ph_hi = N_PHASES; a.use_bar = 1;
    hipLaunchKernelGGL(skel_fwd, dim3(grid), dim3(NWAVES * 64), LDS_BYTES, stream, a);
#else
    for (int p = 0; p < N_PHASES; ++p) { a.ph_lo = p; a.ph_hi = p + 1; a.use_bar = 0;
        hipLaunchKernelGGL(skel_fwd, dim3(grid), dim3(NWAVES * 64), LDS_BYTES, stream, a); }
#endif
}
```

```cpp
#include <hip/hip_runtime.h>
#include <cstdio>
#include <cstdint>
#include <cmath>
namespace pg8 {
#define PG8_LAS __attribute__((address_space(3)))
typedef unsigned short bf16_t;
typedef short bf16x8 __attribute__((ext_vector_type(8)));
typedef float f32x4 __attribute__((ext_vector_type(4)));
typedef unsigned u32x4 __attribute__((ext_vector_type(4)));
constexpr int BM = 256, BK = 64, HALF = 128, HTB = HALF * BK * 2  , STAGE_BYTES = 8 * HTB, NXCD = 8, WGM = 8;

__host__ __device__ __forceinline__ int lds_byte(int r, int c) { const int st = (r >> 4) * 2 + (c >> 5), rr = r & 15, cc = c & 31, ob = rr * 64 + cc * 2; return st * 1024 + (ob ^ (((ob >> 9) & 1) << 5)); }
__host__ __device__ __forceinline__ void stage_rc(int b, int& R, int& C) { const int st = b / 1024, sb = b % 1024, swz = sb ^ (((sb >> 9) & 1) << 5); R = (st >> 1) * 16 + swz / 64; C = (st & 1) * 32 + (swz % 64) / 2; }
__host__ __device__ __forceinline__ int perm32(int rho) { const int n = rho >> 4, i = rho & 15; return 8 * (i >> 2) + 4 * n + (i & 3); }

struct Unit { int pm, pn; };
typedef int v4i_t __attribute__((ext_vector_type(4))); typedef int v8i_t __attribute__((ext_vector_type(8)));
struct Gemm { const bf16_t* A; const bf16_t* Bt; int M, N, K; int sca = 0x7f7f7f7f, scb = 0x7f7f7f7f; int prof = 0; };
#ifdef PG8_PROF
__device__ unsigned long long pg8_prof[4];
#endif

struct StaticOrder {
    int nM, nN, nwg, G, c;
    __host__ __device__ void init(int M, int N, int G_, int c_) { nM = M / BM; nN = N / BM; nwg = nM * nN; G = G_; c = c_; }
    __host__ __device__ bool next(int i, Unit& u) const {
        const long L = (long)i * G + c; if (L >= nwg) return false;
        int wgid = (int)L; { const int q = nwg / NXCD, r = nwg % NXCD, xcd = wgid % NXCD, off = wgid / NXCD; wgid = (xcd < r ? xcd * (q + 1) : r * (q + 1) + (xcd - r) * q) + off; }
        const int nig = WGM * nN, gid = wgid / nig, fm = gid * WGM, gsz = (nM - fm) < WGM ? (nM - fm) : WGM;
        u.pm = fm + ((wgid % nig) % gsz); u.pn = (wgid % nig) / gsz; return true;
    }
    __device__ __forceinline__ void a_ready(const Unit&) const {}
    __device__ __forceinline__ void done(const Unit&) const {}
};

__device__ __forceinline__ unsigned cvt_pk_bf16(float lo, float hi) { unsigned r; asm volatile("v_cvt_pk_bf16_f32 %0, %1, %2" : "=v"(r) : "v"(lo), "v"(hi)); return r; }
typedef float f32x2 __attribute__((ext_vector_type(2)));
__device__ __forceinline__ f32x2 gelu_pk(f32x2 v) {
    const f32x2 av = __builtin_elementwise_abs(v), d = av * 0.2316418882f + 1.0f;
    f32x2 t; t.x = __builtin_amdgcn_rcpf(d.x); t.y = __builtin_amdgcn_rcpf(d.y);
    f32x2 q = t * 0.5307027145f + (-0.7265760135f); q = q * t + 0.7107068705f; q = q * t + (-0.142248368f); q = q * t + 0.127414796f; q = q * t;
    const f32x2 s = (v * v) * (-0.72134752044f);
    f32x2 e; e.x = __builtin_amdgcn_exp2f(s.x); e.y = __builtin_amdgcn_exp2f(s.y);
    const f32x2 m = v * (q * e), r = v - m;
    f32x2 o; o.x = v.x < 0.f ? m.x : r.x; o.y = v.y < 0.f ? m.y : r.y; return o;
}

template <int ACT  > struct EpiBf16 {
    static constexpr bool PERM = true, AFTER_DRAIN = false; static_assert(ACT == 0 || ACT == 1, "EpiBf16: ACT is 0 (none) or 1 (gelu_pk)");
    bf16_t* O; int ldc; const float* bias; int split_cols; size_t split_stride; float scale0;
    __device__ __forceinline__ void operator()(const f32x4 (&acc)[2][2][4][2], const Unit& u, int wr, int wc, int fr, int fq) const {
        const int row0 = u.pm * BM + wr * 64 + fr; int colt = u.pn * BM; bf16_t* base = O;
        float sc = 1.f; if (split_cols) { const int t = colt / split_cols; base += (size_t)t * split_stride; colt -= t * split_cols; if (t == 0) sc = scale0; }
        const int col0 = colt + wc * 32 + 8 * fq, bcol0 = u.pn * BM + wc * 32 + 8 * fq;
        f32x4 bv[2][2];
#pragma unroll
        for (int bj = 0; bj < 2; ++bj)
#pragma unroll
            for (int n = 0; n < 2; ++n) bv[bj][n] = bias ? *(const f32x4*)(bias + bcol0 + bj * HALF + 4 * n) : (f32x4){0.f, 0.f, 0.f, 0.f};
#pragma unroll
        for (int ai = 0; ai < 2; ++ai)
#pragma unroll
            for (int m = 0; m < 4; ++m) { bf16_t* rowp = base + (size_t)(row0 + ai * HALF + m * 16) * ldc + col0;
#pragma unroll
                for (int bj = 0; bj < 2; ++bj) { f32x4 v0 = acc[ai][bj][m][0] + bv[bj][0], v1 = acc[ai][bj][m][1] + bv[bj][1];
                    if (ACT == 1) { f32x2 a = gelu_pk((f32x2){v0[0], v0[1]}), b = gelu_pk((f32x2){v0[2], v0[3]}), c = gelu_pk((f32x2){v1[0], v1[1]}), d = gelu_pk((f32x2){v1[2], v1[3]});
                        v0 = (f32x4){a.x, a.y, b.x, b.y}; v1 = (f32x4){c.x, c.y, d.x, d.y}; }
                    v0 = v0 * sc; v1 = v1 * sc; u32x4 w; w.x = cvt_pk_bf16(v0[0], v0[1]); w.y = cvt_pk_bf16(v0[2], v0[3]); w.z = cvt_pk_bf16(v1[0], v1[1]); w.w = cvt_pk_bf16(v1[2], v1[3]);
                    *(u32x4*)(rowp + bj * HALF) = w; } }
    }
};
template <class E_> struct EpiHasMid { static constexpr bool v = false; };
template <class Epi, class Sched, bool ALIGN_EPI = false, bool SP2 = false, bool FP8 = false>
__device__ __forceinline__ void gemm_phase(PG8_LAS unsigned char* lds, const Gemm g, const Sched& S, const Epi& E) {
    int tid_ = threadIdx.x; asm volatile("" : "+v"(tid_));
    const int tid = tid_, wid = __builtin_amdgcn_readfirstlane(tid >> 6), lane = tid & 63, wr = wid >> 2, wc = wid & 3, fr = lane & 15, fq = lane >> 4;
    const int K = FP8 ? g.K / 2 : g.K, nt = K / BK;
    unsigned voffA[2], voffB[2];
#pragma unroll
    for (int i = 0; i < 2; ++i) { int R, C; stage_rc(tid * 16 + i * 8192, R, C); const int Rb = Epi::PERM ? ((R & ~31) + perm32(R & 31)) : R;
        voffA[i] = (unsigned)(R * K + C) * 2u; voffB[i] = (unsigned)(Rb * K + C) * 2u; }
    const size_t kstep = (size_t)(BK * 2);
    const size_t hstep = (size_t)HALF * K * 2;
    const size_t tstep = 2 * hstep;
    const unsigned ldsw = (unsigned)wid * 1024u;
    const int aoff = FP8 ? lds_byte(wr * 64 + fr, fq * 16) : lds_byte(wr * 64 + fr, fq * 8), boff = FP8 ? lds_byte(wc * 32 + fr, fq * 16) : lds_byte(wc * 32 + fr, fq * 8);
    constexpr int PIECE1 = FP8 ? 16 : 1024; (void)PIECE1;
#define PG8_SA(b, h) (((b) * 2 + (h)) * HTB)
#define PG8_SB(b, h) ((4 + (b) * 2 + (h)) * HTB)
#define PG8_STAGE(bufoff, gbase, voff) do { _Pragma("unroll") for (int _i = 0; _i < 2; ++_i) \
        __builtin_amdgcn_global_load_lds((const unsigned*)((const char*)(gbase) + (voff)[_i]), (PG8_LAS unsigned*)(lds + (bufoff) + ldsw + _i * 8192), 16, 0, 0); } while (0)
#define PG8_LD8(p_) __builtin_shufflevector(*(const PG8_LAS v4i_t*)(p_), *(const PG8_LAS v4i_t*)((p_) + 16), 0, 1, 2, 3, 4, 5, 6, 7)
#define PG8_LDA(dst, b, h) do { if constexpr (FP8) { _Pragma("unroll") for (int m = 0; m < 4; ++m) dst##8[m] = PG8_LD8(lds + PG8_SA(b, h) + aoff + m * 2048); } \
        else { _Pragma("unroll") for (int m = 0; m < 4; ++m) _Pragma("unroll") for (int k = 0; k < 2; ++k) dst[m][k] = *(const PG8_LAS bf16x8*)(lds + PG8_SA(b, h) + aoff + k * 1024 + m * 2048); } } while (0)
#define PG8_LDB(dst, b, h) do { if constexpr (FP8) { _Pragma("unroll") for (int n = 0; n < 2; ++n) dst##8[n] = PG8_LD8(lds + PG8_SB(b, h) + boff + n * 2048); } \
        else { _Pragma("unroll") for (int n = 0; n < 2; ++n) _Pragma("unroll") for (int k = 0; k < 2; ++k) dst[n][k] = *(const PG8_LAS bf16x8*)(lds + PG8_SB(b, h) + boff + k * 1024 + n * 2048); } } while (0)
#define PG8_MMA(ai, bj, At, Bt) do { __builtin_amdgcn_s_setprio(1); \
        if constexpr (FP8) { _Pragma("unroll") for (int m = 0; m < 4; ++m) _Pragma("unroll") for (int n = 0; n < 2; ++n) \
            asm volatile("v_mfma_scale_f32_16x16x128_f8f6f4 %0, %1, %2, %0, %3, %4 op_sel_hi:[0,0,0]" : "+v"(acc[ai][bj][m][n]) : "v"(Bt##8[n]), "v"(At##8[m]), "v"(scb_v), "v"(sca_v)); } \
        else { _Pragma("unroll") for (int m = 0; m < 4; ++m) _Pragma("unroll") for (int n = 0; n < 2; ++n) _Pragma("unroll") for (int k = 0; k < 2; ++k) \
            acc[ai][bj][m][n] = __builtin_amdgcn_mfma_f32_16x16x32_bf16(Bt[n][k], At[m][k], acc[ai][bj][m][n], 0, 0, 0); } __builtin_amdgcn_s_setprio(0); } while (0)
#define PG8_WAIT_V(n) asm volatile("s_waitcnt vmcnt(" #n ")" ::: "memory")
#define PG8_WAIT_L(n) asm volatile("s_waitcnt lgkmcnt(" #n ")" ::: "memory")
#define PG8_BAR __builtin_amdgcn_s_barrier()
#define PG8_SCHED __builtin_amdgcn_sched_barrier(0)
    Unit cur, nxt; int ui = 0;
#ifdef PG8_PROF
#define PG8_TS(slot) do { if (g.prof && wid == 0) { const unsigned n_ = (unsigned)__builtin_amdgcn_s_memrealtime(); volatile PG8_LAS unsigned* p_ = (volatile PG8_LAS unsigned*)(lds + 143744); p_[slot] += n_ - p_[2]; p_[2] = n_; } } while (0)
#else
#define PG8_TS(slot) do { } while (0)
#endif
    if (!S.next(0, cur)) return;
    f32x4 acc[2][2][4][2];
#pragma unroll
    for (int a = 0; a < 2; ++a)
#pragma unroll
        for (int b = 0; b < 2; ++b)
#pragma unroll
            for (int m = 0; m < 4; ++m)
#pragma unroll
                for (int n = 0; n < 2; ++n) acc[a][b][m][n] = (f32x4){0.f, 0.f, 0.f, 0.f};
    const int sca_v = g.sca, scb_v = g.scb;
    bf16x8 At[4][2], B0[2][2], B1[2][2];
    v8i_t At8[4], B08[2], B18[2];
    const char* cA = (const char*)g.A + (size_t)cur.pm * tstep; const char* cB = (const char*)g.Bt + (size_t)cur.pn * tstep;
    S.a_ready(cur);
    if constexpr (SP2) {
        PG8_STAGE(PG8_SB(0, 0), cB, voffB); PG8_STAGE(PG8_SB(0, 1), cB + hstep, voffB); PG8_STAGE(PG8_SA(0, 0), cA, voffA); PG8_STAGE(PG8_SA(0, 1), cA + hstep, voffA);
        if (wr == 1) PG8_BAR;
        PG8_WAIT_V(2); PG8_BAR;
        PG8_STAGE(PG8_SB(1, 0), cB + kstep, voffB); PG8_STAGE(PG8_SA(1, 0), cA + kstep, voffA); PG8_STAGE(PG8_SB(1, 1), cB + hstep + kstep, voffB);
        PG8_WAIT_V(6); PG8_BAR;
    } else {
        PG8_STAGE(PG8_SB(0, 0), cB, voffB); PG8_STAGE(PG8_SA(0, 0), cA, voffA); PG8_STAGE(PG8_SB(0, 1), cB + hstep, voffB); PG8_STAGE(PG8_SA(0, 1), cA + hstep, voffA);
        if (wr == 1) PG8_BAR;
        PG8_WAIT_V(4); PG8_BAR;
        PG8_STAGE(PG8_SB(1, 0), cB + kstep, voffB); PG8_STAGE(PG8_SA(1, 0), cA + kstep, voffA); PG8_STAGE(PG8_SB(1, 1), cB + hstep + kstep, voffB);
        PG8_WAIT_V(6); PG8_BAR;
    }
    for (;;) {
        const bool has_next = S.next(ui + 1, nxt);
        const char* nA = has_next ? (const char*)g.A + (size_t)nxt.pm * tstep : cA; const char* nB = has_next ? (const char*)g.Bt + (size_t)nxt.pn * tstep : cB;
        PG8_TS(3);
#pragma unroll 1
        for (int t = 0; t < nt; t += 2) {
            if constexpr (EpiHasMid<Epi>::v) { if (t == 8 || t == 16) { PG8_SCHED; E.mid(acc, cur, t, wr, wc, fr, fq); PG8_SCHED; } }
            const bool last = (t == nt - 2);
            const char* a1 = cA + (size_t)(t + 1) * kstep;
            const char* a2 = last ? nA : cA + (size_t)(t + 2) * kstep; const char* b2 = last ? nB : cB + (size_t)(t + 2) * kstep;
            const char* a3 = a2 + kstep; const char* b3 = b2 + kstep;
            if (last && has_next) S.a_ready(nxt);
            if constexpr (SP2) {
            PG8_LDB(B0, 0, 0); PG8_LDB(B1, 0, 1); PG8_SCHED; PG8_LDA(At, 0, 0); PG8_STAGE(PG8_SA(1, 1), a1 + hstep, voffA);
            PG8_WAIT_V(8); PG8_WAIT_L(0); PG8_BAR; PG8_MMA(0, 0, At, B0); PG8_MMA(0, 1, At, B1); PG8_BAR; PG8_SCHED;
            PG8_LDA(At, 0, 1); PG8_STAGE(PG8_SB(0, 0), b2, voffB); PG8_STAGE(PG8_SB(0, 1), b2 + hstep, voffB); PG8_STAGE(PG8_SA(0, 0), a2, voffA);
            PG8_WAIT_V(8); PG8_WAIT_L(0); PG8_BAR; PG8_MMA(1, 0, At, B0); PG8_MMA(1, 1, At, B1); PG8_BAR; PG8_SCHED;
            PG8_LDB(B0, 1, 0); PG8_LDB(B1, 1, 1); PG8_SCHED; PG8_LDA(At, 1, 0); PG8_STAGE(PG8_SA(0, 1), a2 + hstep, voffA);
            PG8_WAIT_V(8); PG8_WAIT_L(0); PG8_BAR; PG8_MMA(0, 0, At, B0); PG8_MMA(0, 1, At, B1); PG8_BAR; PG8_SCHED;
            PG8_LDA(At, 1, 1); PG8_STAGE(PG8_SB(1, 0), b3, voffB); PG8_STAGE(PG8_SB(1, 1), b3 + hstep, voffB); PG8_STAGE(PG8_SA(1, 0), a3, voffA);
            PG8_WAIT_V(8); PG8_WAIT_L(0); PG8_BAR; PG8_MMA(1, 0, At, B0); PG8_MMA(1, 1, At, B1); PG8_BAR; PG8_SCHED;
            } else {
            PG8_LDB(B0, 0, 0); PG8_SCHED; PG8_LDA(At, 0, 0); PG8_STAGE(PG8_SA(1, 1), a1 + hstep, voffA);
            PG8_WAIT_L(8); PG8_BAR; PG8_WAIT_L(0); PG8_MMA(0, 0, At, B0); PG8_BAR; PG8_SCHED;
            PG8_LDB(B1, 0, 1); PG8_STAGE(PG8_SB(0, 0), b2, voffB);
            PG8_BAR; PG8_WAIT_L(0); PG8_MMA(0, 1, At, B1); PG8_BAR;
            PG8_LDA(At, 0, 1); PG8_STAGE(PG8_SA(0, 0), a2, voffA);
            PG8_BAR; PG8_WAIT_L(0); PG8_MMA(1, 0, At, B0); PG8_BAR; PG8_SCHED;
            PG8_STAGE(PG8_SB(0, 1), b2 + hstep, voffB);
            PG8_WAIT_V(6); PG8_BAR; PG8_MMA(1, 1, At, B1); PG8_BAR;
            PG8_LDB(B0, 1, 0); PG8_SCHED; PG8_LDA(At, 1, 0); PG8_STAGE(PG8_SA(0, 1), a2 + hstep, voffA);
            PG8_WAIT_L(8); PG8_BAR; PG8_WAIT_L(0); PG8_MMA(0, 0, At, B0); PG8_BAR; PG8_SCHED;
            PG8_LDB(B1, 1, 1); PG8_STAGE(PG8_SB(1, 0), b3, voffB);
            PG8_BAR; PG8_WAIT_L(0); PG8_MMA(0, 1, At, B1); PG8_BAR;
            PG8_LDA(At, 1, 1); PG8_STAGE(PG8_SA(1, 0), a3, voffA);
            PG8_BAR; PG8_WAIT_L(0); PG8_MMA(1, 0, At, B0); PG8_BAR; PG8_SCHED;
            PG8_STAGE(PG8_SB(1, 1), b3 + hstep, voffB);
            PG8_WAIT_V(6); PG8_BAR; PG8_MMA(1, 1, At, B1); PG8_BAR;
            }
        }
        PG8_TS(0);
        if constexpr (FP8) { asm volatile("s_nop 15\n\ts_nop 15" ::: "memory"); }
        if constexpr (ALIGN_EPI) { if (wr == 0) PG8_BAR; }
        if constexpr (!Epi::AFTER_DRAIN) { E(acc, cur, wr, wc, fr, fq); S.done(cur); }
        PG8_TS(1);
        if (!has_next) break;
#pragma unroll
        for (int a = 0; a < 2; ++a)
#pragma unroll
            for (int b = 0; b < 2; ++b)
#pragma unroll
                for (int m = 0; m < 4; ++m)
#pragma unroll
                    for (int n = 0; n < 2; ++n) acc[a][b][m][n] = (f32x4){0.f, 0.f, 0.f, 0.f};
        cur = nxt; cA = nA; cB = nB; ++ui;
        if constexpr (ALIGN_EPI) { if (wr == 1) PG8_BAR; }
    }
#ifdef PG8_PROF
    if (g.prof && blockIdx.x == 0 && tid == 0) { volatile PG8_LAS unsigned* p_ = (volatile PG8_LAS unsigned*)(lds + 143744); pg8_prof[0] = p_[0]; pg8_prof[1] = p_[1]; pg8_prof[2] = (unsigned long long)(ui + 1); }
#endif
    PG8_WAIT_V(0);
    if constexpr (!ALIGN_EPI) { if (wr == 0) PG8_BAR; }
    PG8_BAR;
    if constexpr (Epi::AFTER_DRAIN) { E.fused(acc, cur, wr, wc, fr, fq, lds, wid, lane); S.done(cur); }
#undef PG8_SA
#undef PG8_SB
#undef PG8_STAGE
#undef PG8_LD8
#undef PG8_LDA
#undef PG8_LDB
#undef PG8_MMA
#undef PG8_WAIT_V
#undef PG8_WAIT_L
#undef PG8_BAR
#undef PG8_SCHED
}
}

constexpr int D_MODEL = 1024, BATCH = 2, SEQ = 8192, MTOK = BATCH * SEQ, MEM_LEN = 256, MEMROWS = BATCH * MEM_LEN;
constexpr int IN_COLS = 9984, OFF_AQ = 0, OFF_AK = 1536, OFF_AV = 3072, OFF_R = 4608, OFF_CQ = 6400, OFF_GATE = 6912;
constexpr int RW = 512;
constexpr int N_EXPERTS = 32, TOP_K = 4, D_FF = 1024, MOE_ROWS = 256;
constexpr int MAX_BLOCKS = MTOK * TOP_K / MOE_ROWS + N_EXPERTS;
constexpr int MAX_SLOTS = MAX_BLOCKS * MOE_ROWS;
constexpr bool MRG_FP8 = false; constexpr float M8_SCALE = 16.0f;
constexpr float NORM_EPS = 1e-6f, R_GN_EPS = 64e-5f;
constexpr float LOG2E = 1.4426950408889634f;
constexpr float QSCALE = 0.08838834764831845f * LOG2E;

namespace pg8 {
__device__ __forceinline__ float bf_lo(unsigned w) { return __builtin_bit_cast(float, w << 16); }
__device__ __forceinline__ float bf_hi(unsigned w) { return __builtin_bit_cast(float, w & 0xffff0000u); }
__device__ __forceinline__ float sigmoidf_fast(float x) { return __builtin_amdgcn_rcpf(1.0f + __builtin_amdgcn_exp2f(-1.4426950408889634f * x)); }

constexpr bool WT_STORES = false;
__device__ __forceinline__ void st16(const __amdgpu_buffer_rsrc_t r, void* base, size_t off_bytes, u32x4 w) {
    if constexpr (WT_STORES) __builtin_amdgcn_raw_buffer_store_b128(w, r, (unsigned)off_bytes, 0, 16);
    else *(u32x4*)((unsigned char*)base + off_bytes) = w;
}
struct EpiZ {
    static constexpr bool PERM = true, AFTER_DRAIN = false;
    bf16_t* O; const float* bgate; const float* aqg; const float* akg; const float* cqg; const float* cs;
    bf16_t* KV; const float* ckg;
    PG8_LAS float* P;
    __device__ __forceinline__ void operator()(const f32x4 (&acc)[2][2][4][2], const Unit& u, int wr, int wc, int fr, int fq) const {
        const bool mem = u.pm >= 64; const int pnl = mem ? u.pn - 39 : u.pn, ldc = mem ? 1024 : IN_COLS;
        bf16_t* const Ob = mem ? KV - (size_t)64 * BM * 1024 : O;
        const __amdgpu_buffer_rsrc_t ors = __builtin_amdgcn_make_buffer_rsrc((void*)Ob, (short)0, 0x7fffffff, 0x00020000);
        const int row0 = u.pm * BM + wr * 64 + fr, col0 = pnl * BM + wc * 32 + 8 * fq;
        const int cls = mem ? ((pnl < 2) ? 3 : 0) : (pnl < 6) ? 1 : (pnl < 12) ? 2 : (pnl == 25 || pnl == 26) ? 3 : (pnl >= 27) ? 4 : 0;
        if (cls >= 1 && cls <= 3) {
            const int go = wc * 32 + 8 * fq;
            const f32x4 q0 = *(const f32x4*)(aqg + go), q1 = *(const f32x4*)(aqg + go + 4), k0 = *(const f32x4*)(akg + go), k1 = *(const f32x4*)(akg + go + 4), x0 = *(const f32x4*)(cqg + go), x1 = *(const f32x4*)(cqg + go + 4);
            const f32x4 m0 = *(const f32x4*)(ckg + go), m1 = *(const f32x4*)(ckg + go + 4);
            const f32x4 g0 = mem ? m0 : (cls == 1) ? q0 : (cls == 2) ? k0 : x0, g1 = mem ? m1 : (cls == 1) ? q1 : (cls == 2) ? k1 : x1;
#pragma unroll
            for (int ai = 0; ai < 2; ++ai)
#pragma unroll
                for (int m = 0; m < 4; ++m)
#pragma unroll
                    for (int bj = 0; bj < 2; ++bj) { const f32x4 a = acc[ai][bj][m][0], b = acc[ai][bj][m][1];
                        float s = ((a[0] * a[0] + a[1] * a[1]) + (a[2] * a[2] + a[3] * a[3])) + ((b[0] * b[0] + b[1] * b[1]) + (b[2] * b[2] + b[3] * b[3]));
                        s += __shfl_xor(s, 16); s += __shfl_xor(s, 32);
                        if (fq == 0) P[((ai * HALF + wr * 64 + m * 16 + fr) * 2 + bj) * 4 + wc] = s; }
            asm volatile("s_waitcnt lgkmcnt(0)" ::: "memory"); __builtin_amdgcn_s_barrier(); asm volatile("" ::: "memory");
#pragma unroll
            for (int ai = 0; ai < 2; ++ai)
#pragma unroll
                for (int m = 0; m < 4; ++m) { const int rl = ai * HALF + wr * 64 + m * 16 + fr, row = u.pm * BM + rl;
                    f32x4 c0 = {0.f, 0.f, 0.f, 0.f}, c1 = c0, c2 = c0, c3 = c0;
                    if (cls != 3 && wc == 0) { const f32x4* cp = (const f32x4*)(cs + (size_t)row * 32 + 16 * (fq & 1)); c0 = cp[0]; c1 = cp[1]; c2 = cp[2]; c3 = cp[3]; }
#pragma unroll
                    for (int bj = 0; bj < 2; ++bj) { const f32x4 pv = *(const PG8_LAS f32x4*)(P + (rl * 2 + bj) * 4);
                        const float rstd = __builtin_amdgcn_rsqf(((pv[0] + pv[1]) + (pv[2] + pv[3])) * (1.0f / 128.0f) + NORM_EPS);
                        f32x4 v0 = acc[ai][bj][m][0] * rstd * g0, v1 = acc[ai][bj][m][1] * rstd * g1;
                        if (cls != 3 && wc == 0) {
                            f32x4 p0, p1;
#pragma unroll
                            for (int j = 0; j < 4; ++j) { p0[j] = __shfl_xor(v0[j], 32); p1[j] = __shfl_xor(v1[j], 32); }
                            const float sg = (fq < 2) ? -1.0f : 1.0f;
                            v0[0] = v0[0] * c0[0] + sg * p0[0] * c0[1]; v0[1] = v0[1] * c0[2] + sg * p0[1] * c0[3]; v0[2] = v0[2] * c1[0] + sg * p0[2] * c1[1]; v0[3] = v0[3] * c1[2] + sg * p0[3] * c1[3];
                            v1[0] = v1[0] * c2[0] + sg * p1[0] * c2[1]; v1[1] = v1[1] * c2[2] + sg * p1[1] * c2[3]; v1[2] = v1[2] * c3[0] + sg * p1[2] * c3[1]; v1[3] = v1[3] * c3[2] + sg * p1[3] * c3[3]; }
                        u32x4 w; w.x = cvt_pk_bf16(v0[0], v0[1]); w.y = cvt_pk_bf16(v0[2], v0[3]); w.z = cvt_pk_bf16(v1[0], v1[1]); w.w = cvt_pk_bf16(v1[2], v1[3]);
                        st16(ors, Ob, ((size_t)row * ldc + col0 + bj * HALF) * 2, w); } }
            return;
        }
        const bool gate = cls == 4;
        f32x4 bv[2][2];
#pragma unroll
        for (int bj = 0; bj < 2; ++bj)
#pragma unroll
            for (int n = 0; n < 2; ++n) bv[bj][n] = gate ? *(const f32x4*)(bgate + (col0 - OFF_GATE) + bj * HALF + 4 * n) : (f32x4){0.f, 0.f, 0.f, 0.f};
#pragma unroll
        for (int ai = 0; ai < 2; ++ai)
#pragma unroll
            for (int m = 0; m < 4; ++m) { const size_t rowo = ((size_t)(row0 + ai * HALF + m * 16) * ldc + col0) * 2;
#pragma unroll
                for (int bj = 0; bj < 2; ++bj) { f32x4 v0 = acc[ai][bj][m][0] + bv[bj][0], v1 = acc[ai][bj][m][1] + bv[bj][1];
                    if (gate) {
#pragma unroll
                        for (int j = 0; j < 4; ++j) { v0[j] = sigmoidf_fast(v0[j]); v1[j] = sigmoidf_fast(v1[j]); } }
                    u32x4 w; w.x = cvt_pk_bf16(v0[0], v0[1]); w.y = cvt_pk_bf16(v0[2], v0[3]); w.z = cvt_pk_bf16(v1[0], v1[1]); w.w = cvt_pk_bf16(v1[2], v1[3]);
                    st16(ors, Ob, rowo + bj * HALF * 2, w); } }
    }
};

template <int SET> struct ZOrder {
    StaticOrder so; int nz;
    __device__ void init(int G_, int c_) { so.init(MTOK, (SET == 0 ? 15 : 24) * BM, G_, c_); nz = 64 * (SET == 0 ? 15 : 24); }
    __device__ __forceinline__ bool next(int i, Unit& u) const {
        if (so.next(i, u)) { const int t = u.pn;
            if (SET == 0) u.pn = t + 12; else u.pn = (t < 12) ? t : t + 15;
            return true; }
        if (SET == 0) { const long L = (long)i * so.G + so.c - nz; if (L >= 0 && L < 8) { u.pm = 64 + (int)(L & 1); u.pn = 39 + (int)(L >> 1); return true; } }
        return false;
    }
    __device__ __forceinline__ void a_ready(const Unit&) const {}
    __device__ __forceinline__ void done(const Unit&) const {}
};
struct EpiGate3 {
    static constexpr bool PERM = true, AFTER_DRAIN = false;
    const bf16_t* Z; bf16_t* mergedb;
    __device__ __forceinline__ void mid(f32x4 (&acc)[2][2][4][2], const Unit& u, int t, int wr, int wc, int fr, int fq) const {
        int fr_ = fr; asm volatile("" : "+v"(fr_));
        const int row0 = u.pm * BM + wr * 64 + fr_, col0 = u.pn * BM + wc * 32 + 8 * fq, ba = (t >> 3) - 1;
        const bf16_t* gp = Z + OFF_GATE + ba * D_MODEL + col0;
#pragma unroll
        for (int ai = 0; ai < 2; ++ai)
#pragma unroll
            for (int m = 0; m < 4; ++m) { const bf16_t* rp = gp + (size_t)(row0 + ai * HALF + m * 16) * IN_COLS;
#pragma unroll
                for (int bj = 0; bj < 2; ++bj) { const u32x4 ga = *(const u32x4*)(rp + bj * HALF), gb = *(const u32x4*)(rp + D_MODEL + bj * HALF);
                    f32x4 r0, r1;
                    r0[0] = bf_lo(ga[0]) * __builtin_amdgcn_rcpf(bf_lo(gb[0])); r0[1] = bf_hi(ga[0]) * __builtin_amdgcn_rcpf(bf_hi(gb[0])); r0[2] = bf_lo(ga[1]) * __builtin_amdgcn_rcpf(bf_lo(gb[1])); r0[3] = bf_hi(ga[1]) * __builtin_amdgcn_rcpf(bf_hi(gb[1]));
                    r1[0] = bf_lo(ga[2]) * __builtin_amdgcn_rcpf(bf_lo(gb[2])); r1[1] = bf_hi(ga[2]) * __builtin_amdgcn_rcpf(bf_hi(gb[2])); r1[2] = bf_lo(ga[3]) * __builtin_amdgcn_rcpf(bf_lo(gb[3])); r1[3] = bf_hi(ga[3]) * __builtin_amdgcn_rcpf(bf_hi(gb[3]));
                    acc[ai][bj][m][0] *= r0; acc[ai][bj][m][1] *= r1; }
                if (m == 3) asm volatile("" ::: "memory"); }
    }
    __device__ __forceinline__ void operator()(const f32x4 (&acc)[2][2][4][2], const Unit& u, int wr, int wc, int fr, int fq) const {
        const int row0 = u.pm * BM + wr * 64 + fr, col0 = u.pn * BM + wc * 32 + 8 * fq;
        u32x4 gzr[2][4][2];
#pragma unroll
        for (int ai = 0; ai < 2; ++ai)
#pragma unroll
            for (int m = 0; m < 4; ++m)
#pragma unroll
                for (int bj = 0; bj < 2; ++bj) gzr[ai][m][bj] = *(const u32x4*)(Z + (size_t)(row0 + ai * HALF + m * 16) * IN_COLS + OFF_GATE + 2 * D_MODEL + col0 + bj * HALF);
#pragma unroll
        for (int ai = 0; ai < 2; ++ai)
#pragma unroll
            for (int m = 0; m < 4; ++m) { const int row = row0 + ai * HALF + m * 16;
#pragma unroll
                for (int bj = 0; bj < 2; ++bj) { const int col = col0 + bj * HALF; const u32x4 gz = gzr[ai][m][bj];
                    f32x4 g0, g1;
                    g0[0] = bf_lo(gz[0]); g0[1] = bf_hi(gz[0]); g0[2] = bf_lo(gz[1]); g0[3] = bf_hi(gz[1]); g1[0] = bf_lo(gz[2]); g1[1] = bf_hi(gz[2]); g1[2] = bf_lo(gz[3]); g1[3] = bf_hi(gz[3]);
                    const f32x4 v0 = acc[ai][bj][m][0] * g0, v1 = acc[ai][bj][m][1] * g1;
                    if constexpr (MRG_FP8) { unsigned w0 = 0, w1 = 0;
                        w0 = __builtin_amdgcn_cvt_pk_fp8_f32(v0[0] * M8_SCALE, v0[1] * M8_SCALE, w0, false); w0 = __builtin_amdgcn_cvt_pk_fp8_f32(v0[2] * M8_SCALE, v0[3] * M8_SCALE, w0, true);
                        w1 = __builtin_amdgcn_cvt_pk_fp8_f32(v1[0] * M8_SCALE, v1[1] * M8_SCALE, w1, false); w1 = __builtin_amdgcn_cvt_pk_fp8_f32(v1[2] * M8_SCALE, v1[3] * M8_SCALE, w1, true);
                        *(unsigned long long*)((unsigned char*)mergedb + (size_t)row * D_MODEL + col) = (unsigned long long)w0 | ((unsigned long long)w1 << 32); }
                    else { u32x4 w; w.x = cvt_pk_bf16(v0[0], v0[1]); w.y = cvt_pk_bf16(v0[2], v0[3]); w.z = cvt_pk_bf16(v1[0], v1[1]); w.w = cvt_pk_bf16(v1[2], v1[3]);
                        *(u32x4*)(mergedb + (size_t)row * D_MODEL + col) = w; } } }
    }
};
template <> struct EpiHasMid<EpiGate3> { static constexpr bool v = true; };
struct EpiGate3NoMid : EpiGate3 {};
struct EpiResF32 {
    static constexpr bool PERM = true, AFTER_DRAIN = false;
    const float* base; float* out; int ldc;
    __device__ __forceinline__ void operator()(const f32x4 (&acc)[2][2][4][2], const Unit& u, int wr, int wc, int fr, int fq) const {
        const int row0 = u.pm * BM + wr * 64 + fr, col0 = u.pn * BM + wc * 32 + 8 * fq;
#pragma unroll
        for (int ai = 0; ai < 2; ++ai) {
            f32x4 xr[4][2][2];
#pragma unroll
            for (int m = 0; m < 4; ++m)
#pragma unroll
                for (int bj = 0; bj < 2; ++bj) { const float* bp = base + (size_t)(row0 + ai * HALF + m * 16) * ldc + col0 + bj * HALF; xr[m][bj][0] = *(const f32x4*)bp; xr[m][bj][1] = *(const f32x4*)(bp + 4); }
#pragma unroll
            for (int m = 0; m < 4; ++m)
#pragma unroll
                for (int bj = 0; bj < 2; ++bj) { float* op = out + (size_t)(row0 + ai * HALF + m * 16) * ldc + col0 + bj * HALF;
                    *(f32x4*)op = xr[m][bj][0] + acc[ai][bj][m][0]; *(f32x4*)(op + 4) = xr[m][bj][1] + acc[ai][bj][m][1]; }
            asm volatile("" ::: "memory"); }
    }
};
struct EpiSwiGLU {
    static constexpr bool PERM = true, AFTER_DRAIN = false;
    const float* b1; bf16_t* H;
    __device__ __forceinline__ void operator()(const f32x4 (&acc)[2][2][4][2], const Unit& u, int wr, int wc, int fr, int fq) const {
        const int e = u.pn >> 3, pnl = u.pn & 7;
        const int row0 = u.pm * BM + wr * 64 + fr, ac = pnl * HALF + wc * 32 + 8 * fq;
        const float* bg = b1 + (size_t)e * 2 * D_FF + ac; const float* bl = bg + D_FF;
        const f32x4 bg0 = *(const f32x4*)bg, bg1 = *(const f32x4*)(bg + 4), bl0 = *(const f32x4*)bl, bl1 = *(const f32x4*)(bl + 4);
#pragma unroll
        for (int ai = 0; ai < 2; ++ai)
#pragma unroll
            for (int m = 0; m < 4; ++m) { const int row = row0 + ai * HALF + m * 16;
                float a[8];
#pragma unroll
                for (int n = 0; n < 2; ++n) { const f32x4 ug = acc[ai][0][m][n] + (n ? bg1 : bg0), ul = acc[ai][1][m][n] + (n ? bl1 : bl0);
#pragma unroll
                    for (int j = 0; j < 4; ++j) { const float g = fminf(ug[j], 7.0f), l = fminf(fmaxf(ul[j], -7.0f), 7.0f);
                        a[4 * n + j] = g * sigmoidf_fast(1.702f * g) * (l + 1.0f); } }
                unsigned w0 = 0, w1 = 0;
                w0 = __builtin_amdgcn_cvt_pk_fp8_f32(a[0] * 8.0f, a[1] * 8.0f, w0, false); w0 = __builtin_amdgcn_cvt_pk_fp8_f32(a[2] * 8.0f, a[3] * 8.0f, w0, true);
                w1 = __builtin_amdgcn_cvt_pk_fp8_f32(a[4] * 8.0f, a[5] * 8.0f, w1, false); w1 = __builtin_amdgcn_cvt_pk_fp8_f32(a[6] * 8.0f, a[7] * 8.0f, w1, true);
                *(unsigned long long*)((unsigned char*)H + (size_t)row * D_FF + ac) = (unsigned long long)w0 | ((unsigned long long)w1 << 32); }
    }
};
struct EpiMoeOut {
    static constexpr bool PERM = true, AFTER_DRAIN = false;
    const float* b2; const float* rowgate; bf16_t* Y;
    __device__ __forceinline__ void operator()(const f32x4 (&acc)[2][2][4][2], const Unit& u, int wr, int wc, int fr, int fq) const {
        const int e = u.pn >> 2, pnl = u.pn & 3;
        const int row0 = u.pm * BM + wr * 64 + fr, col0 = pnl * BM + wc * 32 + 8 * fq;
        float gtr[2][4]; f32x4 bb[2][2];
#pragma unroll
        for (int ai = 0; ai < 2; ++ai)
#pragma unroll
            for (int m = 0; m < 4; ++m) gtr[ai][m] = rowgate[row0 + ai * HALF + m * 16];
#pragma unroll
        for (int bj = 0; bj < 2; ++bj) { const float* bp = b2 + (size_t)e * D_MODEL + col0 + bj * HALF; bb[bj][0] = *(const f32x4*)bp; bb[bj][1] = *(const f32x4*)(bp + 4); }
#pragma unroll
        for (int ai = 0; ai < 2; ++ai)
#pragma unroll
            for (int m = 0; m < 4; ++m) { const int row = row0 + ai * HALF + m * 16; const float gt = gtr[ai][m];
#pragma unroll
                for (int bj = 0; bj < 2; ++bj) { const int col = col0 + bj * HALF;
                    const f32x4 v0 = (acc[ai][bj][m][0] + bb[bj][0]) * gt, v1 = (acc[ai][bj][m][1] + bb[bj][1]) * gt;
                    unsigned w0 = 0, w1 = 0;
                    w0 = __builtin_amdgcn_cvt_pk_fp8_f32(v0[0] * 16.0f, v0[1] * 16.0f, w0, false); w0 = __builtin_amdgcn_cvt_pk_fp8_f32(v0[2] * 16.0f, v0[3] * 16.0f, w0, true);
                    w1 = __builtin_amdgcn_cvt_pk_fp8_f32(v1[0] * 16.0f, v1[1] * 16.0f, w1, false); w1 = __builtin_amdgcn_cvt_pk_fp8_f32(v1[2] * 16.0f, v1[3] * 16.0f, w1, true);
                    *(unsigned long long*)((unsigned char*)Y + (size_t)row * D_MODEL + col) = (unsigned long long)w0 | ((unsigned long long)w1 << 32); } }
    }
};
struct MoeOrder {
    const PG8_LAS int* tab;
    int NT, G, c;
    __device__ __forceinline__ bool next(int i, Unit& u) const {
        const int nblk = tab[0], nu = nblk * NT; const long L0 = (long)i * G + c; if (L0 >= (long)nu) return false;
        int L = (int)L0; { const int q = nu / NXCD, r = nu % NXCD, xcd = L % NXCD, off = L / NXCD; L = (xcd < r ? xcd * (q + 1) : r * (q + 1) + (xcd - r) * q) + off; }
        const int blk = L / NT, pnl = L % NT; u.pm = blk; u.pn = tab[1 + blk] * NT + pnl; return true;
    }
    __device__ __forceinline__ void a_ready(const Unit&) const {}
    __device__ __forceinline__ void done(const Unit&) const {}
};
}

namespace swa {
constexpr int D = 128;
constexpr float SCALE = 0.08838834764831845f;
constexpr float THR = 8.f;
constexpr int NW = 8, QBLK = 32, KVBLK = 64, QB = NW * QBLK;
constexpr int SHM_V = KVBLK * D * 2, SHM_K = KVBLK * D * 2;
constexpr int LDS_BYTES = 2 * SHM_V + 2 * SHM_K + NW * 64 * 4;
using bf16 = unsigned short;
typedef short bf16x8 __attribute__((ext_vector_type(8)));
typedef short s16x4 __attribute__((ext_vector_type(4)));
typedef float f32x16 __attribute__((ext_vector_type(16)));
typedef float f32x4 __attribute__((ext_vector_type(4)));
typedef unsigned u32x4 __attribute__((ext_vector_type(4)));
template <class A, class Bt> struct same_t { static constexpr bool v = false; };
template <class A> struct same_t<A, A> { static constexpr bool v = true; };
#define KSWZ(row, colB) ((row) * 256 + ((colB) ^ (((row) & 7) << 4)))
#define SBAR() __builtin_amdgcn_sched_barrier(0)
__device__ __forceinline__ int v_st(int k, int c) { const int kk = (k & ~0xC) | ((k & 4) << 1) | ((k & 8) >> 1); return ((kk >> 3) * 4 + (c >> 5)) * 512 + ((kk & 7) * 32 + (c & 31)) * 2; }
__device__ __forceinline__ int v_rd_base(int lane) { return ((lane & 3) << 3) | (((lane >> 2) & 3) << 6) | (((lane >> 4) & 1) << 5) | (((lane >> 5) & 1) << 8); }
constexpr int v_rd_off(int d0, int ks, int half) { return d0 * 512 + ks * 4096 + half * 2048; }
__device__ __forceinline__ int crow(int r, int hi) { return (r & 3) + 8 * (r >> 2) + 4 * hi; }
__device__ __forceinline__ unsigned cvtpk(float lo, float hi) {
    unsigned r; asm volatile("v_cvt_pk_bf16_f32 %0, %1, %2" : "=v"(r) : "v"(lo), "v"(hi)); return r;
}
__device__ __forceinline__ bf16x8 pack8(f32x4 a, f32x4 b) {
    u32x4 w = {cvtpk(a[0], a[1]), cvtpk(a[2], a[3]), cvtpk(b[0], b[1]), cvtpk(b[2], b[3])};
    return *reinterpret_cast<bf16x8*>(&w);
}
template <class T> __device__ __forceinline__ bf16x8 load8(const T* p) {
    if constexpr (same_t<T, float>::v) { return pack8(*(const f32x4*)p, *(const f32x4*)(p + 4)); }
    else { return *reinterpret_cast<const bf16x8*>(p); }
}
__device__ __forceinline__ void mask_tile(f32x16& p0, f32x16& p1, int dq, unsigned W) {
    const float NEG = -__builtin_inff();
#pragma unroll
    for (int r = 0; r < 16; ++r) {
        const int c = (r & 3) + 8 * (r >> 2);
        if ((unsigned)(dq - c) >= W) p0[r] = NEG;
        if ((unsigned)(dq - c - 32) >= W) p1[r] = NEG;
    }
}
__device__ __forceinline__ void partialSM(f32x16& p0, f32x16& p1, float& m_reg, float& mn, float& alpha) {
    float pmax = p0[0]; for (int r = 1; r < 16; ++r) pmax = fmaxf(pmax, p0[r]); for (int r = 0; r < 16; ++r) pmax = fmaxf(pmax, p1[r]);
    { auto rr = __builtin_amdgcn_permlane32_swap(__float_as_uint(pmax), __float_as_uint(pmax), false, false);
      pmax = fmaxf(__uint_as_float(rr[0]), __uint_as_float(rr[1])); }
    constexpr float C2 = 1.4426950408889634f * SCALE;
    if (__builtin_expect(__all((pmax - m_reg) * SCALE <= THR), 1)) { mn = m_reg; alpha = 1.f; }
    else { mn = fmaxf(m_reg, pmax); alpha = __builtin_amdgcn_exp2f((m_reg - mn) * C2); m_reg = mn; }
    const float mnL = -mn * C2;
    for (int r = 0; r < 16; ++r) p0[r] = fmaf(p0[r], C2, mnL); for (int r = 0; r < 16; ++r) p1[r] = fmaf(p1[r], C2, mnL);
    for (int r = 0; r < 16; ++r) p0[r] = __builtin_amdgcn_exp2f(p0[r]);
}
__device__ __forceinline__ void finishSM(f32x16& p0, f32x16& p1, float alpha, float& l_reg, bf16x8& pa0, bf16x8& pa1, bf16x8& pa2, bf16x8& pa3) {
    for (int r = 0; r < 16; ++r) p1[r] = __builtin_amdgcn_exp2f(p1[r]);
    float ps = 0; for (int r = 0; r < 16; ++r) ps += p0[r]; for (int r = 0; r < 16; ++r) ps += p1[r];
    { auto rr = __builtin_amdgcn_permlane32_swap(__float_as_uint(ps), __float_as_uint(ps), false, false);
      ps = __uint_as_float(rr[0]) + __uint_as_float(rr[1]); }
    l_reg = l_reg * alpha + ps;
#define PK4(P, B_, OUT) do { unsigned a0 = cvtpk(P[B_+0], P[B_+1]), a1 = cvtpk(P[B_+2], P[B_+3]);                          \
        unsigned b0 = cvtpk(P[B_+4], P[B_+5]), b1 = cvtpk(P[B_+6], P[B_+7]);                                             \
        auto r0 = __builtin_amdgcn_permlane32_swap(a0, b0, false, false); auto r1 = __builtin_amdgcn_permlane32_swap(a1, b1, false, false); \
        u32x4 w = {r0[0], r1[0], r0[1], r1[1]}; OUT = *reinterpret_cast<bf16x8*>(&w); } while (0)
    PK4(p0, 0, pa0); PK4(p0, 8, pa1); PK4(p1, 0, pa2); PK4(p1, 8, pa3);
#undef PK4
}
template <int KB, bool SK>
__device__ __forceinline__ void qkt(f32x16& p0, f32x16& p1, const char* K_lds, int r32, int hi, const bf16x8* qr, bool act) {
    if (SK && !act) { const float NEG = -__builtin_inff();
#pragma unroll
        for (int r = 0; r < 16; ++r) { p0[r] = NEG; p1[r] = NEG; } return; }
    p0 = f32x16{}; p1 = f32x16{};
    const char* kb[4];
#pragma unroll
    for (int dd = 0; dd < 4; ++dd) kb[dd] = K_lds + KB * SHM_K + KSWZ(r32, (dd * 16 + hi * 8) * 2);
#pragma unroll
    for (int d0 = 0; d0 < 8; ++d0) { const char* a = kb[d0 & 3] + (d0 >> 2) * 128;
        bf16x8 b0 = *reinterpret_cast<const bf16x8*>(a);
        bf16x8 b1 = *reinterpret_cast<const bf16x8*>(a + 32 * 256);
        p0 = __builtin_amdgcn_mfma_f32_32x32x16_bf16(b0, qr[d0], p0, 0, 0, 0);
        p1 = __builtin_amdgcn_mfma_f32_32x32x16_bf16(b1, qr[d0], p1, 0, 0, 0); }
}
template <int VB, bool SK>
__device__ __forceinline__ void pv_tile(f32x16* o, int vb0, bf16x8 pa0, bf16x8 pa1, bf16x8 pa2, bf16x8 pa3, bool act) {
    if (SK && !act) return;
#define TRRD(dst, off) asm volatile("ds_read_b64_tr_b16 %0, %1 offset:%2" : "=&v"(dst) : "v"(vb0), "i"(off) : "memory")
#define PV_D0(d0) do { s16x4 l0, l1, l2, l3, h0, h1, h2, h3; constexpr int b_ = VB * SHM_V + v_rd_off(d0, 0, 0);     \
        TRRD(l0, b_); TRRD(h0, b_ + 2048); TRRD(l1, b_ + 4096); TRRD(h1, b_ + 6144); TRRD(l2, b_ + 8192); TRRD(h2, b_ + 10240); TRRD(l3, b_ + 12288); TRRD(h3, b_ + 14336); \
        asm volatile("s_waitcnt lgkmcnt(0)" ::: "memory"); SBAR();                 \
        o[d0] = __builtin_amdgcn_mfma_f32_32x32x16_bf16(pa0, (bf16x8){l0[0], l0[1], l0[2], l0[3], h0[0], h0[1], h0[2], h0[3]}, o[d0], 0, 0, 0);   \
        o[d0] = __builtin_amdgcn_mfma_f32_32x32x16_bf16(pa1, (bf16x8){l1[0], l1[1], l1[2], l1[3], h1[0], h1[1], h1[2], h1[3]}, o[d0], 0, 0, 0);   \
        o[d0] = __builtin_amdgcn_mfma_f32_32x32x16_bf16(pa2, (bf16x8){l2[0], l2[1], l2[2], l2[3], h2[0], h2[1], h2[2], h2[3]}, o[d0], 0, 0, 0);   \
        o[d0] = __builtin_amdgcn_mfma_f32_32x32x16_bf16(pa3, (bf16x8){l3[0], l3[1], l3[2], l3[3], h3[0], h3[1], h3[2], h3[3]}, o[d0], 0, 0, 0); } while (0)
    PV_D0(0); PV_D0(1); PV_D0(2); PV_D0(3);
#undef PV_D0
#undef TRRD
}

struct BlockRef { const bf16* Q; const bf16* K; const bf16* V; bf16* O; float* LSE; int QS, KS, OS, LS, P0, skv, W; };
struct Seam { bf16x8 qr[8]; bf16x8 st_v0, st_v1, st_k0, st_k1; };
__device__ __forceinline__ int swa_jlo(int P0, int W) { const int lowk = P0 - W + 1; return lowk > 0 ? lowk / KVBLK : 0; }
#define LD8(p) (*reinterpret_cast<const bf16x8*>(p))
#define ROW(p, k0, rr, RS) ((p) + (size_t)((k0) + (rr)) * (RS) + sc)
#define VMW() asm volatile("s_waitcnt vmcnt(0)" ::: "memory")
#define VMWN(n) asm volatile("s_waitcnt vmcnt(%0)" :: "i"(n) : "memory")
#define SLOAD_H(Kp, Vp, k0, RS) do { const char* kb_ = (const char*)(Kp) + (size_t)(k0) * (size_t)(RS) * 2; const char* vb_ = (const char*)(Vp) + (size_t)(k0) * (size_t)(RS) * 2;  \
                         const unsigned oa_ = (unsigned)(sr * (RS) + sc) * 2u, ob_ = oa_ + (unsigned)(RS) * 64u;                                    \
                         S.st_v0 = LD8(vb_ + oa_); S.st_v1 = LD8(vb_ + ob_); S.st_k0 = LD8(kb_ + oa_); S.st_k1 = LD8(kb_ + ob_); } while (0)
#define SWRITE_HK(bf) do { *(bf16x8*)(K_lds + (bf) * SHM_K + kws) = S.st_k0; *(bf16x8*)(K_lds + (bf) * SHM_K + kws + 32 * 256) = S.st_k1; } while (0)
#define SWRITE_HV(bf) do { *(bf16x8*)(V_lds + (bf) * SHM_V + vst0) = S.st_v0; *(bf16x8*)(V_lds + (bf) * SHM_V + vst1) = S.st_v1; } while (0)
#define SWRITE_H(bf) do { SWRITE_HV(bf); SWRITE_HK(bf); } while (0)
__device__ __forceinline__ void swa_prime(const BlockRef& cur, char* lds, Seam& S) {
    int tid_ = threadIdx.x; asm volatile("" : "+v"(tid_));
    const int tid = tid_, wid = __builtin_amdgcn_readfirstlane(tid >> 6), lane = tid & 63, r32 = lane & 31, hi = lane >> 5;
    const int sr = tid >> 4, sc = (tid & 15) * 8, kws = KSWZ(sr, sc * 2); char* K_lds = lds + 2 * SHM_V;
    const int kb0 = swa_jlo(cur.P0, cur.W) * KVBLK;
    { const char* qb_ = (const char*)cur.Q + (size_t)(wid * QBLK) * (size_t)cur.QS * 2; const unsigned qo_ = (unsigned)(r32 * cur.QS + hi * 8) * 2u;
      for (int d0 = 0; d0 < 8; ++d0) S.qr[d0] = LD8(qb_ + qo_ + d0 * 32); }
    SLOAD_H(cur.K, cur.V, kb0, cur.KS); VMW(); SWRITE_HK(0);
    __syncthreads();
}
__device__ __forceinline__ void swa_block(const BlockRef& cur, const BlockRef& nxt, char* lds, Seam& S) {
    int tid_ = threadIdx.x; asm volatile("" : "+v"(tid_));
    const int tid = tid_, wid = __builtin_amdgcn_readfirstlane(tid >> 6), lane = tid & 63, r32 = lane & 31, hi = lane >> 5;
    const int W = cur.W, skv = cur.skv;
    const int j_lo = swa_jlo(cur.P0, W);
    int j_hi = (cur.P0 + QB - 1) / KVBLK + 1; if (j_hi > skv / KVBLK) j_hi = skv / KVBLK;
    const int NT = j_hi - j_lo;
    const int kbn = swa_jlo(nxt.P0, nxt.W) * KVBLK;
    const int qlo = cur.P0 + wid * QBLK, qm = qlo + r32 - 4 * hi;
    char* V_lds = lds; char* K_lds = lds + 2 * SHM_V;
    float* ws = (float*)(lds + 2 * SHM_V + 2 * SHM_K) + wid * 64; float* li_l = ws, * al_l = ws + 32;
    float m_reg = -1e30f, l_reg = 0; f32x16 o[4] = {};
    const int sr = tid >> 4, sc = (tid & 15) * 8, vst0 = v_st(sr, sc), vst1 = v_st(32 + sr, sc), kws = KSWZ(sr, sc * 2);
    const int vb0 = (int)(uintptr_t)V_lds + v_rd_base(lane);
    const bf16* Kh = cur.K; const bf16* Vh = cur.V; const int KSc = cur.KS;
#define RESC(a) do { if (__any((a) < 1.f)) { if (hi == 0) al_l[r32] = (a); asm volatile("s_waitcnt lgkmcnt(0)" ::: "memory");              \
                     for (int d_ = 0; d_ < 4; ++d_) for (int r = 0; r < 16; ++r) o[d_][r] *= al_l[crow(r, hi)]; } } while (0)
#define KBASE(t) ((j_lo + (t)) * KVBLK)
#define ACT(t) (KBASE(t) <= qlo + QBLK - 1 && KBASE(t) + KVBLK - 1 >= qlo - W + 1)
#define MASKT(P0_, P1_, t) do { const int kb_ = KBASE(t); if ((!SK || ACT(t)) && (kb_ + KVBLK - 1 > qlo || kb_ <= qlo + QBLK - 1 - W)) mask_tile(P0_, P1_, qm - kb_, (unsigned)W); } while (0)
    constexpr int NQL = 8;
    constexpr bool SK = true;
#define SEAM_K0() do { VMWN(NQL); SWRITE_HK(0); SBAR(); } while (0)
    f32x16 pA0, pA1, pB0, pB1; float mnA, mnB, alA, alB; bf16x8 pa0, pa1, pa2, pa3;
    SWRITE_HV(0); SBAR();
    if (NT > 1) { SLOAD_H(Kh, Vh, KBASE(1), KSc); }
    SBAR(); qkt<0, SK>(pA0, pA1, K_lds, r32, hi, S.qr, ACT(0));
    MASKT(pA0, pA1, 0); partialSM(pA0, pA1, m_reg, mnA, alA);
    if (NT > 1) { VMW(); SWRITE_H(1); }
    __syncthreads();
#define HALF_STEP(PX0, PX1, mnX, alX, PY0, PY1, alY, t, KB, VB, SB) do {                                                      \
        SBAR(); qkt<KB, SK>(PX0, PX1, K_lds, r32, hi, S.qr, ACT(t));                                             \
        finishSM(PY0, PY1, alY, l_reg, pa0, pa1, pa2, pa3); SBAR();                                                           \
        if ((t) + 1 < NT) { SLOAD_H(Kh, Vh, KBASE((t) + 1), KSc); SBAR(); }                                               \
        pv_tile<VB, SK>(o, vb0, pa0, pa1, pa2, pa3, ACT((t) - 1)); MASKT(PX0, PX1, (t)); partialSM(PX0, PX1, m_reg, mnX, alX);                                        \
        __syncthreads();                                                                                                      \
        if ((t) + 1 < NT) { VMW(); SWRITE_H(SB); }                                                                          \
        RESC(alX); __syncthreads(); } while (0)
    for (int t = 1; t + 1 < NT; t += 2) {
        HALF_STEP(pB0, pB1, mnB, alB, pA0, pA1, alA, t, 1, 0, 0);
        HALF_STEP(pA0, pA1, mnA, alA, pB0, pB1, alB, t + 1, 0, 1, 1);
    }
    const bool even = (NT & 1) == 0;
    if (even) { SBAR(); qkt<1, SK>(pB0, pB1, K_lds, r32, hi, S.qr, ACT(NT - 1)); SBAR(); }
    { SLOAD_H(nxt.K, nxt.V, kbn, nxt.KS); SBAR();
      const char* qb_ = (const char*)nxt.Q + (size_t)(wid * QBLK) * (size_t)nxt.QS * 2; const unsigned qo_ = (unsigned)(r32 * nxt.QS + hi * 8) * 2u;
#pragma unroll
        for (int d0 = 0; d0 < 8; ++d0) S.qr[d0] = LD8(qb_ + qo_ + d0 * 32); }
    SBAR();
    finishSM(pA0, pA1, alA, l_reg, pa0, pa1, pa2, pa3); SBAR();
    pv_tile<0, SK>(o, vb0, pa0, pa1, pa2, pa3, ACT(even ? NT - 2 : NT - 1));
    if (even) { MASKT(pB0, pB1, NT - 1); partialSM(pB0, pB1, m_reg, mnB, alB); __syncthreads(); RESC(alB);
        finishSM(pB0, pB1, alB, l_reg, pa0, pa1, pa2, pa3); SBAR(); pv_tile<1, SK>(o, vb0, pa0, pa1, pa2, pa3, ACT(NT - 1)); }
    SBAR(); SEAM_K0();
    if (hi == 0) li_l[r32] = l_reg; asm volatile("s_waitcnt lgkmcnt(0)" ::: "memory");
    if (cur.LSE != nullptr && hi == 0) cur.LSE[(size_t)(wid * QBLK + r32) * cur.LS] = __log2f(l_reg) + m_reg * (1.4426950408889634f * SCALE);
    float rli[16];
#pragma unroll
    for (int r = 0; r < 16; ++r) rli[r] = __builtin_amdgcn_rcpf(li_l[crow(r, hi)]);
    bf16* Ow = cur.O + (size_t)(wid * QBLK) * cur.OS;
#pragma unroll
    for (int r = 0; r < 16; ++r) { const int orow = crow(r, hi);
#pragma unroll
        for (int d0 = 0; d0 < 4; ++d0) { const float v = o[d0][r] * rli[r];
            const float vn = __shfl_xor(v, 1);
            if ((r32 & 1) == 0) *(unsigned*)(Ow + (size_t)orow * cur.OS + d0 * 32 + r32) = cvtpk(v, vn); } }
    __syncthreads();
#undef RESC
#undef KBASE
#undef ACT
#undef MASKT
#undef SEAM_K0
#undef HALF_STEP
}
#undef LD8
#undef ROW
#undef VMW
#undef VMWN
#undef SLOAD_H
#undef SWRITE_HK
#undef SWRITE_HV
#undef SWRITE_H
#undef KSWZ
#undef SBAR
}

constexpr int NWAVES = 8;
#ifndef MK_N_LAUNCHES
#define MK_N_LAUNCHES 1
#endif
constexpr int N_PHASES = 13;
constexpr float W8_SCALE = 32.0f, H8_SCALE = 8.0f;
constexpr int SC_ONE = 0x7f7f7f7f, SC_W8 = 0x7a7a7a7a  , SC_H8 = 0x7c7c7c7c  , SC_M8 = MRG_FP8 ? 0x7b7b7b7b   : 0x7f7f7f7f;
#ifndef NAIVE_ATTN
#define NAIVE_ATTN 0
#endif
constexpr float ATT_QSCALE = NAIVE_ATTN ? QSCALE : 1.0f;

constexpr size_t MiB = 1u << 20;
constexpr size_t WS_CTL = 0, CTL_ZERO_BYTES = 1 * MiB;
constexpr size_t WS_WIN = 2 * MiB;
constexpr size_t WS_WB = 24 * MiB;
constexpr size_t WS_WO = 27 * MiB;
constexpr size_t WS_WMEM = WS_WIN + (size_t)9984 * 1024 * 2;
constexpr size_t WS_W1 = 29 * MiB;
constexpr size_t WS_W2 = 157 * MiB;
constexpr size_t WS_XN = 221 * MiB;
constexpr size_t WS_Z = 256 * MiB;
constexpr size_t WS_RW = 568 * MiB;
constexpr size_t WS_YS = 792 * MiB;
constexpr size_t WS_YABC = 824 * MiB;
constexpr size_t WS_MRG = 872 * MiB;
constexpr size_t WS_MRGB = 936 * MiB;
constexpr size_t WS_MEMN = WS_XN + (size_t)16384 * 1024 * 2;
constexpr size_t WS_KVM = 969 * MiB;
constexpr size_t WS_XN2 = 970 * MiB;
constexpr size_t WS_ROUTE = 1002 * MiB;
constexpr size_t WS_LORA = 1004 * MiB;
constexpr size_t WS_END = 1005 * MiB;
constexpr size_t WS_XS = 256 * MiB;
constexpr size_t WS_HACT = 400 * MiB;
constexpr size_t WS_YROWS = 544 * MiB;
constexpr size_t WS_OP = WS_MRG;
constexpr size_t WS_LSE = WS_MRGB;
constexpr size_t WS_CS = WS_RW;
constexpr size_t WS_VMIX = WS_RW + 32 * MiB, WS_GMIX = WS_RW + 64 * MiB;
constexpr size_t WS_XN8 = WS_YS, WS_WIN8 = WS_YS + 16 * MiB;
constexpr size_t RWSZ = (size_t)MTOK * RW * 4;
constexpr size_t RT_TOPI = 0, RT_TOPG = 256 * 1024, RT_POS = 512 * 1024, RT_ROWGATE = 768 * 1024;
static_assert(RT_ROWGATE + (size_t)MAX_SLOTS * 4 <= 1088 * 1024, "route");
constexpr int CW_TMO = 0, CW_CODE = 1;
constexpr int CW_BAR = 4096;
constexpr int CW_CNT = 16384;
constexpr int CW_CUR = 16384 + 2048;

constexpr int RING_OFF = 0, RING_BYTES = 131072;
constexpr int LDSCTL_OFF = 143360, MISC_OFF = LDSCTL_OFF + 320;
constexpr int MOETAB_OFF = MISC_OFF + 128;
constexpr int HIST_OFF = MOETAB_OFF + 1536;
constexpr int LDS_BYTES = 147456;
static_assert(HIST_OFF + 4 * 320 <= LDS_BYTES, "LDS map");
#define GAS __attribute__((address_space(1)))
#define LAS __attribute__((address_space(3)))
typedef unsigned short bf16;
typedef unsigned v4u __attribute__((ext_vector_type(4)));
typedef float f32x4 __attribute__((ext_vector_type(4)));
typedef short bf16x8 __attribute__((ext_vector_type(8)));
typedef GAS unsigned gu32;
typedef GAS unsigned long long gu64;
#define RLX_AGENT __ATOMIC_RELAXED, __HIP_MEMORY_SCOPE_AGENT
#define LDS_WAIT() asm volatile("s_waitcnt lgkmcnt(0)" ::: "memory")
#define VM_WAIT() asm volatile("s_waitcnt vmcnt(0)" ::: "memory")
__device__ __forceinline__ unsigned long long rt() { return __builtin_amdgcn_s_memrealtime(); }
typedef float f32x2_cv __attribute__((ext_vector_type(2))); typedef __bf16 bf16x2_cv __attribute__((ext_vector_type(2)));
__device__ __forceinline__ unsigned pk2(float lo, float hi) { f32x2_cv v = {lo, hi}; bf16x2_cv b = __builtin_convertvector(v, bf16x2_cv); return __builtin_bit_cast(unsigned, b); }
__device__ __forceinline__ unsigned f2bf(float f) { return pk2(f, f) & 0xffffu; }
#define XB_TMO      128
#define XB_XCNT(j)  (256  + 64 * (j))
#define XB_XSUB(j)  (1280 + 64 * (j))
#define XB_XGEN(j)  (2304 + 64 * (j))
#define XB_TOP      3328
#define XB_TOPGEN   3392
#define XCD_BAR_WORDS 3456
#define XB_SPIN_CAP (1u << 18)

__device__ __forceinline__ unsigned xb_ld(unsigned* p)              { return __hip_atomic_load(p, __ATOMIC_RELAXED, __HIP_MEMORY_SCOPE_AGENT); }
__device__ __forceinline__ unsigned xb_add(unsigned* p, unsigned v) { return __hip_atomic_fetch_add(p, v, __ATOMIC_RELAXED, __HIP_MEMORY_SCOPE_AGENT); }
__device__ __forceinline__ unsigned xb_xcc_id() { return (unsigned)__builtin_amdgcn_s_getreg((3 << 11) | 20) & 0xFu; }
#define XB_SPIN(cond, bar) do { unsigned _sp = 0; while (cond) { __builtin_amdgcn_s_sleep(1); \
    if ((++_sp & 255u) == 0u) { if (xb_ld(&(bar)[XB_TMO])) break; if (_sp > XB_SPIN_CAP) { atomicAdd(&(bar)[XB_TMO], 1u); break; } } } } while (0)

struct XcdBarrier {
    unsigned* bar; unsigned x;
    volatile LAS unsigned* st;
};

__device__ __forceinline__ XcdBarrier xcd_barrier_post(unsigned* bar, volatile LAS unsigned* st) {
    XcdBarrier b; b.bar = bar; b.x = xb_xcc_id(); b.st = st;
    if (threadIdx.x == 0) (void)xb_add(&bar[XB_XCNT(b.x)], 1u);
    return b;
}
__device__ __forceinline__ void xcd_barrier_complete(unsigned* bar, unsigned x, unsigned& nloc, unsigned& nx) {
    const unsigned G = gridDim.x * gridDim.y * gridDim.z;
    unsigned sum, cnt, mine, sp = 0u;
    for (;;) {
        sum = 0u; cnt = 0u; mine = 0u;
#pragma unroll
        for (unsigned j = 0; j < 16; ++j) { const unsigned c = xb_ld(&bar[XB_XCNT(j)]); sum += c; cnt += (c > 0u) ? 1u : 0u; mine = (j == x) ? c : mine; }
        if (sum == G) break;
        __builtin_amdgcn_s_sleep(1);
        if ((++sp & 255u) == 0u) { if (xb_ld(&bar[XB_TMO])) break; if (sp > XB_SPIN_CAP) { atomicAdd(&bar[XB_TMO], 1u); break; } }
    }
    nloc = mine > 0u ? mine : 1u; nx = cnt > 0u ? cnt : 1u;
}

__device__ __forceinline__ void xcd_barrier(const XcdBarrier& b) {
    asm volatile("s_waitcnt vmcnt(0)" ::: "memory");
    __syncthreads();
    if (threadIdx.x == 0) {
        unsigned* bar = b.bar;
        __builtin_amdgcn_s_waitcnt(0);
        unsigned nloc = b.st[0], nx = b.st[1];
        if (nloc == 0u) { xcd_barrier_complete(bar, b.x, nloc, nx); b.st[0] = nloc; b.st[1] = nx; }
        const unsigned old = xb_add(&bar[XB_XSUB(b.x)], 1u);
        const unsigned gen = old / nloc;
        if (old + 1u == (gen + 1u) * nloc) {
            __builtin_amdgcn_fence(__ATOMIC_RELEASE, "agent");
            asm volatile("s_waitcnt vmcnt(0)" ::: "memory");
            const unsigned og = xb_add(&bar[XB_TOP], 1u);
            const unsigned tg = og / nx;
            if (og + 1u == (tg + 1u) * nx) xb_add(&bar[XB_TOPGEN], 1u);
            else XB_SPIN(xb_ld(&bar[XB_TOPGEN]) == tg, bar);
            __builtin_amdgcn_fence(__ATOMIC_ACQUIRE, "agent");
            xb_add(&bar[XB_XGEN(b.x)], 1u);
            asm volatile("s_waitcnt vmcnt(0)" ::: "memory");
        } else {
            XB_SPIN(xb_ld(&bar[XB_XGEN(b.x)]) == gen, bar);
            __builtin_amdgcn_fence(__ATOMIC_ACQUIRE, "agent");
            asm volatile("s_waitcnt vmcnt(0)" ::: "memory");
        }
    }
    __syncthreads();
}

typedef float f32x2 __attribute__((ext_vector_type(2)));
struct Args { const float* in[32]; float* out; unsigned char* ws; int ph_lo, ph_hi, use_bar, pad; };
struct Frame {
    LAS unsigned char* lds;
    volatile LAS unsigned* MISC;
    gu32* ctl;
    int tid, lane, wave;
    int vcu, G;
    float* out;
    unsigned char* ws;
};
enum { I_X = 0, I_MEM, I_POS, I_NORM_MIX, I_W_IN, I_B_GATE, I_AQ_GAIN, I_AK_GAIN, I_R_MU, I_R_W0, I_R_W2, I_R_A0, I_R_A2, I_R_G2, I_R_KK, I_R_KA, I_R_RK, I_R_LNW, I_R_LNB,
       I_MEM_NORM, I_W_MEMKV, I_CQ_GAIN, I_CK_GAIN, I_W_BRANCH, I_W_OUT, I_NORM_FFN, I_ROUTER_W, I_ROUTER_B, I_EXP_W1, I_EXP_B1, I_EXP_W2, I_EXP_B2 };

__device__ __forceinline__ bool phase_enter(Frame& F, bool on) { int t = (int)threadIdx.x; asm volatile("" : "+v"(t)); F.tid = t; F.lane = t & 63; F.wave = __builtin_amdgcn_readfirstlane(t >> 6); return on; }
__device__ __forceinline__ const float* ldarg(int i) {
    const __attribute__((address_space(4))) char* ka = (const __attribute__((address_space(4))) char*)__builtin_amdgcn_kernarg_segment_ptr();
    asm volatile("" : "+s"(ka));
    return *(const float* const __attribute__((address_space(4)))*)(ka + 8 * i);
}
__device__ __forceinline__ unsigned pk4_fp8(float a, float b, float c, float d) { unsigned w = 0; w = __builtin_amdgcn_cvt_pk_fp8_f32(a, b, w, false); w = __builtin_amdgcn_cvt_pk_fp8_f32(c, d, w, true); return w; }
__device__ __forceinline__ float fast_sigm(float x) { return __builtin_amdgcn_rcpf(1.0f + __builtin_amdgcn_exp2f(-1.4426950408889634f * x)); }
__device__ __forceinline__ float fast_tanh(float x) { return 1.0f - 2.0f * __builtin_amdgcn_rcpf(1.0f + __builtin_amdgcn_exp2f(2.8853900817779268f * x)); }
__device__ __forceinline__ float fast_softplus(float y) { return fmaxf(y, 0.f) + 0.6931471805599453f * __builtin_amdgcn_logf(1.0f + __builtin_amdgcn_exp2f(-1.4426950408889634f * fabsf(y))); }
__device__ __forceinline__ int opq(int x) { asm volatile("" : "+v"(x)); return x; }
__device__ __forceinline__ float bf_lo(unsigned w) { return __builtin_bit_cast(float, w << 16); }
__device__ __forceinline__ float bf_hi(unsigned w) { return __builtin_bit_cast(float, w & 0xffff0000u); }
__device__ __forceinline__ float sigm(float x) { return 1.0f / (1.0f + __expf(-x)); }
template <int CTRL, int RM> __device__ __forceinline__ float dpp0(float v) {
    return __builtin_bit_cast(float, __builtin_amdgcn_update_dpp(0, __builtin_bit_cast(int, v), CTRL, RM, 0xf, true)); }
__device__ __forceinline__ float row16_sum(float v) {
    v += dpp0<0xB1, 0xf>(v); v += dpp0<0x4E, 0xf>(v); v += dpp0<0x141, 0xf>(v); v += dpp0<0x140, 0xf>(v); return v; }
__device__ __forceinline__ float rdlane(float v, int l) { return __builtin_bit_cast(float, __builtin_amdgcn_readlane(__builtin_bit_cast(int, v), l)); }
__device__ __forceinline__ float wave_sum(float v) {
    v = row16_sum(v); v += dpp0<0x142, 0xA>(v); v += dpp0<0x143, 0xC>(v); return rdlane(v, 63); }
__device__ __forceinline__ void half_sums(float v, float& lo, float& hi) {
    v = row16_sum(v); v += dpp0<0x142, 0xA>(v); lo = rdlane(v, 31); hi = rdlane(v, 63); }
__device__ __forceinline__ float wave_max_bp(float v) {
#pragma unroll
    for (int o = 1; o < 64; o <<= 1) v = fmaxf(v, __shfl_xor(v, o));
    return v; }

__device__ __forceinline__ void tconv_tile(const float* W, int K, int N, bf16* WT, int k0, int n0, int rowbase, int lane, int kd = 0) {
    const int c = lane & 15, q = lane >> 4;
    const GAS f32x4* src = (const GAS f32x4*)(W + (size_t)(k0 + 16 * q) * N + n0 + 4 * c);
    const size_t rs = (size_t)N / 4;
    f32x4 v[16];
#pragma unroll
    for (int i = 0; i < 16; ++i) v[i] = src[i * rs];
#pragma unroll
    for (int j = 0; j < 4; ++j) {
        GAS v4u* dst = (GAS v4u*)(WT + (size_t)(rowbase + 4 * c + j) * K + kd + k0 + 16 * q);
        v4u o0, o1;
        o0.x = pk2(v[0][j], v[1][j]); o0.y = pk2(v[2][j], v[3][j]); o0.z = pk2(v[4][j], v[5][j]); o0.w = pk2(v[6][j], v[7][j]);
        o1.x = pk2(v[8][j], v[9][j]); o1.y = pk2(v[10][j], v[11][j]); o1.z = pk2(v[12][j], v[13][j]); o1.w = pk2(v[14][j], v[15][j]);
        dst[0] = o0; dst[1] = o1;
    }
}
__device__ __forceinline__ void tconv_tile128(const float* W, int K, int N, bf16* WT, int k0, int n0, int rowbase, int lane) {
    const int c = lane & 31, q = lane >> 5;
    const GAS f32x4* src = (const GAS f32x4*)(W + (size_t)(k0 + 32 * q) * N + n0 + 4 * c);
    const size_t rs = (size_t)N / 4;
    f32x4 v[32];
#pragma unroll
    for (int i = 0; i < 32; ++i) v[i] = src[i * rs];
#pragma unroll
    for (int j = 0; j < 4; ++j) {
        GAS v4u* dst = (GAS v4u*)(WT + (size_t)(rowbase + 4 * c + j) * K + k0 + 32 * q);
#pragma unroll
        for (int g = 0; g < 4; ++g) { v4u o; o.x = pk2(v[8 * g][j], v[8 * g + 1][j]); o.y = pk2(v[8 * g + 2][j], v[8 * g + 3][j]); o.z = pk2(v[8 * g + 4][j], v[8 * g + 5][j]); o.w = pk2(v[8 * g + 6][j], v[8 * g + 7][j]); dst[g] = o; }
    }
}
__device__ __forceinline__ void tconv_tile_f8(const float* W, int K, int N, unsigned char* WT, int k0, int n0, int rowbase, int lane, float sc) {
    const int c = lane & 15, q = lane >> 4;
    const GAS f32x4* src = (const GAS f32x4*)(W + (size_t)(k0 + 16 * q) * N + n0 + 4 * c);
    const size_t rs = (size_t)N / 4;
    f32x4 v[16];
#pragma unroll
    for (int i = 0; i < 16; ++i) v[i] = src[i * rs] * sc;
#pragma unroll
    for (int j = 0; j < 4; ++j) {
        v4u o; o.x = pk4_fp8(v[0][j], v[1][j], v[2][j], v[3][j]); o.y = pk4_fp8(v[4][j], v[5][j], v[6][j], v[7][j]); o.z = pk4_fp8(v[8][j], v[9][j], v[10][j], v[11][j]); o.w = pk4_fp8(v[12][j], v[13][j], v[14][j], v[15][j]);
        *(GAS v4u*)(WT + (size_t)(rowbase + 4 * c + j) * K + k0 + 16 * q) = o;
    }
}
__device__ __forceinline__ void tc8_load(const float* W, int N, int k0, int n0, int lane, f32x4 (&v)[16]) {
    const int c = lane & 15, q = lane >> 4; const GAS f32x4* src = (const GAS f32x4*)(W + (size_t)(k0 + 16 * q) * N + n0 + 4 * c); const size_t rs = (size_t)N / 4;
#pragma unroll
    for (int i = 0; i < 16; ++i) v[i] = src[i * rs];
}
__device__ __forceinline__ void tc8_store(unsigned char* WT, int K, int k0, int rowbase, int lane, const f32x4 (&v)[16], float sc) {
    const int c = lane & 15, q = lane >> 4;
#pragma unroll
    for (int j = 0; j < 4; ++j) {
        v4u o; o.x = pk4_fp8(v[0][j] * sc, v[1][j] * sc, v[2][j] * sc, v[3][j] * sc); o.y = pk4_fp8(v[4][j] * sc, v[5][j] * sc, v[6][j] * sc, v[7][j] * sc);
        o.z = pk4_fp8(v[8][j] * sc, v[9][j] * sc, v[10][j] * sc, v[11][j] * sc); o.w = pk4_fp8(v[12][j] * sc, v[13][j] * sc, v[14][j] * sc, v[15][j] * sc);
        *(GAS v4u*)(WT + (size_t)(rowbase + 4 * c + j) * K + k0 + 16 * q) = o; }
}
__device__ __forceinline__ void w1_tile(int r, const float* W1, unsigned char* W1T, const float*& W, unsigned char*& WT, int& k0, int& n0, int& rowbase) {
    const int e = r / 512, q = r % 512, kb = q % 16, nb = q / 16; n0 = 64 * nb; k0 = 64 * kb;
    rowbase = (n0 < 1024) ? ((n0 >> 7) * 256 + (n0 & 127)) : ((((n0 - 1024) >> 7) * 256) + 128 + ((n0 - 1024) & 127));
    W = W1 + (size_t)e * 1024 * 2048; WT = W1T + (size_t)e * 2048 * 1024;
}
__device__ __forceinline__ void rms_row_to_bf16(const float* xrow, const float* gain, bf16* orow, int lane, unsigned char* orow8 = nullptr) {
    const GAS f32x4* xr = (const GAS f32x4*)xrow + lane; const GAS f32x4* gr = (const GAS f32x4*)gain + lane;
    f32x4 v[4]; float s = 0.f;
#pragma unroll
    for (int j = 0; j < 4; ++j) { v[j] = xr[64 * j]; s += (v[j].x * v[j].x + v[j].y * v[j].y) + (v[j].z * v[j].z + v[j].w * v[j].w); }
    const float rstd = 1.0f / sqrtf(wave_sum(s) * (1.f / D_MODEL) + NORM_EPS);
    GAS unsigned long long* o8 = (GAS unsigned long long*)orow + lane;
#pragma unroll
    for (int j = 0; j < 4; ++j) { const f32x4 g = gr[64 * j];
        o8[64 * j] = (unsigned long long)pk2(v[j].x * rstd * g.x, v[j].y * rstd * g.y) | ((unsigned long long)pk2(v[j].z * rstd * g.z, v[j].w * rstd * g.w) << 32);
        if (orow8) ((GAS unsigned*)orow8 + lane)[64 * j] = pk4_fp8(v[j].x * rstd * g.x, v[j].y * rstd * g.y, v[j].z * rstd * g.z, v[j].w * rstd * g.w); }
}
template <int PART> __device__ __forceinline__ void p0_prologue(Frame& F, const Args& args, int gw, int NGW) {
    const int lane = F.lane;
    unsigned char* ws = F.ws;
    constexpr int T_IN = 16 * 156, T_WB = 3 * 128, T_WO = 256, T_WM = 256, T_W1 = 32 * 512, T_W2 = 32 * 256, T_LO = 32;
    constexpr int NT = T_IN + T_WB + T_WO + T_WM + T_W1 + T_W2;
    constexpr int IT0 = (PART == 0) ? 0 : (PART == 1) ? T_IN + T_WB + T_WO + T_WM + T_W1 : T_IN + T_WB + T_WO + T_WM, IT1 = (PART == 0) ? T_IN + T_WB + T_WO + T_WM : (PART == 1) ? NT : T_IN + T_WB + T_WO + T_WM + T_W1;
    if constexpr (PART == 1) {
        constexpr int B1 = T_IN + T_WB + T_WO + T_WM + T_W1;
        auto w2_src = [&](int it_, const float*& W_, unsigned char*& WT_, int& k0_, int& n0_) { const int r_ = it_ - B1, e_ = r_ / 256, q_ = r_ % 256; k0_ = 64 * (q_ % 16); n0_ = 64 * (q_ / 16);
            W_ = ldarg(I_EXP_W2) + (size_t)e_ * 1024 * 1024; WT_ = ws + WS_W2 + (size_t)e_ * 1024 * 1024; };
        f32x4 va[16], vb[16]; const float* Wa; unsigned char* Ta; int ka, na; const float* Wb; unsigned char* Tb; int kb_, nb_;
        int it = IT0 + gw;
        if (it < IT1) { w2_src(it, Wa, Ta, ka, na); tc8_load(Wa, 1024, ka, na, lane, va); }
        while (it < IT1) {
            const int i1 = it + NGW; if (i1 < IT1) { w2_src(i1, Wb, Tb, kb_, nb_); tc8_load(Wb, 1024, kb_, nb_, lane, vb); }
            tc8_store(Ta, 1024, ka, na, lane, va, W8_SCALE);
            if (i1 >= IT1) break;
            const int i2 = i1 + NGW; if (i2 < IT1) { w2_src(i2, Wa, Ta, ka, na); tc8_load(Wa, 1024, ka, na, lane, va); }
            tc8_store(Tb, 1024, kb_, nb_, lane, vb, W8_SCALE);
            it = i2;
        }
        return;
    }
    for (int it = IT0 + gw; it < IT1; it += NGW) {
        int r = it;
        if (r < T_IN) { const int kb = r / 156, nb = r % 156, nt = nb >> 2;
            if (nt < 12 || nt >= 27) tconv_tile_f8(ldarg(I_W_IN), 1024, IN_COLS, ws + WS_WIN8, 64 * kb, 64 * nb, 64 * nb, lane, W8_SCALE);
            else tconv_tile(ldarg(I_W_IN), 1024, IN_COLS, (bf16*)(ws + WS_WIN), 64 * kb, 64 * nb, 64 * nb, lane);
            continue; } r -= T_IN;
        if (r < T_WB) { const int b = r / 128, q = r % 128, kb = q / 16, nb = q % 16;
            tconv_tile(ldarg(I_W_BRANCH) + (size_t)b * 512 * 1024, 1536, 1024, (bf16*)(ws + WS_WB), 64 * kb, 64 * nb, 64 * nb, lane, 512 * b); continue; } r -= T_WB;
        if (r < T_WO) { const int kb = r / 16, nb = r % 16; if (MRG_FP8) tconv_tile_f8(ldarg(I_W_OUT), 1024, 1024, ws + WS_WO, 64 * kb, 64 * nb, 64 * nb, lane, W8_SCALE); else tconv_tile(ldarg(I_W_OUT), 1024, 1024, (bf16*)(ws + WS_WO), 64 * kb, 64 * nb, 64 * nb, lane); continue; } r -= T_WO;
        if (r < T_WM) { const int kb = r / 16, nb = r % 16; tconv_tile(ldarg(I_W_MEMKV), 1024, 1024, (bf16*)(ws + WS_WMEM), 64 * kb, 64 * nb, 64 * nb, lane); continue; } r -= T_WM;
        if (r < T_W1) { const int e = r / 512, q = r % 512, kb = q % 16, nb = q / 16, n0 = 64 * nb;
            const int rowbase = (n0 < 1024) ? ((n0 >> 7) * 256 + (n0 & 127)) : ((((n0 - 1024) >> 7) * 256) + 128 + ((n0 - 1024) & 127));
            tconv_tile_f8(ldarg(I_EXP_W1) + (size_t)e * 1024 * 2048, 1024, 2048, ws + WS_W1 + (size_t)e * 2048 * 1024, 64 * kb, n0, rowbase, lane, W8_SCALE); continue; } r -= T_W1;
        { const int e = r / 256, q = r % 256, kb = q % 16, nb = q / 16;
            tconv_tile_f8(ldarg(I_EXP_W2) + (size_t)e * 1024 * 1024, 1024, 1024, ws + WS_W2 + (size_t)e * 1024 * 1024, 64 * kb, 64 * nb, 64 * nb, lane, W8_SCALE); }
    }
    if (PART == 0) {
    for (int it = gw; it < T_LO; it += NGW) {
        bf16* L = (bf16*)(ws + WS_LORA);
        if (it < 8) tconv_tile(ldarg(I_R_W2), 64, 512, L, 0, 64 * it, 64 * it, lane);
        else if (it < 16) tconv_tile(ldarg(I_R_A2), 64, 512, L + 512 * 64, 0, 64 * (it - 8), 64 * (it - 8), lane);
        else { const int q = it - 16; tconv_tile(ldarg(I_R_G2), 128, 512, L + 2 * 512 * 64, 64 * (q >> 3), 64 * (q & 7), 64 * (q & 7), lane); } }
    { const int* posp = (const int*)ldarg(I_POS); float* cs = (float*)(ws + WS_CS);
      for (int idx = gw * 64 + lane; idx < MTOK * 16; idx += NGW * 64) { const int m = idx >> 4, i = idx & 15; const float ang = (float)posp[m] * exp2f(-(float)i * (18.931568569324174f / 16.0f)); const float sn = sinf(ang), cn = cosf(ang);
          f32x2 o; o.x = cn; o.y = sn; *(GAS f32x2*)(cs + (size_t)idx * 2) = o; } }
    for (int m = gw; m < MTOK; m += NGW) rms_row_to_bf16(ldarg(I_X) + (size_t)m * D_MODEL, ldarg(I_NORM_MIX), (bf16*)(ws + WS_XN) + (size_t)m * D_MODEL, lane, ws + WS_XN8 + (size_t)m * D_MODEL);
    for (int m = gw; m < MEMROWS; m += NGW) rms_row_to_bf16(ldarg(I_MEM) + (size_t)m * D_MODEL, ldarg(I_MEM_NORM), (bf16*)(ws + WS_MEMN) + (size_t)m * D_MODEL, lane);
    }
}

__device__ __forceinline__ void head_norm(bf16* p, const float* gain, bool rot, float c0, float s0, float c1, float s1, float scale, int lane) {
    GAS unsigned* pw = (GAS unsigned*)p + lane;
    const unsigned w = *pw; float a = bf_lo(w), b = bf_hi(w);
    const float ss = wave_sum(a * a + b * b);
    const float rstd = 1.0f / sqrtf(ss * (1.f / 128.f) + NORM_EPS);
    const f32x2 g = *((const GAS f32x2*)gain + lane);
    a = a * rstd * g.x; b = b * rstd * g.y;
    const float pa = __shfl_xor(a, 8), pb = __shfl_xor(b, 8);
    if (rot && lane < 16) {
        if (lane < 8) { a = a * c0 - pa * s0; b = b * c1 - pb * s1; }
        else          { a = a * c0 + pa * s0; b = b * c1 + pb * s1; }
    }
    *pw = pk2(a * scale, b * scale);
}
__device__ __forceinline__ void p2_prep(Frame& F, const Args& args) {
    const int gw = F.vcu * NWAVES + F.wave, NGW = F.G * NWAVES, lane = F.lane;
    unsigned char* ws = F.ws;
    bf16* Z = (bf16*)(ws + WS_Z);
    LAS float* lo = (LAS float*)(F.lds + RING_OFF + F.wave * 8192);
    const float* mu = ldarg(I_R_MU); const float* aqg = ldarg(I_AQ_GAIN); const float* akg = ldarg(I_AK_GAIN); const float* cqg = ldarg(I_CQ_GAIN); const int* posp = (const int*)ldarg(I_POS);
    float* Rr = (float*)(ws + WS_RW); float* Rw = Rr + (size_t)MTOK * RW; float* Rk = Rw + (size_t)MTOK * RW; float* Rv = Rk + (size_t)MTOK * RW;
    float* Ra = Rv + (size_t)MTOK * RW; float* Rb = Ra + (size_t)MTOK * RW; float* Rg = Rb + (size_t)MTOK * RW;
    for (int m = gw; m < MEMROWS; m += NGW)
        for (int hd = 0; hd < 4; ++hd) head_norm((bf16*)(ws + WS_KVM) + (size_t)m * 1024 + hd * 128, ldarg(I_CK_GAIN), false, 1.f, 0.f, 1.f, 0.f, 1.0f, lane);
}

__device__ __forceinline__ void lora_stage(const float* W, LAS unsigned* wl, int tid) {
#pragma unroll
    for (int i = 0; i < 16; ++i) { const int idx = tid + 512 * i; const f32x4 v = *((const GAS f32x4*)W + idx);
        *(LAS unsigned long long*)(wl + 2 * idx) = (unsigned long long)pk2(v.x, v.y) | ((unsigned long long)pk2(v.z, v.w) << 32); }
}
__device__ __forceinline__ void lora_mac(const LAS unsigned* wl, const LAS float* lo, float (&acc)[4][8], int lane) {
#pragma unroll 4
    for (int j = 0; j < 64; ++j) { const f32x4 xin = *(const LAS f32x4*)(lo + j * 4);
#pragma unroll
        for (int i = 0; i < 4; ++i) { const unsigned w = wl[j * 256 + lane + 64 * i]; const float w0 = bf_lo(w), w1 = bf_hi(w);
#pragma unroll
            for (int tt = 0; tt < 4; ++tt) { acc[tt][2 * i] += xin[tt] * w0; acc[tt][2 * i + 1] += xin[tt] * w1; } } }
}
template <int NL> __device__ __forceinline__ void lora_in(const bf16* Z, const float* mu, int ch, int m0, LAS float* lo, int lane) {
    const int col = OFF_R + 1536 + ch; const float muj = mu[1536 + ch];
    float prv = ((m0 % SEQ) == 0) ? 0.f : __builtin_bit_cast(float, (unsigned)Z[(size_t)(m0 - 1) * IN_COLS + col] << 16);
#pragma unroll
    for (int tt = 0; tt < 4; ++tt) { const float cur = __builtin_bit_cast(float, (unsigned)Z[(size_t)(m0 + tt) * IN_COLS + col] << 16);
        float x = cur + (prv - cur) * muj; prv = cur;
        x = (NL == 0) ? tanhf(x) : (NL == 1) ? x : sigm(x);
        lo[lane * 4 + tt] = x; }
    LDS_WAIT(); asm volatile("" ::: "memory");
}
__device__ __forceinline__ void p2_rwkv(Frame& F, const Args& args) {
    const int lane = F.lane, wave = F.wave;
    unsigned char* ws = F.ws;
    const bf16* Z = (const bf16*)(ws + WS_Z);
    LAS unsigned* wl = (LAS unsigned*)(F.lds + RING_OFF);
    LAS float* lo = (LAS float*)(F.lds + RING_OFF + 65536 + wave * 1024);
    const float* mu = ldarg(I_R_MU);
    float* Rr = (float*)(ws + WS_RW); float* Rw = Rr + (size_t)MTOK * RW; float* Rk = Rw + (size_t)MTOK * RW; float* Rv = Rk + (size_t)MTOK * RW;
    float* Ra = Rv + (size_t)MTOK * RW; float* Rb = Ra + (size_t)MTOK * RW; float* Rg = Rb + (size_t)MTOK * RW;
    for (int grp = F.vcu; grp < MTOK / 64; grp += F.G) {
        const int mw = grp * 64 + wave * 8;
        lora_stage(ldarg(I_R_W2), wl, F.tid);
        __syncthreads();
        for (int tk = 0; tk < 2; ++tk) { const int m0 = mw + 4 * tk;
            lora_in<0>(Z, mu, lane, m0, lo, lane);
            float acc[4][8];
#pragma unroll
            for (int tt = 0; tt < 4; ++tt)
#pragma unroll
                for (int c = 0; c < 8; ++c) acc[tt][c] = 0.f;
            lora_mac(wl, lo, acc, lane);
            const float* w0p = ldarg(I_R_W0);
#pragma unroll
            for (int i = 0; i < 4; ++i) { const int c = 2 * lane + 128 * i; const f32x2 w0 = *(const GAS f32x2*)(w0p + c);
#pragma unroll
                for (int tt = 0; tt < 4; ++tt) { const float y0 = -(w0.x + acc[tt][2 * i]), y1 = -(w0.y + acc[tt][2 * i + 1]);
                    const float sp0 = fmaxf(y0, 0.f) + log1pf(__expf(-fabsf(y0))), sp1 = fmaxf(y1, 0.f) + log1pf(__expf(-fabsf(y1)));
                    f32x2 wd; wd.x = -__expf(-sp0 - 0.5f); wd.y = -__expf(-sp1 - 0.5f);
                    *(GAS f32x2*)(Rw + (size_t)(m0 + tt) * RW + c) = wd; } }
            LDS_WAIT(); asm volatile("" ::: "memory"); }
        __syncthreads();
        lora_stage(ldarg(I_R_A2), wl, F.tid);
        __syncthreads();
        for (int tk = 0; tk < 2; ++tk) { const int m0 = mw + 4 * tk; const int tpos0 = m0 % SEQ;
            lora_in<1>(Z, mu, 64 + lane, m0, lo, lane);
            float acca[4][8];
#pragma unroll
            for (int tt = 0; tt < 4; ++tt)
#pragma unroll
                for (int c = 0; c < 8; ++c) acca[tt][c] = 0.f;
            lora_mac(wl, lo, acca, lane);
            const float* a0p = ldarg(I_R_A0); const float* kkp = ldarg(I_R_KK); const float* kap = ldarg(I_R_KA);
#pragma unroll
            for (int i = 0; i < 4; ++i) {
                const int c = 2 * lane + 128 * i;
                const f32x2 a0 = *(const GAS f32x2*)(a0p + c), kkc = *(const GAS f32x2*)(kkp + c), kac = *(const GAS f32x2*)(kap + c);
                const f32x2 mur = *(const GAS f32x2*)(mu + c), muk = *(const GAS f32x2*)(mu + 512 + c), muv = *(const GAS f32x2*)(mu + 1024 + c);
                unsigned pr = 0u, pk = 0u, pv = 0u;
                if (tpos0 != 0) { const bf16* zp = Z + (size_t)(m0 - 1) * IN_COLS + OFF_R + c; pr = *(const GAS unsigned*)zp; pk = *(const GAS unsigned*)(zp + 512); pv = *(const GAS unsigned*)(zp + 1024); }
#pragma unroll
                for (int tt = 0; tt < 4; ++tt) {
                    const size_t m = (size_t)(m0 + tt);
                    const bf16* zc = Z + m * IN_COLS + OFF_R + c;
                    const unsigned cr = *(const GAS unsigned*)zc, ck = *(const GAS unsigned*)(zc + 512), cv = *(const GAS unsigned*)(zc + 1024);
                    f32x2 r, k, v;
                    r.x = bf_lo(cr) + (bf_lo(pr) - bf_lo(cr)) * mur.x; r.y = bf_hi(cr) + (bf_hi(pr) - bf_hi(cr)) * mur.y;
                    k.x = bf_lo(ck) + (bf_lo(pk) - bf_lo(ck)) * muk.x; k.y = bf_hi(ck) + (bf_hi(pk) - bf_hi(ck)) * muk.y;
                    v.x = bf_lo(cv) + (bf_lo(pv) - bf_lo(cv)) * muv.x; v.y = bf_hi(cv) + (bf_hi(pv) - bf_hi(cv)) * muv.y;
                    pr = cr; pk = ck; pv = cv;
                    f32x2 av; av.x = sigm(a0.x + acca[tt][2 * i]); av.y = sigm(a0.y + acca[tt][2 * i + 1]);
                    f32x2 kk; kk.x = k.x * kkc.x; kk.y = k.y * kkc.y;
                    float slo, shi; half_sums(kk.x * kk.x + kk.y * kk.y, slo, shi);
                    const float nrm = fmaxf(sqrtf(lane < 32 ? slo : shi), 1e-12f), inv = 1.0f / nrm;
                    kk.x *= inv; kk.y *= inv;
                    f32x2 k2; k2.x = k.x * (1.0f + (av.x - 1.0f) * kac.x); k2.y = k.y * (1.0f + (av.y - 1.0f) * kac.y);
                    f32x2 as, bs; as.x = -kk.x; as.y = -kk.y; bs.x = kk.x * av.x; bs.y = kk.y * av.y;
                    const size_t o = m * RW + c;
                    *(GAS f32x2*)(Rr + o) = r; *(GAS f32x2*)(Rk + o) = k2; *(GAS f32x2*)(Rv + o) = v; *(GAS f32x2*)(Ra + o) = as; *(GAS f32x2*)(Rb + o) = bs;
                }
            }
            LDS_WAIT(); asm volatile("" ::: "memory"); }
        __syncthreads();
        float accg[2][4][8];
#pragma unroll
        for (int tk = 0; tk < 2; ++tk)
#pragma unroll
            for (int tt = 0; tt < 4; ++tt)
#pragma unroll
                for (int c = 0; c < 8; ++c) accg[tk][tt][c] = 0.f;
#pragma unroll
        for (int hh = 0; hh < 2; ++hh) {
            lora_stage(ldarg(I_R_G2) + (size_t)hh * 64 * RW, wl, F.tid);
            __syncthreads();
#pragma unroll
            for (int tk = 0; tk < 2; ++tk) { lora_in<2>(Z, mu, 128 + 64 * hh + lane, mw + 4 * tk, lo, lane); lora_mac(wl, lo, accg[tk], lane); LDS_WAIT(); asm volatile("" ::: "memory"); }
            __syncthreads();
        }
#pragma unroll
        for (int tk = 0; tk < 2; ++tk)
#pragma unroll
            for (int i = 0; i < 4; ++i)
#pragma unroll
                for (int tt = 0; tt < 4; ++tt) { f32x2 gg; gg.x = accg[tk][tt][2 * i]; gg.y = accg[tk][tt][2 * i + 1]; *(GAS f32x2*)(Rg + (size_t)(mw + 4 * tk + tt) * RW + 2 * lane + 128 * i) = gg; }
    }
}

__device__ __forceinline__ float qk_dot(const LAS float* q, const bf16* krow) {
    const GAS v4u* kp = (const GAS v4u*)krow; float s0 = 0.f, s1 = 0.f;
#pragma unroll
    for (int i = 0; i < 16; ++i) { const v4u w = kp[i]; const f32x4 qa = *(const LAS f32x4*)(q + 8 * i), qb = *(const LAS f32x4*)(q + 8 * i + 4);
        s0 += bf_lo(w.x) * qa[0] + bf_hi(w.x) * qa[1] + bf_lo(w.y) * qa[2] + bf_hi(w.y) * qa[3];
        s1 += bf_lo(w.z) * qb[0] + bf_hi(w.z) * qb[1] + bf_lo(w.w) * qb[2] + bf_hi(w.w) * qb[3]; }
    return s0 + s1;
}
__device__ __forceinline__ void p3_attention(Frame& F) {
    const int gw = F.vcu * NWAVES + F.wave, NGW = F.G * NWAVES, lane = F.lane;
    unsigned char* ws = F.ws;
    const bf16* Z = (const bf16*)(ws + WS_Z);
    const bf16* KV = (const bf16*)(ws + WS_KVM);
    bf16* YA = (bf16*)(ws + WS_YABC); bf16* YC = YA + (size_t)2 * MTOK * 512;
    LAS float* qs = (LAS float*)(F.lds + RING_OFF + F.wave * 8192);
    for (int task = gw; task < MTOK * 4; task += NGW) {
        const int m = task >> 2, h = task & 3, t = m % SEQ;
        const bf16* zrow = Z + (size_t)m * IN_COLS;
#pragma unroll
        for (int g = 0; g < 3; ++g) { const unsigned w = *((const GAS unsigned*)(zrow + OFF_AQ + g * 512 + h * 128) + lane); qs[g * 128 + 2 * lane] = bf_lo(w); qs[g * 128 + 2 * lane + 1] = bf_hi(w); }
        LDS_WAIT(); asm volatile("" ::: "memory");
        float sc[3][3]; float mx = -INFINITY;
#pragma unroll
        for (int g = 0; g < 3; ++g) { const int dl = (g == 0) ? 1 : (g == 1) ? 4 : 16;
#pragma unroll
            for (int p = 0; p < 3; ++p) { const int j = lane + 64 * p; const int tk = t - dl * j; float s = -INFINITY;
                if (j <= 128 && tk >= 0) s = qk_dot(qs + g * 128, zrow - (size_t)dl * j * IN_COLS + OFF_AK + g * 512 + h * 128);
                sc[g][p] = s; mx = fmaxf(mx, s); } }
        mx = wave_max_bp(mx);
        float den = 0.f;
#pragma unroll
        for (int g = 0; g < 3; ++g)
#pragma unroll
            for (int p = 0; p < 3; ++p) { sc[g][p] = exp2f(sc[g][p] - mx); den += sc[g][p]; }
        den = wave_sum(den);
        float o0 = 0.f, o1 = 0.f;
#pragma unroll
        for (int g = 0; g < 3; ++g) { const int dl = (g == 0) ? 1 : (g == 1) ? 4 : 16; const bf16* vb = zrow + OFF_AV + g * 512 + h * 128 + 2 * lane;
#pragma unroll
            for (int p = 0; p < 3; ++p) { const int nj = (p < 2) ? 64 : 1;
                for (int jj = 0; jj < nj; ++jj) { const int j = jj + 64 * p; const float pj = rdlane(sc[g][p], jj);
                    if (t - dl * j >= 0) { const unsigned w = *(const GAS unsigned*)(vb - (size_t)dl * j * IN_COLS); o0 += pj * bf_lo(w); o1 += pj * bf_hi(w); } } } }
        const float inv = 1.0f / den;
        *((GAS unsigned*)(YA + (size_t)m * 512 + h * 128) + lane) = pk2(o0 * inv, o1 * inv);
        asm volatile("" ::: "memory");
    }
    for (int task = gw; task < MTOK * 4; task += NGW) {
        const int m = task >> 2, h = task & 3, b = m / SEQ;
        const bf16* zrow = Z + (size_t)m * IN_COLS;
        { const unsigned w = *((const GAS unsigned*)(zrow + OFF_CQ + h * 128) + lane); qs[2 * lane] = bf_lo(w); qs[2 * lane + 1] = bf_hi(w); }
        LDS_WAIT(); asm volatile("" ::: "memory");
        const bf16* kb = KV + (size_t)b * MEM_LEN * 1024 + h * 128;
        float sc[4]; float mx = -INFINITY;
#pragma unroll
        for (int p = 0; p < 4; ++p) { sc[p] = qk_dot(qs, kb + (size_t)(lane + 64 * p) * 1024); mx = fmaxf(mx, sc[p]); }
        mx = wave_max_bp(mx);
        float den = 0.f;
#pragma unroll
        for (int p = 0; p < 4; ++p) { sc[p] = exp2f(sc[p] - mx); den += sc[p]; }
        den = wave_sum(den);
        float o0 = 0.f, o1 = 0.f; const bf16* vb = kb + 512 + 2 * lane;
#pragma unroll
        for (int p = 0; p < 4; ++p)
            for (int jj = 0; jj < 64; ++jj) { const float pj = rdlane(sc[p], jj); const unsigned w = *(const GAS unsigned*)(vb + (size_t)(jj + 64 * p) * 1024); o0 += pj * bf_lo(w); o1 += pj * bf_hi(w); }
        const float inv = 1.0f / den;
        *((GAS unsigned*)(YC + (size_t)m * 512 + h * 128) + lane) = pk2(o0 * inv, o1 * inv);
        asm volatile("" ::: "memory");
    }
}

__device__ __forceinline__ void p5_post(Frame& F, const Args& args) {
    const int gw = F.vcu * NWAVES + F.wave, NGW = F.G * NWAVES, lane = F.lane;
    unsigned char* ws = F.ws;
    const float* Rr = (const float*)(ws + WS_RW); const float* Rk = Rr + (size_t)2 * MTOK * RW; const float* Rv = Rk + (size_t)MTOK * RW; const float* Rg = Rr + (size_t)6 * MTOK * RW;
    const float* YS = (const float*)(ws + WS_YS);
    bf16* YB = (bf16*)(ws + WS_YABC) + (size_t)MTOK * 512;
    const bf16* OP = (const bf16*)(ws + WS_OP); const float* LS = (const float*)(ws + WS_LSE); bf16* YA = (bf16*)(ws + WS_YABC);
    for (int m = gw; m < MTOK; m += NGW) {
        float l0[4], l1[4], l2[4]; unsigned pa[4], pb[4], pc[4];
#pragma unroll
        for (int h = 0; h < 4; ++h) { l0[h] = LS[(size_t)m * 4 + h]; l1[h] = LS[(size_t)MTOK * 4 + (size_t)m * 4 + h]; l2[h] = LS[(size_t)2 * MTOK * 4 + (size_t)m * 4 + h];
            const size_t o = (size_t)m * 512 + h * 128;
            pa[h] = *((const GAS unsigned*)(OP + o) + lane); pb[h] = *((const GAS unsigned*)(OP + (size_t)MTOK * 512 + o) + lane); pc[h] = *((const GAS unsigned*)(OP + (size_t)2 * MTOK * 512 + o) + lane); }
#pragma unroll
        for (int h = 0; h < 4; ++h) {
            const float mx = fmaxf(l0[h], fmaxf(l1[h], l2[h])); const float w0 = exp2f(l0[h] - mx), w1 = exp2f(l1[h] - mx), w2 = exp2f(l2[h] - mx); const float inv = __builtin_amdgcn_rcpf(w0 + w1 + w2);
            *((GAS unsigned*)(YA + (size_t)m * 1536 + h * 128) + lane) = pk2((w0 * bf_lo(pa[h]) + w1 * bf_lo(pb[h]) + w2 * bf_lo(pc[h])) * inv, (w0 * bf_hi(pa[h]) + w1 * bf_hi(pb[h]) + w2 * bf_hi(pc[h])) * inv); }
    }
}

__device__ __forceinline__ void p8_router(Frame& F, const Args& args) {
    const int lane = F.lane, wave = F.wave;
    unsigned char* ws = F.ws;
    const float* X1 = F.out;
    LAS int* hist = (LAS int*)(F.lds + HIST_OFF);
    { const int t_ = opq(F.tid); if (t_ < 32) hist[t_] = 0; }
    int* topi = (int*)(ws + WS_ROUTE + RT_TOPI); float* topg = (float*)(ws + WS_ROUTE + RT_TOPG);
    const float* RWt = ldarg(I_ROUTER_W); const float* RB = ldarg(I_ROUTER_B); const float* gain = ldarg(I_NORM_FFN);
    LAS float* rw = (LAS float*)(F.lds + RING_OFF);
    typedef float f32x16r __attribute__((ext_vector_type(16)));
    for (int grp = F.vcu; grp < MTOK / 64; grp += F.G) {
#pragma unroll
        for (int i = 0; i < 16; ++i) { const int f = F.tid + 512 * i, k = f >> 3; const f32x4 w = *((const GAS f32x4*)RWt + f); const float g = gain[k]; ((LAS f32x4*)rw)[f] = w * g; }
        __syncthreads();
        const int tile = wave >> 2, wq = wave & 3, i32 = lane & 31, h = lane >> 5;
        const GAS f32x4* xp = (const GAS f32x4*)(X1 + ((size_t)grp * 64 + tile * 32 + i32) * D_MODEL + wq * 256 + 4 * h);
        const LAS float* bp = rw + (wq * 256 + 4 * h) * 32 + i32;
        f32x16r acc;
#pragma unroll
        for (int r = 0; r < 16; ++r) acc[r] = 0.f;
        float ss = 0.f;
#pragma unroll 4
        for (int q = 0; q < 32; ++q) { const f32x4 xv = xp[2 * q]; ss += (xv.x * xv.x + xv.y * xv.y) + (xv.z * xv.z + xv.w * xv.w);
#pragma unroll
            for (int j = 0; j < 4; ++j) acc = __builtin_amdgcn_mfma_f32_32x32x2f32(xv[j], bp[(8 * q + j) * 32], acc, 0, 0, 0); }
        __syncthreads();
        { LAS float* part = rw + (tile * 4 + wq) * 1024;
#pragma unroll
          for (int r = 0; r < 16; ++r) part[((r & 3) + 8 * (r >> 2) + 4 * h) * 32 + i32] = acc[r];
          rw[8192 + (tile * 4 + wq) * 64 + lane] = ss; }
        __syncthreads();
        if (F.tid < 64) { const int t = F.tid, tl = t >> 5, row = t & 31; const size_t m = (size_t)grp * 64 + t;
            float s = 0.f;
#pragma unroll
            for (int q = 0; q < 4; ++q) s += rw[8192 + (tl * 4 + q) * 64 + row] + rw[8192 + (tl * 4 + q) * 64 + 32 + row];
            const float rstd = 1.0f / sqrtf(s * (1.f / D_MODEL) + NORM_EPS);
            float lg[32];
#pragma unroll
            for (int e = 0; e < 32; ++e) { const LAS float* pp = rw + (tl * 4) * 1024 + row * 32 + e; lg[e] = ((pp[0] + pp[1024]) + (pp[2048] + pp[3072])) * rstd + RB[e]; }
            int ti[4]; float tv[4];
#pragma unroll
            for (int k = 0; k < 4; ++k) { float best = -INFINITY; int bi = 0;
#pragma unroll
                for (int e = 0; e < 32; ++e) { const bool taken = (k > 0 && ti[0] == e) || (k > 1 && ti[1] == e) || (k > 2 && ti[2] == e); if (!taken && lg[e] > best) { best = lg[e]; bi = e; } }
                ti[k] = bi; tv[k] = best; }
            const float e1 = __expf(tv[1] - tv[0]), e2 = __expf(tv[2] - tv[0]), e3 = __expf(tv[3] - tv[0]); const float inv = 1.0f / (1.0f + e1 + e2 + e3);
            { typedef int i32x4 __attribute__((ext_vector_type(4))); *(GAS i32x4*)(topi + m * 4) = (i32x4){ti[0], ti[1], ti[2], ti[3]}; } *(GAS f32x4*)(topg + m * 4) = (f32x4){inv, e1 * inv, e2 * inv, e3 * inv};
#pragma unroll
            for (int k = 0; k < 4; ++k) __hip_atomic_fetch_add(hist + ti[k], 1, __ATOMIC_RELAXED, __HIP_MEMORY_SCOPE_WORKGROUP); }
        __syncthreads();
    }
    { const int t_ = opq(F.tid); if (t_ < 32 && hist[t_] != 0) __hip_atomic_fetch_add((unsigned*)(F.ctl + CW_CNT) + 64 * t_, (unsigned)hist[t_], __ATOMIC_RELAXED, __HIP_MEMORY_SCOPE_AGENT); }
}
__device__ __forceinline__ void moe_table(Frame& F) {
    LAS int* tab = (LAS int*)(F.lds + MOETAB_OFF);
    __syncthreads();
    if (F.tid < 64) {
        const int e = opq(F.tid); int nb = 0;
        if (e < 32) { const int c = (int)__hip_atomic_load((unsigned*)(F.ctl + CW_CNT) + 64 * e, __ATOMIC_RELAXED, __HIP_MEMORY_SCOPE_AGENT); nb = (c + MOE_ROWS - 1) / MOE_ROWS; }
        int acc = 0;
#pragma unroll
        for (int j = 0; j < 32; ++j) { const int v = __builtin_amdgcn_readlane(nb, j); acc += (j < e) ? v : 0; }
        if (e < 32) { tab[320 + e] = acc * MOE_ROWS; for (int q = 0; q < nb; ++q) tab[1 + acc + q] = e; }
        if (e == 32) tab[0] = acc; }
    __syncthreads();
}
__device__ __forceinline__ void p9_dispatch(Frame& F, const Args& args) {
    const int lane = F.lane;
    unsigned char* ws = F.ws;
    moe_table(F);
    const LAS int* tab = (const LAS int*)(F.lds + MOETAB_OFF);
    LAS int* hist = (LAS int*)(F.lds + HIST_OFF); LAS int* base = hist + 32; LAS int* slots = hist + 64;
    const int* topi = (const int*)(ws + WS_ROUTE + RT_TOPI); const float* topg = (const float*)(ws + WS_ROUTE + RT_TOPG);
    int* pos = (int*)(ws + WS_ROUTE + RT_POS); float* rowgate = (float*)(ws + WS_ROUTE + RT_ROWGATE);
    bf16* XS = (bf16*)(ws + WS_XS); const float* gain = ldarg(I_NORM_FFN);
    for (int grp = F.vcu; grp < MTOK / 64; grp += F.G) {
        const int t_ = opq(F.tid);
        if (t_ < 32) hist[t_] = 0;
        f32x4 v[8][4];
#pragma unroll
        for (int i = 0; i < 8; ++i) { const GAS f32x4* xr = (const GAS f32x4*)(F.out + ((size_t)grp * 64 + F.wave * 8 + i) * D_MODEL) + 2 * lane;
#pragma unroll
            for (int j = 0; j < 4; ++j) v[i][j] = xr[128 * (j >> 1) + (j & 1)]; }
        const GAS f32x4* gr = (const GAS f32x4*)gain + 2 * lane; const f32x4 g00 = gr[0], g01 = gr[1], g10 = gr[128], g11 = gr[129];
        __syncthreads();
        int e = 0, rank = 0;
        if (F.tid < 256) { e = topi[(size_t)grp * 256 + F.tid]; rank = __hip_atomic_fetch_add(hist + e, 1, __ATOMIC_RELAXED, __HIP_MEMORY_SCOPE_WORKGROUP); }
        __syncthreads();
        if (F.tid < 32) { const int h = hist[F.tid]; int b0 = 0; if (h != 0) b0 = (int)__hip_atomic_fetch_add((unsigned*)(F.ctl + CW_CUR) + 64 * F.tid, (unsigned)h, __ATOMIC_RELAXED, __HIP_MEMORY_SCOPE_AGENT); base[F.tid] = tab[320 + F.tid] + b0; }
        __syncthreads();
        if (F.tid < 256) { const int slot = base[e] + rank; pos[(size_t)grp * 256 + F.tid] = slot; rowgate[slot] = topg[(size_t)grp * 256 + F.tid]; slots[F.tid] = slot; }
        __syncthreads();
        {
#pragma unroll
          for (int i = 0; i < 8; ++i) { const int tl = F.wave * 8 + i;
              float s = 0.f;
#pragma unroll
              for (int j = 0; j < 4; ++j) s += (v[i][j].x * v[i][j].x + v[i][j].y * v[i][j].y) + (v[i][j].z * v[i][j].z + v[i][j].w * v[i][j].w);
              const float rstd = 1.0f / sqrtf(wave_sum(s) * (1.f / D_MODEL) + NORM_EPS);
              unsigned long long o[2];
              { const f32x4 a = v[i][0] * rstd * g00, b = v[i][1] * rstd * g01; o[0] = (unsigned long long)pk4_fp8(a.x, a.y, a.z, a.w) | ((unsigned long long)pk4_fp8(b.x, b.y, b.z, b.w) << 32); }
              { const f32x4 a = v[i][2] * rstd * g10, b = v[i][3] * rstd * g11; o[1] = (unsigned long long)pk4_fp8(a.x, a.y, a.z, a.w) | ((unsigned long long)pk4_fp8(b.x, b.y, b.z, b.w) << 32); }
#pragma unroll
              for (int k = 0; k < 4; ++k) { const int sk = slots[tl * 4 + k]; GAS unsigned long long* dst = (GAS unsigned long long*)((unsigned char*)XS + (size_t)sk * D_MODEL) + lane; dst[0] = o[0]; dst[64] = o[1]; } } }
        __syncthreads();
    }
}
__device__ __forceinline__ void p12_combine(Frame& F) {
    const int gw = F.vcu * NWAVES + F.wave, NGW = F.G * NWAVES, lane = F.lane;
    unsigned char* ws = F.ws;
    const int* pos = (const int*)(ws + WS_ROUTE + RT_POS); const bf16* YR = (const bf16*)(ws + WS_YROWS);
    for (int blk = gw; blk < MTOK / 8; blk += NGW) {
        const int m0 = blk * 8;
        int pk = 0; if (lane < 32) pk = pos[(size_t)m0 * 4 + lane];
#pragma unroll
        for (int tp = 0; tp < 4; ++tp) {
            f32x4 a[2][2], b[2][2]; unsigned long long w[2][2][4];
#pragma unroll
            for (int u = 0; u < 2; ++u) { const int t = 2 * tp + u; GAS f32x4* xo = (GAS f32x4*)(F.out + (size_t)(m0 + t) * D_MODEL) + 2 * lane;
#pragma unroll
                for (int hf = 0; hf < 2; ++hf) { a[u][hf] = xo[128 * hf]; b[u][hf] = xo[128 * hf + 1];
#pragma unroll
                    for (int k = 0; k < 4; ++k) { const int sk = __builtin_amdgcn_readlane(pk, 4 * t + k); w[u][hf][k] = *((const GAS unsigned long long*)((const unsigned char*)YR + (size_t)sk * D_MODEL + 512 * hf) + lane); } } }
#pragma unroll
            for (int u = 0; u < 2; ++u) { const int t = 2 * tp + u; GAS f32x4* xo = (GAS f32x4*)(F.out + (size_t)(m0 + t) * D_MODEL) + 2 * lane;
#pragma unroll
                for (int hf = 0; hf < 2; ++hf) { f32x4 aa = a[u][hf], bb = b[u][hf];
#pragma unroll
                    for (int k = 0; k < 4; ++k) { const unsigned lo_ = (unsigned)w[u][hf][k], hi_ = (unsigned)(w[u][hf][k] >> 32);
                        const f32x2 p0 = __builtin_amdgcn_cvt_pk_f32_fp8(lo_, false), p1 = __builtin_amdgcn_cvt_pk_f32_fp8(lo_, true), p2 = __builtin_amdgcn_cvt_pk_f32_fp8(hi_, false), p3 = __builtin_amdgcn_cvt_pk_f32_fp8(hi_, true);
                        aa[0] += p0.x * 0.0625f; aa[1] += p0.y * 0.0625f; aa[2] += p1.x * 0.0625f; aa[3] += p1.y * 0.0625f; bb[0] += p2.x * 0.0625f; bb[1] += p2.y * 0.0625f; bb[2] += p3.x * 0.0625f; bb[3] += p3.y * 0.0625f; }
                    xo[128 * hf] = aa; xo[128 * hf + 1] = bb; } }
        }
    }
}

constexpr int N_ATT_A = 768, N_ATT_C = 256;
__device__ __forceinline__ swa::BlockRef attn_item(unsigned char* ws, int it) {
    swa::BlockRef r;
    const swa::bf16* Z = (const swa::bf16*)(ws + WS_Z);
    if (it < N_ATT_A) {
        const int h = it & 3, b = (it >> 2) & 1, v = it >> 3;
        int g, rr, qb;
        if (v < 32) { g = 0; rr = 0; qb = v; } else if (v < 64) { g = 1; rr = (v - 32) >> 3; qb = (v - 32) & 7; } else { g = 2; rr = (v - 64) >> 1; qb = (v - 64) & 1; }
        const int d = (g == 0) ? 1 : (g == 1) ? 4 : 16;
        const size_t row0 = (size_t)b * SEQ + rr, qrow = row0 + (size_t)d * qb * 256;
        r.Q = Z + qrow * IN_COLS + OFF_AQ + g * 512 + h * 128; r.K = Z + row0 * IN_COLS + OFF_AK + g * 512 + h * 128; r.V = Z + row0 * IN_COLS + OFF_AV + g * 512 + h * 128;
        r.O = (swa::bf16*)(ws + WS_OP) + (size_t)g * MTOK * 512 + qrow * 512 + h * 128; r.LSE = (float*)(ws + WS_LSE) + (size_t)g * MTOK * 4 + qrow * 4 + h;
        r.QS = d * IN_COLS; r.KS = d * IN_COLS; r.OS = d * 512; r.LS = d * 4; r.P0 = qb * 256; r.skv = SEQ / d; r.W = 129;
    } else {
        const int u = it - N_ATT_A, h = u & 3, b = (u >> 2) & 1, qb = u >> 3;
        const size_t qrow = (size_t)b * SEQ + (size_t)qb * 256;
        const swa::bf16* KV = (const swa::bf16*)(ws + WS_KVM) + (size_t)b * MEM_LEN * 1024 + h * 128;
        r.Q = Z + qrow * IN_COLS + OFF_CQ + h * 128; r.K = KV; r.V = KV + 512;
        r.O = (swa::bf16*)(ws + WS_YABC) + qrow * 1536 + 1024 + h * 128; r.LSE = nullptr;
        r.QS = IN_COLS; r.KS = 1024; r.OS = 1536; r.LS = 0; r.P0 = 256; r.skv = MEM_LEN; r.W = 1 << 20;
    }
    return r;
}
__device__ __forceinline__ void p3_attention_mfma(unsigned char* ws, char* lds, int G) {
    const int total = N_ATT_A + N_ATT_C; int L = blockIdx.x; if (L >= total) return;
    swa::BlockRef cur = attn_item(ws, L); swa::Seam S;
    swa::swa_prime(cur, lds, S);
    for (;;) {
        const int Ln = L + G; const bool last = Ln >= total;
        const swa::BlockRef nxt = last ? cur : attn_item(ws, Ln);
        swa::swa_block(cur, nxt, lds, S);
        if (last) break;
        cur = nxt; L = Ln;
    }
}

constexpr int N_RITEMS = BATCH * 8 * (SEQ / 64);
constexpr size_t WS_PHI = WS_XN;
constexpr size_t WS_PSI = WS_XN + 16 * MiB;
constexpr size_t WS_GAM = WS_YS;
constexpr size_t WS_OM = WS_XN2;
constexpr size_t WS_XFR = WS_MRG + 48 * MiB;
constexpr size_t WS_BONUS = WS_MRGB + 1 * MiB;
constexpr int RB = 9216, RLD = 72;
constexpr int R1_SEG = 15 * RB, R1_WC = R1_SEG + 2048;
static_assert(R1_WC + 256 <= LDSCTL_OFF, "R1 LDS map");
typedef LAS unsigned short* lbf_t;
__device__ __forceinline__ f32x4 r1_tile(const LAS unsigned short* X, const LAS unsigned short* Yt, int mi, int ni, f32x4 acc, int fr, int fq) {
    const LAS unsigned short* xp = X + (16 * mi + fr) * RLD + 8 * fq; const LAS unsigned short* yp = Yt + (16 * ni + fr) * RLD + 8 * fq;
    const bf16x8 a0 = *(const LAS bf16x8*)xp, a1 = *(const LAS bf16x8*)(xp + 32), b0 = *(const LAS bf16x8*)yp, b1 = *(const LAS bf16x8*)(yp + 32);
    acc = __builtin_amdgcn_mfma_f32_16x16x32_bf16(b0, a0, acc, 0, 0, 0);
    acc = __builtin_amdgcn_mfma_f32_16x16x32_bf16(b1, a1, acc, 0, 0, 0);
    return acc;
}
__device__ __forceinline__ void r1_store(LAS unsigned short* dst, int mi, int ni, f32x4 acc, int mode, bool addI, const LAS unsigned short* addT, int fr, int fq) {
    const int m = 16 * mi + fr, n0 = 16 * ni + 4 * fq;
#pragma unroll
    for (int r = 0; r < 4; ++r) { const int n = n0 + r; bool keep = true;
        if (mode == 1) keep = n < m; else if (mode == 2) keep = n <= m; else if (mode == 3) keep = m < n;
        float v = keep ? acc[r] : 0.f; if (addI && m == n) v += 1.0f; acc[r] = v; }
    if (addT != nullptr) { const unsigned long long w = *(const LAS unsigned long long*)(addT + m * RLD + n0);
        acc[0] += bf_lo((unsigned)w); acc[1] += bf_hi((unsigned)w); acc[2] += bf_lo((unsigned)(w >> 32)); acc[3] += bf_hi((unsigned)(w >> 32)); }
    *(LAS unsigned long long*)(dst + m * RLD + n0) = (unsigned long long)pk2(acc[0], acc[1]) | ((unsigned long long)pk2(acc[2], acc[3]) << 32);
}
#define R1BUF(i) ((LAS unsigned short*)(F.lds + (i) * RB))
template <int MODE> __device__ __forceinline__ void p_r1(Frame& F, const Args& args) {
    unsigned char* ws = F.ws; const int lane0 = F.lane, wave = F.wave;
    const bf16* Z = (const bf16*)(ws + WS_Z);
    const float* rkp = ldarg(I_R_RK); const float* mu = ldarg(I_R_MU); const float* w0p = ldarg(I_R_W0); const float* a0p = ldarg(I_R_A0); const float* kkp = ldarg(I_R_KK); const float* kap = ldarg(I_R_KA);
    const float* w1src = ldarg(I_EXP_W1);
    const bf16* W2T = (const bf16*)(ws + WS_LORA); const bf16* A2T = W2T + 512 * 64; const bf16* G2T = A2T + 512 * 64;
    bf16* VM = (bf16*)(ws + WS_VMIX); bf16* GM = (bf16*)(ws + WS_GMIX);
    LAS float* segsum = (LAS float*)(F.lds + R1_SEG); LAS float* wcs = (LAS float*)(F.lds + R1_WC);
    unsigned short zv[7][9];
#define R1LOAD(it_) do { const int bh_ = (it_) >> 7, c_ = (it_) & 127, h_ = bh_ & 7, t0_ = c_ * 64 + 8 * wave; \
        const bf16* zp_ = Z + ((size_t)(bh_ >> 3) * SEQ + t0_) * IN_COLS + OFF_R + lane; \
        _Pragma("unroll") for (int i = 0; i < 9; ++i) { const bool ok_ = (i > 0) || (t0_ > 0); const bf16* rp_ = zp_ + ((long)i - 1) * IN_COLS; const bf16* rq_ = rp_ + 64 * h_;     \
            zv[0][i] = ok_ ? rp_[1536] : (unsigned short)0; zv[1][i] = ok_ ? rp_[1600] : (unsigned short)0; zv[2][i] = ok_ ? rp_[1664] : (unsigned short)0; zv[3][i] = ok_ ? rp_[1728] : (unsigned short)0; \
            zv[4][i] = ok_ ? rq_[0] : (unsigned short)0; zv[5][i] = ok_ ? rq_[512] : (unsigned short)0; zv[6][i] = ok_ ? rq_[1024] : (unsigned short)0; } } while (0)
#define ZF(x) __builtin_bit_cast(float, (unsigned)(x) << 16)
    { const int lane = lane0; if (F.vcu < N_RITEMS) R1LOAD(F.vcu); }
    for (int item = F.vcu; item < N_RITEMS; item += F.G) {
        const int lane = opq(lane0), fr = lane & 15, fq = lane >> 4;
        const int bh = item >> 7, c = item & 127, b = bh >> 3, h = bh & 7;
        const size_t row0 = (size_t)b * SEQ + (size_t)c * 64;
        f32x4 tcv[16]; const float* tcW; unsigned char* tcWT; int tck0, tcn0, tcrb;
        w1_tile(item * 8 + wave, w1src, ws + WS_W1, tcW, tcWT, tck0, tcn0, tcrb); tc8_load(tcW, 2048, tck0, tcn0, lane, tcv);
        const f32x4 zero4 = (f32x4){0.f, 0.f, 0.f, 0.f};
        const int mw = wave >> 2, nw = wave & 3;
        float r[8], lw[8], kx[8], vx[8], ax[8], bx[8];
        { const int k = lane, tq = wave, ch = h * 64 + k;
#pragma unroll
          for (int g = 0; g < 4; ++g) { const float mug = mu[1536 + 64 * g + k];
#pragma unroll
              for (int i = 0; i < 8; ++i) { const float cur = ZF(zv[g][i + 1]), prv = ZF(zv[g][i]); float x = cur + (prv - cur) * mug;
                  x = (g == 0) ? fast_tanh(x) : (g == 1) ? x : fast_sigm(x); const unsigned short xb = (unsigned short)f2bf(x); const int t = 8 * tq + i;
                  if (g == 0) R1BUF(11)[t * RLD + k] = xb; else if (g == 1) R1BUF(12)[t * RLD + k] = xb; else R1BUF(13)[t * 136 + 64 * (g - 2) + k] = xb; } }
          { const int tid_ = wave * 64 + lane, row = tid_ >> 3, chk = tid_ & 7;
            *(LAS v4u*)(R1BUF(5) + row * RLD + chk * 8) = *(const GAS v4u*)(W2T + (size_t)(64 * h + row) * 64 + chk * 8);
            *(LAS v4u*)(R1BUF(6) + row * RLD + chk * 8) = *(const GAS v4u*)(A2T + (size_t)(64 * h + row) * 64 + chk * 8);
#pragma unroll
            for (int hh = 0; hh < 2; ++hh) { const int rg = (tid_ >> 4) + 32 * hh, cg = tid_ & 15;
                *(LAS v4u*)(R1BUF(7) + rg * 136 + cg * 8) = *(const GAS v4u*)(G2T + (size_t)(64 * h + rg) * 128 + cg * 8); } }
          __syncthreads();
          { f32x4 dw0, dw1, da0, da1, dg0 = zero4, dg1 = zero4;
            { const LAS unsigned short* yp_ = R1BUF(5) + (16 * nw + fr) * RLD + 8 * fq; const LAS unsigned short* xp_ = R1BUF(11) + (16 * mw + fr) * RLD + 8 * fq;
              const bf16x8 y0_ = *(const LAS bf16x8*)yp_, y1_ = *(const LAS bf16x8*)(yp_ + 32), xa0_ = *(const LAS bf16x8*)xp_, xa1_ = *(const LAS bf16x8*)(xp_ + 32), xb0_ = *(const LAS bf16x8*)(xp_ + 32 * RLD), xb1_ = *(const LAS bf16x8*)(xp_ + 32 * RLD + 32);
              dw0 = __builtin_amdgcn_mfma_f32_16x16x32_bf16(y0_, xa0_, zero4, 0, 0, 0); dw1 = __builtin_amdgcn_mfma_f32_16x16x32_bf16(y0_, xb0_, zero4, 0, 0, 0);
              dw0 = __builtin_amdgcn_mfma_f32_16x16x32_bf16(y1_, xa1_, dw0, 0, 0, 0); dw1 = __builtin_amdgcn_mfma_f32_16x16x32_bf16(y1_, xb1_, dw1, 0, 0, 0); }
            { const LAS unsigned short* yp_ = R1BUF(6) + (16 * nw + fr) * RLD + 8 * fq; const LAS unsigned short* xp_ = R1BUF(12) + (16 * mw + fr) * RLD + 8 * fq;
              const bf16x8 y0_ = *(const LAS bf16x8*)yp_, y1_ = *(const LAS bf16x8*)(yp_ + 32), xa0_ = *(const LAS bf16x8*)xp_, xa1_ = *(const LAS bf16x8*)(xp_ + 32), xb0_ = *(const LAS bf16x8*)(xp_ + 32 * RLD), xb1_ = *(const LAS bf16x8*)(xp_ + 32 * RLD + 32);
              da0 = __builtin_amdgcn_mfma_f32_16x16x32_bf16(y0_, xa0_, zero4, 0, 0, 0); da1 = __builtin_amdgcn_mfma_f32_16x16x32_bf16(y0_, xb0_, zero4, 0, 0, 0);
              da0 = __builtin_amdgcn_mfma_f32_16x16x32_bf16(y1_, xa1_, da0, 0, 0, 0); da1 = __builtin_amdgcn_mfma_f32_16x16x32_bf16(y1_, xb1_, da1, 0, 0, 0); }
            { const LAS unsigned short* yp_ = R1BUF(7) + (16 * nw + fr) * 136 + 8 * fq; const LAS unsigned short* xp_ = R1BUF(13) + (16 * mw + fr) * 136 + 8 * fq;
#pragma unroll
              for (int kk = 0; kk < 4; ++kk) { const bf16x8 y_ = *(const LAS bf16x8*)(yp_ + 32 * kk), xa_ = *(const LAS bf16x8*)(xp_ + 32 * kk), xb_ = *(const LAS bf16x8*)(xp_ + 32 * 136 + 32 * kk);
                  dg0 = __builtin_amdgcn_mfma_f32_16x16x32_bf16(y_, xa_, dg0, 0, 0, 0); dg1 = __builtin_amdgcn_mfma_f32_16x16x32_bf16(y_, xb_, dg1, 0, 0, 0); } }
            const int o0 = (16 * mw + fr) * 68 + 16 * nw + 4 * fq, o1 = o0 + 32 * 68;
            *(LAS f32x4*)((LAS float*)R1BUF(0) + o0) = dw0; *(LAS f32x4*)((LAS float*)R1BUF(0) + o1) = dw1;
            *(LAS f32x4*)((LAS float*)R1BUF(2) + o0) = da0; *(LAS f32x4*)((LAS float*)R1BUF(2) + o1) = da1;
            *(LAS f32x4*)((LAS float*)R1BUF(9) + o0) = dg0; *(LAS f32x4*)((LAS float*)R1BUF(9) + o1) = dg1; }
          __syncthreads();
          { const float w0c = w0p[ch], a0c = a0p[ch], kkc = kkp[ch], kac = kap[ch], mur = mu[ch], muk = mu[512 + ch], muv = mu[1024 + ch];
#pragma unroll
            for (int i = 0; i < 8; ++i) { const int t = 8 * tq + i;
                const float dwv = ((const LAS float*)R1BUF(0))[t * 68 + k], dav = ((const LAS float*)R1BUF(2))[t * 68 + k], dgv = ((const LAS float*)R1BUF(9))[t * 68 + k];
                const float cr = ZF(zv[4][i + 1]), pr = ZF(zv[4][i]), ck = ZF(zv[5][i + 1]), pk = ZF(zv[5][i]), cv = ZF(zv[6][i + 1]), pv = ZF(zv[6][i]);
                const float rr = cr + (pr - cr) * mur, kr = ck + (pk - ck) * muk, vr = cv + (pv - cv) * muv;
                const float y = -(w0c + dwv); const float sp = fast_softplus(y);
                lw[i] = -__expf(-sp - 0.5f);
                const float av = fast_sigm(a0c + dav);
                const float kkv = kr * kkc; const float ssq = wave_sum(kkv * kkv); const float kkn = kkv * __builtin_amdgcn_rsqf(fmaxf(ssq, 1e-24f));
                r[i] = rr; vx[i] = vr; kx[i] = kr * (1.0f + (av - 1.0f) * kac); ax[i] = -kkn; bx[i] = kkn * av;
                if (MODE == 0) { VM[(row0 + t) * RW + ch] = (bf16)f2bf(vr); GM[(row0 + t) * RW + ch] = (bf16)f2bf(dgv); } } }
        }
        if (item + F.G < N_RITEMS) R1LOAD(item + F.G);
        { const int k = lane, tq = wave;
          float cs[8]; cs[0] = lw[0];
#pragma unroll
          for (int i = 1; i < 8; ++i) cs[i] = cs[i - 1] + lw[i];
          segsum[tq * 64 + k] = cs[7];
          const float rk = rkp[h * 64 + k];
#pragma unroll
          for (int i = 0; i < 8; ++i) { const float bs = wave_sum(r[i] * kx[i] * rk); if (MODE == 0 && lane == 0) *(GAS float*)((float*)(ws + WS_BONUS) + (row0 + 8 * tq + i) * 8 + h) = bs; }
          __syncthreads();
          float pre = 0.f;
#pragma unroll
          for (int q = 0; q < 7; ++q) { const float sv = segsum[q * 64 + k]; pre += (q < tq) ? sv : 0.f; }
          unsigned short at[8], rt[8], bt[8], kt[8], vt[8];
#pragma unroll
          for (int i = 0; i < 8; ++i) { const float L = pre + cs[i], Lp = L - lw[i]; const float e = __expf(L), ep = __expf(Lp), ei = __expf(-L);
              at[i] = (unsigned short)f2bf(ax[i] * ep); rt[i] = (unsigned short)f2bf(r[i] * e); bt[i] = (unsigned short)f2bf(bx[i] * ei); kt[i] = (unsigned short)f2bf(kx[i] * ei); vt[i] = (unsigned short)f2bf(vx[i]);
              if (i == 7 && tq == 7) wcs[k] = e; }
#pragma unroll
          for (int i = 0; i < 8; ++i) { const int o = (8 * tq + i) * RLD + k; R1BUF(8)[o] = at[i]; R1BUF(4)[o] = rt[i]; R1BUF(9)[o] = bt[i]; R1BUF(10)[o] = kt[i]; }
          const int ot = k * RLD + 8 * tq;
#define PK8(x) ((v4u){(unsigned)x[0] | ((unsigned)x[1] << 16), (unsigned)x[2] | ((unsigned)x[3] << 16), (unsigned)x[4] | ((unsigned)x[5] << 16), (unsigned)x[6] | ((unsigned)x[7] << 16)})
          *(LAS v4u*)(R1BUF(0) + ot) = PK8(at); *(LAS v4u*)(R1BUF(1) + ot) = PK8(bt); *(LAS v4u*)(R1BUF(2) + ot) = PK8(kt); *(LAS v4u*)(R1BUF(3) + ot) = PK8(vt);
#undef PK8
        }
        __syncthreads();
#define R1PAIR(X, Y, a0, a1) do { const LAS unsigned short* yp_ = (Y) + (16 * nw + fr) * RLD + 8 * fq; const LAS unsigned short* xp_ = (X) + (16 * mw + fr) * RLD + 8 * fq; \
            const bf16x8 y0_ = *(const LAS bf16x8*)yp_, y1_ = *(const LAS bf16x8*)(yp_ + 32), xa0_ = *(const LAS bf16x8*)xp_, xa1_ = *(const LAS bf16x8*)(xp_ + 32), xb0_ = *(const LAS bf16x8*)(xp_ + 32 * RLD), xb1_ = *(const LAS bf16x8*)(xp_ + 32 * RLD + 32); \
            a0 = __builtin_amdgcn_mfma_f32_16x16x32_bf16(y0_, xa0_, zero4, 0, 0, 0); a1 = __builtin_amdgcn_mfma_f32_16x16x32_bf16(y0_, xb0_, zero4, 0, 0, 0); \
            a0 = __builtin_amdgcn_mfma_f32_16x16x32_bf16(y1_, xa1_, a0, 0, 0, 0); a1 = __builtin_amdgcn_mfma_f32_16x16x32_bf16(y1_, xb1_, a1, 0, 0, 0); } while (0)
#define R1ST2(dst, a0, a1, mode, addI, addT) do { r1_store(dst, mw, nw, a0, mode, addI, addT, fr, fq); r1_store(dst, mw + 2, nw, a1, mode, addI, addT, fr, fq); } while (0)
        { f32x4 n0, n1, t0, t1, l0, l1, b0, b1, k0, k1;
          R1PAIR(R1BUF(8), R1BUF(9), n0, n1); R1PAIR(R1BUF(9), R1BUF(8), t0, t1); R1PAIR(R1BUF(8), R1BUF(10), l0, l1); R1PAIR(R1BUF(4), R1BUF(9), b0, b1); R1PAIR(R1BUF(4), R1BUF(10), k0, k1);
          R1ST2(R1BUF(11), n0, n1, 1, false, nullptr); R1ST2(R1BUF(13), n0, n1, 1, true, nullptr); R1ST2(R1BUF(12), t0, t1, 3, false, nullptr);
          R1ST2(R1BUF(5), l0, l1, 1, false, nullptr); R1ST2(R1BUF(6), b0, b1, 2, false, nullptr); R1ST2(R1BUF(7), k0, k1, 2, false, nullptr); }
        __syncthreads();
        { f32x4 n0, n1, t0, t1, e0, e1;
          R1PAIR(R1BUF(11), R1BUF(12), n0, n1); R1PAIR(R1BUF(12), R1BUF(11), t0, t1); R1PAIR(R1BUF(3), R1BUF(5), e0, e1);
          R1ST2(R1BUF(8), n0, n1, 0, false, nullptr); R1ST2(R1BUF(9), t0, t1, 0, false, nullptr); R1ST2(R1BUF(10), e0, e1, 0, false, nullptr); }
        __syncthreads();
#pragma unroll 1
        for (int lv = 0; lv < 5; ++lv) {
            const bool srcB = (lv & 1) == 0;
            LAS unsigned short* sN = srcB ? R1BUF(8) : R1BUF(11); LAS unsigned short* sNT = srcB ? R1BUF(9) : R1BUF(12);
            LAS unsigned short* dN = srcB ? R1BUF(11) : R1BUF(8); LAS unsigned short* dNT = srcB ? R1BUF(12) : R1BUF(9);
            LAS unsigned short* Tc = (lv & 1) ? R1BUF(14) : R1BUF(13); LAS unsigned short* Tn = (lv & 1) ? R1BUF(13) : R1BUF(14);
            f32x4 u0, u1, t0 = zero4, t1 = zero4, n0 = zero4, n1 = zero4;
            R1PAIR(Tc, sNT, u0, u1);
            if (lv < 4) R1PAIR(sNT, sN, t0, t1);
            if (lv < 3) R1PAIR(sN, sNT, n0, n1);
            R1ST2(Tn, u0, u1, 0, false, Tc);
            if (lv < 4) R1ST2(dNT, t0, t1, 0, false, nullptr);
            if (lv < 3) R1ST2(dN, n0, n1, 0, false, nullptr);
            __syncthreads();
        }
        { f32x4 g0, g1, q0, q1;
          R1PAIR(R1BUF(0), R1BUF(14), g0, g1); R1PAIR(R1BUF(10), R1BUF(14), q0, q1);
          R1ST2(R1BUF(11), g0, g1, 0, false, nullptr); R1ST2(R1BUF(12), q0, q1, 0, false, nullptr); }
        __syncthreads();
#undef R1PAIR
#undef R1ST2
        { const int mi = wave >> 1, ks = wave & 1;
          const f32x4 p0 = r1_tile(R1BUF(1), R1BUF(11), mi, 2 * ks, zero4, fr, fq), p1 = r1_tile(R1BUF(1), R1BUF(11), mi, 2 * ks + 1, zero4, fr, fq);
          const f32x4 s0 = r1_tile(R1BUF(6), R1BUF(11), mi, 2 * ks, zero4, fr, fq), s1 = r1_tile(R1BUF(6), R1BUF(11), mi, 2 * ks + 1, zero4, fr, fq);
          const int m = 16 * mi + fr; const float wc = wcs[m];
          float ph[8], ps[8];
#pragma unroll
          for (int r = 0; r < 4; ++r) { const int n0 = 32 * ks + 4 * fq + r, n1 = n0 + 16;
              ph[r] = (p0[r] + (m == n0 ? 1.f : 0.f)) * wc; ph[4 + r] = (p1[r] + (m == n1 ? 1.f : 0.f)) * wc; }
          { const unsigned long long w0 = *(const LAS unsigned long long*)(R1BUF(4) + m * RLD + 32 * ks + 4 * fq), w1 = *(const LAS unsigned long long*)(R1BUF(4) + m * RLD + 32 * ks + 16 + 4 * fq);
            ps[0] = s0[0] + bf_lo((unsigned)w0); ps[1] = s0[1] + bf_hi((unsigned)w0); ps[2] = s0[2] + bf_lo((unsigned)(w0 >> 32)); ps[3] = s0[3] + bf_hi((unsigned)(w0 >> 32));
            ps[4] = s1[0] + bf_lo((unsigned)w1); ps[5] = s1[1] + bf_hi((unsigned)w1); ps[6] = s1[2] + bf_lo((unsigned)(w1 >> 32)); ps[7] = s1[3] + bf_hi((unsigned)(w1 >> 32)); }
          const size_t fo = (((size_t)item * 4 + mi) * 2 + ks) * 64 + lane;
          if (MODE == 0) *((GAS v4u*)(ws + WS_PHI) + fo) = (v4u){pk2(ph[0], ph[1]), pk2(ph[2], ph[3]), pk2(ph[4], ph[5]), pk2(ph[6], ph[7])};
          if (MODE == 0) *((GAS v4u*)(ws + WS_PSI) + fo) = (v4u){pk2(ps[0], ps[1]), pk2(ps[2], ps[3]), pk2(ps[4], ps[5]), pk2(ps[6], ps[7])};
          const int vb = wave >> 1;
#pragma unroll
          for (int hh = 0; hh < 2; ++hh) { const int mt = 2 * (wave & 1) + hh;
              f32x4 ga = r1_tile(R1BUF(12), R1BUF(1), vb, mt, zero4, fr, fq); ga = r1_tile(R1BUF(3), R1BUF(2), vb, mt, ga, fr, fq);
              f32x4 om = r1_tile(R1BUF(12), R1BUF(6), vb, mt, zero4, fr, fq); om = r1_tile(R1BUF(3), R1BUF(7), vb, mt, om, fr, fq);
#pragma unroll
              for (int r = 0; r < 4; ++r) ga[r] *= wcs[16 * mt + 4 * fq + r];
              const size_t ao = (((size_t)item * 4 + vb) * 4 + mt) * 64 + lane;
              if (MODE == 0) { *((GAS unsigned long long*)(ws + WS_GAM) + ao) = (unsigned long long)pk2(ga[0], ga[1]) | ((unsigned long long)pk2(ga[2], ga[3]) << 32); *((GAS f32x4*)(ws + WS_OM) + ao) = om; } else { asm volatile("" :: "v"(ga), "v"(om)); } }
        }
        tc8_store(tcWT, 1024, tck0, tcrb, lane, tcv, W8_SCALE);
        __syncthreads();
    }
}
#undef R1BUF
#undef R1LOAD
#undef ZF
constexpr bool R2_HELPER = false;
struct R2Buf { bf16x8 ph[4][2]; unsigned long long ga[4]; };
__device__ __forceinline__ void r2_load(R2Buf& B, const unsigned char* ws, int item, int vb, int lane) {
#pragma unroll
    for (int mt = 0; mt < 4; ++mt) {
#pragma unroll
        for (int ks = 0; ks < 2; ++ks) B.ph[mt][ks] = *((const GAS bf16x8*)(ws + WS_PHI) + (((size_t)item * 4 + mt) * 2 + ks) * 64 + lane);
        B.ga[mt] = *((const GAS unsigned long long*)(ws + WS_GAM) + (((size_t)item * 4 + vb) * 4 + mt) * 64 + lane); }
}
__device__ __forceinline__ void r2_step(const R2Buf& B, f32x4 (&acc)[4], unsigned char* ws, int item, int vb, int lane) {
    v4u x0, x1;
    x0.x = pk2(acc[0][0], acc[0][1]); x0.y = pk2(acc[0][2], acc[0][3]); x0.z = pk2(acc[1][0], acc[1][1]); x0.w = pk2(acc[1][2], acc[1][3]);
    x1.x = pk2(acc[2][0], acc[2][1]); x1.y = pk2(acc[2][2], acc[2][3]); x1.z = pk2(acc[3][0], acc[3][1]); x1.w = pk2(acc[3][2], acc[3][3]);
    GAS v4u* xo = (GAS v4u*)(ws + WS_XFR) + (((size_t)item * 4 + vb) * 2) * 64 + lane; xo[0] = x0; xo[64] = x1;
    const bf16x8 f0 = __builtin_bit_cast(bf16x8, x0), f1 = __builtin_bit_cast(bf16x8, x1);
#pragma unroll
    for (int mt = 0; mt < 4; ++mt) { const unsigned g0 = (unsigned)B.ga[mt], g1 = (unsigned)(B.ga[mt] >> 32);
        f32x4 a; a[0] = __builtin_bit_cast(float, g0 << 16); a[1] = __builtin_bit_cast(float, g0 & 0xffff0000u); a[2] = __builtin_bit_cast(float, g1 << 16); a[3] = __builtin_bit_cast(float, g1 & 0xffff0000u);
        a = __builtin_amdgcn_mfma_f32_16x16x32_bf16(B.ph[mt][0], f0, a, 0, 0, 0);
        a = __builtin_amdgcn_mfma_f32_16x16x32_bf16(B.ph[mt][1], f1, a, 0, 0, 0);
        acc[mt] = a; }
}
__device__ __forceinline__ void p_r2(Frame& F) {
    if (blockIdx.x < BATCH * 8 * 4 && F.wave == 0) {
        unsigned char* ws = F.ws; const int bh = blockIdx.x >> 2, vb = blockIdx.x & 3, lane = F.lane;
        f32x4 acc[4];
#pragma unroll
        for (int i = 0; i < 4; ++i) acc[i] = (f32x4){0.f, 0.f, 0.f, 0.f};
        R2Buf A, B, C, D, E;
        const int it0 = bh * 128;
        r2_load(A, ws, it0, vb, lane); r2_load(B, ws, it0 + 1, vb, lane); r2_load(C, ws, it0 + 2, vb, lane); r2_load(D, ws, it0 + 3, vb, lane);
#define R2SB() __builtin_amdgcn_sched_barrier(0)
#define R2IT(c_) (it0 + ((c_) < 128 ? (c_) : 127))
#pragma unroll
        for (int c = 0; c < 125; c += 5) {
            r2_load(E, ws, R2IT(c + 4), vb, lane); R2SB(); r2_step(A, acc, ws, it0 + c, vb, lane); R2SB();
            r2_load(A, ws, R2IT(c + 5), vb, lane); R2SB(); r2_step(B, acc, ws, it0 + c + 1, vb, lane); R2SB();
            r2_load(B, ws, R2IT(c + 6), vb, lane); R2SB(); r2_step(C, acc, ws, it0 + c + 2, vb, lane); R2SB();
            r2_load(C, ws, R2IT(c + 7), vb, lane); R2SB(); r2_step(D, acc, ws, it0 + c + 3, vb, lane); R2SB();
            r2_load(D, ws, R2IT(c + 8), vb, lane); R2SB(); r2_step(E, acc, ws, it0 + c + 4, vb, lane); R2SB();
        }
        r2_step(A, acc, ws, it0 + 125, vb, lane); R2SB(); r2_step(B, acc, ws, it0 + 126, vb, lane); R2SB(); r2_step(C, acc, ws, it0 + 127, vb, lane);
#undef R2IT
#undef R2SB
    }
}
__device__ __forceinline__ void p_r3(Frame& F, const Args& args) {
    const int gw = F.vcu * NWAVES + F.wave, NGW = F.G * NWAVES, lane = F.lane, cc = lane & 15, q = lane >> 4;
    unsigned char* ws = F.ws;
    const bf16* VM = (const bf16*)(ws + WS_VMIX); const bf16* GM = (const bf16*)(ws + WS_GMIX);
    const float* bonus = (const float*)(ws + WS_BONUS);
    bf16* YB = (bf16*)(ws + WS_YABC) + 512;
    const float* lnw = ldarg(I_R_LNW); const float* lnb = ldarg(I_R_LNB);
#pragma unroll 2
    for (int wi = gw; wi < N_RITEMS * 4; wi += NGW) {
        const int item = wi >> 2, tt = wi & 3, bh = item >> 7, c = item & 127, b = bh >> 3, h = bh & 7;
        const bf16x8 ps0 = *((const GAS bf16x8*)(ws + WS_PSI) + (((size_t)item * 4 + tt) * 2 + 0) * 64 + lane), ps1 = *((const GAS bf16x8*)(ws + WS_PSI) + (((size_t)item * 4 + tt) * 2 + 1) * 64 + lane);
        f32x4 acc[4];
#pragma unroll
        for (int vb = 0; vb < 4; ++vb) {
            const bf16x8 x0 = *((const GAS bf16x8*)(ws + WS_XFR) + (((size_t)item * 4 + vb) * 2 + 0) * 64 + lane), x1 = *((const GAS bf16x8*)(ws + WS_XFR) + (((size_t)item * 4 + vb) * 2 + 1) * 64 + lane);
            f32x4 a = *((const GAS f32x4*)(ws + WS_OM) + (((size_t)item * 4 + vb) * 4 + tt) * 64 + lane);
            a = __builtin_amdgcn_mfma_f32_16x16x32_bf16(ps0, x0, a, 0, 0, 0);
            a = __builtin_amdgcn_mfma_f32_16x16x32_bf16(ps1, x1, a, 0, 0, 0);
            acc[vb] = a; }
        const size_t rowb = (size_t)b * SEQ + (size_t)c * 64 + 16 * tt + 4 * q;
        unsigned short vmr[4][4], gmr[4][4]; float bnr[4], lw4[4], lb4[4];
#pragma unroll
        for (int vb = 0; vb < 4; ++vb) { const int ch = h * 64 + 16 * vb + cc; lw4[vb] = lnw[ch]; lb4[vb] = lnb[ch]; }
#pragma unroll
        for (int r = 0; r < 4; ++r) { const size_t t = rowb + r; bnr[r] = bonus[t * 8 + h];
#pragma unroll
            for (int vb = 0; vb < 4; ++vb) { const int ch = h * 64 + 16 * vb + cc; vmr[r][vb] = VM[t * RW + ch]; gmr[r][vb] = GM[t * RW + ch]; } }
#pragma unroll
        for (int r = 0; r < 4; ++r) { const size_t t = rowb + r;
            const float s = (acc[0][r] + acc[1][r]) + (acc[2][r] + acc[3][r]);
            const float mean = row16_sum(s) * (1.f / 64.f);
            const float d0 = acc[0][r] - mean, d1 = acc[1][r] - mean, d2 = acc[2][r] - mean, d3 = acc[3][r] - mean;
            const float var = row16_sum((d0 * d0 + d1 * d1) + (d2 * d2 + d3 * d3)) * (1.f / 64.f);
            const float rstd = __builtin_amdgcn_rsqf(var + R_GN_EPS);
            const float bn = bnr[r];
#pragma unroll
            for (int vb = 0; vb < 4; ++vb) { const int ch = h * 64 + 16 * vb + cc; const float d = (vb == 0) ? d0 : (vb == 1) ? d1 : (vb == 2) ? d2 : d3;
                const float yn = d * rstd * lw4[vb] + lb4[vb];
                const float vv = __builtin_bit_cast(float, (unsigned)vmr[r][vb] << 16), gg = __builtin_bit_cast(float, (unsigned)gmr[r][vb] << 16);
                YB[t * 1536 + ch] = (bf16)f2bf((yn + bn * vv) * gg); } }
    }
}

__global__ void __launch_bounds__(NWAVES * 64, 2) skel_fwd(Args args) {
    extern __shared__ __attribute__((aligned(16))) unsigned char lds[];
    Frame F;
    F.lds = (LAS unsigned char*)lds;
    F.MISC = (volatile LAS unsigned*)(F.lds + MISC_OFF);
    phase_enter(F, true);
    F.G = gridDim.x; { const int bx = blockIdx.x; F.vcu = (F.G % 8 == 0) ? (bx % 8) * (F.G / 8) + bx / 8 : bx; }
    unsigned char* ws = args.ws; F.ws = ws; F.out = args.out;
    F.ctl = (gu32*)(ws + WS_CTL);
    for (int u = F.tid; u < (LDS_BYTES - LDSCTL_OFF) / 4; u += NWAVES * 64) ((LAS unsigned*)(F.lds + LDSCTL_OFF))[u] = 0u;
    __syncthreads();
    XcdBarrier bar; bar.bar = (unsigned*)(F.ctl + CW_BAR); bar.x = 0; bar.st = nullptr;
    if (args.use_bar) bar = xcd_barrier_post((unsigned*)(F.ctl + CW_BAR), F.MISC + 8);
    const int lo = args.ph_lo, hi = args.ph_hi;
#define IN(k) (phase_enter(F, lo <= (k) && (k) < hi))
#define SEAM(k) do { if (lo <= (k) && (k) + 1 < hi) xcd_barrier(bar); } while (0)
    const pg8::bf16_t* wsb = (const pg8::bf16_t*)ws;
#define BF(off) ((pg8::bf16_t*)(ws + (off)))

    if (IN(0)) { p0_prologue<0>(F, args, F.vcu * NWAVES + F.wave, F.G * NWAVES); if (F.G <= 64) p0_prologue<1>(F, args, F.vcu * NWAVES + F.wave, F.G * NWAVES); } SEAM(0);
    if (IN(1)) {
        const float* ckg_ = ldarg(I_CK_GAIN);
        pg8::EpiZ E{BF(WS_Z), ldarg(I_B_GATE), ldarg(I_AQ_GAIN), ldarg(I_AK_GAIN), ldarg(I_CQ_GAIN), (const float*)(ws + WS_CS), BF(WS_KVM), ckg_, (PG8_LAS float*)(F.lds + 131072)};
        { pg8::Gemm g{BF(WS_XN), BF(WS_WIN), MTOK + MEMROWS, IN_COLS + 1024, 1024}; pg8::ZOrder<0> S; S.init(F.G, (int)blockIdx.x);
          pg8::gemm_phase<pg8::EpiZ, pg8::ZOrder<0>, true, true>(F.lds + RING_OFF, g, S, E); }
        { pg8::Gemm g{BF(WS_XN8), BF(WS_WIN8), MTOK, IN_COLS, 1024, SC_ONE, SC_W8}; pg8::ZOrder<1> S; S.init(F.G, (int)blockIdx.x);
          pg8::gemm_phase<pg8::EpiZ, pg8::ZOrder<1>, true, true, true>(F.lds + RING_OFF, g, S, E); }
    } SEAM(1);
#if NAIVE_ATTN
    if (IN(3)) { p3_attention(F); } SEAM(3);
#else
    if (IN(3)) { p3_attention_mfma(ws, (char*)lds + RING_OFF, F.G); __syncthreads(); phase_enter(F, true); p_r1<0>(F, args); } SEAM(3);
#endif
    if (IN(4)) { p_r2(F); if (F.G > 64 && blockIdx.x >= 64) p0_prologue<1>(F, args, ((int)blockIdx.x - 64) * NWAVES + F.wave, (F.G - 64) * NWAVES); } SEAM(4);
    if (IN(5)) { p_r3(F, args); p5_post(F, args); } SEAM(5);
    if (IN(6)) {
        pg8::Gemm g{BF(WS_YABC), BF(WS_WB), MTOK, 1024, 1536}; pg8::StaticOrder S; S.init(MTOK, 1024, F.G, (int)blockIdx.x);
        pg8::EpiGate3 E{BF(WS_Z), BF(WS_MRGB)};
        pg8::gemm_phase<pg8::EpiGate3, pg8::StaticOrder, true, true>(F.lds + RING_OFF, g, S, E);
    } SEAM(6);
    if (IN(7)) {
        pg8::Gemm g{BF(WS_MRGB), BF(WS_WO), MTOK, 1024, 1024, SC_M8, SC_W8}; pg8::StaticOrder S; S.init(MTOK, 1024, F.G, (int)blockIdx.x);
        pg8::EpiResF32 E{ldarg(I_X), F.out, 1024};
        pg8::gemm_phase<pg8::EpiResF32, pg8::StaticOrder, true, true, MRG_FP8>(F.lds + RING_OFF, g, S, E);
    } SEAM(7);
    if (IN(8)) { p8_router(F, args); } SEAM(8);
    if (IN(9)) { p9_dispatch(F, args); } SEAM(9);
    if (IN(10)) {
        moe_table(F);
        pg8::Gemm g{BF(WS_XS), BF(WS_W1), 0, 0, 1024, SC_ONE, SC_W8}; pg8::MoeOrder S{(const PG8_LAS int*)(F.lds + MOETAB_OFF), 8, F.G, (int)blockIdx.x};
        pg8::EpiSwiGLU E{ldarg(I_EXP_B1), BF(WS_HACT)};
        pg8::gemm_phase<pg8::EpiSwiGLU, pg8::MoeOrder, true, true, true>(F.lds + RING_OFF, g, S, E);
    } SEAM(10);
    if (IN(11)) {
        moe_table(F);
        pg8::Gemm g{BF(WS_HACT), BF(WS_W2), 0, 0, 1024, SC_H8, SC_W8}; pg8::MoeOrder S{(const PG8_LAS int*)(F.lds + MOETAB_OFF), 4, F.G, (int)blockIdx.x};
        pg8::EpiMoeOut E{ldarg(I_EXP_B2), (const float*)(ws + WS_ROUTE + RT_ROWGATE), BF(WS_YROWS)};
        pg8::gemm_phase<pg8::EpiMoeOut, pg8::MoeOrder, true, true, true>(F.lds + RING_OFF, g, S, E);
    } SEAM(11);
    if (IN(12)) { p12_combine(F); }
#undef IN
#undef SEAM
#undef BF
    (void)wsb;
}

extern "C" void kernel_launch(void* const* d_in, const int* in_sizes, int n_in, void* d_out, int out_size, void* d_ws, size_t ws_size, hipStream_t stream) {
    static int grid = 0;
    if (grid == 0) {
        if (n_in != 32 || out_size != MTOK * D_MODEL || ws_size < WS_END) { fprintf(stderr, "kernel_launch: unexpected problem (n_in %d, out %d, ws %zu); nothing launched\n", n_in, out_size, ws_size); grid = -1; return; }
        int dev = 0, cus = 0;
        if (hipGetDevice(&dev) != hipSuccess || hipDeviceGetAttribute(&cus, hipDeviceAttributeMultiprocessorCount, dev) != hipSuccess) { grid = -1; return; }
        if (hipFuncSetAttribute((const void*)skel_fwd, hipFuncAttributeMaxDynamicSharedMemorySize, LDS_BYTES) != hipSuccess) { fprintf(stderr, "kernel_launch: hipFuncSetAttribute failed\n"); grid = -1; return; }
        (void)hipGetLastError();
        grid = cus;
    }
    if (grid < 0) return;
    (void)hipMemsetAsync((char*)d_ws + WS_CTL, 0, CTL_ZERO_BYTES, stream);
    Args a{};
    for (int i = 0; i < 32; ++i) a.in[i] = (const float*)d_in[i];
    a.out = (float*)d_out; a.ws = (unsigned char*)d_ws;
#if MK_N_LAUNCHES == 1
    a.ph_lo = 0; a.ph_hi = N_PHASES; a.use_bar = 1;
    hipLaunchKernelGGL(skel_fwd, dim3(grid), dim3(NWAVES * 64), LDS_BYTES, stream, a);
#else
    for (int p = 0; p < N_PHASES; ++p) { a.ph_lo = p; a.ph_hi = p + 1; a.use_bar = 0;
        hipLaunchKernelGGL(skel_fwd, dim3(grid), dim3(NWAVES * 64), LDS_BYTES, stream, a); }
#endif
}
```

```cpp
#include <hip/hip_runtime.h>
#include <cstdio>
#include <cstdint>
#include <cmath>
namespace pg8 {
#define PG8_LAS __attribute__((address_space(3)))
typedef unsigned short bf16_t;
typedef short bf16x8 __attribute__((ext_vector_type(8)));
typedef float f32x4 __attribute__((ext_vector_type(4)));
typedef unsigned u32x4 __attribute__((ext_vector_type(4)));
constexpr int BM = 256, BK = 64, HALF = 128, HTB = HALF * BK * 2  , STAGE_BYTES = 8 * HTB, NXCD = 8, WGM = 8;

__host__ __device__ __forceinline__ int lds_byte(int r, int c) { const int st = (r >> 4) * 2 + (c >> 5), rr = r & 15, cc = c & 31, ob = rr * 64 + cc * 2; return st * 1024 + (ob ^ (((ob >> 9) & 1) << 5)); }
__host__ __device__ __forceinline__ void stage_rc(int b, int& R, int& C) { const int st = b / 1024, sb = b % 1024, swz = sb ^ (((sb >> 9) & 1) << 5); R = (st >> 1) * 16 + swz / 64; C = (st & 1) * 32 + (swz % 64) / 2; }
__host__ __device__ __forceinline__ int perm32(int rho) { const int n = rho >> 4, i = rho & 15; return 8 * (i >> 2) + 4 * n + (i & 3); }

struct Unit { int pm, pn; };
typedef int v4i_t __attribute__((ext_vector_type(4))); typedef int v8i_t __attribute__((ext_vector_type(8)));
struct Gemm { const bf16_t* A; const bf16_t* Bt; int M, N, K; int sca = 0x7f7f7f7f, scb = 0x7f7f7f7f; int prof = 0; };
#ifdef PG8_PROF
__device__ unsigned long long pg8_prof[4];
#endif

struct StaticOrder {
    int nM, nN, nwg, G, c;
    __host__ __device__ void init(int M, int N, int G_, int c_) { nM = M / BM; nN = N / BM; nwg = nM * nN; G = G_; c = c_; }
    __host__ __device__ bool next(int i, Unit& u) const {
        const long L = (long)i * G + c; if (L >= nwg) return false;
        int wgid = (int)L; { const int q = nwg / NXCD, r = nwg % NXCD, xcd = wgid % NXCD, off = wgid / NXCD; wgid = (xcd < r ? xcd * (q + 1) : r * (q + 1) + (xcd - r) * q) + off; }
        const int nig = WGM * nN, gid = wgid / nig, fm = gid * WGM, gsz = (nM - fm) < WGM ? (nM - fm) : WGM;
        u.pm = fm + ((wgid % nig) % gsz); u.pn = (wgid % nig) / gsz; return true;
    }
    __device__ __forceinline__ void a_ready(const Unit&) const {}
    __device__ __forceinline__ void done(const Unit&) const {}
};

__device__ __forceinline__ unsigned cvt_pk_bf16(float lo, float hi) { unsigned r; asm volatile("v_cvt_pk_bf16_f32 %0, %1, %2" : "=v"(r) : "v"(lo), "v"(hi)); return r; }
typedef float f32x2 __attribute__((ext_vector_type(2)));
__device__ __forceinline__ f32x2 gelu_pk(f32x2 v) {
    const f32x2 av = __builtin_elementwise_abs(v), d = av * 0.2316418882f + 1.0f;
    f32x2 t; t.x = __builtin_amdgcn_rcpf(d.x); t.y = __builtin_amdgcn_rcpf(d.y);
    f32x2 q = t * 0.5307027145f + (-0.7265760135f); q = q * t + 0.7107068705f; q = q * t + (-0.142248368f); q = q * t + 0.127414796f; q = q * t;
    const f32x2 s = (v * v) * (-0.72134752044f);
    f32x2 e; e.x = __builtin_amdgcn_exp2f(s.x); e.y = __builtin_amdgcn_exp2f(s.y);
    const f32x2 m = v * (q * e), r = v - m;
    f32x2 o; o.x = v.x < 0.f ? m.x : r.x; o.y = v.y < 0.f ? m.y : r.y; return o;
}

template <int ACT  > struct EpiBf16 {
    static constexpr bool PERM = true, AFTER_DRAIN = false; static_assert(ACT == 0 || ACT == 1, "EpiBf16: ACT is 0 (none) or 1 (gelu_pk)");
    bf16_t* O; int ldc; const float* bias; int split_cols; size_t split_stride; float scale0;
    __device__ __forceinline__ void operator()(const f32x4 (&acc)[2][2][4][2], const Unit& u, int wr, int wc, int fr, int fq) const {
        const int row0 = u.pm * BM + wr * 64 + fr; int colt = u.pn * BM; bf16_t* base = O;
        float sc = 1.f; if (split_cols) { const int t = colt / split_cols; base += (size_t)t * split_stride; colt -= t * split_cols; if (t == 0) sc = scale0; }
        const int col0 = colt + wc * 32 + 8 * fq, bcol0 = u.pn * BM + wc * 32 + 8 * fq;
        f32x4 bv[2][2];
#pragma unroll
        for (int bj = 0; bj < 2; ++bj)
#pragma unroll
            for (int n = 0; n < 2; ++n) bv[bj][n] = bias ? *(const f32x4*)(bias + bcol0 + bj * HALF + 4 * n) : (f32x4){0.f, 0.f, 0.f, 0.f};
#pragma unroll
        for (int ai = 0; ai < 2; ++ai)
#pragma unroll
            for (int m = 0; m < 4; ++m) { bf16_t* rowp = base + (size_t)(row0 + ai * HALF + m * 16) * ldc + col0;
#pragma unroll
                for (int bj = 0; bj < 2; ++bj) { f32x4 v0 = acc[ai][bj][m][0] + bv[bj][0], v1 = acc[ai][bj][m][1] + bv[bj][1];
                    if (ACT == 1) { f32x2 a = gelu_pk((f32x2){v0[0], v0[1]}), b = gelu_pk((f32x2){v0[2], v0[3]}), c = gelu_pk((f32x2){v1[0], v1[1]}), d = gelu_pk((f32x2){v1[2], v1[3]});
                        v0 = (f32x4){a.x, a.y, b.x, b.y}; v1 = (f32x4){c.x, c.y, d.x, d.y}; }
                    v0 = v0 * sc; v1 = v1 * sc; u32x4 w; w.x = cvt_pk_bf16(v0[0], v0[1]); w.y = cvt_pk_bf16(v0[2], v0[3]); w.z = cvt_pk_bf16(v1[0], v1[1]); w.w = cvt_pk_bf16(v1[2], v1[3]);
                    *(u32x4*)(rowp + bj * HALF) = w; } }
    }
};
template <class E_> struct EpiHasMid { static constexpr bool v = false; };
template <class E_> struct EpiHasInit { static constexpr bool v = false; };
template <class Epi, class Sched, bool ALIGN_EPI = false, bool SP2 = false, bool FP8 = false>
__device__ __forceinline__ void gemm_phase(PG8_LAS unsigned char* lds, const Gemm g, const Sched& S, const Epi& E) {
    int tid_ = threadIdx.x; asm volatile("" : "+v"(tid_));
    const int tid = tid_, wid = __builtin_amdgcn_readfirstlane(tid >> 6), lane = tid & 63, wr = wid >> 2, wc = wid & 3, fr = lane & 15, fq = lane >> 4;
    const int K = FP8 ? g.K / 2 : g.K, nt = K / BK;
    unsigned voffA[2], voffB[2];
#pragma unroll
    for (int i = 0; i < 2; ++i) { int R, C; stage_rc(tid * 16 + i * 8192, R, C); const int Rb = Epi::PERM ? ((R & ~31) + perm32(R & 31)) : R;
        voffA[i] = (unsigned)(R * K + C) * 2u; voffB[i] = (unsigned)(Rb * K + C) * 2u; }
    const size_t kstep = (size_t)(BK * 2);
    const size_t hstep = (size_t)HALF * K * 2;
    const size_t tstep = 2 * hstep;
    const unsigned ldsw = (unsigned)wid * 1024u;
    const int aoff = FP8 ? lds_byte(wr * 64 + fr, fq * 16) : lds_byte(wr * 64 + fr, fq * 8), boff = FP8 ? lds_byte(wc * 32 + fr, fq * 16) : lds_byte(wc * 32 + fr, fq * 8);
    const int aoff2 = (aoff | ((fq >> 1) << 4)) ^ 16, boff2 = (boff | ((fq >> 1) << 4)) ^ 16; const int aoff1 = aoff2 ^ 16, boff1 = boff2 ^ 16; (void)aoff1; (void)boff1; (void)aoff2; (void)boff2;
#define PG8_SA(b, h) (((b) * 2 + (h)) * HTB)
#define PG8_SB(b, h) ((4 + (b) * 2 + (h)) * HTB)
#define PG8_STAGE(bufoff, gbase, voff) do { _Pragma("unroll") for (int _i = 0; _i < 2; ++_i) \
        __builtin_amdgcn_global_load_lds((const unsigned*)((const char*)(gbase) + (voff)[_i]), (PG8_LAS unsigned*)(lds + (bufoff) + ldsw + _i * 8192), 16, 0, 0); } while (0)
#define PG8_LD8(p_, q_) __builtin_shufflevector(*(const PG8_LAS v4i_t*)(p_), *(const PG8_LAS v4i_t*)(q_), 0, 1, 2, 3, 4, 5, 6, 7)
#define PG8_LDA(dst, b, h) do { if constexpr (FP8) { if (PG8_XLDS) { _Pragma("unroll") for (int m = 0; m < 4; ++m) dst##8[m] = PG8_LD8(lds + PG8_SA(b, h) + aoff1 + m * 2048, lds + PG8_SA(b, h) + aoff2 + m * 2048); } } \
        else { _Pragma("unroll") for (int m = 0; m < 4; ++m) _Pragma("unroll") for (int k = 0; k < 2; ++k) dst[m][k] = *(const PG8_LAS bf16x8*)(lds + PG8_SA(b, h) + aoff + k * 1024 + m * 2048); } } while (0)
#define PG8_LDB(dst, b, h) do { if constexpr (FP8) { if (PG8_XLDS) { _Pragma("unroll") for (int n = 0; n < 2; ++n) dst##8[n] = PG8_LD8(lds + PG8_SB(b, h) + boff1 + n * 2048, lds + PG8_SB(b, h) + boff2 + n * 2048); } } \
        else { _Pragma("unroll") for (int n = 0; n < 2; ++n) _Pragma("unroll") for (int k = 0; k < 2; ++k) dst[n][k] = *(const PG8_LAS bf16x8*)(lds + PG8_SB(b, h) + boff + k * 1024 + n * 2048); } } while (0)
#define PG8_MMA(ai, bj, At, Bt) do { __builtin_amdgcn_s_setprio(1); \
        if constexpr (FP8) { if (PG8_XMMA) { _Pragma("unroll") for (int m = 0; m < 4; ++m) _Pragma("unroll") for (int n = 0; n < 2; ++n) \
            asm volatile("v_mfma_scale_f32_16x16x128_f8f6f4 %0, %1, %2, %0, %3, %4 op_sel_hi:[0,0,0]" : "+v"(acc[ai][bj][m][n]) : "v"(Bt##8[n]), "v"(At##8[m]), "v"(scb_v), "v"(sca_v)); } } \
        else { _Pragma("unroll") for (int m = 0; m < 4; ++m) _Pragma("unroll") for (int n = 0; n < 2; ++n) _Pragma("unroll") for (int k = 0; k < 2; ++k) \
            acc[ai][bj][m][n] = __builtin_amdgcn_mfma_f32_16x16x32_bf16(Bt[n][k], At[m][k], acc[ai][bj][m][n], 0, 0, 0); } __builtin_amdgcn_s_setprio(0); } while (0)
#define PG8_WAIT_V(n) asm volatile("s_waitcnt vmcnt(" #n ")" ::: "memory")
#define PG8_WAIT_L(n) asm volatile("s_waitcnt lgkmcnt(" #n ")" ::: "memory")
#define PG8_BAR __builtin_amdgcn_s_barrier()
#define PG8_SCHED __builtin_amdgcn_sched_barrier(0)
#ifdef PG8_PROF
    const bool PG8_XMMA = g.prof != 2 && g.prof != 4, PG8_XLDS = g.prof != 3 && g.prof != 4;
#else
    constexpr bool PG8_XMMA = true, PG8_XLDS = true;
#endif
    Unit cur, nxt; int ui = 0;
#ifdef PG8_PROF
#define PG8_TS(slot) do { if (g.prof && wid == 0) { const unsigned n_ = (unsigned)__builtin_amdgcn_s_memrealtime(); volatile PG8_LAS unsigned* p_ = (volatile PG8_LAS unsigned*)(lds + 143744); p_[slot] += n_ - p_[2]; p_[2] = n_; } } while (0)
#else
#define PG8_TS(slot) do { } while (0)
#endif
    if (!S.next(0, cur)) return;
    f32x4 acc[2][2][4][2];
#pragma unroll
    for (int a = 0; a < 2; ++a)
#pragma unroll
        for (int b = 0; b < 2; ++b)
#pragma unroll
            for (int m = 0; m < 4; ++m)
#pragma unroll
                for (int n = 0; n < 2; ++n) acc[a][b][m][n] = (f32x4){0.f, 0.f, 0.f, 0.f};
    if constexpr (EpiHasInit<Epi>::v) E.init(acc, cur, wr, wc, fr, fq);
    const int sca_v = g.sca, scb_v = g.scb;
    bf16x8 At[4][2], B0[2][2], B1[2][2];
    v8i_t At8[4] = {}, B08[2] = {}, B18[2] = {};
    const char* cA = (const char*)g.A + (size_t)cur.pm * tstep; const char* cB = (const char*)g.Bt + (size_t)cur.pn * tstep;
    S.a_ready(cur);
    if constexpr (SP2) {
        PG8_STAGE(PG8_SB(0, 0), cB, voffB); PG8_STAGE(PG8_SB(0, 1), cB + hstep, voffB); PG8_STAGE(PG8_SA(0, 0), cA, voffA); PG8_STAGE(PG8_SA(0, 1), cA + hstep, voffA);
        if (wr == 1) PG8_BAR;
        PG8_WAIT_V(2); PG8_BAR;
        PG8_STAGE(PG8_SB(1, 0), cB + kstep, voffB); PG8_STAGE(PG8_SA(1, 0), cA + kstep, voffA); PG8_STAGE(PG8_SB(1, 1), cB + hstep + kstep, voffB);
        PG8_WAIT_V(6); PG8_BAR;
    } else {
        PG8_STAGE(PG8_SB(0, 0), cB, voffB); PG8_STAGE(PG8_SA(0, 0), cA, voffA); PG8_STAGE(PG8_SB(0, 1), cB + hstep, voffB); PG8_STAGE(PG8_SA(0, 1), cA + hstep, voffA);
        if (wr == 1) PG8_BAR;
        PG8_WAIT_V(4); PG8_BAR;
        PG8_STAGE(PG8_SB(1, 0), cB + kstep, voffB); PG8_STAGE(PG8_SA(1, 0), cA + kstep, voffA); PG8_STAGE(PG8_SB(1, 1), cB + hstep + kstep, voffB);
        PG8_WAIT_V(6); PG8_BAR;
    }
    for (;;) {
        const bool has_next = S.next(ui + 1, nxt);
        const char* nA = has_next ? (const char*)g.A + (size_t)nxt.pm * tstep : cA; const char* nB = has_next ? (const char*)g.Bt + (size_t)nxt.pn * tstep : cB;
        PG8_TS(3);
#pragma unroll 1
        for (int t = 0; t < nt; t += 2) {
            if constexpr (EpiHasMid<Epi>::v) { if (t == 8 || t == 16) { PG8_SCHED; E.mid(acc, cur, t, wr, wc, fr, fq); PG8_SCHED; } }
            const bool last = (t == nt - 2);
            const char* a1 = cA + (size_t)(t + 1) * kstep;
            const char* a2 = last ? nA : cA + (size_t)(t + 2) * kstep; const char* b2 = last ? nB : cB + (size_t)(t + 2) * kstep;
            const char* a3 = a2 + kstep; const char* b3 = b2 + kstep;
            if (last && has_next) S.a_ready(nxt);
            if constexpr (SP2) {
            PG8_LDB(B0, 0, 0); PG8_LDB(B1, 0, 1); PG8_SCHED; PG8_LDA(At, 0, 0); PG8_STAGE(PG8_SA(1, 1), a1 + hstep, voffA);
            PG8_WAIT_V(8); PG8_WAIT_L(0); PG8_BAR; PG8_MMA(0, 0, At, B0); PG8_MMA(0, 1, At, B1); PG8_BAR; PG8_SCHED;
            PG8_LDA(At, 0, 1); PG8_STAGE(PG8_SB(0, 0), b2, voffB); PG8_STAGE(PG8_SB(0, 1), b2 + hstep, voffB); PG8_STAGE(PG8_SA(0, 0), a2, voffA);
            PG8_WAIT_V(8); PG8_WAIT_L(0); PG8_BAR; PG8_MMA(1, 0, At, B0); PG8_MMA(1, 1, At, B1); PG8_BAR; PG8_SCHED;
            PG8_LDB(B0, 1, 0); PG8_LDB(B1, 1, 1); PG8_SCHED; PG8_LDA(At, 1, 0); PG8_STAGE(PG8_SA(0, 1), a2 + hstep, voffA);
            PG8_WAIT_V(8); PG8_WAIT_L(0); PG8_BAR; PG8_MMA(0, 0, At, B0); PG8_MMA(0, 1, At, B1); PG8_BAR; PG8_SCHED;
            PG8_LDA(At, 1, 1); PG8_STAGE(PG8_SB(1, 0), b3, voffB); PG8_STAGE(PG8_SB(1, 1), b3 + hstep, voffB); PG8_STAGE(PG8_SA(1, 0), a3, voffA);
            PG8_WAIT_V(8); PG8_WAIT_L(0); PG8_BAR; PG8_MMA(1, 0, At, B0); PG8_MMA(1, 1, At, B1); PG8_BAR; PG8_SCHED;
            } else {
            PG8_LDB(B0, 0, 0); PG8_SCHED; PG8_LDA(At, 0, 0); PG8_STAGE(PG8_SA(1, 1), a1 + hstep, voffA);
            PG8_WAIT_L(8); PG8_BAR; PG8_WAIT_L(0); PG8_MMA(0, 0, At, B0); PG8_BAR; PG8_SCHED;
            PG8_LDB(B1, 0, 1); PG8_STAGE(PG8_SB(0, 0), b2, voffB);
            PG8_BAR; PG8_WAIT_L(0); PG8_MMA(0, 1, At, B1); PG8_BAR;
            PG8_LDA(At, 0, 1); PG8_STAGE(PG8_SA(0, 0), a2, voffA);
            PG8_BAR; PG8_WAIT_L(0); PG8_MMA(1, 0, At, B0); PG8_BAR; PG8_SCHED;
            PG8_STAGE(PG8_SB(0, 1), b2 + hstep, voffB);
            PG8_WAIT_V(6); PG8_BAR; PG8_MMA(1, 1, At, B1); PG8_BAR;
            PG8_LDB(B0, 1, 0); PG8_SCHED; PG8_LDA(At, 1, 0); PG8_STAGE(PG8_SA(0, 1), a2 + hstep, voffA);
            PG8_WAIT_L(8); PG8_BAR; PG8_WAIT_L(0); PG8_MMA(0, 0, At, B0); PG8_BAR; PG8_SCHED;
            PG8_LDB(B1, 1, 1); PG8_STAGE(PG8_SB(1, 0), b3, voffB);
            PG8_BAR; PG8_WAIT_L(0); PG8_MMA(0, 1, At, B1); PG8_BAR;
            PG8_LDA(At, 1, 1); PG8_STAGE(PG8_SA(1, 0), a3, voffA);
            PG8_BAR; PG8_WAIT_L(0); PG8_MMA(1, 0, At, B0); PG8_BAR; PG8_SCHED;
            PG8_STAGE(PG8_SB(1, 1), b3 + hstep, voffB);
            PG8_WAIT_V(6); PG8_BAR; PG8_MMA(1, 1, At, B1); PG8_BAR;
            }
        }
        PG8_TS(0);
        if constexpr (FP8) { asm volatile("s_nop 15\n\ts_nop 15" ::: "memory"); }
        if constexpr (ALIGN_EPI) { if (wr == 0) PG8_BAR; }
        if constexpr (!Epi::AFTER_DRAIN) { E(acc, cur, wr, wc, fr, fq); S.done(cur); }
        PG8_TS(1);
        if (!has_next) break;
#pragma unroll
        for (int a = 0; a < 2; ++a)
#pragma unroll
            for (int b = 0; b < 2; ++b)
#pragma unroll
                for (int m = 0; m < 4; ++m)
#pragma unroll
                    for (int n = 0; n < 2; ++n) acc[a][b][m][n] = (f32x4){0.f, 0.f, 0.f, 0.f};
        if constexpr (EpiHasInit<Epi>::v) E.init(acc, nxt, wr, wc, fr, fq);
        cur = nxt; cA = nA; cB = nB; ++ui;
        if constexpr (ALIGN_EPI) { if (wr == 1) PG8_BAR; }
    }
#ifdef PG8_PROF
    if (g.prof && blockIdx.x == 0 && tid == 0) { volatile PG8_LAS unsigned* p_ = (volatile PG8_LAS unsigned*)(lds + 143744); pg8_prof[0] = p_[0]; pg8_prof[1] = p_[1]; pg8_prof[2] = (unsigned long long)(ui + 1); }
#endif
    PG8_WAIT_V(0);
    if constexpr (!ALIGN_EPI) { if (wr == 0) PG8_BAR; }
    PG8_BAR;
    if constexpr (Epi::AFTER_DRAIN) { E.fused(acc, cur, wr, wc, fr, fq, lds, wid, lane); S.done(cur); }
#undef PG8_SA
#undef PG8_SB
#undef PG8_STAGE
#undef PG8_LD8
#undef PG8_LDA
#undef PG8_LDB
#undef PG8_MMA
#undef PG8_WAIT_V
#undef PG8_WAIT_L
#undef PG8_BAR
#undef PG8_SCHED
}
}

constexpr int D_MODEL = 1024, BATCH = 2, SEQ = 8192, MTOK = BATCH * SEQ, MEM_LEN = 256, MEMROWS = BATCH * MEM_LEN;
constexpr int IN_COLS = 9984, OFF_AQ = 0, OFF_AK = 1536, OFF_AV = 3072, OFF_R = 4608, OFF_CQ = 6400, OFF_GATE = 6912;
constexpr int RW = 512;
constexpr int N_EXPERTS = 32, TOP_K = 4, D_FF = 1024, MOE_ROWS = 256;
constexpr int MAX_BLOCKS = MTOK * TOP_K / MOE_ROWS + N_EXPERTS;
constexpr int MAX_SLOTS = MAX_BLOCKS * MOE_ROWS;
constexpr bool MRG_FP8 = false; constexpr float M8_SCALE = 16.0f;
constexpr float NORM_EPS = 1e-6f, R_GN_EPS = 64e-5f;
constexpr float LOG2E = 1.4426950408889634f;
constexpr float QSCALE = 0.08838834764831845f * LOG2E;

namespace pg8 {
__device__ __forceinline__ float bf_lo(unsigned w) { return __builtin_bit_cast(float, w << 16); }
__device__ __forceinline__ float bf_hi(unsigned w) { return __builtin_bit_cast(float, w & 0xffff0000u); }
__device__ __forceinline__ float sigmoidf_fast(float x) { return __builtin_amdgcn_rcpf(1.0f + __builtin_amdgcn_exp2f(-1.4426950408889634f * x)); }

constexpr bool WT_STORES = false;
__device__ __forceinline__ void st16(const __amdgpu_buffer_rsrc_t r, void* base, size_t off_bytes, u32x4 w) {
    if constexpr (WT_STORES) __builtin_amdgcn_raw_buffer_store_b128(w, r, (unsigned)off_bytes, 0, 16);
    else *(u32x4*)((unsigned char*)base + off_bytes) = w;
}
struct EpiZ {
    static constexpr bool PERM = true, AFTER_DRAIN = false;
    bf16_t* O; const float* bgate; const float* aqg; const float* akg; const float* cqg; const float* cs;
    bf16_t* KV; const float* ckg;
    PG8_LAS float* P;
    __device__ __forceinline__ void operator()(const f32x4 (&acc)[2][2][4][2], const Unit& u, int wr, int wc, int fr, int fq) const {
        const bool mem = u.pm >= 64; const int pnl = mem ? u.pn - 39 : u.pn, ldc = mem ? 1024 : IN_COLS;
        bf16_t* const Ob = mem ? KV - (size_t)64 * BM * 1024 : O;
        const __amdgpu_buffer_rsrc_t ors = __builtin_amdgcn_make_buffer_rsrc((void*)Ob, (short)0, 0x7fffffff, 0x00020000);
        const int row0 = u.pm * BM + wr * 64 + fr, col0 = pnl * BM + wc * 32 + 8 * fq;
        const int cls = mem ? ((pnl < 2) ? 3 : 0) : (pnl < 6) ? 1 : (pnl < 12) ? 2 : (pnl == 25 || pnl == 26) ? 3 : (pnl >= 27) ? 4 : 0;
        if (cls >= 1 && cls <= 3) {
            const int go = wc * 32 + 8 * fq;
            const f32x4 q0 = *(const f32x4*)(aqg + go), q1 = *(const f32x4*)(aqg + go + 4), k0 = *(const f32x4*)(akg + go), k1 = *(const f32x4*)(akg + go + 4), x0 = *(const f32x4*)(cqg + go), x1 = *(const f32x4*)(cqg + go + 4);
            const f32x4 m0 = *(const f32x4*)(ckg + go), m1 = *(const f32x4*)(ckg + go + 4);
            const f32x4 g0 = mem ? m0 : (cls == 1) ? q0 : (cls == 2) ? k0 : x0, g1 = mem ? m1 : (cls == 1) ? q1 : (cls == 2) ? k1 : x1;
#pragma unroll
            for (int ai = 0; ai < 2; ++ai)
#pragma unroll
                for (int m = 0; m < 4; ++m)
#pragma unroll
                    for (int bj = 0; bj < 2; ++bj) { const f32x4 a = acc[ai][bj][m][0], b = acc[ai][bj][m][1];
                        float s = ((a[0] * a[0] + a[1] * a[1]) + (a[2] * a[2] + a[3] * a[3])) + ((b[0] * b[0] + b[1] * b[1]) + (b[2] * b[2] + b[3] * b[3]));
                        s += __shfl_xor(s, 16); s += __shfl_xor(s, 32);
                        if (fq == 0) P[((ai * HALF + wr * 64 + m * 16 + fr) * 2 + bj) * 4 + wc] = s; }
            asm volatile("s_waitcnt lgkmcnt(0)" ::: "memory"); __builtin_amdgcn_s_barrier(); asm volatile("" ::: "memory");
#pragma unroll
            for (int ai = 0; ai < 2; ++ai)
#pragma unroll
                for (int m = 0; m < 4; ++m) { const int rl = ai * HALF + wr * 64 + m * 16 + fr, row = u.pm * BM + rl;
                    f32x4 c0 = {0.f, 0.f, 0.f, 0.f}, c1 = c0, c2 = c0, c3 = c0;
                    if (cls != 3 && wc == 0) { const f32x4* cp = (const f32x4*)(cs + (size_t)row * 32 + 16 * (fq & 1)); c0 = cp[0]; c1 = cp[1]; c2 = cp[2]; c3 = cp[3]; }
#pragma unroll
                    for (int bj = 0; bj < 2; ++bj) { const f32x4 pv = *(const PG8_LAS f32x4*)(P + (rl * 2 + bj) * 4);
                        const float rstd = __builtin_amdgcn_rsqf(((pv[0] + pv[1]) + (pv[2] + pv[3])) * (1.0f / 128.0f) + NORM_EPS);
                        f32x4 v0 = acc[ai][bj][m][0] * rstd * g0, v1 = acc[ai][bj][m][1] * rstd * g1;
                        if (cls != 3 && wc == 0) {
                            f32x4 p0, p1;
#pragma unroll
                            for (int j = 0; j < 4; ++j) { p0[j] = __shfl_xor(v0[j], 32); p1[j] = __shfl_xor(v1[j], 32); }
                            const float sg = (fq < 2) ? -1.0f : 1.0f;
                            v0[0] = v0[0] * c0[0] + sg * p0[0] * c0[1]; v0[1] = v0[1] * c0[2] + sg * p0[1] * c0[3]; v0[2] = v0[2] * c1[0] + sg * p0[2] * c1[1]; v0[3] = v0[3] * c1[2] + sg * p0[3] * c1[3];
                            v1[0] = v1[0] * c2[0] + sg * p1[0] * c2[1]; v1[1] = v1[1] * c2[2] + sg * p1[1] * c2[3]; v1[2] = v1[2] * c3[0] + sg * p1[2] * c3[1]; v1[3] = v1[3] * c3[2] + sg * p1[3] * c3[3]; }
                        u32x4 w; w.x = cvt_pk_bf16(v0[0], v0[1]); w.y = cvt_pk_bf16(v0[2], v0[3]); w.z = cvt_pk_bf16(v1[0], v1[1]); w.w = cvt_pk_bf16(v1[2], v1[3]);
                        st16(ors, Ob, ((size_t)row * ldc + col0 + bj * HALF) * 2, w); } }
            return;
        }
        const bool gate = cls == 4;
        f32x4 bv[2][2];
#pragma unroll
        for (int bj = 0; bj < 2; ++bj)
#pragma unroll
            for (int n = 0; n < 2; ++n) bv[bj][n] = gate ? *(const f32x4*)(bgate + (col0 - OFF_GATE) + bj * HALF + 4 * n) : (f32x4){0.f, 0.f, 0.f, 0.f};
#pragma unroll
        for (int ai = 0; ai < 2; ++ai)
#pragma unroll
            for (int m = 0; m < 4; ++m) { const size_t rowo = ((size_t)(row0 + ai * HALF + m * 16) * ldc + col0) * 2;
#pragma unroll
                for (int bj = 0; bj < 2; ++bj) { f32x4 v0 = acc[ai][bj][m][0] + bv[bj][0], v1 = acc[ai][bj][m][1] + bv[bj][1];
                    if (gate) {
#pragma unroll
                        for (int j = 0; j < 4; ++j) { v0[j] = sigmoidf_fast(v0[j]); v1[j] = sigmoidf_fast(v1[j]); } }
                    u32x4 w; w.x = cvt_pk_bf16(v0[0], v0[1]); w.y = cvt_pk_bf16(v0[2], v0[3]); w.z = cvt_pk_bf16(v1[0], v1[1]); w.w = cvt_pk_bf16(v1[2], v1[3]);
                    st16(ors, Ob, rowo + bj * HALF * 2, w); } }
    }
};

template <int SET> struct ZOrder {
    StaticOrder so; int nz;
    __device__ void init(int G_, int c_) { so.init(MTOK, (SET == 0 ? 15 : 24) * BM, G_, c_); nz = 64 * (SET == 0 ? 15 : 24); }
    __device__ __forceinline__ bool next(int i, Unit& u) const {
        if (so.next(i, u)) { const int t = u.pn;
            if (SET == 0) u.pn = t + 12; else u.pn = (t < 12) ? t : t + 15;
            return true; }
        if (SET == 0) { const long L = (long)i * so.G + so.c - nz; if (L >= 0 && L < 8) { u.pm = 64 + (int)(L & 1); u.pn = 39 + (int)(L >> 1); return true; } }
        return false;
    }
    __device__ __forceinline__ void a_ready(const Unit&) const {}
    __device__ __forceinline__ void done(const Unit&) const {}
};
struct EpiGate3 {
    static constexpr bool PERM = true, AFTER_DRAIN = false;
    const bf16_t* Z; bf16_t* mergedb;
    __device__ __forceinline__ void mid(f32x4 (&acc)[2][2][4][2], const Unit& u, int t, int wr, int wc, int fr, int fq) const {
        int fr_ = fr; asm volatile("" : "+v"(fr_));
        const int row0 = u.pm * BM + wr * 64 + fr_, col0 = u.pn * BM + wc * 32 + 8 * fq, ba = (t >> 3) - 1;
        const bf16_t* gp = Z + OFF_GATE + ba * D_MODEL + col0;
#pragma unroll
        for (int ai = 0; ai < 2; ++ai)
#pragma unroll
            for (int m = 0; m < 4; ++m) { const bf16_t* rp = gp + (size_t)(row0 + ai * HALF + m * 16) * IN_COLS;
#pragma unroll
                for (int bj = 0; bj < 2; ++bj) { const u32x4 ga = *(const u32x4*)(rp + bj * HALF), gb = *(const u32x4*)(rp + D_MODEL + bj * HALF);
                    f32x4 r0, r1;
                    r0[0] = bf_lo(ga[0]) * __builtin_amdgcn_rcpf(bf_lo(gb[0])); r0[1] = bf_hi(ga[0]) * __builtin_amdgcn_rcpf(bf_hi(gb[0])); r0[2] = bf_lo(ga[1]) * __builtin_amdgcn_rcpf(bf_lo(gb[1])); r0[3] = bf_hi(ga[1]) * __builtin_amdgcn_rcpf(bf_hi(gb[1]));
                    r1[0] = bf_lo(ga[2]) * __builtin_amdgcn_rcpf(bf_lo(gb[2])); r1[1] = bf_hi(ga[2]) * __builtin_amdgcn_rcpf(bf_hi(gb[2])); r1[2] = bf_lo(ga[3]) * __builtin_amdgcn_rcpf(bf_lo(gb[3])); r1[3] = bf_hi(ga[3]) * __builtin_amdgcn_rcpf(bf_hi(gb[3]));
                    acc[ai][bj][m][0] *= r0; acc[ai][bj][m][1] *= r1; }
                if (m == 3) asm volatile("" ::: "memory"); }
    }
    __device__ __forceinline__ void operator()(const f32x4 (&acc)[2][2][4][2], const Unit& u, int wr, int wc, int fr, int fq) const {
        const int row0 = u.pm * BM + wr * 64 + fr, col0 = u.pn * BM + wc * 32 + 8 * fq;
        u32x4 gzr[2][4][2];
#pragma unroll
        for (int ai = 0; ai < 2; ++ai)
#pragma unroll
            for (int m = 0; m < 4; ++m)
#pragma unroll
                for (int bj = 0; bj < 2; ++bj) gzr[ai][m][bj] = *(const u32x4*)(Z + (size_t)(row0 + ai * HALF + m * 16) * IN_COLS + OFF_GATE + 2 * D_MODEL + col0 + bj * HALF);
#pragma unroll
        for (int ai = 0; ai < 2; ++ai)
#pragma unroll
            for (int m = 0; m < 4; ++m) { const int row = row0 + ai * HALF + m * 16;
#pragma unroll
                for (int bj = 0; bj < 2; ++bj) { const int col = col0 + bj * HALF; const u32x4 gz = gzr[ai][m][bj];
                    f32x4 g0, g1;
                    g0[0] = bf_lo(gz[0]); g0[1] = bf_hi(gz[0]); g0[2] = bf_lo(gz[1]); g0[3] = bf_hi(gz[1]); g1[0] = bf_lo(gz[2]); g1[1] = bf_hi(gz[2]); g1[2] = bf_lo(gz[3]); g1[3] = bf_hi(gz[3]);
                    const f32x4 v0 = acc[ai][bj][m][0] * g0, v1 = acc[ai][bj][m][1] * g1;
                    if constexpr (MRG_FP8) { unsigned w0 = 0, w1 = 0;
                        w0 = __builtin_amdgcn_cvt_pk_fp8_f32(v0[0] * M8_SCALE, v0[1] * M8_SCALE, w0, false); w0 = __builtin_amdgcn_cvt_pk_fp8_f32(v0[2] * M8_SCALE, v0[3] * M8_SCALE, w0, true);
                        w1 = __builtin_amdgcn_cvt_pk_fp8_f32(v1[0] * M8_SCALE, v1[1] * M8_SCALE, w1, false); w1 = __builtin_amdgcn_cvt_pk_fp8_f32(v1[2] * M8_SCALE, v1[3] * M8_SCALE, w1, true);
                        *(unsigned long long*)((unsigned char*)mergedb + (size_t)row * D_MODEL + col) = (unsigned long long)w0 | ((unsigned long long)w1 << 32); }
                    else { u32x4 w; w.x = cvt_pk_bf16(v0[0], v0[1]); w.y = cvt_pk_bf16(v0[2], v0[3]); w.z = cvt_pk_bf16(v1[0], v1[1]); w.w = cvt_pk_bf16(v1[2], v1[3]);
                        *(u32x4*)(mergedb + (size_t)row * D_MODEL + col) = w; } } }
    }
};
template <> struct EpiHasMid<EpiGate3> { static constexpr bool v = true; };
struct EpiGate3NoMid : EpiGate3 {};
struct EpiResF32 {
    static constexpr bool PERM = true, AFTER_DRAIN = false;
    const float* base; float* out; int ldc;
    __device__ __forceinline__ void operator()(const f32x4 (&acc)[2][2][4][2], const Unit& u, int wr, int wc, int fr, int fq) const {
        const int row0 = u.pm * BM + wr * 64 + fr, col0 = u.pn * BM + wc * 32 + 8 * fq;
#pragma unroll
        for (int ai = 0; ai < 2; ++ai) {
            f32x4 xr[4][2][2];
#pragma unroll
            for (int m = 0; m < 4; ++m)
#pragma unroll
                for (int bj = 0; bj < 2; ++bj) { const float* bp = base + (size_t)(row0 + ai * HALF + m * 16) * ldc + col0 + bj * HALF; xr[m][bj][0] = *(const f32x4*)bp; xr[m][bj][1] = *(const f32x4*)(bp + 4); }
#pragma unroll
            for (int m = 0; m < 4; ++m)
#pragma unroll
                for (int bj = 0; bj < 2; ++bj) { float* op = out + (size_t)(row0 + ai * HALF + m * 16) * ldc + col0 + bj * HALF;
                    *(f32x4*)op = xr[m][bj][0] + acc[ai][bj][m][0]; *(f32x4*)(op + 4) = xr[m][bj][1] + acc[ai][bj][m][1]; }
            asm volatile("" ::: "memory"); }
    }
};
struct EpiResInit {
    static constexpr bool PERM = true, AFTER_DRAIN = false;
    const float* base; float* out; int ldc;
    __device__ __forceinline__ void init(f32x4 (&acc)[2][2][4][2], const Unit& u, int wr, int wc, int fr, int fq) const {
        const int row0 = u.pm * BM + wr * 64 + fr, col0 = u.pn * BM + wc * 32 + 8 * fq;
#pragma unroll
        for (int ai = 0; ai < 2; ++ai)
#pragma unroll
            for (int m = 0; m < 4; ++m)
#pragma unroll
                for (int bj = 0; bj < 2; ++bj) { const float* bp = base + (size_t)(row0 + ai * HALF + m * 16) * ldc + col0 + bj * HALF; acc[ai][bj][m][0] = *(const f32x4*)bp; acc[ai][bj][m][1] = *(const f32x4*)(bp + 4); }
    }
    __device__ __forceinline__ void operator()(const f32x4 (&acc)[2][2][4][2], const Unit& u, int wr, int wc, int fr, int fq) const {
        const int row0 = u.pm * BM + wr * 64 + fr, col0 = u.pn * BM + wc * 32 + 8 * fq;
#pragma unroll
        for (int ai = 0; ai < 2; ++ai)
#pragma unroll
            for (int m = 0; m < 4; ++m)
#pragma unroll
                for (int bj = 0; bj < 2; ++bj) { float* op = out + (size_t)(row0 + ai * HALF + m * 16) * ldc + col0 + bj * HALF; *(f32x4*)op = acc[ai][bj][m][0]; *(f32x4*)(op + 4) = acc[ai][bj][m][1]; }
    }
};
template <> struct EpiHasInit<EpiResInit> { static constexpr bool v = true; };
struct EpiSwiGLU {
    static constexpr bool PERM = true, AFTER_DRAIN = false;
    const float* b1; bf16_t* H;
    __device__ __forceinline__ void operator()(const f32x4 (&acc)[2][2][4][2], const Unit& u, int wr, int wc, int fr, int fq) const {
        const int e = u.pn >> 3, pnl = u.pn & 7;
        const int row0 = u.pm * BM + wr * 64 + fr, ac = pnl * HALF + wc * 32 + 8 * fq;
        const float* bg = b1 + (size_t)e * 2 * D_FF + ac; const float* bl = bg + D_FF;
        const f32x4 bg0 = *(const f32x4*)bg, bg1 = *(const f32x4*)(bg + 4), bl0 = *(const f32x4*)bl, bl1 = *(const f32x4*)(bl + 4);
#pragma unroll
        for (int ai = 0; ai < 2; ++ai)
#pragma unroll
            for (int m = 0; m < 4; ++m) { const int row = row0 + ai * HALF + m * 16;
                float a[8];
#pragma unroll
                for (int n = 0; n < 2; ++n) { const f32x4 ug = acc[ai][0][m][n] + (n ? bg1 : bg0), ul = acc[ai][1][m][n] + (n ? bl1 : bl0);
#pragma unroll
                    for (int j = 0; j < 4; ++j) { const float g = fminf(ug[j], 7.0f), l = fminf(fmaxf(ul[j], -7.0f), 7.0f);
                        a[4 * n + j] = g * sigmoidf_fast(1.702f * g) * (l + 1.0f); } }
                unsigned w0 = 0, w1 = 0;
                w0 = __builtin_amdgcn_cvt_pk_fp8_f32(a[0] * 8.0f, a[1] * 8.0f, w0, false); w0 = __builtin_amdgcn_cvt_pk_fp8_f32(a[2] * 8.0f, a[3] * 8.0f, w0, true);
                w1 = __builtin_amdgcn_cvt_pk_fp8_f32(a[4] * 8.0f, a[5] * 8.0f, w1, false); w1 = __builtin_amdgcn_cvt_pk_fp8_f32(a[6] * 8.0f, a[7] * 8.0f, w1, true);
                *(unsigned long long*)((unsigned char*)H + (size_t)row * D_FF + ac) = (unsigned long long)w0 | ((unsigned long long)w1 << 32); }
    }
};
struct EpiMoeOut {
    static constexpr bool PERM = true, AFTER_DRAIN = false;
    const float* b2; const float* rowgate; bf16_t* Y;
    __device__ __forceinline__ void operator()(const f32x4 (&acc)[2][2][4][2], const Unit& u, int wr, int wc, int fr, int fq) const {
        const int e = u.pn >> 2, pnl = u.pn & 3;
        const int row0 = u.pm * BM + wr * 64 + fr, col0 = pnl * BM + wc * 32 + 8 * fq;
        float gtr[2][4]; f32x4 bb[2][2];
#pragma unroll
        for (int ai = 0; ai < 2; ++ai)
#pragma unroll
            for (int m = 0; m < 4; ++m) gtr[ai][m] = rowgate[row0 + ai * HALF + m * 16];
#pragma unroll
        for (int bj = 0; bj < 2; ++bj) { const float* bp = b2 + (size_t)e * D_MODEL + col0 + bj * HALF; bb[bj][0] = *(const f32x4*)bp; bb[bj][1] = *(const f32x4*)(bp + 4); }
#pragma unroll
        for (int ai = 0; ai < 2; ++ai)
#pragma unroll
            for (int m = 0; m < 4; ++m) { const int row = row0 + ai * HALF + m * 16; const float gt = gtr[ai][m];
#pragma unroll
                for (int bj = 0; bj < 2; ++bj) { const int col = col0 + bj * HALF;
                    const f32x4 v0 = (acc[ai][bj][m][0] + bb[bj][0]) * gt, v1 = (acc[ai][bj][m][1] + bb[bj][1]) * gt;
                    unsigned w0 = 0, w1 = 0;
                    w0 = __builtin_amdgcn_cvt_pk_fp8_f32(v0[0] * 16.0f, v0[1] * 16.0f, w0, false); w0 = __builtin_amdgcn_cvt_pk_fp8_f32(v0[2] * 16.0f, v0[3] * 16.0f, w0, true);
                    w1 = __builtin_amdgcn_cvt_pk_fp8_f32(v1[0] * 16.0f, v1[1] * 16.0f, w1, false); w1 = __builtin_amdgcn_cvt_pk_fp8_f32(v1[2] * 16.0f, v1[3] * 16.0f, w1, true);
                    *(unsigned long long*)((unsigned char*)Y + (size_t)row * D_MODEL + col) = (unsigned long long)w0 | ((unsigned long long)w1 << 32); } }
    }
};
struct MoeOrder {
    const PG8_LAS int* tab;
    int NT, G, c;
    __device__ __forceinline__ bool next(int i, Unit& u) const {
        const int nblk = tab[0], nu = nblk * NT; const long L0 = (long)i * G + c; if (L0 >= (long)nu) return false;
        int L = (int)L0; { const int q = nu / NXCD, r = nu % NXCD, xcd = L % NXCD, off = L / NXCD; L = (xcd < r ? xcd * (q + 1) : r * (q + 1) + (xcd - r) * q) + off; }
        const int blk = L / NT, pnl = L % NT; u.pm = blk; u.pn = tab[1 + blk] * NT + pnl; return true;
    }
    __device__ __forceinline__ void a_ready(const Unit&) const {}
    __device__ __forceinline__ void done(const Unit&) const {}
};
}

namespace swa {
constexpr int D = 128;
constexpr float SCALE = 0.08838834764831845f;
constexpr float THR = 8.f;
constexpr int NW = 8, QBLK = 32, KVBLK = 64, QB = NW * QBLK;
constexpr int SHM_V = KVBLK * D * 2, SHM_K = KVBLK * D * 2;
constexpr int LDS_BYTES = 2 * SHM_V + 2 * SHM_K + NW * 64 * 4;
using bf16 = unsigned short;
typedef short bf16x8 __attribute__((ext_vector_type(8)));
typedef short s16x4 __attribute__((ext_vector_type(4)));
typedef float f32x16 __attribute__((ext_vector_type(16)));
typedef float f32x4 __attribute__((ext_vector_type(4)));
typedef unsigned u32x4 __attribute__((ext_vector_type(4)));
template <class A, class Bt> struct same_t { static constexpr bool v = false; };
template <class A> struct same_t<A, A> { static constexpr bool v = true; };
#define KSWZ(row, colB) ((row) * 256 + ((colB) ^ (((row) & 7) << 4)))
#define SBAR() __builtin_amdgcn_sched_barrier(0)
__device__ __forceinline__ int v_st(int k, int c) { const int kk = (k & ~0xC) | ((k & 4) << 1) | ((k & 8) >> 1); return ((kk >> 3) * 4 + (c >> 5)) * 512 + ((kk & 7) * 32 + (c & 31)) * 2; }
__device__ __forceinline__ int v_rd_base(int lane) { return ((lane & 3) << 3) | (((lane >> 2) & 3) << 6) | (((lane >> 4) & 1) << 5) | (((lane >> 5) & 1) << 8); }
constexpr int v_rd_off(int d0, int ks, int half) { return d0 * 512 + ks * 4096 + half * 2048; }
__device__ __forceinline__ int crow(int r, int hi) { return (r & 3) + 8 * (r >> 2) + 4 * hi; }
__device__ __forceinline__ unsigned cvtpk(float lo, float hi) {
    unsigned r; asm volatile("v_cvt_pk_bf16_f32 %0, %1, %2" : "=v"(r) : "v"(lo), "v"(hi)); return r;
}
__device__ __forceinline__ bf16x8 pack8(f32x4 a, f32x4 b) {
    u32x4 w = {cvtpk(a[0], a[1]), cvtpk(a[2], a[3]), cvtpk(b[0], b[1]), cvtpk(b[2], b[3])};
    return *reinterpret_cast<bf16x8*>(&w);
}
template <class T> __device__ __forceinline__ bf16x8 load8(const T* p) {
    if constexpr (same_t<T, float>::v) { return pack8(*(const f32x4*)p, *(const f32x4*)(p + 4)); }
    else { return *reinterpret_cast<const bf16x8*>(p); }
}
__device__ __forceinline__ void mask_tile(f32x16& p0, f32x16& p1, int dq, unsigned W) {
    const float NEG = -__builtin_inff();
#pragma unroll
    for (int r = 0; r < 16; ++r) {
        const int c = (r & 3) + 8 * (r >> 2);
        if ((unsigned)(dq - c) >= W) p0[r] = NEG;
        if ((unsigned)(dq - c - 32) >= W) p1[r] = NEG;
    }
}
__device__ __forceinline__ void partialSM(f32x16& p0, f32x16& p1, float& m_reg, float& mn, float& alpha) {
    float pmax = p0[0]; for (int r = 1; r < 16; ++r) pmax = fmaxf(pmax, p0[r]); for (int r = 0; r < 16; ++r) pmax = fmaxf(pmax, p1[r]);
    { auto rr = __builtin_amdgcn_permlane32_swap(__float_as_uint(pmax), __float_as_uint(pmax), false, false);
      pmax = fmaxf(__uint_as_float(rr[0]), __uint_as_float(rr[1])); }
    constexpr float C2 = 1.4426950408889634f * SCALE;
    if (__builtin_expect(__all((pmax - m_reg) * SCALE <= THR), 1)) { mn = m_reg; alpha = 1.f; }
    else { mn = fmaxf(m_reg, pmax); alpha = __builtin_amdgcn_exp2f((m_reg - mn) * C2); m_reg = mn; }
    const float mnL = -mn * C2;
    for (int r = 0; r < 16; ++r) p0[r] = fmaf(p0[r], C2, mnL); for (int r = 0; r < 16; ++r) p1[r] = fmaf(p1[r], C2, mnL);
    for (int r = 0; r < 16; ++r) p0[r] = __builtin_amdgcn_exp2f(p0[r]);
}
__device__ __forceinline__ void finishSM(f32x16& p0, f32x16& p1, float alpha, float& l_reg, bf16x8& pa0, bf16x8& pa1, bf16x8& pa2, bf16x8& pa3) {
    for (int r = 0; r < 16; ++r) p1[r] = __builtin_amdgcn_exp2f(p1[r]);
    float ps = 0; for (int r = 0; r < 16; ++r) ps += p0[r]; for (int r = 0; r < 16; ++r) ps += p1[r];
    { auto rr = __builtin_amdgcn_permlane32_swap(__float_as_uint(ps), __float_as_uint(ps), false, false);
      ps = __uint_as_float(rr[0]) + __uint_as_float(rr[1]); }
    l_reg = l_reg * alpha + ps;
#define PK4(P, B_, OUT) do { unsigned a0 = cvtpk(P[B_+0], P[B_+1]), a1 = cvtpk(P[B_+2], P[B_+3]);                          \
        unsigned b0 = cvtpk(P[B_+4], P[B_+5]), b1 = cvtpk(P[B_+6], P[B_+7]);                                             \
        auto r0 = __builtin_amdgcn_permlane32_swap(a0, b0, false, false); auto r1 = __builtin_amdgcn_permlane32_swap(a1, b1, false, false); \
        u32x4 w = {r0[0], r1[0], r0[1], r1[1]}; OUT = *reinterpret_cast<bf16x8*>(&w); } while (0)
    PK4(p0, 0, pa0); PK4(p0, 8, pa1); PK4(p1, 0, pa2); PK4(p1, 8, pa3);
#undef PK4
}
template <int KB, bool SK>
__device__ __forceinline__ void qkt(f32x16& p0, f32x16& p1, const char* K_lds, int r32, int hi, const bf16x8* qr, bool act) {
    if (SK && !act) { const float NEG = -__builtin_inff();
#pragma unroll
        for (int r = 0; r < 16; ++r) { p0[r] = NEG; p1[r] = NEG; } return; }
    p0 = f32x16{}; p1 = f32x16{};
    const char* kb[4];
#pragma unroll
    for (int dd = 0; dd < 4; ++dd) kb[dd] = K_lds + KB * SHM_K + KSWZ(r32, (dd * 16 + hi * 8) * 2);
#pragma unroll
    for (int d0 = 0; d0 < 8; ++d0) { const char* a = kb[d0 & 3] + (d0 >> 2) * 128;
        bf16x8 b0 = *reinterpret_cast<const bf16x8*>(a);
        bf16x8 b1 = *reinterpret_cast<const bf16x8*>(a + 32 * 256);
        p0 = __builtin_amdgcn_mfma_f32_32x32x16_bf16(b0, qr[d0], p0, 0, 0, 0);
        p1 = __builtin_amdgcn_mfma_f32_32x32x16_bf16(b1, qr[d0], p1, 0, 0, 0); }
}
template <int VB, bool SK>
__device__ __forceinline__ void pv_tile(f32x16* o, int vb0, bf16x8 pa0, bf16x8 pa1, bf16x8 pa2, bf16x8 pa3, bool act) {
    if (SK && !act) return;
#define TRRD(dst, off) asm volatile("ds_read_b64_tr_b16 %0, %1 offset:%2" : "=&v"(dst) : "v"(vb0), "i"(off) : "memory")
#define PV_D0(d0) do { s16x4 l0, l1, l2, l3, h0, h1, h2, h3; constexpr int b_ = VB * SHM_V + v_rd_off(d0, 0, 0);     \
        TRRD(l0, b_); TRRD(h0, b_ + 2048); TRRD(l1, b_ + 4096); TRRD(h1, b_ + 6144); TRRD(l2, b_ + 8192); TRRD(h2, b_ + 10240); TRRD(l3, b_ + 12288); TRRD(h3, b_ + 14336); \
        asm volatile("s_waitcnt lgkmcnt(0)" ::: "memory"); SBAR();                 \
        o[d0] = __builtin_amdgcn_mfma_f32_32x32x16_bf16(pa0, (bf16x8){l0[0], l0[1], l0[2], l0[3], h0[0], h0[1], h0[2], h0[3]}, o[d0], 0, 0, 0);   \
        o[d0] = __builtin_amdgcn_mfma_f32_32x32x16_bf16(pa1, (bf16x8){l1[0], l1[1], l1[2], l1[3], h1[0], h1[1], h1[2], h1[3]}, o[d0], 0, 0, 0);   \
        o[d0] = __builtin_amdgcn_mfma_f32_32x32x16_bf16(pa2, (bf16x8){l2[0], l2[1], l2[2], l2[3], h2[0], h2[1], h2[2], h2[3]}, o[d0], 0, 0, 0);   \
        o[d0] = __builtin_amdgcn_mfma_f32_32x32x16_bf16(pa3, (bf16x8){l3[0], l3[1], l3[2], l3[3], h3[0], h3[1], h3[2], h3[3]}, o[d0], 0, 0, 0); } while (0)
    PV_D0(0); PV_D0(1); PV_D0(2); PV_D0(3);
#undef PV_D0
#undef TRRD
}

struct BlockRef { const bf16* Q; const bf16* K; const bf16* V; bf16* O; float* LSE; int QS, KS, OS, LS, P0, skv, W; };
struct Seam { bf16x8 qr[8]; bf16x8 st_v0, st_v1, st_k0, st_k1; };
__device__ __forceinline__ int swa_jlo(int P0, int W) { const int lowk = P0 - W + 1; return lowk > 0 ? lowk / KVBLK : 0; }
#define LD8(p) (*reinterpret_cast<const bf16x8*>(p))
#define ROW(p, k0, rr, RS) ((p) + (size_t)((k0) + (rr)) * (RS) + sc)
#define VMW() asm volatile("s_waitcnt vmcnt(0)" ::: "memory")
#define VMWN(n) asm volatile("s_waitcnt vmcnt(%0)" :: "i"(n) : "memory")
#define SLOAD_H(Kp, Vp, k0, RS) do { const char* kb_ = (const char*)(Kp) + (size_t)(k0) * (size_t)(RS) * 2; const char* vb_ = (const char*)(Vp) + (size_t)(k0) * (size_t)(RS) * 2;  \
                         const unsigned oa_ = (unsigned)(sr * (RS) + sc) * 2u, ob_ = oa_ + (unsigned)(RS) * 64u;                                    \
                         S.st_v0 = LD8(vb_ + oa_); S.st_v1 = LD8(vb_ + ob_); S.st_k0 = LD8(kb_ + oa_); S.st_k1 = LD8(kb_ + ob_); } while (0)
#define SWRITE_HK(bf) do { *(bf16x8*)(K_lds + (bf) * SHM_K + kws) = S.st_k0; *(bf16x8*)(K_lds + (bf) * SHM_K + kws + 32 * 256) = S.st_k1; } while (0)
#define SWRITE_HV(bf) do { *(bf16x8*)(V_lds + (bf) * SHM_V + vst0) = S.st_v0; *(bf16x8*)(V_lds + (bf) * SHM_V + vst1) = S.st_v1; } while (0)
#define SWRITE_H(bf) do { SWRITE_HV(bf); SWRITE_HK(bf); } while (0)
__device__ __forceinline__ void swa_prime(const BlockRef& cur, char* lds, Seam& S) {
    int tid_ = threadIdx.x; asm volatile("" : "+v"(tid_));
    const int tid = tid_, wid = __builtin_amdgcn_readfirstlane(tid >> 6), lane = tid & 63, r32 = lane & 31, hi = lane >> 5;
    const int sr = tid >> 4, sc = (tid & 15) * 8, kws = KSWZ(sr, sc * 2); char* K_lds = lds + 2 * SHM_V;
    const int kb0 = swa_jlo(cur.P0, cur.W) * KVBLK;
    { const char* qb_ = (const char*)cur.Q + (size_t)(wid * QBLK) * (size_t)cur.QS * 2; const unsigned qo_ = (unsigned)(r32 * cur.QS + hi * 8) * 2u;
      for (int d0 = 0; d0 < 8; ++d0) S.qr[d0] = LD8(qb_ + qo_ + d0 * 32); }
    SLOAD_H(cur.K, cur.V, kb0, cur.KS); VMW(); SWRITE_HK(0);
    __syncthreads();
}
__device__ __forceinline__ void swa_block(const BlockRef& cur, const BlockRef& nxt, char* lds, Seam& S) {
    int tid_ = threadIdx.x; asm volatile("" : "+v"(tid_));
    const int tid = tid_, wid = __builtin_amdgcn_readfirstlane(tid >> 6), lane = tid & 63, r32 = lane & 31, hi = lane >> 5;
    const int W = cur.W, skv = cur.skv;
    const int j_lo = swa_jlo(cur.P0, W);
    int j_hi = (cur.P0 + QB - 1) / KVBLK + 1; if (j_hi > skv / KVBLK) j_hi = skv / KVBLK;
    const int NT = j_hi - j_lo;
    const int kbn = swa_jlo(nxt.P0, nxt.W) * KVBLK;
    const int qlo = cur.P0 + wid * QBLK, qm = qlo + r32 - 4 * hi;
    char* V_lds = lds; char* K_lds = lds + 2 * SHM_V;
    float* ws = (float*)(lds + 2 * SHM_V + 2 * SHM_K) + wid * 64; float* li_l = ws, * al_l = ws + 32;
    float m_reg = -1e30f, l_reg = 0; f32x16 o[4] = {};
    const int sr = tid >> 4, sc = (tid & 15) * 8, vst0 = v_st(sr, sc), vst1 = v_st(32 + sr, sc), kws = KSWZ(sr, sc * 2);
    const int vb0 = (int)(uintptr_t)V_lds + v_rd_base(lane);
    const bf16* Kh = cur.K; const bf16* Vh = cur.V; const int KSc = cur.KS;
#define RESC(a) do { if (__any((a) < 1.f)) { if (hi == 0) al_l[r32] = (a); asm volatile("s_waitcnt lgkmcnt(0)" ::: "memory");              \
                     for (int d_ = 0; d_ < 4; ++d_) for (int r = 0; r < 16; ++r) o[d_][r] *= al_l[crow(r, hi)]; } } while (0)
#define KBASE(t) ((j_lo + (t)) * KVBLK)
#define ACT(t) (KBASE(t) <= qlo + QBLK - 1 && KBASE(t) + KVBLK - 1 >= qlo - W + 1)
#define MASKT(P0_, P1_, t) do { const int kb_ = KBASE(t); if ((!SK || ACT(t)) && (kb_ + KVBLK - 1 > qlo || kb_ <= qlo + QBLK - 1 - W)) mask_tile(P0_, P1_, qm - kb_, (unsigned)W); } while (0)
    constexpr int NQL = 8;
    constexpr bool SK = true;
#define SEAM_K0() do { VMWN(NQL); SWRITE_HK(0); SBAR(); } while (0)
    f32x16 pA0, pA1, pB0, pB1; float mnA, mnB, alA, alB; bf16x8 pa0, pa1, pa2, pa3;
    SWRITE_HV(0); SBAR();
    if (NT > 1) { SLOAD_H(Kh, Vh, KBASE(1), KSc); }
    SBAR(); qkt<0, SK>(pA0, pA1, K_lds, r32, hi, S.qr, ACT(0));
    MASKT(pA0, pA1, 0); partialSM(pA0, pA1, m_reg, mnA, alA);
    if (NT > 1) { VMW(); SWRITE_H(1); }
    __syncthreads();
#define HALF_STEP(PX0, PX1, mnX, alX, PY0, PY1, alY, t, KB, VB, SB) do {                                                      \
        SBAR(); qkt<KB, SK>(PX0, PX1, K_lds, r32, hi, S.qr, ACT(t));                                             \
        finishSM(PY0, PY1, alY, l_reg, pa0, pa1, pa2, pa3); SBAR();                                                           \
        if ((t) + 1 < NT) { SLOAD_H(Kh, Vh, KBASE((t) + 1), KSc); SBAR(); }                                               \
        pv_tile<VB, SK>(o, vb0, pa0, pa1, pa2, pa3, ACT((t) - 1)); MASKT(PX0, PX1, (t)); partialSM(PX0, PX1, m_reg, mnX, alX);                                        \
        __syncthreads();                                                                                                      \
        if ((t) + 1 < NT) { VMW(); SWRITE_H(SB); }                                                                          \
        RESC(alX); __syncthreads(); } while (0)
    for (int t = 1; t + 1 < NT; t += 2) {
        HALF_STEP(pB0, pB1, mnB, alB, pA0, pA1, alA, t, 1, 0, 0);
        HALF_STEP(pA0, pA1, mnA, alA, pB0, pB1, alB, t + 1, 0, 1, 1);
    }
    const bool even = (NT & 1) == 0;
    if (even) { SBAR(); qkt<1, SK>(pB0, pB1, K_lds, r32, hi, S.qr, ACT(NT - 1)); SBAR(); }
    { SLOAD_H(nxt.K, nxt.V, kbn, nxt.KS); SBAR();
      const char* qb_ = (const char*)nxt.Q + (size_t)(wid * QBLK) * (size_t)nxt.QS * 2; const unsigned qo_ = (unsigned)(r32 * nxt.QS + hi * 8) * 2u;
#pragma unroll
        for (int d0 = 0; d0 < 8; ++d0) S.qr[d0] = LD8(qb_ + qo_ + d0 * 32); }
    SBAR();
    finishSM(pA0, pA1, alA, l_reg, pa0, pa1, pa2, pa3); SBAR();
    pv_tile<0, SK>(o, vb0, pa0, pa1, pa2, pa3, ACT(even ? NT - 2 : NT - 1));
    if (even) { MASKT(pB0, pB1, NT - 1); partialSM(pB0, pB1, m_reg, mnB, alB); __syncthreads(); RESC(alB);
        finishSM(pB0, pB1, alB, l_reg, pa0, pa1, pa2, pa3); SBAR(); pv_tile<1, SK>(o, vb0, pa0, pa1, pa2, pa3, ACT(NT - 1)); }
    SBAR(); SEAM_K0();
    if (hi == 0) li_l[r32] = l_reg; asm volatile("s_waitcnt lgkmcnt(0)" ::: "memory");
    if (cur.LSE != nullptr && hi == 0) cur.LSE[(size_t)(wid * QBLK + r32) * cur.LS] = __log2f(l_reg) + m_reg * (1.4426950408889634f * SCALE);
    float rli[16];
#pragma unroll
    for (int r = 0; r < 16; ++r) rli[r] = __builtin_amdgcn_rcpf(li_l[crow(r, hi)]);
    bf16* Ow = cur.O + (size_t)(wid * QBLK) * cur.OS;
#pragma unroll
    for (int r = 0; r < 16; ++r) { const int orow = crow(r, hi);
#pragma unroll
        for (int d0 = 0; d0 < 4; ++d0) { const float v = o[d0][r] * rli[r];
            const float vn = __builtin_bit_cast(float, __builtin_amdgcn_update_dpp(0, __builtin_bit_cast(int, v), 0xB1, 0xF, 0xF, true));
            if ((r32 & 1) == 0) *(unsigned*)(Ow + (size_t)orow * cur.OS + d0 * 32 + r32) = cvtpk(v, vn); } }
    __syncthreads();
#undef RESC
#undef KBASE
#undef ACT
#undef MASKT
#undef SEAM_K0
#undef HALF_STEP
}
#undef LD8
#undef ROW
#undef VMW
#undef VMWN
#undef SLOAD_H
#undef SWRITE_HK
#undef SWRITE_HV
#undef SWRITE_H
#undef KSWZ
#undef SBAR
}

constexpr int NWAVES = 8;
#ifndef MK_N_LAUNCHES
#define MK_N_LAUNCHES 1
#endif
constexpr int N_PHASES = 13;
constexpr float W8_SCALE = 32.0f, H8_SCALE = 8.0f;
constexpr int SC_ONE = 0x7f7f7f7f, SC_W8 = 0x7a7a7a7a  , SC_H8 = 0x7c7c7c7c  , SC_M8 = MRG_FP8 ? 0x7b7b7b7b   : 0x7f7f7f7f;
#ifndef NAIVE_ATTN
#define NAIVE_ATTN 0
#endif
constexpr float ATT_QSCALE = NAIVE_ATTN ? QSCALE : 1.0f;

constexpr size_t MiB = 1u << 20;
constexpr size_t WS_CTL = 0, CTL_ZERO_BYTES = 128 * 1024;
constexpr size_t WS_WIN = 2 * MiB;
constexpr size_t WS_WB = 24 * MiB;
constexpr size_t WS_WO = 27 * MiB;
constexpr size_t WS_WMEM = WS_WIN + (size_t)9984 * 1024 * 2;
constexpr size_t WS_W1 = 29 * MiB;
constexpr size_t WS_W2 = 157 * MiB;
constexpr size_t WS_XN = 221 * MiB;
constexpr size_t WS_Z = 256 * MiB;
constexpr size_t WS_RW = 568 * MiB;
constexpr size_t WS_YS = 792 * MiB;
constexpr size_t WS_YABC = 824 * MiB;
constexpr size_t WS_MRG = 872 * MiB;
constexpr size_t WS_MRGB = 936 * MiB;
constexpr size_t WS_MEMN = WS_XN + (size_t)16384 * 1024 * 2;
constexpr size_t WS_KVM = 969 * MiB;
constexpr size_t WS_XN2 = 970 * MiB;
constexpr size_t WS_ROUTE = 1002 * MiB;
constexpr size_t WS_LORA = 1004 * MiB;
constexpr size_t WS_END = 1005 * MiB;
constexpr size_t WS_XS = 256 * MiB;
constexpr size_t WS_HACT = 400 * MiB;
constexpr size_t WS_YROWS = 544 * MiB;
constexpr size_t WS_OP = WS_MRG;
constexpr size_t WS_LSE = WS_MRGB;
constexpr size_t WS_CS = WS_RW;
constexpr size_t WS_VMIX = WS_RW + 32 * MiB, WS_GMIX = WS_RW + 64 * MiB;
constexpr size_t WS_XN8 = WS_YS, WS_WIN8 = WS_YS + 16 * MiB;
constexpr size_t RWSZ = (size_t)MTOK * RW * 4;
constexpr size_t RT_TOPI = 0, RT_TOPG = 256 * 1024, RT_POS = 512 * 1024, RT_ROWGATE = 768 * 1024;
static_assert(RT_ROWGATE + (size_t)MAX_SLOTS * 4 <= 1088 * 1024, "route");
constexpr int CW_TMO = 0, CW_CODE = 1;
constexpr int CW_BAR = 4096;
constexpr int CW_CNT = 16384;
constexpr int CW_CUR = 16384 + 2048; static_assert((16384 + 2048 + 32 * 64) * 4 <= 128 * 1024, "control words inside the per-call memset");

constexpr int RING_OFF = 0, RING_BYTES = 131072;
constexpr int LDSCTL_OFF = 143360, MISC_OFF = LDSCTL_OFF + 320;
constexpr int MOETAB_OFF = MISC_OFF + 128;
constexpr int HIST_OFF = MOETAB_OFF + 1536;
constexpr int LDS_BYTES = 147456;
static_assert(HIST_OFF + 4 * 320 <= LDS_BYTES, "LDS map");
#define GAS __attribute__((address_space(1)))
#define LAS __attribute__((address_space(3)))
typedef unsigned short bf16;
typedef unsigned v4u __attribute__((ext_vector_type(4)));
typedef float f32x4 __attribute__((ext_vector_type(4)));
typedef short bf16x8 __attribute__((ext_vector_type(8)));
typedef GAS unsigned gu32;
typedef GAS unsigned long long gu64;
#define RLX_AGENT __ATOMIC_RELAXED, __HIP_MEMORY_SCOPE_AGENT
#define LDS_WAIT() asm volatile("s_waitcnt lgkmcnt(0)" ::: "memory")
#define VM_WAIT() asm volatile("s_waitcnt vmcnt(0)" ::: "memory")
__device__ __forceinline__ unsigned long long rt() { return __builtin_amdgcn_s_memrealtime(); }
typedef float f32x2_cv __attribute__((ext_vector_type(2))); typedef __bf16 bf16x2_cv __attribute__((ext_vector_type(2)));
__device__ __forceinline__ unsigned pk2(float lo, float hi) { f32x2_cv v = {lo, hi}; bf16x2_cv b = __builtin_convertvector(v, bf16x2_cv); return __builtin_bit_cast(unsigned, b); }
__device__ __forceinline__ unsigned f2bf(float f) { return pk2(f, f) & 0xffffu; }
#define XB_TMO      128
#define XB_XCNT(j)  (256  + 64 * (j))
#define XB_XSUB(j)  (1280 + 64 * (j))
#define XB_XGEN(j)  (2304 + 64 * (j))
#define XB_TOP      3328
#define XB_TOPGEN   3392
#define XCD_BAR_WORDS 3456
#define XB_SPIN_CAP (1u << 18)

__device__ __forceinline__ unsigned xb_ld(unsigned* p)              { return __hip_atomic_load(p, __ATOMIC_RELAXED, __HIP_MEMORY_SCOPE_AGENT); }
__device__ __forceinline__ unsigned xb_add(unsigned* p, unsigned v) { return __hip_atomic_fetch_add(p, v, __ATOMIC_RELAXED, __HIP_MEMORY_SCOPE_AGENT); }
__device__ __forceinline__ unsigned xb_xcc_id() { return (unsigned)__builtin_amdgcn_s_getreg((3 << 11) | 20) & 0xFu; }
#define XB_SPIN(cond, bar) do { unsigned _sp = 0; while (cond) { __builtin_amdgcn_s_sleep(1); \
    if ((++_sp & 255u) == 0u) { if (xb_ld(&(bar)[XB_TMO])) break; if (_sp > XB_SPIN_CAP) { atomicAdd(&(bar)[XB_TMO], 1u); break; } } } } while (0)

struct XcdBarrier {
    unsigned* bar; unsigned x;
    volatile LAS unsigned* st;
};

__device__ __forceinline__ XcdBarrier xcd_barrier_post(unsigned* bar, volatile LAS unsigned* st) {
    XcdBarrier b; b.bar = bar; b.x = xb_xcc_id(); b.st = st;
    if (threadIdx.x == 0) (void)xb_add(&bar[XB_XCNT(b.x)], 1u);
    return b;
}
__device__ __forceinline__ void xcd_barrier_complete(unsigned* bar, unsigned x, unsigned& nloc, unsigned& nx) {
    const unsigned G = gridDim.x * gridDim.y * gridDim.z;
    unsigned sum, cnt, mine, sp = 0u;
    for (;;) {
        sum = 0u; cnt = 0u; mine = 0u;
#pragma unroll
        for (unsigned j = 0; j < 16; ++j) { const unsigned c = xb_ld(&bar[XB_XCNT(j)]); sum += c; cnt += (c > 0u) ? 1u : 0u; mine = (j == x) ? c : mine; }
        if (sum == G) break;
        __builtin_amdgcn_s_sleep(1);
        if ((++sp & 255u) == 0u) { if (xb_ld(&bar[XB_TMO])) break; if (sp > XB_SPIN_CAP) { atomicAdd(&bar[XB_TMO], 1u); break; } }
    }
    nloc = mine > 0u ? mine : 1u; nx = cnt > 0u ? cnt : 1u;
}

__device__ __forceinline__ void xcd_barrier(const XcdBarrier& b) {
    asm volatile("s_waitcnt vmcnt(0)" ::: "memory");
    __syncthreads();
    if (threadIdx.x == 0) {
        unsigned* bar = b.bar;
        __builtin_amdgcn_s_waitcnt(0);
        unsigned nloc = b.st[0], nx = b.st[1];
        if (nloc == 0u) { xcd_barrier_complete(bar, b.x, nloc, nx); b.st[0] = nloc; b.st[1] = nx; }
        const unsigned old = xb_add(&bar[XB_XSUB(b.x)], 1u);
        const unsigned gen = old / nloc;
        if (old + 1u == (gen + 1u) * nloc) {
            __builtin_amdgcn_fence(__ATOMIC_RELEASE, "agent");
            asm volatile("s_waitcnt vmcnt(0)" ::: "memory");
            const unsigned og = xb_add(&bar[XB_TOP], 1u);
            const unsigned tg = og / nx;
            if (og + 1u == (tg + 1u) * nx) xb_add(&bar[XB_TOPGEN], 1u);
            else XB_SPIN(xb_ld(&bar[XB_TOPGEN]) == tg, bar);
            __builtin_amdgcn_fence(__ATOMIC_ACQUIRE, "agent");
            xb_add(&bar[XB_XGEN(b.x)], 1u);
            asm volatile("s_waitcnt vmcnt(0)" ::: "memory");
        } else {
            XB_SPIN(xb_ld(&bar[XB_XGEN(b.x)]) == gen, bar);
            __builtin_amdgcn_fence(__ATOMIC_ACQUIRE, "agent");
            asm volatile("s_waitcnt vmcnt(0)" ::: "memory");
        }
    }
    __syncthreads();
}

typedef float f32x2 __attribute__((ext_vector_type(2)));
struct Args { const float* in[32]; float* out; unsigned char* ws; int ph_lo, ph_hi, use_bar, pad; };
struct Frame {
    LAS unsigned char* lds;
    volatile LAS unsigned* MISC;
    gu32* ctl;
    int tid, lane, wave;
    int vcu, G;
    float* out;
    unsigned char* ws;
};
enum { I_X = 0, I_MEM, I_POS, I_NORM_MIX, I_W_IN, I_B_GATE, I_AQ_GAIN, I_AK_GAIN, I_R_MU, I_R_W0, I_R_W2, I_R_A0, I_R_A2, I_R_G2, I_R_KK, I_R_KA, I_R_RK, I_R_LNW, I_R_LNB,
       I_MEM_NORM, I_W_MEMKV, I_CQ_GAIN, I_CK_GAIN, I_W_BRANCH, I_W_OUT, I_NORM_FFN, I_ROUTER_W, I_ROUTER_B, I_EXP_W1, I_EXP_B1, I_EXP_W2, I_EXP_B2 };

__device__ __forceinline__ bool phase_enter(Frame& F, bool on) { int t = (int)threadIdx.x; asm volatile("" : "+v"(t)); F.tid = t; F.lane = t & 63; F.wave = __builtin_amdgcn_readfirstlane(t >> 6); return on; }
__device__ __forceinline__ const float* ldarg(int i) {
    const __attribute__((address_space(4))) char* ka = (const __attribute__((address_space(4))) char*)__builtin_amdgcn_kernarg_segment_ptr();
    asm volatile("" : "+s"(ka));
    return *(const float* const __attribute__((address_space(4)))*)(ka + 8 * i);
}
__device__ __forceinline__ unsigned pk4_fp8(float a, float b, float c, float d) { unsigned w = 0; w = __builtin_amdgcn_cvt_pk_fp8_f32(a, b, w, false); w = __builtin_amdgcn_cvt_pk_fp8_f32(c, d, w, true); return w; }
__device__ __forceinline__ float fast_sigm(float x) { return __builtin_amdgcn_rcpf(1.0f + __builtin_amdgcn_exp2f(-1.4426950408889634f * x)); }
__device__ __forceinline__ float fast_tanh(float x) { return 1.0f - 2.0f * __builtin_amdgcn_rcpf(1.0f + __builtin_amdgcn_exp2f(2.8853900817779268f * x)); }
__device__ __forceinline__ float fast_softplus(float y) { return fmaxf(y, 0.f) + 0.6931471805599453f * __builtin_amdgcn_logf(1.0f + __builtin_amdgcn_exp2f(-1.4426950408889634f * fabsf(y))); }
__device__ __forceinline__ int opq(int x) { asm volatile("" : "+v"(x)); return x; }
__device__ __forceinline__ float bf_lo(unsigned w) { return __builtin_bit_cast(float, w << 16); }
__device__ __forceinline__ float bf_hi(unsigned w) { return __builtin_bit_cast(float, w & 0xffff0000u); }
__device__ __forceinline__ float sigm(float x) { return 1.0f / (1.0f + __expf(-x)); }
template <int CTRL, int RM> __device__ __forceinline__ float dpp0(float v) {
    return __builtin_bit_cast(float, __builtin_amdgcn_update_dpp(0, __builtin_bit_cast(int, v), CTRL, RM, 0xf, true)); }
__device__ __forceinline__ float row16_sum(float v) {
    v += dpp0<0xB1, 0xf>(v); v += dpp0<0x4E, 0xf>(v); v += dpp0<0x141, 0xf>(v); v += dpp0<0x140, 0xf>(v); return v; }
__device__ __forceinline__ float rdlane(float v, int l) { return __builtin_bit_cast(float, __builtin_amdgcn_readlane(__builtin_bit_cast(int, v), l)); }
__device__ __forceinline__ float wave_sum(float v) {
    v = row16_sum(v); v += dpp0<0x142, 0xA>(v); v += dpp0<0x143, 0xC>(v); return rdlane(v, 63); }
__device__ __forceinline__ void half_sums(float v, float& lo, float& hi) {
    v = row16_sum(v); v += dpp0<0x142, 0xA>(v); lo = rdlane(v, 31); hi = rdlane(v, 63); }
__device__ __forceinline__ float wave_max_bp(float v) {
#pragma unroll
    for (int o = 1; o < 64; o <<= 1) v = fmaxf(v, __shfl_xor(v, o));
    return v; }

__device__ __forceinline__ void tconv_tile(const float* W, int K, int N, bf16* WT, int k0, int n0, int rowbase, int lane, int kd = 0) {
    const int c = lane & 15, q = lane >> 4;
    const GAS f32x4* src = (const GAS f32x4*)(W + (size_t)(k0 + 16 * q) * N + n0 + 4 * c);
    const size_t rs = (size_t)N / 4;
    f32x4 v[16];
#pragma unroll
    for (int i = 0; i < 16; ++i) v[i] = src[i * rs];
#pragma unroll
    for (int j = 0; j < 4; ++j) {
        GAS v4u* dst = (GAS v4u*)(WT + (size_t)(rowbase + 4 * c + j) * K + kd + k0 + 16 * q);
        v4u o0, o1;
        o0.x = pk2(v[0][j], v[1][j]); o0.y = pk2(v[2][j], v[3][j]); o0.z = pk2(v[4][j], v[5][j]); o0.w = pk2(v[6][j], v[7][j]);
        o1.x = pk2(v[8][j], v[9][j]); o1.y = pk2(v[10][j], v[11][j]); o1.z = pk2(v[12][j], v[13][j]); o1.w = pk2(v[14][j], v[15][j]);
        dst[0] = o0; dst[1] = o1;
    }
}
__device__ __forceinline__ void tconv_tile128(const float* W, int K, int N, bf16* WT, int k0, int n0, int rowbase, int lane) {
    const int c = lane & 31, q = lane >> 5;
    const GAS f32x4* src = (const GAS f32x4*)(W + (size_t)(k0 + 32 * q) * N + n0 + 4 * c);
    const size_t rs = (size_t)N / 4;
    f32x4 v[32];
#pragma unroll
    for (int i = 0; i < 32; ++i) v[i] = src[i * rs];
#pragma unroll
    for (int j = 0; j < 4; ++j) {
        GAS v4u* dst = (GAS v4u*)(WT + (size_t)(rowbase + 4 * c + j) * K + k0 + 32 * q);
#pragma unroll
        for (int g = 0; g < 4; ++g) { v4u o; o.x = pk2(v[8 * g][j], v[8 * g + 1][j]); o.y = pk2(v[8 * g + 2][j], v[8 * g + 3][j]); o.z = pk2(v[8 * g + 4][j], v[8 * g + 5][j]); o.w = pk2(v[8 * g + 6][j], v[8 * g + 7][j]); dst[g] = o; }
    }
}
__device__ __forceinline__ void tconv_tile_f8(const float* W, int K, int N, unsigned char* WT, int k0, int n0, int rowbase, int lane, float sc) {
    const int c = lane & 15, q = lane >> 4;
    const GAS f32x4* src = (const GAS f32x4*)(W + (size_t)(k0 + 16 * q) * N + n0 + 4 * c);
    const size_t rs = (size_t)N / 4;
    f32x4 v[16];
#pragma unroll
    for (int i = 0; i < 16; ++i) v[i] = src[i * rs] * sc;
#pragma unroll
    for (int j = 0; j < 4; ++j) {
        v4u o; o.x = pk4_fp8(v[0][j], v[1][j], v[2][j], v[3][j]); o.y = pk4_fp8(v[4][j], v[5][j], v[6][j], v[7][j]); o.z = pk4_fp8(v[8][j], v[9][j], v[10][j], v[11][j]); o.w = pk4_fp8(v[12][j], v[13][j], v[14][j], v[15][j]);
        *(GAS v4u*)(WT + (size_t)(rowbase + 4 * c + j) * K + k0 + 16 * q) = o;
    }
}
__device__ __forceinline__ void tc8_load(const float* W, int N, int k0, int n0, int lane, f32x4 (&v)[16]) {
    const int c = lane & 15, q = lane >> 4; const GAS f32x4* src = (const GAS f32x4*)(W + (size_t)(k0 + 16 * q) * N + n0 + 4 * c); const size_t rs = (size_t)N / 4;
#pragma unroll
    for (int i = 0; i < 16; ++i) v[i] = src[i * rs];
}
__device__ __forceinline__ void tc8_store(unsigned char* WT, int K, int k0, int rowbase, int lane, const f32x4 (&v)[16], float sc) {
    const int c = lane & 15, q = lane >> 4;
#pragma unroll
    for (int j = 0; j < 4; ++j) {
        v4u o; o.x = pk4_fp8(v[0][j] * sc, v[1][j] * sc, v[2][j] * sc, v[3][j] * sc); o.y = pk4_fp8(v[4][j] * sc, v[5][j] * sc, v[6][j] * sc, v[7][j] * sc);
        o.z = pk4_fp8(v[8][j] * sc, v[9][j] * sc, v[10][j] * sc, v[11][j] * sc); o.w = pk4_fp8(v[12][j] * sc, v[13][j] * sc, v[14][j] * sc, v[15][j] * sc);
        *(GAS v4u*)(WT + (size_t)(rowbase + 4 * c + j) * K + k0 + 16 * q) = o; }
}
__device__ __forceinline__ void w1_tile(int r, const float* W1, unsigned char* W1T, const float*& W, unsigned char*& WT, int& k0, int& n0, int& rowbase) {
    const int e = r / 512, q = r % 512, kb = q % 16, nb = q / 16; n0 = 64 * nb; k0 = 64 * kb;
    rowbase = (n0 < 1024) ? ((n0 >> 7) * 256 + (n0 & 127)) : ((((n0 - 1024) >> 7) * 256) + 128 + ((n0 - 1024) & 127));
    W = W1 + (size_t)e * 1024 * 2048; WT = W1T + (size_t)e * 2048 * 1024;
}
__device__ __forceinline__ void rms_row_to_bf16(const float* xrow, const float* gain, bf16* orow, int lane, unsigned char* orow8 = nullptr) {
    const GAS f32x4* xr = (const GAS f32x4*)xrow + lane; const GAS f32x4* gr = (const GAS f32x4*)gain + lane;
    f32x4 v[4]; float s = 0.f;
#pragma unroll
    for (int j = 0; j < 4; ++j) { v[j] = xr[64 * j]; s += (v[j].x * v[j].x + v[j].y * v[j].y) + (v[j].z * v[j].z + v[j].w * v[j].w); }
    const float rstd = 1.0f / sqrtf(wave_sum(s) * (1.f / D_MODEL) + NORM_EPS);
    GAS unsigned long long* o8 = (GAS unsigned long long*)orow + lane;
#pragma unroll
    for (int j = 0; j < 4; ++j) { const f32x4 g = gr[64 * j];
        o8[64 * j] = (unsigned long long)pk2(v[j].x * rstd * g.x, v[j].y * rstd * g.y) | ((unsigned long long)pk2(v[j].z * rstd * g.z, v[j].w * rstd * g.w) << 32);
        if (orow8) ((GAS unsigned*)orow8 + lane)[64 * j] = pk4_fp8(v[j].x * rstd * g.x, v[j].y * rstd * g.y, v[j].z * rstd * g.z, v[j].w * rstd * g.w); }
}
template <int PART> __device__ __forceinline__ void p0_prologue(Frame& F, const Args& args, int gw, int NGW) {
    const int lane = F.lane;
    unsigned char* ws = F.ws;
    constexpr int T_IN = 16 * 156, T_WB = 3 * 128, T_WO = 256, T_WM = 256, T_W1 = 32 * 512, T_W2 = 32 * 256, T_LO = 32;
    constexpr int NT = T_IN + T_WB + T_WO + T_WM + T_W1 + T_W2;
    constexpr int IT0 = (PART == 0) ? 0 : (PART == 1) ? T_IN + T_WB + T_WO + T_WM + T_W1 : T_IN + T_WB + T_WO + T_WM, IT1 = (PART == 0) ? T_IN + T_WB + T_WO + T_WM : (PART == 1) ? NT : T_IN + T_WB + T_WO + T_WM + T_W1;
    if constexpr (PART == 1) {
        constexpr int B1 = T_IN + T_WB + T_WO + T_WM + T_W1;
        auto w2_src = [&](int it_, const float*& W_, unsigned char*& WT_, int& k0_, int& n0_) { const int r_ = it_ - B1, e_ = r_ / 256, q_ = r_ % 256; k0_ = 64 * (q_ % 16); n0_ = 64 * (q_ / 16);
            W_ = ldarg(I_EXP_W2) + (size_t)e_ * 1024 * 1024; WT_ = ws + WS_W2 + (size_t)e_ * 1024 * 1024; };
        f32x4 va[16], vb[16]; const float* Wa; unsigned char* Ta; int ka, na; const float* Wb; unsigned char* Tb; int kb_, nb_;
        int it = IT0 + gw;
        if (it < IT1) { w2_src(it, Wa, Ta, ka, na); tc8_load(Wa, 1024, ka, na, lane, va); }
        while (it < IT1) {
            const int i1 = it + NGW; if (i1 < IT1) { w2_src(i1, Wb, Tb, kb_, nb_); tc8_load(Wb, 1024, kb_, nb_, lane, vb); }
            tc8_store(Ta, 1024, ka, na, lane, va, W8_SCALE);
            if (i1 >= IT1) break;
            const int i2 = i1 + NGW; if (i2 < IT1) { w2_src(i2, Wa, Ta, ka, na); tc8_load(Wa, 1024, ka, na, lane, va); }
            tc8_store(Tb, 1024, kb_, nb_, lane, vb, W8_SCALE);
            it = i2;
        }
        return;
    }
    for (int it = IT0 + gw; it < IT1; it += NGW) {
        int r = it;
        if (r < T_IN) { const int kb = r / 156, nb = r % 156, nt = nb >> 2;
            if (nt < 12 || nt >= 27) tconv_tile_f8(ldarg(I_W_IN), 1024, IN_COLS, ws + WS_WIN8, 64 * kb, 64 * nb, 64 * nb, lane, W8_SCALE);
            else tconv_tile(ldarg(I_W_IN), 1024, IN_COLS, (bf16*)(ws + WS_WIN), 64 * kb, 64 * nb, 64 * nb, lane);
            continue; } r -= T_IN;
        if (r < T_WB) { const int b = r / 128, q = r % 128, kb = q / 16, nb = q % 16;
            tconv_tile(ldarg(I_W_BRANCH) + (size_t)b * 512 * 1024, 1536, 1024, (bf16*)(ws + WS_WB), 64 * kb, 64 * nb, 64 * nb, lane, 512 * b); continue; } r -= T_WB;
        if (r < T_WO) { const int kb = r / 16, nb = r % 16; if (MRG_FP8) tconv_tile_f8(ldarg(I_W_OUT), 1024, 1024, ws + WS_WO, 64 * kb, 64 * nb, 64 * nb, lane, W8_SCALE); else tconv_tile(ldarg(I_W_OUT), 1024, 1024, (bf16*)(ws + WS_WO), 64 * kb, 64 * nb, 64 * nb, lane); continue; } r -= T_WO;
        if (r < T_WM) { const int kb = r / 16, nb = r % 16; tconv_tile(ldarg(I_W_MEMKV), 1024, 1024, (bf16*)(ws + WS_WMEM), 64 * kb, 64 * nb, 64 * nb, lane); continue; } r -= T_WM;
        if (r < T_W1) { const int e = r / 512, q = r % 512, kb = q % 16, nb = q / 16, n0 = 64 * nb;
            const int rowbase = (n0 < 1024) ? ((n0 >> 7) * 256 + (n0 & 127)) : ((((n0 - 1024) >> 7) * 256) + 128 + ((n0 - 1024) & 127));
            tconv_tile_f8(ldarg(I_EXP_W1) + (size_t)e * 1024 * 2048, 1024, 2048, ws + WS_W1 + (size_t)e * 2048 * 1024, 64 * kb, n0, rowbase, lane, W8_SCALE); continue; } r -= T_W1;
        { const int e = r / 256, q = r % 256, kb = q % 16, nb = q / 16;
            tconv_tile_f8(ldarg(I_EXP_W2) + (size_t)e * 1024 * 1024, 1024, 1024, ws + WS_W2 + (size_t)e * 1024 * 1024, 64 * kb, 64 * nb, 64 * nb, lane, W8_SCALE); }
    }
    if (PART == 0) {
    for (int it = gw; it < T_LO; it += NGW) {
        bf16* L = (bf16*)(ws + WS_LORA);
        if (it < 8) tconv_tile(ldarg(I_R_W2), 64, 512, L, 0, 64 * it, 64 * it, lane);
        else if (it < 16) tconv_tile(ldarg(I_R_A2), 64, 512, L + 512 * 64, 0, 64 * (it - 8), 64 * (it - 8), lane);
        else { const int q = it - 16; tconv_tile(ldarg(I_R_G2), 128, 512, L + 2 * 512 * 64, 64 * (q >> 3), 64 * (q & 7), 64 * (q & 7), lane); } }
    { const int* posp = (const int*)ldarg(I_POS); float* cs = (float*)(ws + WS_CS);
      for (int idx = gw * 64 + lane; idx < MTOK * 16; idx += NGW * 64) { const int m = idx >> 4, i = idx & 15; const float ang = (float)posp[m] * exp2f(-(float)i * (18.931568569324174f / 16.0f)); const float sn = sinf(ang), cn = cosf(ang);
          f32x2 o; o.x = cn; o.y = sn; *(GAS f32x2*)(cs + (size_t)idx * 2) = o; } }
    { const float* X_ = ldarg(I_X); const GAS f32x4* gr = (const GAS f32x4*)ldarg(I_NORM_MIX) + lane; const f32x4 g0 = gr[0], g1 = gr[64], g2 = gr[128], g3 = gr[192];
      for (int m0 = gw; m0 < MTOK; m0 += 4 * NGW) {
          f32x4 v[4][4];
#pragma unroll
          for (int i = 0; i < 4; ++i) { const int m = m0 + i * NGW; const GAS f32x4* xr = (const GAS f32x4*)(X_ + (size_t)(m < MTOK ? m : m0) * D_MODEL) + lane;
#pragma unroll
              for (int j = 0; j < 4; ++j) v[i][j] = xr[64 * j]; }
#pragma unroll
          for (int i = 0; i < 4; ++i) { const int m = m0 + i * NGW; if (m >= MTOK) break;
              float s = 0.f;
#pragma unroll
              for (int j = 0; j < 4; ++j) s += (v[i][j].x * v[i][j].x + v[i][j].y * v[i][j].y) + (v[i][j].z * v[i][j].z + v[i][j].w * v[i][j].w);
              const float rstd = 1.0f / sqrtf(wave_sum(s) * (1.f / D_MODEL) + NORM_EPS);
              GAS unsigned long long* o8 = (GAS unsigned long long*)((bf16*)(ws + WS_XN) + (size_t)m * D_MODEL) + lane; GAS unsigned* q8 = (GAS unsigned*)(ws + WS_XN8 + (size_t)m * D_MODEL) + lane;
#pragma unroll
              for (int j = 0; j < 4; ++j) { const f32x4 g = (j == 0) ? g0 : (j == 1) ? g1 : (j == 2) ? g2 : g3; const f32x4 y = v[i][j] * rstd * g;
                  o8[64 * j] = (unsigned long long)pk2(y.x, y.y) | ((unsigned long long)pk2(y.z, y.w) << 32);
                  q8[64 * j] = pk4_fp8(y.x, y.y, y.z, y.w); } } } }
    for (int m = gw; m < MEMROWS; m += NGW) rms_row_to_bf16(ldarg(I_MEM) + (size_t)m * D_MODEL, ldarg(I_MEM_NORM), (bf16*)(ws + WS_MEMN) + (size_t)m * D_MODEL, lane);
    }
}

__device__ __forceinline__ void head_norm(bf16* p, const float* gain, bool rot, float c0, float s0, float c1, float s1, float scale, int lane) {
    GAS unsigned* pw = (GAS unsigned*)p + lane;
    const unsigned w = *pw; float a = bf_lo(w), b = bf_hi(w);
    const float ss = wave_sum(a * a + b * b);
    const float rstd = 1.0f / sqrtf(ss * (1.f / 128.f) + NORM_EPS);
    const f32x2 g = *((const GAS f32x2*)gain + lane);
    a = a * rstd * g.x; b = b * rstd * g.y;
    const float pa = __shfl_xor(a, 8), pb = __shfl_xor(b, 8);
    if (rot && lane < 16) {
        if (lane < 8) { a = a * c0 - pa * s0; b = b * c1 - pb * s1; }
        else          { a = a * c0 + pa * s0; b = b * c1 + pb * s1; }
    }
    *pw = pk2(a * scale, b * scale);
}
__device__ __forceinline__ void p2_prep(Frame& F, const Args& args) {
    const int gw = F.vcu * NWAVES + F.wave, NGW = F.G * NWAVES, lane = F.lane;
    unsigned char* ws = F.ws;
    bf16* Z = (bf16*)(ws + WS_Z);
    LAS float* lo = (LAS float*)(F.lds + RING_OFF + F.wave * 8192);
    const float* mu = ldarg(I_R_MU); const float* aqg = ldarg(I_AQ_GAIN); const float* akg = ldarg(I_AK_GAIN); const float* cqg = ldarg(I_CQ_GAIN); const int* posp = (const int*)ldarg(I_POS);
    float* Rr = (float*)(ws + WS_RW); float* Rw = Rr + (size_t)MTOK * RW; float* Rk = Rw + (size_t)MTOK * RW; float* Rv = Rk + (size_t)MTOK * RW;
    float* Ra = Rv + (size_t)MTOK * RW; float* Rb = Ra + (size_t)MTOK * RW; float* Rg = Rb + (size_t)MTOK * RW;
    for (int m = gw; m < MEMROWS; m += NGW)
        for (int hd = 0; hd < 4; ++hd) head_norm((bf16*)(ws + WS_KVM) + (size_t)m * 1024 + hd * 128, ldarg(I_CK_GAIN), false, 1.f, 0.f, 1.f, 0.f, 1.0f, lane);
}

__device__ __forceinline__ void lora_stage(const float* W, LAS unsigned* wl, int tid) {
#pragma unroll
    for (int i = 0; i < 16; ++i) { const int idx = tid + 512 * i; const f32x4 v = *((const GAS f32x4*)W + idx);
        *(LAS unsigned long long*)(wl + 2 * idx) = (unsigned long long)pk2(v.x, v.y) | ((unsigned long long)pk2(v.z, v.w) << 32); }
}
__device__ __forceinline__ void lora_mac(const LAS unsigned* wl, const LAS float* lo, float (&acc)[4][8], int lane) {
#pragma unroll 4
    for (int j = 0; j < 64; ++j) { const f32x4 xin = *(const LAS f32x4*)(lo + j * 4);
#pragma unroll
        for (int i = 0; i < 4; ++i) { const unsigned w = wl[j * 256 + lane + 64 * i]; const float w0 = bf_lo(w), w1 = bf_hi(w);
#pragma unroll
            for (int tt = 0; tt < 4; ++tt) { acc[tt][2 * i] += xin[tt] * w0; acc[tt][2 * i + 1] += xin[tt] * w1; } } }
}
template <int NL> __device__ __forceinline__ void lora_in(const bf16* Z, const float* mu, int ch, int m0, LAS float* lo, int lane) {
    const int col = OFF_R + 1536 + ch; const float muj = mu[1536 + ch];
    float prv = ((m0 % SEQ) == 0) ? 0.f : __builtin_bit_cast(float, (unsigned)Z[(size_t)(m0 - 1) * IN_COLS + col] << 16);
#pragma unroll
    for (int tt = 0; tt < 4; ++tt) { const float cur = __builtin_bit_cast(float, (unsigned)Z[(size_t)(m0 + tt) * IN_COLS + col] << 16);
        float x = cur + (prv - cur) * muj; prv = cur;
        x = (NL == 0) ? tanhf(x) : (NL == 1) ? x : sigm(x);
        lo[lane * 4 + tt] = x; }
    LDS_WAIT(); asm volatile("" ::: "memory");
}
__device__ __forceinline__ void p2_rwkv(Frame& F, const Args& args) {
    const int lane = F.lane, wave = F.wave;
    unsigned char* ws = F.ws;
    const bf16* Z = (const bf16*)(ws + WS_Z);
    LAS unsigned* wl = (LAS unsigned*)(F.lds + RING_OFF);
    LAS float* lo = (LAS float*)(F.lds + RING_OFF + 65536 + wave * 1024);
    const float* mu = ldarg(I_R_MU);
    float* Rr = (float*)(ws + WS_RW); float* Rw = Rr + (size_t)MTOK * RW; float* Rk = Rw + (size_t)MTOK * RW; float* Rv = Rk + (size_t)MTOK * RW;
    float* Ra = Rv + (size_t)MTOK * RW; float* Rb = Ra + (size_t)MTOK * RW; float* Rg = Rb + (size_t)MTOK * RW;
    for (int grp = F.vcu; grp < MTOK / 64; grp += F.G) {
        const int mw = grp * 64 + wave * 8;
        lora_stage(ldarg(I_R_W2), wl, F.tid);
        __syncthreads();
        for (int tk = 0; tk < 2; ++tk) { const int m0 = mw + 4 * tk;
            lora_in<0>(Z, mu, lane, m0, lo, lane);
            float acc[4][8];
#pragma unroll
            for (int tt = 0; tt < 4; ++tt)
#pragma unroll
                for (int c = 0; c < 8; ++c) acc[tt][c] = 0.f;
            lora_mac(wl, lo, acc, lane);
            const float* w0p = ldarg(I_R_W0);
#pragma unroll
            for (int i = 0; i < 4; ++i) { const int c = 2 * lane + 128 * i; const f32x2 w0 = *(const GAS f32x2*)(w0p + c);
#pragma unroll
                for (int tt = 0; tt < 4; ++tt) { const float y0 = -(w0.x + acc[tt][2 * i]), y1 = -(w0.y + acc[tt][2 * i + 1]);
                    const float sp0 = fmaxf(y0, 0.f) + log1pf(__expf(-fabsf(y0))), sp1 = fmaxf(y1, 0.f) + log1pf(__expf(-fabsf(y1)));
                    f32x2 wd; wd.x = -__expf(-sp0 - 0.5f); wd.y = -__expf(-sp1 - 0.5f);
                    *(GAS f32x2*)(Rw + (size_t)(m0 + tt) * RW + c) = wd; } }
            LDS_WAIT(); asm volatile("" ::: "memory"); }
        __syncthreads();
        lora_stage(ldarg(I_R_A2), wl, F.tid);
        __syncthreads();
        for (int tk = 0; tk < 2; ++tk) { const int m0 = mw + 4 * tk; const int tpos0 = m0 % SEQ;
            lora_in<1>(Z, mu, 64 + lane, m0, lo, lane);
            float acca[4][8];
#pragma unroll
            for (int tt = 0; tt < 4; ++tt)
#pragma unroll
                for (int c = 0; c < 8; ++c) acca[tt][c] = 0.f;
            lora_mac(wl, lo, acca, lane);
            const float* a0p = ldarg(I_R_A0); const float* kkp = ldarg(I_R_KK); const float* kap = ldarg(I_R_KA);
#pragma unroll
            for (int i = 0; i < 4; ++i) {
                const int c = 2 * lane + 128 * i;
                const f32x2 a0 = *(const GAS f32x2*)(a0p + c), kkc = *(const GAS f32x2*)(kkp + c), kac = *(const GAS f32x2*)(kap + c);
                const f32x2 mur = *(const GAS f32x2*)(mu + c), muk = *(const GAS f32x2*)(mu + 512 + c), muv = *(const GAS f32x2*)(mu + 1024 + c);
                unsigned pr = 0u, pk = 0u, pv = 0u;
                if (tpos0 != 0) { const bf16* zp = Z + (size_t)(m0 - 1) * IN_COLS + OFF_R + c; pr = *(const GAS unsigned*)zp; pk = *(const GAS unsigned*)(zp + 512); pv = *(const GAS unsigned*)(zp + 1024); }
#pragma unroll
                for (int tt = 0; tt < 4; ++tt) {
                    const size_t m = (size_t)(m0 + tt);
                    const bf16* zc = Z + m * IN_COLS + OFF_R + c;
                    const unsigned cr = *(const GAS unsigned*)zc, ck = *(const GAS unsigned*)(zc + 512), cv = *(const GAS unsigned*)(zc + 1024);
                    f32x2 r, k, v;
                    r.x = bf_lo(cr) + (bf_lo(pr) - bf_lo(cr)) * mur.x; r.y = bf_hi(cr) + (bf_hi(pr) - bf_hi(cr)) * mur.y;
                    k.x = bf_lo(ck) + (bf_lo(pk) - bf_lo(ck)) * muk.x; k.y = bf_hi(ck) + (bf_hi(pk) - bf_hi(ck)) * muk.y;
                    v.x = bf_lo(cv) + (bf_lo(pv) - bf_lo(cv)) * muv.x; v.y = bf_hi(cv) + (bf_hi(pv) - bf_hi(cv)) * muv.y;
                    pr = cr; pk = ck; pv = cv;
                    f32x2 av; av.x = sigm(a0.x + acca[tt][2 * i]); av.y = sigm(a0.y + acca[tt][2 * i + 1]);
                    f32x2 kk; kk.x = k.x * kkc.x; kk.y = k.y * kkc.y;
                    float slo, shi; half_sums(kk.x * kk.x + kk.y * kk.y, slo, shi);
                    const float nrm = fmaxf(sqrtf(lane < 32 ? slo : shi), 1e-12f), inv = 1.0f / nrm;
                    kk.x *= inv; kk.y *= inv;
                    f32x2 k2; k2.x = k.x * (1.0f + (av.x - 1.0f) * kac.x); k2.y = k.y * (1.0f + (av.y - 1.0f) * kac.y);
                    f32x2 as, bs; as.x = -kk.x; as.y = -kk.y; bs.x = kk.x * av.x; bs.y = kk.y * av.y;
                    const size_t o = m * RW + c;
                    *(GAS f32x2*)(Rr + o) = r; *(GAS f32x2*)(Rk + o) = k2; *(GAS f32x2*)(Rv + o) = v; *(GAS f32x2*)(Ra + o) = as; *(GAS f32x2*)(Rb + o) = bs;
                }
            }
            LDS_WAIT(); asm volatile("" ::: "memory"); }
        __syncthreads();
        float accg[2][4][8];
#pragma unroll
        for (int tk = 0; tk < 2; ++tk)
#pragma unroll
            for (int tt = 0; tt < 4; ++tt)
#pragma unroll
                for (int c = 0; c < 8; ++c) accg[tk][tt][c] = 0.f;
#pragma unroll
        for (int hh = 0; hh < 2; ++hh) {
            lora_stage(ldarg(I_R_G2) + (size_t)hh * 64 * RW, wl, F.tid);
            __syncthreads();
#pragma unroll
            for (int tk = 0; tk < 2; ++tk) { lora_in<2>(Z, mu, 128 + 64 * hh + lane, mw + 4 * tk, lo, lane); lora_mac(wl, lo, accg[tk], lane); LDS_WAIT(); asm volatile("" ::: "memory"); }
            __syncthreads();
        }
#pragma unroll
        for (int tk = 0; tk < 2; ++tk)
#pragma unroll
            for (int i = 0; i < 4; ++i)
#pragma unroll
                for (int tt = 0; tt < 4; ++tt) { f32x2 gg; gg.x = accg[tk][tt][2 * i]; gg.y = accg[tk][tt][2 * i + 1]; *(GAS f32x2*)(Rg + (size_t)(mw + 4 * tk + tt) * RW + 2 * lane + 128 * i) = gg; }
    }
}

__device__ __forceinline__ float qk_dot(const LAS float* q, const bf16* krow) {
    const GAS v4u* kp = (const GAS v4u*)krow; float s0 = 0.f, s1 = 0.f;
#pragma unroll
    for (int i = 0; i < 16; ++i) { const v4u w = kp[i]; const f32x4 qa = *(const LAS f32x4*)(q + 8 * i), qb = *(const LAS f32x4*)(q + 8 * i + 4);
        s0 += bf_lo(w.x) * qa[0] + bf_hi(w.x) * qa[1] + bf_lo(w.y) * qa[2] + bf_hi(w.y) * qa[3];
        s1 += bf_lo(w.z) * qb[0] + bf_hi(w.z) * qb[1] + bf_lo(w.w) * qb[2] + bf_hi(w.w) * qb[3]; }
    return s0 + s1;
}
__device__ __forceinline__ void p3_attention(Frame& F) {
    const int gw = F.vcu * NWAVES + F.wave, NGW = F.G * NWAVES, lane = F.lane;
    unsigned char* ws = F.ws;
    const bf16* Z = (const bf16*)(ws + WS_Z);
    const bf16* KV = (const bf16*)(ws + WS_KVM);
    bf16* YA = (bf16*)(ws + WS_YABC); bf16* YC = YA + (size_t)2 * MTOK * 512;
    LAS float* qs = (LAS float*)(F.lds + RING_OFF + F.wave * 8192);
    for (int task = gw; task < MTOK * 4; task += NGW) {
        const int m = task >> 2, h = task & 3, t = m % SEQ;
        const bf16* zrow = Z + (size_t)m * IN_COLS;
#pragma unroll
        for (int g = 0; g < 3; ++g) { const unsigned w = *((const GAS unsigned*)(zrow + OFF_AQ + g * 512 + h * 128) + lane); qs[g * 128 + 2 * lane] = bf_lo(w); qs[g * 128 + 2 * lane + 1] = bf_hi(w); }
        LDS_WAIT(); asm volatile("" ::: "memory");
        float sc[3][3]; float mx = -INFINITY;
#pragma unroll
        for (int g = 0; g < 3; ++g) { const int dl = (g == 0) ? 1 : (g == 1) ? 4 : 16;
#pragma unroll
            for (int p = 0; p < 3; ++p) { const int j = lane + 64 * p; const int tk = t - dl * j; float s = -INFINITY;
                if (j <= 128 && tk >= 0) s = qk_dot(qs + g * 128, zrow - (size_t)dl * j * IN_COLS + OFF_AK + g * 512 + h * 128);
                sc[g][p] = s; mx = fmaxf(mx, s); } }
        mx = wave_max_bp(mx);
        float den = 0.f;
#pragma unroll
        for (int g = 0; g < 3; ++g)
#pragma unroll
            for (int p = 0; p < 3; ++p) { sc[g][p] = exp2f(sc[g][p] - mx); den += sc[g][p]; }
        den = wave_sum(den);
        float o0 = 0.f, o1 = 0.f;
#pragma unroll
        for (int g = 0; g < 3; ++g) { const int dl = (g == 0) ? 1 : (g == 1) ? 4 : 16; const bf16* vb = zrow + OFF_AV + g * 512 + h * 128 + 2 * lane;
#pragma unroll
            for (int p = 0; p < 3; ++p) { const int nj = (p < 2) ? 64 : 1;
                for (int jj = 0; jj < nj; ++jj) { const int j = jj + 64 * p; const float pj = rdlane(sc[g][p], jj);
                    if (t - dl * j >= 0) { const unsigned w = *(const GAS unsigned*)(vb - (size_t)dl * j * IN_COLS); o0 += pj * bf_lo(w); o1 += pj * bf_hi(w); } } } }
        const float inv = 1.0f / den;
        *((GAS unsigned*)(YA + (size_t)m * 512 + h * 128) + lane) = pk2(o0 * inv, o1 * inv);
        asm volatile("" ::: "memory");
    }
    for (int task = gw; task < MTOK * 4; task += NGW) {
        const int m = task >> 2, h = task & 3, b = m / SEQ;
        const bf16* zrow = Z + (size_t)m * IN_COLS;
        { const unsigned w = *((const GAS unsigned*)(zrow + OFF_CQ + h * 128) + lane); qs[2 * lane] = bf_lo(w); qs[2 * lane + 1] = bf_hi(w); }
        LDS_WAIT(); asm volatile("" ::: "memory");
        const bf16* kb = KV + (size_t)b * MEM_LEN * 1024 + h * 128;
        float sc[4]; float mx = -INFINITY;
#pragma unroll
        for (int p = 0; p < 4; ++p) { sc[p] = qk_dot(qs, kb + (size_t)(lane + 64 * p) * 1024); mx = fmaxf(mx, sc[p]); }
        mx = wave_max_bp(mx);
        float den = 0.f;
#pragma unroll
        for (int p = 0; p < 4; ++p) { sc[p] = exp2f(sc[p] - mx); den += sc[p]; }
        den = wave_sum(den);
        float o0 = 0.f, o1 = 0.f; const bf16* vb = kb + 512 + 2 * lane;
#pragma unroll
        for (int p = 0; p < 4; ++p)
            for (int jj = 0; jj < 64; ++jj) { const float pj = rdlane(sc[p], jj); const unsigned w = *(const GAS unsigned*)(vb + (size_t)(jj + 64 * p) * 1024); o0 += pj * bf_lo(w); o1 += pj * bf_hi(w); }
        const float inv = 1.0f / den;
        *((GAS unsigned*)(YC + (size_t)m * 512 + h * 128) + lane) = pk2(o0 * inv, o1 * inv);
        asm volatile("" ::: "memory");
    }
}

__device__ __forceinline__ void p5_post(Frame& F, const Args& args) {
    const int gw = F.vcu * NWAVES + F.wave, NGW = F.G * NWAVES, lane = F.lane;
    unsigned char* ws = F.ws;
    const float* Rr = (const float*)(ws + WS_RW); const float* Rk = Rr + (size_t)2 * MTOK * RW; const float* Rv = Rk + (size_t)MTOK * RW; const float* Rg = Rr + (size_t)6 * MTOK * RW;
    const float* YS = (const float*)(ws + WS_YS);
    bf16* YB = (bf16*)(ws + WS_YABC) + (size_t)MTOK * 512;
    const bf16* OP = (const bf16*)(ws + WS_OP); const float* LS = (const float*)(ws + WS_LSE); bf16* YA = (bf16*)(ws + WS_YABC);
    for (int m = gw; m < MTOK; m += NGW) {
        float l0[4], l1[4], l2[4]; unsigned pa[4], pb[4], pc[4];
#pragma unroll
        for (int h = 0; h < 4; ++h) { l0[h] = LS[(size_t)m * 4 + h]; l1[h] = LS[(size_t)MTOK * 4 + (size_t)m * 4 + h]; l2[h] = LS[(size_t)2 * MTOK * 4 + (size_t)m * 4 + h];
            const size_t o = (size_t)m * 512 + h * 128;
            pa[h] = *((const GAS unsigned*)(OP + o) + lane); pb[h] = *((const GAS unsigned*)(OP + (size_t)MTOK * 512 + o) + lane); pc[h] = *((const GAS unsigned*)(OP + (size_t)2 * MTOK * 512 + o) + lane); }
#pragma unroll
        for (int h = 0; h < 4; ++h) {
            const float mx = fmaxf(l0[h], fmaxf(l1[h], l2[h])); const float w0 = exp2f(l0[h] - mx), w1 = exp2f(l1[h] - mx), w2 = exp2f(l2[h] - mx); const float inv = __builtin_amdgcn_rcpf(w0 + w1 + w2);
            *((GAS unsigned*)(YA + (size_t)m * 1536 + h * 128) + lane) = pk2((w0 * bf_lo(pa[h]) + w1 * bf_lo(pb[h]) + w2 * bf_lo(pc[h])) * inv, (w0 * bf_hi(pa[h]) + w1 * bf_hi(pb[h]) + w2 * bf_hi(pc[h])) * inv); }
    }
}

__device__ __forceinline__ void p8_router(Frame& F, const Args& args) {
    const int lane = F.lane, wave = F.wave;
    unsigned char* ws = F.ws;
    const float* X1 = F.out;
    LAS int* hist = (LAS int*)(F.lds + HIST_OFF);
    { const int t_ = opq(F.tid); if (t_ < 32) hist[t_] = 0; }
    int* topi = (int*)(ws + WS_ROUTE + RT_TOPI); float* topg = (float*)(ws + WS_ROUTE + RT_TOPG);
    const float* RWt = ldarg(I_ROUTER_W); const float* RB = ldarg(I_ROUTER_B); const float* gain = ldarg(I_NORM_FFN);
    LAS float* rw = (LAS float*)(F.lds + RING_OFF);
    typedef float f32x16r __attribute__((ext_vector_type(16)));
    for (int grp = F.vcu; grp < MTOK / 64; grp += F.G) {
        const int tile = wave >> 2, wq = wave & 3, i32 = lane & 31, h = lane >> 5;
        const GAS f32x4* xp = (const GAS f32x4*)(X1 + ((size_t)grp * 64 + tile * 32 + i32) * D_MODEL + wq * 256 + 4 * h);
        f32x4 xall[16];
#pragma unroll
        for (int q = 0; q < 16; ++q) xall[q] = xp[2 * q];
#pragma unroll
        for (int i = 0; i < 16; ++i) { const int f = F.tid + 512 * i, k = f >> 3; const f32x4 w = *((const GAS f32x4*)RWt + f); const float g = gain[k]; ((LAS f32x4*)rw)[f] = w * g; }
        __syncthreads();
        const LAS float* bp = rw + (wq * 256 + 4 * h) * 32 + i32;
        f32x16r acc;
#pragma unroll
        for (int r = 0; r < 16; ++r) acc[r] = 0.f;
        float ss = 0.f;
#pragma unroll
        for (int q = 0; q < 16; ++q) { const f32x4 xv = xall[q]; ss += (xv.x * xv.x + xv.y * xv.y) + (xv.z * xv.z + xv.w * xv.w);
#pragma unroll
            for (int j = 0; j < 4; ++j) acc = __builtin_amdgcn_mfma_f32_32x32x2f32(xv[j], bp[(8 * q + j) * 32], acc, 0, 0, 0); }
#pragma unroll 4
        for (int q = 16; q < 32; ++q) { const f32x4 xv = xp[2 * q]; ss += (xv.x * xv.x + xv.y * xv.y) + (xv.z * xv.z + xv.w * xv.w);
#pragma unroll
            for (int j = 0; j < 4; ++j) acc = __builtin_amdgcn_mfma_f32_32x32x2f32(xv[j], bp[(8 * q + j) * 32], acc, 0, 0, 0); }
        __syncthreads();
        { LAS float* part = rw + (tile * 4 + wq) * 1024;
#pragma unroll
          for (int r = 0; r < 16; ++r) part[((r & 3) + 8 * (r >> 2) + 4 * h) * 32 + i32] = acc[r];
          rw[8192 + (tile * 4 + wq) * 64 + lane] = ss; }
        __syncthreads();
        if (F.tid < 64) { const int t = F.tid, tl = t >> 5, row = t & 31; const size_t m = (size_t)grp * 64 + t;
            float s = 0.f;
#pragma unroll
            for (int q = 0; q < 4; ++q) s += rw[8192 + (tl * 4 + q) * 64 + row] + rw[8192 + (tl * 4 + q) * 64 + 32 + row];
            const float rstd = 1.0f / sqrtf(s * (1.f / D_MODEL) + NORM_EPS);
            float lg[32];
#pragma unroll
            for (int e = 0; e < 32; ++e) { const LAS float* pp = rw + (tl * 4) * 1024 + row * 32 + e; lg[e] = ((pp[0] + pp[1024]) + (pp[2048] + pp[3072])) * rstd + RB[e]; }
            int ti[4]; float tv[4];
#pragma unroll
            for (int k = 0; k < 4; ++k) { float best = -INFINITY; int bi = 0;
#pragma unroll
                for (int e = 0; e < 32; ++e) { const bool taken = (k > 0 && ti[0] == e) || (k > 1 && ti[1] == e) || (k > 2 && ti[2] == e); if (!taken && lg[e] > best) { best = lg[e]; bi = e; } }
                ti[k] = bi; tv[k] = best; }
            const float e1 = __expf(tv[1] - tv[0]), e2 = __expf(tv[2] - tv[0]), e3 = __expf(tv[3] - tv[0]); const float inv = 1.0f / (1.0f + e1 + e2 + e3);
            { typedef int i32x4 __attribute__((ext_vector_type(4))); *(GAS i32x4*)(topi + m * 4) = (i32x4){ti[0], ti[1], ti[2], ti[3]}; } *(GAS f32x4*)(topg + m * 4) = (f32x4){inv, e1 * inv, e2 * inv, e3 * inv};
#pragma unroll
            for (int k = 0; k < 4; ++k) __hip_atomic_fetch_add(hist + ti[k], 1, __ATOMIC_RELAXED, __HIP_MEMORY_SCOPE_WORKGROUP); }
        __syncthreads();
    }
    { const int t_ = opq(F.tid); if (t_ < 32 && hist[t_] != 0) __hip_atomic_fetch_add((unsigned*)(F.ctl + CW_CNT) + 64 * t_, (unsigned)hist[t_], __ATOMIC_RELAXED, __HIP_MEMORY_SCOPE_AGENT); }
}
__device__ __forceinline__ void moe_table(Frame& F) {
    LAS int* tab = (LAS int*)(F.lds + MOETAB_OFF);
    __syncthreads();
    if (F.tid < 64) {
        const int e = opq(F.tid); int nb = 0;
        if (e < 32) { const int c = (int)__hip_atomic_load((unsigned*)(F.ctl + CW_CNT) + 64 * e, __ATOMIC_RELAXED, __HIP_MEMORY_SCOPE_AGENT); nb = (c + MOE_ROWS - 1) / MOE_ROWS; }
        int acc = 0;
#pragma unroll
        for (int j = 0; j < 32; ++j) { const int v = __builtin_amdgcn_readlane(nb, j); acc += (j < e) ? v : 0; }
        if (e < 32) { tab[320 + e] = acc * MOE_ROWS; for (int q = 0; q < nb; ++q) tab[1 + acc + q] = e; }
        if (e == 32) tab[0] = acc; }
    __syncthreads();
}
__device__ __forceinline__ void p9_dispatch(Frame& F, const Args& args) {
    const int lane = F.lane;
    unsigned char* ws = F.ws;
    moe_table(F);
    const LAS int* tab = (const LAS int*)(F.lds + MOETAB_OFF);
    LAS int* hist = (LAS int*)(F.lds + HIST_OFF); LAS int* base = hist + 32; LAS int* slots = hist + 64;
    const int* topi = (const int*)(ws + WS_ROUTE + RT_TOPI); const float* topg = (const float*)(ws + WS_ROUTE + RT_TOPG);
    int* pos = (int*)(ws + WS_ROUTE + RT_POS); float* rowgate = (float*)(ws + WS_ROUTE + RT_ROWGATE);
    bf16* XS = (bf16*)(ws + WS_XS); const float* gain = ldarg(I_NORM_FFN);
    for (int grp = F.vcu; grp < MTOK / 64; grp += F.G) {
        const int t_ = opq(F.tid);
        if (t_ < 32) hist[t_] = 0;
        f32x4 v[8][4];
#pragma unroll
        for (int i = 0; i < 8; ++i) { const GAS f32x4* xr = (const GAS f32x4*)(F.out + ((size_t)grp * 64 + F.wave * 8 + i) * D_MODEL) + 2 * lane;
#pragma unroll
            for (int j = 0; j < 4; ++j) v[i][j] = xr[128 * (j >> 1) + (j & 1)]; }
        const GAS f32x4* gr = (const GAS f32x4*)gain + 2 * lane; const f32x4 g00 = gr[0], g01 = gr[1], g10 = gr[128], g11 = gr[129];
        __syncthreads();
        int e = 0, rank = 0;
        if (F.tid < 256) { e = topi[(size_t)grp * 256 + F.tid]; rank = __hip_atomic_fetch_add(hist + e, 1, __ATOMIC_RELAXED, __HIP_MEMORY_SCOPE_WORKGROUP); }
        __syncthreads();
        if (F.tid < 32) { const int h = hist[F.tid]; int b0 = 0; if (h != 0) b0 = (int)__hip_atomic_fetch_add((unsigned*)(F.ctl + CW_CUR) + 64 * F.tid, (unsigned)h, __ATOMIC_RELAXED, __HIP_MEMORY_SCOPE_AGENT); base[F.tid] = tab[320 + F.tid] + b0; }
        __syncthreads();
        if (F.tid < 256) { const int slot = base[e] + rank; pos[(size_t)grp * 256 + F.tid] = slot; rowgate[slot] = topg[(size_t)grp * 256 + F.tid]; slots[F.tid] = slot; }
        __syncthreads();
        {
#pragma unroll
          for (int i = 0; i < 8; ++i) { const int tl = F.wave * 8 + i;
              float s = 0.f;
#pragma unroll
              for (int j = 0; j < 4; ++j) s += (v[i][j].x * v[i][j].x + v[i][j].y * v[i][j].y) + (v[i][j].z * v[i][j].z + v[i][j].w * v[i][j].w);
              const float rstd = 1.0f / sqrtf(wave_sum(s) * (1.f / D_MODEL) + NORM_EPS);
              unsigned long long o[2];
              { const f32x4 a = v[i][0] * rstd * g00, b = v[i][1] * rstd * g01; o[0] = (unsigned long long)pk4_fp8(a.x, a.y, a.z, a.w) | ((unsigned long long)pk4_fp8(b.x, b.y, b.z, b.w) << 32); }
              { const f32x4 a = v[i][2] * rstd * g10, b = v[i][3] * rstd * g11; o[1] = (unsigned long long)pk4_fp8(a.x, a.y, a.z, a.w) | ((unsigned long long)pk4_fp8(b.x, b.y, b.z, b.w) << 32); }
#pragma unroll
              for (int k = 0; k < 4; ++k) { const int sk = slots[tl * 4 + k]; GAS unsigned long long* dst = (GAS unsigned long long*)((unsigned char*)XS + (size_t)sk * D_MODEL) + lane; dst[0] = o[0]; dst[64] = o[1]; } } }
        __syncthreads();
    }
}
__device__ __forceinline__ void p12_combine(Frame& F) {
    const int gw = F.vcu * NWAVES + F.wave, NGW = F.G * NWAVES, lane = F.lane;
    unsigned char* ws = F.ws;
    const int* pos = (const int*)(ws + WS_ROUTE + RT_POS); const bf16* YR = (const bf16*)(ws + WS_YROWS);
    for (int blk = gw; blk < MTOK / 8; blk += NGW) {
        const int m0 = blk * 8;
        int pk = 0; if (lane < 32) pk = pos[(size_t)m0 * 4 + lane];
#pragma unroll
        for (int tp = 0; tp < 4; ++tp) {
            f32x4 a[2][2], b[2][2]; unsigned long long w[2][2][4];
#pragma unroll
            for (int u = 0; u < 2; ++u) { const int t = 2 * tp + u; GAS f32x4* xo = (GAS f32x4*)(F.out + (size_t)(m0 + t) * D_MODEL) + 2 * lane;
#pragma unroll
                for (int hf = 0; hf < 2; ++hf) { a[u][hf] = xo[128 * hf]; b[u][hf] = xo[128 * hf + 1];
#pragma unroll
                    for (int k = 0; k < 4; ++k) { const int sk = __builtin_amdgcn_readlane(pk, 4 * t + k); w[u][hf][k] = *((const GAS unsigned long long*)((const unsigned char*)YR + (size_t)sk * D_MODEL + 512 * hf) + lane); } } }
#pragma unroll
            for (int u = 0; u < 2; ++u) { const int t = 2 * tp + u; GAS f32x4* xo = (GAS f32x4*)(F.out + (size_t)(m0 + t) * D_MODEL) + 2 * lane;
#pragma unroll
                for (int hf = 0; hf < 2; ++hf) { f32x4 aa = a[u][hf], bb = b[u][hf];
#pragma unroll
                    for (int k = 0; k < 4; ++k) { const unsigned lo_ = (unsigned)w[u][hf][k], hi_ = (unsigned)(w[u][hf][k] >> 32);
                        const f32x2 p0 = __builtin_amdgcn_cvt_pk_f32_fp8(lo_, false), p1 = __builtin_amdgcn_cvt_pk_f32_fp8(lo_, true), p2 = __builtin_amdgcn_cvt_pk_f32_fp8(hi_, false), p3 = __builtin_amdgcn_cvt_pk_f32_fp8(hi_, true);
                        aa[0] += p0.x * 0.0625f; aa[1] += p0.y * 0.0625f; aa[2] += p1.x * 0.0625f; aa[3] += p1.y * 0.0625f; bb[0] += p2.x * 0.0625f; bb[1] += p2.y * 0.0625f; bb[2] += p3.x * 0.0625f; bb[3] += p3.y * 0.0625f; }
                    xo[128 * hf] = aa; xo[128 * hf + 1] = bb; } }
        }
    }
}

constexpr int N_ATT_A = 768, N_ATT_C = 256;
__device__ __forceinline__ swa::BlockRef attn_item(unsigned char* ws, int it) {
    swa::BlockRef r;
    const swa::bf16* Z = (const swa::bf16*)(ws + WS_Z);
    if (it < N_ATT_A) {
        const int h = it & 3, b = (it >> 2) & 1, v = it >> 3;
        int g, rr, qb;
        if (v < 32) { g = 0; rr = 0; qb = v; } else if (v < 64) { g = 1; rr = (v - 32) >> 3; qb = (v - 32) & 7; } else { g = 2; rr = (v - 64) >> 1; qb = (v - 64) & 1; }
        const int d = (g == 0) ? 1 : (g == 1) ? 4 : 16;
        const size_t row0 = (size_t)b * SEQ + rr, qrow = row0 + (size_t)d * qb * 256;
        r.Q = Z + qrow * IN_COLS + OFF_AQ + g * 512 + h * 128; r.K = Z + row0 * IN_COLS + OFF_AK + g * 512 + h * 128; r.V = Z + row0 * IN_COLS + OFF_AV + g * 512 + h * 128;
        r.O = (swa::bf16*)(ws + WS_OP) + (size_t)g * MTOK * 512 + qrow * 512 + h * 128; r.LSE = (float*)(ws + WS_LSE) + (size_t)g * MTOK * 4 + qrow * 4 + h;
        r.QS = d * IN_COLS; r.KS = d * IN_COLS; r.OS = d * 512; r.LS = d * 4; r.P0 = qb * 256; r.skv = SEQ / d; r.W = 129;
    } else {
        const int u = it - N_ATT_A, h = u & 3, b = (u >> 2) & 1, qb = u >> 3;
        const size_t qrow = (size_t)b * SEQ + (size_t)qb * 256;
        const swa::bf16* KV = (const swa::bf16*)(ws + WS_KVM) + (size_t)b * MEM_LEN * 1024 + h * 128;
        r.Q = Z + qrow * IN_COLS + OFF_CQ + h * 128; r.K = KV; r.V = KV + 512;
        r.O = (swa::bf16*)(ws + WS_YABC) + qrow * 1536 + 1024 + h * 128; r.LSE = nullptr;
        r.QS = IN_COLS; r.KS = 1024; r.OS = 1536; r.LS = 0; r.P0 = 256; r.skv = MEM_LEN; r.W = 1 << 20;
    }
    return r;
}
__device__ __forceinline__ void p3_attention_mfma(unsigned char* ws, char* lds, int G) {
    const int total = N_ATT_A + N_ATT_C; int L = blockIdx.x; if (L >= total) return;
    swa::BlockRef cur = attn_item(ws, L); swa::Seam S;
    swa::swa_prime(cur, lds, S);
    for (;;) {
        const int Ln = L + G; const bool last = Ln >= total;
        const swa::BlockRef nxt = last ? cur : attn_item(ws, Ln);
        swa::swa_block(cur, nxt, lds, S);
        if (last) break;
        cur = nxt; L = Ln;
    }
}

constexpr int N_RITEMS = BATCH * 8 * (SEQ / 64);
constexpr size_t WS_PHI = WS_XN;
constexpr size_t WS_PSI = WS_XN + 16 * MiB;
constexpr size_t WS_GAM = WS_YS;
constexpr size_t WS_OM = WS_XN2;
constexpr size_t WS_XFR = WS_MRG + 48 * MiB;
constexpr size_t WS_BONUS = WS_MRGB + 1 * MiB;
constexpr int RB = 9216, RLD = 72;
constexpr int R1_SEG = 15 * RB, R1_WC = R1_SEG + 2048;
static_assert(R1_WC + 256 <= LDSCTL_OFF, "R1 LDS map");
typedef LAS unsigned short* lbf_t;
__device__ __forceinline__ f32x4 r1_tile(const LAS unsigned short* X, const LAS unsigned short* Yt, int mi, int ni, f32x4 acc, int fr, int fq) {
    const LAS unsigned short* xp = X + (16 * mi + fr) * RLD + 8 * fq; const LAS unsigned short* yp = Yt + (16 * ni + fr) * RLD + 8 * fq;
    const bf16x8 a0 = *(const LAS bf16x8*)xp, a1 = *(const LAS bf16x8*)(xp + 32), b0 = *(const LAS bf16x8*)yp, b1 = *(const LAS bf16x8*)(yp + 32);
    acc = __builtin_amdgcn_mfma_f32_16x16x32_bf16(b0, a0, acc, 0, 0, 0);
    acc = __builtin_amdgcn_mfma_f32_16x16x32_bf16(b1, a1, acc, 0, 0, 0);
    return acc;
}
__device__ __forceinline__ void r1_store(LAS unsigned short* dst, int mi, int ni, f32x4 acc, int mode, bool addI, const LAS unsigned short* addT, int fr, int fq) {
    const int m = 16 * mi + fr, n0 = 16 * ni + 4 * fq;
#pragma unroll
    for (int r = 0; r < 4; ++r) { const int n = n0 + r; bool keep = true;
        if (mode == 1) keep = n < m; else if (mode == 2) keep = n <= m; else if (mode == 3) keep = m < n;
        float v = keep ? acc[r] : 0.f; if (addI && m == n) v += 1.0f; acc[r] = v; }
    if (addT != nullptr) { const unsigned long long w = *(const LAS unsigned long long*)(addT + m * RLD + n0);
        acc[0] += bf_lo((unsigned)w); acc[1] += bf_hi((unsigned)w); acc[2] += bf_lo((unsigned)(w >> 32)); acc[3] += bf_hi((unsigned)(w >> 32)); }
    *(LAS unsigned long long*)(dst + m * RLD + n0) = (unsigned long long)pk2(acc[0], acc[1]) | ((unsigned long long)pk2(acc[2], acc[3]) << 32);
}
#define R1BUF(i) ((LAS unsigned short*)(F.lds + (i) * RB))
template <int MODE> __device__ __forceinline__ void p_r1(Frame& F, const Args& args) {
    unsigned char* ws = F.ws; const int lane0 = F.lane, wave = F.wave;
    const bf16* Z = (const bf16*)(ws + WS_Z);
    const float* rkp = ldarg(I_R_RK); const float* mu = ldarg(I_R_MU); const float* w0p = ldarg(I_R_W0); const float* a0p = ldarg(I_R_A0); const float* kkp = ldarg(I_R_KK); const float* kap = ldarg(I_R_KA);
    const float* w1src = ldarg(I_EXP_W1);
    const bf16* W2T = (const bf16*)(ws + WS_LORA); const bf16* A2T = W2T + 512 * 64; const bf16* G2T = A2T + 512 * 64;
    bf16* VM = (bf16*)(ws + WS_VMIX); bf16* GM = (bf16*)(ws + WS_GMIX);
    LAS float* segsum = (LAS float*)(F.lds + R1_SEG); LAS float* wcs = (LAS float*)(F.lds + R1_WC);
    unsigned short zv[7][9];
#define R1LOAD(it_) do { const int bh_ = (it_) >> 7, c_ = (it_) & 127, h_ = bh_ & 7, t0_ = c_ * 64 + 8 * wave; \
        const bf16* zp_ = Z + ((size_t)(bh_ >> 3) * SEQ + t0_) * IN_COLS + OFF_R + lane; \
        _Pragma("unroll") for (int i = 0; i < 9; ++i) { const bool ok_ = (i > 0) || (t0_ > 0); const bf16* rp_ = zp_ + ((long)i - 1) * IN_COLS; const bf16* rq_ = rp_ + 64 * h_;     \
            zv[0][i] = ok_ ? rp_[1536] : (unsigned short)0; zv[1][i] = ok_ ? rp_[1600] : (unsigned short)0; zv[2][i] = ok_ ? rp_[1664] : (unsigned short)0; zv[3][i] = ok_ ? rp_[1728] : (unsigned short)0; \
            zv[4][i] = ok_ ? rq_[0] : (unsigned short)0; zv[5][i] = ok_ ? rq_[512] : (unsigned short)0; zv[6][i] = ok_ ? rq_[1024] : (unsigned short)0; } } while (0)
#define ZF(x) __builtin_bit_cast(float, (unsigned)(x) << 16)
    { const int lane = lane0; if (F.vcu < N_RITEMS) R1LOAD(F.vcu); }
    for (int item = F.vcu; item < N_RITEMS; item += F.G) {
        const int lane = opq(lane0), fr = lane & 15, fq = lane >> 4;
        const int bh = item >> 7, c = item & 127, b = bh >> 3, h = bh & 7;
        const size_t row0 = (size_t)b * SEQ + (size_t)c * 64;
        f32x4 tcv[16]; const float* tcW; unsigned char* tcWT; int tck0, tcn0, tcrb;
        w1_tile(item * 8 + wave, w1src, ws + WS_W1, tcW, tcWT, tck0, tcn0, tcrb); tc8_load(tcW, 2048, tck0, tcn0, lane, tcv);
        const f32x4 zero4 = (f32x4){0.f, 0.f, 0.f, 0.f};
        const int mw = wave >> 2, nw = wave & 3;
        float r[8], lw[8], kx[8], vx[8], ax[8], bx[8];
        { const int k = lane, tq = wave, ch = h * 64 + k;
#pragma unroll
          for (int g = 0; g < 4; ++g) { const float mug = mu[1536 + 64 * g + k];
#pragma unroll
              for (int i = 0; i < 8; ++i) { const float cur = ZF(zv[g][i + 1]), prv = ZF(zv[g][i]); float x = cur + (prv - cur) * mug;
                  x = (g == 0) ? fast_tanh(x) : (g == 1) ? x : fast_sigm(x); const unsigned short xb = (unsigned short)f2bf(x); const int t = 8 * tq + i;
                  if (g == 0) R1BUF(11)[t * RLD + k] = xb; else if (g == 1) R1BUF(12)[t * RLD + k] = xb; else R1BUF(13)[t * 136 + 64 * (g - 2) + k] = xb; } }
          { const int tid_ = wave * 64 + lane, row = tid_ >> 3, chk = tid_ & 7;
            *(LAS v4u*)(R1BUF(5) + row * RLD + chk * 8) = *(const GAS v4u*)(W2T + (size_t)(64 * h + row) * 64 + chk * 8);
            *(LAS v4u*)(R1BUF(6) + row * RLD + chk * 8) = *(const GAS v4u*)(A2T + (size_t)(64 * h + row) * 64 + chk * 8);
#pragma unroll
            for (int hh = 0; hh < 2; ++hh) { const int rg = (tid_ >> 4) + 32 * hh, cg = tid_ & 15;
                *(LAS v4u*)(R1BUF(7) + rg * 136 + cg * 8) = *(const GAS v4u*)(G2T + (size_t)(64 * h + rg) * 128 + cg * 8); } }
          __syncthreads();
          { f32x4 dw0, dw1, da0, da1, dg0 = zero4, dg1 = zero4;
            { const LAS unsigned short* yp_ = R1BUF(5) + (16 * nw + fr) * RLD + 8 * fq; const LAS unsigned short* xp_ = R1BUF(11) + (16 * mw + fr) * RLD + 8 * fq;
              const bf16x8 y0_ = *(const LAS bf16x8*)yp_, y1_ = *(const LAS bf16x8*)(yp_ + 32), xa0_ = *(const LAS bf16x8*)xp_, xa1_ = *(const LAS bf16x8*)(xp_ + 32), xb0_ = *(const LAS bf16x8*)(xp_ + 32 * RLD), xb1_ = *(const LAS bf16x8*)(xp_ + 32 * RLD + 32);
              dw0 = __builtin_amdgcn_mfma_f32_16x16x32_bf16(y0_, xa0_, zero4, 0, 0, 0); dw1 = __builtin_amdgcn_mfma_f32_16x16x32_bf16(y0_, xb0_, zero4, 0, 0, 0);
              dw0 = __builtin_amdgcn_mfma_f32_16x16x32_bf16(y1_, xa1_, dw0, 0, 0, 0); dw1 = __builtin_amdgcn_mfma_f32_16x16x32_bf16(y1_, xb1_, dw1, 0, 0, 0); }
            { const LAS unsigned short* yp_ = R1BUF(6) + (16 * nw + fr) * RLD + 8 * fq; const LAS unsigned short* xp_ = R1BUF(12) + (16 * mw + fr) * RLD + 8 * fq;
              const bf16x8 y0_ = *(const LAS bf16x8*)yp_, y1_ = *(const LAS bf16x8*)(yp_ + 32), xa0_ = *(const LAS bf16x8*)xp_, xa1_ = *(const LAS bf16x8*)(xp_ + 32), xb0_ = *(const LAS bf16x8*)(xp_ + 32 * RLD), xb1_ = *(const LAS bf16x8*)(xp_ + 32 * RLD + 32);
              da0 = __builtin_amdgcn_mfma_f32_16x16x32_bf16(y0_, xa0_, zero4, 0, 0, 0); da1 = __builtin_amdgcn_mfma_f32_16x16x32_bf16(y0_, xb0_, zero4, 0, 0, 0);
              da0 = __builtin_amdgcn_mfma_f32_16x16x32_bf16(y1_, xa1_, da0, 0, 0, 0); da1 = __builtin_amdgcn_mfma_f32_16x16x32_bf16(y1_, xb1_, da1, 0, 0, 0); }
            { const LAS unsigned short* yp_ = R1BUF(7) + (16 * nw + fr) * 136 + 8 * fq; const LAS unsigned short* xp_ = R1BUF(13) + (16 * mw + fr) * 136 + 8 * fq;
#pragma unroll
              for (int kk = 0; kk < 4; ++kk) { const bf16x8 y_ = *(const LAS bf16x8*)(yp_ + 32 * kk), xa_ = *(const LAS bf16x8*)(xp_ + 32 * kk), xb_ = *(const LAS bf16x8*)(xp_ + 32 * 136 + 32 * kk);
                  dg0 = __builtin_amdgcn_mfma_f32_16x16x32_bf16(y_, xa_, dg0, 0, 0, 0); dg1 = __builtin_amdgcn_mfma_f32_16x16x32_bf16(y_, xb_, dg1, 0, 0, 0); } }
            const int o0 = (16 * mw + fr) * 68 + 16 * nw + 4 * fq, o1 = o0 + 32 * 68;
            *(LAS f32x4*)((LAS float*)R1BUF(0) + o0) = dw0; *(LAS f32x4*)((LAS float*)R1BUF(0) + o1) = dw1;
            *(LAS f32x4*)((LAS float*)R1BUF(2) + o0) = da0; *(LAS f32x4*)((LAS float*)R1BUF(2) + o1) = da1;
            *(LAS f32x4*)((LAS float*)R1BUF(9) + o0) = dg0; *(LAS f32x4*)((LAS float*)R1BUF(9) + o1) = dg1; }
          __syncthreads();
          { const float w0c = w0p[ch], a0c = a0p[ch], kkc = kkp[ch], kac = kap[ch], mur = mu[ch], muk = mu[512 + ch], muv = mu[1024 + ch];
#pragma unroll
            for (int i = 0; i < 8; ++i) { const int t = 8 * tq + i;
                const float dwv = ((const LAS float*)R1BUF(0))[t * 68 + k], dav = ((const LAS float*)R1BUF(2))[t * 68 + k], dgv = ((const LAS float*)R1BUF(9))[t * 68 + k];
                const float cr = ZF(zv[4][i + 1]), pr = ZF(zv[4][i]), ck = ZF(zv[5][i + 1]), pk = ZF(zv[5][i]), cv = ZF(zv[6][i + 1]), pv = ZF(zv[6][i]);
                const float rr = cr + (pr - cr) * mur, kr = ck + (pk - ck) * muk, vr = cv + (pv - cv) * muv;
                const float y = -(w0c + dwv); const float sp = fast_softplus(y);
                lw[i] = -__expf(-sp - 0.5f);
                const float av = fast_sigm(a0c + dav);
                const float kkv = kr * kkc; const float ssq = wave_sum(kkv * kkv); const float kkn = kkv * __builtin_amdgcn_rsqf(fmaxf(ssq, 1e-24f));
                r[i] = rr; vx[i] = vr; kx[i] = kr * (1.0f + (av - 1.0f) * kac); ax[i] = -kkn; bx[i] = kkn * av;
                if (MODE == 0) { VM[(row0 + t) * RW + ch] = (bf16)f2bf(vr); GM[(row0 + t) * RW + ch] = (bf16)f2bf(dgv); } } }
        }
        if (item + F.G < N_RITEMS) R1LOAD(item + F.G);
        { const int k = lane, tq = wave;
          float cs[8]; cs[0] = lw[0];
#pragma unroll
          for (int i = 1; i < 8; ++i) cs[i] = cs[i - 1] + lw[i];
          segsum[tq * 64 + k] = cs[7];
          const float rk = rkp[h * 64 + k];
#pragma unroll
          for (int i = 0; i < 8; ++i) { const float bs = wave_sum(r[i] * kx[i] * rk); if (MODE == 0 && lane == 0) *(GAS float*)((float*)(ws + WS_BONUS) + (row0 + 8 * tq + i) * 8 + h) = bs; }
          __syncthreads();
          float pre = 0.f;
#pragma unroll
          for (int q = 0; q < 7; ++q) { const float sv = segsum[q * 64 + k]; pre += (q < tq) ? sv : 0.f; }
          unsigned short at[8], rt[8], bt[8], kt[8], vt[8];
#pragma unroll
          for (int i = 0; i < 8; ++i) { const float L = pre + cs[i], Lp = L - lw[i]; const float e = __expf(L), ep = __expf(Lp), ei = __expf(-L);
              at[i] = (unsigned short)f2bf(ax[i] * ep); rt[i] = (unsigned short)f2bf(r[i] * e); bt[i] = (unsigned short)f2bf(bx[i] * ei); kt[i] = (unsigned short)f2bf(kx[i] * ei); vt[i] = (unsigned short)f2bf(vx[i]);
              if (i == 7 && tq == 7) wcs[k] = e; }
#pragma unroll
          for (int i = 0; i < 8; ++i) { const int o = (8 * tq + i) * RLD + k; R1BUF(8)[o] = at[i]; R1BUF(4)[o] = rt[i]; R1BUF(9)[o] = bt[i]; R1BUF(10)[o] = kt[i]; }
          const int ot = k * RLD + 8 * tq;
#define PK8(x) ((v4u){(unsigned)x[0] | ((unsigned)x[1] << 16), (unsigned)x[2] | ((unsigned)x[3] << 16), (unsigned)x[4] | ((unsigned)x[5] << 16), (unsigned)x[6] | ((unsigned)x[7] << 16)})
          *(LAS v4u*)(R1BUF(0) + ot) = PK8(at); *(LAS v4u*)(R1BUF(1) + ot) = PK8(bt); *(LAS v4u*)(R1BUF(2) + ot) = PK8(kt); *(LAS v4u*)(R1BUF(3) + ot) = PK8(vt);
#undef PK8
        }
        __syncthreads();
#define R1PAIR(X, Y, a0, a1) do { const LAS unsigned short* yp_ = (Y) + (16 * nw + fr) * RLD + 8 * fq; const LAS unsigned short* xp_ = (X) + (16 * mw + fr) * RLD + 8 * fq; \
            const bf16x8 y0_ = *(const LAS bf16x8*)yp_, y1_ = *(const LAS bf16x8*)(yp_ + 32), xa0_ = *(const LAS bf16x8*)xp_, xa1_ = *(const LAS bf16x8*)(xp_ + 32), xb0_ = *(const LAS bf16x8*)(xp_ + 32 * RLD), xb1_ = *(const LAS bf16x8*)(xp_ + 32 * RLD + 32); \
            a0 = __builtin_amdgcn_mfma_f32_16x16x32_bf16(y0_, xa0_, zero4, 0, 0, 0); a1 = __builtin_amdgcn_mfma_f32_16x16x32_bf16(y0_, xb0_, zero4, 0, 0, 0); \
            a0 = __builtin_amdgcn_mfma_f32_16x16x32_bf16(y1_, xa1_, a0, 0, 0, 0); a1 = __builtin_amdgcn_mfma_f32_16x16x32_bf16(y1_, xb1_, a1, 0, 0, 0); } while (0)
#define R1ST2(dst, a0, a1, mode, addI, addT) do { r1_store(dst, mw, nw, a0, mode, addI, addT, fr, fq); r1_store(dst, mw + 2, nw, a1, mode, addI, addT, fr, fq); } while (0)
        { f32x4 n0, n1, t0, t1, l0, l1, b0, b1, k0, k1;
          R1PAIR(R1BUF(8), R1BUF(9), n0, n1); R1PAIR(R1BUF(9), R1BUF(8), t0, t1); R1PAIR(R1BUF(8), R1BUF(10), l0, l1); R1PAIR(R1BUF(4), R1BUF(9), b0, b1); R1PAIR(R1BUF(4), R1BUF(10), k0, k1);
          R1ST2(R1BUF(11), n0, n1, 1, false, nullptr); R1ST2(R1BUF(13), n0, n1, 1, true, nullptr); R1ST2(R1BUF(12), t0, t1, 3, false, nullptr);
          R1ST2(R1BUF(5), l0, l1, 1, false, nullptr); R1ST2(R1BUF(6), b0, b1, 2, false, nullptr); R1ST2(R1BUF(7), k0, k1, 2, false, nullptr); }
        __syncthreads();
        { f32x4 n0, n1, t0, t1, e0, e1;
          R1PAIR(R1BUF(11), R1BUF(12), n0, n1); R1PAIR(R1BUF(12), R1BUF(11), t0, t1); R1PAIR(R1BUF(3), R1BUF(5), e0, e1);
          R1ST2(R1BUF(8), n0, n1, 0, false, nullptr); R1ST2(R1BUF(9), t0, t1, 0, false, nullptr); R1ST2(R1BUF(10), e0, e1, 0, false, nullptr); }
        __syncthreads();
#pragma unroll 1
        for (int lv = 0; lv < 5; ++lv) {
            const bool srcB = (lv & 1) == 0;
            LAS unsigned short* sN = srcB ? R1BUF(8) : R1BUF(11); LAS unsigned short* sNT = srcB ? R1BUF(9) : R1BUF(12);
            LAS unsigned short* dN = srcB ? R1BUF(11) : R1BUF(8); LAS unsigned short* dNT = srcB ? R1BUF(12) : R1BUF(9);
            LAS unsigned short* Tc = (lv & 1) ? R1BUF(14) : R1BUF(13); LAS unsigned short* Tn = (lv & 1) ? R1BUF(13) : R1BUF(14);
            f32x4 u0, u1, t0 = zero4, t1 = zero4, n0 = zero4, n1 = zero4;
            R1PAIR(Tc, sNT, u0, u1);
            if (lv < 4) R1PAIR(sNT, sN, t0, t1);
            if (lv < 3) R1PAIR(sN, sNT, n0, n1);
            R1ST2(Tn, u0, u1, 0, false, Tc);
            if (lv < 4) R1ST2(dNT, t0, t1, 0, false, nullptr);
            if (lv < 3) R1ST2(dN, n0, n1, 0, false, nullptr);
            __syncthreads();
        }
        { f32x4 g0, g1, q0, q1;
          R1PAIR(R1BUF(0), R1BUF(14), g0, g1); R1PAIR(R1BUF(10), R1BUF(14), q0, q1);
          R1ST2(R1BUF(11), g0, g1, 0, false, nullptr); R1ST2(R1BUF(12), q0, q1, 0, false, nullptr); }
        __syncthreads();
#undef R1PAIR
#undef R1ST2
        { const int mi = wave >> 1, ks = wave & 1;
          const f32x4 p0 = r1_tile(R1BUF(1), R1BUF(11), mi, 2 * ks, zero4, fr, fq), p1 = r1_tile(R1BUF(1), R1BUF(11), mi, 2 * ks + 1, zero4, fr, fq);
          const f32x4 s0 = r1_tile(R1BUF(6), R1BUF(11), mi, 2 * ks, zero4, fr, fq), s1 = r1_tile(R1BUF(6), R1BUF(11), mi, 2 * ks + 1, zero4, fr, fq);
          const int m = 16 * mi + fr; const float wc = wcs[m];
          float ph[8], ps[8];
#pragma unroll
          for (int r = 0; r < 4; ++r) { const int n0 = 32 * ks + 4 * fq + r, n1 = n0 + 16;
              ph[r] = (p0[r] + (m == n0 ? 1.f : 0.f)) * wc; ph[4 + r] = (p1[r] + (m == n1 ? 1.f : 0.f)) * wc; }
          { const unsigned long long w0 = *(const LAS unsigned long long*)(R1BUF(4) + m * RLD + 32 * ks + 4 * fq), w1 = *(const LAS unsigned long long*)(R1BUF(4) + m * RLD + 32 * ks + 16 + 4 * fq);
            ps[0] = s0[0] + bf_lo((unsigned)w0); ps[1] = s0[1] + bf_hi((unsigned)w0); ps[2] = s0[2] + bf_lo((unsigned)(w0 >> 32)); ps[3] = s0[3] + bf_hi((unsigned)(w0 >> 32));
            ps[4] = s1[0] + bf_lo((unsigned)w1); ps[5] = s1[1] + bf_hi((unsigned)w1); ps[6] = s1[2] + bf_lo((unsigned)(w1 >> 32)); ps[7] = s1[3] + bf_hi((unsigned)(w1 >> 32)); }
          const size_t fo = (((size_t)item * 4 + mi) * 2 + ks) * 64 + lane;
          if (MODE == 0) *((GAS v4u*)(ws + WS_PHI) + fo) = (v4u){pk2(ph[0], ph[1]), pk2(ph[2], ph[3]), pk2(ph[4], ph[5]), pk2(ph[6], ph[7])};
          if (MODE == 0) *((GAS v4u*)(ws + WS_PSI) + fo) = (v4u){pk2(ps[0], ps[1]), pk2(ps[2], ps[3]), pk2(ps[4], ps[5]), pk2(ps[6], ps[7])};
          const int vb = wave >> 1;
#pragma unroll
          for (int hh = 0; hh < 2; ++hh) { const int mt = 2 * (wave & 1) + hh;
              f32x4 ga = r1_tile(R1BUF(12), R1BUF(1), vb, mt, zero4, fr, fq); ga = r1_tile(R1BUF(3), R1BUF(2), vb, mt, ga, fr, fq);
              f32x4 om = r1_tile(R1BUF(12), R1BUF(6), vb, mt, zero4, fr, fq); om = r1_tile(R1BUF(3), R1BUF(7), vb, mt, om, fr, fq);
#pragma unroll
              for (int r = 0; r < 4; ++r) ga[r] *= wcs[16 * mt + 4 * fq + r];
              const size_t ao = (((size_t)item * 4 + vb) * 4 + mt) * 64 + lane;
              if (MODE == 0) { *((GAS unsigned long long*)(ws + WS_GAM) + ao) = (unsigned long long)pk2(ga[0], ga[1]) | ((unsigned long long)pk2(ga[2], ga[3]) << 32); *((GAS f32x4*)(ws + WS_OM) + ao) = om; } else { asm volatile("" :: "v"(ga), "v"(om)); } }
        }
        tc8_store(tcWT, 1024, tck0, tcrb, lane, tcv, W8_SCALE);
        __syncthreads();
    }
}
#undef R1BUF
#undef R1LOAD
#undef ZF
constexpr bool R2_HELPER = false;
struct R2Buf { bf16x8 ph[4][2]; unsigned long long ga[4]; };
__device__ __forceinline__ void r2_load(R2Buf& B, const unsigned char* ws, int item, int vb, int lane) {
#pragma unroll
    for (int mt = 0; mt < 4; ++mt) {
#pragma unroll
        for (int ks = 0; ks < 2; ++ks) B.ph[mt][ks] = *((const GAS bf16x8*)(ws + WS_PHI) + (((size_t)item * 4 + mt) * 2 + ks) * 64 + lane);
        B.ga[mt] = *((const GAS unsigned long long*)(ws + WS_GAM) + (((size_t)item * 4 + vb) * 4 + mt) * 64 + lane); }
}
__device__ __forceinline__ void r2_step(const R2Buf& B, f32x4 (&acc)[4], unsigned char* ws, int item, int vb, int lane) {
    v4u x0, x1;
    x0.x = pk2(acc[0][0], acc[0][1]); x0.y = pk2(acc[0][2], acc[0][3]); x0.z = pk2(acc[1][0], acc[1][1]); x0.w = pk2(acc[1][2], acc[1][3]);
    x1.x = pk2(acc[2][0], acc[2][1]); x1.y = pk2(acc[2][2], acc[2][3]); x1.z = pk2(acc[3][0], acc[3][1]); x1.w = pk2(acc[3][2], acc[3][3]);
    GAS v4u* xo = (GAS v4u*)(ws + WS_XFR) + (((size_t)item * 4 + vb) * 2) * 64 + lane; xo[0] = x0; xo[64] = x1;
    const bf16x8 f0 = __builtin_bit_cast(bf16x8, x0), f1 = __builtin_bit_cast(bf16x8, x1);
#pragma unroll
    for (int mt = 0; mt < 4; ++mt) { const unsigned g0 = (unsigned)B.ga[mt], g1 = (unsigned)(B.ga[mt] >> 32);
        f32x4 a; a[0] = __builtin_bit_cast(float, g0 << 16); a[1] = __builtin_bit_cast(float, g0 & 0xffff0000u); a[2] = __builtin_bit_cast(float, g1 << 16); a[3] = __builtin_bit_cast(float, g1 & 0xffff0000u);
        a = __builtin_amdgcn_mfma_f32_16x16x32_bf16(B.ph[mt][0], f0, a, 0, 0, 0);
        a = __builtin_amdgcn_mfma_f32_16x16x32_bf16(B.ph[mt][1], f1, a, 0, 0, 0);
        acc[mt] = a; }
}
__device__ __forceinline__ void p_r2(Frame& F) {
    if (blockIdx.x < BATCH * 8 * 4 && F.wave == 0) {
        unsigned char* ws = F.ws; const int bh = blockIdx.x >> 2, vb = blockIdx.x & 3, lane = F.lane;
        f32x4 acc[4];
#pragma unroll
        for (int i = 0; i < 4; ++i) acc[i] = (f32x4){0.f, 0.f, 0.f, 0.f};
        R2Buf A, B, C, D, E;
        const int it0 = bh * 128;
        r2_load(A, ws, it0, vb, lane); r2_load(B, ws, it0 + 1, vb, lane); r2_load(C, ws, it0 + 2, vb, lane); r2_load(D, ws, it0 + 3, vb, lane);
#define R2SB() __builtin_amdgcn_sched_barrier(0)
#define R2IT(c_) (it0 + ((c_) < 128 ? (c_) : 127))
#pragma unroll
        for (int c = 0; c < 125; c += 5) {
            r2_load(E, ws, R2IT(c + 4), vb, lane); R2SB(); r2_step(A, acc, ws, it0 + c, vb, lane); R2SB();
            r2_load(A, ws, R2IT(c + 5), vb, lane); R2SB(); r2_step(B, acc, ws, it0 + c + 1, vb, lane); R2SB();
            r2_load(B, ws, R2IT(c + 6), vb, lane); R2SB(); r2_step(C, acc, ws, it0 + c + 2, vb, lane); R2SB();
            r2_load(C, ws, R2IT(c + 7), vb, lane); R2SB(); r2_step(D, acc, ws, it0 + c + 3, vb, lane); R2SB();
            r2_load(D, ws, R2IT(c + 8), vb, lane); R2SB(); r2_step(E, acc, ws, it0 + c + 4, vb, lane); R2SB();
        }
        r2_step(A, acc, ws, it0 + 125, vb, lane); R2SB(); r2_step(B, acc, ws, it0 + 126, vb, lane); R2SB(); r2_step(C, acc, ws, it0 + 127, vb, lane);
#undef R2IT
#undef R2SB
    }
}
__device__ __forceinline__ void p_r3(Frame& F, const Args& args) {
    const int gw = F.vcu * NWAVES + F.wave, NGW = F.G * NWAVES, lane = F.lane, cc = lane & 15, q = lane >> 4;
    unsigned char* ws = F.ws;
    const bf16* VM = (const bf16*)(ws + WS_VMIX); const bf16* GM = (const bf16*)(ws + WS_GMIX);
    const float* bonus = (const float*)(ws + WS_BONUS);
    bf16* YB = (bf16*)(ws + WS_YABC) + 512;
    const float* lnw = ldarg(I_R_LNW); const float* lnb = ldarg(I_R_LNB);
#pragma unroll 2
    for (int wi = gw; wi < N_RITEMS * 4; wi += NGW) {
        const int item = wi >> 2, tt = wi & 3, bh = item >> 7, c = item & 127, b = bh >> 3, h = bh & 7;
        const bf16x8 ps0 = *((const GAS bf16x8*)(ws + WS_PSI) + (((size_t)item * 4 + tt) * 2 + 0) * 64 + lane), ps1 = *((const GAS bf16x8*)(ws + WS_PSI) + (((size_t)item * 4 + tt) * 2 + 1) * 64 + lane);
        f32x4 acc[4];
#pragma unroll
        for (int vb = 0; vb < 4; ++vb) {
            const bf16x8 x0 = *((const GAS bf16x8*)(ws + WS_XFR) + (((size_t)item * 4 + vb) * 2 + 0) * 64 + lane), x1 = *((const GAS bf16x8*)(ws + WS_XFR) + (((size_t)item * 4 + vb) * 2 + 1) * 64 + lane);
            f32x4 a = *((const GAS f32x4*)(ws + WS_OM) + (((size_t)item * 4 + vb) * 4 + tt) * 64 + lane);
            a = __builtin_amdgcn_mfma_f32_16x16x32_bf16(ps0, x0, a, 0, 0, 0);
            a = __builtin_amdgcn_mfma_f32_16x16x32_bf16(ps1, x1, a, 0, 0, 0);
            acc[vb] = a; }
        const size_t rowb = (size_t)b * SEQ + (size_t)c * 64 + 16 * tt + 4 * q;
        unsigned short vmr[4][4], gmr[4][4]; float bnr[4], lw4[4], lb4[4];
#pragma unroll
        for (int vb = 0; vb < 4; ++vb) { const int ch = h * 64 + 16 * vb + cc; lw4[vb] = lnw[ch]; lb4[vb] = lnb[ch]; }
#pragma unroll
        for (int r = 0; r < 4; ++r) { const size_t t = rowb + r; bnr[r] = bonus[t * 8 + h];
#pragma unroll
            for (int vb = 0; vb < 4; ++vb) { const int ch = h * 64 + 16 * vb + cc; vmr[r][vb] = VM[t * RW + ch]; gmr[r][vb] = GM[t * RW + ch]; } }
#pragma unroll
        for (int r = 0; r < 4; ++r) { const size_t t = rowb + r;
            const float s = (acc[0][r] + acc[1][r]) + (acc[2][r] + acc[3][r]);
            const float mean = row16_sum(s) * (1.f / 64.f);
            const float d0 = acc[0][r] - mean, d1 = acc[1][r] - mean, d2 = acc[2][r] - mean, d3 = acc[3][r] - mean;
            const float var = row16_sum((d0 * d0 + d1 * d1) + (d2 * d2 + d3 * d3)) * (1.f / 64.f);
            const float rstd = __builtin_amdgcn_rsqf(var + R_GN_EPS);
            const float bn = bnr[r];
#pragma unroll
            for (int vb = 0; vb < 4; ++vb) { const int ch = h * 64 + 16 * vb + cc; const float d = (vb == 0) ? d0 : (vb == 1) ? d1 : (vb == 2) ? d2 : d3;
                const float yn = d * rstd * lw4[vb] + lb4[vb];
                const float vv = __builtin_bit_cast(float, (unsigned)vmr[r][vb] << 16), gg = __builtin_bit_cast(float, (unsigned)gmr[r][vb] << 16);
                YB[t * 1536 + ch] = (bf16)f2bf((yn + bn * vv) * gg); } }
    }
}

__global__ void __launch_bounds__(NWAVES * 64, 2) skel_fwd(Args args) {
    extern __shared__ __attribute__((aligned(16))) unsigned char lds[];
    Frame F;
    F.lds = (LAS unsigned char*)lds;
    F.MISC = (volatile LAS unsigned*)(F.lds + MISC_OFF);
    phase_enter(F, true);
    F.G = gridDim.x; { const int bx = blockIdx.x; F.vcu = (F.G % 8 == 0) ? (bx % 8) * (F.G / 8) + bx / 8 : bx; }
    unsigned char* ws = args.ws; F.ws = ws; F.out = args.out;
    F.ctl = (gu32*)(ws + WS_CTL);
    for (int u = F.tid; u < (LDS_BYTES - LDSCTL_OFF) / 4; u += NWAVES * 64) ((LAS unsigned*)(F.lds + LDSCTL_OFF))[u] = 0u;
    __syncthreads();
    XcdBarrier bar; bar.bar = (unsigned*)(F.ctl + CW_BAR); bar.x = 0; bar.st = nullptr;
    if (args.use_bar) bar = xcd_barrier_post((unsigned*)(F.ctl + CW_BAR), F.MISC + 8);
    const int lo = args.ph_lo, hi = args.ph_hi;
#define IN(k) (phase_enter(F, lo <= (k) && (k) < hi))
#define SEAM(k) do { if (lo <= (k) && (k) + 1 < hi) xcd_barrier(bar); } while (0)
    const pg8::bf16_t* wsb = (const pg8::bf16_t*)ws;
#define BF(off) ((pg8::bf16_t*)(ws + (off)))

    if (IN(0)) { p0_prologue<0>(F, args, F.vcu * NWAVES + F.wave, F.G * NWAVES); if (F.G <= 64) p0_prologue<1>(F, args, F.vcu * NWAVES + F.wave, F.G * NWAVES); } SEAM(0);
    if (IN(1)) {
        const float* ckg_ = ldarg(I_CK_GAIN);
        pg8::EpiZ E{BF(WS_Z), ldarg(I_B_GATE), ldarg(I_AQ_GAIN), ldarg(I_AK_GAIN), ldarg(I_CQ_GAIN), (const float*)(ws + WS_CS), BF(WS_KVM), ckg_, (PG8_LAS float*)(F.lds + 131072)};
        { pg8::Gemm g{BF(WS_XN), BF(WS_WIN), MTOK + MEMROWS, IN_COLS + 1024, 1024}; pg8::ZOrder<0> S; S.init(F.G, (int)blockIdx.x);
          pg8::gemm_phase<pg8::EpiZ, pg8::ZOrder<0>, true, true>(F.lds + RING_OFF, g, S, E); }
        { pg8::Gemm g{BF(WS_XN8), BF(WS_WIN8), MTOK, IN_COLS, 1024, SC_ONE, SC_W8}; pg8::ZOrder<1> S; S.init(F.G, (int)blockIdx.x);
          pg8::gemm_phase<pg8::EpiZ, pg8::ZOrder<1>, true, true, true>(F.lds + RING_OFF, g, S, E); }
    } SEAM(1);
#if NAIVE_ATTN
    if (IN(3)) { p3_attention(F); } SEAM(3);
#else
    if (IN(3)) { p3_attention_mfma(ws, (char*)lds + RING_OFF, F.G); __syncthreads(); phase_enter(F, true); p_r1<0>(F, args); } SEAM(3);
#endif
    if (IN(4)) { p_r2(F); if (F.G > 64 && blockIdx.x >= 64) p0_prologue<1>(F, args, ((int)blockIdx.x - 64) * NWAVES + F.wave, (F.G - 64) * NWAVES); } SEAM(4);
    if (IN(5)) { p_r3(F, args); p5_post(F, args); } SEAM(5);
    if (IN(6)) {
        pg8::Gemm g{BF(WS_YABC), BF(WS_WB), MTOK, 1024, 1536}; pg8::StaticOrder S; S.init(MTOK, 1024, F.G, (int)blockIdx.x);
        pg8::EpiGate3 E{BF(WS_Z), BF(WS_MRGB)};
        pg8::gemm_phase<pg8::EpiGate3, pg8::StaticOrder, true, true>(F.lds + RING_OFF, g, S, E);
    } SEAM(6);
    if (IN(7)) {
        pg8::Gemm g{BF(WS_MRGB), BF(WS_WO), MTOK, 1024, 1024, SC_M8, SC_W8}; pg8::StaticOrder S; S.init(MTOK, 1024, F.G, (int)blockIdx.x);
        pg8::EpiResInit E{ldarg(I_X), F.out, 1024};
        pg8::gemm_phase<pg8::EpiResInit, pg8::StaticOrder, true, true, MRG_FP8>(F.lds + RING_OFF, g, S, E);
    } SEAM(7);
    if (IN(8)) { p8_router(F, args); } SEAM(8);
    if (IN(9)) { p9_dispatch(F, args); } SEAM(9);
    if (IN(10)) {
        moe_table(F);
        pg8::Gemm g{BF(WS_XS), BF(WS_W1), 0, 0, 1024, SC_ONE, SC_W8}; pg8::MoeOrder S{(const PG8_LAS int*)(F.lds + MOETAB_OFF), 8, F.G, (int)blockIdx.x};
        pg8::EpiSwiGLU E{ldarg(I_EXP_B1), BF(WS_HACT)};
        pg8::gemm_phase<pg8::EpiSwiGLU, pg8::MoeOrder, true, true, true>(F.lds + RING_OFF, g, S, E);
    } SEAM(10);
    if (IN(11)) {
        moe_table(F);
        pg8::Gemm g{BF(WS_HACT), BF(WS_W2), 0, 0, 1024, SC_H8, SC_W8}; pg8::MoeOrder S{(const PG8_LAS int*)(F.lds + MOETAB_OFF), 4, F.G, (int)blockIdx.x};
        pg8::EpiMoeOut E{ldarg(I_EXP_B2), (const float*)(ws + WS_ROUTE + RT_ROWGATE), BF(WS_YROWS)};
        pg8::gemm_phase<pg8::EpiMoeOut, pg8::MoeOrder, true, true, true>(F.lds + RING_OFF, g, S, E);
    } SEAM(11);
    if (IN(12)) { p12_combine(F); }
#undef IN
#undef SEAM
#undef BF
    (void)wsb;
}

extern "C" void kernel_launch(void* const* d_in, const int* in_sizes, int n_in, void* d_out, int out_size, void* d_ws, size_t ws_size, hipStream_t stream) {
    static int grid = 0;
    if (grid == 0) {
        if (n_in != 32 || out_size != MTOK * D_MODEL || ws_size < WS_END) { fprintf(stderr, "kernel_launch: unexpected problem (n_in %d, out %d, ws %zu); nothing launched\n", n_in, out_size, ws_size); grid = -1; return; }
        int dev = 0, cus = 0;
        if (hipGetDevice(&dev) != hipSuccess || hipDeviceGetAttribute(&cus, hipDeviceAttributeMultiprocessorCount, dev) != hipSuccess) { grid = -1; return; }
        if (hipFuncSetAttribute((const void*)skel_fwd, hipFuncAttributeMaxDynamicSharedMemorySize, LDS_BYTES) != hipSuccess) { fprintf(stderr, "kernel_launch: hipFuncSetAttribute failed\n"); grid = -1; return; }
        (void)hipGetLastError();
        grid = cus;
    }
    if (grid < 0) return;
    (void)hipMemsetAsync((char*)d_ws + WS_CTL, 0, CTL_ZERO_BYTES, stream);
    Args a{};
    for (int i = 0; i < 32; ++i) a.in[i] = (const float*)d_in[i];
    a.out = (float*)d_out; a.ws = (unsigned char*)d_ws;
#if MK_N_LAUNCHES == 1
    a.ph_lo = 0; a.ph_hi = N_PHASES; a.use_bar = 1;
    hipLaunchKernelGGL(skel_fwd, dim3(grid), dim3(NWAVES * 64), LDS_BYTES, stream, a);
#else
    for (int p = 0; p < N_PHASES; ++p) { a.ph_lo = p; a.ph_hi = p + 1; a.use_bar = 0;
        hipLaunchKernelGGL(skel_fwd, dim3(grid), dim3(NWAVES * 64), LDS_BYTES, stream, a); }
#endif
}
```

```cpp
#include <hip/hip_runtime.h>
#include <cstdio>
#include <cstdint>
#include <cmath>
namespace pg8 {
#define PG8_LAS __attribute__((address_space(3)))
typedef unsigned short bf16_t;
typedef short bf16x8 __attribute__((ext_vector_type(8)));
typedef float f32x4 __attribute__((ext_vector_type(4)));
typedef unsigned u32x4 __attribute__((ext_vector_type(4)));
constexpr int BM = 256, BK = 64, HALF = 128, HTB = HALF * BK * 2  , STAGE_BYTES = 8 * HTB, NXCD = 8, WGM = 8;

__host__ __device__ __forceinline__ int lds_byte(int r, int c) { const int st = (r >> 4) * 2 + (c >> 5), rr = r & 15, cc = c & 31, ob = rr * 64 + cc * 2; return st * 1024 + (ob ^ (((ob >> 9) & 1) << 5)); }
__host__ __device__ __forceinline__ void stage_rc(int b, int& R, int& C) { const int st = b / 1024, sb = b % 1024, swz = sb ^ (((sb >> 9) & 1) << 5); R = (st >> 1) * 16 + swz / 64; C = (st & 1) * 32 + (swz % 64) / 2; }
__host__ __device__ __forceinline__ int perm32(int rho) { const int n = rho >> 4, i = rho & 15; return 8 * (i >> 2) + 4 * n + (i & 3); }

struct Unit { int pm, pn; };
typedef int v4i_t __attribute__((ext_vector_type(4))); typedef int v8i_t __attribute__((ext_vector_type(8)));
struct Gemm { const bf16_t* A; const bf16_t* Bt; int M, N, K; int sca = 0x7f7f7f7f, scb = 0x7f7f7f7f; int prof = 0; };
#ifdef PG8_PROF
__device__ unsigned long long pg8_prof[4];
#endif

struct StaticOrder {
    int nM, nN, nwg, G, c;
    __host__ __device__ void init(int M, int N, int G_, int c_) { nM = M / BM; nN = N / BM; nwg = nM * nN; G = G_; c = c_; }
    __host__ __device__ bool next(int i, Unit& u) const {
        const long L = (long)i * G + c; if (L >= nwg) return false;
        int wgid = (int)L; { const int q = nwg / NXCD, r = nwg % NXCD, xcd = wgid % NXCD, off = wgid / NXCD; wgid = (xcd < r ? xcd * (q + 1) : r * (q + 1) + (xcd - r) * q) + off; }
        const int nig = WGM * nN, gid = wgid / nig, fm = gid * WGM, gsz = (nM - fm) < WGM ? (nM - fm) : WGM;
        u.pm = fm + ((wgid % nig) % gsz); u.pn = (wgid % nig) / gsz; return true;
    }
    __device__ __forceinline__ void a_ready(const Unit&) const {}
    __device__ __forceinline__ void done(const Unit&) const {}
};

__device__ __forceinline__ unsigned cvt_pk_bf16(float lo, float hi) { unsigned r; asm volatile("v_cvt_pk_bf16_f32 %0, %1, %2" : "=v"(r) : "v"(lo), "v"(hi)); return r; }
typedef float f32x2 __attribute__((ext_vector_type(2)));
__device__ __forceinline__ f32x2 gelu_pk(f32x2 v) {
    const f32x2 av = __builtin_elementwise_abs(v), d = av * 0.2316418882f + 1.0f;
    f32x2 t; t.x = __builtin_amdgcn_rcpf(d.x); t.y = __builtin_amdgcn_rcpf(d.y);
    f32x2 q = t * 0.5307027145f + (-0.7265760135f); q = q * t + 0.7107068705f; q = q * t + (-0.142248368f); q = q * t + 0.127414796f; q = q * t;
    const f32x2 s = (v * v) * (-0.72134752044f);
    f32x2 e; e.x = __builtin_amdgcn_exp2f(s.x); e.y = __builtin_amdgcn_exp2f(s.y);
    const f32x2 m = v * (q * e), r = v - m;
    f32x2 o; o.x = v.x < 0.f ? m.x : r.x; o.y = v.y < 0.f ? m.y : r.y; return o;
}

template <int ACT  > struct EpiBf16 {
    static constexpr bool PERM = true, AFTER_DRAIN = false; static_assert(ACT == 0 || ACT == 1, "EpiBf16: ACT is 0 (none) or 1 (gelu_pk)");
    bf16_t* O; int ldc; const float* bias; int split_cols; size_t split_stride; float scale0;
    __device__ __forceinline__ void operator()(const f32x4 (&acc)[2][2][4][2], const Unit& u, int wr, int wc, int fr, int fq) const {
        const int row0 = u.pm * BM + wr * 64 + fr; int colt = u.pn * BM; bf16_t* base = O;
        float sc = 1.f; if (split_cols) { const int t = colt / split_cols; base += (size_t)t * split_stride; colt -= t * split_cols; if (t == 0) sc = scale0; }
        const int col0 = colt + wc * 32 + 8 * fq, bcol0 = u.pn * BM + wc * 32 + 8 * fq;
        f32x4 bv[2][2];
#pragma unroll
        for (int bj = 0; bj < 2; ++bj)
#pragma unroll
            for (int n = 0; n < 2; ++n) bv[bj][n] = bias ? *(const f32x4*)(bias + bcol0 + bj * HALF + 4 * n) : (f32x4){0.f, 0.f, 0.f, 0.f};
#pragma unroll
        for (int ai = 0; ai < 2; ++ai)
#pragma unroll
            for (int m = 0; m < 4; ++m) { bf16_t* rowp = base + (size_t)(row0 + ai * HALF + m * 16) * ldc + col0;
#pragma unroll
                for (int bj = 0; bj < 2; ++bj) { f32x4 v0 = acc[ai][bj][m][0] + bv[bj][0], v1 = acc[ai][bj][m][1] + bv[bj][1];
                    if (ACT == 1) { f32x2 a = gelu_pk((f32x2){v0[0], v0[1]}), b = gelu_pk((f32x2){v0[2], v0[3]}), c = gelu_pk((f32x2){v1[0], v1[1]}), d = gelu_pk((f32x2){v1[2], v1[3]});
                        v0 = (f32x4){a.x, a.y, b.x, b.y}; v1 = (f32x4){c.x, c.y, d.x, d.y}; }
                    v0 = v0 * sc; v1 = v1 * sc; u32x4 w; w.x = cvt_pk_bf16(v0[0], v0[1]); w.y = cvt_pk_bf16(v0[2], v0[3]); w.z = cvt_pk_bf16(v1[0], v1[1]); w.w = cvt_pk_bf16(v1[2], v1[3]);
                    *(u32x4*)(rowp + bj * HALF) = w; } }
    }
};
template <class E_> struct EpiHasMid { static constexpr bool v = false; };
template <class E_> struct EpiHasInit { static constexpr bool v = false; };
template <class Epi, class Sched, bool ALIGN_EPI = false, bool SP2 = false, bool FP8 = false>
__device__ __forceinline__ void gemm_phase(PG8_LAS unsigned char* lds, const Gemm g, const Sched& S, const Epi& E) {
    int tid_ = threadIdx.x; asm volatile("" : "+v"(tid_));
    const int tid = tid_, wid = __builtin_amdgcn_readfirstlane(tid >> 6), lane = tid & 63, wr = wid >> 2, wc = wid & 3, fr = lane & 15, fq = lane >> 4;
    const int K = FP8 ? g.K / 2 : g.K, nt = K / BK;
    unsigned voffA[2], voffB[2];
#pragma unroll
    for (int i = 0; i < 2; ++i) { int R, C; stage_rc(tid * 16 + i * 8192, R, C); const int Rb = Epi::PERM ? ((R & ~31) + perm32(R & 31)) : R;
        voffA[i] = (unsigned)(R * K + C) * 2u; voffB[i] = (unsigned)(Rb * K + C) * 2u; }
    const size_t kstep = (size_t)(BK * 2);
    const size_t hstep = (size_t)HALF * K * 2;
    const size_t tstep = 2 * hstep;
    const unsigned ldsw = (unsigned)wid * 1024u;
    const int aoff = FP8 ? lds_byte(wr * 64 + fr, fq * 16) : lds_byte(wr * 64 + fr, fq * 8), boff = FP8 ? lds_byte(wc * 32 + fr, fq * 16) : lds_byte(wc * 32 + fr, fq * 8);
    const int aoff2 = (aoff | ((fq >> 1) << 4)) ^ 16, boff2 = (boff | ((fq >> 1) << 4)) ^ 16; const int aoff1 = aoff2 ^ 16, boff1 = boff2 ^ 16; (void)aoff1; (void)boff1; (void)aoff2; (void)boff2;
#define PG8_SA(b, h) (((b) * 2 + (h)) * HTB)
#define PG8_SB(b, h) ((4 + (b) * 2 + (h)) * HTB)
#define PG8_STAGE(bufoff, gbase, voff) do { _Pragma("unroll") for (int _i = 0; _i < 2; ++_i) \
        __builtin_amdgcn_global_load_lds((const unsigned*)((const char*)(gbase) + (voff)[_i]), (PG8_LAS unsigned*)(lds + (bufoff) + ldsw + _i * 8192), 16, 0, 0); } while (0)
#define PG8_LD8(p_, q_) __builtin_shufflevector(*(const PG8_LAS v4i_t*)(p_), *(const PG8_LAS v4i_t*)(q_), 0, 1, 2, 3, 4, 5, 6, 7)
#define PG8_LDA(dst, b, h) do { if constexpr (FP8) { if (PG8_XLDS) { _Pragma("unroll") for (int m = 0; m < 4; ++m) dst##8[m] = PG8_LD8(lds + PG8_SA(b, h) + aoff1 + m * 2048, lds + PG8_SA(b, h) + aoff2 + m * 2048); } } \
        else { _Pragma("unroll") for (int m = 0; m < 4; ++m) _Pragma("unroll") for (int k = 0; k < 2; ++k) dst[m][k] = *(const PG8_LAS bf16x8*)(lds + PG8_SA(b, h) + aoff + k * 1024 + m * 2048); } } while (0)
#define PG8_LDB(dst, b, h) do { if constexpr (FP8) { if (PG8_XLDS) { _Pragma("unroll") for (int n = 0; n < 2; ++n) dst##8[n] = PG8_LD8(lds + PG8_SB(b, h) + boff1 + n * 2048, lds + PG8_SB(b, h) + boff2 + n * 2048); } } \
        else { _Pragma("unroll") for (int n = 0; n < 2; ++n) _Pragma("unroll") for (int k = 0; k < 2; ++k) dst[n][k] = *(const PG8_LAS bf16x8*)(lds + PG8_SB(b, h) + boff + k * 1024 + n * 2048); } } while (0)
#define PG8_MMA(ai, bj, At, Bt) do { __builtin_amdgcn_s_setprio(1); \
        if constexpr (FP8) { if (PG8_XMMA) { _Pragma("unroll") for (int m = 0; m < 4; ++m) _Pragma("unroll") for (int n = 0; n < 2; ++n) \
            asm volatile("v_mfma_scale_f32_16x16x128_f8f6f4 %0, %1, %2, %0, %3, %4 op_sel_hi:[0,0,0]" : "+v"(acc[ai][bj][m][n]) : "v"(Bt##8[n]), "v"(At##8[m]), "v"(scb_v), "v"(sca_v)); } } \
        else { _Pragma("unroll") for (int m = 0; m < 4; ++m) _Pragma("unroll") for (int n = 0; n < 2; ++n) _Pragma("unroll") for (int k = 0; k < 2; ++k) \
            acc[ai][bj][m][n] = __builtin_amdgcn_mfma_f32_16x16x32_bf16(Bt[n][k], At[m][k], acc[ai][bj][m][n], 0, 0, 0); } __builtin_amdgcn_s_setprio(0); } while (0)
#define PG8_WAIT_V(n) asm volatile("s_waitcnt vmcnt(" #n ")" ::: "memory")
#define PG8_WAIT_L(n) asm volatile("s_waitcnt lgkmcnt(" #n ")" ::: "memory")
#define PG8_BAR __builtin_amdgcn_s_barrier()
#define PG8_SCHED __builtin_amdgcn_sched_barrier(0)
#ifdef PG8_PROF
    const bool PG8_XMMA = g.prof != 2 && g.prof != 4, PG8_XLDS = g.prof != 3 && g.prof != 4;
#else
    constexpr bool PG8_XMMA = true, PG8_XLDS = true;
#endif
    Unit cur, nxt; int ui = 0;
#ifdef PG8_PROF
#define PG8_TS(slot) do { if (g.prof && wid == 0) { const unsigned n_ = (unsigned)__builtin_amdgcn_s_memrealtime(); volatile PG8_LAS unsigned* p_ = (volatile PG8_LAS unsigned*)(lds + 143744); p_[slot] += n_ - p_[2]; p_[2] = n_; } } while (0)
#else
#define PG8_TS(slot) do { } while (0)
#endif
    if (!S.next(0, cur)) return;
    f32x4 acc[2][2][4][2];
#pragma unroll
    for (int a = 0; a < 2; ++a)
#pragma unroll
        for (int b = 0; b < 2; ++b)
#pragma unroll
            for (int m = 0; m < 4; ++m)
#pragma unroll
                for (int n = 0; n < 2; ++n) acc[a][b][m][n] = (f32x4){0.f, 0.f, 0.f, 0.f};
    if constexpr (EpiHasInit<Epi>::v) E.init(acc, cur, wr, wc, fr, fq);
    const int sca_v = g.sca, scb_v = g.scb;
    bf16x8 At[4][2], B0[2][2], B1[2][2];
    v8i_t At8[4] = {}, B08[2] = {}, B18[2] = {};
    const char* cA = (const char*)g.A + (size_t)cur.pm * tstep; const char* cB = (const char*)g.Bt + (size_t)cur.pn * tstep;
    S.a_ready(cur);
    if constexpr (SP2) {
        PG8_STAGE(PG8_SB(0, 0), cB, voffB); PG8_STAGE(PG8_SB(0, 1), cB + hstep, voffB); PG8_STAGE(PG8_SA(0, 0), cA, voffA); PG8_STAGE(PG8_SA(0, 1), cA + hstep, voffA);
        if (wr == 1) PG8_BAR;
        PG8_WAIT_V(2); PG8_BAR;
        PG8_STAGE(PG8_SB(1, 0), cB + kstep, voffB); PG8_STAGE(PG8_SA(1, 0), cA + kstep, voffA); PG8_STAGE(PG8_SB(1, 1), cB + hstep + kstep, voffB);
        PG8_WAIT_V(6); PG8_BAR;
    } else {
        PG8_STAGE(PG8_SB(0, 0), cB, voffB); PG8_STAGE(PG8_SA(0, 0), cA, voffA); PG8_STAGE(PG8_SB(0, 1), cB + hstep, voffB); PG8_STAGE(PG8_SA(0, 1), cA + hstep, voffA);
        if (wr == 1) PG8_BAR;
        PG8_WAIT_V(4); PG8_BAR;
        PG8_STAGE(PG8_SB(1, 0), cB + kstep, voffB); PG8_STAGE(PG8_SA(1, 0), cA + kstep, voffA); PG8_STAGE(PG8_SB(1, 1), cB + hstep + kstep, voffB);
        PG8_WAIT_V(6); PG8_BAR;
    }
    for (;;) {
        const bool has_next = S.next(ui + 1, nxt);
        const char* nA = has_next ? (const char*)g.A + (size_t)nxt.pm * tstep : cA; const char* nB = has_next ? (const char*)g.Bt + (size_t)nxt.pn * tstep : cB;
        PG8_TS(3);
#pragma unroll 1
        for (int t = 0; t < nt; t += 2) {
            if constexpr (EpiHasMid<Epi>::v) { if (t == 8 || t == 16) { PG8_SCHED; E.mid(acc, cur, t, wr, wc, fr, fq); PG8_SCHED; } }
            const bool last = (t == nt - 2);
            const char* a1 = cA + (size_t)(t + 1) * kstep;
            const char* a2 = last ? nA : cA + (size_t)(t + 2) * kstep; const char* b2 = last ? nB : cB + (size_t)(t + 2) * kstep;
            const char* a3 = a2 + kstep; const char* b3 = b2 + kstep;
            if (last && has_next) S.a_ready(nxt);
            if constexpr (SP2) {
            PG8_LDB(B0, 0, 0); PG8_LDB(B1, 0, 1); PG8_SCHED; PG8_LDA(At, 0, 0); PG8_STAGE(PG8_SA(1, 1), a1 + hstep, voffA);
            PG8_WAIT_V(8); PG8_WAIT_L(0); PG8_BAR; PG8_MMA(0, 0, At, B0); PG8_MMA(0, 1, At, B1); PG8_BAR; PG8_SCHED;
            PG8_LDA(At, 0, 1); PG8_STAGE(PG8_SB(0, 0), b2, voffB); PG8_STAGE(PG8_SB(0, 1), b2 + hstep, voffB); PG8_STAGE(PG8_SA(0, 0), a2, voffA);
            PG8_WAIT_V(8); PG8_WAIT_L(0); PG8_BAR; PG8_MMA(1, 0, At, B0); PG8_MMA(1, 1, At, B1); PG8_BAR; PG8_SCHED;
            PG8_LDB(B0, 1, 0); PG8_LDB(B1, 1, 1); PG8_SCHED; PG8_LDA(At, 1, 0); PG8_STAGE(PG8_SA(0, 1), a2 + hstep, voffA);
            PG8_WAIT_V(8); PG8_WAIT_L(0); PG8_BAR; PG8_MMA(0, 0, At, B0); PG8_MMA(0, 1, At, B1); PG8_BAR; PG8_SCHED;
            PG8_LDA(At, 1, 1); PG8_STAGE(PG8_SB(1, 0), b3, voffB); PG8_STAGE(PG8_SB(1, 1), b3 + hstep, voffB); PG8_STAGE(PG8_SA(1, 0), a3, voffA);
            PG8_WAIT_V(8); PG8_WAIT_L(0); PG8_BAR; PG8_MMA(1, 0, At, B0); PG8_MMA(1, 1, At, B1); PG8_BAR; PG8_SCHED;
            } else {
            PG8_LDB(B0, 0, 0); PG8_SCHED; PG8_LDA(At, 0, 0); PG8_STAGE(PG8_SA(1, 1), a1 + hstep, voffA);
            PG8_WAIT_L(8); PG8_BAR; PG8_WAIT_L(0); PG8_MMA(0, 0, At, B0); PG8_BAR; PG8_SCHED;
            PG8_LDB(B1, 0, 1); PG8_STAGE(PG8_SB(0, 0), b2, voffB);
            PG8_BAR; PG8_WAIT_L(0); PG8_MMA(0, 1, At, B1); PG8_BAR;
            PG8_LDA(At, 0, 1); PG8_STAGE(PG8_SA(0, 0), a2, voffA);
            PG8_BAR; PG8_WAIT_L(0); PG8_MMA(1, 0, At, B0); PG8_BAR; PG8_SCHED;
            PG8_STAGE(PG8_SB(0, 1), b2 + hstep, voffB);
            PG8_WAIT_V(6); PG8_BAR; PG8_MMA(1, 1, At, B1); PG8_BAR;
            PG8_LDB(B0, 1, 0); PG8_SCHED; PG8_LDA(At, 1, 0); PG8_STAGE(PG8_SA(0, 1), a2 + hstep, voffA);
            PG8_WAIT_L(8); PG8_BAR; PG8_WAIT_L(0); PG8_MMA(0, 0, At, B0); PG8_BAR; PG8_SCHED;
            PG8_LDB(B1, 1, 1); PG8_STAGE(PG8_SB(1, 0), b3, voffB);
            PG8_BAR; PG8_WAIT_L(0); PG8_MMA(0, 1, At, B1); PG8_BAR;
            PG8_LDA(At, 1, 1); PG8_STAGE(PG8_SA(1, 0), a3, voffA);
            PG8_BAR; PG8_WAIT_L(0); PG8_MMA(1, 0, At, B0); PG8_BAR; PG8_SCHED;
            PG8_STAGE(PG8_SB(1, 1), b3 + hstep, voffB);
            PG8_WAIT_V(6); PG8_BAR; PG8_MMA(1, 1, At, B1); PG8_BAR;
            }
        }
        PG8_TS(0);
        if constexpr (FP8) { asm volatile("s_nop 15\n\ts_nop 15" ::: "memory"); }
        if constexpr (ALIGN_EPI) { if (wr == 0) PG8_BAR; }
        if constexpr (!Epi::AFTER_DRAIN) { E(acc, cur, wr, wc, fr, fq); S.done(cur); }
        PG8_TS(1);
        if (!has_next) break;
#pragma unroll
        for (int a = 0; a < 2; ++a)
#pragma unroll
            for (int b = 0; b < 2; ++b)
#pragma unroll
                for (int m = 0; m < 4; ++m)
#pragma unroll
                    for (int n = 0; n < 2; ++n) acc[a][b][m][n] = (f32x4){0.f, 0.f, 0.f, 0.f};
        if constexpr (EpiHasInit<Epi>::v) E.init(acc, nxt, wr, wc, fr, fq);
        cur = nxt; cA = nA; cB = nB; ++ui;
        if constexpr (ALIGN_EPI) { if (wr == 1) PG8_BAR; }
    }
#ifdef PG8_PROF
    if (g.prof && blockIdx.x == 0 && tid == 0) { volatile PG8_LAS unsigned* p_ = (volatile PG8_LAS unsigned*)(lds + 143744); pg8_prof[0] = p_[0]; pg8_prof[1] = p_[1]; pg8_prof[2] = (unsigned long long)(ui + 1); }
#endif
    PG8_WAIT_V(0);
    if constexpr (!ALIGN_EPI) { if (wr == 0) PG8_BAR; }
    PG8_BAR;
    if constexpr (Epi::AFTER_DRAIN) { E.fused(acc, cur, wr, wc, fr, fq, lds, wid, lane); S.done(cur); }
#undef PG8_SA
#undef PG8_SB
#undef PG8_STAGE
#undef PG8_LD8
#undef PG8_LDA
#undef PG8_LDB
#undef PG8_MMA
#undef PG8_WAIT_V
#undef PG8_WAIT_L
#undef PG8_BAR
#undef PG8_SCHED
}
}

constexpr int D_MODEL = 1024, BATCH = 2, SEQ = 8192, MTOK = BATCH * SEQ, MEM_LEN = 256, MEMROWS = BATCH * MEM_LEN;
constexpr int IN_COLS = 9984, OFF_AQ = 0, OFF_AK = 1536, OFF_AV = 3072, OFF_R = 4608, OFF_CQ = 6400, OFF_GATE = 6912;
constexpr int RW = 512;
constexpr int N_EXPERTS = 32, TOP_K = 4, D_FF = 1024, MOE_ROWS = 256;
constexpr int MAX_BLOCKS = MTOK * TOP_K / MOE_ROWS + N_EXPERTS;
constexpr int MAX_SLOTS = MAX_BLOCKS * MOE_ROWS;
constexpr bool MRG_FP8 = false; constexpr float M8_SCALE = 16.0f;
constexpr float NORM_EPS = 1e-6f, R_GN_EPS = 64e-5f;
constexpr float LOG2E = 1.4426950408889634f;
constexpr float QSCALE = 0.08838834764831845f * LOG2E;

namespace pg8 {
__device__ __forceinline__ float bf_lo(unsigned w) { return __builtin_bit_cast(float, w << 16); }
__device__ __forceinline__ float bf_hi(unsigned w) { return __builtin_bit_cast(float, w & 0xffff0000u); }
__device__ __forceinline__ float sigmoidf_fast(float x) { return __builtin_amdgcn_rcpf(1.0f + __builtin_amdgcn_exp2f(-1.4426950408889634f * x)); }

constexpr bool WT_STORES = false;
__device__ __forceinline__ void st16(const __amdgpu_buffer_rsrc_t r, void* base, size_t off_bytes, u32x4 w) {
    if constexpr (WT_STORES) __builtin_amdgcn_raw_buffer_store_b128(w, r, (unsigned)off_bytes, 0, 16);
    else *(u32x4*)((unsigned char*)base + off_bytes) = w;
}
struct EpiZ {
    static constexpr bool PERM = true, AFTER_DRAIN = false;
    bf16_t* O; const float* bgate; const float* aqg; const float* akg; const float* cqg; const float* cs;
    bf16_t* KV; const float* ckg;
    PG8_LAS float* P;
    __device__ __forceinline__ void operator()(const f32x4 (&acc)[2][2][4][2], const Unit& u, int wr, int wc, int fr, int fq) const {
        const bool mem = u.pm >= 64; const int pnl = mem ? u.pn - 39 : u.pn, ldc = mem ? 1024 : IN_COLS;
        bf16_t* const Ob = mem ? KV - (size_t)64 * BM * 1024 : O;
        const __amdgpu_buffer_rsrc_t ors = __builtin_amdgcn_make_buffer_rsrc((void*)Ob, (short)0, 0x7fffffff, 0x00020000);
        const int row0 = u.pm * BM + wr * 64 + fr, col0 = pnl * BM + wc * 32 + 8 * fq;
        const int cls = mem ? ((pnl < 2) ? 3 : 0) : (pnl < 6) ? 1 : (pnl < 12) ? 2 : (pnl == 25 || pnl == 26) ? 3 : (pnl >= 27) ? 4 : 0;
        if (cls >= 1 && cls <= 3) {
            const int go = wc * 32 + 8 * fq;
            const f32x4 q0 = *(const f32x4*)(aqg + go), q1 = *(const f32x4*)(aqg + go + 4), k0 = *(const f32x4*)(akg + go), k1 = *(const f32x4*)(akg + go + 4), x0 = *(const f32x4*)(cqg + go), x1 = *(const f32x4*)(cqg + go + 4);
            const f32x4 m0 = *(const f32x4*)(ckg + go), m1 = *(const f32x4*)(ckg + go + 4);
            const f32x4 g0 = mem ? m0 : (cls == 1) ? q0 : (cls == 2) ? k0 : x0, g1 = mem ? m1 : (cls == 1) ? q1 : (cls == 2) ? k1 : x1;
#pragma unroll
            for (int ai = 0; ai < 2; ++ai)
#pragma unroll
                for (int m = 0; m < 4; ++m)
#pragma unroll
                    for (int bj = 0; bj < 2; ++bj) { const f32x4 a = acc[ai][bj][m][0], b = acc[ai][bj][m][1];
                        float s = ((a[0] * a[0] + a[1] * a[1]) + (a[2] * a[2] + a[3] * a[3])) + ((b[0] * b[0] + b[1] * b[1]) + (b[2] * b[2] + b[3] * b[3]));
                        s += __shfl_xor(s, 16); s += __shfl_xor(s, 32);
                        if (fq == 0) P[((ai * HALF + wr * 64 + m * 16 + fr) * 2 + bj) * 4 + wc] = s; }
            asm volatile("s_waitcnt lgkmcnt(0)" ::: "memory"); __builtin_amdgcn_s_barrier(); asm volatile("" ::: "memory");
#pragma unroll
            for (int ai = 0; ai < 2; ++ai)
#pragma unroll
                for (int m = 0; m < 4; ++m) { const int rl = ai * HALF + wr * 64 + m * 16 + fr, row = u.pm * BM + rl;
                    f32x4 c0 = {0.f, 0.f, 0.f, 0.f}, c1 = c0, c2 = c0, c3 = c0;
                    if (cls != 3 && wc == 0) { const f32x4* cp = (const f32x4*)(cs + (size_t)row * 32 + 16 * (fq & 1)); c0 = cp[0]; c1 = cp[1]; c2 = cp[2]; c3 = cp[3]; }
#pragma unroll
                    for (int bj = 0; bj < 2; ++bj) { const f32x4 pv = *(const PG8_LAS f32x4*)(P + (rl * 2 + bj) * 4);
                        const float rstd = __builtin_amdgcn_rsqf(((pv[0] + pv[1]) + (pv[2] + pv[3])) * (1.0f / 128.0f) + NORM_EPS);
                        f32x4 v0 = acc[ai][bj][m][0] * rstd * g0, v1 = acc[ai][bj][m][1] * rstd * g1;
                        if (cls != 3 && wc == 0) {
                            f32x4 p0, p1;
#pragma unroll
                            for (int j = 0; j < 4; ++j) { p0[j] = __shfl_xor(v0[j], 32); p1[j] = __shfl_xor(v1[j], 32); }
                            const float sg = (fq < 2) ? -1.0f : 1.0f;
                            v0[0] = v0[0] * c0[0] + sg * p0[0] * c0[1]; v0[1] = v0[1] * c0[2] + sg * p0[1] * c0[3]; v0[2] = v0[2] * c1[0] + sg * p0[2] * c1[1]; v0[3] = v0[3] * c1[2] + sg * p0[3] * c1[3];
                            v1[0] = v1[0] * c2[0] + sg * p1[0] * c2[1]; v1[1] = v1[1] * c2[2] + sg * p1[1] * c2[3]; v1[2] = v1[2] * c3[0] + sg * p1[2] * c3[1]; v1[3] = v1[3] * c3[2] + sg * p1[3] * c3[3]; }
                        u32x4 w; w.x = cvt_pk_bf16(v0[0], v0[1]); w.y = cvt_pk_bf16(v0[2], v0[3]); w.z = cvt_pk_bf16(v1[0], v1[1]); w.w = cvt_pk_bf16(v1[2], v1[3]);
                        st16(ors, Ob, ((size_t)row * ldc + col0 + bj * HALF) * 2, w); } }
            return;
        }
        const bool gate = cls == 4;
        f32x4 bv[2][2];
#pragma unroll
        for (int bj = 0; bj < 2; ++bj)
#pragma unroll
            for (int n = 0; n < 2; ++n) bv[bj][n] = gate ? *(const f32x4*)(bgate + (col0 - OFF_GATE) + bj * HALF + 4 * n) : (f32x4){0.f, 0.f, 0.f, 0.f};
#pragma unroll
        for (int ai = 0; ai < 2; ++ai)
#pragma unroll
            for (int m = 0; m < 4; ++m) { const size_t rowo = ((size_t)(row0 + ai * HALF + m * 16) * ldc + col0) * 2;
#pragma unroll
                for (int bj = 0; bj < 2; ++bj) { f32x4 v0 = acc[ai][bj][m][0] + bv[bj][0], v1 = acc[ai][bj][m][1] + bv[bj][1];
                    if (gate) {
#pragma unroll
                        for (int j = 0; j < 4; ++j) { v0[j] = sigmoidf_fast(v0[j]); v1[j] = sigmoidf_fast(v1[j]); } }
                    u32x4 w; w.x = cvt_pk_bf16(v0[0], v0[1]); w.y = cvt_pk_bf16(v0[2], v0[3]); w.z = cvt_pk_bf16(v1[0], v1[1]); w.w = cvt_pk_bf16(v1[2], v1[3]);
                    st16(ors, Ob, rowo + bj * HALF * 2, w); } }
    }
};

template <int SET> struct ZOrder {
    StaticOrder so; int nz;
    __device__ void init(int G_, int c_) { so.init(MTOK, (SET == 0 ? 7 : 32) * BM, G_, c_); nz = 64 * (SET == 0 ? 7 : 32); }
    __device__ __forceinline__ bool next(int i, Unit& u) const {
        if (so.next(i, u)) { const int t = u.pn;
            if (SET == 0) u.pn = t + 18; else u.pn = (t < 18) ? t : t + 7;
            return true; }
        if (SET == 0) { const long L = (long)i * so.G + so.c - nz; if (L >= 0 && L < 8) { u.pm = 64 + (int)(L & 1); u.pn = 39 + (int)(L >> 1); return true; } }
        return false;
    }
    __device__ __forceinline__ void a_ready(const Unit&) const {}
    __device__ __forceinline__ void done(const Unit&) const {}
};
struct EpiGate3 {
    static constexpr bool PERM = true, AFTER_DRAIN = false;
    const bf16_t* Z; bf16_t* mergedb;
    __device__ __forceinline__ void mid(f32x4 (&acc)[2][2][4][2], const Unit& u, int t, int wr, int wc, int fr, int fq) const {
        int fr_ = fr; asm volatile("" : "+v"(fr_));
        const int row0 = u.pm * BM + wr * 64 + fr_, col0 = u.pn * BM + wc * 32 + 8 * fq, ba = (t >> 3) - 1;
        const bf16_t* gp = Z + OFF_GATE + ba * D_MODEL + col0;
#pragma unroll
        for (int ai = 0; ai < 2; ++ai)
#pragma unroll
            for (int m = 0; m < 4; ++m) { const bf16_t* rp = gp + (size_t)(row0 + ai * HALF + m * 16) * IN_COLS;
#pragma unroll
                for (int bj = 0; bj < 2; ++bj) { const u32x4 ga = *(const u32x4*)(rp + bj * HALF), gb = *(const u32x4*)(rp + D_MODEL + bj * HALF);
                    f32x4 r0, r1;
                    r0[0] = bf_lo(ga[0]) * __builtin_amdgcn_rcpf(bf_lo(gb[0])); r0[1] = bf_hi(ga[0]) * __builtin_amdgcn_rcpf(bf_hi(gb[0])); r0[2] = bf_lo(ga[1]) * __builtin_amdgcn_rcpf(bf_lo(gb[1])); r0[3] = bf_hi(ga[1]) * __builtin_amdgcn_rcpf(bf_hi(gb[1]));
                    r1[0] = bf_lo(ga[2]) * __builtin_amdgcn_rcpf(bf_lo(gb[2])); r1[1] = bf_hi(ga[2]) * __builtin_amdgcn_rcpf(bf_hi(gb[2])); r1[2] = bf_lo(ga[3]) * __builtin_amdgcn_rcpf(bf_lo(gb[3])); r1[3] = bf_hi(ga[3]) * __builtin_amdgcn_rcpf(bf_hi(gb[3]));
                    acc[ai][bj][m][0] *= r0; acc[ai][bj][m][1] *= r1; }
                if (m == 3) asm volatile("" ::: "memory"); }
    }
    __device__ __forceinline__ void operator()(const f32x4 (&acc)[2][2][4][2], const Unit& u, int wr, int wc, int fr, int fq) const {
        const int row0 = u.pm * BM + wr * 64 + fr, col0 = u.pn * BM + wc * 32 + 8 * fq;
        u32x4 gzr[2][4][2];
#pragma unroll
        for (int ai = 0; ai < 2; ++ai)
#pragma unroll
            for (int m = 0; m < 4; ++m)
#pragma unroll
                for (int bj = 0; bj < 2; ++bj) gzr[ai][m][bj] = *(const u32x4*)(Z + (size_t)(row0 + ai * HALF + m * 16) * IN_COLS + OFF_GATE + 2 * D_MODEL + col0 + bj * HALF);
#pragma unroll
        for (int ai = 0; ai < 2; ++ai)
#pragma unroll
            for (int m = 0; m < 4; ++m) { const int row = row0 + ai * HALF + m * 16;
#pragma unroll
                for (int bj = 0; bj < 2; ++bj) { const int col = col0 + bj * HALF; const u32x4 gz = gzr[ai][m][bj];
                    f32x4 g0, g1;
                    g0[0] = bf_lo(gz[0]); g0[1] = bf_hi(gz[0]); g0[2] = bf_lo(gz[1]); g0[3] = bf_hi(gz[1]); g1[0] = bf_lo(gz[2]); g1[1] = bf_hi(gz[2]); g1[2] = bf_lo(gz[3]); g1[3] = bf_hi(gz[3]);
                    const f32x4 v0 = acc[ai][bj][m][0] * g0, v1 = acc[ai][bj][m][1] * g1;
                    if constexpr (MRG_FP8) { unsigned w0 = 0, w1 = 0;
                        w0 = __builtin_amdgcn_cvt_pk_fp8_f32(v0[0] * M8_SCALE, v0[1] * M8_SCALE, w0, false); w0 = __builtin_amdgcn_cvt_pk_fp8_f32(v0[2] * M8_SCALE, v0[3] * M8_SCALE, w0, true);
                        w1 = __builtin_amdgcn_cvt_pk_fp8_f32(v1[0] * M8_SCALE, v1[1] * M8_SCALE, w1, false); w1 = __builtin_amdgcn_cvt_pk_fp8_f32(v1[2] * M8_SCALE, v1[3] * M8_SCALE, w1, true);
                        *(unsigned long long*)((unsigned char*)mergedb + (size_t)row * D_MODEL + col) = (unsigned long long)w0 | ((unsigned long long)w1 << 32); }
                    else { u32x4 w; w.x = cvt_pk_bf16(v0[0], v0[1]); w.y = cvt_pk_bf16(v0[2], v0[3]); w.z = cvt_pk_bf16(v1[0], v1[1]); w.w = cvt_pk_bf16(v1[2], v1[3]);
                        *(u32x4*)(mergedb + (size_t)row * D_MODEL + col) = w; } } }
    }
};
template <> struct EpiHasMid<EpiGate3> { static constexpr bool v = true; };
struct EpiGate3NoMid : EpiGate3 {};
struct EpiResF32 {
    static constexpr bool PERM = true, AFTER_DRAIN = false;
    const float* base; float* out; int ldc;
    __device__ __forceinline__ void operator()(const f32x4 (&acc)[2][2][4][2], const Unit& u, int wr, int wc, int fr, int fq) const {
        const int row0 = u.pm * BM + wr * 64 + fr, col0 = u.pn * BM + wc * 32 + 8 * fq;
#pragma unroll
        for (int ai = 0; ai < 2; ++ai) {
            f32x4 xr[4][2][2];
#pragma unroll
            for (int m = 0; m < 4; ++m)
#pragma unroll
                for (int bj = 0; bj < 2; ++bj) { const float* bp = base + (size_t)(row0 + ai * HALF + m * 16) * ldc + col0 + bj * HALF; xr[m][bj][0] = *(const f32x4*)bp; xr[m][bj][1] = *(const f32x4*)(bp + 4); }
#pragma unroll
            for (int m = 0; m < 4; ++m)
#pragma unroll
                for (int bj = 0; bj < 2; ++bj) { float* op = out + (size_t)(row0 + ai * HALF + m * 16) * ldc + col0 + bj * HALF;
                    *(f32x4*)op = xr[m][bj][0] + acc[ai][bj][m][0]; *(f32x4*)(op + 4) = xr[m][bj][1] + acc[ai][bj][m][1]; }
            asm volatile("" ::: "memory"); }
    }
};
struct EpiResInit {
    static constexpr bool PERM = true, AFTER_DRAIN = false;
    const float* base; float* out; int ldc;
    __device__ __forceinline__ void init(f32x4 (&acc)[2][2][4][2], const Unit& u, int wr, int wc, int fr, int fq) const {
        const int row0 = u.pm * BM + wr * 64 + fr, col0 = u.pn * BM + wc * 32 + 8 * fq;
#pragma unroll
        for (int ai = 0; ai < 2; ++ai)
#pragma unroll
            for (int m = 0; m < 4; ++m)
#pragma unroll
                for (int bj = 0; bj < 2; ++bj) { const float* bp = base + (size_t)(row0 + ai * HALF + m * 16) * ldc + col0 + bj * HALF; acc[ai][bj][m][0] = *(const f32x4*)bp; acc[ai][bj][m][1] = *(const f32x4*)(bp + 4); }
    }
    __device__ __forceinline__ void operator()(const f32x4 (&acc)[2][2][4][2], const Unit& u, int wr, int wc, int fr, int fq) const {
        const int row0 = u.pm * BM + wr * 64 + fr, col0 = u.pn * BM + wc * 32 + 8 * fq;
#pragma unroll
        for (int ai = 0; ai < 2; ++ai)
#pragma unroll
            for (int m = 0; m < 4; ++m)
#pragma unroll
                for (int bj = 0; bj < 2; ++bj) { float* op = out + (size_t)(row0 + ai * HALF + m * 16) * ldc + col0 + bj * HALF; *(f32x4*)op = acc[ai][bj][m][0]; *(f32x4*)(op + 4) = acc[ai][bj][m][1]; }
    }
};
template <> struct EpiHasInit<EpiResInit> { static constexpr bool v = true; };
struct EpiSwiGLU {
    static constexpr bool PERM = true, AFTER_DRAIN = false;
    const float* b1; bf16_t* H;
    __device__ __forceinline__ void operator()(const f32x4 (&acc)[2][2][4][2], const Unit& u, int wr, int wc, int fr, int fq) const {
        const int e = u.pn >> 3, pnl = u.pn & 7;
        const int row0 = u.pm * BM + wr * 64 + fr, ac = pnl * HALF + wc * 32 + 8 * fq;
        const float* bg = b1 + (size_t)e * 2 * D_FF + ac; const float* bl = bg + D_FF;
        const f32x4 bg0 = *(const f32x4*)bg, bg1 = *(const f32x4*)(bg + 4), bl0 = *(const f32x4*)bl, bl1 = *(const f32x4*)(bl + 4);
#pragma unroll
        for (int ai = 0; ai < 2; ++ai)
#pragma unroll
            for (int m = 0; m < 4; ++m) { const int row = row0 + ai * HALF + m * 16;
                float a[8];
#pragma unroll
                for (int n = 0; n < 2; ++n) { const f32x4 ug = acc[ai][0][m][n] + (n ? bg1 : bg0), ul = acc[ai][1][m][n] + (n ? bl1 : bl0);
#pragma unroll
                    for (int j = 0; j < 4; ++j) { const float g = fminf(ug[j], 7.0f), l = fminf(fmaxf(ul[j], -7.0f), 7.0f);
                        a[4 * n + j] = g * sigmoidf_fast(1.702f * g) * (l + 1.0f); } }
                unsigned w0 = 0, w1 = 0;
                w0 = __builtin_amdgcn_cvt_pk_fp8_f32(a[0] * 8.0f, a[1] * 8.0f, w0, false); w0 = __builtin_amdgcn_cvt_pk_fp8_f32(a[2] * 8.0f, a[3] * 8.0f, w0, true);
                w1 = __builtin_amdgcn_cvt_pk_fp8_f32(a[4] * 8.0f, a[5] * 8.0f, w1, false); w1 = __builtin_amdgcn_cvt_pk_fp8_f32(a[6] * 8.0f, a[7] * 8.0f, w1, true);
                *(unsigned long long*)((unsigned char*)H + (size_t)row * D_FF + ac) = (unsigned long long)w0 | ((unsigned long long)w1 << 32); }
    }
};
struct EpiMoeOut {
    static constexpr bool PERM = true, AFTER_DRAIN = false;
    const float* b2; const float* rowgate; bf16_t* Y;
    __device__ __forceinline__ void operator()(const f32x4 (&acc)[2][2][4][2], const Unit& u, int wr, int wc, int fr, int fq) const {
        const int e = u.pn >> 2, pnl = u.pn & 3;
        const int row0 = u.pm * BM + wr * 64 + fr, col0 = pnl * BM + wc * 32 + 8 * fq;
        float gtr[2][4]; f32x4 bb[2][2];
#pragma unroll
        for (int ai = 0; ai < 2; ++ai)
#pragma unroll
            for (int m = 0; m < 4; ++m) gtr[ai][m] = rowgate[row0 + ai * HALF + m * 16];
#pragma unroll
        for (int bj = 0; bj < 2; ++bj) { const float* bp = b2 + (size_t)e * D_MODEL + col0 + bj * HALF; bb[bj][0] = *(const f32x4*)bp; bb[bj][1] = *(const f32x4*)(bp + 4); }
#pragma unroll
        for (int ai = 0; ai < 2; ++ai)
#pragma unroll
            for (int m = 0; m < 4; ++m) { const int row = row0 + ai * HALF + m * 16; const float gt = gtr[ai][m];
#pragma unroll
                for (int bj = 0; bj < 2; ++bj) { const int col = col0 + bj * HALF;
                    const f32x4 v0 = (acc[ai][bj][m][0] + bb[bj][0]) * gt, v1 = (acc[ai][bj][m][1] + bb[bj][1]) * gt;
                    unsigned w0 = 0, w1 = 0;
                    w0 = __builtin_amdgcn_cvt_pk_fp8_f32(v0[0] * 16.0f, v0[1] * 16.0f, w0, false); w0 = __builtin_amdgcn_cvt_pk_fp8_f32(v0[2] * 16.0f, v0[3] * 16.0f, w0, true);
                    w1 = __builtin_amdgcn_cvt_pk_fp8_f32(v1[0] * 16.0f, v1[1] * 16.0f, w1, false); w1 = __builtin_amdgcn_cvt_pk_fp8_f32(v1[2] * 16.0f, v1[3] * 16.0f, w1, true);
                    *(unsigned long long*)((unsigned char*)Y + (size_t)row * D_MODEL + col) = (unsigned long long)w0 | ((unsigned long long)w1 << 32); } }
    }
};
struct MoeOrder {
    const PG8_LAS int* tab;
    int NT, G, c;
    __device__ __forceinline__ bool next(int i, Unit& u) const {
        const int nblk = tab[0], nu = nblk * NT; const long L0 = (long)i * G + c; if (L0 >= (long)nu) return false;
        int L = (int)L0; { const int q = nu / NXCD, r = nu % NXCD, xcd = L % NXCD, off = L / NXCD; L = (xcd < r ? xcd * (q + 1) : r * (q + 1) + (xcd - r) * q) + off; }
        const int blk = L / NT, pnl = L % NT; u.pm = blk; u.pn = tab[1 + blk] * NT + pnl; return true;
    }
    __device__ __forceinline__ void a_ready(const Unit&) const {}
    __device__ __forceinline__ void done(const Unit&) const {}
};
}

namespace swa {
constexpr int D = 128;
constexpr float SCALE = 0.08838834764831845f;
constexpr float THR = 8.f;
constexpr int NW = 8, QBLK = 32, KVBLK = 64, QB = NW * QBLK;
constexpr int SHM_V = KVBLK * D * 2, SHM_K = KVBLK * D * 2;
constexpr int LDS_BYTES = 2 * SHM_V + 2 * SHM_K + NW * 64 * 4;
using bf16 = unsigned short;
typedef short bf16x8 __attribute__((ext_vector_type(8)));
typedef short s16x4 __attribute__((ext_vector_type(4)));
typedef float f32x16 __attribute__((ext_vector_type(16)));
typedef float f32x4 __attribute__((ext_vector_type(4)));
typedef unsigned u32x4 __attribute__((ext_vector_type(4)));
template <class A, class Bt> struct same_t { static constexpr bool v = false; };
template <class A> struct same_t<A, A> { static constexpr bool v = true; };
#define KSWZ(row, colB) ((row) * 256 + ((colB) ^ (((row) & 7) << 4)))
#define SBAR() __builtin_amdgcn_sched_barrier(0)
__device__ __forceinline__ int v_st(int k, int c) { const int kk = (k & ~0xC) | ((k & 4) << 1) | ((k & 8) >> 1); return ((kk >> 3) * 4 + (c >> 5)) * 512 + ((kk & 7) * 32 + (c & 31)) * 2; }
__device__ __forceinline__ int v_rd_base(int lane) { return ((lane & 3) << 3) | (((lane >> 2) & 3) << 6) | (((lane >> 4) & 1) << 5) | (((lane >> 5) & 1) << 8); }
constexpr int v_rd_off(int d0, int ks, int half) { return d0 * 512 + ks * 4096 + half * 2048; }
__device__ __forceinline__ int crow(int r, int hi) { return (r & 3) + 8 * (r >> 2) + 4 * hi; }
__device__ __forceinline__ unsigned cvtpk(float lo, float hi) {
    unsigned r; asm volatile("v_cvt_pk_bf16_f32 %0, %1, %2" : "=v"(r) : "v"(lo), "v"(hi)); return r;
}
__device__ __forceinline__ bf16x8 pack8(f32x4 a, f32x4 b) {
    u32x4 w = {cvtpk(a[0], a[1]), cvtpk(a[2], a[3]), cvtpk(b[0], b[1]), cvtpk(b[2], b[3])};
    return *reinterpret_cast<bf16x8*>(&w);
}
template <class T> __device__ __forceinline__ bf16x8 load8(const T* p) {
    if constexpr (same_t<T, float>::v) { return pack8(*(const f32x4*)p, *(const f32x4*)(p + 4)); }
    else { return *reinterpret_cast<const bf16x8*>(p); }
}
__device__ __forceinline__ void mask_tile(f32x16& p0, f32x16& p1, int dq, unsigned W) {
    const float NEG = -__builtin_inff();
#pragma unroll
    for (int r = 0; r < 16; ++r) {
        const int c = (r & 3) + 8 * (r >> 2);
        if ((unsigned)(dq - c) >= W) p0[r] = NEG;
        if ((unsigned)(dq - c - 32) >= W) p1[r] = NEG;
    }
}
__device__ __forceinline__ void partialSM(f32x16& p0, f32x16& p1, float& m_reg, float& mn, float& alpha) {
    float pmax = p0[0]; for (int r = 1; r < 16; ++r) pmax = fmaxf(pmax, p0[r]); for (int r = 0; r < 16; ++r) pmax = fmaxf(pmax, p1[r]);
    { auto rr = __builtin_amdgcn_permlane32_swap(__float_as_uint(pmax), __float_as_uint(pmax), false, false);
      pmax = fmaxf(__uint_as_float(rr[0]), __uint_as_float(rr[1])); }
    constexpr float C2 = 1.4426950408889634f * SCALE;
    if (__builtin_expect(__all((pmax - m_reg) * SCALE <= THR), 1)) { mn = m_reg; alpha = 1.f; }
    else { mn = fmaxf(m_reg, pmax); alpha = __builtin_amdgcn_exp2f((m_reg - mn) * C2); m_reg = mn; }
    const float mnL = -mn * C2;
    for (int r = 0; r < 16; ++r) p0[r] = fmaf(p0[r], C2, mnL); for (int r = 0; r < 16; ++r) p1[r] = fmaf(p1[r], C2, mnL);
    for (int r = 0; r < 16; ++r) p0[r] = __builtin_amdgcn_exp2f(p0[r]);
}
__device__ __forceinline__ void finishSM(f32x16& p0, f32x16& p1, float alpha, float& l_reg, bf16x8& pa0, bf16x8& pa1, bf16x8& pa2, bf16x8& pa3) {
    for (int r = 0; r < 16; ++r) p1[r] = __builtin_amdgcn_exp2f(p1[r]);
    float ps = 0; for (int r = 0; r < 16; ++r) ps += p0[r]; for (int r = 0; r < 16; ++r) ps += p1[r];
    { auto rr = __builtin_amdgcn_permlane32_swap(__float_as_uint(ps), __float_as_uint(ps), false, false);
      ps = __uint_as_float(rr[0]) + __uint_as_float(rr[1]); }
    l_reg = l_reg * alpha + ps;
#define PK4(P, B_, OUT) do { unsigned a0 = cvtpk(P[B_+0], P[B_+1]), a1 = cvtpk(P[B_+2], P[B_+3]);                          \
        unsigned b0 = cvtpk(P[B_+4], P[B_+5]), b1 = cvtpk(P[B_+6], P[B_+7]);                                             \
        auto r0 = __builtin_amdgcn_permlane32_swap(a0, b0, false, false); auto r1 = __builtin_amdgcn_permlane32_swap(a1, b1, false, false); \
        u32x4 w = {r0[0], r1[0], r0[1], r1[1]}; OUT = *reinterpret_cast<bf16x8*>(&w); } while (0)
    PK4(p0, 0, pa0); PK4(p0, 8, pa1); PK4(p1, 0, pa2); PK4(p1, 8, pa3);
#undef PK4
}
template <int KB, bool SK>
__device__ __forceinline__ void qkt(f32x16& p0, f32x16& p1, const char* K_lds, int r32, int hi, const bf16x8* qr, bool act) {
    if (SK && !act) { const float NEG = -__builtin_inff();
#pragma unroll
        for (int r = 0; r < 16; ++r) { p0[r] = NEG; p1[r] = NEG; } return; }
    p0 = f32x16{}; p1 = f32x16{};
    const char* kb[4];
#pragma unroll
    for (int dd = 0; dd < 4; ++dd) kb[dd] = K_lds + KB * SHM_K + KSWZ(r32, (dd * 16 + hi * 8) * 2);
#pragma unroll
    for (int d0 = 0; d0 < 8; ++d0) { const char* a = kb[d0 & 3] + (d0 >> 2) * 128;
        bf16x8 b0 = *reinterpret_cast<const bf16x8*>(a);
        bf16x8 b1 = *reinterpret_cast<const bf16x8*>(a + 32 * 256);
        p0 = __builtin_amdgcn_mfma_f32_32x32x16_bf16(b0, qr[d0], p0, 0, 0, 0);
        p1 = __builtin_amdgcn_mfma_f32_32x32x16_bf16(b1, qr[d0], p1, 0, 0, 0); }
}
template <int VB, bool SK>
__device__ __forceinline__ void pv_tile(f32x16* o, int vb0, bf16x8 pa0, bf16x8 pa1, bf16x8 pa2, bf16x8 pa3, bool act) {
    if (SK && !act) return;
#define TRRD(dst, off) asm volatile("ds_read_b64_tr_b16 %0, %1 offset:%2" : "=&v"(dst) : "v"(vb0), "i"(off) : "memory")
#define PV_D0(d0) do { s16x4 l0, l1, l2, l3, h0, h1, h2, h3; constexpr int b_ = VB * SHM_V + v_rd_off(d0, 0, 0);     \
        TRRD(l0, b_); TRRD(h0, b_ + 2048); TRRD(l1, b_ + 4096); TRRD(h1, b_ + 6144); TRRD(l2, b_ + 8192); TRRD(h2, b_ + 10240); TRRD(l3, b_ + 12288); TRRD(h3, b_ + 14336); \
        asm volatile("s_waitcnt lgkmcnt(0)" ::: "memory"); SBAR();                 \
        o[d0] = __builtin_amdgcn_mfma_f32_32x32x16_bf16(pa0, (bf16x8){l0[0], l0[1], l0[2], l0[3], h0[0], h0[1], h0[2], h0[3]}, o[d0], 0, 0, 0);   \
        o[d0] = __builtin_amdgcn_mfma_f32_32x32x16_bf16(pa1, (bf16x8){l1[0], l1[1], l1[2], l1[3], h1[0], h1[1], h1[2], h1[3]}, o[d0], 0, 0, 0);   \
        o[d0] = __builtin_amdgcn_mfma_f32_32x32x16_bf16(pa2, (bf16x8){l2[0], l2[1], l2[2], l2[3], h2[0], h2[1], h2[2], h2[3]}, o[d0], 0, 0, 0);   \
        o[d0] = __builtin_amdgcn_mfma_f32_32x32x16_bf16(pa3, (bf16x8){l3[0], l3[1], l3[2], l3[3], h3[0], h3[1], h3[2], h3[3]}, o[d0], 0, 0, 0); } while (0)
    PV_D0(0); PV_D0(1); PV_D0(2); PV_D0(3);
#undef PV_D0
#undef TRRD
}

struct BlockRef { const bf16* Q; const bf16* K; const bf16* V; bf16* O; float* LSE; int QS, KS, OS, LS, P0, skv, W; };
struct Seam { bf16x8 qr[8]; bf16x8 st_v0, st_v1, st_k0, st_k1; };
__device__ __forceinline__ int swa_jlo(int P0, int W) { const int lowk = P0 - W + 1; return lowk > 0 ? lowk / KVBLK : 0; }
#define LD8(p) (*reinterpret_cast<const bf16x8*>(p))
#define ROW(p, k0, rr, RS) ((p) + (size_t)((k0) + (rr)) * (RS) + sc)
#define VMW() asm volatile("s_waitcnt vmcnt(0)" ::: "memory")
#define VMWN(n) asm volatile("s_waitcnt vmcnt(%0)" :: "i"(n) : "memory")
#define SLOAD_H(Kp, Vp, k0, RS) do { const char* kb_ = (const char*)(Kp) + (size_t)(k0) * (size_t)(RS) * 2; const char* vb_ = (const char*)(Vp) + (size_t)(k0) * (size_t)(RS) * 2;  \
                         const unsigned oa_ = (unsigned)(sr * (RS) + sc) * 2u, ob_ = oa_ + (unsigned)(RS) * 64u;                                    \
                         S.st_v0 = LD8(vb_ + oa_); S.st_v1 = LD8(vb_ + ob_); S.st_k0 = LD8(kb_ + oa_); S.st_k1 = LD8(kb_ + ob_); } while (0)
#define SWRITE_HK(bf) do { *(bf16x8*)(K_lds + (bf) * SHM_K + kws) = S.st_k0; *(bf16x8*)(K_lds + (bf) * SHM_K + kws + 32 * 256) = S.st_k1; } while (0)
#define SWRITE_HV(bf) do { *(bf16x8*)(V_lds + (bf) * SHM_V + vst0) = S.st_v0; *(bf16x8*)(V_lds + (bf) * SHM_V + vst1) = S.st_v1; } while (0)
#define SWRITE_H(bf) do { SWRITE_HV(bf); SWRITE_HK(bf); } while (0)
__device__ __forceinline__ void swa_prime(const BlockRef& cur, char* lds, Seam& S) {
    int tid_ = threadIdx.x; asm volatile("" : "+v"(tid_));
    const int tid = tid_, wid = __builtin_amdgcn_readfirstlane(tid >> 6), lane = tid & 63, r32 = lane & 31, hi = lane >> 5;
    const int sr = tid >> 4, sc = (tid & 15) * 8, kws = KSWZ(sr, sc * 2); char* K_lds = lds + 2 * SHM_V;
    const int kb0 = swa_jlo(cur.P0, cur.W) * KVBLK;
    { const char* qb_ = (const char*)cur.Q + (size_t)(wid * QBLK) * (size_t)cur.QS * 2; const unsigned qo_ = (unsigned)(r32 * cur.QS + hi * 8) * 2u;
      for (int d0 = 0; d0 < 8; ++d0) S.qr[d0] = LD8(qb_ + qo_ + d0 * 32); }
    SLOAD_H(cur.K, cur.V, kb0, cur.KS); VMW(); SWRITE_HK(0);
    __syncthreads();
}
__device__ __forceinline__ void swa_block(const BlockRef& cur, const BlockRef& nxt, char* lds, Seam& S) {
    int tid_ = threadIdx.x; asm volatile("" : "+v"(tid_));
    const int tid = tid_, wid = __builtin_amdgcn_readfirstlane(tid >> 6), lane = tid & 63, r32 = lane & 31, hi = lane >> 5;
    const int W = cur.W, skv = cur.skv;
    const int j_lo = swa_jlo(cur.P0, W);
    int j_hi = (cur.P0 + QB - 1) / KVBLK + 1; if (j_hi > skv / KVBLK) j_hi = skv / KVBLK;
    const int NT = j_hi - j_lo;
    const int kbn = swa_jlo(nxt.P0, nxt.W) * KVBLK;
    const int qlo = cur.P0 + wid * QBLK, qm = qlo + r32 - 4 * hi;
    char* V_lds = lds; char* K_lds = lds + 2 * SHM_V;
    float* ws = (float*)(lds + 2 * SHM_V + 2 * SHM_K) + wid * 64; float* li_l = ws, * al_l = ws + 32;
    float m_reg = -1e30f, l_reg = 0; f32x16 o[4] = {};
    const int sr = tid >> 4, sc = (tid & 15) * 8, vst0 = v_st(sr, sc), vst1 = v_st(32 + sr, sc), kws = KSWZ(sr, sc * 2);
    const int vb0 = (int)(uintptr_t)V_lds + v_rd_base(lane);
    const bf16* Kh = cur.K; const bf16* Vh = cur.V; const int KSc = cur.KS;
#define RESC(a) do { if (__any((a) < 1.f)) { if (hi == 0) al_l[r32] = (a); asm volatile("s_waitcnt lgkmcnt(0)" ::: "memory");              \
                     for (int d_ = 0; d_ < 4; ++d_) for (int r = 0; r < 16; ++r) o[d_][r] *= al_l[crow(r, hi)]; } } while (0)
#define KBASE(t) ((j_lo + (t)) * KVBLK)
#define ACT(t) (KBASE(t) <= qlo + QBLK - 1 && KBASE(t) + KVBLK - 1 >= qlo - W + 1)
#define MASKT(P0_, P1_, t) do { const int kb_ = KBASE(t); if ((!SK || ACT(t)) && (kb_ + KVBLK - 1 > qlo || kb_ <= qlo + QBLK - 1 - W)) mask_tile(P0_, P1_, qm - kb_, (unsigned)W); } while (0)
    constexpr int NQL = 8;
    constexpr bool SK = true;
#define SEAM_K0() do { VMWN(NQL); SWRITE_HK(0); SBAR(); } while (0)
    f32x16 pA0, pA1, pB0, pB1; float mnA, mnB, alA, alB; bf16x8 pa0, pa1, pa2, pa3;
    SWRITE_HV(0); SBAR();
    if (NT > 1) { SLOAD_H(Kh, Vh, KBASE(1), KSc); }
    SBAR(); qkt<0, SK>(pA0, pA1, K_lds, r32, hi, S.qr, ACT(0));
    MASKT(pA0, pA1, 0); partialSM(pA0, pA1, m_reg, mnA, alA);
    if (NT > 1) { VMW(); SWRITE_H(1); }
    __syncthreads();
#define HALF_STEP(PX0, PX1, mnX, alX, PY0, PY1, alY, t, KB, VB, SB) do {                                                      \
        if ((t) + 1 < NT) { SLOAD_H(Kh, Vh, KBASE((t) + 1), KSc); }     \
        SBAR(); qkt<KB, SK>(PX0, PX1, K_lds, r32, hi, S.qr, ACT(t));                                             \
        finishSM(PY0, PY1, alY, l_reg, pa0, pa1, pa2, pa3); SBAR();                                                           \
        pv_tile<VB, SK>(o, vb0, pa0, pa1, pa2, pa3, ACT((t) - 1)); MASKT(PX0, PX1, (t)); partialSM(PX0, PX1, m_reg, mnX, alX);                                        \
        __syncthreads();                                                                                                      \
        if ((t) + 1 < NT) { VMW(); SWRITE_H(SB); }                                                                          \
        RESC(alX); __syncthreads(); } while (0)
    for (int t = 1; t + 1 < NT; t += 2) {
        HALF_STEP(pB0, pB1, mnB, alB, pA0, pA1, alA, t, 1, 0, 0);
        HALF_STEP(pA0, pA1, mnA, alA, pB0, pB1, alB, t + 1, 0, 1, 1);
    }
    const bool even = (NT & 1) == 0;
    if (even) { SBAR(); qkt<1, SK>(pB0, pB1, K_lds, r32, hi, S.qr, ACT(NT - 1)); SBAR(); }
    { SLOAD_H(nxt.K, nxt.V, kbn, nxt.KS); SBAR();
      const char* qb_ = (const char*)nxt.Q + (size_t)(wid * QBLK) * (size_t)nxt.QS * 2; const unsigned qo_ = (unsigned)(r32 * nxt.QS + hi * 8) * 2u;
#pragma unroll
        for (int d0 = 0; d0 < 8; ++d0) S.qr[d0] = LD8(qb_ + qo_ + d0 * 32); }
    SBAR();
    finishSM(pA0, pA1, alA, l_reg, pa0, pa1, pa2, pa3); SBAR();
    pv_tile<0, SK>(o, vb0, pa0, pa1, pa2, pa3, ACT(even ? NT - 2 : NT - 1));
    if (even) { MASKT(pB0, pB1, NT - 1); partialSM(pB0, pB1, m_reg, mnB, alB); __syncthreads(); RESC(alB);
        finishSM(pB0, pB1, alB, l_reg, pa0, pa1, pa2, pa3); SBAR(); pv_tile<1, SK>(o, vb0, pa0, pa1, pa2, pa3, ACT(NT - 1)); }
    SBAR(); SEAM_K0();
    if (hi == 0) li_l[r32] = l_reg; asm volatile("s_waitcnt lgkmcnt(0)" ::: "memory");
    if (cur.LSE != nullptr && hi == 0) cur.LSE[(size_t)(wid * QBLK + r32) * cur.LS] = __log2f(l_reg) + m_reg * (1.4426950408889634f * SCALE);
    float rli[16];
#pragma unroll
    for (int r = 0; r < 16; ++r) rli[r] = __builtin_amdgcn_rcpf(li_l[crow(r, hi)]);
    bf16* Ow = cur.O + (size_t)(wid * QBLK) * cur.OS;
#pragma unroll
    for (int r = 0; r < 16; ++r) { const int orow = crow(r, hi);
#pragma unroll
        for (int d0 = 0; d0 < 4; ++d0) { const float v = o[d0][r] * rli[r];
            const float vn = __builtin_bit_cast(float, __builtin_amdgcn_update_dpp(0, __builtin_bit_cast(int, v), 0xB1, 0xF, 0xF, true));
            if ((r32 & 1) == 0) *(unsigned*)(Ow + (size_t)orow * cur.OS + d0 * 32 + r32) = cvtpk(v, vn); } }
    __syncthreads();
#undef RESC
#undef KBASE
#undef ACT
#undef MASKT
#undef SEAM_K0
#undef HALF_STEP
}
#undef LD8
#undef ROW
#undef VMW
#undef VMWN
#undef SLOAD_H
#undef SWRITE_HK
#undef SWRITE_HV
#undef SWRITE_H
#undef KSWZ
#undef SBAR
}

constexpr int NWAVES = 8;
#ifndef MK_N_LAUNCHES
#define MK_N_LAUNCHES 1
#endif
constexpr int N_PHASES = 13;
constexpr float W8_SCALE = 32.0f, H8_SCALE = 8.0f;
constexpr int SC_ONE = 0x7f7f7f7f, SC_W8 = 0x7a7a7a7a  , SC_H8 = 0x7c7c7c7c  , SC_M8 = MRG_FP8 ? 0x7b7b7b7b   : 0x7f7f7f7f;
#ifndef NAIVE_ATTN
#define NAIVE_ATTN 0
#endif
constexpr float ATT_QSCALE = NAIVE_ATTN ? QSCALE : 1.0f;

constexpr size_t MiB = 1u << 20;
constexpr size_t WS_CTL = 0, CTL_ZERO_BYTES = 128 * 1024;
constexpr size_t WS_WIN = 2 * MiB;
constexpr size_t WS_WB = 24 * MiB;
constexpr size_t WS_WO = 27 * MiB;
constexpr size_t WS_WMEM = WS_WIN + (size_t)9984 * 1024 * 2;
constexpr size_t WS_W1 = 29 * MiB;
constexpr size_t WS_W2 = 157 * MiB;
constexpr size_t WS_XN = 221 * MiB;
constexpr size_t WS_Z = 256 * MiB;
constexpr size_t WS_RW = 568 * MiB;
constexpr size_t WS_YS = 792 * MiB;
constexpr size_t WS_YABC = 824 * MiB;
constexpr size_t WS_MRG = 872 * MiB;
constexpr size_t WS_MRGB = 936 * MiB;
constexpr size_t WS_MEMN = WS_XN + (size_t)16384 * 1024 * 2;
constexpr size_t WS_KVM = 969 * MiB;
constexpr size_t WS_XN2 = 970 * MiB;
constexpr size_t WS_ROUTE = 1002 * MiB;
constexpr size_t WS_LORA = 1004 * MiB;
constexpr size_t WS_END = 1005 * MiB;
constexpr size_t WS_XS = 256 * MiB;
constexpr size_t WS_HACT = 400 * MiB;
constexpr size_t WS_YROWS = 544 * MiB;
constexpr size_t WS_OP = WS_MRG;
constexpr size_t WS_LSE = WS_MRGB;
constexpr size_t WS_CS = WS_RW;
constexpr size_t WS_VMIX = WS_RW + 32 * MiB, WS_GMIX = WS_RW + 64 * MiB;
constexpr size_t WS_XN8 = WS_YS, WS_WIN8 = WS_YS + 16 * MiB;
constexpr size_t RWSZ = (size_t)MTOK * RW * 4;
constexpr size_t RT_TOPI = 0, RT_TOPG = 256 * 1024, RT_POS = 512 * 1024, RT_ROWGATE = 768 * 1024;
static_assert(RT_ROWGATE + (size_t)MAX_SLOTS * 4 <= 1088 * 1024, "route");
constexpr int CW_TMO = 0, CW_CODE = 1;
constexpr int CW_BAR = 4096;
constexpr int CW_CNT = 16384;
constexpr int CW_CUR = 16384 + 2048; static_assert((16384 + 2048 + 32 * 64) * 4 <= 128 * 1024, "control words inside the per-call memset");

constexpr int RING_OFF = 0, RING_BYTES = 131072;
constexpr int LDSCTL_OFF = 143360, MISC_OFF = LDSCTL_OFF + 320;
constexpr int MOETAB_OFF = MISC_OFF + 128;
constexpr int HIST_OFF = MOETAB_OFF + 1536;
constexpr int LDS_BYTES = 147456;
static_assert(HIST_OFF + 4 * 320 <= LDS_BYTES, "LDS map");
#define GAS __attribute__((address_space(1)))
#define LAS __attribute__((address_space(3)))
typedef unsigned short bf16;
typedef unsigned v4u __attribute__((ext_vector_type(4)));
typedef float f32x4 __attribute__((ext_vector_type(4)));
typedef short bf16x8 __attribute__((ext_vector_type(8)));
typedef GAS unsigned gu32;
typedef GAS unsigned long long gu64;
#define RLX_AGENT __ATOMIC_RELAXED, __HIP_MEMORY_SCOPE_AGENT
#define LDS_WAIT() asm volatile("s_waitcnt lgkmcnt(0)" ::: "memory")
#define VM_WAIT() asm volatile("s_waitcnt vmcnt(0)" ::: "memory")
__device__ __forceinline__ unsigned long long rt() { return __builtin_amdgcn_s_memrealtime(); }
typedef float f32x2_cv __attribute__((ext_vector_type(2))); typedef __bf16 bf16x2_cv __attribute__((ext_vector_type(2)));
__device__ __forceinline__ unsigned pk2(float lo, float hi) { f32x2_cv v = {lo, hi}; bf16x2_cv b = __builtin_convertvector(v, bf16x2_cv); return __builtin_bit_cast(unsigned, b); }
__device__ __forceinline__ unsigned f2bf(float f) { return pk2(f, f) & 0xffffu; }
#define XB_TMO      128
#define XB_XCNT(j)  (256  + 64 * (j))
#define XB_XSUB(j)  (1280 + 64 * (j))
#define XB_XGEN(j)  (2304 + 64 * (j))
#define XB_TOP      3328
#define XB_TOPGEN   3392
#define XCD_BAR_WORDS 3456
#define XB_SPIN_CAP (1u << 18)

__device__ __forceinline__ unsigned xb_ld(unsigned* p)              { return __hip_atomic_load(p, __ATOMIC_RELAXED, __HIP_MEMORY_SCOPE_AGENT); }
__device__ __forceinline__ unsigned xb_add(unsigned* p, unsigned v) { return __hip_atomic_fetch_add(p, v, __ATOMIC_RELAXED, __HIP_MEMORY_SCOPE_AGENT); }
__device__ __forceinline__ unsigned xb_xcc_id() { return (unsigned)__builtin_amdgcn_s_getreg((3 << 11) | 20) & 0xFu; }
#define XB_SPIN(cond, bar) do { unsigned _sp = 0; while (cond) { __builtin_amdgcn_s_sleep(1); \
    if ((++_sp & 255u) == 0u) { if (xb_ld(&(bar)[XB_TMO])) break; if (_sp > XB_SPIN_CAP) { atomicAdd(&(bar)[XB_TMO], 1u); break; } } } } while (0)

struct XcdBarrier {
    unsigned* bar; unsigned x;
    volatile LAS unsigned* st;
};

__device__ __forceinline__ XcdBarrier xcd_barrier_post(unsigned* bar, volatile LAS unsigned* st) {
    XcdBarrier b; b.bar = bar; b.x = xb_xcc_id(); b.st = st;
    if (threadIdx.x == 0) (void)xb_add(&bar[XB_XCNT(b.x)], 1u);
    return b;
}
__device__ __forceinline__ void xcd_barrier_complete(unsigned* bar, unsigned x, unsigned& nloc, unsigned& nx) {
    const unsigned G = gridDim.x * gridDim.y * gridDim.z;
    unsigned sum, cnt, mine, sp = 0u;
    for (;;) {
        sum = 0u; cnt = 0u; mine = 0u;
#pragma unroll
        for (unsigned j = 0; j < 16; ++j) { const unsigned c = xb_ld(&bar[XB_XCNT(j)]); sum += c; cnt += (c > 0u) ? 1u : 0u; mine = (j == x) ? c : mine; }
        if (sum == G) break;
        __builtin_amdgcn_s_sleep(1);
        if ((++sp & 255u) == 0u) { if (xb_ld(&bar[XB_TMO])) break; if (sp > XB_SPIN_CAP) { atomicAdd(&bar[XB_TMO], 1u); break; } }
    }
    nloc = mine > 0u ? mine : 1u; nx = cnt > 0u ? cnt : 1u;
}

__device__ __forceinline__ void xcd_barrier(const XcdBarrier& b) {
    asm volatile("s_waitcnt vmcnt(0)" ::: "memory");
    __syncthreads();
    if (threadIdx.x == 0) {
        unsigned* bar = b.bar;
        __builtin_amdgcn_s_waitcnt(0);
        unsigned nloc = b.st[0], nx = b.st[1];
        if (nloc == 0u) { xcd_barrier_complete(bar, b.x, nloc, nx); b.st[0] = nloc; b.st[1] = nx; }
        const unsigned old = xb_add(&bar[XB_XSUB(b.x)], 1u);
        const unsigned gen = old / nloc;
        if (old + 1u == (gen + 1u) * nloc) {
            __builtin_amdgcn_fence(__ATOMIC_RELEASE, "agent");
            asm volatile("s_waitcnt vmcnt(0)" ::: "memory");
            const unsigned og = xb_add(&bar[XB_TOP], 1u);
            const unsigned tg = og / nx;
            if (og + 1u == (tg + 1u) * nx) xb_add(&bar[XB_TOPGEN], 1u);
            else XB_SPIN(xb_ld(&bar[XB_TOPGEN]) == tg, bar);
            __builtin_amdgcn_fence(__ATOMIC_ACQUIRE, "agent");
            xb_add(&bar[XB_XGEN(b.x)], 1u);
            asm volatile("s_waitcnt vmcnt(0)" ::: "memory");
        } else {
            XB_SPIN(xb_ld(&bar[XB_XGEN(b.x)]) == gen, bar);
            __builtin_amdgcn_fence(__ATOMIC_ACQUIRE, "agent");
            asm volatile("s_waitcnt vmcnt(0)" ::: "memory");
        }
    }
    __syncthreads();
}

typedef float f32x2 __attribute__((ext_vector_type(2)));
struct Args { const float* in[32]; float* out; unsigned char* ws; int ph_lo, ph_hi, use_bar, pad; };
struct Frame {
    LAS unsigned char* lds;
    volatile LAS unsigned* MISC;
    gu32* ctl;
    int tid, lane, wave;
    int vcu, G;
    float* out;
    unsigned char* ws;
};
enum { I_X = 0, I_MEM, I_POS, I_NORM_MIX, I_W_IN, I_B_GATE, I_AQ_GAIN, I_AK_GAIN, I_R_MU, I_R_W0, I_R_W2, I_R_A0, I_R_A2, I_R_G2, I_R_KK, I_R_KA, I_R_RK, I_R_LNW, I_R_LNB,
       I_MEM_NORM, I_W_MEMKV, I_CQ_GAIN, I_CK_GAIN, I_W_BRANCH, I_W_OUT, I_NORM_FFN, I_ROUTER_W, I_ROUTER_B, I_EXP_W1, I_EXP_B1, I_EXP_W2, I_EXP_B2 };

__device__ __forceinline__ bool phase_enter(Frame& F, bool on) { int t = (int)threadIdx.x; asm volatile("" : "+v"(t)); F.tid = t; F.lane = t & 63; F.wave = __builtin_amdgcn_readfirstlane(t >> 6); return on; }
__device__ __forceinline__ const float* ldarg(int i) {
    const __attribute__((address_space(4))) char* ka = (const __attribute__((address_space(4))) char*)__builtin_amdgcn_kernarg_segment_ptr();
    asm volatile("" : "+s"(ka));
    return *(const float* const __attribute__((address_space(4)))*)(ka + 8 * i);
}
__device__ __forceinline__ unsigned pk4_fp8(float a, float b, float c, float d) { unsigned w = 0; w = __builtin_amdgcn_cvt_pk_fp8_f32(a, b, w, false); w = __builtin_amdgcn_cvt_pk_fp8_f32(c, d, w, true); return w; }
__device__ __forceinline__ float fast_sigm(float x) { return __builtin_amdgcn_rcpf(1.0f + __builtin_amdgcn_exp2f(-1.4426950408889634f * x)); }
__device__ __forceinline__ float fast_tanh(float x) { return 1.0f - 2.0f * __builtin_amdgcn_rcpf(1.0f + __builtin_amdgcn_exp2f(2.8853900817779268f * x)); }
__device__ __forceinline__ float fast_softplus(float y) { return fmaxf(y, 0.f) + 0.6931471805599453f * __builtin_amdgcn_logf(1.0f + __builtin_amdgcn_exp2f(-1.4426950408889634f * fabsf(y))); }
__device__ __forceinline__ int opq(int x) { asm volatile("" : "+v"(x)); return x; }
__device__ __forceinline__ float bf_lo(unsigned w) { return __builtin_bit_cast(float, w << 16); }
__device__ __forceinline__ float bf_hi(unsigned w) { return __builtin_bit_cast(float, w & 0xffff0000u); }
__device__ __forceinline__ float sigm(float x) { return 1.0f / (1.0f + __expf(-x)); }
template <int CTRL, int RM> __device__ __forceinline__ float dpp0(float v) {
    return __builtin_bit_cast(float, __builtin_amdgcn_update_dpp(0, __builtin_bit_cast(int, v), CTRL, RM, 0xf, true)); }
__device__ __forceinline__ float row16_sum(float v) {
    v += dpp0<0xB1, 0xf>(v); v += dpp0<0x4E, 0xf>(v); v += dpp0<0x141, 0xf>(v); v += dpp0<0x140, 0xf>(v); return v; }
__device__ __forceinline__ float rdlane(float v, int l) { return __builtin_bit_cast(float, __builtin_amdgcn_readlane(__builtin_bit_cast(int, v), l)); }
__device__ __forceinline__ float wave_sum(float v) {
    v = row16_sum(v); v += dpp0<0x142, 0xA>(v); v += dpp0<0x143, 0xC>(v); return rdlane(v, 63); }
__device__ __forceinline__ void half_sums(float v, float& lo, float& hi) {
    v = row16_sum(v); v += dpp0<0x142, 0xA>(v); lo = rdlane(v, 31); hi = rdlane(v, 63); }
__device__ __forceinline__ float wave_max_bp(float v) {
#pragma unroll
    for (int o = 1; o < 64; o <<= 1) v = fmaxf(v, __shfl_xor(v, o));
    return v; }

__device__ __forceinline__ void tconv_tile(const float* W, int K, int N, bf16* WT, int k0, int n0, int rowbase, int lane, int kd = 0) {
    const int c = lane & 15, q = lane >> 4;
    const GAS f32x4* src = (const GAS f32x4*)(W + (size_t)(k0 + 16 * q) * N + n0 + 4 * c);
    const size_t rs = (size_t)N / 4;
    f32x4 v[16];
#pragma unroll
    for (int i = 0; i < 16; ++i) v[i] = __builtin_nontemporal_load(src + i * rs);
#pragma unroll
    for (int j = 0; j < 4; ++j) {
        GAS v4u* dst = (GAS v4u*)(WT + (size_t)(rowbase + 4 * c + j) * K + kd + k0 + 16 * q);
        v4u o0, o1;
        o0.x = pk2(v[0][j], v[1][j]); o0.y = pk2(v[2][j], v[3][j]); o0.z = pk2(v[4][j], v[5][j]); o0.w = pk2(v[6][j], v[7][j]);
        o1.x = pk2(v[8][j], v[9][j]); o1.y = pk2(v[10][j], v[11][j]); o1.z = pk2(v[12][j], v[13][j]); o1.w = pk2(v[14][j], v[15][j]);
        dst[0] = o0; dst[1] = o1;
    }
}
__device__ __forceinline__ void tconv_tile128(const float* W, int K, int N, bf16* WT, int k0, int n0, int rowbase, int lane) {
    const int c = lane & 31, q = lane >> 5;
    const GAS f32x4* src = (const GAS f32x4*)(W + (size_t)(k0 + 32 * q) * N + n0 + 4 * c);
    const size_t rs = (size_t)N / 4;
    f32x4 v[32];
#pragma unroll
    for (int i = 0; i < 32; ++i) v[i] = src[i * rs];
#pragma unroll
    for (int j = 0; j < 4; ++j) {
        GAS v4u* dst = (GAS v4u*)(WT + (size_t)(rowbase + 4 * c + j) * K + k0 + 32 * q);
#pragma unroll
        for (int g = 0; g < 4; ++g) { v4u o; o.x = pk2(v[8 * g][j], v[8 * g + 1][j]); o.y = pk2(v[8 * g + 2][j], v[8 * g + 3][j]); o.z = pk2(v[8 * g + 4][j], v[8 * g + 5][j]); o.w = pk2(v[8 * g + 6][j], v[8 * g + 7][j]); dst[g] = o; }
    }
}
__device__ __forceinline__ void tconv_tile_f8(const float* W, int K, int N, unsigned char* WT, int k0, int n0, int rowbase, int lane, float sc) {
    const int c = lane & 15, q = lane >> 4;
    const GAS f32x4* src = (const GAS f32x4*)(W + (size_t)(k0 + 16 * q) * N + n0 + 4 * c);
    const size_t rs = (size_t)N / 4;
    f32x4 v[16];
#pragma unroll
    for (int i = 0; i < 16; ++i) v[i] = __builtin_nontemporal_load(src + i * rs) * sc;
#pragma unroll
    for (int j = 0; j < 4; ++j) {
        v4u o; o.x = pk4_fp8(v[0][j], v[1][j], v[2][j], v[3][j]); o.y = pk4_fp8(v[4][j], v[5][j], v[6][j], v[7][j]); o.z = pk4_fp8(v[8][j], v[9][j], v[10][j], v[11][j]); o.w = pk4_fp8(v[12][j], v[13][j], v[14][j], v[15][j]);
        *(GAS v4u*)(WT + (size_t)(rowbase + 4 * c + j) * K + k0 + 16 * q) = o;
    }
}
__device__ __forceinline__ void tc8_load(const float* W, int N, int k0, int n0, int lane, f32x4 (&v)[16]) {
    const int c = lane & 15, q = lane >> 4; const GAS f32x4* src = (const GAS f32x4*)(W + (size_t)(k0 + 16 * q) * N + n0 + 4 * c); const size_t rs = (size_t)N / 4;
#pragma unroll
    for (int i = 0; i < 16; ++i) v[i] = src[i * rs];
}
__device__ __forceinline__ void tc8_load_nt(const float* W, int N, int k0, int n0, int lane, f32x4 (&v)[16]) {
    const int c = lane & 15, q = lane >> 4; const GAS f32x4* src = (const GAS f32x4*)(W + (size_t)(k0 + 16 * q) * N + n0 + 4 * c); const size_t rs = (size_t)N / 4;
#pragma unroll
    for (int i = 0; i < 16; ++i) v[i] = __builtin_nontemporal_load(src + i * rs);
}
__device__ __forceinline__ void tc8_store(unsigned char* WT, int K, int k0, int rowbase, int lane, const f32x4 (&v)[16], float sc) {
    const int c = lane & 15, q = lane >> 4;
#pragma unroll
    for (int j = 0; j < 4; ++j) {
        v4u o; o.x = pk4_fp8(v[0][j] * sc, v[1][j] * sc, v[2][j] * sc, v[3][j] * sc); o.y = pk4_fp8(v[4][j] * sc, v[5][j] * sc, v[6][j] * sc, v[7][j] * sc);
        o.z = pk4_fp8(v[8][j] * sc, v[9][j] * sc, v[10][j] * sc, v[11][j] * sc); o.w = pk4_fp8(v[12][j] * sc, v[13][j] * sc, v[14][j] * sc, v[15][j] * sc);
        *(GAS v4u*)(WT + (size_t)(rowbase + 4 * c + j) * K + k0 + 16 * q) = o; }
}
__device__ __forceinline__ void w1_tile(int r, const float* W1, unsigned char* W1T, const float*& W, unsigned char*& WT, int& k0, int& n0, int& rowbase) {
    const int e = r / 512, q = r % 512, kb = q % 16, nb = q / 16; n0 = 64 * nb; k0 = 64 * kb;
    rowbase = (n0 < 1024) ? ((n0 >> 7) * 256 + (n0 & 127)) : ((((n0 - 1024) >> 7) * 256) + 128 + ((n0 - 1024) & 127));
    W = W1 + (size_t)e * 1024 * 2048; WT = W1T + (size_t)e * 2048 * 1024;
}
__device__ __forceinline__ void rms_row_to_bf16(const float* xrow, const float* gain, bf16* orow, int lane, unsigned char* orow8 = nullptr) {
    const GAS f32x4* xr = (const GAS f32x4*)xrow + lane; const GAS f32x4* gr = (const GAS f32x4*)gain + lane;
    f32x4 v[4]; float s = 0.f;
#pragma unroll
    for (int j = 0; j < 4; ++j) { v[j] = xr[64 * j]; s += (v[j].x * v[j].x + v[j].y * v[j].y) + (v[j].z * v[j].z + v[j].w * v[j].w); }
    const float rstd = 1.0f / sqrtf(wave_sum(s) * (1.f / D_MODEL) + NORM_EPS);
    GAS unsigned long long* o8 = (GAS unsigned long long*)orow + lane;
#pragma unroll
    for (int j = 0; j < 4; ++j) { const f32x4 g = gr[64 * j];
        o8[64 * j] = (unsigned long long)pk2(v[j].x * rstd * g.x, v[j].y * rstd * g.y) | ((unsigned long long)pk2(v[j].z * rstd * g.z, v[j].w * rstd * g.w) << 32);
        if (orow8) ((GAS unsigned*)orow8 + lane)[64 * j] = pk4_fp8(v[j].x * rstd * g.x, v[j].y * rstd * g.y, v[j].z * rstd * g.z, v[j].w * rstd * g.w); }
}
template <int PART> __device__ __forceinline__ void p0_prologue(Frame& F, const Args& args, int gw, int NGW) {
    const int lane = F.lane;
    unsigned char* ws = F.ws;
    constexpr int T_IN = 16 * 156, T_WB = 3 * 128, T_WO = 256, T_WM = 256, T_W1 = 32 * 512, T_W2 = 32 * 256, T_LO = 32;
    constexpr int NT = T_IN + T_WB + T_WO + T_WM + T_W1 + T_W2;
    constexpr int IT0 = (PART == 0) ? 0 : (PART == 1) ? T_IN + T_WB + T_WO + T_WM + T_W1 : T_IN + T_WB + T_WO + T_WM, IT1 = (PART == 0) ? T_IN + T_WB + T_WO + T_WM : (PART == 1) ? NT : T_IN + T_WB + T_WO + T_WM + T_W1;
    if constexpr (PART == 1) {
        constexpr int B1 = T_IN + T_WB + T_WO + T_WM + T_W1;
        auto w2_src = [&](int it_, const float*& W_, unsigned char*& WT_, int& k0_, int& n0_) { const int r_ = it_ - B1, e_ = r_ / 256, q_ = r_ % 256; k0_ = 64 * (q_ % 16); n0_ = 64 * (q_ / 16);
            W_ = ldarg(I_EXP_W2) + (size_t)e_ * 1024 * 1024; WT_ = ws + WS_W2 + (size_t)e_ * 1024 * 1024; };
        f32x4 va[16], vb[16]; const float* Wa; unsigned char* Ta; int ka, na; const float* Wb; unsigned char* Tb; int kb_, nb_;
        int it = IT0 + gw;
        if (it < IT1) { w2_src(it, Wa, Ta, ka, na); tc8_load_nt(Wa, 1024, ka, na, lane, va); }
        while (it < IT1) {
            const int i1 = it + NGW; if (i1 < IT1) { w2_src(i1, Wb, Tb, kb_, nb_); tc8_load_nt(Wb, 1024, kb_, nb_, lane, vb); }
            tc8_store(Ta, 1024, ka, na, lane, va, W8_SCALE);
            if (i1 >= IT1) break;
            const int i2 = i1 + NGW; if (i2 < IT1) { w2_src(i2, Wa, Ta, ka, na); tc8_load_nt(Wa, 1024, ka, na, lane, va); }
            tc8_store(Tb, 1024, kb_, nb_, lane, vb, W8_SCALE);
            it = i2;
        }
        return;
    }
    for (int it = IT0 + gw; it < IT1; it += NGW) {
        int r = it;
        if (r < T_IN) { const int kb = r / 156, nb = r % 156, nt = nb >> 2;
            if (nt < 18 || nt >= 25) tconv_tile_f8(ldarg(I_W_IN), 1024, IN_COLS, ws + WS_WIN8, 64 * kb, 64 * nb, 64 * nb, lane, W8_SCALE);
            else tconv_tile(ldarg(I_W_IN), 1024, IN_COLS, (bf16*)(ws + WS_WIN), 64 * kb, 64 * nb, 64 * nb, lane);
            continue; } r -= T_IN;
        if (r < T_WB) { const int b = r / 128, q = r % 128, kb = q / 16, nb = q % 16;
            tconv_tile(ldarg(I_W_BRANCH) + (size_t)b * 512 * 1024, 1536, 1024, (bf16*)(ws + WS_WB), 64 * kb, 64 * nb, 64 * nb, lane, 512 * b); continue; } r -= T_WB;
        if (r < T_WO) { const int kb = r / 16, nb = r % 16; if (MRG_FP8) tconv_tile_f8(ldarg(I_W_OUT), 1024, 1024, ws + WS_WO, 64 * kb, 64 * nb, 64 * nb, lane, W8_SCALE); else tconv_tile(ldarg(I_W_OUT), 1024, 1024, (bf16*)(ws + WS_WO), 64 * kb, 64 * nb, 64 * nb, lane); continue; } r -= T_WO;
        if (r < T_WM) { const int kb = r / 16, nb = r % 16; tconv_tile(ldarg(I_W_MEMKV), 1024, 1024, (bf16*)(ws + WS_WMEM), 64 * kb, 64 * nb, 64 * nb, lane); continue; } r -= T_WM;
        if (r < T_W1) { const int e = r / 512, q = r % 512, kb = q % 16, nb = q / 16, n0 = 64 * nb;
            const int rowbase = (n0 < 1024) ? ((n0 >> 7) * 256 + (n0 & 127)) : ((((n0 - 1024) >> 7) * 256) + 128 + ((n0 - 1024) & 127));
            tconv_tile_f8(ldarg(I_EXP_W1) + (size_t)e * 1024 * 2048, 1024, 2048, ws + WS_W1 + (size_t)e * 2048 * 1024, 64 * kb, n0, rowbase, lane, W8_SCALE); continue; } r -= T_W1;
        { const int e = r / 256, q = r % 256, kb = q % 16, nb = q / 16;
            tconv_tile_f8(ldarg(I_EXP_W2) + (size_t)e * 1024 * 1024, 1024, 1024, ws + WS_W2 + (size_t)e * 1024 * 1024, 64 * kb, 64 * nb, 64 * nb, lane, W8_SCALE); }
    }
    if (PART == 0) {
    for (int it = gw; it < T_LO; it += NGW) {
        bf16* L = (bf16*)(ws + WS_LORA);
        if (it < 8) tconv_tile(ldarg(I_R_W2), 64, 512, L, 0, 64 * it, 64 * it, lane);
        else if (it < 16) tconv_tile(ldarg(I_R_A2), 64, 512, L + 512 * 64, 0, 64 * (it - 8), 64 * (it - 8), lane);
        else { const int q = it - 16; tconv_tile(ldarg(I_R_G2), 128, 512, L + 2 * 512 * 64, 64 * (q >> 3), 64 * (q & 7), 64 * (q & 7), lane); } }
    { const int* posp = (const int*)ldarg(I_POS); float* cs = (float*)(ws + WS_CS);
      for (int idx = gw * 64 + lane; idx < MTOK * 16; idx += NGW * 64) { const int m = idx >> 4, i = idx & 15; const float ang = (float)posp[m] * exp2f(-(float)i * (18.931568569324174f / 16.0f)); const float sn = sinf(ang), cn = cosf(ang);
          f32x2 o; o.x = cn; o.y = sn; *(GAS f32x2*)(cs + (size_t)idx * 2) = o; } }
    { const float* X_ = ldarg(I_X); const GAS f32x4* gr = (const GAS f32x4*)ldarg(I_NORM_MIX) + lane; const f32x4 g0 = gr[0], g1 = gr[64], g2 = gr[128], g3 = gr[192];
      for (int m0 = gw; m0 < MTOK; m0 += 4 * NGW) {
          f32x4 v[4][4];
#pragma unroll
          for (int i = 0; i < 4; ++i) { const int m = m0 + i * NGW; const GAS f32x4* xr = (const GAS f32x4*)(X_ + (size_t)(m < MTOK ? m : m0) * D_MODEL) + lane;
#pragma unroll
              for (int j = 0; j < 4; ++j) v[i][j] = __builtin_nontemporal_load(xr + 64 * j); }
#pragma unroll
          for (int i = 0; i < 4; ++i) { const int m = m0 + i * NGW; if (m >= MTOK) break;
              float s = 0.f;
#pragma unroll
              for (int j = 0; j < 4; ++j) s += (v[i][j].x * v[i][j].x + v[i][j].y * v[i][j].y) + (v[i][j].z * v[i][j].z + v[i][j].w * v[i][j].w);
              const float rstd = 1.0f / sqrtf(wave_sum(s) * (1.f / D_MODEL) + NORM_EPS);
              GAS unsigned long long* o8 = (GAS unsigned long long*)((bf16*)(ws + WS_XN) + (size_t)m * D_MODEL) + lane; GAS unsigned* q8 = (GAS unsigned*)(ws + WS_XN8 + (size_t)m * D_MODEL) + lane;
#pragma unroll
              for (int j = 0; j < 4; ++j) { const f32x4 g = (j == 0) ? g0 : (j == 1) ? g1 : (j == 2) ? g2 : g3; const f32x4 y = v[i][j] * rstd * g;
                  o8[64 * j] = (unsigned long long)pk2(y.x, y.y) | ((unsigned long long)pk2(y.z, y.w) << 32);
                  q8[64 * j] = pk4_fp8(y.x, y.y, y.z, y.w); } } } }
    for (int m = gw; m < MEMROWS; m += NGW) rms_row_to_bf16(ldarg(I_MEM) + (size_t)m * D_MODEL, ldarg(I_MEM_NORM), (bf16*)(ws + WS_MEMN) + (size_t)m * D_MODEL, lane);
    }
}

__device__ __forceinline__ void head_norm(bf16* p, const float* gain, bool rot, float c0, float s0, float c1, float s1, float scale, int lane) {
    GAS unsigned* pw = (GAS unsigned*)p + lane;
    const unsigned w = *pw; float a = bf_lo(w), b = bf_hi(w);
    const float ss = wave_sum(a * a + b * b);
    const float rstd = 1.0f / sqrtf(ss * (1.f / 128.f) + NORM_EPS);
    const f32x2 g = *((const GAS f32x2*)gain + lane);
    a = a * rstd * g.x; b = b * rstd * g.y;
    const float pa = __shfl_xor(a, 8), pb = __shfl_xor(b, 8);
    if (rot && lane < 16) {
        if (lane < 8) { a = a * c0 - pa * s0; b = b * c1 - pb * s1; }
        else          { a = a * c0 + pa * s0; b = b * c1 + pb * s1; }
    }
    *pw = pk2(a * scale, b * scale);
}
__device__ __forceinline__ void p2_prep(Frame& F, const Args& args) {
    const int gw = F.vcu * NWAVES + F.wave, NGW = F.G * NWAVES, lane = F.lane;
    unsigned char* ws = F.ws;
    bf16* Z = (bf16*)(ws + WS_Z);
    LAS float* lo = (LAS float*)(F.lds + RING_OFF + F.wave * 8192);
    const float* mu = ldarg(I_R_MU); const float* aqg = ldarg(I_AQ_GAIN); const float* akg = ldarg(I_AK_GAIN); const float* cqg = ldarg(I_CQ_GAIN); const int* posp = (const int*)ldarg(I_POS);
    float* Rr = (float*)(ws + WS_RW); float* Rw = Rr + (size_t)MTOK * RW; float* Rk = Rw + (size_t)MTOK * RW; float* Rv = Rk + (size_t)MTOK * RW;
    float* Ra = Rv + (size_t)MTOK * RW; float* Rb = Ra + (size_t)MTOK * RW; float* Rg = Rb + (size_t)MTOK * RW;
    for (int m = gw; m < MEMROWS; m += NGW)
        for (int hd = 0; hd < 4; ++hd) head_norm((bf16*)(ws + WS_KVM) + (size_t)m * 1024 + hd * 128, ldarg(I_CK_GAIN), false, 1.f, 0.f, 1.f, 0.f, 1.0f, lane);
}

__device__ __forceinline__ void lora_stage(const float* W, LAS unsigned* wl, int tid) {
#pragma unroll
    for (int i = 0; i < 16; ++i) { const int idx = tid + 512 * i; const f32x4 v = *((const GAS f32x4*)W + idx);
        *(LAS unsigned long long*)(wl + 2 * idx) = (unsigned long long)pk2(v.x, v.y) | ((unsigned long long)pk2(v.z, v.w) << 32); }
}
__device__ __forceinline__ void lora_mac(const LAS unsigned* wl, const LAS float* lo, float (&acc)[4][8], int lane) {
#pragma unroll 4
    for (int j = 0; j < 64; ++j) { const f32x4 xin = *(const LAS f32x4*)(lo + j * 4);
#pragma unroll
        for (int i = 0; i < 4; ++i) { const unsigned w = wl[j * 256 + lane + 64 * i]; const float w0 = bf_lo(w), w1 = bf_hi(w);
#pragma unroll
            for (int tt = 0; tt < 4; ++tt) { acc[tt][2 * i] += xin[tt] * w0; acc[tt][2 * i + 1] += xin[tt] * w1; } } }
}
template <int NL> __device__ __forceinline__ void lora_in(const bf16* Z, const float* mu, int ch, int m0, LAS float* lo, int lane) {
    const int col = OFF_R + 1536 + ch; const float muj = mu[1536 + ch];
    float prv = ((m0 % SEQ) == 0) ? 0.f : __builtin_bit_cast(float, (unsigned)Z[(size_t)(m0 - 1) * IN_COLS + col] << 16);
#pragma unroll
    for (int tt = 0; tt < 4; ++tt) { const float cur = __builtin_bit_cast(float, (unsigned)Z[(size_t)(m0 + tt) * IN_COLS + col] << 16);
        float x = cur + (prv - cur) * muj; prv = cur;
        x = (NL == 0) ? tanhf(x) : (NL == 1) ? x : sigm(x);
        lo[lane * 4 + tt] = x; }
    LDS_WAIT(); asm volatile("" ::: "memory");
}
__device__ __forceinline__ void p2_rwkv(Frame& F, const Args& args) {
    const int lane = F.lane, wave = F.wave;
    unsigned char* ws = F.ws;
    const bf16* Z = (const bf16*)(ws + WS_Z);
    LAS unsigned* wl = (LAS unsigned*)(F.lds + RING_OFF);
    LAS float* lo = (LAS float*)(F.lds + RING_OFF + 65536 + wave * 1024);
    const float* mu = ldarg(I_R_MU);
    float* Rr = (float*)(ws + WS_RW); float* Rw = Rr + (size_t)MTOK * RW; float* Rk = Rw + (size_t)MTOK * RW; float* Rv = Rk + (size_t)MTOK * RW;
    float* Ra = Rv + (size_t)MTOK * RW; float* Rb = Ra + (size_t)MTOK * RW; float* Rg = Rb + (size_t)MTOK * RW;
    for (int grp = F.vcu; grp < MTOK / 64; grp += F.G) {
        const int mw = grp * 64 + wave * 8;
        lora_stage(ldarg(I_R_W2), wl, F.tid);
        __syncthreads();
        for (int tk = 0; tk < 2; ++tk) { const int m0 = mw + 4 * tk;
            lora_in<0>(Z, mu, lane, m0, lo, lane);
            float acc[4][8];
#pragma unroll
            for (int tt = 0; tt < 4; ++tt)
#pragma unroll
                for (int c = 0; c < 8; ++c) acc[tt][c] = 0.f;
            lora_mac(wl, lo, acc, lane);
            const float* w0p = ldarg(I_R_W0);
#pragma unroll
            for (int i = 0; i < 4; ++i) { const int c = 2 * lane + 128 * i; const f32x2 w0 = *(const GAS f32x2*)(w0p + c);
#pragma unroll
                for (int tt = 0; tt < 4; ++tt) { const float y0 = -(w0.x + acc[tt][2 * i]), y1 = -(w0.y + acc[tt][2 * i + 1]);
                    const float sp0 = fmaxf(y0, 0.f) + log1pf(__expf(-fabsf(y0))), sp1 = fmaxf(y1, 0.f) + log1pf(__expf(-fabsf(y1)));
                    f32x2 wd; wd.x = -__expf(-sp0 - 0.5f); wd.y = -__expf(-sp1 - 0.5f);
                    *(GAS f32x2*)(Rw + (size_t)(m0 + tt) * RW + c) = wd; } }
            LDS_WAIT(); asm volatile("" ::: "memory"); }
        __syncthreads();
        lora_stage(ldarg(I_R_A2), wl, F.tid);
        __syncthreads();
        for (int tk = 0; tk < 2; ++tk) { const int m0 = mw + 4 * tk; const int tpos0 = m0 % SEQ;
            lora_in<1>(Z, mu, 64 + lane, m0, lo, lane);
            float acca[4][8];
#pragma unroll
            for (int tt = 0; tt < 4; ++tt)
#pragma unroll
                for (int c = 0; c < 8; ++c) acca[tt][c] = 0.f;
            lora_mac(wl, lo, acca, lane);
            const float* a0p = ldarg(I_R_A0); const float* kkp = ldarg(I_R_KK); const float* kap = ldarg(I_R_KA);
#pragma unroll
            for (int i = 0; i < 4; ++i) {
                const int c = 2 * lane + 128 * i;
                const f32x2 a0 = *(const GAS f32x2*)(a0p + c), kkc = *(const GAS f32x2*)(kkp + c), kac = *(const GAS f32x2*)(kap + c);
                const f32x2 mur = *(const GAS f32x2*)(mu + c), muk = *(const GAS f32x2*)(mu + 512 + c), muv = *(const GAS f32x2*)(mu + 1024 + c);
                unsigned pr = 0u, pk = 0u, pv = 0u;
                if (tpos0 != 0) { const bf16* zp = Z + (size_t)(m0 - 1) * IN_COLS + OFF_R + c; pr = *(const GAS unsigned*)zp; pk = *(const GAS unsigned*)(zp + 512); pv = *(const GAS unsigned*)(zp + 1024); }
#pragma unroll
                for (int tt = 0; tt < 4; ++tt) {
                    const size_t m = (size_t)(m0 + tt);
                    const bf16* zc = Z + m * IN_COLS + OFF_R + c;
                    const unsigned cr = *(const GAS unsigned*)zc, ck = *(const GAS unsigned*)(zc + 512), cv = *(const GAS unsigned*)(zc + 1024);
                    f32x2 r, k, v;
                    r.x = bf_lo(cr) + (bf_lo(pr) - bf_lo(cr)) * mur.x; r.y = bf_hi(cr) + (bf_hi(pr) - bf_hi(cr)) * mur.y;
                    k.x = bf_lo(ck) + (bf_lo(pk) - bf_lo(ck)) * muk.x; k.y = bf_hi(ck) + (bf_hi(pk) - bf_hi(ck)) * muk.y;
                    v.x = bf_lo(cv) + (bf_lo(pv) - bf_lo(cv)) * muv.x; v.y = bf_hi(cv) + (bf_hi(pv) - bf_hi(cv)) * muv.y;
                    pr = cr; pk = ck; pv = cv;
                    f32x2 av; av.x = sigm(a0.x + acca[tt][2 * i]); av.y = sigm(a0.y + acca[tt][2 * i + 1]);
                    f32x2 kk; kk.x = k.x * kkc.x; kk.y = k.y * kkc.y;
                    float slo, shi; half_sums(kk.x * kk.x + kk.y * kk.y, slo, shi);
                    const float nrm = fmaxf(sqrtf(lane < 32 ? slo : shi), 1e-12f), inv = 1.0f / nrm;
                    kk.x *= inv; kk.y *= inv;
                    f32x2 k2; k2.x = k.x * (1.0f + (av.x - 1.0f) * kac.x); k2.y = k.y * (1.0f + (av.y - 1.0f) * kac.y);
                    f32x2 as, bs; as.x = -kk.x; as.y = -kk.y; bs.x = kk.x * av.x; bs.y = kk.y * av.y;
                    const size_t o = m * RW + c;
                    *(GAS f32x2*)(Rr + o) = r; *(GAS f32x2*)(Rk + o) = k2; *(GAS f32x2*)(Rv + o) = v; *(GAS f32x2*)(Ra + o) = as; *(GAS f32x2*)(Rb + o) = bs;
                }
            }
            LDS_WAIT(); asm volatile("" ::: "memory"); }
        __syncthreads();
        float accg[2][4][8];
#pragma unroll
        for (int tk = 0; tk < 2; ++tk)
#pragma unroll
            for (int tt = 0; tt < 4; ++tt)
#pragma unroll
                for (int c = 0; c < 8; ++c) accg[tk][tt][c] = 0.f;
#pragma unroll
        for (int hh = 0; hh < 2; ++hh) {
            lora_stage(ldarg(I_R_G2) + (size_t)hh * 64 * RW, wl, F.tid);
            __syncthreads();
#pragma unroll
            for (int tk = 0; tk < 2; ++tk) { lora_in<2>(Z, mu, 128 + 64 * hh + lane, mw + 4 * tk, lo, lane); lora_mac(wl, lo, accg[tk], lane); LDS_WAIT(); asm volatile("" ::: "memory"); }
            __syncthreads();
        }
#pragma unroll
        for (int tk = 0; tk < 2; ++tk)
#pragma unroll
            for (int i = 0; i < 4; ++i)
#pragma unroll
                for (int tt = 0; tt < 4; ++tt) { f32x2 gg; gg.x = accg[tk][tt][2 * i]; gg.y = accg[tk][tt][2 * i + 1]; *(GAS f32x2*)(Rg + (size_t)(mw + 4 * tk + tt) * RW + 2 * lane + 128 * i) = gg; }
    }
}

__device__ __forceinline__ float qk_dot(const LAS float* q, const bf16* krow) {
    const GAS v4u* kp = (const GAS v4u*)krow; float s0 = 0.f, s1 = 0.f;
#pragma unroll
    for (int i = 0; i < 16; ++i) { const v4u w = kp[i]; const f32x4 qa = *(const LAS f32x4*)(q + 8 * i), qb = *(const LAS f32x4*)(q + 8 * i + 4);
        s0 += bf_lo(w.x) * qa[0] + bf_hi(w.x) * qa[1] + bf_lo(w.y) * qa[2] + bf_hi(w.y) * qa[3];
        s1 += bf_lo(w.z) * qb[0] + bf_hi(w.z) * qb[1] + bf_lo(w.w) * qb[2] + bf_hi(w.w) * qb[3]; }
    return s0 + s1;
}
__device__ __forceinline__ void p3_attention(Frame& F) {
    const int gw = F.vcu * NWAVES + F.wave, NGW = F.G * NWAVES, lane = F.lane;
    unsigned char* ws = F.ws;
    const bf16* Z = (const bf16*)(ws + WS_Z);
    const bf16* KV = (const bf16*)(ws + WS_KVM);
    bf16* YA = (bf16*)(ws + WS_YABC); bf16* YC = YA + (size_t)2 * MTOK * 512;
    LAS float* qs = (LAS float*)(F.lds + RING_OFF + F.wave * 8192);
    for (int task = gw; task < MTOK * 4; task += NGW) {
        const int m = task >> 2, h = task & 3, t = m % SEQ;
        const bf16* zrow = Z + (size_t)m * IN_COLS;
#pragma unroll
        for (int g = 0; g < 3; ++g) { const unsigned w = *((const GAS unsigned*)(zrow + OFF_AQ + g * 512 + h * 128) + lane); qs[g * 128 + 2 * lane] = bf_lo(w); qs[g * 128 + 2 * lane + 1] = bf_hi(w); }
        LDS_WAIT(); asm volatile("" ::: "memory");
        float sc[3][3]; float mx = -INFINITY;
#pragma unroll
        for (int g = 0; g < 3; ++g) { const int dl = (g == 0) ? 1 : (g == 1) ? 4 : 16;
#pragma unroll
            for (int p = 0; p < 3; ++p) { const int j = lane + 64 * p; const int tk = t - dl * j; float s = -INFINITY;
                if (j <= 128 && tk >= 0) s = qk_dot(qs + g * 128, zrow - (size_t)dl * j * IN_COLS + OFF_AK + g * 512 + h * 128);
                sc[g][p] = s; mx = fmaxf(mx, s); } }
        mx = wave_max_bp(mx);
        float den = 0.f;
#pragma unroll
        for (int g = 0; g < 3; ++g)
#pragma unroll
            for (int p = 0; p < 3; ++p) { sc[g][p] = exp2f(sc[g][p] - mx); den += sc[g][p]; }
        den = wave_sum(den);
        float o0 = 0.f, o1 = 0.f;
#pragma unroll
        for (int g = 0; g < 3; ++g) { const int dl = (g == 0) ? 1 : (g == 1) ? 4 : 16; const bf16* vb = zrow + OFF_AV + g * 512 + h * 128 + 2 * lane;
#pragma unroll
            for (int p = 0; p < 3; ++p) { const int nj = (p < 2) ? 64 : 1;
                for (int jj = 0; jj < nj; ++jj) { const int j = jj + 64 * p; const float pj = rdlane(sc[g][p], jj);
                    if (t - dl * j >= 0) { const unsigned w = *(const GAS unsigned*)(vb - (size_t)dl * j * IN_COLS); o0 += pj * bf_lo(w); o1 += pj * bf_hi(w); } } } }
        const float inv = 1.0f / den;
        *((GAS unsigned*)(YA + (size_t)m * 512 + h * 128) + lane) = pk2(o0 * inv, o1 * inv);
        asm volatile("" ::: "memory");
    }
    for (int task = gw; task < MTOK * 4; task += NGW) {
        const int m = task >> 2, h = task & 3, b = m / SEQ;
        const bf16* zrow = Z + (size_t)m * IN_COLS;
        { const unsigned w = *((const GAS unsigned*)(zrow + OFF_CQ + h * 128) + lane); qs[2 * lane] = bf_lo(w); qs[2 * lane + 1] = bf_hi(w); }
        LDS_WAIT(); asm volatile("" ::: "memory");
        const bf16* kb = KV + (size_t)b * MEM_LEN * 1024 + h * 128;
        float sc[4]; float mx = -INFINITY;
#pragma unroll
        for (int p = 0; p < 4; ++p) { sc[p] = qk_dot(qs, kb + (size_t)(lane + 64 * p) * 1024); mx = fmaxf(mx, sc[p]); }
        mx = wave_max_bp(mx);
        float den = 0.f;
#pragma unroll
        for (int p = 0; p < 4; ++p) { sc[p] = exp2f(sc[p] - mx); den += sc[p]; }
        den = wave_sum(den);
        float o0 = 0.f, o1 = 0.f; const bf16* vb = kb + 512 + 2 * lane;
#pragma unroll
        for (int p = 0; p < 4; ++p)
            for (int jj = 0; jj < 64; ++jj) { const float pj = rdlane(sc[p], jj); const unsigned w = *(const GAS unsigned*)(vb + (size_t)(jj + 64 * p) * 1024); o0 += pj * bf_lo(w); o1 += pj * bf_hi(w); }
        const float inv = 1.0f / den;
        *((GAS unsigned*)(YC + (size_t)m * 512 + h * 128) + lane) = pk2(o0 * inv, o1 * inv);
        asm volatile("" ::: "memory");
    }
}

__device__ __forceinline__ void p5_post(Frame& F, const Args& args) {
    const int gw = F.vcu * NWAVES + F.wave, NGW = F.G * NWAVES, lane = F.lane;
    unsigned char* ws = F.ws;
    const float* Rr = (const float*)(ws + WS_RW); const float* Rk = Rr + (size_t)2 * MTOK * RW; const float* Rv = Rk + (size_t)MTOK * RW; const float* Rg = Rr + (size_t)6 * MTOK * RW;
    const float* YS = (const float*)(ws + WS_YS);
    bf16* YB = (bf16*)(ws + WS_YABC) + (size_t)MTOK * 512;
    const bf16* OP = (const bf16*)(ws + WS_OP); const float* LS = (const float*)(ws + WS_LSE); bf16* YA = (bf16*)(ws + WS_YABC);
    for (int m = gw; m < MTOK; m += NGW) {
        float l0[4], l1[4], l2[4]; unsigned pa[4], pb[4], pc[4];
#pragma unroll
        for (int h = 0; h < 4; ++h) { l0[h] = LS[(size_t)m * 4 + h]; l1[h] = LS[(size_t)MTOK * 4 + (size_t)m * 4 + h]; l2[h] = LS[(size_t)2 * MTOK * 4 + (size_t)m * 4 + h];
            const size_t o = (size_t)m * 512 + h * 128;
            pa[h] = *((const GAS unsigned*)(OP + o) + lane); pb[h] = *((const GAS unsigned*)(OP + (size_t)MTOK * 512 + o) + lane); pc[h] = *((const GAS unsigned*)(OP + (size_t)2 * MTOK * 512 + o) + lane); }
#pragma unroll
        for (int h = 0; h < 4; ++h) {
            const float mx = fmaxf(l0[h], fmaxf(l1[h], l2[h])); const float w0 = exp2f(l0[h] - mx), w1 = exp2f(l1[h] - mx), w2 = exp2f(l2[h] - mx); const float inv = __builtin_amdgcn_rcpf(w0 + w1 + w2);
            *((GAS unsigned*)(YA + (size_t)m * 1536 + h * 128) + lane) = pk2((w0 * bf_lo(pa[h]) + w1 * bf_lo(pb[h]) + w2 * bf_lo(pc[h])) * inv, (w0 * bf_hi(pa[h]) + w1 * bf_hi(pb[h]) + w2 * bf_hi(pc[h])) * inv); }
    }
}

__device__ __forceinline__ void p8_router(Frame& F, const Args& args) {
    const int lane = F.lane, wave = F.wave;
    unsigned char* ws = F.ws;
    const float* X1 = F.out;
    LAS int* hist = (LAS int*)(F.lds + HIST_OFF);
    { const int t_ = opq(F.tid); if (t_ < 32) hist[t_] = 0; }
    int* topi = (int*)(ws + WS_ROUTE + RT_TOPI); float* topg = (float*)(ws + WS_ROUTE + RT_TOPG);
    const float* RWt = ldarg(I_ROUTER_W); const float* RB = ldarg(I_ROUTER_B); const float* gain = ldarg(I_NORM_FFN);
    LAS float* rw = (LAS float*)(F.lds + RING_OFF);
    typedef float f32x16r __attribute__((ext_vector_type(16)));
    for (int grp = F.vcu; grp < MTOK / 64; grp += F.G) {
        const int tile = wave >> 2, wq = wave & 3, i32 = lane & 31, h = lane >> 5;
        const GAS f32x4* xp = (const GAS f32x4*)(X1 + ((size_t)grp * 64 + tile * 32 + i32) * D_MODEL + wq * 256 + 4 * h);
        f32x4 xall[16];
#pragma unroll
        for (int q = 0; q < 16; ++q) xall[q] = xp[2 * q];
#pragma unroll
        for (int i = 0; i < 16; ++i) { const int f = F.tid + 512 * i, k = f >> 3; const f32x4 w = *((const GAS f32x4*)RWt + f); const float g = gain[k]; ((LAS f32x4*)rw)[f] = w * g; }
        __syncthreads();
        const LAS float* bp = rw + (wq * 256 + 4 * h) * 32 + i32;
        f32x16r acc;
#pragma unroll
        for (int r = 0; r < 16; ++r) acc[r] = 0.f;
        float ss = 0.f;
#pragma unroll
        for (int q = 0; q < 16; ++q) { const f32x4 xv = xall[q]; ss += (xv.x * xv.x + xv.y * xv.y) + (xv.z * xv.z + xv.w * xv.w);
#pragma unroll
            for (int j = 0; j < 4; ++j) acc = __builtin_amdgcn_mfma_f32_32x32x2f32(xv[j], bp[(8 * q + j) * 32], acc, 0, 0, 0); }
#pragma unroll 4
        for (int q = 16; q < 32; ++q) { const f32x4 xv = xp[2 * q]; ss += (xv.x * xv.x + xv.y * xv.y) + (xv.z * xv.z + xv.w * xv.w);
#pragma unroll
            for (int j = 0; j < 4; ++j) acc = __builtin_amdgcn_mfma_f32_32x32x2f32(xv[j], bp[(8 * q + j) * 32], acc, 0, 0, 0); }
        __syncthreads();
        { LAS float* part = rw + (tile * 4 + wq) * 1024;
#pragma unroll
          for (int r = 0; r < 16; ++r) part[((r & 3) + 8 * (r >> 2) + 4 * h) * 32 + i32] = acc[r];
          rw[8192 + (tile * 4 + wq) * 64 + lane] = ss; }
        __syncthreads();
        if (F.tid < 64) { const int t = F.tid, tl = t >> 5, row = t & 31; const size_t m = (size_t)grp * 64 + t;
            float s = 0.f;
#pragma unroll
            for (int q = 0; q < 4; ++q) s += rw[8192 + (tl * 4 + q) * 64 + row] + rw[8192 + (tl * 4 + q) * 64 + 32 + row];
            const float rstd = 1.0f / sqrtf(s * (1.f / D_MODEL) + NORM_EPS);
            float lg[32];
#pragma unroll
            for (int e = 0; e < 32; ++e) { const LAS float* pp = rw + (tl * 4) * 1024 + row * 32 + e; lg[e] = ((pp[0] + pp[1024]) + (pp[2048] + pp[3072])) * rstd + RB[e]; }
            int ti[4]; float tv[4];
#pragma unroll
            for (int k = 0; k < 4; ++k) { float best = -INFINITY; int bi = 0;
#pragma unroll
                for (int e = 0; e < 32; ++e) { const bool taken = (k > 0 && ti[0] == e) || (k > 1 && ti[1] == e) || (k > 2 && ti[2] == e); if (!taken && lg[e] > best) { best = lg[e]; bi = e; } }
                ti[k] = bi; tv[k] = best; }
            const float e1 = __expf(tv[1] - tv[0]), e2 = __expf(tv[2] - tv[0]), e3 = __expf(tv[3] - tv[0]); const float inv = 1.0f / (1.0f + e1 + e2 + e3);
            { typedef int i32x4 __attribute__((ext_vector_type(4))); *(GAS i32x4*)(topi + m * 4) = (i32x4){ti[0], ti[1], ti[2], ti[3]}; } *(GAS f32x4*)(topg + m * 4) = (f32x4){inv, e1 * inv, e2 * inv, e3 * inv};
#pragma unroll
            for (int k = 0; k < 4; ++k) __hip_atomic_fetch_add(hist + ti[k], 1, __ATOMIC_RELAXED, __HIP_MEMORY_SCOPE_WORKGROUP); }
        __syncthreads();
    }
    { const int t_ = opq(F.tid); if (t_ < 32 && hist[t_] != 0) __hip_atomic_fetch_add((unsigned*)(F.ctl + CW_CNT) + 64 * t_, (unsigned)hist[t_], __ATOMIC_RELAXED, __HIP_MEMORY_SCOPE_AGENT); }
}
__device__ __forceinline__ void moe_table(Frame& F) {
    LAS int* tab = (LAS int*)(F.lds + MOETAB_OFF);
    __syncthreads();
    if (F.tid < 64) {
        const int e = opq(F.tid); int nb = 0;
        if (e < 32) { const int c = (int)__hip_atomic_load((unsigned*)(F.ctl + CW_CNT) + 64 * e, __ATOMIC_RELAXED, __HIP_MEMORY_SCOPE_AGENT); nb = (c + MOE_ROWS - 1) / MOE_ROWS; }
        int acc = 0;
#pragma unroll
        for (int j = 0; j < 32; ++j) { const int v = __builtin_amdgcn_readlane(nb, j); acc += (j < e) ? v : 0; }
        if (e < 32) { tab[320 + e] = acc * MOE_ROWS; for (int q = 0; q < nb; ++q) tab[1 + acc + q] = e; }
        if (e == 32) tab[0] = acc; }
    __syncthreads();
}
__device__ __forceinline__ void p9_dispatch(Frame& F, const Args& args) {
    const int lane = F.lane;
    unsigned char* ws = F.ws;
    moe_table(F);
    const LAS int* tab = (const LAS int*)(F.lds + MOETAB_OFF);
    LAS int* hist = (LAS int*)(F.lds + HIST_OFF); LAS int* base = hist + 32; LAS int* slots = hist + 64;
    const int* topi = (const int*)(ws + WS_ROUTE + RT_TOPI); const float* topg = (const float*)(ws + WS_ROUTE + RT_TOPG);
    int* pos = (int*)(ws + WS_ROUTE + RT_POS); float* rowgate = (float*)(ws + WS_ROUTE + RT_ROWGATE);
    bf16* XS = (bf16*)(ws + WS_XS); const float* gain = ldarg(I_NORM_FFN);
    for (int grp = F.vcu; grp < MTOK / 64; grp += F.G) {
        const int t_ = opq(F.tid);
        if (t_ < 32) hist[t_] = 0;
        f32x4 v[8][4];
#pragma unroll
        for (int i = 0; i < 8; ++i) { const GAS f32x4* xr = (const GAS f32x4*)(F.out + ((size_t)grp * 64 + F.wave * 8 + i) * D_MODEL) + 2 * lane;
#pragma unroll
            for (int j = 0; j < 4; ++j) v[i][j] = xr[128 * (j >> 1) + (j & 1)]; }
        const GAS f32x4* gr = (const GAS f32x4*)gain + 2 * lane; const f32x4 g00 = gr[0], g01 = gr[1], g10 = gr[128], g11 = gr[129];
        __syncthreads();
        int e = 0, rank = 0;
        if (F.tid < 256) { e = topi[(size_t)grp * 256 + F.tid]; rank = __hip_atomic_fetch_add(hist + e, 1, __ATOMIC_RELAXED, __HIP_MEMORY_SCOPE_WORKGROUP); }
        __syncthreads();
        if (F.tid < 32) { const int h = hist[F.tid]; int b0 = 0; if (h != 0) b0 = (int)__hip_atomic_fetch_add((unsigned*)(F.ctl + CW_CUR) + 64 * F.tid, (unsigned)h, __ATOMIC_RELAXED, __HIP_MEMORY_SCOPE_AGENT); base[F.tid] = tab[320 + F.tid] + b0; }
        __syncthreads();
        if (F.tid < 256) { const int slot = base[e] + rank; pos[(size_t)grp * 256 + F.tid] = slot; rowgate[slot] = topg[(size_t)grp * 256 + F.tid]; slots[F.tid] = slot; }
        __syncthreads();
        {
#pragma unroll
          for (int i = 0; i < 8; ++i) { const int tl = F.wave * 8 + i;
              float s = 0.f;
#pragma unroll
              for (int j = 0; j < 4; ++j) s += (v[i][j].x * v[i][j].x + v[i][j].y * v[i][j].y) + (v[i][j].z * v[i][j].z + v[i][j].w * v[i][j].w);
              const float rstd = 1.0f / sqrtf(wave_sum(s) * (1.f / D_MODEL) + NORM_EPS);
              unsigned long long o[2];
              { const f32x4 a = v[i][0] * rstd * g00, b = v[i][1] * rstd * g01; o[0] = (unsigned long long)pk4_fp8(a.x, a.y, a.z, a.w) | ((unsigned long long)pk4_fp8(b.x, b.y, b.z, b.w) << 32); }
              { const f32x4 a = v[i][2] * rstd * g10, b = v[i][3] * rstd * g11; o[1] = (unsigned long long)pk4_fp8(a.x, a.y, a.z, a.w) | ((unsigned long long)pk4_fp8(b.x, b.y, b.z, b.w) << 32); }
#pragma unroll
              for (int k = 0; k < 4; ++k) { const int sk = slots[tl * 4 + k]; GAS unsigned long long* dst = (GAS unsigned long long*)((unsigned char*)XS + (size_t)sk * D_MODEL) + lane; dst[0] = o[0]; dst[64] = o[1]; } } }
        __syncthreads();
    }
}
__device__ __forceinline__ void p12_combine(Frame& F) {
    const int gw = F.vcu * NWAVES + F.wave, NGW = F.G * NWAVES, lane = F.lane;
    unsigned char* ws = F.ws;
    const int* pos = (const int*)(ws + WS_ROUTE + RT_POS); const bf16* YR = (const bf16*)(ws + WS_YROWS);
    for (int blk = gw; blk < MTOK / 8; blk += NGW) {
        const int m0 = blk * 8;
        int pk = 0; if (lane < 32) pk = pos[(size_t)m0 * 4 + lane];
#pragma unroll
        for (int tp = 0; tp < 4; ++tp) {
            f32x4 a[2][2], b[2][2]; unsigned long long w[2][2][4];
#pragma unroll
            for (int u = 0; u < 2; ++u) { const int t = 2 * tp + u; GAS f32x4* xo = (GAS f32x4*)(F.out + (size_t)(m0 + t) * D_MODEL) + 2 * lane;
#pragma unroll
                for (int hf = 0; hf < 2; ++hf) { a[u][hf] = xo[128 * hf]; b[u][hf] = xo[128 * hf + 1];
#pragma unroll
                    for (int k = 0; k < 4; ++k) { const int sk = __builtin_amdgcn_readlane(pk, 4 * t + k); w[u][hf][k] = *((const GAS unsigned long long*)((const unsigned char*)YR + (size_t)sk * D_MODEL + 512 * hf) + lane); } } }
#pragma unroll
            for (int u = 0; u < 2; ++u) { const int t = 2 * tp + u; GAS f32x4* xo = (GAS f32x4*)(F.out + (size_t)(m0 + t) * D_MODEL) + 2 * lane;
#pragma unroll
                for (int hf = 0; hf < 2; ++hf) { f32x4 aa = a[u][hf], bb = b[u][hf];
#pragma unroll
                    for (int k = 0; k < 4; ++k) { const unsigned lo_ = (unsigned)w[u][hf][k], hi_ = (unsigned)(w[u][hf][k] >> 32);
                        const f32x2 p0 = __builtin_amdgcn_cvt_pk_f32_fp8(lo_, false), p1 = __builtin_amdgcn_cvt_pk_f32_fp8(lo_, true), p2 = __builtin_amdgcn_cvt_pk_f32_fp8(hi_, false), p3 = __builtin_amdgcn_cvt_pk_f32_fp8(hi_, true);
                        aa[0] += p0.x * 0.0625f; aa[1] += p0.y * 0.0625f; aa[2] += p1.x * 0.0625f; aa[3] += p1.y * 0.0625f; bb[0] += p2.x * 0.0625f; bb[1] += p2.y * 0.0625f; bb[2] += p3.x * 0.0625f; bb[3] += p3.y * 0.0625f; }
                    xo[128 * hf] = aa; xo[128 * hf + 1] = bb; } }
        }
    }
}

constexpr int N_ATT_A = 768, N_ATT_C = 256;
__device__ __forceinline__ swa::BlockRef attn_item(unsigned char* ws, int it) {
    swa::BlockRef r;
    const swa::bf16* Z = (const swa::bf16*)(ws + WS_Z);
    if (it < N_ATT_A) {
        const int h = it & 3, b = (it >> 2) & 1, v = it >> 3;
        int g, rr, qb;
        if (v < 32) { g = 0; rr = 0; qb = v; } else if (v < 64) { g = 1; rr = (v - 32) >> 3; qb = (v - 32) & 7; } else { g = 2; rr = (v - 64) >> 1; qb = (v - 64) & 1; }
        const int d = (g == 0) ? 1 : (g == 1) ? 4 : 16;
        const size_t row0 = (size_t)b * SEQ + rr, qrow = row0 + (size_t)d * qb * 256;
        r.Q = Z + qrow * IN_COLS + OFF_AQ + g * 512 + h * 128; r.K = Z + row0 * IN_COLS + OFF_AK + g * 512 + h * 128; r.V = Z + row0 * IN_COLS + OFF_AV + g * 512 + h * 128;
        r.O = (swa::bf16*)(ws + WS_OP) + (size_t)g * MTOK * 512 + qrow * 512 + h * 128; r.LSE = (float*)(ws + WS_LSE) + (size_t)g * MTOK * 4 + qrow * 4 + h;
        r.QS = d * IN_COLS; r.KS = d * IN_COLS; r.OS = d * 512; r.LS = d * 4; r.P0 = qb * 256; r.skv = SEQ / d; r.W = 129;
    } else {
        const int u = it - N_ATT_A, h = u & 3, b = (u >> 2) & 1, qb = u >> 3;
        const size_t qrow = (size_t)b * SEQ + (size_t)qb * 256;
        const swa::bf16* KV = (const swa::bf16*)(ws + WS_KVM) + (size_t)b * MEM_LEN * 1024 + h * 128;
        r.Q = Z + qrow * IN_COLS + OFF_CQ + h * 128; r.K = KV; r.V = KV + 512;
        r.O = (swa::bf16*)(ws + WS_YABC) + qrow * 1536 + 1024 + h * 128; r.LSE = nullptr;
        r.QS = IN_COLS; r.KS = 1024; r.OS = 1536; r.LS = 0; r.P0 = 256; r.skv = MEM_LEN; r.W = 1 << 20;
    }
    return r;
}
__device__ __forceinline__ void p3_attention_mfma(unsigned char* ws, char* lds, int G) {
    const int total = N_ATT_A + N_ATT_C; int L = blockIdx.x; if (L >= total) return;
    swa::BlockRef cur = attn_item(ws, L); swa::Seam S;
    swa::swa_prime(cur, lds, S);
    for (;;) {
        const int Ln = L + G; const bool last = Ln >= total;
        const swa::BlockRef nxt = last ? cur : attn_item(ws, Ln);
        swa::swa_block(cur, nxt, lds, S);
        if (last) break;
        cur = nxt; L = Ln;
    }
}

constexpr int N_RITEMS = BATCH * 8 * (SEQ / 64);
constexpr size_t WS_PHI = WS_XN;
constexpr size_t WS_PSI = WS_XN + 16 * MiB;
constexpr size_t WS_GAM = WS_YS;
constexpr size_t WS_OM = WS_XN2;
constexpr size_t WS_XFR = WS_MRG + 48 * MiB;
constexpr size_t WS_BONUS = WS_MRGB + 1 * MiB;
constexpr int RB = 9216, RLD = 72;
constexpr int R1_SEG = 15 * RB, R1_WC = R1_SEG + 2048;
static_assert(R1_WC + 256 <= LDSCTL_OFF, "R1 LDS map");
typedef LAS unsigned short* lbf_t;
__device__ __forceinline__ f32x4 r1_tile(const LAS unsigned short* X, const LAS unsigned short* Yt, int mi, int ni, f32x4 acc, int fr, int fq) {
    const LAS unsigned short* xp = X + (16 * mi + fr) * RLD + 8 * fq; const LAS unsigned short* yp = Yt + (16 * ni + fr) * RLD + 8 * fq;
    const bf16x8 a0 = *(const LAS bf16x8*)xp, a1 = *(const LAS bf16x8*)(xp + 32), b0 = *(const LAS bf16x8*)yp, b1 = *(const LAS bf16x8*)(yp + 32);
    acc = __builtin_amdgcn_mfma_f32_16x16x32_bf16(b0, a0, acc, 0, 0, 0);
    acc = __builtin_amdgcn_mfma_f32_16x16x32_bf16(b1, a1, acc, 0, 0, 0);
    return acc;
}
__device__ __forceinline__ void r1_store(LAS unsigned short* dst, int mi, int ni, f32x4 acc, int mode, bool addI, const LAS unsigned short* addT, int fr, int fq) {
    const int m = 16 * mi + fr, n0 = 16 * ni + 4 * fq;
#pragma unroll
    for (int r = 0; r < 4; ++r) { const int n = n0 + r; bool keep = true;
        if (mode == 1) keep = n < m; else if (mode == 2) keep = n <= m; else if (mode == 3) keep = m < n;
        float v = keep ? acc[r] : 0.f; if (addI && m == n) v += 1.0f; acc[r] = v; }
    if (addT != nullptr) { const unsigned long long w = *(const LAS unsigned long long*)(addT + m * RLD + n0);
        acc[0] += bf_lo((unsigned)w); acc[1] += bf_hi((unsigned)w); acc[2] += bf_lo((unsigned)(w >> 32)); acc[3] += bf_hi((unsigned)(w >> 32)); }
    *(LAS unsigned long long*)(dst + m * RLD + n0) = (unsigned long long)pk2(acc[0], acc[1]) | ((unsigned long long)pk2(acc[2], acc[3]) << 32);
}
__device__ __forceinline__ void r1_store_t(LAS unsigned short* dst, int mi, int ni, f32x4 acc, int fr, int fq) {
    const int m = 16 * mi + fr, n0 = 16 * ni + 4 * fq; const unsigned w01 = pk2(acc[0], acc[1]), w23 = pk2(acc[2], acc[3]);
    dst[(n0 + 0) * RLD + m] = (unsigned short)w01; dst[(n0 + 1) * RLD + m] = (unsigned short)(w01 >> 16); dst[(n0 + 2) * RLD + m] = (unsigned short)w23; dst[(n0 + 3) * RLD + m] = (unsigned short)(w23 >> 16);
}
#define R1BUF(i) ((LAS unsigned short*)(F.lds + (i) * RB))
template <int MODE> __device__ __forceinline__ void p_r1(Frame& F, const Args& args) {
    unsigned char* ws = F.ws; const int lane0 = F.lane, wave = F.wave;
    const bf16* Z = (const bf16*)(ws + WS_Z);
    const float* rkp = ldarg(I_R_RK); const float* mu = ldarg(I_R_MU); const float* w0p = ldarg(I_R_W0); const float* a0p = ldarg(I_R_A0); const float* kkp = ldarg(I_R_KK); const float* kap = ldarg(I_R_KA);
    const float* w1src = ldarg(I_EXP_W1);
    const bf16* W2T = (const bf16*)(ws + WS_LORA); const bf16* A2T = W2T + 512 * 64; const bf16* G2T = A2T + 512 * 64;
    bf16* VM = (bf16*)(ws + WS_VMIX); bf16* GM = (bf16*)(ws + WS_GMIX);
    LAS float* segsum = (LAS float*)(F.lds + R1_SEG); LAS float* wcs = (LAS float*)(F.lds + R1_WC);
    unsigned short zv[7][9];
#define R1LOAD(it_) do { const int bh_ = (it_) >> 7, c_ = (it_) & 127, h_ = bh_ & 7, t0_ = c_ * 64 + 8 * wave; \
        const bf16* zp_ = Z + ((size_t)(bh_ >> 3) * SEQ + t0_) * IN_COLS + OFF_R + lane; \
        _Pragma("unroll") for (int i = 0; i < 9; ++i) { const bool ok_ = (i > 0) || (t0_ > 0); const bf16* rp_ = zp_ + ((long)i - 1) * IN_COLS; const bf16* rq_ = rp_ + 64 * h_;     \
            zv[0][i] = ok_ ? rp_[1536] : (unsigned short)0; zv[1][i] = ok_ ? rp_[1600] : (unsigned short)0; zv[2][i] = ok_ ? rp_[1664] : (unsigned short)0; zv[3][i] = ok_ ? rp_[1728] : (unsigned short)0; \
            zv[4][i] = ok_ ? rq_[0] : (unsigned short)0; zv[5][i] = ok_ ? rq_[512] : (unsigned short)0; zv[6][i] = ok_ ? rq_[1024] : (unsigned short)0; } } while (0)
#define ZF(x) __builtin_bit_cast(float, (unsigned)(x) << 16)
#define R1ITEM(q_) ((((q_) & 15) << 7) + (127 - ((q_) >> 4)))
    { const int lane = lane0; if (F.vcu < N_RITEMS) R1LOAD(R1ITEM(F.vcu)); }
    const float mug0 = mu[1536 + lane0], mug1 = mu[1536 + 64 + lane0], mug2 = mu[1536 + 128 + lane0], mug3 = mu[1536 + 192 + lane0];
    for (int itq = F.vcu; itq < N_RITEMS; itq += F.G) { const int item = R1ITEM(itq);
        const int lane = opq(lane0), fr = lane & 15, fq = lane >> 4;
        const int bh = item >> 7, c = item & 127, b = bh >> 3, h = bh & 7;
        const size_t row0 = (size_t)b * SEQ + (size_t)c * 64;
        const int tid_ = wave * 64 + lane;
        const v4u w2s = *(const GAS v4u*)(W2T + (size_t)(64 * h + (tid_ >> 3)) * 64 + (tid_ & 7) * 8), a2s = *(const GAS v4u*)(A2T + (size_t)(64 * h + (tid_ >> 3)) * 64 + (tid_ & 7) * 8);
        const v4u g2s0 = *(const GAS v4u*)(G2T + (size_t)(64 * h + (tid_ >> 4)) * 128 + (tid_ & 15) * 8), g2s1 = *(const GAS v4u*)(G2T + (size_t)(64 * h + (tid_ >> 4) + 32) * 128 + (tid_ & 15) * 8);
        const int chp = h * 64 + lane;
        const float w0c = w0p[chp], a0c = a0p[chp], kkc = kkp[chp], kac = kap[chp], mur = mu[chp], muk = mu[512 + chp], muv = mu[1024 + chp], rk = rkp[chp];
        __builtin_amdgcn_sched_barrier(0);
        f32x4 tcv[16]; const float* tcW; unsigned char* tcWT; int tck0, tcn0, tcrb;
        w1_tile(itq * 8 + wave, w1src, ws + WS_W1, tcW, tcWT, tck0, tcn0, tcrb); tc8_load(tcW, 2048, tck0, tcn0, lane, tcv);
        __builtin_amdgcn_sched_barrier(0);
        const f32x4 zero4 = (f32x4){0.f, 0.f, 0.f, 0.f};
        const int mw = wave >> 2, nw = wave & 3;
        float r[8], lw[8], kx[8], vx[8], ax[8], bx[8];
        { const int k = lane, tq = wave, ch = h * 64 + k;
#pragma unroll
          for (int g = 0; g < 4; ++g) { const float mug = (g == 0) ? mug0 : (g == 1) ? mug1 : (g == 2) ? mug2 : mug3;
#pragma unroll
              for (int i = 0; i < 8; ++i) { const float cur = ZF(zv[g][i + 1]), prv = ZF(zv[g][i]); float x = cur + (prv - cur) * mug;
                  x = (g == 0) ? fast_tanh(x) : (g == 1) ? x : fast_sigm(x); const unsigned short xb = (unsigned short)f2bf(x); const int t = 8 * tq + i;
                  if (g == 0) R1BUF(11)[t * RLD + k] = xb; else if (g == 1) R1BUF(12)[t * RLD + k] = xb; else R1BUF(13)[t * 136 + 64 * (g - 2) + k] = xb; } }
          { const int row = tid_ >> 3, chk = tid_ & 7;
            *(LAS v4u*)(R1BUF(5) + row * RLD + chk * 8) = w2s;
            *(LAS v4u*)(R1BUF(6) + row * RLD + chk * 8) = a2s;
            { const int rg = (tid_ >> 4), cg = tid_ & 15; *(LAS v4u*)(R1BUF(7) + rg * 136 + cg * 8) = g2s0; *(LAS v4u*)(R1BUF(7) + (rg + 32) * 136 + cg * 8) = g2s1; } }
          __syncthreads();
          { f32x4 dw0, dw1, da0, da1, dg0 = zero4, dg1 = zero4;
            { const LAS unsigned short* yp_ = R1BUF(5) + (16 * nw + fr) * RLD + 8 * fq; const LAS unsigned short* xp_ = R1BUF(11) + (16 * mw + fr) * RLD + 8 * fq;
              const bf16x8 y0_ = *(const LAS bf16x8*)yp_, y1_ = *(const LAS bf16x8*)(yp_ + 32), xa0_ = *(const LAS bf16x8*)xp_, xa1_ = *(const LAS bf16x8*)(xp_ + 32), xb0_ = *(const LAS bf16x8*)(xp_ + 32 * RLD), xb1_ = *(const LAS bf16x8*)(xp_ + 32 * RLD + 32);
              dw0 = __builtin_amdgcn_mfma_f32_16x16x32_bf16(y0_, xa0_, zero4, 0, 0, 0); dw1 = __builtin_amdgcn_mfma_f32_16x16x32_bf16(y0_, xb0_, zero4, 0, 0, 0);
              dw0 = __builtin_amdgcn_mfma_f32_16x16x32_bf16(y1_, xa1_, dw0, 0, 0, 0); dw1 = __builtin_amdgcn_mfma_f32_16x16x32_bf16(y1_, xb1_, dw1, 0, 0, 0); }
            { const LAS unsigned short* yp_ = R1BUF(6) + (16 * nw + fr) * RLD + 8 * fq; const LAS unsigned short* xp_ = R1BUF(12) + (16 * mw + fr) * RLD + 8 * fq;
              const bf16x8 y0_ = *(const LAS bf16x8*)yp_, y1_ = *(const LAS bf16x8*)(yp_ + 32), xa0_ = *(const LAS bf16x8*)xp_, xa1_ = *(const LAS bf16x8*)(xp_ + 32), xb0_ = *(const LAS bf16x8*)(xp_ + 32 * RLD), xb1_ = *(const LAS bf16x8*)(xp_ + 32 * RLD + 32);
              da0 = __builtin_amdgcn_mfma_f32_16x16x32_bf16(y0_, xa0_, zero4, 0, 0, 0); da1 = __builtin_amdgcn_mfma_f32_16x16x32_bf16(y0_, xb0_, zero4, 0, 0, 0);
              da0 = __builtin_amdgcn_mfma_f32_16x16x32_bf16(y1_, xa1_, da0, 0, 0, 0); da1 = __builtin_amdgcn_mfma_f32_16x16x32_bf16(y1_, xb1_, da1, 0, 0, 0); }
            { const LAS unsigned short* yp_ = R1BUF(7) + (16 * nw + fr) * 136 + 8 * fq; const LAS unsigned short* xp_ = R1BUF(13) + (16 * mw + fr) * 136 + 8 * fq;
#pragma unroll
              for (int kk = 0; kk < 4; ++kk) { const bf16x8 y_ = *(const LAS bf16x8*)(yp_ + 32 * kk), xa_ = *(const LAS bf16x8*)(xp_ + 32 * kk), xb_ = *(const LAS bf16x8*)(xp_ + 32 * 136 + 32 * kk);
                  dg0 = __builtin_amdgcn_mfma_f32_16x16x32_bf16(y_, xa_, dg0, 0, 0, 0); dg1 = __builtin_amdgcn_mfma_f32_16x16x32_bf16(y_, xb_, dg1, 0, 0, 0); } }
            const int o0 = (16 * mw + fr) * 68 + 16 * nw + 4 * fq, o1 = o0 + 32 * 68;
            *(LAS f32x4*)((LAS float*)R1BUF(0) + o0) = dw0; *(LAS f32x4*)((LAS float*)R1BUF(0) + o1) = dw1;
            *(LAS f32x4*)((LAS float*)R1BUF(2) + o0) = da0; *(LAS f32x4*)((LAS float*)R1BUF(2) + o1) = da1;
            *(LAS f32x4*)((LAS float*)R1BUF(9) + o0) = dg0; *(LAS f32x4*)((LAS float*)R1BUF(9) + o1) = dg1; }
          __syncthreads();
          {
#pragma unroll
            for (int i = 0; i < 8; ++i) { const int t = 8 * tq + i;
                const float dwv = ((const LAS float*)R1BUF(0))[t * 68 + k], dav = ((const LAS float*)R1BUF(2))[t * 68 + k], dgv = ((const LAS float*)R1BUF(9))[t * 68 + k];
                const float cr = ZF(zv[4][i + 1]), pr = ZF(zv[4][i]), ck = ZF(zv[5][i + 1]), pk = ZF(zv[5][i]), cv = ZF(zv[6][i + 1]), pv = ZF(zv[6][i]);
                const float rr = cr + (pr - cr) * mur, kr = ck + (pk - ck) * muk, vr = cv + (pv - cv) * muv;
                const float y = -(w0c + dwv); const float sp = fast_softplus(y);
                lw[i] = -__expf(-sp - 0.5f);
                const float av = fast_sigm(a0c + dav);
                const float kkv = kr * kkc; const float ssq = wave_sum(kkv * kkv); const float kkn = kkv * __builtin_amdgcn_rsqf(fmaxf(ssq, 1e-24f));
                r[i] = rr; vx[i] = vr; kx[i] = kr * (1.0f + (av - 1.0f) * kac); ax[i] = -kkn; bx[i] = kkn * av;
                if (MODE == 0) { VM[(row0 + t) * RW + ch] = (bf16)f2bf(vr); GM[(row0 + t) * RW + ch] = (bf16)f2bf(dgv); } } }
        }
        if (itq + F.G < N_RITEMS) R1LOAD(R1ITEM(itq + F.G));
        { const int k = lane, tq = wave;
          float cs[8]; cs[0] = lw[0];
#pragma unroll
          for (int i = 1; i < 8; ++i) cs[i] = cs[i - 1] + lw[i];
          segsum[tq * 64 + k] = cs[7];
#pragma unroll
          for (int i = 0; i < 8; ++i) { const float bs = wave_sum(r[i] * kx[i] * rk); if (MODE == 0 && lane == 0) *(GAS float*)((float*)(ws + WS_BONUS) + (row0 + 8 * tq + i) * 8 + h) = bs; }
          __syncthreads();
          float pre = 0.f;
#pragma unroll
          for (int q = 0; q < 7; ++q) { const float sv = segsum[q * 64 + k]; pre += (q < tq) ? sv : 0.f; }
          unsigned short at[8], rt[8], bt[8], kt[8], vt[8];
#pragma unroll
          for (int i = 0; i < 8; ++i) { const float L = pre + cs[i], Lp = L - lw[i]; const float e = __expf(L), ep = __expf(Lp), ei = __expf(-L);
              at[i] = (unsigned short)f2bf(ax[i] * ep); rt[i] = (unsigned short)f2bf(r[i] * e); bt[i] = (unsigned short)f2bf(bx[i] * ei); kt[i] = (unsigned short)f2bf(kx[i] * ei); vt[i] = (unsigned short)f2bf(vx[i]);
              if (i == 7 && tq == 7) wcs[k] = e; }
#pragma unroll
          for (int i = 0; i < 8; ++i) { const int o = (8 * tq + i) * RLD + k; R1BUF(8)[o] = at[i]; R1BUF(4)[o] = rt[i]; R1BUF(9)[o] = bt[i]; R1BUF(10)[o] = kt[i]; }
          const int ot = k * RLD + 8 * tq;
#define PK8(x) ((v4u){(unsigned)x[0] | ((unsigned)x[1] << 16), (unsigned)x[2] | ((unsigned)x[3] << 16), (unsigned)x[4] | ((unsigned)x[5] << 16), (unsigned)x[6] | ((unsigned)x[7] << 16)})
          *(LAS v4u*)(R1BUF(0) + ot) = PK8(at); *(LAS v4u*)(R1BUF(1) + ot) = PK8(bt); *(LAS v4u*)(R1BUF(2) + ot) = PK8(kt); *(LAS v4u*)(R1BUF(3) + ot) = PK8(vt);
#undef PK8
        }
        __syncthreads();
#define R1PAIR(X, Y, a0, a1) do { const LAS unsigned short* yp_ = (Y) + (16 * nw + fr) * RLD + 8 * fq; const LAS unsigned short* xp_ = (X) + (16 * mw + fr) * RLD + 8 * fq; \
            const bf16x8 y0_ = *(const LAS bf16x8*)yp_, y1_ = *(const LAS bf16x8*)(yp_ + 32), xa0_ = *(const LAS bf16x8*)xp_, xa1_ = *(const LAS bf16x8*)(xp_ + 32), xb0_ = *(const LAS bf16x8*)(xp_ + 32 * RLD), xb1_ = *(const LAS bf16x8*)(xp_ + 32 * RLD + 32); \
            a0 = __builtin_amdgcn_mfma_f32_16x16x32_bf16(y0_, xa0_, zero4, 0, 0, 0); a1 = __builtin_amdgcn_mfma_f32_16x16x32_bf16(y0_, xb0_, zero4, 0, 0, 0); \
            a0 = __builtin_amdgcn_mfma_f32_16x16x32_bf16(y1_, xa1_, a0, 0, 0, 0); a1 = __builtin_amdgcn_mfma_f32_16x16x32_bf16(y1_, xb1_, a1, 0, 0, 0); } while (0)
#define R1ST2(dst, a0, a1, mode, addI, addT) do { r1_store(dst, mw, nw, a0, mode, addI, addT, fr, fq); r1_store(dst, mw + 2, nw, a1, mode, addI, addT, fr, fq); } while (0)
        { f32x4 n0, n1, t0, t1, l0, l1, b0, b1, k0, k1;
          R1PAIR(R1BUF(8), R1BUF(9), n0, n1); R1PAIR(R1BUF(9), R1BUF(8), t0, t1); R1PAIR(R1BUF(8), R1BUF(10), l0, l1); R1PAIR(R1BUF(4), R1BUF(9), b0, b1); R1PAIR(R1BUF(4), R1BUF(10), k0, k1);
          R1ST2(R1BUF(11), n0, n1, 1, false, nullptr); R1ST2(R1BUF(13), n0, n1, 1, true, nullptr); R1ST2(R1BUF(12), t0, t1, 3, false, nullptr);
          R1ST2(R1BUF(5), l0, l1, 1, false, nullptr); R1ST2(R1BUF(6), b0, b1, 2, false, nullptr); R1ST2(R1BUF(7), k0, k1, 2, false, nullptr); }
        __syncthreads();
        { f32x4 t0, t1, e0, e1;
          R1PAIR(R1BUF(12), R1BUF(11), t0, t1); R1PAIR(R1BUF(3), R1BUF(5), e0, e1);
          R1ST2(R1BUF(9), t0, t1, 0, false, nullptr); r1_store_t(R1BUF(8), mw, nw, t0, fr, fq); r1_store_t(R1BUF(8), mw + 2, nw, t1, fr, fq); R1ST2(R1BUF(10), e0, e1, 0, false, nullptr); }
        __syncthreads();
#pragma unroll 1
        for (int lv = 0; lv < 5; ++lv) {
            const bool srcB = (lv & 1) == 0;
            LAS unsigned short* sN = srcB ? R1BUF(8) : R1BUF(11); LAS unsigned short* sNT = srcB ? R1BUF(9) : R1BUF(12);
            LAS unsigned short* dN = srcB ? R1BUF(11) : R1BUF(8); LAS unsigned short* dNT = srcB ? R1BUF(12) : R1BUF(9);
            LAS unsigned short* Tc = (lv & 1) ? R1BUF(14) : R1BUF(13); LAS unsigned short* Tn = (lv & 1) ? R1BUF(13) : R1BUF(14);
            f32x4 u0, u1, t0 = zero4, t1 = zero4;
            R1PAIR(Tc, sNT, u0, u1);
            if (lv < 4) R1PAIR(sNT, sN, t0, t1);
            R1ST2(Tn, u0, u1, 0, false, Tc);
            if (lv < 4) R1ST2(dNT, t0, t1, 0, false, nullptr);
            if (lv < 3) { r1_store_t(dN, mw, nw, t0, fr, fq); r1_store_t(dN, mw + 2, nw, t1, fr, fq); }
            __syncthreads();
        }
        { f32x4 g0, g1, q0, q1;
          R1PAIR(R1BUF(0), R1BUF(14), g0, g1); R1PAIR(R1BUF(10), R1BUF(14), q0, q1);
          R1ST2(R1BUF(11), g0, g1, 0, false, nullptr); R1ST2(R1BUF(12), q0, q1, 0, false, nullptr); }
        __syncthreads();
#undef R1PAIR
#undef R1ST2
        { const int mi = wave >> 1, ks = wave & 1;
          const f32x4 p0 = r1_tile(R1BUF(1), R1BUF(11), mi, 2 * ks, zero4, fr, fq), p1 = r1_tile(R1BUF(1), R1BUF(11), mi, 2 * ks + 1, zero4, fr, fq);
          const f32x4 s0 = r1_tile(R1BUF(6), R1BUF(11), mi, 2 * ks, zero4, fr, fq), s1 = r1_tile(R1BUF(6), R1BUF(11), mi, 2 * ks + 1, zero4, fr, fq);
          const int m = 16 * mi + fr; const float wc = wcs[m];
          float ph[8], ps[8];
#pragma unroll
          for (int r = 0; r < 4; ++r) { const int n0 = 32 * ks + 4 * fq + r, n1 = n0 + 16;
              ph[r] = (p0[r] + (m == n0 ? 1.f : 0.f)) * wc; ph[4 + r] = (p1[r] + (m == n1 ? 1.f : 0.f)) * wc; }
          { const unsigned long long w0 = *(const LAS unsigned long long*)(R1BUF(4) + m * RLD + 32 * ks + 4 * fq), w1 = *(const LAS unsigned long long*)(R1BUF(4) + m * RLD + 32 * ks + 16 + 4 * fq);
            ps[0] = s0[0] + bf_lo((unsigned)w0); ps[1] = s0[1] + bf_hi((unsigned)w0); ps[2] = s0[2] + bf_lo((unsigned)(w0 >> 32)); ps[3] = s0[3] + bf_hi((unsigned)(w0 >> 32));
            ps[4] = s1[0] + bf_lo((unsigned)w1); ps[5] = s1[1] + bf_hi((unsigned)w1); ps[6] = s1[2] + bf_lo((unsigned)(w1 >> 32)); ps[7] = s1[3] + bf_hi((unsigned)(w1 >> 32)); }
          const size_t fo = (((size_t)item * 4 + mi) * 2 + ks) * 64 + lane;
          if (MODE == 0) *((GAS v4u*)(ws + WS_PHI) + fo) = (v4u){pk2(ph[0], ph[1]), pk2(ph[2], ph[3]), pk2(ph[4], ph[5]), pk2(ph[6], ph[7])};
          if (MODE == 0) *((GAS v4u*)(ws + WS_PSI) + fo) = (v4u){pk2(ps[0], ps[1]), pk2(ps[2], ps[3]), pk2(ps[4], ps[5]), pk2(ps[6], ps[7])};
          const int vb = wave >> 1;
#pragma unroll
          for (int hh = 0; hh < 2; ++hh) { const int mt = 2 * (wave & 1) + hh;
              f32x4 ga = r1_tile(R1BUF(12), R1BUF(1), vb, mt, zero4, fr, fq); ga = r1_tile(R1BUF(3), R1BUF(2), vb, mt, ga, fr, fq);
              f32x4 om = r1_tile(R1BUF(12), R1BUF(6), vb, mt, zero4, fr, fq); om = r1_tile(R1BUF(3), R1BUF(7), vb, mt, om, fr, fq);
#pragma unroll
              for (int r = 0; r < 4; ++r) ga[r] *= wcs[16 * mt + 4 * fq + r];
              const size_t ao = (((size_t)item * 4 + vb) * 4 + mt) * 64 + lane;
              if (MODE == 0) { *((GAS unsigned long long*)(ws + WS_GAM) + ao) = (unsigned long long)pk2(ga[0], ga[1]) | ((unsigned long long)pk2(ga[2], ga[3]) << 32); *((GAS unsigned long long*)(ws + WS_OM) + ao) = (unsigned long long)pk2(om[0], om[1]) | ((unsigned long long)pk2(om[2], om[3]) << 32); } else { asm volatile("" :: "v"(ga), "v"(om)); } }
        }
        tc8_store(tcWT, 1024, tck0, tcrb, lane, tcv, W8_SCALE);
        __syncthreads();
    }
}
#undef R1BUF
#undef R1LOAD
#undef ZF
constexpr bool R2_HELPER = false;
struct R2Buf { bf16x8 ph[4][2]; unsigned long long ga[4]; };
__device__ __forceinline__ void r2_load(R2Buf& B, const unsigned char* ws, int item, int vb, int lane) {
#pragma unroll
    for (int mt = 0; mt < 4; ++mt) {
#pragma unroll
        for (int ks = 0; ks < 2; ++ks) B.ph[mt][ks] = *((const GAS bf16x8*)(ws + WS_PHI) + (((size_t)item * 4 + mt) * 2 + ks) * 64 + lane);
        B.ga[mt] = *((const GAS unsigned long long*)(ws + WS_GAM) + (((size_t)item * 4 + vb) * 4 + mt) * 64 + lane); }
}
__device__ __forceinline__ void r2_step(const R2Buf& B, f32x4 (&acc)[4], unsigned char* ws, int item, int vb, int lane) {
    v4u x0, x1;
    x0.x = pk2(acc[0][0], acc[0][1]); x0.y = pk2(acc[0][2], acc[0][3]); x0.z = pk2(acc[1][0], acc[1][1]); x0.w = pk2(acc[1][2], acc[1][3]);
    x1.x = pk2(acc[2][0], acc[2][1]); x1.y = pk2(acc[2][2], acc[2][3]); x1.z = pk2(acc[3][0], acc[3][1]); x1.w = pk2(acc[3][2], acc[3][3]);
    GAS v4u* xo = (GAS v4u*)(ws + WS_XFR) + (((size_t)item * 4 + vb) * 2) * 64 + lane; xo[0] = x0; xo[64] = x1;
    const bf16x8 f0 = __builtin_bit_cast(bf16x8, x0), f1 = __builtin_bit_cast(bf16x8, x1);
#pragma unroll
    for (int mt = 0; mt < 4; ++mt) { const unsigned g0 = (unsigned)B.ga[mt], g1 = (unsigned)(B.ga[mt] >> 32);
        f32x4 a; a[0] = __builtin_bit_cast(float, g0 << 16); a[1] = __builtin_bit_cast(float, g0 & 0xffff0000u); a[2] = __builtin_bit_cast(float, g1 << 16); a[3] = __builtin_bit_cast(float, g1 & 0xffff0000u);
        a = __builtin_amdgcn_mfma_f32_16x16x32_bf16(B.ph[mt][0], f0, a, 0, 0, 0);
        a = __builtin_amdgcn_mfma_f32_16x16x32_bf16(B.ph[mt][1], f1, a, 0, 0, 0);
        acc[mt] = a; }
}
__device__ __forceinline__ void p_r2(Frame& F) {
    if (blockIdx.x < BATCH * 8 * 4 && F.wave == 0) {
        unsigned char* ws = F.ws; const int bh = blockIdx.x >> 2, vb = blockIdx.x & 3, lane = F.lane;
        f32x4 acc[4];
#pragma unroll
        for (int i = 0; i < 4; ++i) acc[i] = (f32x4){0.f, 0.f, 0.f, 0.f};
        R2Buf A, B, C, D, E;
        const int it0 = bh * 128;
        r2_load(A, ws, it0, vb, lane); r2_load(B, ws, it0 + 1, vb, lane); r2_load(C, ws, it0 + 2, vb, lane); r2_load(D, ws, it0 + 3, vb, lane);
#define R2SB() __builtin_amdgcn_sched_barrier(0)
#define R2IT(c_) (it0 + ((c_) < 128 ? (c_) : 127))
#pragma unroll
        for (int c = 0; c < 125; c += 5) {
            r2_load(E, ws, R2IT(c + 4), vb, lane); R2SB(); r2_step(A, acc, ws, it0 + c, vb, lane); R2SB();
            r2_load(A, ws, R2IT(c + 5), vb, lane); R2SB(); r2_step(B, acc, ws, it0 + c + 1, vb, lane); R2SB();
            r2_load(B, ws, R2IT(c + 6), vb, lane); R2SB(); r2_step(C, acc, ws, it0 + c + 2, vb, lane); R2SB();
            r2_load(C, ws, R2IT(c + 7), vb, lane); R2SB(); r2_step(D, acc, ws, it0 + c + 3, vb, lane); R2SB();
            r2_load(D, ws, R2IT(c + 8), vb, lane); R2SB(); r2_step(E, acc, ws, it0 + c + 4, vb, lane); R2SB();
        }
        r2_step(A, acc, ws, it0 + 125, vb, lane); R2SB(); r2_step(B, acc, ws, it0 + 126, vb, lane); R2SB(); r2_step(C, acc, ws, it0 + 127, vb, lane);
#undef R2IT
#undef R2SB
    }
}
__device__ __forceinline__ void p_r3(Frame& F, const Args& args) {
    const int gw = F.vcu * NWAVES + F.wave, NGW = F.G * NWAVES, lane = F.lane, cc = lane & 15, q = lane >> 4;
    unsigned char* ws = F.ws;
    const bf16* VM = (const bf16*)(ws + WS_VMIX); const bf16* GM = (const bf16*)(ws + WS_GMIX);
    const float* bonus = (const float*)(ws + WS_BONUS);
    bf16* YB = (bf16*)(ws + WS_YABC) + 512;
    const float* lnw = ldarg(I_R_LNW); const float* lnb = ldarg(I_R_LNB);
#pragma unroll 2
    for (int wi = gw; wi < N_RITEMS * 4; wi += NGW) {
        const int item = wi >> 2, tt = wi & 3, bh = item >> 7, c = item & 127, b = bh >> 3, h = bh & 7;
        const bf16x8 ps0 = *((const GAS bf16x8*)(ws + WS_PSI) + (((size_t)item * 4 + tt) * 2 + 0) * 64 + lane), ps1 = *((const GAS bf16x8*)(ws + WS_PSI) + (((size_t)item * 4 + tt) * 2 + 1) * 64 + lane);
        f32x4 acc[4];
#pragma unroll
        for (int vb = 0; vb < 4; ++vb) {
            const bf16x8 x0 = *((const GAS bf16x8*)(ws + WS_XFR) + (((size_t)item * 4 + vb) * 2 + 0) * 64 + lane), x1 = *((const GAS bf16x8*)(ws + WS_XFR) + (((size_t)item * 4 + vb) * 2 + 1) * 64 + lane);
            f32x4 a; { const unsigned long long w_ = *((const GAS unsigned long long*)(ws + WS_OM) + (((size_t)item * 4 + vb) * 4 + tt) * 64 + lane); const unsigned g0 = (unsigned)w_, g1 = (unsigned)(w_ >> 32);
              a[0] = __builtin_bit_cast(float, g0 << 16); a[1] = __builtin_bit_cast(float, g0 & 0xffff0000u); a[2] = __builtin_bit_cast(float, g1 << 16); a[3] = __builtin_bit_cast(float, g1 & 0xffff0000u); }
            a = __builtin_amdgcn_mfma_f32_16x16x32_bf16(ps0, x0, a, 0, 0, 0);
            a = __builtin_amdgcn_mfma_f32_16x16x32_bf16(ps1, x1, a, 0, 0, 0);
            acc[vb] = a; }
        const size_t rowb = (size_t)b * SEQ + (size_t)c * 64 + 16 * tt + 4 * q;
        unsigned short vmr[4][4], gmr[4][4]; float bnr[4], lw4[4], lb4[4];
#pragma unroll
        for (int vb = 0; vb < 4; ++vb) { const int ch = h * 64 + 16 * vb + cc; lw4[vb] = lnw[ch]; lb4[vb] = lnb[ch]; }
#pragma unroll
        for (int r = 0; r < 4; ++r) { const size_t t = rowb + r; bnr[r] = bonus[t * 8 + h];
#pragma unroll
            for (int vb = 0; vb < 4; ++vb) { const int ch = h * 64 + 16 * vb + cc; vmr[r][vb] = VM[t * RW + ch]; gmr[r][vb] = GM[t * RW + ch]; } }
#pragma unroll
        for (int r = 0; r < 4; ++r) { const size_t t = rowb + r;
            const float s = (acc[0][r] + acc[1][r]) + (acc[2][r] + acc[3][r]);
            const float mean = row16_sum(s) * (1.f / 64.f);
            const float d0 = acc[0][r] - mean, d1 = acc[1][r] - mean, d2 = acc[2][r] - mean, d3 = acc[3][r] - mean;
            const float var = row16_sum((d0 * d0 + d1 * d1) + (d2 * d2 + d3 * d3)) * (1.f / 64.f);
            const float rstd = __builtin_amdgcn_rsqf(var + R_GN_EPS);
            const float bn = bnr[r];
#pragma unroll
            for (int vb = 0; vb < 4; ++vb) { const int ch = h * 64 + 16 * vb + cc; const float d = (vb == 0) ? d0 : (vb == 1) ? d1 : (vb == 2) ? d2 : d3;
                const float yn = d * rstd * lw4[vb] + lb4[vb];
                const float vv = __builtin_bit_cast(float, (unsigned)vmr[r][vb] << 16), gg = __builtin_bit_cast(float, (unsigned)gmr[r][vb] << 16);
                YB[t * 1536 + ch] = (bf16)f2bf((yn + bn * vv) * gg); } }
    }
}

__global__ void __launch_bounds__(NWAVES * 64, 2) skel_fwd(Args args) {
    extern __shared__ __attribute__((aligned(16))) unsigned char lds[];
    Frame F;
    F.lds = (LAS unsigned char*)lds;
    F.MISC = (volatile LAS unsigned*)(F.lds + MISC_OFF);
    phase_enter(F, true);
    F.G = gridDim.x; { const int bx = blockIdx.x; F.vcu = (F.G % 8 == 0) ? (bx % 8) * (F.G / 8) + bx / 8 : bx; }
    unsigned char* ws = args.ws; F.ws = ws; F.out = args.out;
    F.ctl = (gu32*)(ws + WS_CTL);
    for (int u = F.tid; u < (LDS_BYTES - LDSCTL_OFF) / 4; u += NWAVES * 64) ((LAS unsigned*)(F.lds + LDSCTL_OFF))[u] = 0u;
    __syncthreads();
    XcdBarrier bar; bar.bar = (unsigned*)(F.ctl + CW_BAR); bar.x = 0; bar.st = nullptr;
    if (args.use_bar) bar = xcd_barrier_post((unsigned*)(F.ctl + CW_BAR), F.MISC + 8);
    const int lo = args.ph_lo, hi = args.ph_hi;
#define IN(k) (phase_enter(F, lo <= (k) && (k) < hi))
#define SEAM(k) do { if (lo <= (k) && (k) + 1 < hi) xcd_barrier(bar); } while (0)
    const pg8::bf16_t* wsb = (const pg8::bf16_t*)ws;
#define BF(off) ((pg8::bf16_t*)(ws + (off)))

    if (IN(0)) { p0_prologue<0>(F, args, F.vcu * NWAVES + F.wave, F.G * NWAVES); if (F.G <= 64) p0_prologue<1>(F, args, F.vcu * NWAVES + F.wave, F.G * NWAVES); } SEAM(0);
    if (IN(1)) {
        const float* ckg_ = ldarg(I_CK_GAIN);
        pg8::EpiZ E{BF(WS_Z), ldarg(I_B_GATE), ldarg(I_AQ_GAIN), ldarg(I_AK_GAIN), ldarg(I_CQ_GAIN), (const float*)(ws + WS_CS), BF(WS_KVM), ckg_, (PG8_LAS float*)(F.lds + 131072)};
        { pg8::Gemm g{BF(WS_XN), BF(WS_WIN), MTOK + MEMROWS, IN_COLS + 1024, 1024}; pg8::ZOrder<0> S; S.init(F.G, (int)blockIdx.x);
          pg8::gemm_phase<pg8::EpiZ, pg8::ZOrder<0>, true, true>(F.lds + RING_OFF, g, S, E); }
        { pg8::Gemm g{BF(WS_XN8), BF(WS_WIN8), MTOK, IN_COLS, 1024, SC_ONE, SC_W8}; pg8::ZOrder<1> S; S.init(F.G, (int)blockIdx.x);
          pg8::gemm_phase<pg8::EpiZ, pg8::ZOrder<1>, true, true, true>(F.lds + RING_OFF, g, S, E); }
    } SEAM(1);
#if NAIVE_ATTN
    if (IN(3)) { p3_attention(F); } SEAM(3);
#else
    if (IN(3)) { p3_attention_mfma(ws, (char*)lds + RING_OFF, F.G); __syncthreads(); phase_enter(F, true); p_r1<0>(F, args); } SEAM(3);
#endif
    if (IN(4)) { p_r2(F); if (F.G > 64 && blockIdx.x >= 64) p0_prologue<1>(F, args, ((int)blockIdx.x - 64) * NWAVES + F.wave, (F.G - 64) * NWAVES); } SEAM(4);
    if (IN(5)) { p_r3(F, args); p5_post(F, args); } SEAM(5);
    if (IN(6)) {
        pg8::Gemm g{BF(WS_YABC), BF(WS_WB), MTOK, 1024, 1536}; pg8::StaticOrder S; S.init(MTOK, 1024, F.G, (int)blockIdx.x);
        pg8::EpiGate3 E{BF(WS_Z), BF(WS_MRGB)};
        pg8::gemm_phase<pg8::EpiGate3, pg8::StaticOrder, true, true>(F.lds + RING_OFF, g, S, E);
    } SEAM(6);
    if (IN(7)) {
        pg8::Gemm g{BF(WS_MRGB), BF(WS_WO), MTOK, 1024, 1024, SC_M8, SC_W8}; pg8::StaticOrder S; S.init(MTOK, 1024, F.G, (int)blockIdx.x);
        pg8::EpiResInit E{ldarg(I_X), F.out, 1024};
        pg8::gemm_phase<pg8::EpiResInit, pg8::StaticOrder, true, true, MRG_FP8>(F.lds + RING_OFF, g, S, E);
    } SEAM(7);
    if (IN(8)) { p8_router(F, args); } SEAM(8);
    if (IN(9)) { p9_dispatch(F, args); } SEAM(9);
    if (IN(10)) {
        if (!args.use_bar) moe_table(F);
        pg8::Gemm g{BF(WS_XS), BF(WS_W1), 0, 0, 1024, SC_ONE, SC_W8}; pg8::MoeOrder S{(const PG8_LAS int*)(F.lds + MOETAB_OFF), 8, F.G, (int)blockIdx.x};
        pg8::EpiSwiGLU E{ldarg(I_EXP_B1), BF(WS_HACT)};
        pg8::gemm_phase<pg8::EpiSwiGLU, pg8::MoeOrder, true, true, true>(F.lds + RING_OFF, g, S, E);
    } SEAM(10);
    if (IN(11)) {
        if (!args.use_bar) moe_table(F);
        pg8::Gemm g{BF(WS_HACT), BF(WS_W2), 0, 0, 1024, SC_H8, SC_W8}; pg8::MoeOrder S{(const PG8_LAS int*)(F.lds + MOETAB_OFF), 4, F.G, (int)blockIdx.x};
        pg8::EpiMoeOut E{ldarg(I_EXP_B2), (const float*)(ws + WS_ROUTE + RT_ROWGATE), BF(WS_YROWS)};
        pg8::gemm_phase<pg8::EpiMoeOut, pg8::MoeOrder, true, true, true>(F.lds + RING_OFF, g, S, E);
    } SEAM(11);
    if (IN(12)) { p12_combine(F); }
#undef IN
#undef SEAM
#undef BF
    (void)wsb;
}

extern "C" void kernel_launch(void* const* d_in, const int* in_sizes, int n_in, void* d_out, int out_size, void* d_ws, size_t ws_size, hipStream_t stream) {
    static int grid = 0;
    if (grid == 0) {
        if (n_in != 32 || out_size != MTOK * D_MODEL || ws_size < WS_END) { fprintf(stderr, "kernel_launch: unexpected problem (n_in %d, out %d, ws %zu); nothing launched\n", n_in, out_size, ws_size); grid = -1; return; }
        int dev = 0, cus = 0;
        if (hipGetDevice(&dev) != hipSuccess || hipDeviceGetAttribute(&cus, hipDeviceAttributeMultiprocessorCount, dev) != hipSuccess) { grid = -1; return; }
        if (hipFuncSetAttribute((const void*)skel_fwd, hipFuncAttributeMaxDynamicSharedMemorySize, LDS_BYTES) != hipSuccess) { fprintf(stderr, "kernel_launch: hipFuncSetAttribute failed\n"); grid = -1; return; }
        (void)hipGetLastError();
        grid = cus;
    }
    if (grid < 0) return;
    (void)hipMemsetAsync((char*)d_ws + WS_CTL, 0, CTL_ZERO_BYTES, stream);
    Args a{};
    for (int i = 0; i < 32; ++i) a.in[i] = (const float*)d_in[i];
    a.out = (float*)d_out; a.ws = (unsigned char*)d_ws;
#if MK_N_LAUNCHES == 1
    a.ph_lo = 0; a.ph_hi = N_PHASES; a.use_bar = 1;
    hipLaunchKernelGGL(skel_fwd, dim3(grid), dim3(NWAVES * 64), LDS_BYTES, stream, a);
#else
    for (int p = 0; p < N_PHASES; ++p) { a.ph_lo = p; a.ph_hi = p + 1; a.use_bar = 0;
        hipLaunchKernelGGL(skel_fwd, dim3(grid), dim3(NWAVES * 64), LDS_BYTES, stream, a); }
#endif
}
```
